# Optimizing an MI355X kernel written in HIP

```python
import math
import jax
import jax.numpy as jnp
from jax import lax
import numpy as np

D_MODEL = 1024
BATCH = 4
SEQ = 4096
DEPTH = 2
DEC_BATCH = 128
DEC_SEQ = 4
PAST_LEN = 2048
PAGE_SIZE = 128

HEAD_DIM = 64
MIX_WIDTH = D_MODEL
N_GDN_HEADS = (MIX_WIDTH // 2) // HEAD_DIM
GDN_W = N_GDN_HEADS * HEAD_DIM
N_NSA_HEADS = (MIX_WIDTH - GDN_W) // HEAD_DIM
NSA_W = N_NSA_HEADS * HEAD_DIM
N_KV_HEADS = max(1, N_NSA_HEADS // 4)
GQA_GROUP = N_NSA_HEADS // N_KV_HEADS
KV_W = N_KV_HEADS * HEAD_DIM
CONV_W = 4
GDN_CHUNK = 64
CMP_BLOCK = 32
SEL_BLOCK = 64
TOP_K = 16
WINDOW = 512
NSA_QBLOCK = 64
WIN_QBLOCK = 128
D_FF = 4 * D_MODEL
ROPE_THETA = 10000.0
NORM_EPS = 1e-6
PROJ_WIDTHS = (3 * GDN_W, GDN_W, N_GDN_HEADS, N_GDN_HEADS, NSA_W, 6 * KV_W, 3 * N_NSA_HEADS)
D_PROJ = sum(PROJ_WIDTHS)

kernel_name = 'hymba_gdn_nsa_step'


def rmsnorm(x, g):
    xf = x.astype(jnp.float32)
    y = xf * lax.rsqrt(jnp.mean(xf * xf, axis=-1, keepdims=True) + NORM_EPS)
    return (y * g.astype(jnp.float32)).astype(x.dtype)


def l2norm(x):
    return x * lax.rsqrt(jnp.sum(x * x, axis=-1, keepdims=True) + NORM_EPS)


def rope(x, pos):
    half = HEAD_DIM // 2
    inv_freq = ROPE_THETA ** (-jnp.arange(half, dtype=jnp.float32) / half)
    ang = pos.astype(jnp.float32)[:, None] * inv_freq[None, :]
    cos = jnp.cos(ang)[None, :, None, :]
    sin = jnp.sin(ang)[None, :, None, :]
    xf = x.astype(jnp.float32)
    x1, x2 = xf[..., :half], xf[..., half:]
    return jnp.concatenate([x1 * cos - x2 * sin, x2 * cos + x1 * sin], axis=-1).astype(x.dtype)


def masked_softmax(s, mask):
    s = jnp.where(mask, s, -jnp.inf)
    m = jnp.max(s, axis=-1, keepdims=True)
    m = jnp.where(jnp.isfinite(m), m, 0.0)
    e = jnp.exp(s - m)
    return e / jnp.maximum(jnp.sum(e, axis=-1, keepdims=True), 1e-30)


def project(x, norm_g, w_in):
    b, t, _ = x.shape
    h = rmsnorm(x, norm_g)
    cuts = np.cumsum(PROJ_WIDTHS)[:-1].tolist()
    qkv_pre, z, a, beta_logit, q, kv6, gate_logit = jnp.split(h @ w_in, cuts, axis=-1)
    return (qkv_pre, z, a, beta_logit,
            q.reshape(b, t, N_NSA_HEADS, HEAD_DIM),
            kv6.reshape(b, t, 6, N_KV_HEADS, HEAD_DIM),
            gate_logit.reshape(b, t, N_NSA_HEADS, 3))


def gated_delta(q, k, v, g, beta, s0):
    b, t, h, dk = q.shape
    dv = v.shape[-1]
    c = GDN_CHUNK
    n = -(-t // c)
    pad = n * c - t

    def chunks(a):
        a = jnp.pad(a.astype(jnp.float32), [(0, 0), (0, pad)] + [(0, 0)] * (a.ndim - 2))
        a = a.reshape((b, n, c) + a.shape[2:])
        return jnp.moveaxis(a, 3, 2).swapaxes(0, 1)

    qc, kc, vc, gc, bc = chunks(q), chunks(k), chunks(v), chunks(g), chunks(beta)
    gcum = jnp.cumsum(gc, axis=-1)
    incl = jnp.tril(jnp.ones((c, c), dtype=bool))
    strict = jnp.tril(jnp.ones((c, c), dtype=bool), -1)
    decay = jnp.exp(jnp.where(incl, gcum[..., :, None] - gcum[..., None, :], -jnp.inf))
    a_mat = jnp.where(strict, bc[..., :, None] * jnp.einsum('nbhid,nbhjd->nbhij', kc, kc) * decay, 0.0)
    eye = jnp.broadcast_to(jnp.eye(c, dtype=jnp.float32), a_mat.shape)
    t_inv = lax.linalg.triangular_solve(a_mat + eye, eye, left_side=True, lower=True)
    w = jnp.einsum('nbhij,nbhjd->nbhid', t_inv, kc * (bc * jnp.exp(gcum))[..., None])
    u0 = jnp.einsum('nbhij,nbhjd->nbhid', t_inv, vc * bc[..., None])
    qk = jnp.einsum('nbhid,nbhjd->nbhij', qc, kc) * decay

    def step(s, inp):
        q_n, k_n, g_n, w_n, u0_n, qk_n = inp
        u = u0_n - jnp.einsum('bhcd,bhde->bhce', w_n, s)
        o = (jnp.einsum('bhcd,bhde->bhce', q_n * jnp.exp(g_n)[..., None], s)
             + jnp.einsum('bhij,bhje->bhie', qk_n, u))
        g_last = g_n[..., -1:]
        s = s * jnp.exp(g_last)[..., None] + jnp.einsum(
            'bhcd,bhce->bhde', k_n * jnp.exp(g_last - g_n)[..., None], u)
        return s, o

    s_fin, o = lax.scan(step, s0.astype(jnp.float32), (qc, kc, gcum, w, u0, qk))
    o = jnp.moveaxis(o.swapaxes(0, 1), 2, 3).reshape(b, n * c, h, dv)[:, :t]
    return o, s_fin


def gdn_mixer(qkv_pre, z, a, beta_logit, conv_buf, s0, conv_w, a_log, dt_bias, norm_g):
    b, t, _ = qkv_pre.shape
    xp = jnp.concatenate([conv_buf.astype(qkv_pre.dtype), qkv_pre], axis=1)
    conv = sum(xp[:, i:i + t] * conv_w[i] for i in range(CONV_W))
    new_buf = xp[:, t:]
    qkv = jax.nn.silu(conv.astype(jnp.float32)).reshape(b, t, 3, N_GDN_HEADS, HEAD_DIM)
    q = l2norm(qkv[:, :, 0]) * HEAD_DIM ** -0.5
    k = l2norm(qkv[:, :, 1])
    v = qkv[:, :, 2]
    g = -jnp.exp(a_log.astype(jnp.float32)) * jax.nn.softplus(a.astype(jnp.float32) + dt_bias.astype(jnp.float32))
    beta = jax.nn.sigmoid(beta_logit.astype(jnp.float32))
    o, s_new = gated_delta(q, k, v, g, beta, s0)
    o = rmsnorm(o, norm_g) * jax.nn.silu(z.astype(jnp.float32).reshape(b, t, N_GDN_HEADS, HEAD_DIM))
    return o.reshape(b, t, GDN_W), new_buf, s_new


def compress_kv(k, v, lp):
    b, l = k.shape[:2]
    nc = l // CMP_BLOCK

    def phi(r, pe, w):
        blocks = r[:, :nc * CMP_BLOCK].reshape(b, nc, CMP_BLOCK, N_KV_HEADS, HEAD_DIM)
        return jnp.einsum('bnckd,cde->bnke', blocks + pe[:, None, :], w)

    end_pos = (jnp.arange(nc) + 1) * CMP_BLOCK - 1
    return rope(phi(k, lp['cmp_pe_k'], lp['cmp_w_k']), end_pos), phi(v, lp['cmp_pe_v'], lp['cmp_w_v'])


def to_blocks(k, v):
    b, l = k.shape[:2]
    n = -(-l // SEL_BLOCK)
    rows = jnp.stack([k, v], axis=2)
    rows = jnp.pad(rows, [(0, 0), (0, n * SEL_BLOCK - l), (0, 0), (0, 0), (0, 0)])
    return rows.reshape(b, n, SEL_BLOCK, 2, N_KV_HEADS, HEAD_DIM).transpose(0, 4, 1, 2, 3, 5)


def kv_rows(k_cmp, v_cmp, k_sel, v_sel):
    return jnp.stack([k_cmp, v_cmp, k_sel, v_sel], axis=3).transpose(0, 2, 1, 3, 4)


def nsa_cmp_sel(q, pos0, ck, cv, fetch_sel, n_sel):
    b, t = q.shape[:2]
    nc = ck.shape[1]
    qb = math.gcd(t, NSA_QBLOCK)
    ratio = SEL_BLOCK // CMP_BLOCK
    k_top = min(TOP_K, n_sel)
    scale = HEAD_DIM ** -0.5
    f32 = jnp.float32
    cmp_end = (jnp.arange(nc) + 1) * CMP_BLOCK - 1
    blk = jnp.arange(n_sel)

    def one_block(i):
        qi = lax.dynamic_slice_in_dim(q, i * qb, qb, axis=1).reshape(b, qb, N_KV_HEADS, GQA_GROUP, HEAD_DIM)
        qpos = pos0 + i * qb + jnp.arange(qb)
        s_c = jnp.einsum('btkgd,bnkd->btkgn', qi, ck, preferred_element_type=f32) * scale
        p_c = masked_softmax(s_c, (cmp_end[None, :] <= qpos[:, None])[None, :, None, None, :])
        o_c = jnp.einsum('btkgn,bnkd->btkgd', p_c, cv.astype(f32))
        imp = jnp.pad(p_c.sum(axis=3), [(0, 0), (0, 0), (0, 0), (0, n_sel * ratio - nc)])
        imp = imp.reshape(b, qb, N_KV_HEADS, n_sel, ratio).sum(-1)
        cur = qpos // SEL_BLOCK
        valid = blk[None, :] * SEL_BLOCK <= qpos[:, None]
        forced = (blk[None, :] == 0) | (blk[None, :] == cur[:, None]) | (blk[None, :] == cur[:, None] - 1)
        score = jnp.where(forced[None, :, None, :], jnp.inf,
                          jnp.where(valid[None, :, None, :], imp, -jnp.inf))
        _, idx = lax.top_k(score, k_top)
        kv = fetch_sel(idx)
        tok = idx[..., None] * SEL_BLOCK + jnp.arange(SEL_BLOCK)
        mask_s = (tok <= qpos[None, :, None, None, None]).reshape(b, qb, N_KV_HEADS, 1, k_top * SEL_BLOCK)
        s_s = jnp.einsum('btkgd,btknsd->btkgns', qi, kv[..., 0, :], preferred_element_type=f32) * scale
        p_s = masked_softmax(s_s.reshape(b, qb, N_KV_HEADS, GQA_GROUP, k_top * SEL_BLOCK), mask_s)
        p_s = p_s.reshape(b, qb, N_KV_HEADS, GQA_GROUP, k_top, SEL_BLOCK)
        o_s = jnp.einsum('btkgns,btknsd->btkgd', p_s, kv[..., 1, :].astype(f32))
        return o_c, o_s

    o_c, o_s = lax.map(one_block, jnp.arange(t // qb))
    merge = lambda o: jnp.moveaxis(o, 0, 1).reshape(b, t, N_NSA_HEADS, HEAD_DIM)
    return merge(o_c), merge(o_s)


def window_attn(q, pos0, kw, vw):
    b, t = q.shape[:2]
    qb = math.gcd(t, WIN_QBLOCK)
    span = WINDOW + qb
    scale = HEAD_DIM ** -0.5

    def one_block(i):
        qi = lax.dynamic_slice_in_dim(q, i * qb, qb, axis=1).reshape(b, qb, N_KV_HEADS, GQA_GROUP, HEAD_DIM)
        ki = lax.dynamic_slice_in_dim(kw, i * qb, span, axis=1)
        vi = lax.dynamic_slice_in_dim(vw, i * qb, span, axis=1)
        qpos = pos0 + i * qb + jnp.arange(qb)
        kpos = pos0 - WINDOW + i * qb + jnp.arange(span)
        mask = ((kpos[None, :] >= 0) & (kpos[None, :] <= qpos[:, None])
                & (kpos[None, :] >= qpos[:, None] - WINDOW))
        s = jnp.einsum('btkgd,bskd->btkgs', qi, ki, preferred_element_type=jnp.float32) * scale
        p = masked_softmax(s, mask[None, :, None, None, :])
        return jnp.einsum('btkgs,bskd->btkgd', p, vi.astype(jnp.float32))

    o = lax.map(one_block, jnp.arange(t // qb))
    return jnp.moveaxis(o, 0, 1).reshape(b, t, N_NSA_HEADS, HEAD_DIM)


def layer_front(x, pos, lp, conv_buf, s0):
    qkv_pre, z, a, beta_logit, q, kv6, gate_logit = project(x, lp['norm_mix'], lp['w_in'])
    o_gdn, conv_new, s_new = gdn_mixer(qkv_pre, z, a, beta_logit, conv_buf, s0, lp['conv_w'],
                                       lp['a_log'], lp['dt_bias'], lp['gdn_norm'])
    q = rope(q, pos)
    k_cmp, v_cmp = kv6[:, :, 0], kv6[:, :, 1]
    k_sel, v_sel = rope(kv6[:, :, 2], pos), kv6[:, :, 3]
    k_win, v_win = rope(kv6[:, :, 4], pos), kv6[:, :, 5]
    return o_gdn, conv_new, s_new, q, k_cmp, v_cmp, k_sel, v_sel, k_win, v_win, gate_logit


def layer_back(x, o_gdn, gate_logit, o_c, o_s, o_w, lp):
    b, t, _ = x.shape
    gates = jax.nn.sigmoid(gate_logit.astype(jnp.float32))
    o_nsa = (gates[..., 0:1] * o_c + gates[..., 1:2] * o_s + gates[..., 2:3] * o_w).reshape(b, t, NSA_W)
    mixed = jnp.concatenate([o_gdn, o_nsa], axis=-1).astype(x.dtype)
    x = x + mixed @ lp['w_out']
    h = rmsnorm(x, lp['norm_mlp'])
    return x + jnp.square(jax.nn.relu(h @ lp['w_up'])) @ lp['w_down']


def prompt_layer(x, lp):
    b, t, _ = x.shape
    pos = jnp.arange(t)
    conv0 = jnp.zeros((b, CONV_W - 1, 3 * GDN_W), x.dtype)
    s0 = jnp.zeros((b, N_GDN_HEADS, HEAD_DIM, HEAD_DIM), jnp.float32)
    (o_gdn, conv_new, s_new, q, k_cmp, v_cmp, k_sel, v_sel, k_win, v_win,
     gate_logit) = layer_front(x, pos, lp, conv0, s0)
    ck, cv = compress_kv(k_cmp, v_cmp, lp)
    blocks = to_blocks(k_sel, v_sel)
    bi = jnp.arange(b)[:, None, None, None]
    hi = jnp.arange(N_KV_HEADS)[None, None, :, None]
    o_c, o_s = nsa_cmp_sel(q, 0, ck, cv, lambda idx: blocks[bi, hi, idx], blocks.shape[2])
    pad = [(0, 0), (WINDOW, 0), (0, 0), (0, 0)]
    o_w = window_attn(q, 0, jnp.pad(k_win, pad), jnp.pad(v_win, pad))
    y = layer_back(x, o_gdn, gate_logit, o_c, o_s, o_w, lp)
    win_new = jnp.stack([k_win, v_win], axis=2)[:, t - min(WINDOW, t):]
    return y, kv_rows(k_cmp, v_cmp, k_sel, v_sel), win_new, s_new, conv_new


def sample_layer(x, lp, pool, page_table, win_buf, s0, conv_buf):
    b, t, _ = x.shape
    past = page_table.shape[1] * PAGE_SIZE
    pos = past + jnp.arange(t)
    (o_gdn, conv_new, s_new, q, k_cmp, v_cmp, k_sel, v_sel, k_win, v_win,
     gate_logit) = layer_front(x, pos, lp, conv_buf, s0)
    past_cmp = pool[page_table, :, :, :2].transpose(0, 1, 3, 4, 2, 5).reshape(b, past, 2, N_KV_HEADS, HEAD_DIM)
    ck, cv = compress_kv(jnp.concatenate([past_cmp[:, :, 0], k_cmp], axis=1),
                         jnp.concatenate([past_cmp[:, :, 1], v_cmp], axis=1), lp)
    new_blocks = to_blocks(k_sel, v_sel)
    n_new = new_blocks.shape[2]
    n_past = past // SEL_BLOCK
    per_page = PAGE_SIZE // SEL_BLOCK
    pool_blocks = pool.reshape(pool.shape[0], N_KV_HEADS, per_page, SEL_BLOCK, 4, HEAD_DIM)
    bi = jnp.arange(b)[:, None, None, None]
    hi = jnp.arange(N_KV_HEADS)[None, None, :, None]

    def fetch(idx):
        pidx = jnp.minimum(idx, n_past - 1)
        phys = page_table[bi, pidx // per_page]
        old = pool_blocks[phys, hi, pidx % per_page, :, 2:]
        new = new_blocks[bi, hi, jnp.clip(idx - n_past, 0, n_new - 1)]
        return jnp.where((idx < n_past)[..., None, None, None], old, new)

    o_c, o_s = nsa_cmp_sel(q, past, ck, cv, fetch, n_past + n_new)
    wb = win_buf.shape[1]
    win_rows = jnp.concatenate([win_buf.astype(x.dtype), jnp.stack([k_win, v_win], axis=2)], axis=1)
    win_pad = jnp.pad(win_rows, [(0, 0), (WINDOW - wb, 0), (0, 0), (0, 0), (0, 0)])
    o_w = window_attn(q, past, win_pad[:, :, 0], win_pad[:, :, 1])
    y = layer_back(x, o_gdn, gate_logit, o_c, o_s, o_w, lp)
    return y, kv_rows(k_cmp, v_cmp, k_sel, v_sel), win_rows[:, t:], s_new, conv_new


def setup_inputs(seed: int = 0) -> dict:
    key = jax.random.key(seed)
    ks = jax.random.split(key, 24)
    f32 = jnp.float32
    n_pages = PAST_LEN // PAGE_SIZE
    n_pool = (DEC_BATCH * n_pages * 5) // 4
    win_buf = min(WINDOW, PAST_LEN)

    def nrm(k, shape, scale):
        return jax.random.normal(k, shape, f32) * scale

    page_table = jax.random.permutation(ks[3], n_pool)[:DEC_BATCH * n_pages].reshape(DEC_BATCH, n_pages).astype(jnp.int32)
    dt = jnp.exp(jax.random.uniform(ks[11], (DEPTH, N_GDN_HEADS), f32, math.log(1e-3), math.log(1e-1)))
    return {
        'x_prompt': nrm(ks[0], (BATCH, SEQ, D_MODEL), 1.0),
        'x_sample': nrm(ks[1], (DEC_BATCH, DEC_SEQ, D_MODEL), 1.0),
        'cache_kv': nrm(ks[2], (DEPTH, n_pool, N_KV_HEADS, PAGE_SIZE, 4, HEAD_DIM), 1.0),
        'page_table': page_table,
        'state_win': nrm(ks[4], (DEPTH, DEC_BATCH, win_buf, 2, N_KV_HEADS, HEAD_DIM), 1.0),
        'state_gdn': nrm(ks[5], (DEPTH, DEC_BATCH, N_GDN_HEADS, HEAD_DIM, HEAD_DIM), 0.1),
        'state_conv': nrm(ks[6], (DEPTH, DEC_BATCH, CONV_W - 1, 3 * GDN_W), 1.0),
        'norm_mix': 1.0 + nrm(ks[7], (DEPTH, D_MODEL), 0.02),
        'w_in': nrm(ks[8], (DEPTH, D_MODEL, D_PROJ), D_MODEL ** -0.5),
        'conv_w': nrm(ks[9], (DEPTH, CONV_W, 3 * GDN_W), CONV_W ** -0.5),
        'a_log': jnp.log(jax.random.uniform(ks[10], (DEPTH, N_GDN_HEADS), f32, 1.0, 16.0)),
        'dt_bias': dt + jnp.log(-jnp.expm1(-dt)),
        'gdn_norm': 1.0 + nrm(ks[12], (DEPTH, HEAD_DIM), 0.02),
        'cmp_pe_k': nrm(ks[13], (DEPTH, CMP_BLOCK, HEAD_DIM), 0.2),
        'cmp_w_k': nrm(ks[14], (DEPTH, CMP_BLOCK, HEAD_DIM, HEAD_DIM), (CMP_BLOCK * HEAD_DIM) ** -0.5),
        'cmp_pe_v': nrm(ks[15], (DEPTH, CMP_BLOCK, HEAD_DIM), 0.2),
        'cmp_w_v': nrm(ks[16], (DEPTH, CMP_BLOCK, HEAD_DIM, HEAD_DIM), (CMP_BLOCK * HEAD_DIM) ** -0.5),
        'w_out': nrm(ks[17], (DEPTH, MIX_WIDTH, D_MODEL), MIX_WIDTH ** -0.5),
        'norm_mlp': 1.0 + nrm(ks[18], (DEPTH, D_MODEL), 0.02),
        'w_up': nrm(ks[19], (DEPTH, D_MODEL, D_FF), D_MODEL ** -0.5),
        'w_down': nrm(ks[20], (DEPTH, D_FF, D_MODEL), D_FF ** -0.5),
        'norm_final': 1.0 + nrm(ks[21], (D_MODEL,), 0.02),
    }


def reference(x_prompt, x_sample, cache_kv, page_table, state_win, state_gdn, state_conv,
              norm_mix, w_in, conv_w, a_log, dt_bias, gdn_norm, cmp_pe_k, cmp_w_k, cmp_pe_v, cmp_w_v,
              w_out, norm_mlp, w_up, w_down, norm_final):
    xp, xs = x_prompt, x_sample
    rows_p, rows_s, win_p, win_s, gdn_p, gdn_s, conv_p, conv_s = [], [], [], [], [], [], [], []
    for l in range(DEPTH):
        lp = {'norm_mix': norm_mix[l], 'w_in': w_in[l], 'conv_w': conv_w[l], 'a_log': a_log[l],
              'dt_bias': dt_bias[l], 'gdn_norm': gdn_norm[l], 'cmp_pe_k': cmp_pe_k[l], 'cmp_w_k': cmp_w_k[l],
              'cmp_pe_v': cmp_pe_v[l], 'cmp_w_v': cmp_w_v[l], 'w_out': w_out[l], 'norm_mlp': norm_mlp[l],
              'w_up': w_up[l], 'w_down': w_down[l]}
        xp, r, w, s, c = prompt_layer(xp, lp)
        rows_p.append(r)
        win_p.append(w)
        gdn_p.append(s)
        conv_p.append(c)
        xs, r, w, s, c = sample_layer(xs, lp, cache_kv[l], page_table, state_win[l], state_gdn[l], state_conv[l])
        rows_s.append(r)
        win_s.append(w)
        gdn_s.append(s)
        conv_s.append(c)
    y_prompt = rmsnorm(xp, norm_final)
    y_sample = rmsnorm(xs, norm_final)
    return (y_prompt, y_sample, jnp.stack(rows_p), jnp.stack(rows_s), jnp.stack(win_p), jnp.stack(win_s),
            jnp.stack(gdn_p), jnp.stack(gdn_s), jnp.stack(conv_p), jnp.stack(conv_s))
```

```cpp
#include <hip/hip_runtime.h>
#include <cstdio>
#include <cstdint>
namespace pg8 {
#define PG8_LAS __attribute__((address_space(3)))
typedef unsigned short bf16_t;
typedef short bf16x8 __attribute__((ext_vector_type(8)));
typedef float f32x4 __attribute__((ext_vector_type(4)));
typedef unsigned u32x4 __attribute__((ext_vector_type(4)));
constexpr int BM = 256, BK = 64, HALF = 128, HTB = HALF * BK * 2  , STAGE_BYTES = 8 * HTB, NXCD = 8, WGM = 8;

__host__ __device__ __forceinline__ int lds_byte(int r, int c) { const int st = (r >> 4) * 2 + (c >> 5), rr = r & 15, cc = c & 31, ob = rr * 64 + cc * 2; return st * 1024 + (ob ^ (((ob >> 9) & 1) << 5)); }
__host__ __device__ __forceinline__ void stage_rc(int b, int& R, int& C) { const int st = b / 1024, sb = b % 1024, swz = sb ^ (((sb >> 9) & 1) << 5); R = (st >> 1) * 16 + swz / 64; C = (st & 1) * 32 + (swz % 64) / 2; }
__host__ __device__ __forceinline__ int perm32(int rho) { const int n = rho >> 4, i = rho & 15; return 8 * (i >> 2) + 4 * n + (i & 3); }

struct Unit { int pm, pn; };
struct Gemm { const bf16_t* A; const bf16_t* Bt; int M, N, K; };

struct StaticOrder {
    int nM, nN, nwg, G, c;
    __host__ __device__ void init(int M, int N, int G_, int c_) { nM = M / BM; nN = N / BM; nwg = nM * nN; G = G_; c = c_; }
    __host__ __device__ bool next(int i, Unit& u) const {
        const long L = (long)i * G + c; if (L >= nwg) return false;
        int wgid = (int)L; { const int q = nwg / NXCD, r = nwg % NXCD, xcd = wgid % NXCD, off = wgid / NXCD; wgid = (xcd < r ? xcd * (q + 1) : r * (q + 1) + (xcd - r) * q) + off; }
        const int nig = WGM * nN, gid = wgid / nig, fm = gid * WGM, gsz = (nM - fm) < WGM ? (nM - fm) : WGM;
        u.pm = fm + ((wgid % nig) % gsz); u.pn = (wgid % nig) / gsz; return true;
    }
    __device__ __forceinline__ void a_ready(const Unit&) const {}
    __device__ __forceinline__ void done(const Unit&) const {}
};

__device__ __forceinline__ unsigned cvt_pk_bf16(float lo, float hi) { unsigned r; asm volatile("v_cvt_pk_bf16_f32 %0, %1, %2" : "=v"(r) : "v"(lo), "v"(hi)); return r; }

struct EpiF32 {
    static constexpr bool PERM = false, AFTER_DRAIN = false;
    float* O; int ldc;
    __device__ __forceinline__ void operator()(const f32x4 (&acc)[2][2][4][2], const Unit& u, int wr, int wc, int fr, int fq) const {
        const int row0 = u.pm * BM + wr * 64 + fr, col0 = u.pn * BM + wc * 32 + 4 * fq;
#pragma unroll
        for (int ai = 0; ai < 2; ++ai)
#pragma unroll
            for (int m = 0; m < 4; ++m) { float* rowp = O + (size_t)(row0 + ai * HALF + m * 16) * ldc + col0;
#pragma unroll
                for (int bj = 0; bj < 2; ++bj)
#pragma unroll
                    for (int n = 0; n < 2; ++n) *(f32x4*)(rowp + bj * HALF + n * 16) = acc[ai][bj][m][n]; }
    }
};
struct EpiResid {
    static constexpr bool PERM = false, AFTER_DRAIN = false;
    const float* base; const float* base2; int split_row; float* O; int ldc;
    __device__ __forceinline__ void operator()(const f32x4 (&acc)[2][2][4][2], const Unit& u, int wr, int wc, int fr, int fq) const {
        const int row0 = u.pm * BM + wr * 64 + fr, col0 = u.pn * BM + wc * 32 + 4 * fq;
        const float* bs = (u.pm * BM >= split_row) ? (base2 - (size_t)split_row * ldc) : base;
#pragma unroll
        for (int ai = 0; ai < 2; ++ai)
#pragma unroll
            for (int m = 0; m < 4; ++m) { const size_t off = (size_t)(row0 + ai * HALF + m * 16) * ldc + col0;
#pragma unroll
                for (int bj = 0; bj < 2; ++bj)
#pragma unroll
                    for (int n = 0; n < 2; ++n) { const f32x4 r = *(const f32x4*)(bs + off + bj * HALF + n * 16); *(f32x4*)(O + off + bj * HALF + n * 16) = r + acc[ai][bj][m][n]; } }
    }
};
struct EpiRelu2 {
    static constexpr bool PERM = true, AFTER_DRAIN = false;
    bf16_t* O; int ldc;
    __device__ __forceinline__ void operator()(const f32x4 (&acc)[2][2][4][2], const Unit& u, int wr, int wc, int fr, int fq) const {
        const int row0 = u.pm * BM + wr * 64 + fr, col0 = u.pn * BM + wc * 32 + 8 * fq;
#pragma unroll
        for (int ai = 0; ai < 2; ++ai)
#pragma unroll
            for (int m = 0; m < 4; ++m) { bf16_t* rowp = O + (size_t)(row0 + ai * HALF + m * 16) * ldc + col0;
#pragma unroll
                for (int bj = 0; bj < 2; ++bj) { f32x4 v0 = acc[ai][bj][m][0], v1 = acc[ai][bj][m][1];
#pragma unroll
                    for (int i = 0; i < 4; ++i) { const float a = v0[i] > 0.f ? v0[i] : 0.f, b = v1[i] > 0.f ? v1[i] : 0.f; v0[i] = a * a; v1[i] = b * b; }
                    u32x4 w; w.x = cvt_pk_bf16(v0[0], v0[1]); w.y = cvt_pk_bf16(v0[2], v0[3]); w.z = cvt_pk_bf16(v1[0], v1[1]); w.w = cvt_pk_bf16(v1[2], v1[3]);
                    *(u32x4*)(rowp + bj * HALF) = w; } }
    }
};
template <class Epi, class Sched, bool ALIGN_EPI = false, bool SP2 = false>
__device__ __forceinline__ void gemm_phase(PG8_LAS unsigned char* lds, const Gemm g, const Sched& S, const Epi& E) {
    int tid = threadIdx.x; asm volatile("" : "+v"(tid));
    const int wid = __builtin_amdgcn_readfirstlane(tid >> 6), lane = tid & 63, wr = wid >> 2, wc = wid & 3, fr = lane & 15, fq = lane >> 4;
    const int K = g.K, nt = K / BK;
    unsigned voffA[2], voffB[2];
#pragma unroll
    for (int i = 0; i < 2; ++i) { int R, C; stage_rc(tid * 16 + i * 8192, R, C); const int Rb = Epi::PERM ? ((R & ~31) + perm32(R & 31)) : R;
        voffA[i] = (unsigned)(R * K + C) * 2u; voffB[i] = (unsigned)(Rb * K + C) * 2u; }
    const size_t kstep = (size_t)(BK * 2);
    const size_t hstep = (size_t)HALF * K * 2;
    const size_t tstep = 2 * hstep;
    const unsigned ldsw = (unsigned)wid * 1024u;
    const int aoff = lds_byte(wr * 64 + fr, fq * 8), boff = lds_byte(wc * 32 + fr, fq * 8);
#define PG8_SA(b, h) (((b) * 2 + (h)) * HTB)
#define PG8_SB(b, h) ((4 + (b) * 2 + (h)) * HTB)
#define PG8_STAGE(bufoff, gbase, voff) do { _Pragma("unroll") for (int _i = 0; _i < 2; ++_i) \
        __builtin_amdgcn_global_load_lds((const unsigned*)((const char*)(gbase) + (voff)[_i]), (PG8_LAS unsigned*)(lds + (bufoff) + ldsw + _i * 8192), 16, 0, 0); } while (0)
#define PG8_LDA(dst, b, h) do { _Pragma("unroll") for (int m = 0; m < 4; ++m) _Pragma("unroll") for (int k = 0; k < 2; ++k) dst[m][k] = *(const PG8_LAS bf16x8*)(lds + PG8_SA(b, h) + aoff + m * 2048 + k * 1024); } while (0)
#define PG8_LDB(dst, b, h) do { _Pragma("unroll") for (int n = 0; n < 2; ++n) _Pragma("unroll") for (int k = 0; k < 2; ++k) dst[n][k] = *(const PG8_LAS bf16x8*)(lds + PG8_SB(b, h) + boff + n * 2048 + k * 1024); } while (0)
#define PG8_MMA(ai, bj, At, Bt) do { __builtin_amdgcn_s_setprio(1); _Pragma("unroll") for (int m = 0; m < 4; ++m) _Pragma("unroll") for (int n = 0; n < 2; ++n) _Pragma("unroll") for (int k = 0; k < 2; ++k) \
        acc[ai][bj][m][n] = __builtin_amdgcn_mfma_f32_16x16x32_bf16(Bt[n][k], At[m][k], acc[ai][bj][m][n], 0, 0, 0); __builtin_amdgcn_s_setprio(0); } while (0)
#define PG8_WAIT_V(n) asm volatile("s_waitcnt vmcnt(" #n ")" ::: "memory")
#define PG8_WAIT_L(n) asm volatile("s_waitcnt lgkmcnt(" #n ")" ::: "memory")
#define PG8_BAR __builtin_amdgcn_s_barrier()
#define PG8_SCHED __builtin_amdgcn_sched_barrier(0)
    Unit cur, nxt; int ui = 0;
    if (!S.next(0, cur)) return;
    f32x4 acc[2][2][4][2];
#pragma unroll
    for (int a = 0; a < 2; ++a)
#pragma unroll
        for (int b = 0; b < 2; ++b)
#pragma unroll
            for (int m = 0; m < 4; ++m)
#pragma unroll
                for (int n = 0; n < 2; ++n) acc[a][b][m][n] = (f32x4){0.f, 0.f, 0.f, 0.f};
    bf16x8 At[4][2], B0[2][2], B1[2][2];
    const char* cA = (const char*)g.A + (size_t)cur.pm * tstep; const char* cB = (const char*)g.Bt + (size_t)cur.pn * tstep;
    S.a_ready(cur);
    if constexpr (SP2) {
        PG8_STAGE(PG8_SB(0, 0), cB, voffB); PG8_STAGE(PG8_SB(0, 1), cB + hstep, voffB); PG8_STAGE(PG8_SA(0, 0), cA, voffA); PG8_STAGE(PG8_SA(0, 1), cA + hstep, voffA);
        if (wr == 1) PG8_BAR;
        PG8_WAIT_V(2); PG8_BAR;
        PG8_STAGE(PG8_SB(1, 0), cB + kstep, voffB); PG8_STAGE(PG8_SA(1, 0), cA + kstep, voffA); PG8_STAGE(PG8_SB(1, 1), cB + hstep + kstep, voffB);
        PG8_WAIT_V(6); PG8_BAR;
    } else {
        PG8_STAGE(PG8_SB(0, 0), cB, voffB); PG8_STAGE(PG8_SA(0, 0), cA, voffA); PG8_STAGE(PG8_SB(0, 1), cB + hstep, voffB); PG8_STAGE(PG8_SA(0, 1), cA + hstep, voffA);
        if (wr == 1) PG8_BAR;
        PG8_WAIT_V(4); PG8_BAR;
        PG8_STAGE(PG8_SB(1, 0), cB + kstep, voffB); PG8_STAGE(PG8_SA(1, 0), cA + kstep, voffA); PG8_STAGE(PG8_SB(1, 1), cB + hstep + kstep, voffB);
        PG8_WAIT_V(6); PG8_BAR;
    }
    for (;;) {
        const bool has_next = S.next(ui + 1, nxt);
        const char* nA = has_next ? (const char*)g.A + (size_t)nxt.pm * tstep : cA; const char* nB = has_next ? (const char*)g.Bt + (size_t)nxt.pn * tstep : cB;
        for (int t = 0; t < nt; t += 2) {
            const bool last = (t == nt - 2);
            const char* a1 = cA + (size_t)(t + 1) * kstep;
            const char* a2 = last ? nA : cA + (size_t)(t + 2) * kstep; const char* b2 = last ? nB : cB + (size_t)(t + 2) * kstep;
            const char* a3 = a2 + kstep; const char* b3 = b2 + kstep;
            if (last && has_next) S.a_ready(nxt);
            if constexpr (SP2) {
            PG8_LDB(B0, 0, 0); PG8_LDB(B1, 0, 1); PG8_SCHED; PG8_LDA(At, 0, 0); PG8_STAGE(PG8_SA(1, 1), a1 + hstep, voffA);
            PG8_WAIT_V(8); PG8_WAIT_L(0); PG8_BAR; PG8_MMA(0, 0, At, B0); PG8_MMA(0, 1, At, B1); PG8_BAR; PG8_SCHED;
            PG8_LDA(At, 0, 1); PG8_STAGE(PG8_SB(0, 0), b2, voffB); PG8_STAGE(PG8_SB(0, 1), b2 + hstep, voffB); PG8_STAGE(PG8_SA(0, 0), a2, voffA);
            PG8_WAIT_V(8); PG8_WAIT_L(0); PG8_BAR; PG8_MMA(1, 0, At, B0); PG8_MMA(1, 1, At, B1); PG8_BAR; PG8_SCHED;
            PG8_LDB(B0, 1, 0); PG8_LDB(B1, 1, 1); PG8_SCHED; PG8_LDA(At, 1, 0); PG8_STAGE(PG8_SA(0, 1), a2 + hstep, voffA);
            PG8_WAIT_V(8); PG8_WAIT_L(0); PG8_BAR; PG8_MMA(0, 0, At, B0); PG8_MMA(0, 1, At, B1); PG8_BAR; PG8_SCHED;
            PG8_LDA(At, 1, 1); PG8_STAGE(PG8_SB(1, 0), b3, voffB); PG8_STAGE(PG8_SB(1, 1), b3 + hstep, voffB); PG8_STAGE(PG8_SA(1, 0), a3, voffA);
            PG8_WAIT_V(8); PG8_WAIT_L(0); PG8_BAR; PG8_MMA(1, 0, At, B0); PG8_MMA(1, 1, At, B1); PG8_BAR; PG8_SCHED;
            } else {
            PG8_LDB(B0, 0, 0); PG8_SCHED; PG8_LDA(At, 0, 0); PG8_STAGE(PG8_SA(1, 1), a1 + hstep, voffA);
            PG8_WAIT_L(8); PG8_BAR; PG8_WAIT_L(0); PG8_MMA(0, 0, At, B0); PG8_BAR; PG8_SCHED;
            PG8_LDB(B1, 0, 1); PG8_STAGE(PG8_SB(0, 0), b2, voffB);
            PG8_BAR; PG8_WAIT_L(0); PG8_MMA(0, 1, At, B1); PG8_BAR;
            PG8_LDA(At, 0, 1); PG8_STAGE(PG8_SA(0, 0), a2, voffA);
            PG8_BAR; PG8_WAIT_L(0); PG8_MMA(1, 0, At, B0); PG8_BAR; PG8_SCHED;
            PG8_STAGE(PG8_SB(0, 1), b2 + hstep, voffB);
            PG8_WAIT_V(6); PG8_BAR; PG8_MMA(1, 1, At, B1); PG8_BAR;
            PG8_LDB(B0, 1, 0); PG8_SCHED; PG8_LDA(At, 1, 0); PG8_STAGE(PG8_SA(0, 1), a2 + hstep, voffA);
            PG8_WAIT_L(8); PG8_BAR; PG8_WAIT_L(0); PG8_MMA(0, 0, At, B0); PG8_BAR; PG8_SCHED;
            PG8_LDB(B1, 1, 1); PG8_STAGE(PG8_SB(1, 0), b3, voffB);
            PG8_BAR; PG8_WAIT_L(0); PG8_MMA(0, 1, At, B1); PG8_BAR;
            PG8_LDA(At, 1, 1); PG8_STAGE(PG8_SA(1, 0), a3, voffA);
            PG8_BAR; PG8_WAIT_L(0); PG8_MMA(1, 0, At, B0); PG8_BAR; PG8_SCHED;
            PG8_STAGE(PG8_SB(1, 1), b3 + hstep, voffB);
            PG8_WAIT_V(6); PG8_BAR; PG8_MMA(1, 1, At, B1); PG8_BAR;
            }
        }
        if constexpr (ALIGN_EPI) { if (wr == 0) PG8_BAR; }
        if constexpr (!Epi::AFTER_DRAIN) { E(acc, cur, wr, wc, fr, fq); S.done(cur); }
        if (!has_next) break;
#pragma unroll
        for (int a = 0; a < 2; ++a)
#pragma unroll
            for (int b = 0; b < 2; ++b)
#pragma unroll
                for (int m = 0; m < 4; ++m)
#pragma unroll
                    for (int n = 0; n < 2; ++n) acc[a][b][m][n] = (f32x4){0.f, 0.f, 0.f, 0.f};
        cur = nxt; cA = nA; cB = nB; ++ui;
        if constexpr (ALIGN_EPI) { if (wr == 1) PG8_BAR; }
    }
    PG8_WAIT_V(0);
    if constexpr (!ALIGN_EPI) { if (wr == 0) PG8_BAR; }
    PG8_BAR;
    if constexpr (Epi::AFTER_DRAIN) { E.fused(acc, cur, wr, wc, fr, fq, lds, wid, lane); S.done(cur); }
#undef PG8_SA
#undef PG8_SB
#undef PG8_STAGE
#undef PG8_LDA
#undef PG8_LDB
#undef PG8_MMA
#undef PG8_WAIT_V
#undef PG8_WAIT_L
#undef PG8_BAR
#undef PG8_SCHED
}
}

constexpr int DM = 1024, NPB = 4, SEQ = 4096, MP = NPB * SEQ, NSB = 128, DSEQ = 4, MS = NSB * DSEQ, MT = MP + MS;
constexpr int NPROJ = 3368, NP = 3584, DFF = 4096, NL = 2;
constexpr int C_QKV = 0, C_Z = 1536, C_A = 2048, C_BETA = 2056, C_Q = 2064, C_KV = 2576, C_GATE = 3344;
constexpr int PAST = 2048, NPAGES = 16, NPOOL = 2560;
constexpr float C2 = 0.125f * 1.4426950408889634f;
constexpr float NEG_INF = -__builtin_inff();
constexpr size_t O_YP = 0, O_YS = 16777216, O_KVP = 17301504, O_KVS = 34078720, O_WINP = 34603008, O_WINS = 35651584, O_GDNP = 69206016, O_GDNS = 69468160, O_CONVP = 77856768, O_CONVS = 77893632, O_END = 79073280;
constexpr size_t MiB = 1u << 20;
constexpr size_t WS_CTL = 0, CTL_ZERO_BYTES = 1 * MiB;
constexpr size_t WS_WIN = 2 * MiB, WS_WOUT = 16 * MiB, WS_WUP = 20 * MiB, WS_WDN = 36 * MiB, WS_CMPW = 52 * MiB;
constexpr size_t WS_HB = 54 * MiB, WS_PROJ = 88 * MiB, WS_X1 = 320 * MiB, WS_X2 = 386 * MiB, WS_MIX = 452 * MiB, WS_HID = 486 * MiB;
constexpr size_t WS_QN = 618 * MiB, WS_KN = 651 * MiB, WS_VG = 684 * MiB, WS_OG = 717 * MiB, WS_G = 750 * MiB, WS_BETA = 751 * MiB, WS_KQ = 752 * MiB;
constexpr size_t WS_QB = 753 * MiB, WS_KS = 770 * MiB, WS_VS = 775 * MiB, WS_KW = 780 * MiB, WS_VW = 785 * MiB;
constexpr size_t WS_CKP = 790 * MiB, WS_CVP = 791 * MiB, WS_CKS = 792 * MiB, WS_CVS = 796 * MiB, WS_END = 800 * MiB;
constexpr int CW_BAR = 4096;
constexpr int RING_BYTES = 131072, MISC_OFF = RING_BYTES + 320, LDS_BYTES = 147456;
constexpr int NWAVES = 8;

#define GAS __attribute__((address_space(1)))
#define LAS __attribute__((address_space(3)))
typedef unsigned short bf16;
typedef unsigned v4u __attribute__((ext_vector_type(4)));
typedef unsigned v2u __attribute__((ext_vector_type(2)));
typedef float f32x4 __attribute__((ext_vector_type(4)));
typedef float f32x16 __attribute__((ext_vector_type(16)));
typedef short bf16x8 __attribute__((ext_vector_type(8)));
typedef short s16x4 __attribute__((ext_vector_type(4)));
#define LDS_WAIT() asm volatile("s_waitcnt lgkmcnt(0)" ::: "memory")
__device__ __forceinline__ unsigned f2bf(float f) { unsigned u = __builtin_bit_cast(unsigned, f); return (u + 0x7fffu + ((u >> 16) & 1u)) >> 16; }
__device__ __forceinline__ unsigned pk2(float lo, float hi) { return f2bf(lo) | (f2bf(hi) << 16); }
__device__ __forceinline__ float bf2f(unsigned short b) { return __builtin_bit_cast(float, (unsigned)b << 16); }
__device__ __forceinline__ bf16x8 pack8(float a0, float a1, float a2, float a3, float a4, float a5, float a6, float a7) {
    v4u w; w.x = pk2(a0, a1); w.y = pk2(a2, a3); w.z = pk2(a4, a5); w.w = pk2(a6, a7); return __builtin_bit_cast(bf16x8, w); }
__device__ __forceinline__ float wave_sum(float v) {
#pragma unroll
    for (int o = 1; o < 64; o <<= 1) v += __shfl_xor(v, o);
    return v;
}
template <int CTRL, int RMASK> __device__ __forceinline__ float dpp_add(float v) {
    const int t = __builtin_amdgcn_update_dpp(0, __builtin_bit_cast(int, v), CTRL, RMASK, 0xf, false);
    return v + __builtin_bit_cast(float, t);
}
__device__ __forceinline__ float dpp_sum(float v) {
    v = dpp_add<0x111, 0xf>(v); v = dpp_add<0x112, 0xf>(v); v = dpp_add<0x114, 0xf>(v); v = dpp_add<0x118, 0xf>(v);
    v = dpp_add<0x142, 0xa>(v); v = dpp_add<0x143, 0xc>(v);
    return __builtin_bit_cast(float, __builtin_amdgcn_readlane(__builtin_bit_cast(int, v), 63));
}
__device__ __forceinline__ float ex2(float x) { return __builtin_amdgcn_exp2f(x); }
__device__ __forceinline__ float sigmoidf_(float x) { return 1.f / (1.f + __expf(-x)); }
__device__ __forceinline__ float siluf_(float x) { return x / (1.f + __expf(-x)); }
__device__ __forceinline__ int crow(int r, int hi) { return (r & 3) + 8 * (r >> 2) + 4 * hi; }
__device__ __forceinline__ void rope_cs(int pos, int d, float& cs, float& sn) {
    const float invf = exp2f(-(float)d * 0.4152410118609203f);
    double rv = (double)pos * (double)invf * 0.15915494309189535; rv -= floor(rv);
    const float rf = (float)rv; sn = __builtin_amdgcn_sinf(rf); cs = __builtin_amdgcn_cosf(rf);
}

#define XB_TMO      128
#define XB_XCNT(j)  (256  + 64 * (j))
#define XB_XSUB(j)  (1280 + 64 * (j))
#define XB_XGEN(j)  (2304 + 64 * (j))
#define XB_TOP      3328
#define XB_TOPGEN   3392
#define XCD_BAR_WORDS 3456
#define XB_SPIN_CAP (1u << 18)

__device__ __forceinline__ unsigned xb_ld(unsigned* p)              { return __hip_atomic_load(p, __ATOMIC_RELAXED, __HIP_MEMORY_SCOPE_AGENT); }
__device__ __forceinline__ unsigned xb_add(unsigned* p, unsigned v) { return __hip_atomic_fetch_add(p, v, __ATOMIC_RELAXED, __HIP_MEMORY_SCOPE_AGENT); }
__device__ __forceinline__ unsigned xb_xcc_id() { return (unsigned)__builtin_amdgcn_s_getreg((3 << 11) | 20) & 0xFu; }
#define XB_SPIN(cond, bar) do { unsigned _sp = 0; while (cond) { __builtin_amdgcn_s_sleep(1); \
    if ((++_sp & 255u) == 0u) { if (xb_ld(&(bar)[XB_TMO])) break; if (_sp > XB_SPIN_CAP) { atomicAdd(&(bar)[XB_TMO], 1u); break; } } } } while (0)

struct XcdBarrier {
    unsigned* bar; unsigned x;
    volatile LAS unsigned* st;
};

__device__ __forceinline__ XcdBarrier xcd_barrier_post(unsigned* bar, volatile LAS unsigned* st) {
    XcdBarrier b; b.bar = bar; b.x = xb_xcc_id(); b.st = st;
    if (threadIdx.x == 0) (void)xb_add(&bar[XB_XCNT(b.x)], 1u);
    return b;
}
__device__ __forceinline__ void xcd_barrier_complete(unsigned* bar, unsigned x, unsigned& nloc, unsigned& nx) {
    const unsigned G = gridDim.x * gridDim.y * gridDim.z;
    unsigned sum, cnt, mine, sp = 0u;
    for (;;) {
        sum = 0u; cnt = 0u; mine = 0u;
#pragma unroll
        for (unsigned j = 0; j < 16; ++j) { const unsigned c = xb_ld(&bar[XB_XCNT(j)]); sum += c; cnt += (c > 0u) ? 1u : 0u; mine = (j == x) ? c : mine; }
        if (sum == G) break;
        __builtin_amdgcn_s_sleep(1);
        if ((++sp & 255u) == 0u) { if (xb_ld(&bar[XB_TMO])) break; if (sp > XB_SPIN_CAP) { atomicAdd(&bar[XB_TMO], 1u); break; } }
    }
    nloc = mine > 0u ? mine : 1u; nx = cnt > 0u ? cnt : 1u;
}

__device__ __forceinline__ void xcd_barrier(const XcdBarrier& b) {
    asm volatile("s_waitcnt vmcnt(0)" ::: "memory");
    __syncthreads();
    if (threadIdx.x == 0) {
        unsigned* bar = b.bar;
        __builtin_amdgcn_s_waitcnt(0);
        unsigned nloc = b.st[0], nx = b.st[1];
        if (nloc == 0u) { xcd_barrier_complete(bar, b.x, nloc, nx); b.st[0] = nloc; b.st[1] = nx; }
        const unsigned old = xb_add(&bar[XB_XSUB(b.x)], 1u);
        const unsigned gen = old / nloc;
        if (old + 1u == (gen + 1u) * nloc) {
            __builtin_amdgcn_fence(__ATOMIC_RELEASE, "agent");
            asm volatile("s_waitcnt vmcnt(0)" ::: "memory");
            const unsigned og = xb_add(&bar[XB_TOP], 1u);
            const unsigned tg = og / nx;
            if (og + 1u == (tg + 1u) * nx) xb_add(&bar[XB_TOPGEN], 1u);
            else XB_SPIN(xb_ld(&bar[XB_TOPGEN]) == tg, bar);
            __builtin_amdgcn_fence(__ATOMIC_ACQUIRE, "agent");
            xb_add(&bar[XB_XGEN(b.x)], 1u);
            asm volatile("s_waitcnt vmcnt(0)" ::: "memory");
        } else {
            XB_SPIN(xb_ld(&bar[XB_XGEN(b.x)]) == gen, bar);
            __builtin_amdgcn_fence(__ATOMIC_ACQUIRE, "agent");
            asm volatile("s_waitcnt vmcnt(0)" ::: "memory");
        }
    }
    __syncthreads();
}

__device__ __forceinline__ void transpose_item(const float* W, int K, int N, int Npad, bf16* WT, LAS float* scr, int item, int lane) {
    const int nblk = Npad / 32, kb = item / nblk, nb = item % nblk, k0 = 64 * kb, n0 = 32 * nb;
    const int ncol = n0 + (lane & 31);
#pragma unroll 8
    for (int i = 0; i < 32; ++i) { const int kk = 2 * i + (lane >> 5); scr[kk * 33 + (lane & 31)] = (ncol < N) ? W[(size_t)(k0 + kk) * N + ncol] : 0.f; }
    LDS_WAIT(); asm volatile("" ::: "memory");
    const int c = lane & 7;
#pragma unroll
    for (int j = 0; j < 4; ++j) { const int n = (lane >> 3) + 8 * j; const LAS float* s = scr + (8 * c) * 33 + n;
        v4u o; o.x = pk2(s[0 * 33], s[1 * 33]); o.y = pk2(s[2 * 33], s[3 * 33]); o.z = pk2(s[4 * 33], s[5 * 33]); o.w = pk2(s[6 * 33], s[7 * 33]);
        *(v4u*)(WT + (size_t)(n0 + n) * K + k0 + 8 * c) = o; }
    LDS_WAIT(); asm volatile("" ::: "memory");
}
__device__ __forceinline__ void rms_row(const float* xrow, const float* g, bf16* orow, float* of32, int lane) {
    const f32x4* xr = (const f32x4*)xrow + lane;
    f32x4 v[4]; float s = 0.f;
#pragma unroll
    for (int j = 0; j < 4; ++j) { v[j] = xr[64 * j]; s += (v[j].x * v[j].x + v[j].y * v[j].y) + (v[j].z * v[j].z + v[j].w * v[j].w); }
    const float rstd = 1.f / sqrtf(wave_sum(s) * (1.f / DM) + 1e-6f);
#pragma unroll
    for (int j = 0; j < 4; ++j) { const f32x4 gg = ((const f32x4*)g)[64 * j + lane]; const f32x4 o = v[j] * rstd * gg;
        if (of32) ((f32x4*)of32)[64 * j + lane] = o;
        else ((v2u*)orow)[64 * j + lane] = (v2u){pk2(o.x, o.y), pk2(o.z, o.w)}; }
}

struct PBArgs { const float* PROJ; const float* state_conv; const float* conv_w; const float* a_log; const float* dt_bias;
    float* QN; float* KN; float* VG; float* G; float* BETA; float* KQ; bf16* QB; bf16* KS; bf16* VS; bf16* KW; bf16* VW; float* out; int l; };
__device__ __forceinline__ void pb_row(const PBArgs& A, int m, int lane) {
    const bool is_s = m >= MP; int b, t;
    if (!is_s) { b = m >> 12; t = m & 4095; } else { b = (m - MP) >> 2; t = (m - MP) & 3; }
    const int pos = is_s ? PAST + t : t, l = A.l;
    const float* pr = A.PROJ + (size_t)m * NP;
    const float* cw = A.conv_w + (size_t)l * 4 * 1536;
    const float* cb = A.state_conv + ((size_t)l * NSB + b) * 3 * 1536;
#pragma unroll 1
    for (int h = 0; h < 8; ++h) {
        float qkv[3];
#pragma unroll
        for (int part = 0; part < 3; ++part) { const int c = (part * 8 + h) * 64 + lane; float acc = 0.f;
#pragma unroll
            for (int tap = 0; tap < 4; ++tap) { const int idx = t + tap;
                float xv;
                if (idx >= 3) xv = A.PROJ[(size_t)(m - t + idx - 3) * NP + c];
                else xv = is_s ? cb[idx * 1536 + c] : 0.f;
                acc += xv * cw[tap * 1536 + c]; }
            qkv[part] = siluf_(acc); }
        const float q = qkv[0], k = qkv[1];
        const float qs = wave_sum(q * q), ks = wave_sum(k * k);
        const float qn = q * (1.f / sqrtf(qs + 1e-6f)) * 0.125f, kn = k * (1.f / sqrtf(ks + 1e-6f));
        const float kq = wave_sum(qn * kn);
        A.QN[(size_t)m * 512 + h * 64 + lane] = qn; A.KN[(size_t)m * 512 + h * 64 + lane] = kn; A.VG[(size_t)m * 512 + h * 64 + lane] = qkv[2];
        if (lane == 0) A.KQ[(size_t)m * 8 + h] = kq;
    }
    if (lane < 8) {
        const float a = pr[C_A + lane] + A.dt_bias[l * 8 + lane];
        const float sp = fmaxf(a, 0.f) + log1pf(__expf(-fabsf(a)));
        A.G[(size_t)m * 8 + lane] = -__expf(A.a_log[l * 8 + lane]) * sp;
        A.BETA[(size_t)m * 8 + lane] = sigmoidf_(pr[C_BETA + lane]); }
    if (!is_s && t >= SEQ - 3) { float* o = A.out + O_CONVP + ((size_t)(l * NPB + b) * 3 + (t - (SEQ - 3))) * 1536;
#pragma unroll 4
        for (int j = 0; j < 24; ++j) o[64 * j + lane] = pr[64 * j + lane]; }
    if (is_s && t >= 1) { float* o = A.out + O_CONVS + ((size_t)(l * NSB + b) * 3 + (t - 1)) * 1536;
#pragma unroll 4
        for (int j = 0; j < 24; ++j) o[64 * j + lane] = pr[64 * j + lane]; }
    const int half = lane >> 5; float cs, sn; rope_cs(pos, lane & 31, cs, sn);
#pragma unroll
    for (int h = 0; h < 8; ++h) { const float xs = pr[C_Q + h * 64 + lane], xo = pr[C_Q + h * 64 + (lane ^ 32)];
        const float r = half ? (xs * cs + xo * sn) : (xs * cs - xo * sn);
        A.QB[(size_t)m * 512 + h * 64 + lane] = (bf16)f2bf(r * C2); }
#pragma unroll
    for (int s6 = 0; s6 < 6; ++s6)
#pragma unroll
        for (int kvh = 0; kvh < 2; ++kvh) {
            float v = pr[C_KV + s6 * 128 + kvh * 64 + lane];
            if (s6 == 2 || s6 == 4) { const float xo = pr[C_KV + s6 * 128 + kvh * 64 + (lane ^ 32)]; v = half ? (v * cs + xo * sn) : (v * cs - xo * sn); }
            if (s6 < 4) {
                if (!is_s) A.out[O_KVP + ((((size_t)(l * NPB + b) * 2 + kvh) * SEQ + t) * 4 + s6) * 64 + lane] = v;
                else       A.out[O_KVS + ((((size_t)(l * NSB + b) * 2 + kvh) * DSEQ + t) * 4 + s6) * 64 + lane] = v;
            } else {
                const int idx = s6 - 4;
                if (!is_s) { if (t >= SEQ - 512) A.out[O_WINP + ((((size_t)(l * NPB + b) * 512 + (t - (SEQ - 512))) * 2 + idx) * 2 + kvh) * 64 + lane] = v; }
                else A.out[O_WINS + ((((size_t)(l * NSB + b) * 512 + (508 + t)) * 2 + idx) * 2 + kvh) * 64 + lane] = v;
            }
            const bf16 bv = (bf16)f2bf(v);
            if (s6 == 2) A.KS[(size_t)m * 128 + kvh * 64 + lane] = bv;
            if (s6 == 3) A.VS[(size_t)m * 128 + kvh * 64 + lane] = bv;
            if (s6 == 4) A.KW[(size_t)m * 128 + kvh * 64 + lane] = bv;
            if (s6 == 5) A.VW[(size_t)m * 128 + kvh * 64 + lane] = bv;
        }
}

struct CmpArgs { const float* PROJ; const float* cache; const int* page_table; const float* pe_k; const float* pe_v; const bf16* CMPW; unsigned char* ws; int l; };
__device__ __forceinline__ void compress_unit(const CmpArgs& A, int u, int lane) {
    const int fr = lane & 15, fq = lane >> 4, l = A.l;
    const int kv = u & 1, uu = u >> 1; const bool is_s = uu >= 64; const int ru = is_s ? uu - 64 : uu;
    const int rho = 16 * ru + fr, NC = is_s ? 64 : 128;
    const int seq = rho / (2 * NC), n = (rho >> 1) % NC, kvh = rho & 1;
    const float* abase; size_t astride;
    if (!is_s) { abase = A.PROJ + (size_t)(seq * SEQ + 32 * n) * NP + C_KV + kv * 128 + kvh * 64; astride = NP; }
    else { const int page = A.page_table[seq * NPAGES + (n >> 2)];
        abase = A.cache + ((((size_t)l * NPOOL + page) * 2 + kvh) * 128 + (n & 3) * 32) * 256 + kv * 64; astride = 256; }
    const float* pe = (kv ? A.pe_v : A.pe_k) + (size_t)l * 2048;
    const bf16* Wt = A.CMPW + (size_t)((l * 2 + kv) * 64) * 2048;
    f32x4 acc[4];
#pragma unroll
    for (int et = 0; et < 4; ++et) acc[et] = (f32x4){0.f, 0.f, 0.f, 0.f};
    for (int c = 0; c < 32; ++c) {
#pragma unroll
        for (int ks = 0; ks < 2; ++ks) {
            const float* ap = abase + (size_t)c * astride + 32 * ks + 8 * fq; const float* pp = pe + c * 64 + 32 * ks + 8 * fq;
            const f32x4 a0 = *(const f32x4*)ap + *(const f32x4*)pp, a1 = *(const f32x4*)(ap + 4) + *(const f32x4*)(pp + 4);
            const bf16x8 ya = pack8(a0.x, a0.y, a0.z, a0.w, a1.x, a1.y, a1.z, a1.w);
#pragma unroll
            for (int et = 0; et < 4; ++et) { const bf16x8 xb = *(const bf16x8*)(Wt + (size_t)(16 * et + fr) * 2048 + c * 64 + 32 * ks + 8 * fq);
                acc[et] = __builtin_amdgcn_mfma_f32_16x16x32_bf16(xb, ya, acc[et], 0, 0, 0); }
        }
    }
    if (kv == 0) { const int pos = 32 * n + 31;
#pragma unroll
        for (int et = 0; et < 2; ++et)
#pragma unroll
            for (int i = 0; i < 4; ++i) { float cs, sn; rope_cs(pos, 16 * et + 4 * fq + i, cs, sn);
                const float x1 = acc[et][i], x2 = acc[et + 2][i]; acc[et][i] = x1 * cs - x2 * sn; acc[et + 2][i] = x2 * cs + x1 * sn; } }
    float* ob = (float*)(A.ws + (is_s ? WS_CKS : WS_CKP) + (size_t)kv * (is_s ? (WS_CVS - WS_CKS) : (WS_CVP - WS_CKP))) + (size_t)rho * 64 + 4 * fq;
#pragma unroll
    for (int et = 0; et < 4; ++et) *(f32x4*)(ob + 16 * et) = acc[et];
}

struct GdnArgs { const float* QN; const float* KN; const float* VG; const float* G; const float* BETA; const float* KQ; float* OG; const float* PROJ; const float* state_gdn; const float* gdn_norm; bf16* MIX; float* out; int l; };
__device__ __forceinline__ void gdn_scan_unit(const GdnArgs& A, int unit, int wave, int lane) {
    const int b = unit >> 6, h = (unit >> 3) & 7, e = (unit & 7) * 8 + wave;
    const size_t m0 = (size_t)b * SEQ;
    const float* kp = A.KN + m0 * 512 + h * 64 + lane; const float* qp = A.QN + m0 * 512 + h * 64 + lane;
    const float* vp = A.VG + m0 * 512 + h * 64 + e; const float* gp = A.G + m0 * 8 + h; const float* bp = A.BETA + m0 * 8 + h; const float* kqp = A.KQ + m0 * 8 + h;
    float* op = A.OG + m0 * 512 + h * 64 + e;
    float s = 0.f;
    float ck[8], cq[8], cv[8], cg[8], cb[8], ckq[8], nk[8], nq[8], nv[8], ng[8], nb[8], nkq[8];
#pragma unroll
    for (int i = 0; i < 8; ++i) { ck[i] = kp[(size_t)i * 512]; cq[i] = qp[(size_t)i * 512]; cv[i] = vp[(size_t)i * 512]; cg[i] = gp[i * 8]; cb[i] = bp[i * 8]; ckq[i] = kqp[i * 8]; }
    for (int t0 = 0; t0 < SEQ; t0 += 8) {
        const int tn = (t0 + 8 < SEQ) ? t0 + 8 : t0;
#pragma unroll
        for (int i = 0; i < 8; ++i) { nk[i] = kp[(size_t)(tn + i) * 512]; nq[i] = qp[(size_t)(tn + i) * 512]; nv[i] = vp[(size_t)(tn + i) * 512]; ng[i] = gp[(tn + i) * 8]; nb[i] = bp[(tn + i) * 8]; nkq[i] = kqp[(tn + i) * 8]; }
        float ov[8];
#pragma unroll
        for (int i = 0; i < 8; ++i) {
            const float a = __expf(cg[i]);
            const float r1 = dpp_sum(s * ck[i]), r2 = dpp_sum(s * cq[i]);
            const float u = cb[i] * (cv[i] - a * r1);
            ov[i] = a * r2 + u * ckq[i];
            s = a * s + ck[i] * u;
        }
        if (lane < 8) { float o = 0.f;
#pragma unroll
            for (int i = 0; i < 8; ++i) if (lane == i) o = ov[i];
            op[(size_t)(t0 + lane) * 512] = o; }
#pragma unroll
        for (int i = 0; i < 8; ++i) { ck[i] = nk[i]; cq[i] = nq[i]; cv[i] = nv[i]; cg[i] = ng[i]; cb[i] = nb[i]; ckq[i] = nkq[i]; }
    }
    A.out[O_GDNP + ((((size_t)A.l * NPB + b) * 8 + h) * 64 + lane) * 64 + e] = s;
}
__device__ __forceinline__ void gdn_sample_unit(const GdnArgs& A, int unit, LAS float* wl  , int lane) {
    const int sb = unit >> 3, h = unit & 7, l = A.l;
    const float* sp = A.state_gdn + (((size_t)l * NSB + sb) * 8 + h) * 4096;
    float S[64];
#pragma unroll
    for (int d = 0; d < 64; ++d) S[d] = sp[d * 64 + lane];
    const float gn = A.gdn_norm[l * 64 + lane];
    for (int i = 0; i < DSEQ; ++i) {
        const size_t m = (size_t)MP + sb * 4 + i;
        const float kd = A.KN[m * 512 + h * 64 + lane], qd = A.QN[m * 512 + h * 64 + lane], v = A.VG[m * 512 + h * 64 + lane];
        const float g = A.G[m * 8 + h], beta = A.BETA[m * 8 + h], kq = A.KQ[m * 8 + h];
        const int kdb = __builtin_bit_cast(int, kd), qdb = __builtin_bit_cast(int, qd);
        const float a = __expf(g); float r1 = 0.f, r2 = 0.f;
#pragma unroll
        for (int d = 0; d < 64; ++d) { const float kk = __builtin_bit_cast(float, __builtin_amdgcn_readlane(kdb, d)), qq = __builtin_bit_cast(float, __builtin_amdgcn_readlane(qdb, d)); r1 += S[d] * kk; r2 += S[d] * qq; }
        const float u = beta * (v - a * r1), o = a * r2 + u * kq;
#pragma unroll
        for (int d = 0; d < 64; ++d) { const float kk = __builtin_bit_cast(float, __builtin_amdgcn_readlane(kdb, d)); S[d] = a * S[d] + kk * u; }
        const float ms = wave_sum(o * o) * (1.f / 64.f);
        const float z = A.PROJ[m * NP + C_Z + h * 64 + lane];
        A.MIX[m * 1024 + h * 64 + lane] = (bf16)f2bf(o * (1.f / sqrtf(ms + 1e-6f)) * gn * siluf_(z));
    }
    float* so = A.out + O_GDNS + (((size_t)l * NSB + sb) * 8 + h) * 4096;
#pragma unroll
    for (int d = 0; d < 64; ++d) so[d * 64 + lane] = S[d];
}

constexpr int L_CK = 0, L_CVT = 18432, L_IMP = 36864, L_MASK = 102400, L_UM = 102912, L_INV = 102928, L_K = 104448, L_VT = 113664;
struct AttArgs { const bf16* QB; const bf16* KS; const bf16* VS; const bf16* KW; const bf16* VW; const float* CKP; const float* CVP; const float* PROJ; bf16* MIX; };

template <int MODE>
__device__ __forceinline__ void attn_tiles(unsigned char* lds, const bf16* Kg, const bf16* Vg, int j_lo, int j_hi, unsigned long long umask, unsigned long long tmask,
                                           int qblk, int trel, const bf16x8 (&qr)[4], f32x16 (&o)[2], float& mrun, float& lrun, int tid, int r32, int hi) {
    for (int j = j_lo; j <= j_hi; ++j) {
        if (!((umask >> j) & 1ull)) continue;
        __syncthreads();
        { const int key = tid >> 3, ch = tid & 7;
          const v4u kvv = *(const v4u*)(Kg + (size_t)(64 * j + key) * 128 + ch * 8);
          *(v4u*)(lds + L_K + key * 144 + ch * 16) = kvv;
          const v4u vv = *(const v4u*)(Vg + (size_t)(64 * j + key) * 128 + ch * 8);
          unsigned short* vt = (unsigned short*)(lds + L_VT);
#pragma unroll
          for (int e2 = 0; e2 < 4; ++e2) { const unsigned w = vv[e2]; vt[(ch * 8 + 2 * e2) * 72 + key] = (unsigned short)(w & 0xffffu); vt[(ch * 8 + 2 * e2 + 1) * 72 + key] = (unsigned short)(w >> 16); } }
        __syncthreads();
        f32x16 p[2];
#pragma unroll
        for (int u = 0; u < 2; ++u) { f32x16 acc = {};
#pragma unroll
            for (int d0 = 0; d0 < 4; ++d0) { const bf16x8 kf = *(const bf16x8*)(lds + L_K + (32 * u + r32) * 144 + (16 * d0 + 8 * hi) * 2);
                acc = __builtin_amdgcn_mfma_f32_32x32x16_bf16(kf, qr[d0], acc, 0, 0, 0); }
            p[u] = acc; }
        const bool tsel = (MODE == 0) ? (((tmask >> j) & 1ull) != 0ull) : true;
#pragma unroll
        for (int u = 0; u < 2; ++u)
#pragma unroll
            for (int r = 0; r < 16; ++r) { const int kv = 32 * u + crow(r, hi); bool keep = tsel;
                if (j == qblk) keep = keep && (kv <= trel);
                if (MODE == 1) { if (j == qblk - 8) keep = keep && (kv >= trel); }
                if (!keep) p[u][r] = NEG_INF; }
        float rm = NEG_INF;
#pragma unroll
        for (int u = 0; u < 2; ++u)
#pragma unroll
            for (int r = 0; r < 16; ++r) rm = fmaxf(rm, p[u][r]);
        rm = fmaxf(rm, __shfl_xor(rm, 32));
        const float mn = fmaxf(mrun, rm), msafe = (mn == NEG_INF) ? 0.f : mn;
        const float alpha = ex2(mrun - msafe);
        float ls = 0.f;
#pragma unroll
        for (int u = 0; u < 2; ++u)
#pragma unroll
            for (int r = 0; r < 16; ++r) { const float e = ex2(p[u][r] - msafe); p[u][r] = e; ls += e; }
        lrun = lrun * alpha + ls; mrun = mn;
#pragma unroll
        for (int dh = 0; dh < 2; ++dh)
#pragma unroll
            for (int r = 0; r < 16; ++r) o[dh][r] *= alpha;
#pragma unroll
        for (int u = 0; u < 2; ++u)
#pragma unroll
            for (int s = 0; s < 2; ++s) {
                const bf16x8 pf = pack8(p[u][8 * s + 0], p[u][8 * s + 1], p[u][8 * s + 2], p[u][8 * s + 3], p[u][8 * s + 4], p[u][8 * s + 5], p[u][8 * s + 6], p[u][8 * s + 7]);
#pragma unroll
                for (int dh = 0; dh < 2; ++dh) { const unsigned char* vp = lds + L_VT + (r32 + 32 * dh) * 144 + (32 * u + 16 * s + 4 * hi) * 2;
                    const s16x4 lo = *(const s16x4*)vp, hi4 = *(const s16x4*)(vp + 16);
                    const bf16x8 vf = (bf16x8){lo[0], lo[1], lo[2], lo[3], hi4[0], hi4[1], hi4[2], hi4[3]};
                    o[dh] = __builtin_amdgcn_mfma_f32_32x32x16_bf16(vf, pf, o[dh], 0, 0, 0); }
            }
    }
}

__device__ __forceinline__ void nsa_prompt_unit(const AttArgs& A, unsigned char* lds, int unit, int tid) {
    const int lane = tid & 63, wave = tid >> 6, r32 = lane & 31, hi = lane >> 5, hh = wave & 3, ts = wave >> 2;
    const int b = unit >> 7, kvh = (unit >> 6) & 1, qblk = unit & 63;
    const int head = kvh * 4 + hh, trel = 32 * ts + r32, t = 64 * qblk + trel; const size_t m = (size_t)b * SEQ + t;
    __syncthreads();
    const int nvmax = 2 * qblk + 2, ntile_c = (nvmax + 31) >> 5;
    { const int ch = tid & 7;
      for (int n = tid >> 3; n < 32 * ntile_c; n += 64) {
          const float* ckp = A.CKP + ((size_t)(b * 128 + n) * 2 + kvh) * 64 + ch * 8; const float* cvp = A.CVP + ((size_t)(b * 128 + n) * 2 + kvh) * 64 + ch * 8;
          const f32x4 k0 = *(const f32x4*)ckp, k1 = *(const f32x4*)(ckp + 4), v0 = *(const f32x4*)cvp, v1 = *(const f32x4*)(cvp + 4);
          *(bf16x8*)(lds + L_CK + n * 144 + ch * 16) = pack8(k0.x, k0.y, k0.z, k0.w, k1.x, k1.y, k1.z, k1.w);
          unsigned short* vt = (unsigned short*)(lds + L_CVT);
          vt[(ch * 8 + 0) * 136 + n] = (unsigned short)f2bf(v0.x); vt[(ch * 8 + 1) * 136 + n] = (unsigned short)f2bf(v0.y); vt[(ch * 8 + 2) * 136 + n] = (unsigned short)f2bf(v0.z); vt[(ch * 8 + 3) * 136 + n] = (unsigned short)f2bf(v0.w);
          vt[(ch * 8 + 4) * 136 + n] = (unsigned short)f2bf(v1.x); vt[(ch * 8 + 5) * 136 + n] = (unsigned short)f2bf(v1.y); vt[(ch * 8 + 6) * 136 + n] = (unsigned short)f2bf(v1.z); vt[(ch * 8 + 7) * 136 + n] = (unsigned short)f2bf(v1.w);
      }
      if (tid < 128) ((unsigned*)(lds + L_MASK))[tid] = 0u;
      if (tid < 2) ((unsigned*)(lds + L_UM))[tid] = 0u; }
    bf16x8 qr[4];
#pragma unroll
    for (int d0 = 0; d0 < 4; ++d0) qr[d0] = *(const bf16x8*)(A.QB + m * 512 + head * 64 + 16 * d0 + 8 * hi);
    __syncthreads();
    f32x16 tot[2];
    {
        const int nv = (t + 1) >> 5;
        float mx = NEG_INF;
#pragma unroll 1
        for (int tau = 0; tau < ntile_c; ++tau) {
            f32x16 acc = {};
#pragma unroll
            for (int d0 = 0; d0 < 4; ++d0) { const bf16x8 kf = *(const bf16x8*)(lds + L_CK + (32 * tau + r32) * 144 + (16 * d0 + 8 * hi) * 2);
                acc = __builtin_amdgcn_mfma_f32_32x32x16_bf16(kf, qr[d0], acc, 0, 0, 0); }
#pragma unroll
            for (int r = 0; r < 16; ++r) { const int n = 32 * tau + crow(r, hi); if (n < nv) mx = fmaxf(mx, acc[r]); }
        }
        mx = fmaxf(mx, __shfl_xor(mx, 32)); if (mx == NEG_INF) mx = 0.f;
        float sum = 0.f;
        f32x16 oc[2]; oc[0] = (f32x16){}; oc[1] = (f32x16){};
        float* imph = (float*)(lds + L_IMP) + (size_t)hh * 4096 + (32 * ts + r32) * 64;
#pragma unroll 1
        for (int tau = 0; tau < 4; ++tau) {
            f32x16 e = {};
            if (tau < ntile_c) {
                f32x16 acc = {};
#pragma unroll
                for (int d0 = 0; d0 < 4; ++d0) { const bf16x8 kf = *(const bf16x8*)(lds + L_CK + (32 * tau + r32) * 144 + (16 * d0 + 8 * hi) * 2);
                    acc = __builtin_amdgcn_mfma_f32_32x32x16_bf16(kf, qr[d0], acc, 0, 0, 0); }
#pragma unroll
                for (int r = 0; r < 16; ++r) { const int n = 32 * tau + crow(r, hi); e[r] = (n < nv) ? ex2(acc[r] - mx) : 0.f; sum += e[r]; }
#pragma unroll
                for (int s = 0; s < 2; ++s) {
                    const bf16x8 pf = pack8(e[8 * s + 0], e[8 * s + 1], e[8 * s + 2], e[8 * s + 3], e[8 * s + 4], e[8 * s + 5], e[8 * s + 6], e[8 * s + 7]);
#pragma unroll
                    for (int dh = 0; dh < 2; ++dh) { const unsigned char* vp = lds + L_CVT + (r32 + 32 * dh) * 272 + (32 * tau + 16 * s + 4 * hi) * 2;
                        const s16x4 lo = *(const s16x4*)vp, hi4 = *(const s16x4*)(vp + 16);
                        const bf16x8 vf = (bf16x8){lo[0], lo[1], lo[2], lo[3], hi4[0], hi4[1], hi4[2], hi4[3]};
                        oc[dh] = __builtin_amdgcn_mfma_f32_32x32x16_bf16(vf, pf, oc[dh], 0, 0, 0); }
                }
            }
#pragma unroll
            for (int a = 0; a < 4; ++a) { imph[16 * tau + 4 * a + 2 * hi + 0] = e[4 * a] + e[4 * a + 1]; imph[16 * tau + 4 * a + 2 * hi + 1] = e[4 * a + 2] + e[4 * a + 3]; }
        }
        sum += __shfl_xor(sum, 32);
        const float inv = 1.f / fmaxf(sum, 1e-30f);
        if (hi == 0) ((float*)(lds + L_INV))[hh * 64 + 32 * ts + r32] = inv;
        const float g0 = sigmoidf_(A.PROJ[m * NP + C_GATE + head * 3 + 0]) * inv;
#pragma unroll
        for (int dh = 0; dh < 2; ++dh)
#pragma unroll
            for (int r = 0; r < 16; ++r) tot[dh][r] = g0 * oc[dh][r];
    }
    __syncthreads();
    { float* ip = (float*)(lds + L_IMP); const float* iv = (const float*)(lds + L_INV);
#pragma unroll
      for (int i = 0; i < 8; ++i) { const int idx = tid + 512 * i, tk = idx >> 6;
          ip[idx] = (ip[idx] * iv[tk] + ip[4096 + idx] * iv[64 + tk]) + (ip[8192 + idx] * iv[128 + tk] + ip[12288 + idx] * iv[192 + tk]); } }
    __syncthreads();
    { const int tok = tid >> 3, jg = tid & 7; unsigned* mk = (unsigned*)(lds + L_MASK) + tok * 2;
      if (qblk <= 15) { if (jg == 0) { const unsigned long long am = (1ull << (qblk + 1)) - 1ull; mk[0] = (unsigned)am; mk[1] = (unsigned)(am >> 32); } }
      else {
          const float* iv = (const float*)(lds + L_IMP) + tok * 64; float vj[8]; int rk[8];
#pragma unroll
          for (int jj = 0; jj < 8; ++jj) { vj[jj] = iv[jg * 8 + jj]; rk[jj] = 0; }
          for (int i = 1; i <= qblk - 2; ++i) { const float vi = iv[i];
#pragma unroll
              for (int jj = 0; jj < 8; ++jj) { const int j = jg * 8 + jj; rk[jj] += (vi > vj[jj] || (vi == vj[jj] && i < j)) ? 1 : 0; } }
          unsigned bits = 0u;
#pragma unroll
          for (int jj = 0; jj < 8; ++jj) { const int j = jg * 8 + jj; const bool cand = (j >= 1 && j <= qblk - 2);
              if ((cand && rk[jj] < 13) || j == 0 || j == qblk || j == qblk - 1) bits |= 1u << ((jg & 3) * 8 + jj); }
          if (bits) atomicOr(mk + (jg >> 2), bits);
      } }
    __syncthreads();
    if (tid < 64) { const unsigned* mk = (const unsigned*)(lds + L_MASK) + tid * 2; atomicOr((unsigned*)(lds + L_UM), mk[0]); atomicOr((unsigned*)(lds + L_UM) + 1, mk[1]); }
    __syncthreads();
    unsigned long long tmask, umask;
    { const unsigned* mk = (const unsigned*)(lds + L_MASK) + trel * 2; tmask = (unsigned long long)mk[0] | ((unsigned long long)mk[1] << 32);
      const unsigned* um = (const unsigned*)(lds + L_UM); umask = (unsigned long long)um[0] | ((unsigned long long)um[1] << 32); }
    float* stash = (float*)(lds + L_IMP) + (size_t)wave * 2048 + lane;
#pragma unroll
    for (int dh = 0; dh < 2; ++dh)
#pragma unroll
        for (int r = 0; r < 16; ++r) stash[(dh * 16 + r) * 64] = tot[dh][r];
    {
        f32x16 o[2]; o[0] = (f32x16){}; o[1] = (f32x16){}; float mrun = NEG_INF, lrun = 0.f;
        attn_tiles<0>(lds, A.KS + (size_t)b * SEQ * 128 + kvh * 64, A.VS + (size_t)b * SEQ * 128 + kvh * 64, 0, qblk, umask, tmask, qblk, trel, qr, o, mrun, lrun, tid, r32, hi);
        lrun += __shfl_xor(lrun, 32);
        const float g1 = sigmoidf_(A.PROJ[m * NP + C_GATE + head * 3 + 1]) / fmaxf(lrun, 1e-30f);
#pragma unroll
        for (int dh = 0; dh < 2; ++dh)
#pragma unroll
            for (int r = 0; r < 16; ++r) stash[(dh * 16 + r) * 64] += g1 * o[dh][r];
    }
    {
        f32x16 o[2]; o[0] = (f32x16){}; o[1] = (f32x16){}; float mrun = NEG_INF, lrun = 0.f;
        const int jlo = qblk >= 8 ? qblk - 8 : 0;
        attn_tiles<1>(lds, A.KW + (size_t)b * SEQ * 128 + kvh * 64, A.VW + (size_t)b * SEQ * 128 + kvh * 64, jlo, qblk, ~0ull, ~0ull, qblk, trel, qr, o, mrun, lrun, tid, r32, hi);
        lrun += __shfl_xor(lrun, 32);
        const float g2 = sigmoidf_(A.PROJ[m * NP + C_GATE + head * 3 + 2]) / fmaxf(lrun, 1e-30f);
#pragma unroll
        for (int dh = 0; dh < 2; ++dh)
#pragma unroll
            for (int r = 0; r < 16; ++r) tot[dh][r] = stash[(dh * 16 + r) * 64] + g2 * o[dh][r];
    }
    bf16* mo = A.MIX + m * 1024 + 512 + head * 64;
#pragma unroll
    for (int dh = 0; dh < 2; ++dh)
#pragma unroll
        for (int a = 0; a < 4; ++a) { const int d0 = 32 * dh + 8 * a + 4 * hi;
            *(v2u*)(mo + d0) = (v2u){pk2(tot[dh][4 * a], tot[dh][4 * a + 1]), pk2(tot[dh][4 * a + 2], tot[dh][4 * a + 3])}; }
}

struct SAttArgs { const bf16* QB; const bf16* KS; const bf16* VS; const bf16* KW; const bf16* VW; const float* CKS; const float* CVS; const float* PROJ; const float* cache; const int* page_table; const float* state_win; bf16* MIX; int l; };
constexpr int SL_Q = 0, SL_S = 4096, SL_RM = 4096 + 16 * 65 * 4, SL_RS = SL_RM + 64, SL_IMP = SL_RS + 64, SL_MK = SL_IMP + 4 * 32 * 4;
__device__ __forceinline__ float dot64_f32(const float* q  , const float* k  ) {
    float acc = 0.f;
#pragma unroll
    for (int i = 0; i < 16; ++i) { const f32x4 kk = ((const f32x4*)k)[i]; const f32x4 qq = ((const f32x4*)q)[i]; acc += (kk.x * qq.x + kk.y * qq.y) + (kk.z * qq.z + kk.w * qq.w); }
    return acc;
}
__device__ __forceinline__ float dot64_bf16(const float* q  , const bf16* k  ) {
    float acc = 0.f;
#pragma unroll
    for (int i = 0; i < 8; ++i) { const v4u w = ((const v4u*)k)[i]; const f32x4 q0 = ((const f32x4*)q)[2 * i], q1 = ((const f32x4*)q)[2 * i + 1];
        acc += (bf2f((unsigned short)(w.x & 0xffffu)) * q0.x + bf2f((unsigned short)(w.x >> 16)) * q0.y) + (bf2f((unsigned short)(w.y & 0xffffu)) * q0.z + bf2f((unsigned short)(w.y >> 16)) * q0.w)
             + (bf2f((unsigned short)(w.z & 0xffffu)) * q1.x + bf2f((unsigned short)(w.z >> 16)) * q1.y) + (bf2f((unsigned short)(w.w & 0xffffu)) * q1.z + bf2f((unsigned short)(w.w >> 16)) * q1.w); }
    return acc;
}
__device__ __forceinline__ void sblock_acc(const float* Ss, int r0, int nkeys, const float* vf32, size_t vstride_f32, const bf16* vb16, size_t vstride_b16, float (&mr)[2], float (&lr)[2], float (&ov)[2]) {
    float mb0 = NEG_INF, mb1 = NEG_INF;
    for (int k = 0; k < nkeys; ++k) { mb0 = fmaxf(mb0, Ss[r0 * 65 + k]); mb1 = fmaxf(mb1, Ss[(r0 + 1) * 65 + k]); }
    const float mn0 = fmaxf(mr[0], mb0), mn1 = fmaxf(mr[1], mb1), ms0 = (mn0 == NEG_INF) ? 0.f : mn0, ms1 = (mn1 == NEG_INF) ? 0.f : mn1;
    const float a0 = ex2(mr[0] - ms0), a1 = ex2(mr[1] - ms1);
    float l0 = lr[0] * a0, l1 = lr[1] * a1, o0 = ov[0] * a0, o1 = ov[1] * a1;
    for (int k = 0; k < nkeys; ++k) {
        const float e0 = ex2(Ss[r0 * 65 + k] - ms0), e1 = ex2(Ss[(r0 + 1) * 65 + k] - ms1);
        const float v = vf32 ? vf32[(size_t)k * vstride_f32] : bf2f(vb16[(size_t)k * vstride_b16]);
        l0 += e0; l1 += e1; o0 += e0 * v; o1 += e1 * v; }
    mr[0] = mn0; mr[1] = mn1; lr[0] = l0; lr[1] = l1; ov[0] = o0; ov[1] = o1;
}
__device__ __forceinline__ void nsa_sample_unit(const SAttArgs& A, unsigned char* lds, int unit, int tid) {
    const int sb = unit >> 1, kvh = unit & 1, l = A.l;
    float* Qs = (float*)(lds + SL_Q); float* Ss = (float*)(lds + SL_S); float* RM = (float*)(lds + SL_RM); float* RS = (float*)(lds + SL_RS); float* IMP = (float*)(lds + SL_IMP); unsigned* MK = (unsigned*)(lds + SL_MK);
    const int srow = tid & 15, kA = tid >> 4;
    const int d = tid & 63, r0 = (tid >> 6) * 2;
    const int si = srow >> 2;
    __syncthreads();
    for (int e = tid; e < 1024; e += 512) { const int row = e >> 6, dd = e & 63, i = row >> 2, hh = row & 3;
        Qs[e] = bf2f(A.QB[((size_t)MP + sb * 4 + i) * 512 + (kvh * 4 + hh) * 64 + dd]); }
    if (tid < 8) MK[tid] = 0u;
    __syncthreads();
    const float* ckb = A.CKS + ((size_t)sb * 64 * 2 + kvh) * 64; const float* cvb = A.CVS + ((size_t)sb * 64 * 2 + kvh) * 64;
    Ss[srow * 65 + kA] = dot64_f32(Qs + srow * 64, ckb + (size_t)kA * 128); Ss[srow * 65 + kA + 32] = dot64_f32(Qs + srow * 64, ckb + (size_t)(kA + 32) * 128);
    __syncthreads();
    float tot[2];
    { float mr[2] = {NEG_INF, NEG_INF}, lr[2] = {0.f, 0.f}, ov[2] = {0.f, 0.f};
      sblock_acc(Ss, r0, 64, cvb + d, 128, nullptr, 0, mr, lr, ov);
      if (d == 0) { RM[r0] = mr[0]; RM[r0 + 1] = mr[1]; RS[r0] = lr[0]; RS[r0 + 1] = lr[1]; }
#pragma unroll
      for (int k = 0; k < 2; ++k) { const int row = r0 + k, i = row >> 2, hh = row & 3; const size_t m = (size_t)MP + sb * 4 + i;
          const float g0 = sigmoidf_(A.PROJ[m * NP + C_GATE + (kvh * 4 + hh) * 3 + 0]); tot[k] = g0 * ov[k] / fmaxf(lr[k], 1e-30f); } }
    __syncthreads();
    if (tid < 128) { const int i = tid >> 5, j = tid & 31; float s = 0.f;
#pragma unroll
        for (int hh = 0; hh < 4; ++hh) { const int row = i * 4 + hh; const float inv = 1.f / fmaxf(RS[row], 1e-30f);
            s += (ex2(Ss[row * 65 + 2 * j] - RM[row]) + ex2(Ss[row * 65 + 2 * j + 1] - RM[row])) * inv; }
        IMP[i * 32 + j] = s; }
    __syncthreads();
    if (tid < 128) { const int i = tid >> 5, j = tid & 31; bool sel = (j == 0 || j == 31);
        if (j >= 1 && j <= 30) { const float vj = IMP[i * 32 + j]; int rk = 0;
            for (int q = 1; q <= 30; ++q) { const float vi = IMP[i * 32 + q]; rk += (vi > vj || (vi == vj && q < j)) ? 1 : 0; }
            sel = rk < 13; }
        if (sel) { atomicOr(MK + i, 1u << j); atomicOr(MK + 4, 1u << j); } }
    __syncthreads();
    const unsigned um = MK[4];
    const unsigned tm_s = MK[si];
    float mr[2] = {NEG_INF, NEG_INF}, lr[2] = {0.f, 0.f}, ov[2] = {0.f, 0.f};
    for (int j = 0; j <= 32; ++j) {
        if (j < 32 && !((um >> j) & 1u)) continue;
        if (j < 32) {
            const int phys = A.page_table[sb * NPAGES + (j >> 1)];
            const float* base = A.cache + ((((size_t)l * NPOOL + phys) * 2 + kvh) * 128 + (j & 1) * 64) * 256;
            const bool ts = ((tm_s >> j) & 1u) != 0u;
            Ss[srow * 65 + kA] = ts ? dot64_f32(Qs + srow * 64, base + (size_t)kA * 256 + 128) : NEG_INF;
            Ss[srow * 65 + kA + 32] = ts ? dot64_f32(Qs + srow * 64, base + (size_t)(kA + 32) * 256 + 128) : NEG_INF;
            __syncthreads();
            sblock_acc(Ss, r0, 64, base + 192 + d, 256, nullptr, 0, mr, lr, ov);
        } else {
            if (kA < 4) Ss[srow * 65 + kA] = (kA <= si) ? dot64_bf16(Qs + srow * 64, A.KS + ((size_t)MP + sb * 4 + kA) * 128 + kvh * 64) : NEG_INF;
            __syncthreads();
            sblock_acc(Ss, r0, 4, nullptr, 0, A.VS + ((size_t)MP + sb * 4) * 128 + kvh * 64 + d, 128, mr, lr, ov);
        }
        __syncthreads();
    }
#pragma unroll
    for (int k = 0; k < 2; ++k) { const int row = r0 + k, i = row >> 2, hh = row & 3; const size_t m = (size_t)MP + sb * 4 + i;
        const float g1 = sigmoidf_(A.PROJ[m * NP + C_GATE + (kvh * 4 + hh) * 3 + 1]); tot[k] += g1 * ov[k] / fmaxf(lr[k], 1e-30f); }
    mr[0] = mr[1] = NEG_INF; lr[0] = lr[1] = 0.f; ov[0] = ov[1] = 0.f;
    const float* wb = A.state_win + ((size_t)l * NSB + sb) * 512 * 256 + kvh * 64;
    for (int jb = 0; jb < 9; ++jb) {
        if (jb < 8) {
#pragma unroll
            for (int hk = 0; hk < 2; ++hk) { const int key = kA + 32 * hk, r = 64 * jb + key;
                Ss[srow * 65 + key] = (r >= si) ? dot64_f32(Qs + srow * 64, wb + (size_t)r * 256) : NEG_INF; }
            __syncthreads();
            sblock_acc(Ss, r0, 64, wb + (size_t)(64 * jb) * 256 + 128 + d, 256, nullptr, 0, mr, lr, ov);
        } else {
            if (kA < 4) Ss[srow * 65 + kA] = (kA <= si) ? dot64_bf16(Qs + srow * 64, A.KW + ((size_t)MP + sb * 4 + kA) * 128 + kvh * 64) : NEG_INF;
            __syncthreads();
            sblock_acc(Ss, r0, 4, nullptr, 0, A.VW + ((size_t)MP + sb * 4) * 128 + kvh * 64 + d, 128, mr, lr, ov);
        }
        __syncthreads();
    }
#pragma unroll
    for (int k = 0; k < 2; ++k) { const int row = r0 + k, i = row >> 2, hh = row & 3; const size_t m = (size_t)MP + sb * 4 + i;
        const float g2 = sigmoidf_(A.PROJ[m * NP + C_GATE + (kvh * 4 + hh) * 3 + 2]); tot[k] += g2 * ov[k] / fmaxf(lr[k], 1e-30f);
        A.MIX[m * 1024 + 512 + (kvh * 4 + hh) * 64 + d] = (bf16)f2bf(tot[k]); }
}

struct Args { const void* in[22]; float* out; unsigned char* ws; int ph_lo, ph_hi; };
constexpr int PH_PER_LAYER = 9, N_PHASES = 1 + NL * PH_PER_LAYER;
template <unsigned PH_MASK_T, unsigned SUB_MASK_T> __global__ void __launch_bounds__(NWAVES * 64, 2) hymba_fwd(Args args) {
    extern __shared__ __attribute__((aligned(16))) unsigned char lds[];
    const int G = gridDim.x, bx = blockIdx.x, NGW = G * NWAVES;
#define PHASE_IDS int tid = threadIdx.x; asm volatile("" : "+v"(tid)); const int lane = tid & 63, wave = __builtin_amdgcn_readfirstlane(tid >> 6), gw = bx * NWAVES + wave; (void)lane; (void)gw; unsigned char* wsl = args.ws; asm volatile("" : "+s"(wsl));
    float* out = args.out;
    const float* x_prompt = (const float*)args.in[0]; const float* x_sample = (const float*)args.in[1]; const float* cache_kv = (const float*)args.in[2];
    const int* page_table = (const int*)args.in[3]; const float* state_win = (const float*)args.in[4]; const float* state_gdn = (const float*)args.in[5];
    const float* state_conv = (const float*)args.in[6]; const float* norm_mix = (const float*)args.in[7]; const float* w_in = (const float*)args.in[8];
    const float* conv_w = (const float*)args.in[9]; const float* a_log = (const float*)args.in[10]; const float* dt_bias = (const float*)args.in[11];
    const float* gdn_norm = (const float*)args.in[12]; const float* cmp_pe_k = (const float*)args.in[13]; const float* cmp_w_k = (const float*)args.in[14];
    const float* cmp_pe_v = (const float*)args.in[15]; const float* cmp_w_v = (const float*)args.in[16]; const float* w_out = (const float*)args.in[17];
    const float* norm_mlp = (const float*)args.in[18]; const float* w_up = (const float*)args.in[19]; const float* w_down = (const float*)args.in[20]; const float* norm_final = (const float*)args.in[21];
#define WIN_T ((bf16*)(wsl + WS_WIN))
#define WOUT_T ((bf16*)(wsl + WS_WOUT))
#define WUP_T ((bf16*)(wsl + WS_WUP))
#define WDN_T ((bf16*)(wsl + WS_WDN))
#define CMPW ((bf16*)(wsl + WS_CMPW))
#define HB ((bf16*)(wsl + WS_HB))
#define PROJ ((float*)(wsl + WS_PROJ))
#define X1 ((float*)(wsl + WS_X1))
#define X2 ((float*)(wsl + WS_X2))
#define MIX ((bf16*)(wsl + WS_MIX))
#define HID ((bf16*)(wsl + WS_HID))
#define QN ((float*)(wsl + WS_QN))
#define KN ((float*)(wsl + WS_KN))
#define VG ((float*)(wsl + WS_VG))
#define OG ((float*)(wsl + WS_OG))
#define GG ((float*)(wsl + WS_G))
#define BETA ((float*)(wsl + WS_BETA))
#define KQ ((float*)(wsl + WS_KQ))
#define QB ((bf16*)(wsl + WS_QB))
#define KS ((bf16*)(wsl + WS_KS))
#define VS ((bf16*)(wsl + WS_VS))
#define KW ((bf16*)(wsl + WS_KW))
#define VW ((bf16*)(wsl + WS_VW))
#define CKP ((float*)(wsl + WS_CKP))
#define CVP ((float*)(wsl + WS_CVP))
#define CKS ((float*)(wsl + WS_CKS))
#define CVS ((float*)(wsl + WS_CVS))
    LAS unsigned char* ldsl = (LAS unsigned char*)lds;

    const int lo = args.ph_lo, hi = args.ph_hi;
    for (int u = threadIdx.x; u < (LDS_BYTES - RING_BYTES) / 4; u += NWAVES * 64) ((LAS unsigned*)(ldsl + RING_BYTES))[u] = 0u;
    __syncthreads();
    XcdBarrier bar = xcd_barrier_post((unsigned*)(args.ws + WS_CTL) + CW_BAR, (volatile LAS unsigned*)(ldsl + MISC_OFF) + 8);
#define BOTH(k) (lo <= (k) && (k) + 1 < hi)
#define GRID_BAR(k) do { if (BOTH(k)) xcd_barrier(bar); } while (0)
#define EN(i) (((PH_MASK_T) >> (i)) & 1u)
#define SUB(i) (((SUB_MASK_T) >> (i)) & 1u)
#define IN(k) (lo <= (k) && (k) < hi)

    if (EN(0) && IN(0)) { PHASE_IDS
        LAS float* scr = (LAS float*)(ldsl + wave * 16384);
        constexpr int I_IN = 16 * 112, I_OUT = 16 * 32, I_UP = 16 * 128, I_DN = 64 * 32, I_C = 32 * 2, I_L = I_IN + I_OUT + I_UP + I_DN + 2 * I_C;
        for (int it = gw; it < NL * I_L; it += NGW) {
            const int l = it / I_L; int r = it % I_L;
            if (r < I_IN) { transpose_item(w_in + (size_t)l * DM * NPROJ, DM, NPROJ, NP, WIN_T + (size_t)l * NP * DM, scr, r, lane); continue; } r -= I_IN;
            if (r < I_OUT) { transpose_item(w_out + (size_t)l * DM * DM, DM, DM, DM, WOUT_T + (size_t)l * DM * DM, scr, r, lane); continue; } r -= I_OUT;
            if (r < I_UP) { transpose_item(w_up + (size_t)l * DM * DFF, DM, DFF, DFF, WUP_T + (size_t)l * DFF * DM, scr, r, lane); continue; } r -= I_UP;
            if (r < I_DN) { transpose_item(w_down + (size_t)l * DFF * DM, DFF, DM, DM, WDN_T + (size_t)l * DM * DFF, scr, r, lane); continue; } r -= I_DN;
            if (r < I_C) { transpose_item(cmp_w_k + (size_t)l * 2048 * 64, 2048, 64, 64, CMPW + (size_t)((l * 2 + 0) * 64) * 2048, scr, r, lane); continue; } r -= I_C;
            transpose_item(cmp_w_v + (size_t)l * 2048 * 64, 2048, 64, 64, CMPW + (size_t)((l * 2 + 1) * 64) * 2048, scr, r, lane);
        }
        for (int m = gw; m < MT; m += NGW) { const float* xr = (m < MP) ? x_prompt + (size_t)m * DM : x_sample + (size_t)(m - MP) * DM; rms_row(xr, norm_mix, HB + (size_t)m * DM, nullptr, lane); }
    }

    GRID_BAR(0);
    for (int l = 0; l < NL; ++l) {
        const int pb = 1 + l * PH_PER_LAYER;
        if (EN(1) && IN(pb + 0)) { PHASE_IDS
            pg8::Gemm g{HB, WIN_T + (size_t)l * NP * DM, MT, NP, DM}; pg8::StaticOrder S; S.init(MT, NP, G, bx);
            pg8::EpiF32 E{PROJ, NP};
            pg8::gemm_phase<pg8::EpiF32, pg8::StaticOrder, true, true>(ldsl, g, S, E);
        }
        GRID_BAR(pb + 0);
        if (EN(2) && IN(pb + 1)) { PHASE_IDS
            { PBArgs A{PROJ, state_conv, conv_w, a_log, dt_bias, QN, KN, VG, GG, BETA, KQ, QB, KS, VS, KW, VW, out, l};
              if (SUB(0)) for (int m = gw; m < MT; m += NGW) pb_row(A, m, lane); }
            { CmpArgs A{PROJ, cache_kv, page_table, cmp_pe_k, cmp_pe_v, CMPW, wsl, l};
              if (SUB(1)) for (int u = gw; u < 2176; u += NGW) compress_unit(A, u, lane); }
            { const f32x4* src = (const f32x4*)(state_win + (size_t)l * NSB * 512 * 256); f32x4* dst = (f32x4*)(out + O_WINS + (size_t)l * NSB * 512 * 256);
              for (int i = bx * 512 + tid; i < NSB * 508 * 64; i += G * 512) { const int sb = i / (508 * 64), rem = i % (508 * 64); dst[(size_t)sb * 512 * 64 + rem] = src[(size_t)sb * 512 * 64 + 256 + rem]; } }
        }
        GRID_BAR(pb + 1);
        if (EN(3) && IN(pb + 2)) {
            if (SUB(2)) { PHASE_IDS GdnArgs GA{QN, KN, VG, GG, BETA, KQ, OG, PROJ, state_gdn, gdn_norm, MIX, out, l};
                for (int u = bx; u < 256; u += G) gdn_scan_unit(GA, u, wave, lane); }
            if (SUB(3)) { PHASE_IDS GdnArgs GA{QN, KN, VG, GG, BETA, KQ, OG, PROJ, state_gdn, gdn_norm, MIX, out, l};
                for (int u = gw; u < NSB * 8; u += NGW) gdn_sample_unit(GA, u, (LAS float*)(ldsl + 124000 + wave * 512), lane); }
            __syncthreads();
            if (SUB(4)) { PHASE_IDS AttArgs AA{QB, KS, VS, KW, VW, CKP, CVP, PROJ, MIX};
                for (int u = bx; u < 512; u += G) nsa_prompt_unit(AA, lds, u, tid); }
            if (SUB(5)) { PHASE_IDS SAttArgs SA{QB, KS, VS, KW, VW, CKS, CVS, PROJ, cache_kv, page_table, state_win, MIX, l};
                for (int u = bx; u < 256; u += G) nsa_sample_unit(SA, lds, u, tid); }
        }
        GRID_BAR(pb + 2);
        if (EN(4) && IN(pb + 3)) { PHASE_IDS
            for (int it = gw; it < MP * 8; it += NGW) { const int m = it >> 3, h = it & 7;
                const float o = OG[(size_t)m * 512 + h * 64 + lane]; const float ms = wave_sum(o * o) * (1.f / 64.f);
                const float z = PROJ[(size_t)m * NP + C_Z + h * 64 + lane];
                MIX[(size_t)m * 1024 + h * 64 + lane] = (bf16)f2bf(o * (1.f / sqrtf(ms + 1e-6f)) * gdn_norm[l * 64 + lane] * siluf_(z)); }
        }
        GRID_BAR(pb + 3);
        if (EN(5) && IN(pb + 4)) { PHASE_IDS
            pg8::Gemm g{MIX, WOUT_T + (size_t)l * DM * DM, MT, DM, DM}; pg8::StaticOrder S; S.init(MT, DM, G, bx);
            pg8::EpiResid E{l == 0 ? x_prompt : (const float*)X2, l == 0 ? x_sample : (const float*)X2 + (size_t)MP * DM, MP, X1, DM};
            pg8::gemm_phase<pg8::EpiResid, pg8::StaticOrder, true, true>(ldsl, g, S, E);
        }
        GRID_BAR(pb + 4);
        if (EN(6) && IN(pb + 5)) { PHASE_IDS for (int m = gw; m < MT; m += NGW) rms_row(X1 + (size_t)m * DM, norm_mlp + (size_t)l * DM, HB + (size_t)m * DM, nullptr, lane); }
        GRID_BAR(pb + 5);
        if (EN(7) && IN(pb + 6)) { PHASE_IDS
            pg8::Gemm g{HB, WUP_T + (size_t)l * DFF * DM, MT, DFF, DM}; pg8::StaticOrder S; S.init(MT, DFF, G, bx);
            pg8::EpiRelu2 E{HID, DFF};
            pg8::gemm_phase<pg8::EpiRelu2, pg8::StaticOrder, true, true>(ldsl, g, S, E);
        }
        GRID_BAR(pb + 6);
        if (EN(8) && IN(pb + 7)) { PHASE_IDS
            pg8::Gemm g{HID, WDN_T + (size_t)l * DM * DFF, MT, DM, DFF}; pg8::StaticOrder S; S.init(MT, DM, G, bx);
            pg8::EpiResid E{X1, X1 + (size_t)MP * DM, MP, X2, DM};
            pg8::gemm_phase<pg8::EpiResid, pg8::StaticOrder, true, true>(ldsl, g, S, E);
        }
        GRID_BAR(pb + 7);
        if (EN(9) && IN(pb + 8)) { PHASE_IDS
            if (l + 1 < NL) { for (int m = gw; m < MT; m += NGW) rms_row(X2 + (size_t)m * DM, norm_mix + (size_t)(l + 1) * DM, HB + (size_t)m * DM, nullptr, lane); }
            else { for (int m = gw; m < MT; m += NGW) rms_row(X2 + (size_t)m * DM, norm_final, nullptr, out + O_YP + (size_t)m * DM, lane); }
        }
        GRID_BAR(pb + 8);
    }
#undef IN
}

#ifndef MK_PER_PHASE
#define MK_PER_PHASE 0
#endif
typedef void (*kfn_t)(Args); static const kfn_t K_ALL = hymba_fwd<0x3ffu, 0xffu>;
extern "C" void kernel_launch(void* const* d_in, const int* in_sizes, int n_in, void* d_out, int out_size, void* d_ws, size_t ws_size, hipStream_t stream) {
    static int grid = 0;
    if (grid == 0) {
        if (n_in != 22 || out_size != (int)O_END || ws_size < WS_END) { fprintf(stderr, "kernel_launch: unexpected shapes (n_in %d, out %d, ws %zu)\n", n_in, out_size, ws_size); grid = -1; return; }
        int dev = 0, cus = 0, per_cu = 0;
        if (hipGetDevice(&dev) != hipSuccess || hipDeviceGetAttribute(&cus, hipDeviceAttributeMultiprocessorCount, dev) != hipSuccess) { grid = -1; return; }
        if (hipFuncSetAttribute((const void*)K_ALL, hipFuncAttributeMaxDynamicSharedMemorySize, LDS_BYTES) != hipSuccess) { fprintf(stderr, "kernel_launch: hipFuncSetAttribute failed\n"); grid = -1; return; }
        if (hipOccupancyMaxActiveBlocksPerMultiprocessor(&per_cu, (const void*)K_ALL, NWAVES * 64, LDS_BYTES) != hipSuccess || per_cu < 1) { fprintf(stderr, "kernel_launch: occupancy query says %d blocks per CU\n", per_cu); }
        (void)hipGetLastError();
        grid = cus;
    }
    if (grid < 0) return;
    (void)hipMemsetAsync((char*)d_ws + WS_CTL, 0, CTL_ZERO_BYTES, stream);
    Args a{};
    for (int i = 0; i < 22; ++i) a.in[i] = d_in[i];
    a.out = (float*)d_out; a.ws = (unsigned char*)d_ws;
    const dim3 g(grid), b(NWAVES * 64);
#if MK_PER_PHASE
    for (int ph = 0; ph < N_PHASES; ++ph) { a.ph_lo = ph; a.ph_hi = ph + 1; K_ALL<<<g, b, LDS_BYTES, stream>>>(a); }
#else
    a.ph_lo = 0; a.ph_hi = N_PHASES; K_ALL<<<g, b, LDS_BYTES, stream>>>(a);
#endif
}
```

```cpp
#include <hip/hip_runtime.h>
#include <cstdio>
#include <cstdint>
namespace pg8 {
#define PG8_LAS __attribute__((address_space(3)))
typedef unsigned short bf16_t;
typedef short bf16x8 __attribute__((ext_vector_type(8)));
typedef float f32x4 __attribute__((ext_vector_type(4)));
typedef unsigned u32x4 __attribute__((ext_vector_type(4)));
constexpr int BM = 256, BK = 64, HALF = 128, HTB = HALF * BK * 2  , STAGE_BYTES = 8 * HTB, NXCD = 8, WGM = 8;

__host__ __device__ __forceinline__ int lds_byte(int r, int c) { const int st = (r >> 4) * 2 + (c >> 5), rr = r & 15, cc = c & 31, ob = rr * 64 + cc * 2; return st * 1024 + (ob ^ (((ob >> 9) & 1) << 5)); }
__host__ __device__ __forceinline__ void stage_rc(int b, int& R, int& C) { const int st = b / 1024, sb = b % 1024, swz = sb ^ (((sb >> 9) & 1) << 5); R = (st >> 1) * 16 + swz / 64; C = (st & 1) * 32 + (swz % 64) / 2; }
__host__ __device__ __forceinline__ int perm32(int rho) { const int n = rho >> 4, i = rho & 15; return 8 * (i >> 2) + 4 * n + (i & 3); }

struct Unit { int pm, pn; };
struct Gemm { const bf16_t* A; const bf16_t* Bt; int M, N, K; };

struct StaticOrder {
    int nM, nN, nwg, G, c;
    __host__ __device__ void init(int M, int N, int G_, int c_) { nM = M / BM; nN = N / BM; nwg = nM * nN; G = G_; c = c_; }
    __host__ __device__ bool next(int i, Unit& u) const {
        const long L = (long)i * G + c; if (L >= nwg) return false;
        int wgid = (int)L; { const int q = nwg / NXCD, r = nwg % NXCD, xcd = wgid % NXCD, off = wgid / NXCD; wgid = (xcd < r ? xcd * (q + 1) : r * (q + 1) + (xcd - r) * q) + off; }
        const int nig = WGM * nN, gid = wgid / nig, fm = gid * WGM, gsz = (nM - fm) < WGM ? (nM - fm) : WGM;
        u.pm = fm + ((wgid % nig) % gsz); u.pn = (wgid % nig) / gsz; return true;
    }
    __device__ __forceinline__ void a_ready(const Unit&) const {}
    __device__ __forceinline__ void done(const Unit&) const {}
};

__device__ __forceinline__ unsigned cvt_pk_bf16(float lo, float hi) { unsigned r; asm volatile("v_cvt_pk_bf16_f32 %0, %1, %2" : "=v"(r) : "v"(lo), "v"(hi)); return r; }

struct EpiF32 {
    static constexpr bool PERM = false, AFTER_DRAIN = false;
    float* O; int ldc;
    __device__ __forceinline__ void operator()(const f32x4 (&acc)[2][2][4][2], const Unit& u, int wr, int wc, int fr, int fq) const {
        const int row0 = u.pm * BM + wr * 64 + fr, col0 = u.pn * BM + wc * 32 + 4 * fq;
#pragma unroll
        for (int ai = 0; ai < 2; ++ai)
#pragma unroll
            for (int m = 0; m < 4; ++m) { float* rowp = O + (size_t)(row0 + ai * HALF + m * 16) * ldc + col0;
#pragma unroll
                for (int bj = 0; bj < 2; ++bj)
#pragma unroll
                    for (int n = 0; n < 2; ++n) *(f32x4*)(rowp + bj * HALF + n * 16) = acc[ai][bj][m][n]; }
    }
};
struct EpiResid {
    static constexpr bool PERM = false, AFTER_DRAIN = false;
    const float* base; const float* base2; int split_row; float* O; int ldc;
    __device__ __forceinline__ void operator()(const f32x4 (&acc)[2][2][4][2], const Unit& u, int wr, int wc, int fr, int fq) const {
        const int row0 = u.pm * BM + wr * 64 + fr, col0 = u.pn * BM + wc * 32 + 4 * fq;
        const float* bs = (u.pm * BM >= split_row) ? (base2 - (size_t)split_row * ldc) : base;
#pragma unroll
        for (int ai = 0; ai < 2; ++ai)
#pragma unroll
            for (int m = 0; m < 4; ++m) { const size_t off = (size_t)(row0 + ai * HALF + m * 16) * ldc + col0;
#pragma unroll
                for (int bj = 0; bj < 2; ++bj)
#pragma unroll
                    for (int n = 0; n < 2; ++n) { const f32x4 r = *(const f32x4*)(bs + off + bj * HALF + n * 16); *(f32x4*)(O + off + bj * HALF + n * 16) = r + acc[ai][bj][m][n]; } }
    }
};
struct EpiRelu2 {
    static constexpr bool PERM = true, AFTER_DRAIN = false;
    bf16_t* O; int ldc;
    __device__ __forceinline__ void operator()(const f32x4 (&acc)[2][2][4][2], const Unit& u, int wr, int wc, int fr, int fq) const {
        const int row0 = u.pm * BM + wr * 64 + fr, col0 = u.pn * BM + wc * 32 + 8 * fq;
#pragma unroll
        for (int ai = 0; ai < 2; ++ai)
#pragma unroll
            for (int m = 0; m < 4; ++m) { bf16_t* rowp = O + (size_t)(row0 + ai * HALF + m * 16) * ldc + col0;
#pragma unroll
                for (int bj = 0; bj < 2; ++bj) { f32x4 v0 = acc[ai][bj][m][0], v1 = acc[ai][bj][m][1];
#pragma unroll
                    for (int i = 0; i < 4; ++i) { const float a = v0[i] > 0.f ? v0[i] : 0.f, b = v1[i] > 0.f ? v1[i] : 0.f; v0[i] = a * a; v1[i] = b * b; }
                    u32x4 w; w.x = cvt_pk_bf16(v0[0], v0[1]); w.y = cvt_pk_bf16(v0[2], v0[3]); w.z = cvt_pk_bf16(v1[0], v1[1]); w.w = cvt_pk_bf16(v1[2], v1[3]);
                    *(u32x4*)(rowp + bj * HALF) = w; } }
    }
};
template <class Epi, class Sched, bool ALIGN_EPI = false, bool SP2 = false>
__device__ __forceinline__ void gemm_phase(PG8_LAS unsigned char* lds, const Gemm g, const Sched& S, const Epi& E) {
    int tid = threadIdx.x; asm volatile("" : "+v"(tid));
    const int wid = __builtin_amdgcn_readfirstlane(tid >> 6), lane = tid & 63, wr = wid >> 2, wc = wid & 3, fr = lane & 15, fq = lane >> 4;
    const int K = g.K, nt = K / BK;
    unsigned voffA[2], voffB[2];
#pragma unroll
    for (int i = 0; i < 2; ++i) { int R, C; stage_rc(tid * 16 + i * 8192, R, C); const int Rb = Epi::PERM ? ((R & ~31) + perm32(R & 31)) : R;
        voffA[i] = (unsigned)(R * K + C) * 2u; voffB[i] = (unsigned)(Rb * K + C) * 2u; }
    const size_t kstep = (size_t)(BK * 2);
    const size_t hstep = (size_t)HALF * K * 2;
    const size_t tstep = 2 * hstep;
    const unsigned ldsw = (unsigned)wid * 1024u;
    const int aoff = lds_byte(wr * 64 + fr, fq * 8), boff = lds_byte(wc * 32 + fr, fq * 8);
#define PG8_SA(b, h) (((b) * 2 + (h)) * HTB)
#define PG8_SB(b, h) ((4 + (b) * 2 + (h)) * HTB)
#define PG8_STAGE(bufoff, gbase, voff) do { _Pragma("unroll") for (int _i = 0; _i < 2; ++_i) \
        __builtin_amdgcn_global_load_lds((const unsigned*)((const char*)(gbase) + (voff)[_i]), (PG8_LAS unsigned*)(lds + (bufoff) + ldsw + _i * 8192), 16, 0, 0); } while (0)
#define PG8_LDA(dst, b, h) do { _Pragma("unroll") for (int m = 0; m < 4; ++m) _Pragma("unroll") for (int k = 0; k < 2; ++k) dst[m][k] = *(const PG8_LAS bf16x8*)(lds + PG8_SA(b, h) + aoff + m * 2048 + k * 1024); } while (0)
#define PG8_LDB(dst, b, h) do { _Pragma("unroll") for (int n = 0; n < 2; ++n) _Pragma("unroll") for (int k = 0; k < 2; ++k) dst[n][k] = *(const PG8_LAS bf16x8*)(lds + PG8_SB(b, h) + boff + n * 2048 + k * 1024); } while (0)
#define PG8_MMA(ai, bj, At, Bt) do { __builtin_amdgcn_s_setprio(1); _Pragma("unroll") for (int m = 0; m < 4; ++m) _Pragma("unroll") for (int n = 0; n < 2; ++n) _Pragma("unroll") for (int k = 0; k < 2; ++k) \
        acc[ai][bj][m][n] = __builtin_amdgcn_mfma_f32_16x16x32_bf16(Bt[n][k], At[m][k], acc[ai][bj][m][n], 0, 0, 0); __builtin_amdgcn_s_setprio(0); } while (0)
#define PG8_WAIT_V(n) asm volatile("s_waitcnt vmcnt(" #n ")" ::: "memory")
#define PG8_WAIT_L(n) asm volatile("s_waitcnt lgkmcnt(" #n ")" ::: "memory")
#define PG8_BAR __builtin_amdgcn_s_barrier()
#define PG8_SCHED __builtin_amdgcn_sched_barrier(0)
    Unit cur, nxt; int ui = 0;
    if (!S.next(0, cur)) return;
    f32x4 acc[2][2][4][2];
#pragma unroll
    for (int a = 0; a < 2; ++a)
#pragma unroll
        for (int b = 0; b < 2; ++b)
#pragma unroll
            for (int m = 0; m < 4; ++m)
#pragma unroll
                for (int n = 0; n < 2; ++n) acc[a][b][m][n] = (f32x4){0.f, 0.f, 0.f, 0.f};
    bf16x8 At[4][2], B0[2][2], B1[2][2];
    const char* cA = (const char*)g.A + (size_t)cur.pm * tstep; const char* cB = (const char*)g.Bt + (size_t)cur.pn * tstep;
    S.a_ready(cur);
    if constexpr (SP2) {
        PG8_STAGE(PG8_SB(0, 0), cB, voffB); PG8_STAGE(PG8_SB(0, 1), cB + hstep, voffB); PG8_STAGE(PG8_SA(0, 0), cA, voffA); PG8_STAGE(PG8_SA(0, 1), cA + hstep, voffA);
        if (wr == 1) PG8_BAR;
        PG8_WAIT_V(2); PG8_BAR;
        PG8_STAGE(PG8_SB(1, 0), cB + kstep, voffB); PG8_STAGE(PG8_SA(1, 0), cA + kstep, voffA); PG8_STAGE(PG8_SB(1, 1), cB + hstep + kstep, voffB);
        PG8_WAIT_V(6); PG8_BAR;
    } else {
        PG8_STAGE(PG8_SB(0, 0), cB, voffB); PG8_STAGE(PG8_SA(0, 0), cA, voffA); PG8_STAGE(PG8_SB(0, 1), cB + hstep, voffB); PG8_STAGE(PG8_SA(0, 1), cA + hstep, voffA);
        if (wr == 1) PG8_BAR;
        PG8_WAIT_V(4); PG8_BAR;
        PG8_STAGE(PG8_SB(1, 0), cB + kstep, voffB); PG8_STAGE(PG8_SA(1, 0), cA + kstep, voffA); PG8_STAGE(PG8_SB(1, 1), cB + hstep + kstep, voffB);
        PG8_WAIT_V(6); PG8_BAR;
    }
    for (;;) {
        const bool has_next = S.next(ui + 1, nxt);
        const char* nA = has_next ? (const char*)g.A + (size_t)nxt.pm * tstep : cA; const char* nB = has_next ? (const char*)g.Bt + (size_t)nxt.pn * tstep : cB;
        for (int t = 0; t < nt; t += 2) {
            const bool last = (t == nt - 2);
            const char* a1 = cA + (size_t)(t + 1) * kstep;
            const char* a2 = last ? nA : cA + (size_t)(t + 2) * kstep; const char* b2 = last ? nB : cB + (size_t)(t + 2) * kstep;
            const char* a3 = a2 + kstep; const char* b3 = b2 + kstep;
            if (last && has_next) S.a_ready(nxt);
            if constexpr (SP2) {
            PG8_LDB(B0, 0, 0); PG8_LDB(B1, 0, 1); PG8_SCHED; PG8_LDA(At, 0, 0); PG8_STAGE(PG8_SA(1, 1), a1 + hstep, voffA);
            PG8_WAIT_V(8); PG8_WAIT_L(0); PG8_BAR; PG8_MMA(0, 0, At, B0); PG8_MMA(0, 1, At, B1); PG8_BAR; PG8_SCHED;
            PG8_LDA(At, 0, 1); PG8_STAGE(PG8_SB(0, 0), b2, voffB); PG8_STAGE(PG8_SB(0, 1), b2 + hstep, voffB); PG8_STAGE(PG8_SA(0, 0), a2, voffA);
            PG8_WAIT_V(8); PG8_WAIT_L(0); PG8_BAR; PG8_MMA(1, 0, At, B0); PG8_MMA(1, 1, At, B1); PG8_BAR; PG8_SCHED;
            PG8_LDB(B0, 1, 0); PG8_LDB(B1, 1, 1); PG8_SCHED; PG8_LDA(At, 1, 0); PG8_STAGE(PG8_SA(0, 1), a2 + hstep, voffA);
            PG8_WAIT_V(8); PG8_WAIT_L(0); PG8_BAR; PG8_MMA(0, 0, At, B0); PG8_MMA(0, 1, At, B1); PG8_BAR; PG8_SCHED;
            PG8_LDA(At, 1, 1); PG8_STAGE(PG8_SB(1, 0), b3, voffB); PG8_STAGE(PG8_SB(1, 1), b3 + hstep, voffB); PG8_STAGE(PG8_SA(1, 0), a3, voffA);
            PG8_WAIT_V(8); PG8_WAIT_L(0); PG8_BAR; PG8_MMA(1, 0, At, B0); PG8_MMA(1, 1, At, B1); PG8_BAR; PG8_SCHED;
            } else {
            PG8_LDB(B0, 0, 0); PG8_SCHED; PG8_LDA(At, 0, 0); PG8_STAGE(PG8_SA(1, 1), a1 + hstep, voffA);
            PG8_WAIT_L(8); PG8_BAR; PG8_WAIT_L(0); PG8_MMA(0, 0, At, B0); PG8_BAR; PG8_SCHED;
            PG8_LDB(B1, 0, 1); PG8_STAGE(PG8_SB(0, 0), b2, voffB);
            PG8_BAR; PG8_WAIT_L(0); PG8_MMA(0, 1, At, B1); PG8_BAR;
            PG8_LDA(At, 0, 1); PG8_STAGE(PG8_SA(0, 0), a2, voffA);
            PG8_BAR; PG8_WAIT_L(0); PG8_MMA(1, 0, At, B0); PG8_BAR; PG8_SCHED;
            PG8_STAGE(PG8_SB(0, 1), b2 + hstep, voffB);
            PG8_WAIT_V(6); PG8_BAR; PG8_MMA(1, 1, At, B1); PG8_BAR;
            PG8_LDB(B0, 1, 0); PG8_SCHED; PG8_LDA(At, 1, 0); PG8_STAGE(PG8_SA(0, 1), a2 + hstep, voffA);
            PG8_WAIT_L(8); PG8_BAR; PG8_WAIT_L(0); PG8_MMA(0, 0, At, B0); PG8_BAR; PG8_SCHED;
            PG8_LDB(B1, 1, 1); PG8_STAGE(PG8_SB(1, 0), b3, voffB);
            PG8_BAR; PG8_WAIT_L(0); PG8_MMA(0, 1, At, B1); PG8_BAR;
            PG8_LDA(At, 1, 1); PG8_STAGE(PG8_SA(1, 0), a3, voffA);
            PG8_BAR; PG8_WAIT_L(0); PG8_MMA(1, 0, At, B0); PG8_BAR; PG8_SCHED;
            PG8_STAGE(PG8_SB(1, 1), b3 + hstep, voffB);
            PG8_WAIT_V(6); PG8_BAR; PG8_MMA(1, 1, At, B1); PG8_BAR;
            }
        }
        if constexpr (ALIGN_EPI) { if (wr == 0) PG8_BAR; }
        if constexpr (!Epi::AFTER_DRAIN) { E(acc, cur, wr, wc, fr, fq); S.done(cur); }
        if (!has_next) break;
#pragma unroll
        for (int a = 0; a < 2; ++a)
#pragma unroll
            for (int b = 0; b < 2; ++b)
#pragma unroll
                for (int m = 0; m < 4; ++m)
#pragma unroll
                    for (int n = 0; n < 2; ++n) acc[a][b][m][n] = (f32x4){0.f, 0.f, 0.f, 0.f};
        cur = nxt; cA = nA; cB = nB; ++ui;
        if constexpr (ALIGN_EPI) { if (wr == 1) PG8_BAR; }
    }
    PG8_WAIT_V(0);
    if constexpr (!ALIGN_EPI) { if (wr == 0) PG8_BAR; }
    PG8_BAR;
    if constexpr (Epi::AFTER_DRAIN) { E.fused(acc, cur, wr, wc, fr, fq, lds, wid, lane); S.done(cur); }
#undef PG8_SA
#undef PG8_SB
#undef PG8_STAGE
#undef PG8_LDA
#undef PG8_LDB
#undef PG8_MMA
#undef PG8_WAIT_V
#undef PG8_WAIT_L
#undef PG8_BAR
#undef PG8_SCHED
}
}

constexpr int DM = 1024, NPB = 4, SEQ = 4096, MP = NPB * SEQ, NSB = 128, DSEQ = 4, MS = NSB * DSEQ, MT = MP + MS;
constexpr int NPROJ = 3368, NP = 3584, DFF = 4096, NL = 2;
constexpr int C_QKV = 0, C_Z = 1536, C_A = 2048, C_BETA = 2056, C_Q = 2064, C_KV = 2576, C_GATE = 3344;
constexpr int PAST = 2048, NPAGES = 16, NPOOL = 2560;
constexpr float C2 = 0.125f * 1.4426950408889634f;
constexpr float NEG_INF = -__builtin_inff();
constexpr size_t O_YP = 0, O_YS = 16777216, O_KVP = 17301504, O_KVS = 34078720, O_WINP = 34603008, O_WINS = 35651584, O_GDNP = 69206016, O_GDNS = 69468160, O_CONVP = 77856768, O_CONVS = 77893632, O_END = 79073280;
constexpr size_t MiB = 1u << 20;
constexpr size_t WS_CTL = 0, CTL_ZERO_BYTES = 1 * MiB;
constexpr size_t WS_WIN = 2 * MiB, WS_WOUT = 16 * MiB, WS_WUP = 20 * MiB, WS_WDN = 36 * MiB, WS_CMPW = 52 * MiB;
constexpr size_t WS_HB = 54 * MiB, WS_PROJ = 88 * MiB, WS_X1 = 320 * MiB, WS_X2 = 386 * MiB, WS_MIX = 452 * MiB, WS_HID = 486 * MiB;
constexpr size_t WS_QN = 618 * MiB, WS_KN = 651 * MiB, WS_VG = 684 * MiB, WS_OG = 717 * MiB, WS_G = 750 * MiB, WS_BETA = 751 * MiB, WS_KQ = 752 * MiB;
constexpr size_t WS_QB = 753 * MiB, WS_KS = 770 * MiB, WS_VS = 775 * MiB, WS_KW = 780 * MiB, WS_VW = 785 * MiB;
constexpr size_t WS_CKP = 790 * MiB, WS_CVP = 791 * MiB, WS_CKS = 792 * MiB, WS_CVS = 796 * MiB;
constexpr size_t WS_GK = 800 * MiB, WS_GQ = 816 * MiB, WS_GKT = 832 * MiB, WS_GVT = 848 * MiB, WS_GG2 = 864 * MiB, WS_BETA2 = 865 * MiB;
constexpr size_t WS_WX = 866 * MiB, WS_QX = 882 * MiB, WS_QKX = 898 * MiB, WS_KTX = 914 * MiB, WS_U0F = 930 * MiB, WS_GL = 962 * MiB, WS_END = 963 * MiB;
constexpr int CW_QUEUE = 64;
constexpr int CW_BAR = 4096;
constexpr int RING_BYTES = 131072, LDS_BYTES = 147456, MISC_OFF = LDS_BYTES - 64;
constexpr int NWAVES = 8;

#define GAS __attribute__((address_space(1)))
#define LAS __attribute__((address_space(3)))
typedef unsigned short bf16;
typedef unsigned v4u __attribute__((ext_vector_type(4)));
typedef unsigned v2u __attribute__((ext_vector_type(2)));
typedef float f32x4 __attribute__((ext_vector_type(4)));
typedef float f32x16 __attribute__((ext_vector_type(16)));
typedef short bf16x8 __attribute__((ext_vector_type(8)));
typedef short s16x4 __attribute__((ext_vector_type(4)));
#define LDS_WAIT() asm volatile("s_waitcnt lgkmcnt(0)" ::: "memory")
__device__ __forceinline__ unsigned f2bf(float f) { unsigned u = __builtin_bit_cast(unsigned, f); return (u + 0x7fffu + ((u >> 16) & 1u)) >> 16; }
__device__ __forceinline__ unsigned pk2(float lo, float hi) { return f2bf(lo) | (f2bf(hi) << 16); }
__device__ __forceinline__ float bf2f(unsigned short b) { return __builtin_bit_cast(float, (unsigned)b << 16); }
__device__ __forceinline__ bf16x8 pack8(float a0, float a1, float a2, float a3, float a4, float a5, float a6, float a7) {
    v4u w; w.x = pk2(a0, a1); w.y = pk2(a2, a3); w.z = pk2(a4, a5); w.w = pk2(a6, a7); return __builtin_bit_cast(bf16x8, w); }
__device__ __forceinline__ float wave_sum(float v) {
#pragma unroll
    for (int o = 1; o < 64; o <<= 1) v += __shfl_xor(v, o);
    return v;
}
template <int CTRL, int RMASK> __device__ __forceinline__ float dpp_add(float v) {
    const int t = __builtin_amdgcn_update_dpp(0, __builtin_bit_cast(int, v), CTRL, RMASK, 0xf, false);
    return v + __builtin_bit_cast(float, t);
}
__device__ __forceinline__ float dpp_sum(float v) {
    v = dpp_add<0x111, 0xf>(v); v = dpp_add<0x112, 0xf>(v); v = dpp_add<0x114, 0xf>(v); v = dpp_add<0x118, 0xf>(v);
    v = dpp_add<0x142, 0xa>(v); v = dpp_add<0x143, 0xc>(v);
    return __builtin_bit_cast(float, __builtin_amdgcn_readlane(__builtin_bit_cast(int, v), 63));
}
__device__ __forceinline__ float ex2(float x) { return __builtin_amdgcn_exp2f(x); }
__device__ __forceinline__ float sigmoidf_(float x) { return 1.f / (1.f + __expf(-x)); }
__device__ __forceinline__ float siluf_(float x) { return x / (1.f + __expf(-x)); }
__device__ __forceinline__ int crow(int r, int hi) { return (r & 3) + 8 * (r >> 2) + 4 * hi; }
__device__ __forceinline__ void rope_cs(int pos, int d, float& cs, float& sn) {
    const float invf = exp2f(-(float)d * 0.4152410118609203f);
    double rv = (double)pos * (double)invf * 0.15915494309189535; rv -= floor(rv);
    const float rf = (float)rv; sn = __builtin_amdgcn_sinf(rf); cs = __builtin_amdgcn_cosf(rf);
}

#define XB_TMO      128
#define XB_XCNT(j)  (256  + 64 * (j))
#define XB_XSUB(j)  (1280 + 64 * (j))
#define XB_XGEN(j)  (2304 + 64 * (j))
#define XB_TOP      3328
#define XB_TOPGEN   3392
#define XCD_BAR_WORDS 3456
#define XB_SPIN_CAP (1u << 18)

__device__ __forceinline__ unsigned xb_ld(unsigned* p)              { return __hip_atomic_load(p, __ATOMIC_RELAXED, __HIP_MEMORY_SCOPE_AGENT); }
__device__ __forceinline__ unsigned xb_add(unsigned* p, unsigned v) { return __hip_atomic_fetch_add(p, v, __ATOMIC_RELAXED, __HIP_MEMORY_SCOPE_AGENT); }
__device__ __forceinline__ unsigned xb_xcc_id() { return (unsigned)__builtin_amdgcn_s_getreg((3 << 11) | 20) & 0xFu; }
#define XB_SPIN(cond, bar) do { unsigned _sp = 0; while (cond) { __builtin_amdgcn_s_sleep(1); \
    if ((++_sp & 255u) == 0u) { if (xb_ld(&(bar)[XB_TMO])) break; if (_sp > XB_SPIN_CAP) { atomicAdd(&(bar)[XB_TMO], 1u); break; } } } } while (0)

struct XcdBarrier {
    unsigned* bar; unsigned x;
    volatile LAS unsigned* st;
};

__device__ __forceinline__ XcdBarrier xcd_barrier_post(unsigned* bar, volatile LAS unsigned* st) {
    XcdBarrier b; b.bar = bar; b.x = xb_xcc_id(); b.st = st;
    if (threadIdx.x == 0) (void)xb_add(&bar[XB_XCNT(b.x)], 1u);
    return b;
}
__device__ __forceinline__ void xcd_barrier_complete(unsigned* bar, unsigned x, unsigned& nloc, unsigned& nx) {
    const unsigned G = gridDim.x * gridDim.y * gridDim.z;
    unsigned sum, cnt, mine, sp = 0u;
    for (;;) {
        sum = 0u; cnt = 0u; mine = 0u;
#pragma unroll
        for (unsigned j = 0; j < 16; ++j) { const unsigned c = xb_ld(&bar[XB_XCNT(j)]); sum += c; cnt += (c > 0u) ? 1u : 0u; mine = (j == x) ? c : mine; }
        if (sum == G) break;
        __builtin_amdgcn_s_sleep(1);
        if ((++sp & 255u) == 0u) { if (xb_ld(&bar[XB_TMO])) break; if (sp > XB_SPIN_CAP) { atomicAdd(&bar[XB_TMO], 1u); break; } }
    }
    nloc = mine > 0u ? mine : 1u; nx = cnt > 0u ? cnt : 1u;
}

__device__ __forceinline__ void xcd_barrier(const XcdBarrier& b) {
    asm volatile("s_waitcnt vmcnt(0)" ::: "memory");
    __syncthreads();
    if (threadIdx.x == 0) {
        unsigned* bar = b.bar;
        __builtin_amdgcn_s_waitcnt(0);
        unsigned nloc = b.st[0], nx = b.st[1];
        if (nloc == 0u) { xcd_barrier_complete(bar, b.x, nloc, nx); b.st[0] = nloc; b.st[1] = nx; }
        const unsigned old = xb_add(&bar[XB_XSUB(b.x)], 1u);
        const unsigned gen = old / nloc;
        if (old + 1u == (gen + 1u) * nloc) {
            __builtin_amdgcn_fence(__ATOMIC_RELEASE, "agent");
            asm volatile("s_waitcnt vmcnt(0)" ::: "memory");
            const unsigned og = xb_add(&bar[XB_TOP], 1u);
            const unsigned tg = og / nx;
            if (og + 1u == (tg + 1u) * nx) xb_add(&bar[XB_TOPGEN], 1u);
            else XB_SPIN(xb_ld(&bar[XB_TOPGEN]) == tg, bar);
            __builtin_amdgcn_fence(__ATOMIC_ACQUIRE, "agent");
            xb_add(&bar[XB_XGEN(b.x)], 1u);
            asm volatile("s_waitcnt vmcnt(0)" ::: "memory");
        } else {
            XB_SPIN(xb_ld(&bar[XB_XGEN(b.x)]) == gen, bar);
            __builtin_amdgcn_fence(__ATOMIC_ACQUIRE, "agent");
            asm volatile("s_waitcnt vmcnt(0)" ::: "memory");
        }
    }
    __syncthreads();
}

__device__ __forceinline__ void transpose_item(const float* W, int K, int N, int Npad, bf16* WT, LAS float* scr, int item, int lane) {
    const int nblk = Npad / 32, kb = item / nblk, nb = item % nblk, k0 = 64 * kb, n0 = 32 * nb;
    const int ncol = n0 + (lane & 31);
#pragma unroll 8
    for (int i = 0; i < 32; ++i) { const int kk = 2 * i + (lane >> 5); scr[kk * 33 + (lane & 31)] = (ncol < N) ? W[(size_t)(k0 + kk) * N + ncol] : 0.f; }
    LDS_WAIT(); asm volatile("" ::: "memory");
    const int c = lane & 7;
#pragma unroll
    for (int j = 0; j < 4; ++j) { const int n = (lane >> 3) + 8 * j; const LAS float* s = scr + (8 * c) * 33 + n;
        v4u o; o.x = pk2(s[0 * 33], s[1 * 33]); o.y = pk2(s[2 * 33], s[3 * 33]); o.z = pk2(s[4 * 33], s[5 * 33]); o.w = pk2(s[6 * 33], s[7 * 33]);
        *(v4u*)(WT + (size_t)(n0 + n) * K + k0 + 8 * c) = o; }
    LDS_WAIT(); asm volatile("" ::: "memory");
}
__device__ __forceinline__ void rms_row(const float* xrow, const float* g, bf16* orow, float* of32, int lane) {
    const f32x4* xr = (const f32x4*)xrow + lane;
    f32x4 v[4]; float s = 0.f;
#pragma unroll
    for (int j = 0; j < 4; ++j) { v[j] = xr[64 * j]; s += (v[j].x * v[j].x + v[j].y * v[j].y) + (v[j].z * v[j].z + v[j].w * v[j].w); }
    const float rstd = 1.f / sqrtf(wave_sum(s) * (1.f / DM) + 1e-6f);
#pragma unroll
    for (int j = 0; j < 4; ++j) { const f32x4 gg = ((const f32x4*)g)[64 * j + lane]; const f32x4 o = v[j] * rstd * gg;
        if (of32) ((f32x4*)of32)[64 * j + lane] = o;
        else ((v2u*)orow)[64 * j + lane] = (v2u){pk2(o.x, o.y), pk2(o.z, o.w)}; }
}

struct PBArgs { const float* PROJ; const float* state_conv; const float* conv_w; const float* a_log; const float* dt_bias;
    float* QN; float* KN; float* VG; float* G; float* BETA; float* KQ; bf16* QB; bf16* KS; bf16* VS; bf16* KW; bf16* VW; float* out; int l; };
__device__ __forceinline__ void pb_row(const PBArgs& A, int m, int lane) {
    const bool is_s = m >= MP; int b, t;
    if (!is_s) { b = m >> 12; t = m & 4095; } else { b = (m - MP) >> 2; t = (m - MP) & 3; }
    const int pos = is_s ? PAST + t : t, l = A.l;
    const float* pr = A.PROJ + (size_t)m * NP;
    const float* cw = A.conv_w + (size_t)l * 4 * 1536;
    const float* cb = A.state_conv + ((size_t)l * NSB + b) * 3 * 1536;
    if (is_s) {
#pragma unroll 4
    for (int h = 0; h < 8; ++h) {
        float qkv[3];
#pragma unroll
        for (int part = 0; part < 3; ++part) { const int c = (part * 8 + h) * 64 + lane; float acc = 0.f;
#pragma unroll
            for (int tap = 0; tap < 4; ++tap) { const int idx = t + tap;
                float xv;
                if (idx >= 3) xv = A.PROJ[(size_t)(m - t + idx - 3) * NP + c];
                else xv = is_s ? cb[idx * 1536 + c] : 0.f;
                acc += xv * cw[tap * 1536 + c]; }
            qkv[part] = siluf_(acc); }
        const float q = qkv[0], k = qkv[1];
        const float qs = dpp_sum(q * q), ks = dpp_sum(k * k);
        const float qn = q * (1.f / sqrtf(qs + 1e-6f)) * 0.125f, kn = k * (1.f / sqrtf(ks + 1e-6f));
        const float kq = dpp_sum(qn * kn);
        A.QN[(size_t)m * 512 + h * 64 + lane] = qn; A.KN[(size_t)m * 512 + h * 64 + lane] = kn; A.VG[(size_t)m * 512 + h * 64 + lane] = qkv[2];
        if (lane == 0) A.KQ[(size_t)m * 8 + h] = kq;
    }
    if (lane < 8) {
        const float a = pr[C_A + lane] + A.dt_bias[l * 8 + lane];
        const float sp = fmaxf(a, 0.f) + log1pf(__expf(-fabsf(a)));
        A.G[(size_t)m * 8 + lane] = -__expf(A.a_log[l * 8 + lane]) * sp;
        A.BETA[(size_t)m * 8 + lane] = sigmoidf_(pr[C_BETA + lane]); }
    }
    if (!is_s && t >= SEQ - 3) { float* o = A.out + O_CONVP + ((size_t)(l * NPB + b) * 3 + (t - (SEQ - 3))) * 1536;
#pragma unroll 4
        for (int j = 0; j < 24; ++j) o[64 * j + lane] = pr[64 * j + lane]; }
    if (is_s && t >= 1) { float* o = A.out + O_CONVS + ((size_t)(l * NSB + b) * 3 + (t - 1)) * 1536;
#pragma unroll 4
        for (int j = 0; j < 24; ++j) o[64 * j + lane] = pr[64 * j + lane]; }
    const int half = lane >> 5; float cs, sn; rope_cs(pos, lane & 31, cs, sn);
#pragma unroll
    for (int h = 0; h < 8; ++h) { const float xs = pr[C_Q + h * 64 + lane], xo = pr[C_Q + h * 64 + (lane ^ 32)];
        const float r = half ? (xs * cs + xo * sn) : (xs * cs - xo * sn);
        A.QB[(size_t)m * 512 + h * 64 + lane] = (bf16)f2bf(r * C2); }
#pragma unroll
    for (int s6 = 0; s6 < 6; ++s6)
#pragma unroll
        for (int kvh = 0; kvh < 2; ++kvh) {
            float v = pr[C_KV + s6 * 128 + kvh * 64 + lane];
            if (s6 == 2 || s6 == 4) { const float xo = pr[C_KV + s6 * 128 + kvh * 64 + (lane ^ 32)]; v = half ? (v * cs + xo * sn) : (v * cs - xo * sn); }
            if (s6 < 4) {
                if (!is_s) A.out[O_KVP + ((((size_t)(l * NPB + b) * 2 + kvh) * SEQ + t) * 4 + s6) * 64 + lane] = v;
                else       A.out[O_KVS + ((((size_t)(l * NSB + b) * 2 + kvh) * DSEQ + t) * 4 + s6) * 64 + lane] = v;
            } else {
                const int idx = s6 - 4;
                if (!is_s) { if (t >= SEQ - 512) A.out[O_WINP + ((((size_t)(l * NPB + b) * 512 + (t - (SEQ - 512))) * 2 + idx) * 2 + kvh) * 64 + lane] = v; }
                else A.out[O_WINS + ((((size_t)(l * NSB + b) * 512 + (508 + t)) * 2 + idx) * 2 + kvh) * 64 + lane] = v;
            }
            const bf16 bv = (bf16)f2bf(v);
            if (s6 == 2) A.KS[(size_t)m * 128 + kvh * 64 + lane] = bv;
            if (s6 == 3) A.VS[(size_t)m * 128 + kvh * 64 + lane] = bv;
            if (s6 == 4) A.KW[(size_t)m * 128 + kvh * 64 + lane] = bv;
            if (s6 == 5) A.VW[(size_t)m * 128 + kvh * 64 + lane] = bv;
        }
}

struct CmpArgs { const float* PROJ; const float* cache; const int* page_table; const float* pe_k; const float* pe_v; const bf16* CMPW; unsigned char* ws; int l; };
__device__ __forceinline__ void compress_unit(const CmpArgs& A, int u, int lane) {
    const int fr = lane & 15, fq = lane >> 4, l = A.l;
    const int kv = u & 1, uu = u >> 1; const bool is_s = uu >= 64; const int ru = is_s ? uu - 64 : uu;
    const int rho = 16 * ru + fr, NC = is_s ? 64 : 128;
    const int seq = rho / (2 * NC), n = (rho >> 1) % NC, kvh = rho & 1;
    const float* abase; size_t astride;
    if (!is_s) { abase = A.PROJ + (size_t)(seq * SEQ + 32 * n) * NP + C_KV + kv * 128 + kvh * 64; astride = NP; }
    else { const int page = A.page_table[seq * NPAGES + (n >> 2)];
        abase = A.cache + ((((size_t)l * NPOOL + page) * 2 + kvh) * 128 + (n & 3) * 32) * 256 + kv * 64; astride = 256; }
    const float* pe = (kv ? A.pe_v : A.pe_k) + (size_t)l * 2048;
    const bf16* Wt = A.CMPW + (size_t)((l * 2 + kv) * 64) * 2048;
    f32x4 acc[4];
#pragma unroll
    for (int et = 0; et < 4; ++et) acc[et] = (f32x4){0.f, 0.f, 0.f, 0.f};
#pragma unroll 2
    for (int c = 0; c < 32; ++c) {
#pragma unroll
        for (int ks = 0; ks < 2; ++ks) {
            const float* ap = abase + (size_t)c * astride + 32 * ks + 8 * fq; const float* pp = pe + c * 64 + 32 * ks + 8 * fq;
            const f32x4 a0 = *(const f32x4*)ap + *(const f32x4*)pp, a1 = *(const f32x4*)(ap + 4) + *(const f32x4*)(pp + 4);
            const bf16x8 ya = pack8(a0.x, a0.y, a0.z, a0.w, a1.x, a1.y, a1.z, a1.w);
#pragma unroll
            for (int et = 0; et < 4; ++et) { const bf16x8 xb = *(const bf16x8*)(Wt + (size_t)(16 * et + fr) * 2048 + c * 64 + 32 * ks + 8 * fq);
                acc[et] = __builtin_amdgcn_mfma_f32_16x16x32_bf16(xb, ya, acc[et], 0, 0, 0); }
        }
    }
    if (kv == 0) { const int pos = 32 * n + 31;
#pragma unroll
        for (int et = 0; et < 2; ++et)
#pragma unroll
            for (int i = 0; i < 4; ++i) { float cs, sn; rope_cs(pos, 16 * et + 4 * fq + i, cs, sn);
                const float x1 = acc[et][i], x2 = acc[et + 2][i]; acc[et][i] = x1 * cs - x2 * sn; acc[et + 2][i] = x2 * cs + x1 * sn; } }
    float* ob = (float*)(A.ws + (is_s ? WS_CKS : WS_CKP) + (size_t)kv * (is_s ? (WS_CVS - WS_CKS) : (WS_CVP - WS_CKP))) + (size_t)rho * 64 + 4 * fq;
#pragma unroll
    for (int et = 0; et < 4; ++et) *(f32x4*)(ob + 16 * et) = acc[et];
}

struct GdnArgs { const float* QN; const float* KN; const float* VG; const float* G; const float* BETA; const float* KQ; float* OG; const float* PROJ; const float* state_gdn; const float* gdn_norm; bf16* MIX; float* out; int l; };
__device__ __forceinline__ void gdn_sample_unit(const GdnArgs& A, int unit, int lane) {
    const int sb = unit >> 3, h = unit & 7, l = A.l;
    const float* sp = A.state_gdn + (((size_t)l * NSB + sb) * 8 + h) * 4096;
    float S[64];
#pragma unroll
    for (int d = 0; d < 64; ++d) S[d] = sp[d * 64 + lane];
    const float gn = A.gdn_norm[l * 64 + lane];
    for (int i = 0; i < DSEQ; ++i) {
        const size_t m = (size_t)MP + sb * 4 + i;
        const float kd = A.KN[m * 512 + h * 64 + lane], qd = A.QN[m * 512 + h * 64 + lane], v = A.VG[m * 512 + h * 64 + lane];
        const float g = A.G[m * 8 + h], beta = A.BETA[m * 8 + h], kq = A.KQ[m * 8 + h];
        const int kdb = __builtin_bit_cast(int, kd), qdb = __builtin_bit_cast(int, qd);
        const float a = __expf(g); float r1 = 0.f, r2 = 0.f;
#pragma unroll
        for (int d = 0; d < 64; ++d) { const float kk = __builtin_bit_cast(float, __builtin_amdgcn_readlane(kdb, d)), qq = __builtin_bit_cast(float, __builtin_amdgcn_readlane(qdb, d)); r1 += S[d] * kk; r2 += S[d] * qq; }
        const float u = beta * (v - a * r1), o = a * r2 + u * kq;
#pragma unroll
        for (int d = 0; d < 64; ++d) { const float kk = __builtin_bit_cast(float, __builtin_amdgcn_readlane(kdb, d)); S[d] = a * S[d] + kk * u; }
        const float ms = wave_sum(o * o) * (1.f / 64.f);
        const float z = A.PROJ[m * NP + C_Z + h * 64 + lane];
        A.MIX[m * 1024 + h * 64 + lane] = (bf16)f2bf(o * (1.f / sqrtf(ms + 1e-6f)) * gn * siluf_(z));
    }
    float* so = A.out + O_GDNS + (((size_t)l * NSB + sb) * 8 + h) * 4096;
#pragma unroll
    for (int d = 0; d < 64; ++d) so[d * 64 + lane] = S[d];
}


__device__ __forceinline__ int perm_inv32(int p) { return (p & 32) + 16 * ((p >> 2) & 1) + 4 * ((p >> 3) & 3) + (p & 3); }
struct GPArgs { const float* PROJ; const float* conv_w; const float* a_log; const float* dt_bias; bf16* GK; bf16* GQ; bf16* GKT; bf16* GVT; float* GG2; float* BETA2; int l; };
__device__ __forceinline__ void gdn_prep_unit(const GPArgs& A, int unit, int lane) {
    const int tg = unit >> 3, h = unit & 7, m0 = tg * 8, b = m0 >> 12, t0 = m0 & 4095, l = A.l, bh = b * 8 + h;
    const float* cw = A.conv_w + (size_t)l * 4 * 1536;
    float val[3][8];
#pragma unroll
    for (int part = 0; part < 3; ++part) { const int c = (part * 8 + h) * 64 + lane;
        float x[11];
#pragma unroll
        for (int j = 0; j < 11; ++j) x[j] = (t0 - 3 + j >= 0) ? A.PROJ[(size_t)(m0 - 3 + j) * NP + c] : 0.f;
        const float w0 = cw[c], w1 = cw[1536 + c], w2 = cw[2 * 1536 + c], w3 = cw[3 * 1536 + c];
#pragma unroll
        for (int i = 0; i < 8; ++i) val[part][i] = siluf_(w0 * x[i] + w1 * x[i + 1] + w2 * x[i + 2] + w3 * x[i + 3]); }
#pragma unroll
    for (int i = 0; i < 8; ++i) { const float q = val[0][i], k = val[1][i];
        const float qs = dpp_sum(q * q), ks = dpp_sum(k * k);
        val[0][i] = q * (1.f / sqrtf(qs + 1e-6f)) * 0.125f; val[1][i] = k * (1.f / sqrtf(ks + 1e-6f)); }
#pragma unroll
    for (int i = 0; i < 8; ++i) { A.GQ[((size_t)bh * 4096 + t0 + i) * 64 + lane] = (bf16)f2bf(val[0][i]); A.GK[((size_t)bh * 4096 + t0 + i) * 64 + lane] = (bf16)f2bf(val[1][i]); }
    *(v4u*)(A.GKT + ((size_t)bh * 64 + lane) * 4096 + t0) = (v4u){pk2(val[1][0], val[1][1]), pk2(val[1][2], val[1][3]), pk2(val[1][4], val[1][5]), pk2(val[1][6], val[1][7])};
    *(v4u*)(A.GVT + ((size_t)bh * 64 + lane) * 4096 + t0) = (v4u){pk2(val[2][0], val[2][1]), pk2(val[2][2], val[2][3]), pk2(val[2][4], val[2][5]), pk2(val[2][6], val[2][7])};
    if (lane < 8) { const float* pr = A.PROJ + (size_t)(m0 + lane) * NP;
        const float a = pr[C_A + h] + A.dt_bias[l * 8 + h];
        const float sp = fmaxf(a, 0.f) + log1pf(__expf(-fabsf(a)));
        A.GG2[(size_t)bh * 4096 + t0 + lane] = -__expf(A.a_log[l * 8 + h]) * sp;
        A.BETA2[(size_t)bh * 4096 + t0 + lane] = sigmoidf_(pr[C_BETA + h]); }
}
template <int I> __device__ __forceinline__ void fsub_row(float (&T)[64], const float* AL, int lane) {
    float tv = (lane == I) ? 1.f : 0.f;
#pragma unroll
    for (int j4 = 0; j4 < (I + 3) / 4; ++j4) { const f32x4 a = *(const f32x4*)(AL + I * 64 + 4 * j4);
#pragma unroll
        for (int e = 0; e < 4; ++e) if (4 * j4 + e < I) tv -= a[e] * T[4 * j4 + e]; }
    T[I] = tv;
}
template <int I> struct FSub { static __device__ __forceinline__ void run(float (&T)[64], const float* AL, int lane) { FSub<I - 1>::run(T, AL, lane); fsub_row<I>(T, AL, lane); } };
template <> struct FSub<-1> { static __device__ __forceinline__ void run(float (&)[64], const float*, int) {} };
struct GCArgs { const bf16* GK; const bf16* GQ; const bf16* GKT; const bf16* GVT; const float* GG2; const float* BETA2; bf16* WX; bf16* QX; bf16* QKX; bf16* KTX; float* U0F; float* GL; };
constexpr int GC_LDS_PER_WAVE = 17664;
__device__ __forceinline__ void gdn_chunk_unit(const GCArgs& A, unsigned char* wl, int unit, int lane) {
    const int bh = unit >> 6, n = unit & 63, t0 = 64 * n, fr = lane & 15, fq = lane >> 4;
    float* AL = (float*)wl; float* SC = (float*)(wl + 16384);
    {   const float g = A.GG2[(size_t)bh * 4096 + t0 + lane], beta = A.BETA2[(size_t)bh * 4096 + t0 + lane];
        float gc = g;
        gc = dpp_add<0x111, 0xf>(gc); gc = dpp_add<0x112, 0xf>(gc); gc = dpp_add<0x114, 0xf>(gc); gc = dpp_add<0x118, 0xf>(gc); gc = dpp_add<0x142, 0xa>(gc); gc = dpp_add<0x143, 0xc>(gc);
        const float glast = __builtin_bit_cast(float, __builtin_amdgcn_readlane(__builtin_bit_cast(int, gc), 63));
        const float eg = __expf(gc);
        SC[lane] = gc; SC[64 + lane] = beta; SC[128 + lane] = beta * eg; SC[192 + lane] = eg; SC[256 + lane] = __expf(glast - gc);
        if (lane == 0) A.GL[unit] = __expf(glast); }
    LDS_WAIT(); asm volatile("" ::: "memory");
    {
        bf16x8 kf[4][2];
#pragma unroll
        for (int t4 = 0; t4 < 4; ++t4)
#pragma unroll
            for (int ks = 0; ks < 2; ++ks) kf[t4][ks] = *(const bf16x8*)(A.GK + ((size_t)bh * 4096 + t0 + 16 * t4 + fr) * 64 + 32 * ks + 8 * fq);
#pragma unroll
        for (int ti = 0; ti < 4; ++ti) { const f32x4 gi = *(const f32x4*)(SC + 16 * ti + 4 * fq), bi = *(const f32x4*)(SC + 64 + 16 * ti + 4 * fq);
#pragma unroll
            for (int tj = 0; tj < 4; ++tj) if (tj <= ti) { f32x4 acc = {0.f, 0.f, 0.f, 0.f};
                acc = __builtin_amdgcn_mfma_f32_16x16x32_bf16(kf[ti][0], kf[tj][0], acc, 0, 0, 0); acc = __builtin_amdgcn_mfma_f32_16x16x32_bf16(kf[ti][1], kf[tj][1], acc, 0, 0, 0);
                const float gj = SC[16 * tj + fr];
#pragma unroll
                for (int i = 0; i < 4; ++i) AL[(16 * ti + 4 * fq + i) * 64 + 16 * tj + fr] = bi[i] * acc[i] * __expf(fminf(gi[i] - gj, 0.f)); } }
    }
    LDS_WAIT(); asm volatile("" ::: "memory");
    {
        float T[64];
        FSub<63>::run(T, AL, lane);
        LDS_WAIT(); asm volatile("" ::: "memory");
        unsigned short* TB = (unsigned short*)wl;
#pragma unroll
        for (int i = 0; i < 64; ++i) TB[i * 72 + lane] = (unsigned short)f2bf(T[i]);
    }
    LDS_WAIT(); asm volatile("" ::: "memory");
    {
        bf16x8 tf[4][2];
#pragma unroll
        for (int ti = 0; ti < 4; ++ti)
#pragma unroll
            for (int ks = 0; ks < 2; ++ks) tf[ti][ks] = *(const bf16x8*)(wl + ((16 * ti + fr) * 72 + 32 * ks + 8 * fq) * 2);
#pragma unroll
        for (int which = 0; which < 2; ++which) { const bf16* src = which ? A.GVT : A.GKT; const float* sc = SC + (which ? 64 : 128);
#pragma unroll
            for (int tn = 0; tn < 4; ++tn) { bf16x8 yb[2];
#pragma unroll
                for (int ks = 0; ks < 2; ++ks) { const bf16x8 raw = *(const bf16x8*)(src + ((size_t)bh * 64 + 16 * tn + fr) * 4096 + t0 + 32 * ks + 8 * fq);
                    const f32x4 s0 = *(const f32x4*)(sc + 32 * ks + 8 * fq), s1 = *(const f32x4*)(sc + 32 * ks + 8 * fq + 4);
                    yb[ks] = pack8(bf2f((unsigned short)raw[0]) * s0.x, bf2f((unsigned short)raw[1]) * s0.y, bf2f((unsigned short)raw[2]) * s0.z, bf2f((unsigned short)raw[3]) * s0.w,
                                   bf2f((unsigned short)raw[4]) * s1.x, bf2f((unsigned short)raw[5]) * s1.y, bf2f((unsigned short)raw[6]) * s1.z, bf2f((unsigned short)raw[7]) * s1.w); }
#pragma unroll
                for (int ti = 0; ti < 4; ++ti) { f32x4 acc = {0.f, 0.f, 0.f, 0.f};
                    acc = __builtin_amdgcn_mfma_f32_16x16x32_bf16(tf[ti][0], yb[0], acc, 0, 0, 0);
                    if (ti >= 2) acc = __builtin_amdgcn_mfma_f32_16x16x32_bf16(tf[ti][1], yb[1], acc, 0, 0, 0);
                    if (which == 0) { const int p = 32 * (tn >> 1) + 8 * (fr >> 2) + 4 * (tn & 1) + (fr & 3);
#pragma unroll
                        for (int i = 0; i < 4; ++i) A.WX[((size_t)unit * 64 + 16 * ti + 4 * fq + i) * 64 + p] = (bf16)f2bf(acc[i]); }
                    else *(f32x4*)(A.U0F + (((size_t)unit * 16 + ti * 4 + tn) * 64 + lane) * 4) = acc; } } }
    }
    {
        bf16x8 kf[4][2], qf[4][2];
#pragma unroll
        for (int t4 = 0; t4 < 4; ++t4)
#pragma unroll
            for (int ks = 0; ks < 2; ++ks) { kf[t4][ks] = *(const bf16x8*)(A.GK + ((size_t)bh * 4096 + t0 + 16 * t4 + fr) * 64 + 32 * ks + 8 * fq);
                qf[t4][ks] = *(const bf16x8*)(A.GQ + ((size_t)bh * 4096 + t0 + 16 * t4 + fr) * 64 + 32 * ks + 8 * fq); }
#pragma unroll
        for (int ti = 0; ti < 4; ++ti) { const f32x4 gi = *(const f32x4*)(SC + 16 * ti + 4 * fq);
#pragma unroll
            for (int tj = 0; tj < 4; ++tj) { f32x4 acc = {0.f, 0.f, 0.f, 0.f};
                if (tj <= ti) { acc = __builtin_amdgcn_mfma_f32_16x16x32_bf16(qf[ti][0], kf[tj][0], acc, 0, 0, 0); acc = __builtin_amdgcn_mfma_f32_16x16x32_bf16(qf[ti][1], kf[tj][1], acc, 0, 0, 0); }
                const float gj = SC[16 * tj + fr]; const int p = 32 * (tj >> 1) + 8 * (fr >> 2) + 4 * (tj & 1) + (fr & 3);
#pragma unroll
                for (int i = 0; i < 4; ++i) { const int ri = 16 * ti + 4 * fq + i, cj = 16 * tj + fr;
                    const float v = (tj <= ti && ri >= cj) ? acc[i] * __expf(fminf(gi[i] - gj, 0.f)) : 0.f;
                    A.QKX[((size_t)unit * 64 + ri) * 64 + p] = (bf16)f2bf(v); } } }
    }
    {
        const int lg = perm_inv32(lane);
        const float ek = SC[256 + lg];
#pragma unroll 16
        for (int r = 0; r < 64; ++r) {
            A.QX[((size_t)unit * 64 + r) * 64 + lane] = (bf16)f2bf(bf2f(A.GQ[((size_t)bh * 4096 + t0 + r) * 64 + lg]) * SC[192 + r]);
            A.KTX[((size_t)unit * 64 + r) * 64 + lane] = (bf16)f2bf(bf2f(A.GKT[((size_t)bh * 64 + r) * 4096 + t0 + lg]) * ek); }
    }
    LDS_WAIT(); asm volatile("" ::: "memory");
}
struct GS2Args { const bf16* WX; const bf16* QX; const bf16* QKX; const bf16* KTX; const float* U0F; const float* GL; float* OG; float* out; int l; };
__device__ __forceinline__ void gdn_scan2_wave(const GS2Args& A, int bh, int te, int lane) {
    const int fr = lane & 15, fq = lane >> 4, b = bh >> 3, h = bh & 7;
    f32x4 s[4]; bf16x8 sfr[2];
#pragma unroll
    for (int i = 0; i < 4; ++i) s[i] = (f32x4){0.f, 0.f, 0.f, 0.f};
    sfr[0] = (bf16x8){0, 0, 0, 0, 0, 0, 0, 0}; sfr[1] = sfr[0];
#pragma unroll 1
    for (int n = 0; n < 64; ++n) {
        const size_t unit = (size_t)bh * 64 + n;
        f32x4 u[4]; bf16x8 wf[4][2], kt[4][2];
#pragma unroll
        for (int tc = 0; tc < 4; ++tc) { u[tc] = *(const f32x4*)(A.U0F + ((unit * 16 + tc * 4 + te) * 64 + lane) * 4);
#pragma unroll
            for (int ks = 0; ks < 2; ++ks) { wf[tc][ks] = *(const bf16x8*)(A.WX + (unit * 64 + 16 * tc + fr) * 64 + 32 * ks + 8 * fq);
                kt[tc][ks] = *(const bf16x8*)(A.KTX + (unit * 64 + 16 * tc + fr) * 64 + 32 * ks + 8 * fq); } }
        const float dec = A.GL[unit];
#pragma unroll
        for (int tc = 0; tc < 4; ++tc) { f32x4 acc = {0.f, 0.f, 0.f, 0.f};
            acc = __builtin_amdgcn_mfma_f32_16x16x32_bf16(wf[tc][0], sfr[0], acc, 0, 0, 0); acc = __builtin_amdgcn_mfma_f32_16x16x32_bf16(wf[tc][1], sfr[1], acc, 0, 0, 0);
            u[tc] -= acc; }
        bf16x8 ufr[2];
#pragma unroll
        for (int ks = 0; ks < 2; ++ks) ufr[ks] = pack8(u[2 * ks][0], u[2 * ks][1], u[2 * ks][2], u[2 * ks][3], u[2 * ks + 1][0], u[2 * ks + 1][1], u[2 * ks + 1][2], u[2 * ks + 1][3]);
#pragma unroll
        for (int tc = 0; tc < 4; ++tc) {
            const bf16x8 q0 = *(const bf16x8*)(A.QX + (unit * 64 + 16 * tc + fr) * 64 + 8 * fq), q1 = *(const bf16x8*)(A.QX + (unit * 64 + 16 * tc + fr) * 64 + 32 + 8 * fq);
            const bf16x8 k0 = *(const bf16x8*)(A.QKX + (unit * 64 + 16 * tc + fr) * 64 + 8 * fq), k1 = *(const bf16x8*)(A.QKX + (unit * 64 + 16 * tc + fr) * 64 + 32 + 8 * fq);
            f32x4 acc = {0.f, 0.f, 0.f, 0.f};
            acc = __builtin_amdgcn_mfma_f32_16x16x32_bf16(q0, sfr[0], acc, 0, 0, 0); acc = __builtin_amdgcn_mfma_f32_16x16x32_bf16(q1, sfr[1], acc, 0, 0, 0);
            acc = __builtin_amdgcn_mfma_f32_16x16x32_bf16(k0, ufr[0], acc, 0, 0, 0); acc = __builtin_amdgcn_mfma_f32_16x16x32_bf16(k1, ufr[1], acc, 0, 0, 0);
#pragma unroll
            for (int i = 0; i < 4; ++i) A.OG[((size_t)b * SEQ + 64 * n + 16 * tc + 4 * fq + i) * 512 + h * 64 + 16 * te + fr] = acc[i]; }
#pragma unroll
        for (int td = 0; td < 4; ++td) { f32x4 acc = s[td] * dec;
            acc = __builtin_amdgcn_mfma_f32_16x16x32_bf16(kt[td][0], ufr[0], acc, 0, 0, 0); acc = __builtin_amdgcn_mfma_f32_16x16x32_bf16(kt[td][1], ufr[1], acc, 0, 0, 0);
            s[td] = acc; }
#pragma unroll
        for (int ks = 0; ks < 2; ++ks) sfr[ks] = pack8(s[2 * ks][0], s[2 * ks][1], s[2 * ks][2], s[2 * ks][3], s[2 * ks + 1][0], s[2 * ks + 1][1], s[2 * ks + 1][2], s[2 * ks + 1][3]);
    }
#pragma unroll
    for (int td = 0; td < 4; ++td)
#pragma unroll
        for (int i = 0; i < 4; ++i) A.out[O_GDNP + ((((size_t)A.l * NPB + b) * 8 + h) * 64 + 16 * td + 4 * fq + i) * 64 + 16 * te + fr] = s[td][i];
}

constexpr int L_CK = 0, L_CVT = 18432, L_IMP = 36864, L_MASK = 102400, L_UM = 102912, L_INV = 102928, L_K = 104448, L_VT = 113664;
struct AttArgs { const bf16* QB; const bf16* KS; const bf16* VS; const bf16* KW; const bf16* VW; const float* CKP; const float* CVP; const float* PROJ; bf16* MIX; };

template <int MODE>
__device__ __forceinline__ void attn_tiles(unsigned char* lds, const bf16* Kg, const bf16* Vg, int j_lo, int j_hi, unsigned long long umask, unsigned long long tmask,
                                           int qblk, int trel, const bf16x8 (&qr)[4], f32x16 (&o)[2], float& mrun, float& lrun, int tid, int r32, int hi) {
    for (int j = j_lo; j <= j_hi; ++j) {
        if (!((umask >> j) & 1ull)) continue;
        __syncthreads();
        { const int key = tid >> 3, ch = tid & 7;
          const v4u kvv = *(const v4u*)(Kg + (size_t)(64 * j + key) * 128 + ch * 8);
          *(v4u*)(lds + L_K + key * 144 + ch * 16) = kvv;
          const v4u vv = *(const v4u*)(Vg + (size_t)(64 * j + key) * 128 + ch * 8);
          unsigned short* vt = (unsigned short*)(lds + L_VT);
#pragma unroll
          for (int e2 = 0; e2 < 4; ++e2) { const unsigned w = vv[e2]; vt[(ch * 8 + 2 * e2) * 72 + key] = (unsigned short)(w & 0xffffu); vt[(ch * 8 + 2 * e2 + 1) * 72 + key] = (unsigned short)(w >> 16); } }
        __syncthreads();
        f32x16 p[2];
#pragma unroll
        for (int u = 0; u < 2; ++u) { f32x16 acc = {};
#pragma unroll
            for (int d0 = 0; d0 < 4; ++d0) { const bf16x8 kf = *(const bf16x8*)(lds + L_K + (32 * u + r32) * 144 + (16 * d0 + 8 * hi) * 2);
                acc = __builtin_amdgcn_mfma_f32_32x32x16_bf16(kf, qr[d0], acc, 0, 0, 0); }
            p[u] = acc; }
        const bool tsel = (MODE == 0) ? (((tmask >> j) & 1ull) != 0ull) : true;
#pragma unroll
        for (int u = 0; u < 2; ++u)
#pragma unroll
            for (int r = 0; r < 16; ++r) { const int kv = 32 * u + crow(r, hi); bool keep = tsel;
                if (j == qblk) keep = keep && (kv <= trel);
                if (MODE == 1) { if (j == qblk - 8) keep = keep && (kv >= trel); }
                if (!keep) p[u][r] = NEG_INF; }
        float rm = NEG_INF;
#pragma unroll
        for (int u = 0; u < 2; ++u)
#pragma unroll
            for (int r = 0; r < 16; ++r) rm = fmaxf(rm, p[u][r]);
        rm = fmaxf(rm, __shfl_xor(rm, 32));
        const float mn = fmaxf(mrun, rm), msafe = (mn == NEG_INF) ? 0.f : mn;
        const float alpha = ex2(mrun - msafe);
        float ls = 0.f;
#pragma unroll
        for (int u = 0; u < 2; ++u)
#pragma unroll
            for (int r = 0; r < 16; ++r) { const float e = ex2(p[u][r] - msafe); p[u][r] = e; ls += e; }
        lrun = lrun * alpha + ls; mrun = mn;
#pragma unroll
        for (int dh = 0; dh < 2; ++dh)
#pragma unroll
            for (int r = 0; r < 16; ++r) o[dh][r] *= alpha;
#pragma unroll
        for (int u = 0; u < 2; ++u)
#pragma unroll
            for (int s = 0; s < 2; ++s) {
                const bf16x8 pf = pack8(p[u][8 * s + 0], p[u][8 * s + 1], p[u][8 * s + 2], p[u][8 * s + 3], p[u][8 * s + 4], p[u][8 * s + 5], p[u][8 * s + 6], p[u][8 * s + 7]);
#pragma unroll
                for (int dh = 0; dh < 2; ++dh) { const unsigned char* vp = lds + L_VT + (r32 + 32 * dh) * 144 + (32 * u + 16 * s + 4 * hi) * 2;
                    const s16x4 lo = *(const s16x4*)vp, hi4 = *(const s16x4*)(vp + 16);
                    const bf16x8 vf = (bf16x8){lo[0], lo[1], lo[2], lo[3], hi4[0], hi4[1], hi4[2], hi4[3]};
                    o[dh] = __builtin_amdgcn_mfma_f32_32x32x16_bf16(vf, pf, o[dh], 0, 0, 0); }
            }
    }
}

__device__ __forceinline__ void nsa_prompt_unit(const AttArgs& A, unsigned char* lds, int unit, int tid) {
    const int lane = tid & 63, wave = tid >> 6, r32 = lane & 31, hi = lane >> 5, hh = wave & 3, ts = wave >> 2;
    const int qblk = 63 - (unit >> 3), b = (unit >> 1) & 3, kvh = unit & 1;
    const int head = kvh * 4 + hh, trel = 32 * ts + r32, t = 64 * qblk + trel; const size_t m = (size_t)b * SEQ + t;
    __syncthreads();
    const int nvmax = 2 * qblk + 2, ntile_c = (nvmax + 31) >> 5;
    { const int ch = tid & 7;
      for (int n = tid >> 3; n < 32 * ntile_c; n += 64) {
          const float* ckp = A.CKP + ((size_t)(b * 128 + n) * 2 + kvh) * 64 + ch * 8; const float* cvp = A.CVP + ((size_t)(b * 128 + n) * 2 + kvh) * 64 + ch * 8;
          const f32x4 k0 = *(const f32x4*)ckp, k1 = *(const f32x4*)(ckp + 4), v0 = *(const f32x4*)cvp, v1 = *(const f32x4*)(cvp + 4);
          *(bf16x8*)(lds + L_CK + n * 144 + ch * 16) = pack8(k0.x, k0.y, k0.z, k0.w, k1.x, k1.y, k1.z, k1.w);
          unsigned short* vt = (unsigned short*)(lds + L_CVT);
          vt[(ch * 8 + 0) * 136 + n] = (unsigned short)f2bf(v0.x); vt[(ch * 8 + 1) * 136 + n] = (unsigned short)f2bf(v0.y); vt[(ch * 8 + 2) * 136 + n] = (unsigned short)f2bf(v0.z); vt[(ch * 8 + 3) * 136 + n] = (unsigned short)f2bf(v0.w);
          vt[(ch * 8 + 4) * 136 + n] = (unsigned short)f2bf(v1.x); vt[(ch * 8 + 5) * 136 + n] = (unsigned short)f2bf(v1.y); vt[(ch * 8 + 6) * 136 + n] = (unsigned short)f2bf(v1.z); vt[(ch * 8 + 7) * 136 + n] = (unsigned short)f2bf(v1.w);
      }
      if (tid < 128) ((unsigned*)(lds + L_MASK))[tid] = 0u;
      if (tid < 2) ((unsigned*)(lds + L_UM))[tid] = 0u; }
    bf16x8 qr[4];
#pragma unroll
    for (int d0 = 0; d0 < 4; ++d0) qr[d0] = *(const bf16x8*)(A.QB + m * 512 + head * 64 + 16 * d0 + 8 * hi);
    __syncthreads();
    f32x16 tot[2];
    {
        const int nv = (t + 1) >> 5;
        float mx = NEG_INF;
#pragma unroll 1
        for (int tau = 0; tau < ntile_c; ++tau) {
            f32x16 acc = {};
#pragma unroll
            for (int d0 = 0; d0 < 4; ++d0) { const bf16x8 kf = *(const bf16x8*)(lds + L_CK + (32 * tau + r32) * 144 + (16 * d0 + 8 * hi) * 2);
                acc = __builtin_amdgcn_mfma_f32_32x32x16_bf16(kf, qr[d0], acc, 0, 0, 0); }
#pragma unroll
            for (int r = 0; r < 16; ++r) { const int n = 32 * tau + crow(r, hi); if (n < nv) mx = fmaxf(mx, acc[r]); }
        }
        mx = fmaxf(mx, __shfl_xor(mx, 32)); if (mx == NEG_INF) mx = 0.f;
        float sum = 0.f;
        f32x16 oc[2]; oc[0] = (f32x16){}; oc[1] = (f32x16){};
        float* imph = (float*)(lds + L_IMP) + (size_t)hh * 4096 + (32 * ts + r32) * 64;
#pragma unroll 1
        for (int tau = 0; tau < 4; ++tau) {
            f32x16 e = {};
            if (tau < ntile_c) {
                f32x16 acc = {};
#pragma unroll
                for (int d0 = 0; d0 < 4; ++d0) { const bf16x8 kf = *(const bf16x8*)(lds + L_CK + (32 * tau + r32) * 144 + (16 * d0 + 8 * hi) * 2);
                    acc = __builtin_amdgcn_mfma_f32_32x32x16_bf16(kf, qr[d0], acc, 0, 0, 0); }
#pragma unroll
                for (int r = 0; r < 16; ++r) { const int n = 32 * tau + crow(r, hi); e[r] = (n < nv) ? ex2(acc[r] - mx) : 0.f; sum += e[r]; }
#pragma unroll
                for (int s = 0; s < 2; ++s) {
                    const bf16x8 pf = pack8(e[8 * s + 0], e[8 * s + 1], e[8 * s + 2], e[8 * s + 3], e[8 * s + 4], e[8 * s + 5], e[8 * s + 6], e[8 * s + 7]);
#pragma unroll
                    for (int dh = 0; dh < 2; ++dh) { const unsigned char* vp = lds + L_CVT + (r32 + 32 * dh) * 272 + (32 * tau + 16 * s + 4 * hi) * 2;
                        const s16x4 lo = *(const s16x4*)vp, hi4 = *(const s16x4*)(vp + 16);
                        const bf16x8 vf = (bf16x8){lo[0], lo[1], lo[2], lo[3], hi4[0], hi4[1], hi4[2], hi4[3]};
                        oc[dh] = __builtin_amdgcn_mfma_f32_32x32x16_bf16(vf, pf, oc[dh], 0, 0, 0); }
                }
            }
#pragma unroll
            for (int a = 0; a < 4; ++a) { imph[16 * tau + 4 * a + 2 * hi + 0] = e[4 * a] + e[4 * a + 1]; imph[16 * tau + 4 * a + 2 * hi + 1] = e[4 * a + 2] + e[4 * a + 3]; }
        }
        sum += __shfl_xor(sum, 32);
        const float inv = 1.f / fmaxf(sum, 1e-30f);
        if (hi == 0) ((float*)(lds + L_INV))[hh * 64 + 32 * ts + r32] = inv;
        const float g0 = sigmoidf_(A.PROJ[m * NP + C_GATE + head * 3 + 0]) * inv;
#pragma unroll
        for (int dh = 0; dh < 2; ++dh)
#pragma unroll
            for (int r = 0; r < 16; ++r) tot[dh][r] = g0 * oc[dh][r];
    }
    __syncthreads();
    { float* ip = (float*)(lds + L_IMP); const float* iv = (const float*)(lds + L_INV);
#pragma unroll
      for (int i = 0; i < 8; ++i) { const int idx = tid + 512 * i, tk = idx >> 6;
          ip[idx] = (ip[idx] * iv[tk] + ip[4096 + idx] * iv[64 + tk]) + (ip[8192 + idx] * iv[128 + tk] + ip[12288 + idx] * iv[192 + tk]); } }
    __syncthreads();
    { const int tok = tid >> 3, jg = tid & 7; unsigned* mk = (unsigned*)(lds + L_MASK) + tok * 2;
      if (qblk <= 15) { if (jg == 0) { const unsigned long long am = (1ull << (qblk + 1)) - 1ull; mk[0] = (unsigned)am; mk[1] = (unsigned)(am >> 32); } }
      else {
          const float* iv = (const float*)(lds + L_IMP) + tok * 64; float vj[8]; int rk[8];
#pragma unroll
          for (int jj = 0; jj < 8; ++jj) { vj[jj] = iv[jg * 8 + jj]; rk[jj] = 0; }
          for (int i = 1; i <= qblk - 2; ++i) { const float vi = iv[i];
#pragma unroll
              for (int jj = 0; jj < 8; ++jj) { const int j = jg * 8 + jj; rk[jj] += (vi > vj[jj] || (vi == vj[jj] && i < j)) ? 1 : 0; } }
          unsigned bits = 0u;
#pragma unroll
          for (int jj = 0; jj < 8; ++jj) { const int j = jg * 8 + jj; const bool cand = (j >= 1 && j <= qblk - 2);
              if ((cand && rk[jj] < 13) || j == 0 || j == qblk || j == qblk - 1) bits |= 1u << ((jg & 3) * 8 + jj); }
          if (bits) atomicOr(mk + (jg >> 2), bits);
      } }
    __syncthreads();
    if (tid < 64) { const unsigned* mk = (const unsigned*)(lds + L_MASK) + tid * 2; atomicOr((unsigned*)(lds + L_UM), mk[0]); atomicOr((unsigned*)(lds + L_UM) + 1, mk[1]); }
    __syncthreads();
    unsigned long long tmask, umask;
    { const unsigned* mk = (const unsigned*)(lds + L_MASK) + trel * 2; tmask = (unsigned long long)mk[0] | ((unsigned long long)mk[1] << 32);
      const unsigned* um = (const unsigned*)(lds + L_UM); umask = (unsigned long long)um[0] | ((unsigned long long)um[1] << 32); }
    float* stash = (float*)(lds + L_IMP) + (size_t)wave * 2048 + lane;
#pragma unroll
    for (int dh = 0; dh < 2; ++dh)
#pragma unroll
        for (int r = 0; r < 16; ++r) stash[(dh * 16 + r) * 64] = tot[dh][r];
    {
        f32x16 o[2]; o[0] = (f32x16){}; o[1] = (f32x16){}; float mrun = NEG_INF, lrun = 0.f;
        attn_tiles<0>(lds, A.KS + (size_t)b * SEQ * 128 + kvh * 64, A.VS + (size_t)b * SEQ * 128 + kvh * 64, 0, qblk, umask, tmask, qblk, trel, qr, o, mrun, lrun, tid, r32, hi);
        lrun += __shfl_xor(lrun, 32);
        const float g1 = sigmoidf_(A.PROJ[m * NP + C_GATE + head * 3 + 1]) / fmaxf(lrun, 1e-30f);
#pragma unroll
        for (int dh = 0; dh < 2; ++dh)
#pragma unroll
            for (int r = 0; r < 16; ++r) stash[(dh * 16 + r) * 64] += g1 * o[dh][r];
    }
    {
        f32x16 o[2]; o[0] = (f32x16){}; o[1] = (f32x16){}; float mrun = NEG_INF, lrun = 0.f;
        const int jlo = qblk >= 8 ? qblk - 8 : 0;
        attn_tiles<1>(lds, A.KW + (size_t)b * SEQ * 128 + kvh * 64, A.VW + (size_t)b * SEQ * 128 + kvh * 64, jlo, qblk, ~0ull, ~0ull, qblk, trel, qr, o, mrun, lrun, tid, r32, hi);
        lrun += __shfl_xor(lrun, 32);
        const float g2 = sigmoidf_(A.PROJ[m * NP + C_GATE + head * 3 + 2]) / fmaxf(lrun, 1e-30f);
#pragma unroll
        for (int dh = 0; dh < 2; ++dh)
#pragma unroll
            for (int r = 0; r < 16; ++r) tot[dh][r] = stash[(dh * 16 + r) * 64] + g2 * o[dh][r];
    }
    bf16* mo = A.MIX + m * 1024 + 512 + head * 64;
#pragma unroll
    for (int dh = 0; dh < 2; ++dh)
#pragma unroll
        for (int a = 0; a < 4; ++a) { const int d0 = 32 * dh + 8 * a + 4 * hi;
            *(v2u*)(mo + d0) = (v2u){pk2(tot[dh][4 * a], tot[dh][4 * a + 1]), pk2(tot[dh][4 * a + 2], tot[dh][4 * a + 3])}; }
}

struct SAttArgs { const bf16* QB; const bf16* KS; const bf16* VS; const bf16* KW; const bf16* VW; const float* CKS; const float* CVS; const float* PROJ; const float* cache; const int* page_table; const float* state_win; bf16* MIX; int l; };
constexpr int SL_Q = 0, SL_S = 4096, SL_RM = 4096 + 16 * 65 * 4, SL_RS = SL_RM + 64, SL_IMP = SL_RS + 64, SL_MK = SL_IMP + 4 * 32 * 4;
__device__ __forceinline__ float dot64_f32(const float* q  , const float* k  ) {
    float acc = 0.f;
#pragma unroll
    for (int i = 0; i < 16; ++i) { const f32x4 kk = ((const f32x4*)k)[i]; const f32x4 qq = ((const f32x4*)q)[i]; acc += (kk.x * qq.x + kk.y * qq.y) + (kk.z * qq.z + kk.w * qq.w); }
    return acc;
}
__device__ __forceinline__ float dot64_bf16(const float* q  , const bf16* k  ) {
    float acc = 0.f;
#pragma unroll
    for (int i = 0; i < 8; ++i) { const v4u w = ((const v4u*)k)[i]; const f32x4 q0 = ((const f32x4*)q)[2 * i], q1 = ((const f32x4*)q)[2 * i + 1];
        acc += (bf2f((unsigned short)(w.x & 0xffffu)) * q0.x + bf2f((unsigned short)(w.x >> 16)) * q0.y) + (bf2f((unsigned short)(w.y & 0xffffu)) * q0.z + bf2f((unsigned short)(w.y >> 16)) * q0.w)
             + (bf2f((unsigned short)(w.z & 0xffffu)) * q1.x + bf2f((unsigned short)(w.z >> 16)) * q1.y) + (bf2f((unsigned short)(w.w & 0xffffu)) * q1.z + bf2f((unsigned short)(w.w >> 16)) * q1.w); }
    return acc;
}
__device__ __forceinline__ void sblock_acc(const float* Ss, int r0, int nkeys, const float* vf32, size_t vstride_f32, const bf16* vb16, size_t vstride_b16, float (&mr)[2], float (&lr)[2], float (&ov)[2]) {
    float mb0 = NEG_INF, mb1 = NEG_INF;
    if (nkeys == 64) {
#pragma unroll 16
        for (int k = 0; k < 64; ++k) { mb0 = fmaxf(mb0, Ss[r0 * 65 + k]); mb1 = fmaxf(mb1, Ss[(r0 + 1) * 65 + k]); }
    } else { for (int k = 0; k < nkeys; ++k) { mb0 = fmaxf(mb0, Ss[r0 * 65 + k]); mb1 = fmaxf(mb1, Ss[(r0 + 1) * 65 + k]); } }
    const float mn0 = fmaxf(mr[0], mb0), mn1 = fmaxf(mr[1], mb1), ms0 = (mn0 == NEG_INF) ? 0.f : mn0, ms1 = (mn1 == NEG_INF) ? 0.f : mn1;
    const float a0 = ex2(mr[0] - ms0), a1 = ex2(mr[1] - ms1);
    float l0 = lr[0] * a0, l1 = lr[1] * a1, o0 = ov[0] * a0, o1 = ov[1] * a1;
    if (nkeys == 64) {
#pragma unroll 1
        for (int k0 = 0; k0 < 64; k0 += 16) {
            float vv[16];
#pragma unroll
            for (int i = 0; i < 16; ++i) vv[i] = vf32[(size_t)(k0 + i) * vstride_f32];
#pragma unroll
            for (int i = 0; i < 16; ++i) { const float e0 = ex2(Ss[r0 * 65 + k0 + i] - ms0), e1 = ex2(Ss[(r0 + 1) * 65 + k0 + i] - ms1);
                l0 += e0; l1 += e1; o0 += e0 * vv[i]; o1 += e1 * vv[i]; }
        }
    } else {
        for (int k = 0; k < nkeys; ++k) {
            const float e0 = ex2(Ss[r0 * 65 + k] - ms0), e1 = ex2(Ss[(r0 + 1) * 65 + k] - ms1);
            const float v = bf2f(vb16[(size_t)k * vstride_b16]);
            l0 += e0; l1 += e1; o0 += e0 * v; o1 += e1 * v; }
    }
    mr[0] = mn0; mr[1] = mn1; lr[0] = l0; lr[1] = l1; ov[0] = o0; ov[1] = o1;
}
__device__ __forceinline__ void nsa_sample_unit(const SAttArgs& A, unsigned char* lds, int unit, int tid) {
    const int sb = unit >> 1, kvh = unit & 1, l = A.l;
    float* Qs = (float*)(lds + SL_Q); float* Ss = (float*)(lds + SL_S); float* RM = (float*)(lds + SL_RM); float* RS = (float*)(lds + SL_RS); float* IMP = (float*)(lds + SL_IMP); unsigned* MK = (unsigned*)(lds + SL_MK);
    const int srow = tid & 15, kA = tid >> 4;
    const int d = tid & 63, r0 = (tid >> 6) * 2;
    const int si = srow >> 2;
    __syncthreads();
    for (int e = tid; e < 1024; e += 512) { const int row = e >> 6, dd = e & 63, i = row >> 2, hh = row & 3;
        Qs[e] = bf2f(A.QB[((size_t)MP + sb * 4 + i) * 512 + (kvh * 4 + hh) * 64 + dd]); }
    if (tid < 8) MK[tid] = 0u;
    __syncthreads();
    const float* ckb = A.CKS + ((size_t)sb * 64 * 2 + kvh) * 64; const float* cvb = A.CVS + ((size_t)sb * 64 * 2 + kvh) * 64;
    Ss[srow * 65 + kA] = dot64_f32(Qs + srow * 64, ckb + (size_t)kA * 128); Ss[srow * 65 + kA + 32] = dot64_f32(Qs + srow * 64, ckb + (size_t)(kA + 32) * 128);
    __syncthreads();
    float tot[2];
    { float mr[2] = {NEG_INF, NEG_INF}, lr[2] = {0.f, 0.f}, ov[2] = {0.f, 0.f};
      sblock_acc(Ss, r0, 64, cvb + d, 128, nullptr, 0, mr, lr, ov);
      if (d == 0) { RM[r0] = mr[0]; RM[r0 + 1] = mr[1]; RS[r0] = lr[0]; RS[r0 + 1] = lr[1]; }
#pragma unroll
      for (int k = 0; k < 2; ++k) { const int row = r0 + k, i = row >> 2, hh = row & 3; const size_t m = (size_t)MP + sb * 4 + i;
          const float g0 = sigmoidf_(A.PROJ[m * NP + C_GATE + (kvh * 4 + hh) * 3 + 0]); tot[k] = g0 * ov[k] / fmaxf(lr[k], 1e-30f); } }
    __syncthreads();
    if (tid < 128) { const int i = tid >> 5, j = tid & 31; float s = 0.f;
#pragma unroll
        for (int hh = 0; hh < 4; ++hh) { const int row = i * 4 + hh; const float inv = 1.f / fmaxf(RS[row], 1e-30f);
            s += (ex2(Ss[row * 65 + 2 * j] - RM[row]) + ex2(Ss[row * 65 + 2 * j + 1] - RM[row])) * inv; }
        IMP[i * 32 + j] = s; }
    __syncthreads();
    if (tid < 128) { const int i = tid >> 5, j = tid & 31; bool sel = (j == 0 || j == 31);
        if (j >= 1 && j <= 30) { const float vj = IMP[i * 32 + j]; int rk = 0;
            for (int q = 1; q <= 30; ++q) { const float vi = IMP[i * 32 + q]; rk += (vi > vj || (vi == vj && q < j)) ? 1 : 0; }
            sel = rk < 13; }
        if (sel) { atomicOr(MK + i, 1u << j); atomicOr(MK + 4, 1u << j); } }
    __syncthreads();
    const unsigned um = MK[4];
    const unsigned tm_s = MK[si];
    float mr[2] = {NEG_INF, NEG_INF}, lr[2] = {0.f, 0.f}, ov[2] = {0.f, 0.f};
    for (int j = 0; j <= 32; ++j) {
        if (j < 32 && !((um >> j) & 1u)) continue;
        if (j < 32) {
            const int phys = A.page_table[sb * NPAGES + (j >> 1)];
            const float* base = A.cache + ((((size_t)l * NPOOL + phys) * 2 + kvh) * 128 + (j & 1) * 64) * 256;
            const bool ts = ((tm_s >> j) & 1u) != 0u;
            Ss[srow * 65 + kA] = ts ? dot64_f32(Qs + srow * 64, base + (size_t)kA * 256 + 128) : NEG_INF;
            Ss[srow * 65 + kA + 32] = ts ? dot64_f32(Qs + srow * 64, base + (size_t)(kA + 32) * 256 + 128) : NEG_INF;
            __syncthreads();
            sblock_acc(Ss, r0, 64, base + 192 + d, 256, nullptr, 0, mr, lr, ov);
        } else {
            if (kA < 4) Ss[srow * 65 + kA] = (kA <= si) ? dot64_bf16(Qs + srow * 64, A.KS + ((size_t)MP + sb * 4 + kA) * 128 + kvh * 64) : NEG_INF;
            __syncthreads();
            sblock_acc(Ss, r0, 4, nullptr, 0, A.VS + ((size_t)MP + sb * 4) * 128 + kvh * 64 + d, 128, mr, lr, ov);
        }
        __syncthreads();
    }
#pragma unroll
    for (int k = 0; k < 2; ++k) { const int row = r0 + k, i = row >> 2, hh = row & 3; const size_t m = (size_t)MP + sb * 4 + i;
        const float g1 = sigmoidf_(A.PROJ[m * NP + C_GATE + (kvh * 4 + hh) * 3 + 1]); tot[k] += g1 * ov[k] / fmaxf(lr[k], 1e-30f); }
    mr[0] = mr[1] = NEG_INF; lr[0] = lr[1] = 0.f; ov[0] = ov[1] = 0.f;
    const float* wb = A.state_win + ((size_t)l * NSB + sb) * 512 * 256 + kvh * 64;
    for (int jb = 0; jb < 9; ++jb) {
        if (jb < 8) {
#pragma unroll
            for (int hk = 0; hk < 2; ++hk) { const int key = kA + 32 * hk, r = 64 * jb + key;
                Ss[srow * 65 + key] = (r >= si) ? dot64_f32(Qs + srow * 64, wb + (size_t)r * 256) : NEG_INF; }
            __syncthreads();
            sblock_acc(Ss, r0, 64, wb + (size_t)(64 * jb) * 256 + 128 + d, 256, nullptr, 0, mr, lr, ov);
        } else {
            if (kA < 4) Ss[srow * 65 + kA] = (kA <= si) ? dot64_bf16(Qs + srow * 64, A.KW + ((size_t)MP + sb * 4 + kA) * 128 + kvh * 64) : NEG_INF;
            __syncthreads();
            sblock_acc(Ss, r0, 4, nullptr, 0, A.VW + ((size_t)MP + sb * 4) * 128 + kvh * 64 + d, 128, mr, lr, ov);
        }
        __syncthreads();
    }
#pragma unroll
    for (int k = 0; k < 2; ++k) { const int row = r0 + k, i = row >> 2, hh = row & 3; const size_t m = (size_t)MP + sb * 4 + i;
        const float g2 = sigmoidf_(A.PROJ[m * NP + C_GATE + (kvh * 4 + hh) * 3 + 2]); tot[k] += g2 * ov[k] / fmaxf(lr[k], 1e-30f);
        A.MIX[m * 1024 + 512 + (kvh * 4 + hh) * 64 + d] = (bf16)f2bf(tot[k]); }
}

struct Args { const void* in[22]; float* out; unsigned char* ws; int ph_lo, ph_hi; };
constexpr int PH_PER_LAYER = 10, N_PHASES = 1 + NL * PH_PER_LAYER;
__global__ void __launch_bounds__(NWAVES * 64, 2) hymba_fwd(Args args) {
    extern __shared__ __attribute__((aligned(16))) unsigned char lds[];
    const int G = gridDim.x, bx = blockIdx.x, NGW = G * NWAVES;
#define PHASE_IDS int tid = threadIdx.x; asm volatile("" : "+v"(tid)); const int lane = tid & 63, wave = __builtin_amdgcn_readfirstlane(tid >> 6), gw = bx * NWAVES + wave; (void)lane; (void)gw; unsigned char* wsl = args.ws; asm volatile("" : "+s"(wsl));
    float* out = args.out;
    const float* x_prompt = (const float*)args.in[0]; const float* x_sample = (const float*)args.in[1]; const float* cache_kv = (const float*)args.in[2];
    const int* page_table = (const int*)args.in[3]; const float* state_win = (const float*)args.in[4]; const float* state_gdn = (const float*)args.in[5];
    const float* state_conv = (const float*)args.in[6]; const float* norm_mix = (const float*)args.in[7]; const float* w_in = (const float*)args.in[8];
    const float* conv_w = (const float*)args.in[9]; const float* a_log = (const float*)args.in[10]; const float* dt_bias = (const float*)args.in[11];
    const float* gdn_norm = (const float*)args.in[12]; const float* cmp_pe_k = (const float*)args.in[13]; const float* cmp_w_k = (const float*)args.in[14];
    const float* cmp_pe_v = (const float*)args.in[15]; const float* cmp_w_v = (const float*)args.in[16]; const float* w_out = (const float*)args.in[17];
    const float* norm_mlp = (const float*)args.in[18]; const float* w_up = (const float*)args.in[19]; const float* w_down = (const float*)args.in[20]; const float* norm_final = (const float*)args.in[21];
#define WIN_T ((bf16*)(wsl + WS_WIN))
#define WOUT_T ((bf16*)(wsl + WS_WOUT))
#define WUP_T ((bf16*)(wsl + WS_WUP))
#define WDN_T ((bf16*)(wsl + WS_WDN))
#define CMPW ((bf16*)(wsl + WS_CMPW))
#define HB ((bf16*)(wsl + WS_HB))
#define PROJ ((float*)(wsl + WS_PROJ))
#define X1 ((float*)(wsl + WS_X1))
#define X2 ((float*)(wsl + WS_X2))
#define MIX ((bf16*)(wsl + WS_MIX))
#define HID ((bf16*)(wsl + WS_HID))
#define QN ((float*)(wsl + WS_QN))
#define KN ((float*)(wsl + WS_KN))
#define VG ((float*)(wsl + WS_VG))
#define OG ((float*)(wsl + WS_OG))
#define GG ((float*)(wsl + WS_G))
#define BETA ((float*)(wsl + WS_BETA))
#define KQ ((float*)(wsl + WS_KQ))
#define QB ((bf16*)(wsl + WS_QB))
#define KS ((bf16*)(wsl + WS_KS))
#define VS ((bf16*)(wsl + WS_VS))
#define KW ((bf16*)(wsl + WS_KW))
#define VW ((bf16*)(wsl + WS_VW))
#define CKP ((float*)(wsl + WS_CKP))
#define CVP ((float*)(wsl + WS_CVP))
#define CKS ((float*)(wsl + WS_CKS))
#define CVS ((float*)(wsl + WS_CVS))
#define GK ((bf16*)(wsl + WS_GK))
#define GQ ((bf16*)(wsl + WS_GQ))
#define GKT ((bf16*)(wsl + WS_GKT))
#define GVT ((bf16*)(wsl + WS_GVT))
#define GG2 ((float*)(wsl + WS_GG2))
#define BETA2 ((float*)(wsl + WS_BETA2))
#define WX ((bf16*)(wsl + WS_WX))
#define QX ((bf16*)(wsl + WS_QX))
#define QKX ((bf16*)(wsl + WS_QKX))
#define KTX ((bf16*)(wsl + WS_KTX))
#define U0F ((float*)(wsl + WS_U0F))
#define GL ((float*)(wsl + WS_GL))
    LAS unsigned char* ldsl = (LAS unsigned char*)lds;

    const int lo = args.ph_lo, hi = args.ph_hi;
    if (threadIdx.x < 16) ((LAS unsigned*)(ldsl + MISC_OFF))[threadIdx.x] = 0u;
    __syncthreads();
    XcdBarrier bar = xcd_barrier_post((unsigned*)(args.ws + WS_CTL) + CW_BAR, (volatile LAS unsigned*)(ldsl + MISC_OFF));
#define BOTH(k) (lo <= (k) && (k) + 1 < hi)
#define GRID_BAR(k) do { if (BOTH(k)) xcd_barrier(bar); } while (0)
#ifndef REP_PB
#define REP_PB 1
#endif
#ifndef REP_SCAN
#define REP_SCAN 1
#endif
#ifndef REP_ATTP
#define REP_ATTP 1
#endif
#ifndef REP_ATTS
#define REP_ATTS 1
#endif
#ifndef REP_GEMM
#define REP_GEMM 1
#endif
#define EN(i) (((PH_MASK_T) >> (i)) & 1u)
#define SUB(i) (((SUB_MASK_T) >> (i)) & 1u)
#define IN(k) (lo <= (k) && (k) < hi)

    if (IN(0)) { PHASE_IDS
        LAS float* scr = (LAS float*)(ldsl + wave * 16384);
        constexpr int I_IN = 16 * 112, I_OUT = 16 * 32, I_UP = 16 * 128, I_DN = 64 * 32, I_C = 32 * 2, I_L = I_IN + I_OUT + I_UP + I_DN + 2 * I_C;
        for (int it = gw; it < NL * I_L; it += NGW) {
            const int l = it / I_L; int r = it % I_L;
            if (r < I_IN) { transpose_item(w_in + (size_t)l * DM * NPROJ, DM, NPROJ, NP, WIN_T + (size_t)l * NP * DM, scr, r, lane); continue; } r -= I_IN;
            if (r < I_OUT) { transpose_item(w_out + (size_t)l * DM * DM, DM, DM, DM, WOUT_T + (size_t)l * DM * DM, scr, r, lane); continue; } r -= I_OUT;
            if (r < I_UP) { transpose_item(w_up + (size_t)l * DM * DFF, DM, DFF, DFF, WUP_T + (size_t)l * DFF * DM, scr, r, lane); continue; } r -= I_UP;
            if (r < I_DN) { transpose_item(w_down + (size_t)l * DFF * DM, DFF, DM, DM, WDN_T + (size_t)l * DM * DFF, scr, r, lane); continue; } r -= I_DN;
            if (r < I_C) { transpose_item(cmp_w_k + (size_t)l * 2048 * 64, 2048, 64, 64, CMPW + (size_t)((l * 2 + 0) * 64) * 2048, scr, r, lane); continue; } r -= I_C;
            transpose_item(cmp_w_v + (size_t)l * 2048 * 64, 2048, 64, 64, CMPW + (size_t)((l * 2 + 1) * 64) * 2048, scr, r, lane);
        }
        for (int m = gw; m < MT; m += NGW) { const float* xr = (m < MP) ? x_prompt + (size_t)m * DM : x_sample + (size_t)(m - MP) * DM; rms_row(xr, norm_mix, HB + (size_t)m * DM, nullptr, lane); }
    }

    GRID_BAR(0);
    for (int l = 0; l < NL; ++l) {
        const int pb = 1 + l * PH_PER_LAYER;
        if (IN(pb + 0)) { PHASE_IDS
            pg8::Gemm g{HB, WIN_T + (size_t)l * NP * DM, MT, NP, DM}; pg8::StaticOrder S; S.init(MT, NP, G, bx);
            pg8::EpiF32 E{PROJ, NP};
            pg8::gemm_phase<pg8::EpiF32, pg8::StaticOrder, true, true>(ldsl, g, S, E);
        }
        GRID_BAR(pb + 0);
        if (IN(pb + 1)) { PHASE_IDS
            { PBArgs A{PROJ, state_conv, conv_w, a_log, dt_bias, QN, KN, VG, GG, BETA, KQ, QB, KS, VS, KW, VW, out, l};
              for (int m = gw; m < MT; m += NGW) pb_row(A, m, lane); }
            { GPArgs A{PROJ, conv_w, a_log, dt_bias, GK, GQ, GKT, GVT, GG2, BETA2, l};
              for (int u = gw; u < (MP / 8) * 8; u += NGW) gdn_prep_unit(A, u, lane); }
            { CmpArgs A{PROJ, cache_kv, page_table, cmp_pe_k, cmp_pe_v, CMPW, wsl, l};
              for (int u = gw; u < 2176; u += NGW) compress_unit(A, u, lane); }
            { const f32x4* src = (const f32x4*)(state_win + (size_t)l * NSB * 512 * 256); f32x4* dst = (f32x4*)(out + O_WINS + (size_t)l * NSB * 512 * 256);
              for (int i = bx * 512 + tid; i < NSB * 508 * 64; i += G * 512) { const int sb = i / (508 * 64), rem = i % (508 * 64); dst[(size_t)sb * 512 * 64 + rem] = src[(size_t)sb * 512 * 64 + 256 + rem]; } }
        }
        GRID_BAR(pb + 1);
        if (IN(pb + 2)) { PHASE_IDS
            GCArgs A{GK, GQ, GKT, GVT, GG2, BETA2, WX, QX, QKX, KTX, U0F, GL};
            for (int u = gw; u < 32 * 64; u += NGW) gdn_chunk_unit(A, lds + wave * GC_LDS_PER_WAVE, u, lane);
        }
        GRID_BAR(pb + 2);
        if (IN(pb + 3)) {
            { PHASE_IDS GdnArgs GA{QN, KN, VG, GG, BETA, KQ, OG, PROJ, state_gdn, gdn_norm, MIX, out, l};
                for (int u = gw; u < NSB * 8; u += NGW) gdn_sample_unit(GA, u, lane); }
            { PHASE_IDS
                GS2Args SG{WX, QX, QKX, KTX, U0F, GL, OG, out, l};
                AttArgs AA{QB, KS, VS, KW, VW, CKP, CVP, PROJ, MIX};
                SAttArgs SA{QB, KS, VS, KW, VW, CKS, CVS, PROJ, cache_kv, page_table, state_win, MIX, l};
                unsigned* qhead = (unsigned*)(wsl + WS_CTL) + CW_QUEUE + 64 * l;
                volatile LAS int* slot = (volatile LAS int*)(ldsl + MISC_OFF + 32);
                for (;;) {
                    __syncthreads();
                    if (tid == 0) *slot = (int)__hip_atomic_fetch_add(qhead, 1u, __ATOMIC_RELAXED, __HIP_MEMORY_SCOPE_AGENT);
                    __syncthreads();
                    const int u = *slot;
                    if (u >= 16 + 512 + 256) break;
                    int tq = threadIdx.x; asm volatile("" : "+v"(tq));
                    if (u < 16) gdn_scan2_wave(SG, 2 * u + (__builtin_amdgcn_readfirstlane(tq >> 6) >> 2), __builtin_amdgcn_readfirstlane(tq >> 6) & 3, tq & 63);
                    else if (u < 16 + 512) nsa_prompt_unit(AA, lds, u - 16, tq);
                    else nsa_sample_unit(SA, lds, u - 528, tq);
                }
            }
        }
        GRID_BAR(pb + 3);
        if (IN(pb + 4)) { PHASE_IDS
            for (int it = gw; it < MP * 8; it += NGW) { const int m = it >> 3, h = it & 7;
                const float o = OG[(size_t)m * 512 + h * 64 + lane]; const float ms = wave_sum(o * o) * (1.f / 64.f);
                const float z = PROJ[(size_t)m * NP + C_Z + h * 64 + lane];
                MIX[(size_t)m * 1024 + h * 64 + lane] = (bf16)f2bf(o * (1.f / sqrtf(ms + 1e-6f)) * gdn_norm[l * 64 + lane] * siluf_(z)); }
        }
        GRID_BAR(pb + 4);
        if (IN(pb + 5)) { PHASE_IDS
            pg8::Gemm g{MIX, WOUT_T + (size_t)l * DM * DM, MT, DM, DM}; pg8::StaticOrder S; S.init(MT, DM, G, bx);
            pg8::EpiResid E{l == 0 ? x_prompt : (const float*)X2, l == 0 ? x_sample : (const float*)X2 + (size_t)MP * DM, MP, X1, DM};
            pg8::gemm_phase<pg8::EpiResid, pg8::StaticOrder, true, true>(ldsl, g, S, E);
        }
        GRID_BAR(pb + 5);
        if (IN(pb + 6)) { PHASE_IDS for (int m = gw; m < MT; m += NGW) rms_row(X1 + (size_t)m * DM, norm_mlp + (size_t)l * DM, HB + (size_t)m * DM, nullptr, lane); }
        GRID_BAR(pb + 6);
        if (IN(pb + 7)) { PHASE_IDS
            pg8::Gemm g{HB, WUP_T + (size_t)l * DFF * DM, MT, DFF, DM}; pg8::StaticOrder S; S.init(MT, DFF, G, bx);
            pg8::EpiRelu2 E{HID, DFF};
            pg8::gemm_phase<pg8::EpiRelu2, pg8::StaticOrder, true, true>(ldsl, g, S, E);
        }
        GRID_BAR(pb + 7);
        if (IN(pb + 8)) { PHASE_IDS
            pg8::Gemm g{HID, WDN_T + (size_t)l * DM * DFF, MT, DM, DFF}; pg8::StaticOrder S; S.init(MT, DM, G, bx);
            pg8::EpiResid E{X1, X1 + (size_t)MP * DM, MP, X2, DM};
            pg8::gemm_phase<pg8::EpiResid, pg8::StaticOrder, true, true>(ldsl, g, S, E);
        }
        GRID_BAR(pb + 8);
        if (IN(pb + 9)) { PHASE_IDS
            if (l + 1 < NL) { for (int m = gw; m < MT; m += NGW) rms_row(X2 + (size_t)m * DM, norm_mix + (size_t)(l + 1) * DM, HB + (size_t)m * DM, nullptr, lane); }
            else { for (int m = gw; m < MT; m += NGW) rms_row(X2 + (size_t)m * DM, norm_final, nullptr, out + O_YP + (size_t)m * DM, lane); }
        }
        GRID_BAR(pb + 9);
    }
#undef IN
}

#ifndef MK_PER_PHASE
#define MK_PER_PHASE 0
#endif
typedef void (*kfn_t)(Args); static const kfn_t K_ALL = hymba_fwd;
extern "C" void kernel_launch(void* const* d_in, const int* in_sizes, int n_in, void* d_out, int out_size, void* d_ws, size_t ws_size, hipStream_t stream) {
    static int grid = 0;
    if (grid == 0) {
        if (n_in != 22 || out_size != (int)O_END || ws_size < WS_END) { fprintf(stderr, "kernel_launch: unexpected shapes (n_in %d, out %d, ws %zu)\n", n_in, out_size, ws_size); grid = -1; return; }
        int dev = 0, cus = 0, per_cu = 0;
        if (hipGetDevice(&dev) != hipSuccess || hipDeviceGetAttribute(&cus, hipDeviceAttributeMultiprocessorCount, dev) != hipSuccess) { grid = -1; return; }
        if (hipFuncSetAttribute((const void*)K_ALL, hipFuncAttributeMaxDynamicSharedMemorySize, LDS_BYTES) != hipSuccess) { fprintf(stderr, "kernel_launch: hipFuncSetAttribute failed\n"); grid = -1; return; }
        if (hipOccupancyMaxActiveBlocksPerMultiprocessor(&per_cu, (const void*)K_ALL, NWAVES * 64, LDS_BYTES) != hipSuccess || per_cu < 1) { fprintf(stderr, "kernel_launch: occupancy query says %d blocks per CU\n", per_cu); }
        (void)hipGetLastError();
        grid = cus;
    }
    if (grid < 0) return;
    (void)hipMemsetAsync((char*)d_ws + WS_CTL, 0, CTL_ZERO_BYTES, stream);
    Args a{};
    for (int i = 0; i < 22; ++i) a.in[i] = d_in[i];
    a.out = (float*)d_out; a.ws = (unsigned char*)d_ws;
    const dim3 g(grid), b(NWAVES * 64);
#if MK_PER_PHASE
    for (int ph = 0; ph < N_PHASES; ++ph) { a.ph_lo = ph; a.ph_hi = ph + 1; K_ALL<<<g, b, LDS_BYTES, stream>>>(a); }
#else
    a.ph_lo = 0; a.ph_hi = N_PHASES; K_ALL<<<g, b, LDS_BYTES, stream>>>(a);
#endif
}
```

```cpp
#include <hip/hip_runtime.h>
#include <cstdio>
#include <cstdint>
namespace pg8 {
#define PG8_LAS __attribute__((address_space(3)))
typedef unsigned short bf16_t;
typedef short bf16x8 __attribute__((ext_vector_type(8)));
typedef float f32x4 __attribute__((ext_vector_type(4)));
typedef unsigned u32x4 __attribute__((ext_vector_type(4)));
constexpr int BM = 256, BK = 64, HALF = 128, HTB = HALF * BK * 2  , STAGE_BYTES = 8 * HTB, NXCD = 8, WGM = 8;

__host__ __device__ __forceinline__ int lds_byte(int r, int c) { const int st = (r >> 4) * 2 + (c >> 5), rr = r & 15, cc = c & 31, ob = rr * 64 + cc * 2; return st * 1024 + (ob ^ (((ob >> 9) & 1) << 5)); }
__host__ __device__ __forceinline__ void stage_rc(int b, int& R, int& C) { const int st = b / 1024, sb = b % 1024, swz = sb ^ (((sb >> 9) & 1) << 5); R = (st >> 1) * 16 + swz / 64; C = (st & 1) * 32 + (swz % 64) / 2; }
__host__ __device__ __forceinline__ int perm32(int rho) { const int n = rho >> 4, i = rho & 15; return 8 * (i >> 2) + 4 * n + (i & 3); }

struct Unit { int pm, pn; };
struct Gemm { const bf16_t* A; const bf16_t* Bt; int M, N, K; };

struct StaticOrder {
    int nM, nN, nwg, G, c;
    __host__ __device__ void init(int M, int N, int G_, int c_) { nM = M / BM; nN = N / BM; nwg = nM * nN; G = G_; c = c_; }
    __host__ __device__ bool next(int i, Unit& u) const {
        const long L = (long)i * G + c; if (L >= nwg) return false;
        int wgid = (int)L; { const int q = nwg / NXCD, r = nwg % NXCD, xcd = wgid % NXCD, off = wgid / NXCD; wgid = (xcd < r ? xcd * (q + 1) : r * (q + 1) + (xcd - r) * q) + off; }
        const int nig = WGM * nN, gid = wgid / nig, fm = gid * WGM, gsz = (nM - fm) < WGM ? (nM - fm) : WGM;
        u.pm = fm + ((wgid % nig) % gsz); u.pn = (wgid % nig) / gsz; return true;
    }
    __device__ __forceinline__ void a_ready(const Unit&) const {}
    __device__ __forceinline__ void done(const Unit&) const {}
};

__device__ __forceinline__ unsigned cvt_pk_bf16(float lo, float hi) { unsigned r; asm volatile("v_cvt_pk_bf16_f32 %0, %1, %2" : "=v"(r) : "v"(lo), "v"(hi)); return r; }

struct EpiF32 {
    static constexpr bool PERM = false, AFTER_DRAIN = false;
    float* O; int ldc;
    __device__ __forceinline__ void operator()(const f32x4 (&acc)[2][2][4][2], const Unit& u, int wr, int wc, int fr, int fq) const {
        const int row0 = u.pm * BM + wr * 64 + fr, col0 = u.pn * BM + wc * 32 + 4 * fq;
#pragma unroll
        for (int ai = 0; ai < 2; ++ai)
#pragma unroll
            for (int m = 0; m < 4; ++m) { float* rowp = O + (size_t)(row0 + ai * HALF + m * 16) * ldc + col0;
#pragma unroll
                for (int bj = 0; bj < 2; ++bj)
#pragma unroll
                    for (int n = 0; n < 2; ++n) *(f32x4*)(rowp + bj * HALF + n * 16) = acc[ai][bj][m][n]; }
    }
};
struct EpiResid {
    static constexpr bool PERM = false, AFTER_DRAIN = false;
    const float* base; const float* base2; int split_row; float* O; int ldc;
    __device__ __forceinline__ void operator()(const f32x4 (&acc)[2][2][4][2], const Unit& u, int wr, int wc, int fr, int fq) const {
        const int row0 = u.pm * BM + wr * 64 + fr, col0 = u.pn * BM + wc * 32 + 4 * fq;
        const float* bs = (u.pm * BM >= split_row) ? (base2 - (size_t)split_row * ldc) : base;
#pragma unroll
        for (int ai = 0; ai < 2; ++ai)
#pragma unroll
            for (int m = 0; m < 4; ++m) { const size_t off = (size_t)(row0 + ai * HALF + m * 16) * ldc + col0;
#pragma unroll
                for (int bj = 0; bj < 2; ++bj)
#pragma unroll
                    for (int n = 0; n < 2; ++n) { const f32x4 r = *(const f32x4*)(bs + off + bj * HALF + n * 16); *(f32x4*)(O + off + bj * HALF + n * 16) = r + acc[ai][bj][m][n]; } }
    }
};
struct EpiRelu2 {
    static constexpr bool PERM = true, AFTER_DRAIN = false;
    bf16_t* O; int ldc;
    __device__ __forceinline__ void operator()(const f32x4 (&acc)[2][2][4][2], const Unit& u, int wr, int wc, int fr, int fq) const {
        const int row0 = u.pm * BM + wr * 64 + fr, col0 = u.pn * BM + wc * 32 + 8 * fq;
#pragma unroll
        for (int ai = 0; ai < 2; ++ai)
#pragma unroll
            for (int m = 0; m < 4; ++m) { bf16_t* rowp = O + (size_t)(row0 + ai * HALF + m * 16) * ldc + col0;
#pragma unroll
                for (int bj = 0; bj < 2; ++bj) { f32x4 v0 = acc[ai][bj][m][0], v1 = acc[ai][bj][m][1];
#pragma unroll
                    for (int i = 0; i < 4; ++i) { const float a = v0[i] > 0.f ? v0[i] : 0.f, b = v1[i] > 0.f ? v1[i] : 0.f; v0[i] = a * a; v1[i] = b * b; }
                    u32x4 w; w.x = cvt_pk_bf16(v0[0], v0[1]); w.y = cvt_pk_bf16(v0[2], v0[3]); w.z = cvt_pk_bf16(v1[0], v1[1]); w.w = cvt_pk_bf16(v1[2], v1[3]);
                    *(u32x4*)(rowp + bj * HALF) = w; } }
    }
};
template <class Epi, class Sched, bool ALIGN_EPI = false, bool SP2 = false>
__device__ __forceinline__ void gemm_phase(PG8_LAS unsigned char* lds, const Gemm g, const Sched& S, const Epi& E) {
    int tid = threadIdx.x; asm volatile("" : "+v"(tid));
    const int wid = __builtin_amdgcn_readfirstlane(tid >> 6), lane = tid & 63, wr = wid >> 2, wc = wid & 3, fr = lane & 15, fq = lane >> 4;
    const int K = g.K, nt = K / BK;
    unsigned voffA[2], voffB[2];
#pragma unroll
    for (int i = 0; i < 2; ++i) { int R, C; stage_rc(tid * 16 + i * 8192, R, C); const int Rb = Epi::PERM ? ((R & ~31) + perm32(R & 31)) : R;
        voffA[i] = (unsigned)(R * K + C) * 2u; voffB[i] = (unsigned)(Rb * K + C) * 2u; }
    const size_t kstep = (size_t)(BK * 2);
    const size_t hstep = (size_t)HALF * K * 2;
    const size_t tstep = 2 * hstep;
    const unsigned ldsw = (unsigned)wid * 1024u;
    const int aoff = lds_byte(wr * 64 + fr, fq * 8), boff = lds_byte(wc * 32 + fr, fq * 8);
#define PG8_SA(b, h) (((b) * 2 + (h)) * HTB)
#define PG8_SB(b, h) ((4 + (b) * 2 + (h)) * HTB)
#define PG8_STAGE(bufoff, gbase, voff) do { _Pragma("unroll") for (int _i = 0; _i < 2; ++_i) \
        __builtin_amdgcn_global_load_lds((const unsigned*)((const char*)(gbase) + (voff)[_i]), (PG8_LAS unsigned*)(lds + (bufoff) + ldsw + _i * 8192), 16, 0, 0); } while (0)
#define PG8_LDA(dst, b, h) do { _Pragma("unroll") for (int m = 0; m < 4; ++m) _Pragma("unroll") for (int k = 0; k < 2; ++k) dst[m][k] = *(const PG8_LAS bf16x8*)(lds + PG8_SA(b, h) + aoff + m * 2048 + k * 1024); } while (0)
#define PG8_LDB(dst, b, h) do { _Pragma("unroll") for (int n = 0; n < 2; ++n) _Pragma("unroll") for (int k = 0; k < 2; ++k) dst[n][k] = *(const PG8_LAS bf16x8*)(lds + PG8_SB(b, h) + boff + n * 2048 + k * 1024); } while (0)
#define PG8_MMA(ai, bj, At, Bt) do { __builtin_amdgcn_s_setprio(1); _Pragma("unroll") for (int m = 0; m < 4; ++m) _Pragma("unroll") for (int n = 0; n < 2; ++n) _Pragma("unroll") for (int k = 0; k < 2; ++k) \
        acc[ai][bj][m][n] = __builtin_amdgcn_mfma_f32_16x16x32_bf16(Bt[n][k], At[m][k], acc[ai][bj][m][n], 0, 0, 0); __builtin_amdgcn_s_setprio(0); } while (0)
#define PG8_WAIT_V(n) asm volatile("s_waitcnt vmcnt(" #n ")" ::: "memory")
#define PG8_WAIT_L(n) asm volatile("s_waitcnt lgkmcnt(" #n ")" ::: "memory")
#define PG8_BAR __builtin_amdgcn_s_barrier()
#define PG8_SCHED __builtin_amdgcn_sched_barrier(0)
    Unit cur, nxt; int ui = 0;
    if (!S.next(0, cur)) return;
    f32x4 acc[2][2][4][2];
#pragma unroll
    for (int a = 0; a < 2; ++a)
#pragma unroll
        for (int b = 0; b < 2; ++b)
#pragma unroll
            for (int m = 0; m < 4; ++m)
#pragma unroll
                for (int n = 0; n < 2; ++n) acc[a][b][m][n] = (f32x4){0.f, 0.f, 0.f, 0.f};
    bf16x8 At[4][2], B0[2][2], B1[2][2];
    const char* cA = (const char*)g.A + (size_t)cur.pm * tstep; const char* cB = (const char*)g.Bt + (size_t)cur.pn * tstep;
    S.a_ready(cur);
    if constexpr (SP2) {
        PG8_STAGE(PG8_SB(0, 0), cB, voffB); PG8_STAGE(PG8_SB(0, 1), cB + hstep, voffB); PG8_STAGE(PG8_SA(0, 0), cA, voffA); PG8_STAGE(PG8_SA(0, 1), cA + hstep, voffA);
        if (wr == 1) PG8_BAR;
        PG8_WAIT_V(2); PG8_BAR;
        PG8_STAGE(PG8_SB(1, 0), cB + kstep, voffB); PG8_STAGE(PG8_SA(1, 0), cA + kstep, voffA); PG8_STAGE(PG8_SB(1, 1), cB + hstep + kstep, voffB);
        PG8_WAIT_V(6); PG8_BAR;
    } else {
        PG8_STAGE(PG8_SB(0, 0), cB, voffB); PG8_STAGE(PG8_SA(0, 0), cA, voffA); PG8_STAGE(PG8_SB(0, 1), cB + hstep, voffB); PG8_STAGE(PG8_SA(0, 1), cA + hstep, voffA);
        if (wr == 1) PG8_BAR;
        PG8_WAIT_V(4); PG8_BAR;
        PG8_STAGE(PG8_SB(1, 0), cB + kstep, voffB); PG8_STAGE(PG8_SA(1, 0), cA + kstep, voffA); PG8_STAGE(PG8_SB(1, 1), cB + hstep + kstep, voffB);
        PG8_WAIT_V(6); PG8_BAR;
    }
    for (;;) {
        const bool has_next = S.next(ui + 1, nxt);
        const char* nA = has_next ? (const char*)g.A + (size_t)nxt.pm * tstep : cA; const char* nB = has_next ? (const char*)g.Bt + (size_t)nxt.pn * tstep : cB;
        for (int t = 0; t < nt; t += 2) {
            const bool last = (t == nt - 2);
            const char* a1 = cA + (size_t)(t + 1) * kstep;
            const char* a2 = last ? nA : cA + (size_t)(t + 2) * kstep; const char* b2 = last ? nB : cB + (size_t)(t + 2) * kstep;
            const char* a3 = a2 + kstep; const char* b3 = b2 + kstep;
            if (last && has_next) S.a_ready(nxt);
            if constexpr (SP2) {
            PG8_LDB(B0, 0, 0); PG8_LDB(B1, 0, 1); PG8_SCHED; PG8_LDA(At, 0, 0); PG8_STAGE(PG8_SA(1, 1), a1 + hstep, voffA);
            PG8_WAIT_V(8); PG8_WAIT_L(0); PG8_BAR; PG8_MMA(0, 0, At, B0); PG8_MMA(0, 1, At, B1); PG8_BAR; PG8_SCHED;
            PG8_LDA(At, 0, 1); PG8_STAGE(PG8_SB(0, 0), b2, voffB); PG8_STAGE(PG8_SB(0, 1), b2 + hstep, voffB); PG8_STAGE(PG8_SA(0, 0), a2, voffA);
            PG8_WAIT_V(8); PG8_WAIT_L(0); PG8_BAR; PG8_MMA(1, 0, At, B0); PG8_MMA(1, 1, At, B1); PG8_BAR; PG8_SCHED;
            PG8_LDB(B0, 1, 0); PG8_LDB(B1, 1, 1); PG8_SCHED; PG8_LDA(At, 1, 0); PG8_STAGE(PG8_SA(0, 1), a2 + hstep, voffA);
            PG8_WAIT_V(8); PG8_WAIT_L(0); PG8_BAR; PG8_MMA(0, 0, At, B0); PG8_MMA(0, 1, At, B1); PG8_BAR; PG8_SCHED;
            PG8_LDA(At, 1, 1); PG8_STAGE(PG8_SB(1, 0), b3, voffB); PG8_STAGE(PG8_SB(1, 1), b3 + hstep, voffB); PG8_STAGE(PG8_SA(1, 0), a3, voffA);
            PG8_WAIT_V(8); PG8_WAIT_L(0); PG8_BAR; PG8_MMA(1, 0, At, B0); PG8_MMA(1, 1, At, B1); PG8_BAR; PG8_SCHED;
            } else {
            PG8_LDB(B0, 0, 0); PG8_SCHED; PG8_LDA(At, 0, 0); PG8_STAGE(PG8_SA(1, 1), a1 + hstep, voffA);
            PG8_WAIT_L(8); PG8_BAR; PG8_WAIT_L(0); PG8_MMA(0, 0, At, B0); PG8_BAR; PG8_SCHED;
            PG8_LDB(B1, 0, 1); PG8_STAGE(PG8_SB(0, 0), b2, voffB);
            PG8_BAR; PG8_WAIT_L(0); PG8_MMA(0, 1, At, B1); PG8_BAR;
            PG8_LDA(At, 0, 1); PG8_STAGE(PG8_SA(0, 0), a2, voffA);
            PG8_BAR; PG8_WAIT_L(0); PG8_MMA(1, 0, At, B0); PG8_BAR; PG8_SCHED;
            PG8_STAGE(PG8_SB(0, 1), b2 + hstep, voffB);
            PG8_WAIT_V(6); PG8_BAR; PG8_MMA(1, 1, At, B1); PG8_BAR;
            PG8_LDB(B0, 1, 0); PG8_SCHED; PG8_LDA(At, 1, 0); PG8_STAGE(PG8_SA(0, 1), a2 + hstep, voffA);
            PG8_WAIT_L(8); PG8_BAR; PG8_WAIT_L(0); PG8_MMA(0, 0, At, B0); PG8_BAR; PG8_SCHED;
            PG8_LDB(B1, 1, 1); PG8_STAGE(PG8_SB(1, 0), b3, voffB);
            PG8_BAR; PG8_WAIT_L(0); PG8_MMA(0, 1, At, B1); PG8_BAR;
            PG8_LDA(At, 1, 1); PG8_STAGE(PG8_SA(1, 0), a3, voffA);
            PG8_BAR; PG8_WAIT_L(0); PG8_MMA(1, 0, At, B0); PG8_BAR; PG8_SCHED;
            PG8_STAGE(PG8_SB(1, 1), b3 + hstep, voffB);
            PG8_WAIT_V(6); PG8_BAR; PG8_MMA(1, 1, At, B1); PG8_BAR;
            }
        }
        if constexpr (ALIGN_EPI) { if (wr == 0) PG8_BAR; }
        if constexpr (!Epi::AFTER_DRAIN) { E(acc, cur, wr, wc, fr, fq); S.done(cur); }
        if (!has_next) break;
#pragma unroll
        for (int a = 0; a < 2; ++a)
#pragma unroll
            for (int b = 0; b < 2; ++b)
#pragma unroll
                for (int m = 0; m < 4; ++m)
#pragma unroll
                    for (int n = 0; n < 2; ++n) acc[a][b][m][n] = (f32x4){0.f, 0.f, 0.f, 0.f};
        cur = nxt; cA = nA; cB = nB; ++ui;
        if constexpr (ALIGN_EPI) { if (wr == 1) PG8_BAR; }
    }
    PG8_WAIT_V(0);
    if constexpr (!ALIGN_EPI) { if (wr == 0) PG8_BAR; }
    PG8_BAR;
    if constexpr (Epi::AFTER_DRAIN) { E.fused(acc, cur, wr, wc, fr, fq, lds, wid, lane); S.done(cur); }
#undef PG8_SA
#undef PG8_SB
#undef PG8_STAGE
#undef PG8_LDA
#undef PG8_LDB
#undef PG8_MMA
#undef PG8_WAIT_V
#undef PG8_WAIT_L
#undef PG8_BAR
#undef PG8_SCHED
}
}

constexpr int DM = 1024, NPB = 4, SEQ = 4096, MP = NPB * SEQ, NSB = 128, DSEQ = 4, MS = NSB * DSEQ, MT = MP + MS;
constexpr int NPROJ = 3368, NP = 3584, DFF = 4096, NL = 2;
constexpr int C_QKV = 0, C_Z = 1536, C_A = 2048, C_BETA = 2056, C_Q = 2064, C_KV = 2576, C_GATE = 3344;
constexpr int PAST = 2048, NPAGES = 16, NPOOL = 2560;
constexpr float C2 = 0.125f * 1.4426950408889634f;
constexpr float NEG_INF = -__builtin_inff();
constexpr size_t O_YP = 0, O_YS = 16777216, O_KVP = 17301504, O_KVS = 34078720, O_WINP = 34603008, O_WINS = 35651584, O_GDNP = 69206016, O_GDNS = 69468160, O_CONVP = 77856768, O_CONVS = 77893632, O_END = 79073280;
constexpr size_t MiB = 1u << 20;
constexpr size_t WS_CTL = 0, CTL_ZERO_BYTES = 1 * MiB;
constexpr size_t WS_WIN = 2 * MiB, WS_WOUT = 16 * MiB, WS_WUP = 20 * MiB, WS_WDN = 36 * MiB, WS_CMPW = 52 * MiB;
constexpr size_t WS_HB = 54 * MiB, WS_PROJ = 88 * MiB, WS_X1 = 320 * MiB, WS_X2 = 386 * MiB, WS_MIX = 452 * MiB, WS_HID = 486 * MiB;
constexpr size_t WS_QN = 618 * MiB, WS_KN = 651 * MiB, WS_VG = 684 * MiB, WS_OG = 717 * MiB, WS_G = 750 * MiB, WS_BETA = 751 * MiB, WS_KQ = 752 * MiB;
constexpr size_t WS_QB = 753 * MiB, WS_KS = 770 * MiB, WS_VS = 775 * MiB, WS_KW = 780 * MiB, WS_VW = 785 * MiB;
constexpr size_t WS_CKP = 790 * MiB, WS_CVP = 791 * MiB, WS_CKS = 792 * MiB, WS_CVS = 796 * MiB;
constexpr size_t WS_GK = 800 * MiB, WS_GQ = 816 * MiB, WS_GKT = 832 * MiB, WS_GVT = 848 * MiB, WS_GG2 = 864 * MiB, WS_BETA2 = 865 * MiB;
constexpr size_t WS_WX = 866 * MiB, WS_QX = 882 * MiB, WS_QKX = 898 * MiB, WS_KTX = 914 * MiB, WS_U0F = 930 * MiB, WS_GL = 962 * MiB, WS_END = 963 * MiB;
constexpr int CW_QUEUE = 64;
constexpr int CW_BAR = 4096;
constexpr int RING_BYTES = 131072, LDS_BYTES = 147456, MISC_OFF = LDS_BYTES - 64;
constexpr int NWAVES = 8;

#define GAS __attribute__((address_space(1)))
#define LAS __attribute__((address_space(3)))
typedef unsigned short bf16;
typedef unsigned v4u __attribute__((ext_vector_type(4)));
typedef unsigned v2u __attribute__((ext_vector_type(2)));
typedef float f32x4 __attribute__((ext_vector_type(4)));
typedef float f32x16 __attribute__((ext_vector_type(16)));
typedef short bf16x8 __attribute__((ext_vector_type(8)));
typedef short s16x4 __attribute__((ext_vector_type(4)));
#define LDS_WAIT() asm volatile("s_waitcnt lgkmcnt(0)" ::: "memory")
__device__ __forceinline__ unsigned f2bf(float f) { unsigned u = __builtin_bit_cast(unsigned, f); return (u + 0x7fffu + ((u >> 16) & 1u)) >> 16; }
__device__ __forceinline__ unsigned pk2(float lo, float hi) { return f2bf(lo) | (f2bf(hi) << 16); }
__device__ __forceinline__ float bf2f(unsigned short b) { return __builtin_bit_cast(float, (unsigned)b << 16); }
__device__ __forceinline__ bf16x8 pack8(float a0, float a1, float a2, float a3, float a4, float a5, float a6, float a7) {
    v4u w; w.x = pk2(a0, a1); w.y = pk2(a2, a3); w.z = pk2(a4, a5); w.w = pk2(a6, a7); return __builtin_bit_cast(bf16x8, w); }
__device__ __forceinline__ float wave_sum(float v) {
#pragma unroll
    for (int o = 1; o < 64; o <<= 1) v += __shfl_xor(v, o);
    return v;
}
template <int CTRL, int RMASK> __device__ __forceinline__ float dpp_add(float v) {
    const int t = __builtin_amdgcn_update_dpp(0, __builtin_bit_cast(int, v), CTRL, RMASK, 0xf, false);
    return v + __builtin_bit_cast(float, t);
}
__device__ __forceinline__ float dpp_sum(float v) {
    v = dpp_add<0x111, 0xf>(v); v = dpp_add<0x112, 0xf>(v); v = dpp_add<0x114, 0xf>(v); v = dpp_add<0x118, 0xf>(v);
    v = dpp_add<0x142, 0xa>(v); v = dpp_add<0x143, 0xc>(v);
    return __builtin_bit_cast(float, __builtin_amdgcn_readlane(__builtin_bit_cast(int, v), 63));
}
__device__ __forceinline__ float ex2(float x) { return __builtin_amdgcn_exp2f(x); }
__device__ __forceinline__ float sigmoidf_(float x) { return 1.f / (1.f + __expf(-x)); }
__device__ __forceinline__ float siluf_(float x) { return x / (1.f + __expf(-x)); }
__device__ __forceinline__ int crow(int r, int hi) { return (r & 3) + 8 * (r >> 2) + 4 * hi; }
__device__ __forceinline__ void rope_cs(int pos, int d, float& cs, float& sn) {
    const float invf = exp2f(-(float)d * 0.4152410118609203f);
    double rv = (double)pos * (double)invf * 0.15915494309189535; rv -= floor(rv);
    const float rf = (float)rv; sn = __builtin_amdgcn_sinf(rf); cs = __builtin_amdgcn_cosf(rf);
}

#define XB_TMO      128
#define XB_XCNT(j)  (256  + 64 * (j))
#define XB_XSUB(j)  (1280 + 64 * (j))
#define XB_XGEN(j)  (2304 + 64 * (j))
#define XB_TOP      3328
#define XB_TOPGEN   3392
#define XCD_BAR_WORDS 3456
#define XB_SPIN_CAP (1u << 18)

__device__ __forceinline__ unsigned xb_ld(unsigned* p)              { return __hip_atomic_load(p, __ATOMIC_RELAXED, __HIP_MEMORY_SCOPE_AGENT); }
__device__ __forceinline__ unsigned xb_add(unsigned* p, unsigned v) { return __hip_atomic_fetch_add(p, v, __ATOMIC_RELAXED, __HIP_MEMORY_SCOPE_AGENT); }
__device__ __forceinline__ unsigned xb_xcc_id() { return (unsigned)__builtin_amdgcn_s_getreg((3 << 11) | 20) & 0xFu; }
#define XB_SPIN(cond, bar) do { unsigned _sp = 0; while (cond) { __builtin_amdgcn_s_sleep(1); \
    if ((++_sp & 255u) == 0u) { if (xb_ld(&(bar)[XB_TMO])) break; if (_sp > XB_SPIN_CAP) { atomicAdd(&(bar)[XB_TMO], 1u); break; } } } } while (0)

struct XcdBarrier {
    unsigned* bar; unsigned x;
    volatile LAS unsigned* st;
};

__device__ __forceinline__ XcdBarrier xcd_barrier_post(unsigned* bar, volatile LAS unsigned* st) {
    XcdBarrier b; b.bar = bar; b.x = xb_xcc_id(); b.st = st;
    if (threadIdx.x == 0) (void)xb_add(&bar[XB_XCNT(b.x)], 1u);
    return b;
}
__device__ __forceinline__ void xcd_barrier_complete(unsigned* bar, unsigned x, unsigned& nloc, unsigned& nx) {
    const unsigned G = gridDim.x * gridDim.y * gridDim.z;
    unsigned sum, cnt, mine, sp = 0u;
    for (;;) {
        sum = 0u; cnt = 0u; mine = 0u;
#pragma unroll
        for (unsigned j = 0; j < 16; ++j) { const unsigned c = xb_ld(&bar[XB_XCNT(j)]); sum += c; cnt += (c > 0u) ? 1u : 0u; mine = (j == x) ? c : mine; }
        if (sum == G) break;
        __builtin_amdgcn_s_sleep(1);
        if ((++sp & 255u) == 0u) { if (xb_ld(&bar[XB_TMO])) break; if (sp > XB_SPIN_CAP) { atomicAdd(&bar[XB_TMO], 1u); break; } }
    }
    nloc = mine > 0u ? mine : 1u; nx = cnt > 0u ? cnt : 1u;
}

__device__ __forceinline__ void xcd_barrier(const XcdBarrier& b) {
    asm volatile("s_waitcnt vmcnt(0)" ::: "memory");
    __syncthreads();
    if (threadIdx.x == 0) {
        unsigned* bar = b.bar;
        __builtin_amdgcn_s_waitcnt(0);
        unsigned nloc = b.st[0], nx = b.st[1];
        if (nloc == 0u) { xcd_barrier_complete(bar, b.x, nloc, nx); b.st[0] = nloc; b.st[1] = nx; }
        const unsigned old = xb_add(&bar[XB_XSUB(b.x)], 1u);
        const unsigned gen = old / nloc;
        if (old + 1u == (gen + 1u) * nloc) {
            __builtin_amdgcn_fence(__ATOMIC_RELEASE, "agent");
            asm volatile("s_waitcnt vmcnt(0)" ::: "memory");
            const unsigned og = xb_add(&bar[XB_TOP], 1u);
            const unsigned tg = og / nx;
            if (og + 1u == (tg + 1u) * nx) xb_add(&bar[XB_TOPGEN], 1u);
            else XB_SPIN(xb_ld(&bar[XB_TOPGEN]) == tg, bar);
            __builtin_amdgcn_fence(__ATOMIC_ACQUIRE, "agent");
            xb_add(&bar[XB_XGEN(b.x)], 1u);
            asm volatile("s_waitcnt vmcnt(0)" ::: "memory");
        } else {
            XB_SPIN(xb_ld(&bar[XB_XGEN(b.x)]) == gen, bar);
            __builtin_amdgcn_fence(__ATOMIC_ACQUIRE, "agent");
            asm volatile("s_waitcnt vmcnt(0)" ::: "memory");
        }
    }
    __syncthreads();
}

__device__ __forceinline__ void transpose_item(const float* W, int K, int N, int Npad, bf16* WT, LAS float* scr, int item, int lane) {
    const int nblk = Npad / 32, kb = item / nblk, nb = item % nblk, k0 = 64 * kb, n0 = 32 * nb;
    const int ncol = n0 + (lane & 31);
#pragma unroll 8
    for (int i = 0; i < 32; ++i) { const int kk = 2 * i + (lane >> 5); scr[kk * 33 + (lane & 31)] = (ncol < N) ? W[(size_t)(k0 + kk) * N + ncol] : 0.f; }
    LDS_WAIT(); asm volatile("" ::: "memory");
    const int c = lane & 7;
#pragma unroll
    for (int j = 0; j < 4; ++j) { const int n = (lane >> 3) + 8 * j; const LAS float* s = scr + (8 * c) * 33 + n;
        v4u o; o.x = pk2(s[0 * 33], s[1 * 33]); o.y = pk2(s[2 * 33], s[3 * 33]); o.z = pk2(s[4 * 33], s[5 * 33]); o.w = pk2(s[6 * 33], s[7 * 33]);
        *(v4u*)(WT + (size_t)(n0 + n) * K + k0 + 8 * c) = o; }
    LDS_WAIT(); asm volatile("" ::: "memory");
}
__device__ __forceinline__ void rms_row(const float* xrow, const float* g, bf16* orow, float* of32, int lane) {
    const f32x4* xr = (const f32x4*)xrow + lane;
    f32x4 v[4]; float s = 0.f;
#pragma unroll
    for (int j = 0; j < 4; ++j) { v[j] = xr[64 * j]; s += (v[j].x * v[j].x + v[j].y * v[j].y) + (v[j].z * v[j].z + v[j].w * v[j].w); }
    const float rstd = 1.f / sqrtf(wave_sum(s) * (1.f / DM) + 1e-6f);
#pragma unroll
    for (int j = 0; j < 4; ++j) { const f32x4 gg = ((const f32x4*)g)[64 * j + lane]; const f32x4 o = v[j] * rstd * gg;
        if (of32) ((f32x4*)of32)[64 * j + lane] = o;
        else ((v2u*)orow)[64 * j + lane] = (v2u){pk2(o.x, o.y), pk2(o.z, o.w)}; }
}

struct PBArgs { const float* PROJ; const float* state_conv; const float* conv_w; const float* a_log; const float* dt_bias;
    float* QN; float* KN; float* VG; float* G; float* BETA; float* KQ; bf16* QB; bf16* KS; bf16* VS; bf16* KW; bf16* VW; float* out; int l; };
__device__ __forceinline__ void pb_row(const PBArgs& A, int m, int lane) {
    const bool is_s = m >= MP; int b, t;
    if (!is_s) { b = m >> 12; t = m & 4095; } else { b = (m - MP) >> 2; t = (m - MP) & 3; }
    const int pos = is_s ? PAST + t : t, l = A.l;
    const float* pr = A.PROJ + (size_t)m * NP;
    const float* cw = A.conv_w + (size_t)l * 4 * 1536;
    const float* cb = A.state_conv + ((size_t)l * NSB + b) * 3 * 1536;
    if (is_s) {
#pragma unroll 4
    for (int h = 0; h < 8; ++h) {
        float qkv[3];
#pragma unroll
        for (int part = 0; part < 3; ++part) { const int c = (part * 8 + h) * 64 + lane; float acc = 0.f;
#pragma unroll
            for (int tap = 0; tap < 4; ++tap) { const int idx = t + tap;
                float xv;
                if (idx >= 3) xv = A.PROJ[(size_t)(m - t + idx - 3) * NP + c];
                else xv = is_s ? cb[idx * 1536 + c] : 0.f;
                acc += xv * cw[tap * 1536 + c]; }
            qkv[part] = siluf_(acc); }
        const float q = qkv[0], k = qkv[1];
        const float qs = dpp_sum(q * q), ks = dpp_sum(k * k);
        const float qn = q * (1.f / sqrtf(qs + 1e-6f)) * 0.125f, kn = k * (1.f / sqrtf(ks + 1e-6f));
        const float kq = dpp_sum(qn * kn);
        A.QN[(size_t)m * 512 + h * 64 + lane] = qn; A.KN[(size_t)m * 512 + h * 64 + lane] = kn; A.VG[(size_t)m * 512 + h * 64 + lane] = qkv[2];
        if (lane == 0) A.KQ[(size_t)m * 8 + h] = kq;
    }
    if (lane < 8) {
        const float a = pr[C_A + lane] + A.dt_bias[l * 8 + lane];
        const float sp = fmaxf(a, 0.f) + log1pf(__expf(-fabsf(a)));
        A.G[(size_t)m * 8 + lane] = -__expf(A.a_log[l * 8 + lane]) * sp;
        A.BETA[(size_t)m * 8 + lane] = sigmoidf_(pr[C_BETA + lane]); }
    }
    if (!is_s && t >= SEQ - 3) { float* o = A.out + O_CONVP + ((size_t)(l * NPB + b) * 3 + (t - (SEQ - 3))) * 1536;
#pragma unroll 4
        for (int j = 0; j < 24; ++j) o[64 * j + lane] = pr[64 * j + lane]; }
    if (is_s && t >= 1) { float* o = A.out + O_CONVS + ((size_t)(l * NSB + b) * 3 + (t - 1)) * 1536;
#pragma unroll 4
        for (int j = 0; j < 24; ++j) o[64 * j + lane] = pr[64 * j + lane]; }
    const int half = lane >> 5; float cs, sn; rope_cs(pos, lane & 31, cs, sn);
    float qs_[8], qo_[8], kvs_[12], kvo_[12];
#pragma unroll
    for (int h = 0; h < 8; ++h) { qs_[h] = pr[C_Q + h * 64 + lane]; qo_[h] = pr[C_Q + h * 64 + (lane ^ 32)]; }
#pragma unroll
    for (int i = 0; i < 12; ++i) { kvs_[i] = pr[C_KV + i * 64 + lane]; kvo_[i] = pr[C_KV + i * 64 + (lane ^ 32)]; }
    __builtin_amdgcn_sched_barrier(0);
#pragma unroll
    for (int h = 0; h < 8; ++h) { const float xs = qs_[h], xo = qo_[h];
        const float r = half ? (xs * cs + xo * sn) : (xs * cs - xo * sn);
        A.QB[(size_t)m * 512 + h * 64 + lane] = (bf16)f2bf(r * C2); }
#pragma unroll
    for (int s6 = 0; s6 < 6; ++s6)
#pragma unroll
        for (int kvh = 0; kvh < 2; ++kvh) {
            float v = kvs_[s6 * 2 + kvh];
            if (s6 == 2 || s6 == 4) { const float xo = kvo_[s6 * 2 + kvh]; v = half ? (v * cs + xo * sn) : (v * cs - xo * sn); }
            if (s6 < 4) {
                if (!is_s) A.out[O_KVP + ((((size_t)(l * NPB + b) * 2 + kvh) * SEQ + t) * 4 + s6) * 64 + lane] = v;
                else       A.out[O_KVS + ((((size_t)(l * NSB + b) * 2 + kvh) * DSEQ + t) * 4 + s6) * 64 + lane] = v;
            } else {
                const int idx = s6 - 4;
                if (!is_s) { if (t >= SEQ - 512) A.out[O_WINP + ((((size_t)(l * NPB + b) * 512 + (t - (SEQ - 512))) * 2 + idx) * 2 + kvh) * 64 + lane] = v; }
                else A.out[O_WINS + ((((size_t)(l * NSB + b) * 512 + (508 + t)) * 2 + idx) * 2 + kvh) * 64 + lane] = v;
            }
            const bf16 bv = (bf16)f2bf(v);
            if (s6 == 2) A.KS[(size_t)m * 128 + kvh * 64 + lane] = bv;
            if (s6 == 3) A.VS[(size_t)m * 128 + kvh * 64 + lane] = bv;
            if (s6 == 4) A.KW[(size_t)m * 128 + kvh * 64 + lane] = bv;
            if (s6 == 5) A.VW[(size_t)m * 128 + kvh * 64 + lane] = bv;
        }
}

struct CmpArgs { const float* PROJ; const float* cache; const int* page_table; const float* pe_k; const float* pe_v; const bf16* CMPW; unsigned char* ws; int l; };
__device__ __forceinline__ void compress_unit(const CmpArgs& A, int u, int lane) {
    const int fr = lane & 15, fq = lane >> 4, l = A.l;
    const int kv = u & 1, uu = u >> 1; const bool is_s = uu >= 64; const int ru = is_s ? uu - 64 : uu;
    const int rho = 16 * ru + fr, NC = is_s ? 64 : 128;
    const int seq = rho / (2 * NC), n = (rho >> 1) % NC, kvh = rho & 1;
    const float* abase; size_t astride;
    if (!is_s) { abase = A.PROJ + (size_t)(seq * SEQ + 32 * n) * NP + C_KV + kv * 128 + kvh * 64; astride = NP; }
    else { const int page = A.page_table[seq * NPAGES + (n >> 2)];
        abase = A.cache + ((((size_t)l * NPOOL + page) * 2 + kvh) * 128 + (n & 3) * 32) * 256 + kv * 64; astride = 256; }
    const float* pe = (kv ? A.pe_v : A.pe_k) + (size_t)l * 2048;
    const bf16* Wt = A.CMPW + (size_t)((l * 2 + kv) * 64) * 2048;
    f32x4 acc[4];
#pragma unroll
    for (int et = 0; et < 4; ++et) acc[et] = (f32x4){0.f, 0.f, 0.f, 0.f};
    f32x4 sa[2][4], sp[2][4]; bf16x8 sw[2][8];
#define CMP_LOAD(S, c) do { _Pragma("unroll") for (int ks = 0; ks < 2; ++ks) { const float* ap = abase + (size_t)(c) * astride + 32 * ks + 8 * fq; const float* pp = pe + (c) * 64 + 32 * ks + 8 * fq; \
        sa[S][2 * ks] = *(const f32x4*)ap; sa[S][2 * ks + 1] = *(const f32x4*)(ap + 4); sp[S][2 * ks] = *(const f32x4*)pp; sp[S][2 * ks + 1] = *(const f32x4*)(pp + 4); \
        _Pragma("unroll") for (int et = 0; et < 4; ++et) sw[S][ks * 4 + et] = *(const bf16x8*)(Wt + (size_t)(16 * et + fr) * 2048 + (c) * 64 + 32 * ks + 8 * fq); } } while (0)
#define CMP_MMA(S) do { _Pragma("unroll") for (int ks = 0; ks < 2; ++ks) { const f32x4 a0 = sa[S][2 * ks] + sp[S][2 * ks], a1 = sa[S][2 * ks + 1] + sp[S][2 * ks + 1]; \
        const bf16x8 ya = pack8(a0.x, a0.y, a0.z, a0.w, a1.x, a1.y, a1.z, a1.w); \
        _Pragma("unroll") for (int et = 0; et < 4; ++et) acc[et] = __builtin_amdgcn_mfma_f32_16x16x32_bf16(sw[S][ks * 4 + et], ya, acc[et], 0, 0, 0); } } while (0)
    CMP_LOAD(0, 0);
#pragma unroll 1
    for (int c = 0; c < 32; c += 2) {
        CMP_LOAD(1, c + 1); __builtin_amdgcn_sched_barrier(0);
        CMP_MMA(0); __builtin_amdgcn_sched_barrier(0);
        if (c + 2 < 32) { CMP_LOAD(0, c + 2); } __builtin_amdgcn_sched_barrier(0);
        CMP_MMA(1); __builtin_amdgcn_sched_barrier(0);
    }
#undef CMP_LOAD
#undef CMP_MMA
    if (kv == 0) { const int pos = 32 * n + 31;
#pragma unroll
        for (int et = 0; et < 2; ++et)
#pragma unroll
            for (int i = 0; i < 4; ++i) { float cs, sn; rope_cs(pos, 16 * et + 4 * fq + i, cs, sn);
                const float x1 = acc[et][i], x2 = acc[et + 2][i]; acc[et][i] = x1 * cs - x2 * sn; acc[et + 2][i] = x2 * cs + x1 * sn; } }
    float* ob = (float*)(A.ws + (is_s ? WS_CKS : WS_CKP) + (size_t)kv * (is_s ? (WS_CVS - WS_CKS) : (WS_CVP - WS_CKP))) + (size_t)rho * 64 + 4 * fq;
#pragma unroll
    for (int et = 0; et < 4; ++et) *(f32x4*)(ob + 16 * et) = acc[et];
}

struct GdnArgs { const float* QN; const float* KN; const float* VG; const float* G; const float* BETA; const float* KQ; float* OG; const float* PROJ; const float* state_gdn; const float* gdn_norm; bf16* MIX; float* out; int l; };
__device__ __forceinline__ void gdn_sample_unit(const GdnArgs& A, int unit, int lane) {
    const int sb = unit >> 3, h = unit & 7, l = A.l;
    const float* sp = A.state_gdn + (((size_t)l * NSB + sb) * 8 + h) * 4096;
    float S[64];
#pragma unroll
    for (int d = 0; d < 64; ++d) S[d] = sp[d * 64 + lane];
    const float gn = A.gdn_norm[l * 64 + lane];
    for (int i = 0; i < DSEQ; ++i) {
        const size_t m = (size_t)MP + sb * 4 + i;
        const float kd = A.KN[m * 512 + h * 64 + lane], qd = A.QN[m * 512 + h * 64 + lane], v = A.VG[m * 512 + h * 64 + lane];
        const float g = A.G[m * 8 + h], beta = A.BETA[m * 8 + h], kq = A.KQ[m * 8 + h];
        const int kdb = __builtin_bit_cast(int, kd), qdb = __builtin_bit_cast(int, qd);
        const float a = __expf(g); float r1 = 0.f, r2 = 0.f;
#pragma unroll
        for (int d = 0; d < 64; ++d) { const float kk = __builtin_bit_cast(float, __builtin_amdgcn_readlane(kdb, d)), qq = __builtin_bit_cast(float, __builtin_amdgcn_readlane(qdb, d)); r1 += S[d] * kk; r2 += S[d] * qq; }
        const float u = beta * (v - a * r1), o = a * r2 + u * kq;
#pragma unroll
        for (int d = 0; d < 64; ++d) { const float kk = __builtin_bit_cast(float, __builtin_amdgcn_readlane(kdb, d)); S[d] = a * S[d] + kk * u; }
        const float ms = wave_sum(o * o) * (1.f / 64.f);
        const float z = A.PROJ[m * NP + C_Z + h * 64 + lane];
        A.MIX[m * 1024 + h * 64 + lane] = (bf16)f2bf(o * (1.f / sqrtf(ms + 1e-6f)) * gn * siluf_(z));
    }
    float* so = A.out + O_GDNS + (((size_t)l * NSB + sb) * 8 + h) * 4096;
#pragma unroll
    for (int d = 0; d < 64; ++d) so[d * 64 + lane] = S[d];
}


__device__ __forceinline__ int perm_inv32(int p) { return (p & 32) + 16 * ((p >> 2) & 1) + 4 * ((p >> 3) & 3) + (p & 3); }
struct GPArgs { const float* PROJ; const float* conv_w; const float* a_log; const float* dt_bias; bf16* GK; bf16* GQ; bf16* GKT; bf16* GVT; float* GG2; float* BETA2; int l; };
__device__ __forceinline__ void gdn_prep_unit(const GPArgs& A, int unit, int lane) {
    const int tg = unit >> 3, h = unit & 7, m0 = tg * 8, b = m0 >> 12, t0 = m0 & 4095, l = A.l, bh = b * 8 + h;
    const float* cw = A.conv_w + (size_t)l * 4 * 1536;
    float val[3][8], xx[3][11], ww[3][4];
#pragma unroll
    for (int part = 0; part < 3; ++part) { const int c = (part * 8 + h) * 64 + lane;
#pragma unroll
        for (int j = 0; j < 11; ++j) xx[part][j] = (t0 - 3 + j >= 0) ? A.PROJ[(size_t)(m0 - 3 + j) * NP + c] : 0.f;
#pragma unroll
        for (int k = 0; k < 4; ++k) ww[part][k] = cw[k * 1536 + c]; }
    __builtin_amdgcn_sched_barrier(0);
#pragma unroll
    for (int part = 0; part < 3; ++part)
#pragma unroll
        for (int i = 0; i < 8; ++i) val[part][i] = siluf_(ww[part][0] * xx[part][i] + ww[part][1] * xx[part][i + 1] + ww[part][2] * xx[part][i + 2] + ww[part][3] * xx[part][i + 3]);
#pragma unroll
    for (int i = 0; i < 8; ++i) { const float q = val[0][i], k = val[1][i];
        const float qs = dpp_sum(q * q), ks = dpp_sum(k * k);
        val[0][i] = q * (1.f / sqrtf(qs + 1e-6f)) * 0.125f; val[1][i] = k * (1.f / sqrtf(ks + 1e-6f)); }
#pragma unroll
    for (int i = 0; i < 8; ++i) { A.GQ[((size_t)bh * 4096 + t0 + i) * 64 + lane] = (bf16)f2bf(val[0][i]); A.GK[((size_t)bh * 4096 + t0 + i) * 64 + lane] = (bf16)f2bf(val[1][i]); }
    *(v4u*)(A.GKT + ((size_t)bh * 64 + lane) * 4096 + t0) = (v4u){pk2(val[1][0], val[1][1]), pk2(val[1][2], val[1][3]), pk2(val[1][4], val[1][5]), pk2(val[1][6], val[1][7])};
    *(v4u*)(A.GVT + ((size_t)bh * 64 + lane) * 4096 + t0) = (v4u){pk2(val[2][0], val[2][1]), pk2(val[2][2], val[2][3]), pk2(val[2][4], val[2][5]), pk2(val[2][6], val[2][7])};
    if (lane < 8) { const float* pr = A.PROJ + (size_t)(m0 + lane) * NP;
        const float a = pr[C_A + h] + A.dt_bias[l * 8 + h];
        const float sp = fmaxf(a, 0.f) + log1pf(__expf(-fabsf(a)));
        A.GG2[(size_t)bh * 4096 + t0 + lane] = -__expf(A.a_log[l * 8 + h]) * sp;
        A.BETA2[(size_t)bh * 4096 + t0 + lane] = sigmoidf_(pr[C_BETA + h]); }
}
template <int I> __device__ __forceinline__ void fsub_row(float (&T)[64], const float* AL, int lane) {
    float tv = (lane == I) ? 1.f : 0.f;
#pragma unroll
    for (int j4 = 0; j4 < (I + 3) / 4; ++j4) { const f32x4 a = *(const f32x4*)(AL + I * 64 + 4 * j4);
#pragma unroll
        for (int e = 0; e < 4; ++e) if (4 * j4 + e < I) tv -= a[e] * T[4 * j4 + e]; }
    T[I] = tv;
}
template <int I> struct FSub { static __device__ __forceinline__ void run(float (&T)[64], const float* AL, int lane) { FSub<I - 1>::run(T, AL, lane); fsub_row<I>(T, AL, lane); } };
template <> struct FSub<-1> { static __device__ __forceinline__ void run(float (&)[64], const float*, int) {} };
struct GCArgs { const bf16* GK; const bf16* GQ; const bf16* GKT; const bf16* GVT; const float* GG2; const float* BETA2; bf16* WX; bf16* QX; bf16* QKX; bf16* KTX; float* U0F; float* GL; };
constexpr int GC_LDS_PER_WAVE = 17664;
__device__ __forceinline__ void gdn_chunk_unit(const GCArgs& A, unsigned char* wl, int unit, int lane_) {
    int lane = lane_; asm volatile("" : "+v"(lane));
    const int bh = unit >> 6, n = unit & 63, t0 = 64 * n, fr = lane & 15, fq = lane >> 4;
    float* AL = (float*)wl; float* SC = (float*)(wl + 16384);
    {   const float g = A.GG2[(size_t)bh * 4096 + t0 + lane], beta = A.BETA2[(size_t)bh * 4096 + t0 + lane];
        float gc = g;
        gc = dpp_add<0x111, 0xf>(gc); gc = dpp_add<0x112, 0xf>(gc); gc = dpp_add<0x114, 0xf>(gc); gc = dpp_add<0x118, 0xf>(gc); gc = dpp_add<0x142, 0xa>(gc); gc = dpp_add<0x143, 0xc>(gc);
        const float glast = __builtin_bit_cast(float, __builtin_amdgcn_readlane(__builtin_bit_cast(int, gc), 63));
        const float eg = __expf(gc);
        SC[lane] = gc; SC[64 + lane] = beta; SC[128 + lane] = beta * eg; SC[192 + lane] = eg; SC[256 + lane] = __expf(glast - gc);
        if (lane == 0) A.GL[unit] = __expf(glast); }
    LDS_WAIT(); asm volatile("" ::: "memory");
    {
        bf16x8 kf[4][2];
#pragma unroll
        for (int t4 = 0; t4 < 4; ++t4)
#pragma unroll
            for (int ks = 0; ks < 2; ++ks) kf[t4][ks] = *(const bf16x8*)(A.GK + ((size_t)bh * 4096 + t0 + 16 * t4 + fr) * 64 + 32 * ks + 8 * fq);
        __builtin_amdgcn_sched_barrier(0);
#pragma unroll
        for (int ti = 0; ti < 4; ++ti) { const f32x4 gi = *(const f32x4*)(SC + 16 * ti + 4 * fq), bi = *(const f32x4*)(SC + 64 + 16 * ti + 4 * fq);
#pragma unroll
            for (int tj = 0; tj < 4; ++tj) if (tj <= ti) { f32x4 acc = {0.f, 0.f, 0.f, 0.f};
                acc = __builtin_amdgcn_mfma_f32_16x16x32_bf16(kf[ti][0], kf[tj][0], acc, 0, 0, 0); acc = __builtin_amdgcn_mfma_f32_16x16x32_bf16(kf[ti][1], kf[tj][1], acc, 0, 0, 0);
                const float gj = SC[16 * tj + fr];
#pragma unroll
                for (int i = 0; i < 4; ++i) AL[(16 * ti + 4 * fq + i) * 64 + 16 * tj + fr] = bi[i] * acc[i] * __expf(fminf(gi[i] - gj, 0.f)); } }
    }
    LDS_WAIT(); asm volatile("" ::: "memory");
    {
        float T[64];
        FSub<63>::run(T, AL, lane);
        LDS_WAIT(); asm volatile("" ::: "memory");
        unsigned short* TB = (unsigned short*)wl;
#pragma unroll
        for (int i = 0; i < 64; ++i) TB[i * 72 + lane] = (unsigned short)f2bf(T[i]);
    }
    LDS_WAIT(); asm volatile("" ::: "memory");
    {
        bf16x8 tf[4][2];
#pragma unroll
        for (int ti = 0; ti < 4; ++ti)
#pragma unroll
            for (int ks = 0; ks < 2; ++ks) tf[ti][ks] = *(const bf16x8*)(wl + ((16 * ti + fr) * 72 + 32 * ks + 8 * fq) * 2);
#pragma unroll
        for (int which = 0; which < 2; ++which) { const bf16* src = which ? A.GVT : A.GKT; const float* sc = SC + (which ? 64 : 128);
            bf16x8 raws[4][2];
#pragma unroll
            for (int tn = 0; tn < 4; ++tn)
#pragma unroll
                for (int ks = 0; ks < 2; ++ks) raws[tn][ks] = *(const bf16x8*)(src + ((size_t)bh * 64 + 16 * tn + fr) * 4096 + t0 + 32 * ks + 8 * fq);
            __builtin_amdgcn_sched_barrier(0);
#pragma unroll
            for (int tn = 0; tn < 4; ++tn) { bf16x8 yb[2];
#pragma unroll
                for (int ks = 0; ks < 2; ++ks) { const bf16x8 raw = raws[tn][ks];
                    const f32x4 s0 = *(const f32x4*)(sc + 32 * ks + 8 * fq), s1 = *(const f32x4*)(sc + 32 * ks + 8 * fq + 4);
                    yb[ks] = pack8(bf2f((unsigned short)raw[0]) * s0.x, bf2f((unsigned short)raw[1]) * s0.y, bf2f((unsigned short)raw[2]) * s0.z, bf2f((unsigned short)raw[3]) * s0.w,
                                   bf2f((unsigned short)raw[4]) * s1.x, bf2f((unsigned short)raw[5]) * s1.y, bf2f((unsigned short)raw[6]) * s1.z, bf2f((unsigned short)raw[7]) * s1.w); }
#pragma unroll
                for (int ti = 0; ti < 4; ++ti) { f32x4 acc = {0.f, 0.f, 0.f, 0.f};
                    acc = __builtin_amdgcn_mfma_f32_16x16x32_bf16(tf[ti][0], yb[0], acc, 0, 0, 0);
                    if (ti >= 2) acc = __builtin_amdgcn_mfma_f32_16x16x32_bf16(tf[ti][1], yb[1], acc, 0, 0, 0);
                    if (which == 0) { const int p = 32 * (tn >> 1) + 8 * (fr >> 2) + 4 * (tn & 1) + (fr & 3);
#pragma unroll
                        for (int i = 0; i < 4; ++i) A.WX[((size_t)unit * 64 + 16 * ti + 4 * fq + i) * 64 + p] = (bf16)f2bf(acc[i]); }
                    else *(f32x4*)(A.U0F + (((size_t)unit * 16 + ti * 4 + tn) * 64 + lane) * 4) = acc; } } }
    }
    {
        bf16x8 kf[4][2], qf[4][2];
#pragma unroll
        for (int t4 = 0; t4 < 4; ++t4)
#pragma unroll
            for (int ks = 0; ks < 2; ++ks) { kf[t4][ks] = *(const bf16x8*)(A.GK + ((size_t)bh * 4096 + t0 + 16 * t4 + fr) * 64 + 32 * ks + 8 * fq);
                qf[t4][ks] = *(const bf16x8*)(A.GQ + ((size_t)bh * 4096 + t0 + 16 * t4 + fr) * 64 + 32 * ks + 8 * fq); }
        __builtin_amdgcn_sched_barrier(0);
#pragma unroll
        for (int ti = 0; ti < 4; ++ti) { const f32x4 gi = *(const f32x4*)(SC + 16 * ti + 4 * fq);
#pragma unroll
            for (int tj = 0; tj < 4; ++tj) { f32x4 acc = {0.f, 0.f, 0.f, 0.f};
                if (tj <= ti) { acc = __builtin_amdgcn_mfma_f32_16x16x32_bf16(qf[ti][0], kf[tj][0], acc, 0, 0, 0); acc = __builtin_amdgcn_mfma_f32_16x16x32_bf16(qf[ti][1], kf[tj][1], acc, 0, 0, 0); }
                const float gj = SC[16 * tj + fr]; const int p = 32 * (tj >> 1) + 8 * (fr >> 2) + 4 * (tj & 1) + (fr & 3);
#pragma unroll
                for (int i = 0; i < 4; ++i) { const int ri = 16 * ti + 4 * fq + i, cj = 16 * tj + fr;
                    const float v = (tj <= ti && ri >= cj) ? acc[i] * __expf(fminf(gi[i] - gj, 0.f)) : 0.f;
                    A.QKX[((size_t)unit * 64 + ri) * 64 + p] = (bf16)f2bf(v); } } }
    }
    {
        const int lg = perm_inv32(lane);
        const float ek = SC[256 + lg];
#pragma unroll 1
        for (int r0 = 0; r0 < 64; r0 += 16) { bf16 qv[16], kv[16];
#pragma unroll
            for (int i = 0; i < 16; ++i) { qv[i] = A.GQ[((size_t)bh * 4096 + t0 + r0 + i) * 64 + lg]; kv[i] = A.GKT[((size_t)bh * 64 + r0 + i) * 4096 + t0 + lg]; }
            __builtin_amdgcn_sched_barrier(0);
#pragma unroll
            for (int i = 0; i < 16; ++i) { A.QX[((size_t)unit * 64 + r0 + i) * 64 + lane] = (bf16)f2bf(bf2f(qv[i]) * SC[192 + r0 + i]);
                A.KTX[((size_t)unit * 64 + r0 + i) * 64 + lane] = (bf16)f2bf(bf2f(kv[i]) * ek); } }
    }
    LDS_WAIT(); asm volatile("" ::: "memory");
}
struct GS2Args { const bf16* WX; const bf16* QX; const bf16* QKX; const bf16* KTX; const float* U0F; const float* GL; float* OG; float* out; int l; };
__device__ __forceinline__ void gdn_scan2_wave(const GS2Args& A, int bh, int te, int lane) {
    const int fr = lane & 15, fq = lane >> 4, b = bh >> 3, h = bh & 7;
    f32x4 s[4]; bf16x8 sfr[2];
#pragma unroll
    for (int i = 0; i < 4; ++i) s[i] = (f32x4){0.f, 0.f, 0.f, 0.f};
    sfr[0] = (bf16x8){0, 0, 0, 0, 0, 0, 0, 0}; sfr[1] = sfr[0];
    f32x4 u[4]; bf16x8 wf[4][2], kt[4][2], qx[4][2], qkx[4][2]; float dec;
#define GS_LD_UW(nn) do { const size_t un_ = (size_t)bh * 64 + (nn); _Pragma("unroll") for (int tc = 0; tc < 4; ++tc) { u[tc] = *(const f32x4*)(A.U0F + ((un_ * 16 + tc * 4 + te) * 64 + lane) * 4); \
        _Pragma("unroll") for (int ks = 0; ks < 2; ++ks) wf[tc][ks] = *(const bf16x8*)(A.WX + (un_ * 64 + 16 * tc + fr) * 64 + 32 * ks + 8 * fq); } } while (0)
#define GS_LD_Q(nn) do { const size_t un_ = (size_t)bh * 64 + (nn); _Pragma("unroll") for (int tc = 0; tc < 4; ++tc) _Pragma("unroll") for (int ks = 0; ks < 2; ++ks) { \
        qx[tc][ks] = *(const bf16x8*)(A.QX + (un_ * 64 + 16 * tc + fr) * 64 + 32 * ks + 8 * fq); qkx[tc][ks] = *(const bf16x8*)(A.QKX + (un_ * 64 + 16 * tc + fr) * 64 + 32 * ks + 8 * fq); } } while (0)
#define GS_LD_K(nn) do { const size_t un_ = (size_t)bh * 64 + (nn); dec = A.GL[un_]; _Pragma("unroll") for (int tc = 0; tc < 4; ++tc) _Pragma("unroll") for (int ks = 0; ks < 2; ++ks) \
        kt[tc][ks] = *(const bf16x8*)(A.KTX + (un_ * 64 + 16 * tc + fr) * 64 + 32 * ks + 8 * fq); } while (0)
    GS_LD_UW(0); GS_LD_Q(0); GS_LD_K(0);
    __builtin_amdgcn_sched_barrier(0);
#pragma unroll 1
    for (int n = 0; n < 64; ++n) {
        const int nn = n < 63 ? n + 1 : 63;
#pragma unroll
        for (int tc = 0; tc < 4; ++tc) { f32x4 acc = {0.f, 0.f, 0.f, 0.f};
            acc = __builtin_amdgcn_mfma_f32_16x16x32_bf16(wf[tc][0], sfr[0], acc, 0, 0, 0); acc = __builtin_amdgcn_mfma_f32_16x16x32_bf16(wf[tc][1], sfr[1], acc, 0, 0, 0);
            u[tc] -= acc; }
        bf16x8 ufr[2];
#pragma unroll
        for (int ks = 0; ks < 2; ++ks) ufr[ks] = pack8(u[2 * ks][0], u[2 * ks][1], u[2 * ks][2], u[2 * ks][3], u[2 * ks + 1][0], u[2 * ks + 1][1], u[2 * ks + 1][2], u[2 * ks + 1][3]);
        __builtin_amdgcn_sched_barrier(0);
        GS_LD_UW(nn);
        __builtin_amdgcn_sched_barrier(0);
        f32x4 oacc[4];
#pragma unroll
        for (int tc = 0; tc < 4; ++tc) {
            f32x4 acc = {0.f, 0.f, 0.f, 0.f};
            acc = __builtin_amdgcn_mfma_f32_16x16x32_bf16(qx[tc][0], sfr[0], acc, 0, 0, 0); acc = __builtin_amdgcn_mfma_f32_16x16x32_bf16(qx[tc][1], sfr[1], acc, 0, 0, 0);
            acc = __builtin_amdgcn_mfma_f32_16x16x32_bf16(qkx[tc][0], ufr[0], acc, 0, 0, 0); acc = __builtin_amdgcn_mfma_f32_16x16x32_bf16(qkx[tc][1], ufr[1], acc, 0, 0, 0);
            oacc[tc] = acc; }
#pragma unroll
        for (int td = 0; td < 4; ++td) { f32x4 acc = s[td] * dec;
            acc = __builtin_amdgcn_mfma_f32_16x16x32_bf16(kt[td][0], ufr[0], acc, 0, 0, 0); acc = __builtin_amdgcn_mfma_f32_16x16x32_bf16(kt[td][1], ufr[1], acc, 0, 0, 0);
            s[td] = acc; }
#pragma unroll
        for (int ks = 0; ks < 2; ++ks) sfr[ks] = pack8(s[2 * ks][0], s[2 * ks][1], s[2 * ks][2], s[2 * ks][3], s[2 * ks + 1][0], s[2 * ks + 1][1], s[2 * ks + 1][2], s[2 * ks + 1][3]);
        __builtin_amdgcn_sched_barrier(0);
        GS_LD_Q(nn); GS_LD_K(nn);
#pragma unroll
        for (int tc = 0; tc < 4; ++tc)
#pragma unroll
            for (int i = 0; i < 4; ++i) A.OG[((size_t)b * SEQ + 64 * n + 16 * tc + 4 * fq + i) * 512 + h * 64 + 16 * te + fr] = oacc[tc][i];
        __builtin_amdgcn_sched_barrier(0);
    }
#undef GS_LD_UW
#undef GS_LD_Q
#undef GS_LD_K
#pragma unroll
    for (int td = 0; td < 4; ++td)
#pragma unroll
        for (int i = 0; i < 4; ++i) A.out[O_GDNP + ((((size_t)A.l * NPB + b) * 8 + h) * 64 + 16 * td + 4 * fq + i) * 64 + 16 * te + fr] = s[td][i];
}

constexpr int L_CK = 0, L_CVT = 18432, L_IMP = 36864, L_MASK = 102400, L_UM = 102912, L_INV = 102928, L_K = 104448, L_VT = 113664;
struct AttArgs { const bf16* QB; const bf16* KS; const bf16* VS; const bf16* KW; const bf16* VW; const float* CKP; const float* CVP; const float* PROJ; bf16* MIX; };

template <int MODE>
__device__ __forceinline__ void attn_tiles(unsigned char* lds, const bf16* Kg, const bf16* Vg, int j_lo, int j_hi, unsigned long long umask, unsigned long long tmask,
                                           int qblk, int trel, const bf16x8 (&qr)[4], f32x16 (&o)[2], float& mrun, float& lrun, int tid, int r32, int hi) {
    int j = j_lo; while (j <= j_hi && !((umask >> j) & 1ull)) ++j;
    const int key = tid >> 3, ch = tid & 7;
    v4u kvv = {0u, 0u, 0u, 0u}, vv = {0u, 0u, 0u, 0u};
    if (j <= j_hi) { kvv = *(const v4u*)(Kg + (size_t)(64 * j + key) * 128 + ch * 8); vv = *(const v4u*)(Vg + (size_t)(64 * j + key) * 128 + ch * 8); }
    while (j <= j_hi) {
        __syncthreads();
        { *(v4u*)(lds + L_K + key * 144 + ch * 16) = kvv;
          unsigned short* vt = (unsigned short*)(lds + L_VT);
#pragma unroll
          for (int e2 = 0; e2 < 4; ++e2) { const unsigned w = vv[e2]; vt[(ch * 8 + 2 * e2) * 72 + key] = (unsigned short)(w & 0xffffu); vt[(ch * 8 + 2 * e2 + 1) * 72 + key] = (unsigned short)(w >> 16); } }
        __syncthreads();
        int jn = j + 1; while (jn <= j_hi && !((umask >> jn) & 1ull)) ++jn;
        if (jn <= j_hi) { kvv = *(const v4u*)(Kg + (size_t)(64 * jn + key) * 128 + ch * 8); vv = *(const v4u*)(Vg + (size_t)(64 * jn + key) * 128 + ch * 8); }
        __builtin_amdgcn_sched_barrier(0);
        f32x16 p[2];
#pragma unroll
        for (int u = 0; u < 2; ++u) { f32x16 acc = {};
#pragma unroll
            for (int d0 = 0; d0 < 4; ++d0) { const bf16x8 kf = *(const bf16x8*)(lds + L_K + (32 * u + r32) * 144 + (16 * d0 + 8 * hi) * 2);
                acc = __builtin_amdgcn_mfma_f32_32x32x16_bf16(kf, qr[d0], acc, 0, 0, 0); }
            p[u] = acc; }
        const bool tsel = (MODE == 0) ? (((tmask >> j) & 1ull) != 0ull) : true;
#pragma unroll
        for (int u = 0; u < 2; ++u)
#pragma unroll
            for (int r = 0; r < 16; ++r) { const int kv = 32 * u + crow(r, hi); bool keep = tsel;
                if (j == qblk) keep = keep && (kv <= trel);
                if (MODE == 1) { if (j == qblk - 8) keep = keep && (kv >= trel); }
                if (!keep) p[u][r] = NEG_INF; }
        float rm = NEG_INF;
#pragma unroll
        for (int u = 0; u < 2; ++u)
#pragma unroll
            for (int r = 0; r < 16; ++r) rm = fmaxf(rm, p[u][r]);
        rm = fmaxf(rm, __shfl_xor(rm, 32));
        const float mn = fmaxf(mrun, rm), msafe = (mn == NEG_INF) ? 0.f : mn;
        const float alpha = ex2(mrun - msafe);
        float ls = 0.f;
#pragma unroll
        for (int u = 0; u < 2; ++u)
#pragma unroll
            for (int r = 0; r < 16; ++r) { const float e = ex2(p[u][r] - msafe); p[u][r] = e; ls += e; }
        lrun = lrun * alpha + ls; mrun = mn;
#pragma unroll
        for (int dh = 0; dh < 2; ++dh)
#pragma unroll
            for (int r = 0; r < 16; ++r) o[dh][r] *= alpha;
#pragma unroll
        for (int u = 0; u < 2; ++u)
#pragma unroll
            for (int s = 0; s < 2; ++s) {
                const bf16x8 pf = pack8(p[u][8 * s + 0], p[u][8 * s + 1], p[u][8 * s + 2], p[u][8 * s + 3], p[u][8 * s + 4], p[u][8 * s + 5], p[u][8 * s + 6], p[u][8 * s + 7]);
#pragma unroll
                for (int dh = 0; dh < 2; ++dh) { const unsigned char* vp = lds + L_VT + (r32 + 32 * dh) * 144 + (32 * u + 16 * s + 4 * hi) * 2;
                    const s16x4 lo = *(const s16x4*)vp, hi4 = *(const s16x4*)(vp + 16);
                    const bf16x8 vf = (bf16x8){lo[0], lo[1], lo[2], lo[3], hi4[0], hi4[1], hi4[2], hi4[3]};
                    o[dh] = __builtin_amdgcn_mfma_f32_32x32x16_bf16(vf, pf, o[dh], 0, 0, 0); }
            }
        j = jn;
    }
}

__device__ __forceinline__ void nsa_prompt_unit(const AttArgs& A, unsigned char* lds, int unit, int tid) {
    const int lane = tid & 63, wave = tid >> 6, r32 = lane & 31, hi = lane >> 5, hh = wave & 3, ts = wave >> 2;
    const int qblk = 63 - (unit >> 3), b = (unit >> 1) & 3, kvh = unit & 1;
    const int head = kvh * 4 + hh, trel = 32 * ts + r32, t = 64 * qblk + trel; const size_t m = (size_t)b * SEQ + t;
    __syncthreads();
    const int nvmax = 2 * qblk + 2, ntile_c = (nvmax + 31) >> 5;
    { const int ch = tid & 7;
      for (int n = tid >> 3; n < 32 * ntile_c; n += 64) {
          const float* ckp = A.CKP + ((size_t)(b * 128 + n) * 2 + kvh) * 64 + ch * 8; const float* cvp = A.CVP + ((size_t)(b * 128 + n) * 2 + kvh) * 64 + ch * 8;
          const f32x4 k0 = *(const f32x4*)ckp, k1 = *(const f32x4*)(ckp + 4), v0 = *(const f32x4*)cvp, v1 = *(const f32x4*)(cvp + 4);
          *(bf16x8*)(lds + L_CK + n * 144 + ch * 16) = pack8(k0.x, k0.y, k0.z, k0.w, k1.x, k1.y, k1.z, k1.w);
          unsigned short* vt = (unsigned short*)(lds + L_CVT);
          vt[(ch * 8 + 0) * 136 + n] = (unsigned short)f2bf(v0.x); vt[(ch * 8 + 1) * 136 + n] = (unsigned short)f2bf(v0.y); vt[(ch * 8 + 2) * 136 + n] = (unsigned short)f2bf(v0.z); vt[(ch * 8 + 3) * 136 + n] = (unsigned short)f2bf(v0.w);
          vt[(ch * 8 + 4) * 136 + n] = (unsigned short)f2bf(v1.x); vt[(ch * 8 + 5) * 136 + n] = (unsigned short)f2bf(v1.y); vt[(ch * 8 + 6) * 136 + n] = (unsigned short)f2bf(v1.z); vt[(ch * 8 + 7) * 136 + n] = (unsigned short)f2bf(v1.w);
      }
      if (tid < 128) ((unsigned*)(lds + L_MASK))[tid] = 0u;
      if (tid < 2) ((unsigned*)(lds + L_UM))[tid] = 0u; }
    bf16x8 qr[4];
#pragma unroll
    for (int d0 = 0; d0 < 4; ++d0) qr[d0] = *(const bf16x8*)(A.QB + m * 512 + head * 64 + 16 * d0 + 8 * hi);
    __syncthreads();
    f32x16 tot[2];
    {
        const int nv = (t + 1) >> 5;
        float mx = NEG_INF;
#pragma unroll 1
        for (int tau = 0; tau < ntile_c; ++tau) {
            f32x16 acc = {};
#pragma unroll
            for (int d0 = 0; d0 < 4; ++d0) { const bf16x8 kf = *(const bf16x8*)(lds + L_CK + (32 * tau + r32) * 144 + (16 * d0 + 8 * hi) * 2);
                acc = __builtin_amdgcn_mfma_f32_32x32x16_bf16(kf, qr[d0], acc, 0, 0, 0); }
#pragma unroll
            for (int r = 0; r < 16; ++r) { const int n = 32 * tau + crow(r, hi); if (n < nv) mx = fmaxf(mx, acc[r]); }
        }
        mx = fmaxf(mx, __shfl_xor(mx, 32)); if (mx == NEG_INF) mx = 0.f;
        float sum = 0.f;
        f32x16 oc[2]; oc[0] = (f32x16){}; oc[1] = (f32x16){};
        float* imph = (float*)(lds + L_IMP) + (size_t)hh * 4096 + (32 * ts + r32) * 64;
#pragma unroll 1
        for (int tau = 0; tau < 4; ++tau) {
            f32x16 e = {};
            if (tau < ntile_c) {
                f32x16 acc = {};
#pragma unroll
                for (int d0 = 0; d0 < 4; ++d0) { const bf16x8 kf = *(const bf16x8*)(lds + L_CK + (32 * tau + r32) * 144 + (16 * d0 + 8 * hi) * 2);
                    acc = __builtin_amdgcn_mfma_f32_32x32x16_bf16(kf, qr[d0], acc, 0, 0, 0); }
#pragma unroll
                for (int r = 0; r < 16; ++r) { const int n = 32 * tau + crow(r, hi); e[r] = (n < nv) ? ex2(acc[r] - mx) : 0.f; sum += e[r]; }
#pragma unroll
                for (int s = 0; s < 2; ++s) {
                    const bf16x8 pf = pack8(e[8 * s + 0], e[8 * s + 1], e[8 * s + 2], e[8 * s + 3], e[8 * s + 4], e[8 * s + 5], e[8 * s + 6], e[8 * s + 7]);
#pragma unroll
                    for (int dh = 0; dh < 2; ++dh) { const unsigned char* vp = lds + L_CVT + (r32 + 32 * dh) * 272 + (32 * tau + 16 * s + 4 * hi) * 2;
                        const s16x4 lo = *(const s16x4*)vp, hi4 = *(const s16x4*)(vp + 16);
                        const bf16x8 vf = (bf16x8){lo[0], lo[1], lo[2], lo[3], hi4[0], hi4[1], hi4[2], hi4[3]};
                        oc[dh] = __builtin_amdgcn_mfma_f32_32x32x16_bf16(vf, pf, oc[dh], 0, 0, 0); }
                }
            }
#pragma unroll
            for (int a = 0; a < 4; ++a) { imph[16 * tau + 4 * a + 2 * hi + 0] = e[4 * a] + e[4 * a + 1]; imph[16 * tau + 4 * a + 2 * hi + 1] = e[4 * a + 2] + e[4 * a + 3]; }
        }
        sum += __shfl_xor(sum, 32);
        const float inv = 1.f / fmaxf(sum, 1e-30f);
        if (hi == 0) ((float*)(lds + L_INV))[hh * 64 + 32 * ts + r32] = inv;
        const float g0 = sigmoidf_(A.PROJ[m * NP + C_GATE + head * 3 + 0]) * inv;
#pragma unroll
        for (int dh = 0; dh < 2; ++dh)
#pragma unroll
            for (int r = 0; r < 16; ++r) tot[dh][r] = g0 * oc[dh][r];
    }
    __syncthreads();
    { float* ip = (float*)(lds + L_IMP); const float* iv = (const float*)(lds + L_INV);
#pragma unroll
      for (int i = 0; i < 8; ++i) { const int idx = tid + 512 * i, tk = idx >> 6;
          ip[idx] = (ip[idx] * iv[tk] + ip[4096 + idx] * iv[64 + tk]) + (ip[8192 + idx] * iv[128 + tk] + ip[12288 + idx] * iv[192 + tk]); } }
    __syncthreads();
    { const int tok = tid >> 3, jg = tid & 7; unsigned* mk = (unsigned*)(lds + L_MASK) + tok * 2;
      if (qblk <= 15) { if (jg == 0) { const unsigned long long am = (1ull << (qblk + 1)) - 1ull; mk[0] = (unsigned)am; mk[1] = (unsigned)(am >> 32); } }
      else {
          const float* iv = (const float*)(lds + L_IMP) + tok * 64; float vj[8]; int rk[8];
#pragma unroll
          for (int jj = 0; jj < 8; ++jj) { vj[jj] = iv[jg * 8 + jj]; rk[jj] = 0; }
          for (int i = 1; i <= qblk - 2; ++i) { const float vi = iv[i];
#pragma unroll
              for (int jj = 0; jj < 8; ++jj) { const int j = jg * 8 + jj; rk[jj] += (vi > vj[jj] || (vi == vj[jj] && i < j)) ? 1 : 0; } }
          unsigned bits = 0u;
#pragma unroll
          for (int jj = 0; jj < 8; ++jj) { const int j = jg * 8 + jj; const bool cand = (j >= 1 && j <= qblk - 2);
              if ((cand && rk[jj] < 13) || j == 0 || j == qblk || j == qblk - 1) bits |= 1u << ((jg & 3) * 8 + jj); }
          if (bits) atomicOr(mk + (jg >> 2), bits);
      } }
    __syncthreads();
    if (tid < 64) { const unsigned* mk = (const unsigned*)(lds + L_MASK) + tid * 2; atomicOr((unsigned*)(lds + L_UM), mk[0]); atomicOr((unsigned*)(lds + L_UM) + 1, mk[1]); }
    __syncthreads();
    unsigned long long tmask, umask;
    { const unsigned* mk = (const unsigned*)(lds + L_MASK) + trel * 2; tmask = (unsigned long long)mk[0] | ((unsigned long long)mk[1] << 32);
      const unsigned* um = (const unsigned*)(lds + L_UM); umask = (unsigned long long)um[0] | ((unsigned long long)um[1] << 32); }
    float* stash = (float*)(lds + L_IMP) + (size_t)wave * 2048 + lane;
#pragma unroll
    for (int dh = 0; dh < 2; ++dh)
#pragma unroll
        for (int r = 0; r < 16; ++r) stash[(dh * 16 + r) * 64] = tot[dh][r];
    {
        f32x16 o[2]; o[0] = (f32x16){}; o[1] = (f32x16){}; float mrun = NEG_INF, lrun = 0.f;
        attn_tiles<0>(lds, A.KS + (size_t)b * SEQ * 128 + kvh * 64, A.VS + (size_t)b * SEQ * 128 + kvh * 64, 0, qblk, umask, tmask, qblk, trel, qr, o, mrun, lrun, tid, r32, hi);
        lrun += __shfl_xor(lrun, 32);
        const float g1 = sigmoidf_(A.PROJ[m * NP + C_GATE + head * 3 + 1]) / fmaxf(lrun, 1e-30f);
#pragma unroll
        for (int dh = 0; dh < 2; ++dh)
#pragma unroll
            for (int r = 0; r < 16; ++r) stash[(dh * 16 + r) * 64] += g1 * o[dh][r];
    }
    {
        f32x16 o[2]; o[0] = (f32x16){}; o[1] = (f32x16){}; float mrun = NEG_INF, lrun = 0.f;
        const int jlo = qblk >= 8 ? qblk - 8 : 0;
        attn_tiles<1>(lds, A.KW + (size_t)b * SEQ * 128 + kvh * 64, A.VW + (size_t)b * SEQ * 128 + kvh * 64, jlo, qblk, ~0ull, ~0ull, qblk, trel, qr, o, mrun, lrun, tid, r32, hi);
        lrun += __shfl_xor(lrun, 32);
        const float g2 = sigmoidf_(A.PROJ[m * NP + C_GATE + head * 3 + 2]) / fmaxf(lrun, 1e-30f);
#pragma unroll
        for (int dh = 0; dh < 2; ++dh)
#pragma unroll
            for (int r = 0; r < 16; ++r) tot[dh][r] = stash[(dh * 16 + r) * 64] + g2 * o[dh][r];
    }
    bf16* mo = A.MIX + m * 1024 + 512 + head * 64;
#pragma unroll
    for (int dh = 0; dh < 2; ++dh)
#pragma unroll
        for (int a = 0; a < 4; ++a) { const int d0 = 32 * dh + 8 * a + 4 * hi;
            *(v2u*)(mo + d0) = (v2u){pk2(tot[dh][4 * a], tot[dh][4 * a + 1]), pk2(tot[dh][4 * a + 2], tot[dh][4 * a + 3])}; }
}

struct SAttArgs { const bf16* QB; const bf16* KS; const bf16* VS; const bf16* KW; const bf16* VW; const float* CKS; const float* CVS; const float* PROJ; const float* cache; const int* page_table; const float* state_win; bf16* MIX; int l; };
constexpr int S2_IMP = 0, S2_MK = 512, S2_ITEMS = 576, S2_OC = 1024, S2_MG = 8192;
constexpr int S2_MG_STRIDE = 4224;
template <bool F32> __device__ __forceinline__ void s2_block(const void* kbase, const void* vbase, int kstride, int nvalid, const bf16x8 (&qf)[2], const bool (&keep)[4][4], f32x4 (&O)[4], float& mrun, float& lrun, int fr, int fq) {
    f32x4 kraw[4][2][2]; bf16x8 kb[4][2]; f32x4 vraw[2][8]; v2u vb[2][8];
#pragma unroll
    for (int tk = 0; tk < 4; ++tk) { const int key = 16 * tk + fr, kc = key < nvalid ? key : nvalid - 1;
#pragma unroll
        for (int ks = 0; ks < 2; ++ks) {
            if (F32) { const float* p = (const float*)kbase + (size_t)kc * kstride + 32 * ks + 8 * fq; kraw[tk][ks][0] = *(const f32x4*)p; kraw[tk][ks][1] = *(const f32x4*)(p + 4); }
            else kb[tk][ks] = *(const bf16x8*)((const bf16*)kbase + (size_t)kc * 128 + 32 * ks + 8 * fq); } }
#pragma unroll
    for (int ks = 0; ks < 2; ++ks)
#pragma unroll
        for (int j = 0; j < 8; ++j) { const int key = 32 * ks + 16 * (j >> 2) + 4 * fq + (j & 3), kc = key < nvalid ? key : nvalid - 1;
            if (F32) vraw[ks][j] = *(const f32x4*)((const float*)vbase + (size_t)kc * kstride + 4 * fr);
            else vb[ks][j] = *(const v2u*)((const bf16*)vbase + (size_t)kc * 128 + 4 * fr); }
    __builtin_amdgcn_sched_barrier(0);
    f32x4 acc[4];
#pragma unroll
    for (int tk = 0; tk < 4; ++tk) { bf16x8 kx[2];
#pragma unroll
        for (int ks = 0; ks < 2; ++ks) { if (F32) { const f32x4 a = kraw[tk][ks][0], b = kraw[tk][ks][1]; kx[ks] = pack8(a.x, a.y, a.z, a.w, b.x, b.y, b.z, b.w); } else kx[ks] = kb[tk][ks]; }
        f32x4 a4 = {0.f, 0.f, 0.f, 0.f};
        a4 = __builtin_amdgcn_mfma_f32_16x16x32_bf16(kx[0], qf[0], a4, 0, 0, 0); a4 = __builtin_amdgcn_mfma_f32_16x16x32_bf16(kx[1], qf[1], a4, 0, 0, 0);
        acc[tk] = a4; }
    float mx = NEG_INF;
#pragma unroll
    for (int tk = 0; tk < 4; ++tk)
#pragma unroll
        for (int i = 0; i < 4; ++i) { if (!keep[tk][i]) acc[tk][i] = NEG_INF; mx = fmaxf(mx, acc[tk][i]); }
    mx = fmaxf(mx, __shfl_xor(mx, 16)); mx = fmaxf(mx, __shfl_xor(mx, 32));
    const float mn = fmaxf(mrun, mx), msafe = (mn == NEG_INF) ? 0.f : mn, alpha = ex2(mrun - msafe);
    float ls = 0.f;
#pragma unroll
    for (int tk = 0; tk < 4; ++tk)
#pragma unroll
        for (int i = 0; i < 4; ++i) { const float e = ex2(acc[tk][i] - msafe); acc[tk][i] = e; ls += e; }
    lrun = lrun * alpha + ls; mrun = mn;
#pragma unroll
    for (int td = 0; td < 4; ++td) O[td] *= alpha;
#pragma unroll
    for (int ks = 0; ks < 2; ++ks) {
        const bf16x8 pf = pack8(acc[2 * ks][0], acc[2 * ks][1], acc[2 * ks][2], acc[2 * ks][3], acc[2 * ks + 1][0], acc[2 * ks + 1][1], acc[2 * ks + 1][2], acc[2 * ks + 1][3]);
        float vv[8][4];
#pragma unroll
        for (int j = 0; j < 8; ++j) {
            if (F32) { const f32x4 v = vraw[ks][j]; vv[j][0] = v.x; vv[j][1] = v.y; vv[j][2] = v.z; vv[j][3] = v.w; }
            else { const v2u w = vb[ks][j]; vv[j][0] = bf2f((unsigned short)(w.x & 0xffffu)); vv[j][1] = bf2f((unsigned short)(w.x >> 16)); vv[j][2] = bf2f((unsigned short)(w.y & 0xffffu)); vv[j][3] = bf2f((unsigned short)(w.y >> 16)); } }
#pragma unroll
        for (int td = 0; td < 4; ++td) { const bf16x8 vx = pack8(vv[0][td], vv[1][td], vv[2][td], vv[3][td], vv[4][td], vv[5][td], vv[6][td], vv[7][td]);
            O[td] = __builtin_amdgcn_mfma_f32_16x16x32_bf16(vx, pf, O[td], 0, 0, 0); }
    }
}
__device__ __forceinline__ void nsa_sample_unit(const SAttArgs& A, unsigned char* lds, int unit, int tid) {
    const int sb = unit >> 1, kvh = unit & 1, l = A.l;
    const int lane = tid & 63, wave = __builtin_amdgcn_readfirstlane(tid >> 6), fr = lane & 15, fq = lane >> 4;
    const int qi = fr >> 2, qh = fr & 3;
    float* IMP = (float*)(lds + S2_IMP); unsigned* MK = (unsigned*)(lds + S2_MK); int* ITEMS = (int*)(lds + S2_ITEMS);
    const size_t mq = (size_t)MP + sb * 4 + qi;
    __syncthreads();
    if (tid < 8) MK[tid] = 0u;
    bf16x8 qf[2];
#pragma unroll
    for (int ks = 0; ks < 2; ++ks) qf[ks] = *(const bf16x8*)(A.QB + mq * 512 + (kvh * 4 + qh) * 64 + 32 * ks + 8 * fq);
    {
        f32x4 O[4]; float mrun = NEG_INF, lrun = 0.f;
#pragma unroll
        for (int td = 0; td < 4; ++td) O[td] = (f32x4){0.f, 0.f, 0.f, 0.f};
        bool keep[4][4];
#pragma unroll
        for (int tk = 0; tk < 4; ++tk)
#pragma unroll
            for (int i = 0; i < 4; ++i) keep[tk][i] = true;
        const float* ckf = A.CKS + ((size_t)sb * 64 * 2 + kvh) * 64; const float* cvf = A.CVS + ((size_t)sb * 64 * 2 + kvh) * 64;
        f32x4 acc[4];
#pragma unroll
        for (int tk = 0; tk < 4; ++tk) { bf16x8 kx[2];
#pragma unroll
            for (int ks = 0; ks < 2; ++ks) { const float* p = ckf + (size_t)(16 * tk + fr) * 128 + 32 * ks + 8 * fq; const f32x4 a = *(const f32x4*)p, b = *(const f32x4*)(p + 4); kx[ks] = pack8(a.x, a.y, a.z, a.w, b.x, b.y, b.z, b.w); }
            f32x4 a4 = {0.f, 0.f, 0.f, 0.f};
            a4 = __builtin_amdgcn_mfma_f32_16x16x32_bf16(kx[0], qf[0], a4, 0, 0, 0); a4 = __builtin_amdgcn_mfma_f32_16x16x32_bf16(kx[1], qf[1], a4, 0, 0, 0);
            acc[tk] = a4; }
        float mx = NEG_INF;
#pragma unroll
        for (int tk = 0; tk < 4; ++tk)
#pragma unroll
            for (int i = 0; i < 4; ++i) mx = fmaxf(mx, acc[tk][i]);
        mx = fmaxf(mx, __shfl_xor(mx, 16)); mx = fmaxf(mx, __shfl_xor(mx, 32));
        float ls = 0.f;
#pragma unroll
        for (int tk = 0; tk < 4; ++tk)
#pragma unroll
            for (int i = 0; i < 4; ++i) { const float e = ex2(acc[tk][i] - mx); acc[tk][i] = e; ls += e; }
        ls += __shfl_xor(ls, 16); ls += __shfl_xor(ls, 32);
        const float inv = 1.f / fmaxf(ls, 1e-30f);
        if (wave == 0) {
#pragma unroll
            for (int tk = 0; tk < 4; ++tk)
#pragma unroll
                for (int b2 = 0; b2 < 2; ++b2) { float v = (acc[tk][2 * b2] + acc[tk][2 * b2 + 1]) * inv;
                    v += __shfl_xor(v, 1); v += __shfl_xor(v, 2);
                    if (qh == 0) IMP[qi * 32 + 8 * tk + 2 * fq + b2] = v; }
#pragma unroll
            for (int ks = 0; ks < 2; ++ks) {
                const bf16x8 pf = pack8(acc[2 * ks][0], acc[2 * ks][1], acc[2 * ks][2], acc[2 * ks][3], acc[2 * ks + 1][0], acc[2 * ks + 1][1], acc[2 * ks + 1][2], acc[2 * ks + 1][3]);
#pragma unroll
                for (int td = 0; td < 4; ++td) { float vv[8];
#pragma unroll
                    for (int j = 0; j < 8; ++j) { const int key = 32 * ks + 16 * (j >> 2) + 4 * fq + (j & 3); vv[j] = cvf[(size_t)key * 128 + 4 * fr + td]; }
                    const bf16x8 vx = pack8(vv[0], vv[1], vv[2], vv[3], vv[4], vv[5], vv[6], vv[7]);
                    O[td] = __builtin_amdgcn_mfma_f32_16x16x32_bf16(vx, pf, O[td], 0, 0, 0); } }
            const float g0 = sigmoidf_(A.PROJ[mq * NP + C_GATE + (kvh * 4 + qh) * 3 + 0]) * inv;
            float* OC = (float*)(lds + S2_OC);
#pragma unroll
            for (int td = 0; td < 4; ++td)
#pragma unroll
                for (int i = 0; i < 4; ++i) OC[(16 * fq + 4 * i + td) * 16 + fr] = g0 * O[td][i];
        }
        (void)mrun; (void)lrun; (void)keep;
    }
    __syncthreads();
    if (tid < 128) { const int i = tid >> 5, j = tid & 31; bool sel = (j == 0 || j == 31);
        if (j >= 1 && j <= 30) { const float vj = IMP[i * 32 + j]; int rk = 0;
            for (int q = 1; q <= 30; ++q) { const float vi = IMP[i * 32 + q]; rk += (vi > vj || (vi == vj && q < j)) ? 1 : 0; }
            sel = rk < 13; }
        if (sel) { atomicOr(MK + i, 1u << j); atomicOr(MK + 4, 1u << j); } }
    __syncthreads();
    if (tid == 0) { const unsigned um = MK[4]; int n = 0;
        for (int j = 0; j < 32; ++j) if ((um >> j) & 1u) ITEMS[1 + n++] = j;
        ITEMS[1 + n++] = 32;
        for (int jb = 0; jb < 9; ++jb) ITEMS[1 + n++] = 64 + jb;
        ITEMS[0] = n; }
    __syncthreads();
    {
        const int nitems = ITEMS[0]; const unsigned tm = MK[qi];
        f32x4 Os[4], Ow[4]; float ms = NEG_INF, lsum = 0.f, mw = NEG_INF, lw = 0.f;
#pragma unroll
        for (int td = 0; td < 4; ++td) { Os[td] = (f32x4){0.f, 0.f, 0.f, 0.f}; Ow[td] = (f32x4){0.f, 0.f, 0.f, 0.f}; }
        const float* wb = A.state_win + ((size_t)l * NSB + sb) * 512 * 256 + kvh * 64;
        for (int it = wave; it < nitems; it += NWAVES) {
            const int code = ITEMS[1 + it]; bool keep[4][4];
            if (code < 64) {
                const int j = code;
                if (j < 32) { const int phys = A.page_table[sb * NPAGES + (j >> 1)];
                    const float* base = A.cache + ((((size_t)l * NPOOL + phys) * 2 + kvh) * 128 + (j & 1) * 64) * 256;
                    const bool tsel = ((tm >> j) & 1u) != 0u;
#pragma unroll
                    for (int tk = 0; tk < 4; ++tk)
#pragma unroll
                        for (int i = 0; i < 4; ++i) keep[tk][i] = tsel;
                    s2_block<true>(base + 128, base + 192, 256, 64, qf, keep, Os, ms, lsum, fr, fq);
                } else {
#pragma unroll
                    for (int tk = 0; tk < 4; ++tk)
#pragma unroll
                        for (int i = 0; i < 4; ++i) { const int key = 16 * tk + 4 * fq + i; keep[tk][i] = key <= qi; }
                    s2_block<false>(A.KS + ((size_t)MP + sb * 4) * 128 + kvh * 64, A.VS + ((size_t)MP + sb * 4) * 128 + kvh * 64, 128, 4, qf, keep, Os, ms, lsum, fr, fq);
                }
            } else {
                const int jb = code - 64;
                if (jb < 8) {
#pragma unroll
                    for (int tk = 0; tk < 4; ++tk)
#pragma unroll
                        for (int i = 0; i < 4; ++i) { const int r = 64 * jb + 16 * tk + 4 * fq + i; keep[tk][i] = r >= qi; }
                    s2_block<true>(wb + (size_t)(64 * jb) * 256, wb + (size_t)(64 * jb) * 256 + 128, 256, 64, qf, keep, Ow, mw, lw, fr, fq);
                } else {
#pragma unroll
                    for (int tk = 0; tk < 4; ++tk)
#pragma unroll
                        for (int i = 0; i < 4; ++i) { const int key = 16 * tk + 4 * fq + i; keep[tk][i] = key <= qi; }
                    s2_block<false>(A.KW + ((size_t)MP + sb * 4) * 128 + kvh * 64, A.VW + ((size_t)MP + sb * 4) * 128 + kvh * 64, 128, 4, qf, keep, Ow, mw, lw, fr, fq);
                }
            }
        }
        lsum += __shfl_xor(lsum, 16); lsum += __shfl_xor(lsum, 32); lw += __shfl_xor(lw, 16); lw += __shfl_xor(lw, 32);
        float* Ps = (float*)(lds + S2_MG + (wave * 2 + 0) * S2_MG_STRIDE); float* Pw = (float*)(lds + S2_MG + (wave * 2 + 1) * S2_MG_STRIDE);
#pragma unroll
        for (int td = 0; td < 4; ++td)
#pragma unroll
            for (int i = 0; i < 4; ++i) { Ps[(16 * fq + 4 * i + td) * 16 + fr] = Os[td][i]; Pw[(16 * fq + 4 * i + td) * 16 + fr] = Ow[td][i]; }
        if (fq == 0) { Ps[1024 + fr] = ms; Ps[1040 + fr] = lsum; Pw[1024 + fr] = mw; Pw[1040 + fr] = lw; }
    }
    __syncthreads();
    {
        const int q = tid & 15, i = q >> 2, hh = q & 3; const size_t m = (size_t)MP + sb * 4 + i;
        const float* OC = (const float*)(lds + S2_OC);
        float res[2];
#pragma unroll
        for (int k = 0; k < 2; ++k) res[k] = OC[((tid >> 4) + 32 * k) * 16 + q];
#pragma unroll
        for (int br = 0; br < 2; ++br) {
            float M = NEG_INF;
#pragma unroll
            for (int w = 0; w < NWAVES; ++w) M = fmaxf(M, ((const float*)(lds + S2_MG + (w * 2 + br) * S2_MG_STRIDE))[1024 + q]);
            float L = 0.f, o0 = 0.f, o1 = 0.f;
#pragma unroll
            for (int w = 0; w < NWAVES; ++w) { const float* P = (const float*)(lds + S2_MG + (w * 2 + br) * S2_MG_STRIDE);
                const float f = ex2(P[1024 + q] - M);
                L += P[1040 + q] * f; o0 += P[(tid >> 4) * 16 + q] * f; o1 += P[((tid >> 4) + 32) * 16 + q] * f; }
            const float g = sigmoidf_(A.PROJ[m * NP + C_GATE + (kvh * 4 + hh) * 3 + 1 + br]) / fmaxf(L, 1e-30f);
            res[0] += g * o0; res[1] += g * o1;
        }
#pragma unroll
        for (int k = 0; k < 2; ++k) A.MIX[m * 1024 + 512 + (kvh * 4 + hh) * 64 + (tid >> 4) + 32 * k] = (bf16)f2bf(res[k]);
    }
}

struct Args { const GAS void* in[22]; GAS float* out; GAS unsigned char* ws; int ph_lo, ph_hi; };
constexpr int PH_PER_LAYER = 10, N_PHASES = 1 + NL * PH_PER_LAYER;
__global__ void __launch_bounds__(NWAVES * 64, 2) hymba_fwd(Args args) {
    extern __shared__ __attribute__((aligned(16))) unsigned char lds[];
    const int G = gridDim.x, bx = blockIdx.x, NGW = G * NWAVES;
#define PHASE_IDS int tid = threadIdx.x; asm volatile("" : "+v"(tid)); const int lane = tid & 63, wave = __builtin_amdgcn_readfirstlane(tid >> 6), gw = bx * NWAVES + wave; (void)lane; (void)gw; GAS unsigned char* wsg_ = args.ws; asm volatile("" : "+s"(wsg_)); unsigned char* wsl = (unsigned char*)wsg_;
    float* out = (float*)args.out;
    const float* x_prompt = (const float*)(const GAS float*)args.in[0]; const float* x_sample = (const float*)(const GAS float*)args.in[1]; const float* cache_kv = (const float*)(const GAS float*)args.in[2];
    const int* page_table = (const int*)(const GAS int*)args.in[3]; const float* state_win = (const float*)(const GAS float*)args.in[4]; const float* state_gdn = (const float*)(const GAS float*)args.in[5];
    const float* state_conv = (const float*)(const GAS float*)args.in[6]; const float* norm_mix = (const float*)(const GAS float*)args.in[7]; const float* w_in = (const float*)(const GAS float*)args.in[8];
    const float* conv_w = (const float*)(const GAS float*)args.in[9]; const float* a_log = (const float*)(const GAS float*)args.in[10]; const float* dt_bias = (const float*)(const GAS float*)args.in[11];
    const float* gdn_norm = (const float*)(const GAS float*)args.in[12]; const float* cmp_pe_k = (const float*)(const GAS float*)args.in[13]; const float* cmp_w_k = (const float*)(const GAS float*)args.in[14];
    const float* cmp_pe_v = (const float*)(const GAS float*)args.in[15]; const float* cmp_w_v = (const float*)(const GAS float*)args.in[16]; const float* w_out = (const float*)(const GAS float*)args.in[17];
    const float* norm_mlp = (const float*)(const GAS float*)args.in[18]; const float* w_up = (const float*)(const GAS float*)args.in[19]; const float* w_down = (const float*)(const GAS float*)args.in[20]; const float* norm_final = (const float*)(const GAS float*)args.in[21];
#define WIN_T ((bf16*)(wsl + WS_WIN))
#define WOUT_T ((bf16*)(wsl + WS_WOUT))
#define WUP_T ((bf16*)(wsl + WS_WUP))
#define WDN_T ((bf16*)(wsl + WS_WDN))
#define CMPW ((bf16*)(wsl + WS_CMPW))
#define HB ((bf16*)(wsl + WS_HB))
#define PROJ ((float*)(wsl + WS_PROJ))
#define X1 ((float*)(wsl + WS_X1))
#define X2 ((float*)(wsl + WS_X2))
#define MIX ((bf16*)(wsl + WS_MIX))
#define HID ((bf16*)(wsl + WS_HID))
#define QN ((float*)(wsl + WS_QN))
#define KN ((float*)(wsl + WS_KN))
#define VG ((float*)(wsl + WS_VG))
#define OG ((float*)(wsl + WS_OG))
#define GG ((float*)(wsl + WS_G))
#define BETA ((float*)(wsl + WS_BETA))
#define KQ ((float*)(wsl + WS_KQ))
#define QB ((bf16*)(wsl + WS_QB))
#define KS ((bf16*)(wsl + WS_KS))
#define VS ((bf16*)(wsl + WS_VS))
#define KW ((bf16*)(wsl + WS_KW))
#define VW ((bf16*)(wsl + WS_VW))
#define CKP ((float*)(wsl + WS_CKP))
#define CVP ((float*)(wsl + WS_CVP))
#define CKS ((float*)(wsl + WS_CKS))
#define CVS ((float*)(wsl + WS_CVS))
#define GK ((bf16*)(wsl + WS_GK))
#define GQ ((bf16*)(wsl + WS_GQ))
#define GKT ((bf16*)(wsl + WS_GKT))
#define GVT ((bf16*)(wsl + WS_GVT))
#define GG2 ((float*)(wsl + WS_GG2))
#define BETA2 ((float*)(wsl + WS_BETA2))
#define WX ((bf16*)(wsl + WS_WX))
#define QX ((bf16*)(wsl + WS_QX))
#define QKX ((bf16*)(wsl + WS_QKX))
#define KTX ((bf16*)(wsl + WS_KTX))
#define U0F ((float*)(wsl + WS_U0F))
#define GL ((float*)(wsl + WS_GL))
    LAS unsigned char* ldsl = (LAS unsigned char*)lds;

    const int lo = args.ph_lo, hi = args.ph_hi;
    if (threadIdx.x < 16) ((LAS unsigned*)(ldsl + MISC_OFF))[threadIdx.x] = 0u;
    __syncthreads();
    XcdBarrier bar = xcd_barrier_post((unsigned*)((unsigned char*)args.ws + WS_CTL) + CW_BAR, (volatile LAS unsigned*)(ldsl + MISC_OFF));
#define BOTH(k) (lo <= (k) && (k) + 1 < hi)
#define GRID_BAR(k) do { if (BOTH(k)) xcd_barrier(bar); } while (0)
#ifndef REP_P0
#define REP_P0 1
#endif
#ifndef REP_LIGHT
#define REP_LIGHT 1
#endif
#ifndef REP_PB_ROW
#define REP_PB_ROW 1
#endif
#ifndef REP_PB_PREP
#define REP_PB_PREP 1
#endif
#ifndef REP_PB_CMP
#define REP_PB_CMP 1
#endif
#ifndef REP_PB_COPY
#define REP_PB_COPY 1
#endif
#ifndef REP_PB2
#define REP_PB2 1
#endif
#ifndef REP_SCAN
#define REP_SCAN 1
#endif
#ifndef REP_ATTP
#define REP_ATTP 1
#endif
#ifndef REP_ATTS
#define REP_ATTS 1
#endif
#ifndef REP_GEMM
#define REP_GEMM 1
#endif
#define EN(i) (((PH_MASK_T) >> (i)) & 1u)
#define SUB(i) (((SUB_MASK_T) >> (i)) & 1u)
#define IN(k) (lo <= (k) && (k) < hi)

    if (IN(0)) { PHASE_IDS
        for (int rep0 = 0; rep0 < REP_P0; ++rep0) {
        LAS float* scr = (LAS float*)(ldsl + wave * 16384);
        constexpr int I_IN = 16 * 112, I_OUT = 16 * 32, I_UP = 16 * 128, I_DN = 64 * 32, I_C = 32 * 2, I_L = I_IN + I_OUT + I_UP + I_DN + 2 * I_C;
        for (int it = gw; it < NL * I_L; it += NGW) {
            const int l = it / I_L; int r = it % I_L;
            if (r < I_IN) { transpose_item(w_in + (size_t)l * DM * NPROJ, DM, NPROJ, NP, WIN_T + (size_t)l * NP * DM, scr, r, lane); continue; } r -= I_IN;
            if (r < I_OUT) { transpose_item(w_out + (size_t)l * DM * DM, DM, DM, DM, WOUT_T + (size_t)l * DM * DM, scr, r, lane); continue; } r -= I_OUT;
            if (r < I_UP) { transpose_item(w_up + (size_t)l * DM * DFF, DM, DFF, DFF, WUP_T + (size_t)l * DFF * DM, scr, r, lane); continue; } r -= I_UP;
            if (r < I_DN) { transpose_item(w_down + (size_t)l * DFF * DM, DFF, DM, DM, WDN_T + (size_t)l * DM * DFF, scr, r, lane); continue; } r -= I_DN;
            if (r < I_C) { transpose_item(cmp_w_k + (size_t)l * 2048 * 64, 2048, 64, 64, CMPW + (size_t)((l * 2 + 0) * 64) * 2048, scr, r, lane); continue; } r -= I_C;
            transpose_item(cmp_w_v + (size_t)l * 2048 * 64, 2048, 64, 64, CMPW + (size_t)((l * 2 + 1) * 64) * 2048, scr, r, lane);
        }
        for (int m = gw; m < MT; m += NGW) { const float* xr = (m < MP) ? x_prompt + (size_t)m * DM : x_sample + (size_t)(m - MP) * DM; rms_row(xr, norm_mix, HB + (size_t)m * DM, nullptr, lane); }
        }
    }

    GRID_BAR(0);
    for (int l = 0; l < NL; ++l) {
        const int pb = 1 + l * PH_PER_LAYER;
        if (IN(pb + 0)) { PHASE_IDS
            pg8::Gemm g{HB, WIN_T + (size_t)l * NP * DM, MT, NP, DM}; pg8::StaticOrder S; S.init(MT, NP, G, bx);
            pg8::EpiF32 E{PROJ, NP};
            pg8::gemm_phase<pg8::EpiF32, pg8::StaticOrder, true, true>(ldsl, g, S, E);
        }
        GRID_BAR(pb + 0);
        if (IN(pb + 1)) { PHASE_IDS
            { PBArgs A{PROJ, state_conv, conv_w, a_log, dt_bias, QN, KN, VG, GG, BETA, KQ, QB, KS, VS, KW, VW, out, l};
              for (int rep = 0; rep < REP_PB_ROW; ++rep) if (gw >= 128) for (int m = gw - 128; m < MT; m += NGW - 128) pb_row(A, m, lane); }
            { GPArgs A{PROJ, conv_w, a_log, dt_bias, GK, GQ, GKT, GVT, GG2, BETA2, l};
              for (int rep = 0; rep < REP_PB_PREP; ++rep) for (int u = gw; u < (MP / 8) * 8; u += NGW) gdn_prep_unit(A, u, lane); }
            { CmpArgs A{PROJ, cache_kv, page_table, cmp_pe_k, cmp_pe_v, CMPW, wsl, l};
              for (int rep = 0; rep < REP_PB_CMP; ++rep) for (int u = gw; u < 2176; u += NGW) compress_unit(A, u, lane); }
            { const f32x4* src = (const f32x4*)(state_win + (size_t)l * NSB * 512 * 256); f32x4* dst = (f32x4*)(out + O_WINS + (size_t)l * NSB * 512 * 256);
              for (int rep = 0; rep < REP_PB_COPY; ++rep) for (int i = bx * 512 + tid; i < NSB * 508 * 64; i += G * 512) { const int sb = i / (508 * 64), rem = i % (508 * 64); dst[(size_t)sb * 512 * 64 + rem] = src[(size_t)sb * 512 * 64 + 256 + rem]; } }
        }
        GRID_BAR(pb + 1);
        if (IN(pb + 2)) { PHASE_IDS
            GCArgs A{GK, GQ, GKT, GVT, GG2, BETA2, WX, QX, QKX, KTX, U0F, GL};
            for (int rep = 0; rep < REP_PB2; ++rep) for (int u = gw; u < 32 * 64; u += NGW) gdn_chunk_unit(A, lds + wave * GC_LDS_PER_WAVE, u, lane);
        }
        GRID_BAR(pb + 2);
        if (IN(pb + 3)) {
            { PHASE_IDS GdnArgs GA{QN, KN, VG, GG, BETA, KQ, OG, PROJ, state_gdn, gdn_norm, MIX, out, l};
                for (int u = gw; u < NSB * 8; u += NGW) gdn_sample_unit(GA, u, lane); }
            { PHASE_IDS
                GS2Args SG{WX, QX, QKX, KTX, U0F, GL, OG, out, l};
                AttArgs AA{QB, KS, VS, KW, VW, CKP, CVP, PROJ, MIX};
                SAttArgs SA{QB, KS, VS, KW, VW, CKS, CVS, PROJ, cache_kv, page_table, state_win, MIX, l};
                unsigned* qhead = (unsigned*)(wsl + WS_CTL) + CW_QUEUE + 64 * l;
                volatile LAS int* slot = (volatile LAS int*)(ldsl + MISC_OFF + 32);
                for (;;) {
                    __syncthreads();
                    if (tid == 0) *slot = (int)__hip_atomic_fetch_add(qhead, 1u, __ATOMIC_RELAXED, __HIP_MEMORY_SCOPE_AGENT);
                    __syncthreads();
                    int u = *slot;
                    constexpr int XP = (REP_ATTP - 1) * 512, XS = (REP_ATTS - 1) * 256, XG = (REP_SCAN - 1) * 16;
                    if (u >= 784 + XP + XS + XG) break;
                    if (u >= 784) { int v = u - 784; if (v < XP) u = 16 + (v & 511); else { v -= XP; if (v < XS) u = 528 + (v & 255); else u = (v - XS) & 15; } }
                    int tq = threadIdx.x; asm volatile("" : "+v"(tq));
                    if (u < 16) gdn_scan2_wave(SG, 2 * u + (__builtin_amdgcn_readfirstlane(tq >> 6) >> 2), __builtin_amdgcn_readfirstlane(tq >> 6) & 3, tq & 63);
                    else if (u < 16 + 512) nsa_prompt_unit(AA, lds, u - 16, tq);
                    else nsa_sample_unit(SA, lds, u - 528, tq);
                }
            }
        }
        GRID_BAR(pb + 3);
        if (IN(pb + 4)) { PHASE_IDS
            for (int rep = 0; rep < REP_LIGHT; ++rep) for (int it = gw; it < MP * 8; it += NGW) { const int m = it >> 3, h = it & 7;
                const float o = OG[(size_t)m * 512 + h * 64 + lane]; const float ms = wave_sum(o * o) * (1.f / 64.f);
                const float z = PROJ[(size_t)m * NP + C_Z + h * 64 + lane];
                MIX[(size_t)m * 1024 + h * 64 + lane] = (bf16)f2bf(o * (1.f / sqrtf(ms + 1e-6f)) * gdn_norm[l * 64 + lane] * siluf_(z)); }
        }
        GRID_BAR(pb + 4);
        if (IN(pb + 5)) { PHASE_IDS
            pg8::Gemm g{MIX, WOUT_T + (size_t)l * DM * DM, MT, DM, DM}; pg8::StaticOrder S; S.init(MT, DM, G, bx);
            pg8::EpiResid E{l == 0 ? x_prompt : (const float*)X2, l == 0 ? x_sample : (const float*)X2 + (size_t)MP * DM, MP, X1, DM};
            pg8::gemm_phase<pg8::EpiResid, pg8::StaticOrder, true, true>(ldsl, g, S, E);
        }
        GRID_BAR(pb + 5);
        if (IN(pb + 6)) { PHASE_IDS for (int rep = 0; rep < REP_LIGHT; ++rep) for (int m = gw; m < MT; m += NGW) rms_row(X1 + (size_t)m * DM, norm_mlp + (size_t)l * DM, HB + (size_t)m * DM, nullptr, lane); }
        GRID_BAR(pb + 6);
        if (IN(pb + 7)) { PHASE_IDS
            pg8::Gemm g{HB, WUP_T + (size_t)l * DFF * DM, MT, DFF, DM}; pg8::StaticOrder S; S.init(MT, DFF, G, bx);
            pg8::EpiRelu2 E{HID, DFF};
            _Pragma("unroll 1") for (int rep = 0; rep < REP_GEMM; ++rep) pg8::gemm_phase<pg8::EpiRelu2, pg8::StaticOrder, true, true>(ldsl, g, S, E);
        }
        GRID_BAR(pb + 7);
        if (IN(pb + 8)) { PHASE_IDS
            pg8::Gemm g{HID, WDN_T + (size_t)l * DM * DFF, MT, DM, DFF}; pg8::StaticOrder S; S.init(MT, DM, G, bx);
            pg8::EpiResid E{X1, X1 + (size_t)MP * DM, MP, X2, DM};
            pg8::gemm_phase<pg8::EpiResid, pg8::StaticOrder, true, true>(ldsl, g, S, E);
        }
        GRID_BAR(pb + 8);
        if (IN(pb + 9)) { PHASE_IDS
            if (l + 1 < NL) { for (int rep = 0; rep < REP_LIGHT; ++rep) for (int m = gw; m < MT; m += NGW) rms_row(X2 + (size_t)m * DM, norm_mix + (size_t)(l + 1) * DM, HB + (size_t)m * DM, nullptr, lane); }
            else { for (int rep = 0; rep < REP_LIGHT; ++rep) for (int m = gw; m < MT; m += NGW) rms_row(X2 + (size_t)m * DM, norm_final, nullptr, out + O_YP + (size_t)m * DM, lane); }
        }
        GRID_BAR(pb + 9);
    }
#undef IN
}

#ifndef MK_PER_PHASE
#define MK_PER_PHASE 0
#endif
typedef void (*kfn_t)(Args); static const kfn_t K_ALL = hymba_fwd;
extern "C" void kernel_launch(void* const* d_in, const int* in_sizes, int n_in, void* d_out, int out_size, void* d_ws, size_t ws_size, hipStream_t stream) {
    static int grid = 0;
    if (grid == 0) {
        if (n_in != 22 || out_size != (int)O_END || ws_size < WS_END) { fprintf(stderr, "kernel_launch: unexpected shapes (n_in %d, out %d, ws %zu)\n", n_in, out_size, ws_size); grid = -1; return; }
        int dev = 0, cus = 0, per_cu = 0;
        if (hipGetDevice(&dev) != hipSuccess || hipDeviceGetAttribute(&cus, hipDeviceAttributeMultiprocessorCount, dev) != hipSuccess) { grid = -1; return; }
        if (hipFuncSetAttribute((const void*)K_ALL, hipFuncAttributeMaxDynamicSharedMemorySize, LDS_BYTES) != hipSuccess) { fprintf(stderr, "kernel_launch: hipFuncSetAttribute failed\n"); grid = -1; return; }
        if (hipOccupancyMaxActiveBlocksPerMultiprocessor(&per_cu, (const void*)K_ALL, NWAVES * 64, LDS_BYTES) != hipSuccess || per_cu < 1) { fprintf(stderr, "kernel_launch: occupancy query says %d blocks per CU\n", per_cu); }
        (void)hipGetLastError();
        grid = cus;
    }
    if (grid < 0) return;
    (void)hipMemsetAsync((char*)d_ws + WS_CTL, 0, CTL_ZERO_BYTES, stream);
    Args a{};
    for (int i = 0; i < 22; ++i) a.in[i] = (const GAS void*)d_in[i];
    a.out = (GAS float*)d_out; a.ws = (GAS unsigned char*)d_ws;
    const dim3 g(grid), b(NWAVES * 64);
#if MK_PER_PHASE
    for (int ph = 0; ph < N_PHASES; ++ph) { a.ph_lo = ph; a.ph_hi = ph + 1; K_ALL<<<g, b, LDS_BYTES, stream>>>(a); }
#else
    a.ph_lo = 0; a.ph_hi = N_PHASES; K_ALL<<<g, b, LDS_BYTES, stream>>>(a);
#endif
}
```

```cpp
#include <hip/hip_runtime.h>
#include <cstdio>
#include <cstdint>
namespace pg8 {
#define PG8_LAS __attribute__((address_space(3)))
typedef unsigned short bf16_t;
typedef short bf16x8 __attribute__((ext_vector_type(8)));
typedef float f32x4 __attribute__((ext_vector_type(4)));
typedef unsigned u32x4 __attribute__((ext_vector_type(4)));
constexpr int BM = 256, BK = 64, HALF = 128, HTB = HALF * BK * 2  , STAGE_BYTES = 8 * HTB, NXCD = 8, WGM = 8;

__host__ __device__ __forceinline__ int lds_byte(int r, int c) { const int st = (r >> 4) * 2 + (c >> 5), rr = r & 15, cc = c & 31, ob = rr * 64 + cc * 2; return st * 1024 + (ob ^ (((ob >> 9) & 1) << 5)); }
__host__ __device__ __forceinline__ void stage_rc(int b, int& R, int& C) { const int st = b / 1024, sb = b % 1024, swz = sb ^ (((sb >> 9) & 1) << 5); R = (st >> 1) * 16 + swz / 64; C = (st & 1) * 32 + (swz % 64) / 2; }
__host__ __device__ __forceinline__ int perm32(int rho) { const int n = rho >> 4, i = rho & 15; return 8 * (i >> 2) + 4 * n + (i & 3); }

struct Unit { int pm, pn, kofs, kc; };
struct Gemm { const bf16_t* A; const bf16_t* Bt; int M, N, K, ld; };

struct StaticOrder {
    int nM, nN, nwg, G, c;
    __host__ __device__ void init(int M, int N, int G_, int c_) { nM = M / BM; nN = N / BM; nwg = nM * nN; G = G_; c = c_; }
    __host__ __device__ bool next(int i, Unit& u) const {
        const long L = (long)i * G + c; if (L >= nwg) return false;
        int wgid = (int)L; { const int q = nwg / NXCD, r = nwg % NXCD, xcd = wgid % NXCD, off = wgid / NXCD; wgid = (xcd < r ? xcd * (q + 1) : r * (q + 1) + (xcd - r) * q) + off; }
        const int nig = WGM * nN, gid = wgid / nig, fm = gid * WGM, gsz = (nM - fm) < WGM ? (nM - fm) : WGM;
        u.pm = fm + ((wgid % nig) % gsz); u.pn = (wgid % nig) / gsz; u.kofs = 0; u.kc = 0; return true;
    }
    __device__ __forceinline__ void a_ready(const Unit&) const {}
    __device__ __forceinline__ void done(const Unit&) const {}
};

__device__ __forceinline__ unsigned cvt_pk_bf16(float lo, float hi) { unsigned r; asm volatile("v_cvt_pk_bf16_f32 %0, %1, %2" : "=v"(r) : "v"(lo), "v"(hi)); return r; }

struct EpiF32 {
    static constexpr bool PERM = false, AFTER_DRAIN = false;
    float* O; int ldc;
    __device__ __forceinline__ void operator()(const f32x4 (&acc)[2][2][4][2], const Unit& u, int wr, int wc, int fr, int fq) const {
        const int row0 = u.pm * BM + wr * 64 + fr, col0 = u.pn * BM + wc * 32 + 4 * fq;
#pragma unroll
        for (int ai = 0; ai < 2; ++ai)
#pragma unroll
            for (int m = 0; m < 4; ++m) { float* rowp = O + (size_t)(row0 + ai * HALF + m * 16) * ldc + col0;
#pragma unroll
                for (int bj = 0; bj < 2; ++bj)
#pragma unroll
                    for (int n = 0; n < 2; ++n) *(f32x4*)(rowp + bj * HALF + n * 16) = acc[ai][bj][m][n]; }
    }
};
struct EpiResid {
    static constexpr bool PERM = false, AFTER_DRAIN = false;
    const float* base; const float* base2; int split_row; float* O; int ldc;
    __device__ __forceinline__ void operator()(const f32x4 (&acc)[2][2][4][2], const Unit& u, int wr, int wc, int fr, int fq) const {
        const int row0 = u.pm * BM + wr * 64 + fr, col0 = u.pn * BM + wc * 32 + 4 * fq;
        const float* bs = (u.pm * BM >= split_row) ? (base2 - (size_t)split_row * ldc) : base;
#pragma unroll
        for (int ai = 0; ai < 2; ++ai)
#pragma unroll
            for (int m = 0; m < 4; ++m) { const size_t off = (size_t)(row0 + ai * HALF + m * 16) * ldc + col0;
#pragma unroll
                for (int bj = 0; bj < 2; ++bj)
#pragma unroll
                    for (int n = 0; n < 2; ++n) { const f32x4 r = *(const f32x4*)(bs + off + bj * HALF + n * 16); *(f32x4*)(O + off + bj * HALF + n * 16) = r + acc[ai][bj][m][n]; } }
    }
};
struct EpiRelu2 {
    static constexpr bool PERM = true, AFTER_DRAIN = false;
    bf16_t* O; int ldc;
    __device__ __forceinline__ void operator()(const f32x4 (&acc)[2][2][4][2], const Unit& u, int wr, int wc, int fr, int fq) const {
        const int row0 = u.pm * BM + wr * 64 + fr, col0 = u.pn * BM + wc * 32 + 8 * fq;
#pragma unroll
        for (int ai = 0; ai < 2; ++ai)
#pragma unroll
            for (int m = 0; m < 4; ++m) { bf16_t* rowp = O + (size_t)(row0 + ai * HALF + m * 16) * ldc + col0;
#pragma unroll
                for (int bj = 0; bj < 2; ++bj) { f32x4 v0 = acc[ai][bj][m][0], v1 = acc[ai][bj][m][1];
#pragma unroll
                    for (int i = 0; i < 4; ++i) { const float a = v0[i] > 0.f ? v0[i] : 0.f, b = v1[i] > 0.f ? v1[i] : 0.f; v0[i] = a * a; v1[i] = b * b; }
                    u32x4 w; w.x = cvt_pk_bf16(v0[0], v0[1]); w.y = cvt_pk_bf16(v0[2], v0[3]); w.z = cvt_pk_bf16(v1[0], v1[1]); w.w = cvt_pk_bf16(v1[2], v1[3]);
                    *(u32x4*)(rowp + bj * HALF) = w; } }
    }
};

struct SplitKOrder {
    int pm0, nN, KS, KL, total, G, c;
    __host__ __device__ void init(int pm0_, int nPm, int nN_, int KS_, int KL_, int G_, int c_) { pm0 = pm0_; nN = nN_; KS = KS_; KL = KL_; total = nPm * nN_ * KS_; G = G_; c = c_; }
    __host__ __device__ bool next(int i, Unit& u) const {
        const long L = (long)i * G + c; if (L >= total) return false;
        const int l = (int)L, kc = l % KS, rest = l / KS; u.pn = rest % nN; u.pm = pm0 + rest / nN; u.kofs = kc * KL; u.kc = kc; return true; }
    __device__ __forceinline__ void a_ready(const Unit&) const {}
    __device__ __forceinline__ void done(const Unit&) const {}
};
struct EpiPart {
    static constexpr bool PERM = false, AFTER_DRAIN = false;
    float* P; int ldc; int row0; int rows;
    __device__ __forceinline__ void operator()(const f32x4 (&acc)[2][2][4][2], const Unit& u, int wr, int wc, int fr, int fq) const {
        const int rowl = u.pm * BM - row0 + wr * 64 + fr, col0 = u.pn * BM + wc * 32 + 4 * fq;
        float* base = P + (size_t)u.kc * rows * ldc;
#pragma unroll
        for (int ai = 0; ai < 2; ++ai)
#pragma unroll
            for (int m = 0; m < 4; ++m) { float* rowp = base + (size_t)(rowl + ai * HALF + m * 16) * ldc + col0;
#pragma unroll
                for (int bj = 0; bj < 2; ++bj)
#pragma unroll
                    for (int n = 0; n < 2; ++n) *(f32x4*)(rowp + bj * HALF + n * 16) = acc[ai][bj][m][n]; }
    }
};
template <class Epi, class Sched, bool ALIGN_EPI = false, bool SP2 = false>
__device__ __forceinline__ void gemm_phase(PG8_LAS unsigned char* lds, const Gemm g, const Sched& S, const Epi& E, int tid_in) {
    int tid = tid_in; asm volatile("" : "+v"(tid));
    const int wid = __builtin_amdgcn_readfirstlane(tid >> 6), lane = tid & 63, wr = wid >> 2, wc = wid & 3, fr = lane & 15, fq = lane >> 4;
    const int K = g.ld, nt = g.K / BK;
    unsigned voffA[2], voffB[2];
#pragma unroll
    for (int i = 0; i < 2; ++i) { int R, C; stage_rc(tid * 16 + i * 8192, R, C); const int Rb = Epi::PERM ? ((R & ~31) + perm32(R & 31)) : R;
        voffA[i] = (unsigned)(R * K + C) * 2u; voffB[i] = (unsigned)(Rb * K + C) * 2u; }
    const size_t kstep = (size_t)(BK * 2);
    const size_t hstep = (size_t)HALF * K * 2;
    const size_t tstep = 2 * hstep;
    const unsigned ldsw = (unsigned)wid * 1024u;
    const int aoff = lds_byte(wr * 64 + fr, fq * 8), boff = lds_byte(wc * 32 + fr, fq * 8);
#define PG8_SA(b, h) (((b) * 2 + (h)) * HTB)
#define PG8_SB(b, h) ((4 + (b) * 2 + (h)) * HTB)
#define PG8_STAGE(bufoff, gbase, voff) do { _Pragma("unroll") for (int _i = 0; _i < 2; ++_i) \
        __builtin_amdgcn_global_load_lds((const unsigned*)((const char*)(gbase) + (voff)[_i]), (PG8_LAS unsigned*)(lds + (bufoff) + ldsw + _i * 8192), 16, 0, 0); } while (0)
#define PG8_LDA(dst, b, h) do { _Pragma("unroll") for (int m = 0; m < 4; ++m) _Pragma("unroll") for (int k = 0; k < 2; ++k) dst[m][k] = *(const PG8_LAS bf16x8*)(lds + PG8_SA(b, h) + aoff + m * 2048 + k * 1024); } while (0)
#define PG8_LDB(dst, b, h) do { _Pragma("unroll") for (int n = 0; n < 2; ++n) _Pragma("unroll") for (int k = 0; k < 2; ++k) dst[n][k] = *(const PG8_LAS bf16x8*)(lds + PG8_SB(b, h) + boff + n * 2048 + k * 1024); } while (0)
#define PG8_MMA(ai, bj, At, Bt) do { __builtin_amdgcn_s_setprio(1); _Pragma("unroll") for (int m = 0; m < 4; ++m) _Pragma("unroll") for (int n = 0; n < 2; ++n) _Pragma("unroll") for (int k = 0; k < 2; ++k) \
        acc[ai][bj][m][n] = __builtin_amdgcn_mfma_f32_16x16x32_bf16(Bt[n][k], At[m][k], acc[ai][bj][m][n], 0, 0, 0); __builtin_amdgcn_s_setprio(0); } while (0)
#define PG8_WAIT_V(n) asm volatile("s_waitcnt vmcnt(" #n ")" ::: "memory")
#define PG8_WAIT_L(n) asm volatile("s_waitcnt lgkmcnt(" #n ")" ::: "memory")
#define PG8_BAR __builtin_amdgcn_s_barrier()
#define PG8_SCHED __builtin_amdgcn_sched_barrier(0)
    Unit cur, nxt; int ui = 0;
    if (!S.next(0, cur)) return;
    f32x4 acc[2][2][4][2];
#pragma unroll
    for (int a = 0; a < 2; ++a)
#pragma unroll
        for (int b = 0; b < 2; ++b)
#pragma unroll
            for (int m = 0; m < 4; ++m)
#pragma unroll
                for (int n = 0; n < 2; ++n) acc[a][b][m][n] = (f32x4){0.f, 0.f, 0.f, 0.f};
    bf16x8 At[4][2], B0[2][2], B1[2][2];
    const char* cA = (const char*)g.A + (size_t)cur.pm * tstep + (size_t)cur.kofs * 2; const char* cB = (const char*)g.Bt + (size_t)cur.pn * tstep + (size_t)cur.kofs * 2;
    S.a_ready(cur);
    if constexpr (SP2) {
        PG8_STAGE(PG8_SB(0, 0), cB, voffB); PG8_STAGE(PG8_SB(0, 1), cB + hstep, voffB); PG8_STAGE(PG8_SA(0, 0), cA, voffA); PG8_STAGE(PG8_SA(0, 1), cA + hstep, voffA);
        if (wr == 1) PG8_BAR;
        PG8_WAIT_V(2); PG8_BAR;
        PG8_STAGE(PG8_SB(1, 0), cB + kstep, voffB); PG8_STAGE(PG8_SA(1, 0), cA + kstep, voffA); PG8_STAGE(PG8_SB(1, 1), cB + hstep + kstep, voffB);
        PG8_WAIT_V(6); PG8_BAR;
    } else {
        PG8_STAGE(PG8_SB(0, 0), cB, voffB); PG8_STAGE(PG8_SA(0, 0), cA, voffA); PG8_STAGE(PG8_SB(0, 1), cB + hstep, voffB); PG8_STAGE(PG8_SA(0, 1), cA + hstep, voffA);
        if (wr == 1) PG8_BAR;
        PG8_WAIT_V(4); PG8_BAR;
        PG8_STAGE(PG8_SB(1, 0), cB + kstep, voffB); PG8_STAGE(PG8_SA(1, 0), cA + kstep, voffA); PG8_STAGE(PG8_SB(1, 1), cB + hstep + kstep, voffB);
        PG8_WAIT_V(6); PG8_BAR;
    }
    for (;;) {
        const bool has_next = S.next(ui + 1, nxt);
        const char* nA = has_next ? (const char*)g.A + (size_t)nxt.pm * tstep + (size_t)nxt.kofs * 2 : cA; const char* nB = has_next ? (const char*)g.Bt + (size_t)nxt.pn * tstep + (size_t)nxt.kofs * 2 : cB;
        for (int t = 0; t < nt; t += 2) {
            const bool last = (t == nt - 2);
            const char* a1 = cA + (size_t)(t + 1) * kstep;
            const char* a2 = last ? nA : cA + (size_t)(t + 2) * kstep; const char* b2 = last ? nB : cB + (size_t)(t + 2) * kstep;
            const char* a3 = a2 + kstep; const char* b3 = b2 + kstep;
            if (last && has_next) S.a_ready(nxt);
            if constexpr (SP2) {
            PG8_LDB(B0, 0, 0); PG8_LDB(B1, 0, 1); PG8_SCHED; PG8_LDA(At, 0, 0); PG8_STAGE(PG8_SA(1, 1), a1 + hstep, voffA);
            PG8_WAIT_V(8); PG8_WAIT_L(0); PG8_BAR; PG8_MMA(0, 0, At, B0); PG8_MMA(0, 1, At, B1); PG8_BAR; PG8_SCHED;
            PG8_LDA(At, 0, 1); PG8_STAGE(PG8_SB(0, 0), b2, voffB); PG8_STAGE(PG8_SB(0, 1), b2 + hstep, voffB); PG8_STAGE(PG8_SA(0, 0), a2, voffA);
            PG8_WAIT_V(8); PG8_WAIT_L(0); PG8_BAR; PG8_MMA(1, 0, At, B0); PG8_MMA(1, 1, At, B1); PG8_BAR; PG8_SCHED;
            PG8_LDB(B0, 1, 0); PG8_LDB(B1, 1, 1); PG8_SCHED; PG8_LDA(At, 1, 0); PG8_STAGE(PG8_SA(0, 1), a2 + hstep, voffA);
            PG8_WAIT_V(8); PG8_WAIT_L(0); PG8_BAR; PG8_MMA(0, 0, At, B0); PG8_MMA(0, 1, At, B1); PG8_BAR; PG8_SCHED;
            PG8_LDA(At, 1, 1); PG8_STAGE(PG8_SB(1, 0), b3, voffB); PG8_STAGE(PG8_SB(1, 1), b3 + hstep, voffB); PG8_STAGE(PG8_SA(1, 0), a3, voffA);
            PG8_WAIT_V(8); PG8_WAIT_L(0); PG8_BAR; PG8_MMA(1, 0, At, B0); PG8_MMA(1, 1, At, B1); PG8_BAR; PG8_SCHED;
            } else {
            PG8_LDB(B0, 0, 0); PG8_SCHED; PG8_LDA(At, 0, 0); PG8_STAGE(PG8_SA(1, 1), a1 + hstep, voffA);
            PG8_WAIT_L(8); PG8_BAR; PG8_WAIT_L(0); PG8_MMA(0, 0, At, B0); PG8_BAR; PG8_SCHED;
            PG8_LDB(B1, 0, 1); PG8_STAGE(PG8_SB(0, 0), b2, voffB);
            PG8_BAR; PG8_WAIT_L(0); PG8_MMA(0, 1, At, B1); PG8_BAR;
            PG8_LDA(At, 0, 1); PG8_STAGE(PG8_SA(0, 0), a2, voffA);
            PG8_BAR; PG8_WAIT_L(0); PG8_MMA(1, 0, At, B0); PG8_BAR; PG8_SCHED;
            PG8_STAGE(PG8_SB(0, 1), b2 + hstep, voffB);
            PG8_WAIT_V(6); PG8_BAR; PG8_MMA(1, 1, At, B1); PG8_BAR;
            PG8_LDB(B0, 1, 0); PG8_SCHED; PG8_LDA(At, 1, 0); PG8_STAGE(PG8_SA(0, 1), a2 + hstep, voffA);
            PG8_WAIT_L(8); PG8_BAR; PG8_WAIT_L(0); PG8_MMA(0, 0, At, B0); PG8_BAR; PG8_SCHED;
            PG8_LDB(B1, 1, 1); PG8_STAGE(PG8_SB(1, 0), b3, voffB);
            PG8_BAR; PG8_WAIT_L(0); PG8_MMA(0, 1, At, B1); PG8_BAR;
            PG8_LDA(At, 1, 1); PG8_STAGE(PG8_SA(1, 0), a3, voffA);
            PG8_BAR; PG8_WAIT_L(0); PG8_MMA(1, 0, At, B0); PG8_BAR; PG8_SCHED;
            PG8_STAGE(PG8_SB(1, 1), b3 + hstep, voffB);
            PG8_WAIT_V(6); PG8_BAR; PG8_MMA(1, 1, At, B1); PG8_BAR;
            }
        }
        if constexpr (ALIGN_EPI) { if (wr == 0) PG8_BAR; }
        if constexpr (!Epi::AFTER_DRAIN) { E(acc, cur, wr, wc, fr, fq); S.done(cur); }
        if (!has_next) break;
#pragma unroll
        for (int a = 0; a < 2; ++a)
#pragma unroll
            for (int b = 0; b < 2; ++b)
#pragma unroll
                for (int m = 0; m < 4; ++m)
#pragma unroll
                    for (int n = 0; n < 2; ++n) acc[a][b][m][n] = (f32x4){0.f, 0.f, 0.f, 0.f};
        cur = nxt; cA = nA; cB = nB; ++ui;
        if constexpr (ALIGN_EPI) { if (wr == 1) PG8_BAR; }
    }
    PG8_WAIT_V(0);
    if constexpr (!ALIGN_EPI) { if (wr == 0) PG8_BAR; }
    PG8_BAR;
    if constexpr (Epi::AFTER_DRAIN) { E.fused(acc, cur, wr, wc, fr, fq, lds, wid, lane); S.done(cur); }
#undef PG8_SA
#undef PG8_SB
#undef PG8_STAGE
#undef PG8_LDA
#undef PG8_LDB
#undef PG8_MMA
#undef PG8_WAIT_V
#undef PG8_WAIT_L
#undef PG8_BAR
#undef PG8_SCHED
}
}

constexpr int DM = 1024, NPB = 4, SEQ = 4096, MP = NPB * SEQ, NSB = 128, DSEQ = 4, MS = NSB * DSEQ, MT = MP + MS;
constexpr int NPROJ = 3368, NP = 3584, DFF = 4096, NL = 2;
constexpr int C_QKV = 0, C_Z = 1536, C_A = 2048, C_BETA = 2056, C_Q = 2064, C_KV = 2576, C_GATE = 3344;
constexpr int PAST = 2048, NPAGES = 16, NPOOL = 2560;
constexpr float C2 = 0.125f * 1.4426950408889634f;
constexpr float NEG_INF = -__builtin_inff();
constexpr size_t O_YP = 0, O_YS = 16777216, O_KVP = 17301504, O_KVS = 34078720, O_WINP = 34603008, O_WINS = 35651584, O_GDNP = 69206016, O_GDNS = 69468160, O_CONVP = 77856768, O_CONVS = 77893632, O_END = 79073280;
constexpr size_t MiB = 1u << 20;
constexpr size_t WS_CTL = 0, CTL_ZERO_BYTES = 1 * MiB;
constexpr size_t WS_WIN = 2 * MiB, WS_WOUT = 16 * MiB, WS_WUP = 20 * MiB, WS_WDN = 36 * MiB, WS_CMPW = 52 * MiB;
constexpr size_t WS_HB = 54 * MiB, WS_PROJ = 88 * MiB, WS_X1 = 320 * MiB, WS_X2 = 386 * MiB, WS_MIX = 452 * MiB, WS_HID = 486 * MiB;
constexpr size_t WS_QN = 618 * MiB, WS_KN = 651 * MiB, WS_VG = 684 * MiB, WS_OG = 717 * MiB, WS_G = 750 * MiB, WS_BETA = 751 * MiB, WS_KQ = 752 * MiB;
constexpr size_t WS_QB = 753 * MiB, WS_KS = 770 * MiB, WS_VS = 775 * MiB, WS_KW = 780 * MiB, WS_VW = 785 * MiB;
constexpr size_t WS_CKP = 790 * MiB, WS_CVP = 791 * MiB, WS_CKS = 792 * MiB, WS_CVS = 796 * MiB;
constexpr size_t WS_GK = 800 * MiB, WS_GQ = 816 * MiB, WS_GKT = 832 * MiB, WS_GVT = 848 * MiB, WS_GG2 = 864 * MiB, WS_BETA2 = 865 * MiB;
constexpr size_t WS_WX = 866 * MiB, WS_QX = 882 * MiB, WS_QKX = 898 * MiB, WS_KTX = 914 * MiB, WS_U0F = 930 * MiB, WS_GL = 962 * MiB, WS_END = 1043 * MiB;
constexpr size_t WS_PARTD = 963 * MiB, WS_PARTG = 979 * MiB;
constexpr int PD_KS = 4, PD_KL = DM / PD_KS, PG_KS = 8, PG_KL = DFF / PG_KS;
constexpr int CW_QUEUE = 64;
constexpr int CW_BAR = 4096;
constexpr int RING_BYTES = 131072, LDS_BYTES = 147456, MISC_OFF = LDS_BYTES - 64;
constexpr int NWAVES = 8;

#define GAS __attribute__((address_space(1)))
#define LAS __attribute__((address_space(3)))
typedef unsigned short bf16;
typedef unsigned v4u __attribute__((ext_vector_type(4)));
typedef unsigned v2u __attribute__((ext_vector_type(2)));
typedef float f32x4 __attribute__((ext_vector_type(4)));
typedef float f32x16 __attribute__((ext_vector_type(16)));
typedef short bf16x8 __attribute__((ext_vector_type(8)));
typedef short s16x4 __attribute__((ext_vector_type(4)));
#define LDS_WAIT() asm volatile("s_waitcnt lgkmcnt(0)" ::: "memory")
__device__ __forceinline__ unsigned f2bf(float f) { unsigned u = __builtin_bit_cast(unsigned, f); return (u + 0x7fffu + ((u >> 16) & 1u)) >> 16; }
__device__ __forceinline__ unsigned pk2(float lo, float hi) { return f2bf(lo) | (f2bf(hi) << 16); }
__device__ __forceinline__ float bf2f(unsigned short b) { return __builtin_bit_cast(float, (unsigned)b << 16); }
__device__ __forceinline__ bf16x8 pack8(float a0, float a1, float a2, float a3, float a4, float a5, float a6, float a7) {
    v4u w; w.x = pk2(a0, a1); w.y = pk2(a2, a3); w.z = pk2(a4, a5); w.w = pk2(a6, a7); return __builtin_bit_cast(bf16x8, w); }
__device__ __forceinline__ float wave_sum(float v) {
#pragma unroll
    for (int o = 1; o < 64; o <<= 1) v += __shfl_xor(v, o);
    return v;
}
template <int CTRL, int RMASK> __device__ __forceinline__ float dpp_add(float v) {
    const int t = __builtin_amdgcn_update_dpp(0, __builtin_bit_cast(int, v), CTRL, RMASK, 0xf, false);
    return v + __builtin_bit_cast(float, t);
}
__device__ __forceinline__ float dpp_sum(float v) {
    v = dpp_add<0x111, 0xf>(v); v = dpp_add<0x112, 0xf>(v); v = dpp_add<0x114, 0xf>(v); v = dpp_add<0x118, 0xf>(v);
    v = dpp_add<0x142, 0xa>(v); v = dpp_add<0x143, 0xc>(v);
    return __builtin_bit_cast(float, __builtin_amdgcn_readlane(__builtin_bit_cast(int, v), 63));
}
__device__ __forceinline__ float ex2(float x) { return __builtin_amdgcn_exp2f(x); }
__device__ __forceinline__ float sigmoidf_(float x) { return 1.f / (1.f + __expf(-x)); }
__device__ __forceinline__ float siluf_(float x) { return x / (1.f + __expf(-x)); }
__device__ __forceinline__ int crow(int r, int hi) { return (r & 3) + 8 * (r >> 2) + 4 * hi; }
__device__ __forceinline__ void rope_cs(int pos, int d, float& cs, float& sn) {
    const float invf = exp2f(-(float)d * 0.4152410118609203f);
    double rv = (double)pos * (double)invf * 0.15915494309189535; rv -= floor(rv);
    const float rf = (float)rv; sn = __builtin_amdgcn_sinf(rf); cs = __builtin_amdgcn_cosf(rf);
}

#define XB_TMO      128
#define XB_XCNT(j)  (256  + 64 * (j))
#define XB_XSUB(j)  (1280 + 64 * (j))
#define XB_XGEN(j)  (2304 + 64 * (j))
#define XB_TOP      3328
#define XB_TOPGEN   3392
#define XCD_BAR_WORDS 3456
#define XB_SPIN_CAP (1u << 18)

__device__ __forceinline__ unsigned xb_ld(unsigned* p)              { return __hip_atomic_load(p, __ATOMIC_RELAXED, __HIP_MEMORY_SCOPE_AGENT); }
__device__ __forceinline__ unsigned xb_add(unsigned* p, unsigned v) { return __hip_atomic_fetch_add(p, v, __ATOMIC_RELAXED, __HIP_MEMORY_SCOPE_AGENT); }
__device__ __forceinline__ unsigned xb_xcc_id() { return (unsigned)__builtin_amdgcn_s_getreg((3 << 11) | 20) & 0xFu; }
#define XB_SPIN(cond, bar) do { unsigned _sp = 0; while (cond) { __builtin_amdgcn_s_sleep(1); \
    if ((++_sp & 255u) == 0u) { if (xb_ld(&(bar)[XB_TMO])) break; if (_sp > XB_SPIN_CAP) { atomicAdd(&(bar)[XB_TMO], 1u); break; } } } } while (0)

struct XcdBarrier {
    unsigned* bar; unsigned x;
    volatile LAS unsigned* st;
};

__device__ __forceinline__ XcdBarrier xcd_barrier_post(unsigned* bar, volatile LAS unsigned* st, bool leader) {
    XcdBarrier b; b.bar = bar; b.x = xb_xcc_id(); b.st = st;
    if (leader) (void)xb_add(&bar[XB_XCNT(b.x)], 1u);
    return b;
}
__device__ __forceinline__ void xcd_barrier_complete(unsigned* bar, unsigned x, unsigned& nloc, unsigned& nx) {
    const unsigned G = gridDim.x * gridDim.y * gridDim.z;
    unsigned sum, cnt, mine, sp = 0u;
    for (;;) {
        sum = 0u; cnt = 0u; mine = 0u;
#pragma unroll
        for (unsigned j = 0; j < 16; ++j) { const unsigned c = xb_ld(&bar[XB_XCNT(j)]); sum += c; cnt += (c > 0u) ? 1u : 0u; mine = (j == x) ? c : mine; }
        if (sum == G) break;
        __builtin_amdgcn_s_sleep(1);
        if ((++sp & 255u) == 0u) { if (xb_ld(&bar[XB_TMO])) break; if (sp > XB_SPIN_CAP) { atomicAdd(&bar[XB_TMO], 1u); break; } }
    }
    nloc = mine > 0u ? mine : 1u; nx = cnt > 0u ? cnt : 1u;
}

__device__ __forceinline__ void xcd_barrier(const XcdBarrier& b, bool leader) {
    asm volatile("s_waitcnt vmcnt(0)" ::: "memory");
    __syncthreads();
    if (leader) {
        unsigned* bar = b.bar;
        __builtin_amdgcn_s_waitcnt(0);
        unsigned nloc = b.st[0], nx = b.st[1];
        if (nloc == 0u) { xcd_barrier_complete(bar, b.x, nloc, nx); b.st[0] = nloc; b.st[1] = nx; }
        const unsigned old = xb_add(&bar[XB_XSUB(b.x)], 1u);
        const unsigned gen = old / nloc;
        if (old + 1u == (gen + 1u) * nloc) {
            __builtin_amdgcn_fence(__ATOMIC_RELEASE, "agent");
            asm volatile("s_waitcnt vmcnt(0)" ::: "memory");
            const unsigned og = xb_add(&bar[XB_TOP], 1u);
            const unsigned tg = og / nx;
            if (og + 1u == (tg + 1u) * nx) xb_add(&bar[XB_TOPGEN], 1u);
            else XB_SPIN(xb_ld(&bar[XB_TOPGEN]) == tg, bar);
            __builtin_amdgcn_fence(__ATOMIC_ACQUIRE, "agent");
            xb_add(&bar[XB_XGEN(b.x)], 1u);
            asm volatile("s_waitcnt vmcnt(0)" ::: "memory");
        } else {
            XB_SPIN(xb_ld(&bar[XB_XGEN(b.x)]) == gen, bar);
            __builtin_amdgcn_fence(__ATOMIC_ACQUIRE, "agent");
            asm volatile("s_waitcnt vmcnt(0)" ::: "memory");
        }
    }
    __syncthreads();
}

__device__ __forceinline__ void transpose_item(const float* W, int K, int N, int Npad, bf16* WT, LAS float* scr, int item, int lane) {
    const int nblk = Npad / 32, kb = item / nblk, nb = item % nblk, k0 = 64 * kb, n0 = 32 * nb;
    const int ncol = n0 + (lane & 31);
#pragma unroll 8
    for (int i = 0; i < 32; ++i) { const int kk = 2 * i + (lane >> 5); scr[kk * 33 + (lane & 31)] = (ncol < N) ? W[(size_t)(k0 + kk) * N + ncol] : 0.f; }
    LDS_WAIT(); asm volatile("" ::: "memory");
    const int c = lane & 7;
#pragma unroll
    for (int j = 0; j < 4; ++j) { const int n = (lane >> 3) + 8 * j; const LAS float* s = scr + (8 * c) * 33 + n;
        v4u o; o.x = pk2(s[0 * 33], s[1 * 33]); o.y = pk2(s[2 * 33], s[3 * 33]); o.z = pk2(s[4 * 33], s[5 * 33]); o.w = pk2(s[6 * 33], s[7 * 33]);
        *(v4u*)(WT + (size_t)(n0 + n) * K + k0 + 8 * c) = o; }
    LDS_WAIT(); asm volatile("" ::: "memory");
}
__device__ __forceinline__ void rms_row(const float* xrow, const float* g, bf16* orow, float* of32, int lane) {
    const f32x4* xr = (const f32x4*)xrow + lane;
    f32x4 v[4]; float s = 0.f;
#pragma unroll
    for (int j = 0; j < 4; ++j) { v[j] = xr[64 * j]; s += (v[j].x * v[j].x + v[j].y * v[j].y) + (v[j].z * v[j].z + v[j].w * v[j].w); }
    const float rstd = 1.f / sqrtf(wave_sum(s) * (1.f / DM) + 1e-6f);
#pragma unroll
    for (int j = 0; j < 4; ++j) { const f32x4 gg = ((const f32x4*)g)[64 * j + lane]; const f32x4 o = v[j] * rstd * gg;
        if (of32) ((f32x4*)of32)[64 * j + lane] = o;
        else ((v2u*)orow)[64 * j + lane] = (v2u){pk2(o.x, o.y), pk2(o.z, o.w)}; }
}

__device__ __forceinline__ void rms_row_parts(const float* base, const float* parts, int nparts, size_t part_stride, float* xout, const float* g, bf16* orow, float* of32, int lane) {
    f32x4 v[4]; float s = 0.f;
#pragma unroll
    for (int j = 0; j < 4; ++j) v[j] = ((const f32x4*)base)[64 * j + lane];
    for (int p = 0; p < nparts; ++p) { const f32x4* pr = (const f32x4*)(parts + (size_t)p * part_stride) + lane;
#pragma unroll
        for (int j = 0; j < 4; ++j) v[j] += pr[64 * j]; }
#pragma unroll
    for (int j = 0; j < 4; ++j) { if (xout) ((f32x4*)xout)[64 * j + lane] = v[j]; s += (v[j].x * v[j].x + v[j].y * v[j].y) + (v[j].z * v[j].z + v[j].w * v[j].w); }
    const float rstd = 1.f / sqrtf(wave_sum(s) * (1.f / DM) + 1e-6f);
#pragma unroll
    for (int j = 0; j < 4; ++j) { const f32x4 gg = ((const f32x4*)g)[64 * j + lane]; const f32x4 o = v[j] * rstd * gg;
        if (of32) ((f32x4*)of32)[64 * j + lane] = o;
        else ((v2u*)orow)[64 * j + lane] = (v2u){pk2(o.x, o.y), pk2(o.z, o.w)}; }
}

struct PBArgs { const float* PROJ; const float* state_conv; const float* conv_w; const float* a_log; const float* dt_bias;
    float* QN; float* KN; float* VG; float* G; float* BETA; float* KQ; bf16* QB; bf16* KS; bf16* VS; bf16* KW; bf16* VW; float* out; int l; };
struct PBRegs { float qs_[8], qo_[8], kvs_[12], kvo_[12]; };
__device__ __forceinline__ void pb_row_load(const PBArgs& A, int m, int lane, PBRegs& R) {
    const float* pr = A.PROJ + (size_t)m * NP;
#pragma unroll
    for (int h = 0; h < 8; ++h) { R.qs_[h] = pr[C_Q + h * 64 + lane]; R.qo_[h] = pr[C_Q + h * 64 + (lane ^ 32)]; }
#pragma unroll
    for (int i = 0; i < 12; ++i) { R.kvs_[i] = pr[C_KV + i * 64 + lane]; R.kvo_[i] = pr[C_KV + i * 64 + (lane ^ 32)]; }
}
__device__ __forceinline__ void pb_row(const PBArgs& A, int m, int lane, const PBRegs& R) {
    const bool is_s = m >= MP; int b, t;
    if (!is_s) { b = m >> 12; t = m & 4095; } else { b = (m - MP) >> 2; t = (m - MP) & 3; }
    const int pos = is_s ? PAST + t : t, l = A.l;
    const float* pr = A.PROJ + (size_t)m * NP;
    const float* cw = A.conv_w + (size_t)l * 4 * 1536;
    const float* cb = A.state_conv + ((size_t)l * NSB + b) * 3 * 1536;
    if (!is_s && t >= SEQ - 3) { float* o = A.out + O_CONVP + ((size_t)(l * NPB + b) * 3 + (t - (SEQ - 3))) * 1536;
#pragma unroll 4
        for (int j = 0; j < 24; ++j) o[64 * j + lane] = pr[64 * j + lane]; }
    if (is_s && t >= 1) { float* o = A.out + O_CONVS + ((size_t)(l * NSB + b) * 3 + (t - 1)) * 1536;
#pragma unroll 4
        for (int j = 0; j < 24; ++j) o[64 * j + lane] = pr[64 * j + lane]; }
    const int half = lane >> 5; float cs, sn; rope_cs(pos, lane & 31, cs, sn);
    const float (&qs_)[8] = R.qs_; const float (&qo_)[8] = R.qo_; const float (&kvs_)[12] = R.kvs_; const float (&kvo_)[12] = R.kvo_;
#pragma unroll
    for (int h = 0; h < 8; ++h) { const float xs = qs_[h], xo = qo_[h];
        const float r = half ? (xs * cs + xo * sn) : (xs * cs - xo * sn);
        A.QB[(size_t)m * 512 + h * 64 + lane] = (bf16)f2bf(r * C2); }
#pragma unroll
    for (int s6 = 0; s6 < 6; ++s6)
#pragma unroll
        for (int kvh = 0; kvh < 2; ++kvh) {
            float v = kvs_[s6 * 2 + kvh];
            if (s6 == 2 || s6 == 4) { const float xo = kvo_[s6 * 2 + kvh]; v = half ? (v * cs + xo * sn) : (v * cs - xo * sn); }
            if (s6 < 4) {
                if (!is_s) A.out[O_KVP + ((((size_t)(l * NPB + b) * 2 + kvh) * SEQ + t) * 4 + s6) * 64 + lane] = v;
                else       A.out[O_KVS + ((((size_t)(l * NSB + b) * 2 + kvh) * DSEQ + t) * 4 + s6) * 64 + lane] = v;
            } else {
                const int idx = s6 - 4;
                if (!is_s) { if (t >= SEQ - 512) A.out[O_WINP + ((((size_t)(l * NPB + b) * 512 + (t - (SEQ - 512))) * 2 + idx) * 2 + kvh) * 64 + lane] = v; }
                else A.out[O_WINS + ((((size_t)(l * NSB + b) * 512 + (508 + t)) * 2 + idx) * 2 + kvh) * 64 + lane] = v;
            }
            const bf16 bv = (bf16)f2bf(v);
            if (s6 == 2) A.KS[(size_t)m * 128 + kvh * 64 + lane] = bv;
            if (s6 == 3) A.VS[(size_t)m * 128 + kvh * 64 + lane] = bv;
            if (s6 == 4) A.KW[(size_t)m * 128 + kvh * 64 + lane] = bv;
            if (s6 == 5) A.VW[(size_t)m * 128 + kvh * 64 + lane] = bv;
        }
}

__device__ __forceinline__ void pb_sample_head(const PBArgs& A, int u, int lane) {
    const int m = MP + (u >> 3), h = u & 7, b = (m - MP) >> 2, t = (m - MP) & 3, l = A.l;
    const float* pr = A.PROJ + (size_t)m * NP;
    const float* cw = A.conv_w + (size_t)l * 4 * 1536;
    const float* cb = A.state_conv + ((size_t)l * NSB + b) * 3 * 1536;
    float xv[3][4], wv[3][4];
#pragma unroll
    for (int part = 0; part < 3; ++part) { const int c = (part * 8 + h) * 64 + lane;
#pragma unroll
        for (int tap = 0; tap < 4; ++tap) { const int idx = t + tap;
            xv[part][tap] = (idx >= 3) ? A.PROJ[(size_t)(m - t + idx - 3) * NP + c] : cb[idx * 1536 + c];
            wv[part][tap] = cw[tap * 1536 + c]; } }
    __builtin_amdgcn_sched_barrier(0);
    float qkv[3];
#pragma unroll
    for (int part = 0; part < 3; ++part) qkv[part] = siluf_((xv[part][0] * wv[part][0] + xv[part][1] * wv[part][1]) + (xv[part][2] * wv[part][2] + xv[part][3] * wv[part][3]));
    const float q = qkv[0], k = qkv[1];
    const float qs = dpp_sum(q * q), ks = dpp_sum(k * k);
    const float qn = q * (1.f / sqrtf(qs + 1e-6f)) * 0.125f, kn = k * (1.f / sqrtf(ks + 1e-6f));
    const float kq = dpp_sum(qn * kn);
    A.QN[(size_t)m * 512 + h * 64 + lane] = qn; A.KN[(size_t)m * 512 + h * 64 + lane] = kn; A.VG[(size_t)m * 512 + h * 64 + lane] = qkv[2];
    if (lane == 0) A.KQ[(size_t)m * 8 + h] = kq;
    if (h == 0 && lane < 8) {
        const float a = pr[C_A + lane] + A.dt_bias[l * 8 + lane];
        const float sp = fmaxf(a, 0.f) + log1pf(__expf(-fabsf(a)));
        A.G[(size_t)m * 8 + lane] = -__expf(A.a_log[l * 8 + lane]) * sp;
        A.BETA[(size_t)m * 8 + lane] = sigmoidf_(pr[C_BETA + lane]); }
}

struct CmpArgs { const float* PROJ; const float* cache; const int* page_table; const float* pe_k; const float* pe_v; const bf16* CMPW; unsigned char* ws; int l; };
__device__ __forceinline__ void compress_unit(const CmpArgs& A, int u, int lane) {
    const int fr = lane & 15, fq = lane >> 4, l = A.l;
    const int kv = u & 1, uu = u >> 1; const bool is_s = uu >= 64; const int ru = is_s ? uu - 64 : uu;
    const int rho = 16 * ru + fr, NC = is_s ? 64 : 128;
    const int seq = rho / (2 * NC), n = (rho >> 1) % NC, kvh = rho & 1;
    const float* abase; size_t astride;
    if (!is_s) { abase = A.PROJ + (size_t)(seq * SEQ + 32 * n) * NP + C_KV + kv * 128 + kvh * 64; astride = NP; }
    else { const int page = A.page_table[seq * NPAGES + (n >> 2)];
        abase = A.cache + ((((size_t)l * NPOOL + page) * 2 + kvh) * 128 + (n & 3) * 32) * 256 + kv * 64; astride = 256; }
    const float* pe = (kv ? A.pe_v : A.pe_k) + (size_t)l * 2048;
    const bf16* Wt = A.CMPW + (size_t)((l * 2 + kv) * 64) * 2048;
    f32x4 acc[4];
#pragma unroll
    for (int et = 0; et < 4; ++et) acc[et] = (f32x4){0.f, 0.f, 0.f, 0.f};
    f32x4 sa[2][4], sp[2][4]; bf16x8 sw[2][8];
#define CMP_LOAD(S, c) do { _Pragma("unroll") for (int ks = 0; ks < 2; ++ks) { const float* ap = abase + (size_t)(c) * astride + 32 * ks + 8 * fq; const float* pp = pe + (c) * 64 + 32 * ks + 8 * fq; \
        sa[S][2 * ks] = *(const f32x4*)ap; sa[S][2 * ks + 1] = *(const f32x4*)(ap + 4); sp[S][2 * ks] = *(const f32x4*)pp; sp[S][2 * ks + 1] = *(const f32x4*)(pp + 4); \
        _Pragma("unroll") for (int et = 0; et < 4; ++et) sw[S][ks * 4 + et] = *(const bf16x8*)(Wt + (size_t)(16 * et + fr) * 2048 + (c) * 64 + 32 * ks + 8 * fq); } } while (0)
#define CMP_MMA(S) do { _Pragma("unroll") for (int ks = 0; ks < 2; ++ks) { const f32x4 a0 = sa[S][2 * ks] + sp[S][2 * ks], a1 = sa[S][2 * ks + 1] + sp[S][2 * ks + 1]; \
        const bf16x8 ya = pack8(a0.x, a0.y, a0.z, a0.w, a1.x, a1.y, a1.z, a1.w); \
        _Pragma("unroll") for (int et = 0; et < 4; ++et) acc[et] = __builtin_amdgcn_mfma_f32_16x16x32_bf16(sw[S][ks * 4 + et], ya, acc[et], 0, 0, 0); } } while (0)
    CMP_LOAD(0, 0);
#pragma unroll 1
    for (int c = 0; c < 32; c += 2) {
        CMP_LOAD(1, c + 1); __builtin_amdgcn_sched_barrier(0);
        CMP_MMA(0); __builtin_amdgcn_sched_barrier(0);
        if (c + 2 < 32) { CMP_LOAD(0, c + 2); } __builtin_amdgcn_sched_barrier(0);
        CMP_MMA(1); __builtin_amdgcn_sched_barrier(0);
    }
#undef CMP_LOAD
#undef CMP_MMA
    if (kv == 0) { const int pos = 32 * n + 31;
#pragma unroll
        for (int et = 0; et < 2; ++et)
#pragma unroll
            for (int i = 0; i < 4; ++i) { float cs, sn; rope_cs(pos, 16 * et + 4 * fq + i, cs, sn);
                const float x1 = acc[et][i], x2 = acc[et + 2][i]; acc[et][i] = x1 * cs - x2 * sn; acc[et + 2][i] = x2 * cs + x1 * sn; } }
    float* ob = (float*)(A.ws + (is_s ? WS_CKS : WS_CKP) + (size_t)kv * (is_s ? (WS_CVS - WS_CKS) : (WS_CVP - WS_CKP))) + (size_t)rho * 64 + 4 * fq;
#pragma unroll
    for (int et = 0; et < 4; ++et) *(f32x4*)(ob + 16 * et) = acc[et];
}

struct GdnArgs { const float* QN; const float* KN; const float* VG; const float* G; const float* BETA; const float* KQ; float* OG; const float* PROJ; const float* state_gdn; const float* gdn_norm; bf16* MIX; float* out; int l; };
__device__ __forceinline__ void gdn_sample_unit(const GdnArgs& A, int unit, int lane) {
    const int sb = unit >> 3, h = unit & 7, l = A.l;
    const float* sp = A.state_gdn + (((size_t)l * NSB + sb) * 8 + h) * 4096;
    float S[64];
#pragma unroll
    for (int d = 0; d < 64; ++d) S[d] = sp[d * 64 + lane];
    const float gn = A.gdn_norm[l * 64 + lane];
    for (int i = 0; i < DSEQ; ++i) {
        const size_t m = (size_t)MP + sb * 4 + i;
        const float kd = A.KN[m * 512 + h * 64 + lane], qd = A.QN[m * 512 + h * 64 + lane], v = A.VG[m * 512 + h * 64 + lane];
        const float g = A.G[m * 8 + h], beta = A.BETA[m * 8 + h], kq = A.KQ[m * 8 + h];
        const int kdb = __builtin_bit_cast(int, kd), qdb = __builtin_bit_cast(int, qd);
        const float a = __expf(g); float r1 = 0.f, r2 = 0.f;
#pragma unroll
        for (int d = 0; d < 64; ++d) { const float kk = __builtin_bit_cast(float, __builtin_amdgcn_readlane(kdb, d)), qq = __builtin_bit_cast(float, __builtin_amdgcn_readlane(qdb, d)); r1 += S[d] * kk; r2 += S[d] * qq; }
        const float u = beta * (v - a * r1), o = a * r2 + u * kq;
#pragma unroll
        for (int d = 0; d < 64; ++d) { const float kk = __builtin_bit_cast(float, __builtin_amdgcn_readlane(kdb, d)); S[d] = a * S[d] + kk * u; }
        const float ms = wave_sum(o * o) * (1.f / 64.f);
        const float z = A.PROJ[m * NP + C_Z + h * 64 + lane];
        A.MIX[m * 1024 + h * 64 + lane] = (bf16)f2bf(o * (1.f / sqrtf(ms + 1e-6f)) * gn * siluf_(z));
    }
    float* so = A.out + O_GDNS + (((size_t)l * NSB + sb) * 8 + h) * 4096;
#pragma unroll
    for (int d = 0; d < 64; ++d) so[d * 64 + lane] = S[d];
}


__device__ __forceinline__ int perm_inv32(int p) { return (p & 32) + 16 * ((p >> 2) & 1) + 4 * ((p >> 3) & 3) + (p & 3); }
struct GPArgs { const float* PROJ; const float* conv_w; const float* a_log; const float* dt_bias; bf16* GK; bf16* GQ; bf16* GKT; bf16* GVT; float* GG2; float* BETA2; int l; };
struct GPRegs { float xx[3][11], ww[3][4]; };
__device__ __forceinline__ void gdn_prep_load(const GPArgs& A, int unit, int lane, GPRegs& R) {
    const int tg = unit >> 3, h = unit & 7, m0 = tg * 8, t0 = m0 & 4095;
    const float* cw = A.conv_w + (size_t)A.l * 4 * 1536;
#pragma unroll
    for (int part = 0; part < 3; ++part) { const int c = (part * 8 + h) * 64 + lane;
#pragma unroll
        for (int j = 0; j < 11; ++j) R.xx[part][j] = (t0 - 3 + j >= 0) ? A.PROJ[(size_t)(m0 - 3 + j) * NP + c] : 0.f;
#pragma unroll
        for (int k = 0; k < 4; ++k) R.ww[part][k] = cw[k * 1536 + c]; }
}
__device__ __forceinline__ void gdn_prep_unit(const GPArgs& A, int unit, int lane, const GPRegs& R) {
    const int tg = unit >> 3, h = unit & 7, m0 = tg * 8, b = m0 >> 12, t0 = m0 & 4095, l = A.l, bh = b * 8 + h;
    const float* cw = A.conv_w + (size_t)l * 4 * 1536;
    float val[3][8]; const float (&xx)[3][11] = R.xx; const float (&ww)[3][4] = R.ww;
#pragma unroll
    for (int part = 0; part < 3; ++part)
#pragma unroll
        for (int i = 0; i < 8; ++i) val[part][i] = siluf_(ww[part][0] * xx[part][i] + ww[part][1] * xx[part][i + 1] + ww[part][2] * xx[part][i + 2] + ww[part][3] * xx[part][i + 3]);
#pragma unroll
    for (int i = 0; i < 8; ++i) { const float q = val[0][i], k = val[1][i];
        const float qs = dpp_sum(q * q), ks = dpp_sum(k * k);
        val[0][i] = q * (1.f / sqrtf(qs + 1e-6f)) * 0.125f; val[1][i] = k * (1.f / sqrtf(ks + 1e-6f)); }
#pragma unroll
    for (int i = 0; i < 8; ++i) { A.GQ[((size_t)bh * 4096 + t0 + i) * 64 + lane] = (bf16)f2bf(val[0][i]); A.GK[((size_t)bh * 4096 + t0 + i) * 64 + lane] = (bf16)f2bf(val[1][i]); }
    *(v4u*)(A.GKT + ((size_t)bh * 64 + lane) * 4096 + t0) = (v4u){pk2(val[1][0], val[1][1]), pk2(val[1][2], val[1][3]), pk2(val[1][4], val[1][5]), pk2(val[1][6], val[1][7])};
    *(v4u*)(A.GVT + ((size_t)bh * 64 + lane) * 4096 + t0) = (v4u){pk2(val[2][0], val[2][1]), pk2(val[2][2], val[2][3]), pk2(val[2][4], val[2][5]), pk2(val[2][6], val[2][7])};
    if (lane < 8) { const float* pr = A.PROJ + (size_t)(m0 + lane) * NP;
        const float a = pr[C_A + h] + A.dt_bias[l * 8 + h];
        const float sp = fmaxf(a, 0.f) + log1pf(__expf(-fabsf(a)));
        A.GG2[(size_t)bh * 4096 + t0 + lane] = -__expf(A.a_log[l * 8 + h]) * sp;
        A.BETA2[(size_t)bh * 4096 + t0 + lane] = sigmoidf_(pr[C_BETA + h]); }
}
template <int I> __device__ __forceinline__ void fsub_row(float (&T)[64], const float* AL, int lane) {
    float tv = (lane == I) ? 1.f : 0.f;
#pragma unroll
    for (int j4 = 0; j4 < (I + 3) / 4; ++j4) { const f32x4 a = *(const f32x4*)(AL + I * 64 + 4 * j4);
#pragma unroll
        for (int e = 0; e < 4; ++e) if (4 * j4 + e < I) tv -= a[e] * T[4 * j4 + e]; }
    T[I] = tv;
}
template <int I> struct FSub { static __device__ __forceinline__ void run(float (&T)[64], const float* AL, int lane) { FSub<I - 1>::run(T, AL, lane); fsub_row<I>(T, AL, lane); } };
template <> struct FSub<-1> { static __device__ __forceinline__ void run(float (&)[64], const float*, int) {} };
struct GCArgs { const bf16* GK; const bf16* GQ; const bf16* GKT; const bf16* GVT; const float* GG2; const float* BETA2; bf16* WX; bf16* QX; bf16* QKX; bf16* KTX; float* U0F; float* GL; };
constexpr int GC_LDS_PER_WAVE = 17664;
__device__ __forceinline__ void gdn_chunk_unit(const GCArgs& A, unsigned char* wl, int unit, int lane_) {
    int lane = lane_; asm volatile("" : "+v"(lane));
    const int bh = unit >> 6, n = unit & 63, t0 = 64 * n, fr = lane & 15, fq = lane >> 4;
    float* AL = (float*)wl; float* SC = (float*)(wl + 16384);
    {   const float g = A.GG2[(size_t)bh * 4096 + t0 + lane], beta = A.BETA2[(size_t)bh * 4096 + t0 + lane];
        float gc = g;
        gc = dpp_add<0x111, 0xf>(gc); gc = dpp_add<0x112, 0xf>(gc); gc = dpp_add<0x114, 0xf>(gc); gc = dpp_add<0x118, 0xf>(gc); gc = dpp_add<0x142, 0xa>(gc); gc = dpp_add<0x143, 0xc>(gc);
        const float glast = __builtin_bit_cast(float, __builtin_amdgcn_readlane(__builtin_bit_cast(int, gc), 63));
        const float eg = __expf(gc);
        SC[lane] = gc; SC[64 + lane] = beta; SC[128 + lane] = beta * eg; SC[192 + lane] = eg; SC[256 + lane] = __expf(glast - gc);
        if (lane == 0) A.GL[unit] = __expf(glast); }
    LDS_WAIT(); asm volatile("" ::: "memory");
    {
        bf16x8 kf[4][2];
#pragma unroll
        for (int t4 = 0; t4 < 4; ++t4)
#pragma unroll
            for (int ks = 0; ks < 2; ++ks) kf[t4][ks] = *(const bf16x8*)(A.GK + ((size_t)bh * 4096 + t0 + 16 * t4 + fr) * 64 + 32 * ks + 8 * fq);
        __builtin_amdgcn_sched_barrier(0);
#pragma unroll
        for (int ti = 0; ti < 4; ++ti) { const f32x4 gi = *(const f32x4*)(SC + 16 * ti + 4 * fq), bi = *(const f32x4*)(SC + 64 + 16 * ti + 4 * fq);
#pragma unroll
            for (int tj = 0; tj < 4; ++tj) if (tj <= ti) { f32x4 acc = {0.f, 0.f, 0.f, 0.f};
                acc = __builtin_amdgcn_mfma_f32_16x16x32_bf16(kf[ti][0], kf[tj][0], acc, 0, 0, 0); acc = __builtin_amdgcn_mfma_f32_16x16x32_bf16(kf[ti][1], kf[tj][1], acc, 0, 0, 0);
                const float gj = SC[16 * tj + fr];
#pragma unroll
                for (int i = 0; i < 4; ++i) AL[(16 * ti + 4 * fq + i) * 64 + 16 * tj + fr] = bi[i] * acc[i] * __expf(fminf(gi[i] - gj, 0.f)); } }
    }
    LDS_WAIT(); asm volatile("" ::: "memory");
    {
        float T[64];
        FSub<63>::run(T, AL, lane);
        LDS_WAIT(); asm volatile("" ::: "memory");
        unsigned short* TB = (unsigned short*)wl;
#pragma unroll
        for (int i = 0; i < 64; ++i) TB[i * 72 + lane] = (unsigned short)f2bf(T[i]);
    }
    LDS_WAIT(); asm volatile("" ::: "memory");
    {
        bf16x8 tf[4][2];
#pragma unroll
        for (int ti = 0; ti < 4; ++ti)
#pragma unroll
            for (int ks = 0; ks < 2; ++ks) tf[ti][ks] = *(const bf16x8*)(wl + ((16 * ti + fr) * 72 + 32 * ks + 8 * fq) * 2);
#pragma unroll
        for (int which = 0; which < 2; ++which) { const bf16* src = which ? A.GVT : A.GKT; const float* sc = SC + (which ? 64 : 128);
            bf16x8 raws[4][2];
#pragma unroll
            for (int tn = 0; tn < 4; ++tn)
#pragma unroll
                for (int ks = 0; ks < 2; ++ks) raws[tn][ks] = *(const bf16x8*)(src + ((size_t)bh * 64 + 16 * tn + fr) * 4096 + t0 + 32 * ks + 8 * fq);
            __builtin_amdgcn_sched_barrier(0);
#pragma unroll
            for (int tn = 0; tn < 4; ++tn) { bf16x8 yb[2];
#pragma unroll
                for (int ks = 0; ks < 2; ++ks) { const bf16x8 raw = raws[tn][ks];
                    const f32x4 s0 = *(const f32x4*)(sc + 32 * ks + 8 * fq), s1 = *(const f32x4*)(sc + 32 * ks + 8 * fq + 4);
                    yb[ks] = pack8(bf2f((unsigned short)raw[0]) * s0.x, bf2f((unsigned short)raw[1]) * s0.y, bf2f((unsigned short)raw[2]) * s0.z, bf2f((unsigned short)raw[3]) * s0.w,
                                   bf2f((unsigned short)raw[4]) * s1.x, bf2f((unsigned short)raw[5]) * s1.y, bf2f((unsigned short)raw[6]) * s1.z, bf2f((unsigned short)raw[7]) * s1.w); }
#pragma unroll
                for (int ti = 0; ti < 4; ++ti) { f32x4 acc = {0.f, 0.f, 0.f, 0.f};
                    acc = __builtin_amdgcn_mfma_f32_16x16x32_bf16(tf[ti][0], yb[0], acc, 0, 0, 0);
                    if (ti >= 2) acc = __builtin_amdgcn_mfma_f32_16x16x32_bf16(tf[ti][1], yb[1], acc, 0, 0, 0);
                    if (which == 0) { const int p = 32 * (tn >> 1) + 8 * (fr >> 2) + 4 * (tn & 1) + (fr & 3);
#pragma unroll
                        for (int i = 0; i < 4; ++i) A.WX[((size_t)unit * 64 + 16 * ti + 4 * fq + i) * 64 + p] = (bf16)f2bf(acc[i]); }
                    else *(f32x4*)(A.U0F + (((size_t)unit * 16 + ti * 4 + tn) * 64 + lane) * 4) = acc; } } }
    }
    {
        bf16x8 kf[4][2], qf[4][2];
#pragma unroll
        for (int t4 = 0; t4 < 4; ++t4)
#pragma unroll
            for (int ks = 0; ks < 2; ++ks) { kf[t4][ks] = *(const bf16x8*)(A.GK + ((size_t)bh * 4096 + t0 + 16 * t4 + fr) * 64 + 32 * ks + 8 * fq);
                qf[t4][ks] = *(const bf16x8*)(A.GQ + ((size_t)bh * 4096 + t0 + 16 * t4 + fr) * 64 + 32 * ks + 8 * fq); }
        __builtin_amdgcn_sched_barrier(0);
#pragma unroll
        for (int ti = 0; ti < 4; ++ti) { const f32x4 gi = *(const f32x4*)(SC + 16 * ti + 4 * fq);
#pragma unroll
            for (int tj = 0; tj < 4; ++tj) { f32x4 acc = {0.f, 0.f, 0.f, 0.f};
                if (tj <= ti) { acc = __builtin_amdgcn_mfma_f32_16x16x32_bf16(qf[ti][0], kf[tj][0], acc, 0, 0, 0); acc = __builtin_amdgcn_mfma_f32_16x16x32_bf16(qf[ti][1], kf[tj][1], acc, 0, 0, 0); }
                const float gj = SC[16 * tj + fr]; const int p = 32 * (tj >> 1) + 8 * (fr >> 2) + 4 * (tj & 1) + (fr & 3);
#pragma unroll
                for (int i = 0; i < 4; ++i) { const int ri = 16 * ti + 4 * fq + i, cj = 16 * tj + fr;
                    const float v = (tj <= ti && ri >= cj) ? acc[i] * __expf(fminf(gi[i] - gj, 0.f)) : 0.f;
                    A.QKX[((size_t)unit * 64 + ri) * 64 + p] = (bf16)f2bf(v); } } }
    }
    {
        const int lg = perm_inv32(lane);
        const float ek = SC[256 + lg];
#pragma unroll 1
        for (int r0 = 0; r0 < 64; r0 += 16) { bf16 qv[16], kv[16];
#pragma unroll
            for (int i = 0; i < 16; ++i) { qv[i] = A.GQ[((size_t)bh * 4096 + t0 + r0 + i) * 64 + lg]; kv[i] = A.GKT[((size_t)bh * 64 + r0 + i) * 4096 + t0 + lg]; }
            __builtin_amdgcn_sched_barrier(0);
#pragma unroll
            for (int i = 0; i < 16; ++i) { A.QX[((size_t)unit * 64 + r0 + i) * 64 + lane] = (bf16)f2bf(bf2f(qv[i]) * SC[192 + r0 + i]);
                A.KTX[((size_t)unit * 64 + r0 + i) * 64 + lane] = (bf16)f2bf(bf2f(kv[i]) * ek); } }
    }
    LDS_WAIT(); asm volatile("" ::: "memory");
}
struct GS2Args { const bf16* WX; const bf16* QX; const bf16* QKX; const bf16* KTX; const float* U0F; const float* GL; float* OG; float* out; int l; };
__device__ __forceinline__ void gdn_scan2_wave(const GS2Args& A, int bh, int te, int lane) {
    const int fr = lane & 15, fq = lane >> 4, b = bh >> 3, h = bh & 7;
    f32x4 s[4]; bf16x8 sfr[2];
#pragma unroll
    for (int i = 0; i < 4; ++i) s[i] = (f32x4){0.f, 0.f, 0.f, 0.f};
    sfr[0] = (bf16x8){0, 0, 0, 0, 0, 0, 0, 0}; sfr[1] = sfr[0];
    f32x4 u[4]; bf16x8 wf[4][2], kt[4][2], qx[4][2], qkx[4][2]; float dec;
#define GS_LD_UW(nn) do { const size_t un_ = (size_t)bh * 64 + (nn); _Pragma("unroll") for (int tc = 0; tc < 4; ++tc) { u[tc] = *(const f32x4*)(A.U0F + ((un_ * 16 + tc * 4 + te) * 64 + lane) * 4); \
        _Pragma("unroll") for (int ks = 0; ks < 2; ++ks) wf[tc][ks] = *(const bf16x8*)(A.WX + (un_ * 64 + 16 * tc + fr) * 64 + 32 * ks + 8 * fq); } } while (0)
#define GS_LD_Q(nn) do { const size_t un_ = (size_t)bh * 64 + (nn); _Pragma("unroll") for (int tc = 0; tc < 4; ++tc) _Pragma("unroll") for (int ks = 0; ks < 2; ++ks) { \
        qx[tc][ks] = *(const bf16x8*)(A.QX + (un_ * 64 + 16 * tc + fr) * 64 + 32 * ks + 8 * fq); qkx[tc][ks] = *(const bf16x8*)(A.QKX + (un_ * 64 + 16 * tc + fr) * 64 + 32 * ks + 8 * fq); } } while (0)
#define GS_LD_K(nn) do { const size_t un_ = (size_t)bh * 64 + (nn); dec = A.GL[un_]; _Pragma("unroll") for (int tc = 0; tc < 4; ++tc) _Pragma("unroll") for (int ks = 0; ks < 2; ++ks) \
        kt[tc][ks] = *(const bf16x8*)(A.KTX + (un_ * 64 + 16 * tc + fr) * 64 + 32 * ks + 8 * fq); } while (0)
    GS_LD_UW(0); GS_LD_Q(0); GS_LD_K(0);
    __builtin_amdgcn_sched_barrier(0);
#pragma unroll 1
    for (int n = 0; n < 64; ++n) {
        const int nn = n < 63 ? n + 1 : 63;
#pragma unroll
        for (int tc = 0; tc < 4; ++tc) { f32x4 acc = {0.f, 0.f, 0.f, 0.f};
            acc = __builtin_amdgcn_mfma_f32_16x16x32_bf16(wf[tc][0], sfr[0], acc, 0, 0, 0); acc = __builtin_amdgcn_mfma_f32_16x16x32_bf16(wf[tc][1], sfr[1], acc, 0, 0, 0);
            u[tc] -= acc; }
        bf16x8 ufr[2];
#pragma unroll
        for (int ks = 0; ks < 2; ++ks) ufr[ks] = pack8(u[2 * ks][0], u[2 * ks][1], u[2 * ks][2], u[2 * ks][3], u[2 * ks + 1][0], u[2 * ks + 1][1], u[2 * ks + 1][2], u[2 * ks + 1][3]);
        __builtin_amdgcn_sched_barrier(0);
        GS_LD_UW(nn);
        __builtin_amdgcn_sched_barrier(0);
        f32x4 oacc[4];
#pragma unroll
        for (int tc = 0; tc < 4; ++tc) {
            f32x4 acc = {0.f, 0.f, 0.f, 0.f};
            acc = __builtin_amdgcn_mfma_f32_16x16x32_bf16(qx[tc][0], sfr[0], acc, 0, 0, 0); acc = __builtin_amdgcn_mfma_f32_16x16x32_bf16(qx[tc][1], sfr[1], acc, 0, 0, 0);
            acc = __builtin_amdgcn_mfma_f32_16x16x32_bf16(qkx[tc][0], ufr[0], acc, 0, 0, 0); acc = __builtin_amdgcn_mfma_f32_16x16x32_bf16(qkx[tc][1], ufr[1], acc, 0, 0, 0);
            oacc[tc] = acc; }
#pragma unroll
        for (int td = 0; td < 4; ++td) { f32x4 acc = s[td] * dec;
            acc = __builtin_amdgcn_mfma_f32_16x16x32_bf16(kt[td][0], ufr[0], acc, 0, 0, 0); acc = __builtin_amdgcn_mfma_f32_16x16x32_bf16(kt[td][1], ufr[1], acc, 0, 0, 0);
            s[td] = acc; }
#pragma unroll
        for (int ks = 0; ks < 2; ++ks) sfr[ks] = pack8(s[2 * ks][0], s[2 * ks][1], s[2 * ks][2], s[2 * ks][3], s[2 * ks + 1][0], s[2 * ks + 1][1], s[2 * ks + 1][2], s[2 * ks + 1][3]);
        __builtin_amdgcn_sched_barrier(0);
        GS_LD_Q(nn); GS_LD_K(nn);
#pragma unroll
        for (int tc = 0; tc < 4; ++tc)
#pragma unroll
            for (int i = 0; i < 4; ++i) A.OG[((size_t)b * SEQ + 64 * n + 16 * tc + 4 * fq + i) * 512 + h * 64 + 16 * te + fr] = oacc[tc][i];
        __builtin_amdgcn_sched_barrier(0);
    }
#undef GS_LD_UW
#undef GS_LD_Q
#undef GS_LD_K
#pragma unroll
    for (int td = 0; td < 4; ++td)
#pragma unroll
        for (int i = 0; i < 4; ++i) A.out[O_GDNP + ((((size_t)A.l * NPB + b) * 8 + h) * 64 + 16 * td + 4 * fq + i) * 64 + 16 * te + fr] = s[td][i];
}

constexpr int L_CK = 0, L_CVT = 18432, L_IMP = 36864, L_MASK = 102400, L_UM = 102912, L_INV = 102928, L_K = 104448, L_VT = 113664;
struct AttArgs { const bf16* QB; const bf16* KS; const bf16* VS; const bf16* KW; const bf16* VW; const float* CKP; const float* CVP; const float* PROJ; bf16* MIX; };

template <int MODE>
__device__ __forceinline__ void attn_tiles(unsigned char* lds, const bf16* Kg, const bf16* Vg, int j_lo, int j_hi, unsigned long long umask, unsigned long long tmask,
                                           int qblk, int trel, const bf16x8 (&qr)[4], f32x16 (&o)[2], float& mrun, float& lrun, int tid, int r32, int hi) {
    int j = j_lo; while (j <= j_hi && !((umask >> j) & 1ull)) ++j;
    const int key = tid >> 3, ch = tid & 7;
    v4u kvv = {0u, 0u, 0u, 0u}, vv = {0u, 0u, 0u, 0u};
    if (j <= j_hi) { kvv = *(const v4u*)(Kg + (size_t)(64 * j + key) * 128 + ch * 8); vv = *(const v4u*)(Vg + (size_t)(64 * j + key) * 128 + ch * 8); }
    while (j <= j_hi) {
        __syncthreads();
        { *(v4u*)(lds + L_K + key * 144 + ch * 16) = kvv;
          unsigned short* vt = (unsigned short*)(lds + L_VT);
#pragma unroll
          for (int e2 = 0; e2 < 4; ++e2) { const unsigned w = vv[e2]; vt[(ch * 8 + 2 * e2) * 72 + key] = (unsigned short)(w & 0xffffu); vt[(ch * 8 + 2 * e2 + 1) * 72 + key] = (unsigned short)(w >> 16); } }
        __syncthreads();
        int jn = j + 1; while (jn <= j_hi && !((umask >> jn) & 1ull)) ++jn;
        if (jn <= j_hi) { kvv = *(const v4u*)(Kg + (size_t)(64 * jn + key) * 128 + ch * 8); vv = *(const v4u*)(Vg + (size_t)(64 * jn + key) * 128 + ch * 8); }
        __builtin_amdgcn_sched_barrier(0);
        f32x16 p[2];
#pragma unroll
        for (int u = 0; u < 2; ++u) { f32x16 acc = {};
#pragma unroll
            for (int d0 = 0; d0 < 4; ++d0) { const bf16x8 kf = *(const bf16x8*)(lds + L_K + (32 * u + r32) * 144 + (16 * d0 + 8 * hi) * 2);
                acc = __builtin_amdgcn_mfma_f32_32x32x16_bf16(kf, qr[d0], acc, 0, 0, 0); }
            p[u] = acc; }
        const bool tsel = (MODE == 0) ? (((tmask >> j) & 1ull) != 0ull) : true;
#pragma unroll
        for (int u = 0; u < 2; ++u)
#pragma unroll
            for (int r = 0; r < 16; ++r) { const int kv = 32 * u + crow(r, hi); bool keep = tsel;
                if (j == qblk) keep = keep && (kv <= trel);
                if (MODE == 1) { if (j == qblk - 8) keep = keep && (kv >= trel); }
                if (!keep) p[u][r] = NEG_INF; }
        float rm = NEG_INF;
#pragma unroll
        for (int u = 0; u < 2; ++u)
#pragma unroll
            for (int r = 0; r < 16; ++r) rm = fmaxf(rm, p[u][r]);
        rm = fmaxf(rm, __shfl_xor(rm, 32));
        const float mn = fmaxf(mrun, rm), msafe = (mn == NEG_INF) ? 0.f : mn;
        const float alpha = ex2(mrun - msafe);
        float ls = 0.f;
#pragma unroll
        for (int u = 0; u < 2; ++u)
#pragma unroll
            for (int r = 0; r < 16; ++r) { const float e = ex2(p[u][r] - msafe); p[u][r] = e; ls += e; }
        lrun = lrun * alpha + ls; mrun = mn;
#pragma unroll
        for (int dh = 0; dh < 2; ++dh)
#pragma unroll
            for (int r = 0; r < 16; ++r) o[dh][r] *= alpha;
#pragma unroll
        for (int u = 0; u < 2; ++u)
#pragma unroll
            for (int s = 0; s < 2; ++s) {
                const bf16x8 pf = pack8(p[u][8 * s + 0], p[u][8 * s + 1], p[u][8 * s + 2], p[u][8 * s + 3], p[u][8 * s + 4], p[u][8 * s + 5], p[u][8 * s + 6], p[u][8 * s + 7]);
#pragma unroll
                for (int dh = 0; dh < 2; ++dh) { const unsigned char* vp = lds + L_VT + (r32 + 32 * dh) * 144 + (32 * u + 16 * s + 4 * hi) * 2;
                    const s16x4 lo = *(const s16x4*)vp, hi4 = *(const s16x4*)(vp + 16);
                    const bf16x8 vf = (bf16x8){lo[0], lo[1], lo[2], lo[3], hi4[0], hi4[1], hi4[2], hi4[3]};
                    o[dh] = __builtin_amdgcn_mfma_f32_32x32x16_bf16(vf, pf, o[dh], 0, 0, 0); }
            }
        j = jn;
    }
}

__device__ __forceinline__ void nsa_prompt_unit(const AttArgs& A, unsigned char* lds, int unit, int tid) {
    const int lane = tid & 63, wave = tid >> 6, r32 = lane & 31, hi = lane >> 5, hh = wave & 3, ts = wave >> 2;
    const int qblk = 63 - (unit >> 3), b = (unit >> 1) & 3, kvh = unit & 1;
    const int head = kvh * 4 + hh, trel = 32 * ts + r32, t = 64 * qblk + trel; const size_t m = (size_t)b * SEQ + t;
    __syncthreads();
    const int nvmax = 2 * qblk + 2, ntile_c = (nvmax + 31) >> 5;
    { const int ch = tid & 7;
      for (int n = tid >> 3; n < 32 * ntile_c; n += 64) {
          const float* ckp = A.CKP + ((size_t)(b * 128 + n) * 2 + kvh) * 64 + ch * 8; const float* cvp = A.CVP + ((size_t)(b * 128 + n) * 2 + kvh) * 64 + ch * 8;
          const f32x4 k0 = *(const f32x4*)ckp, k1 = *(const f32x4*)(ckp + 4), v0 = *(const f32x4*)cvp, v1 = *(const f32x4*)(cvp + 4);
          *(bf16x8*)(lds + L_CK + n * 144 + ch * 16) = pack8(k0.x, k0.y, k0.z, k0.w, k1.x, k1.y, k1.z, k1.w);
          unsigned short* vt = (unsigned short*)(lds + L_CVT);
          vt[(ch * 8 + 0) * 136 + n] = (unsigned short)f2bf(v0.x); vt[(ch * 8 + 1) * 136 + n] = (unsigned short)f2bf(v0.y); vt[(ch * 8 + 2) * 136 + n] = (unsigned short)f2bf(v0.z); vt[(ch * 8 + 3) * 136 + n] = (unsigned short)f2bf(v0.w);
          vt[(ch * 8 + 4) * 136 + n] = (unsigned short)f2bf(v1.x); vt[(ch * 8 + 5) * 136 + n] = (unsigned short)f2bf(v1.y); vt[(ch * 8 + 6) * 136 + n] = (unsigned short)f2bf(v1.z); vt[(ch * 8 + 7) * 136 + n] = (unsigned short)f2bf(v1.w);
      }
      if (tid < 128) ((unsigned*)(lds + L_MASK))[tid] = 0u;
      if (tid < 2) ((unsigned*)(lds + L_UM))[tid] = 0u; }
    bf16x8 qr[4];
#pragma unroll
    for (int d0 = 0; d0 < 4; ++d0) qr[d0] = *(const bf16x8*)(A.QB + m * 512 + head * 64 + 16 * d0 + 8 * hi);
    __syncthreads();
    f32x16 tot[2];
    {
        const int nv = (t + 1) >> 5;
        float mx = NEG_INF;
#pragma unroll 1
        for (int tau = 0; tau < ntile_c; ++tau) {
            f32x16 acc = {};
#pragma unroll
            for (int d0 = 0; d0 < 4; ++d0) { const bf16x8 kf = *(const bf16x8*)(lds + L_CK + (32 * tau + r32) * 144 + (16 * d0 + 8 * hi) * 2);
                acc = __builtin_amdgcn_mfma_f32_32x32x16_bf16(kf, qr[d0], acc, 0, 0, 0); }
#pragma unroll
            for (int r = 0; r < 16; ++r) { const int n = 32 * tau + crow(r, hi); if (n < nv) mx = fmaxf(mx, acc[r]); }
        }
        mx = fmaxf(mx, __shfl_xor(mx, 32)); if (mx == NEG_INF) mx = 0.f;
        float sum = 0.f;
        f32x16 oc[2]; oc[0] = (f32x16){}; oc[1] = (f32x16){};
        float* imph = (float*)(lds + L_IMP) + (size_t)hh * 4096 + (32 * ts + r32) * 64;
#pragma unroll 1
        for (int tau = 0; tau < 4; ++tau) {
            f32x16 e = {};
            if (tau < ntile_c) {
                f32x16 acc = {};
#pragma unroll
                for (int d0 = 0; d0 < 4; ++d0) { const bf16x8 kf = *(const bf16x8*)(lds + L_CK + (32 * tau + r32) * 144 + (16 * d0 + 8 * hi) * 2);
                    acc = __builtin_amdgcn_mfma_f32_32x32x16_bf16(kf, qr[d0], acc, 0, 0, 0); }
#pragma unroll
                for (int r = 0; r < 16; ++r) { const int n = 32 * tau + crow(r, hi); e[r] = (n < nv) ? ex2(acc[r] - mx) : 0.f; sum += e[r]; }
#pragma unroll
                for (int s = 0; s < 2; ++s) {
                    const bf16x8 pf = pack8(e[8 * s + 0], e[8 * s + 1], e[8 * s + 2], e[8 * s + 3], e[8 * s + 4], e[8 * s + 5], e[8 * s + 6], e[8 * s + 7]);
#pragma unroll
                    for (int dh = 0; dh < 2; ++dh) { const unsigned char* vp = lds + L_CVT + (r32 + 32 * dh) * 272 + (32 * tau + 16 * s + 4 * hi) * 2;
                        const s16x4 lo = *(const s16x4*)vp, hi4 = *(const s16x4*)(vp + 16);
                        const bf16x8 vf = (bf16x8){lo[0], lo[1], lo[2], lo[3], hi4[0], hi4[1], hi4[2], hi4[3]};
                        oc[dh] = __builtin_amdgcn_mfma_f32_32x32x16_bf16(vf, pf, oc[dh], 0, 0, 0); }
                }
            }
#pragma unroll
            for (int a = 0; a < 4; ++a) { imph[16 * tau + 4 * a + 2 * hi + 0] = e[4 * a] + e[4 * a + 1]; imph[16 * tau + 4 * a + 2 * hi + 1] = e[4 * a + 2] + e[4 * a + 3]; }
        }
        sum += __shfl_xor(sum, 32);
        const float inv = 1.f / fmaxf(sum, 1e-30f);
        if (hi == 0) ((float*)(lds + L_INV))[hh * 64 + 32 * ts + r32] = inv;
        const float g0 = sigmoidf_(A.PROJ[m * NP + C_GATE + head * 3 + 0]) * inv;
#pragma unroll
        for (int dh = 0; dh < 2; ++dh)
#pragma unroll
            for (int r = 0; r < 16; ++r) tot[dh][r] = g0 * oc[dh][r];
    }
    __syncthreads();
    { float* ip = (float*)(lds + L_IMP); const float* iv = (const float*)(lds + L_INV);
#pragma unroll
      for (int i = 0; i < 8; ++i) { const int idx = tid + 512 * i, tk = idx >> 6;
          ip[idx] = (ip[idx] * iv[tk] + ip[4096 + idx] * iv[64 + tk]) + (ip[8192 + idx] * iv[128 + tk] + ip[12288 + idx] * iv[192 + tk]); } }
    __syncthreads();
    { const int tok = tid >> 3, jg = tid & 7; unsigned* mk = (unsigned*)(lds + L_MASK) + tok * 2;
      if (qblk <= 15) { if (jg == 0) { const unsigned long long am = (1ull << (qblk + 1)) - 1ull; mk[0] = (unsigned)am; mk[1] = (unsigned)(am >> 32); } }
      else {
          const float* iv = (const float*)(lds + L_IMP) + tok * 64; float vj[8]; int rk[8];
#pragma unroll
          for (int jj = 0; jj < 8; ++jj) { vj[jj] = iv[jg * 8 + jj]; rk[jj] = 0; }
          for (int i = 1; i <= qblk - 2; ++i) { const float vi = iv[i];
#pragma unroll
              for (int jj = 0; jj < 8; ++jj) { const int j = jg * 8 + jj; rk[jj] += (vi > vj[jj] || (vi == vj[jj] && i < j)) ? 1 : 0; } }
          unsigned bits = 0u;
#pragma unroll
          for (int jj = 0; jj < 8; ++jj) { const int j = jg * 8 + jj; const bool cand = (j >= 1 && j <= qblk - 2);
              if ((cand && rk[jj] < 13) || j == 0 || j == qblk || j == qblk - 1) bits |= 1u << ((jg & 3) * 8 + jj); }
          if (bits) atomicOr(mk + (jg >> 2), bits);
      } }
    __syncthreads();
    if (tid < 64) { const unsigned* mk = (const unsigned*)(lds + L_MASK) + tid * 2; atomicOr((unsigned*)(lds + L_UM), mk[0]); atomicOr((unsigned*)(lds + L_UM) + 1, mk[1]); }
    __syncthreads();
    unsigned long long tmask, umask;
    { const unsigned* mk = (const unsigned*)(lds + L_MASK) + trel * 2; tmask = (unsigned long long)mk[0] | ((unsigned long long)mk[1] << 32);
      const unsigned* um = (const unsigned*)(lds + L_UM); umask = (unsigned long long)um[0] | ((unsigned long long)um[1] << 32); }
    float* stash = (float*)(lds + L_IMP) + (size_t)wave * 2048 + lane;
#pragma unroll
    for (int dh = 0; dh < 2; ++dh)
#pragma unroll
        for (int r = 0; r < 16; ++r) stash[(dh * 16 + r) * 64] = tot[dh][r];
    {
        f32x16 o[2]; o[0] = (f32x16){}; o[1] = (f32x16){}; float mrun = NEG_INF, lrun = 0.f;
        attn_tiles<0>(lds, A.KS + (size_t)b * SEQ * 128 + kvh * 64, A.VS + (size_t)b * SEQ * 128 + kvh * 64, 0, qblk, umask, tmask, qblk, trel, qr, o, mrun, lrun, tid, r32, hi);
        lrun += __shfl_xor(lrun, 32);
        const float g1 = sigmoidf_(A.PROJ[m * NP + C_GATE + head * 3 + 1]) / fmaxf(lrun, 1e-30f);
#pragma unroll
        for (int dh = 0; dh < 2; ++dh)
#pragma unroll
            for (int r = 0; r < 16; ++r) stash[(dh * 16 + r) * 64] += g1 * o[dh][r];
    }
    {
        f32x16 o[2]; o[0] = (f32x16){}; o[1] = (f32x16){}; float mrun = NEG_INF, lrun = 0.f;
        const int jlo = qblk >= 8 ? qblk - 8 : 0;
        attn_tiles<1>(lds, A.KW + (size_t)b * SEQ * 128 + kvh * 64, A.VW + (size_t)b * SEQ * 128 + kvh * 64, jlo, qblk, ~0ull, ~0ull, qblk, trel, qr, o, mrun, lrun, tid, r32, hi);
        lrun += __shfl_xor(lrun, 32);
        const float g2 = sigmoidf_(A.PROJ[m * NP + C_GATE + head * 3 + 2]) / fmaxf(lrun, 1e-30f);
#pragma unroll
        for (int dh = 0; dh < 2; ++dh)
#pragma unroll
            for (int r = 0; r < 16; ++r) tot[dh][r] = stash[(dh * 16 + r) * 64] + g2 * o[dh][r];
    }
    bf16* mo = A.MIX + m * 1024 + 512 + head * 64;
#pragma unroll
    for (int dh = 0; dh < 2; ++dh)
#pragma unroll
        for (int a = 0; a < 4; ++a) { const int d0 = 32 * dh + 8 * a + 4 * hi;
            *(v2u*)(mo + d0) = (v2u){pk2(tot[dh][4 * a], tot[dh][4 * a + 1]), pk2(tot[dh][4 * a + 2], tot[dh][4 * a + 3])}; }
}

struct SAttArgs { const bf16* QB; const bf16* KS; const bf16* VS; const bf16* KW; const bf16* VW; const float* CKS; const float* CVS; const float* PROJ; const float* cache; const int* page_table; const float* state_win; bf16* MIX; int l; };
constexpr int S2_IMP = 0, S2_MK = 512, S2_ITEMS = 576, S2_OC = 1024, S2_MG = 8192;
constexpr int S2_MG_STRIDE = 4224;
template <bool F32> __device__ __forceinline__ void s2_block(const void* kbase, const void* vbase, int kstride, int nvalid, const bf16x8 (&qf)[2], const bool (&keep)[4][4], f32x4 (&O)[4], float& mrun, float& lrun, int fr, int fq) {
    f32x4 kraw[4][2][2]; bf16x8 kb[4][2]; f32x4 vraw[2][8]; v2u vb[2][8];
#pragma unroll
    for (int tk = 0; tk < 4; ++tk) { const int key = 16 * tk + fr, kc = key < nvalid ? key : nvalid - 1;
#pragma unroll
        for (int ks = 0; ks < 2; ++ks) {
            if (F32) { const float* p = (const float*)kbase + (size_t)kc * kstride + 32 * ks + 8 * fq; kraw[tk][ks][0] = *(const f32x4*)p; kraw[tk][ks][1] = *(const f32x4*)(p + 4); }
            else kb[tk][ks] = *(const bf16x8*)((const bf16*)kbase + (size_t)kc * 128 + 32 * ks + 8 * fq); } }
#pragma unroll
    for (int ks = 0; ks < 2; ++ks)
#pragma unroll
        for (int j = 0; j < 8; ++j) { const int key = 32 * ks + 16 * (j >> 2) + 4 * fq + (j & 3), kc = key < nvalid ? key : nvalid - 1;
            if (F32) vraw[ks][j] = *(const f32x4*)((const float*)vbase + (size_t)kc * kstride + 4 * fr);
            else vb[ks][j] = *(const v2u*)((const bf16*)vbase + (size_t)kc * 128 + 4 * fr); }
    __builtin_amdgcn_sched_barrier(0);
    f32x4 acc[4];
#pragma unroll
    for (int tk = 0; tk < 4; ++tk) { bf16x8 kx[2];
#pragma unroll
        for (int ks = 0; ks < 2; ++ks) { if (F32) { const f32x4 a = kraw[tk][ks][0], b = kraw[tk][ks][1]; kx[ks] = pack8(a.x, a.y, a.z, a.w, b.x, b.y, b.z, b.w); } else kx[ks] = kb[tk][ks]; }
        f32x4 a4 = {0.f, 0.f, 0.f, 0.f};
        a4 = __builtin_amdgcn_mfma_f32_16x16x32_bf16(kx[0], qf[0], a4, 0, 0, 0); a4 = __builtin_amdgcn_mfma_f32_16x16x32_bf16(kx[1], qf[1], a4, 0, 0, 0);
        acc[tk] = a4; }
    float mx = NEG_INF;
#pragma unroll
    for (int tk = 0; tk < 4; ++tk)
#pragma unroll
        for (int i = 0; i < 4; ++i) { if (!keep[tk][i]) acc[tk][i] = NEG_INF; mx = fmaxf(mx, acc[tk][i]); }
    mx = fmaxf(mx, __shfl_xor(mx, 16)); mx = fmaxf(mx, __shfl_xor(mx, 32));
    const float mn = fmaxf(mrun, mx), msafe = (mn == NEG_INF) ? 0.f : mn, alpha = ex2(mrun - msafe);
    float ls = 0.f;
#pragma unroll
    for (int tk = 0; tk < 4; ++tk)
#pragma unroll
        for (int i = 0; i < 4; ++i) { const float e = ex2(acc[tk][i] - msafe); acc[tk][i] = e; ls += e; }
    lrun = lrun * alpha + ls; mrun = mn;
#pragma unroll
    for (int td = 0; td < 4; ++td) O[td] *= alpha;
#pragma unroll
    for (int ks = 0; ks < 2; ++ks) {
        const bf16x8 pf = pack8(acc[2 * ks][0], acc[2 * ks][1], acc[2 * ks][2], acc[2 * ks][3], acc[2 * ks + 1][0], acc[2 * ks + 1][1], acc[2 * ks + 1][2], acc[2 * ks + 1][3]);
        float vv[8][4];
#pragma unroll
        for (int j = 0; j < 8; ++j) {
            if (F32) { const f32x4 v = vraw[ks][j]; vv[j][0] = v.x; vv[j][1] = v.y; vv[j][2] = v.z; vv[j][3] = v.w; }
            else { const v2u w = vb[ks][j]; vv[j][0] = bf2f((unsigned short)(w.x & 0xffffu)); vv[j][1] = bf2f((unsigned short)(w.x >> 16)); vv[j][2] = bf2f((unsigned short)(w.y & 0xffffu)); vv[j][3] = bf2f((unsigned short)(w.y >> 16)); } }
#pragma unroll
        for (int td = 0; td < 4; ++td) { const bf16x8 vx = pack8(vv[0][td], vv[1][td], vv[2][td], vv[3][td], vv[4][td], vv[5][td], vv[6][td], vv[7][td]);
            O[td] = __builtin_amdgcn_mfma_f32_16x16x32_bf16(vx, pf, O[td], 0, 0, 0); }
    }
}
__device__ __forceinline__ void nsa_sample_unit(const SAttArgs& A, unsigned char* lds, int unit, int tid) {
    const int sb = unit >> 1, kvh = unit & 1, l = A.l;
    const int lane = tid & 63, wave = __builtin_amdgcn_readfirstlane(tid >> 6), fr = lane & 15, fq = lane >> 4;
    const int qi = fr >> 2, qh = fr & 3;
    float* IMP = (float*)(lds + S2_IMP); unsigned* MK = (unsigned*)(lds + S2_MK); int* ITEMS = (int*)(lds + S2_ITEMS);
    const size_t mq = (size_t)MP + sb * 4 + qi;
    __syncthreads();
    if (tid < 8) MK[tid] = 0u;
    bf16x8 qf[2];
#pragma unroll
    for (int ks = 0; ks < 2; ++ks) qf[ks] = *(const bf16x8*)(A.QB + mq * 512 + (kvh * 4 + qh) * 64 + 32 * ks + 8 * fq);
    {
        f32x4 O[4]; float mrun = NEG_INF, lrun = 0.f;
#pragma unroll
        for (int td = 0; td < 4; ++td) O[td] = (f32x4){0.f, 0.f, 0.f, 0.f};
        bool keep[4][4];
#pragma unroll
        for (int tk = 0; tk < 4; ++tk)
#pragma unroll
            for (int i = 0; i < 4; ++i) keep[tk][i] = true;
        const float* ckf = A.CKS + ((size_t)sb * 64 * 2 + kvh) * 64; const float* cvf = A.CVS + ((size_t)sb * 64 * 2 + kvh) * 64;
        f32x4 acc[4];
#pragma unroll
        for (int tk = 0; tk < 4; ++tk) { bf16x8 kx[2];
#pragma unroll
            for (int ks = 0; ks < 2; ++ks) { const float* p = ckf + (size_t)(16 * tk + fr) * 128 + 32 * ks + 8 * fq; const f32x4 a = *(const f32x4*)p, b = *(const f32x4*)(p + 4); kx[ks] = pack8(a.x, a.y, a.z, a.w, b.x, b.y, b.z, b.w); }
            f32x4 a4 = {0.f, 0.f, 0.f, 0.f};
            a4 = __builtin_amdgcn_mfma_f32_16x16x32_bf16(kx[0], qf[0], a4, 0, 0, 0); a4 = __builtin_amdgcn_mfma_f32_16x16x32_bf16(kx[1], qf[1], a4, 0, 0, 0);
            acc[tk] = a4; }
        float mx = NEG_INF;
#pragma unroll
        for (int tk = 0; tk < 4; ++tk)
#pragma unroll
            for (int i = 0; i < 4; ++i) mx = fmaxf(mx, acc[tk][i]);
        mx = fmaxf(mx, __shfl_xor(mx, 16)); mx = fmaxf(mx, __shfl_xor(mx, 32));
        float ls = 0.f;
#pragma unroll
        for (int tk = 0; tk < 4; ++tk)
#pragma unroll
            for (int i = 0; i < 4; ++i) { const float e = ex2(acc[tk][i] - mx); acc[tk][i] = e; ls += e; }
        ls += __shfl_xor(ls, 16); ls += __shfl_xor(ls, 32);
        const float inv = 1.f / fmaxf(ls, 1e-30f);
        if (wave == 0) {
#pragma unroll
            for (int tk = 0; tk < 4; ++tk)
#pragma unroll
                for (int b2 = 0; b2 < 2; ++b2) { float v = (acc[tk][2 * b2] + acc[tk][2 * b2 + 1]) * inv;
                    v += __shfl_xor(v, 1); v += __shfl_xor(v, 2);
                    if (qh == 0) IMP[qi * 32 + 8 * tk + 2 * fq + b2] = v; }
#pragma unroll
            for (int ks = 0; ks < 2; ++ks) {
                const bf16x8 pf = pack8(acc[2 * ks][0], acc[2 * ks][1], acc[2 * ks][2], acc[2 * ks][3], acc[2 * ks + 1][0], acc[2 * ks + 1][1], acc[2 * ks + 1][2], acc[2 * ks + 1][3]);
#pragma unroll
                for (int td = 0; td < 4; ++td) { float vv[8];
#pragma unroll
                    for (int j = 0; j < 8; ++j) { const int key = 32 * ks + 16 * (j >> 2) + 4 * fq + (j & 3); vv[j] = cvf[(size_t)key * 128 + 4 * fr + td]; }
                    const bf16x8 vx = pack8(vv[0], vv[1], vv[2], vv[3], vv[4], vv[5], vv[6], vv[7]);
                    O[td] = __builtin_amdgcn_mfma_f32_16x16x32_bf16(vx, pf, O[td], 0, 0, 0); } }
            const float g0 = sigmoidf_(A.PROJ[mq * NP + C_GATE + (kvh * 4 + qh) * 3 + 0]) * inv;
            float* OC = (float*)(lds + S2_OC);
#pragma unroll
            for (int td = 0; td < 4; ++td)
#pragma unroll
                for (int i = 0; i < 4; ++i) OC[(16 * fq + 4 * i + td) * 16 + fr] = g0 * O[td][i];
        }
        (void)mrun; (void)lrun; (void)keep;
    }
    __syncthreads();
    if (tid < 128) { const int i = tid >> 5, j = tid & 31; bool sel = (j == 0 || j == 31);
        if (j >= 1 && j <= 30) { const float vj = IMP[i * 32 + j]; int rk = 0;
            for (int q = 1; q <= 30; ++q) { const float vi = IMP[i * 32 + q]; rk += (vi > vj || (vi == vj && q < j)) ? 1 : 0; }
            sel = rk < 13; }
        if (sel) { atomicOr(MK + i, 1u << j); atomicOr(MK + 4, 1u << j); } }
    __syncthreads();
    if (tid == 0) { const unsigned um = MK[4]; int n = 0;
        for (int j = 0; j < 32; ++j) if ((um >> j) & 1u) ITEMS[1 + n++] = j;
        ITEMS[1 + n++] = 32;
        for (int jb = 0; jb < 9; ++jb) ITEMS[1 + n++] = 64 + jb;
        ITEMS[0] = n; }
    __syncthreads();
    {
        const int nitems = ITEMS[0]; const unsigned tm = MK[qi];
        f32x4 Os[4], Ow[4]; float ms = NEG_INF, lsum = 0.f, mw = NEG_INF, lw = 0.f;
#pragma unroll
        for (int td = 0; td < 4; ++td) { Os[td] = (f32x4){0.f, 0.f, 0.f, 0.f}; Ow[td] = (f32x4){0.f, 0.f, 0.f, 0.f}; }
        const float* wb = A.state_win + ((size_t)l * NSB + sb) * 512 * 256 + kvh * 64;
        for (int it = wave; it < nitems; it += NWAVES) {
            const int code = ITEMS[1 + it]; bool keep[4][4];
            if (code < 64) {
                const int j = code;
                if (j < 32) { const int phys = A.page_table[sb * NPAGES + (j >> 1)];
                    const float* base = A.cache + ((((size_t)l * NPOOL + phys) * 2 + kvh) * 128 + (j & 1) * 64) * 256;
                    const bool tsel = ((tm >> j) & 1u) != 0u;
#pragma unroll
                    for (int tk = 0; tk < 4; ++tk)
#pragma unroll
                        for (int i = 0; i < 4; ++i) keep[tk][i] = tsel;
                    s2_block<true>(base + 128, base + 192, 256, 64, qf, keep, Os, ms, lsum, fr, fq);
                } else {
#pragma unroll
                    for (int tk = 0; tk < 4; ++tk)
#pragma unroll
                        for (int i = 0; i < 4; ++i) { const int key = 16 * tk + 4 * fq + i; keep[tk][i] = key <= qi; }
                    s2_block<false>(A.KS + ((size_t)MP + sb * 4) * 128 + kvh * 64, A.VS + ((size_t)MP + sb * 4) * 128 + kvh * 64, 128, 4, qf, keep, Os, ms, lsum, fr, fq);
                }
            } else {
                const int jb = code - 64;
                if (jb < 8) {
#pragma unroll
                    for (int tk = 0; tk < 4; ++tk)
#pragma unroll
                        for (int i = 0; i < 4; ++i) { const int r = 64 * jb + 16 * tk + 4 * fq + i; keep[tk][i] = r >= qi; }
                    s2_block<true>(wb + (size_t)(64 * jb) * 256, wb + (size_t)(64 * jb) * 256 + 128, 256, 64, qf, keep, Ow, mw, lw, fr, fq);
                } else {
#pragma unroll
                    for (int tk = 0; tk < 4; ++tk)
#pragma unroll
                        for (int i = 0; i < 4; ++i) { const int key = 16 * tk + 4 * fq + i; keep[tk][i] = key <= qi; }
                    s2_block<false>(A.KW + ((size_t)MP + sb * 4) * 128 + kvh * 64, A.VW + ((size_t)MP + sb * 4) * 128 + kvh * 64, 128, 4, qf, keep, Ow, mw, lw, fr, fq);
                }
            }
        }
        lsum += __shfl_xor(lsum, 16); lsum += __shfl_xor(lsum, 32); lw += __shfl_xor(lw, 16); lw += __shfl_xor(lw, 32);
        float* Ps = (float*)(lds + S2_MG + (wave * 2 + 0) * S2_MG_STRIDE); float* Pw = (float*)(lds + S2_MG + (wave * 2 + 1) * S2_MG_STRIDE);
#pragma unroll
        for (int td = 0; td < 4; ++td)
#pragma unroll
            for (int i = 0; i < 4; ++i) { Ps[(16 * fq + 4 * i + td) * 16 + fr] = Os[td][i]; Pw[(16 * fq + 4 * i + td) * 16 + fr] = Ow[td][i]; }
        if (fq == 0) { Ps[1024 + fr] = ms; Ps[1040 + fr] = lsum; Pw[1024 + fr] = mw; Pw[1040 + fr] = lw; }
    }
    __syncthreads();
    {
        const int q = tid & 15, i = q >> 2, hh = q & 3; const size_t m = (size_t)MP + sb * 4 + i;
        const float* OC = (const float*)(lds + S2_OC);
        float res[2];
#pragma unroll
        for (int k = 0; k < 2; ++k) res[k] = OC[((tid >> 4) + 32 * k) * 16 + q];
#pragma unroll
        for (int br = 0; br < 2; ++br) {
            float M = NEG_INF;
#pragma unroll
            for (int w = 0; w < NWAVES; ++w) M = fmaxf(M, ((const float*)(lds + S2_MG + (w * 2 + br) * S2_MG_STRIDE))[1024 + q]);
            float L = 0.f, o0 = 0.f, o1 = 0.f;
#pragma unroll
            for (int w = 0; w < NWAVES; ++w) { const float* P = (const float*)(lds + S2_MG + (w * 2 + br) * S2_MG_STRIDE);
                const float f = ex2(P[1024 + q] - M);
                L += P[1040 + q] * f; o0 += P[(tid >> 4) * 16 + q] * f; o1 += P[((tid >> 4) + 32) * 16 + q] * f; }
            const float g = sigmoidf_(A.PROJ[m * NP + C_GATE + (kvh * 4 + hh) * 3 + 1 + br]) / fmaxf(L, 1e-30f);
            res[0] += g * o0; res[1] += g * o1;
        }
#pragma unroll
        for (int k = 0; k < 2; ++k) A.MIX[m * 1024 + 512 + (kvh * 4 + hh) * 64 + (tid >> 4) + 32 * k] = (bf16)f2bf(res[k]);
    }
}

constexpr int CW_CMPQ = 256;
__device__ __forceinline__ void compress_pull(const CmpArgs& A, unsigned* head, volatile LAS int* slot, int max_batches, int tid) {
    const int lane = tid & 63, wave = __builtin_amdgcn_readfirstlane(tid >> 6);
    for (int nb = 0; nb < max_batches; ++nb) {
        __syncthreads();
        if (tid == 0) *slot = (int)__hip_atomic_fetch_add(head, 8u, __ATOMIC_RELAXED, __HIP_MEMORY_SCOPE_AGENT);
        __syncthreads();
        const int base = *slot;
        if (base >= 2048) break;
        compress_unit(A, 128 + base + wave, lane);
    }
    __syncthreads();
}

struct Args { const GAS void* in[22]; GAS float* out; GAS unsigned char* ws; int ph_lo, ph_hi; };
constexpr int PH_PER_LAYER = 10, N_PHASES = 1 + NL * PH_PER_LAYER;
__global__ void __launch_bounds__(NWAVES * 64, 2) hymba_fwd(Args args) {
    extern __shared__ __attribute__((aligned(16))) unsigned char lds[];
    const int G = gridDim.x, bx = blockIdx.x, NGW = G * NWAVES;
    const int wave_s_ = __builtin_amdgcn_readfirstlane((int)threadIdx.x >> 6);
#define TID_NOW() (wave_s_ * 64 + (int)__builtin_amdgcn_mbcnt_hi(~0u, __builtin_amdgcn_mbcnt_lo(~0u, 0u)))
#define SUB_IDS int tid = TID_NOW(); asm volatile("" : "+v"(tid)); const int lane = tid & 63, wave = __builtin_amdgcn_readfirstlane(tid >> 6), gw = bx * NWAVES + wave; (void)lane; (void)gw; (void)wave;
#define PHASE_IDS int tid = TID_NOW(); asm volatile("" : "+v"(tid)); const int lane = tid & 63, wave = __builtin_amdgcn_readfirstlane(tid >> 6), gw = bx * NWAVES + wave; (void)lane; (void)gw; const __attribute__((address_space(4))) unsigned long long* ka_ = (const __attribute__((address_space(4))) unsigned long long*)__builtin_amdgcn_kernarg_segment_ptr(); asm volatile("" : "+s"(ka_)); GAS unsigned char* wsg_ = (GAS unsigned char*)ka_[23]; unsigned char* wsl = (unsigned char*)wsg_;
#define x_prompt ((const float*)(const GAS float*)ka_[0])
#define x_sample ((const float*)(const GAS float*)ka_[1])
#define cache_kv ((const float*)(const GAS float*)ka_[2])
#define page_table ((const int*)(const GAS int*)ka_[3])
#define state_win ((const float*)(const GAS float*)ka_[4])
#define state_gdn ((const float*)(const GAS float*)ka_[5])
#define state_conv ((const float*)(const GAS float*)ka_[6])
#define norm_mix ((const float*)(const GAS float*)ka_[7])
#define w_in ((const float*)(const GAS float*)ka_[8])
#define conv_w ((const float*)(const GAS float*)ka_[9])
#define a_log ((const float*)(const GAS float*)ka_[10])
#define dt_bias ((const float*)(const GAS float*)ka_[11])
#define gdn_norm ((const float*)(const GAS float*)ka_[12])
#define cmp_pe_k ((const float*)(const GAS float*)ka_[13])
#define cmp_w_k ((const float*)(const GAS float*)ka_[14])
#define cmp_pe_v ((const float*)(const GAS float*)ka_[15])
#define cmp_w_v ((const float*)(const GAS float*)ka_[16])
#define w_out ((const float*)(const GAS float*)ka_[17])
#define norm_mlp ((const float*)(const GAS float*)ka_[18])
#define w_up ((const float*)(const GAS float*)ka_[19])
#define w_down ((const float*)(const GAS float*)ka_[20])
#define norm_final ((const float*)(const GAS float*)ka_[21])
#define out ((float*)(GAS float*)ka_[22])
#define WIN_T ((bf16*)(wsl + WS_WIN))
#define WOUT_T ((bf16*)(wsl + WS_WOUT))
#define WUP_T ((bf16*)(wsl + WS_WUP))
#define WDN_T ((bf16*)(wsl + WS_WDN))
#define CMPW ((bf16*)(wsl + WS_CMPW))
#define HB ((bf16*)(wsl + WS_HB))
#define PROJ ((float*)(wsl + WS_PROJ))
#define X1 ((float*)(wsl + WS_X1))
#define X2 ((float*)(wsl + WS_X2))
#define MIX ((bf16*)(wsl + WS_MIX))
#define HID ((bf16*)(wsl + WS_HID))
#define QN ((float*)(wsl + WS_QN))
#define KN ((float*)(wsl + WS_KN))
#define VG ((float*)(wsl + WS_VG))
#define OG ((float*)(wsl + WS_OG))
#define GG ((float*)(wsl + WS_G))
#define BETA ((float*)(wsl + WS_BETA))
#define KQ ((float*)(wsl + WS_KQ))
#define QB ((bf16*)(wsl + WS_QB))
#define KS ((bf16*)(wsl + WS_KS))
#define VS ((bf16*)(wsl + WS_VS))
#define KW ((bf16*)(wsl + WS_KW))
#define VW ((bf16*)(wsl + WS_VW))
#define CKP ((float*)(wsl + WS_CKP))
#define CVP ((float*)(wsl + WS_CVP))
#define CKS ((float*)(wsl + WS_CKS))
#define CVS ((float*)(wsl + WS_CVS))
#define GK ((bf16*)(wsl + WS_GK))
#define GQ ((bf16*)(wsl + WS_GQ))
#define GKT ((bf16*)(wsl + WS_GKT))
#define GVT ((bf16*)(wsl + WS_GVT))
#define GG2 ((float*)(wsl + WS_GG2))
#define BETA2 ((float*)(wsl + WS_BETA2))
#define WX ((bf16*)(wsl + WS_WX))
#define QX ((bf16*)(wsl + WS_QX))
#define QKX ((bf16*)(wsl + WS_QKX))
#define KTX ((bf16*)(wsl + WS_KTX))
#define U0F ((float*)(wsl + WS_U0F))
#define GL ((float*)(wsl + WS_GL))
#define PARTD ((float*)(wsl + WS_PARTD))
#define PARTG ((float*)(wsl + WS_PARTG))
    LAS unsigned char* ldsl = (LAS unsigned char*)lds;

    const int lo = args.ph_lo, hi = args.ph_hi;
    { const int t0_ = TID_NOW(); if (t0_ < 16) ((LAS unsigned*)(ldsl + MISC_OFF))[t0_] = 0u; }
    __syncthreads();
    XcdBarrier bar = xcd_barrier_post((unsigned*)((unsigned char*)args.ws + WS_CTL) + CW_BAR, (volatile LAS unsigned*)(ldsl + MISC_OFF), TID_NOW() == 0);
#define BOTH(k) (lo <= (k) && (k) + 1 < hi)
#define GRID_BAR(k) do { if (BOTH(k)) { for (int rb_ = 0; rb_ < REP_BAR; ++rb_) xcd_barrier(bar, TID_NOW() == 0); } } while (0)
#ifndef REP_PG
#define REP_PG 1
#endif
#ifndef REP_PA
#define REP_PA 1
#endif
#ifndef REP_BAR
#define REP_BAR 1
#endif
#ifndef REP_GSMP
#define REP_GSMP 1
#endif
#ifndef REP_P0
#define REP_P0 1
#endif
#ifndef REP_LIGHT
#define REP_LIGHT 1
#endif
#ifndef REP_PB_ROW
#define REP_PB_ROW 1
#endif
#ifndef REP_PB_PREP
#define REP_PB_PREP 1
#endif
#ifndef REP_PB_CMP
#define REP_PB_CMP 1
#endif
#ifndef REP_PB_COPY
#define REP_PB_COPY 1
#endif
#ifndef REP_PB2
#define REP_PB2 1
#endif
#ifndef REP_SCAN
#define REP_SCAN 1
#endif
#ifndef REP_ATTP
#define REP_ATTP 1
#endif
#ifndef REP_ATTS
#define REP_ATTS 1
#endif
#ifndef REP_GEMM
#define REP_GEMM 1
#endif
#define EN(i) (((PH_MASK_T) >> (i)) & 1u)
#define SUB(i) (((SUB_MASK_T) >> (i)) & 1u)
#define IN(k) (lo <= (k) && (k) < hi)

    if (IN(0)) { PHASE_IDS
        for (int rep0 = 0; rep0 < REP_P0; ++rep0) {
        LAS float* scr = (LAS float*)(ldsl + wave * 16384);
        constexpr int I_IN = 16 * 112, I_OUT = 16 * 32, I_UP = 16 * 128, I_DN = 64 * 32, I_C = 32 * 2, I_L = I_IN + I_OUT + I_UP + I_DN + 2 * I_C;
        for (int it = gw; it < NL * I_L; it += NGW) {
            const int l = it / I_L; int r = it % I_L;
            if (r < I_IN) { transpose_item(w_in + (size_t)l * DM * NPROJ, DM, NPROJ, NP, WIN_T + (size_t)l * NP * DM, scr, r, lane); continue; } r -= I_IN;
            if (r < I_OUT) { transpose_item(w_out + (size_t)l * DM * DM, DM, DM, DM, WOUT_T + (size_t)l * DM * DM, scr, r, lane); continue; } r -= I_OUT;
            if (r < I_UP) { transpose_item(w_up + (size_t)l * DM * DFF, DM, DFF, DFF, WUP_T + (size_t)l * DFF * DM, scr, r, lane); continue; } r -= I_UP;
            if (r < I_DN) { transpose_item(w_down + (size_t)l * DFF * DM, DFF, DM, DM, WDN_T + (size_t)l * DM * DFF, scr, r, lane); continue; } r -= I_DN;
            if (r < I_C) { transpose_item(cmp_w_k + (size_t)l * 2048 * 64, 2048, 64, 64, CMPW + (size_t)((l * 2 + 0) * 64) * 2048, scr, r, lane); continue; } r -= I_C;
            transpose_item(cmp_w_v + (size_t)l * 2048 * 64, 2048, 64, 64, CMPW + (size_t)((l * 2 + 1) * 64) * 2048, scr, r, lane);
        }
        for (int m = gw; m < MT; m += NGW) { const float* xr = (m < MP) ? x_prompt + (size_t)m * DM : x_sample + (size_t)(m - MP) * DM; rms_row(xr, norm_mix, HB + (size_t)m * DM, nullptr, lane); }
        }
    }

    GRID_BAR(0);
    for (int l = 0; l < NL; ++l) {
        const int pb = 1 + l * PH_PER_LAYER;
        if (IN(pb + 0)) { PHASE_IDS
            pg8::Gemm g{HB, WIN_T + (size_t)l * NP * DM, MT, NP, DM, DM}; pg8::StaticOrder S; S.init(MT, NP, G, bx);
            pg8::EpiF32 E{PROJ, NP};
            _Pragma("unroll 1") for (int rep = 0; rep < REP_PA; ++rep) pg8::gemm_phase<pg8::EpiF32, pg8::StaticOrder, true, true>(ldsl, g, S, E, tid);
            if (l == 0 && bx >= (MT / 256) * (NP / 256) % G) { SUB_IDS CmpArgs CA{PROJ, cache_kv, page_table, cmp_pe_k, cmp_pe_v, CMPW, wsl, 0};
                compress_pull(CA, (unsigned*)(wsl + WS_CTL) + CW_CMPQ, (volatile LAS int*)(ldsl + MISC_OFF + 36), 1, tid); }
        }
        GRID_BAR(pb + 0);
        if (IN(pb + 1)) { PHASE_IDS
            { SUB_IDS PBArgs A{PROJ, state_conv, conv_w, a_log, dt_bias, QN, KN, VG, GG, BETA, KQ, QB, KS, VS, KW, VW, out, l};
              for (int rep = 0; rep < REP_PB_ROW; ++rep) if (gw >= 128) for (int m = gw - 128; m < MT; m += 2 * (NGW - 128)) {
                  const int m2 = m + (NGW - 128); const bool has2 = m2 < MT; PBRegs r0, r1;
                  pb_row_load(A, m, lane, r0); pb_row_load(A, has2 ? m2 : m, lane, r1);
                  __builtin_amdgcn_sched_barrier(0);
                  pb_row(A, m, lane, r0); if (has2) pb_row(A, m2, lane, r1); }
              for (int u = gw; u < MS * 8; u += NGW) pb_sample_head(A, u, lane); }
            { SUB_IDS GPArgs A{PROJ, conv_w, a_log, dt_bias, GK, GQ, GKT, GVT, GG2, BETA2, l};
              for (int rep = 0; rep < REP_PB_PREP; ++rep) for (int u = gw; u < (MP / 8) * 8; u += 2 * NGW) {
                  GPRegs r0, r1; const int u2 = (u + NGW < (MP / 8) * 8) ? u + NGW : u; gdn_prep_load(A, u, lane, r0); gdn_prep_load(A, u2, lane, r1);
                  __builtin_amdgcn_sched_barrier(0);
                  gdn_prep_unit(A, u, lane, r0); gdn_prep_unit(A, u2, lane, r1); } }
            { SUB_IDS CmpArgs A{PROJ, cache_kv, page_table, cmp_pe_k, cmp_pe_v, CMPW, wsl, l};
              if (gw < 128) compress_unit(A, gw, lane);
              compress_pull(A, (unsigned*)(wsl + WS_CTL) + CW_CMPQ + 64 * l, (volatile LAS int*)(ldsl + MISC_OFF + 36), 1 << 20, tid); }
        }
        GRID_BAR(pb + 1);
        if (IN(pb + 2)) { PHASE_IDS
            GCArgs A{GK, GQ, GKT, GVT, GG2, BETA2, WX, QX, QKX, KTX, U0F, GL};
            for (int rep = 0; rep < REP_PB2; ++rep) for (int u = gw; u < 32 * 64; u += NGW) gdn_chunk_unit(A, lds + wave * GC_LDS_PER_WAVE, u, lane);
        }
        GRID_BAR(pb + 2);
        if (IN(pb + 3)) {
            { PHASE_IDS GdnArgs GA{QN, KN, VG, GG, BETA, KQ, OG, PROJ, state_gdn, gdn_norm, MIX, out, l};
                for (int rep = 0; rep < REP_GSMP; ++rep) for (int u = gw; u < NSB * 8; u += NGW) gdn_sample_unit(GA, u, lane); }
            { PHASE_IDS
                GS2Args SG{WX, QX, QKX, KTX, U0F, GL, OG, out, l};
                AttArgs AA{QB, KS, VS, KW, VW, CKP, CVP, PROJ, MIX};
                SAttArgs SA{QB, KS, VS, KW, VW, CKS, CVS, PROJ, cache_kv, page_table, state_win, MIX, l};
                unsigned* qhead = (unsigned*)(wsl + WS_CTL) + CW_QUEUE + 64 * l;
                volatile LAS int* slot = (volatile LAS int*)(ldsl + MISC_OFF + 32);
                for (;;) {
                    __syncthreads();
                    if (tid == 0) *slot = (int)__hip_atomic_fetch_add(qhead, 1u, __ATOMIC_RELAXED, __HIP_MEMORY_SCOPE_AGENT);
                    __syncthreads();
                    int u = *slot;
                    constexpr int XP = (REP_ATTP - 1) * 512, XS = (REP_ATTS - 1) * 256, XG = (REP_SCAN - 1) * 16;
                    if (u >= 784 + XP + XS + XG + 128) break;
                    if (u >= 784 + XP + XS + XG) {
                        const int sb = u - (784 + XP + XS + XG); const f32x4* src = (const f32x4*)(state_win + ((size_t)l * NSB + sb) * 512 * 256) + 256; f32x4* dst = (f32x4*)(out + O_WINS + ((size_t)l * NSB + sb) * 512 * 256);
                        for (int i = tid; i < 508 * 64; i += 8 * NWAVES * 64) { f32x4 v[8];
#pragma unroll
                            for (int k = 0; k < 8; ++k) { const int ii = i + k * NWAVES * 64; v[k] = src[ii < 508 * 64 ? ii : i]; }
#pragma unroll
                            for (int k = 0; k < 8; ++k) { const int ii = i + k * NWAVES * 64; if (ii < 508 * 64) dst[ii] = v[k]; } }
                        continue; }
                    if (u >= 784) { int v = u - 784; if (v < XP) u = 16 + (v & 511); else { v -= XP; if (v < XS) u = 528 + (v & 255); else u = (v - XS) & 15; } }
                    int tq = TID_NOW(); asm volatile("" : "+v"(tq));
                    if (u < 16) gdn_scan2_wave(SG, 2 * u + (__builtin_amdgcn_readfirstlane(tq >> 6) >> 2), __builtin_amdgcn_readfirstlane(tq >> 6) & 3, tq & 63);
                    else if (u < 16 + 512) nsa_prompt_unit(AA, lds, u - 16, tq);
                    else nsa_sample_unit(SA, lds, u - 528, tq);
                }
            }
        }
        GRID_BAR(pb + 3);
        if (IN(pb + 4)) { PHASE_IDS
            const float gnl = gdn_norm[l * 64 + lane];
            for (int rep = 0; rep < REP_LIGHT; ++rep) for (int m = gw; m < MP; m += NGW) {
                float ov[8], zv[8];
#pragma unroll
                for (int h = 0; h < 8; ++h) { ov[h] = OG[(size_t)m * 512 + h * 64 + lane]; zv[h] = PROJ[(size_t)m * NP + C_Z + h * 64 + lane]; }
                __builtin_amdgcn_sched_barrier(0);
#pragma unroll
                for (int h = 0; h < 8; ++h) { const float ms = dpp_sum(ov[h] * ov[h]) * (1.f / 64.f);
                    MIX[(size_t)m * 1024 + h * 64 + lane] = (bf16)f2bf(ov[h] * (1.f / sqrtf(ms + 1e-6f)) * gnl * siluf_(zv[h])); } }
        }
        GRID_BAR(pb + 4);
        if (IN(pb + 5)) { PHASE_IDS
            { pg8::Gemm g{MIX, WOUT_T + (size_t)l * DM * DM, MP, DM, DM, DM}; pg8::StaticOrder S; S.init(MP, DM, G, bx);
              const float* rb = (l == 0) ? x_prompt : (const float*)X2;
              pg8::EpiResid E{rb, rb, MP, X1, DM};
              pg8::gemm_phase<pg8::EpiResid, pg8::StaticOrder, true, true>(ldsl, g, S, E, tid); }
            { pg8::Gemm g{MIX, WOUT_T + (size_t)l * DM * DM, MT, DM, PD_KL, DM}; pg8::SplitKOrder S; S.init(MP / 256, MS / 256, DM / 256, PD_KS, PD_KL, G, bx);
              pg8::EpiPart E{PARTD, DM, MP, MS};
              pg8::gemm_phase<pg8::EpiPart, pg8::SplitKOrder, false, true>(ldsl, g, S, E, tid); }
        }
        GRID_BAR(pb + 5);
        if (IN(pb + 6)) { PHASE_IDS
            for (int m = gw; m < MT; m += NGW) {
                if (m < MP) rms_row(X1 + (size_t)m * DM, norm_mlp + (size_t)l * DM, HB + (size_t)m * DM, nullptr, lane);
                else { const float* bs = (l == 0) ? x_sample + (size_t)(m - MP) * DM : (const float*)X2 + (size_t)m * DM;
                    rms_row_parts(bs, PARTD + (size_t)(m - MP) * DM, PD_KS, (size_t)MS * DM, X1 + (size_t)m * DM, norm_mlp + (size_t)l * DM, HB + (size_t)m * DM, nullptr, lane); } } }
        GRID_BAR(pb + 6);
        if (IN(pb + 7)) { PHASE_IDS
            pg8::Gemm g{HB, WUP_T + (size_t)l * DFF * DM, MT, DFF, DM, DM}; pg8::StaticOrder S; S.init(MT, DFF, G, bx);
            pg8::EpiRelu2 E{HID, DFF};
            pg8::gemm_phase<pg8::EpiRelu2, pg8::StaticOrder, true, true>(ldsl, g, S, E, tid);
            if (l + 1 < NL && bx >= (MT / 256) * (DFF / 256) % G) { SUB_IDS CmpArgs CA{PROJ, cache_kv, page_table, cmp_pe_k, cmp_pe_v, CMPW, wsl, l + 1};
                compress_pull(CA, (unsigned*)(wsl + WS_CTL) + CW_CMPQ + 64 * (l + 1), (volatile LAS int*)(ldsl + MISC_OFF + 36), 1, tid); }
        }
        GRID_BAR(pb + 7);
        if (IN(pb + 8)) { PHASE_IDS
            { pg8::Gemm g{HID, WDN_T + (size_t)l * DM * DFF, MP, DM, DFF, DFF}; pg8::StaticOrder S; S.init(MP, DM, G, bx);
              pg8::EpiResid E{X1, X1, MP, X2, DM};
              pg8::gemm_phase<pg8::EpiResid, pg8::StaticOrder, true, true>(ldsl, g, S, E, tid); }
            { pg8::Gemm g{HID, WDN_T + (size_t)l * DM * DFF, MT, DM, PG_KL, DFF}; pg8::SplitKOrder S; S.init(MP / 256, MS / 256, DM / 256, PG_KS, PG_KL, G, bx);
              pg8::EpiPart E{PARTG, DM, MP, MS};
              pg8::gemm_phase<pg8::EpiPart, pg8::SplitKOrder, false, true>(ldsl, g, S, E, tid); }
        }
        GRID_BAR(pb + 8);
        if (IN(pb + 9)) { PHASE_IDS
            for (int m = gw; m < MT; m += NGW) {
                const float* gn = (l + 1 < NL) ? norm_mix + (size_t)(l + 1) * DM : norm_final;
                bf16* ob = (l + 1 < NL) ? HB + (size_t)m * DM : nullptr; float* of = (l + 1 < NL) ? nullptr : out + O_YP + (size_t)m * DM;
                if (m < MP) rms_row(X2 + (size_t)m * DM, gn, ob, of, lane);
                else rms_row_parts(X1 + (size_t)m * DM, PARTG + (size_t)(m - MP) * DM, PG_KS, (size_t)MS * DM, X2 + (size_t)m * DM, gn, ob, of, lane);
            }
        }
        GRID_BAR(pb + 9);
    }
#undef IN
}

#undef x_prompt
#undef x_sample
#undef cache_kv
#undef page_table
#undef state_win
#undef state_gdn
#undef state_conv
#undef norm_mix
#undef w_in
#undef conv_w
#undef a_log
#undef dt_bias
#undef gdn_norm
#undef cmp_pe_k
#undef cmp_w_k
#undef cmp_pe_v
#undef cmp_w_v
#undef w_out
#undef norm_mlp
#undef w_up
#undef w_down
#undef norm_final
#undef out
#ifndef MK_PER_PHASE
#define MK_PER_PHASE 0
#endif
typedef void (*kfn_t)(Args); static const kfn_t K_ALL = hymba_fwd;
extern "C" void kernel_launch(void* const* d_in, const int* in_sizes, int n_in, void* d_out, int out_size, void* d_ws, size_t ws_size, hipStream_t stream) {
    static int grid = 0;
    if (grid == 0) {
        if (n_in != 22 || out_size != (int)O_END || ws_size < WS_END) { fprintf(stderr, "kernel_launch: unexpected shapes (n_in %d, out %d, ws %zu)\n", n_in, out_size, ws_size); grid = -1; return; }
        int dev = 0, cus = 0, per_cu = 0;
        if (hipGetDevice(&dev) != hipSuccess || hipDeviceGetAttribute(&cus, hipDeviceAttributeMultiprocessorCount, dev) != hipSuccess) { grid = -1; return; }
        if (hipFuncSetAttribute((const void*)K_ALL, hipFuncAttributeMaxDynamicSharedMemorySize, LDS_BYTES) != hipSuccess) { fprintf(stderr, "kernel_launch: hipFuncSetAttribute failed\n"); grid = -1; return; }
        if (hipOccupancyMaxActiveBlocksPerMultiprocessor(&per_cu, (const void*)K_ALL, NWAVES * 64, LDS_BYTES) != hipSuccess || per_cu < 1) { fprintf(stderr, "kernel_launch: occupancy query says %d blocks per CU\n", per_cu); }
        (void)hipGetLastError();
        grid = cus;
    }
    if (grid < 0) return;
    (void)hipMemsetAsync((char*)d_ws + WS_CTL, 0, CTL_ZERO_BYTES, stream);
    Args a{};
    for (int i = 0; i < 22; ++i) a.in[i] = (const GAS void*)d_in[i];
    a.out = (GAS float*)d_out; a.ws = (GAS unsigned char*)d_ws;
    const dim3 g(grid), b(NWAVES * 64);
#if MK_PER_PHASE
    for (int ph = 0; ph < N_PHASES; ++ph) { a.ph_lo = ph; a.ph_hi = ph + 1; K_ALL<<<g, b, LDS_BYTES, stream>>>(a); }
#else
    a.ph_lo = 0; a.ph_hi = N_PHASES; K_ALL<<<g, b, LDS_BYTES, stream>>>(a);
#endif
}
```

```cpp
#include <hip/hip_runtime.h>
#include <cstdio>
#include <cstdint>
namespace pg8 {
#define PG8_LAS __attribute__((address_space(3)))
typedef unsigned short bf16_t;
typedef short bf16x8 __attribute__((ext_vector_type(8)));
typedef float f32x4 __attribute__((ext_vector_type(4)));
typedef unsigned u32x4 __attribute__((ext_vector_type(4)));
constexpr int BM = 256, BK = 64, HALF = 128, HTB = HALF * BK * 2  , STAGE_BYTES = 8 * HTB, NXCD = 8, WGM = 8;

__host__ __device__ __forceinline__ int lds_byte(int r, int c) { const int st = (r >> 4) * 2 + (c >> 5), rr = r & 15, cc = c & 31, ob = rr * 64 + cc * 2; return st * 1024 + (ob ^ (((ob >> 9) & 1) << 5)); }
__host__ __device__ __forceinline__ void stage_rc(int b, int& R, int& C) { const int st = b / 1024, sb = b % 1024, swz = sb ^ (((sb >> 9) & 1) << 5); R = (st >> 1) * 16 + swz / 64; C = (st & 1) * 32 + (swz % 64) / 2; }
__host__ __device__ __forceinline__ int perm32(int rho) { const int n = rho >> 4, i = rho & 15; return 8 * (i >> 2) + 4 * n + (i & 3); }

struct Unit { int pm, pn, kofs, kc; };
struct Gemm { const bf16_t* A; const bf16_t* Bt; int M, N, K, ld; };

struct StaticOrder {
    int nM, nN, nwg, G, c;
    __host__ __device__ void init(int M, int N, int G_, int c_) { nM = M / BM; nN = N / BM; nwg = nM * nN; G = G_; c = c_; }
    __host__ __device__ bool next(int i, Unit& u) const {
        const long L = (long)i * G + c; if (L >= nwg) return false;
        int wgid = (int)L; { const int q = nwg / NXCD, r = nwg % NXCD, xcd = wgid % NXCD, off = wgid / NXCD; wgid = (xcd < r ? xcd * (q + 1) : r * (q + 1) + (xcd - r) * q) + off; }
        const int nig = WGM * nN, gid = wgid / nig, fm = gid * WGM, gsz = (nM - fm) < WGM ? (nM - fm) : WGM;
        u.pm = fm + ((wgid % nig) % gsz); u.pn = (wgid % nig) / gsz; u.kofs = 0; u.kc = 0; return true;
    }
    __device__ __forceinline__ void a_ready(const Unit&) const {}
    __device__ __forceinline__ void done(const Unit&) const {}
};

__device__ __forceinline__ unsigned cvt_pk_bf16(float lo, float hi) { unsigned r; asm volatile("v_cvt_pk_bf16_f32 %0, %1, %2" : "=v"(r) : "v"(lo), "v"(hi)); return r; }

struct EpiF32 {
    static constexpr bool PERM = false, AFTER_DRAIN = false;
    float* O; int ldc;
    __device__ __forceinline__ void operator()(const f32x4 (&acc)[2][2][4][2], const Unit& u, int wr, int wc, int fr, int fq) const {
        const int row0 = u.pm * BM + wr * 64 + fr, col0 = u.pn * BM + wc * 32 + 4 * fq;
#pragma unroll
        for (int ai = 0; ai < 2; ++ai)
#pragma unroll
            for (int m = 0; m < 4; ++m) { float* rowp = O + (size_t)(row0 + ai * HALF + m * 16) * ldc + col0;
#pragma unroll
                for (int bj = 0; bj < 2; ++bj)
#pragma unroll
                    for (int n = 0; n < 2; ++n) *(f32x4*)(rowp + bj * HALF + n * 16) = acc[ai][bj][m][n]; }
    }
};
struct EpiResid {
    static constexpr bool PERM = false, AFTER_DRAIN = false;
    const float* base; const float* base2; int split_row; float* O; int ldc;
    __device__ __forceinline__ void operator()(const f32x4 (&acc)[2][2][4][2], const Unit& u, int wr, int wc, int fr, int fq) const {
        const int row0 = u.pm * BM + wr * 64 + fr, col0 = u.pn * BM + wc * 32 + 4 * fq;
        const float* bs = (u.pm * BM >= split_row) ? (base2 - (size_t)split_row * ldc) : base;
#pragma unroll
        for (int ai = 0; ai < 2; ++ai)
#pragma unroll
            for (int m = 0; m < 4; ++m) { const size_t off = (size_t)(row0 + ai * HALF + m * 16) * ldc + col0;
#pragma unroll
                for (int bj = 0; bj < 2; ++bj)
#pragma unroll
                    for (int n = 0; n < 2; ++n) { const f32x4 r = *(const f32x4*)(bs + off + bj * HALF + n * 16); *(f32x4*)(O + off + bj * HALF + n * 16) = r + acc[ai][bj][m][n]; } }
    }
};
struct EpiRelu2 {
    static constexpr bool PERM = true, AFTER_DRAIN = false;
    bf16_t* O; int ldc;
    __device__ __forceinline__ void operator()(const f32x4 (&acc)[2][2][4][2], const Unit& u, int wr, int wc, int fr, int fq) const {
        const int row0 = u.pm * BM + wr * 64 + fr, col0 = u.pn * BM + wc * 32 + 8 * fq;
#pragma unroll
        for (int ai = 0; ai < 2; ++ai)
#pragma unroll
            for (int m = 0; m < 4; ++m) { bf16_t* rowp = O + (size_t)(row0 + ai * HALF + m * 16) * ldc + col0;
#pragma unroll
                for (int bj = 0; bj < 2; ++bj) { f32x4 v0 = acc[ai][bj][m][0], v1 = acc[ai][bj][m][1];
#pragma unroll
                    for (int i = 0; i < 4; ++i) { const float a = v0[i] > 0.f ? v0[i] : 0.f, b = v1[i] > 0.f ? v1[i] : 0.f; v0[i] = a * a; v1[i] = b * b; }
                    u32x4 w; w.x = cvt_pk_bf16(v0[0], v0[1]); w.y = cvt_pk_bf16(v0[2], v0[3]); w.z = cvt_pk_bf16(v1[0], v1[1]); w.w = cvt_pk_bf16(v1[2], v1[3]);
                    *(u32x4*)(rowp + bj * HALF) = w; } }
    }
};

struct SplitKOrder {
    int pm0, nN, KS, KL, total, G, c;
    __host__ __device__ void init(int pm0_, int nPm, int nN_, int KS_, int KL_, int G_, int c_) { pm0 = pm0_; nN = nN_; KS = KS_; KL = KL_; total = nPm * nN_ * KS_; G = G_; c = c_; }
    __host__ __device__ bool next(int i, Unit& u) const {
        const long L = (long)i * G + c; if (L >= total) return false;
        const int l = (int)L, kc = l % KS, rest = l / KS; u.pn = rest % nN; u.pm = pm0 + rest / nN; u.kofs = kc * KL; u.kc = kc; return true; }
    __device__ __forceinline__ void a_ready(const Unit&) const {}
    __device__ __forceinline__ void done(const Unit&) const {}
};
struct EpiPart {
    static constexpr bool PERM = false, AFTER_DRAIN = false;
    float* P; int ldc; int row0; int rows;
    __device__ __forceinline__ void operator()(const f32x4 (&acc)[2][2][4][2], const Unit& u, int wr, int wc, int fr, int fq) const {
        const int rowl = u.pm * BM - row0 + wr * 64 + fr, col0 = u.pn * BM + wc * 32 + 4 * fq;
        float* base = P + (size_t)u.kc * rows * ldc;
#pragma unroll
        for (int ai = 0; ai < 2; ++ai)
#pragma unroll
            for (int m = 0; m < 4; ++m) { float* rowp = base + (size_t)(rowl + ai * HALF + m * 16) * ldc + col0;
#pragma unroll
                for (int bj = 0; bj < 2; ++bj)
#pragma unroll
                    for (int n = 0; n < 2; ++n) *(f32x4*)(rowp + bj * HALF + n * 16) = acc[ai][bj][m][n]; }
    }
};
template <class Epi, class Sched, bool ALIGN_EPI = false, bool SP2 = false>
__device__ __forceinline__ void gemm_phase(PG8_LAS unsigned char* lds, const Gemm g, const Sched& S, const Epi& E, int tid_in) {
    int tid = tid_in; asm volatile("" : "+v"(tid));
    const int wid = __builtin_amdgcn_readfirstlane(tid >> 6), lane = tid & 63, wr = wid >> 2, wc = wid & 3, fr = lane & 15, fq = lane >> 4;
    const int K = g.ld, nt = g.K / BK;
    unsigned voffA[2], voffB[2];
#pragma unroll
    for (int i = 0; i < 2; ++i) { int R, C; stage_rc(tid * 16 + i * 8192, R, C); const int Rb = Epi::PERM ? ((R & ~31) + perm32(R & 31)) : R;
        voffA[i] = (unsigned)(R * K + C) * 2u; voffB[i] = (unsigned)(Rb * K + C) * 2u; }
    const size_t kstep = (size_t)(BK * 2);
    const size_t hstep = (size_t)HALF * K * 2;
    const size_t tstep = 2 * hstep;
    const unsigned ldsw = (unsigned)wid * 1024u;
    const int aoff = lds_byte(wr * 64 + fr, fq * 8), boff = lds_byte(wc * 32 + fr, fq * 8);
#define PG8_SA(b, h) (((b) * 2 + (h)) * HTB)
#define PG8_SB(b, h) ((4 + (b) * 2 + (h)) * HTB)
#define PG8_STAGE(bufoff, gbase, voff) do { _Pragma("unroll") for (int _i = 0; _i < 2; ++_i) \
        __builtin_amdgcn_global_load_lds((const unsigned*)((const char*)(gbase) + (voff)[_i]), (PG8_LAS unsigned*)(lds + (bufoff) + ldsw + _i * 8192), 16, 0, 0); } while (0)
#define PG8_LDA(dst, b, h) do { _Pragma("unroll") for (int m = 0; m < 4; ++m) _Pragma("unroll") for (int k = 0; k < 2; ++k) dst[m][k] = *(const PG8_LAS bf16x8*)(lds + PG8_SA(b, h) + aoff + m * 2048 + k * 1024); } while (0)
#define PG8_LDB(dst, b, h) do { _Pragma("unroll") for (int n = 0; n < 2; ++n) _Pragma("unroll") for (int k = 0; k < 2; ++k) dst[n][k] = *(const PG8_LAS bf16x8*)(lds + PG8_SB(b, h) + boff + n * 2048 + k * 1024); } while (0)
#define PG8_MMA(ai, bj, At, Bt) do { __builtin_amdgcn_s_setprio(1); _Pragma("unroll") for (int m = 0; m < 4; ++m) _Pragma("unroll") for (int n = 0; n < 2; ++n) _Pragma("unroll") for (int k = 0; k < 2; ++k) \
        acc[ai][bj][m][n] = __builtin_amdgcn_mfma_f32_16x16x32_bf16(Bt[n][k], At[m][k], acc[ai][bj][m][n], 0, 0, 0); __builtin_amdgcn_s_setprio(0); } while (0)
#define PG8_WAIT_V(n) asm volatile("s_waitcnt vmcnt(" #n ")" ::: "memory")
#define PG8_WAIT_L(n) asm volatile("s_waitcnt lgkmcnt(" #n ")" ::: "memory")
#define PG8_BAR __builtin_amdgcn_s_barrier()
#define PG8_SCHED __builtin_amdgcn_sched_barrier(0)
    Unit cur, nxt; int ui = 0;
    if (!S.next(0, cur)) return;
    f32x4 acc[2][2][4][2];
#pragma unroll
    for (int a = 0; a < 2; ++a)
#pragma unroll
        for (int b = 0; b < 2; ++b)
#pragma unroll
            for (int m = 0; m < 4; ++m)
#pragma unroll
                for (int n = 0; n < 2; ++n) acc[a][b][m][n] = (f32x4){0.f, 0.f, 0.f, 0.f};
    bf16x8 At[4][2], B0[2][2], B1[2][2];
    const char* cA = (const char*)g.A + (size_t)cur.pm * tstep + (size_t)cur.kofs * 2; const char* cB = (const char*)g.Bt + (size_t)cur.pn * tstep + (size_t)cur.kofs * 2;
    S.a_ready(cur);
    if constexpr (SP2) {
        PG8_STAGE(PG8_SB(0, 0), cB, voffB); PG8_STAGE(PG8_SB(0, 1), cB + hstep, voffB); PG8_STAGE(PG8_SA(0, 0), cA, voffA); PG8_STAGE(PG8_SA(0, 1), cA + hstep, voffA);
        if (wr == 1) PG8_BAR;
        PG8_WAIT_V(2); PG8_BAR;
        PG8_STAGE(PG8_SB(1, 0), cB + kstep, voffB); PG8_STAGE(PG8_SA(1, 0), cA + kstep, voffA); PG8_STAGE(PG8_SB(1, 1), cB + hstep + kstep, voffB);
        PG8_WAIT_V(6); PG8_BAR;
    } else {
        PG8_STAGE(PG8_SB(0, 0), cB, voffB); PG8_STAGE(PG8_SA(0, 0), cA, voffA); PG8_STAGE(PG8_SB(0, 1), cB + hstep, voffB); PG8_STAGE(PG8_SA(0, 1), cA + hstep, voffA);
        if (wr == 1) PG8_BAR;
        PG8_WAIT_V(4); PG8_BAR;
        PG8_STAGE(PG8_SB(1, 0), cB + kstep, voffB); PG8_STAGE(PG8_SA(1, 0), cA + kstep, voffA); PG8_STAGE(PG8_SB(1, 1), cB + hstep + kstep, voffB);
        PG8_WAIT_V(6); PG8_BAR;
    }
    for (;;) {
        const bool has_next = S.next(ui + 1, nxt);
        const char* nA = has_next ? (const char*)g.A + (size_t)nxt.pm * tstep + (size_t)nxt.kofs * 2 : cA; const char* nB = has_next ? (const char*)g.Bt + (size_t)nxt.pn * tstep + (size_t)nxt.kofs * 2 : cB;
        for (int t = 0; t < nt; t += 2) {
            const bool last = (t == nt - 2);
            const char* a1 = cA + (size_t)(t + 1) * kstep;
            const char* a2 = last ? nA : cA + (size_t)(t + 2) * kstep; const char* b2 = last ? nB : cB + (size_t)(t + 2) * kstep;
            const char* a3 = a2 + kstep; const char* b3 = b2 + kstep;
            if (last && has_next) S.a_ready(nxt);
            if constexpr (SP2) {
            PG8_LDB(B0, 0, 0); PG8_LDB(B1, 0, 1); PG8_SCHED; PG8_LDA(At, 0, 0); PG8_STAGE(PG8_SA(1, 1), a1 + hstep, voffA);
            PG8_WAIT_V(8); PG8_WAIT_L(0); PG8_BAR; PG8_MMA(0, 0, At, B0); PG8_MMA(0, 1, At, B1); PG8_BAR; PG8_SCHED;
            PG8_LDA(At, 0, 1); PG8_STAGE(PG8_SB(0, 0), b2, voffB); PG8_STAGE(PG8_SB(0, 1), b2 + hstep, voffB); PG8_STAGE(PG8_SA(0, 0), a2, voffA);
            PG8_WAIT_V(8); PG8_WAIT_L(0); PG8_BAR; PG8_MMA(1, 0, At, B0); PG8_MMA(1, 1, At, B1); PG8_BAR; PG8_SCHED;
            PG8_LDB(B0, 1, 0); PG8_LDB(B1, 1, 1); PG8_SCHED; PG8_LDA(At, 1, 0); PG8_STAGE(PG8_SA(0, 1), a2 + hstep, voffA);
            PG8_WAIT_V(8); PG8_WAIT_L(0); PG8_BAR; PG8_MMA(0, 0, At, B0); PG8_MMA(0, 1, At, B1); PG8_BAR; PG8_SCHED;
            PG8_LDA(At, 1, 1); PG8_STAGE(PG8_SB(1, 0), b3, voffB); PG8_STAGE(PG8_SB(1, 1), b3 + hstep, voffB); PG8_STAGE(PG8_SA(1, 0), a3, voffA);
            PG8_WAIT_V(8); PG8_WAIT_L(0); PG8_BAR; PG8_MMA(1, 0, At, B0); PG8_MMA(1, 1, At, B1); PG8_BAR; PG8_SCHED;
            } else {
            PG8_LDB(B0, 0, 0); PG8_SCHED; PG8_LDA(At, 0, 0); PG8_STAGE(PG8_SA(1, 1), a1 + hstep, voffA);
            PG8_WAIT_L(8); PG8_BAR; PG8_WAIT_L(0); PG8_MMA(0, 0, At, B0); PG8_BAR; PG8_SCHED;
            PG8_LDB(B1, 0, 1); PG8_STAGE(PG8_SB(0, 0), b2, voffB);
            PG8_BAR; PG8_WAIT_L(0); PG8_MMA(0, 1, At, B1); PG8_BAR;
            PG8_LDA(At, 0, 1); PG8_STAGE(PG8_SA(0, 0), a2, voffA);
            PG8_BAR; PG8_WAIT_L(0); PG8_MMA(1, 0, At, B0); PG8_BAR; PG8_SCHED;
            PG8_STAGE(PG8_SB(0, 1), b2 + hstep, voffB);
            PG8_WAIT_V(6); PG8_BAR; PG8_MMA(1, 1, At, B1); PG8_BAR;
            PG8_LDB(B0, 1, 0); PG8_SCHED; PG8_LDA(At, 1, 0); PG8_STAGE(PG8_SA(0, 1), a2 + hstep, voffA);
            PG8_WAIT_L(8); PG8_BAR; PG8_WAIT_L(0); PG8_MMA(0, 0, At, B0); PG8_BAR; PG8_SCHED;
            PG8_LDB(B1, 1, 1); PG8_STAGE(PG8_SB(1, 0), b3, voffB);
            PG8_BAR; PG8_WAIT_L(0); PG8_MMA(0, 1, At, B1); PG8_BAR;
            PG8_LDA(At, 1, 1); PG8_STAGE(PG8_SA(1, 0), a3, voffA);
            PG8_BAR; PG8_WAIT_L(0); PG8_MMA(1, 0, At, B0); PG8_BAR; PG8_SCHED;
            PG8_STAGE(PG8_SB(1, 1), b3 + hstep, voffB);
            PG8_WAIT_V(6); PG8_BAR; PG8_MMA(1, 1, At, B1); PG8_BAR;
            }
        }
        if constexpr (ALIGN_EPI) { if (wr == 0) PG8_BAR; }
        if constexpr (!Epi::AFTER_DRAIN) { E(acc, cur, wr, wc, fr, fq); S.done(cur); }
        if (!has_next) break;
#pragma unroll
        for (int a = 0; a < 2; ++a)
#pragma unroll
            for (int b = 0; b < 2; ++b)
#pragma unroll
                for (int m = 0; m < 4; ++m)
#pragma unroll
                    for (int n = 0; n < 2; ++n) acc[a][b][m][n] = (f32x4){0.f, 0.f, 0.f, 0.f};
        cur = nxt; cA = nA; cB = nB; ++ui;
        if constexpr (ALIGN_EPI) { if (wr == 1) PG8_BAR; }
    }
    PG8_WAIT_V(0);
    if constexpr (!ALIGN_EPI) { if (wr == 0) PG8_BAR; }
    PG8_BAR;
    if constexpr (Epi::AFTER_DRAIN) { E.fused(acc, cur, wr, wc, fr, fq, lds, wid, lane); S.done(cur); }
#undef PG8_SA
#undef PG8_SB
#undef PG8_STAGE
#undef PG8_LDA
#undef PG8_LDB
#undef PG8_MMA
#undef PG8_WAIT_V
#undef PG8_WAIT_L
#undef PG8_BAR
#undef PG8_SCHED
}
}

constexpr int DM = 1024, NPB = 4, SEQ = 4096, MP = NPB * SEQ, NSB = 128, DSEQ = 4, MS = NSB * DSEQ, MT = MP + MS;
constexpr int NPROJ = 3368, NP = 3584, DFF = 4096, NL = 2;
constexpr int C_QKV = 0, C_Z = 1536, C_A = 2048, C_BETA = 2056, C_Q = 2064, C_KV = 2576, C_GATE = 3344;
constexpr int PAST = 2048, NPAGES = 16, NPOOL = 2560;
constexpr float C2 = 0.125f * 1.4426950408889634f;
constexpr float NEG_INF = -__builtin_inff();
constexpr size_t O_YP = 0, O_YS = 16777216, O_KVP = 17301504, O_KVS = 34078720, O_WINP = 34603008, O_WINS = 35651584, O_GDNP = 69206016, O_GDNS = 69468160, O_CONVP = 77856768, O_CONVS = 77893632, O_END = 79073280;
constexpr size_t MiB = 1u << 20;
constexpr size_t WS_CTL = 0, CTL_ZERO_BYTES = 1 * MiB;
constexpr size_t WS_WIN = 2 * MiB, WS_WOUT = 16 * MiB, WS_WUP = 20 * MiB, WS_WDN = 36 * MiB, WS_CMPW = 52 * MiB;
constexpr size_t WS_HB = 54 * MiB, WS_PROJ = 88 * MiB, WS_X1 = 320 * MiB, WS_X2 = 386 * MiB, WS_MIX = 452 * MiB, WS_HID = 486 * MiB;
constexpr size_t WS_QN = 618 * MiB, WS_KN = 651 * MiB, WS_VG = 684 * MiB, WS_OG = 717 * MiB, WS_G = 750 * MiB, WS_BETA = 751 * MiB, WS_KQ = 752 * MiB;
constexpr size_t WS_QB = 753 * MiB, WS_KS = 770 * MiB, WS_VS = 775 * MiB, WS_KW = 780 * MiB, WS_VW = 785 * MiB;
constexpr size_t WS_CKP = 790 * MiB, WS_CVP = 791 * MiB, WS_CKS = 792 * MiB, WS_CVS = 796 * MiB;
constexpr size_t WS_GK = 800 * MiB, WS_GQ = 816 * MiB, WS_GKT = 832 * MiB, WS_GVT = 848 * MiB, WS_GG2 = 864 * MiB, WS_BETA2 = 865 * MiB;
constexpr size_t WS_WX = 866 * MiB, WS_QX = 882 * MiB, WS_QKX = 898 * MiB, WS_KTX = 914 * MiB, WS_U0F = 930 * MiB, WS_GL = 962 * MiB, WS_END = 1043 * MiB;
constexpr size_t WS_PARTD = 963 * MiB, WS_PARTG = 979 * MiB;
constexpr int PD_KS = 4, PD_KL = DM / PD_KS, PG_KS = 8, PG_KL = DFF / PG_KS;
constexpr int CW_QUEUE = 64;
constexpr int CW_BAR = 4096;
constexpr int RING_BYTES = 131072, LDS_BYTES = 147456, MISC_OFF = LDS_BYTES - 64;
constexpr int NWAVES = 8;

#define GAS __attribute__((address_space(1)))
#define LAS __attribute__((address_space(3)))
typedef unsigned short bf16;
typedef unsigned v4u __attribute__((ext_vector_type(4)));
typedef unsigned v2u __attribute__((ext_vector_type(2)));
typedef float f32x4 __attribute__((ext_vector_type(4)));
typedef float f32x16 __attribute__((ext_vector_type(16)));
typedef short bf16x8 __attribute__((ext_vector_type(8)));
typedef short s16x4 __attribute__((ext_vector_type(4)));
#define LDS_WAIT() asm volatile("s_waitcnt lgkmcnt(0)" ::: "memory")
__device__ __forceinline__ unsigned f2bf(float f) { unsigned u = __builtin_bit_cast(unsigned, f); return (u + 0x7fffu + ((u >> 16) & 1u)) >> 16; }
__device__ __forceinline__ unsigned pk2(float lo, float hi) { return f2bf(lo) | (f2bf(hi) << 16); }
__device__ __forceinline__ float bf2f(unsigned short b) { return __builtin_bit_cast(float, (unsigned)b << 16); }
__device__ __forceinline__ bf16x8 pack8(float a0, float a1, float a2, float a3, float a4, float a5, float a6, float a7) {
    v4u w; w.x = pk2(a0, a1); w.y = pk2(a2, a3); w.z = pk2(a4, a5); w.w = pk2(a6, a7); return __builtin_bit_cast(bf16x8, w); }
__device__ __forceinline__ float wave_sum(float v) {
#pragma unroll
    for (int o = 1; o < 64; o <<= 1) v += __shfl_xor(v, o);
    return v;
}
template <int CTRL, int RMASK> __device__ __forceinline__ float dpp_add(float v) {
    const int t = __builtin_amdgcn_update_dpp(0, __builtin_bit_cast(int, v), CTRL, RMASK, 0xf, false);
    return v + __builtin_bit_cast(float, t);
}
__device__ __forceinline__ float dpp_sum(float v) {
    v = dpp_add<0x111, 0xf>(v); v = dpp_add<0x112, 0xf>(v); v = dpp_add<0x114, 0xf>(v); v = dpp_add<0x118, 0xf>(v);
    v = dpp_add<0x142, 0xa>(v); v = dpp_add<0x143, 0xc>(v);
    return __builtin_bit_cast(float, __builtin_amdgcn_readlane(__builtin_bit_cast(int, v), 63));
}
__device__ __forceinline__ float ex2(float x) { return __builtin_amdgcn_exp2f(x); }
__device__ __forceinline__ float sigmoidf_(float x) { return 1.f / (1.f + __expf(-x)); }
__device__ __forceinline__ float siluf_(float x) { return x / (1.f + __expf(-x)); }
__device__ __forceinline__ int crow(int r, int hi) { return (r & 3) + 8 * (r >> 2) + 4 * hi; }
__device__ __forceinline__ void rope_cs(int pos, int d, float& cs, float& sn) {
    const float invf = exp2f(-(float)d * 0.4152410118609203f);
    double rv = (double)pos * (double)invf * 0.15915494309189535; rv -= floor(rv);
    const float rf = (float)rv; sn = __builtin_amdgcn_sinf(rf); cs = __builtin_amdgcn_cosf(rf);
}

#define XB_TMO      128
#define XB_XCNT(j)  (256  + 64 * (j))
#define XB_XSUB(j)  (1280 + 64 * (j))
#define XB_XGEN(j)  (2304 + 64 * (j))
#define XB_TOP      3328
#define XB_TOPGEN   3392
#define XCD_BAR_WORDS 3456
#define XB_SPIN_CAP (1u << 18)

__device__ __forceinline__ unsigned xb_ld(unsigned* p)              { return __hip_atomic_load(p, __ATOMIC_RELAXED, __HIP_MEMORY_SCOPE_AGENT); }
__device__ __forceinline__ unsigned xb_add(unsigned* p, unsigned v) { return __hip_atomic_fetch_add(p, v, __ATOMIC_RELAXED, __HIP_MEMORY_SCOPE_AGENT); }
__device__ __forceinline__ unsigned xb_xcc_id() { return (unsigned)__builtin_amdgcn_s_getreg((3 << 11) | 20) & 0xFu; }
#define XB_SPIN(cond, bar) do { unsigned _sp = 0; while (cond) { __builtin_amdgcn_s_sleep(1); \
    if ((++_sp & 255u) == 0u) { if (xb_ld(&(bar)[XB_TMO])) break; if (_sp > XB_SPIN_CAP) { atomicAdd(&(bar)[XB_TMO], 1u); break; } } } } while (0)

struct XcdBarrier {
    unsigned* bar; unsigned x;
    volatile LAS unsigned* st;
};

__device__ __forceinline__ XcdBarrier xcd_barrier_post(unsigned* bar, volatile LAS unsigned* st, bool leader) {
    XcdBarrier b; b.bar = bar; b.x = xb_xcc_id(); b.st = st;
    if (leader) (void)xb_add(&bar[XB_XCNT(b.x)], 1u);
    return b;
}
__device__ __forceinline__ void xcd_barrier_complete(unsigned* bar, unsigned x, unsigned& nloc, unsigned& nx) {
    const unsigned G = gridDim.x * gridDim.y * gridDim.z;
    unsigned sum, cnt, mine, sp = 0u;
    for (;;) {
        sum = 0u; cnt = 0u; mine = 0u;
#pragma unroll
        for (unsigned j = 0; j < 16; ++j) { const unsigned c = xb_ld(&bar[XB_XCNT(j)]); sum += c; cnt += (c > 0u) ? 1u : 0u; mine = (j == x) ? c : mine; }
        if (sum == G) break;
        __builtin_amdgcn_s_sleep(1);
        if ((++sp & 255u) == 0u) { if (xb_ld(&bar[XB_TMO])) break; if (sp > XB_SPIN_CAP) { atomicAdd(&bar[XB_TMO], 1u); break; } }
    }
    nloc = mine > 0u ? mine : 1u; nx = cnt > 0u ? cnt : 1u;
}

__device__ __forceinline__ void xcd_barrier(const XcdBarrier& b, bool leader) {
    asm volatile("s_waitcnt vmcnt(0)" ::: "memory");
    __syncthreads();
    if (leader) {
        unsigned* bar = b.bar;
        __builtin_amdgcn_s_waitcnt(0);
        unsigned nloc = b.st[0], nx = b.st[1];
        if (nloc == 0u) { xcd_barrier_complete(bar, b.x, nloc, nx); b.st[0] = nloc; b.st[1] = nx; }
        const unsigned old = xb_add(&bar[XB_XSUB(b.x)], 1u);
        const unsigned gen = old / nloc;
        if (old + 1u == (gen + 1u) * nloc) {
            __builtin_amdgcn_fence(__ATOMIC_RELEASE, "agent");
            asm volatile("s_waitcnt vmcnt(0)" ::: "memory");
            const unsigned og = xb_add(&bar[XB_TOP], 1u);
            const unsigned tg = og / nx;
            if (og + 1u == (tg + 1u) * nx) xb_add(&bar[XB_TOPGEN], 1u);
            else XB_SPIN(xb_ld(&bar[XB_TOPGEN]) == tg, bar);
            __builtin_amdgcn_fence(__ATOMIC_ACQUIRE, "agent");
            xb_add(&bar[XB_XGEN(b.x)], 1u);
            asm volatile("s_waitcnt vmcnt(0)" ::: "memory");
        } else {
            XB_SPIN(xb_ld(&bar[XB_XGEN(b.x)]) == gen, bar);
            __builtin_amdgcn_fence(__ATOMIC_ACQUIRE, "agent");
            asm volatile("s_waitcnt vmcnt(0)" ::: "memory");
        }
    }
    __syncthreads();
}

__device__ __forceinline__ void transpose_item(const float* W, int K, int N, int Npad, bf16* WT, LAS float* scr, int item, int lane) {
    const int nblk = Npad / 32, kb = item / nblk, nb = item % nblk, k0 = 64 * kb, n0 = 32 * nb;
    const int ncol = n0 + (lane & 31);
#pragma unroll 8
    for (int i = 0; i < 32; ++i) { const int kk = 2 * i + (lane >> 5); scr[kk * 33 + (lane & 31)] = (ncol < N) ? W[(size_t)(k0 + kk) * N + ncol] : 0.f; }
    LDS_WAIT(); asm volatile("" ::: "memory");
    const int c = lane & 7;
#pragma unroll
    for (int j = 0; j < 4; ++j) { const int n = (lane >> 3) + 8 * j; const LAS float* s = scr + (8 * c) * 33 + n;
        v4u o; o.x = pk2(s[0 * 33], s[1 * 33]); o.y = pk2(s[2 * 33], s[3 * 33]); o.z = pk2(s[4 * 33], s[5 * 33]); o.w = pk2(s[6 * 33], s[7 * 33]);
        *(v4u*)(WT + (size_t)(n0 + n) * K + k0 + 8 * c) = o; }
    LDS_WAIT(); asm volatile("" ::: "memory");
}
__device__ __forceinline__ void rms_row(const float* xrow, const float* g, bf16* orow, float* of32, int lane) {
    const f32x4* xr = (const f32x4*)xrow + lane;
    f32x4 v[4]; float s = 0.f;
#pragma unroll
    for (int j = 0; j < 4; ++j) { v[j] = xr[64 * j]; s += (v[j].x * v[j].x + v[j].y * v[j].y) + (v[j].z * v[j].z + v[j].w * v[j].w); }
    const float rstd = 1.f / sqrtf(wave_sum(s) * (1.f / DM) + 1e-6f);
#pragma unroll
    for (int j = 0; j < 4; ++j) { const f32x4 gg = ((const f32x4*)g)[64 * j + lane]; const f32x4 o = v[j] * rstd * gg;
        if (of32) ((f32x4*)of32)[64 * j + lane] = o;
        else ((v2u*)orow)[64 * j + lane] = (v2u){pk2(o.x, o.y), pk2(o.z, o.w)}; }
}

__device__ __forceinline__ void rms_row2(const float* xa, const float* xb, const float* g, bf16* oa, bf16* ob, float* fa, float* fb, int lane) {
    f32x4 va[4], vb[4];
#pragma unroll
    for (int j = 0; j < 4; ++j) { va[j] = ((const f32x4*)xa)[64 * j + lane]; vb[j] = ((const f32x4*)xb)[64 * j + lane]; }
    __builtin_amdgcn_sched_barrier(0);
    float sa = 0.f, sb = 0.f;
#pragma unroll
    for (int j = 0; j < 4; ++j) { sa += (va[j].x * va[j].x + va[j].y * va[j].y) + (va[j].z * va[j].z + va[j].w * va[j].w); sb += (vb[j].x * vb[j].x + vb[j].y * vb[j].y) + (vb[j].z * vb[j].z + vb[j].w * vb[j].w); }
    const float ra = 1.f / sqrtf(wave_sum(sa) * (1.f / DM) + 1e-6f), rb = 1.f / sqrtf(wave_sum(sb) * (1.f / DM) + 1e-6f);
#pragma unroll
    for (int j = 0; j < 4; ++j) { const f32x4 gg = ((const f32x4*)g)[64 * j + lane]; const f32x4 o1 = va[j] * ra * gg, o2 = vb[j] * rb * gg;
        if (fa) { ((f32x4*)fa)[64 * j + lane] = o1; ((f32x4*)fb)[64 * j + lane] = o2; }
        else { ((v2u*)oa)[64 * j + lane] = (v2u){pk2(o1.x, o1.y), pk2(o1.z, o1.w)}; ((v2u*)ob)[64 * j + lane] = (v2u){pk2(o2.x, o2.y), pk2(o2.z, o2.w)}; } }
}
__device__ __forceinline__ void rms_row_parts(const float* base, const float* parts, int nparts, size_t part_stride, float* xout, const float* g, bf16* orow, float* of32, int lane) {
    f32x4 v[4]; float s = 0.f;
#pragma unroll
    for (int j = 0; j < 4; ++j) v[j] = ((const f32x4*)base)[64 * j + lane];
    for (int p = 0; p < nparts; ++p) { const f32x4* pr = (const f32x4*)(parts + (size_t)p * part_stride) + lane;
#pragma unroll
        for (int j = 0; j < 4; ++j) v[j] += pr[64 * j]; }
#pragma unroll
    for (int j = 0; j < 4; ++j) { if (xout) ((f32x4*)xout)[64 * j + lane] = v[j]; s += (v[j].x * v[j].x + v[j].y * v[j].y) + (v[j].z * v[j].z + v[j].w * v[j].w); }
    const float rstd = 1.f / sqrtf(wave_sum(s) * (1.f / DM) + 1e-6f);
#pragma unroll
    for (int j = 0; j < 4; ++j) { const f32x4 gg = ((const f32x4*)g)[64 * j + lane]; const f32x4 o = v[j] * rstd * gg;
        if (of32) ((f32x4*)of32)[64 * j + lane] = o;
        else ((v2u*)orow)[64 * j + lane] = (v2u){pk2(o.x, o.y), pk2(o.z, o.w)}; }
}

struct PBArgs { const float* PROJ; const float* state_conv; const float* conv_w; const float* a_log; const float* dt_bias;
    float* QN; float* KN; float* VG; float* G; float* BETA; float* KQ; bf16* QB; bf16* KS; bf16* VS; bf16* KW; bf16* VW; float* out; int l; };
struct PBRegs { float qs_[8], qo_[8], kvs_[12], kvo_[12]; };
__device__ __forceinline__ void pb_row_load(const PBArgs& A, int m, int lane, PBRegs& R) {
    const float* pr = A.PROJ + (size_t)m * NP;
#pragma unroll
    for (int h = 0; h < 8; ++h) { R.qs_[h] = pr[C_Q + h * 64 + lane]; R.qo_[h] = pr[C_Q + h * 64 + (lane ^ 32)]; }
#pragma unroll
    for (int i = 0; i < 12; ++i) { R.kvs_[i] = pr[C_KV + i * 64 + lane]; R.kvo_[i] = pr[C_KV + i * 64 + (lane ^ 32)]; }
}
__device__ __forceinline__ void pb_row(const PBArgs& A, int m, int lane, const PBRegs& R) {
    const bool is_s = m >= MP; int b, t;
    if (!is_s) { b = m >> 12; t = m & 4095; } else { b = (m - MP) >> 2; t = (m - MP) & 3; }
    const int pos = is_s ? PAST + t : t, l = A.l;
    const float* pr = A.PROJ + (size_t)m * NP;
    const float* cw = A.conv_w + (size_t)l * 4 * 1536;
    const float* cb = A.state_conv + ((size_t)l * NSB + b) * 3 * 1536;
    if (!is_s && t >= SEQ - 3) { float* o = A.out + O_CONVP + ((size_t)(l * NPB + b) * 3 + (t - (SEQ - 3))) * 1536;
#pragma unroll 4
        for (int j = 0; j < 24; ++j) o[64 * j + lane] = pr[64 * j + lane]; }
    if (is_s && t >= 1) { float* o = A.out + O_CONVS + ((size_t)(l * NSB + b) * 3 + (t - 1)) * 1536;
#pragma unroll 4
        for (int j = 0; j < 24; ++j) o[64 * j + lane] = pr[64 * j + lane]; }
    const int half = lane >> 5; float cs, sn; rope_cs(pos, lane & 31, cs, sn);
    const float (&qs_)[8] = R.qs_; const float (&qo_)[8] = R.qo_; const float (&kvs_)[12] = R.kvs_; const float (&kvo_)[12] = R.kvo_;
#pragma unroll
    for (int h = 0; h < 8; ++h) { const float xs = qs_[h], xo = qo_[h];
        const float r = half ? (xs * cs + xo * sn) : (xs * cs - xo * sn);
        A.QB[(size_t)m * 512 + h * 64 + lane] = (bf16)f2bf(r * C2); }
#pragma unroll
    for (int s6 = 0; s6 < 6; ++s6)
#pragma unroll
        for (int kvh = 0; kvh < 2; ++kvh) {
            float v = kvs_[s6 * 2 + kvh];
            if (s6 == 2 || s6 == 4) { const float xo = kvo_[s6 * 2 + kvh]; v = half ? (v * cs + xo * sn) : (v * cs - xo * sn); }
            if (s6 < 4) {
                if (!is_s) A.out[O_KVP + ((((size_t)(l * NPB + b) * 2 + kvh) * SEQ + t) * 4 + s6) * 64 + lane] = v;
                else       A.out[O_KVS + ((((size_t)(l * NSB + b) * 2 + kvh) * DSEQ + t) * 4 + s6) * 64 + lane] = v;
            } else {
                const int idx = s6 - 4;
                if (!is_s) { if (t >= SEQ - 512) A.out[O_WINP + ((((size_t)(l * NPB + b) * 512 + (t - (SEQ - 512))) * 2 + idx) * 2 + kvh) * 64 + lane] = v; }
                else A.out[O_WINS + ((((size_t)(l * NSB + b) * 512 + (508 + t)) * 2 + idx) * 2 + kvh) * 64 + lane] = v;
            }
            const bf16 bv = (bf16)f2bf(v);
            if (s6 == 2) A.KS[(size_t)m * 128 + kvh * 64 + lane] = bv;
            if (s6 == 3) A.VS[(size_t)m * 128 + kvh * 64 + lane] = bv;
            if (s6 == 4) A.KW[(size_t)m * 128 + kvh * 64 + lane] = bv;
            if (s6 == 5) A.VW[(size_t)m * 128 + kvh * 64 + lane] = bv;
        }
}

__device__ __forceinline__ void pb_sample_head(const PBArgs& A, int u, int lane) {
    const int m = MP + (u >> 3), h = u & 7, b = (m - MP) >> 2, t = (m - MP) & 3, l = A.l;
    const float* pr = A.PROJ + (size_t)m * NP;
    const float* cw = A.conv_w + (size_t)l * 4 * 1536;
    const float* cb = A.state_conv + ((size_t)l * NSB + b) * 3 * 1536;
    float xv[3][4], wv[3][4];
#pragma unroll
    for (int part = 0; part < 3; ++part) { const int c = (part * 8 + h) * 64 + lane;
#pragma unroll
        for (int tap = 0; tap < 4; ++tap) { const int idx = t + tap;
            xv[part][tap] = (idx >= 3) ? A.PROJ[(size_t)(m - t + idx - 3) * NP + c] : cb[idx * 1536 + c];
            wv[part][tap] = cw[tap * 1536 + c]; } }
    __builtin_amdgcn_sched_barrier(0);
    float qkv[3];
#pragma unroll
    for (int part = 0; part < 3; ++part) qkv[part] = siluf_((xv[part][0] * wv[part][0] + xv[part][1] * wv[part][1]) + (xv[part][2] * wv[part][2] + xv[part][3] * wv[part][3]));
    const float q = qkv[0], k = qkv[1];
    const float qs = dpp_sum(q * q), ks = dpp_sum(k * k);
    const float qn = q * (1.f / sqrtf(qs + 1e-6f)) * 0.125f, kn = k * (1.f / sqrtf(ks + 1e-6f));
    const float kq = dpp_sum(qn * kn);
    A.QN[(size_t)m * 512 + h * 64 + lane] = qn; A.KN[(size_t)m * 512 + h * 64 + lane] = kn; A.VG[(size_t)m * 512 + h * 64 + lane] = qkv[2];
    if (lane == 0) A.KQ[(size_t)m * 8 + h] = kq;
    if (h == 0 && lane < 8) {
        const float a = pr[C_A + lane] + A.dt_bias[l * 8 + lane];
        const float sp = fmaxf(a, 0.f) + log1pf(__expf(-fabsf(a)));
        A.G[(size_t)m * 8 + lane] = -__expf(A.a_log[l * 8 + lane]) * sp;
        A.BETA[(size_t)m * 8 + lane] = sigmoidf_(pr[C_BETA + lane]); }
}

struct CmpArgs { const float* PROJ; const float* cache; const int* page_table; const float* pe_k; const float* pe_v; const bf16* CMPW; unsigned char* ws; int l; };
__device__ __forceinline__ void compress_unit(const CmpArgs& A, int u, int lane) {
    const int fr = lane & 15, fq = lane >> 4, l = A.l;
    const int kv = u & 1, uu = u >> 1; const bool is_s = uu >= 64; const int ru = is_s ? uu - 64 : uu;
    const int rho = 16 * ru + fr, NC = is_s ? 64 : 128;
    const int seq = rho / (2 * NC), n = (rho >> 1) % NC, kvh = rho & 1;
    const float* abase; size_t astride;
    if (!is_s) { abase = A.PROJ + (size_t)(seq * SEQ + 32 * n) * NP + C_KV + kv * 128 + kvh * 64; astride = NP; }
    else { const int page = A.page_table[seq * NPAGES + (n >> 2)];
        abase = A.cache + ((((size_t)l * NPOOL + page) * 2 + kvh) * 128 + (n & 3) * 32) * 256 + kv * 64; astride = 256; }
    const float* pe = (kv ? A.pe_v : A.pe_k) + (size_t)l * 2048;
    const bf16* Wt = A.CMPW + (size_t)((l * 2 + kv) * 64) * 2048;
    f32x4 acc[4];
#pragma unroll
    for (int et = 0; et < 4; ++et) acc[et] = (f32x4){0.f, 0.f, 0.f, 0.f};
    f32x4 sa[2][4], sp[2][4]; bf16x8 sw[2][8];
#define CMP_LOAD(S, c) do { _Pragma("unroll") for (int ks = 0; ks < 2; ++ks) { const float* ap = abase + (size_t)(c) * astride + 32 * ks + 8 * fq; const float* pp = pe + (c) * 64 + 32 * ks + 8 * fq; \
        sa[S][2 * ks] = *(const f32x4*)ap; sa[S][2 * ks + 1] = *(const f32x4*)(ap + 4); sp[S][2 * ks] = *(const f32x4*)pp; sp[S][2 * ks + 1] = *(const f32x4*)(pp + 4); \
        _Pragma("unroll") for (int et = 0; et < 4; ++et) sw[S][ks * 4 + et] = *(const bf16x8*)(Wt + (size_t)(16 * et + fr) * 2048 + (c) * 64 + 32 * ks + 8 * fq); } } while (0)
#define CMP_MMA(S) do { _Pragma("unroll") for (int ks = 0; ks < 2; ++ks) { const f32x4 a0 = sa[S][2 * ks] + sp[S][2 * ks], a1 = sa[S][2 * ks + 1] + sp[S][2 * ks + 1]; \
        const bf16x8 ya = pack8(a0.x, a0.y, a0.z, a0.w, a1.x, a1.y, a1.z, a1.w); \
        _Pragma("unroll") for (int et = 0; et < 4; ++et) acc[et] = __builtin_amdgcn_mfma_f32_16x16x32_bf16(sw[S][ks * 4 + et], ya, acc[et], 0, 0, 0); } } while (0)
    CMP_LOAD(0, 0);
#pragma unroll 1
    for (int c = 0; c < 32; c += 2) {
        CMP_LOAD(1, c + 1); __builtin_amdgcn_sched_barrier(0);
        CMP_MMA(0); __builtin_amdgcn_sched_barrier(0);
        if (c + 2 < 32) { CMP_LOAD(0, c + 2); } __builtin_amdgcn_sched_barrier(0);
        CMP_MMA(1); __builtin_amdgcn_sched_barrier(0);
    }
#undef CMP_LOAD
#undef CMP_MMA
    if (kv == 0) { const int pos = 32 * n + 31;
#pragma unroll
        for (int et = 0; et < 2; ++et)
#pragma unroll
            for (int i = 0; i < 4; ++i) { float cs, sn; rope_cs(pos, 16 * et + 4 * fq + i, cs, sn);
                const float x1 = acc[et][i], x2 = acc[et + 2][i]; acc[et][i] = x1 * cs - x2 * sn; acc[et + 2][i] = x2 * cs + x1 * sn; } }
    float* ob = (float*)(A.ws + (is_s ? WS_CKS : WS_CKP) + (size_t)kv * (is_s ? (WS_CVS - WS_CKS) : (WS_CVP - WS_CKP))) + (size_t)rho * 64 + 4 * fq;
#pragma unroll
    for (int et = 0; et < 4; ++et) *(f32x4*)(ob + 16 * et) = acc[et];
}

struct GdnArgs { const float* QN; const float* KN; const float* VG; const float* G; const float* BETA; const float* KQ; float* OG; const float* PROJ; const float* state_gdn; const float* gdn_norm; bf16* MIX; float* out; int l; };
__device__ __forceinline__ void gdn_sample_unit(const GdnArgs& A, int unit, int lane) {
    const int sb = unit >> 3, h = unit & 7, l = A.l;
    const float* sp = A.state_gdn + (((size_t)l * NSB + sb) * 8 + h) * 4096;
    float S[64];
#pragma unroll
    for (int d = 0; d < 64; ++d) S[d] = sp[d * 64 + lane];
    const float gn = A.gdn_norm[l * 64 + lane];
    for (int i = 0; i < DSEQ; ++i) {
        const size_t m = (size_t)MP + sb * 4 + i;
        const float kd = A.KN[m * 512 + h * 64 + lane], qd = A.QN[m * 512 + h * 64 + lane], v = A.VG[m * 512 + h * 64 + lane];
        const float g = A.G[m * 8 + h], beta = A.BETA[m * 8 + h], kq = A.KQ[m * 8 + h];
        const int kdb = __builtin_bit_cast(int, kd), qdb = __builtin_bit_cast(int, qd);
        const float a = __expf(g); float r1 = 0.f, r2 = 0.f;
#pragma unroll
        for (int d = 0; d < 64; ++d) { const float kk = __builtin_bit_cast(float, __builtin_amdgcn_readlane(kdb, d)), qq = __builtin_bit_cast(float, __builtin_amdgcn_readlane(qdb, d)); r1 += S[d] * kk; r2 += S[d] * qq; }
        const float u = beta * (v - a * r1), o = a * r2 + u * kq;
#pragma unroll
        for (int d = 0; d < 64; ++d) { const float kk = __builtin_bit_cast(float, __builtin_amdgcn_readlane(kdb, d)); S[d] = a * S[d] + kk * u; }
        const float ms = wave_sum(o * o) * (1.f / 64.f);
        const float z = A.PROJ[m * NP + C_Z + h * 64 + lane];
        A.MIX[m * 1024 + h * 64 + lane] = (bf16)f2bf(o * (1.f / sqrtf(ms + 1e-6f)) * gn * siluf_(z));
    }
    float* so = A.out + O_GDNS + (((size_t)l * NSB + sb) * 8 + h) * 4096;
#pragma unroll
    for (int d = 0; d < 64; ++d) so[d * 64 + lane] = S[d];
}


__device__ __forceinline__ int perm_inv32(int p) { return (p & 32) + 16 * ((p >> 2) & 1) + 4 * ((p >> 3) & 3) + (p & 3); }
struct GPArgs { const float* PROJ; const float* conv_w; const float* a_log; const float* dt_bias; bf16* GK; bf16* GQ; bf16* GKT; bf16* GVT; float* GG2; float* BETA2; int l; };
struct GPRegs { float xx[3][11], ww[3][4]; };
__device__ __forceinline__ void gdn_prep_load(const GPArgs& A, int unit, int lane, GPRegs& R) {
    const int tg = unit >> 3, h = unit & 7, m0 = tg * 8, t0 = m0 & 4095;
    const float* cw = A.conv_w + (size_t)A.l * 4 * 1536;
#pragma unroll
    for (int part = 0; part < 3; ++part) { const int c = (part * 8 + h) * 64 + lane;
#pragma unroll
        for (int j = 0; j < 11; ++j) R.xx[part][j] = (t0 - 3 + j >= 0) ? A.PROJ[(size_t)(m0 - 3 + j) * NP + c] : 0.f;
#pragma unroll
        for (int k = 0; k < 4; ++k) R.ww[part][k] = cw[k * 1536 + c]; }
}
__device__ __forceinline__ void gdn_prep_unit(const GPArgs& A, int unit, int lane, const GPRegs& R) {
    const int tg = unit >> 3, h = unit & 7, m0 = tg * 8, b = m0 >> 12, t0 = m0 & 4095, l = A.l, bh = b * 8 + h;
    const float* cw = A.conv_w + (size_t)l * 4 * 1536;
    float val[3][8]; const float (&xx)[3][11] = R.xx; const float (&ww)[3][4] = R.ww;
#pragma unroll
    for (int part = 0; part < 3; ++part)
#pragma unroll
        for (int i = 0; i < 8; ++i) val[part][i] = siluf_(ww[part][0] * xx[part][i] + ww[part][1] * xx[part][i + 1] + ww[part][2] * xx[part][i + 2] + ww[part][3] * xx[part][i + 3]);
#pragma unroll
    for (int i = 0; i < 8; ++i) { const float q = val[0][i], k = val[1][i];
        const float qs = dpp_sum(q * q), ks = dpp_sum(k * k);
        val[0][i] = q * (1.f / sqrtf(qs + 1e-6f)) * 0.125f; val[1][i] = k * (1.f / sqrtf(ks + 1e-6f)); }
#pragma unroll
    for (int i = 0; i < 8; ++i) { A.GQ[((size_t)bh * 4096 + t0 + i) * 64 + lane] = (bf16)f2bf(val[0][i]); A.GK[((size_t)bh * 4096 + t0 + i) * 64 + lane] = (bf16)f2bf(val[1][i]); }
    *(v4u*)(A.GKT + ((size_t)bh * 64 + lane) * 4096 + t0) = (v4u){pk2(val[1][0], val[1][1]), pk2(val[1][2], val[1][3]), pk2(val[1][4], val[1][5]), pk2(val[1][6], val[1][7])};
    *(v4u*)(A.GVT + ((size_t)bh * 64 + lane) * 4096 + t0) = (v4u){pk2(val[2][0], val[2][1]), pk2(val[2][2], val[2][3]), pk2(val[2][4], val[2][5]), pk2(val[2][6], val[2][7])};
    if (lane < 8) { const float* pr = A.PROJ + (size_t)(m0 + lane) * NP;
        const float a = pr[C_A + h] + A.dt_bias[l * 8 + h];
        const float sp = fmaxf(a, 0.f) + log1pf(__expf(-fabsf(a)));
        A.GG2[(size_t)bh * 4096 + t0 + lane] = -__expf(A.a_log[l * 8 + h]) * sp;
        A.BETA2[(size_t)bh * 4096 + t0 + lane] = sigmoidf_(pr[C_BETA + h]); }
}
template <int I> __device__ __forceinline__ void fsub_row(float (&T)[64], const float* AL, int lane) {
    float tv = (lane == I) ? 1.f : 0.f;
#pragma unroll
    for (int j4 = 0; j4 < (I + 3) / 4; ++j4) { const f32x4 a = *(const f32x4*)(AL + I * 64 + 4 * j4);
#pragma unroll
        for (int e = 0; e < 4; ++e) if (4 * j4 + e < I) tv -= a[e] * T[4 * j4 + e]; }
    T[I] = tv;
}
template <int I> struct FSub { static __device__ __forceinline__ void run(float (&T)[64], const float* AL, int lane) { FSub<I - 1>::run(T, AL, lane); fsub_row<I>(T, AL, lane); } };
template <> struct FSub<-1> { static __device__ __forceinline__ void run(float (&)[64], const float*, int) {} };
struct GCArgs { const bf16* GK; const bf16* GQ; const bf16* GKT; const bf16* GVT; const float* GG2; const float* BETA2; bf16* WX; bf16* QX; bf16* QKX; bf16* KTX; float* U0F; float* GL; };
constexpr int GC_LDS_PER_WAVE = 17664;
__device__ __forceinline__ void gdn_chunk_unit(const GCArgs& A, unsigned char* wl, int unit, int lane_) {
    int lane = lane_; asm volatile("" : "+v"(lane));
    const int bh = unit >> 6, n = unit & 63, t0 = 64 * n, fr = lane & 15, fq = lane >> 4;
    float* AL = (float*)wl; float* SC = (float*)(wl + 16384);
    {   const float g = A.GG2[(size_t)bh * 4096 + t0 + lane], beta = A.BETA2[(size_t)bh * 4096 + t0 + lane];
        float gc = g;
        gc = dpp_add<0x111, 0xf>(gc); gc = dpp_add<0x112, 0xf>(gc); gc = dpp_add<0x114, 0xf>(gc); gc = dpp_add<0x118, 0xf>(gc); gc = dpp_add<0x142, 0xa>(gc); gc = dpp_add<0x143, 0xc>(gc);
        const float glast = __builtin_bit_cast(float, __builtin_amdgcn_readlane(__builtin_bit_cast(int, gc), 63));
        const float eg = __expf(gc);
        SC[lane] = gc; SC[64 + lane] = beta; SC[128 + lane] = beta * eg; SC[192 + lane] = eg; SC[256 + lane] = __expf(glast - gc);
        if (lane == 0) A.GL[unit] = __expf(glast); }
    LDS_WAIT(); asm volatile("" ::: "memory");
    {
        bf16x8 kf[4][2];
#pragma unroll
        for (int t4 = 0; t4 < 4; ++t4)
#pragma unroll
            for (int ks = 0; ks < 2; ++ks) kf[t4][ks] = *(const bf16x8*)(A.GK + ((size_t)bh * 4096 + t0 + 16 * t4 + fr) * 64 + 32 * ks + 8 * fq);
        __builtin_amdgcn_sched_barrier(0);
#pragma unroll
        for (int ti = 0; ti < 4; ++ti) { const f32x4 gi = *(const f32x4*)(SC + 16 * ti + 4 * fq), bi = *(const f32x4*)(SC + 64 + 16 * ti + 4 * fq);
#pragma unroll
            for (int tj = 0; tj < 4; ++tj) if (tj <= ti) { f32x4 acc = {0.f, 0.f, 0.f, 0.f};
                acc = __builtin_amdgcn_mfma_f32_16x16x32_bf16(kf[ti][0], kf[tj][0], acc, 0, 0, 0); acc = __builtin_amdgcn_mfma_f32_16x16x32_bf16(kf[ti][1], kf[tj][1], acc, 0, 0, 0);
                const float gj = SC[16 * tj + fr];
#pragma unroll
                for (int i = 0; i < 4; ++i) AL[(16 * ti + 4 * fq + i) * 64 + 16 * tj + fr] = bi[i] * acc[i] * __expf(fminf(gi[i] - gj, 0.f)); } }
    }
    LDS_WAIT(); asm volatile("" ::: "memory");
    {
        float T[64];
        FSub<63>::run(T, AL, lane);
        LDS_WAIT(); asm volatile("" ::: "memory");
        unsigned short* TB = (unsigned short*)wl;
#pragma unroll
        for (int i = 0; i < 64; ++i) TB[i * 72 + lane] = (unsigned short)f2bf(T[i]);
    }
    LDS_WAIT(); asm volatile("" ::: "memory");
    {
        bf16x8 tf[4][2];
#pragma unroll
        for (int ti = 0; ti < 4; ++ti)
#pragma unroll
            for (int ks = 0; ks < 2; ++ks) tf[ti][ks] = *(const bf16x8*)(wl + ((16 * ti + fr) * 72 + 32 * ks + 8 * fq) * 2);
#pragma unroll
        for (int which = 0; which < 2; ++which) { const bf16* src = which ? A.GVT : A.GKT; const float* sc = SC + (which ? 64 : 128);
            bf16x8 raws[4][2];
#pragma unroll
            for (int tn = 0; tn < 4; ++tn)
#pragma unroll
                for (int ks = 0; ks < 2; ++ks) raws[tn][ks] = *(const bf16x8*)(src + ((size_t)bh * 64 + 16 * tn + fr) * 4096 + t0 + 32 * ks + 8 * fq);
            __builtin_amdgcn_sched_barrier(0);
#pragma unroll
            for (int tn = 0; tn < 4; ++tn) { bf16x8 yb[2];
#pragma unroll
                for (int ks = 0; ks < 2; ++ks) { const bf16x8 raw = raws[tn][ks];
                    const f32x4 s0 = *(const f32x4*)(sc + 32 * ks + 8 * fq), s1 = *(const f32x4*)(sc + 32 * ks + 8 * fq + 4);
                    yb[ks] = pack8(bf2f((unsigned short)raw[0]) * s0.x, bf2f((unsigned short)raw[1]) * s0.y, bf2f((unsigned short)raw[2]) * s0.z, bf2f((unsigned short)raw[3]) * s0.w,
                                   bf2f((unsigned short)raw[4]) * s1.x, bf2f((unsigned short)raw[5]) * s1.y, bf2f((unsigned short)raw[6]) * s1.z, bf2f((unsigned short)raw[7]) * s1.w); }
#pragma unroll
                for (int ti = 0; ti < 4; ++ti) { f32x4 acc = {0.f, 0.f, 0.f, 0.f};
                    acc = __builtin_amdgcn_mfma_f32_16x16x32_bf16(tf[ti][0], yb[0], acc, 0, 0, 0);
                    if (ti >= 2) acc = __builtin_amdgcn_mfma_f32_16x16x32_bf16(tf[ti][1], yb[1], acc, 0, 0, 0);
                    if (which == 0) { const int p = 32 * (tn >> 1) + 8 * (fr >> 2) + 4 * (tn & 1) + (fr & 3);
#pragma unroll
                        for (int i = 0; i < 4; ++i) A.WX[((size_t)unit * 64 + 16 * ti + 4 * fq + i) * 64 + p] = (bf16)f2bf(acc[i]); }
                    else *(f32x4*)(A.U0F + (((size_t)unit * 16 + ti * 4 + tn) * 64 + lane) * 4) = acc; } } }
    }
    {
        bf16x8 kf[4][2], qf[4][2];
#pragma unroll
        for (int t4 = 0; t4 < 4; ++t4)
#pragma unroll
            for (int ks = 0; ks < 2; ++ks) { kf[t4][ks] = *(const bf16x8*)(A.GK + ((size_t)bh * 4096 + t0 + 16 * t4 + fr) * 64 + 32 * ks + 8 * fq);
                qf[t4][ks] = *(const bf16x8*)(A.GQ + ((size_t)bh * 4096 + t0 + 16 * t4 + fr) * 64 + 32 * ks + 8 * fq); }
        __builtin_amdgcn_sched_barrier(0);
#pragma unroll
        for (int ti = 0; ti < 4; ++ti) { const f32x4 gi = *(const f32x4*)(SC + 16 * ti + 4 * fq);
#pragma unroll
            for (int tj = 0; tj < 4; ++tj) { f32x4 acc = {0.f, 0.f, 0.f, 0.f};
                if (tj <= ti) { acc = __builtin_amdgcn_mfma_f32_16x16x32_bf16(qf[ti][0], kf[tj][0], acc, 0, 0, 0); acc = __builtin_amdgcn_mfma_f32_16x16x32_bf16(qf[ti][1], kf[tj][1], acc, 0, 0, 0); }
                const float gj = SC[16 * tj + fr]; const int p = 32 * (tj >> 1) + 8 * (fr >> 2) + 4 * (tj & 1) + (fr & 3);
#pragma unroll
                for (int i = 0; i < 4; ++i) { const int ri = 16 * ti + 4 * fq + i, cj = 16 * tj + fr;
                    const float v = (tj <= ti && ri >= cj) ? acc[i] * __expf(fminf(gi[i] - gj, 0.f)) : 0.f;
                    A.QKX[((size_t)unit * 64 + ri) * 64 + p] = (bf16)f2bf(v); } } }
    }
    {
        const int lg = perm_inv32(lane);
        const float ek = SC[256 + lg];
#pragma unroll 1
        for (int r0 = 0; r0 < 64; r0 += 16) { bf16 qv[16], kv[16];
#pragma unroll
            for (int i = 0; i < 16; ++i) { qv[i] = A.GQ[((size_t)bh * 4096 + t0 + r0 + i) * 64 + lg]; kv[i] = A.GKT[((size_t)bh * 64 + r0 + i) * 4096 + t0 + lg]; }
            __builtin_amdgcn_sched_barrier(0);
#pragma unroll
            for (int i = 0; i < 16; ++i) { A.QX[((size_t)unit * 64 + r0 + i) * 64 + lane] = (bf16)f2bf(bf2f(qv[i]) * SC[192 + r0 + i]);
                A.KTX[((size_t)unit * 64 + r0 + i) * 64 + lane] = (bf16)f2bf(bf2f(kv[i]) * ek); } }
    }
    LDS_WAIT(); asm volatile("" ::: "memory");
}
struct GS2Args { const bf16* WX; const bf16* QX; const bf16* QKX; const bf16* KTX; const float* U0F; const float* GL; float* OG; float* out; int l; };
__device__ __forceinline__ void gdn_scan2_wave(const GS2Args& A, int bh, int te, int lane) {
    const int fr = lane & 15, fq = lane >> 4, b = bh >> 3, h = bh & 7;
    f32x4 s[4]; bf16x8 sfr[2];
#pragma unroll
    for (int i = 0; i < 4; ++i) s[i] = (f32x4){0.f, 0.f, 0.f, 0.f};
    sfr[0] = (bf16x8){0, 0, 0, 0, 0, 0, 0, 0}; sfr[1] = sfr[0];
    f32x4 u[4]; bf16x8 wf[4][2], kt[4][2], qx[4][2], qkx[4][2]; float dec;
#define GS_LD_UW(nn) do { const size_t un_ = (size_t)bh * 64 + (nn); _Pragma("unroll") for (int tc = 0; tc < 4; ++tc) { u[tc] = *(const f32x4*)(A.U0F + ((un_ * 16 + tc * 4 + te) * 64 + lane) * 4); \
        _Pragma("unroll") for (int ks = 0; ks < 2; ++ks) wf[tc][ks] = *(const bf16x8*)(A.WX + (un_ * 64 + 16 * tc + fr) * 64 + 32 * ks + 8 * fq); } } while (0)
#define GS_LD_Q(nn) do { const size_t un_ = (size_t)bh * 64 + (nn); _Pragma("unroll") for (int tc = 0; tc < 4; ++tc) _Pragma("unroll") for (int ks = 0; ks < 2; ++ks) { \
        qx[tc][ks] = *(const bf16x8*)(A.QX + (un_ * 64 + 16 * tc + fr) * 64 + 32 * ks + 8 * fq); qkx[tc][ks] = *(const bf16x8*)(A.QKX + (un_ * 64 + 16 * tc + fr) * 64 + 32 * ks + 8 * fq); } } while (0)
#define GS_LD_K(nn) do { const size_t un_ = (size_t)bh * 64 + (nn); dec = A.GL[un_]; _Pragma("unroll") for (int tc = 0; tc < 4; ++tc) _Pragma("unroll") for (int ks = 0; ks < 2; ++ks) \
        kt[tc][ks] = *(const bf16x8*)(A.KTX + (un_ * 64 + 16 * tc + fr) * 64 + 32 * ks + 8 * fq); } while (0)
    GS_LD_UW(0); GS_LD_Q(0); GS_LD_K(0);
    __builtin_amdgcn_sched_barrier(0);
#pragma unroll 1
    for (int n = 0; n < 64; ++n) {
        const int nn = n < 63 ? n + 1 : 63;
#pragma unroll
        for (int tc = 0; tc < 4; ++tc) { f32x4 acc = {0.f, 0.f, 0.f, 0.f};
            acc = __builtin_amdgcn_mfma_f32_16x16x32_bf16(wf[tc][0], sfr[0], acc, 0, 0, 0); acc = __builtin_amdgcn_mfma_f32_16x16x32_bf16(wf[tc][1], sfr[1], acc, 0, 0, 0);
            u[tc] -= acc; }
        bf16x8 ufr[2];
#pragma unroll
        for (int ks = 0; ks < 2; ++ks) ufr[ks] = pack8(u[2 * ks][0], u[2 * ks][1], u[2 * ks][2], u[2 * ks][3], u[2 * ks + 1][0], u[2 * ks + 1][1], u[2 * ks + 1][2], u[2 * ks + 1][3]);
        __builtin_amdgcn_sched_barrier(0);
        GS_LD_UW(nn);
        __builtin_amdgcn_sched_barrier(0);
        f32x4 oacc[4];
#pragma unroll
        for (int tc = 0; tc < 4; ++tc) {
            f32x4 acc = {0.f, 0.f, 0.f, 0.f};
            acc = __builtin_amdgcn_mfma_f32_16x16x32_bf16(qx[tc][0], sfr[0], acc, 0, 0, 0); acc = __builtin_amdgcn_mfma_f32_16x16x32_bf16(qx[tc][1], sfr[1], acc, 0, 0, 0);
            acc = __builtin_amdgcn_mfma_f32_16x16x32_bf16(qkx[tc][0], ufr[0], acc, 0, 0, 0); acc = __builtin_amdgcn_mfma_f32_16x16x32_bf16(qkx[tc][1], ufr[1], acc, 0, 0, 0);
            oacc[tc] = acc; }
#pragma unroll
        for (int td = 0; td < 4; ++td) { f32x4 acc = s[td] * dec;
            acc = __builtin_amdgcn_mfma_f32_16x16x32_bf16(kt[td][0], ufr[0], acc, 0, 0, 0); acc = __builtin_amdgcn_mfma_f32_16x16x32_bf16(kt[td][1], ufr[1], acc, 0, 0, 0);
            s[td] = acc; }
#pragma unroll
        for (int ks = 0; ks < 2; ++ks) sfr[ks] = pack8(s[2 * ks][0], s[2 * ks][1], s[2 * ks][2], s[2 * ks][3], s[2 * ks + 1][0], s[2 * ks + 1][1], s[2 * ks + 1][2], s[2 * ks + 1][3]);
        __builtin_amdgcn_sched_barrier(0);
        GS_LD_Q(nn); GS_LD_K(nn);
#pragma unroll
        for (int tc = 0; tc < 4; ++tc)
#pragma unroll
            for (int i = 0; i < 4; ++i) A.OG[((size_t)b * SEQ + 64 * n + 16 * tc + 4 * fq + i) * 512 + h * 64 + 16 * te + fr] = oacc[tc][i];
        __builtin_amdgcn_sched_barrier(0);
    }
#undef GS_LD_UW
#undef GS_LD_Q
#undef GS_LD_K
#pragma unroll
    for (int td = 0; td < 4; ++td)
#pragma unroll
        for (int i = 0; i < 4; ++i) A.out[O_GDNP + ((((size_t)A.l * NPB + b) * 8 + h) * 64 + 16 * td + 4 * fq + i) * 64 + 16 * te + fr] = s[td][i];
}

constexpr int L_CK = 0, L_CVT = 18432, L_IMP = 36864, L_MASK = 102400, L_UM = 102912, L_INV = 102928, L_K = 104448, L_VT = 113664;
struct AttArgs { const bf16* QB; const bf16* KS; const bf16* VS; const bf16* KW; const bf16* VW; const float* CKP; const float* CVP; const float* PROJ; bf16* MIX; };

template <int MODE>
__device__ __forceinline__ void attn_tiles(unsigned char* lds, const bf16* Kg, const bf16* Vg, int j_lo, int j_hi, unsigned long long umask, unsigned long long tmask,
                                           int qblk, int trel, const bf16x8 (&qr)[4], f32x16 (&o)[2], float& mrun, float& lrun, int tid, int r32, int hi) {
    int j = j_lo; while (j <= j_hi && !((umask >> j) & 1ull)) ++j;
    const int key = tid >> 3, ch = tid & 7;
    v4u kvv = {0u, 0u, 0u, 0u}, vv = {0u, 0u, 0u, 0u};
    if (j <= j_hi) { kvv = *(const v4u*)(Kg + (size_t)(64 * j + key) * 128 + ch * 8); vv = *(const v4u*)(Vg + (size_t)(64 * j + key) * 128 + ch * 8); }
    while (j <= j_hi) {
        __syncthreads();
        { *(v4u*)(lds + L_K + key * 144 + ch * 16) = kvv;
          unsigned short* vt = (unsigned short*)(lds + L_VT);
#pragma unroll
          for (int e2 = 0; e2 < 4; ++e2) { const unsigned w = vv[e2]; vt[(ch * 8 + 2 * e2) * 72 + key] = (unsigned short)(w & 0xffffu); vt[(ch * 8 + 2 * e2 + 1) * 72 + key] = (unsigned short)(w >> 16); } }
        __syncthreads();
        int jn = j + 1; while (jn <= j_hi && !((umask >> jn) & 1ull)) ++jn;
        if (jn <= j_hi) { kvv = *(const v4u*)(Kg + (size_t)(64 * jn + key) * 128 + ch * 8); vv = *(const v4u*)(Vg + (size_t)(64 * jn + key) * 128 + ch * 8); }
        __builtin_amdgcn_sched_barrier(0);
        f32x16 p[2];
#pragma unroll
        for (int u = 0; u < 2; ++u) { f32x16 acc = {};
#pragma unroll
            for (int d0 = 0; d0 < 4; ++d0) { const bf16x8 kf = *(const bf16x8*)(lds + L_K + (32 * u + r32) * 144 + (16 * d0 + 8 * hi) * 2);
                acc = __builtin_amdgcn_mfma_f32_32x32x16_bf16(kf, qr[d0], acc, 0, 0, 0); }
            p[u] = acc; }
        const bool tsel = (MODE == 0) ? (((tmask >> j) & 1ull) != 0ull) : true;
#pragma unroll
        for (int u = 0; u < 2; ++u)
#pragma unroll
            for (int r = 0; r < 16; ++r) { const int kv = 32 * u + crow(r, hi); bool keep = tsel;
                if (j == qblk) keep = keep && (kv <= trel);
                if (MODE == 1) { if (j == qblk - 8) keep = keep && (kv >= trel); }
                if (!keep) p[u][r] = NEG_INF; }
        float rm = NEG_INF;
#pragma unroll
        for (int u = 0; u < 2; ++u)
#pragma unroll
            for (int r = 0; r < 16; ++r) rm = fmaxf(rm, p[u][r]);
        rm = fmaxf(rm, __shfl_xor(rm, 32));
        const float mn = fmaxf(mrun, rm), msafe = (mn == NEG_INF) ? 0.f : mn;
        const float alpha = ex2(mrun - msafe);
        float ls = 0.f;
#pragma unroll
        for (int u = 0; u < 2; ++u)
#pragma unroll
            for (int r = 0; r < 16; ++r) { const float e = ex2(p[u][r] - msafe); p[u][r] = e; ls += e; }
        lrun = lrun * alpha + ls; mrun = mn;
#pragma unroll
        for (int dh = 0; dh < 2; ++dh)
#pragma unroll
            for (int r = 0; r < 16; ++r) o[dh][r] *= alpha;
#pragma unroll
        for (int u = 0; u < 2; ++u)
#pragma unroll
            for (int s = 0; s < 2; ++s) {
                const bf16x8 pf = pack8(p[u][8 * s + 0], p[u][8 * s + 1], p[u][8 * s + 2], p[u][8 * s + 3], p[u][8 * s + 4], p[u][8 * s + 5], p[u][8 * s + 6], p[u][8 * s + 7]);
#pragma unroll
                for (int dh = 0; dh < 2; ++dh) { const unsigned char* vp = lds + L_VT + (r32 + 32 * dh) * 144 + (32 * u + 16 * s + 4 * hi) * 2;
                    const s16x4 lo = *(const s16x4*)vp, hi4 = *(const s16x4*)(vp + 16);
                    const bf16x8 vf = (bf16x8){lo[0], lo[1], lo[2], lo[3], hi4[0], hi4[1], hi4[2], hi4[3]};
                    o[dh] = __builtin_amdgcn_mfma_f32_32x32x16_bf16(vf, pf, o[dh], 0, 0, 0); }
            }
        j = jn;
    }
}

__device__ __forceinline__ void nsa_prompt_unit(const AttArgs& A, unsigned char* lds, int unit, int tid) {
    const int lane = tid & 63, wave = tid >> 6, r32 = lane & 31, hi = lane >> 5, hh = wave & 3, ts = wave >> 2;
    const int qblk = 63 - (unit >> 3), b = (unit >> 1) & 3, kvh = unit & 1;
    const int head = kvh * 4 + hh, trel = 32 * ts + r32, t = 64 * qblk + trel; const size_t m = (size_t)b * SEQ + t;
    __syncthreads();
    const int nvmax = 2 * qblk + 2, ntile_c = (nvmax + 31) >> 5;
    { const int ch = tid & 7;
      for (int n = tid >> 3; n < 32 * ntile_c; n += 64) {
          const float* ckp = A.CKP + ((size_t)(b * 128 + n) * 2 + kvh) * 64 + ch * 8; const float* cvp = A.CVP + ((size_t)(b * 128 + n) * 2 + kvh) * 64 + ch * 8;
          const f32x4 k0 = *(const f32x4*)ckp, k1 = *(const f32x4*)(ckp + 4), v0 = *(const f32x4*)cvp, v1 = *(const f32x4*)(cvp + 4);
          *(bf16x8*)(lds + L_CK + n * 144 + ch * 16) = pack8(k0.x, k0.y, k0.z, k0.w, k1.x, k1.y, k1.z, k1.w);
          unsigned short* vt = (unsigned short*)(lds + L_CVT);
          vt[(ch * 8 + 0) * 136 + n] = (unsigned short)f2bf(v0.x); vt[(ch * 8 + 1) * 136 + n] = (unsigned short)f2bf(v0.y); vt[(ch * 8 + 2) * 136 + n] = (unsigned short)f2bf(v0.z); vt[(ch * 8 + 3) * 136 + n] = (unsigned short)f2bf(v0.w);
          vt[(ch * 8 + 4) * 136 + n] = (unsigned short)f2bf(v1.x); vt[(ch * 8 + 5) * 136 + n] = (unsigned short)f2bf(v1.y); vt[(ch * 8 + 6) * 136 + n] = (unsigned short)f2bf(v1.z); vt[(ch * 8 + 7) * 136 + n] = (unsigned short)f2bf(v1.w);
      }
      if (tid < 128) ((unsigned*)(lds + L_MASK))[tid] = 0u;
      if (tid < 2) ((unsigned*)(lds + L_UM))[tid] = 0u; }
    bf16x8 qr[4];
#pragma unroll
    for (int d0 = 0; d0 < 4; ++d0) qr[d0] = *(const bf16x8*)(A.QB + m * 512 + head * 64 + 16 * d0 + 8 * hi);
    __syncthreads();
    f32x16 tot[2];
    {
        const int nv = (t + 1) >> 5;
        float mx = NEG_INF;
#pragma unroll 1
        for (int tau = 0; tau < ntile_c; ++tau) {
            f32x16 acc = {};
#pragma unroll
            for (int d0 = 0; d0 < 4; ++d0) { const bf16x8 kf = *(const bf16x8*)(lds + L_CK + (32 * tau + r32) * 144 + (16 * d0 + 8 * hi) * 2);
                acc = __builtin_amdgcn_mfma_f32_32x32x16_bf16(kf, qr[d0], acc, 0, 0, 0); }
#pragma unroll
            for (int r = 0; r < 16; ++r) { const int n = 32 * tau + crow(r, hi); if (n < nv) mx = fmaxf(mx, acc[r]); }
        }
        mx = fmaxf(mx, __shfl_xor(mx, 32)); if (mx == NEG_INF) mx = 0.f;
        float sum = 0.f;
        f32x16 oc[2]; oc[0] = (f32x16){}; oc[1] = (f32x16){};
        float* imph = (float*)(lds + L_IMP) + (size_t)hh * 4096 + (32 * ts + r32) * 64;
#pragma unroll 1
        for (int tau = 0; tau < 4; ++tau) {
            f32x16 e = {};
            if (tau < ntile_c) {
                f32x16 acc = {};
#pragma unroll
                for (int d0 = 0; d0 < 4; ++d0) { const bf16x8 kf = *(const bf16x8*)(lds + L_CK + (32 * tau + r32) * 144 + (16 * d0 + 8 * hi) * 2);
                    acc = __builtin_amdgcn_mfma_f32_32x32x16_bf16(kf, qr[d0], acc, 0, 0, 0); }
#pragma unroll
                for (int r = 0; r < 16; ++r) { const int n = 32 * tau + crow(r, hi); e[r] = (n < nv) ? ex2(acc[r] - mx) : 0.f; sum += e[r]; }
#pragma unroll
                for (int s = 0; s < 2; ++s) {
                    const bf16x8 pf = pack8(e[8 * s + 0], e[8 * s + 1], e[8 * s + 2], e[8 * s + 3], e[8 * s + 4], e[8 * s + 5], e[8 * s + 6], e[8 * s + 7]);
#pragma unroll
                    for (int dh = 0; dh < 2; ++dh) { const unsigned char* vp = lds + L_CVT + (r32 + 32 * dh) * 272 + (32 * tau + 16 * s + 4 * hi) * 2;
                        const s16x4 lo = *(const s16x4*)vp, hi4 = *(const s16x4*)(vp + 16);
                        const bf16x8 vf = (bf16x8){lo[0], lo[1], lo[2], lo[3], hi4[0], hi4[1], hi4[2], hi4[3]};
                        oc[dh] = __builtin_amdgcn_mfma_f32_32x32x16_bf16(vf, pf, oc[dh], 0, 0, 0); }
                }
            }
#pragma unroll
            for (int a = 0; a < 4; ++a) { imph[16 * tau + 4 * a + 2 * hi + 0] = e[4 * a] + e[4 * a + 1]; imph[16 * tau + 4 * a + 2 * hi + 1] = e[4 * a + 2] + e[4 * a + 3]; }
        }
        sum += __shfl_xor(sum, 32);
        const float inv = 1.f / fmaxf(sum, 1e-30f);
        if (hi == 0) ((float*)(lds + L_INV))[hh * 64 + 32 * ts + r32] = inv;
        const float g0 = sigmoidf_(A.PROJ[m * NP + C_GATE + head * 3 + 0]) * inv;
#pragma unroll
        for (int dh = 0; dh < 2; ++dh)
#pragma unroll
            for (int r = 0; r < 16; ++r) tot[dh][r] = g0 * oc[dh][r];
    }
    __syncthreads();
    { float* ip = (float*)(lds + L_IMP); const float* iv = (const float*)(lds + L_INV);
#pragma unroll
      for (int i = 0; i < 8; ++i) { const int idx = tid + 512 * i, tk = idx >> 6;
          ip[idx] = (ip[idx] * iv[tk] + ip[4096 + idx] * iv[64 + tk]) + (ip[8192 + idx] * iv[128 + tk] + ip[12288 + idx] * iv[192 + tk]); } }
    __syncthreads();
    { const int tok = tid >> 3, jg = tid & 7; unsigned* mk = (unsigned*)(lds + L_MASK) + tok * 2;
      if (qblk <= 15) { if (jg == 0) { const unsigned long long am = (1ull << (qblk + 1)) - 1ull; mk[0] = (unsigned)am; mk[1] = (unsigned)(am >> 32); } }
      else {
          const float* iv = (const float*)(lds + L_IMP) + tok * 64; float vj[8]; int rk[8];
#pragma unroll
          for (int jj = 0; jj < 8; ++jj) { vj[jj] = iv[jg * 8 + jj]; rk[jj] = 0; }
          for (int i = 1; i <= qblk - 2; ++i) { const float vi = iv[i];
#pragma unroll
              for (int jj = 0; jj < 8; ++jj) { const int j = jg * 8 + jj; rk[jj] += (vi > vj[jj] || (vi == vj[jj] && i < j)) ? 1 : 0; } }
          unsigned bits = 0u;
#pragma unroll
          for (int jj = 0; jj < 8; ++jj) { const int j = jg * 8 + jj; const bool cand = (j >= 1 && j <= qblk - 2);
              if ((cand && rk[jj] < 13) || j == 0 || j == qblk || j == qblk - 1) bits |= 1u << ((jg & 3) * 8 + jj); }
          if (bits) atomicOr(mk + (jg >> 2), bits);
      } }
    __syncthreads();
    if (tid < 64) { const unsigned* mk = (const unsigned*)(lds + L_MASK) + tid * 2; atomicOr((unsigned*)(lds + L_UM), mk[0]); atomicOr((unsigned*)(lds + L_UM) + 1, mk[1]); }
    __syncthreads();
    unsigned long long tmask, umask;
    { const unsigned* mk = (const unsigned*)(lds + L_MASK) + trel * 2; tmask = (unsigned long long)mk[0] | ((unsigned long long)mk[1] << 32);
      const unsigned* um = (const unsigned*)(lds + L_UM); umask = (unsigned long long)um[0] | ((unsigned long long)um[1] << 32); }
    float* stash = (float*)(lds + L_IMP) + (size_t)wave * 2048 + lane;
#pragma unroll
    for (int dh = 0; dh < 2; ++dh)
#pragma unroll
        for (int r = 0; r < 16; ++r) stash[(dh * 16 + r) * 64] = tot[dh][r];
    {
        f32x16 o[2]; o[0] = (f32x16){}; o[1] = (f32x16){}; float mrun = NEG_INF, lrun = 0.f;
        attn_tiles<0>(lds, A.KS + (size_t)b * SEQ * 128 + kvh * 64, A.VS + (size_t)b * SEQ * 128 + kvh * 64, 0, qblk, umask, tmask, qblk, trel, qr, o, mrun, lrun, tid, r32, hi);
        lrun += __shfl_xor(lrun, 32);
        const float g1 = sigmoidf_(A.PROJ[m * NP + C_GATE + head * 3 + 1]) / fmaxf(lrun, 1e-30f);
#pragma unroll
        for (int dh = 0; dh < 2; ++dh)
#pragma unroll
            for (int r = 0; r < 16; ++r) stash[(dh * 16 + r) * 64] += g1 * o[dh][r];
    }
    {
        f32x16 o[2]; o[0] = (f32x16){}; o[1] = (f32x16){}; float mrun = NEG_INF, lrun = 0.f;
        const int jlo = qblk >= 8 ? qblk - 8 : 0;
        attn_tiles<1>(lds, A.KW + (size_t)b * SEQ * 128 + kvh * 64, A.VW + (size_t)b * SEQ * 128 + kvh * 64, jlo, qblk, ~0ull, ~0ull, qblk, trel, qr, o, mrun, lrun, tid, r32, hi);
        lrun += __shfl_xor(lrun, 32);
        const float g2 = sigmoidf_(A.PROJ[m * NP + C_GATE + head * 3 + 2]) / fmaxf(lrun, 1e-30f);
#pragma unroll
        for (int dh = 0; dh < 2; ++dh)
#pragma unroll
            for (int r = 0; r < 16; ++r) tot[dh][r] = stash[(dh * 16 + r) * 64] + g2 * o[dh][r];
    }
    bf16* mo = A.MIX + m * 1024 + 512 + head * 64;
#pragma unroll
    for (int dh = 0; dh < 2; ++dh)
#pragma unroll
        for (int a = 0; a < 4; ++a) { const int d0 = 32 * dh + 8 * a + 4 * hi;
            *(v2u*)(mo + d0) = (v2u){pk2(tot[dh][4 * a], tot[dh][4 * a + 1]), pk2(tot[dh][4 * a + 2], tot[dh][4 * a + 3])}; }
}

struct SAttArgs { const bf16* QB; const bf16* KS; const bf16* VS; const bf16* KW; const bf16* VW; const float* CKS; const float* CVS; const float* PROJ; const float* cache; const int* page_table; const float* state_win; bf16* MIX; int l; };
constexpr int S2_IMP = 0, S2_MK = 512, S2_ITEMS = 576, S2_OC = 1024, S2_MG = 8192;
constexpr int S2_MG_STRIDE = 4224;
template <bool F32> __device__ __forceinline__ void s2_block(const void* kbase, const void* vbase, int kstride, int nvalid, const bf16x8 (&qf)[2], const bool (&keep)[4][4], f32x4 (&O)[4], float& mrun, float& lrun, int fr, int fq) {
    f32x4 kraw[4][2][2]; bf16x8 kb[4][2]; f32x4 vraw[2][8]; v2u vb[2][8];
#pragma unroll
    for (int tk = 0; tk < 4; ++tk) { const int key = 16 * tk + fr, kc = key < nvalid ? key : nvalid - 1;
#pragma unroll
        for (int ks = 0; ks < 2; ++ks) {
            if (F32) { const float* p = (const float*)kbase + (size_t)kc * kstride + 32 * ks + 8 * fq; kraw[tk][ks][0] = *(const f32x4*)p; kraw[tk][ks][1] = *(const f32x4*)(p + 4); }
            else kb[tk][ks] = *(const bf16x8*)((const bf16*)kbase + (size_t)kc * 128 + 32 * ks + 8 * fq); } }
#pragma unroll
    for (int ks = 0; ks < 2; ++ks)
#pragma unroll
        for (int j = 0; j < 8; ++j) { const int key = 32 * ks + 16 * (j >> 2) + 4 * fq + (j & 3), kc = key < nvalid ? key : nvalid - 1;
            if (F32) vraw[ks][j] = *(const f32x4*)((const float*)vbase + (size_t)kc * kstride + 4 * fr);
            else vb[ks][j] = *(const v2u*)((const bf16*)vbase + (size_t)kc * 128 + 4 * fr); }
    __builtin_amdgcn_sched_barrier(0);
    f32x4 acc[4];
#pragma unroll
    for (int tk = 0; tk < 4; ++tk) { bf16x8 kx[2];
#pragma unroll
        for (int ks = 0; ks < 2; ++ks) { if (F32) { const f32x4 a = kraw[tk][ks][0], b = kraw[tk][ks][1]; kx[ks] = pack8(a.x, a.y, a.z, a.w, b.x, b.y, b.z, b.w); } else kx[ks] = kb[tk][ks]; }
        f32x4 a4 = {0.f, 0.f, 0.f, 0.f};
        a4 = __builtin_amdgcn_mfma_f32_16x16x32_bf16(kx[0], qf[0], a4, 0, 0, 0); a4 = __builtin_amdgcn_mfma_f32_16x16x32_bf16(kx[1], qf[1], a4, 0, 0, 0);
        acc[tk] = a4; }
    float mx = NEG_INF;
#pragma unroll
    for (int tk = 0; tk < 4; ++tk)
#pragma unroll
        for (int i = 0; i < 4; ++i) { if (!keep[tk][i]) acc[tk][i] = NEG_INF; mx = fmaxf(mx, acc[tk][i]); }
    mx = fmaxf(mx, __shfl_xor(mx, 16)); mx = fmaxf(mx, __shfl_xor(mx, 32));
    const float mn = fmaxf(mrun, mx), msafe = (mn == NEG_INF) ? 0.f : mn, alpha = ex2(mrun - msafe);
    float ls = 0.f;
#pragma unroll
    for (int tk = 0; tk < 4; ++tk)
#pragma unroll
        for (int i = 0; i < 4; ++i) { const float e = ex2(acc[tk][i] - msafe); acc[tk][i] = e; ls += e; }
    lrun = lrun * alpha + ls; mrun = mn;
#pragma unroll
    for (int td = 0; td < 4; ++td) O[td] *= alpha;
#pragma unroll
    for (int ks = 0; ks < 2; ++ks) {
        const bf16x8 pf = pack8(acc[2 * ks][0], acc[2 * ks][1], acc[2 * ks][2], acc[2 * ks][3], acc[2 * ks + 1][0], acc[2 * ks + 1][1], acc[2 * ks + 1][2], acc[2 * ks + 1][3]);
        float vv[8][4];
#pragma unroll
        for (int j = 0; j < 8; ++j) {
            if (F32) { const f32x4 v = vraw[ks][j]; vv[j][0] = v.x; vv[j][1] = v.y; vv[j][2] = v.z; vv[j][3] = v.w; }
            else { const v2u w = vb[ks][j]; vv[j][0] = bf2f((unsigned short)(w.x & 0xffffu)); vv[j][1] = bf2f((unsigned short)(w.x >> 16)); vv[j][2] = bf2f((unsigned short)(w.y & 0xffffu)); vv[j][3] = bf2f((unsigned short)(w.y >> 16)); } }
#pragma unroll
        for (int td = 0; td < 4; ++td) { const bf16x8 vx = pack8(vv[0][td], vv[1][td], vv[2][td], vv[3][td], vv[4][td], vv[5][td], vv[6][td], vv[7][td]);
            O[td] = __builtin_amdgcn_mfma_f32_16x16x32_bf16(vx, pf, O[td], 0, 0, 0); }
    }
}
__device__ __forceinline__ void nsa_sample_unit(const SAttArgs& A, unsigned char* lds, int unit, int tid) {
    const int sb = unit >> 1, kvh = unit & 1, l = A.l;
    const int lane = tid & 63, wave = __builtin_amdgcn_readfirstlane(tid >> 6), fr = lane & 15, fq = lane >> 4;
    const int qi = fr >> 2, qh = fr & 3;
    float* IMP = (float*)(lds + S2_IMP); unsigned* MK = (unsigned*)(lds + S2_MK); int* ITEMS = (int*)(lds + S2_ITEMS);
    const size_t mq = (size_t)MP + sb * 4 + qi;
    __syncthreads();
    if (tid < 8) MK[tid] = 0u;
    bf16x8 qf[2];
#pragma unroll
    for (int ks = 0; ks < 2; ++ks) qf[ks] = *(const bf16x8*)(A.QB + mq * 512 + (kvh * 4 + qh) * 64 + 32 * ks + 8 * fq);
    {
        f32x4 O[4]; float mrun = NEG_INF, lrun = 0.f;
#pragma unroll
        for (int td = 0; td < 4; ++td) O[td] = (f32x4){0.f, 0.f, 0.f, 0.f};
        bool keep[4][4];
#pragma unroll
        for (int tk = 0; tk < 4; ++tk)
#pragma unroll
            for (int i = 0; i < 4; ++i) keep[tk][i] = true;
        const float* ckf = A.CKS + ((size_t)sb * 64 * 2 + kvh) * 64; const float* cvf = A.CVS + ((size_t)sb * 64 * 2 + kvh) * 64;
        f32x4 acc[4];
#pragma unroll
        for (int tk = 0; tk < 4; ++tk) { bf16x8 kx[2];
#pragma unroll
            for (int ks = 0; ks < 2; ++ks) { const float* p = ckf + (size_t)(16 * tk + fr) * 128 + 32 * ks + 8 * fq; const f32x4 a = *(const f32x4*)p, b = *(const f32x4*)(p + 4); kx[ks] = pack8(a.x, a.y, a.z, a.w, b.x, b.y, b.z, b.w); }
            f32x4 a4 = {0.f, 0.f, 0.f, 0.f};
            a4 = __builtin_amdgcn_mfma_f32_16x16x32_bf16(kx[0], qf[0], a4, 0, 0, 0); a4 = __builtin_amdgcn_mfma_f32_16x16x32_bf16(kx[1], qf[1], a4, 0, 0, 0);
            acc[tk] = a4; }
        float mx = NEG_INF;
#pragma unroll
        for (int tk = 0; tk < 4; ++tk)
#pragma unroll
            for (int i = 0; i < 4; ++i) mx = fmaxf(mx, acc[tk][i]);
        mx = fmaxf(mx, __shfl_xor(mx, 16)); mx = fmaxf(mx, __shfl_xor(mx, 32));
        float ls = 0.f;
#pragma unroll
        for (int tk = 0; tk < 4; ++tk)
#pragma unroll
            for (int i = 0; i < 4; ++i) { const float e = ex2(acc[tk][i] - mx); acc[tk][i] = e; ls += e; }
        ls += __shfl_xor(ls, 16); ls += __shfl_xor(ls, 32);
        const float inv = 1.f / fmaxf(ls, 1e-30f);
        if (wave == 0) {
#pragma unroll
            for (int tk = 0; tk < 4; ++tk)
#pragma unroll
                for (int b2 = 0; b2 < 2; ++b2) { float v = (acc[tk][2 * b2] + acc[tk][2 * b2 + 1]) * inv;
                    v += __shfl_xor(v, 1); v += __shfl_xor(v, 2);
                    if (qh == 0) IMP[qi * 32 + 8 * tk + 2 * fq + b2] = v; }
#pragma unroll
            for (int ks = 0; ks < 2; ++ks) {
                const bf16x8 pf = pack8(acc[2 * ks][0], acc[2 * ks][1], acc[2 * ks][2], acc[2 * ks][3], acc[2 * ks + 1][0], acc[2 * ks + 1][1], acc[2 * ks + 1][2], acc[2 * ks + 1][3]);
#pragma unroll
                for (int td = 0; td < 4; ++td) { float vv[8];
#pragma unroll
                    for (int j = 0; j < 8; ++j) { const int key = 32 * ks + 16 * (j >> 2) + 4 * fq + (j & 3); vv[j] = cvf[(size_t)key * 128 + 4 * fr + td]; }
                    const bf16x8 vx = pack8(vv[0], vv[1], vv[2], vv[3], vv[4], vv[5], vv[6], vv[7]);
                    O[td] = __builtin_amdgcn_mfma_f32_16x16x32_bf16(vx, pf, O[td], 0, 0, 0); } }
            const float g0 = sigmoidf_(A.PROJ[mq * NP + C_GATE + (kvh * 4 + qh) * 3 + 0]) * inv;
            float* OC = (float*)(lds + S2_OC);
#pragma unroll
            for (int td = 0; td < 4; ++td)
#pragma unroll
                for (int i = 0; i < 4; ++i) OC[(16 * fq + 4 * i + td) * 16 + fr] = g0 * O[td][i];
        }
        (void)mrun; (void)lrun; (void)keep;
    }
    __syncthreads();
    if (tid < 128) { const int i = tid >> 5, j = tid & 31; bool sel = (j == 0 || j == 31);
        if (j >= 1 && j <= 30) { const float vj = IMP[i * 32 + j]; int rk = 0;
            for (int q = 1; q <= 30; ++q) { const float vi = IMP[i * 32 + q]; rk += (vi > vj || (vi == vj && q < j)) ? 1 : 0; }
            sel = rk < 13; }
        if (sel) { atomicOr(MK + i, 1u << j); atomicOr(MK + 4, 1u << j); } }
    __syncthreads();
    if (tid == 0) { const unsigned um = MK[4]; int n = 0;
        for (int j = 0; j < 32; ++j) if ((um >> j) & 1u) ITEMS[1 + n++] = j;
        ITEMS[1 + n++] = 32;
        for (int jb = 0; jb < 9; ++jb) ITEMS[1 + n++] = 64 + jb;
        ITEMS[0] = n; }
    __syncthreads();
    {
        const int nitems = ITEMS[0]; const unsigned tm = MK[qi];
        f32x4 Os[4], Ow[4]; float ms = NEG_INF, lsum = 0.f, mw = NEG_INF, lw = 0.f;
#pragma unroll
        for (int td = 0; td < 4; ++td) { Os[td] = (f32x4){0.f, 0.f, 0.f, 0.f}; Ow[td] = (f32x4){0.f, 0.f, 0.f, 0.f}; }
        const float* wb = A.state_win + ((size_t)l * NSB + sb) * 512 * 256 + kvh * 64;
        for (int it = wave; it < nitems; it += NWAVES) {
            const int code = ITEMS[1 + it]; bool keep[4][4];
            if (code < 64) {
                const int j = code;
                if (j < 32) { const int phys = A.page_table[sb * NPAGES + (j >> 1)];
                    const float* base = A.cache + ((((size_t)l * NPOOL + phys) * 2 + kvh) * 128 + (j & 1) * 64) * 256;
                    const bool tsel = ((tm >> j) & 1u) != 0u;
#pragma unroll
                    for (int tk = 0; tk < 4; ++tk)
#pragma unroll
                        for (int i = 0; i < 4; ++i) keep[tk][i] = tsel;
                    s2_block<true>(base + 128, base + 192, 256, 64, qf, keep, Os, ms, lsum, fr, fq);
                } else {
#pragma unroll
                    for (int tk = 0; tk < 4; ++tk)
#pragma unroll
                        for (int i = 0; i < 4; ++i) { const int key = 16 * tk + 4 * fq + i; keep[tk][i] = key <= qi; }
                    s2_block<false>(A.KS + ((size_t)MP + sb * 4) * 128 + kvh * 64, A.VS + ((size_t)MP + sb * 4) * 128 + kvh * 64, 128, 4, qf, keep, Os, ms, lsum, fr, fq);
                }
            } else {
                const int jb = code - 64;
                if (jb < 8) {
#pragma unroll
                    for (int tk = 0; tk < 4; ++tk)
#pragma unroll
                        for (int i = 0; i < 4; ++i) { const int r = 64 * jb + 16 * tk + 4 * fq + i; keep[tk][i] = r >= qi; }
                    s2_block<true>(wb + (size_t)(64 * jb) * 256, wb + (size_t)(64 * jb) * 256 + 128, 256, 64, qf, keep, Ow, mw, lw, fr, fq);
                } else {
#pragma unroll
                    for (int tk = 0; tk < 4; ++tk)
#pragma unroll
                        for (int i = 0; i < 4; ++i) { const int key = 16 * tk + 4 * fq + i; keep[tk][i] = key <= qi; }
                    s2_block<false>(A.KW + ((size_t)MP + sb * 4) * 128 + kvh * 64, A.VW + ((size_t)MP + sb * 4) * 128 + kvh * 64, 128, 4, qf, keep, Ow, mw, lw, fr, fq);
                }
            }
        }
        lsum += __shfl_xor(lsum, 16); lsum += __shfl_xor(lsum, 32); lw += __shfl_xor(lw, 16); lw += __shfl_xor(lw, 32);
        float* Ps = (float*)(lds + S2_MG + (wave * 2 + 0) * S2_MG_STRIDE); float* Pw = (float*)(lds + S2_MG + (wave * 2 + 1) * S2_MG_STRIDE);
#pragma unroll
        for (int td = 0; td < 4; ++td)
#pragma unroll
            for (int i = 0; i < 4; ++i) { Ps[(16 * fq + 4 * i + td) * 16 + fr] = Os[td][i]; Pw[(16 * fq + 4 * i + td) * 16 + fr] = Ow[td][i]; }
        if (fq == 0) { Ps[1024 + fr] = ms; Ps[1040 + fr] = lsum; Pw[1024 + fr] = mw; Pw[1040 + fr] = lw; }
    }
    __syncthreads();
    {
        const int q = tid & 15, i = q >> 2, hh = q & 3; const size_t m = (size_t)MP + sb * 4 + i;
        const float* OC = (const float*)(lds + S2_OC);
        float res[2];
#pragma unroll
        for (int k = 0; k < 2; ++k) res[k] = OC[((tid >> 4) + 32 * k) * 16 + q];
#pragma unroll
        for (int br = 0; br < 2; ++br) {
            float M = NEG_INF;
#pragma unroll
            for (int w = 0; w < NWAVES; ++w) M = fmaxf(M, ((const float*)(lds + S2_MG + (w * 2 + br) * S2_MG_STRIDE))[1024 + q]);
            float L = 0.f, o0 = 0.f, o1 = 0.f;
#pragma unroll
            for (int w = 0; w < NWAVES; ++w) { const float* P = (const float*)(lds + S2_MG + (w * 2 + br) * S2_MG_STRIDE);
                const float f = ex2(P[1024 + q] - M);
                L += P[1040 + q] * f; o0 += P[(tid >> 4) * 16 + q] * f; o1 += P[((tid >> 4) + 32) * 16 + q] * f; }
            const float g = sigmoidf_(A.PROJ[m * NP + C_GATE + (kvh * 4 + hh) * 3 + 1 + br]) / fmaxf(L, 1e-30f);
            res[0] += g * o0; res[1] += g * o1;
        }
#pragma unroll
        for (int k = 0; k < 2; ++k) A.MIX[m * 1024 + 512 + (kvh * 4 + hh) * 64 + (tid >> 4) + 32 * k] = (bf16)f2bf(res[k]);
    }
}

constexpr int CW_CMPQ = 256;
__device__ __forceinline__ void compress_pull(const CmpArgs& A, unsigned* head, volatile LAS int* slot, int max_batches, int tid) {
    const int lane = tid & 63, wave = __builtin_amdgcn_readfirstlane(tid >> 6);
    for (int nb = 0; nb < max_batches; ++nb) {
        __syncthreads();
        if (tid == 0) *slot = (int)__hip_atomic_fetch_add(head, 8u, __ATOMIC_RELAXED, __HIP_MEMORY_SCOPE_AGENT);
        __syncthreads();
        const int base = *slot;
        if (base >= 2048) break;
        compress_unit(A, 128 + base + wave, lane);
    }
    __syncthreads();
}

struct Args { const GAS void* in[22]; GAS float* out; GAS unsigned char* ws; int ph_lo, ph_hi; };
constexpr int PH_PER_LAYER = 10, N_PHASES = 1 + NL * PH_PER_LAYER;
__global__ void __launch_bounds__(NWAVES * 64, 2) hymba_fwd(Args args) {
    extern __shared__ __attribute__((aligned(16))) unsigned char lds[];
    const int G = gridDim.x, bx = blockIdx.x, NGW = G * NWAVES;
    const int wave_s_ = __builtin_amdgcn_readfirstlane((int)threadIdx.x >> 6);
#define TID_NOW() (wave_s_ * 64 + (int)__builtin_amdgcn_mbcnt_hi(~0u, __builtin_amdgcn_mbcnt_lo(~0u, 0u)))
#define SUB_IDS int tid = TID_NOW(); asm volatile("" : "+v"(tid)); const int lane = tid & 63, wave = __builtin_amdgcn_readfirstlane(tid >> 6), gw = bx * NWAVES + wave; (void)lane; (void)gw; (void)wave;
#define PHASE_IDS int tid = TID_NOW(); asm volatile("" : "+v"(tid)); const int lane = tid & 63, wave = __builtin_amdgcn_readfirstlane(tid >> 6), gw = bx * NWAVES + wave; (void)lane; (void)gw; const __attribute__((address_space(4))) unsigned long long* ka_ = (const __attribute__((address_space(4))) unsigned long long*)__builtin_amdgcn_kernarg_segment_ptr(); asm volatile("" : "+s"(ka_)); GAS unsigned char* wsg_ = (GAS unsigned char*)ka_[23]; unsigned char* wsl = (unsigned char*)wsg_;
#define x_prompt ((const float*)(const GAS float*)ka_[0])
#define x_sample ((const float*)(const GAS float*)ka_[1])
#define cache_kv ((const float*)(const GAS float*)ka_[2])
#define page_table ((const int*)(const GAS int*)ka_[3])
#define state_win ((const float*)(const GAS float*)ka_[4])
#define state_gdn ((const float*)(const GAS float*)ka_[5])
#define state_conv ((const float*)(const GAS float*)ka_[6])
#define norm_mix ((const float*)(const GAS float*)ka_[7])
#define w_in ((const float*)(const GAS float*)ka_[8])
#define conv_w ((const float*)(const GAS float*)ka_[9])
#define a_log ((const float*)(const GAS float*)ka_[10])
#define dt_bias ((const float*)(const GAS float*)ka_[11])
#define gdn_norm ((const float*)(const GAS float*)ka_[12])
#define cmp_pe_k ((const float*)(const GAS float*)ka_[13])
#define cmp_w_k ((const float*)(const GAS float*)ka_[14])
#define cmp_pe_v ((const float*)(const GAS float*)ka_[15])
#define cmp_w_v ((const float*)(const GAS float*)ka_[16])
#define w_out ((const float*)(const GAS float*)ka_[17])
#define norm_mlp ((const float*)(const GAS float*)ka_[18])
#define w_up ((const float*)(const GAS float*)ka_[19])
#define w_down ((const float*)(const GAS float*)ka_[20])
#define norm_final ((const float*)(const GAS float*)ka_[21])
#define out ((float*)(GAS float*)ka_[22])
#define WIN_T ((bf16*)(wsl + WS_WIN))
#define WOUT_T ((bf16*)(wsl + WS_WOUT))
#define WUP_T ((bf16*)(wsl + WS_WUP))
#define WDN_T ((bf16*)(wsl + WS_WDN))
#define CMPW ((bf16*)(wsl + WS_CMPW))
#define HB ((bf16*)(wsl + WS_HB))
#define PROJ ((float*)(wsl + WS_PROJ))
#define X1 ((float*)(wsl + WS_X1))
#define X2 ((float*)(wsl + WS_X2))
#define MIX ((bf16*)(wsl + WS_MIX))
#define HID ((bf16*)(wsl + WS_HID))
#define QN ((float*)(wsl + WS_QN))
#define KN ((float*)(wsl + WS_KN))
#define VG ((float*)(wsl + WS_VG))
#define OG ((float*)(wsl + WS_OG))
#define GG ((float*)(wsl + WS_G))
#define BETA ((float*)(wsl + WS_BETA))
#define KQ ((float*)(wsl + WS_KQ))
#define QB ((bf16*)(wsl + WS_QB))
#define KS ((bf16*)(wsl + WS_KS))
#define VS ((bf16*)(wsl + WS_VS))
#define KW ((bf16*)(wsl + WS_KW))
#define VW ((bf16*)(wsl + WS_VW))
#define CKP ((float*)(wsl + WS_CKP))
#define CVP ((float*)(wsl + WS_CVP))
#define CKS ((float*)(wsl + WS_CKS))
#define CVS ((float*)(wsl + WS_CVS))
#define GK ((bf16*)(wsl + WS_GK))
#define GQ ((bf16*)(wsl + WS_GQ))
#define GKT ((bf16*)(wsl + WS_GKT))
#define GVT ((bf16*)(wsl + WS_GVT))
#define GG2 ((float*)(wsl + WS_GG2))
#define BETA2 ((float*)(wsl + WS_BETA2))
#define WX ((bf16*)(wsl + WS_WX))
#define QX ((bf16*)(wsl + WS_QX))
#define QKX ((bf16*)(wsl + WS_QKX))
#define KTX ((bf16*)(wsl + WS_KTX))
#define U0F ((float*)(wsl + WS_U0F))
#define GL ((float*)(wsl + WS_GL))
#define PARTD ((float*)(wsl + WS_PARTD))
#define PARTG ((float*)(wsl + WS_PARTG))
    LAS unsigned char* ldsl = (LAS unsigned char*)lds;

    const int lo = args.ph_lo, hi = args.ph_hi;
    { const int t0_ = TID_NOW(); if (t0_ < 16) ((LAS unsigned*)(ldsl + MISC_OFF))[t0_] = 0u; }
    __syncthreads();
    XcdBarrier bar = xcd_barrier_post((unsigned*)((unsigned char*)args.ws + WS_CTL) + CW_BAR, (volatile LAS unsigned*)(ldsl + MISC_OFF), TID_NOW() == 0);
#define BOTH(k) (lo <= (k) && (k) + 1 < hi)
#define GRID_BAR(k) do { if (BOTH(k)) { for (int rb_ = 0; rb_ < REP_BAR; ++rb_) xcd_barrier(bar, TID_NOW() == 0); } } while (0)
#ifndef REP_PG
#define REP_PG 1
#endif
#ifndef REP_PA
#define REP_PA 1
#endif
#ifndef REP_BAR
#define REP_BAR 1
#endif
#ifndef REP_GSMP
#define REP_GSMP 1
#endif
#ifndef REP_P0
#define REP_P0 1
#endif
#ifndef REP_LIGHT
#define REP_LIGHT 1
#endif
#ifndef REP_PB_ROW
#define REP_PB_ROW 1
#endif
#ifndef REP_PB_PREP
#define REP_PB_PREP 1
#endif
#ifndef REP_PB_CMP
#define REP_PB_CMP 1
#endif
#ifndef REP_PB_COPY
#define REP_PB_COPY 1
#endif
#ifndef REP_PB2
#define REP_PB2 1
#endif
#ifndef REP_SCAN
#define REP_SCAN 1
#endif
#ifndef REP_ATTP
#define REP_ATTP 1
#endif
#ifndef REP_ATTS
#define REP_ATTS 1
#endif
#ifndef REP_GEMM
#define REP_GEMM 1
#endif
#define EN(i) (((PH_MASK_T) >> (i)) & 1u)
#define SUB(i) (((SUB_MASK_T) >> (i)) & 1u)
#define IN(k) (lo <= (k) && (k) < hi)

    if (IN(0)) { PHASE_IDS
        for (int rep0 = 0; rep0 < REP_P0; ++rep0) {
        LAS float* scr = (LAS float*)(ldsl + wave * 16384);
        constexpr int I_IN = 16 * 112, I_OUT = 16 * 32, I_UP = 16 * 128, I_DN = 64 * 32, I_C = 32 * 2, I_L = I_IN + I_OUT + I_UP + I_DN + 2 * I_C;
        for (int it = gw; it < NL * I_L; it += NGW) {
            const int l = it / I_L; int r = it % I_L;
            if (r < I_IN) { transpose_item(w_in + (size_t)l * DM * NPROJ, DM, NPROJ, NP, WIN_T + (size_t)l * NP * DM, scr, r, lane); continue; } r -= I_IN;
            if (r < I_OUT) { transpose_item(w_out + (size_t)l * DM * DM, DM, DM, DM, WOUT_T + (size_t)l * DM * DM, scr, r, lane); continue; } r -= I_OUT;
            if (r < I_UP) { transpose_item(w_up + (size_t)l * DM * DFF, DM, DFF, DFF, WUP_T + (size_t)l * DFF * DM, scr, r, lane); continue; } r -= I_UP;
            if (r < I_DN) { transpose_item(w_down + (size_t)l * DFF * DM, DFF, DM, DM, WDN_T + (size_t)l * DM * DFF, scr, r, lane); continue; } r -= I_DN;
            if (r < I_C) { transpose_item(cmp_w_k + (size_t)l * 2048 * 64, 2048, 64, 64, CMPW + (size_t)((l * 2 + 0) * 64) * 2048, scr, r, lane); continue; } r -= I_C;
            transpose_item(cmp_w_v + (size_t)l * 2048 * 64, 2048, 64, 64, CMPW + (size_t)((l * 2 + 1) * 64) * 2048, scr, r, lane);
        }
        for (int m = gw; m < MT; m += NGW) { const float* xr = (m < MP) ? x_prompt + (size_t)m * DM : x_sample + (size_t)(m - MP) * DM; rms_row(xr, norm_mix, HB + (size_t)m * DM, nullptr, lane); }
        }
    }

    GRID_BAR(0);
    for (int l = 0; l < NL; ++l) {
        const int pb = 1 + l * PH_PER_LAYER;
        if (IN(pb + 0)) { PHASE_IDS
            pg8::Gemm g{HB, WIN_T + (size_t)l * NP * DM, MT, NP, DM, DM}; pg8::StaticOrder S; S.init(MT, NP, G, bx);
            pg8::EpiF32 E{PROJ, NP};
            _Pragma("unroll 1") for (int rep = 0; rep < REP_PA; ++rep) pg8::gemm_phase<pg8::EpiF32, pg8::StaticOrder, true, true>(ldsl, g, S, E, tid);
            if (l == 0 && bx >= (MT / 256) * (NP / 256) % G) { SUB_IDS CmpArgs CA{PROJ, cache_kv, page_table, cmp_pe_k, cmp_pe_v, CMPW, wsl, 0};
                compress_pull(CA, (unsigned*)(wsl + WS_CTL) + CW_CMPQ, (volatile LAS int*)(ldsl + MISC_OFF + 36), 1, tid); }
        }
        GRID_BAR(pb + 0);
        if (IN(pb + 1)) { PHASE_IDS
            { SUB_IDS PBArgs A{PROJ, state_conv, conv_w, a_log, dt_bias, QN, KN, VG, GG, BETA, KQ, QB, KS, VS, KW, VW, out, l};
              for (int rep = 0; rep < REP_PB_ROW; ++rep) if (gw >= 128) for (int m = gw - 128; m < MT; m += 2 * (NGW - 128)) {
                  const int m2 = m + (NGW - 128); const bool has2 = m2 < MT; PBRegs r0, r1;
                  pb_row_load(A, m, lane, r0); pb_row_load(A, has2 ? m2 : m, lane, r1);
                  __builtin_amdgcn_sched_barrier(0);
                  pb_row(A, m, lane, r0); if (has2) pb_row(A, m2, lane, r1); }
              for (int u = gw; u < MS * 8; u += NGW) pb_sample_head(A, u, lane); }
            { SUB_IDS GPArgs A{PROJ, conv_w, a_log, dt_bias, GK, GQ, GKT, GVT, GG2, BETA2, l};
              for (int rep = 0; rep < REP_PB_PREP; ++rep) for (int u = gw; u < (MP / 8) * 8; u += 2 * NGW) {
                  GPRegs r0, r1; const int u2 = (u + NGW < (MP / 8) * 8) ? u + NGW : u; gdn_prep_load(A, u, lane, r0); gdn_prep_load(A, u2, lane, r1);
                  __builtin_amdgcn_sched_barrier(0);
                  gdn_prep_unit(A, u, lane, r0); gdn_prep_unit(A, u2, lane, r1); } }
            { SUB_IDS CmpArgs A{PROJ, cache_kv, page_table, cmp_pe_k, cmp_pe_v, CMPW, wsl, l};
              if (gw < 128) compress_unit(A, gw, lane);
              compress_pull(A, (unsigned*)(wsl + WS_CTL) + CW_CMPQ + 64 * l, (volatile LAS int*)(ldsl + MISC_OFF + 36), 1 << 20, tid); }
        }
        GRID_BAR(pb + 1);
        if (IN(pb + 2)) { PHASE_IDS
            GCArgs A{GK, GQ, GKT, GVT, GG2, BETA2, WX, QX, QKX, KTX, U0F, GL};
            for (int rep = 0; rep < REP_PB2; ++rep) for (int u = gw; u < 32 * 64; u += NGW) gdn_chunk_unit(A, lds + wave * GC_LDS_PER_WAVE, u, lane);
        }
        GRID_BAR(pb + 2);
        if (IN(pb + 3)) {
            { PHASE_IDS GdnArgs GA{QN, KN, VG, GG, BETA, KQ, OG, PROJ, state_gdn, gdn_norm, MIX, out, l};
                for (int rep = 0; rep < REP_GSMP; ++rep) for (int u = gw; u < NSB * 8; u += NGW) gdn_sample_unit(GA, u, lane); }
            { PHASE_IDS
                GS2Args SG{WX, QX, QKX, KTX, U0F, GL, OG, out, l};
                AttArgs AA{QB, KS, VS, KW, VW, CKP, CVP, PROJ, MIX};
                SAttArgs SA{QB, KS, VS, KW, VW, CKS, CVS, PROJ, cache_kv, page_table, state_win, MIX, l};
                unsigned* qhead = (unsigned*)(wsl + WS_CTL) + CW_QUEUE + 64 * l;
                volatile LAS int* slot = (volatile LAS int*)(ldsl + MISC_OFF + 32);
                for (;;) {
                    __syncthreads();
                    if (tid == 0) *slot = (int)__hip_atomic_fetch_add(qhead, 1u, __ATOMIC_RELAXED, __HIP_MEMORY_SCOPE_AGENT);
                    __syncthreads();
                    int u = *slot;
                    constexpr int XP = (REP_ATTP - 1) * 512, XS = (REP_ATTS - 1) * 256, XG = (REP_SCAN - 1) * 16;
                    if (u >= 784 + XP + XS + XG + 128) break;
                    if (u >= 784 + XP + XS + XG) {
                        const int sb = u - (784 + XP + XS + XG); const f32x4* src = (const f32x4*)(state_win + ((size_t)l * NSB + sb) * 512 * 256) + 256; f32x4* dst = (f32x4*)(out + O_WINS + ((size_t)l * NSB + sb) * 512 * 256);
                        for (int i = tid; i < 508 * 64; i += 8 * NWAVES * 64) { f32x4 v[8];
#pragma unroll
                            for (int k = 0; k < 8; ++k) { const int ii = i + k * NWAVES * 64; v[k] = src[ii < 508 * 64 ? ii : i]; }
#pragma unroll
                            for (int k = 0; k < 8; ++k) { const int ii = i + k * NWAVES * 64; if (ii < 508 * 64) dst[ii] = v[k]; } }
                        continue; }
                    if (u >= 784) { int v = u - 784; if (v < XP) u = 16 + (v & 511); else { v -= XP; if (v < XS) u = 528 + (v & 255); else u = (v - XS) & 15; } }
                    int tq = TID_NOW(); asm volatile("" : "+v"(tq));
                    if (u < 16) gdn_scan2_wave(SG, 2 * u + (__builtin_amdgcn_readfirstlane(tq >> 6) >> 2), __builtin_amdgcn_readfirstlane(tq >> 6) & 3, tq & 63);
                    else if (u < 16 + 512) nsa_prompt_unit(AA, lds, u - 16, tq);
                    else nsa_sample_unit(SA, lds, u - 528, tq);
                }
            }
        }
        GRID_BAR(pb + 3);
        if (IN(pb + 4)) { PHASE_IDS
            const float gnl = gdn_norm[l * 64 + lane];
            for (int rep = 0; rep < REP_LIGHT; ++rep) for (int m = gw; m < MP; m += NGW) {
                float ov[8], zv[8];
#pragma unroll
                for (int h = 0; h < 8; ++h) { ov[h] = OG[(size_t)m * 512 + h * 64 + lane]; zv[h] = PROJ[(size_t)m * NP + C_Z + h * 64 + lane]; }
                __builtin_amdgcn_sched_barrier(0);
#pragma unroll
                for (int h = 0; h < 8; ++h) { const float ms = dpp_sum(ov[h] * ov[h]) * (1.f / 64.f);
                    MIX[(size_t)m * 1024 + h * 64 + lane] = (bf16)f2bf(ov[h] * (1.f / sqrtf(ms + 1e-6f)) * gnl * siluf_(zv[h])); } }
        }
        GRID_BAR(pb + 4);
        if (IN(pb + 5)) { PHASE_IDS
            { pg8::Gemm g{MIX, WOUT_T + (size_t)l * DM * DM, MP, DM, DM, DM}; pg8::StaticOrder S; S.init(MP, DM, G, bx);
              const float* rb = (l == 0) ? x_prompt : (const float*)X2;
              pg8::EpiResid E{rb, rb, MP, X1, DM};
              pg8::gemm_phase<pg8::EpiResid, pg8::StaticOrder, true, true>(ldsl, g, S, E, tid); }
            { pg8::Gemm g{MIX, WOUT_T + (size_t)l * DM * DM, MT, DM, PD_KL, DM}; pg8::SplitKOrder S; S.init(MP / 256, MS / 256, DM / 256, PD_KS, PD_KL, G, bx);
              pg8::EpiPart E{PARTD, DM, MP, MS};
              pg8::gemm_phase<pg8::EpiPart, pg8::SplitKOrder, false, true>(ldsl, g, S, E, tid); }
        }
        GRID_BAR(pb + 5);
        if (IN(pb + 6)) { PHASE_IDS
            for (int m = gw; m < MP; m += 2 * NGW) { const int m2 = m + NGW;
                if (m2 < MP) rms_row2(X1 + (size_t)m * DM, X1 + (size_t)m2 * DM, norm_mlp + (size_t)l * DM, HB + (size_t)m * DM, HB + (size_t)m2 * DM, nullptr, nullptr, lane);
                else rms_row(X1 + (size_t)m * DM, norm_mlp + (size_t)l * DM, HB + (size_t)m * DM, nullptr, lane); }
            for (int m = MP + gw; m < MT; m += NGW) { const float* bs = (l == 0) ? x_sample + (size_t)(m - MP) * DM : (const float*)X2 + (size_t)m * DM;
                rms_row_parts(bs, PARTD + (size_t)(m - MP) * DM, PD_KS, (size_t)MS * DM, X1 + (size_t)m * DM, norm_mlp + (size_t)l * DM, HB + (size_t)m * DM, nullptr, lane); } }
        GRID_BAR(pb + 6);
        if (IN(pb + 7)) { PHASE_IDS
            pg8::Gemm g{HB, WUP_T + (size_t)l * DFF * DM, MT, DFF, DM, DM}; pg8::StaticOrder S; S.init(MT, DFF, G, bx);
            pg8::EpiRelu2 E{HID, DFF};
            pg8::gemm_phase<pg8::EpiRelu2, pg8::StaticOrder, true, true>(ldsl, g, S, E, tid);
            if (l + 1 < NL && bx >= (MT / 256) * (DFF / 256) % G) { SUB_IDS CmpArgs CA{PROJ, cache_kv, page_table, cmp_pe_k, cmp_pe_v, CMPW, wsl, l + 1};
                compress_pull(CA, (unsigned*)(wsl + WS_CTL) + CW_CMPQ + 64 * (l + 1), (volatile LAS int*)(ldsl + MISC_OFF + 36), 1, tid); }
        }
        GRID_BAR(pb + 7);
        if (IN(pb + 8)) { PHASE_IDS
            { pg8::Gemm g{HID, WDN_T + (size_t)l * DM * DFF, MP, DM, DFF, DFF}; pg8::StaticOrder S; S.init(MP, DM, G, bx);
              pg8::EpiResid E{X1, X1, MP, X2, DM};
              pg8::gemm_phase<pg8::EpiResid, pg8::StaticOrder, true, true>(ldsl, g, S, E, tid); }
            { pg8::Gemm g{HID, WDN_T + (size_t)l * DM * DFF, MT, DM, PG_KL, DFF}; pg8::SplitKOrder S; S.init(MP / 256, MS / 256, DM / 256, PG_KS, PG_KL, G, bx);
              pg8::EpiPart E{PARTG, DM, MP, MS};
              pg8::gemm_phase<pg8::EpiPart, pg8::SplitKOrder, false, true>(ldsl, g, S, E, tid); }
        }
        GRID_BAR(pb + 8);
        if (IN(pb + 9)) { PHASE_IDS
            const float* gn = (l + 1 < NL) ? norm_mix + (size_t)(l + 1) * DM : norm_final; const bool fin = !(l + 1 < NL);
            for (int m = gw; m < MP; m += 2 * NGW) { const int m2 = m + NGW;
                if (m2 < MP) rms_row2(X2 + (size_t)m * DM, X2 + (size_t)m2 * DM, gn, fin ? nullptr : HB + (size_t)m * DM, fin ? nullptr : HB + (size_t)m2 * DM, fin ? out + O_YP + (size_t)m * DM : nullptr, fin ? out + O_YP + (size_t)m2 * DM : nullptr, lane);
                else rms_row(X2 + (size_t)m * DM, gn, fin ? nullptr : HB + (size_t)m * DM, fin ? out + O_YP + (size_t)m * DM : nullptr, lane); }
            for (int m = MP + gw; m < MT; m += NGW)
                rms_row_parts(X1 + (size_t)m * DM, PARTG + (size_t)(m - MP) * DM, PG_KS, (size_t)MS * DM, X2 + (size_t)m * DM, gn, fin ? nullptr : HB + (size_t)m * DM, fin ? out + O_YP + (size_t)m * DM : nullptr, lane);
        }
        GRID_BAR(pb + 9);
    }
#undef IN
}

#undef x_prompt
#undef x_sample
#undef cache_kv
#undef page_table
#undef state_win
#undef state_gdn
#undef state_conv
#undef norm_mix
#undef w_in
#undef conv_w
#undef a_log
#undef dt_bias
#undef gdn_norm
#undef cmp_pe_k
#undef cmp_w_k
#undef cmp_pe_v
#undef cmp_w_v
#undef w_out
#undef norm_mlp
#undef w_up
#undef w_down
#undef norm_final
#undef out
#ifndef MK_PER_PHASE
#define MK_PER_PHASE 0
#endif
typedef void (*kfn_t)(Args); static const kfn_t K_ALL = hymba_fwd;
extern "C" void kernel_launch(void* const* d_in, const int* in_sizes, int n_in, void* d_out, int out_size, void* d_ws, size_t ws_size, hipStream_t stream) {
    static int grid = 0;
    if (grid == 0) {
        if (n_in != 22 || out_size != (int)O_END || ws_size < WS_END) { fprintf(stderr, "kernel_launch: unexpected shapes (n_in %d, out %d, ws %zu)\n", n_in, out_size, ws_size); grid = -1; return; }
        int dev = 0, cus = 0, per_cu = 0;
        if (hipGetDevice(&dev) != hipSuccess || hipDeviceGetAttribute(&cus, hipDeviceAttributeMultiprocessorCount, dev) != hipSuccess) { grid = -1; return; }
        if (hipFuncSetAttribute((const void*)K_ALL, hipFuncAttributeMaxDynamicSharedMemorySize, LDS_BYTES) != hipSuccess) { fprintf(stderr, "kernel_launch: hipFuncSetAttribute failed\n"); grid = -1; return; }
        if (hipOccupancyMaxActiveBlocksPerMultiprocessor(&per_cu, (const void*)K_ALL, NWAVES * 64, LDS_BYTES) != hipSuccess || per_cu < 1) { fprintf(stderr, "kernel_launch: occupancy query says %d blocks per CU\n", per_cu); }
        (void)hipGetLastError();
        grid = cus;
    }
    if (grid < 0) return;
    (void)hipMemsetAsync((char*)d_ws + WS_CTL, 0, CTL_ZERO_BYTES, stream);
    Args a{};
    for (int i = 0; i < 22; ++i) a.in[i] = (const GAS void*)d_in[i];
    a.out = (GAS float*)d_out; a.ws = (GAS unsigned char*)d_ws;
    const dim3 g(grid), b(NWAVES * 64);
#if MK_PER_PHASE
    for (int ph = 0; ph < N_PHASES; ++ph) { a.ph_lo = ph; a.ph_hi = ph + 1; K_ALL<<<g, b, LDS_BYTES, stream>>>(a); }
#else
    a.ph_lo = 0; a.ph_hi = N_PHASES; K_ALL<<<g, b, LDS_BYTES, stream>>>(a);
#endif
}
```

```cpp
#include <hip/hip_runtime.h>
#include <cstdio>
#include <cstdint>
namespace pg8 {
#define PG8_LAS __attribute__((address_space(3)))
typedef unsigned short bf16_t;
typedef short bf16x8 __attribute__((ext_vector_type(8)));
typedef float f32x4 __attribute__((ext_vector_type(4)));
typedef unsigned u32x4 __attribute__((ext_vector_type(4)));
constexpr int BM = 256, BK = 64, HALF = 128, HTB = HALF * BK * 2  , STAGE_BYTES = 8 * HTB, NXCD = 8, WGM = 8;

__host__ __device__ __forceinline__ int lds_byte(int r, int c) { const int st = (r >> 4) * 2 + (c >> 5), rr = r & 15, cc = c & 31, ob = rr * 64 + cc * 2; return st * 1024 + (ob ^ (((ob >> 9) & 1) << 5)); }
__host__ __device__ __forceinline__ void stage_rc(int b, int& R, int& C) { const int st = b / 1024, sb = b % 1024, swz = sb ^ (((sb >> 9) & 1) << 5); R = (st >> 1) * 16 + swz / 64; C = (st & 1) * 32 + (swz % 64) / 2; }
__host__ __device__ __forceinline__ int perm32(int rho) { const int n = rho >> 4, i = rho & 15; return 8 * (i >> 2) + 4 * n + (i & 3); }

struct Unit { int pm, pn, kofs, kc; };
struct Gemm { const bf16_t* A; const bf16_t* Bt; int M, N, K, ld; };

struct StaticOrder {
    int nM, nN, nwg, G, c;
    __host__ __device__ void init(int M, int N, int G_, int c_) { nM = M / BM; nN = N / BM; nwg = nM * nN; G = G_; c = c_; }
    __host__ __device__ bool next(int i, Unit& u) const {
        const long L = (long)i * G + c; if (L >= nwg) return false;
        int wgid = (int)L; { const int q = nwg / NXCD, r = nwg % NXCD, xcd = wgid % NXCD, off = wgid / NXCD; wgid = (xcd < r ? xcd * (q + 1) : r * (q + 1) + (xcd - r) * q) + off; }
        const int nig = WGM * nN, gid = wgid / nig, fm = gid * WGM, gsz = (nM - fm) < WGM ? (nM - fm) : WGM;
        u.pm = fm + ((wgid % nig) % gsz); u.pn = (wgid % nig) / gsz; u.kofs = 0; u.kc = 0; return true;
    }
    __device__ __forceinline__ void a_ready(const Unit&) const {}
    __device__ __forceinline__ void done(const Unit&) const {}
};

__device__ __forceinline__ unsigned cvt_pk_bf16(float lo, float hi) { unsigned r; asm volatile("v_cvt_pk_bf16_f32 %0, %1, %2" : "=v"(r) : "v"(lo), "v"(hi)); return r; }

struct EpiF32 {
    static constexpr bool PERM = false, AFTER_DRAIN = false;
    float* O; int ldc;
    __device__ __forceinline__ void operator()(const f32x4 (&acc)[2][2][4][2], const Unit& u, int wr, int wc, int fr, int fq) const {
        const int row0 = u.pm * BM + wr * 64 + fr, col0 = u.pn * BM + wc * 32 + 4 * fq;
#pragma unroll
        for (int ai = 0; ai < 2; ++ai)
#pragma unroll
            for (int m = 0; m < 4; ++m) { float* rowp = O + (size_t)(row0 + ai * HALF + m * 16) * ldc + col0;
#pragma unroll
                for (int bj = 0; bj < 2; ++bj)
#pragma unroll
                    for (int n = 0; n < 2; ++n) *(f32x4*)(rowp + bj * HALF + n * 16) = acc[ai][bj][m][n]; }
    }
};
struct EpiResid {
    static constexpr bool PERM = false, AFTER_DRAIN = false;
    const float* base; const float* base2; int split_row; float* O; int ldc;
    __device__ __forceinline__ void operator()(const f32x4 (&acc)[2][2][4][2], const Unit& u, int wr, int wc, int fr, int fq) const {
        const int row0 = u.pm * BM + wr * 64 + fr, col0 = u.pn * BM + wc * 32 + 4 * fq;
        const float* bs = (u.pm * BM >= split_row) ? (base2 - (size_t)split_row * ldc) : base;
#pragma unroll
        for (int ai = 0; ai < 2; ++ai)
#pragma unroll
            for (int m = 0; m < 4; ++m) { const size_t off = (size_t)(row0 + ai * HALF + m * 16) * ldc + col0;
#pragma unroll
                for (int bj = 0; bj < 2; ++bj)
#pragma unroll
                    for (int n = 0; n < 2; ++n) { const f32x4 r = *(const f32x4*)(bs + off + bj * HALF + n * 16); *(f32x4*)(O + off + bj * HALF + n * 16) = r + acc[ai][bj][m][n]; } }
    }
};
struct EpiRelu2 {
    static constexpr bool PERM = true, AFTER_DRAIN = false;
    bf16_t* O; int ldc;
    __device__ __forceinline__ void operator()(const f32x4 (&acc)[2][2][4][2], const Unit& u, int wr, int wc, int fr, int fq) const {
        const int row0 = u.pm * BM + wr * 64 + fr, col0 = u.pn * BM + wc * 32 + 8 * fq;
#pragma unroll
        for (int ai = 0; ai < 2; ++ai)
#pragma unroll
            for (int m = 0; m < 4; ++m) { bf16_t* rowp = O + (size_t)(row0 + ai * HALF + m * 16) * ldc + col0;
#pragma unroll
                for (int bj = 0; bj < 2; ++bj) { f32x4 v0 = acc[ai][bj][m][0], v1 = acc[ai][bj][m][1];
#pragma unroll
                    for (int i = 0; i < 4; ++i) { const float a = v0[i] > 0.f ? v0[i] : 0.f, b = v1[i] > 0.f ? v1[i] : 0.f; v0[i] = a * a; v1[i] = b * b; }
                    u32x4 w; w.x = cvt_pk_bf16(v0[0], v0[1]); w.y = cvt_pk_bf16(v0[2], v0[3]); w.z = cvt_pk_bf16(v1[0], v1[1]); w.w = cvt_pk_bf16(v1[2], v1[3]);
                    *(u32x4*)(rowp + bj * HALF) = w; } }
    }
};

struct SplitKOrder {
    int pm0, nN, KS, KL, total, G, c;
    __host__ __device__ void init(int pm0_, int nPm, int nN_, int KS_, int KL_, int G_, int c_) { pm0 = pm0_; nN = nN_; KS = KS_; KL = KL_; total = nPm * nN_ * KS_; G = G_; c = c_; }
    __host__ __device__ bool next(int i, Unit& u) const {
        const long L = (long)i * G + c; if (L >= total) return false;
        const int l = (int)L, kc = l % KS, rest = l / KS; u.pn = rest % nN; u.pm = pm0 + rest / nN; u.kofs = kc * KL; u.kc = kc; return true; }
    __device__ __forceinline__ void a_ready(const Unit&) const {}
    __device__ __forceinline__ void done(const Unit&) const {}
};
struct EpiPart {
    static constexpr bool PERM = false, AFTER_DRAIN = false;
    float* P; int ldc; int row0; int rows;
    __device__ __forceinline__ void operator()(const f32x4 (&acc)[2][2][4][2], const Unit& u, int wr, int wc, int fr, int fq) const {
        const int rowl = u.pm * BM - row0 + wr * 64 + fr, col0 = u.pn * BM + wc * 32 + 4 * fq;
        float* base = P + (size_t)u.kc * rows * ldc;
#pragma unroll
        for (int ai = 0; ai < 2; ++ai)
#pragma unroll
            for (int m = 0; m < 4; ++m) { float* rowp = base + (size_t)(rowl + ai * HALF + m * 16) * ldc + col0;
#pragma unroll
                for (int bj = 0; bj < 2; ++bj)
#pragma unroll
                    for (int n = 0; n < 2; ++n) *(f32x4*)(rowp + bj * HALF + n * 16) = acc[ai][bj][m][n]; }
    }
};
template <class Epi, class Sched, bool ALIGN_EPI = false, bool SP2 = false>
__device__ __forceinline__ void gemm_phase(PG8_LAS unsigned char* lds, const Gemm g, const Sched& S, const Epi& E, int tid_in) {
    int tid = tid_in; asm volatile("" : "+v"(tid));
    const int wid = __builtin_amdgcn_readfirstlane(tid >> 6), lane = tid & 63, wr = wid >> 2, wc = wid & 3, fr = lane & 15, fq = lane >> 4;
    const int K = g.ld, nt = g.K / BK;
    unsigned voffA[2], voffB[2];
#pragma unroll
    for (int i = 0; i < 2; ++i) { int R, C; stage_rc(tid * 16 + i * 8192, R, C); const int Rb = Epi::PERM ? ((R & ~31) + perm32(R & 31)) : R;
        voffA[i] = (unsigned)(R * K + C) * 2u; voffB[i] = (unsigned)(Rb * K + C) * 2u; }
    const size_t kstep = (size_t)(BK * 2);
    const size_t hstep = (size_t)HALF * K * 2;
    const size_t tstep = 2 * hstep;
    const unsigned ldsw = (unsigned)wid * 1024u;
    const int aoff = lds_byte(wr * 64 + fr, fq * 8), boff = lds_byte(wc * 32 + fr, fq * 8);
#define PG8_SA(b, h) (((b) * 2 + (h)) * HTB)
#define PG8_SB(b, h) ((4 + (b) * 2 + (h)) * HTB)
#define PG8_STAGE(bufoff, gbase, voff) do { _Pragma("unroll") for (int _i = 0; _i < 2; ++_i) \
        __builtin_amdgcn_global_load_lds((const unsigned*)((const char*)(gbase) + (voff)[_i]), (PG8_LAS unsigned*)(lds + (bufoff) + ldsw + _i * 8192), 16, 0, 0); } while (0)
#define PG8_LDA(dst, b, h) do { _Pragma("unroll") for (int m = 0; m < 4; ++m) _Pragma("unroll") for (int k = 0; k < 2; ++k) dst[m][k] = *(const PG8_LAS bf16x8*)(lds + PG8_SA(b, h) + aoff + m * 2048 + k * 1024); } while (0)
#define PG8_LDB(dst, b, h) do { _Pragma("unroll") for (int n = 0; n < 2; ++n) _Pragma("unroll") for (int k = 0; k < 2; ++k) dst[n][k] = *(const PG8_LAS bf16x8*)(lds + PG8_SB(b, h) + boff + n * 2048 + k * 1024); } while (0)
#define PG8_MMA(ai, bj, At, Bt) do { __builtin_amdgcn_s_setprio(1); _Pragma("unroll") for (int m = 0; m < 4; ++m) _Pragma("unroll") for (int n = 0; n < 2; ++n) _Pragma("unroll") for (int k = 0; k < 2; ++k) \
        acc[ai][bj][m][n] = __builtin_amdgcn_mfma_f32_16x16x32_bf16(Bt[n][k], At[m][k], acc[ai][bj][m][n], 0, 0, 0); __builtin_amdgcn_s_setprio(0); } while (0)
#define PG8_WAIT_V(n) asm volatile("s_waitcnt vmcnt(" #n ")" ::: "memory")
#define PG8_WAIT_L(n) asm volatile("s_waitcnt lgkmcnt(" #n ")" ::: "memory")
#define PG8_BAR __builtin_amdgcn_s_barrier()
#define PG8_SCHED __builtin_amdgcn_sched_barrier(0)
    Unit cur, nxt; int ui = 0;
    if (!S.next(0, cur)) return;
    f32x4 acc[2][2][4][2];
#pragma unroll
    for (int a = 0; a < 2; ++a)
#pragma unroll
        for (int b = 0; b < 2; ++b)
#pragma unroll
            for (int m = 0; m < 4; ++m)
#pragma unroll
                for (int n = 0; n < 2; ++n) acc[a][b][m][n] = (f32x4){0.f, 0.f, 0.f, 0.f};
    bf16x8 At[4][2], B0[2][2], B1[2][2];
    const char* cA = (const char*)g.A + (size_t)cur.pm * tstep + (size_t)cur.kofs * 2; const char* cB = (const char*)g.Bt + (size_t)cur.pn * tstep + (size_t)cur.kofs * 2;
    S.a_ready(cur);
    if constexpr (SP2) {
        PG8_STAGE(PG8_SB(0, 0), cB, voffB); PG8_STAGE(PG8_SB(0, 1), cB + hstep, voffB); PG8_STAGE(PG8_SA(0, 0), cA, voffA); PG8_STAGE(PG8_SA(0, 1), cA + hstep, voffA);
        if (wr == 1) PG8_BAR;
        PG8_WAIT_V(2); PG8_BAR;
        PG8_STAGE(PG8_SB(1, 0), cB + kstep, voffB); PG8_STAGE(PG8_SA(1, 0), cA + kstep, voffA); PG8_STAGE(PG8_SB(1, 1), cB + hstep + kstep, voffB);
        PG8_WAIT_V(6); PG8_BAR;
    } else {
        PG8_STAGE(PG8_SB(0, 0), cB, voffB); PG8_STAGE(PG8_SA(0, 0), cA, voffA); PG8_STAGE(PG8_SB(0, 1), cB + hstep, voffB); PG8_STAGE(PG8_SA(0, 1), cA + hstep, voffA);
        if (wr == 1) PG8_BAR;
        PG8_WAIT_V(4); PG8_BAR;
        PG8_STAGE(PG8_SB(1, 0), cB + kstep, voffB); PG8_STAGE(PG8_SA(1, 0), cA + kstep, voffA); PG8_STAGE(PG8_SB(1, 1), cB + hstep + kstep, voffB);
        PG8_WAIT_V(6); PG8_BAR;
    }
    for (;;) {
        const bool has_next = S.next(ui + 1, nxt);
        const char* nA = has_next ? (const char*)g.A + (size_t)nxt.pm * tstep + (size_t)nxt.kofs * 2 : cA; const char* nB = has_next ? (const char*)g.Bt + (size_t)nxt.pn * tstep + (size_t)nxt.kofs * 2 : cB;
        for (int t = 0; t < nt; t += 2) {
            const bool last = (t == nt - 2);
            const char* a1 = cA + (size_t)(t + 1) * kstep;
            const char* a2 = last ? nA : cA + (size_t)(t + 2) * kstep; const char* b2 = last ? nB : cB + (size_t)(t + 2) * kstep;
            const char* a3 = a2 + kstep; const char* b3 = b2 + kstep;
            if (last && has_next) S.a_ready(nxt);
            if constexpr (SP2) {
            PG8_LDB(B0, 0, 0); PG8_LDB(B1, 0, 1); PG8_SCHED; PG8_LDA(At, 0, 0); PG8_STAGE(PG8_SA(1, 1), a1 + hstep, voffA);
            PG8_WAIT_V(8); PG8_WAIT_L(0); PG8_BAR; PG8_MMA(0, 0, At, B0); PG8_MMA(0, 1, At, B1); PG8_BAR; PG8_SCHED;
            PG8_LDA(At, 0, 1); PG8_STAGE(PG8_SB(0, 0), b2, voffB); PG8_STAGE(PG8_SB(0, 1), b2 + hstep, voffB); PG8_STAGE(PG8_SA(0, 0), a2, voffA);
            PG8_WAIT_V(8); PG8_WAIT_L(0); PG8_BAR; PG8_MMA(1, 0, At, B0); PG8_MMA(1, 1, At, B1); PG8_BAR; PG8_SCHED;
            PG8_LDB(B0, 1, 0); PG8_LDB(B1, 1, 1); PG8_SCHED; PG8_LDA(At, 1, 0); PG8_STAGE(PG8_SA(0, 1), a2 + hstep, voffA);
            PG8_WAIT_V(8); PG8_WAIT_L(0); PG8_BAR; PG8_MMA(0, 0, At, B0); PG8_MMA(0, 1, At, B1); PG8_BAR; PG8_SCHED;
            PG8_LDA(At, 1, 1); PG8_STAGE(PG8_SB(1, 0), b3, voffB); PG8_STAGE(PG8_SB(1, 1), b3 + hstep, voffB); PG8_STAGE(PG8_SA(1, 0), a3, voffA);
            PG8_WAIT_V(8); PG8_WAIT_L(0); PG8_BAR; PG8_MMA(1, 0, At, B0); PG8_MMA(1, 1, At, B1); PG8_BAR; PG8_SCHED;
            } else {
            PG8_LDB(B0, 0, 0); PG8_SCHED; PG8_LDA(At, 0, 0); PG8_STAGE(PG8_SA(1, 1), a1 + hstep, voffA);
            PG8_WAIT_L(8); PG8_BAR; PG8_WAIT_L(0); PG8_MMA(0, 0, At, B0); PG8_BAR; PG8_SCHED;
            PG8_LDB(B1, 0, 1); PG8_STAGE(PG8_SB(0, 0), b2, voffB);
            PG8_BAR; PG8_WAIT_L(0); PG8_MMA(0, 1, At, B1); PG8_BAR;
            PG8_LDA(At, 0, 1); PG8_STAGE(PG8_SA(0, 0), a2, voffA);
            PG8_BAR; PG8_WAIT_L(0); PG8_MMA(1, 0, At, B0); PG8_BAR; PG8_SCHED;
            PG8_STAGE(PG8_SB(0, 1), b2 + hstep, voffB);
            PG8_WAIT_V(6); PG8_BAR; PG8_MMA(1, 1, At, B1); PG8_BAR;
            PG8_LDB(B0, 1, 0); PG8_SCHED; PG8_LDA(At, 1, 0); PG8_STAGE(PG8_SA(0, 1), a2 + hstep, voffA);
            PG8_WAIT_L(8); PG8_BAR; PG8_WAIT_L(0); PG8_MMA(0, 0, At, B0); PG8_BAR; PG8_SCHED;
            PG8_LDB(B1, 1, 1); PG8_STAGE(PG8_SB(1, 0), b3, voffB);
            PG8_BAR; PG8_WAIT_L(0); PG8_MMA(0, 1, At, B1); PG8_BAR;
            PG8_LDA(At, 1, 1); PG8_STAGE(PG8_SA(1, 0), a3, voffA);
            PG8_BAR; PG8_WAIT_L(0); PG8_MMA(1, 0, At, B0); PG8_BAR; PG8_SCHED;
            PG8_STAGE(PG8_SB(1, 1), b3 + hstep, voffB);
            PG8_WAIT_V(6); PG8_BAR; PG8_MMA(1, 1, At, B1); PG8_BAR;
            }
        }
        if constexpr (ALIGN_EPI) { if (wr == 0) PG8_BAR; }
        if constexpr (!Epi::AFTER_DRAIN) { E(acc, cur, wr, wc, fr, fq); S.done(cur); }
        if (!has_next) break;
#pragma unroll
        for (int a = 0; a < 2; ++a)
#pragma unroll
            for (int b = 0; b < 2; ++b)
#pragma unroll
                for (int m = 0; m < 4; ++m)
#pragma unroll
                    for (int n = 0; n < 2; ++n) acc[a][b][m][n] = (f32x4){0.f, 0.f, 0.f, 0.f};
        cur = nxt; cA = nA; cB = nB; ++ui;
        if constexpr (ALIGN_EPI) { if (wr == 1) PG8_BAR; }
    }
    PG8_WAIT_V(0);
    if constexpr (!ALIGN_EPI) { if (wr == 0) PG8_BAR; }
    PG8_BAR;
    if constexpr (Epi::AFTER_DRAIN) { E.fused(acc, cur, wr, wc, fr, fq, lds, wid, lane); S.done(cur); }
#undef PG8_SA
#undef PG8_SB
#undef PG8_STAGE
#undef PG8_LDA
#undef PG8_LDB
#undef PG8_MMA
#undef PG8_WAIT_V
#undef PG8_WAIT_L
#undef PG8_BAR
#undef PG8_SCHED
}
}

constexpr int DM = 1024, NPB = 4, SEQ = 4096, MP = NPB * SEQ, NSB = 128, DSEQ = 4, MS = NSB * DSEQ, MT = MP + MS;
constexpr int NPROJ = 3368, NP = 3584, DFF = 4096, NL = 2;
constexpr int C_QKV = 0, C_Z = 1536, C_A = 2048, C_BETA = 2056, C_Q = 2064, C_KV = 2576, C_GATE = 3344;
constexpr int PAST = 2048, NPAGES = 16, NPOOL = 2560;
constexpr float C2 = 0.125f * 1.4426950408889634f;
constexpr float NEG_INF = -__builtin_inff();
constexpr size_t O_YP = 0, O_YS = 16777216, O_KVP = 17301504, O_KVS = 34078720, O_WINP = 34603008, O_WINS = 35651584, O_GDNP = 69206016, O_GDNS = 69468160, O_CONVP = 77856768, O_CONVS = 77893632, O_END = 79073280;
constexpr size_t MiB = 1u << 20;
constexpr size_t WS_CTL = 0, CTL_ZERO_BYTES = 1 * MiB;
constexpr size_t WS_WIN = 2 * MiB, WS_WOUT = 16 * MiB, WS_WUP = 20 * MiB, WS_WDN = 36 * MiB, WS_CMPW = 52 * MiB;
constexpr size_t WS_HB = 54 * MiB, WS_PROJ = 88 * MiB, WS_X1 = 320 * MiB, WS_X2 = 386 * MiB, WS_MIX = 452 * MiB, WS_HID = 486 * MiB;
constexpr size_t WS_QN = 618 * MiB, WS_KN = 651 * MiB, WS_VG = 684 * MiB, WS_OG = 717 * MiB, WS_G = 750 * MiB, WS_BETA = 751 * MiB, WS_KQ = 752 * MiB;
constexpr size_t WS_QB = 753 * MiB, WS_KS = 770 * MiB, WS_VS = 775 * MiB, WS_KW = 780 * MiB, WS_VW = 785 * MiB;
constexpr size_t WS_CKP = 790 * MiB, WS_CVP = 791 * MiB, WS_CKS = 792 * MiB, WS_CVS = 796 * MiB;
constexpr size_t WS_GK = 800 * MiB, WS_GQ = 816 * MiB, WS_GKT = 832 * MiB, WS_GVT = 848 * MiB, WS_GG2 = 864 * MiB, WS_BETA2 = 865 * MiB;
constexpr size_t WS_WX = 866 * MiB, WS_QX = 882 * MiB, WS_QKX = 898 * MiB, WS_KTX = 914 * MiB, WS_U0F = 930 * MiB, WS_GL = 962 * MiB, WS_END = 1043 * MiB;
constexpr size_t WS_PARTD = 963 * MiB, WS_PARTG = 979 * MiB;
constexpr int PD_KS = 4, PD_KL = DM / PD_KS, PG_KS = 8, PG_KL = DFF / PG_KS;
constexpr int CW_QUEUE = 64;
constexpr int CW_BAR = 4096;
constexpr int RING_BYTES = 131072, LDS_BYTES = 147456, MISC_OFF = LDS_BYTES - 64;
constexpr int NWAVES = 8;

#define GAS __attribute__((address_space(1)))
#define LAS __attribute__((address_space(3)))
typedef unsigned short bf16;
typedef unsigned v4u __attribute__((ext_vector_type(4)));
typedef unsigned v2u __attribute__((ext_vector_type(2)));
typedef float f32x4 __attribute__((ext_vector_type(4)));
typedef float f32x16 __attribute__((ext_vector_type(16)));
typedef short bf16x8 __attribute__((ext_vector_type(8)));
typedef short s16x4 __attribute__((ext_vector_type(4)));
#define LDS_WAIT() asm volatile("s_waitcnt lgkmcnt(0)" ::: "memory")
__device__ __forceinline__ unsigned f2bf(float f) { unsigned u = __builtin_bit_cast(unsigned, f); return (u + 0x7fffu + ((u >> 16) & 1u)) >> 16; }
typedef float f32x2_t_ __attribute__((ext_vector_type(2))); typedef __bf16 bf16x2_t_ __attribute__((ext_vector_type(2)));
__device__ __forceinline__ unsigned pk2(float lo, float hi) { const f32x2_t_ v = {lo, hi}; const bf16x2_t_ b = __builtin_convertvector(v, bf16x2_t_); return __builtin_bit_cast(unsigned, b); }
__device__ __forceinline__ float bf2f(unsigned short b) { return __builtin_bit_cast(float, (unsigned)b << 16); }
__device__ __forceinline__ bf16x8 pack8(float a0, float a1, float a2, float a3, float a4, float a5, float a6, float a7) {
    v4u w; w.x = pk2(a0, a1); w.y = pk2(a2, a3); w.z = pk2(a4, a5); w.w = pk2(a6, a7); return __builtin_bit_cast(bf16x8, w); }
__device__ __forceinline__ float wave_sum(float v) {
#pragma unroll
    for (int o = 1; o < 64; o <<= 1) v += __shfl_xor(v, o);
    return v;
}
template <int CTRL, int RMASK> __device__ __forceinline__ float dpp_add(float v) {
    const int t = __builtin_amdgcn_update_dpp(0, __builtin_bit_cast(int, v), CTRL, RMASK, 0xf, false);
    return v + __builtin_bit_cast(float, t);
}
__device__ __forceinline__ float dpp_sum(float v) {
    v = dpp_add<0x111, 0xf>(v); v = dpp_add<0x112, 0xf>(v); v = dpp_add<0x114, 0xf>(v); v = dpp_add<0x118, 0xf>(v);
    v = dpp_add<0x142, 0xa>(v); v = dpp_add<0x143, 0xc>(v);
    return __builtin_bit_cast(float, __builtin_amdgcn_readlane(__builtin_bit_cast(int, v), 63));
}
__device__ __forceinline__ float ex2(float x) { return __builtin_amdgcn_exp2f(x); }
__device__ __forceinline__ float sigmoidf_(float x) { return 1.f / (1.f + __expf(-x)); }
__device__ __forceinline__ float siluf_(float x) { return x / (1.f + __expf(-x)); }
__device__ __forceinline__ int crow(int r, int hi) { return (r & 3) + 8 * (r >> 2) + 4 * hi; }
__device__ __forceinline__ void rope_cs(int pos, int d, float& cs, float& sn) {
    const float invf = exp2f(-(float)d * 0.4152410118609203f);
    double rv = (double)pos * (double)invf * 0.15915494309189535; rv -= floor(rv);
    const float rf = (float)rv; sn = __builtin_amdgcn_sinf(rf); cs = __builtin_amdgcn_cosf(rf);
}

#define XB_TMO      128
#define XB_XCNT(j)  (256  + 64 * (j))
#define XB_XSUB(j)  (1280 + 64 * (j))
#define XB_XGEN(j)  (2304 + 64 * (j))
#define XB_TOP      3328
#define XB_TOPGEN   3392
#define XCD_BAR_WORDS 3456
#define XB_SPIN_CAP (1u << 18)

__device__ __forceinline__ unsigned xb_ld(unsigned* p)              { return __hip_atomic_load(p, __ATOMIC_RELAXED, __HIP_MEMORY_SCOPE_AGENT); }
__device__ __forceinline__ unsigned xb_add(unsigned* p, unsigned v) { return __hip_atomic_fetch_add(p, v, __ATOMIC_RELAXED, __HIP_MEMORY_SCOPE_AGENT); }
__device__ __forceinline__ unsigned xb_xcc_id() { return (unsigned)__builtin_amdgcn_s_getreg((3 << 11) | 20) & 0xFu; }
#define XB_SPIN(cond, bar) do { unsigned _sp = 0; while (cond) { __builtin_amdgcn_s_sleep(1); \
    if ((++_sp & 255u) == 0u) { if (xb_ld(&(bar)[XB_TMO])) break; if (_sp > XB_SPIN_CAP) { atomicAdd(&(bar)[XB_TMO], 1u); break; } } } } while (0)

struct XcdBarrier {
    unsigned* bar; unsigned x;
    volatile LAS unsigned* st;
};

__device__ __forceinline__ XcdBarrier xcd_barrier_post(unsigned* bar, volatile LAS unsigned* st, bool leader) {
    XcdBarrier b; b.bar = bar; b.x = xb_xcc_id(); b.st = st;
    if (leader) (void)xb_add(&bar[XB_XCNT(b.x)], 1u);
    return b;
}
__device__ __forceinline__ void xcd_barrier_complete(unsigned* bar, unsigned x, unsigned& nloc, unsigned& nx) {
    const unsigned G = gridDim.x * gridDim.y * gridDim.z;
    unsigned sum, cnt, mine, sp = 0u;
    for (;;) {
        sum = 0u; cnt = 0u; mine = 0u;
#pragma unroll
        for (unsigned j = 0; j < 16; ++j) { const unsigned c = xb_ld(&bar[XB_XCNT(j)]); sum += c; cnt += (c > 0u) ? 1u : 0u; mine = (j == x) ? c : mine; }
        if (sum == G) break;
        __builtin_amdgcn_s_sleep(1);
        if ((++sp & 255u) == 0u) { if (xb_ld(&bar[XB_TMO])) break; if (sp > XB_SPIN_CAP) { atomicAdd(&bar[XB_TMO], 1u); break; } }
    }
    nloc = mine > 0u ? mine : 1u; nx = cnt > 0u ? cnt : 1u;
}

__device__ __forceinline__ void xcd_barrier(const XcdBarrier& b, bool leader) {
    asm volatile("s_waitcnt vmcnt(0)" ::: "memory");
    __syncthreads();
    if (leader) {
        unsigned* bar = b.bar;
        __builtin_amdgcn_s_waitcnt(0);
        unsigned nloc = b.st[0], nx = b.st[1];
        if (nloc == 0u) { xcd_barrier_complete(bar, b.x, nloc, nx); b.st[0] = nloc; b.st[1] = nx; }
        const unsigned old = xb_add(&bar[XB_XSUB(b.x)], 1u);
        const unsigned gen = old / nloc;
        if (old + 1u == (gen + 1u) * nloc) {
            __builtin_amdgcn_fence(__ATOMIC_RELEASE, "agent");
            asm volatile("s_waitcnt vmcnt(0)" ::: "memory");
            const unsigned og = xb_add(&bar[XB_TOP], 1u);
            const unsigned tg = og / nx;
            if (og + 1u == (tg + 1u) * nx) xb_add(&bar[XB_TOPGEN], 1u);
            else XB_SPIN(xb_ld(&bar[XB_TOPGEN]) == tg, bar);
            __builtin_amdgcn_fence(__ATOMIC_ACQUIRE, "agent");
            xb_add(&bar[XB_XGEN(b.x)], 1u);
            asm volatile("s_waitcnt vmcnt(0)" ::: "memory");
        } else {
            XB_SPIN(xb_ld(&bar[XB_XGEN(b.x)]) == gen, bar);
            __builtin_amdgcn_fence(__ATOMIC_ACQUIRE, "agent");
            asm volatile("s_waitcnt vmcnt(0)" ::: "memory");
        }
    }
    __syncthreads();
}

__device__ __forceinline__ void transpose_item(const float* W, int K, int N, int Npad, bf16* WT, LAS float* scr, int item, int lane) {
    const int nblk = Npad / 32, kb = item / nblk, nb = item % nblk, k0 = 64 * kb, n0 = 32 * nb;
    const int ncol = n0 + (lane & 31);
#pragma unroll 8
    for (int i = 0; i < 32; ++i) { const int kk = 2 * i + (lane >> 5); scr[kk * 33 + (lane & 31)] = (ncol < N) ? W[(size_t)(k0 + kk) * N + ncol] : 0.f; }
    LDS_WAIT(); asm volatile("" ::: "memory");
    const int c = lane & 7;
#pragma unroll
    for (int j = 0; j < 4; ++j) { const int n = (lane >> 3) + 8 * j; const LAS float* s = scr + (8 * c) * 33 + n;
        v4u o; o.x = pk2(s[0 * 33], s[1 * 33]); o.y = pk2(s[2 * 33], s[3 * 33]); o.z = pk2(s[4 * 33], s[5 * 33]); o.w = pk2(s[6 * 33], s[7 * 33]);
        *(v4u*)(WT + (size_t)(n0 + n) * K + k0 + 8 * c) = o; }
    LDS_WAIT(); asm volatile("" ::: "memory");
}
__device__ __forceinline__ void rms_row(const float* xrow, const float* g, bf16* orow, float* of32, int lane) {
    const f32x4* xr = (const f32x4*)xrow + lane;
    f32x4 v[4]; float s = 0.f;
#pragma unroll
    for (int j = 0; j < 4; ++j) { v[j] = xr[64 * j]; s += (v[j].x * v[j].x + v[j].y * v[j].y) + (v[j].z * v[j].z + v[j].w * v[j].w); }
    const float rstd = 1.f / sqrtf(wave_sum(s) * (1.f / DM) + 1e-6f);
#pragma unroll
    for (int j = 0; j < 4; ++j) { const f32x4 gg = ((const f32x4*)g)[64 * j + lane]; const f32x4 o = v[j] * rstd * gg;
        if (of32) ((f32x4*)of32)[64 * j + lane] = o;
        else ((v2u*)orow)[64 * j + lane] = (v2u){pk2(o.x, o.y), pk2(o.z, o.w)}; }
}

__device__ __forceinline__ void rms_row2(const float* xa, const float* xb, const float* g, bf16* oa, bf16* ob, float* fa, float* fb, int lane) {
    f32x4 va[4], vb[4];
#pragma unroll
    for (int j = 0; j < 4; ++j) { va[j] = ((const f32x4*)xa)[64 * j + lane]; vb[j] = ((const f32x4*)xb)[64 * j + lane]; }
    __builtin_amdgcn_sched_barrier(0);
    float sa = 0.f, sb = 0.f;
#pragma unroll
    for (int j = 0; j < 4; ++j) { sa += (va[j].x * va[j].x + va[j].y * va[j].y) + (va[j].z * va[j].z + va[j].w * va[j].w); sb += (vb[j].x * vb[j].x + vb[j].y * vb[j].y) + (vb[j].z * vb[j].z + vb[j].w * vb[j].w); }
    const float ra = 1.f / sqrtf(wave_sum(sa) * (1.f / DM) + 1e-6f), rb = 1.f / sqrtf(wave_sum(sb) * (1.f / DM) + 1e-6f);
#pragma unroll
    for (int j = 0; j < 4; ++j) { const f32x4 gg = ((const f32x4*)g)[64 * j + lane]; const f32x4 o1 = va[j] * ra * gg, o2 = vb[j] * rb * gg;
        if (fa) { ((f32x4*)fa)[64 * j + lane] = o1; ((f32x4*)fb)[64 * j + lane] = o2; }
        else { ((v2u*)oa)[64 * j + lane] = (v2u){pk2(o1.x, o1.y), pk2(o1.z, o1.w)}; ((v2u*)ob)[64 * j + lane] = (v2u){pk2(o2.x, o2.y), pk2(o2.z, o2.w)}; } }
}
__device__ __forceinline__ void rms_row_parts(const float* base, const float* parts, int nparts, size_t part_stride, float* xout, const float* g, bf16* orow, float* of32, int lane) {
    f32x4 v[4]; float s = 0.f;
#pragma unroll
    for (int j = 0; j < 4; ++j) v[j] = ((const f32x4*)base)[64 * j + lane];
    for (int p = 0; p < nparts; ++p) { const f32x4* pr = (const f32x4*)(parts + (size_t)p * part_stride) + lane;
#pragma unroll
        for (int j = 0; j < 4; ++j) v[j] += pr[64 * j]; }
#pragma unroll
    for (int j = 0; j < 4; ++j) { if (xout) ((f32x4*)xout)[64 * j + lane] = v[j]; s += (v[j].x * v[j].x + v[j].y * v[j].y) + (v[j].z * v[j].z + v[j].w * v[j].w); }
    const float rstd = 1.f / sqrtf(wave_sum(s) * (1.f / DM) + 1e-6f);
#pragma unroll
    for (int j = 0; j < 4; ++j) { const f32x4 gg = ((const f32x4*)g)[64 * j + lane]; const f32x4 o = v[j] * rstd * gg;
        if (of32) ((f32x4*)of32)[64 * j + lane] = o;
        else ((v2u*)orow)[64 * j + lane] = (v2u){pk2(o.x, o.y), pk2(o.z, o.w)}; }
}

struct PBArgs { const float* PROJ; const float* state_conv; const float* conv_w; const float* a_log; const float* dt_bias;
    float* QN; float* KN; float* VG; float* G; float* BETA; float* KQ; bf16* QB; bf16* KS; bf16* VS; bf16* KW; bf16* VW; float* out; int l; };
struct PBRegs { float qs_[8], qo_[8], kvs_[12], kvo_[12]; };
__device__ __forceinline__ void pb_row_load(const PBArgs& A, int m, int lane, PBRegs& R) {
    const float* pr = A.PROJ + (size_t)m * NP;
#pragma unroll
    for (int h = 0; h < 8; ++h) { R.qs_[h] = pr[C_Q + h * 64 + lane]; R.qo_[h] = pr[C_Q + h * 64 + (lane ^ 32)]; }
#pragma unroll
    for (int i = 0; i < 12; ++i) { R.kvs_[i] = pr[C_KV + i * 64 + lane]; R.kvo_[i] = pr[C_KV + i * 64 + (lane ^ 32)]; }
}
__device__ __forceinline__ void pb_row(const PBArgs& A, int m, int lane, const PBRegs& R) {
    const bool is_s = m >= MP; int b, t;
    if (!is_s) { b = m >> 12; t = m & 4095; } else { b = (m - MP) >> 2; t = (m - MP) & 3; }
    const int pos = is_s ? PAST + t : t, l = A.l;
    const float* pr = A.PROJ + (size_t)m * NP;
    const float* cw = A.conv_w + (size_t)l * 4 * 1536;
    const float* cb = A.state_conv + ((size_t)l * NSB + b) * 3 * 1536;
    if (!is_s && t >= SEQ - 3) { float* o = A.out + O_CONVP + ((size_t)(l * NPB + b) * 3 + (t - (SEQ - 3))) * 1536;
#pragma unroll 4
        for (int j = 0; j < 24; ++j) o[64 * j + lane] = pr[64 * j + lane]; }
    if (is_s && t >= 1) { float* o = A.out + O_CONVS + ((size_t)(l * NSB + b) * 3 + (t - 1)) * 1536;
#pragma unroll 4
        for (int j = 0; j < 24; ++j) o[64 * j + lane] = pr[64 * j + lane]; }
    const int half = lane >> 5; float cs, sn; rope_cs(pos, lane & 31, cs, sn);
    const float (&qs_)[8] = R.qs_; const float (&qo_)[8] = R.qo_; const float (&kvs_)[12] = R.kvs_; const float (&kvo_)[12] = R.kvo_;
#pragma unroll
    for (int h = 0; h < 8; ++h) { const float xs = qs_[h], xo = qo_[h];
        const float r = half ? (xs * cs + xo * sn) : (xs * cs - xo * sn);
        A.QB[(size_t)m * 512 + h * 64 + lane] = (bf16)f2bf(r * C2); }
#pragma unroll
    for (int s6 = 0; s6 < 6; ++s6)
#pragma unroll
        for (int kvh = 0; kvh < 2; ++kvh) {
            float v = kvs_[s6 * 2 + kvh];
            if (s6 == 2 || s6 == 4) { const float xo = kvo_[s6 * 2 + kvh]; v = half ? (v * cs + xo * sn) : (v * cs - xo * sn); }
            if (s6 < 4) {
                if (!is_s) A.out[O_KVP + ((((size_t)(l * NPB + b) * 2 + kvh) * SEQ + t) * 4 + s6) * 64 + lane] = v;
                else       A.out[O_KVS + ((((size_t)(l * NSB + b) * 2 + kvh) * DSEQ + t) * 4 + s6) * 64 + lane] = v;
            } else {
                const int idx = s6 - 4;
                if (!is_s) { if (t >= SEQ - 512) A.out[O_WINP + ((((size_t)(l * NPB + b) * 512 + (t - (SEQ - 512))) * 2 + idx) * 2 + kvh) * 64 + lane] = v; }
                else A.out[O_WINS + ((((size_t)(l * NSB + b) * 512 + (508 + t)) * 2 + idx) * 2 + kvh) * 64 + lane] = v;
            }
            const bf16 bv = (bf16)f2bf(v);
            if (s6 == 2) A.KS[(size_t)m * 128 + kvh * 64 + lane] = bv;
            if (s6 == 3) A.VS[(size_t)m * 128 + kvh * 64 + lane] = bv;
            if (s6 == 4) A.KW[(size_t)m * 128 + kvh * 64 + lane] = bv;
            if (s6 == 5) A.VW[(size_t)m * 128 + kvh * 64 + lane] = bv;
        }
}

__device__ __forceinline__ void pb_sample_head(const PBArgs& A, int u, int lane) {
    const int m = MP + (u >> 3), h = u & 7, b = (m - MP) >> 2, t = (m - MP) & 3, l = A.l;
    const float* pr = A.PROJ + (size_t)m * NP;
    const float* cw = A.conv_w + (size_t)l * 4 * 1536;
    const float* cb = A.state_conv + ((size_t)l * NSB + b) * 3 * 1536;
    float xv[3][4], wv[3][4];
#pragma unroll
    for (int part = 0; part < 3; ++part) { const int c = (part * 8 + h) * 64 + lane;
#pragma unroll
        for (int tap = 0; tap < 4; ++tap) { const int idx = t + tap;
            xv[part][tap] = (idx >= 3) ? A.PROJ[(size_t)(m - t + idx - 3) * NP + c] : cb[idx * 1536 + c];
            wv[part][tap] = cw[tap * 1536 + c]; } }
    __builtin_amdgcn_sched_barrier(0);
    float qkv[3];
#pragma unroll
    for (int part = 0; part < 3; ++part) qkv[part] = siluf_((xv[part][0] * wv[part][0] + xv[part][1] * wv[part][1]) + (xv[part][2] * wv[part][2] + xv[part][3] * wv[part][3]));
    const float q = qkv[0], k = qkv[1];
    const float qs = dpp_sum(q * q), ks = dpp_sum(k * k);
    const float qn = q * (1.f / sqrtf(qs + 1e-6f)) * 0.125f, kn = k * (1.f / sqrtf(ks + 1e-6f));
    const float kq = dpp_sum(qn * kn);
    A.QN[(size_t)m * 512 + h * 64 + lane] = qn; A.KN[(size_t)m * 512 + h * 64 + lane] = kn; A.VG[(size_t)m * 512 + h * 64 + lane] = qkv[2];
    if (lane == 0) A.KQ[(size_t)m * 8 + h] = kq;
    if (h == 0 && lane < 8) {
        const float a = pr[C_A + lane] + A.dt_bias[l * 8 + lane];
        const float sp = fmaxf(a, 0.f) + log1pf(__expf(-fabsf(a)));
        A.G[(size_t)m * 8 + lane] = -__expf(A.a_log[l * 8 + lane]) * sp;
        A.BETA[(size_t)m * 8 + lane] = sigmoidf_(pr[C_BETA + lane]); }
}

struct CmpArgs { const float* PROJ; const float* cache; const int* page_table; const float* pe_k; const float* pe_v; const bf16* CMPW; unsigned char* ws; int l; };
__device__ __forceinline__ void compress_unit(const CmpArgs& A, int u, int lane) {
    const int fr = lane & 15, fq = lane >> 4, l = A.l;
    const int kv = u & 1, uu = u >> 1; const bool is_s = uu >= 64; const int ru = is_s ? uu - 64 : uu;
    const int rho = 16 * ru + fr, NC = is_s ? 64 : 128;
    const int seq = rho / (2 * NC), n = (rho >> 1) % NC, kvh = rho & 1;
    const float* abase; size_t astride;
    if (!is_s) { abase = A.PROJ + (size_t)(seq * SEQ + 32 * n) * NP + C_KV + kv * 128 + kvh * 64; astride = NP; }
    else { const int page = A.page_table[seq * NPAGES + (n >> 2)];
        abase = A.cache + ((((size_t)l * NPOOL + page) * 2 + kvh) * 128 + (n & 3) * 32) * 256 + kv * 64; astride = 256; }
    const float* pe = (kv ? A.pe_v : A.pe_k) + (size_t)l * 2048;
    const bf16* Wt = A.CMPW + (size_t)((l * 2 + kv) * 64) * 2048;
    f32x4 acc[4];
#pragma unroll
    for (int et = 0; et < 4; ++et) acc[et] = (f32x4){0.f, 0.f, 0.f, 0.f};
    f32x4 sa[2][4], sp[2][4]; bf16x8 sw[2][8];
#define CMP_LOAD(S, c) do { _Pragma("unroll") for (int ks = 0; ks < 2; ++ks) { const float* ap = abase + (size_t)(c) * astride + 32 * ks + 8 * fq; const float* pp = pe + (c) * 64 + 32 * ks + 8 * fq; \
        sa[S][2 * ks] = *(const f32x4*)ap; sa[S][2 * ks + 1] = *(const f32x4*)(ap + 4); sp[S][2 * ks] = *(const f32x4*)pp; sp[S][2 * ks + 1] = *(const f32x4*)(pp + 4); \
        _Pragma("unroll") for (int et = 0; et < 4; ++et) sw[S][ks * 4 + et] = *(const bf16x8*)(Wt + (size_t)(16 * et + fr) * 2048 + (c) * 64 + 32 * ks + 8 * fq); } } while (0)
#define CMP_MMA(S) do { _Pragma("unroll") for (int ks = 0; ks < 2; ++ks) { const f32x4 a0 = sa[S][2 * ks] + sp[S][2 * ks], a1 = sa[S][2 * ks + 1] + sp[S][2 * ks + 1]; \
        const bf16x8 ya = pack8(a0.x, a0.y, a0.z, a0.w, a1.x, a1.y, a1.z, a1.w); \
        _Pragma("unroll") for (int et = 0; et < 4; ++et) acc[et] = __builtin_amdgcn_mfma_f32_16x16x32_bf16(sw[S][ks * 4 + et], ya, acc[et], 0, 0, 0); } } while (0)
    CMP_LOAD(0, 0);
#pragma unroll 1
    for (int c = 0; c < 32; c += 2) {
        CMP_LOAD(1, c + 1); __builtin_amdgcn_sched_barrier(0);
        CMP_MMA(0); __builtin_amdgcn_sched_barrier(0);
        if (c + 2 < 32) { CMP_LOAD(0, c + 2); } __builtin_amdgcn_sched_barrier(0);
        CMP_MMA(1); __builtin_amdgcn_sched_barrier(0);
    }
#undef CMP_LOAD
#undef CMP_MMA
    if (kv == 0) { const int pos = 32 * n + 31;
#pragma unroll
        for (int et = 0; et < 2; ++et)
#pragma unroll
            for (int i = 0; i < 4; ++i) { float cs, sn; rope_cs(pos, 16 * et + 4 * fq + i, cs, sn);
                const float x1 = acc[et][i], x2 = acc[et + 2][i]; acc[et][i] = x1 * cs - x2 * sn; acc[et + 2][i] = x2 * cs + x1 * sn; } }
    float* ob = (float*)(A.ws + (is_s ? WS_CKS : WS_CKP) + (size_t)kv * (is_s ? (WS_CVS - WS_CKS) : (WS_CVP - WS_CKP))) + (size_t)rho * 64 + 4 * fq;
#pragma unroll
    for (int et = 0; et < 4; ++et) *(f32x4*)(ob + 16 * et) = acc[et];
}

struct GdnArgs { const float* QN; const float* KN; const float* VG; const float* G; const float* BETA; const float* KQ; float* OG; const float* PROJ; const float* state_gdn; const float* gdn_norm; bf16* MIX; float* out; int l; };
__device__ __forceinline__ void gdn_sample_unit(const GdnArgs& A, int unit, int lane) {
    const int sb = unit >> 3, h = unit & 7, l = A.l;
    const float* sp = A.state_gdn + (((size_t)l * NSB + sb) * 8 + h) * 4096;
    float S[64];
#pragma unroll
    for (int d = 0; d < 64; ++d) S[d] = sp[d * 64 + lane];
    const float gn = A.gdn_norm[l * 64 + lane];
    for (int i = 0; i < DSEQ; ++i) {
        const size_t m = (size_t)MP + sb * 4 + i;
        const float kd = A.KN[m * 512 + h * 64 + lane], qd = A.QN[m * 512 + h * 64 + lane], v = A.VG[m * 512 + h * 64 + lane];
        const float g = A.G[m * 8 + h], beta = A.BETA[m * 8 + h], kq = A.KQ[m * 8 + h];
        const int kdb = __builtin_bit_cast(int, kd), qdb = __builtin_bit_cast(int, qd);
        const float a = __expf(g); float r1 = 0.f, r2 = 0.f;
#pragma unroll
        for (int d = 0; d < 64; ++d) { const float kk = __builtin_bit_cast(float, __builtin_amdgcn_readlane(kdb, d)), qq = __builtin_bit_cast(float, __builtin_amdgcn_readlane(qdb, d)); r1 += S[d] * kk; r2 += S[d] * qq; }
        const float u = beta * (v - a * r1), o = a * r2 + u * kq;
#pragma unroll
        for (int d = 0; d < 64; ++d) { const float kk = __builtin_bit_cast(float, __builtin_amdgcn_readlane(kdb, d)); S[d] = a * S[d] + kk * u; }
        const float ms = wave_sum(o * o) * (1.f / 64.f);
        const float z = A.PROJ[m * NP + C_Z + h * 64 + lane];
        A.MIX[m * 1024 + h * 64 + lane] = (bf16)f2bf(o * (1.f / sqrtf(ms + 1e-6f)) * gn * siluf_(z));
    }
    float* so = A.out + O_GDNS + (((size_t)l * NSB + sb) * 8 + h) * 4096;
#pragma unroll
    for (int d = 0; d < 64; ++d) so[d * 64 + lane] = S[d];
}


__device__ __forceinline__ int perm_inv32(int p) { return (p & 32) + 16 * ((p >> 2) & 1) + 4 * ((p >> 3) & 3) + (p & 3); }
struct GPArgs { const float* PROJ; const float* conv_w; const float* a_log; const float* dt_bias; bf16* GK; bf16* GQ; bf16* GKT; bf16* GVT; float* GG2; float* BETA2; int l; };
struct GPRegs { float xx[3][11], ww[3][4]; };
__device__ __forceinline__ void gdn_prep_load(const GPArgs& A, int unit, int lane, GPRegs& R) {
    const int tg = unit >> 3, h = unit & 7, m0 = tg * 8, t0 = m0 & 4095;
    const float* cw = A.conv_w + (size_t)A.l * 4 * 1536;
#pragma unroll
    for (int part = 0; part < 3; ++part) { const int c = (part * 8 + h) * 64 + lane;
#pragma unroll
        for (int j = 0; j < 11; ++j) R.xx[part][j] = (t0 - 3 + j >= 0) ? A.PROJ[(size_t)(m0 - 3 + j) * NP + c] : 0.f;
#pragma unroll
        for (int k = 0; k < 4; ++k) R.ww[part][k] = cw[k * 1536 + c]; }
}
__device__ __forceinline__ void gdn_prep_unit(const GPArgs& A, int unit, int lane, const GPRegs& R) {
    const int tg = unit >> 3, h = unit & 7, m0 = tg * 8, b = m0 >> 12, t0 = m0 & 4095, l = A.l, bh = b * 8 + h;
    const float* cw = A.conv_w + (size_t)l * 4 * 1536;
    float val[3][8]; const float (&xx)[3][11] = R.xx; const float (&ww)[3][4] = R.ww;
#pragma unroll
    for (int part = 0; part < 3; ++part)
#pragma unroll
        for (int i = 0; i < 8; ++i) val[part][i] = siluf_(ww[part][0] * xx[part][i] + ww[part][1] * xx[part][i + 1] + ww[part][2] * xx[part][i + 2] + ww[part][3] * xx[part][i + 3]);
#pragma unroll
    for (int i = 0; i < 8; ++i) { const float q = val[0][i], k = val[1][i];
        const float qs = dpp_sum(q * q), ks = dpp_sum(k * k);
        val[0][i] = q * (1.f / sqrtf(qs + 1e-6f)) * 0.125f; val[1][i] = k * (1.f / sqrtf(ks + 1e-6f)); }
#pragma unroll
    for (int i = 0; i < 8; ++i) { A.GQ[((size_t)bh * 4096 + t0 + i) * 64 + lane] = (bf16)f2bf(val[0][i]); A.GK[((size_t)bh * 4096 + t0 + i) * 64 + lane] = (bf16)f2bf(val[1][i]); }
    *(v4u*)(A.GKT + ((size_t)bh * 64 + lane) * 4096 + t0) = (v4u){pk2(val[1][0], val[1][1]), pk2(val[1][2], val[1][3]), pk2(val[1][4], val[1][5]), pk2(val[1][6], val[1][7])};
    *(v4u*)(A.GVT + ((size_t)bh * 64 + lane) * 4096 + t0) = (v4u){pk2(val[2][0], val[2][1]), pk2(val[2][2], val[2][3]), pk2(val[2][4], val[2][5]), pk2(val[2][6], val[2][7])};
    if (lane < 8) { const float* pr = A.PROJ + (size_t)(m0 + lane) * NP;
        const float a = pr[C_A + h] + A.dt_bias[l * 8 + h];
        const float sp = fmaxf(a, 0.f) + log1pf(__expf(-fabsf(a)));
        A.GG2[(size_t)bh * 4096 + t0 + lane] = -__expf(A.a_log[l * 8 + h]) * sp;
        A.BETA2[(size_t)bh * 4096 + t0 + lane] = sigmoidf_(pr[C_BETA + h]); }
}
template <int I> __device__ __forceinline__ void fsub_row(float (&T)[64], const float* AL, int lane) {
    float tv = (lane == I) ? 1.f : 0.f;
#pragma unroll
    for (int j4 = 0; j4 < (I + 3) / 4; ++j4) { const f32x4 a = *(const f32x4*)(AL + I * 64 + 4 * j4);
#pragma unroll
        for (int e = 0; e < 4; ++e) if (4 * j4 + e < I) tv -= a[e] * T[4 * j4 + e]; }
    T[I] = tv;
}
template <int I> struct FSub { static __device__ __forceinline__ void run(float (&T)[64], const float* AL, int lane) { FSub<I - 1>::run(T, AL, lane); fsub_row<I>(T, AL, lane); } };
template <> struct FSub<-1> { static __device__ __forceinline__ void run(float (&)[64], const float*, int) {} };
struct GCArgs { const bf16* GK; const bf16* GQ; const bf16* GKT; const bf16* GVT; const float* GG2; const float* BETA2; bf16* WX; bf16* QX; bf16* QKX; bf16* KTX; float* U0F; float* GL; };
constexpr int GC_LDS_PER_WAVE = 17664;
__device__ __forceinline__ void gdn_chunk_unit(const GCArgs& A, unsigned char* wl, int unit, int lane_) {
    int lane = lane_; asm volatile("" : "+v"(lane));
    const int bh = unit >> 6, n = unit & 63, t0 = 64 * n, fr = lane & 15, fq = lane >> 4;
    float* AL = (float*)wl; float* SC = (float*)(wl + 16384);
    {   const float g = A.GG2[(size_t)bh * 4096 + t0 + lane], beta = A.BETA2[(size_t)bh * 4096 + t0 + lane];
        float gc = g;
        gc = dpp_add<0x111, 0xf>(gc); gc = dpp_add<0x112, 0xf>(gc); gc = dpp_add<0x114, 0xf>(gc); gc = dpp_add<0x118, 0xf>(gc); gc = dpp_add<0x142, 0xa>(gc); gc = dpp_add<0x143, 0xc>(gc);
        const float glast = __builtin_bit_cast(float, __builtin_amdgcn_readlane(__builtin_bit_cast(int, gc), 63));
        const float eg = __expf(gc);
        SC[lane] = gc; SC[64 + lane] = beta; SC[128 + lane] = beta * eg; SC[192 + lane] = eg; SC[256 + lane] = __expf(glast - gc);
        if (lane == 0) A.GL[unit] = __expf(glast); }
    LDS_WAIT(); asm volatile("" ::: "memory");
    {
        bf16x8 kf[4][2];
#pragma unroll
        for (int t4 = 0; t4 < 4; ++t4)
#pragma unroll
            for (int ks = 0; ks < 2; ++ks) kf[t4][ks] = *(const bf16x8*)(A.GK + ((size_t)bh * 4096 + t0 + 16 * t4 + fr) * 64 + 32 * ks + 8 * fq);
        __builtin_amdgcn_sched_barrier(0);
#pragma unroll
        for (int ti = 0; ti < 4; ++ti) { const f32x4 gi = *(const f32x4*)(SC + 16 * ti + 4 * fq), bi = *(const f32x4*)(SC + 64 + 16 * ti + 4 * fq);
#pragma unroll
            for (int tj = 0; tj < 4; ++tj) if (tj <= ti) { f32x4 acc = {0.f, 0.f, 0.f, 0.f};
                acc = __builtin_amdgcn_mfma_f32_16x16x32_bf16(kf[ti][0], kf[tj][0], acc, 0, 0, 0); acc = __builtin_amdgcn_mfma_f32_16x16x32_bf16(kf[ti][1], kf[tj][1], acc, 0, 0, 0);
                const float gj = SC[16 * tj + fr];
#pragma unroll
                for (int i = 0; i < 4; ++i) AL[(16 * ti + 4 * fq + i) * 64 + 16 * tj + fr] = bi[i] * acc[i] * __expf(fminf(gi[i] - gj, 0.f)); } }
    }
    LDS_WAIT(); asm volatile("" ::: "memory");
    {
        float T[64];
        FSub<63>::run(T, AL, lane);
        LDS_WAIT(); asm volatile("" ::: "memory");
        unsigned short* TB = (unsigned short*)wl;
#pragma unroll
        for (int i = 0; i < 64; ++i) TB[i * 72 + lane] = (unsigned short)f2bf(T[i]);
    }
    LDS_WAIT(); asm volatile("" ::: "memory");
    {
        bf16x8 tf[4][2];
#pragma unroll
        for (int ti = 0; ti < 4; ++ti)
#pragma unroll
            for (int ks = 0; ks < 2; ++ks) tf[ti][ks] = *(const bf16x8*)(wl + ((16 * ti + fr) * 72 + 32 * ks + 8 * fq) * 2);
#pragma unroll
        for (int which = 0; which < 2; ++which) { const bf16* src = which ? A.GVT : A.GKT; const float* sc = SC + (which ? 64 : 128);
            bf16x8 raws[4][2];
#pragma unroll
            for (int tn = 0; tn < 4; ++tn)
#pragma unroll
                for (int ks = 0; ks < 2; ++ks) raws[tn][ks] = *(const bf16x8*)(src + ((size_t)bh * 64 + 16 * tn + fr) * 4096 + t0 + 32 * ks + 8 * fq);
            __builtin_amdgcn_sched_barrier(0);
#pragma unroll
            for (int tn = 0; tn < 4; ++tn) { bf16x8 yb[2];
#pragma unroll
                for (int ks = 0; ks < 2; ++ks) { const bf16x8 raw = raws[tn][ks];
                    const f32x4 s0 = *(const f32x4*)(sc + 32 * ks + 8 * fq), s1 = *(const f32x4*)(sc + 32 * ks + 8 * fq + 4);
                    yb[ks] = pack8(bf2f((unsigned short)raw[0]) * s0.x, bf2f((unsigned short)raw[1]) * s0.y, bf2f((unsigned short)raw[2]) * s0.z, bf2f((unsigned short)raw[3]) * s0.w,
                                   bf2f((unsigned short)raw[4]) * s1.x, bf2f((unsigned short)raw[5]) * s1.y, bf2f((unsigned short)raw[6]) * s1.z, bf2f((unsigned short)raw[7]) * s1.w); }
#pragma unroll
                for (int ti = 0; ti < 4; ++ti) { f32x4 acc = {0.f, 0.f, 0.f, 0.f};
                    acc = __builtin_amdgcn_mfma_f32_16x16x32_bf16(tf[ti][0], yb[0], acc, 0, 0, 0);
                    if (ti >= 2) acc = __builtin_amdgcn_mfma_f32_16x16x32_bf16(tf[ti][1], yb[1], acc, 0, 0, 0);
                    if (which == 0) { const int p = 32 * (tn >> 1) + 8 * (fr >> 2) + 4 * (tn & 1) + (fr & 3);
#pragma unroll
                        for (int i = 0; i < 4; ++i) A.WX[((size_t)unit * 64 + 16 * ti + 4 * fq + i) * 64 + p] = (bf16)f2bf(acc[i]); }
                    else *(f32x4*)(A.U0F + (((size_t)unit * 16 + ti * 4 + tn) * 64 + lane) * 4) = acc; } } }
    }
    {
        bf16x8 kf[4][2], qf[4][2];
#pragma unroll
        for (int t4 = 0; t4 < 4; ++t4)
#pragma unroll
            for (int ks = 0; ks < 2; ++ks) { kf[t4][ks] = *(const bf16x8*)(A.GK + ((size_t)bh * 4096 + t0 + 16 * t4 + fr) * 64 + 32 * ks + 8 * fq);
                qf[t4][ks] = *(const bf16x8*)(A.GQ + ((size_t)bh * 4096 + t0 + 16 * t4 + fr) * 64 + 32 * ks + 8 * fq); }
        __builtin_amdgcn_sched_barrier(0);
#pragma unroll
        for (int ti = 0; ti < 4; ++ti) { const f32x4 gi = *(const f32x4*)(SC + 16 * ti + 4 * fq);
#pragma unroll
            for (int tj = 0; tj < 4; ++tj) { f32x4 acc = {0.f, 0.f, 0.f, 0.f};
                if (tj <= ti) { acc = __builtin_amdgcn_mfma_f32_16x16x32_bf16(qf[ti][0], kf[tj][0], acc, 0, 0, 0); acc = __builtin_amdgcn_mfma_f32_16x16x32_bf16(qf[ti][1], kf[tj][1], acc, 0, 0, 0); }
                const float gj = SC[16 * tj + fr]; const int p = 32 * (tj >> 1) + 8 * (fr >> 2) + 4 * (tj & 1) + (fr & 3);
#pragma unroll
                for (int i = 0; i < 4; ++i) { const int ri = 16 * ti + 4 * fq + i, cj = 16 * tj + fr;
                    const float v = (tj <= ti && ri >= cj) ? acc[i] * __expf(fminf(gi[i] - gj, 0.f)) : 0.f;
                    A.QKX[((size_t)unit * 64 + ri) * 64 + p] = (bf16)f2bf(v); } } }
    }
    {
        const int lg = perm_inv32(lane);
        const float ek = SC[256 + lg];
#pragma unroll 1
        for (int r0 = 0; r0 < 64; r0 += 16) { bf16 qv[16], kv[16];
#pragma unroll
            for (int i = 0; i < 16; ++i) { qv[i] = A.GQ[((size_t)bh * 4096 + t0 + r0 + i) * 64 + lg]; kv[i] = A.GKT[((size_t)bh * 64 + r0 + i) * 4096 + t0 + lg]; }
            __builtin_amdgcn_sched_barrier(0);
#pragma unroll
            for (int i = 0; i < 16; ++i) { A.QX[((size_t)unit * 64 + r0 + i) * 64 + lane] = (bf16)f2bf(bf2f(qv[i]) * SC[192 + r0 + i]);
                A.KTX[((size_t)unit * 64 + r0 + i) * 64 + lane] = (bf16)f2bf(bf2f(kv[i]) * ek); } }
    }
    LDS_WAIT(); asm volatile("" ::: "memory");
}
struct GS2Args { const bf16* WX; const bf16* QX; const bf16* QKX; const bf16* KTX; const float* U0F; const float* GL; float* OG; float* out; int l; };
__device__ __forceinline__ void gdn_scan2_wave(const GS2Args& A, int bh, int te, int lane) {
    const int fr = lane & 15, fq = lane >> 4, b = bh >> 3, h = bh & 7;
    f32x4 s[4]; bf16x8 sfr[2];
#pragma unroll
    for (int i = 0; i < 4; ++i) s[i] = (f32x4){0.f, 0.f, 0.f, 0.f};
    sfr[0] = (bf16x8){0, 0, 0, 0, 0, 0, 0, 0}; sfr[1] = sfr[0];
    f32x4 u[4]; bf16x8 wf[4][2], kt[4][2], qx[4][2], qkx[4][2]; float dec;
#define GS_LD_UW(nn) do { const size_t un_ = (size_t)bh * 64 + (nn); _Pragma("unroll") for (int tc = 0; tc < 4; ++tc) { u[tc] = *(const f32x4*)(A.U0F + ((un_ * 16 + tc * 4 + te) * 64 + lane) * 4); \
        _Pragma("unroll") for (int ks = 0; ks < 2; ++ks) wf[tc][ks] = *(const bf16x8*)(A.WX + (un_ * 64 + 16 * tc + fr) * 64 + 32 * ks + 8 * fq); } } while (0)
#define GS_LD_Q(nn) do { const size_t un_ = (size_t)bh * 64 + (nn); _Pragma("unroll") for (int tc = 0; tc < 4; ++tc) _Pragma("unroll") for (int ks = 0; ks < 2; ++ks) { \
        qx[tc][ks] = *(const bf16x8*)(A.QX + (un_ * 64 + 16 * tc + fr) * 64 + 32 * ks + 8 * fq); qkx[tc][ks] = *(const bf16x8*)(A.QKX + (un_ * 64 + 16 * tc + fr) * 64 + 32 * ks + 8 * fq); } } while (0)
#define GS_LD_K(nn) do { const size_t un_ = (size_t)bh * 64 + (nn); dec = A.GL[un_]; _Pragma("unroll") for (int tc = 0; tc < 4; ++tc) _Pragma("unroll") for (int ks = 0; ks < 2; ++ks) \
        kt[tc][ks] = *(const bf16x8*)(A.KTX + (un_ * 64 + 16 * tc + fr) * 64 + 32 * ks + 8 * fq); } while (0)
    GS_LD_UW(0); GS_LD_Q(0); GS_LD_K(0);
    __builtin_amdgcn_sched_barrier(0);
#pragma unroll 1
    for (int n = 0; n < 64; ++n) {
        const int nn = n < 63 ? n + 1 : 63;
#pragma unroll
        for (int tc = 0; tc < 4; ++tc) { f32x4 acc = {0.f, 0.f, 0.f, 0.f};
            acc = __builtin_amdgcn_mfma_f32_16x16x32_bf16(wf[tc][0], sfr[0], acc, 0, 0, 0); acc = __builtin_amdgcn_mfma_f32_16x16x32_bf16(wf[tc][1], sfr[1], acc, 0, 0, 0);
            u[tc] -= acc; }
        bf16x8 ufr[2];
#pragma unroll
        for (int ks = 0; ks < 2; ++ks) ufr[ks] = pack8(u[2 * ks][0], u[2 * ks][1], u[2 * ks][2], u[2 * ks][3], u[2 * ks + 1][0], u[2 * ks + 1][1], u[2 * ks + 1][2], u[2 * ks + 1][3]);
        __builtin_amdgcn_sched_barrier(0);
        GS_LD_UW(nn);
        __builtin_amdgcn_sched_barrier(0);
        f32x4 oacc[4];
#pragma unroll
        for (int tc = 0; tc < 4; ++tc) {
            f32x4 acc = {0.f, 0.f, 0.f, 0.f};
            acc = __builtin_amdgcn_mfma_f32_16x16x32_bf16(qx[tc][0], sfr[0], acc, 0, 0, 0); acc = __builtin_amdgcn_mfma_f32_16x16x32_bf16(qx[tc][1], sfr[1], acc, 0, 0, 0);
            acc = __builtin_amdgcn_mfma_f32_16x16x32_bf16(qkx[tc][0], ufr[0], acc, 0, 0, 0); acc = __builtin_amdgcn_mfma_f32_16x16x32_bf16(qkx[tc][1], ufr[1], acc, 0, 0, 0);
            oacc[tc] = acc; }
#pragma unroll
        for (int td = 0; td < 4; ++td) { f32x4 acc = s[td] * dec;
            acc = __builtin_amdgcn_mfma_f32_16x16x32_bf16(kt[td][0], ufr[0], acc, 0, 0, 0); acc = __builtin_amdgcn_mfma_f32_16x16x32_bf16(kt[td][1], ufr[1], acc, 0, 0, 0);
            s[td] = acc; }
#pragma unroll
        for (int ks = 0; ks < 2; ++ks) sfr[ks] = pack8(s[2 * ks][0], s[2 * ks][1], s[2 * ks][2], s[2 * ks][3], s[2 * ks + 1][0], s[2 * ks + 1][1], s[2 * ks + 1][2], s[2 * ks + 1][3]);
        __builtin_amdgcn_sched_barrier(0);
        GS_LD_Q(nn); GS_LD_K(nn);
#pragma unroll
        for (int tc = 0; tc < 4; ++tc)
#pragma unroll
            for (int i = 0; i < 4; ++i) A.OG[((size_t)b * SEQ + 64 * n + 16 * tc + 4 * fq + i) * 512 + h * 64 + 16 * te + fr] = oacc[tc][i];
        __builtin_amdgcn_sched_barrier(0);
    }
#undef GS_LD_UW
#undef GS_LD_Q
#undef GS_LD_K
#pragma unroll
    for (int td = 0; td < 4; ++td)
#pragma unroll
        for (int i = 0; i < 4; ++i) A.out[O_GDNP + ((((size_t)A.l * NPB + b) * 8 + h) * 64 + 16 * td + 4 * fq + i) * 64 + 16 * te + fr] = s[td][i];
}

constexpr int SC_ROW = 144, SC_MAT = 64 * SC_ROW, SC_U = 4 * SC_MAT, SC_STAGE = SC_U + 16384, SC_DEC = 2 * SC_STAGE;
__device__ __forceinline__ void gdn_scan3_block(const GS2Args& A, unsigned char* lds, int bh, int tid) {
    const int lane = tid & 63, wave = __builtin_amdgcn_readfirstlane(tid >> 6), fr = lane & 15, fq = lane >> 4, b = bh >> 3, h = bh & 7, te = wave;
    const int mrow = (tid >> 3), mch = tid & 7;
    v4u ra[6], rb[6];
#define SC_LOAD(R, nn) do { const size_t un_ = (size_t)bh * 64 + ((nn) < 63 ? (nn) : 63); \
        R[0] = *(const v4u*)(A.WX + un_ * 4096 + mrow * 64 + mch * 8); R[1] = *(const v4u*)(A.KTX + un_ * 4096 + mrow * 64 + mch * 8); \
        R[2] = *(const v4u*)(A.QX + un_ * 4096 + mrow * 64 + mch * 8); R[3] = *(const v4u*)(A.QKX + un_ * 4096 + mrow * 64 + mch * 8); \
        R[4] = *(const v4u*)(A.U0F + un_ * 4096 + (size_t)tid * 4); R[5] = *(const v4u*)(A.U0F + un_ * 4096 + (size_t)(tid + 512) * 4); } while (0)
#define SC_STORE(R, st) do { unsigned char* sb_ = lds + (st) * SC_STAGE; \
        *(v4u*)(sb_ + 0 * SC_MAT + mrow * SC_ROW + mch * 16) = R[0]; *(v4u*)(sb_ + 1 * SC_MAT + mrow * SC_ROW + mch * 16) = R[1]; \
        *(v4u*)(sb_ + 2 * SC_MAT + mrow * SC_ROW + mch * 16) = R[2]; *(v4u*)(sb_ + 3 * SC_MAT + mrow * SC_ROW + mch * 16) = R[3]; \
        *(v4u*)(sb_ + SC_U + tid * 16) = R[4]; *(v4u*)(sb_ + SC_U + (tid + 512) * 16) = R[5]; } while (0)
    f32x4 s[4]; bf16x8 sfr[2];
#pragma unroll
    for (int i = 0; i < 4; ++i) s[i] = (f32x4){0.f, 0.f, 0.f, 0.f};
    sfr[0] = (bf16x8){0, 0, 0, 0, 0, 0, 0, 0}; sfr[1] = sfr[0];
    __syncthreads();
    if (tid < 64) ((float*)(lds + SC_DEC))[tid] = A.GL[(size_t)bh * 64 + tid];
    SC_LOAD(ra, 0); SC_STORE(ra, 0);
    SC_LOAD(rb, 1); SC_LOAD(ra, 2);
    __syncthreads();
#define SC_CHUNK(n, st) do { if (wave < 4) { const unsigned char* sb_ = lds + (st) * SC_STAGE; \
        f32x4 u[4]; bf16x8 ufr[2]; \
        _Pragma("unroll") for (int tc = 0; tc < 4; ++tc) { u[tc] = *(const f32x4*)(sb_ + SC_U + ((tc * 4 + te) * 64 + lane) * 16); \
            const bf16x8 w0 = *(const bf16x8*)(sb_ + (16 * tc + fr) * SC_ROW + (8 * fq) * 2), w1 = *(const bf16x8*)(sb_ + (16 * tc + fr) * SC_ROW + (32 + 8 * fq) * 2); \
            f32x4 acc = {0.f, 0.f, 0.f, 0.f}; acc = __builtin_amdgcn_mfma_f32_16x16x32_bf16(w0, sfr[0], acc, 0, 0, 0); acc = __builtin_amdgcn_mfma_f32_16x16x32_bf16(w1, sfr[1], acc, 0, 0, 0); u[tc] -= acc; } \
        _Pragma("unroll") for (int ks = 0; ks < 2; ++ks) ufr[ks] = pack8(u[2 * ks][0], u[2 * ks][1], u[2 * ks][2], u[2 * ks][3], u[2 * ks + 1][0], u[2 * ks + 1][1], u[2 * ks + 1][2], u[2 * ks + 1][3]); \
        _Pragma("unroll") for (int tc = 0; tc < 4; ++tc) { \
            const bf16x8 q0 = *(const bf16x8*)(sb_ + 2 * SC_MAT + (16 * tc + fr) * SC_ROW + (8 * fq) * 2), q1 = *(const bf16x8*)(sb_ + 2 * SC_MAT + (16 * tc + fr) * SC_ROW + (32 + 8 * fq) * 2); \
            const bf16x8 k0 = *(const bf16x8*)(sb_ + 3 * SC_MAT + (16 * tc + fr) * SC_ROW + (8 * fq) * 2), k1 = *(const bf16x8*)(sb_ + 3 * SC_MAT + (16 * tc + fr) * SC_ROW + (32 + 8 * fq) * 2); \
            f32x4 acc = {0.f, 0.f, 0.f, 0.f}; \
            acc = __builtin_amdgcn_mfma_f32_16x16x32_bf16(q0, sfr[0], acc, 0, 0, 0); acc = __builtin_amdgcn_mfma_f32_16x16x32_bf16(q1, sfr[1], acc, 0, 0, 0); \
            acc = __builtin_amdgcn_mfma_f32_16x16x32_bf16(k0, ufr[0], acc, 0, 0, 0); acc = __builtin_amdgcn_mfma_f32_16x16x32_bf16(k1, ufr[1], acc, 0, 0, 0); \
            _Pragma("unroll") for (int i = 0; i < 4; ++i) A.OG[((size_t)b * SEQ + 64 * (n) + 16 * tc + 4 * fq + i) * 512 + h * 64 + 16 * te + fr] = acc[i]; } \
        const float dec = ((const float*)(lds + SC_DEC))[(n)]; \
        _Pragma("unroll") for (int td = 0; td < 4; ++td) { \
            const bf16x8 t0 = *(const bf16x8*)(sb_ + 1 * SC_MAT + (16 * td + fr) * SC_ROW + (8 * fq) * 2), t1 = *(const bf16x8*)(sb_ + 1 * SC_MAT + (16 * td + fr) * SC_ROW + (32 + 8 * fq) * 2); \
            f32x4 acc = s[td] * dec; acc = __builtin_amdgcn_mfma_f32_16x16x32_bf16(t0, ufr[0], acc, 0, 0, 0); acc = __builtin_amdgcn_mfma_f32_16x16x32_bf16(t1, ufr[1], acc, 0, 0, 0); s[td] = acc; } \
        _Pragma("unroll") for (int ks = 0; ks < 2; ++ks) sfr[ks] = pack8(s[2 * ks][0], s[2 * ks][1], s[2 * ks][2], s[2 * ks][3], s[2 * ks + 1][0], s[2 * ks + 1][1], s[2 * ks + 1][2], s[2 * ks + 1][3]); } } while (0)
#pragma unroll 1
    for (int n = 0; n < 64; n += 2) {
        SC_STORE(rb, 1); __builtin_amdgcn_sched_barrier(0); SC_LOAD(rb, n + 3); __builtin_amdgcn_sched_barrier(0);
        SC_CHUNK(n, 0);
        __syncthreads();
        SC_STORE(ra, 0); __builtin_amdgcn_sched_barrier(0); SC_LOAD(ra, n + 4); __builtin_amdgcn_sched_barrier(0);
        SC_CHUNK(n + 1, 1);
        __syncthreads();
    }
#undef SC_LOAD
#undef SC_STORE
#undef SC_CHUNK
    if (wave < 4) {
#pragma unroll
        for (int td = 0; td < 4; ++td)
#pragma unroll
            for (int i = 0; i < 4; ++i) A.out[O_GDNP + ((((size_t)A.l * NPB + b) * 8 + h) * 64 + 16 * td + 4 * fq + i) * 64 + 16 * te + fr] = s[td][i];
    }
}

constexpr int L_CK = 0, L_CVT = 18432, L_IMP = 36864, L_MASK = 102400, L_UM = 102912, L_INV = 102928, L_K = 104448, L_VT = 113664;
struct AttArgs { const bf16* QB; const bf16* KS; const bf16* VS; const bf16* KW; const bf16* VW; const float* CKP; const float* CVP; const float* PROJ; bf16* MIX; };

template <int MODE>
__device__ __forceinline__ void attn_tiles(unsigned char* lds, const bf16* Kg, const bf16* Vg, int j_lo, int j_hi, unsigned long long umask, unsigned long long tmask,
                                           int qblk, int trel, const bf16x8 (&qr)[4], f32x16 (&o)[2], float& mrun, float& lrun, int tid, int r32, int hi) {
    int j = j_lo; while (j <= j_hi && !((umask >> j) & 1ull)) ++j;
    const int key = tid >> 3, ch = tid & 7;
    v4u kvv = {0u, 0u, 0u, 0u}, vv = {0u, 0u, 0u, 0u};
    if (j <= j_hi) { kvv = *(const v4u*)(Kg + (size_t)(64 * j + key) * 128 + ch * 8); vv = *(const v4u*)(Vg + (size_t)(64 * j + key) * 128 + ch * 8); }
    while (j <= j_hi) {
        __syncthreads();
        { *(v4u*)(lds + L_K + key * 144 + ch * 16) = kvv;
          unsigned short* vt = (unsigned short*)(lds + L_VT);
#pragma unroll
          for (int e2 = 0; e2 < 4; ++e2) { const unsigned w = vv[e2]; vt[(ch * 8 + 2 * e2) * 72 + key] = (unsigned short)(w & 0xffffu); vt[(ch * 8 + 2 * e2 + 1) * 72 + key] = (unsigned short)(w >> 16); } }
        __syncthreads();
        int jn = j + 1; while (jn <= j_hi && !((umask >> jn) & 1ull)) ++jn;
        if (jn <= j_hi) { kvv = *(const v4u*)(Kg + (size_t)(64 * jn + key) * 128 + ch * 8); vv = *(const v4u*)(Vg + (size_t)(64 * jn + key) * 128 + ch * 8); }
        __builtin_amdgcn_sched_barrier(0);
        f32x16 p[2];
#pragma unroll
        for (int u = 0; u < 2; ++u) { f32x16 acc = {};
#pragma unroll
            for (int d0 = 0; d0 < 4; ++d0) { const bf16x8 kf = *(const bf16x8*)(lds + L_K + (32 * u + r32) * 144 + (16 * d0 + 8 * hi) * 2);
                acc = __builtin_amdgcn_mfma_f32_32x32x16_bf16(kf, qr[d0], acc, 0, 0, 0); }
            p[u] = acc; }
        const bool tsel = (MODE == 0) ? (((tmask >> j) & 1ull) != 0ull) : true;
#pragma unroll
        for (int u = 0; u < 2; ++u)
#pragma unroll
            for (int r = 0; r < 16; ++r) { const int kv = 32 * u + crow(r, hi); bool keep = tsel;
                if (j == qblk) keep = keep && (kv <= trel);
                if (MODE == 1) { if (j == qblk - 8) keep = keep && (kv >= trel); }
                if (!keep) p[u][r] = NEG_INF; }
        float rm = NEG_INF;
#pragma unroll
        for (int u = 0; u < 2; ++u)
#pragma unroll
            for (int r = 0; r < 16; ++r) rm = fmaxf(rm, p[u][r]);
        rm = fmaxf(rm, __shfl_xor(rm, 32));
        const float mn = fmaxf(mrun, rm), msafe = (mn == NEG_INF) ? 0.f : mn;
        const float alpha = ex2(mrun - msafe);
        float ls = 0.f;
#pragma unroll
        for (int u = 0; u < 2; ++u)
#pragma unroll
            for (int r = 0; r < 16; ++r) { const float e = ex2(p[u][r] - msafe); p[u][r] = e; ls += e; }
        lrun = lrun * alpha + ls; mrun = mn;
#pragma unroll
        for (int dh = 0; dh < 2; ++dh)
#pragma unroll
            for (int r = 0; r < 16; ++r) o[dh][r] *= alpha;
#pragma unroll
        for (int u = 0; u < 2; ++u)
#pragma unroll
            for (int s = 0; s < 2; ++s) {
                const bf16x8 pf = pack8(p[u][8 * s + 0], p[u][8 * s + 1], p[u][8 * s + 2], p[u][8 * s + 3], p[u][8 * s + 4], p[u][8 * s + 5], p[u][8 * s + 6], p[u][8 * s + 7]);
#pragma unroll
                for (int dh = 0; dh < 2; ++dh) { const unsigned char* vp = lds + L_VT + (r32 + 32 * dh) * 144 + (32 * u + 16 * s + 4 * hi) * 2;
                    const s16x4 lo = *(const s16x4*)vp, hi4 = *(const s16x4*)(vp + 16);
                    const bf16x8 vf = (bf16x8){lo[0], lo[1], lo[2], lo[3], hi4[0], hi4[1], hi4[2], hi4[3]};
                    o[dh] = __builtin_amdgcn_mfma_f32_32x32x16_bf16(vf, pf, o[dh], 0, 0, 0); }
            }
        j = jn;
    }
}

__device__ __forceinline__ void nsa_prompt_unit(const AttArgs& A, unsigned char* lds, int unit, int tid) {
    const int lane = tid & 63, wave = tid >> 6, r32 = lane & 31, hi = lane >> 5, hh = wave & 3, ts = wave >> 2;
    const int qblk = 63 - (unit >> 3), b = (unit >> 1) & 3, kvh = unit & 1;
    const int head = kvh * 4 + hh, trel = 32 * ts + r32, t = 64 * qblk + trel; const size_t m = (size_t)b * SEQ + t;
    __syncthreads();
    const int nvmax = 2 * qblk + 2, ntile_c = (nvmax + 31) >> 5;
    { const int ch = tid & 7;
      for (int n = tid >> 3; n < 32 * ntile_c; n += 64) {
          const float* ckp = A.CKP + ((size_t)(b * 128 + n) * 2 + kvh) * 64 + ch * 8; const float* cvp = A.CVP + ((size_t)(b * 128 + n) * 2 + kvh) * 64 + ch * 8;
          const f32x4 k0 = *(const f32x4*)ckp, k1 = *(const f32x4*)(ckp + 4), v0 = *(const f32x4*)cvp, v1 = *(const f32x4*)(cvp + 4);
          *(bf16x8*)(lds + L_CK + n * 144 + ch * 16) = pack8(k0.x, k0.y, k0.z, k0.w, k1.x, k1.y, k1.z, k1.w);
          unsigned short* vt = (unsigned short*)(lds + L_CVT);
          vt[(ch * 8 + 0) * 136 + n] = (unsigned short)f2bf(v0.x); vt[(ch * 8 + 1) * 136 + n] = (unsigned short)f2bf(v0.y); vt[(ch * 8 + 2) * 136 + n] = (unsigned short)f2bf(v0.z); vt[(ch * 8 + 3) * 136 + n] = (unsigned short)f2bf(v0.w);
          vt[(ch * 8 + 4) * 136 + n] = (unsigned short)f2bf(v1.x); vt[(ch * 8 + 5) * 136 + n] = (unsigned short)f2bf(v1.y); vt[(ch * 8 + 6) * 136 + n] = (unsigned short)f2bf(v1.z); vt[(ch * 8 + 7) * 136 + n] = (unsigned short)f2bf(v1.w);
      }
      if (tid < 128) ((unsigned*)(lds + L_MASK))[tid] = 0u;
      if (tid < 2) ((unsigned*)(lds + L_UM))[tid] = 0u; }
    bf16x8 qr[4];
#pragma unroll
    for (int d0 = 0; d0 < 4; ++d0) qr[d0] = *(const bf16x8*)(A.QB + m * 512 + head * 64 + 16 * d0 + 8 * hi);
    __syncthreads();
    f32x16 tot[2];
    {
        const int nv = (t + 1) >> 5;
        float mx = NEG_INF;
#pragma unroll 1
        for (int tau = 0; tau < ntile_c; ++tau) {
            f32x16 acc = {};
#pragma unroll
            for (int d0 = 0; d0 < 4; ++d0) { const bf16x8 kf = *(const bf16x8*)(lds + L_CK + (32 * tau + r32) * 144 + (16 * d0 + 8 * hi) * 2);
                acc = __builtin_amdgcn_mfma_f32_32x32x16_bf16(kf, qr[d0], acc, 0, 0, 0); }
#pragma unroll
            for (int r = 0; r < 16; ++r) { const int n = 32 * tau + crow(r, hi); if (n < nv) mx = fmaxf(mx, acc[r]); }
        }
        mx = fmaxf(mx, __shfl_xor(mx, 32)); if (mx == NEG_INF) mx = 0.f;
        float sum = 0.f;
        f32x16 oc[2]; oc[0] = (f32x16){}; oc[1] = (f32x16){};
        float* imph = (float*)(lds + L_IMP) + (size_t)hh * 4096 + (32 * ts + r32) * 64;
#pragma unroll 1
        for (int tau = 0; tau < 4; ++tau) {
            f32x16 e = {};
            if (tau < ntile_c) {
                f32x16 acc = {};
#pragma unroll
                for (int d0 = 0; d0 < 4; ++d0) { const bf16x8 kf = *(const bf16x8*)(lds + L_CK + (32 * tau + r32) * 144 + (16 * d0 + 8 * hi) * 2);
                    acc = __builtin_amdgcn_mfma_f32_32x32x16_bf16(kf, qr[d0], acc, 0, 0, 0); }
#pragma unroll
                for (int r = 0; r < 16; ++r) { const int n = 32 * tau + crow(r, hi); e[r] = (n < nv) ? ex2(acc[r] - mx) : 0.f; sum += e[r]; }
#pragma unroll
                for (int s = 0; s < 2; ++s) {
                    const bf16x8 pf = pack8(e[8 * s + 0], e[8 * s + 1], e[8 * s + 2], e[8 * s + 3], e[8 * s + 4], e[8 * s + 5], e[8 * s + 6], e[8 * s + 7]);
#pragma unroll
                    for (int dh = 0; dh < 2; ++dh) { const unsigned char* vp = lds + L_CVT + (r32 + 32 * dh) * 272 + (32 * tau + 16 * s + 4 * hi) * 2;
                        const s16x4 lo = *(const s16x4*)vp, hi4 = *(const s16x4*)(vp + 16);
                        const bf16x8 vf = (bf16x8){lo[0], lo[1], lo[2], lo[3], hi4[0], hi4[1], hi4[2], hi4[3]};
                        oc[dh] = __builtin_amdgcn_mfma_f32_32x32x16_bf16(vf, pf, oc[dh], 0, 0, 0); }
                }
            }
#pragma unroll
            for (int a = 0; a < 4; ++a) { imph[16 * tau + 4 * a + 2 * hi + 0] = e[4 * a] + e[4 * a + 1]; imph[16 * tau + 4 * a + 2 * hi + 1] = e[4 * a + 2] + e[4 * a + 3]; }
        }
        sum += __shfl_xor(sum, 32);
        const float inv = 1.f / fmaxf(sum, 1e-30f);
        if (hi == 0) ((float*)(lds + L_INV))[hh * 64 + 32 * ts + r32] = inv;
        const float g0 = sigmoidf_(A.PROJ[m * NP + C_GATE + head * 3 + 0]) * inv;
#pragma unroll
        for (int dh = 0; dh < 2; ++dh)
#pragma unroll
            for (int r = 0; r < 16; ++r) tot[dh][r] = g0 * oc[dh][r];
    }
    __syncthreads();
    { float* ip = (float*)(lds + L_IMP); const float* iv = (const float*)(lds + L_INV);
#pragma unroll
      for (int i = 0; i < 8; ++i) { const int idx = tid + 512 * i, tk = idx >> 6;
          ip[idx] = (ip[idx] * iv[tk] + ip[4096 + idx] * iv[64 + tk]) + (ip[8192 + idx] * iv[128 + tk] + ip[12288 + idx] * iv[192 + tk]); } }
    __syncthreads();
    { const int tok = tid >> 3, jg = tid & 7; unsigned* mk = (unsigned*)(lds + L_MASK) + tok * 2;
      if (qblk <= 15) { if (jg == 0) { const unsigned long long am = (1ull << (qblk + 1)) - 1ull; mk[0] = (unsigned)am; mk[1] = (unsigned)(am >> 32); } }
      else {
          const float* iv = (const float*)(lds + L_IMP) + tok * 64; float vj[8]; int rk[8];
#pragma unroll
          for (int jj = 0; jj < 8; ++jj) { vj[jj] = iv[jg * 8 + jj]; rk[jj] = 0; }
          for (int i = 1; i <= qblk - 2; ++i) { const float vi = iv[i];
#pragma unroll
              for (int jj = 0; jj < 8; ++jj) { const int j = jg * 8 + jj; rk[jj] += (vi > vj[jj] || (vi == vj[jj] && i < j)) ? 1 : 0; } }
          unsigned bits = 0u;
#pragma unroll
          for (int jj = 0; jj < 8; ++jj) { const int j = jg * 8 + jj; const bool cand = (j >= 1 && j <= qblk - 2);
              if ((cand && rk[jj] < 13) || j == 0 || j == qblk || j == qblk - 1) bits |= 1u << ((jg & 3) * 8 + jj); }
          if (bits) atomicOr(mk + (jg >> 2), bits);
      } }
    __syncthreads();
    if (tid < 64) { const unsigned* mk = (const unsigned*)(lds + L_MASK) + tid * 2; atomicOr((unsigned*)(lds + L_UM), mk[0]); atomicOr((unsigned*)(lds + L_UM) + 1, mk[1]); }
    __syncthreads();
    unsigned long long tmask, umask;
    { const unsigned* mk = (const unsigned*)(lds + L_MASK) + trel * 2; tmask = (unsigned long long)mk[0] | ((unsigned long long)mk[1] << 32);
      const unsigned* um = (const unsigned*)(lds + L_UM); umask = (unsigned long long)um[0] | ((unsigned long long)um[1] << 32); }
    float* stash = (float*)(lds + L_IMP) + (size_t)wave * 2048 + lane;
#pragma unroll
    for (int dh = 0; dh < 2; ++dh)
#pragma unroll
        for (int r = 0; r < 16; ++r) stash[(dh * 16 + r) * 64] = tot[dh][r];
    {
        f32x16 o[2]; o[0] = (f32x16){}; o[1] = (f32x16){}; float mrun = NEG_INF, lrun = 0.f;
        attn_tiles<0>(lds, A.KS + (size_t)b * SEQ * 128 + kvh * 64, A.VS + (size_t)b * SEQ * 128 + kvh * 64, 0, qblk, umask, tmask, qblk, trel, qr, o, mrun, lrun, tid, r32, hi);
        lrun += __shfl_xor(lrun, 32);
        const float g1 = sigmoidf_(A.PROJ[m * NP + C_GATE + head * 3 + 1]) / fmaxf(lrun, 1e-30f);
#pragma unroll
        for (int dh = 0; dh < 2; ++dh)
#pragma unroll
            for (int r = 0; r < 16; ++r) stash[(dh * 16 + r) * 64] += g1 * o[dh][r];
    }
    {
        f32x16 o[2]; o[0] = (f32x16){}; o[1] = (f32x16){}; float mrun = NEG_INF, lrun = 0.f;
        const int jlo = qblk >= 8 ? qblk - 8 : 0;
        attn_tiles<1>(lds, A.KW + (size_t)b * SEQ * 128 + kvh * 64, A.VW + (size_t)b * SEQ * 128 + kvh * 64, jlo, qblk, ~0ull, ~0ull, qblk, trel, qr, o, mrun, lrun, tid, r32, hi);
        lrun += __shfl_xor(lrun, 32);
        const float g2 = sigmoidf_(A.PROJ[m * NP + C_GATE + head * 3 + 2]) / fmaxf(lrun, 1e-30f);
#pragma unroll
        for (int dh = 0; dh < 2; ++dh)
#pragma unroll
            for (int r = 0; r < 16; ++r) tot[dh][r] = stash[(dh * 16 + r) * 64] + g2 * o[dh][r];
    }
    bf16* mo = A.MIX + m * 1024 + 512 + head * 64;
#pragma unroll
    for (int dh = 0; dh < 2; ++dh)
#pragma unroll
        for (int a = 0; a < 4; ++a) { const int d0 = 32 * dh + 8 * a + 4 * hi;
            *(v2u*)(mo + d0) = (v2u){pk2(tot[dh][4 * a], tot[dh][4 * a + 1]), pk2(tot[dh][4 * a + 2], tot[dh][4 * a + 3])}; }
}

struct SAttArgs { const bf16* QB; const bf16* KS; const bf16* VS; const bf16* KW; const bf16* VW; const float* CKS; const float* CVS; const float* PROJ; const float* cache; const int* page_table; const float* state_win; bf16* MIX; int l; };
constexpr int S2_IMP = 0, S2_MK = 512, S2_ITEMS = 576, S2_OC = 1024, S2_MG = 8192;
constexpr int S2_MG_STRIDE = 4224;
template <bool F32> __device__ __forceinline__ void s2_block(const void* kbase, const void* vbase, int kstride, int nvalid, const bf16x8 (&qf)[2], const bool (&keep)[4][4], f32x4 (&O)[4], float& mrun, float& lrun, int fr, int fq) {
    f32x4 kraw[4][2][2]; bf16x8 kb[4][2]; f32x4 vraw[2][8]; v2u vb[2][8];
#pragma unroll
    for (int tk = 0; tk < 4; ++tk) { const int key = 16 * tk + fr, kc = key < nvalid ? key : nvalid - 1;
#pragma unroll
        for (int ks = 0; ks < 2; ++ks) {
            if (F32) { const float* p = (const float*)kbase + (size_t)kc * kstride + 32 * ks + 8 * fq; kraw[tk][ks][0] = *(const f32x4*)p; kraw[tk][ks][1] = *(const f32x4*)(p + 4); }
            else kb[tk][ks] = *(const bf16x8*)((const bf16*)kbase + (size_t)kc * 128 + 32 * ks + 8 * fq); } }
#pragma unroll
    for (int ks = 0; ks < 2; ++ks)
#pragma unroll
        for (int j = 0; j < 8; ++j) { const int key = 32 * ks + 16 * (j >> 2) + 4 * fq + (j & 3), kc = key < nvalid ? key : nvalid - 1;
            if (F32) vraw[ks][j] = *(const f32x4*)((const float*)vbase + (size_t)kc * kstride + 4 * fr);
            else vb[ks][j] = *(const v2u*)((const bf16*)vbase + (size_t)kc * 128 + 4 * fr); }
    __builtin_amdgcn_sched_barrier(0);
    f32x4 acc[4];
#pragma unroll
    for (int tk = 0; tk < 4; ++tk) { bf16x8 kx[2];
#pragma unroll
        for (int ks = 0; ks < 2; ++ks) { if (F32) { const f32x4 a = kraw[tk][ks][0], b = kraw[tk][ks][1]; kx[ks] = pack8(a.x, a.y, a.z, a.w, b.x, b.y, b.z, b.w); } else kx[ks] = kb[tk][ks]; }
        f32x4 a4 = {0.f, 0.f, 0.f, 0.f};
        a4 = __builtin_amdgcn_mfma_f32_16x16x32_bf16(kx[0], qf[0], a4, 0, 0, 0); a4 = __builtin_amdgcn_mfma_f32_16x16x32_bf16(kx[1], qf[1], a4, 0, 0, 0);
        acc[tk] = a4; }
    float mx = NEG_INF;
#pragma unroll
    for (int tk = 0; tk < 4; ++tk)
#pragma unroll
        for (int i = 0; i < 4; ++i) { if (!keep[tk][i]) acc[tk][i] = NEG_INF; mx = fmaxf(mx, acc[tk][i]); }
    mx = fmaxf(mx, __shfl_xor(mx, 16)); mx = fmaxf(mx, __shfl_xor(mx, 32));
    const float mn = fmaxf(mrun, mx), msafe = (mn == NEG_INF) ? 0.f : mn, alpha = ex2(mrun - msafe);
    float ls = 0.f;
#pragma unroll
    for (int tk = 0; tk < 4; ++tk)
#pragma unroll
        for (int i = 0; i < 4; ++i) { const float e = ex2(acc[tk][i] - msafe); acc[tk][i] = e; ls += e; }
    lrun = lrun * alpha + ls; mrun = mn;
#pragma unroll
    for (int td = 0; td < 4; ++td) O[td] *= alpha;
#pragma unroll
    for (int ks = 0; ks < 2; ++ks) {
        const bf16x8 pf = pack8(acc[2 * ks][0], acc[2 * ks][1], acc[2 * ks][2], acc[2 * ks][3], acc[2 * ks + 1][0], acc[2 * ks + 1][1], acc[2 * ks + 1][2], acc[2 * ks + 1][3]);
        float vv[8][4];
#pragma unroll
        for (int j = 0; j < 8; ++j) {
            if (F32) { const f32x4 v = vraw[ks][j]; vv[j][0] = v.x; vv[j][1] = v.y; vv[j][2] = v.z; vv[j][3] = v.w; }
            else { const v2u w = vb[ks][j]; vv[j][0] = bf2f((unsigned short)(w.x & 0xffffu)); vv[j][1] = bf2f((unsigned short)(w.x >> 16)); vv[j][2] = bf2f((unsigned short)(w.y & 0xffffu)); vv[j][3] = bf2f((unsigned short)(w.y >> 16)); } }
#pragma unroll
        for (int td = 0; td < 4; ++td) { const bf16x8 vx = pack8(vv[0][td], vv[1][td], vv[2][td], vv[3][td], vv[4][td], vv[5][td], vv[6][td], vv[7][td]);
            O[td] = __builtin_amdgcn_mfma_f32_16x16x32_bf16(vx, pf, O[td], 0, 0, 0); }
    }
}
__device__ __forceinline__ void nsa_sample_unit(const SAttArgs& A, unsigned char* lds, int unit, int tid) {
    const int sb = unit >> 1, kvh = unit & 1, l = A.l;
    const int lane = tid & 63, wave = __builtin_amdgcn_readfirstlane(tid >> 6), fr = lane & 15, fq = lane >> 4;
    const int qi = fr >> 2, qh = fr & 3;
    float* IMP = (float*)(lds + S2_IMP); unsigned* MK = (unsigned*)(lds + S2_MK); int* ITEMS = (int*)(lds + S2_ITEMS);
    const size_t mq = (size_t)MP + sb * 4 + qi;
    __syncthreads();
    if (tid < 8) MK[tid] = 0u;
    bf16x8 qf[2];
#pragma unroll
    for (int ks = 0; ks < 2; ++ks) qf[ks] = *(const bf16x8*)(A.QB + mq * 512 + (kvh * 4 + qh) * 64 + 32 * ks + 8 * fq);
    {
        f32x4 O[4]; float mrun = NEG_INF, lrun = 0.f;
#pragma unroll
        for (int td = 0; td < 4; ++td) O[td] = (f32x4){0.f, 0.f, 0.f, 0.f};
        bool keep[4][4];
#pragma unroll
        for (int tk = 0; tk < 4; ++tk)
#pragma unroll
            for (int i = 0; i < 4; ++i) keep[tk][i] = true;
        const float* ckf = A.CKS + ((size_t)sb * 64 * 2 + kvh) * 64; const float* cvf = A.CVS + ((size_t)sb * 64 * 2 + kvh) * 64;
        f32x4 acc[4];
#pragma unroll
        for (int tk = 0; tk < 4; ++tk) { bf16x8 kx[2];
#pragma unroll
            for (int ks = 0; ks < 2; ++ks) { const float* p = ckf + (size_t)(16 * tk + fr) * 128 + 32 * ks + 8 * fq; const f32x4 a = *(const f32x4*)p, b = *(const f32x4*)(p + 4); kx[ks] = pack8(a.x, a.y, a.z, a.w, b.x, b.y, b.z, b.w); }
            f32x4 a4 = {0.f, 0.f, 0.f, 0.f};
            a4 = __builtin_amdgcn_mfma_f32_16x16x32_bf16(kx[0], qf[0], a4, 0, 0, 0); a4 = __builtin_amdgcn_mfma_f32_16x16x32_bf16(kx[1], qf[1], a4, 0, 0, 0);
            acc[tk] = a4; }
        float mx = NEG_INF;
#pragma unroll
        for (int tk = 0; tk < 4; ++tk)
#pragma unroll
            for (int i = 0; i < 4; ++i) mx = fmaxf(mx, acc[tk][i]);
        mx = fmaxf(mx, __shfl_xor(mx, 16)); mx = fmaxf(mx, __shfl_xor(mx, 32));
        float ls = 0.f;
#pragma unroll
        for (int tk = 0; tk < 4; ++tk)
#pragma unroll
            for (int i = 0; i < 4; ++i) { const float e = ex2(acc[tk][i] - mx); acc[tk][i] = e; ls += e; }
        ls += __shfl_xor(ls, 16); ls += __shfl_xor(ls, 32);
        const float inv = 1.f / fmaxf(ls, 1e-30f);
        if (wave == 0) {
#pragma unroll
            for (int tk = 0; tk < 4; ++tk)
#pragma unroll
                for (int b2 = 0; b2 < 2; ++b2) { float v = (acc[tk][2 * b2] + acc[tk][2 * b2 + 1]) * inv;
                    v += __shfl_xor(v, 1); v += __shfl_xor(v, 2);
                    if (qh == 0) IMP[qi * 32 + 8 * tk + 2 * fq + b2] = v; }
#pragma unroll
            for (int ks = 0; ks < 2; ++ks) {
                const bf16x8 pf = pack8(acc[2 * ks][0], acc[2 * ks][1], acc[2 * ks][2], acc[2 * ks][3], acc[2 * ks + 1][0], acc[2 * ks + 1][1], acc[2 * ks + 1][2], acc[2 * ks + 1][3]);
#pragma unroll
                for (int td = 0; td < 4; ++td) { float vv[8];
#pragma unroll
                    for (int j = 0; j < 8; ++j) { const int key = 32 * ks + 16 * (j >> 2) + 4 * fq + (j & 3); vv[j] = cvf[(size_t)key * 128 + 4 * fr + td]; }
                    const bf16x8 vx = pack8(vv[0], vv[1], vv[2], vv[3], vv[4], vv[5], vv[6], vv[7]);
                    O[td] = __builtin_amdgcn_mfma_f32_16x16x32_bf16(vx, pf, O[td], 0, 0, 0); } }
            const float g0 = sigmoidf_(A.PROJ[mq * NP + C_GATE + (kvh * 4 + qh) * 3 + 0]) * inv;
            float* OC = (float*)(lds + S2_OC);
#pragma unroll
            for (int td = 0; td < 4; ++td)
#pragma unroll
                for (int i = 0; i < 4; ++i) OC[(16 * fq + 4 * i + td) * 16 + fr] = g0 * O[td][i];
        }
        (void)mrun; (void)lrun; (void)keep;
    }
    __syncthreads();
    if (tid < 128) { const int i = tid >> 5, j = tid & 31; bool sel = (j == 0 || j == 31);
        if (j >= 1 && j <= 30) { const float vj = IMP[i * 32 + j]; int rk = 0;
            for (int q = 1; q <= 30; ++q) { const float vi = IMP[i * 32 + q]; rk += (vi > vj || (vi == vj && q < j)) ? 1 : 0; }
            sel = rk < 13; }
        if (sel) { atomicOr(MK + i, 1u << j); atomicOr(MK + 4, 1u << j); } }
    __syncthreads();
    if (tid == 0) { const unsigned um = MK[4]; int n = 0;
        for (int j = 0; j < 32; ++j) if ((um >> j) & 1u) ITEMS[1 + n++] = j;
        ITEMS[1 + n++] = 32;
        for (int jb = 0; jb < 9; ++jb) ITEMS[1 + n++] = 64 + jb;
        ITEMS[0] = n; }
    __syncthreads();
    {
        const int nitems = ITEMS[0]; const unsigned tm = MK[qi];
        f32x4 Os[4], Ow[4]; float ms = NEG_INF, lsum = 0.f, mw = NEG_INF, lw = 0.f;
#pragma unroll
        for (int td = 0; td < 4; ++td) { Os[td] = (f32x4){0.f, 0.f, 0.f, 0.f}; Ow[td] = (f32x4){0.f, 0.f, 0.f, 0.f}; }
        const float* wb = A.state_win + ((size_t)l * NSB + sb) * 512 * 256 + kvh * 64;
        for (int it = wave; it < nitems; it += NWAVES) {
            const int code = ITEMS[1 + it]; bool keep[4][4];
            if (code < 64) {
                const int j = code;
                if (j < 32) { const int phys = A.page_table[sb * NPAGES + (j >> 1)];
                    const float* base = A.cache + ((((size_t)l * NPOOL + phys) * 2 + kvh) * 128 + (j & 1) * 64) * 256;
                    const bool tsel = ((tm >> j) & 1u) != 0u;
#pragma unroll
                    for (int tk = 0; tk < 4; ++tk)
#pragma unroll
                        for (int i = 0; i < 4; ++i) keep[tk][i] = tsel;
                    s2_block<true>(base + 128, base + 192, 256, 64, qf, keep, Os, ms, lsum, fr, fq);
                } else {
#pragma unroll
                    for (int tk = 0; tk < 4; ++tk)
#pragma unroll
                        for (int i = 0; i < 4; ++i) { const int key = 16 * tk + 4 * fq + i; keep[tk][i] = key <= qi; }
                    s2_block<false>(A.KS + ((size_t)MP + sb * 4) * 128 + kvh * 64, A.VS + ((size_t)MP + sb * 4) * 128 + kvh * 64, 128, 4, qf, keep, Os, ms, lsum, fr, fq);
                }
            } else {
                const int jb = code - 64;
                if (jb < 8) {
#pragma unroll
                    for (int tk = 0; tk < 4; ++tk)
#pragma unroll
                        for (int i = 0; i < 4; ++i) { const int r = 64 * jb + 16 * tk + 4 * fq + i; keep[tk][i] = r >= qi; }
                    s2_block<true>(wb + (size_t)(64 * jb) * 256, wb + (size_t)(64 * jb) * 256 + 128, 256, 64, qf, keep, Ow, mw, lw, fr, fq);
                } else {
#pragma unroll
                    for (int tk = 0; tk < 4; ++tk)
#pragma unroll
                        for (int i = 0; i < 4; ++i) { const int key = 16 * tk + 4 * fq + i; keep[tk][i] = key <= qi; }
                    s2_block<false>(A.KW + ((size_t)MP + sb * 4) * 128 + kvh * 64, A.VW + ((size_t)MP + sb * 4) * 128 + kvh * 64, 128, 4, qf, keep, Ow, mw, lw, fr, fq);
                }
            }
        }
        lsum += __shfl_xor(lsum, 16); lsum += __shfl_xor(lsum, 32); lw += __shfl_xor(lw, 16); lw += __shfl_xor(lw, 32);
        float* Ps = (float*)(lds + S2_MG + (wave * 2 + 0) * S2_MG_STRIDE); float* Pw = (float*)(lds + S2_MG + (wave * 2 + 1) * S2_MG_STRIDE);
#pragma unroll
        for (int td = 0; td < 4; ++td)
#pragma unroll
            for (int i = 0; i < 4; ++i) { Ps[(16 * fq + 4 * i + td) * 16 + fr] = Os[td][i]; Pw[(16 * fq + 4 * i + td) * 16 + fr] = Ow[td][i]; }
        if (fq == 0) { Ps[1024 + fr] = ms; Ps[1040 + fr] = lsum; Pw[1024 + fr] = mw; Pw[1040 + fr] = lw; }
    }
    __syncthreads();
    {
        const int q = tid & 15, i = q >> 2, hh = q & 3; const size_t m = (size_t)MP + sb * 4 + i;
        const float* OC = (const float*)(lds + S2_OC);
        float res[2];
#pragma unroll
        for (int k = 0; k < 2; ++k) res[k] = OC[((tid >> 4) + 32 * k) * 16 + q];
#pragma unroll
        for (int br = 0; br < 2; ++br) {
            float M = NEG_INF;
#pragma unroll
            for (int w = 0; w < NWAVES; ++w) M = fmaxf(M, ((const float*)(lds + S2_MG + (w * 2 + br) * S2_MG_STRIDE))[1024 + q]);
            float L = 0.f, o0 = 0.f, o1 = 0.f;
#pragma unroll
            for (int w = 0; w < NWAVES; ++w) { const float* P = (const float*)(lds + S2_MG + (w * 2 + br) * S2_MG_STRIDE);
                const float f = ex2(P[1024 + q] - M);
                L += P[1040 + q] * f; o0 += P[(tid >> 4) * 16 + q] * f; o1 += P[((tid >> 4) + 32) * 16 + q] * f; }
            const float g = sigmoidf_(A.PROJ[m * NP + C_GATE + (kvh * 4 + hh) * 3 + 1 + br]) / fmaxf(L, 1e-30f);
            res[0] += g * o0; res[1] += g * o1;
        }
#pragma unroll
        for (int k = 0; k < 2; ++k) A.MIX[m * 1024 + 512 + (kvh * 4 + hh) * 64 + (tid >> 4) + 32 * k] = (bf16)f2bf(res[k]);
    }
}

constexpr int CW_CMPQ = 256;
__device__ __forceinline__ void compress_pull(const CmpArgs& A, unsigned* head, volatile LAS int* slot, int max_batches, int tid) {
    const int lane = tid & 63, wave = __builtin_amdgcn_readfirstlane(tid >> 6);
    for (int nb = 0; nb < max_batches; ++nb) {
        __syncthreads();
        if (tid == 0) *slot = (int)__hip_atomic_fetch_add(head, 8u, __ATOMIC_RELAXED, __HIP_MEMORY_SCOPE_AGENT);
        __syncthreads();
        const int base = *slot;
        if (base >= 2048) break;
        compress_unit(A, 128 + base + wave, lane);
    }
    __syncthreads();
}

struct Args { const GAS void* in[22]; GAS float* out; GAS unsigned char* ws; int ph_lo, ph_hi; };
constexpr int PH_PER_LAYER = 10, N_PHASES = 1 + NL * PH_PER_LAYER;
__global__ void __launch_bounds__(NWAVES * 64, 2) hymba_fwd(Args args) {
    extern __shared__ __attribute__((aligned(16))) unsigned char lds[];
    const int G = gridDim.x, bx = blockIdx.x, NGW = G * NWAVES;
    const int wave_s_ = __builtin_amdgcn_readfirstlane((int)threadIdx.x >> 6);
#define TID_NOW() (wave_s_ * 64 + (int)__builtin_amdgcn_mbcnt_hi(~0u, __builtin_amdgcn_mbcnt_lo(~0u, 0u)))
#define SUB_IDS int tid = TID_NOW(); asm volatile("" : "+v"(tid)); const int lane = tid & 63, wave = __builtin_amdgcn_readfirstlane(tid >> 6), gw = bx * NWAVES + wave; (void)lane; (void)gw; (void)wave;
#define PHASE_IDS int tid = TID_NOW(); asm volatile("" : "+v"(tid)); const int lane = tid & 63, wave = __builtin_amdgcn_readfirstlane(tid >> 6), gw = bx * NWAVES + wave; (void)lane; (void)gw; const __attribute__((address_space(4))) unsigned long long* ka_ = (const __attribute__((address_space(4))) unsigned long long*)__builtin_amdgcn_kernarg_segment_ptr(); asm volatile("" : "+s"(ka_)); GAS unsigned char* wsg_ = (GAS unsigned char*)ka_[23]; unsigned char* wsl = (unsigned char*)wsg_;
#define x_prompt ((const float*)(const GAS float*)ka_[0])
#define x_sample ((const float*)(const GAS float*)ka_[1])
#define cache_kv ((const float*)(const GAS float*)ka_[2])
#define page_table ((const int*)(const GAS int*)ka_[3])
#define state_win ((const float*)(const GAS float*)ka_[4])
#define state_gdn ((const float*)(const GAS float*)ka_[5])
#define state_conv ((const float*)(const GAS float*)ka_[6])
#define norm_mix ((const float*)(const GAS float*)ka_[7])
#define w_in ((const float*)(const GAS float*)ka_[8])
#define conv_w ((const float*)(const GAS float*)ka_[9])
#define a_log ((const float*)(const GAS float*)ka_[10])
#define dt_bias ((const float*)(const GAS float*)ka_[11])
#define gdn_norm ((const float*)(const GAS float*)ka_[12])
#define cmp_pe_k ((const float*)(const GAS float*)ka_[13])
#define cmp_w_k ((const float*)(const GAS float*)ka_[14])
#define cmp_pe_v ((const float*)(const GAS float*)ka_[15])
#define cmp_w_v ((const float*)(const GAS float*)ka_[16])
#define w_out ((const float*)(const GAS float*)ka_[17])
#define norm_mlp ((const float*)(const GAS float*)ka_[18])
#define w_up ((const float*)(const GAS float*)ka_[19])
#define w_down ((const float*)(const GAS float*)ka_[20])
#define norm_final ((const float*)(const GAS float*)ka_[21])
#define out ((float*)(GAS float*)ka_[22])
#define WIN_T ((bf16*)(wsl + WS_WIN))
#define WOUT_T ((bf16*)(wsl + WS_WOUT))
#define WUP_T ((bf16*)(wsl + WS_WUP))
#define WDN_T ((bf16*)(wsl + WS_WDN))
#define CMPW ((bf16*)(wsl + WS_CMPW))
#define HB ((bf16*)(wsl + WS_HB))
#define PROJ ((float*)(wsl + WS_PROJ))
#define X1 ((float*)(wsl + WS_X1))
#define X2 ((float*)(wsl + WS_X2))
#define MIX ((bf16*)(wsl + WS_MIX))
#define HID ((bf16*)(wsl + WS_HID))
#define QN ((float*)(wsl + WS_QN))
#define KN ((float*)(wsl + WS_KN))
#define VG ((float*)(wsl + WS_VG))
#define OG ((float*)(wsl + WS_OG))
#define GG ((float*)(wsl + WS_G))
#define BETA ((float*)(wsl + WS_BETA))
#define KQ ((float*)(wsl + WS_KQ))
#define QB ((bf16*)(wsl + WS_QB))
#define KS ((bf16*)(wsl + WS_KS))
#define VS ((bf16*)(wsl + WS_VS))
#define KW ((bf16*)(wsl + WS_KW))
#define VW ((bf16*)(wsl + WS_VW))
#define CKP ((float*)(wsl + WS_CKP))
#define CVP ((float*)(wsl + WS_CVP))
#define CKS ((float*)(wsl + WS_CKS))
#define CVS ((float*)(wsl + WS_CVS))
#define GK ((bf16*)(wsl + WS_GK))
#define GQ ((bf16*)(wsl + WS_GQ))
#define GKT ((bf16*)(wsl + WS_GKT))
#define GVT ((bf16*)(wsl + WS_GVT))
#define GG2 ((float*)(wsl + WS_GG2))
#define BETA2 ((float*)(wsl + WS_BETA2))
#define WX ((bf16*)(wsl + WS_WX))
#define QX ((bf16*)(wsl + WS_QX))
#define QKX ((bf16*)(wsl + WS_QKX))
#define KTX ((bf16*)(wsl + WS_KTX))
#define U0F ((float*)(wsl + WS_U0F))
#define GL ((float*)(wsl + WS_GL))
#define PARTD ((float*)(wsl + WS_PARTD))
#define PARTG ((float*)(wsl + WS_PARTG))
    LAS unsigned char* ldsl = (LAS unsigned char*)lds;

    const int lo = args.ph_lo, hi = args.ph_hi;
    { const int t0_ = TID_NOW(); if (t0_ < 16) ((LAS unsigned*)(ldsl + MISC_OFF))[t0_] = 0u; }
    __syncthreads();
    XcdBarrier bar = xcd_barrier_post((unsigned*)((unsigned char*)args.ws + WS_CTL) + CW_BAR, (volatile LAS unsigned*)(ldsl + MISC_OFF), TID_NOW() == 0);
#define BOTH(k) (lo <= (k) && (k) + 1 < hi)
#define GRID_BAR(k) do { if (BOTH(k)) { for (int rb_ = 0; rb_ < REP_BAR; ++rb_) xcd_barrier(bar, TID_NOW() == 0); } } while (0)
#ifndef REP_PG
#define REP_PG 1
#endif
#ifndef REP_PA
#define REP_PA 1
#endif
#ifndef REP_BAR
#define REP_BAR 1
#endif
#ifndef REP_GSMP
#define REP_GSMP 1
#endif
#ifndef REP_P0
#define REP_P0 1
#endif
#ifndef REP_LIGHT
#define REP_LIGHT 1
#endif
#ifndef REP_PB_ROW
#define REP_PB_ROW 1
#endif
#ifndef REP_PB_PREP
#define REP_PB_PREP 1
#endif
#ifndef REP_PB_CMP
#define REP_PB_CMP 1
#endif
#ifndef REP_PB_COPY
#define REP_PB_COPY 1
#endif
#ifndef REP_PB2
#define REP_PB2 1
#endif
#ifndef REP_SCAN
#define REP_SCAN 1
#endif
#ifndef REP_ATTP
#define REP_ATTP 1
#endif
#ifndef REP_ATTS
#define REP_ATTS 1
#endif
#ifndef REP_GEMM
#define REP_GEMM 1
#endif
#define EN(i) (((PH_MASK_T) >> (i)) & 1u)
#define SUB(i) (((SUB_MASK_T) >> (i)) & 1u)
#define IN(k) (lo <= (k) && (k) < hi)

    if (IN(0)) { PHASE_IDS
        for (int rep0 = 0; rep0 < REP_P0; ++rep0) {
        LAS float* scr = (LAS float*)(ldsl + wave * 16384);
        constexpr int I_IN = 16 * 112, I_OUT = 16 * 32, I_UP = 16 * 128, I_DN = 64 * 32, I_C = 32 * 2, I_L = I_IN + I_OUT + I_UP + I_DN + 2 * I_C;
        for (int it = gw; it < NL * I_L; it += NGW) {
            const int l = it / I_L; int r = it % I_L;
            if (r < I_IN) { transpose_item(w_in + (size_t)l * DM * NPROJ, DM, NPROJ, NP, WIN_T + (size_t)l * NP * DM, scr, r, lane); continue; } r -= I_IN;
            if (r < I_OUT) { transpose_item(w_out + (size_t)l * DM * DM, DM, DM, DM, WOUT_T + (size_t)l * DM * DM, scr, r, lane); continue; } r -= I_OUT;
            if (r < I_UP) { transpose_item(w_up + (size_t)l * DM * DFF, DM, DFF, DFF, WUP_T + (size_t)l * DFF * DM, scr, r, lane); continue; } r -= I_UP;
            if (r < I_DN) { transpose_item(w_down + (size_t)l * DFF * DM, DFF, DM, DM, WDN_T + (size_t)l * DM * DFF, scr, r, lane); continue; } r -= I_DN;
            if (r < I_C) { transpose_item(cmp_w_k + (size_t)l * 2048 * 64, 2048, 64, 64, CMPW + (size_t)((l * 2 + 0) * 64) * 2048, scr, r, lane); continue; } r -= I_C;
            transpose_item(cmp_w_v + (size_t)l * 2048 * 64, 2048, 64, 64, CMPW + (size_t)((l * 2 + 1) * 64) * 2048, scr, r, lane);
        }
        for (int m = gw; m < MT; m += NGW) { const float* xr = (m < MP) ? x_prompt + (size_t)m * DM : x_sample + (size_t)(m - MP) * DM; rms_row(xr, norm_mix, HB + (size_t)m * DM, nullptr, lane); }
        }
    }

    GRID_BAR(0);
    for (int l = 0; l < NL; ++l) {
        const int pb = 1 + l * PH_PER_LAYER;
        if (IN(pb + 0)) { PHASE_IDS
            pg8::Gemm g{HB, WIN_T + (size_t)l * NP * DM, MT, NP, DM, DM}; pg8::StaticOrder S; S.init(MT, NP, G, bx);
            pg8::EpiF32 E{PROJ, NP};
            _Pragma("unroll 1") for (int rep = 0; rep < REP_PA; ++rep) pg8::gemm_phase<pg8::EpiF32, pg8::StaticOrder, true, true>(ldsl, g, S, E, tid);
            if (l == 0 && bx >= (MT / 256) * (NP / 256) % G) { SUB_IDS CmpArgs CA{PROJ, cache_kv, page_table, cmp_pe_k, cmp_pe_v, CMPW, wsl, 0};
                compress_pull(CA, (unsigned*)(wsl + WS_CTL) + CW_CMPQ, (volatile LAS int*)(ldsl + MISC_OFF + 36), 1, tid); }
        }
        GRID_BAR(pb + 0);
        if (IN(pb + 1)) { PHASE_IDS
            { SUB_IDS PBArgs A{PROJ, state_conv, conv_w, a_log, dt_bias, QN, KN, VG, GG, BETA, KQ, QB, KS, VS, KW, VW, out, l};
              for (int rep = 0; rep < REP_PB_ROW; ++rep) if (gw >= 128) for (int m = gw - 128; m < MT; m += 2 * (NGW - 128)) {
                  const int m2 = m + (NGW - 128); const bool has2 = m2 < MT; PBRegs r0, r1;
                  pb_row_load(A, m, lane, r0); pb_row_load(A, has2 ? m2 : m, lane, r1);
                  __builtin_amdgcn_sched_barrier(0);
                  pb_row(A, m, lane, r0); if (has2) pb_row(A, m2, lane, r1); }
              for (int u = gw; u < MS * 8; u += NGW) pb_sample_head(A, u, lane); }
            { SUB_IDS GPArgs A{PROJ, conv_w, a_log, dt_bias, GK, GQ, GKT, GVT, GG2, BETA2, l};
              for (int rep = 0; rep < REP_PB_PREP; ++rep) for (int u = gw; u < (MP / 8) * 8; u += 2 * NGW) {
                  GPRegs r0, r1; const int u2 = (u + NGW < (MP / 8) * 8) ? u + NGW : u; gdn_prep_load(A, u, lane, r0); gdn_prep_load(A, u2, lane, r1);
                  __builtin_amdgcn_sched_barrier(0);
                  gdn_prep_unit(A, u, lane, r0); gdn_prep_unit(A, u2, lane, r1); } }
            { SUB_IDS CmpArgs A{PROJ, cache_kv, page_table, cmp_pe_k, cmp_pe_v, CMPW, wsl, l};
              if (gw < 128) compress_unit(A, gw, lane);
              compress_pull(A, (unsigned*)(wsl + WS_CTL) + CW_CMPQ + 64 * l, (volatile LAS int*)(ldsl + MISC_OFF + 36), 1 << 20, tid); }
        }
        GRID_BAR(pb + 1);
        if (IN(pb + 2)) { PHASE_IDS
            GCArgs A{GK, GQ, GKT, GVT, GG2, BETA2, WX, QX, QKX, KTX, U0F, GL};
            for (int rep = 0; rep < REP_PB2; ++rep) for (int u = gw; u < 32 * 64; u += NGW) gdn_chunk_unit(A, lds + wave * GC_LDS_PER_WAVE, u, lane);
        }
        GRID_BAR(pb + 2);
        if (IN(pb + 3)) {
            { PHASE_IDS GdnArgs GA{QN, KN, VG, GG, BETA, KQ, OG, PROJ, state_gdn, gdn_norm, MIX, out, l};
                for (int rep = 0; rep < REP_GSMP; ++rep) for (int u = gw; u < NSB * 8; u += NGW) gdn_sample_unit(GA, u, lane); }
            { PHASE_IDS
                GS2Args SG{WX, QX, QKX, KTX, U0F, GL, OG, out, l};
                AttArgs AA{QB, KS, VS, KW, VW, CKP, CVP, PROJ, MIX};
                SAttArgs SA{QB, KS, VS, KW, VW, CKS, CVS, PROJ, cache_kv, page_table, state_win, MIX, l};
                unsigned* qhead = (unsigned*)(wsl + WS_CTL) + CW_QUEUE + 64 * l;
                volatile LAS int* slot = (volatile LAS int*)(ldsl + MISC_OFF + 32);
                for (;;) {
                    __syncthreads();
                    if (tid == 0) *slot = (int)__hip_atomic_fetch_add(qhead, 1u, __ATOMIC_RELAXED, __HIP_MEMORY_SCOPE_AGENT);
                    __syncthreads();
                    int u = *slot;
                    constexpr int XP = (REP_ATTP - 1) * 512, XS = (REP_ATTS - 1) * 256, XG = (REP_SCAN - 1) * 32;
                    if (u >= 800 + XP + XS + XG + 128) break;
                    if (u >= 800 + XP + XS + XG) {
                        const int sb = u - (800 + XP + XS + XG); const f32x4* src = (const f32x4*)(state_win + ((size_t)l * NSB + sb) * 512 * 256) + 256; f32x4* dst = (f32x4*)(out + O_WINS + ((size_t)l * NSB + sb) * 512 * 256);
                        for (int i = tid; i < 508 * 64; i += 8 * NWAVES * 64) { f32x4 v[8];
#pragma unroll
                            for (int k = 0; k < 8; ++k) { const int ii = i + k * NWAVES * 64; v[k] = src[ii < 508 * 64 ? ii : i]; }
#pragma unroll
                            for (int k = 0; k < 8; ++k) { const int ii = i + k * NWAVES * 64; if (ii < 508 * 64) dst[ii] = v[k]; } }
                        continue; }
                    if (u >= 800) { int v = u - 800; if (v < XP) u = 32 + (v & 511); else { v -= XP; if (v < XS) u = 544 + (v & 255); else u = (v - XS) & 31; } }
                    int tq = TID_NOW(); asm volatile("" : "+v"(tq));
                    if (u < 32) gdn_scan3_block(SG, lds, u, tq);
                    else if (u < 32 + 512) nsa_prompt_unit(AA, lds, u - 32, tq);
                    else nsa_sample_unit(SA, lds, u - 544, tq);
                }
            }
        }
        GRID_BAR(pb + 3);
        if (IN(pb + 4)) { PHASE_IDS
            const float gnl = gdn_norm[l * 64 + lane];
            for (int rep = 0; rep < REP_LIGHT; ++rep) for (int m = gw; m < MP; m += NGW) {
                float ov[8], zv[8];
#pragma unroll
                for (int h = 0; h < 8; ++h) { ov[h] = OG[(size_t)m * 512 + h * 64 + lane]; zv[h] = PROJ[(size_t)m * NP + C_Z + h * 64 + lane]; }
                __builtin_amdgcn_sched_barrier(0);
#pragma unroll
                for (int h = 0; h < 8; ++h) { const float ms = dpp_sum(ov[h] * ov[h]) * (1.f / 64.f);
                    MIX[(size_t)m * 1024 + h * 64 + lane] = (bf16)f2bf(ov[h] * (1.f / sqrtf(ms + 1e-6f)) * gnl * siluf_(zv[h])); } }
        }
        GRID_BAR(pb + 4);
        if (IN(pb + 5)) { PHASE_IDS
            { pg8::Gemm g{MIX, WOUT_T + (size_t)l * DM * DM, MP, DM, DM, DM}; pg8::StaticOrder S; S.init(MP, DM, G, bx);
              const float* rb = (l == 0) ? x_prompt : (const float*)X2;
              pg8::EpiResid E{rb, rb, MP, X1, DM};
              pg8::gemm_phase<pg8::EpiResid, pg8::StaticOrder, true, true>(ldsl, g, S, E, tid); }
            { pg8::Gemm g{MIX, WOUT_T + (size_t)l * DM * DM, MT, DM, PD_KL, DM}; pg8::SplitKOrder S; S.init(MP / 256, MS / 256, DM / 256, PD_KS, PD_KL, G, bx);
              pg8::EpiPart E{PARTD, DM, MP, MS};
              pg8::gemm_phase<pg8::EpiPart, pg8::SplitKOrder, false, true>(ldsl, g, S, E, tid); }
        }
        GRID_BAR(pb + 5);
        if (IN(pb + 6)) { PHASE_IDS
            for (int m = gw; m < MP; m += 2 * NGW) { const int m2 = m + NGW;
                if (m2 < MP) rms_row2(X1 + (size_t)m * DM, X1 + (size_t)m2 * DM, norm_mlp + (size_t)l * DM, HB + (size_t)m * DM, HB + (size_t)m2 * DM, nullptr, nullptr, lane);
                else rms_row(X1 + (size_t)m * DM, norm_mlp + (size_t)l * DM, HB + (size_t)m * DM, nullptr, lane); }
            for (int m = MP + gw; m < MT; m += NGW) { const float* bs = (l == 0) ? x_sample + (size_t)(m - MP) * DM : (const float*)X2 + (size_t)m * DM;
                rms_row_parts(bs, PARTD + (size_t)(m - MP) * DM, PD_KS, (size_t)MS * DM, X1 + (size_t)m * DM, norm_mlp + (size_t)l * DM, HB + (size_t)m * DM, nullptr, lane); } }
        GRID_BAR(pb + 6);
        if (IN(pb + 7)) { PHASE_IDS
            pg8::Gemm g{HB, WUP_T + (size_t)l * DFF * DM, MT, DFF, DM, DM}; pg8::StaticOrder S; S.init(MT, DFF, G, bx);
            pg8::EpiRelu2 E{HID, DFF};
            pg8::gemm_phase<pg8::EpiRelu2, pg8::StaticOrder, true, true>(ldsl, g, S, E, tid);
            if (l + 1 < NL && bx >= (MT / 256) * (DFF / 256) % G) { SUB_IDS CmpArgs CA{PROJ, cache_kv, page_table, cmp_pe_k, cmp_pe_v, CMPW, wsl, l + 1};
                compress_pull(CA, (unsigned*)(wsl + WS_CTL) + CW_CMPQ + 64 * (l + 1), (volatile LAS int*)(ldsl + MISC_OFF + 36), 1, tid); }
        }
        GRID_BAR(pb + 7);
        if (IN(pb + 8)) { PHASE_IDS
            { pg8::Gemm g{HID, WDN_T + (size_t)l * DM * DFF, MP, DM, DFF, DFF}; pg8::StaticOrder S; S.init(MP, DM, G, bx);
              pg8::EpiResid E{X1, X1, MP, X2, DM};
              pg8::gemm_phase<pg8::EpiResid, pg8::StaticOrder, true, true>(ldsl, g, S, E, tid); }
            { pg8::Gemm g{HID, WDN_T + (size_t)l * DM * DFF, MT, DM, PG_KL, DFF}; pg8::SplitKOrder S; S.init(MP / 256, MS / 256, DM / 256, PG_KS, PG_KL, G, bx);
              pg8::EpiPart E{PARTG, DM, MP, MS};
              pg8::gemm_phase<pg8::EpiPart, pg8::SplitKOrder, false, true>(ldsl, g, S, E, tid); }
        }
        GRID_BAR(pb + 8);
        if (IN(pb + 9)) { PHASE_IDS
            const float* gn = (l + 1 < NL) ? norm_mix + (size_t)(l + 1) * DM : norm_final; const bool fin = !(l + 1 < NL);
            for (int m = gw; m < MP; m += 2 * NGW) { const int m2 = m + NGW;
                if (m2 < MP) rms_row2(X2 + (size_t)m * DM, X2 + (size_t)m2 * DM, gn, fin ? nullptr : HB + (size_t)m * DM, fin ? nullptr : HB + (size_t)m2 * DM, fin ? out + O_YP + (size_t)m * DM : nullptr, fin ? out + O_YP + (size_t)m2 * DM : nullptr, lane);
                else rms_row(X2 + (size_t)m * DM, gn, fin ? nullptr : HB + (size_t)m * DM, fin ? out + O_YP + (size_t)m * DM : nullptr, lane); }
            for (int m = MP + gw; m < MT; m += NGW)
                rms_row_parts(X1 + (size_t)m * DM, PARTG + (size_t)(m - MP) * DM, PG_KS, (size_t)MS * DM, X2 + (size_t)m * DM, gn, fin ? nullptr : HB + (size_t)m * DM, fin ? out + O_YP + (size_t)m * DM : nullptr, lane);
        }
        GRID_BAR(pb + 9);
    }
#undef IN
}

#undef x_prompt
#undef x_sample
#undef cache_kv
#undef page_table
#undef state_win
#undef state_gdn
#undef state_conv
#undef norm_mix
#undef w_in
#undef conv_w
#undef a_log
#undef dt_bias
#undef gdn_norm
#undef cmp_pe_k
#undef cmp_w_k
#undef cmp_pe_v
#undef cmp_w_v
#undef w_out
#undef norm_mlp
#undef w_up
#undef w_down
#undef norm_final
#undef out
#ifndef MK_PER_PHASE
#define MK_PER_PHASE 0
#endif
typedef void (*kfn_t)(Args); static const kfn_t K_ALL = hymba_fwd;
extern "C" void kernel_launch(void* const* d_in, const int* in_sizes, int n_in, void* d_out, int out_size, void* d_ws, size_t ws_size, hipStream_t stream) {
    static int grid = 0;
    if (grid == 0) {
        if (n_in != 22 || out_size != (int)O_END || ws_size < WS_END) { fprintf(stderr, "kernel_launch: unexpected shapes (n_in %d, out %d, ws %zu)\n", n_in, out_size, ws_size); grid = -1; return; }
        int dev = 0, cus = 0, per_cu = 0;
        if (hipGetDevice(&dev) != hipSuccess || hipDeviceGetAttribute(&cus, hipDeviceAttributeMultiprocessorCount, dev) != hipSuccess) { grid = -1; return; }
        if (hipFuncSetAttribute((const void*)K_ALL, hipFuncAttributeMaxDynamicSharedMemorySize, LDS_BYTES) != hipSuccess) { fprintf(stderr, "kernel_launch: hipFuncSetAttribute failed\n"); grid = -1; return; }
        if (hipOccupancyMaxActiveBlocksPerMultiprocessor(&per_cu, (const void*)K_ALL, NWAVES * 64, LDS_BYTES) != hipSuccess || per_cu < 1) { fprintf(stderr, "kernel_launch: occupancy query says %d blocks per CU\n", per_cu); }
        (void)hipGetLastError();
        grid = cus;
    }
    if (grid < 0) return;
    (void)hipMemsetAsync((char*)d_ws + WS_CTL, 0, CTL_ZERO_BYTES, stream);
    Args a{};
    for (int i = 0; i < 22; ++i) a.in[i] = (const GAS void*)d_in[i];
    a.out = (GAS float*)d_out; a.ws = (GAS unsigned char*)d_ws;
    const dim3 g(grid), b(NWAVES * 64);
#if MK_PER_PHASE
    for (int ph = 0; ph < N_PHASES; ++ph) { a.ph_lo = ph; a.ph_hi = ph + 1; K_ALL<<<g, b, LDS_BYTES, stream>>>(a); }
#else
    a.ph_lo = 0; a.ph_hi = N_PHASES; K_ALL<<<g, b, LDS_BYTES, stream>>>(a);
#endif
}
```

```cpp
#include <hip/hip_runtime.h>
#include <cstdio>
#include <cstdint>
namespace pg8 {
#define PG8_LAS __attribute__((address_space(3)))
typedef unsigned short bf16_t;
typedef short bf16x8 __attribute__((ext_vector_type(8)));
typedef float f32x4 __attribute__((ext_vector_type(4)));
typedef unsigned u32x4 __attribute__((ext_vector_type(4)));
constexpr int BM = 256, BK = 64, HALF = 128, HTB = HALF * BK * 2  , STAGE_BYTES = 8 * HTB, NXCD = 8, WGM = 8;

__host__ __device__ __forceinline__ int lds_byte(int r, int c) { const int st = (r >> 4) * 2 + (c >> 5), rr = r & 15, cc = c & 31, ob = rr * 64 + cc * 2; return st * 1024 + (ob ^ (((ob >> 9) & 1) << 5)); }
__host__ __device__ __forceinline__ void stage_rc(int b, int& R, int& C) { const int st = b / 1024, sb = b % 1024, swz = sb ^ (((sb >> 9) & 1) << 5); R = (st >> 1) * 16 + swz / 64; C = (st & 1) * 32 + (swz % 64) / 2; }
__host__ __device__ __forceinline__ int perm32(int rho) { const int n = rho >> 4, i = rho & 15; return 8 * (i >> 2) + 4 * n + (i & 3); }

struct Unit { int pm, pn, kofs, kc; };
struct Gemm { const bf16_t* A; const bf16_t* Bt; int M, N, K, ld; };

struct StaticOrder {
    int nM, nN, nwg, G, c;
    __host__ __device__ void init(int M, int N, int G_, int c_) { nM = M / BM; nN = N / BM; nwg = nM * nN; G = G_; c = c_; }
    __host__ __device__ bool next(int i, Unit& u) const {
        const long L = (long)i * G + c; if (L >= nwg) return false;
        int wgid = (int)L; { const int q = nwg / NXCD, r = nwg % NXCD, xcd = wgid % NXCD, off = wgid / NXCD; wgid = (xcd < r ? xcd * (q + 1) : r * (q + 1) + (xcd - r) * q) + off; }
        const int nig = WGM * nN, gid = wgid / nig, fm = gid * WGM, gsz = (nM - fm) < WGM ? (nM - fm) : WGM;
        u.pm = fm + ((wgid % nig) % gsz); u.pn = (wgid % nig) / gsz; u.kofs = 0; u.kc = 0; return true;
    }
    __device__ __forceinline__ void a_ready(const Unit&) const {}
    __device__ __forceinline__ void done(const Unit&) const {}
};

__device__ __forceinline__ unsigned cvt_pk_bf16(float lo, float hi) { unsigned r; asm volatile("v_cvt_pk_bf16_f32 %0, %1, %2" : "=v"(r) : "v"(lo), "v"(hi)); return r; }

struct EpiF32 {
    static constexpr bool PERM = false, AFTER_DRAIN = false;
    float* O; int ldc;
    __device__ __forceinline__ void operator()(const f32x4 (&acc)[2][2][4][2], const Unit& u, int wr, int wc, int fr, int fq) const {
        const int row0 = u.pm * BM + wr * 64 + fr, col0 = u.pn * BM + wc * 32 + 4 * fq;
#pragma unroll
        for (int ai = 0; ai < 2; ++ai)
#pragma unroll
            for (int m = 0; m < 4; ++m) { float* rowp = O + (size_t)(row0 + ai * HALF + m * 16) * ldc + col0;
#pragma unroll
                for (int bj = 0; bj < 2; ++bj)
#pragma unroll
                    for (int n = 0; n < 2; ++n) *(f32x4*)(rowp + bj * HALF + n * 16) = acc[ai][bj][m][n]; }
    }
};
struct EpiResid {
    static constexpr bool PERM = false, AFTER_DRAIN = false;
    const float* base; const float* base2; int split_row; float* O; int ldc;
    __device__ __forceinline__ void operator()(const f32x4 (&acc)[2][2][4][2], const Unit& u, int wr, int wc, int fr, int fq) const {
        const int row0 = u.pm * BM + wr * 64 + fr, col0 = u.pn * BM + wc * 32 + 4 * fq;
        const float* bs = (u.pm * BM >= split_row) ? (base2 - (size_t)split_row * ldc) : base;
#pragma unroll
        for (int ai = 0; ai < 2; ++ai)
#pragma unroll
            for (int m = 0; m < 4; ++m) { const size_t off = (size_t)(row0 + ai * HALF + m * 16) * ldc + col0;
#pragma unroll
                for (int bj = 0; bj < 2; ++bj)
#pragma unroll
                    for (int n = 0; n < 2; ++n) { const f32x4 r = *(const f32x4*)(bs + off + bj * HALF + n * 16); *(f32x4*)(O + off + bj * HALF + n * 16) = r + acc[ai][bj][m][n]; } }
    }
};
struct EpiRelu2 {
    static constexpr bool PERM = true, AFTER_DRAIN = false;
    bf16_t* O; int ldc;
    __device__ __forceinline__ void operator()(const f32x4 (&acc)[2][2][4][2], const Unit& u, int wr, int wc, int fr, int fq) const {
        const int row0 = u.pm * BM + wr * 64 + fr, col0 = u.pn * BM + wc * 32 + 8 * fq;
#pragma unroll
        for (int ai = 0; ai < 2; ++ai)
#pragma unroll
            for (int m = 0; m < 4; ++m) { bf16_t* rowp = O + (size_t)(row0 + ai * HALF + m * 16) * ldc + col0;
#pragma unroll
                for (int bj = 0; bj < 2; ++bj) { f32x4 v0 = acc[ai][bj][m][0], v1 = acc[ai][bj][m][1];
#pragma unroll
                    for (int i = 0; i < 4; ++i) { const float a = v0[i] > 0.f ? v0[i] : 0.f, b = v1[i] > 0.f ? v1[i] : 0.f; v0[i] = a * a; v1[i] = b * b; }
                    u32x4 w; w.x = cvt_pk_bf16(v0[0], v0[1]); w.y = cvt_pk_bf16(v0[2], v0[3]); w.z = cvt_pk_bf16(v1[0], v1[1]); w.w = cvt_pk_bf16(v1[2], v1[3]);
                    *(u32x4*)(rowp + bj * HALF) = w; } }
    }
};

struct SplitKOrder {
    int pm0, nN, KS, KL, total, G, c;
    __host__ __device__ void init(int pm0_, int nPm, int nN_, int KS_, int KL_, int G_, int c_) { pm0 = pm0_; nN = nN_; KS = KS_; KL = KL_; total = nPm * nN_ * KS_; G = G_; c = c_; }
    __host__ __device__ bool next(int i, Unit& u) const {
        const long L = (long)i * G + c; if (L >= total) return false;
        const int l = (int)L, kc = l % KS, rest = l / KS; u.pn = rest % nN; u.pm = pm0 + rest / nN; u.kofs = kc * KL; u.kc = kc; return true; }
    __device__ __forceinline__ void a_ready(const Unit&) const {}
    __device__ __forceinline__ void done(const Unit&) const {}
};
struct EpiPart {
    static constexpr bool PERM = false, AFTER_DRAIN = false;
    float* P; int ldc; int row0; int rows;
    __device__ __forceinline__ void operator()(const f32x4 (&acc)[2][2][4][2], const Unit& u, int wr, int wc, int fr, int fq) const {
        const int rowl = u.pm * BM - row0 + wr * 64 + fr, col0 = u.pn * BM + wc * 32 + 4 * fq;
        float* base = P + (size_t)u.kc * rows * ldc;
#pragma unroll
        for (int ai = 0; ai < 2; ++ai)
#pragma unroll
            for (int m = 0; m < 4; ++m) { float* rowp = base + (size_t)(rowl + ai * HALF + m * 16) * ldc + col0;
#pragma unroll
                for (int bj = 0; bj < 2; ++bj)
#pragma unroll
                    for (int n = 0; n < 2; ++n) *(f32x4*)(rowp + bj * HALF + n * 16) = acc[ai][bj][m][n]; }
    }
};
template <class Epi, class Sched, bool ALIGN_EPI = false, bool SP2 = false>
__device__ __forceinline__ void gemm_phase(PG8_LAS unsigned char* lds, const Gemm g, const Sched& S, const Epi& E, int tid_in) {
    int tid = tid_in; asm volatile("" : "+v"(tid));
    const int wid = __builtin_amdgcn_readfirstlane(tid >> 6), lane = tid & 63, wr = wid >> 2, wc = wid & 3, fr = lane & 15, fq = lane >> 4;
    const int K = g.ld, nt = g.K / BK;
    unsigned voffA[2], voffB[2];
#pragma unroll
    for (int i = 0; i < 2; ++i) { int R, C; stage_rc(tid * 16 + i * 8192, R, C); const int Rb = Epi::PERM ? ((R & ~31) + perm32(R & 31)) : R;
        voffA[i] = (unsigned)(R * K + C) * 2u; voffB[i] = (unsigned)(Rb * K + C) * 2u; }
    const size_t kstep = (size_t)(BK * 2);
    const size_t hstep = (size_t)HALF * K * 2;
    const size_t tstep = 2 * hstep;
    const unsigned ldsw = (unsigned)wid * 1024u;
    const int aoff = lds_byte(wr * 64 + fr, fq * 8), boff = lds_byte(wc * 32 + fr, fq * 8);
#define PG8_SA(b, h) (((b) * 2 + (h)) * HTB)
#define PG8_SB(b, h) ((4 + (b) * 2 + (h)) * HTB)
#define PG8_STAGE(bufoff, gbase, voff) do { _Pragma("unroll") for (int _i = 0; _i < 2; ++_i) \
        __builtin_amdgcn_global_load_lds((const unsigned*)((const char*)(gbase) + (voff)[_i]), (PG8_LAS unsigned*)(lds + (bufoff) + ldsw + _i * 8192), 16, 0, 0); } while (0)
#define PG8_LDA(dst, b, h) do { _Pragma("unroll") for (int m = 0; m < 4; ++m) _Pragma("unroll") for (int k = 0; k < 2; ++k) dst[m][k] = *(const PG8_LAS bf16x8*)(lds + PG8_SA(b, h) + aoff + m * 2048 + k * 1024); } while (0)
#define PG8_LDB(dst, b, h) do { _Pragma("unroll") for (int n = 0; n < 2; ++n) _Pragma("unroll") for (int k = 0; k < 2; ++k) dst[n][k] = *(const PG8_LAS bf16x8*)(lds + PG8_SB(b, h) + boff + n * 2048 + k * 1024); } while (0)
#define PG8_MMA(ai, bj, At, Bt) do { __builtin_amdgcn_s_setprio(1); _Pragma("unroll") for (int m = 0; m < 4; ++m) _Pragma("unroll") for (int n = 0; n < 2; ++n) _Pragma("unroll") for (int k = 0; k < 2; ++k) \
        acc[ai][bj][m][n] = __builtin_amdgcn_mfma_f32_16x16x32_bf16(Bt[n][k], At[m][k], acc[ai][bj][m][n], 0, 0, 0); __builtin_amdgcn_s_setprio(0); } while (0)
#define PG8_WAIT_V(n) asm volatile("s_waitcnt vmcnt(" #n ")" ::: "memory")
#define PG8_WAIT_L(n) asm volatile("s_waitcnt lgkmcnt(" #n ")" ::: "memory")
#define PG8_BAR __builtin_amdgcn_s_barrier()
#define PG8_SCHED __builtin_amdgcn_sched_barrier(0)
    Unit cur, nxt; int ui = 0;
    if (!S.next(0, cur)) return;
    f32x4 acc[2][2][4][2];
#pragma unroll
    for (int a = 0; a < 2; ++a)
#pragma unroll
        for (int b = 0; b < 2; ++b)
#pragma unroll
            for (int m = 0; m < 4; ++m)
#pragma unroll
                for (int n = 0; n < 2; ++n) acc[a][b][m][n] = (f32x4){0.f, 0.f, 0.f, 0.f};
    bf16x8 At[4][2], B0[2][2], B1[2][2];
    const char* cA = (const char*)g.A + (size_t)cur.pm * tstep + (size_t)cur.kofs * 2; const char* cB = (const char*)g.Bt + (size_t)cur.pn * tstep + (size_t)cur.kofs * 2;
    S.a_ready(cur);
    if constexpr (SP2) {
        PG8_STAGE(PG8_SB(0, 0), cB, voffB); PG8_STAGE(PG8_SB(0, 1), cB + hstep, voffB); PG8_STAGE(PG8_SA(0, 0), cA, voffA); PG8_STAGE(PG8_SA(0, 1), cA + hstep, voffA);
        if (wr == 1) PG8_BAR;
        PG8_WAIT_V(2); PG8_BAR;
        PG8_STAGE(PG8_SB(1, 0), cB + kstep, voffB); PG8_STAGE(PG8_SA(1, 0), cA + kstep, voffA); PG8_STAGE(PG8_SB(1, 1), cB + hstep + kstep, voffB);
        PG8_WAIT_V(6); PG8_BAR;
    } else {
        PG8_STAGE(PG8_SB(0, 0), cB, voffB); PG8_STAGE(PG8_SA(0, 0), cA, voffA); PG8_STAGE(PG8_SB(0, 1), cB + hstep, voffB); PG8_STAGE(PG8_SA(0, 1), cA + hstep, voffA);
        if (wr == 1) PG8_BAR;
        PG8_WAIT_V(4); PG8_BAR;
        PG8_STAGE(PG8_SB(1, 0), cB + kstep, voffB); PG8_STAGE(PG8_SA(1, 0), cA + kstep, voffA); PG8_STAGE(PG8_SB(1, 1), cB + hstep + kstep, voffB);
        PG8_WAIT_V(6); PG8_BAR;
    }
    for (;;) {
        const bool has_next = S.next(ui + 1, nxt);
        const char* nA = has_next ? (const char*)g.A + (size_t)nxt.pm * tstep + (size_t)nxt.kofs * 2 : cA; const char* nB = has_next ? (const char*)g.Bt + (size_t)nxt.pn * tstep + (size_t)nxt.kofs * 2 : cB;
        for (int t = 0; t < nt; t += 2) {
            const bool last = (t == nt - 2);
            const char* a1 = cA + (size_t)(t + 1) * kstep;
            const char* a2 = last ? nA : cA + (size_t)(t + 2) * kstep; const char* b2 = last ? nB : cB + (size_t)(t + 2) * kstep;
            const char* a3 = a2 + kstep; const char* b3 = b2 + kstep;
            if (last && has_next) S.a_ready(nxt);
            if constexpr (SP2) {
            PG8_LDB(B0, 0, 0); PG8_LDB(B1, 0, 1); PG8_SCHED; PG8_LDA(At, 0, 0); PG8_STAGE(PG8_SA(1, 1), a1 + hstep, voffA);
            PG8_WAIT_V(8); PG8_WAIT_L(0); PG8_BAR; PG8_MMA(0, 0, At, B0); PG8_MMA(0, 1, At, B1); PG8_BAR; PG8_SCHED;
            PG8_LDA(At, 0, 1); PG8_STAGE(PG8_SB(0, 0), b2, voffB); PG8_STAGE(PG8_SB(0, 1), b2 + hstep, voffB); PG8_STAGE(PG8_SA(0, 0), a2, voffA);
            PG8_WAIT_V(8); PG8_WAIT_L(0); PG8_BAR; PG8_MMA(1, 0, At, B0); PG8_MMA(1, 1, At, B1); PG8_BAR; PG8_SCHED;
            PG8_LDB(B0, 1, 0); PG8_LDB(B1, 1, 1); PG8_SCHED; PG8_LDA(At, 1, 0); PG8_STAGE(PG8_SA(0, 1), a2 + hstep, voffA);
            PG8_WAIT_V(8); PG8_WAIT_L(0); PG8_BAR; PG8_MMA(0, 0, At, B0); PG8_MMA(0, 1, At, B1); PG8_BAR; PG8_SCHED;
            PG8_LDA(At, 1, 1); PG8_STAGE(PG8_SB(1, 0), b3, voffB); PG8_STAGE(PG8_SB(1, 1), b3 + hstep, voffB); PG8_STAGE(PG8_SA(1, 0), a3, voffA);
            PG8_WAIT_V(8); PG8_WAIT_L(0); PG8_BAR; PG8_MMA(1, 0, At, B0); PG8_MMA(1, 1, At, B1); PG8_BAR; PG8_SCHED;
            } else {
            PG8_LDB(B0, 0, 0); PG8_SCHED; PG8_LDA(At, 0, 0); PG8_STAGE(PG8_SA(1, 1), a1 + hstep, voffA);
            PG8_WAIT_L(8); PG8_BAR; PG8_WAIT_L(0); PG8_MMA(0, 0, At, B0); PG8_BAR; PG8_SCHED;
            PG8_LDB(B1, 0, 1); PG8_STAGE(PG8_SB(0, 0), b2, voffB);
            PG8_BAR; PG8_WAIT_L(0); PG8_MMA(0, 1, At, B1); PG8_BAR;
            PG8_LDA(At, 0, 1); PG8_STAGE(PG8_SA(0, 0), a2, voffA);
            PG8_BAR; PG8_WAIT_L(0); PG8_MMA(1, 0, At, B0); PG8_BAR; PG8_SCHED;
            PG8_STAGE(PG8_SB(0, 1), b2 + hstep, voffB);
            PG8_WAIT_V(6); PG8_BAR; PG8_MMA(1, 1, At, B1); PG8_BAR;
            PG8_LDB(B0, 1, 0); PG8_SCHED; PG8_LDA(At, 1, 0); PG8_STAGE(PG8_SA(0, 1), a2 + hstep, voffA);
            PG8_WAIT_L(8); PG8_BAR; PG8_WAIT_L(0); PG8_MMA(0, 0, At, B0); PG8_BAR; PG8_SCHED;
            PG8_LDB(B1, 1, 1); PG8_STAGE(PG8_SB(1, 0), b3, voffB);
            PG8_BAR; PG8_WAIT_L(0); PG8_MMA(0, 1, At, B1); PG8_BAR;
            PG8_LDA(At, 1, 1); PG8_STAGE(PG8_SA(1, 0), a3, voffA);
            PG8_BAR; PG8_WAIT_L(0); PG8_MMA(1, 0, At, B0); PG8_BAR; PG8_SCHED;
            PG8_STAGE(PG8_SB(1, 1), b3 + hstep, voffB);
            PG8_WAIT_V(6); PG8_BAR; PG8_MMA(1, 1, At, B1); PG8_BAR;
            }
        }
        if constexpr (ALIGN_EPI) { if (wr == 0) PG8_BAR; }
        if constexpr (!Epi::AFTER_DRAIN) { E(acc, cur, wr, wc, fr, fq); S.done(cur); }
        if (!has_next) break;
#pragma unroll
        for (int a = 0; a < 2; ++a)
#pragma unroll
            for (int b = 0; b < 2; ++b)
#pragma unroll
                for (int m = 0; m < 4; ++m)
#pragma unroll
                    for (int n = 0; n < 2; ++n) acc[a][b][m][n] = (f32x4){0.f, 0.f, 0.f, 0.f};
        cur = nxt; cA = nA; cB = nB; ++ui;
        if constexpr (ALIGN_EPI) { if (wr == 1) PG8_BAR; }
    }
    PG8_WAIT_V(0);
    if constexpr (!ALIGN_EPI) { if (wr == 0) PG8_BAR; }
    PG8_BAR;
    if constexpr (Epi::AFTER_DRAIN) { E.fused(acc, cur, wr, wc, fr, fq, lds, wid, lane); S.done(cur); }
#undef PG8_SA
#undef PG8_SB
#undef PG8_STAGE
#undef PG8_LDA
#undef PG8_LDB
#undef PG8_MMA
#undef PG8_WAIT_V
#undef PG8_WAIT_L
#undef PG8_BAR
#undef PG8_SCHED
}
}

constexpr int DM = 1024, NPB = 4, SEQ = 4096, MP = NPB * SEQ, NSB = 128, DSEQ = 4, MS = NSB * DSEQ, MT = MP + MS;
constexpr int NPROJ = 3368, NP = 3584, DFF = 4096, NL = 2;
constexpr int C_QKV = 0, C_Z = 1536, C_A = 2048, C_BETA = 2056, C_Q = 2064, C_KV = 2576, C_GATE = 3344;
constexpr int PAST = 2048, NPAGES = 16, NPOOL = 2560;
constexpr float C2 = 0.125f * 1.4426950408889634f;
constexpr float NEG_INF = -__builtin_inff();
constexpr size_t O_YP = 0, O_YS = 16777216, O_KVP = 17301504, O_KVS = 34078720, O_WINP = 34603008, O_WINS = 35651584, O_GDNP = 69206016, O_GDNS = 69468160, O_CONVP = 77856768, O_CONVS = 77893632, O_END = 79073280;
constexpr size_t MiB = 1u << 20;
constexpr size_t WS_CTL = 0, CTL_ZERO_BYTES = 1 * MiB;
constexpr size_t WS_WIN = 2 * MiB, WS_WOUT = 16 * MiB, WS_WUP = 20 * MiB, WS_WDN = 36 * MiB, WS_CMPW = 52 * MiB;
constexpr size_t WS_HB = 54 * MiB, WS_PROJ = 88 * MiB, WS_X1 = 320 * MiB, WS_X2 = 386 * MiB, WS_MIX = 452 * MiB, WS_HID = 486 * MiB;
constexpr size_t WS_QN = 618 * MiB, WS_KN = 651 * MiB, WS_VG = 684 * MiB, WS_OG = 717 * MiB, WS_G = 750 * MiB, WS_BETA = 751 * MiB, WS_KQ = 752 * MiB;
constexpr size_t WS_QB = 753 * MiB, WS_KS = 770 * MiB, WS_VS = 775 * MiB, WS_KW = 780 * MiB, WS_VW = 785 * MiB;
constexpr size_t WS_CKP = 790 * MiB, WS_CVP = 791 * MiB, WS_CKS = 792 * MiB, WS_CVS = 796 * MiB;
constexpr size_t WS_GK = 800 * MiB, WS_GQ = 816 * MiB, WS_GKT = 832 * MiB, WS_GVT = 848 * MiB, WS_GG2 = 864 * MiB, WS_BETA2 = 865 * MiB;
constexpr size_t WS_WX = 866 * MiB, WS_QX = 882 * MiB, WS_QKX = 898 * MiB, WS_KTX = 914 * MiB, WS_U0F = 930 * MiB, WS_GL = 962 * MiB, WS_END = 1043 * MiB;
constexpr size_t WS_PARTD = 963 * MiB, WS_PARTG = 979 * MiB;
constexpr int PD_KS = 4, PD_KL = DM / PD_KS, PG_KS = 8, PG_KL = DFF / PG_KS;
constexpr int CW_QUEUE = 64;
constexpr int CW_BAR = 4096;
constexpr int RING_BYTES = 131072, LDS_BYTES = 147456, MISC_OFF = LDS_BYTES - 64;
constexpr int NWAVES = 8;

#define GAS __attribute__((address_space(1)))
#define LAS __attribute__((address_space(3)))
typedef unsigned short bf16;
typedef unsigned v4u __attribute__((ext_vector_type(4)));
typedef unsigned v2u __attribute__((ext_vector_type(2)));
typedef float f32x4 __attribute__((ext_vector_type(4)));
typedef float f32x16 __attribute__((ext_vector_type(16)));
typedef short bf16x8 __attribute__((ext_vector_type(8)));
typedef short s16x4 __attribute__((ext_vector_type(4)));
#define LDS_WAIT() asm volatile("s_waitcnt lgkmcnt(0)" ::: "memory")
__device__ __forceinline__ unsigned f2bf(float f) { unsigned u = __builtin_bit_cast(unsigned, f); return (u + 0x7fffu + ((u >> 16) & 1u)) >> 16; }
typedef float f32x2_t_ __attribute__((ext_vector_type(2))); typedef __bf16 bf16x2_t_ __attribute__((ext_vector_type(2)));
__device__ __forceinline__ unsigned pk2(float lo, float hi) { const f32x2_t_ v = {lo, hi}; const bf16x2_t_ b = __builtin_convertvector(v, bf16x2_t_); return __builtin_bit_cast(unsigned, b); }
__device__ __forceinline__ float bf2f(unsigned short b) { return __builtin_bit_cast(float, (unsigned)b << 16); }
__device__ __forceinline__ bf16x8 pack8(float a0, float a1, float a2, float a3, float a4, float a5, float a6, float a7) {
    v4u w; w.x = pk2(a0, a1); w.y = pk2(a2, a3); w.z = pk2(a4, a5); w.w = pk2(a6, a7); return __builtin_bit_cast(bf16x8, w); }
__device__ __forceinline__ float wave_sum(float v) {
#pragma unroll
    for (int o = 1; o < 64; o <<= 1) v += __shfl_xor(v, o);
    return v;
}
template <int CTRL, int RMASK> __device__ __forceinline__ float dpp_add(float v) {
    const int t = __builtin_amdgcn_update_dpp(0, __builtin_bit_cast(int, v), CTRL, RMASK, 0xf, false);
    return v + __builtin_bit_cast(float, t);
}
__device__ __forceinline__ float dpp_sum(float v) {
    v = dpp_add<0x111, 0xf>(v); v = dpp_add<0x112, 0xf>(v); v = dpp_add<0x114, 0xf>(v); v = dpp_add<0x118, 0xf>(v);
    v = dpp_add<0x142, 0xa>(v); v = dpp_add<0x143, 0xc>(v);
    return __builtin_bit_cast(float, __builtin_amdgcn_readlane(__builtin_bit_cast(int, v), 63));
}
__device__ __forceinline__ float ex2(float x) { return __builtin_amdgcn_exp2f(x); }
__device__ __forceinline__ float sigmoidf_(float x) { return 1.f / (1.f + __expf(-x)); }
__device__ __forceinline__ float siluf_(float x) { return x / (1.f + __expf(-x)); }
__device__ __forceinline__ int crow(int r, int hi) { return (r & 3) + 8 * (r >> 2) + 4 * hi; }
__device__ __forceinline__ void rope_cs(int pos, int d, float& cs, float& sn) {
    const float invf = exp2f(-(float)d * 0.4152410118609203f);
    double rv = (double)pos * (double)invf * 0.15915494309189535; rv -= floor(rv);
    const float rf = (float)rv; sn = __builtin_amdgcn_sinf(rf); cs = __builtin_amdgcn_cosf(rf);
}

#define XB_TMO      128
#define XB_XCNT(j)  (256  + 64 * (j))
#define XB_XSUB(j)  (1280 + 64 * (j))
#define XB_XGEN(j)  (2304 + 64 * (j))
#define XB_TOP      3328
#define XB_TOPGEN   3392
#define XCD_BAR_WORDS 3456
#define XB_SPIN_CAP (1u << 18)

__device__ __forceinline__ unsigned xb_ld(unsigned* p)              { return __hip_atomic_load(p, __ATOMIC_RELAXED, __HIP_MEMORY_SCOPE_AGENT); }
__device__ __forceinline__ unsigned xb_add(unsigned* p, unsigned v) { return __hip_atomic_fetch_add(p, v, __ATOMIC_RELAXED, __HIP_MEMORY_SCOPE_AGENT); }
__device__ __forceinline__ unsigned xb_xcc_id() { return (unsigned)__builtin_amdgcn_s_getreg((3 << 11) | 20) & 0xFu; }
#define XB_SPIN(cond, bar) do { unsigned _sp = 0; while (cond) { __builtin_amdgcn_s_sleep(1); \
    if ((++_sp & 255u) == 0u) { if (xb_ld(&(bar)[XB_TMO])) break; if (_sp > XB_SPIN_CAP) { atomicAdd(&(bar)[XB_TMO], 1u); break; } } } } while (0)

struct XcdBarrier {
    unsigned* bar; unsigned x;
    volatile LAS unsigned* st;
};

__device__ __forceinline__ XcdBarrier xcd_barrier_post(unsigned* bar, volatile LAS unsigned* st, bool leader) {
    XcdBarrier b; b.bar = bar; b.x = xb_xcc_id(); b.st = st;
    if (leader) (void)xb_add(&bar[XB_XCNT(b.x)], 1u);
    return b;
}
__device__ __forceinline__ void xcd_barrier_complete(unsigned* bar, unsigned x, unsigned& nloc, unsigned& nx) {
    const unsigned G = gridDim.x * gridDim.y * gridDim.z;
    unsigned sum, cnt, mine, sp = 0u;
    for (;;) {
        sum = 0u; cnt = 0u; mine = 0u;
#pragma unroll
        for (unsigned j = 0; j < 16; ++j) { const unsigned c = xb_ld(&bar[XB_XCNT(j)]); sum += c; cnt += (c > 0u) ? 1u : 0u; mine = (j == x) ? c : mine; }
        if (sum == G) break;
        __builtin_amdgcn_s_sleep(1);
        if ((++sp & 255u) == 0u) { if (xb_ld(&bar[XB_TMO])) break; if (sp > XB_SPIN_CAP) { atomicAdd(&bar[XB_TMO], 1u); break; } }
    }
    nloc = mine > 0u ? mine : 1u; nx = cnt > 0u ? cnt : 1u;
}

__device__ __forceinline__ void xcd_barrier(const XcdBarrier& b, bool leader) {
    asm volatile("s_waitcnt vmcnt(0)" ::: "memory");
    __syncthreads();
    if (leader) {
        unsigned* bar = b.bar;
        __builtin_amdgcn_s_waitcnt(0);
        unsigned nloc = b.st[0], nx = b.st[1];
        if (nloc == 0u) { xcd_barrier_complete(bar, b.x, nloc, nx); b.st[0] = nloc; b.st[1] = nx; }
        const unsigned old = xb_add(&bar[XB_XSUB(b.x)], 1u);
        const unsigned gen = old / nloc;
        if (old + 1u == (gen + 1u) * nloc) {
            __builtin_amdgcn_fence(__ATOMIC_RELEASE, "agent");
            asm volatile("s_waitcnt vmcnt(0)" ::: "memory");
            const unsigned og = xb_add(&bar[XB_TOP], 1u);
            const unsigned tg = og / nx;
            if (og + 1u == (tg + 1u) * nx) xb_add(&bar[XB_TOPGEN], 1u);
            else XB_SPIN(xb_ld(&bar[XB_TOPGEN]) == tg, bar);
            __builtin_amdgcn_fence(__ATOMIC_ACQUIRE, "agent");
            xb_add(&bar[XB_XGEN(b.x)], 1u);
            asm volatile("s_waitcnt vmcnt(0)" ::: "memory");
        } else {
            XB_SPIN(xb_ld(&bar[XB_XGEN(b.x)]) == gen, bar);
            __builtin_amdgcn_fence(__ATOMIC_ACQUIRE, "agent");
            asm volatile("s_waitcnt vmcnt(0)" ::: "memory");
        }
    }
    __syncthreads();
}

__device__ __forceinline__ void transpose_item(const float* W, int K, int N, int Npad, bf16* WT, LAS float* scr, int item, int lane) {
    const int nblk = Npad / 32, kb = item / nblk, nb = item % nblk, k0 = 64 * kb, n0 = 32 * nb;
    const int ncol = n0 + (lane & 31);
#pragma unroll 8
    for (int i = 0; i < 32; ++i) { const int kk = 2 * i + (lane >> 5); scr[kk * 33 + (lane & 31)] = (ncol < N) ? W[(size_t)(k0 + kk) * N + ncol] : 0.f; }
    LDS_WAIT(); asm volatile("" ::: "memory");
    const int c = lane & 7;
#pragma unroll
    for (int j = 0; j < 4; ++j) { const int n = (lane >> 3) + 8 * j; const LAS float* s = scr + (8 * c) * 33 + n;
        v4u o; o.x = pk2(s[0 * 33], s[1 * 33]); o.y = pk2(s[2 * 33], s[3 * 33]); o.z = pk2(s[4 * 33], s[5 * 33]); o.w = pk2(s[6 * 33], s[7 * 33]);
        *(v4u*)(WT + (size_t)(n0 + n) * K + k0 + 8 * c) = o; }
    LDS_WAIT(); asm volatile("" ::: "memory");
}
__device__ __forceinline__ void rms_row(const float* xrow, const float* g, bf16* orow, float* of32, int lane) {
    const f32x4* xr = (const f32x4*)xrow + lane;
    f32x4 v[4]; float s = 0.f;
#pragma unroll
    for (int j = 0; j < 4; ++j) { v[j] = xr[64 * j]; s += (v[j].x * v[j].x + v[j].y * v[j].y) + (v[j].z * v[j].z + v[j].w * v[j].w); }
    const float rstd = 1.f / sqrtf(wave_sum(s) * (1.f / DM) + 1e-6f);
#pragma unroll
    for (int j = 0; j < 4; ++j) { const f32x4 gg = ((const f32x4*)g)[64 * j + lane]; const f32x4 o = v[j] * rstd * gg;
        if (of32) ((f32x4*)of32)[64 * j + lane] = o;
        else ((v2u*)orow)[64 * j + lane] = (v2u){pk2(o.x, o.y), pk2(o.z, o.w)}; }
}

__device__ __forceinline__ void rms_row2(const float* xa, const float* xb, const float* g, bf16* oa, bf16* ob, float* fa, float* fb, int lane) {
    f32x4 va[4], vb[4];
#pragma unroll
    for (int j = 0; j < 4; ++j) { va[j] = ((const f32x4*)xa)[64 * j + lane]; vb[j] = ((const f32x4*)xb)[64 * j + lane]; }
    __builtin_amdgcn_sched_barrier(0);
    float sa = 0.f, sb = 0.f;
#pragma unroll
    for (int j = 0; j < 4; ++j) { sa += (va[j].x * va[j].x + va[j].y * va[j].y) + (va[j].z * va[j].z + va[j].w * va[j].w); sb += (vb[j].x * vb[j].x + vb[j].y * vb[j].y) + (vb[j].z * vb[j].z + vb[j].w * vb[j].w); }
    const float ra = 1.f / sqrtf(wave_sum(sa) * (1.f / DM) + 1e-6f), rb = 1.f / sqrtf(wave_sum(sb) * (1.f / DM) + 1e-6f);
#pragma unroll
    for (int j = 0; j < 4; ++j) { const f32x4 gg = ((const f32x4*)g)[64 * j + lane]; const f32x4 o1 = va[j] * ra * gg, o2 = vb[j] * rb * gg;
        if (fa) { ((f32x4*)fa)[64 * j + lane] = o1; ((f32x4*)fb)[64 * j + lane] = o2; }
        else { ((v2u*)oa)[64 * j + lane] = (v2u){pk2(o1.x, o1.y), pk2(o1.z, o1.w)}; ((v2u*)ob)[64 * j + lane] = (v2u){pk2(o2.x, o2.y), pk2(o2.z, o2.w)}; } }
}
__device__ __forceinline__ void rms_row_parts(const float* base, const float* parts, int nparts, size_t part_stride, float* xout, const float* g, bf16* orow, float* of32, int lane) {
    f32x4 v[4]; float s = 0.f;
#pragma unroll
    for (int j = 0; j < 4; ++j) v[j] = ((const f32x4*)base)[64 * j + lane];
    for (int p = 0; p < nparts; ++p) { const f32x4* pr = (const f32x4*)(parts + (size_t)p * part_stride) + lane;
#pragma unroll
        for (int j = 0; j < 4; ++j) v[j] += pr[64 * j]; }
#pragma unroll
    for (int j = 0; j < 4; ++j) { if (xout) ((f32x4*)xout)[64 * j + lane] = v[j]; s += (v[j].x * v[j].x + v[j].y * v[j].y) + (v[j].z * v[j].z + v[j].w * v[j].w); }
    const float rstd = 1.f / sqrtf(wave_sum(s) * (1.f / DM) + 1e-6f);
#pragma unroll
    for (int j = 0; j < 4; ++j) { const f32x4 gg = ((const f32x4*)g)[64 * j + lane]; const f32x4 o = v[j] * rstd * gg;
        if (of32) ((f32x4*)of32)[64 * j + lane] = o;
        else ((v2u*)orow)[64 * j + lane] = (v2u){pk2(o.x, o.y), pk2(o.z, o.w)}; }
}

struct PBArgs { const float* PROJ; const float* state_conv; const float* conv_w; const float* a_log; const float* dt_bias;
    float* QN; float* KN; float* VG; float* G; float* BETA; float* KQ; bf16* QB; bf16* KS; bf16* VS; bf16* KW; bf16* VW; float* out; int l; };
struct PBRegs { float qs_[8], qo_[8], kvs_[12], kvo_[12]; };
__device__ __forceinline__ void pb_row_load(const PBArgs& A, int m, int lane, PBRegs& R) {
    const float* pr = A.PROJ + (size_t)m * NP;
#pragma unroll
    for (int h = 0; h < 8; ++h) { R.qs_[h] = pr[C_Q + h * 64 + lane]; R.qo_[h] = pr[C_Q + h * 64 + (lane ^ 32)]; }
#pragma unroll
    for (int i = 0; i < 12; ++i) { R.kvs_[i] = pr[C_KV + i * 64 + lane]; R.kvo_[i] = pr[C_KV + i * 64 + (lane ^ 32)]; }
}
__device__ __forceinline__ void pb_row(const PBArgs& A, int m, int lane, const PBRegs& R) {
    const bool is_s = m >= MP; int b, t;
    if (!is_s) { b = m >> 12; t = m & 4095; } else { b = (m - MP) >> 2; t = (m - MP) & 3; }
    const int pos = is_s ? PAST + t : t, l = A.l;
    const float* pr = A.PROJ + (size_t)m * NP;
    const float* cw = A.conv_w + (size_t)l * 4 * 1536;
    const float* cb = A.state_conv + ((size_t)l * NSB + b) * 3 * 1536;
    if (!is_s && t >= SEQ - 3) { float* o = A.out + O_CONVP + ((size_t)(l * NPB + b) * 3 + (t - (SEQ - 3))) * 1536;
#pragma unroll 4
        for (int j = 0; j < 24; ++j) o[64 * j + lane] = pr[64 * j + lane]; }
    if (is_s && t >= 1) { float* o = A.out + O_CONVS + ((size_t)(l * NSB + b) * 3 + (t - 1)) * 1536;
#pragma unroll 4
        for (int j = 0; j < 24; ++j) o[64 * j + lane] = pr[64 * j + lane]; }
    const int half = lane >> 5; float cs, sn; rope_cs(pos, lane & 31, cs, sn);
    const float (&qs_)[8] = R.qs_; const float (&qo_)[8] = R.qo_; const float (&kvs_)[12] = R.kvs_; const float (&kvo_)[12] = R.kvo_;
#pragma unroll
    for (int h = 0; h < 8; ++h) { const float xs = qs_[h], xo = qo_[h];
        const float r = half ? (xs * cs + xo * sn) : (xs * cs - xo * sn);
        A.QB[(size_t)m * 512 + h * 64 + lane] = (bf16)f2bf(r * C2); }
#pragma unroll
    for (int s6 = 0; s6 < 6; ++s6)
#pragma unroll
        for (int kvh = 0; kvh < 2; ++kvh) {
            float v = kvs_[s6 * 2 + kvh];
            if (s6 == 2 || s6 == 4) { const float xo = kvo_[s6 * 2 + kvh]; v = half ? (v * cs + xo * sn) : (v * cs - xo * sn); }
            if (s6 < 4) {
                if (!is_s) A.out[O_KVP + ((((size_t)(l * NPB + b) * 2 + kvh) * SEQ + t) * 4 + s6) * 64 + lane] = v;
                else       A.out[O_KVS + ((((size_t)(l * NSB + b) * 2 + kvh) * DSEQ + t) * 4 + s6) * 64 + lane] = v;
            } else {
                const int idx = s6 - 4;
                if (!is_s) { if (t >= SEQ - 512) A.out[O_WINP + ((((size_t)(l * NPB + b) * 512 + (t - (SEQ - 512))) * 2 + idx) * 2 + kvh) * 64 + lane] = v; }
                else A.out[O_WINS + ((((size_t)(l * NSB + b) * 512 + (508 + t)) * 2 + idx) * 2 + kvh) * 64 + lane] = v;
            }
            const bf16 bv = (bf16)f2bf(v);
            if (s6 == 2) A.KS[(size_t)m * 128 + kvh * 64 + lane] = bv;
            if (s6 == 3) A.VS[(size_t)m * 128 + kvh * 64 + lane] = bv;
            if (s6 == 4) A.KW[(size_t)m * 128 + kvh * 64 + lane] = bv;
            if (s6 == 5) A.VW[(size_t)m * 128 + kvh * 64 + lane] = bv;
        }
}

__device__ __forceinline__ void pb_sample_head(const PBArgs& A, int u, int lane) {
    const int m = MP + (u >> 3), h = u & 7, b = (m - MP) >> 2, t = (m - MP) & 3, l = A.l;
    const float* pr = A.PROJ + (size_t)m * NP;
    const float* cw = A.conv_w + (size_t)l * 4 * 1536;
    const float* cb = A.state_conv + ((size_t)l * NSB + b) * 3 * 1536;
    float xv[3][4], wv[3][4];
#pragma unroll
    for (int part = 0; part < 3; ++part) { const int c = (part * 8 + h) * 64 + lane;
#pragma unroll
        for (int tap = 0; tap < 4; ++tap) { const int idx = t + tap;
            xv[part][tap] = (idx >= 3) ? A.PROJ[(size_t)(m - t + idx - 3) * NP + c] : cb[idx * 1536 + c];
            wv[part][tap] = cw[tap * 1536 + c]; } }
    __builtin_amdgcn_sched_barrier(0);
    float qkv[3];
#pragma unroll
    for (int part = 0; part < 3; ++part) qkv[part] = siluf_((xv[part][0] * wv[part][0] + xv[part][1] * wv[part][1]) + (xv[part][2] * wv[part][2] + xv[part][3] * wv[part][3]));
    const float q = qkv[0], k = qkv[1];
    const float qs = dpp_sum(q * q), ks = dpp_sum(k * k);
    const float qn = q * (1.f / sqrtf(qs + 1e-6f)) * 0.125f, kn = k * (1.f / sqrtf(ks + 1e-6f));
    const float kq = dpp_sum(qn * kn);
    A.QN[(size_t)m * 512 + h * 64 + lane] = qn; A.KN[(size_t)m * 512 + h * 64 + lane] = kn; A.VG[(size_t)m * 512 + h * 64 + lane] = qkv[2];
    if (lane == 0) A.KQ[(size_t)m * 8 + h] = kq;
    if (h == 0 && lane < 8) {
        const float a = pr[C_A + lane] + A.dt_bias[l * 8 + lane];
        const float sp = fmaxf(a, 0.f) + log1pf(__expf(-fabsf(a)));
        A.G[(size_t)m * 8 + lane] = -__expf(A.a_log[l * 8 + lane]) * sp;
        A.BETA[(size_t)m * 8 + lane] = sigmoidf_(pr[C_BETA + lane]); }
}

struct CmpArgs { const float* PROJ; const float* cache; const int* page_table; const float* pe_k; const float* pe_v; const bf16* CMPW; unsigned char* ws; int l; };
__device__ __forceinline__ void compress_batch(const CmpArgs& A, unsigned char* lds, int batch, bool is_s, int tid) {
    const int lane = tid & 63, wave = __builtin_amdgcn_readfirstlane(tid >> 6), fr = lane & 15, fq = lane >> 4, l = A.l;
    const int kv = batch & 1, ru = (batch >> 1) * 8 + wave;
    const int rho = 16 * ru + fr, NC = is_s ? 64 : 128;
    const int seq = rho / (2 * NC), n = (rho >> 1) % NC, kvh = rho & 1;
    const float* abase; size_t astride;
    if (!is_s) { abase = A.PROJ + (size_t)(seq * SEQ + 32 * n) * NP + C_KV + kv * 128 + kvh * 64; astride = NP; }
    else { const int page = A.page_table[seq * NPAGES + (n >> 2)];
        abase = A.cache + ((((size_t)l * NPOOL + page) * 2 + kvh) * 128 + (n & 3) * 32) * 256 + kv * 64; astride = 256; }
    const float* pe = (kv ? A.pe_v : A.pe_k) + (size_t)l * 2048;
    const bf16* Wt = A.CMPW + (size_t)((l * 2 + kv) * 64) * 2048;
    const int we = tid >> 3, wch = tid & 7;
    f32x4 acc[4];
#pragma unroll
    for (int et = 0; et < 4; ++et) acc[et] = (f32x4){0.f, 0.f, 0.f, 0.f};
    f32x4 sa[2][4], sp[2][4]; v4u wreg;
#define CB_LOADA(S, c) do { _Pragma("unroll") for (int ks = 0; ks < 2; ++ks) { const float* ap = abase + (size_t)(c) * astride + 32 * ks + 8 * fq; const float* pp = pe + (c) * 64 + 32 * ks + 8 * fq; \
        sa[S][2 * ks] = *(const f32x4*)ap; sa[S][2 * ks + 1] = *(const f32x4*)(ap + 4); sp[S][2 * ks] = *(const f32x4*)pp; sp[S][2 * ks + 1] = *(const f32x4*)(pp + 4); } } while (0)
#define CB_LOADW(c) do { wreg = *(const v4u*)(Wt + (size_t)we * 2048 + ((c) < 31 ? (c) : 31) * 64 + wch * 8); } while (0)
#define CB_STOREW(bufi) do { *(v4u*)(lds + (bufi) * 9216 + we * 144 + wch * 16) = wreg; } while (0)
#define CB_MMA(S, bufi) do { _Pragma("unroll") for (int ks = 0; ks < 2; ++ks) { const f32x4 a0 = sa[S][2 * ks] + sp[S][2 * ks], a1 = sa[S][2 * ks + 1] + sp[S][2 * ks + 1]; \
        const bf16x8 ya = pack8(a0.x, a0.y, a0.z, a0.w, a1.x, a1.y, a1.z, a1.w); \
        _Pragma("unroll") for (int et = 0; et < 4; ++et) { const bf16x8 wf_ = *(const bf16x8*)(lds + (bufi) * 9216 + (16 * et + fr) * 144 + (32 * ks + 8 * fq) * 2); \
            acc[et] = __builtin_amdgcn_mfma_f32_16x16x32_bf16(wf_, ya, acc[et], 0, 0, 0); } } } while (0)
    __syncthreads();
    CB_LOADW(0); CB_LOADA(0, 0);
    CB_STOREW(0); CB_LOADW(1);
    __syncthreads();
#pragma unroll 1
    for (int c = 0; c < 32; c += 2) {
        CB_STOREW(1); __builtin_amdgcn_sched_barrier(0); CB_LOADW(c + 2); CB_LOADA(1, c + 1); __builtin_amdgcn_sched_barrier(0);
        CB_MMA(0, 0); __builtin_amdgcn_sched_barrier(0);
        __syncthreads();
        CB_STOREW(0); __builtin_amdgcn_sched_barrier(0); CB_LOADW(c + 3); if (c + 2 < 32) { CB_LOADA(0, c + 2); } __builtin_amdgcn_sched_barrier(0);
        CB_MMA(1, 1); __builtin_amdgcn_sched_barrier(0);
        __syncthreads();
    }
#undef CB_LOADA
#undef CB_LOADW
#undef CB_STOREW
#undef CB_MMA
    if (kv == 0) { const int pos = 32 * n + 31;
#pragma unroll
        for (int et = 0; et < 2; ++et)
#pragma unroll
            for (int i = 0; i < 4; ++i) { float cs, sn; rope_cs(pos, 16 * et + 4 * fq + i, cs, sn);
                const float x1 = acc[et][i], x2 = acc[et + 2][i]; acc[et][i] = x1 * cs - x2 * sn; acc[et + 2][i] = x2 * cs + x1 * sn; } }
    float* ob = (float*)(A.ws + (is_s ? WS_CKS : WS_CKP) + (size_t)kv * (is_s ? (WS_CVS - WS_CKS) : (WS_CVP - WS_CKP))) + (size_t)rho * 64 + 4 * fq;
#pragma unroll
    for (int et = 0; et < 4; ++et) *(f32x4*)(ob + 16 * et) = acc[et];
}

struct GdnArgs { const float* QN; const float* KN; const float* VG; const float* G; const float* BETA; const float* KQ; float* OG; const float* PROJ; const float* state_gdn; const float* gdn_norm; bf16* MIX; float* out; int l; };
__device__ __forceinline__ void gdn_sample_unit(const GdnArgs& A, int unit, int lane) {
    const int sb = unit >> 3, h = unit & 7, l = A.l;
    const float* sp = A.state_gdn + (((size_t)l * NSB + sb) * 8 + h) * 4096;
    float S[64];
#pragma unroll
    for (int d = 0; d < 64; ++d) S[d] = sp[d * 64 + lane];
    const float gn = A.gdn_norm[l * 64 + lane];
    for (int i = 0; i < DSEQ; ++i) {
        const size_t m = (size_t)MP + sb * 4 + i;
        const float kd = A.KN[m * 512 + h * 64 + lane], qd = A.QN[m * 512 + h * 64 + lane], v = A.VG[m * 512 + h * 64 + lane];
        const float g = A.G[m * 8 + h], beta = A.BETA[m * 8 + h], kq = A.KQ[m * 8 + h];
        const int kdb = __builtin_bit_cast(int, kd), qdb = __builtin_bit_cast(int, qd);
        const float a = __expf(g); float r1 = 0.f, r2 = 0.f;
#pragma unroll
        for (int d = 0; d < 64; ++d) { const float kk = __builtin_bit_cast(float, __builtin_amdgcn_readlane(kdb, d)), qq = __builtin_bit_cast(float, __builtin_amdgcn_readlane(qdb, d)); r1 += S[d] * kk; r2 += S[d] * qq; }
        const float u = beta * (v - a * r1), o = a * r2 + u * kq;
#pragma unroll
        for (int d = 0; d < 64; ++d) { const float kk = __builtin_bit_cast(float, __builtin_amdgcn_readlane(kdb, d)); S[d] = a * S[d] + kk * u; }
        const float ms = wave_sum(o * o) * (1.f / 64.f);
        const float z = A.PROJ[m * NP + C_Z + h * 64 + lane];
        A.MIX[m * 1024 + h * 64 + lane] = (bf16)f2bf(o * (1.f / sqrtf(ms + 1e-6f)) * gn * siluf_(z));
    }
    float* so = A.out + O_GDNS + (((size_t)l * NSB + sb) * 8 + h) * 4096;
#pragma unroll
    for (int d = 0; d < 64; ++d) so[d * 64 + lane] = S[d];
}


__device__ __forceinline__ int perm_inv32(int p) { return (p & 32) + 16 * ((p >> 2) & 1) + 4 * ((p >> 3) & 3) + (p & 3); }
struct GPArgs { const float* PROJ; const float* conv_w; const float* a_log; const float* dt_bias; bf16* GK; bf16* GQ; bf16* GKT; bf16* GVT; float* GG2; float* BETA2; int l; };
struct GPRegs { float xx[3][11], ww[3][4]; };
__device__ __forceinline__ void gdn_prep_load(const GPArgs& A, int unit, int lane, GPRegs& R) {
    const int tg = unit >> 3, h = unit & 7, m0 = tg * 8, t0 = m0 & 4095;
    const float* cw = A.conv_w + (size_t)A.l * 4 * 1536;
#pragma unroll
    for (int part = 0; part < 3; ++part) { const int c = (part * 8 + h) * 64 + lane;
#pragma unroll
        for (int j = 0; j < 11; ++j) R.xx[part][j] = (t0 - 3 + j >= 0) ? A.PROJ[(size_t)(m0 - 3 + j) * NP + c] : 0.f;
#pragma unroll
        for (int k = 0; k < 4; ++k) R.ww[part][k] = cw[k * 1536 + c]; }
}
__device__ __forceinline__ void gdn_prep_unit(const GPArgs& A, int unit, int lane, const GPRegs& R) {
    const int tg = unit >> 3, h = unit & 7, m0 = tg * 8, b = m0 >> 12, t0 = m0 & 4095, l = A.l, bh = b * 8 + h;
    const float* cw = A.conv_w + (size_t)l * 4 * 1536;
    float val[3][8]; const float (&xx)[3][11] = R.xx; const float (&ww)[3][4] = R.ww;
#pragma unroll
    for (int part = 0; part < 3; ++part)
#pragma unroll
        for (int i = 0; i < 8; ++i) val[part][i] = siluf_(ww[part][0] * xx[part][i] + ww[part][1] * xx[part][i + 1] + ww[part][2] * xx[part][i + 2] + ww[part][3] * xx[part][i + 3]);
#pragma unroll
    for (int i = 0; i < 8; ++i) { const float q = val[0][i], k = val[1][i];
        const float qs = dpp_sum(q * q), ks = dpp_sum(k * k);
        val[0][i] = q * (1.f / sqrtf(qs + 1e-6f)) * 0.125f; val[1][i] = k * (1.f / sqrtf(ks + 1e-6f)); }
#pragma unroll
    for (int i = 0; i < 8; ++i) { A.GQ[((size_t)bh * 4096 + t0 + i) * 64 + lane] = (bf16)f2bf(val[0][i]); A.GK[((size_t)bh * 4096 + t0 + i) * 64 + lane] = (bf16)f2bf(val[1][i]); }
    *(v4u*)(A.GKT + ((size_t)bh * 64 + lane) * 4096 + t0) = (v4u){pk2(val[1][0], val[1][1]), pk2(val[1][2], val[1][3]), pk2(val[1][4], val[1][5]), pk2(val[1][6], val[1][7])};
    *(v4u*)(A.GVT + ((size_t)bh * 64 + lane) * 4096 + t0) = (v4u){pk2(val[2][0], val[2][1]), pk2(val[2][2], val[2][3]), pk2(val[2][4], val[2][5]), pk2(val[2][6], val[2][7])};
    if (lane < 8) { const float* pr = A.PROJ + (size_t)(m0 + lane) * NP;
        const float a = pr[C_A + h] + A.dt_bias[l * 8 + h];
        const float sp = fmaxf(a, 0.f) + log1pf(__expf(-fabsf(a)));
        A.GG2[(size_t)bh * 4096 + t0 + lane] = -__expf(A.a_log[l * 8 + h]) * sp;
        A.BETA2[(size_t)bh * 4096 + t0 + lane] = sigmoidf_(pr[C_BETA + h]); }
}
template <int I> __device__ __forceinline__ void fsub_row(float (&T)[64], const float* AL, int lane) {
    float tv = (lane == I) ? 1.f : 0.f;
#pragma unroll
    for (int j4 = 0; j4 < (I + 3) / 4; ++j4) { const f32x4 a = *(const f32x4*)(AL + I * 64 + 4 * j4);
#pragma unroll
        for (int e = 0; e < 4; ++e) if (4 * j4 + e < I) tv -= a[e] * T[4 * j4 + e]; }
    T[I] = tv;
}
template <int I> struct FSub { static __device__ __forceinline__ void run(float (&T)[64], const float* AL, int lane) { FSub<I - 1>::run(T, AL, lane); fsub_row<I>(T, AL, lane); } };
template <> struct FSub<-1> { static __device__ __forceinline__ void run(float (&)[64], const float*, int) {} };
struct GCArgs { const bf16* GK; const bf16* GQ; const bf16* GKT; const bf16* GVT; const float* GG2; const float* BETA2; bf16* WX; bf16* QX; bf16* QKX; bf16* KTX; float* U0F; float* GL; };
constexpr int GC_LDS_PER_WAVE = 17664;
__device__ __forceinline__ void gdn_chunk_unit(const GCArgs& A, unsigned char* wl, int unit, int lane_) {
    int lane = lane_; asm volatile("" : "+v"(lane));
    const int bh = unit >> 6, n = unit & 63, t0 = 64 * n, fr = lane & 15, fq = lane >> 4;
    float* AL = (float*)wl; float* SC = (float*)(wl + 16384);
    {   const float g = A.GG2[(size_t)bh * 4096 + t0 + lane], beta = A.BETA2[(size_t)bh * 4096 + t0 + lane];
        float gc = g;
        gc = dpp_add<0x111, 0xf>(gc); gc = dpp_add<0x112, 0xf>(gc); gc = dpp_add<0x114, 0xf>(gc); gc = dpp_add<0x118, 0xf>(gc); gc = dpp_add<0x142, 0xa>(gc); gc = dpp_add<0x143, 0xc>(gc);
        const float glast = __builtin_bit_cast(float, __builtin_amdgcn_readlane(__builtin_bit_cast(int, gc), 63));
        const float eg = __expf(gc);
        SC[lane] = gc; SC[64 + lane] = beta; SC[128 + lane] = beta * eg; SC[192 + lane] = eg; SC[256 + lane] = __expf(glast - gc);
        if (lane == 0) A.GL[unit] = __expf(glast); }
    LDS_WAIT(); asm volatile("" ::: "memory");
    {
        bf16x8 kf[4][2];
#pragma unroll
        for (int t4 = 0; t4 < 4; ++t4)
#pragma unroll
            for (int ks = 0; ks < 2; ++ks) kf[t4][ks] = *(const bf16x8*)(A.GK + ((size_t)bh * 4096 + t0 + 16 * t4 + fr) * 64 + 32 * ks + 8 * fq);
        __builtin_amdgcn_sched_barrier(0);
#pragma unroll
        for (int ti = 0; ti < 4; ++ti) { const f32x4 gi = *(const f32x4*)(SC + 16 * ti + 4 * fq), bi = *(const f32x4*)(SC + 64 + 16 * ti + 4 * fq);
#pragma unroll
            for (int tj = 0; tj < 4; ++tj) if (tj <= ti) { f32x4 acc = {0.f, 0.f, 0.f, 0.f};
                acc = __builtin_amdgcn_mfma_f32_16x16x32_bf16(kf[ti][0], kf[tj][0], acc, 0, 0, 0); acc = __builtin_amdgcn_mfma_f32_16x16x32_bf16(kf[ti][1], kf[tj][1], acc, 0, 0, 0);
                const float gj = SC[16 * tj + fr];
#pragma unroll
                for (int i = 0; i < 4; ++i) AL[(16 * ti + 4 * fq + i) * 64 + 16 * tj + fr] = bi[i] * acc[i] * __expf(fminf(gi[i] - gj, 0.f)); } }
    }
    LDS_WAIT(); asm volatile("" ::: "memory");
    {
        float T[64];
        FSub<63>::run(T, AL, lane);
        LDS_WAIT(); asm volatile("" ::: "memory");
        unsigned short* TB = (unsigned short*)wl;
#pragma unroll
        for (int i = 0; i < 64; ++i) TB[i * 72 + lane] = (unsigned short)f2bf(T[i]);
    }
    LDS_WAIT(); asm volatile("" ::: "memory");
    {
        bf16x8 tf[4][2];
#pragma unroll
        for (int ti = 0; ti < 4; ++ti)
#pragma unroll
            for (int ks = 0; ks < 2; ++ks) tf[ti][ks] = *(const bf16x8*)(wl + ((16 * ti + fr) * 72 + 32 * ks + 8 * fq) * 2);
#pragma unroll
        for (int which = 0; which < 2; ++which) { const bf16* src = which ? A.GVT : A.GKT; const float* sc = SC + (which ? 64 : 128);
            bf16x8 raws[4][2];
#pragma unroll
            for (int tn = 0; tn < 4; ++tn)
#pragma unroll
                for (int ks = 0; ks < 2; ++ks) raws[tn][ks] = *(const bf16x8*)(src + ((size_t)bh * 64 + 16 * tn + fr) * 4096 + t0 + 32 * ks + 8 * fq);
            __builtin_amdgcn_sched_barrier(0);
#pragma unroll
            for (int tn = 0; tn < 4; ++tn) { bf16x8 yb[2];
#pragma unroll
                for (int ks = 0; ks < 2; ++ks) { const bf16x8 raw = raws[tn][ks];
                    const f32x4 s0 = *(const f32x4*)(sc + 32 * ks + 8 * fq), s1 = *(const f32x4*)(sc + 32 * ks + 8 * fq + 4);
                    yb[ks] = pack8(bf2f((unsigned short)raw[0]) * s0.x, bf2f((unsigned short)raw[1]) * s0.y, bf2f((unsigned short)raw[2]) * s0.z, bf2f((unsigned short)raw[3]) * s0.w,
                                   bf2f((unsigned short)raw[4]) * s1.x, bf2f((unsigned short)raw[5]) * s1.y, bf2f((unsigned short)raw[6]) * s1.z, bf2f((unsigned short)raw[7]) * s1.w); }
#pragma unroll
                for (int ti = 0; ti < 4; ++ti) { f32x4 acc = {0.f, 0.f, 0.f, 0.f};
                    acc = __builtin_amdgcn_mfma_f32_16x16x32_bf16(tf[ti][0], yb[0], acc, 0, 0, 0);
                    if (ti >= 2) acc = __builtin_amdgcn_mfma_f32_16x16x32_bf16(tf[ti][1], yb[1], acc, 0, 0, 0);
                    if (which == 0) { const int p = 32 * (tn >> 1) + 8 * (fr >> 2) + 4 * (tn & 1) + (fr & 3);
#pragma unroll
                        for (int i = 0; i < 4; ++i) A.WX[((size_t)unit * 64 + 16 * ti + 4 * fq + i) * 64 + p] = (bf16)f2bf(acc[i]); }
                    else *(f32x4*)(A.U0F + (((size_t)unit * 16 + ti * 4 + tn) * 64 + lane) * 4) = acc; } } }
    }
    {
        bf16x8 kf[4][2], qf[4][2];
#pragma unroll
        for (int t4 = 0; t4 < 4; ++t4)
#pragma unroll
            for (int ks = 0; ks < 2; ++ks) { kf[t4][ks] = *(const bf16x8*)(A.GK + ((size_t)bh * 4096 + t0 + 16 * t4 + fr) * 64 + 32 * ks + 8 * fq);
                qf[t4][ks] = *(const bf16x8*)(A.GQ + ((size_t)bh * 4096 + t0 + 16 * t4 + fr) * 64 + 32 * ks + 8 * fq); }
        __builtin_amdgcn_sched_barrier(0);
#pragma unroll
        for (int ti = 0; ti < 4; ++ti) { const f32x4 gi = *(const f32x4*)(SC + 16 * ti + 4 * fq);
#pragma unroll
            for (int tj = 0; tj < 4; ++tj) { f32x4 acc = {0.f, 0.f, 0.f, 0.f};
                if (tj <= ti) { acc = __builtin_amdgcn_mfma_f32_16x16x32_bf16(qf[ti][0], kf[tj][0], acc, 0, 0, 0); acc = __builtin_amdgcn_mfma_f32_16x16x32_bf16(qf[ti][1], kf[tj][1], acc, 0, 0, 0); }
                const float gj = SC[16 * tj + fr]; const int p = 32 * (tj >> 1) + 8 * (fr >> 2) + 4 * (tj & 1) + (fr & 3);
#pragma unroll
                for (int i = 0; i < 4; ++i) { const int ri = 16 * ti + 4 * fq + i, cj = 16 * tj + fr;
                    const float v = (tj <= ti && ri >= cj) ? acc[i] * __expf(fminf(gi[i] - gj, 0.f)) : 0.f;
                    A.QKX[((size_t)unit * 64 + ri) * 64 + p] = (bf16)f2bf(v); } } }
    }
    {
        const int lg = perm_inv32(lane);
        const float ek = SC[256 + lg];
#pragma unroll 1
        for (int r0 = 0; r0 < 64; r0 += 16) { bf16 qv[16], kv[16];
#pragma unroll
            for (int i = 0; i < 16; ++i) { qv[i] = A.GQ[((size_t)bh * 4096 + t0 + r0 + i) * 64 + lg]; kv[i] = A.GKT[((size_t)bh * 64 + r0 + i) * 4096 + t0 + lg]; }
            __builtin_amdgcn_sched_barrier(0);
#pragma unroll
            for (int i = 0; i < 16; ++i) { A.QX[((size_t)unit * 64 + r0 + i) * 64 + lane] = (bf16)f2bf(bf2f(qv[i]) * SC[192 + r0 + i]);
                A.KTX[((size_t)unit * 64 + r0 + i) * 64 + lane] = (bf16)f2bf(bf2f(kv[i]) * ek); } }
    }
    LDS_WAIT(); asm volatile("" ::: "memory");
}
struct GS2Args { const bf16* WX; const bf16* QX; const bf16* QKX; const bf16* KTX; const float* U0F; const float* GL; float* OG; float* out; int l; };
__device__ __forceinline__ void gdn_scan2_wave(const GS2Args& A, int bh, int te, int lane) {
    const int fr = lane & 15, fq = lane >> 4, b = bh >> 3, h = bh & 7;
    f32x4 s[4]; bf16x8 sfr[2];
#pragma unroll
    for (int i = 0; i < 4; ++i) s[i] = (f32x4){0.f, 0.f, 0.f, 0.f};
    sfr[0] = (bf16x8){0, 0, 0, 0, 0, 0, 0, 0}; sfr[1] = sfr[0];
    f32x4 u[4]; bf16x8 wf[4][2], kt[4][2], qx[4][2], qkx[4][2]; float dec;
#define GS_LD_UW(nn) do { const size_t un_ = (size_t)bh * 64 + (nn); _Pragma("unroll") for (int tc = 0; tc < 4; ++tc) { u[tc] = *(const f32x4*)(A.U0F + ((un_ * 16 + tc * 4 + te) * 64 + lane) * 4); \
        _Pragma("unroll") for (int ks = 0; ks < 2; ++ks) wf[tc][ks] = *(const bf16x8*)(A.WX + (un_ * 64 + 16 * tc + fr) * 64 + 32 * ks + 8 * fq); } } while (0)
#define GS_LD_Q(nn) do { const size_t un_ = (size_t)bh * 64 + (nn); _Pragma("unroll") for (int tc = 0; tc < 4; ++tc) _Pragma("unroll") for (int ks = 0; ks < 2; ++ks) { \
        qx[tc][ks] = *(const bf16x8*)(A.QX + (un_ * 64 + 16 * tc + fr) * 64 + 32 * ks + 8 * fq); qkx[tc][ks] = *(const bf16x8*)(A.QKX + (un_ * 64 + 16 * tc + fr) * 64 + 32 * ks + 8 * fq); } } while (0)
#define GS_LD_K(nn) do { const size_t un_ = (size_t)bh * 64 + (nn); dec = A.GL[un_]; _Pragma("unroll") for (int tc = 0; tc < 4; ++tc) _Pragma("unroll") for (int ks = 0; ks < 2; ++ks) \
        kt[tc][ks] = *(const bf16x8*)(A.KTX + (un_ * 64 + 16 * tc + fr) * 64 + 32 * ks + 8 * fq); } while (0)
    GS_LD_UW(0); GS_LD_Q(0); GS_LD_K(0);
    __builtin_amdgcn_sched_barrier(0);
#pragma unroll 1
    for (int n = 0; n < 64; ++n) {
        const int nn = n < 63 ? n + 1 : 63;
#pragma unroll
        for (int tc = 0; tc < 4; ++tc) { f32x4 acc = {0.f, 0.f, 0.f, 0.f};
            acc = __builtin_amdgcn_mfma_f32_16x16x32_bf16(wf[tc][0], sfr[0], acc, 0, 0, 0); acc = __builtin_amdgcn_mfma_f32_16x16x32_bf16(wf[tc][1], sfr[1], acc, 0, 0, 0);
            u[tc] -= acc; }
        bf16x8 ufr[2];
#pragma unroll
        for (int ks = 0; ks < 2; ++ks) ufr[ks] = pack8(u[2 * ks][0], u[2 * ks][1], u[2 * ks][2], u[2 * ks][3], u[2 * ks + 1][0], u[2 * ks + 1][1], u[2 * ks + 1][2], u[2 * ks + 1][3]);
        __builtin_amdgcn_sched_barrier(0);
        GS_LD_UW(nn);
        __builtin_amdgcn_sched_barrier(0);
        f32x4 oacc[4];
#pragma unroll
        for (int tc = 0; tc < 4; ++tc) {
            f32x4 acc = {0.f, 0.f, 0.f, 0.f};
            acc = __builtin_amdgcn_mfma_f32_16x16x32_bf16(qx[tc][0], sfr[0], acc, 0, 0, 0); acc = __builtin_amdgcn_mfma_f32_16x16x32_bf16(qx[tc][1], sfr[1], acc, 0, 0, 0);
            acc = __builtin_amdgcn_mfma_f32_16x16x32_bf16(qkx[tc][0], ufr[0], acc, 0, 0, 0); acc = __builtin_amdgcn_mfma_f32_16x16x32_bf16(qkx[tc][1], ufr[1], acc, 0, 0, 0);
            oacc[tc] = acc; }
#pragma unroll
        for (int td = 0; td < 4; ++td) { f32x4 acc = s[td] * dec;
            acc = __builtin_amdgcn_mfma_f32_16x16x32_bf16(kt[td][0], ufr[0], acc, 0, 0, 0); acc = __builtin_amdgcn_mfma_f32_16x16x32_bf16(kt[td][1], ufr[1], acc, 0, 0, 0);
            s[td] = acc; }
#pragma unroll
        for (int ks = 0; ks < 2; ++ks) sfr[ks] = pack8(s[2 * ks][0], s[2 * ks][1], s[2 * ks][2], s[2 * ks][3], s[2 * ks + 1][0], s[2 * ks + 1][1], s[2 * ks + 1][2], s[2 * ks + 1][3]);
        __builtin_amdgcn_sched_barrier(0);
        GS_LD_Q(nn); GS_LD_K(nn);
#pragma unroll
        for (int tc = 0; tc < 4; ++tc)
#pragma unroll
            for (int i = 0; i < 4; ++i) A.OG[((size_t)b * SEQ + 64 * n + 16 * tc + 4 * fq + i) * 512 + h * 64 + 16 * te + fr] = oacc[tc][i];
        __builtin_amdgcn_sched_barrier(0);
    }
#undef GS_LD_UW
#undef GS_LD_Q
#undef GS_LD_K
#pragma unroll
    for (int td = 0; td < 4; ++td)
#pragma unroll
        for (int i = 0; i < 4; ++i) A.out[O_GDNP + ((((size_t)A.l * NPB + b) * 8 + h) * 64 + 16 * td + 4 * fq + i) * 64 + 16 * te + fr] = s[td][i];
}

constexpr int SC_ROW = 144, SC_MAT = 64 * SC_ROW, SC_U = 4 * SC_MAT, SC_STAGE = SC_U + 16384, SC_DEC = 2 * SC_STAGE;
__device__ __forceinline__ void gdn_scan3_block(const GS2Args& A, unsigned char* lds, int bh, int tid) {
    const int lane = tid & 63, wave = __builtin_amdgcn_readfirstlane(tid >> 6), fr = lane & 15, fq = lane >> 4, b = bh >> 3, h = bh & 7, te = wave;
    const int mrow = (tid >> 3), mch = tid & 7;
    v4u ra[6], rb[6];
#define SC_LOAD(R, nn) do { const size_t un_ = (size_t)bh * 64 + ((nn) < 63 ? (nn) : 63); \
        R[0] = *(const v4u*)(A.WX + un_ * 4096 + mrow * 64 + mch * 8); R[1] = *(const v4u*)(A.KTX + un_ * 4096 + mrow * 64 + mch * 8); \
        R[2] = *(const v4u*)(A.QX + un_ * 4096 + mrow * 64 + mch * 8); R[3] = *(const v4u*)(A.QKX + un_ * 4096 + mrow * 64 + mch * 8); \
        R[4] = *(const v4u*)(A.U0F + un_ * 4096 + (size_t)tid * 4); R[5] = *(const v4u*)(A.U0F + un_ * 4096 + (size_t)(tid + 512) * 4); } while (0)
#define SC_STORE(R, st) do { unsigned char* sb_ = lds + (st) * SC_STAGE; \
        *(v4u*)(sb_ + 0 * SC_MAT + mrow * SC_ROW + mch * 16) = R[0]; *(v4u*)(sb_ + 1 * SC_MAT + mrow * SC_ROW + mch * 16) = R[1]; \
        *(v4u*)(sb_ + 2 * SC_MAT + mrow * SC_ROW + mch * 16) = R[2]; *(v4u*)(sb_ + 3 * SC_MAT + mrow * SC_ROW + mch * 16) = R[3]; \
        *(v4u*)(sb_ + SC_U + tid * 16) = R[4]; *(v4u*)(sb_ + SC_U + (tid + 512) * 16) = R[5]; } while (0)
    f32x4 s[4]; bf16x8 sfr[2];
#pragma unroll
    for (int i = 0; i < 4; ++i) s[i] = (f32x4){0.f, 0.f, 0.f, 0.f};
    sfr[0] = (bf16x8){0, 0, 0, 0, 0, 0, 0, 0}; sfr[1] = sfr[0];
    __syncthreads();
    if (tid < 64) ((float*)(lds + SC_DEC))[tid] = A.GL[(size_t)bh * 64 + tid];
    SC_LOAD(ra, 0); SC_STORE(ra, 0);
    SC_LOAD(rb, 1); SC_LOAD(ra, 2);
    __syncthreads();
#define SC_CHUNK(n, st) do { if (wave < 4) { const unsigned char* sb_ = lds + (st) * SC_STAGE; \
        f32x4 u[4]; bf16x8 ufr[2]; \
        _Pragma("unroll") for (int tc = 0; tc < 4; ++tc) { u[tc] = *(const f32x4*)(sb_ + SC_U + ((tc * 4 + te) * 64 + lane) * 16); \
            const bf16x8 w0 = *(const bf16x8*)(sb_ + (16 * tc + fr) * SC_ROW + (8 * fq) * 2), w1 = *(const bf16x8*)(sb_ + (16 * tc + fr) * SC_ROW + (32 + 8 * fq) * 2); \
            f32x4 acc = {0.f, 0.f, 0.f, 0.f}; acc = __builtin_amdgcn_mfma_f32_16x16x32_bf16(w0, sfr[0], acc, 0, 0, 0); acc = __builtin_amdgcn_mfma_f32_16x16x32_bf16(w1, sfr[1], acc, 0, 0, 0); u[tc] -= acc; } \
        _Pragma("unroll") for (int ks = 0; ks < 2; ++ks) ufr[ks] = pack8(u[2 * ks][0], u[2 * ks][1], u[2 * ks][2], u[2 * ks][3], u[2 * ks + 1][0], u[2 * ks + 1][1], u[2 * ks + 1][2], u[2 * ks + 1][3]); \
        _Pragma("unroll") for (int tc = 0; tc < 4; ++tc) { \
            const bf16x8 q0 = *(const bf16x8*)(sb_ + 2 * SC_MAT + (16 * tc + fr) * SC_ROW + (8 * fq) * 2), q1 = *(const bf16x8*)(sb_ + 2 * SC_MAT + (16 * tc + fr) * SC_ROW + (32 + 8 * fq) * 2); \
            const bf16x8 k0 = *(const bf16x8*)(sb_ + 3 * SC_MAT + (16 * tc + fr) * SC_ROW + (8 * fq) * 2), k1 = *(const bf16x8*)(sb_ + 3 * SC_MAT + (16 * tc + fr) * SC_ROW + (32 + 8 * fq) * 2); \
            f32x4 acc = {0.f, 0.f, 0.f, 0.f}; \
            acc = __builtin_amdgcn_mfma_f32_16x16x32_bf16(q0, sfr[0], acc, 0, 0, 0); acc = __builtin_amdgcn_mfma_f32_16x16x32_bf16(q1, sfr[1], acc, 0, 0, 0); \
            acc = __builtin_amdgcn_mfma_f32_16x16x32_bf16(k0, ufr[0], acc, 0, 0, 0); acc = __builtin_amdgcn_mfma_f32_16x16x32_bf16(k1, ufr[1], acc, 0, 0, 0); \
            _Pragma("unroll") for (int i = 0; i < 4; ++i) A.OG[((size_t)b * SEQ + 64 * (n) + 16 * tc + 4 * fq + i) * 512 + h * 64 + 16 * te + fr] = acc[i]; } \
        const float dec = ((const float*)(lds + SC_DEC))[(n)]; \
        _Pragma("unroll") for (int td = 0; td < 4; ++td) { \
            const bf16x8 t0 = *(const bf16x8*)(sb_ + 1 * SC_MAT + (16 * td + fr) * SC_ROW + (8 * fq) * 2), t1 = *(const bf16x8*)(sb_ + 1 * SC_MAT + (16 * td + fr) * SC_ROW + (32 + 8 * fq) * 2); \
            f32x4 acc = s[td] * dec; acc = __builtin_amdgcn_mfma_f32_16x16x32_bf16(t0, ufr[0], acc, 0, 0, 0); acc = __builtin_amdgcn_mfma_f32_16x16x32_bf16(t1, ufr[1], acc, 0, 0, 0); s[td] = acc; } \
        _Pragma("unroll") for (int ks = 0; ks < 2; ++ks) sfr[ks] = pack8(s[2 * ks][0], s[2 * ks][1], s[2 * ks][2], s[2 * ks][3], s[2 * ks + 1][0], s[2 * ks + 1][1], s[2 * ks + 1][2], s[2 * ks + 1][3]); } } while (0)
#pragma unroll 1
    for (int n = 0; n < 64; n += 2) {
        SC_STORE(rb, 1); __builtin_amdgcn_sched_barrier(0); SC_LOAD(rb, n + 3); __builtin_amdgcn_sched_barrier(0);
        SC_CHUNK(n, 0);
        __syncthreads();
        SC_STORE(ra, 0); __builtin_amdgcn_sched_barrier(0); SC_LOAD(ra, n + 4); __builtin_amdgcn_sched_barrier(0);
        SC_CHUNK(n + 1, 1);
        __syncthreads();
    }
#undef SC_LOAD
#undef SC_STORE
#undef SC_CHUNK
    if (wave < 4) {
#pragma unroll
        for (int td = 0; td < 4; ++td)
#pragma unroll
            for (int i = 0; i < 4; ++i) A.out[O_GDNP + ((((size_t)A.l * NPB + b) * 8 + h) * 64 + 16 * td + 4 * fq + i) * 64 + 16 * te + fr] = s[td][i];
    }
}

constexpr int L_CK = 0, L_CVT = 18432, L_IMP = 36864, L_MASK = 102400, L_UM = 102912, L_INV = 102928, L_K = 104448, L_VT = 113664;
struct AttArgs { const bf16* QB; const bf16* KS; const bf16* VS; const bf16* KW; const bf16* VW; const float* CKP; const float* CVP; const float* PROJ; bf16* MIX; };

constexpr float ATT_THR = 16.f;
constexpr int L_K2 = 122880, L_VT2 = 132096;
template <int MODE>
__device__ __forceinline__ void attn_tiles(unsigned char* lds, const bf16* Kg, const bf16* Vg, int j_lo, int j_hi, unsigned long long umask, unsigned long long tmask,
                                           int qblk, int trel, const bf16x8 (&qr)[4], f32x16 (&o)[2], float& mref, float& lrun, int tid, int r32, int hi) {
    int j = j_lo; while (j <= j_hi && !((umask >> j) & 1ull)) ++j;
    const int key = tid >> 3, ch = tid & 7;
    v4u kvv = {0u, 0u, 0u, 0u}, vv = {0u, 0u, 0u, 0u};
#define AT_LOAD(jj) do { kvv = *(const v4u*)(Kg + (size_t)(64 * (jj) + key) * 128 + ch * 8); vv = *(const v4u*)(Vg + (size_t)(64 * (jj) + key) * 128 + ch * 8); } while (0)
#define AT_WRITE(kofs, vofs) do { *(v4u*)(lds + (kofs) + key * 144 + ch * 16) = kvv; unsigned short* vt = (unsigned short*)(lds + (vofs)); \
        _Pragma("unroll") for (int e2 = 0; e2 < 4; ++e2) { const unsigned w = vv[e2]; vt[(ch * 8 + 2 * e2) * 72 + key] = (unsigned short)(w & 0xffffu); vt[(ch * 8 + 2 * e2 + 1) * 72 + key] = (unsigned short)(w >> 16); } } while (0)
    if (j > j_hi) return;
    AT_LOAD(j);
    __syncthreads();
    AT_WRITE(L_K, L_VT);
    int jn = j + 1; while (jn <= j_hi && !((umask >> jn) & 1ull)) ++jn;
    if (jn <= j_hi) AT_LOAD(jn);
    __syncthreads();
    int kb = L_K, vb = L_VT, kb2 = L_K2, vb2 = L_VT2;
    bool anyref = __any(mref != 0.f);
    while (j <= j_hi) {
        if (jn <= j_hi) AT_WRITE(kb2, vb2);
        int jnn = jn + 1; while (jnn <= j_hi && !((umask >> jnn) & 1ull)) ++jnn;
        if (jnn <= j_hi) AT_LOAD(jnn);
        __builtin_amdgcn_sched_barrier(0);
        f32x16 p[2];
#pragma unroll
        for (int u = 0; u < 2; ++u) { f32x16 acc = {};
#pragma unroll
            for (int d0 = 0; d0 < 4; ++d0) { const bf16x8 kf = *(const bf16x8*)(lds + kb + (32 * u + r32) * 144 + (16 * d0 + 8 * hi) * 2);
                acc = __builtin_amdgcn_mfma_f32_32x32x16_bf16(kf, qr[d0], acc, 0, 0, 0); }
            p[u] = acc; }
        if (anyref) {
#pragma unroll
            for (int u = 0; u < 2; ++u)
#pragma unroll
                for (int r = 0; r < 16; ++r) p[u][r] -= mref; }
        if (j == qblk) {
#pragma unroll
            for (int u = 0; u < 2; ++u)
#pragma unroll
                for (int r = 0; r < 16; ++r) { const int kv = 32 * u + crow(r, hi); if (kv > trel) p[u][r] = NEG_INF; } }
        if (MODE == 1 && j == qblk - 8) {
#pragma unroll
            for (int u = 0; u < 2; ++u)
#pragma unroll
                for (int r = 0; r < 16; ++r) { const int kv = 32 * u + crow(r, hi); if (kv < trel) p[u][r] = NEG_INF; } }
        const bool tsel = (MODE == 0) ? (((tmask >> j) & 1ull) != 0ull) : true;
        float rm;
        { float a = __builtin_fmaxf(__builtin_fmaxf(p[0][0], p[0][1]), p[1][0]), b2 = __builtin_fmaxf(__builtin_fmaxf(p[0][2], p[0][3]), p[1][1]); a = __builtin_fmaxf(__builtin_fmaxf(a, p[1][2]), p[1][3]);
#pragma unroll
          for (int r = 4; r < 16; r += 4) { a = __builtin_fmaxf(__builtin_fmaxf(a, p[0][r]), p[0][r + 1]); b2 = __builtin_fmaxf(__builtin_fmaxf(b2, p[0][r + 2]), p[0][r + 3]);
              a = __builtin_fmaxf(__builtin_fmaxf(a, p[1][r]), p[1][r + 1]); b2 = __builtin_fmaxf(__builtin_fmaxf(b2, p[1][r + 2]), p[1][r + 3]); }
          rm = __builtin_fmaxf(a, b2); }
        rm = tsel ? rm : NEG_INF;
        { auto rr = __builtin_amdgcn_permlane32_swap(__float_as_uint(rm), __float_as_uint(rm), false, false); rm = __builtin_fmaxf(__uint_as_float(rr[0]), __uint_as_float(rr[1])); }
        if (__builtin_expect(__any(rm > ATT_THR), 0)) {
            const float dl = (rm > ATT_THR) ? rm : 0.f, f = ex2(-dl);
            mref += dl; lrun *= f;
#pragma unroll
            for (int u = 0; u < 2; ++u)
#pragma unroll
                for (int r = 0; r < 16; ++r) p[u][r] -= dl;
#pragma unroll
            for (int dh = 0; dh < 2; ++dh)
#pragma unroll
                for (int r = 0; r < 16; ++r) o[dh][r] *= f;
            anyref = true; }
        typedef float f32x2v_ __attribute__((ext_vector_type(2)));
        f32x2v_ ls2 = {0.f, 0.f};
#pragma unroll
        for (int u = 0; u < 2; ++u)
#pragma unroll
            for (int r = 0; r < 16; r += 2) { const float e0 = ex2(p[u][r]), e1 = ex2(p[u][r + 1]); p[u][r] = e0; p[u][r + 1] = e1; ls2 += (f32x2v_){e0, e1}; }
        lrun += tsel ? (ls2.x + ls2.y) : 0.f;
        const unsigned keepm = tsel ? 0xffffffffu : 0u; const bool allsel = (MODE == 1) || __all(tsel);
#pragma unroll
        for (int u = 0; u < 2; ++u)
#pragma unroll
            for (int s = 0; s < 2; ++s) {
                v4u pw; pw.x = pk2(p[u][8 * s + 0], p[u][8 * s + 1]); pw.y = pk2(p[u][8 * s + 2], p[u][8 * s + 3]); pw.z = pk2(p[u][8 * s + 4], p[u][8 * s + 5]); pw.w = pk2(p[u][8 * s + 6], p[u][8 * s + 7]);
                if (!allsel) { pw.x &= keepm; pw.y &= keepm; pw.z &= keepm; pw.w &= keepm; }
                const bf16x8 pf = __builtin_bit_cast(bf16x8, pw);
#pragma unroll
                for (int dh = 0; dh < 2; ++dh) { const unsigned char* vp = lds + vb + (r32 + 32 * dh) * 144 + (32 * u + 16 * s + 4 * hi) * 2;
                    const s16x4 lo = *(const s16x4*)vp, hi4 = *(const s16x4*)(vp + 16);
                    const bf16x8 vf = (bf16x8){lo[0], lo[1], lo[2], lo[3], hi4[0], hi4[1], hi4[2], hi4[3]};
                    o[dh] = __builtin_amdgcn_mfma_f32_32x32x16_bf16(vf, pf, o[dh], 0, 0, 0); }
            }
        __syncthreads();
        j = jn; jn = jnn; { const int tk = kb; kb = kb2; kb2 = tk; const int tv = vb; vb = vb2; vb2 = tv; }
    }
#undef AT_LOAD
#undef AT_WRITE
}

__device__ __forceinline__ void nsa_prompt_unit(const AttArgs& A, unsigned char* lds, int unit, int tid) {
    const int lane = tid & 63, wave = tid >> 6, r32 = lane & 31, hi = lane >> 5, hh = wave & 3, ts = wave >> 2;
    const int qblk = 63 - (unit >> 3), b = (unit >> 1) & 3, kvh = unit & 1;
    const int head = kvh * 4 + hh, trel = 32 * ts + r32, t = 64 * qblk + trel; const size_t m = (size_t)b * SEQ + t;
    __syncthreads();
    const int nvmax = 2 * qblk + 2, ntile_c = (nvmax + 31) >> 5;
    { const int ch = tid & 7;
      for (int n = tid >> 3; n < 32 * ntile_c; n += 64) {
          const float* ckp = A.CKP + ((size_t)(b * 128 + n) * 2 + kvh) * 64 + ch * 8; const float* cvp = A.CVP + ((size_t)(b * 128 + n) * 2 + kvh) * 64 + ch * 8;
          const f32x4 k0 = *(const f32x4*)ckp, k1 = *(const f32x4*)(ckp + 4), v0 = *(const f32x4*)cvp, v1 = *(const f32x4*)(cvp + 4);
          *(bf16x8*)(lds + L_CK + n * 144 + ch * 16) = pack8(k0.x, k0.y, k0.z, k0.w, k1.x, k1.y, k1.z, k1.w);
          unsigned short* vt = (unsigned short*)(lds + L_CVT);
          vt[(ch * 8 + 0) * 136 + n] = (unsigned short)f2bf(v0.x); vt[(ch * 8 + 1) * 136 + n] = (unsigned short)f2bf(v0.y); vt[(ch * 8 + 2) * 136 + n] = (unsigned short)f2bf(v0.z); vt[(ch * 8 + 3) * 136 + n] = (unsigned short)f2bf(v0.w);
          vt[(ch * 8 + 4) * 136 + n] = (unsigned short)f2bf(v1.x); vt[(ch * 8 + 5) * 136 + n] = (unsigned short)f2bf(v1.y); vt[(ch * 8 + 6) * 136 + n] = (unsigned short)f2bf(v1.z); vt[(ch * 8 + 7) * 136 + n] = (unsigned short)f2bf(v1.w);
      }
      if (tid < 128) ((unsigned*)(lds + L_MASK))[tid] = 0u;
      if (tid < 2) ((unsigned*)(lds + L_UM))[tid] = 0u; }
    bf16x8 qr[4];
#pragma unroll
    for (int d0 = 0; d0 < 4; ++d0) qr[d0] = *(const bf16x8*)(A.QB + m * 512 + head * 64 + 16 * d0 + 8 * hi);
    __syncthreads();
    f32x16 tot[2];
    {
        const int nv = (t + 1) >> 5;
        float mx = NEG_INF;
#pragma unroll 1
        for (int tau = 0; tau < ntile_c; ++tau) {
            f32x16 acc = {};
#pragma unroll
            for (int d0 = 0; d0 < 4; ++d0) { const bf16x8 kf = *(const bf16x8*)(lds + L_CK + (32 * tau + r32) * 144 + (16 * d0 + 8 * hi) * 2);
                acc = __builtin_amdgcn_mfma_f32_32x32x16_bf16(kf, qr[d0], acc, 0, 0, 0); }
#pragma unroll
            for (int r = 0; r < 16; ++r) { const int n = 32 * tau + crow(r, hi); if (n < nv) mx = fmaxf(mx, acc[r]); }
        }
        mx = fmaxf(mx, __shfl_xor(mx, 32)); if (mx == NEG_INF) mx = 0.f;
        float sum = 0.f;
        f32x16 oc[2]; oc[0] = (f32x16){}; oc[1] = (f32x16){};
        float* imph = (float*)(lds + L_IMP) + (size_t)hh * 4096 + (32 * ts + r32) * 64;
#pragma unroll 1
        for (int tau = 0; tau < 4; ++tau) {
            f32x16 e = {};
            if (tau < ntile_c) {
                f32x16 acc = {};
#pragma unroll
                for (int d0 = 0; d0 < 4; ++d0) { const bf16x8 kf = *(const bf16x8*)(lds + L_CK + (32 * tau + r32) * 144 + (16 * d0 + 8 * hi) * 2);
                    acc = __builtin_amdgcn_mfma_f32_32x32x16_bf16(kf, qr[d0], acc, 0, 0, 0); }
#pragma unroll
                for (int r = 0; r < 16; ++r) { const int n = 32 * tau + crow(r, hi); e[r] = (n < nv) ? ex2(acc[r] - mx) : 0.f; sum += e[r]; }
#pragma unroll
                for (int s = 0; s < 2; ++s) {
                    const bf16x8 pf = pack8(e[8 * s + 0], e[8 * s + 1], e[8 * s + 2], e[8 * s + 3], e[8 * s + 4], e[8 * s + 5], e[8 * s + 6], e[8 * s + 7]);
#pragma unroll
                    for (int dh = 0; dh < 2; ++dh) { const unsigned char* vp = lds + L_CVT + (r32 + 32 * dh) * 272 + (32 * tau + 16 * s + 4 * hi) * 2;
                        const s16x4 lo = *(const s16x4*)vp, hi4 = *(const s16x4*)(vp + 16);
                        const bf16x8 vf = (bf16x8){lo[0], lo[1], lo[2], lo[3], hi4[0], hi4[1], hi4[2], hi4[3]};
                        oc[dh] = __builtin_amdgcn_mfma_f32_32x32x16_bf16(vf, pf, oc[dh], 0, 0, 0); }
                }
            }
#pragma unroll
            for (int a = 0; a < 4; ++a) { imph[16 * tau + 4 * a + 2 * hi + 0] = e[4 * a] + e[4 * a + 1]; imph[16 * tau + 4 * a + 2 * hi + 1] = e[4 * a + 2] + e[4 * a + 3]; }
        }
        sum += __shfl_xor(sum, 32);
        const float inv = 1.f / fmaxf(sum, 1e-30f);
        if (hi == 0) ((float*)(lds + L_INV))[hh * 64 + 32 * ts + r32] = inv;
        const float g0 = sigmoidf_(A.PROJ[m * NP + C_GATE + head * 3 + 0]) * inv;
#pragma unroll
        for (int dh = 0; dh < 2; ++dh)
#pragma unroll
            for (int r = 0; r < 16; ++r) tot[dh][r] = g0 * oc[dh][r];
    }
    __syncthreads();
    { float* ip = (float*)(lds + L_IMP); const float* iv = (const float*)(lds + L_INV);
#pragma unroll
      for (int i = 0; i < 8; ++i) { const int idx = tid + 512 * i, tk = idx >> 6;
          ip[idx] = (ip[idx] * iv[tk] + ip[4096 + idx] * iv[64 + tk]) + (ip[8192 + idx] * iv[128 + tk] + ip[12288 + idx] * iv[192 + tk]); } }
    __syncthreads();
    { const int tok = tid >> 3, jg = tid & 7; unsigned* mk = (unsigned*)(lds + L_MASK) + tok * 2;
      if (qblk <= 15) { if (jg == 0) { const unsigned long long am = (1ull << (qblk + 1)) - 1ull; mk[0] = (unsigned)am; mk[1] = (unsigned)(am >> 32); } }
      else {
          const float* iv = (const float*)(lds + L_IMP) + tok * 64; float vj[8]; int rk[8];
#pragma unroll
          for (int jj = 0; jj < 8; ++jj) { vj[jj] = iv[jg * 8 + jj]; rk[jj] = 0; }
          for (int i = 1; i <= qblk - 2; ++i) { const float vi = iv[i];
#pragma unroll
              for (int jj = 0; jj < 8; ++jj) { const int j = jg * 8 + jj; rk[jj] += (vi > vj[jj] || (vi == vj[jj] && i < j)) ? 1 : 0; } }
          unsigned bits = 0u;
#pragma unroll
          for (int jj = 0; jj < 8; ++jj) { const int j = jg * 8 + jj; const bool cand = (j >= 1 && j <= qblk - 2);
              if ((cand && rk[jj] < 13) || j == 0 || j == qblk || j == qblk - 1) bits |= 1u << ((jg & 3) * 8 + jj); }
          if (bits) atomicOr(mk + (jg >> 2), bits);
      } }
    __syncthreads();
    if (tid < 64) { const unsigned* mk = (const unsigned*)(lds + L_MASK) + tid * 2; atomicOr((unsigned*)(lds + L_UM), mk[0]); atomicOr((unsigned*)(lds + L_UM) + 1, mk[1]); }
    __syncthreads();
    unsigned long long tmask, umask;
    { const unsigned* mk = (const unsigned*)(lds + L_MASK) + trel * 2; tmask = (unsigned long long)mk[0] | ((unsigned long long)mk[1] << 32);
      const unsigned* um = (const unsigned*)(lds + L_UM); umask = (unsigned long long)um[0] | ((unsigned long long)um[1] << 32); }
    float* stash = (float*)(lds + L_IMP) + (size_t)wave * 2048 + lane;
#pragma unroll
    for (int dh = 0; dh < 2; ++dh)
#pragma unroll
        for (int r = 0; r < 16; ++r) stash[(dh * 16 + r) * 64] = tot[dh][r];
    {
        f32x16 o[2]; o[0] = (f32x16){}; o[1] = (f32x16){}; float mrun = 0.f, lrun = 0.f;
        attn_tiles<0>(lds, A.KS + (size_t)b * SEQ * 128 + kvh * 64, A.VS + (size_t)b * SEQ * 128 + kvh * 64, 0, qblk, umask, tmask, qblk, trel, qr, o, mrun, lrun, tid, r32, hi);
        lrun += __shfl_xor(lrun, 32);
        const float g1 = lrun > 0.f ? sigmoidf_(A.PROJ[m * NP + C_GATE + head * 3 + 1]) / lrun : 0.f;
#pragma unroll
        for (int dh = 0; dh < 2; ++dh)
#pragma unroll
            for (int r = 0; r < 16; ++r) stash[(dh * 16 + r) * 64] += g1 * o[dh][r];
    }
    {
        f32x16 o[2]; o[0] = (f32x16){}; o[1] = (f32x16){}; float mrun = 0.f, lrun = 0.f;
        const int jlo = qblk >= 8 ? qblk - 8 : 0;
        attn_tiles<1>(lds, A.KW + (size_t)b * SEQ * 128 + kvh * 64, A.VW + (size_t)b * SEQ * 128 + kvh * 64, jlo, qblk, ~0ull, ~0ull, qblk, trel, qr, o, mrun, lrun, tid, r32, hi);
        lrun += __shfl_xor(lrun, 32);
        const float g2 = lrun > 0.f ? sigmoidf_(A.PROJ[m * NP + C_GATE + head * 3 + 2]) / lrun : 0.f;
#pragma unroll
        for (int dh = 0; dh < 2; ++dh)
#pragma unroll
            for (int r = 0; r < 16; ++r) tot[dh][r] = stash[(dh * 16 + r) * 64] + g2 * o[dh][r];
    }
    bf16* mo = A.MIX + m * 1024 + 512 + head * 64;
#pragma unroll
    for (int dh = 0; dh < 2; ++dh)
#pragma unroll
        for (int a = 0; a < 4; ++a) { const int d0 = 32 * dh + 8 * a + 4 * hi;
            *(v2u*)(mo + d0) = (v2u){pk2(tot[dh][4 * a], tot[dh][4 * a + 1]), pk2(tot[dh][4 * a + 2], tot[dh][4 * a + 3])}; }
}

struct SAttArgs { const bf16* QB; const bf16* KS; const bf16* VS; const bf16* KW; const bf16* VW; const float* CKS; const float* CVS; const float* PROJ; const float* cache; const int* page_table; const float* state_win; bf16* MIX; int l; };
constexpr int S2_IMP = 0, S2_MK = 512, S2_ITEMS = 576, S2_OC = 1024, S2_MG = 8192;
constexpr int S2_MG_STRIDE = 4224;
template <bool F32> __device__ __forceinline__ void s2_block(const void* kbase, const void* vbase, int kstride, int nvalid, const bf16x8 (&qf)[2], const bool (&keep)[4][4], f32x4 (&O)[4], float& mrun, float& lrun, int fr, int fq) {
    f32x4 kraw[4][2][2]; bf16x8 kb[4][2]; f32x4 vraw[2][8]; v2u vb[2][8];
#pragma unroll
    for (int tk = 0; tk < 4; ++tk) { const int key = 16 * tk + fr, kc = key < nvalid ? key : nvalid - 1;
#pragma unroll
        for (int ks = 0; ks < 2; ++ks) {
            if (F32) { const float* p = (const float*)kbase + (size_t)kc * kstride + 32 * ks + 8 * fq; kraw[tk][ks][0] = *(const f32x4*)p; kraw[tk][ks][1] = *(const f32x4*)(p + 4); }
            else kb[tk][ks] = *(const bf16x8*)((const bf16*)kbase + (size_t)kc * 128 + 32 * ks + 8 * fq); } }
#pragma unroll
    for (int ks = 0; ks < 2; ++ks)
#pragma unroll
        for (int j = 0; j < 8; ++j) { const int key = 32 * ks + 16 * (j >> 2) + 4 * fq + (j & 3), kc = key < nvalid ? key : nvalid - 1;
            if (F32) vraw[ks][j] = *(const f32x4*)((const float*)vbase + (size_t)kc * kstride + 4 * fr);
            else vb[ks][j] = *(const v2u*)((const bf16*)vbase + (size_t)kc * 128 + 4 * fr); }
    __builtin_amdgcn_sched_barrier(0);
    f32x4 acc[4];
#pragma unroll
    for (int tk = 0; tk < 4; ++tk) { bf16x8 kx[2];
#pragma unroll
        for (int ks = 0; ks < 2; ++ks) { if (F32) { const f32x4 a = kraw[tk][ks][0], b = kraw[tk][ks][1]; kx[ks] = pack8(a.x, a.y, a.z, a.w, b.x, b.y, b.z, b.w); } else kx[ks] = kb[tk][ks]; }
        f32x4 a4 = {0.f, 0.f, 0.f, 0.f};
        a4 = __builtin_amdgcn_mfma_f32_16x16x32_bf16(kx[0], qf[0], a4, 0, 0, 0); a4 = __builtin_amdgcn_mfma_f32_16x16x32_bf16(kx[1], qf[1], a4, 0, 0, 0);
        acc[tk] = a4; }
    float mx = NEG_INF;
#pragma unroll
    for (int tk = 0; tk < 4; ++tk)
#pragma unroll
        for (int i = 0; i < 4; ++i) { if (!keep[tk][i]) acc[tk][i] = NEG_INF; mx = fmaxf(mx, acc[tk][i]); }
    mx = fmaxf(mx, __shfl_xor(mx, 16)); mx = fmaxf(mx, __shfl_xor(mx, 32));
    const float mn = fmaxf(mrun, mx), msafe = (mn == NEG_INF) ? 0.f : mn, alpha = ex2(mrun - msafe);
    float ls = 0.f;
#pragma unroll
    for (int tk = 0; tk < 4; ++tk)
#pragma unroll
        for (int i = 0; i < 4; ++i) { const float e = ex2(acc[tk][i] - msafe); acc[tk][i] = e; ls += e; }
    lrun = lrun * alpha + ls; mrun = mn;
#pragma unroll
    for (int td = 0; td < 4; ++td) O[td] *= alpha;
#pragma unroll
    for (int ks = 0; ks < 2; ++ks) {
        const bf16x8 pf = pack8(acc[2 * ks][0], acc[2 * ks][1], acc[2 * ks][2], acc[2 * ks][3], acc[2 * ks + 1][0], acc[2 * ks + 1][1], acc[2 * ks + 1][2], acc[2 * ks + 1][3]);
        float vv[8][4];
#pragma unroll
        for (int j = 0; j < 8; ++j) {
            if (F32) { const f32x4 v = vraw[ks][j]; vv[j][0] = v.x; vv[j][1] = v.y; vv[j][2] = v.z; vv[j][3] = v.w; }
            else { const v2u w = vb[ks][j]; vv[j][0] = bf2f((unsigned short)(w.x & 0xffffu)); vv[j][1] = bf2f((unsigned short)(w.x >> 16)); vv[j][2] = bf2f((unsigned short)(w.y & 0xffffu)); vv[j][3] = bf2f((unsigned short)(w.y >> 16)); } }
#pragma unroll
        for (int td = 0; td < 4; ++td) { const bf16x8 vx = pack8(vv[0][td], vv[1][td], vv[2][td], vv[3][td], vv[4][td], vv[5][td], vv[6][td], vv[7][td]);
            O[td] = __builtin_amdgcn_mfma_f32_16x16x32_bf16(vx, pf, O[td], 0, 0, 0); }
    }
}
__device__ __forceinline__ void nsa_sample_unit(const SAttArgs& A, unsigned char* lds, int unit, int tid) {
    const int sb = unit >> 1, kvh = unit & 1, l = A.l;
    const int lane = tid & 63, wave = __builtin_amdgcn_readfirstlane(tid >> 6), fr = lane & 15, fq = lane >> 4;
    const int qi = fr >> 2, qh = fr & 3;
    float* IMP = (float*)(lds + S2_IMP); unsigned* MK = (unsigned*)(lds + S2_MK); int* ITEMS = (int*)(lds + S2_ITEMS);
    const size_t mq = (size_t)MP + sb * 4 + qi;
    __syncthreads();
    if (tid < 8) MK[tid] = 0u;
    bf16x8 qf[2];
#pragma unroll
    for (int ks = 0; ks < 2; ++ks) qf[ks] = *(const bf16x8*)(A.QB + mq * 512 + (kvh * 4 + qh) * 64 + 32 * ks + 8 * fq);
    {
        f32x4 O[4]; float mrun = NEG_INF, lrun = 0.f;
#pragma unroll
        for (int td = 0; td < 4; ++td) O[td] = (f32x4){0.f, 0.f, 0.f, 0.f};
        bool keep[4][4];
#pragma unroll
        for (int tk = 0; tk < 4; ++tk)
#pragma unroll
            for (int i = 0; i < 4; ++i) keep[tk][i] = true;
        const float* ckf = A.CKS + ((size_t)sb * 64 * 2 + kvh) * 64; const float* cvf = A.CVS + ((size_t)sb * 64 * 2 + kvh) * 64;
        f32x4 acc[4];
#pragma unroll
        for (int tk = 0; tk < 4; ++tk) { bf16x8 kx[2];
#pragma unroll
            for (int ks = 0; ks < 2; ++ks) { const float* p = ckf + (size_t)(16 * tk + fr) * 128 + 32 * ks + 8 * fq; const f32x4 a = *(const f32x4*)p, b = *(const f32x4*)(p + 4); kx[ks] = pack8(a.x, a.y, a.z, a.w, b.x, b.y, b.z, b.w); }
            f32x4 a4 = {0.f, 0.f, 0.f, 0.f};
            a4 = __builtin_amdgcn_mfma_f32_16x16x32_bf16(kx[0], qf[0], a4, 0, 0, 0); a4 = __builtin_amdgcn_mfma_f32_16x16x32_bf16(kx[1], qf[1], a4, 0, 0, 0);
            acc[tk] = a4; }
        float mx = NEG_INF;
#pragma unroll
        for (int tk = 0; tk < 4; ++tk)
#pragma unroll
            for (int i = 0; i < 4; ++i) mx = fmaxf(mx, acc[tk][i]);
        mx = fmaxf(mx, __shfl_xor(mx, 16)); mx = fmaxf(mx, __shfl_xor(mx, 32));
        float ls = 0.f;
#pragma unroll
        for (int tk = 0; tk < 4; ++tk)
#pragma unroll
            for (int i = 0; i < 4; ++i) { const float e = ex2(acc[tk][i] - mx); acc[tk][i] = e; ls += e; }
        ls += __shfl_xor(ls, 16); ls += __shfl_xor(ls, 32);
        const float inv = 1.f / fmaxf(ls, 1e-30f);
        if (wave == 0) {
#pragma unroll
            for (int tk = 0; tk < 4; ++tk)
#pragma unroll
                for (int b2 = 0; b2 < 2; ++b2) { float v = (acc[tk][2 * b2] + acc[tk][2 * b2 + 1]) * inv;
                    v += __shfl_xor(v, 1); v += __shfl_xor(v, 2);
                    if (qh == 0) IMP[qi * 32 + 8 * tk + 2 * fq + b2] = v; }
#pragma unroll
            for (int ks = 0; ks < 2; ++ks) {
                const bf16x8 pf = pack8(acc[2 * ks][0], acc[2 * ks][1], acc[2 * ks][2], acc[2 * ks][3], acc[2 * ks + 1][0], acc[2 * ks + 1][1], acc[2 * ks + 1][2], acc[2 * ks + 1][3]);
#pragma unroll
                for (int td = 0; td < 4; ++td) { float vv[8];
#pragma unroll
                    for (int j = 0; j < 8; ++j) { const int key = 32 * ks + 16 * (j >> 2) + 4 * fq + (j & 3); vv[j] = cvf[(size_t)key * 128 + 4 * fr + td]; }
                    const bf16x8 vx = pack8(vv[0], vv[1], vv[2], vv[3], vv[4], vv[5], vv[6], vv[7]);
                    O[td] = __builtin_amdgcn_mfma_f32_16x16x32_bf16(vx, pf, O[td], 0, 0, 0); } }
            const float g0 = sigmoidf_(A.PROJ[mq * NP + C_GATE + (kvh * 4 + qh) * 3 + 0]) * inv;
            float* OC = (float*)(lds + S2_OC);
#pragma unroll
            for (int td = 0; td < 4; ++td)
#pragma unroll
                for (int i = 0; i < 4; ++i) OC[(16 * fq + 4 * i + td) * 16 + fr] = g0 * O[td][i];
        }
        (void)mrun; (void)lrun; (void)keep;
    }
    __syncthreads();
    if (tid < 128) { const int i = tid >> 5, j = tid & 31; bool sel = (j == 0 || j == 31);
        if (j >= 1 && j <= 30) { const float vj = IMP[i * 32 + j]; int rk = 0;
            for (int q = 1; q <= 30; ++q) { const float vi = IMP[i * 32 + q]; rk += (vi > vj || (vi == vj && q < j)) ? 1 : 0; }
            sel = rk < 13; }
        if (sel) { atomicOr(MK + i, 1u << j); atomicOr(MK + 4, 1u << j); } }
    __syncthreads();
    if (tid == 0) { const unsigned um = MK[4]; int n = 0;
        for (int j = 0; j < 32; ++j) if ((um >> j) & 1u) ITEMS[1 + n++] = j;
        ITEMS[1 + n++] = 32;
        for (int jb = 0; jb < 9; ++jb) ITEMS[1 + n++] = 64 + jb;
        ITEMS[0] = n; }
    __syncthreads();
    {
        const int nitems = ITEMS[0]; const unsigned tm = MK[qi];
        f32x4 Os[4], Ow[4]; float ms = NEG_INF, lsum = 0.f, mw = NEG_INF, lw = 0.f;
#pragma unroll
        for (int td = 0; td < 4; ++td) { Os[td] = (f32x4){0.f, 0.f, 0.f, 0.f}; Ow[td] = (f32x4){0.f, 0.f, 0.f, 0.f}; }
        const float* wb = A.state_win + ((size_t)l * NSB + sb) * 512 * 256 + kvh * 64;
        for (int it = wave; it < nitems; it += NWAVES) {
            const int code = ITEMS[1 + it]; bool keep[4][4];
            if (code < 64) {
                const int j = code;
                if (j < 32) { const int phys = A.page_table[sb * NPAGES + (j >> 1)];
                    const float* base = A.cache + ((((size_t)l * NPOOL + phys) * 2 + kvh) * 128 + (j & 1) * 64) * 256;
                    const bool tsel = ((tm >> j) & 1u) != 0u;
#pragma unroll
                    for (int tk = 0; tk < 4; ++tk)
#pragma unroll
                        for (int i = 0; i < 4; ++i) keep[tk][i] = tsel;
                    s2_block<true>(base + 128, base + 192, 256, 64, qf, keep, Os, ms, lsum, fr, fq);
                } else {
#pragma unroll
                    for (int tk = 0; tk < 4; ++tk)
#pragma unroll
                        for (int i = 0; i < 4; ++i) { const int key = 16 * tk + 4 * fq + i; keep[tk][i] = key <= qi; }
                    s2_block<false>(A.KS + ((size_t)MP + sb * 4) * 128 + kvh * 64, A.VS + ((size_t)MP + sb * 4) * 128 + kvh * 64, 128, 4, qf, keep, Os, ms, lsum, fr, fq);
                }
            } else {
                const int jb = code - 64;
                if (jb < 8) {
#pragma unroll
                    for (int tk = 0; tk < 4; ++tk)
#pragma unroll
                        for (int i = 0; i < 4; ++i) { const int r = 64 * jb + 16 * tk + 4 * fq + i; keep[tk][i] = r >= qi; }
                    s2_block<true>(wb + (size_t)(64 * jb) * 256, wb + (size_t)(64 * jb) * 256 + 128, 256, 64, qf, keep, Ow, mw, lw, fr, fq);
                } else {
#pragma unroll
                    for (int tk = 0; tk < 4; ++tk)
#pragma unroll
                        for (int i = 0; i < 4; ++i) { const int key = 16 * tk + 4 * fq + i; keep[tk][i] = key <= qi; }
                    s2_block<false>(A.KW + ((size_t)MP + sb * 4) * 128 + kvh * 64, A.VW + ((size_t)MP + sb * 4) * 128 + kvh * 64, 128, 4, qf, keep, Ow, mw, lw, fr, fq);
                }
            }
        }
        lsum += __shfl_xor(lsum, 16); lsum += __shfl_xor(lsum, 32); lw += __shfl_xor(lw, 16); lw += __shfl_xor(lw, 32);
        float* Ps = (float*)(lds + S2_MG + (wave * 2 + 0) * S2_MG_STRIDE); float* Pw = (float*)(lds + S2_MG + (wave * 2 + 1) * S2_MG_STRIDE);
#pragma unroll
        for (int td = 0; td < 4; ++td)
#pragma unroll
            for (int i = 0; i < 4; ++i) { Ps[(16 * fq + 4 * i + td) * 16 + fr] = Os[td][i]; Pw[(16 * fq + 4 * i + td) * 16 + fr] = Ow[td][i]; }
        if (fq == 0) { Ps[1024 + fr] = ms; Ps[1040 + fr] = lsum; Pw[1024 + fr] = mw; Pw[1040 + fr] = lw; }
    }
    __syncthreads();
    {
        const int q = tid & 15, i = q >> 2, hh = q & 3; const size_t m = (size_t)MP + sb * 4 + i;
        const float* OC = (const float*)(lds + S2_OC);
        float res[2];
#pragma unroll
        for (int k = 0; k < 2; ++k) res[k] = OC[((tid >> 4) + 32 * k) * 16 + q];
#pragma unroll
        for (int br = 0; br < 2; ++br) {
            float M = NEG_INF;
#pragma unroll
            for (int w = 0; w < NWAVES; ++w) M = fmaxf(M, ((const float*)(lds + S2_MG + (w * 2 + br) * S2_MG_STRIDE))[1024 + q]);
            float L = 0.f, o0 = 0.f, o1 = 0.f;
#pragma unroll
            for (int w = 0; w < NWAVES; ++w) { const float* P = (const float*)(lds + S2_MG + (w * 2 + br) * S2_MG_STRIDE);
                const float f = ex2(P[1024 + q] - M);
                L += P[1040 + q] * f; o0 += P[(tid >> 4) * 16 + q] * f; o1 += P[((tid >> 4) + 32) * 16 + q] * f; }
            const float g = sigmoidf_(A.PROJ[m * NP + C_GATE + (kvh * 4 + hh) * 3 + 1 + br]) / fmaxf(L, 1e-30f);
            res[0] += g * o0; res[1] += g * o1;
        }
#pragma unroll
        for (int k = 0; k < 2; ++k) A.MIX[m * 1024 + 512 + (kvh * 4 + hh) * 64 + (tid >> 4) + 32 * k] = (bf16)f2bf(res[k]);
    }
}

constexpr int CW_CMPQ = 256;
__device__ __forceinline__ void compress_pull(const CmpArgs& A, unsigned char* lds, unsigned* head, volatile LAS int* slot, int max_batches, int tid) {
    for (int nb = 0; nb < max_batches; ++nb) {
        __syncthreads();
        if (tid == 0) *slot = (int)__hip_atomic_fetch_add(head, 1u, __ATOMIC_RELAXED, __HIP_MEMORY_SCOPE_AGENT);
        __syncthreads();
        const int b = *slot;
        if (b >= 256) break;
        compress_batch(A, lds, b, true, tid);
    }
    __syncthreads();
}

struct Args { const GAS void* in[22]; GAS float* out; GAS unsigned char* ws; int ph_lo, ph_hi; };
constexpr int PH_PER_LAYER = 10, N_PHASES = 1 + NL * PH_PER_LAYER;
__global__ void __launch_bounds__(NWAVES * 64, 2) hymba_fwd(Args args) {
    extern __shared__ __attribute__((aligned(16))) unsigned char lds[];
    const int G = gridDim.x, bx = blockIdx.x, NGW = G * NWAVES;
    const int wave_s_ = __builtin_amdgcn_readfirstlane((int)threadIdx.x >> 6);
#define TID_NOW() (wave_s_ * 64 + (int)__builtin_amdgcn_mbcnt_hi(~0u, __builtin_amdgcn_mbcnt_lo(~0u, 0u)))
#define SUB_IDS int tid = TID_NOW(); asm volatile("" : "+v"(tid)); const int lane = tid & 63, wave = __builtin_amdgcn_readfirstlane(tid >> 6), gw = bx * NWAVES + wave; (void)lane; (void)gw; (void)wave;
#define PHASE_IDS int tid = TID_NOW(); asm volatile("" : "+v"(tid)); const int lane = tid & 63, wave = __builtin_amdgcn_readfirstlane(tid >> 6), gw = bx * NWAVES + wave; (void)lane; (void)gw; const __attribute__((address_space(4))) unsigned long long* ka_ = (const __attribute__((address_space(4))) unsigned long long*)__builtin_amdgcn_kernarg_segment_ptr(); asm volatile("" : "+s"(ka_)); GAS unsigned char* wsg_ = (GAS unsigned char*)ka_[23]; unsigned char* wsl = (unsigned char*)wsg_;
#define x_prompt ((const float*)(const GAS float*)ka_[0])
#define x_sample ((const float*)(const GAS float*)ka_[1])
#define cache_kv ((const float*)(const GAS float*)ka_[2])
#define page_table ((const int*)(const GAS int*)ka_[3])
#define state_win ((const float*)(const GAS float*)ka_[4])
#define state_gdn ((const float*)(const GAS float*)ka_[5])
#define state_conv ((const float*)(const GAS float*)ka_[6])
#define norm_mix ((const float*)(const GAS float*)ka_[7])
#define w_in ((const float*)(const GAS float*)ka_[8])
#define conv_w ((const float*)(const GAS float*)ka_[9])
#define a_log ((const float*)(const GAS float*)ka_[10])
#define dt_bias ((const float*)(const GAS float*)ka_[11])
#define gdn_norm ((const float*)(const GAS float*)ka_[12])
#define cmp_pe_k ((const float*)(const GAS float*)ka_[13])
#define cmp_w_k ((const float*)(const GAS float*)ka_[14])
#define cmp_pe_v ((const float*)(const GAS float*)ka_[15])
#define cmp_w_v ((const float*)(const GAS float*)ka_[16])
#define w_out ((const float*)(const GAS float*)ka_[17])
#define norm_mlp ((const float*)(const GAS float*)ka_[18])
#define w_up ((const float*)(const GAS float*)ka_[19])
#define w_down ((const float*)(const GAS float*)ka_[20])
#define norm_final ((const float*)(const GAS float*)ka_[21])
#define out ((float*)(GAS float*)ka_[22])
#define WIN_T ((bf16*)(wsl + WS_WIN))
#define WOUT_T ((bf16*)(wsl + WS_WOUT))
#define WUP_T ((bf16*)(wsl + WS_WUP))
#define WDN_T ((bf16*)(wsl + WS_WDN))
#define CMPW ((bf16*)(wsl + WS_CMPW))
#define HB ((bf16*)(wsl + WS_HB))
#define PROJ ((float*)(wsl + WS_PROJ))
#define X1 ((float*)(wsl + WS_X1))
#define X2 ((float*)(wsl + WS_X2))
#define MIX ((bf16*)(wsl + WS_MIX))
#define HID ((bf16*)(wsl + WS_HID))
#define QN ((float*)(wsl + WS_QN))
#define KN ((float*)(wsl + WS_KN))
#define VG ((float*)(wsl + WS_VG))
#define OG ((float*)(wsl + WS_OG))
#define GG ((float*)(wsl + WS_G))
#define BETA ((float*)(wsl + WS_BETA))
#define KQ ((float*)(wsl + WS_KQ))
#define QB ((bf16*)(wsl + WS_QB))
#define KS ((bf16*)(wsl + WS_KS))
#define VS ((bf16*)(wsl + WS_VS))
#define KW ((bf16*)(wsl + WS_KW))
#define VW ((bf16*)(wsl + WS_VW))
#define CKP ((float*)(wsl + WS_CKP))
#define CVP ((float*)(wsl + WS_CVP))
#define CKS ((float*)(wsl + WS_CKS))
#define CVS ((float*)(wsl + WS_CVS))
#define GK ((bf16*)(wsl + WS_GK))
#define GQ ((bf16*)(wsl + WS_GQ))
#define GKT ((bf16*)(wsl + WS_GKT))
#define GVT ((bf16*)(wsl + WS_GVT))
#define GG2 ((float*)(wsl + WS_GG2))
#define BETA2 ((float*)(wsl + WS_BETA2))
#define WX ((bf16*)(wsl + WS_WX))
#define QX ((bf16*)(wsl + WS_QX))
#define QKX ((bf16*)(wsl + WS_QKX))
#define KTX ((bf16*)(wsl + WS_KTX))
#define U0F ((float*)(wsl + WS_U0F))
#define GL ((float*)(wsl + WS_GL))
#define PARTD ((float*)(wsl + WS_PARTD))
#define PARTG ((float*)(wsl + WS_PARTG))
    LAS unsigned char* ldsl = (LAS unsigned char*)lds;

    const int lo = args.ph_lo, hi = args.ph_hi;
    { const int t0_ = TID_NOW(); if (t0_ < 16) ((LAS unsigned*)(ldsl + MISC_OFF))[t0_] = 0u; }
    __syncthreads();
    XcdBarrier bar = xcd_barrier_post((unsigned*)((unsigned char*)args.ws + WS_CTL) + CW_BAR, (volatile LAS unsigned*)(ldsl + MISC_OFF), TID_NOW() == 0);
#define BOTH(k) (lo <= (k) && (k) + 1 < hi)
#define GRID_BAR(k) do { if (BOTH(k)) { for (int rb_ = 0; rb_ < REP_BAR; ++rb_) xcd_barrier(bar, TID_NOW() == 0); } } while (0)
#ifndef REP_PG
#define REP_PG 1
#endif
#ifndef REP_PA
#define REP_PA 1
#endif
#ifndef REP_BAR
#define REP_BAR 1
#endif
#ifndef REP_GSMP
#define REP_GSMP 1
#endif
#ifndef REP_P0
#define REP_P0 1
#endif
#ifndef REP_LIGHT
#define REP_LIGHT 1
#endif
#ifndef REP_PB_ROW
#define REP_PB_ROW 1
#endif
#ifndef REP_PB_PREP
#define REP_PB_PREP 1
#endif
#ifndef REP_PB_CMP
#define REP_PB_CMP 1
#endif
#ifndef REP_PB_COPY
#define REP_PB_COPY 1
#endif
#ifndef REP_PB2
#define REP_PB2 1
#endif
#ifndef REP_SCAN
#define REP_SCAN 1
#endif
#ifndef REP_ATTP
#define REP_ATTP 1
#endif
#ifndef REP_ATTS
#define REP_ATTS 1
#endif
#ifndef REP_GEMM
#define REP_GEMM 1
#endif
#define EN(i) (((PH_MASK_T) >> (i)) & 1u)
#define SUB(i) (((SUB_MASK_T) >> (i)) & 1u)
#define IN(k) (lo <= (k) && (k) < hi)

    if (IN(0)) { PHASE_IDS
        for (int rep0 = 0; rep0 < REP_P0; ++rep0) {
        LAS float* scr = (LAS float*)(ldsl + wave * 16384);
        constexpr int I_IN = 16 * 112, I_OUT = 16 * 32, I_UP = 16 * 128, I_DN = 64 * 32, I_C = 32 * 2, I_L = I_IN + I_OUT + I_UP + I_DN + 2 * I_C;
        for (int it = gw; it < NL * I_L; it += NGW) {
            const int l = it / I_L; int r = it % I_L;
            if (r < I_IN) { transpose_item(w_in + (size_t)l * DM * NPROJ, DM, NPROJ, NP, WIN_T + (size_t)l * NP * DM, scr, r, lane); continue; } r -= I_IN;
            if (r < I_OUT) { transpose_item(w_out + (size_t)l * DM * DM, DM, DM, DM, WOUT_T + (size_t)l * DM * DM, scr, r, lane); continue; } r -= I_OUT;
            if (r < I_UP) { transpose_item(w_up + (size_t)l * DM * DFF, DM, DFF, DFF, WUP_T + (size_t)l * DFF * DM, scr, r, lane); continue; } r -= I_UP;
            if (r < I_DN) { transpose_item(w_down + (size_t)l * DFF * DM, DFF, DM, DM, WDN_T + (size_t)l * DM * DFF, scr, r, lane); continue; } r -= I_DN;
            if (r < I_C) { transpose_item(cmp_w_k + (size_t)l * 2048 * 64, 2048, 64, 64, CMPW + (size_t)((l * 2 + 0) * 64) * 2048, scr, r, lane); continue; } r -= I_C;
            transpose_item(cmp_w_v + (size_t)l * 2048 * 64, 2048, 64, 64, CMPW + (size_t)((l * 2 + 1) * 64) * 2048, scr, r, lane);
        }
        for (int m = gw; m < MT; m += NGW) { const float* xr = (m < MP) ? x_prompt + (size_t)m * DM : x_sample + (size_t)(m - MP) * DM; rms_row(xr, norm_mix, HB + (size_t)m * DM, nullptr, lane); }
        }
    }

    GRID_BAR(0);
    for (int l = 0; l < NL; ++l) {
        const int pb = 1 + l * PH_PER_LAYER;
        if (IN(pb + 0)) { PHASE_IDS
            pg8::Gemm g{HB, WIN_T + (size_t)l * NP * DM, MT, NP, DM, DM}; pg8::StaticOrder S; S.init(MT, NP, G, bx);
            pg8::EpiF32 E{PROJ, NP};
            _Pragma("unroll 1") for (int rep = 0; rep < REP_PA; ++rep) pg8::gemm_phase<pg8::EpiF32, pg8::StaticOrder, true, true>(ldsl, g, S, E, tid);
            if (l == 0 && bx >= (MT / 256) * (NP / 256) % G) { SUB_IDS CmpArgs CA{PROJ, cache_kv, page_table, cmp_pe_k, cmp_pe_v, CMPW, wsl, 0};
                compress_pull(CA, lds, (unsigned*)(wsl + WS_CTL) + CW_CMPQ, (volatile LAS int*)(ldsl + MISC_OFF + 36), 1, tid); }
        }
        GRID_BAR(pb + 0);
        if (IN(pb + 1)) { PHASE_IDS
            { SUB_IDS PBArgs A{PROJ, state_conv, conv_w, a_log, dt_bias, QN, KN, VG, GG, BETA, KQ, QB, KS, VS, KW, VW, out, l};
              for (int rep = 0; rep < REP_PB_ROW; ++rep) if (gw >= 128) for (int m = gw - 128; m < MT; m += 2 * (NGW - 128)) {
                  const int m2 = m + (NGW - 128); const bool has2 = m2 < MT; PBRegs r0, r1;
                  pb_row_load(A, m, lane, r0); pb_row_load(A, has2 ? m2 : m, lane, r1);
                  __builtin_amdgcn_sched_barrier(0);
                  pb_row(A, m, lane, r0); if (has2) pb_row(A, m2, lane, r1); }
              for (int u = gw; u < MS * 8; u += NGW) pb_sample_head(A, u, lane); }
            { SUB_IDS GPArgs A{PROJ, conv_w, a_log, dt_bias, GK, GQ, GKT, GVT, GG2, BETA2, l};
              for (int rep = 0; rep < REP_PB_PREP; ++rep) for (int u = gw; u < (MP / 8) * 8; u += 2 * NGW) {
                  GPRegs r0, r1; const int u2 = (u + NGW < (MP / 8) * 8) ? u + NGW : u; gdn_prep_load(A, u, lane, r0); gdn_prep_load(A, u2, lane, r1);
                  __builtin_amdgcn_sched_barrier(0);
                  gdn_prep_unit(A, u, lane, r0); gdn_prep_unit(A, u2, lane, r1); } }
            { SUB_IDS CmpArgs A{PROJ, cache_kv, page_table, cmp_pe_k, cmp_pe_v, CMPW, wsl, l};
              if (bx < 16) compress_batch(A, lds, bx, false, tid);
              compress_pull(A, lds, (unsigned*)(wsl + WS_CTL) + CW_CMPQ + 64 * l, (volatile LAS int*)(ldsl + MISC_OFF + 36), 1 << 20, tid); }
        }
        GRID_BAR(pb + 1);
        if (IN(pb + 2)) { PHASE_IDS
            GCArgs A{GK, GQ, GKT, GVT, GG2, BETA2, WX, QX, QKX, KTX, U0F, GL};
            for (int rep = 0; rep < REP_PB2; ++rep) for (int u = gw; u < 32 * 64; u += NGW) gdn_chunk_unit(A, lds + wave * GC_LDS_PER_WAVE, u, lane);
        }
        GRID_BAR(pb + 2);
        if (IN(pb + 3)) {
            { PHASE_IDS GdnArgs GA{QN, KN, VG, GG, BETA, KQ, OG, PROJ, state_gdn, gdn_norm, MIX, out, l};
                for (int rep = 0; rep < REP_GSMP; ++rep) for (int u = gw; u < NSB * 8; u += NGW) gdn_sample_unit(GA, u, lane); }
            { PHASE_IDS
                GS2Args SG{WX, QX, QKX, KTX, U0F, GL, OG, out, l};
                AttArgs AA{QB, KS, VS, KW, VW, CKP, CVP, PROJ, MIX};
                SAttArgs SA{QB, KS, VS, KW, VW, CKS, CVS, PROJ, cache_kv, page_table, state_win, MIX, l};
                unsigned* qhead = (unsigned*)(wsl + WS_CTL) + CW_QUEUE + 64 * l;
                volatile LAS int* slot = (volatile LAS int*)(ldsl + MISC_OFF + 32);
                for (;;) {
                    __syncthreads();
                    if (tid == 0) *slot = (int)__hip_atomic_fetch_add(qhead, 1u, __ATOMIC_RELAXED, __HIP_MEMORY_SCOPE_AGENT);
                    __syncthreads();
                    int u = *slot;
                    constexpr int XP = (REP_ATTP - 1) * 512, XS = (REP_ATTS - 1) * 256, XG = (REP_SCAN - 1) * 32;
                    if (u >= 800 + XP + XS + XG + 128) break;
                    if (u >= 800 + XP + XS + XG) {
                        const int sb = u - (800 + XP + XS + XG); const f32x4* src = (const f32x4*)(state_win + ((size_t)l * NSB + sb) * 512 * 256) + 256; f32x4* dst = (f32x4*)(out + O_WINS + ((size_t)l * NSB + sb) * 512 * 256);
                        for (int i = tid; i < 508 * 64; i += 8 * NWAVES * 64) { f32x4 v[8];
#pragma unroll
                            for (int k = 0; k < 8; ++k) { const int ii = i + k * NWAVES * 64; v[k] = src[ii < 508 * 64 ? ii : i]; }
#pragma unroll
                            for (int k = 0; k < 8; ++k) { const int ii = i + k * NWAVES * 64; if (ii < 508 * 64) dst[ii] = v[k]; } }
                        continue; }
                    if (u >= 800) { int v = u - 800; if (v < XP) u = 32 + (v & 511); else { v -= XP; if (v < XS) u = 544 + (v & 255); else u = (v - XS) & 31; } }
                    int tq = TID_NOW(); asm volatile("" : "+v"(tq));
                    if (u < 32) gdn_scan3_block(SG, lds, u, tq);
                    else if (u < 32 + 512) nsa_prompt_unit(AA, lds, u - 32, tq);
                    else nsa_sample_unit(SA, lds, u - 544, tq);
                }
            }
        }
        GRID_BAR(pb + 3);
        if (IN(pb + 4)) { PHASE_IDS
            const float gnl = gdn_norm[l * 64 + lane];
            for (int rep = 0; rep < REP_LIGHT; ++rep) for (int m = gw; m < MP; m += NGW) {
                float ov[8], zv[8];
#pragma unroll
                for (int h = 0; h < 8; ++h) { ov[h] = OG[(size_t)m * 512 + h * 64 + lane]; zv[h] = PROJ[(size_t)m * NP + C_Z + h * 64 + lane]; }
                __builtin_amdgcn_sched_barrier(0);
#pragma unroll
                for (int h = 0; h < 8; ++h) { const float ms = dpp_sum(ov[h] * ov[h]) * (1.f / 64.f);
                    MIX[(size_t)m * 1024 + h * 64 + lane] = (bf16)f2bf(ov[h] * (1.f / sqrtf(ms + 1e-6f)) * gnl * siluf_(zv[h])); } }
        }
        GRID_BAR(pb + 4);
        if (IN(pb + 5)) { PHASE_IDS
            { pg8::Gemm g{MIX, WOUT_T + (size_t)l * DM * DM, MP, DM, DM, DM}; pg8::StaticOrder S; S.init(MP, DM, G, bx);
              const float* rb = (l == 0) ? x_prompt : (const float*)X2;
              pg8::EpiResid E{rb, rb, MP, X1, DM};
              pg8::gemm_phase<pg8::EpiResid, pg8::StaticOrder, true, true>(ldsl, g, S, E, tid); }
            { pg8::Gemm g{MIX, WOUT_T + (size_t)l * DM * DM, MT, DM, PD_KL, DM}; pg8::SplitKOrder S; S.init(MP / 256, MS / 256, DM / 256, PD_KS, PD_KL, G, bx);
              pg8::EpiPart E{PARTD, DM, MP, MS};
              pg8::gemm_phase<pg8::EpiPart, pg8::SplitKOrder, false, true>(ldsl, g, S, E, tid); }
        }
        GRID_BAR(pb + 5);
        if (IN(pb + 6)) { PHASE_IDS
            for (int m = gw; m < MP; m += 2 * NGW) { const int m2 = m + NGW;
                if (m2 < MP) rms_row2(X1 + (size_t)m * DM, X1 + (size_t)m2 * DM, norm_mlp + (size_t)l * DM, HB + (size_t)m * DM, HB + (size_t)m2 * DM, nullptr, nullptr, lane);
                else rms_row(X1 + (size_t)m * DM, norm_mlp + (size_t)l * DM, HB + (size_t)m * DM, nullptr, lane); }
            for (int m = MP + gw; m < MT; m += NGW) { const float* bs = (l == 0) ? x_sample + (size_t)(m - MP) * DM : (const float*)X2 + (size_t)m * DM;
                rms_row_parts(bs, PARTD + (size_t)(m - MP) * DM, PD_KS, (size_t)MS * DM, X1 + (size_t)m * DM, norm_mlp + (size_t)l * DM, HB + (size_t)m * DM, nullptr, lane); } }
        GRID_BAR(pb + 6);
        if (IN(pb + 7)) { PHASE_IDS
            pg8::Gemm g{HB, WUP_T + (size_t)l * DFF * DM, MT, DFF, DM, DM}; pg8::StaticOrder S; S.init(MT, DFF, G, bx);
            pg8::EpiRelu2 E{HID, DFF};
            pg8::gemm_phase<pg8::EpiRelu2, pg8::StaticOrder, true, true>(ldsl, g, S, E, tid);
            if (l + 1 < NL && bx >= (MT / 256) * (DFF / 256) % G) { SUB_IDS CmpArgs CA{PROJ, cache_kv, page_table, cmp_pe_k, cmp_pe_v, CMPW, wsl, l + 1};
                compress_pull(CA, lds, (unsigned*)(wsl + WS_CTL) + CW_CMPQ + 64 * (l + 1), (volatile LAS int*)(ldsl + MISC_OFF + 36), 1, tid); }
        }
        GRID_BAR(pb + 7);
        if (IN(pb + 8)) { PHASE_IDS
            { pg8::Gemm g{HID, WDN_T + (size_t)l * DM * DFF, MP, DM, DFF, DFF}; pg8::StaticOrder S; S.init(MP, DM, G, bx);
              pg8::EpiResid E{X1, X1, MP, X2, DM};
              pg8::gemm_phase<pg8::EpiResid, pg8::StaticOrder, true, true>(ldsl, g, S, E, tid); }
            { pg8::Gemm g{HID, WDN_T + (size_t)l * DM * DFF, MT, DM, PG_KL, DFF}; pg8::SplitKOrder S; S.init(MP / 256, MS / 256, DM / 256, PG_KS, PG_KL, G, bx);
              pg8::EpiPart E{PARTG, DM, MP, MS};
              pg8::gemm_phase<pg8::EpiPart, pg8::SplitKOrder, false, true>(ldsl, g, S, E, tid); }
        }
        GRID_BAR(pb + 8);
        if (IN(pb + 9)) { PHASE_IDS
            const float* gn = (l + 1 < NL) ? norm_mix + (size_t)(l + 1) * DM : norm_final; const bool fin = !(l + 1 < NL);
            for (int m = gw; m < MP; m += 2 * NGW) { const int m2 = m + NGW;
                if (m2 < MP) rms_row2(X2 + (size_t)m * DM, X2 + (size_t)m2 * DM, gn, fin ? nullptr : HB + (size_t)m * DM, fin ? nullptr : HB + (size_t)m2 * DM, fin ? out + O_YP + (size_t)m * DM : nullptr, fin ? out + O_YP + (size_t)m2 * DM : nullptr, lane);
                else rms_row(X2 + (size_t)m * DM, gn, fin ? nullptr : HB + (size_t)m * DM, fin ? out + O_YP + (size_t)m * DM : nullptr, lane); }
            for (int m = MP + gw; m < MT; m += NGW)
                rms_row_parts(X1 + (size_t)m * DM, PARTG + (size_t)(m - MP) * DM, PG_KS, (size_t)MS * DM, X2 + (size_t)m * DM, gn, fin ? nullptr : HB + (size_t)m * DM, fin ? out + O_YP + (size_t)m * DM : nullptr, lane);
        }
        GRID_BAR(pb + 9);
    }
#undef IN
}

#undef x_prompt
#undef x_sample
#undef cache_kv
#undef page_table
#undef state_win
#undef state_gdn
#undef state_conv
#undef norm_mix
#undef w_in
#undef conv_w
#undef a_log
#undef dt_bias
#undef gdn_norm
#undef cmp_pe_k
#undef cmp_w_k
#undef cmp_pe_v
#undef cmp_w_v
#undef w_out
#undef norm_mlp
#undef w_up
#undef w_down
#undef norm_final
#undef out
#ifndef MK_PER_PHASE
#define MK_PER_PHASE 0
#endif
typedef void (*kfn_t)(Args); static const kfn_t K_ALL = hymba_fwd;
extern "C" void kernel_launch(void* const* d_in, const int* in_sizes, int n_in, void* d_out, int out_size, void* d_ws, size_t ws_size, hipStream_t stream) {
    static int grid = 0;
    if (grid == 0) {
        if (n_in != 22 || out_size != (int)O_END || ws_size < WS_END) { fprintf(stderr, "kernel_launch: unexpected shapes (n_in %d, out %d, ws %zu)\n", n_in, out_size, ws_size); grid = -1; return; }
        int dev = 0, cus = 0, per_cu = 0;
        if (hipGetDevice(&dev) != hipSuccess || hipDeviceGetAttribute(&cus, hipDeviceAttributeMultiprocessorCount, dev) != hipSuccess) { grid = -1; return; }
        if (hipFuncSetAttribute((const void*)K_ALL, hipFuncAttributeMaxDynamicSharedMemorySize, LDS_BYTES) != hipSuccess) { fprintf(stderr, "kernel_launch: hipFuncSetAttribute failed\n"); grid = -1; return; }
        if (hipOccupancyMaxActiveBlocksPerMultiprocessor(&per_cu, (const void*)K_ALL, NWAVES * 64, LDS_BYTES) != hipSuccess || per_cu < 1) { fprintf(stderr, "kernel_launch: occupancy query says %d blocks per CU\n", per_cu); }
        (void)hipGetLastError();
        grid = cus;
    }
    if (grid < 0) return;
    (void)hipMemsetAsync((char*)d_ws + WS_CTL, 0, CTL_ZERO_BYTES, stream);
    Args a{};
    for (int i = 0; i < 22; ++i) a.in[i] = (const GAS void*)d_in[i];
    a.out = (GAS float*)d_out; a.ws = (GAS unsigned char*)d_ws;
    const dim3 g(grid), b(NWAVES * 64);
#if MK_PER_PHASE
    for (int ph = 0; ph < N_PHASES; ++ph) { a.ph_lo = ph; a.ph_hi = ph + 1; K_ALL<<<g, b, LDS_BYTES, stream>>>(a); }
#else
    a.ph_lo = 0; a.ph_hi = N_PHASES; K_ALL<<<g, b, LDS_BYTES, stream>>>(a);
#endif
}
```

```cpp
#include <hip/hip_runtime.h>
#include <cstdio>
#include <cstdint>
namespace pg8 {
#define PG8_LAS __attribute__((address_space(3)))
typedef unsigned short bf16_t;
typedef short bf16x8 __attribute__((ext_vector_type(8)));
typedef float f32x4 __attribute__((ext_vector_type(4)));
typedef unsigned u32x4 __attribute__((ext_vector_type(4)));
constexpr int BM = 256, BK = 64, HALF = 128, HTB = HALF * BK * 2  , STAGE_BYTES = 8 * HTB, NXCD = 8, WGM = 8;

__host__ __device__ __forceinline__ int lds_byte(int r, int c) { const int st = (r >> 4) * 2 + (c >> 5), rr = r & 15, cc = c & 31, ob = rr * 64 + cc * 2; return st * 1024 + (ob ^ (((ob >> 9) & 1) << 5)); }
__host__ __device__ __forceinline__ void stage_rc(int b, int& R, int& C) { const int st = b / 1024, sb = b % 1024, swz = sb ^ (((sb >> 9) & 1) << 5); R = (st >> 1) * 16 + swz / 64; C = (st & 1) * 32 + (swz % 64) / 2; }
__host__ __device__ __forceinline__ int perm32(int rho) { const int n = rho >> 4, i = rho & 15; return 8 * (i >> 2) + 4 * n + (i & 3); }

struct Unit { int pm, pn, kofs, kc; };
struct Gemm { const bf16_t* A; const bf16_t* Bt; int M, N, K, ld; };

struct StaticOrder {
    int nM, nN, nwg, G, c;
    __host__ __device__ void init(int M, int N, int G_, int c_) { nM = M / BM; nN = N / BM; nwg = nM * nN; G = G_; c = c_; }
    __host__ __device__ bool next(int i, Unit& u) const {
        const long L = (long)i * G + c; if (L >= nwg) return false;
        int wgid = (int)L; { const int q = nwg / NXCD, r = nwg % NXCD, xcd = wgid % NXCD, off = wgid / NXCD; wgid = (xcd < r ? xcd * (q + 1) : r * (q + 1) + (xcd - r) * q) + off; }
        const int nig = WGM * nN, gid = wgid / nig, fm = gid * WGM, gsz = (nM - fm) < WGM ? (nM - fm) : WGM;
        u.pm = fm + ((wgid % nig) % gsz); u.pn = (wgid % nig) / gsz; u.kofs = 0; u.kc = 0; return true;
    }
    __device__ __forceinline__ void a_ready(const Unit&) const {}
    __device__ __forceinline__ void done(const Unit&) const {}
};

__device__ __forceinline__ unsigned cvt_pk_bf16(float lo, float hi) { unsigned r; asm volatile("v_cvt_pk_bf16_f32 %0, %1, %2" : "=v"(r) : "v"(lo), "v"(hi)); return r; }

struct EpiF32 {
    static constexpr bool PERM = false, AFTER_DRAIN = false;
    float* O; int ldc;
    __device__ __forceinline__ void operator()(const f32x4 (&acc)[2][2][4][2], const Unit& u, int wr, int wc, int fr, int fq) const {
        const int row0 = u.pm * BM + wr * 64 + fr, col0 = u.pn * BM + wc * 32 + 4 * fq;
#pragma unroll
        for (int ai = 0; ai < 2; ++ai)
#pragma unroll
            for (int m = 0; m < 4; ++m) { float* rowp = O + (size_t)(row0 + ai * HALF + m * 16) * ldc + col0;
#pragma unroll
                for (int bj = 0; bj < 2; ++bj)
#pragma unroll
                    for (int n = 0; n < 2; ++n) *(f32x4*)(rowp + bj * HALF + n * 16) = acc[ai][bj][m][n]; }
    }
};
struct EpiResid {
    static constexpr bool PERM = false, AFTER_DRAIN = false;
    const float* base; const float* base2; int split_row; float* O; int ldc;
    __device__ __forceinline__ void operator()(const f32x4 (&acc)[2][2][4][2], const Unit& u, int wr, int wc, int fr, int fq) const {
        const int row0 = u.pm * BM + wr * 64 + fr, col0 = u.pn * BM + wc * 32 + 4 * fq;
        const float* bs = (u.pm * BM >= split_row) ? (base2 - (size_t)split_row * ldc) : base;
#pragma unroll
        for (int ai = 0; ai < 2; ++ai)
#pragma unroll
            for (int m = 0; m < 4; ++m) { const size_t off = (size_t)(row0 + ai * HALF + m * 16) * ldc + col0;
#pragma unroll
                for (int bj = 0; bj < 2; ++bj)
#pragma unroll
                    for (int n = 0; n < 2; ++n) { const f32x4 r = *(const f32x4*)(bs + off + bj * HALF + n * 16); *(f32x4*)(O + off + bj * HALF + n * 16) = r + acc[ai][bj][m][n]; } }
    }
};
struct EpiRelu2 {
    static constexpr bool PERM = true, AFTER_DRAIN = false;
    bf16_t* O; int ldc;
    __device__ __forceinline__ void operator()(const f32x4 (&acc)[2][2][4][2], const Unit& u, int wr, int wc, int fr, int fq) const {
        const int row0 = u.pm * BM + wr * 64 + fr, col0 = u.pn * BM + wc * 32 + 8 * fq;
#pragma unroll
        for (int ai = 0; ai < 2; ++ai)
#pragma unroll
            for (int m = 0; m < 4; ++m) { bf16_t* rowp = O + (size_t)(row0 + ai * HALF + m * 16) * ldc + col0;
#pragma unroll
                for (int bj = 0; bj < 2; ++bj) { f32x4 v0 = acc[ai][bj][m][0], v1 = acc[ai][bj][m][1];
#pragma unroll
                    for (int i = 0; i < 4; ++i) { const float a = v0[i] > 0.f ? v0[i] : 0.f, b = v1[i] > 0.f ? v1[i] : 0.f; v0[i] = a * a; v1[i] = b * b; }
                    u32x4 w; w.x = cvt_pk_bf16(v0[0], v0[1]); w.y = cvt_pk_bf16(v0[2], v0[3]); w.z = cvt_pk_bf16(v1[0], v1[1]); w.w = cvt_pk_bf16(v1[2], v1[3]);
                    *(u32x4*)(rowp + bj * HALF) = w; } }
    }
};

struct SplitKOrder {
    int pm0, nN, KS, KL, total, G, c;
    __host__ __device__ void init(int pm0_, int nPm, int nN_, int KS_, int KL_, int G_, int c_) { pm0 = pm0_; nN = nN_; KS = KS_; KL = KL_; total = nPm * nN_ * KS_; G = G_; c = c_; }
    __host__ __device__ bool next(int i, Unit& u) const {
        const long L = (long)i * G + c; if (L >= total) return false;
        const int l = (int)L, kc = l % KS, rest = l / KS; u.pn = rest % nN; u.pm = pm0 + rest / nN; u.kofs = kc * KL; u.kc = kc; return true; }
    __device__ __forceinline__ void a_ready(const Unit&) const {}
    __device__ __forceinline__ void done(const Unit&) const {}
};
struct EpiPart {
    static constexpr bool PERM = false, AFTER_DRAIN = false;
    float* P; int ldc; int row0; int rows;
    __device__ __forceinline__ void operator()(const f32x4 (&acc)[2][2][4][2], const Unit& u, int wr, int wc, int fr, int fq) const {
        const int rowl = u.pm * BM - row0 + wr * 64 + fr, col0 = u.pn * BM + wc * 32 + 4 * fq;
        float* base = P + (size_t)u.kc * rows * ldc;
#pragma unroll
        for (int ai = 0; ai < 2; ++ai)
#pragma unroll
            for (int m = 0; m < 4; ++m) { float* rowp = base + (size_t)(rowl + ai * HALF + m * 16) * ldc + col0;
#pragma unroll
                for (int bj = 0; bj < 2; ++bj)
#pragma unroll
                    for (int n = 0; n < 2; ++n) *(f32x4*)(rowp + bj * HALF + n * 16) = acc[ai][bj][m][n]; }
    }
};
template <class Epi, class Sched, bool ALIGN_EPI = false, bool SP2 = false>
__device__ __forceinline__ void gemm_phase(PG8_LAS unsigned char* lds, const Gemm g, const Sched& S, const Epi& E, int tid_in) {
    int tid = tid_in; asm volatile("" : "+v"(tid));
    const int wid = __builtin_amdgcn_readfirstlane(tid >> 6), lane = tid & 63, wr = wid >> 2, wc = wid & 3, fr = lane & 15, fq = lane >> 4;
    const int K = g.ld, nt = g.K / BK;
    unsigned voffA[2], voffB[2];
#pragma unroll
    for (int i = 0; i < 2; ++i) { int R, C; stage_rc(tid * 16 + i * 8192, R, C); const int Rb = Epi::PERM ? ((R & ~31) + perm32(R & 31)) : R;
        voffA[i] = (unsigned)(R * K + C) * 2u; voffB[i] = (unsigned)(Rb * K + C) * 2u; }
    const size_t kstep = (size_t)(BK * 2);
    const size_t hstep = (size_t)HALF * K * 2;
    const size_t tstep = 2 * hstep;
    const unsigned ldsw = (unsigned)wid * 1024u;
    const int aoff = lds_byte(wr * 64 + fr, fq * 8), boff = lds_byte(wc * 32 + fr, fq * 8);
#define PG8_SA(b, h) (((b) * 2 + (h)) * HTB)
#define PG8_SB(b, h) ((4 + (b) * 2 + (h)) * HTB)
#define PG8_STAGE(bufoff, gbase, voff) do { _Pragma("unroll") for (int _i = 0; _i < 2; ++_i) \
        __builtin_amdgcn_global_load_lds((const unsigned*)((const char*)(gbase) + (voff)[_i]), (PG8_LAS unsigned*)(lds + (bufoff) + ldsw + _i * 8192), 16, 0, 0); } while (0)
#define PG8_LDA(dst, b, h) do { _Pragma("unroll") for (int m = 0; m < 4; ++m) _Pragma("unroll") for (int k = 0; k < 2; ++k) dst[m][k] = *(const PG8_LAS bf16x8*)(lds + PG8_SA(b, h) + aoff + m * 2048 + k * 1024); } while (0)
#define PG8_LDB(dst, b, h) do { _Pragma("unroll") for (int n = 0; n < 2; ++n) _Pragma("unroll") for (int k = 0; k < 2; ++k) dst[n][k] = *(const PG8_LAS bf16x8*)(lds + PG8_SB(b, h) + boff + n * 2048 + k * 1024); } while (0)
#define PG8_MMA(ai, bj, At, Bt) do { __builtin_amdgcn_s_setprio(1); _Pragma("unroll") for (int m = 0; m < 4; ++m) _Pragma("unroll") for (int n = 0; n < 2; ++n) _Pragma("unroll") for (int k = 0; k < 2; ++k) \
        acc[ai][bj][m][n] = __builtin_amdgcn_mfma_f32_16x16x32_bf16(Bt[n][k], At[m][k], acc[ai][bj][m][n], 0, 0, 0); __builtin_amdgcn_s_setprio(0); } while (0)
#define PG8_WAIT_V(n) asm volatile("s_waitcnt vmcnt(" #n ")" ::: "memory")
#define PG8_WAIT_L(n) asm volatile("s_waitcnt lgkmcnt(" #n ")" ::: "memory")
#define PG8_BAR __builtin_amdgcn_s_barrier()
#define PG8_SCHED __builtin_amdgcn_sched_barrier(0)
    Unit cur, nxt; int ui = 0;
    if (!S.next(0, cur)) return;
    f32x4 acc[2][2][4][2];
#pragma unroll
    for (int a = 0; a < 2; ++a)
#pragma unroll
        for (int b = 0; b < 2; ++b)
#pragma unroll
            for (int m = 0; m < 4; ++m)
#pragma unroll
                for (int n = 0; n < 2; ++n) acc[a][b][m][n] = (f32x4){0.f, 0.f, 0.f, 0.f};
    bf16x8 At[4][2], B0[2][2], B1[2][2];
    const char* cA = (const char*)g.A + (size_t)cur.pm * tstep + (size_t)cur.kofs * 2; const char* cB = (const char*)g.Bt + (size_t)cur.pn * tstep + (size_t)cur.kofs * 2;
    S.a_ready(cur);
    if constexpr (SP2) {
        PG8_STAGE(PG8_SB(0, 0), cB, voffB); PG8_STAGE(PG8_SB(0, 1), cB + hstep, voffB); PG8_STAGE(PG8_SA(0, 0), cA, voffA); PG8_STAGE(PG8_SA(0, 1), cA + hstep, voffA);
        if (wr == 1) PG8_BAR;
        PG8_WAIT_V(2); PG8_BAR;
        PG8_STAGE(PG8_SB(1, 0), cB + kstep, voffB); PG8_STAGE(PG8_SA(1, 0), cA + kstep, voffA); PG8_STAGE(PG8_SB(1, 1), cB + hstep + kstep, voffB);
        PG8_WAIT_V(6); PG8_BAR;
    } else {
        PG8_STAGE(PG8_SB(0, 0), cB, voffB); PG8_STAGE(PG8_SA(0, 0), cA, voffA); PG8_STAGE(PG8_SB(0, 1), cB + hstep, voffB); PG8_STAGE(PG8_SA(0, 1), cA + hstep, voffA);
        if (wr == 1) PG8_BAR;
        PG8_WAIT_V(4); PG8_BAR;
        PG8_STAGE(PG8_SB(1, 0), cB + kstep, voffB); PG8_STAGE(PG8_SA(1, 0), cA + kstep, voffA); PG8_STAGE(PG8_SB(1, 1), cB + hstep + kstep, voffB);
        PG8_WAIT_V(6); PG8_BAR;
    }
    for (;;) {
        const bool has_next = S.next(ui + 1, nxt);
        const char* nA = has_next ? (const char*)g.A + (size_t)nxt.pm * tstep + (size_t)nxt.kofs * 2 : cA; const char* nB = has_next ? (const char*)g.Bt + (size_t)nxt.pn * tstep + (size_t)nxt.kofs * 2 : cB;
        for (int t = 0; t < nt; t += 2) {
            const bool last = (t == nt - 2);
            const char* a1 = cA + (size_t)(t + 1) * kstep;
            const char* a2 = last ? nA : cA + (size_t)(t + 2) * kstep; const char* b2 = last ? nB : cB + (size_t)(t + 2) * kstep;
            const char* a3 = a2 + kstep; const char* b3 = b2 + kstep;
            if (last && has_next) S.a_ready(nxt);
            if constexpr (SP2) {
            PG8_LDB(B0, 0, 0); PG8_LDB(B1, 0, 1); PG8_SCHED; PG8_LDA(At, 0, 0); PG8_STAGE(PG8_SA(1, 1), a1 + hstep, voffA);
            PG8_WAIT_V(8); PG8_WAIT_L(0); PG8_BAR; PG8_MMA(0, 0, At, B0); PG8_MMA(0, 1, At, B1); PG8_BAR; PG8_SCHED;
            PG8_LDA(At, 0, 1); PG8_STAGE(PG8_SB(0, 0), b2, voffB); PG8_STAGE(PG8_SB(0, 1), b2 + hstep, voffB); PG8_STAGE(PG8_SA(0, 0), a2, voffA);
            PG8_WAIT_V(8); PG8_WAIT_L(0); PG8_BAR; PG8_MMA(1, 0, At, B0); PG8_MMA(1, 1, At, B1); PG8_BAR; PG8_SCHED;
            PG8_LDB(B0, 1, 0); PG8_LDB(B1, 1, 1); PG8_SCHED; PG8_LDA(At, 1, 0); PG8_STAGE(PG8_SA(0, 1), a2 + hstep, voffA);
            PG8_WAIT_V(8); PG8_WAIT_L(0); PG8_BAR; PG8_MMA(0, 0, At, B0); PG8_MMA(0, 1, At, B1); PG8_BAR; PG8_SCHED;
            PG8_LDA(At, 1, 1); PG8_STAGE(PG8_SB(1, 0), b3, voffB); PG8_STAGE(PG8_SB(1, 1), b3 + hstep, voffB); PG8_STAGE(PG8_SA(1, 0), a3, voffA);
            PG8_WAIT_V(8); PG8_WAIT_L(0); PG8_BAR; PG8_MMA(1, 0, At, B0); PG8_MMA(1, 1, At, B1); PG8_BAR; PG8_SCHED;
            } else {
            PG8_LDB(B0, 0, 0); PG8_SCHED; PG8_LDA(At, 0, 0); PG8_STAGE(PG8_SA(1, 1), a1 + hstep, voffA);
            PG8_WAIT_L(8); PG8_BAR; PG8_WAIT_L(0); PG8_MMA(0, 0, At, B0); PG8_BAR; PG8_SCHED;
            PG8_LDB(B1, 0, 1); PG8_STAGE(PG8_SB(0, 0), b2, voffB);
            PG8_BAR; PG8_WAIT_L(0); PG8_MMA(0, 1, At, B1); PG8_BAR;
            PG8_LDA(At, 0, 1); PG8_STAGE(PG8_SA(0, 0), a2, voffA);
            PG8_BAR; PG8_WAIT_L(0); PG8_MMA(1, 0, At, B0); PG8_BAR; PG8_SCHED;
            PG8_STAGE(PG8_SB(0, 1), b2 + hstep, voffB);
            PG8_WAIT_V(6); PG8_BAR; PG8_MMA(1, 1, At, B1); PG8_BAR;
            PG8_LDB(B0, 1, 0); PG8_SCHED; PG8_LDA(At, 1, 0); PG8_STAGE(PG8_SA(0, 1), a2 + hstep, voffA);
            PG8_WAIT_L(8); PG8_BAR; PG8_WAIT_L(0); PG8_MMA(0, 0, At, B0); PG8_BAR; PG8_SCHED;
            PG8_LDB(B1, 1, 1); PG8_STAGE(PG8_SB(1, 0), b3, voffB);
            PG8_BAR; PG8_WAIT_L(0); PG8_MMA(0, 1, At, B1); PG8_BAR;
            PG8_LDA(At, 1, 1); PG8_STAGE(PG8_SA(1, 0), a3, voffA);
            PG8_BAR; PG8_WAIT_L(0); PG8_MMA(1, 0, At, B0); PG8_BAR; PG8_SCHED;
            PG8_STAGE(PG8_SB(1, 1), b3 + hstep, voffB);
            PG8_WAIT_V(6); PG8_BAR; PG8_MMA(1, 1, At, B1); PG8_BAR;
            }
        }
        if constexpr (ALIGN_EPI) { if (wr == 0) PG8_BAR; }
        if constexpr (!Epi::AFTER_DRAIN) { E(acc, cur, wr, wc, fr, fq); S.done(cur); }
        if (!has_next) break;
#pragma unroll
        for (int a = 0; a < 2; ++a)
#pragma unroll
            for (int b = 0; b < 2; ++b)
#pragma unroll
                for (int m = 0; m < 4; ++m)
#pragma unroll
                    for (int n = 0; n < 2; ++n) acc[a][b][m][n] = (f32x4){0.f, 0.f, 0.f, 0.f};
        cur = nxt; cA = nA; cB = nB; ++ui;
        if constexpr (ALIGN_EPI) { if (wr == 1) PG8_BAR; }
    }
    PG8_WAIT_V(0);
    if constexpr (!ALIGN_EPI) { if (wr == 0) PG8_BAR; }
    PG8_BAR;
    if constexpr (Epi::AFTER_DRAIN) { E.fused(acc, cur, wr, wc, fr, fq, lds, wid, lane); S.done(cur); }
#undef PG8_SA
#undef PG8_SB
#undef PG8_STAGE
#undef PG8_LDA
#undef PG8_LDB
#undef PG8_MMA
#undef PG8_WAIT_V
#undef PG8_WAIT_L
#undef PG8_BAR
#undef PG8_SCHED
}
}

constexpr int DM = 1024, NPB = 4, SEQ = 4096, MP = NPB * SEQ, NSB = 128, DSEQ = 4, MS = NSB * DSEQ, MT = MP + MS;
constexpr int NPROJ = 3368, NP = 3584, DFF = 4096, NL = 2;
constexpr int C_QKV = 0, C_Z = 1536, C_A = 2048, C_BETA = 2056, C_Q = 2064, C_KV = 2576, C_GATE = 3344;
constexpr int PAST = 2048, NPAGES = 16, NPOOL = 2560;
constexpr float C2 = 0.125f * 1.4426950408889634f;
constexpr float NEG_INF = -__builtin_inff();
constexpr size_t O_YP = 0, O_YS = 16777216, O_KVP = 17301504, O_KVS = 34078720, O_WINP = 34603008, O_WINS = 35651584, O_GDNP = 69206016, O_GDNS = 69468160, O_CONVP = 77856768, O_CONVS = 77893632, O_END = 79073280;
constexpr size_t MiB = 1u << 20;
constexpr size_t WS_CTL = 0, CTL_ZERO_BYTES = 1 * MiB;
constexpr size_t WS_WIN = 2 * MiB, WS_WOUT = 16 * MiB, WS_WUP = 20 * MiB, WS_WDN = 36 * MiB, WS_CMPW = 52 * MiB;
constexpr size_t WS_HB = 54 * MiB, WS_PROJ = 88 * MiB, WS_X1 = 320 * MiB, WS_X2 = 386 * MiB, WS_MIX = 452 * MiB, WS_HID = 486 * MiB;
constexpr size_t WS_QN = 618 * MiB, WS_KN = 651 * MiB, WS_VG = 684 * MiB, WS_OG = 717 * MiB, WS_G = 750 * MiB, WS_BETA = 751 * MiB, WS_KQ = 752 * MiB;
constexpr size_t WS_QB = 753 * MiB, WS_KS = 770 * MiB, WS_VS = 775 * MiB, WS_KW = 780 * MiB, WS_VW = 785 * MiB;
constexpr size_t WS_CKP = 790 * MiB, WS_CVP = 791 * MiB, WS_CKS = 792 * MiB, WS_CVS = 796 * MiB;
constexpr size_t WS_GK = 800 * MiB, WS_GQ = 816 * MiB, WS_GKT = 832 * MiB, WS_GVT = 848 * MiB, WS_GG2 = 864 * MiB, WS_BETA2 = 865 * MiB;
constexpr size_t WS_WX = 866 * MiB, WS_QX = 882 * MiB, WS_QKX = 898 * MiB, WS_KTX = 914 * MiB, WS_U0F = 930 * MiB, WS_GL = 962 * MiB, WS_END = 1043 * MiB;
constexpr size_t WS_PARTD = 963 * MiB, WS_PARTG = 979 * MiB;
constexpr int PD_KS = 4, PD_KL = DM / PD_KS, PG_KS = 8, PG_KL = DFF / PG_KS;
constexpr int CW_QUEUE = 64;
constexpr int CW_BAR = 4096;
constexpr int RING_BYTES = 131072, LDS_BYTES = 147456, MISC_OFF = LDS_BYTES - 64;
constexpr int NWAVES = 8;

#define GAS __attribute__((address_space(1)))
#define LAS __attribute__((address_space(3)))
typedef unsigned short bf16;
typedef unsigned v4u __attribute__((ext_vector_type(4)));
typedef unsigned v2u __attribute__((ext_vector_type(2)));
typedef float f32x4 __attribute__((ext_vector_type(4)));
typedef float f32x16 __attribute__((ext_vector_type(16)));
typedef short bf16x8 __attribute__((ext_vector_type(8)));
typedef short s16x4 __attribute__((ext_vector_type(4)));
#define LDS_WAIT() asm volatile("s_waitcnt lgkmcnt(0)" ::: "memory")
__device__ __forceinline__ unsigned f2bf(float f) { unsigned u = __builtin_bit_cast(unsigned, f); return (u + 0x7fffu + ((u >> 16) & 1u)) >> 16; }
typedef float f32x2_t_ __attribute__((ext_vector_type(2))); typedef __bf16 bf16x2_t_ __attribute__((ext_vector_type(2)));
__device__ __forceinline__ unsigned pk2(float lo, float hi) { const f32x2_t_ v = {lo, hi}; const bf16x2_t_ b = __builtin_convertvector(v, bf16x2_t_); return __builtin_bit_cast(unsigned, b); }
__device__ __forceinline__ float bf2f(unsigned short b) { return __builtin_bit_cast(float, (unsigned)b << 16); }
__device__ __forceinline__ bf16x8 pack8(float a0, float a1, float a2, float a3, float a4, float a5, float a6, float a7) {
    v4u w; w.x = pk2(a0, a1); w.y = pk2(a2, a3); w.z = pk2(a4, a5); w.w = pk2(a6, a7); return __builtin_bit_cast(bf16x8, w); }
__device__ __forceinline__ float wave_sum(float v) {
#pragma unroll
    for (int o = 1; o < 64; o <<= 1) v += __shfl_xor(v, o);
    return v;
}
template <int CTRL, int RMASK> __device__ __forceinline__ float dpp_add(float v) {
    const int t = __builtin_amdgcn_update_dpp(0, __builtin_bit_cast(int, v), CTRL, RMASK, 0xf, false);
    return v + __builtin_bit_cast(float, t);
}
__device__ __forceinline__ float dpp_sum(float v) {
    v = dpp_add<0x111, 0xf>(v); v = dpp_add<0x112, 0xf>(v); v = dpp_add<0x114, 0xf>(v); v = dpp_add<0x118, 0xf>(v);
    v = dpp_add<0x142, 0xa>(v); v = dpp_add<0x143, 0xc>(v);
    return __builtin_bit_cast(float, __builtin_amdgcn_readlane(__builtin_bit_cast(int, v), 63));
}
__device__ __forceinline__ float ex2(float x) { return __builtin_amdgcn_exp2f(x); }
__device__ __forceinline__ float sigmoidf_(float x) { return 1.f / (1.f + __expf(-x)); }
__device__ __forceinline__ float siluf_(float x) { return x / (1.f + __expf(-x)); }
__device__ __forceinline__ int crow(int r, int hi) { return (r & 3) + 8 * (r >> 2) + 4 * hi; }
__device__ __forceinline__ void rope_cs(int pos, int d, float& cs, float& sn) {
    const float invf = exp2f(-(float)d * 0.4152410118609203f);
    double rv = (double)pos * (double)invf * 0.15915494309189535; rv -= floor(rv);
    const float rf = (float)rv; sn = __builtin_amdgcn_sinf(rf); cs = __builtin_amdgcn_cosf(rf);
}

#define XB_TMO      128
#define XB_XCNT(j)  (256  + 64 * (j))
#define XB_XSUB(j)  (1280 + 64 * (j))
#define XB_XGEN(j)  (2304 + 64 * (j))
#define XB_TOP      3328
#define XB_TOPGEN   3392
#define XCD_BAR_WORDS 3456
#define XB_SPIN_CAP (1u << 18)

__device__ __forceinline__ unsigned xb_ld(unsigned* p)              { return __hip_atomic_load(p, __ATOMIC_RELAXED, __HIP_MEMORY_SCOPE_AGENT); }
__device__ __forceinline__ unsigned xb_add(unsigned* p, unsigned v) { return __hip_atomic_fetch_add(p, v, __ATOMIC_RELAXED, __HIP_MEMORY_SCOPE_AGENT); }
__device__ __forceinline__ unsigned xb_xcc_id() { return (unsigned)__builtin_amdgcn_s_getreg((3 << 11) | 20) & 0xFu; }
#define XB_SPIN(cond, bar) do { unsigned _sp = 0; while (cond) { __builtin_amdgcn_s_sleep(1); \
    if ((++_sp & 255u) == 0u) { if (xb_ld(&(bar)[XB_TMO])) break; if (_sp > XB_SPIN_CAP) { atomicAdd(&(bar)[XB_TMO], 1u); break; } } } } while (0)

struct XcdBarrier {
    unsigned* bar; unsigned x;
    volatile LAS unsigned* st;
};

__device__ __forceinline__ XcdBarrier xcd_barrier_post(unsigned* bar, volatile LAS unsigned* st, bool leader) {
    XcdBarrier b; b.bar = bar; b.x = xb_xcc_id(); b.st = st;
    if (leader) (void)xb_add(&bar[XB_XCNT(b.x)], 1u);
    return b;
}
__device__ __forceinline__ void xcd_barrier_complete(unsigned* bar, unsigned x, unsigned& nloc, unsigned& nx) {
    const unsigned G = gridDim.x * gridDim.y * gridDim.z;
    unsigned sum, cnt, mine, sp = 0u;
    for (;;) {
        sum = 0u; cnt = 0u; mine = 0u;
#pragma unroll
        for (unsigned j = 0; j < 16; ++j) { const unsigned c = xb_ld(&bar[XB_XCNT(j)]); sum += c; cnt += (c > 0u) ? 1u : 0u; mine = (j == x) ? c : mine; }
        if (sum == G) break;
        __builtin_amdgcn_s_sleep(1);
        if ((++sp & 255u) == 0u) { if (xb_ld(&bar[XB_TMO])) break; if (sp > XB_SPIN_CAP) { atomicAdd(&bar[XB_TMO], 1u); break; } }
    }
    nloc = mine > 0u ? mine : 1u; nx = cnt > 0u ? cnt : 1u;
}

__device__ __forceinline__ void xcd_barrier(const XcdBarrier& b, bool leader) {
    asm volatile("s_waitcnt vmcnt(0)" ::: "memory");
    __syncthreads();
    if (leader) {
        unsigned* bar = b.bar;
        __builtin_amdgcn_s_waitcnt(0);
        unsigned nloc = b.st[0], nx = b.st[1];
        if (nloc == 0u) { xcd_barrier_complete(bar, b.x, nloc, nx); b.st[0] = nloc; b.st[1] = nx; }
        const unsigned old = xb_add(&bar[XB_XSUB(b.x)], 1u);
        const unsigned gen = old / nloc;
        if (old + 1u == (gen + 1u) * nloc) {
            __builtin_amdgcn_fence(__ATOMIC_RELEASE, "agent");
            asm volatile("s_waitcnt vmcnt(0)" ::: "memory");
            const unsigned og = xb_add(&bar[XB_TOP], 1u);
            const unsigned tg = og / nx;
            if (og + 1u == (tg + 1u) * nx) xb_add(&bar[XB_TOPGEN], 1u);
            else XB_SPIN(xb_ld(&bar[XB_TOPGEN]) == tg, bar);
            __builtin_amdgcn_fence(__ATOMIC_ACQUIRE, "agent");
            xb_add(&bar[XB_XGEN(b.x)], 1u);
            asm volatile("s_waitcnt vmcnt(0)" ::: "memory");
        } else {
            XB_SPIN(xb_ld(&bar[XB_XGEN(b.x)]) == gen, bar);
            __builtin_amdgcn_fence(__ATOMIC_ACQUIRE, "agent");
            asm volatile("s_waitcnt vmcnt(0)" ::: "memory");
        }
    }
    __syncthreads();
}

__device__ __forceinline__ void transpose_item(const float* W, int K, int N, int Npad, bf16* WT, LAS float* scr, int item, int lane) {
    const int nblk = Npad / 32, kb = item / nblk, nb = item % nblk, k0 = 64 * kb, n0 = 32 * nb;
    const int ncol = n0 + (lane & 31);
    float wv_[32];
#pragma unroll
    for (int i = 0; i < 32; ++i) { const int kk = 2 * i + (lane >> 5); wv_[i] = (ncol < N) ? W[(size_t)(k0 + kk) * N + ncol] : 0.f; }
    __builtin_amdgcn_sched_barrier(0);
#pragma unroll
    for (int i = 0; i < 32; ++i) { const int kk = 2 * i + (lane >> 5); scr[kk * 33 + (lane & 31)] = wv_[i]; }
    LDS_WAIT(); asm volatile("" ::: "memory");
    const int c = lane & 7;
#pragma unroll
    for (int j = 0; j < 4; ++j) { const int n = (lane >> 3) + 8 * j; const LAS float* s = scr + (8 * c) * 33 + n;
        v4u o; o.x = pk2(s[0 * 33], s[1 * 33]); o.y = pk2(s[2 * 33], s[3 * 33]); o.z = pk2(s[4 * 33], s[5 * 33]); o.w = pk2(s[6 * 33], s[7 * 33]);
        *(v4u*)(WT + (size_t)(n0 + n) * K + k0 + 8 * c) = o; }
    LDS_WAIT(); asm volatile("" ::: "memory");
}
__device__ __forceinline__ void rms_row(const float* xrow, const float* g, bf16* orow, float* of32, int lane) {
    const f32x4* xr = (const f32x4*)xrow + lane;
    f32x4 v[4]; float s = 0.f;
#pragma unroll
    for (int j = 0; j < 4; ++j) { v[j] = xr[64 * j]; s += (v[j].x * v[j].x + v[j].y * v[j].y) + (v[j].z * v[j].z + v[j].w * v[j].w); }
    const float rstd = 1.f / sqrtf(wave_sum(s) * (1.f / DM) + 1e-6f);
#pragma unroll
    for (int j = 0; j < 4; ++j) { const f32x4 gg = ((const f32x4*)g)[64 * j + lane]; const f32x4 o = v[j] * rstd * gg;
        if (of32) ((f32x4*)of32)[64 * j + lane] = o;
        else ((v2u*)orow)[64 * j + lane] = (v2u){pk2(o.x, o.y), pk2(o.z, o.w)}; }
}

__device__ __forceinline__ void rms_row2(const float* xa, const float* xb, const float* g, bf16* oa, bf16* ob, float* fa, float* fb, int lane) {
    f32x4 va[4], vb[4];
#pragma unroll
    for (int j = 0; j < 4; ++j) { va[j] = ((const f32x4*)xa)[64 * j + lane]; vb[j] = ((const f32x4*)xb)[64 * j + lane]; }
    __builtin_amdgcn_sched_barrier(0);
    float sa = 0.f, sb = 0.f;
#pragma unroll
    for (int j = 0; j < 4; ++j) { sa += (va[j].x * va[j].x + va[j].y * va[j].y) + (va[j].z * va[j].z + va[j].w * va[j].w); sb += (vb[j].x * vb[j].x + vb[j].y * vb[j].y) + (vb[j].z * vb[j].z + vb[j].w * vb[j].w); }
    const float ra = 1.f / sqrtf(wave_sum(sa) * (1.f / DM) + 1e-6f), rb = 1.f / sqrtf(wave_sum(sb) * (1.f / DM) + 1e-6f);
#pragma unroll
    for (int j = 0; j < 4; ++j) { const f32x4 gg = ((const f32x4*)g)[64 * j + lane]; const f32x4 o1 = va[j] * ra * gg, o2 = vb[j] * rb * gg;
        if (fa) { ((f32x4*)fa)[64 * j + lane] = o1; ((f32x4*)fb)[64 * j + lane] = o2; }
        else { ((v2u*)oa)[64 * j + lane] = (v2u){pk2(o1.x, o1.y), pk2(o1.z, o1.w)}; ((v2u*)ob)[64 * j + lane] = (v2u){pk2(o2.x, o2.y), pk2(o2.z, o2.w)}; } }
}
__device__ __forceinline__ void rms_row_parts(const float* base, const float* parts, int nparts, size_t part_stride, float* xout, const float* g, bf16* orow, float* of32, int lane) {
    f32x4 v[4]; float s = 0.f;
#pragma unroll
    for (int j = 0; j < 4; ++j) v[j] = ((const f32x4*)base)[64 * j + lane];
    for (int p = 0; p < nparts; ++p) { const f32x4* pr = (const f32x4*)(parts + (size_t)p * part_stride) + lane;
#pragma unroll
        for (int j = 0; j < 4; ++j) v[j] += pr[64 * j]; }
#pragma unroll
    for (int j = 0; j < 4; ++j) { if (xout) ((f32x4*)xout)[64 * j + lane] = v[j]; s += (v[j].x * v[j].x + v[j].y * v[j].y) + (v[j].z * v[j].z + v[j].w * v[j].w); }
    const float rstd = 1.f / sqrtf(wave_sum(s) * (1.f / DM) + 1e-6f);
#pragma unroll
    for (int j = 0; j < 4; ++j) { const f32x4 gg = ((const f32x4*)g)[64 * j + lane]; const f32x4 o = v[j] * rstd * gg;
        if (of32) ((f32x4*)of32)[64 * j + lane] = o;
        else ((v2u*)orow)[64 * j + lane] = (v2u){pk2(o.x, o.y), pk2(o.z, o.w)}; }
}

struct PBArgs { const float* PROJ; const float* state_conv; const float* conv_w; const float* a_log; const float* dt_bias;
    float* QN; float* KN; float* VG; float* G; float* BETA; float* KQ; bf16* QB; bf16* KS; bf16* VS; bf16* KW; bf16* VW; float* out; int l; };
struct PBRegs { float qs_[8], qo_[8], kvs_[12], kvo_[12]; };
__device__ __forceinline__ void pb_row_load(const PBArgs& A, int m, int lane, PBRegs& R) {
    const float* pr = A.PROJ + (size_t)m * NP;
#pragma unroll
    for (int h = 0; h < 8; ++h) { R.qs_[h] = pr[C_Q + h * 64 + lane]; R.qo_[h] = pr[C_Q + h * 64 + (lane ^ 32)]; }
#pragma unroll
    for (int i = 0; i < 12; ++i) { R.kvs_[i] = pr[C_KV + i * 64 + lane]; R.kvo_[i] = pr[C_KV + i * 64 + (lane ^ 32)]; }
}
__device__ __forceinline__ void pb_row(const PBArgs& A, int m, int lane, const PBRegs& R) {
    const bool is_s = m >= MP; int b, t;
    if (!is_s) { b = m >> 12; t = m & 4095; } else { b = (m - MP) >> 2; t = (m - MP) & 3; }
    const int pos = is_s ? PAST + t : t, l = A.l;
    const float* pr = A.PROJ + (size_t)m * NP;
    const float* cw = A.conv_w + (size_t)l * 4 * 1536;
    const float* cb = A.state_conv + ((size_t)l * NSB + b) * 3 * 1536;
    if (!is_s && t >= SEQ - 3) { float* o = A.out + O_CONVP + ((size_t)(l * NPB + b) * 3 + (t - (SEQ - 3))) * 1536;
#pragma unroll 4
        for (int j = 0; j < 24; ++j) o[64 * j + lane] = pr[64 * j + lane]; }
    if (is_s && t >= 1) { float* o = A.out + O_CONVS + ((size_t)(l * NSB + b) * 3 + (t - 1)) * 1536;
#pragma unroll 4
        for (int j = 0; j < 24; ++j) o[64 * j + lane] = pr[64 * j + lane]; }
    const int half = lane >> 5; float cs, sn; rope_cs(pos, lane & 31, cs, sn);
    const float (&qs_)[8] = R.qs_; const float (&qo_)[8] = R.qo_; const float (&kvs_)[12] = R.kvs_; const float (&kvo_)[12] = R.kvo_;
#pragma unroll
    for (int h = 0; h < 8; ++h) { const float xs = qs_[h], xo = qo_[h];
        const float r = half ? (xs * cs + xo * sn) : (xs * cs - xo * sn);
        A.QB[(size_t)m * 512 + h * 64 + lane] = (bf16)f2bf(r * C2); }
#pragma unroll
    for (int s6 = 0; s6 < 6; ++s6)
#pragma unroll
        for (int kvh = 0; kvh < 2; ++kvh) {
            float v = kvs_[s6 * 2 + kvh];
            if (s6 == 2 || s6 == 4) { const float xo = kvo_[s6 * 2 + kvh]; v = half ? (v * cs + xo * sn) : (v * cs - xo * sn); }
            if (s6 < 4) {
                if (!is_s) A.out[O_KVP + ((((size_t)(l * NPB + b) * 2 + kvh) * SEQ + t) * 4 + s6) * 64 + lane] = v;
                else       A.out[O_KVS + ((((size_t)(l * NSB + b) * 2 + kvh) * DSEQ + t) * 4 + s6) * 64 + lane] = v;
            } else {
                const int idx = s6 - 4;
                if (!is_s) { if (t >= SEQ - 512) A.out[O_WINP + ((((size_t)(l * NPB + b) * 512 + (t - (SEQ - 512))) * 2 + idx) * 2 + kvh) * 64 + lane] = v; }
                else A.out[O_WINS + ((((size_t)(l * NSB + b) * 512 + (508 + t)) * 2 + idx) * 2 + kvh) * 64 + lane] = v;
            }
            const bf16 bv = (bf16)f2bf(v);
            if (s6 == 2) A.KS[(size_t)m * 128 + kvh * 64 + lane] = bv;
            if (s6 == 3) A.VS[(size_t)m * 128 + kvh * 64 + lane] = bv;
            if (s6 == 4) A.KW[(size_t)m * 128 + kvh * 64 + lane] = bv;
            if (s6 == 5) A.VW[(size_t)m * 128 + kvh * 64 + lane] = bv;
        }
}

__device__ __forceinline__ void pb_sample_head(const PBArgs& A, int u, int lane) {
    const int m = MP + (u >> 3), h = u & 7, b = (m - MP) >> 2, t = (m - MP) & 3, l = A.l;
    const float* pr = A.PROJ + (size_t)m * NP;
    const float* cw = A.conv_w + (size_t)l * 4 * 1536;
    const float* cb = A.state_conv + ((size_t)l * NSB + b) * 3 * 1536;
    float xv[3][4], wv[3][4];
#pragma unroll
    for (int part = 0; part < 3; ++part) { const int c = (part * 8 + h) * 64 + lane;
#pragma unroll
        for (int tap = 0; tap < 4; ++tap) { const int idx = t + tap;
            xv[part][tap] = (idx >= 3) ? A.PROJ[(size_t)(m - t + idx - 3) * NP + c] : cb[idx * 1536 + c];
            wv[part][tap] = cw[tap * 1536 + c]; } }
    __builtin_amdgcn_sched_barrier(0);
    float qkv[3];
#pragma unroll
    for (int part = 0; part < 3; ++part) qkv[part] = siluf_((xv[part][0] * wv[part][0] + xv[part][1] * wv[part][1]) + (xv[part][2] * wv[part][2] + xv[part][3] * wv[part][3]));
    const float q = qkv[0], k = qkv[1];
    const float qs = dpp_sum(q * q), ks = dpp_sum(k * k);
    const float qn = q * (1.f / sqrtf(qs + 1e-6f)) * 0.125f, kn = k * (1.f / sqrtf(ks + 1e-6f));
    const float kq = dpp_sum(qn * kn);
    A.QN[(size_t)m * 512 + h * 64 + lane] = qn; A.KN[(size_t)m * 512 + h * 64 + lane] = kn; A.VG[(size_t)m * 512 + h * 64 + lane] = qkv[2];
    if (lane == 0) A.KQ[(size_t)m * 8 + h] = kq;
    if (h == 0 && lane < 8) {
        const float a = pr[C_A + lane] + A.dt_bias[l * 8 + lane];
        const float sp = fmaxf(a, 0.f) + log1pf(__expf(-fabsf(a)));
        A.G[(size_t)m * 8 + lane] = -__expf(A.a_log[l * 8 + lane]) * sp;
        A.BETA[(size_t)m * 8 + lane] = sigmoidf_(pr[C_BETA + lane]); }
}

struct CmpArgs { const float* PROJ; const float* cache; const int* page_table; const float* pe_k; const float* pe_v; const bf16* CMPW; unsigned char* ws; int l; };
__device__ __forceinline__ void compress_batch(const CmpArgs& A, unsigned char* lds, int batch, bool is_s, int tid) {
    const int lane = tid & 63, wave = __builtin_amdgcn_readfirstlane(tid >> 6), fr = lane & 15, fq = lane >> 4, l = A.l;
    const int kv = batch & 1, ru = (batch >> 1) * 8 + wave;
    const int rho = 16 * ru + fr, NC = is_s ? 64 : 128;
    const int seq = rho / (2 * NC), n = (rho >> 1) % NC, kvh = rho & 1;
    const float* abase; size_t astride;
    if (!is_s) { abase = A.PROJ + (size_t)(seq * SEQ + 32 * n) * NP + C_KV + kv * 128 + kvh * 64; astride = NP; }
    else { const int page = A.page_table[seq * NPAGES + (n >> 2)];
        abase = A.cache + ((((size_t)l * NPOOL + page) * 2 + kvh) * 128 + (n & 3) * 32) * 256 + kv * 64; astride = 256; }
    const float* pe = (kv ? A.pe_v : A.pe_k) + (size_t)l * 2048;
    const bf16* Wt = A.CMPW + (size_t)((l * 2 + kv) * 64) * 2048;
    const int we = tid >> 3, wch = tid & 7;
    f32x4 acc[4];
#pragma unroll
    for (int et = 0; et < 4; ++et) acc[et] = (f32x4){0.f, 0.f, 0.f, 0.f};
    f32x4 sa[2][4], sp[2][4]; v4u wreg;
#define CB_LOADA(S, c) do { _Pragma("unroll") for (int ks = 0; ks < 2; ++ks) { const float* ap = abase + (size_t)(c) * astride + 32 * ks + 8 * fq; const float* pp = pe + (c) * 64 + 32 * ks + 8 * fq; \
        sa[S][2 * ks] = *(const f32x4*)ap; sa[S][2 * ks + 1] = *(const f32x4*)(ap + 4); sp[S][2 * ks] = *(const f32x4*)pp; sp[S][2 * ks + 1] = *(const f32x4*)(pp + 4); } } while (0)
#define CB_LOADW(c) do { wreg = *(const v4u*)(Wt + (size_t)we * 2048 + ((c) < 31 ? (c) : 31) * 64 + wch * 8); } while (0)
#define CB_STOREW(bufi) do { *(v4u*)(lds + (bufi) * 9216 + we * 144 + wch * 16) = wreg; } while (0)
#define CB_MMA(S, bufi) do { _Pragma("unroll") for (int ks = 0; ks < 2; ++ks) { const f32x4 a0 = sa[S][2 * ks] + sp[S][2 * ks], a1 = sa[S][2 * ks + 1] + sp[S][2 * ks + 1]; \
        const bf16x8 ya = pack8(a0.x, a0.y, a0.z, a0.w, a1.x, a1.y, a1.z, a1.w); \
        _Pragma("unroll") for (int et = 0; et < 4; ++et) { const bf16x8 wf_ = *(const bf16x8*)(lds + (bufi) * 9216 + (16 * et + fr) * 144 + (32 * ks + 8 * fq) * 2); \
            acc[et] = __builtin_amdgcn_mfma_f32_16x16x32_bf16(wf_, ya, acc[et], 0, 0, 0); } } } while (0)
    __syncthreads();
    CB_LOADW(0); CB_LOADA(0, 0);
    CB_STOREW(0); CB_LOADW(1);
    __syncthreads();
#pragma unroll 1
    for (int c = 0; c < 32; c += 2) {
        CB_STOREW(1); __builtin_amdgcn_sched_barrier(0); CB_LOADW(c + 2); CB_LOADA(1, c + 1); __builtin_amdgcn_sched_barrier(0);
        CB_MMA(0, 0); __builtin_amdgcn_sched_barrier(0);
        __syncthreads();
        CB_STOREW(0); __builtin_amdgcn_sched_barrier(0); CB_LOADW(c + 3); if (c + 2 < 32) { CB_LOADA(0, c + 2); } __builtin_amdgcn_sched_barrier(0);
        CB_MMA(1, 1); __builtin_amdgcn_sched_barrier(0);
        __syncthreads();
    }
#undef CB_LOADA
#undef CB_LOADW
#undef CB_STOREW
#undef CB_MMA
    if (kv == 0) { const int pos = 32 * n + 31;
#pragma unroll
        for (int et = 0; et < 2; ++et)
#pragma unroll
            for (int i = 0; i < 4; ++i) { float cs, sn; rope_cs(pos, 16 * et + 4 * fq + i, cs, sn);
                const float x1 = acc[et][i], x2 = acc[et + 2][i]; acc[et][i] = x1 * cs - x2 * sn; acc[et + 2][i] = x2 * cs + x1 * sn; } }
    float* ob = (float*)(A.ws + (is_s ? WS_CKS : WS_CKP) + (size_t)kv * (is_s ? (WS_CVS - WS_CKS) : (WS_CVP - WS_CKP))) + (size_t)rho * 64 + 4 * fq;
#pragma unroll
    for (int et = 0; et < 4; ++et) *(f32x4*)(ob + 16 * et) = acc[et];
}

struct GdnArgs { const float* QN; const float* KN; const float* VG; const float* G; const float* BETA; const float* KQ; float* OG; const float* PROJ; const float* state_gdn; const float* gdn_norm; bf16* MIX; float* out; int l; };
__device__ __forceinline__ void gdn_sample_unit(const GdnArgs& A, int unit, int lane) {
    const int sb = unit >> 3, h = unit & 7, l = A.l;
    const float* sp = A.state_gdn + (((size_t)l * NSB + sb) * 8 + h) * 4096;
    float S[64];
#pragma unroll
    for (int d = 0; d < 64; ++d) S[d] = sp[d * 64 + lane];
    const float gn = A.gdn_norm[l * 64 + lane];
    for (int i = 0; i < DSEQ; ++i) {
        const size_t m = (size_t)MP + sb * 4 + i;
        const float kd = A.KN[m * 512 + h * 64 + lane], qd = A.QN[m * 512 + h * 64 + lane], v = A.VG[m * 512 + h * 64 + lane];
        const float g = A.G[m * 8 + h], beta = A.BETA[m * 8 + h], kq = A.KQ[m * 8 + h];
        const int kdb = __builtin_bit_cast(int, kd), qdb = __builtin_bit_cast(int, qd);
        const float a = __expf(g); float r1 = 0.f, r2 = 0.f;
#pragma unroll
        for (int d = 0; d < 64; ++d) { const float kk = __builtin_bit_cast(float, __builtin_amdgcn_readlane(kdb, d)), qq = __builtin_bit_cast(float, __builtin_amdgcn_readlane(qdb, d)); r1 += S[d] * kk; r2 += S[d] * qq; }
        const float u = beta * (v - a * r1), o = a * r2 + u * kq;
#pragma unroll
        for (int d = 0; d < 64; ++d) { const float kk = __builtin_bit_cast(float, __builtin_amdgcn_readlane(kdb, d)); S[d] = a * S[d] + kk * u; }
        const float ms = wave_sum(o * o) * (1.f / 64.f);
        const float z = A.PROJ[m * NP + C_Z + h * 64 + lane];
        A.MIX[m * 1024 + h * 64 + lane] = (bf16)f2bf(o * (1.f / sqrtf(ms + 1e-6f)) * gn * siluf_(z));
    }
    float* so = A.out + O_GDNS + (((size_t)l * NSB + sb) * 8 + h) * 4096;
#pragma unroll
    for (int d = 0; d < 64; ++d) so[d * 64 + lane] = S[d];
}


__device__ __forceinline__ int perm_inv32(int p) { return (p & 32) + 16 * ((p >> 2) & 1) + 4 * ((p >> 3) & 3) + (p & 3); }
struct GPArgs { const float* PROJ; const float* conv_w; const float* a_log; const float* dt_bias; bf16* GK; bf16* GQ; bf16* GKT; bf16* GVT; float* GG2; float* BETA2; int l; };
struct GPRegs { float xx[3][11], ww[3][4]; };
__device__ __forceinline__ void gdn_prep_load(const GPArgs& A, int unit, int lane, GPRegs& R) {
    const int tg = unit >> 3, h = unit & 7, m0 = tg * 8, t0 = m0 & 4095;
    const float* cw = A.conv_w + (size_t)A.l * 4 * 1536;
#pragma unroll
    for (int part = 0; part < 3; ++part) { const int c = (part * 8 + h) * 64 + lane;
#pragma unroll
        for (int j = 0; j < 11; ++j) R.xx[part][j] = (t0 - 3 + j >= 0) ? A.PROJ[(size_t)(m0 - 3 + j) * NP + c] : 0.f;
#pragma unroll
        for (int k = 0; k < 4; ++k) R.ww[part][k] = cw[k * 1536 + c]; }
}
__device__ __forceinline__ void gdn_prep_unit(const GPArgs& A, int unit, int lane, const GPRegs& R) {
    const int tg = unit >> 3, h = unit & 7, m0 = tg * 8, b = m0 >> 12, t0 = m0 & 4095, l = A.l, bh = b * 8 + h;
    const float* cw = A.conv_w + (size_t)l * 4 * 1536;
    float val[3][8]; const float (&xx)[3][11] = R.xx; const float (&ww)[3][4] = R.ww;
#pragma unroll
    for (int part = 0; part < 3; ++part)
#pragma unroll
        for (int i = 0; i < 8; ++i) val[part][i] = siluf_(ww[part][0] * xx[part][i] + ww[part][1] * xx[part][i + 1] + ww[part][2] * xx[part][i + 2] + ww[part][3] * xx[part][i + 3]);
#pragma unroll
    for (int i = 0; i < 8; ++i) { const float q = val[0][i], k = val[1][i];
        const float qs = dpp_sum(q * q), ks = dpp_sum(k * k);
        val[0][i] = q * (1.f / sqrtf(qs + 1e-6f)) * 0.125f; val[1][i] = k * (1.f / sqrtf(ks + 1e-6f)); }
#pragma unroll
    for (int i = 0; i < 8; ++i) { A.GQ[((size_t)bh * 4096 + t0 + i) * 64 + lane] = (bf16)f2bf(val[0][i]); A.GK[((size_t)bh * 4096 + t0 + i) * 64 + lane] = (bf16)f2bf(val[1][i]); }
    *(v4u*)(A.GKT + ((size_t)bh * 64 + lane) * 4096 + t0) = (v4u){pk2(val[1][0], val[1][1]), pk2(val[1][2], val[1][3]), pk2(val[1][4], val[1][5]), pk2(val[1][6], val[1][7])};
    *(v4u*)(A.GVT + ((size_t)bh * 64 + lane) * 4096 + t0) = (v4u){pk2(val[2][0], val[2][1]), pk2(val[2][2], val[2][3]), pk2(val[2][4], val[2][5]), pk2(val[2][6], val[2][7])};
    if (lane < 8) { const float* pr = A.PROJ + (size_t)(m0 + lane) * NP;
        const float a = pr[C_A + h] + A.dt_bias[l * 8 + h];
        const float sp = fmaxf(a, 0.f) + log1pf(__expf(-fabsf(a)));
        A.GG2[(size_t)bh * 4096 + t0 + lane] = -__expf(A.a_log[l * 8 + h]) * sp;
        A.BETA2[(size_t)bh * 4096 + t0 + lane] = sigmoidf_(pr[C_BETA + h]); }
}
template <int I> __device__ __forceinline__ void fsub_row(float (&T)[64], const float* AL, int lane) {
    float tv = (lane == I) ? 1.f : 0.f;
#pragma unroll
    for (int j4 = 0; j4 < (I + 3) / 4; ++j4) { const f32x4 a = *(const f32x4*)(AL + I * 64 + 4 * j4);
#pragma unroll
        for (int e = 0; e < 4; ++e) if (4 * j4 + e < I) tv -= a[e] * T[4 * j4 + e]; }
    T[I] = tv;
}
template <int I> struct FSub { static __device__ __forceinline__ void run(float (&T)[64], const float* AL, int lane) { FSub<I - 1>::run(T, AL, lane); fsub_row<I>(T, AL, lane); } };
template <> struct FSub<-1> { static __device__ __forceinline__ void run(float (&)[64], const float*, int) {} };
struct GCArgs { const bf16* GK; const bf16* GQ; const bf16* GKT; const bf16* GVT; const float* GG2; const float* BETA2; bf16* WX; bf16* QX; bf16* QKX; bf16* KTX; float* U0F; float* GL; };
constexpr int GC_LDS_PER_WAVE = 17664;
__device__ __forceinline__ void gdn_chunk_unit(const GCArgs& A, unsigned char* wl, int unit, int lane_) {
    int lane = lane_; asm volatile("" : "+v"(lane));
    const int bh = unit >> 6, n = unit & 63, t0 = 64 * n, fr = lane & 15, fq = lane >> 4;
    float* AL = (float*)wl; float* SC = (float*)(wl + 16384);
    {   const float g = A.GG2[(size_t)bh * 4096 + t0 + lane], beta = A.BETA2[(size_t)bh * 4096 + t0 + lane];
        float gc = g;
        gc = dpp_add<0x111, 0xf>(gc); gc = dpp_add<0x112, 0xf>(gc); gc = dpp_add<0x114, 0xf>(gc); gc = dpp_add<0x118, 0xf>(gc); gc = dpp_add<0x142, 0xa>(gc); gc = dpp_add<0x143, 0xc>(gc);
        const float glast = __builtin_bit_cast(float, __builtin_amdgcn_readlane(__builtin_bit_cast(int, gc), 63));
        const float eg = __expf(gc);
        SC[lane] = gc; SC[64 + lane] = beta; SC[128 + lane] = beta * eg; SC[192 + lane] = eg; SC[256 + lane] = __expf(glast - gc);
        if (lane == 0) A.GL[unit] = __expf(glast); }
    LDS_WAIT(); asm volatile("" ::: "memory");
    {
        bf16x8 kf[4][2];
#pragma unroll
        for (int t4 = 0; t4 < 4; ++t4)
#pragma unroll
            for (int ks = 0; ks < 2; ++ks) kf[t4][ks] = *(const bf16x8*)(A.GK + ((size_t)bh * 4096 + t0 + 16 * t4 + fr) * 64 + 32 * ks + 8 * fq);
        __builtin_amdgcn_sched_barrier(0);
#pragma unroll
        for (int ti = 0; ti < 4; ++ti) { const f32x4 gi = *(const f32x4*)(SC + 16 * ti + 4 * fq), bi = *(const f32x4*)(SC + 64 + 16 * ti + 4 * fq);
#pragma unroll
            for (int tj = 0; tj < 4; ++tj) if (tj <= ti) { f32x4 acc = {0.f, 0.f, 0.f, 0.f};
                acc = __builtin_amdgcn_mfma_f32_16x16x32_bf16(kf[ti][0], kf[tj][0], acc, 0, 0, 0); acc = __builtin_amdgcn_mfma_f32_16x16x32_bf16(kf[ti][1], kf[tj][1], acc, 0, 0, 0);
                const float gj = SC[16 * tj + fr];
#pragma unroll
                for (int i = 0; i < 4; ++i) AL[(16 * ti + 4 * fq + i) * 64 + 16 * tj + fr] = bi[i] * acc[i] * __expf(fminf(gi[i] - gj, 0.f)); } }
    }
    LDS_WAIT(); asm volatile("" ::: "memory");
    {
        float T[64];
        FSub<63>::run(T, AL, lane);
        LDS_WAIT(); asm volatile("" ::: "memory");
        unsigned short* TB = (unsigned short*)wl;
#pragma unroll
        for (int i = 0; i < 64; ++i) TB[i * 72 + lane] = (unsigned short)f2bf(T[i]);
    }
    LDS_WAIT(); asm volatile("" ::: "memory");
    {
        bf16x8 tf[4][2];
#pragma unroll
        for (int ti = 0; ti < 4; ++ti)
#pragma unroll
            for (int ks = 0; ks < 2; ++ks) tf[ti][ks] = *(const bf16x8*)(wl + ((16 * ti + fr) * 72 + 32 * ks + 8 * fq) * 2);
#pragma unroll
        for (int which = 0; which < 2; ++which) { const bf16* src = which ? A.GVT : A.GKT; const float* sc = SC + (which ? 64 : 128);
            bf16x8 raws[4][2];
#pragma unroll
            for (int tn = 0; tn < 4; ++tn)
#pragma unroll
                for (int ks = 0; ks < 2; ++ks) raws[tn][ks] = *(const bf16x8*)(src + ((size_t)bh * 64 + 16 * tn + fr) * 4096 + t0 + 32 * ks + 8 * fq);
            __builtin_amdgcn_sched_barrier(0);
#pragma unroll
            for (int tn = 0; tn < 4; ++tn) { bf16x8 yb[2];
#pragma unroll
                for (int ks = 0; ks < 2; ++ks) { const bf16x8 raw = raws[tn][ks];
                    const f32x4 s0 = *(const f32x4*)(sc + 32 * ks + 8 * fq), s1 = *(const f32x4*)(sc + 32 * ks + 8 * fq + 4);
                    yb[ks] = pack8(bf2f((unsigned short)raw[0]) * s0.x, bf2f((unsigned short)raw[1]) * s0.y, bf2f((unsigned short)raw[2]) * s0.z, bf2f((unsigned short)raw[3]) * s0.w,
                                   bf2f((unsigned short)raw[4]) * s1.x, bf2f((unsigned short)raw[5]) * s1.y, bf2f((unsigned short)raw[6]) * s1.z, bf2f((unsigned short)raw[7]) * s1.w); }
#pragma unroll
                for (int ti = 0; ti < 4; ++ti) { f32x4 acc = {0.f, 0.f, 0.f, 0.f};
                    acc = __builtin_amdgcn_mfma_f32_16x16x32_bf16(tf[ti][0], yb[0], acc, 0, 0, 0);
                    if (ti >= 2) acc = __builtin_amdgcn_mfma_f32_16x16x32_bf16(tf[ti][1], yb[1], acc, 0, 0, 0);
                    if (which == 0) { const int p = 32 * (tn >> 1) + 8 * (fr >> 2) + 4 * (tn & 1) + (fr & 3);
#pragma unroll
                        for (int i = 0; i < 4; ++i) A.WX[((size_t)unit * 64 + 16 * ti + 4 * fq + i) * 64 + p] = (bf16)f2bf(acc[i]); }
                    else *(f32x4*)(A.U0F + (((size_t)unit * 16 + ti * 4 + tn) * 64 + lane) * 4) = acc; } } }
    }
    {
        bf16x8 kf[4][2], qf[4][2];
#pragma unroll
        for (int t4 = 0; t4 < 4; ++t4)
#pragma unroll
            for (int ks = 0; ks < 2; ++ks) { kf[t4][ks] = *(const bf16x8*)(A.GK + ((size_t)bh * 4096 + t0 + 16 * t4 + fr) * 64 + 32 * ks + 8 * fq);
                qf[t4][ks] = *(const bf16x8*)(A.GQ + ((size_t)bh * 4096 + t0 + 16 * t4 + fr) * 64 + 32 * ks + 8 * fq); }
        __builtin_amdgcn_sched_barrier(0);
#pragma unroll
        for (int ti = 0; ti < 4; ++ti) { const f32x4 gi = *(const f32x4*)(SC + 16 * ti + 4 * fq);
#pragma unroll
            for (int tj = 0; tj < 4; ++tj) { f32x4 acc = {0.f, 0.f, 0.f, 0.f};
                if (tj <= ti) { acc = __builtin_amdgcn_mfma_f32_16x16x32_bf16(qf[ti][0], kf[tj][0], acc, 0, 0, 0); acc = __builtin_amdgcn_mfma_f32_16x16x32_bf16(qf[ti][1], kf[tj][1], acc, 0, 0, 0); }
                const float gj = SC[16 * tj + fr]; const int p = 32 * (tj >> 1) + 8 * (fr >> 2) + 4 * (tj & 1) + (fr & 3);
#pragma unroll
                for (int i = 0; i < 4; ++i) { const int ri = 16 * ti + 4 * fq + i, cj = 16 * tj + fr;
                    const float v = (tj <= ti && ri >= cj) ? acc[i] * __expf(fminf(gi[i] - gj, 0.f)) : 0.f;
                    A.QKX[((size_t)unit * 64 + ri) * 64 + p] = (bf16)f2bf(v); } } }
    }
    {
        const int lg = perm_inv32(lane);
        const float ek = SC[256 + lg];
#pragma unroll 1
        for (int r0 = 0; r0 < 64; r0 += 16) { bf16 qv[16], kv[16];
#pragma unroll
            for (int i = 0; i < 16; ++i) { qv[i] = A.GQ[((size_t)bh * 4096 + t0 + r0 + i) * 64 + lg]; kv[i] = A.GKT[((size_t)bh * 64 + r0 + i) * 4096 + t0 + lg]; }
            __builtin_amdgcn_sched_barrier(0);
#pragma unroll
            for (int i = 0; i < 16; ++i) { A.QX[((size_t)unit * 64 + r0 + i) * 64 + lane] = (bf16)f2bf(bf2f(qv[i]) * SC[192 + r0 + i]);
                A.KTX[((size_t)unit * 64 + r0 + i) * 64 + lane] = (bf16)f2bf(bf2f(kv[i]) * ek); } }
    }
    LDS_WAIT(); asm volatile("" ::: "memory");
}
struct GS2Args { const bf16* WX; const bf16* QX; const bf16* QKX; const bf16* KTX; const float* U0F; const float* GL; float* OG; float* out; int l; };
__device__ __forceinline__ void gdn_scan2_wave(const GS2Args& A, int bh, int te, int lane) {
    const int fr = lane & 15, fq = lane >> 4, b = bh >> 3, h = bh & 7;
    f32x4 s[4]; bf16x8 sfr[2];
#pragma unroll
    for (int i = 0; i < 4; ++i) s[i] = (f32x4){0.f, 0.f, 0.f, 0.f};
    sfr[0] = (bf16x8){0, 0, 0, 0, 0, 0, 0, 0}; sfr[1] = sfr[0];
    f32x4 u[4]; bf16x8 wf[4][2], kt[4][2], qx[4][2], qkx[4][2]; float dec;
#define GS_LD_UW(nn) do { const size_t un_ = (size_t)bh * 64 + (nn); _Pragma("unroll") for (int tc = 0; tc < 4; ++tc) { u[tc] = *(const f32x4*)(A.U0F + ((un_ * 16 + tc * 4 + te) * 64 + lane) * 4); \
        _Pragma("unroll") for (int ks = 0; ks < 2; ++ks) wf[tc][ks] = *(const bf16x8*)(A.WX + (un_ * 64 + 16 * tc + fr) * 64 + 32 * ks + 8 * fq); } } while (0)
#define GS_LD_Q(nn) do { const size_t un_ = (size_t)bh * 64 + (nn); _Pragma("unroll") for (int tc = 0; tc < 4; ++tc) _Pragma("unroll") for (int ks = 0; ks < 2; ++ks) { \
        qx[tc][ks] = *(const bf16x8*)(A.QX + (un_ * 64 + 16 * tc + fr) * 64 + 32 * ks + 8 * fq); qkx[tc][ks] = *(const bf16x8*)(A.QKX + (un_ * 64 + 16 * tc + fr) * 64 + 32 * ks + 8 * fq); } } while (0)
#define GS_LD_K(nn) do { const size_t un_ = (size_t)bh * 64 + (nn); dec = A.GL[un_]; _Pragma("unroll") for (int tc = 0; tc < 4; ++tc) _Pragma("unroll") for (int ks = 0; ks < 2; ++ks) \
        kt[tc][ks] = *(const bf16x8*)(A.KTX + (un_ * 64 + 16 * tc + fr) * 64 + 32 * ks + 8 * fq); } while (0)
    GS_LD_UW(0); GS_LD_Q(0); GS_LD_K(0);
    __builtin_amdgcn_sched_barrier(0);
#pragma unroll 1
    for (int n = 0; n < 64; ++n) {
        const int nn = n < 63 ? n + 1 : 63;
#pragma unroll
        for (int tc = 0; tc < 4; ++tc) { f32x4 acc = {0.f, 0.f, 0.f, 0.f};
            acc = __builtin_amdgcn_mfma_f32_16x16x32_bf16(wf[tc][0], sfr[0], acc, 0, 0, 0); acc = __builtin_amdgcn_mfma_f32_16x16x32_bf16(wf[tc][1], sfr[1], acc, 0, 0, 0);
            u[tc] -= acc; }
        bf16x8 ufr[2];
#pragma unroll
        for (int ks = 0; ks < 2; ++ks) ufr[ks] = pack8(u[2 * ks][0], u[2 * ks][1], u[2 * ks][2], u[2 * ks][3], u[2 * ks + 1][0], u[2 * ks + 1][1], u[2 * ks + 1][2], u[2 * ks + 1][3]);
        __builtin_amdgcn_sched_barrier(0);
        GS_LD_UW(nn);
        __builtin_amdgcn_sched_barrier(0);
        f32x4 oacc[4];
#pragma unroll
        for (int tc = 0; tc < 4; ++tc) {
            f32x4 acc = {0.f, 0.f, 0.f, 0.f};
            acc = __builtin_amdgcn_mfma_f32_16x16x32_bf16(qx[tc][0], sfr[0], acc, 0, 0, 0); acc = __builtin_amdgcn_mfma_f32_16x16x32_bf16(qx[tc][1], sfr[1], acc, 0, 0, 0);
            acc = __builtin_amdgcn_mfma_f32_16x16x32_bf16(qkx[tc][0], ufr[0], acc, 0, 0, 0); acc = __builtin_amdgcn_mfma_f32_16x16x32_bf16(qkx[tc][1], ufr[1], acc, 0, 0, 0);
            oacc[tc] = acc; }
#pragma unroll
        for (int td = 0; td < 4; ++td) { f32x4 acc = s[td] * dec;
            acc = __builtin_amdgcn_mfma_f32_16x16x32_bf16(kt[td][0], ufr[0], acc, 0, 0, 0); acc = __builtin_amdgcn_mfma_f32_16x16x32_bf16(kt[td][1], ufr[1], acc, 0, 0, 0);
            s[td] = acc; }
#pragma unroll
        for (int ks = 0; ks < 2; ++ks) sfr[ks] = pack8(s[2 * ks][0], s[2 * ks][1], s[2 * ks][2], s[2 * ks][3], s[2 * ks + 1][0], s[2 * ks + 1][1], s[2 * ks + 1][2], s[2 * ks + 1][3]);
        __builtin_amdgcn_sched_barrier(0);
        GS_LD_Q(nn); GS_LD_K(nn);
#pragma unroll
        for (int tc = 0; tc < 4; ++tc)
#pragma unroll
            for (int i = 0; i < 4; ++i) A.OG[((size_t)b * SEQ + 64 * n + 16 * tc + 4 * fq + i) * 512 + h * 64 + 16 * te + fr] = oacc[tc][i];
        __builtin_amdgcn_sched_barrier(0);
    }
#undef GS_LD_UW
#undef GS_LD_Q
#undef GS_LD_K
#pragma unroll
    for (int td = 0; td < 4; ++td)
#pragma unroll
        for (int i = 0; i < 4; ++i) A.out[O_GDNP + ((((size_t)A.l * NPB + b) * 8 + h) * 64 + 16 * td + 4 * fq + i) * 64 + 16 * te + fr] = s[td][i];
}

constexpr int SC_ROW = 144, SC_MAT = 64 * SC_ROW, SC_U = 4 * SC_MAT, SC_STAGE = SC_U + 16384, SC_DEC = 2 * SC_STAGE;
__device__ __forceinline__ void gdn_scan3_block(const GS2Args& A, unsigned char* lds, int bh, int tid) {
    const int lane = tid & 63, wave = __builtin_amdgcn_readfirstlane(tid >> 6), fr = lane & 15, fq = lane >> 4, b = bh >> 3, h = bh & 7, te = wave;
    const int mrow = (tid >> 3), mch = tid & 7;
    v4u ra[6], rb[6];
#define SC_LOAD(R, nn) do { const size_t un_ = (size_t)bh * 64 + ((nn) < 63 ? (nn) : 63); \
        R[0] = *(const v4u*)(A.WX + un_ * 4096 + mrow * 64 + mch * 8); R[1] = *(const v4u*)(A.KTX + un_ * 4096 + mrow * 64 + mch * 8); \
        R[2] = *(const v4u*)(A.QX + un_ * 4096 + mrow * 64 + mch * 8); R[3] = *(const v4u*)(A.QKX + un_ * 4096 + mrow * 64 + mch * 8); \
        R[4] = *(const v4u*)(A.U0F + un_ * 4096 + (size_t)tid * 4); R[5] = *(const v4u*)(A.U0F + un_ * 4096 + (size_t)(tid + 512) * 4); } while (0)
#define SC_STORE(R, st) do { unsigned char* sb_ = lds + (st) * SC_STAGE; \
        *(v4u*)(sb_ + 0 * SC_MAT + mrow * SC_ROW + mch * 16) = R[0]; *(v4u*)(sb_ + 1 * SC_MAT + mrow * SC_ROW + mch * 16) = R[1]; \
        *(v4u*)(sb_ + 2 * SC_MAT + mrow * SC_ROW + mch * 16) = R[2]; *(v4u*)(sb_ + 3 * SC_MAT + mrow * SC_ROW + mch * 16) = R[3]; \
        *(v4u*)(sb_ + SC_U + tid * 16) = R[4]; *(v4u*)(sb_ + SC_U + (tid + 512) * 16) = R[5]; } while (0)
    f32x4 s[4]; bf16x8 sfr[2];
#pragma unroll
    for (int i = 0; i < 4; ++i) s[i] = (f32x4){0.f, 0.f, 0.f, 0.f};
    sfr[0] = (bf16x8){0, 0, 0, 0, 0, 0, 0, 0}; sfr[1] = sfr[0];
    __syncthreads();
    if (tid < 64) ((float*)(lds + SC_DEC))[tid] = A.GL[(size_t)bh * 64 + tid];
    SC_LOAD(ra, 0); SC_STORE(ra, 0);
    SC_LOAD(rb, 1); SC_LOAD(ra, 2);
    __syncthreads();
#define SC_CHUNK(n, st) do { if (wave < 4) { const unsigned char* sb_ = lds + (st) * SC_STAGE; \
        f32x4 u[4]; bf16x8 ufr[2]; \
        _Pragma("unroll") for (int tc = 0; tc < 4; ++tc) { u[tc] = *(const f32x4*)(sb_ + SC_U + ((tc * 4 + te) * 64 + lane) * 16); \
            const bf16x8 w0 = *(const bf16x8*)(sb_ + (16 * tc + fr) * SC_ROW + (8 * fq) * 2), w1 = *(const bf16x8*)(sb_ + (16 * tc + fr) * SC_ROW + (32 + 8 * fq) * 2); \
            f32x4 acc = {0.f, 0.f, 0.f, 0.f}; acc = __builtin_amdgcn_mfma_f32_16x16x32_bf16(w0, sfr[0], acc, 0, 0, 0); acc = __builtin_amdgcn_mfma_f32_16x16x32_bf16(w1, sfr[1], acc, 0, 0, 0); u[tc] -= acc; } \
        _Pragma("unroll") for (int ks = 0; ks < 2; ++ks) ufr[ks] = pack8(u[2 * ks][0], u[2 * ks][1], u[2 * ks][2], u[2 * ks][3], u[2 * ks + 1][0], u[2 * ks + 1][1], u[2 * ks + 1][2], u[2 * ks + 1][3]); \
        _Pragma("unroll") for (int tc = 0; tc < 4; ++tc) { \
            const bf16x8 q0 = *(const bf16x8*)(sb_ + 2 * SC_MAT + (16 * tc + fr) * SC_ROW + (8 * fq) * 2), q1 = *(const bf16x8*)(sb_ + 2 * SC_MAT + (16 * tc + fr) * SC_ROW + (32 + 8 * fq) * 2); \
            const bf16x8 k0 = *(const bf16x8*)(sb_ + 3 * SC_MAT + (16 * tc + fr) * SC_ROW + (8 * fq) * 2), k1 = *(const bf16x8*)(sb_ + 3 * SC_MAT + (16 * tc + fr) * SC_ROW + (32 + 8 * fq) * 2); \
            f32x4 acc = {0.f, 0.f, 0.f, 0.f}; \
            acc = __builtin_amdgcn_mfma_f32_16x16x32_bf16(q0, sfr[0], acc, 0, 0, 0); acc = __builtin_amdgcn_mfma_f32_16x16x32_bf16(q1, sfr[1], acc, 0, 0, 0); \
            acc = __builtin_amdgcn_mfma_f32_16x16x32_bf16(k0, ufr[0], acc, 0, 0, 0); acc = __builtin_amdgcn_mfma_f32_16x16x32_bf16(k1, ufr[1], acc, 0, 0, 0); \
            _Pragma("unroll") for (int i = 0; i < 4; ++i) A.OG[((size_t)b * SEQ + 64 * (n) + 16 * tc + 4 * fq + i) * 512 + h * 64 + 16 * te + fr] = acc[i]; } \
        const float dec = ((const float*)(lds + SC_DEC))[(n)]; \
        _Pragma("unroll") for (int td = 0; td < 4; ++td) { \
            const bf16x8 t0 = *(const bf16x8*)(sb_ + 1 * SC_MAT + (16 * td + fr) * SC_ROW + (8 * fq) * 2), t1 = *(const bf16x8*)(sb_ + 1 * SC_MAT + (16 * td + fr) * SC_ROW + (32 + 8 * fq) * 2); \
            f32x4 acc = s[td] * dec; acc = __builtin_amdgcn_mfma_f32_16x16x32_bf16(t0, ufr[0], acc, 0, 0, 0); acc = __builtin_amdgcn_mfma_f32_16x16x32_bf16(t1, ufr[1], acc, 0, 0, 0); s[td] = acc; } \
        _Pragma("unroll") for (int ks = 0; ks < 2; ++ks) sfr[ks] = pack8(s[2 * ks][0], s[2 * ks][1], s[2 * ks][2], s[2 * ks][3], s[2 * ks + 1][0], s[2 * ks + 1][1], s[2 * ks + 1][2], s[2 * ks + 1][3]); } } while (0)
#pragma unroll 1
    for (int n = 0; n < 64; n += 2) {
        SC_STORE(rb, 1); __builtin_amdgcn_sched_barrier(0); SC_LOAD(rb, n + 3); __builtin_amdgcn_sched_barrier(0);
        SC_CHUNK(n, 0);
        __syncthreads();
        SC_STORE(ra, 0); __builtin_amdgcn_sched_barrier(0); SC_LOAD(ra, n + 4); __builtin_amdgcn_sched_barrier(0);
        SC_CHUNK(n + 1, 1);
        __syncthreads();
    }
#undef SC_LOAD
#undef SC_STORE
#undef SC_CHUNK
    if (wave < 4) {
#pragma unroll
        for (int td = 0; td < 4; ++td)
#pragma unroll
            for (int i = 0; i < 4; ++i) A.out[O_GDNP + ((((size_t)A.l * NPB + b) * 8 + h) * 64 + 16 * td + 4 * fq + i) * 64 + 16 * te + fr] = s[td][i];
    }
}

constexpr int L_CK = 0, L_CVT = 18432, L_IMP = 36864, L_MASK = 102400, L_UM = 102912, L_INV = 102928, L_K = 104448, L_VT = 113664;
struct AttArgs { const bf16* QB; const bf16* KS; const bf16* VS; const bf16* KW; const bf16* VW; const float* CKP; const float* CVP; const float* PROJ; bf16* MIX; };

constexpr float ATT_THR = 16.f;
constexpr int L_K2 = 122880, L_VT2 = 132096, L_VT3 = 0;
template <int MODE>
__device__ __forceinline__ void attn_tiles(unsigned char* lds, const bf16* Kg, const bf16* Vg, int j_lo, int j_hi, unsigned long long umask, unsigned long long tmask,
                                           int qblk, int trel, const bf16x8 (&qr)[4], f32x16 (&o)[2], float& mref, float& lrun, int tid, int r32, int hi) {
    int j = j_lo; while (j <= j_hi && !((umask >> j) & 1ull)) ++j;
    const int key = tid >> 3, ch = tid & 7;
    v4u kvv = {0u, 0u, 0u, 0u}, vv = {0u, 0u, 0u, 0u};
#define AT_LOAD(jj) do { kvv = *(const v4u*)(Kg + (size_t)(64 * (jj) + key) * 128 + ch * 8); vv = *(const v4u*)(Vg + (size_t)(64 * (jj) + key) * 128 + ch * 8); } while (0)
#define AT_WRITE(kofs, vofs) do { *(v4u*)(lds + (kofs) + key * 144 + ch * 16) = kvv; *(v4u*)(lds + (vofs) + key * 144 + ch * 16) = vv; } while (0)
    if (j > j_hi) return;
    AT_LOAD(j);
    __syncthreads();
    AT_WRITE(L_K, L_VT);
    int jn = j + 1; while (jn <= j_hi && !((umask >> jn) & 1ull)) ++jn;
    if (jn <= j_hi) AT_LOAD(jn);
    __syncthreads();
    const bool grpB = (tid >= 256);
    v4u pwp[4];
#pragma unroll
    for (int i = 0; i < 4; ++i) pwp[i] = (v4u){0u, 0u, 0u, 0u};
    int it = 0, vprev = L_VT;
    typedef short v4i16_t_ __attribute__((ext_vector_type(4)));
    const int trl_ = tid & 63, trq_ = (trl_ & 15) >> 2, trp_ = trl_ & 3, trd_ = 16 * ((trl_ >> 4) & 1) + 4 * trp_;
#define AT_TR(p_) __builtin_bit_cast(s16x4, __builtin_amdgcn_ds_read_tr16_b64_v4i16((__attribute__((address_space(3))) v4i16_t_*)(p_)))
#define AT_PV(vofs, PW) do { _Pragma("unroll") for (int u = 0; u < 2; ++u) _Pragma("unroll") for (int s = 0; s < 2; ++s) { const bf16x8 pf = __builtin_bit_cast(bf16x8, PW[u * 2 + s]); \
        _Pragma("unroll") for (int dh = 0; dh < 2; ++dh) { const unsigned char* vp = lds + (vofs) + (32 * u + 16 * s + 4 * hi + trq_) * 144 + (32 * dh + trd_) * 2; \
            const s16x4 lo = AT_TR(vp), hi4 = AT_TR(vp + 8 * 144); \
            const bf16x8 vf = (bf16x8){lo[0], lo[1], lo[2], lo[3], hi4[0], hi4[1], hi4[2], hi4[3]}; \
            o[dh] = __builtin_amdgcn_mfma_f32_32x32x16_bf16(vf, pf, o[dh], 0, 0, 0); } } } while (0)
    while (j <= j_hi) {
        const int kb = (it & 1) ? L_K2 : L_K, kb2 = (it & 1) ? L_K : L_K2;
        const int m3 = it % 3, vb = (m3 == 0) ? L_VT : (m3 == 1) ? L_VT2 : L_VT3, vb2 = (m3 == 0) ? L_VT2 : (m3 == 1) ? L_VT3 : L_VT;
        if (grpB && it > 0) AT_PV(vprev, pwp);
        if (jn <= j_hi) AT_WRITE(kb2, vb2);
        int jnn = jn + 1; while (jnn <= j_hi && !((umask >> jnn) & 1ull)) ++jnn;
        if (jnn <= j_hi) AT_LOAD(jnn);
        __builtin_amdgcn_sched_barrier(0);
        const bool tsel = (MODE == 0) ? (((tmask >> j) & 1ull) != 0ull) : true;
        const float cval = tsel ? -mref : NEG_INF;
        f32x16 ct;
#pragma unroll
        for (int r = 0; r < 16; ++r) ct[r] = cval;
        f32x16 p[2];
#pragma unroll
        for (int u = 0; u < 2; ++u) { f32x16 acc;
#pragma unroll
            for (int d0 = 0; d0 < 4; ++d0) { const bf16x8 kf = *(const bf16x8*)(lds + kb + (32 * u + r32) * 144 + (16 * d0 + 8 * hi) * 2);
                acc = __builtin_amdgcn_mfma_f32_32x32x16_bf16(kf, qr[d0], d0 == 0 ? ct : acc, 0, 0, 0); }
            p[u] = acc; }
        if (j == qblk) {
#pragma unroll
            for (int u = 0; u < 2; ++u)
#pragma unroll
                for (int r = 0; r < 16; ++r) { const int kv = 32 * u + crow(r, hi); if (kv > trel) p[u][r] = NEG_INF; } }
        if (MODE == 1 && j == qblk - 8) {
#pragma unroll
            for (int u = 0; u < 2; ++u)
#pragma unroll
                for (int r = 0; r < 16; ++r) { const int kv = 32 * u + crow(r, hi); if (kv < trel) p[u][r] = NEG_INF; } }
        float rm;
        { float a = __builtin_fmaxf(__builtin_fmaxf(p[0][0], p[0][1]), p[1][0]), b2 = __builtin_fmaxf(__builtin_fmaxf(p[0][2], p[0][3]), p[1][1]); a = __builtin_fmaxf(__builtin_fmaxf(a, p[1][2]), p[1][3]);
#pragma unroll
          for (int r = 4; r < 16; r += 4) { a = __builtin_fmaxf(__builtin_fmaxf(a, p[0][r]), p[0][r + 1]); b2 = __builtin_fmaxf(__builtin_fmaxf(b2, p[0][r + 2]), p[0][r + 3]);
              a = __builtin_fmaxf(__builtin_fmaxf(a, p[1][r]), p[1][r + 1]); b2 = __builtin_fmaxf(__builtin_fmaxf(b2, p[1][r + 2]), p[1][r + 3]); }
          rm = __builtin_fmaxf(a, b2); }
        { auto rr = __builtin_amdgcn_permlane32_swap(__float_as_uint(rm), __float_as_uint(rm), false, false); rm = __builtin_fmaxf(__uint_as_float(rr[0]), __uint_as_float(rr[1])); }
        if (__builtin_expect(__any(rm > ATT_THR), 0)) {
            const float dl = (rm > ATT_THR) ? rm : 0.f, f = ex2(-dl);
            mref += dl; lrun *= f;
#pragma unroll
            for (int u = 0; u < 2; ++u)
#pragma unroll
                for (int r = 0; r < 16; ++r) p[u][r] -= dl;
#pragma unroll
            for (int dh = 0; dh < 2; ++dh)
#pragma unroll
                for (int r = 0; r < 16; ++r) o[dh][r] *= f; }
        typedef float f32x2v_ __attribute__((ext_vector_type(2)));
        f32x2v_ ls2 = {0.f, 0.f};
#pragma unroll
        for (int u = 0; u < 2; ++u)
#pragma unroll
            for (int r = 0; r < 16; r += 2) { const float e0 = ex2(p[u][r]), e1 = ex2(p[u][r + 1]); p[u][r] = e0; p[u][r + 1] = e1; ls2 += (f32x2v_){e0, e1}; }
        lrun += ls2.x + ls2.y;
        v4u pw[4];
#pragma unroll
        for (int u = 0; u < 2; ++u)
#pragma unroll
            for (int s = 0; s < 2; ++s) { pw[u * 2 + s].x = pk2(p[u][8 * s + 0], p[u][8 * s + 1]); pw[u * 2 + s].y = pk2(p[u][8 * s + 2], p[u][8 * s + 3]);
                pw[u * 2 + s].z = pk2(p[u][8 * s + 4], p[u][8 * s + 5]); pw[u * 2 + s].w = pk2(p[u][8 * s + 6], p[u][8 * s + 7]); }
        if (!grpB) AT_PV(vb, pw);
        else {
#pragma unroll
            for (int i = 0; i < 4; ++i) pwp[i] = pw[i];
            vprev = vb; }
        __syncthreads();
        j = jn; jn = jnn; ++it;
    }
    if (grpB && it > 0) AT_PV(vprev, pwp);
#undef AT_PV
#undef AT_TR
#undef AT_LOAD
#undef AT_WRITE
}

__device__ __forceinline__ void nsa_prompt_unit(const AttArgs& A, unsigned char* lds, int unit, int tid) {
    const int lane = tid & 63, wave = tid >> 6, r32 = lane & 31, hi = lane >> 5, hh = wave & 3, ts = wave >> 2;
    const int qblk = 63 - (unit >> 3), b = (unit >> 1) & 3, kvh = unit & 1;
    const int head = kvh * 4 + hh, trel = 32 * ts + r32, t = 64 * qblk + trel; const size_t m = (size_t)b * SEQ + t;
    __syncthreads();
    const int nvmax = 2 * qblk + 2, ntile_c = (nvmax + 31) >> 5;
    { const int ch = tid & 7;
      for (int n = tid >> 3; n < 32 * ntile_c; n += 64) {
          const float* ckp = A.CKP + ((size_t)(b * 128 + n) * 2 + kvh) * 64 + ch * 8; const float* cvp = A.CVP + ((size_t)(b * 128 + n) * 2 + kvh) * 64 + ch * 8;
          const f32x4 k0 = *(const f32x4*)ckp, k1 = *(const f32x4*)(ckp + 4), v0 = *(const f32x4*)cvp, v1 = *(const f32x4*)(cvp + 4);
          *(bf16x8*)(lds + L_CK + n * 144 + ch * 16) = pack8(k0.x, k0.y, k0.z, k0.w, k1.x, k1.y, k1.z, k1.w);
          unsigned short* vt = (unsigned short*)(lds + L_CVT);
          vt[(ch * 8 + 0) * 136 + n] = (unsigned short)f2bf(v0.x); vt[(ch * 8 + 1) * 136 + n] = (unsigned short)f2bf(v0.y); vt[(ch * 8 + 2) * 136 + n] = (unsigned short)f2bf(v0.z); vt[(ch * 8 + 3) * 136 + n] = (unsigned short)f2bf(v0.w);
          vt[(ch * 8 + 4) * 136 + n] = (unsigned short)f2bf(v1.x); vt[(ch * 8 + 5) * 136 + n] = (unsigned short)f2bf(v1.y); vt[(ch * 8 + 6) * 136 + n] = (unsigned short)f2bf(v1.z); vt[(ch * 8 + 7) * 136 + n] = (unsigned short)f2bf(v1.w);
      }
      if (tid < 128) ((unsigned*)(lds + L_MASK))[tid] = 0u;
      if (tid < 2) ((unsigned*)(lds + L_UM))[tid] = 0u; }
    bf16x8 qr[4];
#pragma unroll
    for (int d0 = 0; d0 < 4; ++d0) qr[d0] = *(const bf16x8*)(A.QB + m * 512 + head * 64 + 16 * d0 + 8 * hi);
    __syncthreads();
    f32x16 tot[2];
    {
        const int nv = (t + 1) >> 5;
        float mx = NEG_INF;
#pragma unroll 1
        for (int tau = 0; tau < ntile_c; ++tau) {
            f32x16 acc = {};
#pragma unroll
            for (int d0 = 0; d0 < 4; ++d0) { const bf16x8 kf = *(const bf16x8*)(lds + L_CK + (32 * tau + r32) * 144 + (16 * d0 + 8 * hi) * 2);
                acc = __builtin_amdgcn_mfma_f32_32x32x16_bf16(kf, qr[d0], acc, 0, 0, 0); }
#pragma unroll
            for (int r = 0; r < 16; ++r) { const int n = 32 * tau + crow(r, hi); if (n < nv) mx = fmaxf(mx, acc[r]); }
        }
        mx = fmaxf(mx, __shfl_xor(mx, 32)); if (mx == NEG_INF) mx = 0.f;
        float sum = 0.f;
        f32x16 oc[2]; oc[0] = (f32x16){}; oc[1] = (f32x16){};
        float* imph = (float*)(lds + L_IMP) + (size_t)hh * 4096 + (32 * ts + r32) * 64;
#pragma unroll 1
        for (int tau = 0; tau < 4; ++tau) {
            f32x16 e = {};
            if (tau < ntile_c) {
                f32x16 acc = {};
#pragma unroll
                for (int d0 = 0; d0 < 4; ++d0) { const bf16x8 kf = *(const bf16x8*)(lds + L_CK + (32 * tau + r32) * 144 + (16 * d0 + 8 * hi) * 2);
                    acc = __builtin_amdgcn_mfma_f32_32x32x16_bf16(kf, qr[d0], acc, 0, 0, 0); }
#pragma unroll
                for (int r = 0; r < 16; ++r) { const int n = 32 * tau + crow(r, hi); e[r] = (n < nv) ? ex2(acc[r] - mx) : 0.f; sum += e[r]; }
#pragma unroll
                for (int s = 0; s < 2; ++s) {
                    const bf16x8 pf = pack8(e[8 * s + 0], e[8 * s + 1], e[8 * s + 2], e[8 * s + 3], e[8 * s + 4], e[8 * s + 5], e[8 * s + 6], e[8 * s + 7]);
#pragma unroll
                    for (int dh = 0; dh < 2; ++dh) { const unsigned char* vp = lds + L_CVT + (r32 + 32 * dh) * 272 + (32 * tau + 16 * s + 4 * hi) * 2;
                        const s16x4 lo = *(const s16x4*)vp, hi4 = *(const s16x4*)(vp + 16);
                        const bf16x8 vf = (bf16x8){lo[0], lo[1], lo[2], lo[3], hi4[0], hi4[1], hi4[2], hi4[3]};
                        oc[dh] = __builtin_amdgcn_mfma_f32_32x32x16_bf16(vf, pf, oc[dh], 0, 0, 0); }
                }
            }
#pragma unroll
            for (int a = 0; a < 4; ++a) { imph[16 * tau + 4 * a + 2 * hi + 0] = e[4 * a] + e[4 * a + 1]; imph[16 * tau + 4 * a + 2 * hi + 1] = e[4 * a + 2] + e[4 * a + 3]; }
        }
        sum += __shfl_xor(sum, 32);
        const float inv = 1.f / fmaxf(sum, 1e-30f);
        if (hi == 0) ((float*)(lds + L_INV))[hh * 64 + 32 * ts + r32] = inv;
        const float g0 = sigmoidf_(A.PROJ[m * NP + C_GATE + head * 3 + 0]) * inv;
#pragma unroll
        for (int dh = 0; dh < 2; ++dh)
#pragma unroll
            for (int r = 0; r < 16; ++r) tot[dh][r] = g0 * oc[dh][r];
    }
    __syncthreads();
    { float* ip = (float*)(lds + L_IMP); const float* iv = (const float*)(lds + L_INV);
#pragma unroll
      for (int i = 0; i < 8; ++i) { const int idx = tid + 512 * i, tk = idx >> 6;
          ip[idx] = (ip[idx] * iv[tk] + ip[4096 + idx] * iv[64 + tk]) + (ip[8192 + idx] * iv[128 + tk] + ip[12288 + idx] * iv[192 + tk]); } }
    __syncthreads();
    { const int tok = tid >> 3, jg = tid & 7; unsigned* mk = (unsigned*)(lds + L_MASK) + tok * 2;
      if (qblk <= 15) { if (jg == 0) { const unsigned long long am = (1ull << (qblk + 1)) - 1ull; mk[0] = (unsigned)am; mk[1] = (unsigned)(am >> 32); } }
      else {
          const float* iv = (const float*)(lds + L_IMP) + tok * 64; float vj[8]; int rk[8];
#pragma unroll
          for (int jj = 0; jj < 8; ++jj) { vj[jj] = iv[jg * 8 + jj]; rk[jj] = 0; }
          for (int i = 1; i <= qblk - 2; ++i) { const float vi = iv[i];
#pragma unroll
              for (int jj = 0; jj < 8; ++jj) { const int j = jg * 8 + jj; rk[jj] += (vi > vj[jj] || (vi == vj[jj] && i < j)) ? 1 : 0; } }
          unsigned bits = 0u;
#pragma unroll
          for (int jj = 0; jj < 8; ++jj) { const int j = jg * 8 + jj; const bool cand = (j >= 1 && j <= qblk - 2);
              if ((cand && rk[jj] < 13) || j == 0 || j == qblk || j == qblk - 1) bits |= 1u << ((jg & 3) * 8 + jj); }
          if (bits) atomicOr(mk + (jg >> 2), bits);
      } }
    __syncthreads();
    if (tid < 64) { const unsigned* mk = (const unsigned*)(lds + L_MASK) + tid * 2; atomicOr((unsigned*)(lds + L_UM), mk[0]); atomicOr((unsigned*)(lds + L_UM) + 1, mk[1]); }
    __syncthreads();
    unsigned long long tmask, umask;
    { const unsigned* mk = (const unsigned*)(lds + L_MASK) + trel * 2; tmask = (unsigned long long)mk[0] | ((unsigned long long)mk[1] << 32);
      const unsigned* um = (const unsigned*)(lds + L_UM); umask = (unsigned long long)um[0] | ((unsigned long long)um[1] << 32); }
    float* stash = (float*)(lds + L_IMP) + (size_t)wave * 2048 + lane;
#pragma unroll
    for (int dh = 0; dh < 2; ++dh)
#pragma unroll
        for (int r = 0; r < 16; ++r) stash[(dh * 16 + r) * 64] = tot[dh][r];
    {
        f32x16 o[2]; o[0] = (f32x16){}; o[1] = (f32x16){}; float mrun = 0.f, lrun = 0.f;
        attn_tiles<0>(lds, A.KS + (size_t)b * SEQ * 128 + kvh * 64, A.VS + (size_t)b * SEQ * 128 + kvh * 64, 0, qblk, umask, tmask, qblk, trel, qr, o, mrun, lrun, tid, r32, hi);
        lrun += __shfl_xor(lrun, 32);
        const float g1 = lrun > 0.f ? sigmoidf_(A.PROJ[m * NP + C_GATE + head * 3 + 1]) / lrun : 0.f;
#pragma unroll
        for (int dh = 0; dh < 2; ++dh)
#pragma unroll
            for (int r = 0; r < 16; ++r) stash[(dh * 16 + r) * 64] += g1 * o[dh][r];
    }
    {
        f32x16 o[2]; o[0] = (f32x16){}; o[1] = (f32x16){}; float mrun = 0.f, lrun = 0.f;
        const int jlo = qblk >= 8 ? qblk - 8 : 0;
        attn_tiles<1>(lds, A.KW + (size_t)b * SEQ * 128 + kvh * 64, A.VW + (size_t)b * SEQ * 128 + kvh * 64, jlo, qblk, ~0ull, ~0ull, qblk, trel, qr, o, mrun, lrun, tid, r32, hi);
        lrun += __shfl_xor(lrun, 32);
        const float g2 = lrun > 0.f ? sigmoidf_(A.PROJ[m * NP + C_GATE + head * 3 + 2]) / lrun : 0.f;
#pragma unroll
        for (int dh = 0; dh < 2; ++dh)
#pragma unroll
            for (int r = 0; r < 16; ++r) tot[dh][r] = stash[(dh * 16 + r) * 64] + g2 * o[dh][r];
    }
    bf16* mo = A.MIX + m * 1024 + 512 + head * 64;
#pragma unroll
    for (int dh = 0; dh < 2; ++dh)
#pragma unroll
        for (int a = 0; a < 4; ++a) { const int d0 = 32 * dh + 8 * a + 4 * hi;
            *(v2u*)(mo + d0) = (v2u){pk2(tot[dh][4 * a], tot[dh][4 * a + 1]), pk2(tot[dh][4 * a + 2], tot[dh][4 * a + 3])}; }
}

struct SAttArgs { const bf16* QB; const bf16* KS; const bf16* VS; const bf16* KW; const bf16* VW; const float* CKS; const float* CVS; const float* PROJ; const float* cache; const int* page_table; const float* state_win; bf16* MIX; int l; };
constexpr int S2_IMP = 0, S2_MK = 512, S2_ITEMS = 576, S2_OC = 1024, S2_MG = 8192;
constexpr int S2_MG_STRIDE = 4224;
template <bool F32> __device__ __forceinline__ void s2_block(const void* kbase, const void* vbase, int kstride, int nvalid, const bf16x8 (&qf)[2], const bool (&keep)[4][4], f32x4 (&O)[4], float& mrun, float& lrun, int fr, int fq) {
    f32x4 kraw[4][2][2]; bf16x8 kb[4][2]; f32x4 vraw[2][8]; v2u vb[2][8];
#pragma unroll
    for (int tk = 0; tk < 4; ++tk) { const int key = 16 * tk + fr, kc = key < nvalid ? key : nvalid - 1;
#pragma unroll
        for (int ks = 0; ks < 2; ++ks) {
            if (F32) { const float* p = (const float*)kbase + (size_t)kc * kstride + 32 * ks + 8 * fq; kraw[tk][ks][0] = *(const f32x4*)p; kraw[tk][ks][1] = *(const f32x4*)(p + 4); }
            else kb[tk][ks] = *(const bf16x8*)((const bf16*)kbase + (size_t)kc * 128 + 32 * ks + 8 * fq); } }
#pragma unroll
    for (int ks = 0; ks < 2; ++ks)
#pragma unroll
        for (int j = 0; j < 8; ++j) { const int key = 32 * ks + 16 * (j >> 2) + 4 * fq + (j & 3), kc = key < nvalid ? key : nvalid - 1;
            if (F32) vraw[ks][j] = *(const f32x4*)((const float*)vbase + (size_t)kc * kstride + 4 * fr);
            else vb[ks][j] = *(const v2u*)((const bf16*)vbase + (size_t)kc * 128 + 4 * fr); }
    __builtin_amdgcn_sched_barrier(0);
    f32x4 acc[4];
#pragma unroll
    for (int tk = 0; tk < 4; ++tk) { bf16x8 kx[2];
#pragma unroll
        for (int ks = 0; ks < 2; ++ks) { if (F32) { const f32x4 a = kraw[tk][ks][0], b = kraw[tk][ks][1]; kx[ks] = pack8(a.x, a.y, a.z, a.w, b.x, b.y, b.z, b.w); } else kx[ks] = kb[tk][ks]; }
        f32x4 a4 = {0.f, 0.f, 0.f, 0.f};
        a4 = __builtin_amdgcn_mfma_f32_16x16x32_bf16(kx[0], qf[0], a4, 0, 0, 0); a4 = __builtin_amdgcn_mfma_f32_16x16x32_bf16(kx[1], qf[1], a4, 0, 0, 0);
        acc[tk] = a4; }
    float mx = NEG_INF;
#pragma unroll
    for (int tk = 0; tk < 4; ++tk)
#pragma unroll
        for (int i = 0; i < 4; ++i) { if (!keep[tk][i]) acc[tk][i] = NEG_INF; mx = fmaxf(mx, acc[tk][i]); }
    mx = fmaxf(mx, __shfl_xor(mx, 16)); mx = fmaxf(mx, __shfl_xor(mx, 32));
    const float mn = fmaxf(mrun, mx), msafe = (mn == NEG_INF) ? 0.f : mn, alpha = ex2(mrun - msafe);
    float ls = 0.f;
#pragma unroll
    for (int tk = 0; tk < 4; ++tk)
#pragma unroll
        for (int i = 0; i < 4; ++i) { const float e = ex2(acc[tk][i] - msafe); acc[tk][i] = e; ls += e; }
    lrun = lrun * alpha + ls; mrun = mn;
#pragma unroll
    for (int td = 0; td < 4; ++td) O[td] *= alpha;
#pragma unroll
    for (int ks = 0; ks < 2; ++ks) {
        const bf16x8 pf = pack8(acc[2 * ks][0], acc[2 * ks][1], acc[2 * ks][2], acc[2 * ks][3], acc[2 * ks + 1][0], acc[2 * ks + 1][1], acc[2 * ks + 1][2], acc[2 * ks + 1][3]);
        float vv[8][4];
#pragma unroll
        for (int j = 0; j < 8; ++j) {
            if (F32) { const f32x4 v = vraw[ks][j]; vv[j][0] = v.x; vv[j][1] = v.y; vv[j][2] = v.z; vv[j][3] = v.w; }
            else { const v2u w = vb[ks][j]; vv[j][0] = bf2f((unsigned short)(w.x & 0xffffu)); vv[j][1] = bf2f((unsigned short)(w.x >> 16)); vv[j][2] = bf2f((unsigned short)(w.y & 0xffffu)); vv[j][3] = bf2f((unsigned short)(w.y >> 16)); } }
#pragma unroll
        for (int td = 0; td < 4; ++td) { const bf16x8 vx = pack8(vv[0][td], vv[1][td], vv[2][td], vv[3][td], vv[4][td], vv[5][td], vv[6][td], vv[7][td]);
            O[td] = __builtin_amdgcn_mfma_f32_16x16x32_bf16(vx, pf, O[td], 0, 0, 0); }
    }
}
__device__ __forceinline__ void nsa_sample_unit(const SAttArgs& A, unsigned char* lds, int unit, int tid) {
    const int sb = unit >> 1, kvh = unit & 1, l = A.l;
    const int lane = tid & 63, wave = __builtin_amdgcn_readfirstlane(tid >> 6), fr = lane & 15, fq = lane >> 4;
    const int qi = fr >> 2, qh = fr & 3;
    float* IMP = (float*)(lds + S2_IMP); unsigned* MK = (unsigned*)(lds + S2_MK); int* ITEMS = (int*)(lds + S2_ITEMS);
    const size_t mq = (size_t)MP + sb * 4 + qi;
    __syncthreads();
    if (tid < 8) MK[tid] = 0u;
    bf16x8 qf[2];
#pragma unroll
    for (int ks = 0; ks < 2; ++ks) qf[ks] = *(const bf16x8*)(A.QB + mq * 512 + (kvh * 4 + qh) * 64 + 32 * ks + 8 * fq);
    {
        f32x4 O[4]; float mrun = NEG_INF, lrun = 0.f;
#pragma unroll
        for (int td = 0; td < 4; ++td) O[td] = (f32x4){0.f, 0.f, 0.f, 0.f};
        bool keep[4][4];
#pragma unroll
        for (int tk = 0; tk < 4; ++tk)
#pragma unroll
            for (int i = 0; i < 4; ++i) keep[tk][i] = true;
        const float* ckf = A.CKS + ((size_t)sb * 64 * 2 + kvh) * 64; const float* cvf = A.CVS + ((size_t)sb * 64 * 2 + kvh) * 64;
        f32x4 acc[4];
#pragma unroll
        for (int tk = 0; tk < 4; ++tk) { bf16x8 kx[2];
#pragma unroll
            for (int ks = 0; ks < 2; ++ks) { const float* p = ckf + (size_t)(16 * tk + fr) * 128 + 32 * ks + 8 * fq; const f32x4 a = *(const f32x4*)p, b = *(const f32x4*)(p + 4); kx[ks] = pack8(a.x, a.y, a.z, a.w, b.x, b.y, b.z, b.w); }
            f32x4 a4 = {0.f, 0.f, 0.f, 0.f};
            a4 = __builtin_amdgcn_mfma_f32_16x16x32_bf16(kx[0], qf[0], a4, 0, 0, 0); a4 = __builtin_amdgcn_mfma_f32_16x16x32_bf16(kx[1], qf[1], a4, 0, 0, 0);
            acc[tk] = a4; }
        float mx = NEG_INF;
#pragma unroll
        for (int tk = 0; tk < 4; ++tk)
#pragma unroll
            for (int i = 0; i < 4; ++i) mx = fmaxf(mx, acc[tk][i]);
        mx = fmaxf(mx, __shfl_xor(mx, 16)); mx = fmaxf(mx, __shfl_xor(mx, 32));
        float ls = 0.f;
#pragma unroll
        for (int tk = 0; tk < 4; ++tk)
#pragma unroll
            for (int i = 0; i < 4; ++i) { const float e = ex2(acc[tk][i] - mx); acc[tk][i] = e; ls += e; }
        ls += __shfl_xor(ls, 16); ls += __shfl_xor(ls, 32);
        const float inv = 1.f / fmaxf(ls, 1e-30f);
        if (wave == 0) {
#pragma unroll
            for (int tk = 0; tk < 4; ++tk)
#pragma unroll
                for (int b2 = 0; b2 < 2; ++b2) { float v = (acc[tk][2 * b2] + acc[tk][2 * b2 + 1]) * inv;
                    v += __shfl_xor(v, 1); v += __shfl_xor(v, 2);
                    if (qh == 0) IMP[qi * 32 + 8 * tk + 2 * fq + b2] = v; }
#pragma unroll
            for (int ks = 0; ks < 2; ++ks) {
                const bf16x8 pf = pack8(acc[2 * ks][0], acc[2 * ks][1], acc[2 * ks][2], acc[2 * ks][3], acc[2 * ks + 1][0], acc[2 * ks + 1][1], acc[2 * ks + 1][2], acc[2 * ks + 1][3]);
#pragma unroll
                for (int td = 0; td < 4; ++td) { float vv[8];
#pragma unroll
                    for (int j = 0; j < 8; ++j) { const int key = 32 * ks + 16 * (j >> 2) + 4 * fq + (j & 3); vv[j] = cvf[(size_t)key * 128 + 4 * fr + td]; }
                    const bf16x8 vx = pack8(vv[0], vv[1], vv[2], vv[3], vv[4], vv[5], vv[6], vv[7]);
                    O[td] = __builtin_amdgcn_mfma_f32_16x16x32_bf16(vx, pf, O[td], 0, 0, 0); } }
            const float g0 = sigmoidf_(A.PROJ[mq * NP + C_GATE + (kvh * 4 + qh) * 3 + 0]) * inv;
            float* OC = (float*)(lds + S2_OC);
#pragma unroll
            for (int td = 0; td < 4; ++td)
#pragma unroll
                for (int i = 0; i < 4; ++i) OC[(16 * fq + 4 * i + td) * 16 + fr] = g0 * O[td][i];
        }
        (void)mrun; (void)lrun; (void)keep;
    }
    __syncthreads();
    if (tid < 128) { const int i = tid >> 5, j = tid & 31; bool sel = (j == 0 || j == 31);
        if (j >= 1 && j <= 30) { const float vj = IMP[i * 32 + j]; int rk = 0;
            for (int q = 1; q <= 30; ++q) { const float vi = IMP[i * 32 + q]; rk += (vi > vj || (vi == vj && q < j)) ? 1 : 0; }
            sel = rk < 13; }
        if (sel) { atomicOr(MK + i, 1u << j); atomicOr(MK + 4, 1u << j); } }
    __syncthreads();
    if (tid == 0) { const unsigned um = MK[4]; int n = 0;
        for (int j = 0; j < 32; ++j) if ((um >> j) & 1u) ITEMS[1 + n++] = j;
        ITEMS[1 + n++] = 32;
        for (int jb = 0; jb < 9; ++jb) ITEMS[1 + n++] = 64 + jb;
        ITEMS[0] = n; }
    __syncthreads();
    {
        const int nitems = ITEMS[0]; const unsigned tm = MK[qi];
        f32x4 Os[4], Ow[4]; float ms = NEG_INF, lsum = 0.f, mw = NEG_INF, lw = 0.f;
#pragma unroll
        for (int td = 0; td < 4; ++td) { Os[td] = (f32x4){0.f, 0.f, 0.f, 0.f}; Ow[td] = (f32x4){0.f, 0.f, 0.f, 0.f}; }
        const float* wb = A.state_win + ((size_t)l * NSB + sb) * 512 * 256 + kvh * 64;
        for (int it = wave; it < nitems; it += NWAVES) {
            const int code = ITEMS[1 + it]; bool keep[4][4];
            if (code < 64) {
                const int j = code;
                if (j < 32) { const int phys = A.page_table[sb * NPAGES + (j >> 1)];
                    const float* base = A.cache + ((((size_t)l * NPOOL + phys) * 2 + kvh) * 128 + (j & 1) * 64) * 256;
                    const bool tsel = ((tm >> j) & 1u) != 0u;
#pragma unroll
                    for (int tk = 0; tk < 4; ++tk)
#pragma unroll
                        for (int i = 0; i < 4; ++i) keep[tk][i] = tsel;
                    s2_block<true>(base + 128, base + 192, 256, 64, qf, keep, Os, ms, lsum, fr, fq);
                } else {
#pragma unroll
                    for (int tk = 0; tk < 4; ++tk)
#pragma unroll
                        for (int i = 0; i < 4; ++i) { const int key = 16 * tk + 4 * fq + i; keep[tk][i] = key <= qi; }
                    s2_block<false>(A.KS + ((size_t)MP + sb * 4) * 128 + kvh * 64, A.VS + ((size_t)MP + sb * 4) * 128 + kvh * 64, 128, 4, qf, keep, Os, ms, lsum, fr, fq);
                }
            } else {
                const int jb = code - 64;
                if (jb < 8) {
#pragma unroll
                    for (int tk = 0; tk < 4; ++tk)
#pragma unroll
                        for (int i = 0; i < 4; ++i) { const int r = 64 * jb + 16 * tk + 4 * fq + i; keep[tk][i] = r >= qi; }
                    s2_block<true>(wb + (size_t)(64 * jb) * 256, wb + (size_t)(64 * jb) * 256 + 128, 256, 64, qf, keep, Ow, mw, lw, fr, fq);
                } else {
#pragma unroll
                    for (int tk = 0; tk < 4; ++tk)
#pragma unroll
                        for (int i = 0; i < 4; ++i) { const int key = 16 * tk + 4 * fq + i; keep[tk][i] = key <= qi; }
                    s2_block<false>(A.KW + ((size_t)MP + sb * 4) * 128 + kvh * 64, A.VW + ((size_t)MP + sb * 4) * 128 + kvh * 64, 128, 4, qf, keep, Ow, mw, lw, fr, fq);
                }
            }
        }
        lsum += __shfl_xor(lsum, 16); lsum += __shfl_xor(lsum, 32); lw += __shfl_xor(lw, 16); lw += __shfl_xor(lw, 32);
        float* Ps = (float*)(lds + S2_MG + (wave * 2 + 0) * S2_MG_STRIDE); float* Pw = (float*)(lds + S2_MG + (wave * 2 + 1) * S2_MG_STRIDE);
#pragma unroll
        for (int td = 0; td < 4; ++td)
#pragma unroll
            for (int i = 0; i < 4; ++i) { Ps[(16 * fq + 4 * i + td) * 16 + fr] = Os[td][i]; Pw[(16 * fq + 4 * i + td) * 16 + fr] = Ow[td][i]; }
        if (fq == 0) { Ps[1024 + fr] = ms; Ps[1040 + fr] = lsum; Pw[1024 + fr] = mw; Pw[1040 + fr] = lw; }
    }
    __syncthreads();
    {
        const int q = tid & 15, i = q >> 2, hh = q & 3; const size_t m = (size_t)MP + sb * 4 + i;
        const float* OC = (const float*)(lds + S2_OC);
        float res[2];
#pragma unroll
        for (int k = 0; k < 2; ++k) res[k] = OC[((tid >> 4) + 32 * k) * 16 + q];
#pragma unroll
        for (int br = 0; br < 2; ++br) {
            float M = NEG_INF;
#pragma unroll
            for (int w = 0; w < NWAVES; ++w) M = fmaxf(M, ((const float*)(lds + S2_MG + (w * 2 + br) * S2_MG_STRIDE))[1024 + q]);
            float L = 0.f, o0 = 0.f, o1 = 0.f;
#pragma unroll
            for (int w = 0; w < NWAVES; ++w) { const float* P = (const float*)(lds + S2_MG + (w * 2 + br) * S2_MG_STRIDE);
                const float f = ex2(P[1024 + q] - M);
                L += P[1040 + q] * f; o0 += P[(tid >> 4) * 16 + q] * f; o1 += P[((tid >> 4) + 32) * 16 + q] * f; }
            const float g = sigmoidf_(A.PROJ[m * NP + C_GATE + (kvh * 4 + hh) * 3 + 1 + br]) / fmaxf(L, 1e-30f);
            res[0] += g * o0; res[1] += g * o1;
        }
#pragma unroll
        for (int k = 0; k < 2; ++k) A.MIX[m * 1024 + 512 + (kvh * 4 + hh) * 64 + (tid >> 4) + 32 * k] = (bf16)f2bf(res[k]);
    }
}

constexpr int CW_CMPQ = 256;
__device__ __forceinline__ void compress_pull(const CmpArgs& A, unsigned char* lds, unsigned* head, volatile LAS int* slot, int max_batches, int tid) {
    for (int nb = 0; nb < max_batches; ++nb) {
        __syncthreads();
        if (tid == 0) *slot = (int)__hip_atomic_fetch_add(head, 1u, __ATOMIC_RELAXED, __HIP_MEMORY_SCOPE_AGENT);
        __syncthreads();
        const int b = *slot;
        if (b >= 256) break;
        compress_batch(A, lds, b, true, tid);
    }
    __syncthreads();
}

struct Args { const GAS void* in[22]; GAS float* out; GAS unsigned char* ws; int ph_lo, ph_hi; };
constexpr int PH_PER_LAYER = 10, N_PHASES = 1 + NL * PH_PER_LAYER;
__global__ void __launch_bounds__(NWAVES * 64, 2) hymba_fwd(Args args) {
    extern __shared__ __attribute__((aligned(16))) unsigned char lds[];
    const int G = gridDim.x, bx = blockIdx.x, NGW = G * NWAVES;
    const int wave_s_ = __builtin_amdgcn_readfirstlane((int)threadIdx.x >> 6);
#define TID_NOW() (wave_s_ * 64 + (int)__builtin_amdgcn_mbcnt_hi(~0u, __builtin_amdgcn_mbcnt_lo(~0u, 0u)))
#define SUB_IDS int tid = TID_NOW(); asm volatile("" : "+v"(tid)); const int lane = tid & 63, wave = __builtin_amdgcn_readfirstlane(tid >> 6), gw = bx * NWAVES + wave; (void)lane; (void)gw; (void)wave;
#define PHASE_IDS int tid = TID_NOW(); asm volatile("" : "+v"(tid)); const int lane = tid & 63, wave = __builtin_amdgcn_readfirstlane(tid >> 6), gw = bx * NWAVES + wave; (void)lane; (void)gw; const __attribute__((address_space(4))) unsigned long long* ka_ = (const __attribute__((address_space(4))) unsigned long long*)__builtin_amdgcn_kernarg_segment_ptr(); asm volatile("" : "+s"(ka_)); GAS unsigned char* wsg_ = (GAS unsigned char*)ka_[23]; unsigned char* wsl = (unsigned char*)wsg_;
#define x_prompt ((const float*)(const GAS float*)ka_[0])
#define x_sample ((const float*)(const GAS float*)ka_[1])
#define cache_kv ((const float*)(const GAS float*)ka_[2])
#define page_table ((const int*)(const GAS int*)ka_[3])
#define state_win ((const float*)(const GAS float*)ka_[4])
#define state_gdn ((const float*)(const GAS float*)ka_[5])
#define state_conv ((const float*)(const GAS float*)ka_[6])
#define norm_mix ((const float*)(const GAS float*)ka_[7])
#define w_in ((const float*)(const GAS float*)ka_[8])
#define conv_w ((const float*)(const GAS float*)ka_[9])
#define a_log ((const float*)(const GAS float*)ka_[10])
#define dt_bias ((const float*)(const GAS float*)ka_[11])
#define gdn_norm ((const float*)(const GAS float*)ka_[12])
#define cmp_pe_k ((const float*)(const GAS float*)ka_[13])
#define cmp_w_k ((const float*)(const GAS float*)ka_[14])
#define cmp_pe_v ((const float*)(const GAS float*)ka_[15])
#define cmp_w_v ((const float*)(const GAS float*)ka_[16])
#define w_out ((const float*)(const GAS float*)ka_[17])
#define norm_mlp ((const float*)(const GAS float*)ka_[18])
#define w_up ((const float*)(const GAS float*)ka_[19])
#define w_down ((const float*)(const GAS float*)ka_[20])
#define norm_final ((const float*)(const GAS float*)ka_[21])
#define out ((float*)(GAS float*)ka_[22])
#define WIN_T ((bf16*)(wsl + WS_WIN))
#define WOUT_T ((bf16*)(wsl + WS_WOUT))
#define WUP_T ((bf16*)(wsl + WS_WUP))
#define WDN_T ((bf16*)(wsl + WS_WDN))
#define CMPW ((bf16*)(wsl + WS_CMPW))
#define HB ((bf16*)(wsl + WS_HB))
#define PROJ ((float*)(wsl + WS_PROJ))
#define X1 ((float*)(wsl + WS_X1))
#define X2 ((float*)(wsl + WS_X2))
#define MIX ((bf16*)(wsl + WS_MIX))
#define HID ((bf16*)(wsl + WS_HID))
#define QN ((float*)(wsl + WS_QN))
#define KN ((float*)(wsl + WS_KN))
#define VG ((float*)(wsl + WS_VG))
#define OG ((float*)(wsl + WS_OG))
#define GG ((float*)(wsl + WS_G))
#define BETA ((float*)(wsl + WS_BETA))
#define KQ ((float*)(wsl + WS_KQ))
#define QB ((bf16*)(wsl + WS_QB))
#define KS ((bf16*)(wsl + WS_KS))
#define VS ((bf16*)(wsl + WS_VS))
#define KW ((bf16*)(wsl + WS_KW))
#define VW ((bf16*)(wsl + WS_VW))
#define CKP ((float*)(wsl + WS_CKP))
#define CVP ((float*)(wsl + WS_CVP))
#define CKS ((float*)(wsl + WS_CKS))
#define CVS ((float*)(wsl + WS_CVS))
#define GK ((bf16*)(wsl + WS_GK))
#define GQ ((bf16*)(wsl + WS_GQ))
#define GKT ((bf16*)(wsl + WS_GKT))
#define GVT ((bf16*)(wsl + WS_GVT))
#define GG2 ((float*)(wsl + WS_GG2))
#define BETA2 ((float*)(wsl + WS_BETA2))
#define WX ((bf16*)(wsl + WS_WX))
#define QX ((bf16*)(wsl + WS_QX))
#define QKX ((bf16*)(wsl + WS_QKX))
#define KTX ((bf16*)(wsl + WS_KTX))
#define U0F ((float*)(wsl + WS_U0F))
#define GL ((float*)(wsl + WS_GL))
#define PARTD ((float*)(wsl + WS_PARTD))
#define PARTG ((float*)(wsl + WS_PARTG))
    LAS unsigned char* ldsl = (LAS unsigned char*)lds;

    const int lo = args.ph_lo, hi = args.ph_hi;
    { const int t0_ = TID_NOW(); if (t0_ < 16) ((LAS unsigned*)(ldsl + MISC_OFF))[t0_] = 0u; }
    __syncthreads();
    XcdBarrier bar = xcd_barrier_post((unsigned*)((unsigned char*)args.ws + WS_CTL) + CW_BAR, (volatile LAS unsigned*)(ldsl + MISC_OFF), TID_NOW() == 0);
#define BOTH(k) (lo <= (k) && (k) + 1 < hi)
#define GRID_BAR(k) do { if (BOTH(k)) { for (int rb_ = 0; rb_ < REP_BAR; ++rb_) xcd_barrier(bar, TID_NOW() == 0); } } while (0)
#ifndef REP_PG
#define REP_PG 1
#endif
#ifndef REP_PA
#define REP_PA 1
#endif
#ifndef REP_BAR
#define REP_BAR 1
#endif
#ifndef REP_GSMP
#define REP_GSMP 1
#endif
#ifndef REP_P0
#define REP_P0 1
#endif
#ifndef REP_LIGHT
#define REP_LIGHT 1
#endif
#ifndef REP_PB_ROW
#define REP_PB_ROW 1
#endif
#ifndef REP_PB_PREP
#define REP_PB_PREP 1
#endif
#ifndef REP_PB_CMP
#define REP_PB_CMP 1
#endif
#ifndef REP_PB_COPY
#define REP_PB_COPY 1
#endif
#ifndef REP_PB2
#define REP_PB2 1
#endif
#ifndef REP_SCAN
#define REP_SCAN 1
#endif
#ifndef REP_ATTP
#define REP_ATTP 1
#endif
#ifndef REP_ATTS
#define REP_ATTS 1
#endif
#ifndef REP_GEMM
#define REP_GEMM 1
#endif
#define EN(i) (((PH_MASK_T) >> (i)) & 1u)
#define SUB(i) (((SUB_MASK_T) >> (i)) & 1u)
#define IN(k) (lo <= (k) && (k) < hi)

    if (IN(0)) { PHASE_IDS
        for (int rep0 = 0; rep0 < REP_P0; ++rep0) {
        LAS float* scr = (LAS float*)(ldsl + wave * 16384);
        constexpr int I_IN = 16 * 112, I_OUT = 16 * 32, I_UP = 16 * 128, I_DN = 64 * 32, I_C = 32 * 2, I_L = I_IN + I_OUT + I_UP + I_DN + 2 * I_C;
        for (int it = gw; it < NL * I_L; it += NGW) {
            const int l = it / I_L; int r = it % I_L;
            if (r < I_IN) { transpose_item(w_in + (size_t)l * DM * NPROJ, DM, NPROJ, NP, WIN_T + (size_t)l * NP * DM, scr, r, lane); continue; } r -= I_IN;
            if (r < I_OUT) { transpose_item(w_out + (size_t)l * DM * DM, DM, DM, DM, WOUT_T + (size_t)l * DM * DM, scr, r, lane); continue; } r -= I_OUT;
            if (r < I_UP) { transpose_item(w_up + (size_t)l * DM * DFF, DM, DFF, DFF, WUP_T + (size_t)l * DFF * DM, scr, r, lane); continue; } r -= I_UP;
            if (r < I_DN) { transpose_item(w_down + (size_t)l * DFF * DM, DFF, DM, DM, WDN_T + (size_t)l * DM * DFF, scr, r, lane); continue; } r -= I_DN;
            if (r < I_C) { transpose_item(cmp_w_k + (size_t)l * 2048 * 64, 2048, 64, 64, CMPW + (size_t)((l * 2 + 0) * 64) * 2048, scr, r, lane); continue; } r -= I_C;
            transpose_item(cmp_w_v + (size_t)l * 2048 * 64, 2048, 64, 64, CMPW + (size_t)((l * 2 + 1) * 64) * 2048, scr, r, lane);
        }
        for (int m = gw; m < MT; m += NGW) { const float* xr = (m < MP) ? x_prompt + (size_t)m * DM : x_sample + (size_t)(m - MP) * DM; rms_row(xr, norm_mix, HB + (size_t)m * DM, nullptr, lane); }
        }
    }

    GRID_BAR(0);
    for (int l = 0; l < NL; ++l) {
        const int pb = 1 + l * PH_PER_LAYER;
        if (IN(pb + 0)) { PHASE_IDS
            pg8::Gemm g{HB, WIN_T + (size_t)l * NP * DM, MT, NP, DM, DM}; pg8::StaticOrder S; S.init(MT, NP, G, bx);
            pg8::EpiF32 E{PROJ, NP};
            _Pragma("unroll 1") for (int rep = 0; rep < REP_PA; ++rep) pg8::gemm_phase<pg8::EpiF32, pg8::StaticOrder, true, true>(ldsl, g, S, E, tid);
            if (l == 0 && bx >= (MT / 256) * (NP / 256) % G) { SUB_IDS CmpArgs CA{PROJ, cache_kv, page_table, cmp_pe_k, cmp_pe_v, CMPW, wsl, 0};
                compress_pull(CA, lds, (unsigned*)(wsl + WS_CTL) + CW_CMPQ, (volatile LAS int*)(ldsl + MISC_OFF + 36), 1, tid); }
        }
        GRID_BAR(pb + 0);
        if (IN(pb + 1)) { PHASE_IDS
            { SUB_IDS PBArgs A{PROJ, state_conv, conv_w, a_log, dt_bias, QN, KN, VG, GG, BETA, KQ, QB, KS, VS, KW, VW, out, l};
              for (int rep = 0; rep < REP_PB_ROW; ++rep) if (gw >= 128) for (int m = gw - 128; m < MT; m += 2 * (NGW - 128)) {
                  const int m2 = m + (NGW - 128); const bool has2 = m2 < MT; PBRegs r0, r1;
                  pb_row_load(A, m, lane, r0); pb_row_load(A, has2 ? m2 : m, lane, r1);
                  __builtin_amdgcn_sched_barrier(0);
                  pb_row(A, m, lane, r0); if (has2) pb_row(A, m2, lane, r1); }
              for (int u = gw; u < MS * 8; u += NGW) pb_sample_head(A, u, lane); }
            { SUB_IDS GPArgs A{PROJ, conv_w, a_log, dt_bias, GK, GQ, GKT, GVT, GG2, BETA2, l};
              for (int rep = 0; rep < REP_PB_PREP; ++rep) for (int u = gw; u < (MP / 8) * 8; u += 2 * NGW) {
                  GPRegs r0, r1; const int u2 = (u + NGW < (MP / 8) * 8) ? u + NGW : u; gdn_prep_load(A, u, lane, r0); gdn_prep_load(A, u2, lane, r1);
                  __builtin_amdgcn_sched_barrier(0);
                  gdn_prep_unit(A, u, lane, r0); gdn_prep_unit(A, u2, lane, r1); } }
            { SUB_IDS CmpArgs A{PROJ, cache_kv, page_table, cmp_pe_k, cmp_pe_v, CMPW, wsl, l};
              if (bx < 16) compress_batch(A, lds, bx, false, tid);
              compress_pull(A, lds, (unsigned*)(wsl + WS_CTL) + CW_CMPQ + 64 * l, (volatile LAS int*)(ldsl + MISC_OFF + 36), 1 << 20, tid); }
        }
        GRID_BAR(pb + 1);
        if (IN(pb + 2)) { PHASE_IDS
            GCArgs A{GK, GQ, GKT, GVT, GG2, BETA2, WX, QX, QKX, KTX, U0F, GL};
            for (int rep = 0; rep < REP_PB2; ++rep) for (int u = gw; u < 32 * 64; u += NGW) gdn_chunk_unit(A, lds + wave * GC_LDS_PER_WAVE, u, lane);
        }
        GRID_BAR(pb + 2);
        if (IN(pb + 3)) {
            { PHASE_IDS GdnArgs GA{QN, KN, VG, GG, BETA, KQ, OG, PROJ, state_gdn, gdn_norm, MIX, out, l};
                for (int rep = 0; rep < REP_GSMP; ++rep) for (int u = gw; u < NSB * 8; u += NGW) gdn_sample_unit(GA, u, lane); }
            { PHASE_IDS
                GS2Args SG{WX, QX, QKX, KTX, U0F, GL, OG, out, l};
                AttArgs AA{QB, KS, VS, KW, VW, CKP, CVP, PROJ, MIX};
                SAttArgs SA{QB, KS, VS, KW, VW, CKS, CVS, PROJ, cache_kv, page_table, state_win, MIX, l};
                unsigned* qhead = (unsigned*)(wsl + WS_CTL) + CW_QUEUE + 64 * l;
                volatile LAS int* slot = (volatile LAS int*)(ldsl + MISC_OFF + 32);
                for (;;) {
                    __syncthreads();
                    if (tid == 0) *slot = (int)__hip_atomic_fetch_add(qhead, 1u, __ATOMIC_RELAXED, __HIP_MEMORY_SCOPE_AGENT);
                    __syncthreads();
                    int u = *slot;
                    constexpr int XP = (REP_ATTP - 1) * 512, XS = (REP_ATTS - 1) * 256, XG = (REP_SCAN - 1) * 32;
                    if (u >= 800 + XP + XS + XG + 128) break;
                    if (u >= 800 + XP + XS + XG) {
                        const int sb = u - (800 + XP + XS + XG); const f32x4* src = (const f32x4*)(state_win + ((size_t)l * NSB + sb) * 512 * 256) + 256; f32x4* dst = (f32x4*)(out + O_WINS + ((size_t)l * NSB + sb) * 512 * 256);
                        for (int i = tid; i < 508 * 64; i += 8 * NWAVES * 64) { f32x4 v[8];
#pragma unroll
                            for (int k = 0; k < 8; ++k) { const int ii = i + k * NWAVES * 64; v[k] = src[ii < 508 * 64 ? ii : i]; }
#pragma unroll
                            for (int k = 0; k < 8; ++k) { const int ii = i + k * NWAVES * 64; if (ii < 508 * 64) dst[ii] = v[k]; } }
                        continue; }
                    if (u >= 800) { int v = u - 800; if (v < XP) u = 32 + (v & 511); else { v -= XP; if (v < XS) u = 544 + (v & 255); else u = (v - XS) & 31; } }
                    int tq = TID_NOW(); asm volatile("" : "+v"(tq));
                    if (u < 32) gdn_scan3_block(SG, lds, u, tq);
                    else if (u < 32 + 512) nsa_prompt_unit(AA, lds, u - 32, tq);
                    else nsa_sample_unit(SA, lds, u - 544, tq);
                }
            }
        }
        GRID_BAR(pb + 3);
        if (IN(pb + 4)) { PHASE_IDS
            const float gnl = gdn_norm[l * 64 + lane];
            for (int rep = 0; rep < REP_LIGHT; ++rep) for (int m = gw; m < MP; m += NGW) {
                float ov[8], zv[8];
#pragma unroll
                for (int h = 0; h < 8; ++h) { ov[h] = OG[(size_t)m * 512 + h * 64 + lane]; zv[h] = PROJ[(size_t)m * NP + C_Z + h * 64 + lane]; }
                __builtin_amdgcn_sched_barrier(0);
#pragma unroll
                for (int h = 0; h < 8; ++h) { const float ms = dpp_sum(ov[h] * ov[h]) * (1.f / 64.f);
                    MIX[(size_t)m * 1024 + h * 64 + lane] = (bf16)f2bf(ov[h] * (1.f / sqrtf(ms + 1e-6f)) * gnl * siluf_(zv[h])); } }
        }
        GRID_BAR(pb + 4);
        if (IN(pb + 5)) { PHASE_IDS
            { pg8::Gemm g{MIX, WOUT_T + (size_t)l * DM * DM, MP, DM, DM, DM}; pg8::StaticOrder S; S.init(MP, DM, G, bx);
              const float* rb = (l == 0) ? x_prompt : (const float*)X2;
              pg8::EpiResid E{rb, rb, MP, X1, DM};
              pg8::gemm_phase<pg8::EpiResid, pg8::StaticOrder, true, true>(ldsl, g, S, E, tid); }
            { pg8::Gemm g{MIX, WOUT_T + (size_t)l * DM * DM, MT, DM, PD_KL, DM}; pg8::SplitKOrder S; S.init(MP / 256, MS / 256, DM / 256, PD_KS, PD_KL, G, bx);
              pg8::EpiPart E{PARTD, DM, MP, MS};
              pg8::gemm_phase<pg8::EpiPart, pg8::SplitKOrder, false, true>(ldsl, g, S, E, tid); }
        }
        GRID_BAR(pb + 5);
        if (IN(pb + 6)) { PHASE_IDS
            for (int m = gw; m < MP; m += 2 * NGW) { const int m2 = m + NGW;
                if (m2 < MP) rms_row2(X1 + (size_t)m * DM, X1 + (size_t)m2 * DM, norm_mlp + (size_t)l * DM, HB + (size_t)m * DM, HB + (size_t)m2 * DM, nullptr, nullptr, lane);
                else rms_row(X1 + (size_t)m * DM, norm_mlp + (size_t)l * DM, HB + (size_t)m * DM, nullptr, lane); }
            for (int m = MP + gw; m < MT; m += NGW) { const float* bs = (l == 0) ? x_sample + (size_t)(m - MP) * DM : (const float*)X2 + (size_t)m * DM;
                rms_row_parts(bs, PARTD + (size_t)(m - MP) * DM, PD_KS, (size_t)MS * DM, X1 + (size_t)m * DM, norm_mlp + (size_t)l * DM, HB + (size_t)m * DM, nullptr, lane); } }
        GRID_BAR(pb + 6);
        if (IN(pb + 7)) { PHASE_IDS
            pg8::Gemm g{HB, WUP_T + (size_t)l * DFF * DM, MT, DFF, DM, DM}; pg8::StaticOrder S; S.init(MT, DFF, G, bx);
            pg8::EpiRelu2 E{HID, DFF};
            pg8::gemm_phase<pg8::EpiRelu2, pg8::StaticOrder, true, true>(ldsl, g, S, E, tid);
            if (l + 1 < NL && bx >= (MT / 256) * (DFF / 256) % G) { SUB_IDS CmpArgs CA{PROJ, cache_kv, page_table, cmp_pe_k, cmp_pe_v, CMPW, wsl, l + 1};
                compress_pull(CA, lds, (unsigned*)(wsl + WS_CTL) + CW_CMPQ + 64 * (l + 1), (volatile LAS int*)(ldsl + MISC_OFF + 36), 1, tid); }
        }
        GRID_BAR(pb + 7);
        if (IN(pb + 8)) { PHASE_IDS
            { pg8::Gemm g{HID, WDN_T + (size_t)l * DM * DFF, MP, DM, DFF, DFF}; pg8::StaticOrder S; S.init(MP, DM, G, bx);
              pg8::EpiResid E{X1, X1, MP, X2, DM};
              pg8::gemm_phase<pg8::EpiResid, pg8::StaticOrder, true, true>(ldsl, g, S, E, tid); }
            { pg8::Gemm g{HID, WDN_T + (size_t)l * DM * DFF, MT, DM, PG_KL, DFF}; pg8::SplitKOrder S; S.init(MP / 256, MS / 256, DM / 256, PG_KS, PG_KL, G, bx);
              pg8::EpiPart E{PARTG, DM, MP, MS};
              pg8::gemm_phase<pg8::EpiPart, pg8::SplitKOrder, false, true>(ldsl, g, S, E, tid); }
        }
        GRID_BAR(pb + 8);
        if (IN(pb + 9)) { PHASE_IDS
            const float* gn = (l + 1 < NL) ? norm_mix + (size_t)(l + 1) * DM : norm_final; const bool fin = !(l + 1 < NL);
            for (int m = gw; m < MP; m += 2 * NGW) { const int m2 = m + NGW;
                if (m2 < MP) rms_row2(X2 + (size_t)m * DM, X2 + (size_t)m2 * DM, gn, fin ? nullptr : HB + (size_t)m * DM, fin ? nullptr : HB + (size_t)m2 * DM, fin ? out + O_YP + (size_t)m * DM : nullptr, fin ? out + O_YP + (size_t)m2 * DM : nullptr, lane);
                else rms_row(X2 + (size_t)m * DM, gn, fin ? nullptr : HB + (size_t)m * DM, fin ? out + O_YP + (size_t)m * DM : nullptr, lane); }
            for (int m = MP + gw; m < MT; m += NGW)
                rms_row_parts(X1 + (size_t)m * DM, PARTG + (size_t)(m - MP) * DM, PG_KS, (size_t)MS * DM, X2 + (size_t)m * DM, gn, fin ? nullptr : HB + (size_t)m * DM, fin ? out + O_YP + (size_t)m * DM : nullptr, lane);
        }
        GRID_BAR(pb + 9);
    }
#undef IN
}

#undef x_prompt
#undef x_sample
#undef cache_kv
#undef page_table
#undef state_win
#undef state_gdn
#undef state_conv
#undef norm_mix
#undef w_in
#undef conv_w
#undef a_log
#undef dt_bias
#undef gdn_norm
#undef cmp_pe_k
#undef cmp_w_k
#undef cmp_pe_v
#undef cmp_w_v
#undef w_out
#undef norm_mlp
#undef w_up
#undef w_down
#undef norm_final
#undef out
#ifndef MK_PER_PHASE
#define MK_PER_PHASE 0
#endif
typedef void (*kfn_t)(Args); static const kfn_t K_ALL = hymba_fwd;
extern "C" void kernel_launch(void* const* d_in, const int* in_sizes, int n_in, void* d_out, int out_size, void* d_ws, size_t ws_size, hipStream_t stream) {
    static int grid = 0;
    if (grid == 0) {
        if (n_in != 22 || out_size != (int)O_END || ws_size < WS_END) { fprintf(stderr, "kernel_launch: unexpected shapes (n_in %d, out %d, ws %zu)\n", n_in, out_size, ws_size); grid = -1; return; }
        int dev = 0, cus = 0, per_cu = 0;
        if (hipGetDevice(&dev) != hipSuccess || hipDeviceGetAttribute(&cus, hipDeviceAttributeMultiprocessorCount, dev) != hipSuccess) { grid = -1; return; }
        if (hipFuncSetAttribute((const void*)K_ALL, hipFuncAttributeMaxDynamicSharedMemorySize, LDS_BYTES) != hipSuccess) { fprintf(stderr, "kernel_launch: hipFuncSetAttribute failed\n"); grid = -1; return; }
        if (hipOccupancyMaxActiveBlocksPerMultiprocessor(&per_cu, (const void*)K_ALL, NWAVES * 64, LDS_BYTES) != hipSuccess || per_cu < 1) { fprintf(stderr, "kernel_launch: occupancy query says %d blocks per CU\n", per_cu); }
        (void)hipGetLastError();
        grid = cus;
    }
    if (grid < 0) return;
    (void)hipMemsetAsync((char*)d_ws + WS_CTL, 0, CTL_ZERO_BYTES, stream);
    Args a{};
    for (int i = 0; i < 22; ++i) a.in[i] = (const GAS void*)d_in[i];
    a.out = (GAS float*)d_out; a.ws = (GAS unsigned char*)d_ws;
    const dim3 g(grid), b(NWAVES * 64);
#if MK_PER_PHASE
    for (int ph = 0; ph < N_PHASES; ++ph) { a.ph_lo = ph; a.ph_hi = ph + 1; K_ALL<<<g, b, LDS_BYTES, stream>>>(a); }
#else
    a.ph_lo = 0; a.ph_hi = N_PHASES; K_ALL<<<g, b, LDS_BYTES, stream>>>(a);
#endif
}
```

```cpp
#include <hip/hip_runtime.h>
#include <cstdio>
#include <cstdint>
namespace pg8 {
#define PG8_LAS __attribute__((address_space(3)))
typedef unsigned short bf16_t;
typedef short bf16x8 __attribute__((ext_vector_type(8)));
typedef float f32x4 __attribute__((ext_vector_type(4)));
typedef unsigned u32x4 __attribute__((ext_vector_type(4)));
constexpr int BM = 256, BK = 64, HALF = 128, HTB = HALF * BK * 2  , STAGE_BYTES = 8 * HTB, NXCD = 8, WGM = 8;

__host__ __device__ __forceinline__ int lds_byte(int r, int c) { const int st = (r >> 4) * 2 + (c >> 5), rr = r & 15, cc = c & 31, ob = rr * 64 + cc * 2; return st * 1024 + (ob ^ (((ob >> 9) & 1) << 5)); }
__host__ __device__ __forceinline__ void stage_rc(int b, int& R, int& C) { const int st = b / 1024, sb = b % 1024, swz = sb ^ (((sb >> 9) & 1) << 5); R = (st >> 1) * 16 + swz / 64; C = (st & 1) * 32 + (swz % 64) / 2; }
__host__ __device__ __forceinline__ int perm32(int rho) { const int n = rho >> 4, i = rho & 15; return 8 * (i >> 2) + 4 * n + (i & 3); }

struct Unit { int pm, pn, kofs, kc; };
struct Gemm { const bf16_t* A; const bf16_t* Bt; int M, N, K, ld; };

struct StaticOrder {
    int nM, nN, nwg, G, c;
    __host__ __device__ void init(int M, int N, int G_, int c_) { nM = M / BM; nN = N / BM; nwg = nM * nN; G = G_; c = c_; }
    __host__ __device__ bool next(int i, Unit& u) const {
        const long L = (long)i * G + c; if (L >= nwg) return false;
        int wgid = (int)L; { const int q = nwg / NXCD, r = nwg % NXCD, xcd = wgid % NXCD, off = wgid / NXCD; wgid = (xcd < r ? xcd * (q + 1) : r * (q + 1) + (xcd - r) * q) + off; }
        const int nig = WGM * nN, gid = wgid / nig, fm = gid * WGM, gsz = (nM - fm) < WGM ? (nM - fm) : WGM;
        u.pm = fm + ((wgid % nig) % gsz); u.pn = (wgid % nig) / gsz; u.kofs = 0; u.kc = 0; return true;
    }
    __device__ __forceinline__ void a_ready(const Unit&) const {}
    __device__ __forceinline__ void done(const Unit&) const {}
};

__device__ __forceinline__ unsigned cvt_pk_bf16(float lo, float hi) { unsigned r; asm volatile("v_cvt_pk_bf16_f32 %0, %1, %2" : "=v"(r) : "v"(lo), "v"(hi)); return r; }

struct EpiF32 {
    static constexpr bool PERM = false, AFTER_DRAIN = false;
    float* O; int ldc;
    __device__ __forceinline__ void operator()(const f32x4 (&acc)[2][2][4][2], const Unit& u, int wr, int wc, int fr, int fq) const {
        const int row0 = u.pm * BM + wr * 64 + fr, col0 = u.pn * BM + wc * 32 + 4 * fq;
#pragma unroll
        for (int ai = 0; ai < 2; ++ai)
#pragma unroll
            for (int m = 0; m < 4; ++m) { float* rowp = O + (size_t)(row0 + ai * HALF + m * 16) * ldc + col0;
#pragma unroll
                for (int bj = 0; bj < 2; ++bj)
#pragma unroll
                    for (int n = 0; n < 2; ++n) *(f32x4*)(rowp + bj * HALF + n * 16) = acc[ai][bj][m][n]; }
    }
};
struct EpiResid {
    static constexpr bool PERM = false, AFTER_DRAIN = false;
    const void* base; bool base_bf; bf16_t* O; int ldc;
    __device__ __forceinline__ void operator()(const f32x4 (&acc)[2][2][4][2], const Unit& u, int wr, int wc, int fr, int fq) const {
        const int row0 = u.pm * BM + wr * 64 + fr, col0 = u.pn * BM + wc * 32 + 4 * fq;
        typedef unsigned u32x2_ __attribute__((ext_vector_type(2)));
#pragma unroll
        for (int ai = 0; ai < 2; ++ai)
#pragma unroll
            for (int m = 0; m < 4; ++m) { const size_t off = (size_t)(row0 + ai * HALF + m * 16) * ldc + col0;
#pragma unroll
                for (int bj = 0; bj < 2; ++bj)
#pragma unroll
                    for (int n = 0; n < 2; ++n) { const size_t o2 = off + bj * HALF + n * 16; f32x4 r;
                        if (base_bf) { const u32x2_ w = *(const u32x2_*)((const bf16_t*)base + o2);
                            r = (f32x4){__builtin_bit_cast(float, w.x << 16), __builtin_bit_cast(float, w.x & 0xffff0000u), __builtin_bit_cast(float, w.y << 16), __builtin_bit_cast(float, w.y & 0xffff0000u)}; }
                        else r = *(const f32x4*)((const float*)base + o2);
                        r += acc[ai][bj][m][n];
                        u32x2_ ow; ow.x = cvt_pk_bf16(r[0], r[1]); ow.y = cvt_pk_bf16(r[2], r[3]); *(u32x2_*)(O + o2) = ow; } }
    }
};
struct EpiRelu2 {
    static constexpr bool PERM = true, AFTER_DRAIN = false;
    bf16_t* O; int ldc;
    __device__ __forceinline__ void operator()(const f32x4 (&acc)[2][2][4][2], const Unit& u, int wr, int wc, int fr, int fq) const {
        const int row0 = u.pm * BM + wr * 64 + fr, col0 = u.pn * BM + wc * 32 + 8 * fq;
#pragma unroll
        for (int ai = 0; ai < 2; ++ai)
#pragma unroll
            for (int m = 0; m < 4; ++m) { bf16_t* rowp = O + (size_t)(row0 + ai * HALF + m * 16) * ldc + col0;
#pragma unroll
                for (int bj = 0; bj < 2; ++bj) { f32x4 v0 = acc[ai][bj][m][0], v1 = acc[ai][bj][m][1];
#pragma unroll
                    for (int i = 0; i < 4; ++i) { const float a = v0[i] > 0.f ? v0[i] : 0.f, b = v1[i] > 0.f ? v1[i] : 0.f; v0[i] = a * a; v1[i] = b * b; }
                    u32x4 w; w.x = cvt_pk_bf16(v0[0], v0[1]); w.y = cvt_pk_bf16(v0[2], v0[3]); w.z = cvt_pk_bf16(v1[0], v1[1]); w.w = cvt_pk_bf16(v1[2], v1[3]);
                    *(u32x4*)(rowp + bj * HALF) = w; } }
    }
};

struct SplitKOrder {
    int pm0, nN, KS, KL, total, G, c;
    __host__ __device__ void init(int pm0_, int nPm, int nN_, int KS_, int KL_, int G_, int c_) { pm0 = pm0_; nN = nN_; KS = KS_; KL = KL_; total = nPm * nN_ * KS_; G = G_; c = c_; }
    __host__ __device__ bool next(int i, Unit& u) const {
        const long L = (long)i * G + c; if (L >= total) return false;
        const int l = (int)L, kc = l % KS, rest = l / KS; u.pn = rest % nN; u.pm = pm0 + rest / nN; u.kofs = kc * KL; u.kc = kc; return true; }
    __device__ __forceinline__ void a_ready(const Unit&) const {}
    __device__ __forceinline__ void done(const Unit&) const {}
};
struct EpiPart {
    static constexpr bool PERM = false, AFTER_DRAIN = false;
    float* P; int ldc; int row0; int rows;
    __device__ __forceinline__ void operator()(const f32x4 (&acc)[2][2][4][2], const Unit& u, int wr, int wc, int fr, int fq) const {
        const int rowl = u.pm * BM - row0 + wr * 64 + fr, col0 = u.pn * BM + wc * 32 + 4 * fq;
        float* base = P + (size_t)u.kc * rows * ldc;
#pragma unroll
        for (int ai = 0; ai < 2; ++ai)
#pragma unroll
            for (int m = 0; m < 4; ++m) { float* rowp = base + (size_t)(rowl + ai * HALF + m * 16) * ldc + col0;
#pragma unroll
                for (int bj = 0; bj < 2; ++bj)
#pragma unroll
                    for (int n = 0; n < 2; ++n) *(f32x4*)(rowp + bj * HALF + n * 16) = acc[ai][bj][m][n]; }
    }
};
template <class Epi, class Sched, bool ALIGN_EPI = false, bool SP2 = false>
__device__ __forceinline__ void gemm_phase(PG8_LAS unsigned char* lds, const Gemm g, const Sched& S, const Epi& E, int tid_in) {
    int tid = tid_in; asm volatile("" : "+v"(tid));
    const int wid = __builtin_amdgcn_readfirstlane(tid >> 6), lane = tid & 63, wr = wid >> 2, wc = wid & 3, fr = lane & 15, fq = lane >> 4;
    const int K = g.ld, nt = g.K / BK;
    unsigned voffA[2], voffB[2];
#pragma unroll
    for (int i = 0; i < 2; ++i) { int R, C; stage_rc(tid * 16 + i * 8192, R, C); const int Rb = Epi::PERM ? ((R & ~31) + perm32(R & 31)) : R;
        voffA[i] = (unsigned)(R * K + C) * 2u; voffB[i] = (unsigned)(Rb * K + C) * 2u; }
    const size_t kstep = (size_t)(BK * 2);
    const size_t hstep = (size_t)HALF * K * 2;
    const size_t tstep = 2 * hstep;
    const unsigned ldsw = (unsigned)wid * 1024u;
    const int aoff = lds_byte(wr * 64 + fr, fq * 8), boff = lds_byte(wc * 32 + fr, fq * 8);
#define PG8_SA(b, h) (((b) * 2 + (h)) * HTB)
#define PG8_SB(b, h) ((4 + (b) * 2 + (h)) * HTB)
#define PG8_STAGE(bufoff, gbase, voff) do { _Pragma("unroll") for (int _i = 0; _i < 2; ++_i) \
        __builtin_amdgcn_global_load_lds((const unsigned*)((const char*)(gbase) + (voff)[_i]), (PG8_LAS unsigned*)(lds + (bufoff) + ldsw + _i * 8192), 16, 0, 0); } while (0)
#define PG8_LDA(dst, b, h) do { _Pragma("unroll") for (int m = 0; m < 4; ++m) _Pragma("unroll") for (int k = 0; k < 2; ++k) dst[m][k] = *(const PG8_LAS bf16x8*)(lds + PG8_SA(b, h) + aoff + m * 2048 + k * 1024); } while (0)
#define PG8_LDB(dst, b, h) do { _Pragma("unroll") for (int n = 0; n < 2; ++n) _Pragma("unroll") for (int k = 0; k < 2; ++k) dst[n][k] = *(const PG8_LAS bf16x8*)(lds + PG8_SB(b, h) + boff + n * 2048 + k * 1024); } while (0)
#define PG8_MMA(ai, bj, At, Bt) do { __builtin_amdgcn_s_setprio(1); _Pragma("unroll") for (int m = 0; m < 4; ++m) _Pragma("unroll") for (int n = 0; n < 2; ++n) _Pragma("unroll") for (int k = 0; k < 2; ++k) \
        acc[ai][bj][m][n] = __builtin_amdgcn_mfma_f32_16x16x32_bf16(Bt[n][k], At[m][k], acc[ai][bj][m][n], 0, 0, 0); __builtin_amdgcn_s_setprio(0); } while (0)
#define PG8_WAIT_V(n) asm volatile("s_waitcnt vmcnt(" #n ")" ::: "memory")
#define PG8_WAIT_L(n) asm volatile("s_waitcnt lgkmcnt(" #n ")" ::: "memory")
#define PG8_BAR __builtin_amdgcn_s_barrier()
#define PG8_SCHED __builtin_amdgcn_sched_barrier(0)
    Unit cur, nxt; int ui = 0;
    if (!S.next(0, cur)) return;
    f32x4 acc[2][2][4][2];
#pragma unroll
    for (int a = 0; a < 2; ++a)
#pragma unroll
        for (int b = 0; b < 2; ++b)
#pragma unroll
            for (int m = 0; m < 4; ++m)
#pragma unroll
                for (int n = 0; n < 2; ++n) acc[a][b][m][n] = (f32x4){0.f, 0.f, 0.f, 0.f};
    bf16x8 At[4][2], B0[2][2], B1[2][2];
    const char* cA = (const char*)g.A + (size_t)cur.pm * tstep + (size_t)cur.kofs * 2; const char* cB = (const char*)g.Bt + (size_t)cur.pn * tstep + (size_t)cur.kofs * 2;
    S.a_ready(cur);
    if constexpr (SP2) {
        PG8_STAGE(PG8_SB(0, 0), cB, voffB); PG8_STAGE(PG8_SB(0, 1), cB + hstep, voffB); PG8_STAGE(PG8_SA(0, 0), cA, voffA); PG8_STAGE(PG8_SA(0, 1), cA + hstep, voffA);
        if (wr == 1) PG8_BAR;
        PG8_WAIT_V(2); PG8_BAR;
        PG8_STAGE(PG8_SB(1, 0), cB + kstep, voffB); PG8_STAGE(PG8_SA(1, 0), cA + kstep, voffA); PG8_STAGE(PG8_SB(1, 1), cB + hstep + kstep, voffB);
        PG8_WAIT_V(6); PG8_BAR;
    } else {
        PG8_STAGE(PG8_SB(0, 0), cB, voffB); PG8_STAGE(PG8_SA(0, 0), cA, voffA); PG8_STAGE(PG8_SB(0, 1), cB + hstep, voffB); PG8_STAGE(PG8_SA(0, 1), cA + hstep, voffA);
        if (wr == 1) PG8_BAR;
        PG8_WAIT_V(4); PG8_BAR;
        PG8_STAGE(PG8_SB(1, 0), cB + kstep, voffB); PG8_STAGE(PG8_SA(1, 0), cA + kstep, voffA); PG8_STAGE(PG8_SB(1, 1), cB + hstep + kstep, voffB);
        PG8_WAIT_V(6); PG8_BAR;
    }
    for (;;) {
        const bool has_next = S.next(ui + 1, nxt);
        const char* nA = has_next ? (const char*)g.A + (size_t)nxt.pm * tstep + (size_t)nxt.kofs * 2 : cA; const char* nB = has_next ? (const char*)g.Bt + (size_t)nxt.pn * tstep + (size_t)nxt.kofs * 2 : cB;
        for (int t = 0; t < nt; t += 2) {
            const bool last = (t == nt - 2);
            const char* a1 = cA + (size_t)(t + 1) * kstep;
            const char* a2 = last ? nA : cA + (size_t)(t + 2) * kstep; const char* b2 = last ? nB : cB + (size_t)(t + 2) * kstep;
            const char* a3 = a2 + kstep; const char* b3 = b2 + kstep;
            if (last && has_next) S.a_ready(nxt);
            if constexpr (SP2) {
            PG8_LDB(B0, 0, 0); PG8_LDB(B1, 0, 1); PG8_SCHED; PG8_LDA(At, 0, 0); PG8_STAGE(PG8_SA(1, 1), a1 + hstep, voffA);
            PG8_WAIT_V(8); PG8_WAIT_L(0); PG8_BAR; PG8_MMA(0, 0, At, B0); PG8_MMA(0, 1, At, B1); PG8_BAR; PG8_SCHED;
            PG8_LDA(At, 0, 1); PG8_STAGE(PG8_SB(0, 0), b2, voffB); PG8_STAGE(PG8_SB(0, 1), b2 + hstep, voffB); PG8_STAGE(PG8_SA(0, 0), a2, voffA);
            PG8_WAIT_V(8); PG8_WAIT_L(0); PG8_BAR; PG8_MMA(1, 0, At, B0); PG8_MMA(1, 1, At, B1); PG8_BAR; PG8_SCHED;
            PG8_LDB(B0, 1, 0); PG8_LDB(B1, 1, 1); PG8_SCHED; PG8_LDA(At, 1, 0); PG8_STAGE(PG8_SA(0, 1), a2 + hstep, voffA);
            PG8_WAIT_V(8); PG8_WAIT_L(0); PG8_BAR; PG8_MMA(0, 0, At, B0); PG8_MMA(0, 1, At, B1); PG8_BAR; PG8_SCHED;
            PG8_LDA(At, 1, 1); PG8_STAGE(PG8_SB(1, 0), b3, voffB); PG8_STAGE(PG8_SB(1, 1), b3 + hstep, voffB); PG8_STAGE(PG8_SA(1, 0), a3, voffA);
            PG8_WAIT_V(8); PG8_WAIT_L(0); PG8_BAR; PG8_MMA(1, 0, At, B0); PG8_MMA(1, 1, At, B1); PG8_BAR; PG8_SCHED;
            } else {
            PG8_LDB(B0, 0, 0); PG8_SCHED; PG8_LDA(At, 0, 0); PG8_STAGE(PG8_SA(1, 1), a1 + hstep, voffA);
            PG8_WAIT_L(8); PG8_BAR; PG8_WAIT_L(0); PG8_MMA(0, 0, At, B0); PG8_BAR; PG8_SCHED;
            PG8_LDB(B1, 0, 1); PG8_STAGE(PG8_SB(0, 0), b2, voffB);
            PG8_BAR; PG8_WAIT_L(0); PG8_MMA(0, 1, At, B1); PG8_BAR;
            PG8_LDA(At, 0, 1); PG8_STAGE(PG8_SA(0, 0), a2, voffA);
            PG8_BAR; PG8_WAIT_L(0); PG8_MMA(1, 0, At, B0); PG8_BAR; PG8_SCHED;
            PG8_STAGE(PG8_SB(0, 1), b2 + hstep, voffB);
            PG8_WAIT_V(6); PG8_BAR; PG8_MMA(1, 1, At, B1); PG8_BAR;
            PG8_LDB(B0, 1, 0); PG8_SCHED; PG8_LDA(At, 1, 0); PG8_STAGE(PG8_SA(0, 1), a2 + hstep, voffA);
            PG8_WAIT_L(8); PG8_BAR; PG8_WAIT_L(0); PG8_MMA(0, 0, At, B0); PG8_BAR; PG8_SCHED;
            PG8_LDB(B1, 1, 1); PG8_STAGE(PG8_SB(1, 0), b3, voffB);
            PG8_BAR; PG8_WAIT_L(0); PG8_MMA(0, 1, At, B1); PG8_BAR;
            PG8_LDA(At, 1, 1); PG8_STAGE(PG8_SA(1, 0), a3, voffA);
            PG8_BAR; PG8_WAIT_L(0); PG8_MMA(1, 0, At, B0); PG8_BAR; PG8_SCHED;
            PG8_STAGE(PG8_SB(1, 1), b3 + hstep, voffB);
            PG8_WAIT_V(6); PG8_BAR; PG8_MMA(1, 1, At, B1); PG8_BAR;
            }
        }
        if constexpr (ALIGN_EPI) { if (wr == 0) PG8_BAR; }
        if constexpr (!Epi::AFTER_DRAIN) { E(acc, cur, wr, wc, fr, fq); S.done(cur); }
        if (!has_next) break;
#pragma unroll
        for (int a = 0; a < 2; ++a)
#pragma unroll
            for (int b = 0; b < 2; ++b)
#pragma unroll
                for (int m = 0; m < 4; ++m)
#pragma unroll
                    for (int n = 0; n < 2; ++n) acc[a][b][m][n] = (f32x4){0.f, 0.f, 0.f, 0.f};
        cur = nxt; cA = nA; cB = nB; ++ui;
        if constexpr (ALIGN_EPI) { if (wr == 1) PG8_BAR; }
    }
    PG8_WAIT_V(0);
    if constexpr (!ALIGN_EPI) { if (wr == 0) PG8_BAR; }
    PG8_BAR;
    if constexpr (Epi::AFTER_DRAIN) { E.fused(acc, cur, wr, wc, fr, fq, lds, wid, lane); S.done(cur); }
#undef PG8_SA
#undef PG8_SB
#undef PG8_STAGE
#undef PG8_LDA
#undef PG8_LDB
#undef PG8_MMA
#undef PG8_WAIT_V
#undef PG8_WAIT_L
#undef PG8_BAR
#undef PG8_SCHED
}
}

constexpr int DM = 1024, NPB = 4, SEQ = 4096, MP = NPB * SEQ, NSB = 128, DSEQ = 4, MS = NSB * DSEQ, MT = MP + MS;
constexpr int NPROJ = 3368, NP = 3584, DFF = 4096, NL = 2;
constexpr int C_QKV = 0, C_Z = 1536, C_A = 2048, C_BETA = 2056, C_Q = 2064, C_KV = 2576, C_GATE = 3344;
constexpr int PAST = 2048, NPAGES = 16, NPOOL = 2560;
constexpr float C2 = 0.125f * 1.4426950408889634f;
constexpr float NEG_INF = -__builtin_inff();
constexpr size_t O_YP = 0, O_YS = 16777216, O_KVP = 17301504, O_KVS = 34078720, O_WINP = 34603008, O_WINS = 35651584, O_GDNP = 69206016, O_GDNS = 69468160, O_CONVP = 77856768, O_CONVS = 77893632, O_END = 79073280;
constexpr size_t MiB = 1u << 20;
constexpr size_t WS_CTL = 0, CTL_ZERO_BYTES = 1 * MiB;
constexpr size_t WS_WIN = 2 * MiB, WS_WOUT = 16 * MiB, WS_WUP = 20 * MiB, WS_WDN = 36 * MiB, WS_CMPW = 52 * MiB;
constexpr size_t WS_HB = 54 * MiB, WS_PROJ = 88 * MiB, WS_X1 = 320 * MiB, WS_X2 = 386 * MiB, WS_MIX = 452 * MiB, WS_HID = 486 * MiB;
constexpr size_t WS_QN = 618 * MiB, WS_KN = 651 * MiB, WS_VG = 684 * MiB, WS_OG = 717 * MiB, WS_G = 750 * MiB, WS_BETA = 751 * MiB, WS_KQ = 752 * MiB;
constexpr size_t WS_QB = 753 * MiB, WS_KS = 770 * MiB, WS_VS = 775 * MiB, WS_KW = 780 * MiB, WS_VW = 785 * MiB;
constexpr size_t WS_CKP = 790 * MiB, WS_CVP = 791 * MiB, WS_CKS = 792 * MiB, WS_CVS = 796 * MiB;
constexpr size_t WS_GK = 800 * MiB, WS_GQ = 816 * MiB, WS_GKT = 832 * MiB, WS_GVT = 848 * MiB, WS_GG2 = 864 * MiB, WS_BETA2 = 865 * MiB;
constexpr size_t WS_WX = 866 * MiB, WS_QX = 882 * MiB, WS_QKX = 898 * MiB, WS_KTX = 914 * MiB, WS_U0F = 930 * MiB, WS_GL = 962 * MiB, WS_END = 1043 * MiB;
constexpr size_t WS_PARTD = 963 * MiB, WS_PARTG = 979 * MiB;
constexpr int PD_KS = 4, PD_KL = DM / PD_KS, PG_KS = 8, PG_KL = DFF / PG_KS;
constexpr int CW_QUEUE = 64;
constexpr int CW_BAR = 4096;
constexpr int RING_BYTES = 131072, LDS_BYTES = 147456, MISC_OFF = LDS_BYTES - 64;
constexpr int NWAVES = 8;

#define GAS __attribute__((address_space(1)))
#define LAS __attribute__((address_space(3)))
typedef unsigned short bf16;
typedef unsigned v4u __attribute__((ext_vector_type(4)));
typedef unsigned v2u __attribute__((ext_vector_type(2)));
typedef float f32x4 __attribute__((ext_vector_type(4)));
typedef float f32x16 __attribute__((ext_vector_type(16)));
typedef short bf16x8 __attribute__((ext_vector_type(8)));
typedef short s16x4 __attribute__((ext_vector_type(4)));
#define LDS_WAIT() asm volatile("s_waitcnt lgkmcnt(0)" ::: "memory")
__device__ __forceinline__ unsigned f2bf(float f) { unsigned u = __builtin_bit_cast(unsigned, f); return (u + 0x7fffu + ((u >> 16) & 1u)) >> 16; }
typedef float f32x2_t_ __attribute__((ext_vector_type(2))); typedef __bf16 bf16x2_t_ __attribute__((ext_vector_type(2)));
__device__ __forceinline__ unsigned pk2(float lo, float hi) { const f32x2_t_ v = {lo, hi}; const bf16x2_t_ b = __builtin_convertvector(v, bf16x2_t_); return __builtin_bit_cast(unsigned, b); }
__device__ __forceinline__ float bf2f(unsigned short b) { return __builtin_bit_cast(float, (unsigned)b << 16); }
__device__ __forceinline__ bf16x8 pack8(float a0, float a1, float a2, float a3, float a4, float a5, float a6, float a7) {
    v4u w; w.x = pk2(a0, a1); w.y = pk2(a2, a3); w.z = pk2(a4, a5); w.w = pk2(a6, a7); return __builtin_bit_cast(bf16x8, w); }
__device__ __forceinline__ float wave_sum(float v) {
#pragma unroll
    for (int o = 1; o < 64; o <<= 1) v += __shfl_xor(v, o);
    return v;
}
template <int CTRL, int RMASK> __device__ __forceinline__ float dpp_add(float v) {
    const int t = __builtin_amdgcn_update_dpp(0, __builtin_bit_cast(int, v), CTRL, RMASK, 0xf, false);
    return v + __builtin_bit_cast(float, t);
}
__device__ __forceinline__ float dpp_sum(float v) {
    v = dpp_add<0x111, 0xf>(v); v = dpp_add<0x112, 0xf>(v); v = dpp_add<0x114, 0xf>(v); v = dpp_add<0x118, 0xf>(v);
    v = dpp_add<0x142, 0xa>(v); v = dpp_add<0x143, 0xc>(v);
    return __builtin_bit_cast(float, __builtin_amdgcn_readlane(__builtin_bit_cast(int, v), 63));
}
__device__ __forceinline__ float ex2(float x) { return __builtin_amdgcn_exp2f(x); }
__device__ __forceinline__ float sigmoidf_(float x) { return 1.f / (1.f + __expf(-x)); }
__device__ __forceinline__ float siluf_(float x) { return x / (1.f + __expf(-x)); }
__device__ __forceinline__ int crow(int r, int hi) { return (r & 3) + 8 * (r >> 2) + 4 * hi; }
__device__ __forceinline__ void rope_cs(int pos, int d, float& cs, float& sn) {
    const float invf = exp2f(-(float)d * 0.4152410118609203f);
    double rv = (double)pos * (double)invf * 0.15915494309189535; rv -= floor(rv);
    const float rf = (float)rv; sn = __builtin_amdgcn_sinf(rf); cs = __builtin_amdgcn_cosf(rf);
}

#define XB_TMO      128
#define XB_XCNT(j)  (256  + 64 * (j))
#define XB_XSUB(j)  (1280 + 64 * (j))
#define XB_XGEN(j)  (2304 + 64 * (j))
#define XB_TOP      3328
#define XB_TOPGEN   3392
#define XCD_BAR_WORDS 3456
#define XB_SPIN_CAP (1u << 18)

__device__ __forceinline__ unsigned xb_ld(unsigned* p)              { return __hip_atomic_load(p, __ATOMIC_RELAXED, __HIP_MEMORY_SCOPE_AGENT); }
__device__ __forceinline__ unsigned xb_add(unsigned* p, unsigned v) { return __hip_atomic_fetch_add(p, v, __ATOMIC_RELAXED, __HIP_MEMORY_SCOPE_AGENT); }
__device__ __forceinline__ unsigned xb_xcc_id() { return (unsigned)__builtin_amdgcn_s_getreg((3 << 11) | 20) & 0xFu; }
#define XB_SPIN(cond, bar) do { unsigned _sp = 0; while (cond) { __builtin_amdgcn_s_sleep(1); \
    if ((++_sp & 255u) == 0u) { if (xb_ld(&(bar)[XB_TMO])) break; if (_sp > XB_SPIN_CAP) { atomicAdd(&(bar)[XB_TMO], 1u); break; } } } } while (0)

struct XcdBarrier {
    unsigned* bar; unsigned x;
    volatile LAS unsigned* st;
};

__device__ __forceinline__ XcdBarrier xcd_barrier_post(unsigned* bar, volatile LAS unsigned* st, bool leader) {
    XcdBarrier b; b.bar = bar; b.x = xb_xcc_id(); b.st = st;
    if (leader) (void)xb_add(&bar[XB_XCNT(b.x)], 1u);
    return b;
}
__device__ __forceinline__ void xcd_barrier_complete(unsigned* bar, unsigned x, unsigned& nloc, unsigned& nx) {
    const unsigned G = gridDim.x * gridDim.y * gridDim.z;
    unsigned sum, cnt, mine, sp = 0u;
    for (;;) {
        sum = 0u; cnt = 0u; mine = 0u;
#pragma unroll
        for (unsigned j = 0; j < 16; ++j) { const unsigned c = xb_ld(&bar[XB_XCNT(j)]); sum += c; cnt += (c > 0u) ? 1u : 0u; mine = (j == x) ? c : mine; }
        if (sum == G) break;
        __builtin_amdgcn_s_sleep(1);
        if ((++sp & 255u) == 0u) { if (xb_ld(&bar[XB_TMO])) break; if (sp > XB_SPIN_CAP) { atomicAdd(&bar[XB_TMO], 1u); break; } }
    }
    nloc = mine > 0u ? mine : 1u; nx = cnt > 0u ? cnt : 1u;
}

__device__ __forceinline__ void xcd_barrier(const XcdBarrier& b, bool leader) {
    asm volatile("s_waitcnt vmcnt(0)" ::: "memory");
    __syncthreads();
    if (leader) {
        unsigned* bar = b.bar;
        __builtin_amdgcn_s_waitcnt(0);
        unsigned nloc = b.st[0], nx = b.st[1];
        if (nloc == 0u) { xcd_barrier_complete(bar, b.x, nloc, nx); b.st[0] = nloc; b.st[1] = nx; }
        const unsigned old = xb_add(&bar[XB_XSUB(b.x)], 1u);
        const unsigned gen = old / nloc;
        if (old + 1u == (gen + 1u) * nloc) {
            __builtin_amdgcn_fence(__ATOMIC_RELEASE, "agent");
            asm volatile("s_waitcnt vmcnt(0)" ::: "memory");
            const unsigned og = xb_add(&bar[XB_TOP], 1u);
            const unsigned tg = og / nx;
            if (og + 1u == (tg + 1u) * nx) xb_add(&bar[XB_TOPGEN], 1u);
            else XB_SPIN(xb_ld(&bar[XB_TOPGEN]) == tg, bar);
            __builtin_amdgcn_fence(__ATOMIC_ACQUIRE, "agent");
            xb_add(&bar[XB_XGEN(b.x)], 1u);
            asm volatile("s_waitcnt vmcnt(0)" ::: "memory");
        } else {
            XB_SPIN(xb_ld(&bar[XB_XGEN(b.x)]) == gen, bar);
            __builtin_amdgcn_fence(__ATOMIC_ACQUIRE, "agent");
            asm volatile("s_waitcnt vmcnt(0)" ::: "memory");
        }
    }
    __syncthreads();
}

__device__ __forceinline__ void transpose_item(const float* W, int K, int N, int Npad, bf16* WT, LAS float* scr, int item, int lane) {
    const int nblk = Npad / 32, kb = item / nblk, nb = item % nblk, k0 = 64 * kb, n0 = 32 * nb;
    const int ncol = n0 + (lane & 31);
    float wv_[32];
#pragma unroll
    for (int i = 0; i < 32; ++i) { const int kk = 2 * i + (lane >> 5); wv_[i] = (ncol < N) ? W[(size_t)(k0 + kk) * N + ncol] : 0.f; }
    __builtin_amdgcn_sched_barrier(0);
#pragma unroll
    for (int i = 0; i < 32; ++i) { const int kk = 2 * i + (lane >> 5); scr[kk * 33 + (lane & 31)] = wv_[i]; }
    LDS_WAIT(); asm volatile("" ::: "memory");
    const int c = lane & 7;
#pragma unroll
    for (int j = 0; j < 4; ++j) { const int n = (lane >> 3) + 8 * j; const LAS float* s = scr + (8 * c) * 33 + n;
        v4u o; o.x = pk2(s[0 * 33], s[1 * 33]); o.y = pk2(s[2 * 33], s[3 * 33]); o.z = pk2(s[4 * 33], s[5 * 33]); o.w = pk2(s[6 * 33], s[7 * 33]);
        *(v4u*)(WT + (size_t)(n0 + n) * K + k0 + 8 * c) = o; }
    LDS_WAIT(); asm volatile("" ::: "memory");
}
__device__ __forceinline__ f32x4 ld4x(const void* row, int i, bool bf) {
    if (bf) { const v2u w = ((const v2u*)row)[i]; return (f32x4){bf2f((unsigned short)(w.x & 0xffffu)), bf2f((unsigned short)(w.x >> 16)), bf2f((unsigned short)(w.y & 0xffffu)), bf2f((unsigned short)(w.y >> 16))}; }
    return ((const f32x4*)row)[i]; }
__device__ __forceinline__ void rms_row(const void* xrow, bool bf, const float* g, bf16* orow, float* of32, int lane) {
    f32x4 v[4]; float s = 0.f;
#pragma unroll
    for (int j = 0; j < 4; ++j) { v[j] = ld4x(xrow, 64 * j + lane, bf); s += (v[j].x * v[j].x + v[j].y * v[j].y) + (v[j].z * v[j].z + v[j].w * v[j].w); }
    const float rstd = 1.f / sqrtf(wave_sum(s) * (1.f / DM) + 1e-6f);
#pragma unroll
    for (int j = 0; j < 4; ++j) { const f32x4 gg = ((const f32x4*)g)[64 * j + lane]; const f32x4 o = v[j] * rstd * gg;
        if (of32) ((f32x4*)of32)[64 * j + lane] = o;
        else ((v2u*)orow)[64 * j + lane] = (v2u){pk2(o.x, o.y), pk2(o.z, o.w)}; }
}

__device__ __forceinline__ void rms_row2(const void* xa, const void* xb, bool bf, const float* g, bf16* oa, bf16* ob, float* fa, float* fb, int lane) {
    f32x4 va[4], vb[4];
#pragma unroll
    for (int j = 0; j < 4; ++j) { va[j] = ld4x(xa, 64 * j + lane, bf); vb[j] = ld4x(xb, 64 * j + lane, bf); }
    __builtin_amdgcn_sched_barrier(0);
    float sa = 0.f, sb = 0.f;
#pragma unroll
    for (int j = 0; j < 4; ++j) { sa += (va[j].x * va[j].x + va[j].y * va[j].y) + (va[j].z * va[j].z + va[j].w * va[j].w); sb += (vb[j].x * vb[j].x + vb[j].y * vb[j].y) + (vb[j].z * vb[j].z + vb[j].w * vb[j].w); }
    const float ra = 1.f / sqrtf(wave_sum(sa) * (1.f / DM) + 1e-6f), rb = 1.f / sqrtf(wave_sum(sb) * (1.f / DM) + 1e-6f);
#pragma unroll
    for (int j = 0; j < 4; ++j) { const f32x4 gg = ((const f32x4*)g)[64 * j + lane]; const f32x4 o1 = va[j] * ra * gg, o2 = vb[j] * rb * gg;
        if (fa) { ((f32x4*)fa)[64 * j + lane] = o1; ((f32x4*)fb)[64 * j + lane] = o2; }
        else { ((v2u*)oa)[64 * j + lane] = (v2u){pk2(o1.x, o1.y), pk2(o1.z, o1.w)}; ((v2u*)ob)[64 * j + lane] = (v2u){pk2(o2.x, o2.y), pk2(o2.z, o2.w)}; } }
}
__device__ __forceinline__ void rms_row_parts(const void* base, bool bf, const float* parts, int nparts, size_t part_stride, bf16* xout, const float* g, bf16* orow, float* of32, int lane) {
    f32x4 v[4]; float s = 0.f;
#pragma unroll
    for (int j = 0; j < 4; ++j) v[j] = ld4x(base, 64 * j + lane, bf);
    for (int p = 0; p < nparts; ++p) { const f32x4* pr = (const f32x4*)(parts + (size_t)p * part_stride) + lane;
#pragma unroll
        for (int j = 0; j < 4; ++j) v[j] += pr[64 * j]; }
#pragma unroll
    for (int j = 0; j < 4; ++j) { if (xout) ((v2u*)xout)[64 * j + lane] = (v2u){pk2(v[j].x, v[j].y), pk2(v[j].z, v[j].w)}; s += (v[j].x * v[j].x + v[j].y * v[j].y) + (v[j].z * v[j].z + v[j].w * v[j].w); }
    const float rstd = 1.f / sqrtf(wave_sum(s) * (1.f / DM) + 1e-6f);
#pragma unroll
    for (int j = 0; j < 4; ++j) { const f32x4 gg = ((const f32x4*)g)[64 * j + lane]; const f32x4 o = v[j] * rstd * gg;
        if (of32) ((f32x4*)of32)[64 * j + lane] = o;
        else ((v2u*)orow)[64 * j + lane] = (v2u){pk2(o.x, o.y), pk2(o.z, o.w)}; }
}

struct PBArgs { const float* PROJ; const float* state_conv; const float* conv_w; const float* a_log; const float* dt_bias;
    float* QN; float* KN; float* VG; float* G; float* BETA; float* KQ; bf16* QB; bf16* KS; bf16* VS; bf16* KW; bf16* VW; float* out; int l; };
struct PBRegs { float qs_[8], qo_[8], kvs_[12], kvo_[12]; };
__device__ __forceinline__ void pb_row_load(const PBArgs& A, int m, int lane, PBRegs& R) {
    const float* pr = A.PROJ + (size_t)m * NP;
#pragma unroll
    for (int h = 0; h < 8; ++h) { R.qs_[h] = pr[C_Q + h * 64 + lane]; R.qo_[h] = pr[C_Q + h * 64 + (lane ^ 32)]; }
#pragma unroll
    for (int i = 0; i < 12; ++i) { R.kvs_[i] = pr[C_KV + i * 64 + lane]; R.kvo_[i] = pr[C_KV + i * 64 + (lane ^ 32)]; }
}
__device__ __forceinline__ void pb_row(const PBArgs& A, int m, int lane, const PBRegs& R) {
    const bool is_s = m >= MP; int b, t;
    if (!is_s) { b = m >> 12; t = m & 4095; } else { b = (m - MP) >> 2; t = (m - MP) & 3; }
    const int pos = is_s ? PAST + t : t, l = A.l;
    const float* pr = A.PROJ + (size_t)m * NP;
    const float* cw = A.conv_w + (size_t)l * 4 * 1536;
    const float* cb = A.state_conv + ((size_t)l * NSB + b) * 3 * 1536;
    if (!is_s && t >= SEQ - 3) { float* o = A.out + O_CONVP + ((size_t)(l * NPB + b) * 3 + (t - (SEQ - 3))) * 1536;
#pragma unroll 4
        for (int j = 0; j < 24; ++j) o[64 * j + lane] = pr[64 * j + lane]; }
    if (is_s && t >= 1) { float* o = A.out + O_CONVS + ((size_t)(l * NSB + b) * 3 + (t - 1)) * 1536;
#pragma unroll 4
        for (int j = 0; j < 24; ++j) o[64 * j + lane] = pr[64 * j + lane]; }
    const int half = lane >> 5; float cs, sn; rope_cs(pos, lane & 31, cs, sn);
    const float (&qs_)[8] = R.qs_; const float (&qo_)[8] = R.qo_; const float (&kvs_)[12] = R.kvs_; const float (&kvo_)[12] = R.kvo_;
#pragma unroll
    for (int h = 0; h < 8; ++h) { const float xs = qs_[h], xo = qo_[h];
        const float r = half ? (xs * cs + xo * sn) : (xs * cs - xo * sn);
        A.QB[(size_t)m * 512 + h * 64 + lane] = (bf16)f2bf(r * C2); }
#pragma unroll
    for (int s6 = 0; s6 < 6; ++s6)
#pragma unroll
        for (int kvh = 0; kvh < 2; ++kvh) {
            float v = kvs_[s6 * 2 + kvh];
            if (s6 == 2 || s6 == 4) { const float xo = kvo_[s6 * 2 + kvh]; v = half ? (v * cs + xo * sn) : (v * cs - xo * sn); }
            if (s6 < 4) {
                if (!is_s) A.out[O_KVP + ((((size_t)(l * NPB + b) * 2 + kvh) * SEQ + t) * 4 + s6) * 64 + lane] = v;
                else       A.out[O_KVS + ((((size_t)(l * NSB + b) * 2 + kvh) * DSEQ + t) * 4 + s6) * 64 + lane] = v;
            } else {
                const int idx = s6 - 4;
                if (!is_s) { if (t >= SEQ - 512) A.out[O_WINP + ((((size_t)(l * NPB + b) * 512 + (t - (SEQ - 512))) * 2 + idx) * 2 + kvh) * 64 + lane] = v; }
                else A.out[O_WINS + ((((size_t)(l * NSB + b) * 512 + (508 + t)) * 2 + idx) * 2 + kvh) * 64 + lane] = v;
            }
            const bf16 bv = (bf16)f2bf(v);
            if (s6 == 2) A.KS[(size_t)m * 128 + kvh * 64 + lane] = bv;
            if (s6 == 3) A.VS[(size_t)m * 128 + kvh * 64 + lane] = bv;
            if (s6 == 4) A.KW[(size_t)m * 128 + kvh * 64 + lane] = bv;
            if (s6 == 5) A.VW[(size_t)m * 128 + kvh * 64 + lane] = bv;
        }
}

__device__ __forceinline__ void pb_sample_head(const PBArgs& A, int u, int lane) {
    const int m = MP + (u >> 3), h = u & 7, b = (m - MP) >> 2, t = (m - MP) & 3, l = A.l;
    const float* pr = A.PROJ + (size_t)m * NP;
    const float* cw = A.conv_w + (size_t)l * 4 * 1536;
    const float* cb = A.state_conv + ((size_t)l * NSB + b) * 3 * 1536;
    float xv[3][4], wv[3][4];
#pragma unroll
    for (int part = 0; part < 3; ++part) { const int c = (part * 8 + h) * 64 + lane;
#pragma unroll
        for (int tap = 0; tap < 4; ++tap) { const int idx = t + tap;
            xv[part][tap] = (idx >= 3) ? A.PROJ[(size_t)(m - t + idx - 3) * NP + c] : cb[idx * 1536 + c];
            wv[part][tap] = cw[tap * 1536 + c]; } }
    __builtin_amdgcn_sched_barrier(0);
    float qkv[3];
#pragma unroll
    for (int part = 0; part < 3; ++part) qkv[part] = siluf_((xv[part][0] * wv[part][0] + xv[part][1] * wv[part][1]) + (xv[part][2] * wv[part][2] + xv[part][3] * wv[part][3]));
    const float q = qkv[0], k = qkv[1];
    const float qs = dpp_sum(q * q), ks = dpp_sum(k * k);
    const float qn = q * (1.f / sqrtf(qs + 1e-6f)) * 0.125f, kn = k * (1.f / sqrtf(ks + 1e-6f));
    const float kq = dpp_sum(qn * kn);
    A.QN[(size_t)m * 512 + h * 64 + lane] = qn; A.KN[(size_t)m * 512 + h * 64 + lane] = kn; A.VG[(size_t)m * 512 + h * 64 + lane] = qkv[2];
    if (lane == 0) A.KQ[(size_t)m * 8 + h] = kq;
    if (h == 0 && lane < 8) {
        const float a = pr[C_A + lane] + A.dt_bias[l * 8 + lane];
        const float sp = fmaxf(a, 0.f) + log1pf(__expf(-fabsf(a)));
        A.G[(size_t)m * 8 + lane] = -__expf(A.a_log[l * 8 + lane]) * sp;
        A.BETA[(size_t)m * 8 + lane] = sigmoidf_(pr[C_BETA + lane]); }
}

struct CmpArgs { const float* PROJ; const float* cache; const int* page_table; const float* pe_k; const float* pe_v; const bf16* CMPW; unsigned char* ws; int l; };
__device__ __forceinline__ void compress_batch(const CmpArgs& A, unsigned char* lds, int batch, bool is_s, int tid) {
    const int lane = tid & 63, wave = __builtin_amdgcn_readfirstlane(tid >> 6), fr = lane & 15, fq = lane >> 4, l = A.l;
    const int kv = batch & 1, ru = (batch >> 1) * 8 + wave;
    const int rho = 16 * ru + fr, NC = is_s ? 64 : 128;
    const int seq = rho / (2 * NC), n = (rho >> 1) % NC, kvh = rho & 1;
    const float* abase; size_t astride;
    if (!is_s) { abase = A.PROJ + (size_t)(seq * SEQ + 32 * n) * NP + C_KV + kv * 128 + kvh * 64; astride = NP; }
    else { const int page = A.page_table[seq * NPAGES + (n >> 2)];
        abase = A.cache + ((((size_t)l * NPOOL + page) * 2 + kvh) * 128 + (n & 3) * 32) * 256 + kv * 64; astride = 256; }
    const float* pe = (kv ? A.pe_v : A.pe_k) + (size_t)l * 2048;
    const bf16* Wt = A.CMPW + (size_t)((l * 2 + kv) * 64) * 2048;
    const int we = tid >> 3, wch = tid & 7;
    f32x4 acc[4];
#pragma unroll
    for (int et = 0; et < 4; ++et) acc[et] = (f32x4){0.f, 0.f, 0.f, 0.f};
    f32x4 sa[2][4], sp[2][4]; v4u wreg;
#define CB_LOADA(S, c) do { _Pragma("unroll") for (int ks = 0; ks < 2; ++ks) { const float* ap = abase + (size_t)(c) * astride + 32 * ks + 8 * fq; const float* pp = pe + (c) * 64 + 32 * ks + 8 * fq; \
        sa[S][2 * ks] = *(const f32x4*)ap; sa[S][2 * ks + 1] = *(const f32x4*)(ap + 4); sp[S][2 * ks] = *(const f32x4*)pp; sp[S][2 * ks + 1] = *(const f32x4*)(pp + 4); } } while (0)
#define CB_LOADW(c) do { wreg = *(const v4u*)(Wt + (size_t)we * 2048 + ((c) < 31 ? (c) : 31) * 64 + wch * 8); } while (0)
#define CB_STOREW(bufi) do { *(v4u*)(lds + (bufi) * 9216 + we * 144 + wch * 16) = wreg; } while (0)
#define CB_MMA(S, bufi) do { _Pragma("unroll") for (int ks = 0; ks < 2; ++ks) { const f32x4 a0 = sa[S][2 * ks] + sp[S][2 * ks], a1 = sa[S][2 * ks + 1] + sp[S][2 * ks + 1]; \
        const bf16x8 ya = pack8(a0.x, a0.y, a0.z, a0.w, a1.x, a1.y, a1.z, a1.w); \
        _Pragma("unroll") for (int et = 0; et < 4; ++et) { const bf16x8 wf_ = *(const bf16x8*)(lds + (bufi) * 9216 + (16 * et + fr) * 144 + (32 * ks + 8 * fq) * 2); \
            acc[et] = __builtin_amdgcn_mfma_f32_16x16x32_bf16(wf_, ya, acc[et], 0, 0, 0); } } } while (0)
    __syncthreads();
    CB_LOADW(0); CB_LOADA(0, 0);
    CB_STOREW(0); CB_LOADW(1);
    __syncthreads();
#pragma unroll 1
    for (int c = 0; c < 32; c += 2) {
        CB_STOREW(1); __builtin_amdgcn_sched_barrier(0); CB_LOADW(c + 2); CB_LOADA(1, c + 1); __builtin_amdgcn_sched_barrier(0);
        CB_MMA(0, 0); __builtin_amdgcn_sched_barrier(0);
        __syncthreads();
        CB_STOREW(0); __builtin_amdgcn_sched_barrier(0); CB_LOADW(c + 3); if (c + 2 < 32) { CB_LOADA(0, c + 2); } __builtin_amdgcn_sched_barrier(0);
        CB_MMA(1, 1); __builtin_amdgcn_sched_barrier(0);
        __syncthreads();
    }
#undef CB_LOADA
#undef CB_LOADW
#undef CB_STOREW
#undef CB_MMA
    if (kv == 0) { const int pos = 32 * n + 31;
#pragma unroll
        for (int et = 0; et < 2; ++et)
#pragma unroll
            for (int i = 0; i < 4; ++i) { float cs, sn; rope_cs(pos, 16 * et + 4 * fq + i, cs, sn);
                const float x1 = acc[et][i], x2 = acc[et + 2][i]; acc[et][i] = x1 * cs - x2 * sn; acc[et + 2][i] = x2 * cs + x1 * sn; } }
    float* ob = (float*)(A.ws + (is_s ? WS_CKS : WS_CKP) + (size_t)kv * (is_s ? (WS_CVS - WS_CKS) : (WS_CVP - WS_CKP))) + (size_t)rho * 64 + 4 * fq;
#pragma unroll
    for (int et = 0; et < 4; ++et) *(f32x4*)(ob + 16 * et) = acc[et];
}

struct GdnArgs { const float* QN; const float* KN; const float* VG; const float* G; const float* BETA; const float* KQ; float* OG; const float* PROJ; const float* state_gdn; const float* gdn_norm; bf16* MIX; float* out; int l; };
__device__ __forceinline__ void gdn_sample_unit(const GdnArgs& A, int unit, int lane) {
    const int sb = unit >> 3, h = unit & 7, l = A.l;
    const float* sp = A.state_gdn + (((size_t)l * NSB + sb) * 8 + h) * 4096;
    float S[64];
#pragma unroll
    for (int d = 0; d < 64; ++d) S[d] = sp[d * 64 + lane];
    const float gn = A.gdn_norm[l * 64 + lane];
    for (int i = 0; i < DSEQ; ++i) {
        const size_t m = (size_t)MP + sb * 4 + i;
        const float kd = A.KN[m * 512 + h * 64 + lane], qd = A.QN[m * 512 + h * 64 + lane], v = A.VG[m * 512 + h * 64 + lane];
        const float g = A.G[m * 8 + h], beta = A.BETA[m * 8 + h], kq = A.KQ[m * 8 + h];
        const int kdb = __builtin_bit_cast(int, kd), qdb = __builtin_bit_cast(int, qd);
        const float a = __expf(g); float r1 = 0.f, r2 = 0.f;
#pragma unroll
        for (int d = 0; d < 64; ++d) { const float kk = __builtin_bit_cast(float, __builtin_amdgcn_readlane(kdb, d)), qq = __builtin_bit_cast(float, __builtin_amdgcn_readlane(qdb, d)); r1 += S[d] * kk; r2 += S[d] * qq; }
        const float u = beta * (v - a * r1), o = a * r2 + u * kq;
#pragma unroll
        for (int d = 0; d < 64; ++d) { const float kk = __builtin_bit_cast(float, __builtin_amdgcn_readlane(kdb, d)); S[d] = a * S[d] + kk * u; }
        const float ms = wave_sum(o * o) * (1.f / 64.f);
        const float z = A.PROJ[m * NP + C_Z + h * 64 + lane];
        A.MIX[m * 1024 + h * 64 + lane] = (bf16)f2bf(o * (1.f / sqrtf(ms + 1e-6f)) * gn * siluf_(z));
    }
    float* so = A.out + O_GDNS + (((size_t)l * NSB + sb) * 8 + h) * 4096;
#pragma unroll
    for (int d = 0; d < 64; ++d) so[d * 64 + lane] = S[d];
}


__device__ __forceinline__ int perm_inv32(int p) { return (p & 32) + 16 * ((p >> 2) & 1) + 4 * ((p >> 3) & 3) + (p & 3); }
struct GPArgs { const float* PROJ; const float* conv_w; const float* a_log; const float* dt_bias; bf16* GK; bf16* GQ; bf16* GKT; bf16* GVT; float* GG2; float* BETA2; int l; };
struct GPRegs { float xx[3][11], ww[3][4]; };
__device__ __forceinline__ void gdn_prep_load(const GPArgs& A, int unit, int lane, GPRegs& R) {
    const int tg = unit >> 3, h = unit & 7, m0 = tg * 8, t0 = m0 & 4095;
    const float* cw = A.conv_w + (size_t)A.l * 4 * 1536;
#pragma unroll
    for (int part = 0; part < 3; ++part) { const int c = (part * 8 + h) * 64 + lane;
#pragma unroll
        for (int j = 0; j < 11; ++j) R.xx[part][j] = (t0 - 3 + j >= 0) ? A.PROJ[(size_t)(m0 - 3 + j) * NP + c] : 0.f;
#pragma unroll
        for (int k = 0; k < 4; ++k) R.ww[part][k] = cw[k * 1536 + c]; }
}
__device__ __forceinline__ void gdn_prep_unit(const GPArgs& A, int unit, int lane, const GPRegs& R) {
    const int tg = unit >> 3, h = unit & 7, m0 = tg * 8, b = m0 >> 12, t0 = m0 & 4095, l = A.l, bh = b * 8 + h;
    const float* cw = A.conv_w + (size_t)l * 4 * 1536;
    float val[3][8]; const float (&xx)[3][11] = R.xx; const float (&ww)[3][4] = R.ww;
#pragma unroll
    for (int part = 0; part < 3; ++part)
#pragma unroll
        for (int i = 0; i < 8; ++i) val[part][i] = siluf_(ww[part][0] * xx[part][i] + ww[part][1] * xx[part][i + 1] + ww[part][2] * xx[part][i + 2] + ww[part][3] * xx[part][i + 3]);
#pragma unroll
    for (int i = 0; i < 8; ++i) { const float q = val[0][i], k = val[1][i];
        const float qs = dpp_sum(q * q), ks = dpp_sum(k * k);
        val[0][i] = q * (1.f / sqrtf(qs + 1e-6f)) * 0.125f; val[1][i] = k * (1.f / sqrtf(ks + 1e-6f)); }
#pragma unroll
    for (int i = 0; i < 8; ++i) { A.GQ[((size_t)bh * 4096 + t0 + i) * 64 + lane] = (bf16)f2bf(val[0][i]); A.GK[((size_t)bh * 4096 + t0 + i) * 64 + lane] = (bf16)f2bf(val[1][i]); }
    *(v4u*)(A.GKT + ((size_t)bh * 64 + lane) * 4096 + t0) = (v4u){pk2(val[1][0], val[1][1]), pk2(val[1][2], val[1][3]), pk2(val[1][4], val[1][5]), pk2(val[1][6], val[1][7])};
    *(v4u*)(A.GVT + ((size_t)bh * 64 + lane) * 4096 + t0) = (v4u){pk2(val[2][0], val[2][1]), pk2(val[2][2], val[2][3]), pk2(val[2][4], val[2][5]), pk2(val[2][6], val[2][7])};
    if (lane < 8) { const float* pr = A.PROJ + (size_t)(m0 + lane) * NP;
        const float a = pr[C_A + h] + A.dt_bias[l * 8 + h];
        const float sp = fmaxf(a, 0.f) + log1pf(__expf(-fabsf(a)));
        A.GG2[(size_t)bh * 4096 + t0 + lane] = -__expf(A.a_log[l * 8 + h]) * sp;
        A.BETA2[(size_t)bh * 4096 + t0 + lane] = sigmoidf_(pr[C_BETA + h]); }
}
template <int I> __device__ __forceinline__ void fsub_row(float (&T)[64], const float* AL, int lane) {
    float tv = (lane == I) ? 1.f : 0.f;
#pragma unroll
    for (int j4 = 0; j4 < (I + 3) / 4; ++j4) { const f32x4 a = *(const f32x4*)(AL + I * 64 + 4 * j4);
#pragma unroll
        for (int e = 0; e < 4; ++e) if (4 * j4 + e < I) tv -= a[e] * T[4 * j4 + e]; }
    T[I] = tv;
}
template <int I> struct FSub { static __device__ __forceinline__ void run(float (&T)[64], const float* AL, int lane) { FSub<I - 1>::run(T, AL, lane); fsub_row<I>(T, AL, lane); } };
template <> struct FSub<-1> { static __device__ __forceinline__ void run(float (&)[64], const float*, int) {} };
struct GCArgs { const bf16* GK; const bf16* GQ; const bf16* GKT; const bf16* GVT; const float* GG2; const float* BETA2; bf16* WX; bf16* QX; bf16* QKX; bf16* KTX; float* U0F; float* GL; };
constexpr int GC_LDS_PER_WAVE = 17664;
__device__ __forceinline__ void gdn_chunk_unit(const GCArgs& A, unsigned char* wl, int unit, int lane_) {
    int lane = lane_; asm volatile("" : "+v"(lane));
    const int bh = unit >> 6, n = unit & 63, t0 = 64 * n, fr = lane & 15, fq = lane >> 4;
    float* AL = (float*)wl; float* SC = (float*)(wl + 16384);
    {   const float g = A.GG2[(size_t)bh * 4096 + t0 + lane], beta = A.BETA2[(size_t)bh * 4096 + t0 + lane];
        float gc = g;
        gc = dpp_add<0x111, 0xf>(gc); gc = dpp_add<0x112, 0xf>(gc); gc = dpp_add<0x114, 0xf>(gc); gc = dpp_add<0x118, 0xf>(gc); gc = dpp_add<0x142, 0xa>(gc); gc = dpp_add<0x143, 0xc>(gc);
        const float glast = __builtin_bit_cast(float, __builtin_amdgcn_readlane(__builtin_bit_cast(int, gc), 63));
        const float eg = __expf(gc);
        SC[lane] = gc; SC[64 + lane] = beta; SC[128 + lane] = beta * eg; SC[192 + lane] = eg; SC[256 + lane] = __expf(glast - gc);
        if (lane == 0) A.GL[unit] = __expf(glast); }
    LDS_WAIT(); asm volatile("" ::: "memory");
    {
        bf16x8 kf[4][2];
#pragma unroll
        for (int t4 = 0; t4 < 4; ++t4)
#pragma unroll
            for (int ks = 0; ks < 2; ++ks) kf[t4][ks] = *(const bf16x8*)(A.GK + ((size_t)bh * 4096 + t0 + 16 * t4 + fr) * 64 + 32 * ks + 8 * fq);
        __builtin_amdgcn_sched_barrier(0);
#pragma unroll
        for (int ti = 0; ti < 4; ++ti) { const f32x4 gi = *(const f32x4*)(SC + 16 * ti + 4 * fq), bi = *(const f32x4*)(SC + 64 + 16 * ti + 4 * fq);
#pragma unroll
            for (int tj = 0; tj < 4; ++tj) if (tj <= ti) { f32x4 acc = {0.f, 0.f, 0.f, 0.f};
                acc = __builtin_amdgcn_mfma_f32_16x16x32_bf16(kf[ti][0], kf[tj][0], acc, 0, 0, 0); acc = __builtin_amdgcn_mfma_f32_16x16x32_bf16(kf[ti][1], kf[tj][1], acc, 0, 0, 0);
                const float gj = SC[16 * tj + fr];
#pragma unroll
                for (int i = 0; i < 4; ++i) AL[(16 * ti + 4 * fq + i) * 64 + 16 * tj + fr] = bi[i] * acc[i] * __expf(fminf(gi[i] - gj, 0.f)); } }
    }
    LDS_WAIT(); asm volatile("" ::: "memory");
    {
        float T[64];
        FSub<63>::run(T, AL, lane);
        LDS_WAIT(); asm volatile("" ::: "memory");
        unsigned short* TB = (unsigned short*)wl;
#pragma unroll
        for (int i = 0; i < 64; ++i) TB[i * 72 + lane] = (unsigned short)f2bf(T[i]);
    }
    LDS_WAIT(); asm volatile("" ::: "memory");
    {
        bf16x8 tf[4][2];
#pragma unroll
        for (int ti = 0; ti < 4; ++ti)
#pragma unroll
            for (int ks = 0; ks < 2; ++ks) tf[ti][ks] = *(const bf16x8*)(wl + ((16 * ti + fr) * 72 + 32 * ks + 8 * fq) * 2);
#pragma unroll
        for (int which = 0; which < 2; ++which) { const bf16* src = which ? A.GVT : A.GKT; const float* sc = SC + (which ? 64 : 128);
            bf16x8 raws[4][2];
#pragma unroll
            for (int tn = 0; tn < 4; ++tn)
#pragma unroll
                for (int ks = 0; ks < 2; ++ks) raws[tn][ks] = *(const bf16x8*)(src + ((size_t)bh * 64 + 16 * tn + fr) * 4096 + t0 + 32 * ks + 8 * fq);
            __builtin_amdgcn_sched_barrier(0);
#pragma unroll
            for (int tn = 0; tn < 4; ++tn) { bf16x8 yb[2];
#pragma unroll
                for (int ks = 0; ks < 2; ++ks) { const bf16x8 raw = raws[tn][ks];
                    const f32x4 s0 = *(const f32x4*)(sc + 32 * ks + 8 * fq), s1 = *(const f32x4*)(sc + 32 * ks + 8 * fq + 4);
                    yb[ks] = pack8(bf2f((unsigned short)raw[0]) * s0.x, bf2f((unsigned short)raw[1]) * s0.y, bf2f((unsigned short)raw[2]) * s0.z, bf2f((unsigned short)raw[3]) * s0.w,
                                   bf2f((unsigned short)raw[4]) * s1.x, bf2f((unsigned short)raw[5]) * s1.y, bf2f((unsigned short)raw[6]) * s1.z, bf2f((unsigned short)raw[7]) * s1.w); }
#pragma unroll
                for (int ti = 0; ti < 4; ++ti) { f32x4 acc = {0.f, 0.f, 0.f, 0.f};
                    acc = __builtin_amdgcn_mfma_f32_16x16x32_bf16(tf[ti][0], yb[0], acc, 0, 0, 0);
                    if (ti >= 2) acc = __builtin_amdgcn_mfma_f32_16x16x32_bf16(tf[ti][1], yb[1], acc, 0, 0, 0);
                    if (which == 0) { const int p = 32 * (tn >> 1) + 8 * (fr >> 2) + 4 * (tn & 1) + (fr & 3);
#pragma unroll
                        for (int i = 0; i < 4; ++i) A.WX[((size_t)unit * 64 + 16 * ti + 4 * fq + i) * 64 + p] = (bf16)f2bf(acc[i]); }
                    else *(f32x4*)(A.U0F + (((size_t)unit * 16 + ti * 4 + tn) * 64 + lane) * 4) = acc; } } }
    }
    {
        bf16x8 kf[4][2], qf[4][2];
#pragma unroll
        for (int t4 = 0; t4 < 4; ++t4)
#pragma unroll
            for (int ks = 0; ks < 2; ++ks) { kf[t4][ks] = *(const bf16x8*)(A.GK + ((size_t)bh * 4096 + t0 + 16 * t4 + fr) * 64 + 32 * ks + 8 * fq);
                qf[t4][ks] = *(const bf16x8*)(A.GQ + ((size_t)bh * 4096 + t0 + 16 * t4 + fr) * 64 + 32 * ks + 8 * fq); }
        __builtin_amdgcn_sched_barrier(0);
#pragma unroll
        for (int ti = 0; ti < 4; ++ti) { const f32x4 gi = *(const f32x4*)(SC + 16 * ti + 4 * fq);
#pragma unroll
            for (int tj = 0; tj < 4; ++tj) { f32x4 acc = {0.f, 0.f, 0.f, 0.f};
                if (tj <= ti) { acc = __builtin_amdgcn_mfma_f32_16x16x32_bf16(qf[ti][0], kf[tj][0], acc, 0, 0, 0); acc = __builtin_amdgcn_mfma_f32_16x16x32_bf16(qf[ti][1], kf[tj][1], acc, 0, 0, 0); }
                const float gj = SC[16 * tj + fr]; const int p = 32 * (tj >> 1) + 8 * (fr >> 2) + 4 * (tj & 1) + (fr & 3);
#pragma unroll
                for (int i = 0; i < 4; ++i) { const int ri = 16 * ti + 4 * fq + i, cj = 16 * tj + fr;
                    const float v = (tj <= ti && ri >= cj) ? acc[i] * __expf(fminf(gi[i] - gj, 0.f)) : 0.f;
                    A.QKX[((size_t)unit * 64 + ri) * 64 + p] = (bf16)f2bf(v); } } }
    }
    {
        const int lg = perm_inv32(lane);
        const float ek = SC[256 + lg];
#pragma unroll 1
        for (int r0 = 0; r0 < 64; r0 += 16) { bf16 qv[16], kv[16];
#pragma unroll
            for (int i = 0; i < 16; ++i) { qv[i] = A.GQ[((size_t)bh * 4096 + t0 + r0 + i) * 64 + lg]; kv[i] = A.GKT[((size_t)bh * 64 + r0 + i) * 4096 + t0 + lg]; }
            __builtin_amdgcn_sched_barrier(0);
#pragma unroll
            for (int i = 0; i < 16; ++i) { A.QX[((size_t)unit * 64 + r0 + i) * 64 + lane] = (bf16)f2bf(bf2f(qv[i]) * SC[192 + r0 + i]);
                A.KTX[((size_t)unit * 64 + r0 + i) * 64 + lane] = (bf16)f2bf(bf2f(kv[i]) * ek); } }
    }
    LDS_WAIT(); asm volatile("" ::: "memory");
}
struct GS2Args { const bf16* WX; const bf16* QX; const bf16* QKX; const bf16* KTX; const float* U0F; const float* GL; float* OG; float* out; int l; };
__device__ __forceinline__ void gdn_scan2_wave(const GS2Args& A, int bh, int te, int lane) {
    const int fr = lane & 15, fq = lane >> 4, b = bh >> 3, h = bh & 7;
    f32x4 s[4]; bf16x8 sfr[2];
#pragma unroll
    for (int i = 0; i < 4; ++i) s[i] = (f32x4){0.f, 0.f, 0.f, 0.f};
    sfr[0] = (bf16x8){0, 0, 0, 0, 0, 0, 0, 0}; sfr[1] = sfr[0];
    f32x4 u[4]; bf16x8 wf[4][2], kt[4][2], qx[4][2], qkx[4][2]; float dec;
#define GS_LD_UW(nn) do { const size_t un_ = (size_t)bh * 64 + (nn); _Pragma("unroll") for (int tc = 0; tc < 4; ++tc) { u[tc] = *(const f32x4*)(A.U0F + ((un_ * 16 + tc * 4 + te) * 64 + lane) * 4); \
        _Pragma("unroll") for (int ks = 0; ks < 2; ++ks) wf[tc][ks] = *(const bf16x8*)(A.WX + (un_ * 64 + 16 * tc + fr) * 64 + 32 * ks + 8 * fq); } } while (0)
#define GS_LD_Q(nn) do { const size_t un_ = (size_t)bh * 64 + (nn); _Pragma("unroll") for (int tc = 0; tc < 4; ++tc) _Pragma("unroll") for (int ks = 0; ks < 2; ++ks) { \
        qx[tc][ks] = *(const bf16x8*)(A.QX + (un_ * 64 + 16 * tc + fr) * 64 + 32 * ks + 8 * fq); qkx[tc][ks] = *(const bf16x8*)(A.QKX + (un_ * 64 + 16 * tc + fr) * 64 + 32 * ks + 8 * fq); } } while (0)
#define GS_LD_K(nn) do { const size_t un_ = (size_t)bh * 64 + (nn); dec = A.GL[un_]; _Pragma("unroll") for (int tc = 0; tc < 4; ++tc) _Pragma("unroll") for (int ks = 0; ks < 2; ++ks) \
        kt[tc][ks] = *(const bf16x8*)(A.KTX + (un_ * 64 + 16 * tc + fr) * 64 + 32 * ks + 8 * fq); } while (0)
    GS_LD_UW(0); GS_LD_Q(0); GS_LD_K(0);
    __builtin_amdgcn_sched_barrier(0);
#pragma unroll 1
    for (int n = 0; n < 64; ++n) {
        const int nn = n < 63 ? n + 1 : 63;
#pragma unroll
        for (int tc = 0; tc < 4; ++tc) { f32x4 acc = {0.f, 0.f, 0.f, 0.f};
            acc = __builtin_amdgcn_mfma_f32_16x16x32_bf16(wf[tc][0], sfr[0], acc, 0, 0, 0); acc = __builtin_amdgcn_mfma_f32_16x16x32_bf16(wf[tc][1], sfr[1], acc, 0, 0, 0);
            u[tc] -= acc; }
        bf16x8 ufr[2];
#pragma unroll
        for (int ks = 0; ks < 2; ++ks) ufr[ks] = pack8(u[2 * ks][0], u[2 * ks][1], u[2 * ks][2], u[2 * ks][3], u[2 * ks + 1][0], u[2 * ks + 1][1], u[2 * ks + 1][2], u[2 * ks + 1][3]);
        __builtin_amdgcn_sched_barrier(0);
        GS_LD_UW(nn);
        __builtin_amdgcn_sched_barrier(0);
        f32x4 oacc[4];
#pragma unroll
        for (int tc = 0; tc < 4; ++tc) {
            f32x4 acc = {0.f, 0.f, 0.f, 0.f};
            acc = __builtin_amdgcn_mfma_f32_16x16x32_bf16(qx[tc][0], sfr[0], acc, 0, 0, 0); acc = __builtin_amdgcn_mfma_f32_16x16x32_bf16(qx[tc][1], sfr[1], acc, 0, 0, 0);
            acc = __builtin_amdgcn_mfma_f32_16x16x32_bf16(qkx[tc][0], ufr[0], acc, 0, 0, 0); acc = __builtin_amdgcn_mfma_f32_16x16x32_bf16(qkx[tc][1], ufr[1], acc, 0, 0, 0);
            oacc[tc] = acc; }
#pragma unroll
        for (int td = 0; td < 4; ++td) { f32x4 acc = s[td] * dec;
            acc = __builtin_amdgcn_mfma_f32_16x16x32_bf16(kt[td][0], ufr[0], acc, 0, 0, 0); acc = __builtin_amdgcn_mfma_f32_16x16x32_bf16(kt[td][1], ufr[1], acc, 0, 0, 0);
            s[td] = acc; }
#pragma unroll
        for (int ks = 0; ks < 2; ++ks) sfr[ks] = pack8(s[2 * ks][0], s[2 * ks][1], s[2 * ks][2], s[2 * ks][3], s[2 * ks + 1][0], s[2 * ks + 1][1], s[2 * ks + 1][2], s[2 * ks + 1][3]);
        __builtin_amdgcn_sched_barrier(0);
        GS_LD_Q(nn); GS_LD_K(nn);
#pragma unroll
        for (int tc = 0; tc < 4; ++tc)
#pragma unroll
            for (int i = 0; i < 4; ++i) A.OG[((size_t)b * SEQ + 64 * n + 16 * tc + 4 * fq + i) * 512 + h * 64 + 16 * te + fr] = oacc[tc][i];
        __builtin_amdgcn_sched_barrier(0);
    }
#undef GS_LD_UW
#undef GS_LD_Q
#undef GS_LD_K
#pragma unroll
    for (int td = 0; td < 4; ++td)
#pragma unroll
        for (int i = 0; i < 4; ++i) A.out[O_GDNP + ((((size_t)A.l * NPB + b) * 8 + h) * 64 + 16 * td + 4 * fq + i) * 64 + 16 * te + fr] = s[td][i];
}

constexpr int SC_ROW = 144, SC_MAT = 64 * SC_ROW, SC_U = 4 * SC_MAT, SC_STAGE = SC_U + 16384, SC_DEC = 2 * SC_STAGE;
__device__ __forceinline__ void gdn_scan3_block(const GS2Args& A, unsigned char* lds, int bh, int tid) {
    const int lane = tid & 63, wave = __builtin_amdgcn_readfirstlane(tid >> 6), fr = lane & 15, fq = lane >> 4, b = bh >> 3, h = bh & 7, te = wave;
    const int mrow = (tid >> 3), mch = tid & 7;
    v4u ra[6], rb[6];
#define SC_LOAD(R, nn) do { const size_t un_ = (size_t)bh * 64 + ((nn) < 63 ? (nn) : 63); \
        R[0] = *(const v4u*)(A.WX + un_ * 4096 + mrow * 64 + mch * 8); R[1] = *(const v4u*)(A.KTX + un_ * 4096 + mrow * 64 + mch * 8); \
        R[2] = *(const v4u*)(A.QX + un_ * 4096 + mrow * 64 + mch * 8); R[3] = *(const v4u*)(A.QKX + un_ * 4096 + mrow * 64 + mch * 8); \
        R[4] = *(const v4u*)(A.U0F + un_ * 4096 + (size_t)tid * 4); R[5] = *(const v4u*)(A.U0F + un_ * 4096 + (size_t)(tid + 512) * 4); } while (0)
#define SC_STORE(R, st) do { unsigned char* sb_ = lds + (st) * SC_STAGE; \
        *(v4u*)(sb_ + 0 * SC_MAT + mrow * SC_ROW + mch * 16) = R[0]; *(v4u*)(sb_ + 1 * SC_MAT + mrow * SC_ROW + mch * 16) = R[1]; \
        *(v4u*)(sb_ + 2 * SC_MAT + mrow * SC_ROW + mch * 16) = R[2]; *(v4u*)(sb_ + 3 * SC_MAT + mrow * SC_ROW + mch * 16) = R[3]; \
        *(v4u*)(sb_ + SC_U + tid * 16) = R[4]; *(v4u*)(sb_ + SC_U + (tid + 512) * 16) = R[5]; } while (0)
    f32x4 s[4]; bf16x8 sfr[2];
#pragma unroll
    for (int i = 0; i < 4; ++i) s[i] = (f32x4){0.f, 0.f, 0.f, 0.f};
    sfr[0] = (bf16x8){0, 0, 0, 0, 0, 0, 0, 0}; sfr[1] = sfr[0];
    __syncthreads();
    if (tid < 64) ((float*)(lds + SC_DEC))[tid] = A.GL[(size_t)bh * 64 + tid];
    SC_LOAD(ra, 0); SC_STORE(ra, 0);
    SC_LOAD(rb, 1); SC_LOAD(ra, 2);
    __syncthreads();
#define SC_CHUNK(n, st) do { if (wave < 4) { const unsigned char* sb_ = lds + (st) * SC_STAGE; \
        f32x4 u[4]; bf16x8 ufr[2]; \
        _Pragma("unroll") for (int tc = 0; tc < 4; ++tc) { u[tc] = *(const f32x4*)(sb_ + SC_U + ((tc * 4 + te) * 64 + lane) * 16); \
            const bf16x8 w0 = *(const bf16x8*)(sb_ + (16 * tc + fr) * SC_ROW + (8 * fq) * 2), w1 = *(const bf16x8*)(sb_ + (16 * tc + fr) * SC_ROW + (32 + 8 * fq) * 2); \
            f32x4 acc = {0.f, 0.f, 0.f, 0.f}; acc = __builtin_amdgcn_mfma_f32_16x16x32_bf16(w0, sfr[0], acc, 0, 0, 0); acc = __builtin_amdgcn_mfma_f32_16x16x32_bf16(w1, sfr[1], acc, 0, 0, 0); u[tc] -= acc; } \
        _Pragma("unroll") for (int ks = 0; ks < 2; ++ks) ufr[ks] = pack8(u[2 * ks][0], u[2 * ks][1], u[2 * ks][2], u[2 * ks][3], u[2 * ks + 1][0], u[2 * ks + 1][1], u[2 * ks + 1][2], u[2 * ks + 1][3]); \
        _Pragma("unroll") for (int tc = 0; tc < 4; ++tc) { \
            const bf16x8 q0 = *(const bf16x8*)(sb_ + 2 * SC_MAT + (16 * tc + fr) * SC_ROW + (8 * fq) * 2), q1 = *(const bf16x8*)(sb_ + 2 * SC_MAT + (16 * tc + fr) * SC_ROW + (32 + 8 * fq) * 2); \
            const bf16x8 k0 = *(const bf16x8*)(sb_ + 3 * SC_MAT + (16 * tc + fr) * SC_ROW + (8 * fq) * 2), k1 = *(const bf16x8*)(sb_ + 3 * SC_MAT + (16 * tc + fr) * SC_ROW + (32 + 8 * fq) * 2); \
            f32x4 acc = {0.f, 0.f, 0.f, 0.f}; \
            acc = __builtin_amdgcn_mfma_f32_16x16x32_bf16(q0, sfr[0], acc, 0, 0, 0); acc = __builtin_amdgcn_mfma_f32_16x16x32_bf16(q1, sfr[1], acc, 0, 0, 0); \
            acc = __builtin_amdgcn_mfma_f32_16x16x32_bf16(k0, ufr[0], acc, 0, 0, 0); acc = __builtin_amdgcn_mfma_f32_16x16x32_bf16(k1, ufr[1], acc, 0, 0, 0); \
            _Pragma("unroll") for (int i = 0; i < 4; ++i) A.OG[((size_t)b * SEQ + 64 * (n) + 16 * tc + 4 * fq + i) * 512 + h * 64 + 16 * te + fr] = acc[i]; } \
        const float dec = ((const float*)(lds + SC_DEC))[(n)]; \
        _Pragma("unroll") for (int td = 0; td < 4; ++td) { \
            const bf16x8 t0 = *(const bf16x8*)(sb_ + 1 * SC_MAT + (16 * td + fr) * SC_ROW + (8 * fq) * 2), t1 = *(const bf16x8*)(sb_ + 1 * SC_MAT + (16 * td + fr) * SC_ROW + (32 + 8 * fq) * 2); \
            f32x4 acc = s[td] * dec; acc = __builtin_amdgcn_mfma_f32_16x16x32_bf16(t0, ufr[0], acc, 0, 0, 0); acc = __builtin_amdgcn_mfma_f32_16x16x32_bf16(t1, ufr[1], acc, 0, 0, 0); s[td] = acc; } \
        _Pragma("unroll") for (int ks = 0; ks < 2; ++ks) sfr[ks] = pack8(s[2 * ks][0], s[2 * ks][1], s[2 * ks][2], s[2 * ks][3], s[2 * ks + 1][0], s[2 * ks + 1][1], s[2 * ks + 1][2], s[2 * ks + 1][3]); } } while (0)
#pragma unroll 1
    for (int n = 0; n < 64; n += 2) {
        SC_STORE(rb, 1); __builtin_amdgcn_sched_barrier(0); SC_LOAD(rb, n + 3); __builtin_amdgcn_sched_barrier(0);
        SC_CHUNK(n, 0);
        __syncthreads();
        SC_STORE(ra, 0); __builtin_amdgcn_sched_barrier(0); SC_LOAD(ra, n + 4); __builtin_amdgcn_sched_barrier(0);
        SC_CHUNK(n + 1, 1);
        __syncthreads();
    }
#undef SC_LOAD
#undef SC_STORE
#undef SC_CHUNK
    if (wave < 4) {
#pragma unroll
        for (int td = 0; td < 4; ++td)
#pragma unroll
            for (int i = 0; i < 4; ++i) A.out[O_GDNP + ((((size_t)A.l * NPB + b) * 8 + h) * 64 + 16 * td + 4 * fq + i) * 64 + 16 * te + fr] = s[td][i];
    }
}

constexpr int L_CK = 0, L_CVT = 18432, L_IMP = 36864, L_MASK = 102400, L_UM = 102912, L_INV = 102928, L_K = 104448, L_VT = 113664;
struct AttArgs { const bf16* QB; const bf16* KS; const bf16* VS; const bf16* KW; const bf16* VW; const float* CKP; const float* CVP; const float* PROJ; bf16* MIX; };

constexpr float ATT_THR = 16.f;
constexpr int L_K2 = 122880, L_VT2 = 132096, L_VT3 = 0;
template <int MODE>
__device__ __forceinline__ void attn_tiles(unsigned char* lds, const bf16* Kg, const bf16* Vg, int j_lo, int j_hi, unsigned long long umask, unsigned long long tmask,
                                           int qblk, int trel, const bf16x8 (&qr)[4], f32x16 (&o)[2], float& mref, float& lrun, int tid, int r32, int hi) {
    int j = j_lo; while (j <= j_hi && !((umask >> j) & 1ull)) ++j;
    const int key = tid >> 3, ch = tid & 7;
    v4u kvv = {0u, 0u, 0u, 0u}, vv = {0u, 0u, 0u, 0u};
#define AT_LOAD(jj) do { kvv = *(const v4u*)(Kg + (size_t)(64 * (jj) + key) * 128 + ch * 8); vv = *(const v4u*)(Vg + (size_t)(64 * (jj) + key) * 128 + ch * 8); } while (0)
#define AT_WRITE(kofs, vofs) do { *(v4u*)(lds + (kofs) + key * 144 + ch * 16) = kvv; *(v4u*)(lds + (vofs) + key * 144 + ch * 16) = vv; } while (0)
    if (j > j_hi) return;
    AT_LOAD(j);
    __syncthreads();
    AT_WRITE(L_K, L_VT);
    int jn = j + 1; while (jn <= j_hi && !((umask >> jn) & 1ull)) ++jn;
    if (jn <= j_hi) AT_LOAD(jn);
    __syncthreads();
    const bool grpB = (tid >= 256);
    v4u pwp[4];
#pragma unroll
    for (int i = 0; i < 4; ++i) pwp[i] = (v4u){0u, 0u, 0u, 0u};
    int it = 0, vprev = L_VT;
    typedef short v4i16_t_ __attribute__((ext_vector_type(4)));
    const int trl_ = tid & 63, trq_ = (trl_ & 15) >> 2, trp_ = trl_ & 3, trd_ = 16 * ((trl_ >> 4) & 1) + 4 * trp_;
#define AT_TR(p_) __builtin_bit_cast(s16x4, __builtin_amdgcn_ds_read_tr16_b64_v4i16((__attribute__((address_space(3))) v4i16_t_*)(p_)))
#define AT_PV(vofs, PW) do { _Pragma("unroll") for (int u = 0; u < 2; ++u) _Pragma("unroll") for (int s = 0; s < 2; ++s) { const bf16x8 pf = __builtin_bit_cast(bf16x8, PW[u * 2 + s]); \
        _Pragma("unroll") for (int dh = 0; dh < 2; ++dh) { const unsigned char* vp = lds + (vofs) + (32 * u + 16 * s + 4 * hi + trq_) * 144 + (32 * dh + trd_) * 2; \
            const s16x4 lo = AT_TR(vp), hi4 = AT_TR(vp + 8 * 144); \
            const bf16x8 vf = (bf16x8){lo[0], lo[1], lo[2], lo[3], hi4[0], hi4[1], hi4[2], hi4[3]}; \
            o[dh] = __builtin_amdgcn_mfma_f32_32x32x16_bf16(vf, pf, o[dh], 0, 0, 0); } } } while (0)
    while (j <= j_hi) {
        const int kb = (it & 1) ? L_K2 : L_K, kb2 = (it & 1) ? L_K : L_K2;
        const int m3 = it % 3, vb = (m3 == 0) ? L_VT : (m3 == 1) ? L_VT2 : L_VT3, vb2 = (m3 == 0) ? L_VT2 : (m3 == 1) ? L_VT3 : L_VT;
        if (grpB && it > 0) AT_PV(vprev, pwp);
        if (jn <= j_hi) AT_WRITE(kb2, vb2);
        int jnn = jn + 1; while (jnn <= j_hi && !((umask >> jnn) & 1ull)) ++jnn;
        if (jnn <= j_hi) AT_LOAD(jnn);
        __builtin_amdgcn_sched_barrier(0);
        const bool tsel = (MODE == 0) ? (((tmask >> j) & 1ull) != 0ull) : true;
        const float cval = tsel ? -mref : NEG_INF;
        f32x16 ct;
#pragma unroll
        for (int r = 0; r < 16; ++r) ct[r] = cval;
        f32x16 p[2];
#pragma unroll
        for (int u = 0; u < 2; ++u) { f32x16 acc;
#pragma unroll
            for (int d0 = 0; d0 < 4; ++d0) { const bf16x8 kf = *(const bf16x8*)(lds + kb + (32 * u + r32) * 144 + (16 * d0 + 8 * hi) * 2);
                acc = __builtin_amdgcn_mfma_f32_32x32x16_bf16(kf, qr[d0], d0 == 0 ? ct : acc, 0, 0, 0); }
            p[u] = acc; }
        if (j == qblk) {
#pragma unroll
            for (int u = 0; u < 2; ++u)
#pragma unroll
                for (int r = 0; r < 16; ++r) { const int kv = 32 * u + crow(r, hi); if (kv > trel) p[u][r] = NEG_INF; } }
        if (MODE == 1 && j == qblk - 8) {
#pragma unroll
            for (int u = 0; u < 2; ++u)
#pragma unroll
                for (int r = 0; r < 16; ++r) { const int kv = 32 * u + crow(r, hi); if (kv < trel) p[u][r] = NEG_INF; } }
        float rm;
        { float a = __builtin_fmaxf(__builtin_fmaxf(p[0][0], p[0][1]), p[1][0]), b2 = __builtin_fmaxf(__builtin_fmaxf(p[0][2], p[0][3]), p[1][1]); a = __builtin_fmaxf(__builtin_fmaxf(a, p[1][2]), p[1][3]);
#pragma unroll
          for (int r = 4; r < 16; r += 4) { a = __builtin_fmaxf(__builtin_fmaxf(a, p[0][r]), p[0][r + 1]); b2 = __builtin_fmaxf(__builtin_fmaxf(b2, p[0][r + 2]), p[0][r + 3]);
              a = __builtin_fmaxf(__builtin_fmaxf(a, p[1][r]), p[1][r + 1]); b2 = __builtin_fmaxf(__builtin_fmaxf(b2, p[1][r + 2]), p[1][r + 3]); }
          rm = __builtin_fmaxf(a, b2); }
        { auto rr = __builtin_amdgcn_permlane32_swap(__float_as_uint(rm), __float_as_uint(rm), false, false); rm = __builtin_fmaxf(__uint_as_float(rr[0]), __uint_as_float(rr[1])); }
        if (__builtin_expect(__any(rm > ATT_THR), 0)) {
            const float dl = (rm > ATT_THR) ? rm : 0.f, f = ex2(-dl);
            mref += dl; lrun *= f;
#pragma unroll
            for (int u = 0; u < 2; ++u)
#pragma unroll
                for (int r = 0; r < 16; ++r) p[u][r] -= dl;
#pragma unroll
            for (int dh = 0; dh < 2; ++dh)
#pragma unroll
                for (int r = 0; r < 16; ++r) o[dh][r] *= f; }
        typedef float f32x2v_ __attribute__((ext_vector_type(2)));
        f32x2v_ ls2 = {0.f, 0.f};
#pragma unroll
        for (int u = 0; u < 2; ++u)
#pragma unroll
            for (int r = 0; r < 16; r += 2) { const float e0 = ex2(p[u][r]), e1 = ex2(p[u][r + 1]); p[u][r] = e0; p[u][r + 1] = e1; ls2 += (f32x2v_){e0, e1}; }
        lrun += ls2.x + ls2.y;
        v4u pw[4];
#pragma unroll
        for (int u = 0; u < 2; ++u)
#pragma unroll
            for (int s = 0; s < 2; ++s) { pw[u * 2 + s].x = pk2(p[u][8 * s + 0], p[u][8 * s + 1]); pw[u * 2 + s].y = pk2(p[u][8 * s + 2], p[u][8 * s + 3]);
                pw[u * 2 + s].z = pk2(p[u][8 * s + 4], p[u][8 * s + 5]); pw[u * 2 + s].w = pk2(p[u][8 * s + 6], p[u][8 * s + 7]); }
        if (!grpB) AT_PV(vb, pw);
        else {
#pragma unroll
            for (int i = 0; i < 4; ++i) pwp[i] = pw[i];
            vprev = vb; }
        __syncthreads();
        j = jn; jn = jnn; ++it;
    }
    if (grpB && it > 0) AT_PV(vprev, pwp);
#undef AT_PV
#undef AT_TR
#undef AT_LOAD
#undef AT_WRITE
}

__device__ __forceinline__ void nsa_prompt_unit(const AttArgs& A, unsigned char* lds, int unit, int tid) {
    const int lane = tid & 63, wave = tid >> 6, r32 = lane & 31, hi = lane >> 5, hh = wave & 3, ts = wave >> 2;
    const int qblk = 63 - (unit >> 3), b = (unit >> 1) & 3, kvh = unit & 1;
    const int head = kvh * 4 + hh, trel = 32 * ts + r32, t = 64 * qblk + trel; const size_t m = (size_t)b * SEQ + t;
    __syncthreads();
    const int nvmax = 2 * qblk + 2, ntile_c = (nvmax + 31) >> 5;
    { const int ch = tid & 7;
      for (int n = tid >> 3; n < 32 * ntile_c; n += 64) {
          const float* ckp = A.CKP + ((size_t)(b * 128 + n) * 2 + kvh) * 64 + ch * 8; const float* cvp = A.CVP + ((size_t)(b * 128 + n) * 2 + kvh) * 64 + ch * 8;
          const f32x4 k0 = *(const f32x4*)ckp, k1 = *(const f32x4*)(ckp + 4), v0 = *(const f32x4*)cvp, v1 = *(const f32x4*)(cvp + 4);
          *(bf16x8*)(lds + L_CK + n * 144 + ch * 16) = pack8(k0.x, k0.y, k0.z, k0.w, k1.x, k1.y, k1.z, k1.w);
          unsigned short* vt = (unsigned short*)(lds + L_CVT);
          vt[(ch * 8 + 0) * 136 + n] = (unsigned short)f2bf(v0.x); vt[(ch * 8 + 1) * 136 + n] = (unsigned short)f2bf(v0.y); vt[(ch * 8 + 2) * 136 + n] = (unsigned short)f2bf(v0.z); vt[(ch * 8 + 3) * 136 + n] = (unsigned short)f2bf(v0.w);
          vt[(ch * 8 + 4) * 136 + n] = (unsigned short)f2bf(v1.x); vt[(ch * 8 + 5) * 136 + n] = (unsigned short)f2bf(v1.y); vt[(ch * 8 + 6) * 136 + n] = (unsigned short)f2bf(v1.z); vt[(ch * 8 + 7) * 136 + n] = (unsigned short)f2bf(v1.w);
      }
      if (tid < 128) ((unsigned*)(lds + L_MASK))[tid] = 0u;
      if (tid < 2) ((unsigned*)(lds + L_UM))[tid] = 0u; }
    bf16x8 qr[4];
#pragma unroll
    for (int d0 = 0; d0 < 4; ++d0) qr[d0] = *(const bf16x8*)(A.QB + m * 512 + head * 64 + 16 * d0 + 8 * hi);
    __syncthreads();
    f32x16 tot[2];
    {
        const int nv = (t + 1) >> 5;
        float mx = NEG_INF;
#pragma unroll 1
        for (int tau = 0; tau < ntile_c; ++tau) {
            f32x16 acc = {};
#pragma unroll
            for (int d0 = 0; d0 < 4; ++d0) { const bf16x8 kf = *(const bf16x8*)(lds + L_CK + (32 * tau + r32) * 144 + (16 * d0 + 8 * hi) * 2);
                acc = __builtin_amdgcn_mfma_f32_32x32x16_bf16(kf, qr[d0], acc, 0, 0, 0); }
#pragma unroll
            for (int r = 0; r < 16; ++r) { const int n = 32 * tau + crow(r, hi); if (n < nv) mx = fmaxf(mx, acc[r]); }
        }
        mx = fmaxf(mx, __shfl_xor(mx, 32)); if (mx == NEG_INF) mx = 0.f;
        float sum = 0.f;
        f32x16 oc[2]; oc[0] = (f32x16){}; oc[1] = (f32x16){};
        float* imph = (float*)(lds + L_IMP) + (size_t)hh * 4096 + (32 * ts + r32) * 64;
#pragma unroll 1
        for (int tau = 0; tau < 4; ++tau) {
            f32x16 e = {};
            if (tau < ntile_c) {
                f32x16 acc = {};
#pragma unroll
                for (int d0 = 0; d0 < 4; ++d0) { const bf16x8 kf = *(const bf16x8*)(lds + L_CK + (32 * tau + r32) * 144 + (16 * d0 + 8 * hi) * 2);
                    acc = __builtin_amdgcn_mfma_f32_32x32x16_bf16(kf, qr[d0], acc, 0, 0, 0); }
#pragma unroll
                for (int r = 0; r < 16; ++r) { const int n = 32 * tau + crow(r, hi); e[r] = (n < nv) ? ex2(acc[r] - mx) : 0.f; sum += e[r]; }
#pragma unroll
                for (int s = 0; s < 2; ++s) {
                    const bf16x8 pf = pack8(e[8 * s + 0], e[8 * s + 1], e[8 * s + 2], e[8 * s + 3], e[8 * s + 4], e[8 * s + 5], e[8 * s + 6], e[8 * s + 7]);
#pragma unroll
                    for (int dh = 0; dh < 2; ++dh) { const unsigned char* vp = lds + L_CVT + (r32 + 32 * dh) * 272 + (32 * tau + 16 * s + 4 * hi) * 2;
                        const s16x4 lo = *(const s16x4*)vp, hi4 = *(const s16x4*)(vp + 16);
                        const bf16x8 vf = (bf16x8){lo[0], lo[1], lo[2], lo[3], hi4[0], hi4[1], hi4[2], hi4[3]};
                        oc[dh] = __builtin_amdgcn_mfma_f32_32x32x16_bf16(vf, pf, oc[dh], 0, 0, 0); }
                }
            }
#pragma unroll
            for (int a = 0; a < 4; ++a) { imph[16 * tau + 4 * a + 2 * hi + 0] = e[4 * a] + e[4 * a + 1]; imph[16 * tau + 4 * a + 2 * hi + 1] = e[4 * a + 2] + e[4 * a + 3]; }
        }
        sum += __shfl_xor(sum, 32);
        const float inv = 1.f / fmaxf(sum, 1e-30f);
        if (hi == 0) ((float*)(lds + L_INV))[hh * 64 + 32 * ts + r32] = inv;
        const float g0 = sigmoidf_(A.PROJ[m * NP + C_GATE + head * 3 + 0]) * inv;
#pragma unroll
        for (int dh = 0; dh < 2; ++dh)
#pragma unroll
            for (int r = 0; r < 16; ++r) tot[dh][r] = g0 * oc[dh][r];
    }
    __syncthreads();
    { float* ip = (float*)(lds + L_IMP); const float* iv = (const float*)(lds + L_INV);
#pragma unroll
      for (int i = 0; i < 8; ++i) { const int idx = tid + 512 * i, tk = idx >> 6;
          ip[idx] = (ip[idx] * iv[tk] + ip[4096 + idx] * iv[64 + tk]) + (ip[8192 + idx] * iv[128 + tk] + ip[12288 + idx] * iv[192 + tk]); } }
    __syncthreads();
    { const int tok = tid >> 3, jg = tid & 7; unsigned* mk = (unsigned*)(lds + L_MASK) + tok * 2;
      if (qblk <= 15) { if (jg == 0) { const unsigned long long am = (1ull << (qblk + 1)) - 1ull; mk[0] = (unsigned)am; mk[1] = (unsigned)(am >> 32); } }
      else {
          const float* iv = (const float*)(lds + L_IMP) + tok * 64; float vj[8]; int rk[8];
#pragma unroll
          for (int jj = 0; jj < 8; ++jj) { vj[jj] = iv[jg * 8 + jj]; rk[jj] = 0; }
          for (int i = 1; i <= qblk - 2; ++i) { const float vi = iv[i];
#pragma unroll
              for (int jj = 0; jj < 8; ++jj) { const int j = jg * 8 + jj; rk[jj] += (vi > vj[jj] || (vi == vj[jj] && i < j)) ? 1 : 0; } }
          unsigned bits = 0u;
#pragma unroll
          for (int jj = 0; jj < 8; ++jj) { const int j = jg * 8 + jj; const bool cand = (j >= 1 && j <= qblk - 2);
              if ((cand && rk[jj] < 13) || j == 0 || j == qblk || j == qblk - 1) bits |= 1u << ((jg & 3) * 8 + jj); }
          if (bits) atomicOr(mk + (jg >> 2), bits);
      } }
    __syncthreads();
    if (tid < 64) { const unsigned* mk = (const unsigned*)(lds + L_MASK) + tid * 2; atomicOr((unsigned*)(lds + L_UM), mk[0]); atomicOr((unsigned*)(lds + L_UM) + 1, mk[1]); }
    __syncthreads();
    unsigned long long tmask, umask;
    { const unsigned* mk = (const unsigned*)(lds + L_MASK) + trel * 2; tmask = (unsigned long long)mk[0] | ((unsigned long long)mk[1] << 32);
      const unsigned* um = (const unsigned*)(lds + L_UM); umask = (unsigned long long)um[0] | ((unsigned long long)um[1] << 32); }
    float* stash = (float*)(lds + L_IMP) + (size_t)wave * 2048 + lane;
#pragma unroll
    for (int dh = 0; dh < 2; ++dh)
#pragma unroll
        for (int r = 0; r < 16; ++r) stash[(dh * 16 + r) * 64] = tot[dh][r];
    {
        f32x16 o[2]; o[0] = (f32x16){}; o[1] = (f32x16){}; float mrun = 0.f, lrun = 0.f;
        attn_tiles<0>(lds, A.KS + (size_t)b * SEQ * 128 + kvh * 64, A.VS + (size_t)b * SEQ * 128 + kvh * 64, 0, qblk, umask, tmask, qblk, trel, qr, o, mrun, lrun, tid, r32, hi);
        lrun += __shfl_xor(lrun, 32);
        const float g1 = lrun > 0.f ? sigmoidf_(A.PROJ[m * NP + C_GATE + head * 3 + 1]) / lrun : 0.f;
#pragma unroll
        for (int dh = 0; dh < 2; ++dh)
#pragma unroll
            for (int r = 0; r < 16; ++r) stash[(dh * 16 + r) * 64] += g1 * o[dh][r];
    }
    {
        f32x16 o[2]; o[0] = (f32x16){}; o[1] = (f32x16){}; float mrun = 0.f, lrun = 0.f;
        const int jlo = qblk >= 8 ? qblk - 8 : 0;
        attn_tiles<1>(lds, A.KW + (size_t)b * SEQ * 128 + kvh * 64, A.VW + (size_t)b * SEQ * 128 + kvh * 64, jlo, qblk, ~0ull, ~0ull, qblk, trel, qr, o, mrun, lrun, tid, r32, hi);
        lrun += __shfl_xor(lrun, 32);
        const float g2 = lrun > 0.f ? sigmoidf_(A.PROJ[m * NP + C_GATE + head * 3 + 2]) / lrun : 0.f;
#pragma unroll
        for (int dh = 0; dh < 2; ++dh)
#pragma unroll
            for (int r = 0; r < 16; ++r) tot[dh][r] = stash[(dh * 16 + r) * 64] + g2 * o[dh][r];
    }
    bf16* mo = A.MIX + m * 1024 + 512 + head * 64;
#pragma unroll
    for (int dh = 0; dh < 2; ++dh)
#pragma unroll
        for (int a = 0; a < 4; ++a) { const int d0 = 32 * dh + 8 * a + 4 * hi;
            *(v2u*)(mo + d0) = (v2u){pk2(tot[dh][4 * a], tot[dh][4 * a + 1]), pk2(tot[dh][4 * a + 2], tot[dh][4 * a + 3])}; }
}

struct SAttArgs { const bf16* QB; const bf16* KS; const bf16* VS; const bf16* KW; const bf16* VW; const float* CKS; const float* CVS; const float* PROJ; const float* cache; const int* page_table; const float* state_win; bf16* MIX; int l; };
constexpr int S2_IMP = 0, S2_MK = 512, S2_ITEMS = 576, S2_OC = 1024, S2_MG = 8192;
constexpr int S2_MG_STRIDE = 4224;
template <bool F32> __device__ __forceinline__ void s2_block(const void* kbase, const void* vbase, int kstride, int nvalid, const bf16x8 (&qf)[2], const bool (&keep)[4][4], f32x4 (&O)[4], float& mrun, float& lrun, int fr, int fq) {
    f32x4 kraw[4][2][2]; bf16x8 kb[4][2]; f32x4 vraw[2][8]; v2u vb[2][8];
#pragma unroll
    for (int tk = 0; tk < 4; ++tk) { const int key = 16 * tk + fr, kc = key < nvalid ? key : nvalid - 1;
#pragma unroll
        for (int ks = 0; ks < 2; ++ks) {
            if (F32) { const float* p = (const float*)kbase + (size_t)kc * kstride + 32 * ks + 8 * fq; kraw[tk][ks][0] = *(const f32x4*)p; kraw[tk][ks][1] = *(const f32x4*)(p + 4); }
            else kb[tk][ks] = *(const bf16x8*)((const bf16*)kbase + (size_t)kc * 128 + 32 * ks + 8 * fq); } }
#pragma unroll
    for (int ks = 0; ks < 2; ++ks)
#pragma unroll
        for (int j = 0; j < 8; ++j) { const int key = 32 * ks + 16 * (j >> 2) + 4 * fq + (j & 3), kc = key < nvalid ? key : nvalid - 1;
            if (F32) vraw[ks][j] = *(const f32x4*)((const float*)vbase + (size_t)kc * kstride + 4 * fr);
            else vb[ks][j] = *(const v2u*)((const bf16*)vbase + (size_t)kc * 128 + 4 * fr); }
    __builtin_amdgcn_sched_barrier(0);
    f32x4 acc[4];
#pragma unroll
    for (int tk = 0; tk < 4; ++tk) { bf16x8 kx[2];
#pragma unroll
        for (int ks = 0; ks < 2; ++ks) { if (F32) { const f32x4 a = kraw[tk][ks][0], b = kraw[tk][ks][1]; kx[ks] = pack8(a.x, a.y, a.z, a.w, b.x, b.y, b.z, b.w); } else kx[ks] = kb[tk][ks]; }
        f32x4 a4 = {0.f, 0.f, 0.f, 0.f};
        a4 = __builtin_amdgcn_mfma_f32_16x16x32_bf16(kx[0], qf[0], a4, 0, 0, 0); a4 = __builtin_amdgcn_mfma_f32_16x16x32_bf16(kx[1], qf[1], a4, 0, 0, 0);
        acc[tk] = a4; }
    float mx = NEG_INF;
#pragma unroll
    for (int tk = 0; tk < 4; ++tk)
#pragma unroll
        for (int i = 0; i < 4; ++i) { if (!keep[tk][i]) acc[tk][i] = NEG_INF; mx = fmaxf(mx, acc[tk][i]); }
    mx = fmaxf(mx, __shfl_xor(mx, 16)); mx = fmaxf(mx, __shfl_xor(mx, 32));
    const float mn = fmaxf(mrun, mx), msafe = (mn == NEG_INF) ? 0.f : mn, alpha = ex2(mrun - msafe);
    float ls = 0.f;
#pragma unroll
    for (int tk = 0; tk < 4; ++tk)
#pragma unroll
        for (int i = 0; i < 4; ++i) { const float e = ex2(acc[tk][i] - msafe); acc[tk][i] = e; ls += e; }
    lrun = lrun * alpha + ls; mrun = mn;
#pragma unroll
    for (int td = 0; td < 4; ++td) O[td] *= alpha;
#pragma unroll
    for (int ks = 0; ks < 2; ++ks) {
        const bf16x8 pf = pack8(acc[2 * ks][0], acc[2 * ks][1], acc[2 * ks][2], acc[2 * ks][3], acc[2 * ks + 1][0], acc[2 * ks + 1][1], acc[2 * ks + 1][2], acc[2 * ks + 1][3]);
        float vv[8][4];
#pragma unroll
        for (int j = 0; j < 8; ++j) {
            if (F32) { const f32x4 v = vraw[ks][j]; vv[j][0] = v.x; vv[j][1] = v.y; vv[j][2] = v.z; vv[j][3] = v.w; }
            else { const v2u w = vb[ks][j]; vv[j][0] = bf2f((unsigned short)(w.x & 0xffffu)); vv[j][1] = bf2f((unsigned short)(w.x >> 16)); vv[j][2] = bf2f((unsigned short)(w.y & 0xffffu)); vv[j][3] = bf2f((unsigned short)(w.y >> 16)); } }
#pragma unroll
        for (int td = 0; td < 4; ++td) { const bf16x8 vx = pack8(vv[0][td], vv[1][td], vv[2][td], vv[3][td], vv[4][td], vv[5][td], vv[6][td], vv[7][td]);
            O[td] = __builtin_amdgcn_mfma_f32_16x16x32_bf16(vx, pf, O[td], 0, 0, 0); }
    }
}
__device__ __forceinline__ void nsa_sample_unit(const SAttArgs& A, unsigned char* lds, int unit, int tid) {
    const int sb = unit >> 1, kvh = unit & 1, l = A.l;
    const int lane = tid & 63, wave = __builtin_amdgcn_readfirstlane(tid >> 6), fr = lane & 15, fq = lane >> 4;
    const int qi = fr >> 2, qh = fr & 3;
    float* IMP = (float*)(lds + S2_IMP); unsigned* MK = (unsigned*)(lds + S2_MK); int* ITEMS = (int*)(lds + S2_ITEMS);
    const size_t mq = (size_t)MP + sb * 4 + qi;
    __syncthreads();
    if (tid < 8) MK[tid] = 0u;
    bf16x8 qf[2];
#pragma unroll
    for (int ks = 0; ks < 2; ++ks) qf[ks] = *(const bf16x8*)(A.QB + mq * 512 + (kvh * 4 + qh) * 64 + 32 * ks + 8 * fq);
    {
        f32x4 O[4]; float mrun = NEG_INF, lrun = 0.f;
#pragma unroll
        for (int td = 0; td < 4; ++td) O[td] = (f32x4){0.f, 0.f, 0.f, 0.f};
        bool keep[4][4];
#pragma unroll
        for (int tk = 0; tk < 4; ++tk)
#pragma unroll
            for (int i = 0; i < 4; ++i) keep[tk][i] = true;
        const float* ckf = A.CKS + ((size_t)sb * 64 * 2 + kvh) * 64; const float* cvf = A.CVS + ((size_t)sb * 64 * 2 + kvh) * 64;
        f32x4 acc[4];
#pragma unroll
        for (int tk = 0; tk < 4; ++tk) { bf16x8 kx[2];
#pragma unroll
            for (int ks = 0; ks < 2; ++ks) { const float* p = ckf + (size_t)(16 * tk + fr) * 128 + 32 * ks + 8 * fq; const f32x4 a = *(const f32x4*)p, b = *(const f32x4*)(p + 4); kx[ks] = pack8(a.x, a.y, a.z, a.w, b.x, b.y, b.z, b.w); }
            f32x4 a4 = {0.f, 0.f, 0.f, 0.f};
            a4 = __builtin_amdgcn_mfma_f32_16x16x32_bf16(kx[0], qf[0], a4, 0, 0, 0); a4 = __builtin_amdgcn_mfma_f32_16x16x32_bf16(kx[1], qf[1], a4, 0, 0, 0);
            acc[tk] = a4; }
        float mx = NEG_INF;
#pragma unroll
        for (int tk = 0; tk < 4; ++tk)
#pragma unroll
            for (int i = 0; i < 4; ++i) mx = fmaxf(mx, acc[tk][i]);
        mx = fmaxf(mx, __shfl_xor(mx, 16)); mx = fmaxf(mx, __shfl_xor(mx, 32));
        float ls = 0.f;
#pragma unroll
        for (int tk = 0; tk < 4; ++tk)
#pragma unroll
            for (int i = 0; i < 4; ++i) { const float e = ex2(acc[tk][i] - mx); acc[tk][i] = e; ls += e; }
        ls += __shfl_xor(ls, 16); ls += __shfl_xor(ls, 32);
        const float inv = 1.f / fmaxf(ls, 1e-30f);
        if (wave == 0) {
#pragma unroll
            for (int tk = 0; tk < 4; ++tk)
#pragma unroll
                for (int b2 = 0; b2 < 2; ++b2) { float v = (acc[tk][2 * b2] + acc[tk][2 * b2 + 1]) * inv;
                    v += __shfl_xor(v, 1); v += __shfl_xor(v, 2);
                    if (qh == 0) IMP[qi * 32 + 8 * tk + 2 * fq + b2] = v; }
#pragma unroll
            for (int ks = 0; ks < 2; ++ks) {
                const bf16x8 pf = pack8(acc[2 * ks][0], acc[2 * ks][1], acc[2 * ks][2], acc[2 * ks][3], acc[2 * ks + 1][0], acc[2 * ks + 1][1], acc[2 * ks + 1][2], acc[2 * ks + 1][3]);
#pragma unroll
                for (int td = 0; td < 4; ++td) { float vv[8];
#pragma unroll
                    for (int j = 0; j < 8; ++j) { const int key = 32 * ks + 16 * (j >> 2) + 4 * fq + (j & 3); vv[j] = cvf[(size_t)key * 128 + 4 * fr + td]; }
                    const bf16x8 vx = pack8(vv[0], vv[1], vv[2], vv[3], vv[4], vv[5], vv[6], vv[7]);
                    O[td] = __builtin_amdgcn_mfma_f32_16x16x32_bf16(vx, pf, O[td], 0, 0, 0); } }
            const float g0 = sigmoidf_(A.PROJ[mq * NP + C_GATE + (kvh * 4 + qh) * 3 + 0]) * inv;
            float* OC = (float*)(lds + S2_OC);
#pragma unroll
            for (int td = 0; td < 4; ++td)
#pragma unroll
                for (int i = 0; i < 4; ++i) OC[(16 * fq + 4 * i + td) * 16 + fr] = g0 * O[td][i];
        }
        (void)mrun; (void)lrun; (void)keep;
    }
    __syncthreads();
    if (tid < 128) { const int i = tid >> 5, j = tid & 31; bool sel = (j == 0 || j == 31);
        if (j >= 1 && j <= 30) { const float vj = IMP[i * 32 + j]; int rk = 0;
            for (int q = 1; q <= 30; ++q) { const float vi = IMP[i * 32 + q]; rk += (vi > vj || (vi == vj && q < j)) ? 1 : 0; }
            sel = rk < 13; }
        if (sel) { atomicOr(MK + i, 1u << j); atomicOr(MK + 4, 1u << j); } }
    __syncthreads();
    if (tid == 0) { const unsigned um = MK[4]; int n = 0;
        for (int j = 0; j < 32; ++j) if ((um >> j) & 1u) ITEMS[1 + n++] = j;
        ITEMS[1 + n++] = 32;
        for (int jb = 0; jb < 9; ++jb) ITEMS[1 + n++] = 64 + jb;
        ITEMS[0] = n; }
    __syncthreads();
    {
        const int nitems = ITEMS[0]; const unsigned tm = MK[qi];
        f32x4 Os[4], Ow[4]; float ms = NEG_INF, lsum = 0.f, mw = NEG_INF, lw = 0.f;
#pragma unroll
        for (int td = 0; td < 4; ++td) { Os[td] = (f32x4){0.f, 0.f, 0.f, 0.f}; Ow[td] = (f32x4){0.f, 0.f, 0.f, 0.f}; }
        const float* wb = A.state_win + ((size_t)l * NSB + sb) * 512 * 256 + kvh * 64;
        for (int it = wave; it < nitems; it += NWAVES) {
            const int code = ITEMS[1 + it]; bool keep[4][4];
            if (code < 64) {
                const int j = code;
                if (j < 32) { const int phys = A.page_table[sb * NPAGES + (j >> 1)];
                    const float* base = A.cache + ((((size_t)l * NPOOL + phys) * 2 + kvh) * 128 + (j & 1) * 64) * 256;
                    const bool tsel = ((tm >> j) & 1u) != 0u;
#pragma unroll
                    for (int tk = 0; tk < 4; ++tk)
#pragma unroll
                        for (int i = 0; i < 4; ++i) keep[tk][i] = tsel;
                    s2_block<true>(base + 128, base + 192, 256, 64, qf, keep, Os, ms, lsum, fr, fq);
                } else {
#pragma unroll
                    for (int tk = 0; tk < 4; ++tk)
#pragma unroll
                        for (int i = 0; i < 4; ++i) { const int key = 16 * tk + 4 * fq + i; keep[tk][i] = key <= qi; }
                    s2_block<false>(A.KS + ((size_t)MP + sb * 4) * 128 + kvh * 64, A.VS + ((size_t)MP + sb * 4) * 128 + kvh * 64, 128, 4, qf, keep, Os, ms, lsum, fr, fq);
                }
            } else {
                const int jb = code - 64;
                if (jb < 8) {
#pragma unroll
                    for (int tk = 0; tk < 4; ++tk)
#pragma unroll
                        for (int i = 0; i < 4; ++i) { const int r = 64 * jb + 16 * tk + 4 * fq + i; keep[tk][i] = r >= qi; }
                    s2_block<true>(wb + (size_t)(64 * jb) * 256, wb + (size_t)(64 * jb) * 256 + 128, 256, 64, qf, keep, Ow, mw, lw, fr, fq);
                } else {
#pragma unroll
                    for (int tk = 0; tk < 4; ++tk)
#pragma unroll
                        for (int i = 0; i < 4; ++i) { const int key = 16 * tk + 4 * fq + i; keep[tk][i] = key <= qi; }
                    s2_block<false>(A.KW + ((size_t)MP + sb * 4) * 128 + kvh * 64, A.VW + ((size_t)MP + sb * 4) * 128 + kvh * 64, 128, 4, qf, keep, Ow, mw, lw, fr, fq);
                }
            }
        }
        lsum += __shfl_xor(lsum, 16); lsum += __shfl_xor(lsum, 32); lw += __shfl_xor(lw, 16); lw += __shfl_xor(lw, 32);
        float* Ps = (float*)(lds + S2_MG + (wave * 2 + 0) * S2_MG_STRIDE); float* Pw = (float*)(lds + S2_MG + (wave * 2 + 1) * S2_MG_STRIDE);
#pragma unroll
        for (int td = 0; td < 4; ++td)
#pragma unroll
            for (int i = 0; i < 4; ++i) { Ps[(16 * fq + 4 * i + td) * 16 + fr] = Os[td][i]; Pw[(16 * fq + 4 * i + td) * 16 + fr] = Ow[td][i]; }
        if (fq == 0) { Ps[1024 + fr] = ms; Ps[1040 + fr] = lsum; Pw[1024 + fr] = mw; Pw[1040 + fr] = lw; }
    }
    __syncthreads();
    {
        const int q = tid & 15, i = q >> 2, hh = q & 3; const size_t m = (size_t)MP + sb * 4 + i;
        const float* OC = (const float*)(lds + S2_OC);
        float res[2];
#pragma unroll
        for (int k = 0; k < 2; ++k) res[k] = OC[((tid >> 4) + 32 * k) * 16 + q];
#pragma unroll
        for (int br = 0; br < 2; ++br) {
            float M = NEG_INF;
#pragma unroll
            for (int w = 0; w < NWAVES; ++w) M = fmaxf(M, ((const float*)(lds + S2_MG + (w * 2 + br) * S2_MG_STRIDE))[1024 + q]);
            float L = 0.f, o0 = 0.f, o1 = 0.f;
#pragma unroll
            for (int w = 0; w < NWAVES; ++w) { const float* P = (const float*)(lds + S2_MG + (w * 2 + br) * S2_MG_STRIDE);
                const float f = ex2(P[1024 + q] - M);
                L += P[1040 + q] * f; o0 += P[(tid >> 4) * 16 + q] * f; o1 += P[((tid >> 4) + 32) * 16 + q] * f; }
            const float g = sigmoidf_(A.PROJ[m * NP + C_GATE + (kvh * 4 + hh) * 3 + 1 + br]) / fmaxf(L, 1e-30f);
            res[0] += g * o0; res[1] += g * o1;
        }
#pragma unroll
        for (int k = 0; k < 2; ++k) A.MIX[m * 1024 + 512 + (kvh * 4 + hh) * 64 + (tid >> 4) + 32 * k] = (bf16)f2bf(res[k]);
    }
}

constexpr int CW_CMPQ = 256;
__device__ __forceinline__ void compress_pull(const CmpArgs& A, unsigned char* lds, unsigned* head, volatile LAS int* slot, int max_batches, int tid) {
    for (int nb = 0; nb < max_batches; ++nb) {
        __syncthreads();
        if (tid == 0) *slot = (int)__hip_atomic_fetch_add(head, 1u, __ATOMIC_RELAXED, __HIP_MEMORY_SCOPE_AGENT);
        __syncthreads();
        const int b = *slot;
        if (b >= 256) break;
        compress_batch(A, lds, b, true, tid);
    }
    __syncthreads();
}

struct Args { const GAS void* in[22]; GAS float* out; GAS unsigned char* ws; int ph_lo, ph_hi; };
constexpr int PH_PER_LAYER = 10, N_PHASES = 1 + NL * PH_PER_LAYER;
__global__ void __launch_bounds__(NWAVES * 64, 2) hymba_fwd(Args args) {
    extern __shared__ __attribute__((aligned(16))) unsigned char lds[];
    const int G = gridDim.x, bx = blockIdx.x, NGW = G * NWAVES;
    const int wave_s_ = __builtin_amdgcn_readfirstlane((int)threadIdx.x >> 6);
#define TID_NOW() (wave_s_ * 64 + (int)__builtin_amdgcn_mbcnt_hi(~0u, __builtin_amdgcn_mbcnt_lo(~0u, 0u)))
#define SUB_IDS int tid = TID_NOW(); asm volatile("" : "+v"(tid)); const int lane = tid & 63, wave = __builtin_amdgcn_readfirstlane(tid >> 6), gw = bx * NWAVES + wave; (void)lane; (void)gw; (void)wave;
#define PHASE_IDS int tid = TID_NOW(); asm volatile("" : "+v"(tid)); const int lane = tid & 63, wave = __builtin_amdgcn_readfirstlane(tid >> 6), gw = bx * NWAVES + wave; (void)lane; (void)gw; const __attribute__((address_space(4))) unsigned long long* ka_ = (const __attribute__((address_space(4))) unsigned long long*)__builtin_amdgcn_kernarg_segment_ptr(); asm volatile("" : "+s"(ka_)); GAS unsigned char* wsg_ = (GAS unsigned char*)ka_[23]; unsigned char* wsl = (unsigned char*)wsg_;
#define x_prompt ((const float*)(const GAS float*)ka_[0])
#define x_sample ((const float*)(const GAS float*)ka_[1])
#define cache_kv ((const float*)(const GAS float*)ka_[2])
#define page_table ((const int*)(const GAS int*)ka_[3])
#define state_win ((const float*)(const GAS float*)ka_[4])
#define state_gdn ((const float*)(const GAS float*)ka_[5])
#define state_conv ((const float*)(const GAS float*)ka_[6])
#define norm_mix ((const float*)(const GAS float*)ka_[7])
#define w_in ((const float*)(const GAS float*)ka_[8])
#define conv_w ((const float*)(const GAS float*)ka_[9])
#define a_log ((const float*)(const GAS float*)ka_[10])
#define dt_bias ((const float*)(const GAS float*)ka_[11])
#define gdn_norm ((const float*)(const GAS float*)ka_[12])
#define cmp_pe_k ((const float*)(const GAS float*)ka_[13])
#define cmp_w_k ((const float*)(const GAS float*)ka_[14])
#define cmp_pe_v ((const float*)(const GAS float*)ka_[15])
#define cmp_w_v ((const float*)(const GAS float*)ka_[16])
#define w_out ((const float*)(const GAS float*)ka_[17])
#define norm_mlp ((const float*)(const GAS float*)ka_[18])
#define w_up ((const float*)(const GAS float*)ka_[19])
#define w_down ((const float*)(const GAS float*)ka_[20])
#define norm_final ((const float*)(const GAS float*)ka_[21])
#define out ((float*)(GAS float*)ka_[22])
#define WIN_T ((bf16*)(wsl + WS_WIN))
#define WOUT_T ((bf16*)(wsl + WS_WOUT))
#define WUP_T ((bf16*)(wsl + WS_WUP))
#define WDN_T ((bf16*)(wsl + WS_WDN))
#define CMPW ((bf16*)(wsl + WS_CMPW))
#define HB ((bf16*)(wsl + WS_HB))
#define PROJ ((float*)(wsl + WS_PROJ))
#define X1 ((bf16*)(wsl + WS_X1))
#define X2 ((bf16*)(wsl + WS_X2))
#define MIX ((bf16*)(wsl + WS_MIX))
#define HID ((bf16*)(wsl + WS_HID))
#define QN ((float*)(wsl + WS_QN))
#define KN ((float*)(wsl + WS_KN))
#define VG ((float*)(wsl + WS_VG))
#define OG ((float*)(wsl + WS_OG))
#define GG ((float*)(wsl + WS_G))
#define BETA ((float*)(wsl + WS_BETA))
#define KQ ((float*)(wsl + WS_KQ))
#define QB ((bf16*)(wsl + WS_QB))
#define KS ((bf16*)(wsl + WS_KS))
#define VS ((bf16*)(wsl + WS_VS))
#define KW ((bf16*)(wsl + WS_KW))
#define VW ((bf16*)(wsl + WS_VW))
#define CKP ((float*)(wsl + WS_CKP))
#define CVP ((float*)(wsl + WS_CVP))
#define CKS ((float*)(wsl + WS_CKS))
#define CVS ((float*)(wsl + WS_CVS))
#define GK ((bf16*)(wsl + WS_GK))
#define GQ ((bf16*)(wsl + WS_GQ))
#define GKT ((bf16*)(wsl + WS_GKT))
#define GVT ((bf16*)(wsl + WS_GVT))
#define GG2 ((float*)(wsl + WS_GG2))
#define BETA2 ((float*)(wsl + WS_BETA2))
#define WX ((bf16*)(wsl + WS_WX))
#define QX ((bf16*)(wsl + WS_QX))
#define QKX ((bf16*)(wsl + WS_QKX))
#define KTX ((bf16*)(wsl + WS_KTX))
#define U0F ((float*)(wsl + WS_U0F))
#define GL ((float*)(wsl + WS_GL))
#define PARTD ((float*)(wsl + WS_PARTD))
#define PARTG ((float*)(wsl + WS_PARTG))
    LAS unsigned char* ldsl = (LAS unsigned char*)lds;

    const int lo = args.ph_lo, hi = args.ph_hi;
    { const int t0_ = TID_NOW(); if (t0_ < 16) ((LAS unsigned*)(ldsl + MISC_OFF))[t0_] = 0u; }
    __syncthreads();
    XcdBarrier bar = xcd_barrier_post((unsigned*)((unsigned char*)args.ws + WS_CTL) + CW_BAR, (volatile LAS unsigned*)(ldsl + MISC_OFF), TID_NOW() == 0);
#define BOTH(k) (lo <= (k) && (k) + 1 < hi)
#define GRID_BAR(k) do { if (BOTH(k)) { for (int rb_ = 0; rb_ < REP_BAR; ++rb_) xcd_barrier(bar, TID_NOW() == 0); } } while (0)
#ifndef REP_PG
#define REP_PG 1
#endif
#ifndef REP_PA
#define REP_PA 1
#endif
#ifndef REP_BAR
#define REP_BAR 1
#endif
#ifndef REP_GSMP
#define REP_GSMP 1
#endif
#ifndef REP_P0
#define REP_P0 1
#endif
#ifndef REP_LIGHT
#define REP_LIGHT 1
#endif
#ifndef REP_PB_ROW
#define REP_PB_ROW 1
#endif
#ifndef REP_PB_PREP
#define REP_PB_PREP 1
#endif
#ifndef REP_PB_CMP
#define REP_PB_CMP 1
#endif
#ifndef REP_PB_COPY
#define REP_PB_COPY 1
#endif
#ifndef REP_PB2
#define REP_PB2 1
#endif
#ifndef REP_SCAN
#define REP_SCAN 1
#endif
#ifndef REP_ATTP
#define REP_ATTP 1
#endif
#ifndef REP_ATTS
#define REP_ATTS 1
#endif
#ifndef REP_GEMM
#define REP_GEMM 1
#endif
#define EN(i) (((PH_MASK_T) >> (i)) & 1u)
#define SUB(i) (((SUB_MASK_T) >> (i)) & 1u)
#define IN(k) (lo <= (k) && (k) < hi)

    if (IN(0)) { PHASE_IDS
        for (int rep0 = 0; rep0 < REP_P0; ++rep0) {
        LAS float* scr = (LAS float*)(ldsl + wave * 16384);
        constexpr int I_IN = 16 * 112, I_OUT = 16 * 32, I_UP = 16 * 128, I_DN = 64 * 32, I_C = 32 * 2, I_L = I_IN + I_OUT + I_UP + I_DN + 2 * I_C;
        for (int it = gw; it < NL * I_L; it += NGW) {
            const int l = it / I_L; int r = it % I_L;
            if (r < I_IN) { transpose_item(w_in + (size_t)l * DM * NPROJ, DM, NPROJ, NP, WIN_T + (size_t)l * NP * DM, scr, r, lane); continue; } r -= I_IN;
            if (r < I_OUT) { transpose_item(w_out + (size_t)l * DM * DM, DM, DM, DM, WOUT_T + (size_t)l * DM * DM, scr, r, lane); continue; } r -= I_OUT;
            if (r < I_UP) { transpose_item(w_up + (size_t)l * DM * DFF, DM, DFF, DFF, WUP_T + (size_t)l * DFF * DM, scr, r, lane); continue; } r -= I_UP;
            if (r < I_DN) { transpose_item(w_down + (size_t)l * DFF * DM, DFF, DM, DM, WDN_T + (size_t)l * DM * DFF, scr, r, lane); continue; } r -= I_DN;
            if (r < I_C) { transpose_item(cmp_w_k + (size_t)l * 2048 * 64, 2048, 64, 64, CMPW + (size_t)((l * 2 + 0) * 64) * 2048, scr, r, lane); continue; } r -= I_C;
            transpose_item(cmp_w_v + (size_t)l * 2048 * 64, 2048, 64, 64, CMPW + (size_t)((l * 2 + 1) * 64) * 2048, scr, r, lane);
        }
        for (int m = gw; m < MT; m += NGW) { const float* xr = (m < MP) ? x_prompt + (size_t)m * DM : x_sample + (size_t)(m - MP) * DM; rms_row(xr, false, norm_mix, HB + (size_t)m * DM, nullptr, lane); }
        }
    }

    GRID_BAR(0);
    for (int l = 0; l < NL; ++l) {
        const int pb = 1 + l * PH_PER_LAYER;
        if (IN(pb + 0)) { PHASE_IDS
            pg8::Gemm g{HB, WIN_T + (size_t)l * NP * DM, MT, NP, DM, DM}; pg8::StaticOrder S; S.init(MT, NP, G, bx);
            pg8::EpiF32 E{PROJ, NP};
            _Pragma("unroll 1") for (int rep = 0; rep < REP_PA; ++rep) pg8::gemm_phase<pg8::EpiF32, pg8::StaticOrder, true, true>(ldsl, g, S, E, tid);
            if (l == 0 && bx >= (MT / 256) * (NP / 256) % G) { SUB_IDS CmpArgs CA{PROJ, cache_kv, page_table, cmp_pe_k, cmp_pe_v, CMPW, wsl, 0};
                compress_pull(CA, lds, (unsigned*)(wsl + WS_CTL) + CW_CMPQ, (volatile LAS int*)(ldsl + MISC_OFF + 36), 1, tid); }
        }
        GRID_BAR(pb + 0);
        if (IN(pb + 1)) { PHASE_IDS
            { SUB_IDS PBArgs A{PROJ, state_conv, conv_w, a_log, dt_bias, QN, KN, VG, GG, BETA, KQ, QB, KS, VS, KW, VW, out, l};
              for (int rep = 0; rep < REP_PB_ROW; ++rep) if (gw >= 128) for (int m = gw - 128; m < MT; m += 2 * (NGW - 128)) {
                  const int m2 = m + (NGW - 128); const bool has2 = m2 < MT; PBRegs r0, r1;
                  pb_row_load(A, m, lane, r0); pb_row_load(A, has2 ? m2 : m, lane, r1);
                  __builtin_amdgcn_sched_barrier(0);
                  pb_row(A, m, lane, r0); if (has2) pb_row(A, m2, lane, r1); }
              for (int u = gw; u < MS * 8; u += NGW) pb_sample_head(A, u, lane); }
            { SUB_IDS GPArgs A{PROJ, conv_w, a_log, dt_bias, GK, GQ, GKT, GVT, GG2, BETA2, l};
              for (int rep = 0; rep < REP_PB_PREP; ++rep) for (int u = gw; u < (MP / 8) * 8; u += 2 * NGW) {
                  GPRegs r0, r1; const int u2 = (u + NGW < (MP / 8) * 8) ? u + NGW : u; gdn_prep_load(A, u, lane, r0); gdn_prep_load(A, u2, lane, r1);
                  __builtin_amdgcn_sched_barrier(0);
                  gdn_prep_unit(A, u, lane, r0); gdn_prep_unit(A, u2, lane, r1); } }
            { SUB_IDS CmpArgs A{PROJ, cache_kv, page_table, cmp_pe_k, cmp_pe_v, CMPW, wsl, l};
              if (bx < 16) compress_batch(A, lds, bx, false, tid);
              compress_pull(A, lds, (unsigned*)(wsl + WS_CTL) + CW_CMPQ + 64 * l, (volatile LAS int*)(ldsl + MISC_OFF + 36), 1 << 20, tid); }
        }
        GRID_BAR(pb + 1);
        if (IN(pb + 2)) { PHASE_IDS
            GCArgs A{GK, GQ, GKT, GVT, GG2, BETA2, WX, QX, QKX, KTX, U0F, GL};
            for (int rep = 0; rep < REP_PB2; ++rep) for (int u = gw; u < 32 * 64; u += NGW) gdn_chunk_unit(A, lds + wave * GC_LDS_PER_WAVE, u, lane);
        }
        GRID_BAR(pb + 2);
        if (IN(pb + 3)) {
            { PHASE_IDS GdnArgs GA{QN, KN, VG, GG, BETA, KQ, OG, PROJ, state_gdn, gdn_norm, MIX, out, l};
                for (int rep = 0; rep < REP_GSMP; ++rep) for (int u = gw; u < NSB * 8; u += NGW) gdn_sample_unit(GA, u, lane); }
            { PHASE_IDS
                GS2Args SG{WX, QX, QKX, KTX, U0F, GL, OG, out, l};
                AttArgs AA{QB, KS, VS, KW, VW, CKP, CVP, PROJ, MIX};
                SAttArgs SA{QB, KS, VS, KW, VW, CKS, CVS, PROJ, cache_kv, page_table, state_win, MIX, l};
                unsigned* qhead = (unsigned*)(wsl + WS_CTL) + CW_QUEUE + 64 * l;
                volatile LAS int* slot = (volatile LAS int*)(ldsl + MISC_OFF + 32);
                for (;;) {
                    __syncthreads();
                    if (tid == 0) *slot = (int)__hip_atomic_fetch_add(qhead, 1u, __ATOMIC_RELAXED, __HIP_MEMORY_SCOPE_AGENT);
                    __syncthreads();
                    int u = *slot;
                    constexpr int XP = (REP_ATTP - 1) * 512, XS = (REP_ATTS - 1) * 256, XG = (REP_SCAN - 1) * 32;
                    if (u >= 800 + XP + XS + XG + 128) break;
                    if (u >= 800 + XP + XS + XG) {
                        const int sb = u - (800 + XP + XS + XG); const f32x4* src = (const f32x4*)(state_win + ((size_t)l * NSB + sb) * 512 * 256) + 256; f32x4* dst = (f32x4*)(out + O_WINS + ((size_t)l * NSB + sb) * 512 * 256);
                        for (int i = tid; i < 508 * 64; i += 8 * NWAVES * 64) { f32x4 v[8];
#pragma unroll
                            for (int k = 0; k < 8; ++k) { const int ii = i + k * NWAVES * 64; v[k] = src[ii < 508 * 64 ? ii : i]; }
#pragma unroll
                            for (int k = 0; k < 8; ++k) { const int ii = i + k * NWAVES * 64; if (ii < 508 * 64) dst[ii] = v[k]; } }
                        continue; }
                    if (u >= 800) { int v = u - 800; if (v < XP) u = 32 + (v & 511); else { v -= XP; if (v < XS) u = 544 + (v & 255); else u = (v - XS) & 31; } }
                    int tq = TID_NOW(); asm volatile("" : "+v"(tq));
                    if (u < 32) gdn_scan3_block(SG, lds, u, tq);
                    else if (u < 32 + 512) nsa_prompt_unit(AA, lds, u - 32, tq);
                    else nsa_sample_unit(SA, lds, u - 544, tq);
                }
            }
        }
        GRID_BAR(pb + 3);
        if (IN(pb + 4)) { PHASE_IDS
            const float gnl = gdn_norm[l * 64 + lane];
            for (int rep = 0; rep < REP_LIGHT; ++rep) for (int m = gw; m < MP; m += NGW) {
                float ov[8], zv[8];
#pragma unroll
                for (int h = 0; h < 8; ++h) { ov[h] = OG[(size_t)m * 512 + h * 64 + lane]; zv[h] = PROJ[(size_t)m * NP + C_Z + h * 64 + lane]; }
                __builtin_amdgcn_sched_barrier(0);
#pragma unroll
                for (int h = 0; h < 8; ++h) { const float ms = dpp_sum(ov[h] * ov[h]) * (1.f / 64.f);
                    MIX[(size_t)m * 1024 + h * 64 + lane] = (bf16)f2bf(ov[h] * (1.f / sqrtf(ms + 1e-6f)) * gnl * siluf_(zv[h])); } }
        }
        GRID_BAR(pb + 4);
        if (IN(pb + 5)) { PHASE_IDS
            { pg8::Gemm g{MIX, WOUT_T + (size_t)l * DM * DM, MP, DM, DM, DM}; pg8::StaticOrder S; S.init(MP, DM, G, bx);
              pg8::EpiResid E{(l == 0) ? (const void*)x_prompt : (const void*)X2, l != 0, X1, DM};
              pg8::gemm_phase<pg8::EpiResid, pg8::StaticOrder, true, true>(ldsl, g, S, E, tid); }
            { pg8::Gemm g{MIX, WOUT_T + (size_t)l * DM * DM, MT, DM, PD_KL, DM}; pg8::SplitKOrder S; S.init(MP / 256, MS / 256, DM / 256, PD_KS, PD_KL, G, bx);
              pg8::EpiPart E{PARTD, DM, MP, MS};
              pg8::gemm_phase<pg8::EpiPart, pg8::SplitKOrder, false, true>(ldsl, g, S, E, tid); }
        }
        GRID_BAR(pb + 5);
        if (IN(pb + 6)) { PHASE_IDS
            for (int m = gw; m < MP; m += 2 * NGW) { const int m2 = m + NGW;
                if (m2 < MP) rms_row2(X1 + (size_t)m * DM, X1 + (size_t)m2 * DM, true, norm_mlp + (size_t)l * DM, HB + (size_t)m * DM, HB + (size_t)m2 * DM, nullptr, nullptr, lane);
                else rms_row(X1 + (size_t)m * DM, true, norm_mlp + (size_t)l * DM, HB + (size_t)m * DM, nullptr, lane); }
            for (int m = MP + gw; m < MT; m += NGW) { const void* bs = (l == 0) ? (const void*)(x_sample + (size_t)(m - MP) * DM) : (const void*)(X2 + (size_t)m * DM);
                rms_row_parts(bs, l != 0, PARTD + (size_t)(m - MP) * DM, PD_KS, (size_t)MS * DM, X1 + (size_t)m * DM, norm_mlp + (size_t)l * DM, HB + (size_t)m * DM, nullptr, lane); } }
        GRID_BAR(pb + 6);
        if (IN(pb + 7)) { PHASE_IDS
            pg8::Gemm g{HB, WUP_T + (size_t)l * DFF * DM, MT, DFF, DM, DM}; pg8::StaticOrder S; S.init(MT, DFF, G, bx);
            pg8::EpiRelu2 E{HID, DFF};
            pg8::gemm_phase<pg8::EpiRelu2, pg8::StaticOrder, true, true>(ldsl, g, S, E, tid);
            if (l + 1 < NL && bx >= (MT / 256) * (DFF / 256) % G) { SUB_IDS CmpArgs CA{PROJ, cache_kv, page_table, cmp_pe_k, cmp_pe_v, CMPW, wsl, l + 1};
                compress_pull(CA, lds, (unsigned*)(wsl + WS_CTL) + CW_CMPQ + 64 * (l + 1), (volatile LAS int*)(ldsl + MISC_OFF + 36), 1, tid); }
        }
        GRID_BAR(pb + 7);
        if (IN(pb + 8)) { PHASE_IDS
            { pg8::Gemm g{HID, WDN_T + (size_t)l * DM * DFF, MP, DM, DFF, DFF}; pg8::StaticOrder S; S.init(MP, DM, G, bx);
              pg8::EpiResid E{(const void*)X1, true, X2, DM};
              pg8::gemm_phase<pg8::EpiResid, pg8::StaticOrder, true, true>(ldsl, g, S, E, tid); }
            { pg8::Gemm g{HID, WDN_T + (size_t)l * DM * DFF, MT, DM, PG_KL, DFF}; pg8::SplitKOrder S; S.init(MP / 256, MS / 256, DM / 256, PG_KS, PG_KL, G, bx);
              pg8::EpiPart E{PARTG, DM, MP, MS};
              pg8::gemm_phase<pg8::EpiPart, pg8::SplitKOrder, false, true>(ldsl, g, S, E, tid); }
        }
        GRID_BAR(pb + 8);
        if (IN(pb + 9)) { PHASE_IDS
            const float* gn = (l + 1 < NL) ? norm_mix + (size_t)(l + 1) * DM : norm_final; const bool fin = !(l + 1 < NL);
            for (int m = gw; m < MP; m += 2 * NGW) { const int m2 = m + NGW;
                if (m2 < MP) rms_row2(X2 + (size_t)m * DM, X2 + (size_t)m2 * DM, true, gn, fin ? nullptr : HB + (size_t)m * DM, fin ? nullptr : HB + (size_t)m2 * DM, fin ? out + O_YP + (size_t)m * DM : nullptr, fin ? out + O_YP + (size_t)m2 * DM : nullptr, lane);
                else rms_row(X2 + (size_t)m * DM, true, gn, fin ? nullptr : HB + (size_t)m * DM, fin ? out + O_YP + (size_t)m * DM : nullptr, lane); }
            for (int m = MP + gw; m < MT; m += NGW)
                rms_row_parts(X1 + (size_t)m * DM, true, PARTG + (size_t)(m - MP) * DM, PG_KS, (size_t)MS * DM, X2 + (size_t)m * DM, gn, fin ? nullptr : HB + (size_t)m * DM, fin ? out + O_YP + (size_t)m * DM : nullptr, lane);
        }
        GRID_BAR(pb + 9);
    }
#undef IN
}

#undef x_prompt
#undef x_sample
#undef cache_kv
#undef page_table
#undef state_win
#undef state_gdn
#undef state_conv
#undef norm_mix
#undef w_in
#undef conv_w
#undef a_log
#undef dt_bias
#undef gdn_norm
#undef cmp_pe_k
#undef cmp_w_k
#undef cmp_pe_v
#undef cmp_w_v
#undef w_out
#undef norm_mlp
#undef w_up
#undef w_down
#undef norm_final
#undef out
#ifndef MK_PER_PHASE
#define MK_PER_PHASE 0
#endif
typedef void (*kfn_t)(Args); static const kfn_t K_ALL = hymba_fwd;
extern "C" void kernel_launch(void* const* d_in, const int* in_sizes, int n_in, void* d_out, int out_size, void* d_ws, size_t ws_size, hipStream_t stream) {
    static int grid = 0;
    if (grid == 0) {
        if (n_in != 22 || out_size != (int)O_END || ws_size < WS_END) { fprintf(stderr, "kernel_launch: unexpected shapes (n_in %d, out %d, ws %zu)\n", n_in, out_size, ws_size); grid = -1; return; }
        int dev = 0, cus = 0, per_cu = 0;
        if (hipGetDevice(&dev) != hipSuccess || hipDeviceGetAttribute(&cus, hipDeviceAttributeMultiprocessorCount, dev) != hipSuccess) { grid = -1; return; }
        if (hipFuncSetAttribute((const void*)K_ALL, hipFuncAttributeMaxDynamicSharedMemorySize, LDS_BYTES) != hipSuccess) { fprintf(stderr, "kernel_launch: hipFuncSetAttribute failed\n"); grid = -1; return; }
        if (hipOccupancyMaxActiveBlocksPerMultiprocessor(&per_cu, (const void*)K_ALL, NWAVES * 64, LDS_BYTES) != hipSuccess || per_cu < 1) { fprintf(stderr, "kernel_launch: occupancy query says %d blocks per CU\n", per_cu); }
        (void)hipGetLastError();
        grid = cus;
    }
    if (grid < 0) return;
    (void)hipMemsetAsync((char*)d_ws + WS_CTL, 0, CTL_ZERO_BYTES, stream);
    Args a{};
    for (int i = 0; i < 22; ++i) a.in[i] = (const GAS void*)d_in[i];
    a.out = (GAS float*)d_out; a.ws = (GAS unsigned char*)d_ws;
    const dim3 g(grid), b(NWAVES * 64);
#if MK_PER_PHASE
    for (int ph = 0; ph < N_PHASES; ++ph) { a.ph_lo = ph; a.ph_hi = ph + 1; K_ALL<<<g, b, LDS_BYTES, stream>>>(a); }
#else
    a.ph_lo = 0; a.ph_hi = N_PHASES; K_ALL<<<g, b, LDS_BYTES, stream>>>(a);
#endif
}
```

```cpp
#include <hip/hip_runtime.h>
#include <cstdio>
#include <cstdint>
namespace pg8 {
#define PG8_LAS __attribute__((address_space(3)))
typedef unsigned short bf16_t;
typedef short bf16x8 __attribute__((ext_vector_type(8)));
typedef float f32x4 __attribute__((ext_vector_type(4)));
typedef unsigned u32x4 __attribute__((ext_vector_type(4)));
constexpr int BM = 256, BK = 64, HALF = 128, HTB = HALF * BK * 2  , STAGE_BYTES = 8 * HTB, NXCD = 8, WGM = 8;

__host__ __device__ __forceinline__ int lds_byte(int r, int c) { const int st = (r >> 4) * 2 + (c >> 5), rr = r & 15, cc = c & 31, ob = rr * 64 + cc * 2; return st * 1024 + (ob ^ (((ob >> 9) & 1) << 5)); }
__host__ __device__ __forceinline__ void stage_rc(int b, int& R, int& C) { const int st = b / 1024, sb = b % 1024, swz = sb ^ (((sb >> 9) & 1) << 5); R = (st >> 1) * 16 + swz / 64; C = (st & 1) * 32 + (swz % 64) / 2; }
__host__ __device__ __forceinline__ int perm32(int rho) { const int n = rho >> 4, i = rho & 15; return 8 * (i >> 2) + 4 * n + (i & 3); }

struct Unit { int pm, pn, kofs, kc; };
struct Gemm { const bf16_t* A; const bf16_t* Bt; int M, N, K, ld; };

struct StaticOrder {
    int nM, nN, nwg, G, c;
    __host__ __device__ void init(int M, int N, int G_, int c_) { nM = M / BM; nN = N / BM; nwg = nM * nN; G = G_; c = c_; }
    __host__ __device__ bool next(int i, Unit& u) const {
        const long L = (long)i * G + c; if (L >= nwg) return false;
        int wgid = (int)L; { const int q = nwg / NXCD, r = nwg % NXCD, xcd = wgid % NXCD, off = wgid / NXCD; wgid = (xcd < r ? xcd * (q + 1) : r * (q + 1) + (xcd - r) * q) + off; }
        const int nig = WGM * nN, gid = wgid / nig, fm = gid * WGM, gsz = (nM - fm) < WGM ? (nM - fm) : WGM;
        u.pm = fm + ((wgid % nig) % gsz); u.pn = (wgid % nig) / gsz; u.kofs = 0; u.kc = 0; return true;
    }
    __device__ __forceinline__ void a_ready(const Unit&) const {}
    __device__ __forceinline__ void done(const Unit&) const {}
};

__device__ __forceinline__ unsigned cvt_pk_bf16(float lo, float hi) { unsigned r; asm volatile("v_cvt_pk_bf16_f32 %0, %1, %2" : "=v"(r) : "v"(lo), "v"(hi)); return r; }

struct EpiF32 {
    static constexpr bool PERM = false, AFTER_DRAIN = false;
    float* O; int ldc;
    __device__ __forceinline__ void operator()(const f32x4 (&acc)[2][2][4][2], const Unit& u, int wr, int wc, int fr, int fq) const {
        const int row0 = u.pm * BM + wr * 64 + fr, col0 = u.pn * BM + wc * 32 + 4 * fq;
#pragma unroll
        for (int ai = 0; ai < 2; ++ai)
#pragma unroll
            for (int m = 0; m < 4; ++m) { float* rowp = O + (size_t)(row0 + ai * HALF + m * 16) * ldc + col0;
#pragma unroll
                for (int bj = 0; bj < 2; ++bj)
#pragma unroll
                    for (int n = 0; n < 2; ++n) *(f32x4*)(rowp + bj * HALF + n * 16) = acc[ai][bj][m][n]; }
    }
};
struct EpiResid {
    static constexpr bool PERM = false, AFTER_DRAIN = false;
    const void* base; bool base_bf; bf16_t* O; int ldc;
    __device__ __forceinline__ void operator()(const f32x4 (&acc)[2][2][4][2], const Unit& u, int wr, int wc, int fr, int fq) const {
        const int row0 = u.pm * BM + wr * 64 + fr, col0 = u.pn * BM + wc * 32 + 4 * fq;
        typedef unsigned u32x2_ __attribute__((ext_vector_type(2)));
#pragma unroll
        for (int ai = 0; ai < 2; ++ai)
#pragma unroll
            for (int m = 0; m < 4; ++m) { const size_t off = (size_t)(row0 + ai * HALF + m * 16) * ldc + col0;
#pragma unroll
                for (int bj = 0; bj < 2; ++bj)
#pragma unroll
                    for (int n = 0; n < 2; ++n) { const size_t o2 = off + bj * HALF + n * 16; f32x4 r;
                        if (base_bf) { const u32x2_ w = *(const u32x2_*)((const bf16_t*)base + o2);
                            r = (f32x4){__builtin_bit_cast(float, w.x << 16), __builtin_bit_cast(float, w.x & 0xffff0000u), __builtin_bit_cast(float, w.y << 16), __builtin_bit_cast(float, w.y & 0xffff0000u)}; }
                        else r = *(const f32x4*)((const float*)base + o2);
                        r += acc[ai][bj][m][n];
                        u32x2_ ow; ow.x = cvt_pk_bf16(r[0], r[1]); ow.y = cvt_pk_bf16(r[2], r[3]); *(u32x2_*)(O + o2) = ow; } }
    }
};
struct EpiRelu2 {
    static constexpr bool PERM = true, AFTER_DRAIN = false;
    bf16_t* O; int ldc;
    __device__ __forceinline__ void operator()(const f32x4 (&acc)[2][2][4][2], const Unit& u, int wr, int wc, int fr, int fq) const {
        const int row0 = u.pm * BM + wr * 64 + fr, col0 = u.pn * BM + wc * 32 + 8 * fq;
#pragma unroll
        for (int ai = 0; ai < 2; ++ai)
#pragma unroll
            for (int m = 0; m < 4; ++m) { bf16_t* rowp = O + (size_t)(row0 + ai * HALF + m * 16) * ldc + col0;
#pragma unroll
                for (int bj = 0; bj < 2; ++bj) { f32x4 v0 = acc[ai][bj][m][0], v1 = acc[ai][bj][m][1];
#pragma unroll
                    for (int i = 0; i < 4; ++i) { const float a = v0[i] > 0.f ? v0[i] : 0.f, b = v1[i] > 0.f ? v1[i] : 0.f; v0[i] = a * a; v1[i] = b * b; }
                    u32x4 w; w.x = cvt_pk_bf16(v0[0], v0[1]); w.y = cvt_pk_bf16(v0[2], v0[3]); w.z = cvt_pk_bf16(v1[0], v1[1]); w.w = cvt_pk_bf16(v1[2], v1[3]);
                    *(u32x4*)(rowp + bj * HALF) = w; } }
    }
};

struct SplitKOrder {
    int pm0, nN, KS, KL, total, G, c;
    __host__ __device__ void init(int pm0_, int nPm, int nN_, int KS_, int KL_, int G_, int c_) { pm0 = pm0_; nN = nN_; KS = KS_; KL = KL_; total = nPm * nN_ * KS_; G = G_; c = c_; }
    __host__ __device__ bool next(int i, Unit& u) const {
        const long L = (long)i * G + c; if (L >= total) return false;
        const int l = (int)L, kc = l % KS, rest = l / KS; u.pn = rest % nN; u.pm = pm0 + rest / nN; u.kofs = kc * KL; u.kc = kc; return true; }
    __device__ __forceinline__ void a_ready(const Unit&) const {}
    __device__ __forceinline__ void done(const Unit&) const {}
};
struct EpiPart {
    static constexpr bool PERM = false, AFTER_DRAIN = false;
    float* P; int ldc; int row0; int rows;
    __device__ __forceinline__ void operator()(const f32x4 (&acc)[2][2][4][2], const Unit& u, int wr, int wc, int fr, int fq) const {
        const int rowl = u.pm * BM - row0 + wr * 64 + fr, col0 = u.pn * BM + wc * 32 + 4 * fq;
        float* base = P + (size_t)u.kc * rows * ldc;
#pragma unroll
        for (int ai = 0; ai < 2; ++ai)
#pragma unroll
            for (int m = 0; m < 4; ++m) { float* rowp = base + (size_t)(rowl + ai * HALF + m * 16) * ldc + col0;
#pragma unroll
                for (int bj = 0; bj < 2; ++bj)
#pragma unroll
                    for (int n = 0; n < 2; ++n) *(f32x4*)(rowp + bj * HALF + n * 16) = acc[ai][bj][m][n]; }
    }
};
template <class Epi, class Sched, bool ALIGN_EPI = false, bool SP2 = false>
__device__ __forceinline__ void gemm_phase(PG8_LAS unsigned char* lds, const Gemm g, const Sched& S, const Epi& E, int tid_in) {
    int tid = tid_in; asm volatile("" : "+v"(tid));
    const int wid = __builtin_amdgcn_readfirstlane(tid >> 6), lane = tid & 63, wr = wid >> 2, wc = wid & 3, fr = lane & 15, fq = lane >> 4;
    const int K = g.ld, nt = g.K / BK;
    unsigned voffA[2], voffB[2];
#pragma unroll
    for (int i = 0; i < 2; ++i) { int R, C; stage_rc(tid * 16 + i * 8192, R, C); const int Rb = Epi::PERM ? ((R & ~31) + perm32(R & 31)) : R;
        voffA[i] = (unsigned)(R * K + C) * 2u; voffB[i] = (unsigned)(Rb * K + C) * 2u; }
    const size_t kstep = (size_t)(BK * 2);
    const size_t hstep = (size_t)HALF * K * 2;
    const size_t tstep = 2 * hstep;
    const unsigned ldsw = (unsigned)wid * 1024u;
    const int aoff = lds_byte(wr * 64 + fr, fq * 8), boff = lds_byte(wc * 32 + fr, fq * 8);
#define PG8_SA(b, h) (((b) * 2 + (h)) * HTB)
#define PG8_SB(b, h) ((4 + (b) * 2 + (h)) * HTB)
#define PG8_STAGE(bufoff, gbase, voff) do { _Pragma("unroll") for (int _i = 0; _i < 2; ++_i) \
        __builtin_amdgcn_global_load_lds((const unsigned*)((const char*)(gbase) + (voff)[_i]), (PG8_LAS unsigned*)(lds + (bufoff) + ldsw + _i * 8192), 16, 0, 0); } while (0)
#define PG8_LDA(dst, b, h) do { _Pragma("unroll") for (int m = 0; m < 4; ++m) _Pragma("unroll") for (int k = 0; k < 2; ++k) dst[m][k] = *(const PG8_LAS bf16x8*)(lds + PG8_SA(b, h) + aoff + m * 2048 + k * 1024); } while (0)
#define PG8_LDB(dst, b, h) do { _Pragma("unroll") for (int n = 0; n < 2; ++n) _Pragma("unroll") for (int k = 0; k < 2; ++k) dst[n][k] = *(const PG8_LAS bf16x8*)(lds + PG8_SB(b, h) + boff + n * 2048 + k * 1024); } while (0)
#define PG8_MMA(ai, bj, At, Bt) do { __builtin_amdgcn_s_setprio(1); _Pragma("unroll") for (int m = 0; m < 4; ++m) _Pragma("unroll") for (int n = 0; n < 2; ++n) _Pragma("unroll") for (int k = 0; k < 2; ++k) \
        acc[ai][bj][m][n] = __builtin_amdgcn_mfma_f32_16x16x32_bf16(Bt[n][k], At[m][k], acc[ai][bj][m][n], 0, 0, 0); __builtin_amdgcn_s_setprio(0); } while (0)
#define PG8_WAIT_V(n) asm volatile("s_waitcnt vmcnt(" #n ")" ::: "memory")
#define PG8_WAIT_L(n) asm volatile("s_waitcnt lgkmcnt(" #n ")" ::: "memory")
#define PG8_BAR __builtin_amdgcn_s_barrier()
#define PG8_SCHED __builtin_amdgcn_sched_barrier(0)
    Unit cur, nxt; int ui = 0;
    if (!S.next(0, cur)) return;
    f32x4 acc[2][2][4][2];
#pragma unroll
    for (int a = 0; a < 2; ++a)
#pragma unroll
        for (int b = 0; b < 2; ++b)
#pragma unroll
            for (int m = 0; m < 4; ++m)
#pragma unroll
                for (int n = 0; n < 2; ++n) acc[a][b][m][n] = (f32x4){0.f, 0.f, 0.f, 0.f};
    bf16x8 At[4][2], B0[2][2], B1[2][2];
    const char* cA = (const char*)g.A + (size_t)cur.pm * tstep + (size_t)cur.kofs * 2; const char* cB = (const char*)g.Bt + (size_t)cur.pn * tstep + (size_t)cur.kofs * 2;
    S.a_ready(cur);
    if constexpr (SP2) {
        PG8_STAGE(PG8_SB(0, 0), cB, voffB); PG8_STAGE(PG8_SB(0, 1), cB + hstep, voffB); PG8_STAGE(PG8_SA(0, 0), cA, voffA); PG8_STAGE(PG8_SA(0, 1), cA + hstep, voffA);
        if (wr == 1) PG8_BAR;
        PG8_WAIT_V(2); PG8_BAR;
        PG8_STAGE(PG8_SB(1, 0), cB + kstep, voffB); PG8_STAGE(PG8_SA(1, 0), cA + kstep, voffA); PG8_STAGE(PG8_SB(1, 1), cB + hstep + kstep, voffB);
        PG8_WAIT_V(6); PG8_BAR;
    } else {
        PG8_STAGE(PG8_SB(0, 0), cB, voffB); PG8_STAGE(PG8_SA(0, 0), cA, voffA); PG8_STAGE(PG8_SB(0, 1), cB + hstep, voffB); PG8_STAGE(PG8_SA(0, 1), cA + hstep, voffA);
        if (wr == 1) PG8_BAR;
        PG8_WAIT_V(4); PG8_BAR;
        PG8_STAGE(PG8_SB(1, 0), cB + kstep, voffB); PG8_STAGE(PG8_SA(1, 0), cA + kstep, voffA); PG8_STAGE(PG8_SB(1, 1), cB + hstep + kstep, voffB);
        PG8_WAIT_V(6); PG8_BAR;
    }
    for (;;) {
        const bool has_next = S.next(ui + 1, nxt);
        const char* nA = has_next ? (const char*)g.A + (size_t)nxt.pm * tstep + (size_t)nxt.kofs * 2 : cA; const char* nB = has_next ? (const char*)g.Bt + (size_t)nxt.pn * tstep + (size_t)nxt.kofs * 2 : cB;
        for (int t = 0; t < nt; t += 2) {
            const bool last = (t == nt - 2);
            const char* a1 = cA + (size_t)(t + 1) * kstep;
            const char* a2 = last ? nA : cA + (size_t)(t + 2) * kstep; const char* b2 = last ? nB : cB + (size_t)(t + 2) * kstep;
            const char* a3 = a2 + kstep; const char* b3 = b2 + kstep;
            if (last && has_next) S.a_ready(nxt);
            if constexpr (SP2) {
            PG8_LDB(B0, 0, 0); PG8_LDB(B1, 0, 1); PG8_SCHED; PG8_LDA(At, 0, 0); PG8_STAGE(PG8_SA(1, 1), a1 + hstep, voffA);
            PG8_WAIT_V(8); PG8_WAIT_L(0); PG8_BAR; PG8_MMA(0, 0, At, B0); PG8_MMA(0, 1, At, B1); PG8_BAR; PG8_SCHED;
            PG8_LDA(At, 0, 1); PG8_STAGE(PG8_SB(0, 0), b2, voffB); PG8_STAGE(PG8_SB(0, 1), b2 + hstep, voffB); PG8_STAGE(PG8_SA(0, 0), a2, voffA);
            PG8_WAIT_V(8); PG8_WAIT_L(0); PG8_BAR; PG8_MMA(1, 0, At, B0); PG8_MMA(1, 1, At, B1); PG8_BAR; PG8_SCHED;
            PG8_LDB(B0, 1, 0); PG8_LDB(B1, 1, 1); PG8_SCHED; PG8_LDA(At, 1, 0); PG8_STAGE(PG8_SA(0, 1), a2 + hstep, voffA);
            PG8_WAIT_V(8); PG8_WAIT_L(0); PG8_BAR; PG8_MMA(0, 0, At, B0); PG8_MMA(0, 1, At, B1); PG8_BAR; PG8_SCHED;
            PG8_LDA(At, 1, 1); PG8_STAGE(PG8_SB(1, 0), b3, voffB); PG8_STAGE(PG8_SB(1, 1), b3 + hstep, voffB); PG8_STAGE(PG8_SA(1, 0), a3, voffA);
            PG8_WAIT_V(8); PG8_WAIT_L(0); PG8_BAR; PG8_MMA(1, 0, At, B0); PG8_MMA(1, 1, At, B1); PG8_BAR; PG8_SCHED;
            } else {
            PG8_LDB(B0, 0, 0); PG8_SCHED; PG8_LDA(At, 0, 0); PG8_STAGE(PG8_SA(1, 1), a1 + hstep, voffA);
            PG8_WAIT_L(8); PG8_BAR; PG8_WAIT_L(0); PG8_MMA(0, 0, At, B0); PG8_BAR; PG8_SCHED;
            PG8_LDB(B1, 0, 1); PG8_STAGE(PG8_SB(0, 0), b2, voffB);
            PG8_BAR; PG8_WAIT_L(0); PG8_MMA(0, 1, At, B1); PG8_BAR;
            PG8_LDA(At, 0, 1); PG8_STAGE(PG8_SA(0, 0), a2, voffA);
            PG8_BAR; PG8_WAIT_L(0); PG8_MMA(1, 0, At, B0); PG8_BAR; PG8_SCHED;
            PG8_STAGE(PG8_SB(0, 1), b2 + hstep, voffB);
            PG8_WAIT_V(6); PG8_BAR; PG8_MMA(1, 1, At, B1); PG8_BAR;
            PG8_LDB(B0, 1, 0); PG8_SCHED; PG8_LDA(At, 1, 0); PG8_STAGE(PG8_SA(0, 1), a2 + hstep, voffA);
            PG8_WAIT_L(8); PG8_BAR; PG8_WAIT_L(0); PG8_MMA(0, 0, At, B0); PG8_BAR; PG8_SCHED;
            PG8_LDB(B1, 1, 1); PG8_STAGE(PG8_SB(1, 0), b3, voffB);
            PG8_BAR; PG8_WAIT_L(0); PG8_MMA(0, 1, At, B1); PG8_BAR;
            PG8_LDA(At, 1, 1); PG8_STAGE(PG8_SA(1, 0), a3, voffA);
            PG8_BAR; PG8_WAIT_L(0); PG8_MMA(1, 0, At, B0); PG8_BAR; PG8_SCHED;
            PG8_STAGE(PG8_SB(1, 1), b3 + hstep, voffB);
            PG8_WAIT_V(6); PG8_BAR; PG8_MMA(1, 1, At, B1); PG8_BAR;
            }
        }
        if constexpr (ALIGN_EPI) { if (wr == 0) PG8_BAR; }
        if constexpr (!Epi::AFTER_DRAIN) { E(acc, cur, wr, wc, fr, fq); S.done(cur); }
        if (!has_next) break;
#pragma unroll
        for (int a = 0; a < 2; ++a)
#pragma unroll
            for (int b = 0; b < 2; ++b)
#pragma unroll
                for (int m = 0; m < 4; ++m)
#pragma unroll
                    for (int n = 0; n < 2; ++n) acc[a][b][m][n] = (f32x4){0.f, 0.f, 0.f, 0.f};
        cur = nxt; cA = nA; cB = nB; ++ui;
        if constexpr (ALIGN_EPI) { if (wr == 1) PG8_BAR; }
    }
    PG8_WAIT_V(0);
    if constexpr (!ALIGN_EPI) { if (wr == 0) PG8_BAR; }
    PG8_BAR;
    if constexpr (Epi::AFTER_DRAIN) { E.fused(acc, cur, wr, wc, fr, fq, lds, wid, lane); S.done(cur); }
#undef PG8_SA
#undef PG8_SB
#undef PG8_STAGE
#undef PG8_LDA
#undef PG8_LDB
#undef PG8_MMA
#undef PG8_WAIT_V
#undef PG8_WAIT_L
#undef PG8_BAR
#undef PG8_SCHED
}
}

constexpr int DM = 1024, NPB = 4, SEQ = 4096, MP = NPB * SEQ, NSB = 128, DSEQ = 4, MS = NSB * DSEQ, MT = MP + MS;
constexpr int NPROJ = 3368, NP = 3584, DFF = 4096, NL = 2;
constexpr int C_QKV = 0, C_Z = 1536, C_A = 2048, C_BETA = 2056, C_Q = 2064, C_KV = 2576, C_GATE = 3344;
constexpr int PAST = 2048, NPAGES = 16, NPOOL = 2560;
constexpr float C2 = 0.125f * 1.4426950408889634f;
constexpr float NEG_INF = -__builtin_inff();
constexpr size_t O_YP = 0, O_YS = 16777216, O_KVP = 17301504, O_KVS = 34078720, O_WINP = 34603008, O_WINS = 35651584, O_GDNP = 69206016, O_GDNS = 69468160, O_CONVP = 77856768, O_CONVS = 77893632, O_END = 79073280;
constexpr size_t MiB = 1u << 20;
constexpr size_t WS_CTL = 0, CTL_ZERO_BYTES = 1 * MiB;
constexpr size_t WS_WIN = 2 * MiB, WS_WOUT = 16 * MiB, WS_WUP = 20 * MiB, WS_WDN = 36 * MiB, WS_CMPW = 52 * MiB;
constexpr size_t WS_HB = 54 * MiB, WS_PROJ = 88 * MiB, WS_X1 = 320 * MiB, WS_X2 = 386 * MiB, WS_MIX = 452 * MiB, WS_HID = 486 * MiB;
constexpr size_t WS_QN = 618 * MiB, WS_KN = 651 * MiB, WS_VG = 684 * MiB, WS_OG = 717 * MiB, WS_G = 750 * MiB, WS_BETA = 751 * MiB, WS_KQ = 752 * MiB;
constexpr size_t WS_QB = 753 * MiB, WS_KS = 770 * MiB, WS_VS = 775 * MiB, WS_KW = 780 * MiB, WS_VW = 785 * MiB;
constexpr size_t WS_CKP = 790 * MiB, WS_CVP = 791 * MiB, WS_CKS = 792 * MiB, WS_CVS = 796 * MiB;
constexpr size_t WS_GK = 800 * MiB, WS_GQ = 816 * MiB, WS_GKT = 832 * MiB, WS_GVT = 848 * MiB, WS_GG2 = 864 * MiB, WS_BETA2 = 865 * MiB;
constexpr size_t WS_WX = 866 * MiB, WS_QX = 882 * MiB, WS_QKX = 898 * MiB, WS_KTX = 914 * MiB, WS_U0F = 930 * MiB, WS_GL = 962 * MiB, WS_END = 1043 * MiB;
constexpr size_t WS_PARTD = 963 * MiB, WS_PARTG = 979 * MiB;
constexpr int PD_KS = 4, PD_KL = DM / PD_KS, PG_KS = 8, PG_KL = DFF / PG_KS;
constexpr int CW_QUEUE = 64;
constexpr int CW_BAR = 4096;
constexpr int RING_BYTES = 131072, LDS_BYTES = 147456, MISC_OFF = LDS_BYTES - 64;
constexpr int NWAVES = 8;

#define GAS __attribute__((address_space(1)))
#define LAS __attribute__((address_space(3)))
typedef unsigned short bf16;
typedef unsigned v4u __attribute__((ext_vector_type(4)));
typedef unsigned v2u __attribute__((ext_vector_type(2)));
typedef float f32x4 __attribute__((ext_vector_type(4)));
typedef float f32x16 __attribute__((ext_vector_type(16)));
typedef short bf16x8 __attribute__((ext_vector_type(8)));
typedef short s16x4 __attribute__((ext_vector_type(4)));
#define LDS_WAIT() asm volatile("s_waitcnt lgkmcnt(0)" ::: "memory")
__device__ __forceinline__ unsigned f2bf(float f) { unsigned u = __builtin_bit_cast(unsigned, f); return (u + 0x7fffu + ((u >> 16) & 1u)) >> 16; }
typedef float f32x2_t_ __attribute__((ext_vector_type(2))); typedef __bf16 bf16x2_t_ __attribute__((ext_vector_type(2)));
__device__ __forceinline__ unsigned pk2(float lo, float hi) { const f32x2_t_ v = {lo, hi}; const bf16x2_t_ b = __builtin_convertvector(v, bf16x2_t_); return __builtin_bit_cast(unsigned, b); }
__device__ __forceinline__ float bf2f(unsigned short b) { return __builtin_bit_cast(float, (unsigned)b << 16); }
__device__ __forceinline__ bf16x8 pack8(float a0, float a1, float a2, float a3, float a4, float a5, float a6, float a7) {
    v4u w; w.x = pk2(a0, a1); w.y = pk2(a2, a3); w.z = pk2(a4, a5); w.w = pk2(a6, a7); return __builtin_bit_cast(bf16x8, w); }
__device__ __forceinline__ float wave_sum(float v) {
#pragma unroll
    for (int o = 1; o < 64; o <<= 1) v += __shfl_xor(v, o);
    return v;
}
template <int CTRL, int RMASK> __device__ __forceinline__ float dpp_add(float v) {
    const int t = __builtin_amdgcn_update_dpp(0, __builtin_bit_cast(int, v), CTRL, RMASK, 0xf, false);
    return v + __builtin_bit_cast(float, t);
}
__device__ __forceinline__ float dpp_sum(float v) {
    v = dpp_add<0x111, 0xf>(v); v = dpp_add<0x112, 0xf>(v); v = dpp_add<0x114, 0xf>(v); v = dpp_add<0x118, 0xf>(v);
    v = dpp_add<0x142, 0xa>(v); v = dpp_add<0x143, 0xc>(v);
    return __builtin_bit_cast(float, __builtin_amdgcn_readlane(__builtin_bit_cast(int, v), 63));
}
__device__ __forceinline__ float ex2(float x) { return __builtin_amdgcn_exp2f(x); }
__device__ __forceinline__ float sigmoidf_(float x) { return 1.f / (1.f + __expf(-x)); }
__device__ __forceinline__ float siluf_(float x) { return x / (1.f + __expf(-x)); }
__device__ __forceinline__ int crow(int r, int hi) { return (r & 3) + 8 * (r >> 2) + 4 * hi; }
__device__ __forceinline__ void rope_cs(int pos, int d, float& cs, float& sn) {
    const float invf = exp2f(-(float)d * 0.4152410118609203f);
    double rv = (double)pos * (double)invf * 0.15915494309189535; rv -= floor(rv);
    const float rf = (float)rv; sn = __builtin_amdgcn_sinf(rf); cs = __builtin_amdgcn_cosf(rf);
}

#define XB_TMO      128
#define XB_XCNT(j)  (256  + 64 * (j))
#define XB_XSUB(j)  (1280 + 64 * (j))
#define XB_XGEN(j)  (2304 + 64 * (j))
#define XB_TOP      3328
#define XB_TOPGEN   3392
#define XCD_BAR_WORDS 3456
#define XB_SPIN_CAP (1u << 18)

__device__ __forceinline__ unsigned xb_ld(unsigned* p)              { return __hip_atomic_load(p, __ATOMIC_RELAXED, __HIP_MEMORY_SCOPE_AGENT); }
__device__ __forceinline__ unsigned xb_add(unsigned* p, unsigned v) { return __hip_atomic_fetch_add(p, v, __ATOMIC_RELAXED, __HIP_MEMORY_SCOPE_AGENT); }
__device__ __forceinline__ unsigned xb_xcc_id() { return (unsigned)__builtin_amdgcn_s_getreg((3 << 11) | 20) & 0xFu; }
#define XB_SPIN(cond, bar) do { unsigned _sp = 0; while (cond) { __builtin_amdgcn_s_sleep(1); \
    if ((++_sp & 255u) == 0u) { if (xb_ld(&(bar)[XB_TMO])) break; if (_sp > XB_SPIN_CAP) { atomicAdd(&(bar)[XB_TMO], 1u); break; } } } } while (0)

struct XcdBarrier {
    unsigned* bar; unsigned x;
    volatile LAS unsigned* st;
};

__device__ __forceinline__ XcdBarrier xcd_barrier_post(unsigned* bar, volatile LAS unsigned* st, bool leader) {
    XcdBarrier b; b.bar = bar; b.x = xb_xcc_id(); b.st = st;
    if (leader) (void)xb_add(&bar[XB_XCNT(b.x)], 1u);
    return b;
}
__device__ __forceinline__ void xcd_barrier_complete(unsigned* bar, unsigned x, unsigned& nloc, unsigned& nx) {
    const unsigned G = gridDim.x * gridDim.y * gridDim.z;
    unsigned sum, cnt, mine, sp = 0u;
    for (;;) {
        sum = 0u; cnt = 0u; mine = 0u;
#pragma unroll
        for (unsigned j = 0; j < 16; ++j) { const unsigned c = xb_ld(&bar[XB_XCNT(j)]); sum += c; cnt += (c > 0u) ? 1u : 0u; mine = (j == x) ? c : mine; }
        if (sum == G) break;
        __builtin_amdgcn_s_sleep(1);
        if ((++sp & 255u) == 0u) { if (xb_ld(&bar[XB_TMO])) break; if (sp > XB_SPIN_CAP) { atomicAdd(&bar[XB_TMO], 1u); break; } }
    }
    nloc = mine > 0u ? mine : 1u; nx = cnt > 0u ? cnt : 1u;
}

__device__ __forceinline__ void xcd_barrier(const XcdBarrier& b, bool leader) {
    asm volatile("s_waitcnt vmcnt(0)" ::: "memory");
    __syncthreads();
    if (leader) {
        unsigned* bar = b.bar;
        __builtin_amdgcn_s_waitcnt(0);
        unsigned nloc = b.st[0], nx = b.st[1];
        if (nloc == 0u) { xcd_barrier_complete(bar, b.x, nloc, nx); b.st[0] = nloc; b.st[1] = nx; }
        const unsigned old = xb_add(&bar[XB_XSUB(b.x)], 1u);
        const unsigned gen = old / nloc;
        if (old + 1u == (gen + 1u) * nloc) {
            __builtin_amdgcn_fence(__ATOMIC_RELEASE, "agent");
            asm volatile("s_waitcnt vmcnt(0)" ::: "memory");
            const unsigned og = xb_add(&bar[XB_TOP], 1u);
            const unsigned tg = og / nx;
            if (og + 1u == (tg + 1u) * nx) xb_add(&bar[XB_TOPGEN], 1u);
            else XB_SPIN(xb_ld(&bar[XB_TOPGEN]) == tg, bar);
            __builtin_amdgcn_fence(__ATOMIC_ACQUIRE, "agent");
            xb_add(&bar[XB_XGEN(b.x)], 1u);
            asm volatile("s_waitcnt vmcnt(0)" ::: "memory");
        } else {
            XB_SPIN(xb_ld(&bar[XB_XGEN(b.x)]) == gen, bar);
            __builtin_amdgcn_fence(__ATOMIC_ACQUIRE, "agent");
            asm volatile("s_waitcnt vmcnt(0)" ::: "memory");
        }
    }
    __syncthreads();
}

__device__ __forceinline__ void transpose_item(const float* W, int K, int N, int Npad, bf16* WT, LAS float* scr, int item, int lane) {
    const int nblk = Npad / 32, kb = item / nblk, nb = item % nblk, k0 = 64 * kb, n0 = 32 * nb;
    const int ncol = n0 + (lane & 31);
    float wv_[32];
#pragma unroll
    for (int i = 0; i < 32; ++i) { const int kk = 2 * i + (lane >> 5); wv_[i] = (ncol < N) ? W[(size_t)(k0 + kk) * N + ncol] : 0.f; }
    __builtin_amdgcn_sched_barrier(0);
#pragma unroll
    for (int i = 0; i < 32; ++i) { const int kk = 2 * i + (lane >> 5); scr[kk * 33 + (lane & 31)] = wv_[i]; }
    LDS_WAIT(); asm volatile("" ::: "memory");
    const int c = lane & 7;
#pragma unroll
    for (int j = 0; j < 4; ++j) { const int n = (lane >> 3) + 8 * j; const LAS float* s = scr + (8 * c) * 33 + n;
        v4u o; o.x = pk2(s[0 * 33], s[1 * 33]); o.y = pk2(s[2 * 33], s[3 * 33]); o.z = pk2(s[4 * 33], s[5 * 33]); o.w = pk2(s[6 * 33], s[7 * 33]);
        *(v4u*)(WT + (size_t)(n0 + n) * K + k0 + 8 * c) = o; }
    LDS_WAIT(); asm volatile("" ::: "memory");
}
__device__ __forceinline__ f32x4 ld4x(const void* row, int i, bool bf) {
    if (bf) { const v2u w = ((const v2u*)row)[i]; return (f32x4){bf2f((unsigned short)(w.x & 0xffffu)), bf2f((unsigned short)(w.x >> 16)), bf2f((unsigned short)(w.y & 0xffffu)), bf2f((unsigned short)(w.y >> 16))}; }
    return ((const f32x4*)row)[i]; }
__device__ __forceinline__ void rms_row(const void* xrow, bool bf, const float* g, bf16* orow, float* of32, int lane) {
    f32x4 v[4]; float s = 0.f;
#pragma unroll
    for (int j = 0; j < 4; ++j) { v[j] = ld4x(xrow, 64 * j + lane, bf); s += (v[j].x * v[j].x + v[j].y * v[j].y) + (v[j].z * v[j].z + v[j].w * v[j].w); }
    const float rstd = 1.f / sqrtf(wave_sum(s) * (1.f / DM) + 1e-6f);
#pragma unroll
    for (int j = 0; j < 4; ++j) { const f32x4 gg = ((const f32x4*)g)[64 * j + lane]; const f32x4 o = v[j] * rstd * gg;
        if (of32) ((f32x4*)of32)[64 * j + lane] = o;
        else ((v2u*)orow)[64 * j + lane] = (v2u){pk2(o.x, o.y), pk2(o.z, o.w)}; }
}

__device__ __forceinline__ void rms_row2(const void* xa, const void* xb, bool bf, const float* g, bf16* oa, bf16* ob, float* fa, float* fb, int lane) {
    f32x4 va[4], vb[4];
#pragma unroll
    for (int j = 0; j < 4; ++j) { va[j] = ld4x(xa, 64 * j + lane, bf); vb[j] = ld4x(xb, 64 * j + lane, bf); }
    __builtin_amdgcn_sched_barrier(0);
    float sa = 0.f, sb = 0.f;
#pragma unroll
    for (int j = 0; j < 4; ++j) { sa += (va[j].x * va[j].x + va[j].y * va[j].y) + (va[j].z * va[j].z + va[j].w * va[j].w); sb += (vb[j].x * vb[j].x + vb[j].y * vb[j].y) + (vb[j].z * vb[j].z + vb[j].w * vb[j].w); }
    const float ra = 1.f / sqrtf(wave_sum(sa) * (1.f / DM) + 1e-6f), rb = 1.f / sqrtf(wave_sum(sb) * (1.f / DM) + 1e-6f);
#pragma unroll
    for (int j = 0; j < 4; ++j) { const f32x4 gg = ((const f32x4*)g)[64 * j + lane]; const f32x4 o1 = va[j] * ra * gg, o2 = vb[j] * rb * gg;
        if (fa) { ((f32x4*)fa)[64 * j + lane] = o1; ((f32x4*)fb)[64 * j + lane] = o2; }
        else { ((v2u*)oa)[64 * j + lane] = (v2u){pk2(o1.x, o1.y), pk2(o1.z, o1.w)}; ((v2u*)ob)[64 * j + lane] = (v2u){pk2(o2.x, o2.y), pk2(o2.z, o2.w)}; } }
}
__device__ __forceinline__ void rms_row_parts(const void* base, bool bf, const float* parts, int nparts, size_t part_stride, bf16* xout, const float* g, bf16* orow, float* of32, int lane) {
    f32x4 v[4]; float s = 0.f;
#pragma unroll
    for (int j = 0; j < 4; ++j) v[j] = ld4x(base, 64 * j + lane, bf);
    for (int p = 0; p < nparts; ++p) { const f32x4* pr = (const f32x4*)(parts + (size_t)p * part_stride) + lane;
#pragma unroll
        for (int j = 0; j < 4; ++j) v[j] += pr[64 * j]; }
#pragma unroll
    for (int j = 0; j < 4; ++j) { if (xout) ((v2u*)xout)[64 * j + lane] = (v2u){pk2(v[j].x, v[j].y), pk2(v[j].z, v[j].w)}; s += (v[j].x * v[j].x + v[j].y * v[j].y) + (v[j].z * v[j].z + v[j].w * v[j].w); }
    const float rstd = 1.f / sqrtf(wave_sum(s) * (1.f / DM) + 1e-6f);
#pragma unroll
    for (int j = 0; j < 4; ++j) { const f32x4 gg = ((const f32x4*)g)[64 * j + lane]; const f32x4 o = v[j] * rstd * gg;
        if (of32) ((f32x4*)of32)[64 * j + lane] = o;
        else ((v2u*)orow)[64 * j + lane] = (v2u){pk2(o.x, o.y), pk2(o.z, o.w)}; }
}

struct PBArgs { const float* PROJ; const float* state_conv; const float* conv_w; const float* a_log; const float* dt_bias;
    float* QN; float* KN; float* VG; float* G; float* BETA; float* KQ; bf16* QB; bf16* KS; bf16* VS; bf16* KW; bf16* VW; float* out; int l; };
struct PBRegs { float qs_[8], qo_[8], kvs_[12], kvo_[12]; };
__device__ __forceinline__ void pb_row_load(const PBArgs& A, int m, int lane, PBRegs& R) {
    const float* pr = A.PROJ + (size_t)m * NP;
#pragma unroll
    for (int h = 0; h < 8; ++h) { R.qs_[h] = pr[C_Q + h * 64 + lane]; R.qo_[h] = pr[C_Q + h * 64 + (lane ^ 32)]; }
#pragma unroll
    for (int i = 0; i < 12; ++i) { R.kvs_[i] = pr[C_KV + i * 64 + lane]; R.kvo_[i] = pr[C_KV + i * 64 + (lane ^ 32)]; }
}
__device__ __forceinline__ void pb_row(const PBArgs& A, int m, int lane, const PBRegs& R) {
    const bool is_s = m >= MP; int b, t;
    if (!is_s) { b = m >> 12; t = m & 4095; } else { b = (m - MP) >> 2; t = (m - MP) & 3; }
    const int pos = is_s ? PAST + t : t, l = A.l;
    const float* pr = A.PROJ + (size_t)m * NP;
    const float* cw = A.conv_w + (size_t)l * 4 * 1536;
    const float* cb = A.state_conv + ((size_t)l * NSB + b) * 3 * 1536;
    if (!is_s && t >= SEQ - 3) { float* o = A.out + O_CONVP + ((size_t)(l * NPB + b) * 3 + (t - (SEQ - 3))) * 1536;
#pragma unroll 4
        for (int j = 0; j < 24; ++j) o[64 * j + lane] = pr[64 * j + lane]; }
    if (is_s && t >= 1) { float* o = A.out + O_CONVS + ((size_t)(l * NSB + b) * 3 + (t - 1)) * 1536;
#pragma unroll 4
        for (int j = 0; j < 24; ++j) o[64 * j + lane] = pr[64 * j + lane]; }
    const int half = lane >> 5; float cs, sn; rope_cs(pos, lane & 31, cs, sn);
    const float (&qs_)[8] = R.qs_; const float (&qo_)[8] = R.qo_; const float (&kvs_)[12] = R.kvs_; const float (&kvo_)[12] = R.kvo_;
#pragma unroll
    for (int h = 0; h < 8; ++h) { const float xs = qs_[h], xo = qo_[h];
        const float r = half ? (xs * cs + xo * sn) : (xs * cs - xo * sn);
        A.QB[(size_t)m * 512 + h * 64 + lane] = (bf16)f2bf(r * C2); }
#pragma unroll
    for (int s6 = 0; s6 < 6; ++s6)
#pragma unroll
        for (int kvh = 0; kvh < 2; ++kvh) {
            float v = kvs_[s6 * 2 + kvh];
            if (s6 == 2 || s6 == 4) { const float xo = kvo_[s6 * 2 + kvh]; v = half ? (v * cs + xo * sn) : (v * cs - xo * sn); }
            if (s6 < 4) {
                if (!is_s) A.out[O_KVP + ((((size_t)(l * NPB + b) * 2 + kvh) * SEQ + t) * 4 + s6) * 64 + lane] = v;
                else       A.out[O_KVS + ((((size_t)(l * NSB + b) * 2 + kvh) * DSEQ + t) * 4 + s6) * 64 + lane] = v;
            } else {
                const int idx = s6 - 4;
                if (!is_s) { if (t >= SEQ - 512) A.out[O_WINP + ((((size_t)(l * NPB + b) * 512 + (t - (SEQ - 512))) * 2 + idx) * 2 + kvh) * 64 + lane] = v; }
                else A.out[O_WINS + ((((size_t)(l * NSB + b) * 512 + (508 + t)) * 2 + idx) * 2 + kvh) * 64 + lane] = v;
            }
            const bf16 bv = (bf16)f2bf(v);
            if (s6 == 2) A.KS[(size_t)m * 128 + kvh * 64 + lane] = bv;
            if (s6 == 3) A.VS[(size_t)m * 128 + kvh * 64 + lane] = bv;
            if (s6 == 4) A.KW[(size_t)m * 128 + kvh * 64 + lane] = bv;
            if (s6 == 5) A.VW[(size_t)m * 128 + kvh * 64 + lane] = bv;
        }
}

__device__ __forceinline__ void pb_sample_head(const PBArgs& A, int u, int lane) {
    const int m = MP + (u >> 3), h = u & 7, b = (m - MP) >> 2, t = (m - MP) & 3, l = A.l;
    const float* pr = A.PROJ + (size_t)m * NP;
    const float* cw = A.conv_w + (size_t)l * 4 * 1536;
    const float* cb = A.state_conv + ((size_t)l * NSB + b) * 3 * 1536;
    float xv[3][4], wv[3][4];
#pragma unroll
    for (int part = 0; part < 3; ++part) { const int c = (part * 8 + h) * 64 + lane;
#pragma unroll
        for (int tap = 0; tap < 4; ++tap) { const int idx = t + tap;
            xv[part][tap] = (idx >= 3) ? A.PROJ[(size_t)(m - t + idx - 3) * NP + c] : cb[idx * 1536 + c];
            wv[part][tap] = cw[tap * 1536 + c]; } }
    __builtin_amdgcn_sched_barrier(0);
    float qkv[3];
#pragma unroll
    for (int part = 0; part < 3; ++part) qkv[part] = siluf_((xv[part][0] * wv[part][0] + xv[part][1] * wv[part][1]) + (xv[part][2] * wv[part][2] + xv[part][3] * wv[part][3]));
    const float q = qkv[0], k = qkv[1];
    const float qs = dpp_sum(q * q), ks = dpp_sum(k * k);
    const float qn = q * (1.f / sqrtf(qs + 1e-6f)) * 0.125f, kn = k * (1.f / sqrtf(ks + 1e-6f));
    const float kq = dpp_sum(qn * kn);
    A.QN[(size_t)m * 512 + h * 64 + lane] = qn; A.KN[(size_t)m * 512 + h * 64 + lane] = kn; A.VG[(size_t)m * 512 + h * 64 + lane] = qkv[2];
    if (lane == 0) A.KQ[(size_t)m * 8 + h] = kq;
    if (h == 0 && lane < 8) {
        const float a = pr[C_A + lane] + A.dt_bias[l * 8 + lane];
        const float sp = fmaxf(a, 0.f) + log1pf(__expf(-fabsf(a)));
        A.G[(size_t)m * 8 + lane] = -__expf(A.a_log[l * 8 + lane]) * sp;
        A.BETA[(size_t)m * 8 + lane] = sigmoidf_(pr[C_BETA + lane]); }
}

struct CmpArgs { const float* PROJ; const float* cache; const int* page_table; const float* pe_k; const float* pe_v; const bf16* CMPW; unsigned char* ws; int l; };
__device__ __forceinline__ void compress_batch(const CmpArgs& A, unsigned char* lds, int batch, bool is_s, int tid) {
    const int lane = tid & 63, wave = __builtin_amdgcn_readfirstlane(tid >> 6), fr = lane & 15, fq = lane >> 4, l = A.l;
    const int kv = batch & 1, ru = (batch >> 1) * 8 + wave;
    const int rho = 16 * ru + fr, NC = is_s ? 64 : 128;
    const int seq = rho / (2 * NC), n = (rho >> 1) % NC, kvh = rho & 1;
    const float* abase; size_t astride;
    if (!is_s) { abase = A.PROJ + (size_t)(seq * SEQ + 32 * n) * NP + C_KV + kv * 128 + kvh * 64; astride = NP; }
    else { const int page = A.page_table[seq * NPAGES + (n >> 2)];
        abase = A.cache + ((((size_t)l * NPOOL + page) * 2 + kvh) * 128 + (n & 3) * 32) * 256 + kv * 64; astride = 256; }
    const float* pe = (kv ? A.pe_v : A.pe_k) + (size_t)l * 2048;
    const bf16* Wt = A.CMPW + (size_t)((l * 2 + kv) * 64) * 2048;
    const int we = tid >> 3, wch = tid & 7;
    f32x4 acc[4];
#pragma unroll
    for (int et = 0; et < 4; ++et) acc[et] = (f32x4){0.f, 0.f, 0.f, 0.f};
    f32x4 sa[2][4], sp[2][4]; v4u wreg;
#define CB_LOADA(S, c) do { _Pragma("unroll") for (int ks = 0; ks < 2; ++ks) { const float* ap = abase + (size_t)(c) * astride + 32 * ks + 8 * fq; const float* pp = pe + (c) * 64 + 32 * ks + 8 * fq; \
        sa[S][2 * ks] = *(const f32x4*)ap; sa[S][2 * ks + 1] = *(const f32x4*)(ap + 4); sp[S][2 * ks] = *(const f32x4*)pp; sp[S][2 * ks + 1] = *(const f32x4*)(pp + 4); } } while (0)
#define CB_LOADW(c) do { wreg = *(const v4u*)(Wt + (size_t)we * 2048 + ((c) < 31 ? (c) : 31) * 64 + wch * 8); } while (0)
#define CB_STOREW(bufi) do { *(v4u*)(lds + (bufi) * 9216 + we * 144 + wch * 16) = wreg; } while (0)
#define CB_MMA(S, bufi) do { _Pragma("unroll") for (int ks = 0; ks < 2; ++ks) { const f32x4 a0 = sa[S][2 * ks] + sp[S][2 * ks], a1 = sa[S][2 * ks + 1] + sp[S][2 * ks + 1]; \
        const bf16x8 ya = pack8(a0.x, a0.y, a0.z, a0.w, a1.x, a1.y, a1.z, a1.w); \
        _Pragma("unroll") for (int et = 0; et < 4; ++et) { const bf16x8 wf_ = *(const bf16x8*)(lds + (bufi) * 9216 + (16 * et + fr) * 144 + (32 * ks + 8 * fq) * 2); \
            acc[et] = __builtin_amdgcn_mfma_f32_16x16x32_bf16(wf_, ya, acc[et], 0, 0, 0); } } } while (0)
    __syncthreads();
    CB_LOADW(0); CB_LOADA(0, 0);
    CB_STOREW(0); CB_LOADW(1);
    __syncthreads();
#pragma unroll 1
    for (int c = 0; c < 32; c += 2) {
        CB_STOREW(1); __builtin_amdgcn_sched_barrier(0); CB_LOADW(c + 2); CB_LOADA(1, c + 1); __builtin_amdgcn_sched_barrier(0);
        CB_MMA(0, 0); __builtin_amdgcn_sched_barrier(0);
        __syncthreads();
        CB_STOREW(0); __builtin_amdgcn_sched_barrier(0); CB_LOADW(c + 3); if (c + 2 < 32) { CB_LOADA(0, c + 2); } __builtin_amdgcn_sched_barrier(0);
        CB_MMA(1, 1); __builtin_amdgcn_sched_barrier(0);
        __syncthreads();
    }
#undef CB_LOADA
#undef CB_LOADW
#undef CB_STOREW
#undef CB_MMA
    if (kv == 0) { const int pos = 32 * n + 31;
#pragma unroll
        for (int et = 0; et < 2; ++et)
#pragma unroll
            for (int i = 0; i < 4; ++i) { float cs, sn; rope_cs(pos, 16 * et + 4 * fq + i, cs, sn);
                const float x1 = acc[et][i], x2 = acc[et + 2][i]; acc[et][i] = x1 * cs - x2 * sn; acc[et + 2][i] = x2 * cs + x1 * sn; } }
    float* ob = (float*)(A.ws + (is_s ? WS_CKS : WS_CKP) + (size_t)kv * (is_s ? (WS_CVS - WS_CKS) : (WS_CVP - WS_CKP))) + (size_t)rho * 64 + 4 * fq;
#pragma unroll
    for (int et = 0; et < 4; ++et) *(f32x4*)(ob + 16 * et) = acc[et];
}

struct GdnArgs { const float* QN; const float* KN; const float* VG; const float* G; const float* BETA; const float* KQ; float* OG; const float* PROJ; const float* state_gdn; const float* gdn_norm; bf16* MIX; float* out; int l; };
__device__ __forceinline__ void gdn_sample_unit(const GdnArgs& A, int unit, int lane) {
    const int sb = unit >> 3, h = unit & 7, l = A.l;
    const float* sp = A.state_gdn + (((size_t)l * NSB + sb) * 8 + h) * 4096;
    float S[64];
#pragma unroll
    for (int d = 0; d < 64; ++d) S[d] = sp[d * 64 + lane];
    const float gn = A.gdn_norm[l * 64 + lane];
    for (int i = 0; i < DSEQ; ++i) {
        const size_t m = (size_t)MP + sb * 4 + i;
        const float kd = A.KN[m * 512 + h * 64 + lane], qd = A.QN[m * 512 + h * 64 + lane], v = A.VG[m * 512 + h * 64 + lane];
        const float g = A.G[m * 8 + h], beta = A.BETA[m * 8 + h], kq = A.KQ[m * 8 + h];
        const int kdb = __builtin_bit_cast(int, kd), qdb = __builtin_bit_cast(int, qd);
        const float a = __expf(g); float r1 = 0.f, r2 = 0.f;
#pragma unroll
        for (int d = 0; d < 64; ++d) { const float kk = __builtin_bit_cast(float, __builtin_amdgcn_readlane(kdb, d)), qq = __builtin_bit_cast(float, __builtin_amdgcn_readlane(qdb, d)); r1 += S[d] * kk; r2 += S[d] * qq; }
        const float u = beta * (v - a * r1), o = a * r2 + u * kq;
#pragma unroll
        for (int d = 0; d < 64; ++d) { const float kk = __builtin_bit_cast(float, __builtin_amdgcn_readlane(kdb, d)); S[d] = a * S[d] + kk * u; }
        const float ms = wave_sum(o * o) * (1.f / 64.f);
        const float z = A.PROJ[m * NP + C_Z + h * 64 + lane];
        A.MIX[m * 1024 + h * 64 + lane] = (bf16)f2bf(o * (1.f / sqrtf(ms + 1e-6f)) * gn * siluf_(z));
    }
    float* so = A.out + O_GDNS + (((size_t)l * NSB + sb) * 8 + h) * 4096;
#pragma unroll
    for (int d = 0; d < 64; ++d) so[d * 64 + lane] = S[d];
}


__device__ __forceinline__ int perm_inv32(int p) { return (p & 32) + 16 * ((p >> 2) & 1) + 4 * ((p >> 3) & 3) + (p & 3); }
struct GPArgs { const float* PROJ; const float* conv_w; const float* a_log; const float* dt_bias; bf16* GK; bf16* GQ; bf16* GKT; bf16* GVT; float* GG2; float* BETA2; int l; };
struct GPRegs { float xx[3][11], ww[3][4]; };
__device__ __forceinline__ void gdn_prep_load(const GPArgs& A, int unit, int lane, GPRegs& R) {
    const int tg = unit >> 3, h = unit & 7, m0 = tg * 8, t0 = m0 & 4095;
    const float* cw = A.conv_w + (size_t)A.l * 4 * 1536;
#pragma unroll
    for (int part = 0; part < 3; ++part) { const int c = (part * 8 + h) * 64 + lane;
#pragma unroll
        for (int j = 0; j < 11; ++j) R.xx[part][j] = (t0 - 3 + j >= 0) ? A.PROJ[(size_t)(m0 - 3 + j) * NP + c] : 0.f;
#pragma unroll
        for (int k = 0; k < 4; ++k) R.ww[part][k] = cw[k * 1536 + c]; }
}
__device__ __forceinline__ void gdn_prep_unit(const GPArgs& A, int unit, int lane, const GPRegs& R) {
    const int tg = unit >> 3, h = unit & 7, m0 = tg * 8, b = m0 >> 12, t0 = m0 & 4095, l = A.l, bh = b * 8 + h;
    const float* cw = A.conv_w + (size_t)l * 4 * 1536;
    float val[3][8]; const float (&xx)[3][11] = R.xx; const float (&ww)[3][4] = R.ww;
#pragma unroll
    for (int part = 0; part < 3; ++part)
#pragma unroll
        for (int i = 0; i < 8; ++i) val[part][i] = siluf_(ww[part][0] * xx[part][i] + ww[part][1] * xx[part][i + 1] + ww[part][2] * xx[part][i + 2] + ww[part][3] * xx[part][i + 3]);
#pragma unroll
    for (int i = 0; i < 8; ++i) { const float q = val[0][i], k = val[1][i];
        const float qs = dpp_sum(q * q), ks = dpp_sum(k * k);
        val[0][i] = q * (1.f / sqrtf(qs + 1e-6f)) * 0.125f; val[1][i] = k * (1.f / sqrtf(ks + 1e-6f)); }
#pragma unroll
    for (int i = 0; i < 8; ++i) { A.GQ[((size_t)bh * 4096 + t0 + i) * 64 + lane] = (bf16)f2bf(val[0][i]); A.GK[((size_t)bh * 4096 + t0 + i) * 64 + lane] = (bf16)f2bf(val[1][i]); }
    *(v4u*)(A.GKT + ((size_t)bh * 64 + lane) * 4096 + t0) = (v4u){pk2(val[1][0], val[1][1]), pk2(val[1][2], val[1][3]), pk2(val[1][4], val[1][5]), pk2(val[1][6], val[1][7])};
    *(v4u*)(A.GVT + ((size_t)bh * 64 + lane) * 4096 + t0) = (v4u){pk2(val[2][0], val[2][1]), pk2(val[2][2], val[2][3]), pk2(val[2][4], val[2][5]), pk2(val[2][6], val[2][7])};
    if (lane < 8) { const float* pr = A.PROJ + (size_t)(m0 + lane) * NP;
        const float a = pr[C_A + h] + A.dt_bias[l * 8 + h];
        const float sp = fmaxf(a, 0.f) + log1pf(__expf(-fabsf(a)));
        A.GG2[(size_t)bh * 4096 + t0 + lane] = -__expf(A.a_log[l * 8 + h]) * sp;
        A.BETA2[(size_t)bh * 4096 + t0 + lane] = sigmoidf_(pr[C_BETA + h]); }
}
template <int I> __device__ __forceinline__ void fsub_row(float (&T)[64], const float* AL, int lane) {
    float tv = (lane == I) ? 1.f : 0.f;
#pragma unroll
    for (int j4 = 0; j4 < (I + 3) / 4; ++j4) { const f32x4 a = *(const f32x4*)(AL + I * 64 + 4 * j4);
#pragma unroll
        for (int e = 0; e < 4; ++e) if (4 * j4 + e < I) tv -= a[e] * T[4 * j4 + e]; }
    T[I] = tv;
}
template <int I> struct FSub { static __device__ __forceinline__ void run(float (&T)[64], const float* AL, int lane) { FSub<I - 1>::run(T, AL, lane); fsub_row<I>(T, AL, lane); } };
template <> struct FSub<-1> { static __device__ __forceinline__ void run(float (&)[64], const float*, int) {} };
struct GCArgs { const bf16* GK; const bf16* GQ; const bf16* GKT; const bf16* GVT; const float* GG2; const float* BETA2; bf16* WX; bf16* QX; bf16* QKX; bf16* KTX; float* U0F; float* GL; };
constexpr int GC_LDS_PER_WAVE = 17664;
__device__ __forceinline__ void gdn_chunk_unit(const GCArgs& A, unsigned char* wl, int unit, int lane_) {
    int lane = lane_; asm volatile("" : "+v"(lane));
    const int bh = unit >> 6, n = unit & 63, t0 = 64 * n, fr = lane & 15, fq = lane >> 4;
    float* AL = (float*)wl; float* SC = (float*)(wl + 16384);
    {   const float g = A.GG2[(size_t)bh * 4096 + t0 + lane], beta = A.BETA2[(size_t)bh * 4096 + t0 + lane];
        float gc = g;
        gc = dpp_add<0x111, 0xf>(gc); gc = dpp_add<0x112, 0xf>(gc); gc = dpp_add<0x114, 0xf>(gc); gc = dpp_add<0x118, 0xf>(gc); gc = dpp_add<0x142, 0xa>(gc); gc = dpp_add<0x143, 0xc>(gc);
        const float glast = __builtin_bit_cast(float, __builtin_amdgcn_readlane(__builtin_bit_cast(int, gc), 63));
        const float eg = __expf(gc);
        SC[lane] = gc; SC[64 + lane] = beta; SC[128 + lane] = beta * eg; SC[192 + lane] = eg; SC[256 + lane] = __expf(glast - gc);
        if (lane == 0) A.GL[unit] = __expf(glast); }
    LDS_WAIT(); asm volatile("" ::: "memory");
    {
        bf16x8 kf[4][2];
#pragma unroll
        for (int t4 = 0; t4 < 4; ++t4)
#pragma unroll
            for (int ks = 0; ks < 2; ++ks) kf[t4][ks] = *(const bf16x8*)(A.GK + ((size_t)bh * 4096 + t0 + 16 * t4 + fr) * 64 + 32 * ks + 8 * fq);
        __builtin_amdgcn_sched_barrier(0);
#pragma unroll
        for (int ti = 0; ti < 4; ++ti) { const f32x4 gi = *(const f32x4*)(SC + 16 * ti + 4 * fq), bi = *(const f32x4*)(SC + 64 + 16 * ti + 4 * fq);
#pragma unroll
            for (int tj = 0; tj < 4; ++tj) if (tj <= ti) { f32x4 acc = {0.f, 0.f, 0.f, 0.f};
                acc = __builtin_amdgcn_mfma_f32_16x16x32_bf16(kf[ti][0], kf[tj][0], acc, 0, 0, 0); acc = __builtin_amdgcn_mfma_f32_16x16x32_bf16(kf[ti][1], kf[tj][1], acc, 0, 0, 0);
                const float gj = SC[16 * tj + fr];
#pragma unroll
                for (int i = 0; i < 4; ++i) AL[(16 * ti + 4 * fq + i) * 64 + 16 * tj + fr] = bi[i] * acc[i] * __expf(fminf(gi[i] - gj, 0.f)); } }
    }
    LDS_WAIT(); asm volatile("" ::: "memory");
    {
        float T[64];
        FSub<63>::run(T, AL, lane);
        LDS_WAIT(); asm volatile("" ::: "memory");
        unsigned short* TB = (unsigned short*)wl;
#pragma unroll
        for (int i = 0; i < 64; ++i) TB[i * 72 + lane] = (unsigned short)f2bf(T[i]);
    }
    LDS_WAIT(); asm volatile("" ::: "memory");
    {
        bf16x8 tf[4][2];
#pragma unroll
        for (int ti = 0; ti < 4; ++ti)
#pragma unroll
            for (int ks = 0; ks < 2; ++ks) tf[ti][ks] = *(const bf16x8*)(wl + ((16 * ti + fr) * 72 + 32 * ks + 8 * fq) * 2);
#pragma unroll
        for (int which = 0; which < 2; ++which) { const bf16* src = which ? A.GVT : A.GKT; const float* sc = SC + (which ? 64 : 128);
            bf16x8 raws[4][2];
#pragma unroll
            for (int tn = 0; tn < 4; ++tn)
#pragma unroll
                for (int ks = 0; ks < 2; ++ks) raws[tn][ks] = *(const bf16x8*)(src + ((size_t)bh * 64 + 16 * tn + fr) * 4096 + t0 + 32 * ks + 8 * fq);
            __builtin_amdgcn_sched_barrier(0);
#pragma unroll
            for (int tn = 0; tn < 4; ++tn) { bf16x8 yb[2];
#pragma unroll
                for (int ks = 0; ks < 2; ++ks) { const bf16x8 raw = raws[tn][ks];
                    const f32x4 s0 = *(const f32x4*)(sc + 32 * ks + 8 * fq), s1 = *(const f32x4*)(sc + 32 * ks + 8 * fq + 4);
                    yb[ks] = pack8(bf2f((unsigned short)raw[0]) * s0.x, bf2f((unsigned short)raw[1]) * s0.y, bf2f((unsigned short)raw[2]) * s0.z, bf2f((unsigned short)raw[3]) * s0.w,
                                   bf2f((unsigned short)raw[4]) * s1.x, bf2f((unsigned short)raw[5]) * s1.y, bf2f((unsigned short)raw[6]) * s1.z, bf2f((unsigned short)raw[7]) * s1.w); }
#pragma unroll
                for (int ti = 0; ti < 4; ++ti) { f32x4 acc = {0.f, 0.f, 0.f, 0.f};
                    acc = __builtin_amdgcn_mfma_f32_16x16x32_bf16(tf[ti][0], yb[0], acc, 0, 0, 0);
                    if (ti >= 2) acc = __builtin_amdgcn_mfma_f32_16x16x32_bf16(tf[ti][1], yb[1], acc, 0, 0, 0);
                    if (which == 0) { const int p = 32 * (tn >> 1) + 8 * (fr >> 2) + 4 * (tn & 1) + (fr & 3);
#pragma unroll
                        for (int i = 0; i < 4; ++i) A.WX[((size_t)unit * 64 + 16 * ti + 4 * fq + i) * 64 + p] = (bf16)f2bf(acc[i]); }
                    else *(f32x4*)(A.U0F + (((size_t)unit * 16 + ti * 4 + tn) * 64 + lane) * 4) = acc; } } }
    }
    {
        bf16x8 kf[4][2], qf[4][2];
#pragma unroll
        for (int t4 = 0; t4 < 4; ++t4)
#pragma unroll
            for (int ks = 0; ks < 2; ++ks) { kf[t4][ks] = *(const bf16x8*)(A.GK + ((size_t)bh * 4096 + t0 + 16 * t4 + fr) * 64 + 32 * ks + 8 * fq);
                qf[t4][ks] = *(const bf16x8*)(A.GQ + ((size_t)bh * 4096 + t0 + 16 * t4 + fr) * 64 + 32 * ks + 8 * fq); }
        __builtin_amdgcn_sched_barrier(0);
#pragma unroll
        for (int ti = 0; ti < 4; ++ti) { const f32x4 gi = *(const f32x4*)(SC + 16 * ti + 4 * fq);
#pragma unroll
            for (int tj = 0; tj < 4; ++tj) { f32x4 acc = {0.f, 0.f, 0.f, 0.f};
                if (tj <= ti) { acc = __builtin_amdgcn_mfma_f32_16x16x32_bf16(qf[ti][0], kf[tj][0], acc, 0, 0, 0); acc = __builtin_amdgcn_mfma_f32_16x16x32_bf16(qf[ti][1], kf[tj][1], acc, 0, 0, 0); }
                const float gj = SC[16 * tj + fr]; const int p = 32 * (tj >> 1) + 8 * (fr >> 2) + 4 * (tj & 1) + (fr & 3);
#pragma unroll
                for (int i = 0; i < 4; ++i) { const int ri = 16 * ti + 4 * fq + i, cj = 16 * tj + fr;
                    const float v = (tj <= ti && ri >= cj) ? acc[i] * __expf(fminf(gi[i] - gj, 0.f)) : 0.f;
                    A.QKX[((size_t)unit * 64 + ri) * 64 + p] = (bf16)f2bf(v); } } }
    }
    {
        const int lg = perm_inv32(lane);
        const float ek = SC[256 + lg];
#pragma unroll 1
        for (int r0 = 0; r0 < 64; r0 += 16) { bf16 qv[16], kv[16];
#pragma unroll
            for (int i = 0; i < 16; ++i) { qv[i] = A.GQ[((size_t)bh * 4096 + t0 + r0 + i) * 64 + lg]; kv[i] = A.GKT[((size_t)bh * 64 + r0 + i) * 4096 + t0 + lg]; }
            __builtin_amdgcn_sched_barrier(0);
#pragma unroll
            for (int i = 0; i < 16; ++i) { A.QX[((size_t)unit * 64 + r0 + i) * 64 + lane] = (bf16)f2bf(bf2f(qv[i]) * SC[192 + r0 + i]);
                A.KTX[((size_t)unit * 64 + r0 + i) * 64 + lane] = (bf16)f2bf(bf2f(kv[i]) * ek); } }
    }
    LDS_WAIT(); asm volatile("" ::: "memory");
}
struct GS2Args { const bf16* WX; const bf16* QX; const bf16* QKX; const bf16* KTX; const float* U0F; const float* GL; float* OG; float* out; int l; };
__device__ __forceinline__ void gdn_scan2_wave(const GS2Args& A, int bh, int te, int lane) {
    const int fr = lane & 15, fq = lane >> 4, b = bh >> 3, h = bh & 7;
    f32x4 s[4]; bf16x8 sfr[2];
#pragma unroll
    for (int i = 0; i < 4; ++i) s[i] = (f32x4){0.f, 0.f, 0.f, 0.f};
    sfr[0] = (bf16x8){0, 0, 0, 0, 0, 0, 0, 0}; sfr[1] = sfr[0];
    f32x4 u[4]; bf16x8 wf[4][2], kt[4][2], qx[4][2], qkx[4][2]; float dec;
#define GS_LD_UW(nn) do { const size_t un_ = (size_t)bh * 64 + (nn); _Pragma("unroll") for (int tc = 0; tc < 4; ++tc) { u[tc] = *(const f32x4*)(A.U0F + ((un_ * 16 + tc * 4 + te) * 64 + lane) * 4); \
        _Pragma("unroll") for (int ks = 0; ks < 2; ++ks) wf[tc][ks] = *(const bf16x8*)(A.WX + (un_ * 64 + 16 * tc + fr) * 64 + 32 * ks + 8 * fq); } } while (0)
#define GS_LD_Q(nn) do { const size_t un_ = (size_t)bh * 64 + (nn); _Pragma("unroll") for (int tc = 0; tc < 4; ++tc) _Pragma("unroll") for (int ks = 0; ks < 2; ++ks) { \
        qx[tc][ks] = *(const bf16x8*)(A.QX + (un_ * 64 + 16 * tc + fr) * 64 + 32 * ks + 8 * fq); qkx[tc][ks] = *(const bf16x8*)(A.QKX + (un_ * 64 + 16 * tc + fr) * 64 + 32 * ks + 8 * fq); } } while (0)
#define GS_LD_K(nn) do { const size_t un_ = (size_t)bh * 64 + (nn); dec = A.GL[un_]; _Pragma("unroll") for (int tc = 0; tc < 4; ++tc) _Pragma("unroll") for (int ks = 0; ks < 2; ++ks) \
        kt[tc][ks] = *(const bf16x8*)(A.KTX + (un_ * 64 + 16 * tc + fr) * 64 + 32 * ks + 8 * fq); } while (0)
    GS_LD_UW(0); GS_LD_Q(0); GS_LD_K(0);
    __builtin_amdgcn_sched_barrier(0);
#pragma unroll 1
    for (int n = 0; n < 64; ++n) {
        const int nn = n < 63 ? n + 1 : 63;
#pragma unroll
        for (int tc = 0; tc < 4; ++tc) { f32x4 acc = {0.f, 0.f, 0.f, 0.f};
            acc = __builtin_amdgcn_mfma_f32_16x16x32_bf16(wf[tc][0], sfr[0], acc, 0, 0, 0); acc = __builtin_amdgcn_mfma_f32_16x16x32_bf16(wf[tc][1], sfr[1], acc, 0, 0, 0);
            u[tc] -= acc; }
        bf16x8 ufr[2];
#pragma unroll
        for (int ks = 0; ks < 2; ++ks) ufr[ks] = pack8(u[2 * ks][0], u[2 * ks][1], u[2 * ks][2], u[2 * ks][3], u[2 * ks + 1][0], u[2 * ks + 1][1], u[2 * ks + 1][2], u[2 * ks + 1][3]);
        __builtin_amdgcn_sched_barrier(0);
        GS_LD_UW(nn);
        __builtin_amdgcn_sched_barrier(0);
        f32x4 oacc[4];
#pragma unroll
        for (int tc = 0; tc < 4; ++tc) {
            f32x4 acc = {0.f, 0.f, 0.f, 0.f};
            acc = __builtin_amdgcn_mfma_f32_16x16x32_bf16(qx[tc][0], sfr[0], acc, 0, 0, 0); acc = __builtin_amdgcn_mfma_f32_16x16x32_bf16(qx[tc][1], sfr[1], acc, 0, 0, 0);
            acc = __builtin_amdgcn_mfma_f32_16x16x32_bf16(qkx[tc][0], ufr[0], acc, 0, 0, 0); acc = __builtin_amdgcn_mfma_f32_16x16x32_bf16(qkx[tc][1], ufr[1], acc, 0, 0, 0);
            oacc[tc] = acc; }
#pragma unroll
        for (int td = 0; td < 4; ++td) { f32x4 acc = s[td] * dec;
            acc = __builtin_amdgcn_mfma_f32_16x16x32_bf16(kt[td][0], ufr[0], acc, 0, 0, 0); acc = __builtin_amdgcn_mfma_f32_16x16x32_bf16(kt[td][1], ufr[1], acc, 0, 0, 0);
            s[td] = acc; }
#pragma unroll
        for (int ks = 0; ks < 2; ++ks) sfr[ks] = pack8(s[2 * ks][0], s[2 * ks][1], s[2 * ks][2], s[2 * ks][3], s[2 * ks + 1][0], s[2 * ks + 1][1], s[2 * ks + 1][2], s[2 * ks + 1][3]);
        __builtin_amdgcn_sched_barrier(0);
        GS_LD_Q(nn); GS_LD_K(nn);
#pragma unroll
        for (int tc = 0; tc < 4; ++tc)
#pragma unroll
            for (int i = 0; i < 4; ++i) A.OG[((size_t)b * SEQ + 64 * n + 16 * tc + 4 * fq + i) * 512 + h * 64 + 16 * te + fr] = oacc[tc][i];
        __builtin_amdgcn_sched_barrier(0);
    }
#undef GS_LD_UW
#undef GS_LD_Q
#undef GS_LD_K
#pragma unroll
    for (int td = 0; td < 4; ++td)
#pragma unroll
        for (int i = 0; i < 4; ++i) A.out[O_GDNP + ((((size_t)A.l * NPB + b) * 8 + h) * 64 + 16 * td + 4 * fq + i) * 64 + 16 * te + fr] = s[td][i];
}

constexpr int SC_ROW = 144, SC_MAT = 64 * SC_ROW, SC_U = 4 * SC_MAT, SC_STAGE = SC_U + 16384, SC_DEC = 2 * SC_STAGE;
__device__ __forceinline__ void gdn_scan3_block(const GS2Args& A, unsigned char* lds, int bh, int tid) {
    const int lane = tid & 63, wave = __builtin_amdgcn_readfirstlane(tid >> 6), fr = lane & 15, fq = lane >> 4, b = bh >> 3, h = bh & 7, te = wave;
    const int mrow = (tid >> 3), mch = tid & 7;
    v4u ra[6], rb[6];
#define SC_LOAD(R, nn) do { const size_t un_ = (size_t)bh * 64 + ((nn) < 63 ? (nn) : 63); \
        R[0] = *(const v4u*)(A.WX + un_ * 4096 + mrow * 64 + mch * 8); R[1] = *(const v4u*)(A.KTX + un_ * 4096 + mrow * 64 + mch * 8); \
        R[2] = *(const v4u*)(A.QX + un_ * 4096 + mrow * 64 + mch * 8); R[3] = *(const v4u*)(A.QKX + un_ * 4096 + mrow * 64 + mch * 8); \
        R[4] = *(const v4u*)(A.U0F + un_ * 4096 + (size_t)tid * 4); R[5] = *(const v4u*)(A.U0F + un_ * 4096 + (size_t)(tid + 512) * 4); } while (0)
#define SC_STORE(R, st) do { unsigned char* sb_ = lds + (st) * SC_STAGE; \
        *(v4u*)(sb_ + 0 * SC_MAT + mrow * SC_ROW + mch * 16) = R[0]; *(v4u*)(sb_ + 1 * SC_MAT + mrow * SC_ROW + mch * 16) = R[1]; \
        *(v4u*)(sb_ + 2 * SC_MAT + mrow * SC_ROW + mch * 16) = R[2]; *(v4u*)(sb_ + 3 * SC_MAT + mrow * SC_ROW + mch * 16) = R[3]; \
        *(v4u*)(sb_ + SC_U + tid * 16) = R[4]; *(v4u*)(sb_ + SC_U + (tid + 512) * 16) = R[5]; } while (0)
    f32x4 s[4]; bf16x8 sfr[2];
#pragma unroll
    for (int i = 0; i < 4; ++i) s[i] = (f32x4){0.f, 0.f, 0.f, 0.f};
    sfr[0] = (bf16x8){0, 0, 0, 0, 0, 0, 0, 0}; sfr[1] = sfr[0];
    __syncthreads();
    if (tid < 64) ((float*)(lds + SC_DEC))[tid] = A.GL[(size_t)bh * 64 + tid];
    SC_LOAD(ra, 0); SC_STORE(ra, 0);
    SC_LOAD(rb, 1); SC_LOAD(ra, 2);
    __syncthreads();
#define SC_CHUNK(n, st) do { if (wave < 4) { const unsigned char* sb_ = lds + (st) * SC_STAGE; \
        f32x4 u[4]; bf16x8 ufr[2]; \
        _Pragma("unroll") for (int tc = 0; tc < 4; ++tc) { u[tc] = *(const f32x4*)(sb_ + SC_U + ((tc * 4 + te) * 64 + lane) * 16); \
            const bf16x8 w0 = *(const bf16x8*)(sb_ + (16 * tc + fr) * SC_ROW + (8 * fq) * 2), w1 = *(const bf16x8*)(sb_ + (16 * tc + fr) * SC_ROW + (32 + 8 * fq) * 2); \
            f32x4 acc = {0.f, 0.f, 0.f, 0.f}; acc = __builtin_amdgcn_mfma_f32_16x16x32_bf16(w0, sfr[0], acc, 0, 0, 0); acc = __builtin_amdgcn_mfma_f32_16x16x32_bf16(w1, sfr[1], acc, 0, 0, 0); u[tc] -= acc; } \
        _Pragma("unroll") for (int ks = 0; ks < 2; ++ks) ufr[ks] = pack8(u[2 * ks][0], u[2 * ks][1], u[2 * ks][2], u[2 * ks][3], u[2 * ks + 1][0], u[2 * ks + 1][1], u[2 * ks + 1][2], u[2 * ks + 1][3]); \
        _Pragma("unroll") for (int tc = 0; tc < 4; ++tc) { \
            const bf16x8 q0 = *(const bf16x8*)(sb_ + 2 * SC_MAT + (16 * tc + fr) * SC_ROW + (8 * fq) * 2), q1 = *(const bf16x8*)(sb_ + 2 * SC_MAT + (16 * tc + fr) * SC_ROW + (32 + 8 * fq) * 2); \
            const bf16x8 k0 = *(const bf16x8*)(sb_ + 3 * SC_MAT + (16 * tc + fr) * SC_ROW + (8 * fq) * 2), k1 = *(const bf16x8*)(sb_ + 3 * SC_MAT + (16 * tc + fr) * SC_ROW + (32 + 8 * fq) * 2); \
            f32x4 acc = {0.f, 0.f, 0.f, 0.f}; \
            acc = __builtin_amdgcn_mfma_f32_16x16x32_bf16(q0, sfr[0], acc, 0, 0, 0); acc = __builtin_amdgcn_mfma_f32_16x16x32_bf16(q1, sfr[1], acc, 0, 0, 0); \
            acc = __builtin_amdgcn_mfma_f32_16x16x32_bf16(k0, ufr[0], acc, 0, 0, 0); acc = __builtin_amdgcn_mfma_f32_16x16x32_bf16(k1, ufr[1], acc, 0, 0, 0); \
            _Pragma("unroll") for (int i = 0; i < 4; ++i) A.OG[((size_t)b * SEQ + 64 * (n) + 16 * tc + 4 * fq + i) * 512 + h * 64 + 16 * te + fr] = acc[i]; } \
        const float dec = ((const float*)(lds + SC_DEC))[(n)]; \
        _Pragma("unroll") for (int td = 0; td < 4; ++td) { \
            const bf16x8 t0 = *(const bf16x8*)(sb_ + 1 * SC_MAT + (16 * td + fr) * SC_ROW + (8 * fq) * 2), t1 = *(const bf16x8*)(sb_ + 1 * SC_MAT + (16 * td + fr) * SC_ROW + (32 + 8 * fq) * 2); \
            f32x4 acc = s[td] * dec; acc = __builtin_amdgcn_mfma_f32_16x16x32_bf16(t0, ufr[0], acc, 0, 0, 0); acc = __builtin_amdgcn_mfma_f32_16x16x32_bf16(t1, ufr[1], acc, 0, 0, 0); s[td] = acc; } \
        _Pragma("unroll") for (int ks = 0; ks < 2; ++ks) sfr[ks] = pack8(s[2 * ks][0], s[2 * ks][1], s[2 * ks][2], s[2 * ks][3], s[2 * ks + 1][0], s[2 * ks + 1][1], s[2 * ks + 1][2], s[2 * ks + 1][3]); } } while (0)
#pragma unroll 1
    for (int n = 0; n < 64; n += 2) {
        SC_STORE(rb, 1); __builtin_amdgcn_sched_barrier(0); SC_LOAD(rb, n + 3); __builtin_amdgcn_sched_barrier(0);
        SC_CHUNK(n, 0);
        __syncthreads();
        SC_STORE(ra, 0); __builtin_amdgcn_sched_barrier(0); SC_LOAD(ra, n + 4); __builtin_amdgcn_sched_barrier(0);
        SC_CHUNK(n + 1, 1);
        __syncthreads();
    }
#undef SC_LOAD
#undef SC_STORE
#undef SC_CHUNK
    if (wave < 4) {
#pragma unroll
        for (int td = 0; td < 4; ++td)
#pragma unroll
            for (int i = 0; i < 4; ++i) A.out[O_GDNP + ((((size_t)A.l * NPB + b) * 8 + h) * 64 + 16 * td + 4 * fq + i) * 64 + 16 * te + fr] = s[td][i];
    }
}

constexpr int L_CK = 0, L_CVT = 18432, L_IMP = 36864, L_MASK = 102400, L_UM = 102912, L_INV = 102928, L_K = 104448, L_VT = 113664;
struct AttArgs { const bf16* QB; const bf16* KS; const bf16* VS; const bf16* KW; const bf16* VW; const float* CKP; const float* CVP; const float* PROJ; bf16* MIX; };

constexpr float ATT_THR = 16.f;
constexpr int L_K2 = 122880, L_VT2 = 132096, L_VT3 = 0;
template <int MODE>
__device__ __forceinline__ void attn_tiles(unsigned char* lds, const bf16* Kg, const bf16* Vg, int j_lo, int j_hi, unsigned long long umask, unsigned long long tmask,
                                           int qblk, int trel, const bf16x8 (&qr)[4], f32x16 (&o)[2], float& mref, float& lrun, int tid, int r32, int hi) {
    int j = j_lo; while (j <= j_hi && !((umask >> j) & 1ull)) ++j;
    const int key = tid >> 3, ch = tid & 7;
    v4u kvv = {0u, 0u, 0u, 0u}, vv = {0u, 0u, 0u, 0u};
#define AT_LOAD(jj) do { kvv = *(const v4u*)(Kg + (size_t)(64 * (jj) + key) * 128 + ch * 8); vv = *(const v4u*)(Vg + (size_t)(64 * (jj) + key) * 128 + ch * 8); } while (0)
#define AT_WRITE(kofs, vofs) do { *(v4u*)(lds + (kofs) + key * 144 + ch * 16) = kvv; *(v4u*)(lds + (vofs) + key * 144 + ch * 16) = vv; } while (0)
    if (j > j_hi) return;
    AT_LOAD(j);
    __syncthreads();
    AT_WRITE(L_K, L_VT);
    int jn = j + 1; while (jn <= j_hi && !((umask >> jn) & 1ull)) ++jn;
    if (jn <= j_hi) AT_LOAD(jn);
    __syncthreads();
    const bool grpB = (tid >= 256);
    v4u pwp[4];
#pragma unroll
    for (int i = 0; i < 4; ++i) pwp[i] = (v4u){0u, 0u, 0u, 0u};
    int it = 0, vprev = L_VT;
    typedef short v4i16_t_ __attribute__((ext_vector_type(4)));
    const int trl_ = tid & 63, trq_ = (trl_ & 15) >> 2, trp_ = trl_ & 3, trd_ = 16 * ((trl_ >> 4) & 1) + 4 * trp_;
#define AT_TR(p_) __builtin_bit_cast(s16x4, __builtin_amdgcn_ds_read_tr16_b64_v4i16((__attribute__((address_space(3))) v4i16_t_*)(p_)))
#define AT_PV(vofs, PW) do { _Pragma("unroll") for (int u = 0; u < 2; ++u) _Pragma("unroll") for (int s = 0; s < 2; ++s) { const bf16x8 pf = __builtin_bit_cast(bf16x8, PW[u * 2 + s]); \
        _Pragma("unroll") for (int dh = 0; dh < 2; ++dh) { const unsigned char* vp = lds + (vofs) + (32 * u + 16 * s + 4 * hi + trq_) * 144 + (32 * dh + trd_) * 2; \
            const s16x4 lo = AT_TR(vp), hi4 = AT_TR(vp + 8 * 144); \
            const bf16x8 vf = (bf16x8){lo[0], lo[1], lo[2], lo[3], hi4[0], hi4[1], hi4[2], hi4[3]}; \
            o[dh] = __builtin_amdgcn_mfma_f32_32x32x16_bf16(vf, pf, o[dh], 0, 0, 0); } } } while (0)
    while (j <= j_hi) {
        const int kb = (it & 1) ? L_K2 : L_K, kb2 = (it & 1) ? L_K : L_K2;
        const int m3 = it % 3, vb = (m3 == 0) ? L_VT : (m3 == 1) ? L_VT2 : L_VT3, vb2 = (m3 == 0) ? L_VT2 : (m3 == 1) ? L_VT3 : L_VT;
        if (grpB && it > 0) AT_PV(vprev, pwp);
        if (jn <= j_hi) AT_WRITE(kb2, vb2);
        int jnn = jn + 1; while (jnn <= j_hi && !((umask >> jnn) & 1ull)) ++jnn;
        if (jnn <= j_hi) AT_LOAD(jnn);
        __builtin_amdgcn_sched_barrier(0);
        const bool tsel = (MODE == 0) ? (((tmask >> j) & 1ull) != 0ull) : true;
        const float cval = tsel ? -mref : NEG_INF;
        f32x16 ct;
#pragma unroll
        for (int r = 0; r < 16; ++r) ct[r] = cval;
        f32x16 p[2];
#pragma unroll
        for (int u = 0; u < 2; ++u) { f32x16 acc;
#pragma unroll
            for (int d0 = 0; d0 < 4; ++d0) { const bf16x8 kf = *(const bf16x8*)(lds + kb + (32 * u + r32) * 144 + (16 * d0 + 8 * hi) * 2);
                acc = __builtin_amdgcn_mfma_f32_32x32x16_bf16(kf, qr[d0], d0 == 0 ? ct : acc, 0, 0, 0); }
            p[u] = acc; }
        if (j == qblk) {
#pragma unroll
            for (int u = 0; u < 2; ++u)
#pragma unroll
                for (int r = 0; r < 16; ++r) { const int kv = 32 * u + crow(r, hi); if (kv > trel) p[u][r] = NEG_INF; } }
        if (MODE == 1 && j == qblk - 8) {
#pragma unroll
            for (int u = 0; u < 2; ++u)
#pragma unroll
                for (int r = 0; r < 16; ++r) { const int kv = 32 * u + crow(r, hi); if (kv < trel) p[u][r] = NEG_INF; } }
        float rm;
        { float a = __builtin_fmaxf(__builtin_fmaxf(p[0][0], p[0][1]), p[1][0]), b2 = __builtin_fmaxf(__builtin_fmaxf(p[0][2], p[0][3]), p[1][1]); a = __builtin_fmaxf(__builtin_fmaxf(a, p[1][2]), p[1][3]);
#pragma unroll
          for (int r = 4; r < 16; r += 4) { a = __builtin_fmaxf(__builtin_fmaxf(a, p[0][r]), p[0][r + 1]); b2 = __builtin_fmaxf(__builtin_fmaxf(b2, p[0][r + 2]), p[0][r + 3]);
              a = __builtin_fmaxf(__builtin_fmaxf(a, p[1][r]), p[1][r + 1]); b2 = __builtin_fmaxf(__builtin_fmaxf(b2, p[1][r + 2]), p[1][r + 3]); }
          rm = __builtin_fmaxf(a, b2); }
        { auto rr = __builtin_amdgcn_permlane32_swap(__float_as_uint(rm), __float_as_uint(rm), false, false); rm = __builtin_fmaxf(__uint_as_float(rr[0]), __uint_as_float(rr[1])); }
        if (__builtin_expect(__any(rm > ATT_THR), 0)) {
            const float dl = (rm > ATT_THR) ? rm : 0.f, f = ex2(-dl);
            mref += dl; lrun *= f;
#pragma unroll
            for (int u = 0; u < 2; ++u)
#pragma unroll
                for (int r = 0; r < 16; ++r) p[u][r] -= dl;
#pragma unroll
            for (int dh = 0; dh < 2; ++dh)
#pragma unroll
                for (int r = 0; r < 16; ++r) o[dh][r] *= f; }
        typedef float f32x2v_ __attribute__((ext_vector_type(2)));
        f32x2v_ ls2 = {0.f, 0.f};
#pragma unroll
        for (int u = 0; u < 2; ++u)
#pragma unroll
            for (int r = 0; r < 16; r += 2) { const float e0 = ex2(p[u][r]), e1 = ex2(p[u][r + 1]); p[u][r] = e0; p[u][r + 1] = e1; ls2 += (f32x2v_){e0, e1}; }
        lrun += ls2.x + ls2.y;
        v4u pw[4];
#pragma unroll
        for (int u = 0; u < 2; ++u)
#pragma unroll
            for (int s = 0; s < 2; ++s) { pw[u * 2 + s].x = pk2(p[u][8 * s + 0], p[u][8 * s + 1]); pw[u * 2 + s].y = pk2(p[u][8 * s + 2], p[u][8 * s + 3]);
                pw[u * 2 + s].z = pk2(p[u][8 * s + 4], p[u][8 * s + 5]); pw[u * 2 + s].w = pk2(p[u][8 * s + 6], p[u][8 * s + 7]); }
        if (!grpB) AT_PV(vb, pw);
        else {
#pragma unroll
            for (int i = 0; i < 4; ++i) pwp[i] = pw[i];
            vprev = vb; }
        __syncthreads();
        j = jn; jn = jnn; ++it;
    }
    if (grpB && it > 0) AT_PV(vprev, pwp);
#undef AT_PV
#undef AT_TR
#undef AT_LOAD
#undef AT_WRITE
}

__device__ __forceinline__ void nsa_prompt_unit(const AttArgs& A, unsigned char* lds, int unit, int tid) {
    const int lane = tid & 63, wave = tid >> 6, r32 = lane & 31, hi = lane >> 5, hh = wave & 3, ts = wave >> 2;
    const int qblk = 63 - (unit >> 3), b = (unit >> 1) & 3, kvh = unit & 1;
    const int head = kvh * 4 + hh, trel = 32 * ts + r32, t = 64 * qblk + trel; const size_t m = (size_t)b * SEQ + t;
    __syncthreads();
    const int nvmax = 2 * qblk + 2, ntile_c = (nvmax + 31) >> 5;
    { const int ch = tid & 7;
      for (int n = tid >> 3; n < 32 * ntile_c; n += 64) {
          const float* ckp = A.CKP + ((size_t)(b * 128 + n) * 2 + kvh) * 64 + ch * 8; const float* cvp = A.CVP + ((size_t)(b * 128 + n) * 2 + kvh) * 64 + ch * 8;
          const f32x4 k0 = *(const f32x4*)ckp, k1 = *(const f32x4*)(ckp + 4), v0 = *(const f32x4*)cvp, v1 = *(const f32x4*)(cvp + 4);
          *(bf16x8*)(lds + L_CK + n * 144 + ch * 16) = pack8(k0.x, k0.y, k0.z, k0.w, k1.x, k1.y, k1.z, k1.w);
          unsigned short* vt = (unsigned short*)(lds + L_CVT);
          vt[(ch * 8 + 0) * 136 + n] = (unsigned short)f2bf(v0.x); vt[(ch * 8 + 1) * 136 + n] = (unsigned short)f2bf(v0.y); vt[(ch * 8 + 2) * 136 + n] = (unsigned short)f2bf(v0.z); vt[(ch * 8 + 3) * 136 + n] = (unsigned short)f2bf(v0.w);
          vt[(ch * 8 + 4) * 136 + n] = (unsigned short)f2bf(v1.x); vt[(ch * 8 + 5) * 136 + n] = (unsigned short)f2bf(v1.y); vt[(ch * 8 + 6) * 136 + n] = (unsigned short)f2bf(v1.z); vt[(ch * 8 + 7) * 136 + n] = (unsigned short)f2bf(v1.w);
      }
      if (tid < 128) ((unsigned*)(lds + L_MASK))[tid] = 0u;
      if (tid < 2) ((unsigned*)(lds + L_UM))[tid] = 0u; }
    bf16x8 qr[4];
#pragma unroll
    for (int d0 = 0; d0 < 4; ++d0) qr[d0] = *(const bf16x8*)(A.QB + m * 512 + head * 64 + 16 * d0 + 8 * hi);
    __syncthreads();
    f32x16 tot[2];
    {
        const int nv = (t + 1) >> 5;
        float mx = NEG_INF;
#pragma unroll 1
        for (int tau = 0; tau < ntile_c; ++tau) {
            f32x16 acc = {};
#pragma unroll
            for (int d0 = 0; d0 < 4; ++d0) { const bf16x8 kf = *(const bf16x8*)(lds + L_CK + (32 * tau + r32) * 144 + (16 * d0 + 8 * hi) * 2);
                acc = __builtin_amdgcn_mfma_f32_32x32x16_bf16(kf, qr[d0], acc, 0, 0, 0); }
#pragma unroll
            for (int r = 0; r < 16; ++r) { const int n = 32 * tau + crow(r, hi); if (n < nv) mx = fmaxf(mx, acc[r]); }
        }
        mx = fmaxf(mx, __shfl_xor(mx, 32)); if (mx == NEG_INF) mx = 0.f;
        float sum = 0.f;
        f32x16 oc[2]; oc[0] = (f32x16){}; oc[1] = (f32x16){};
        float* imph = (float*)(lds + L_IMP) + (size_t)hh * 4096 + (32 * ts + r32) * 64;
#pragma unroll 1
        for (int tau = 0; tau < 4; ++tau) {
            f32x16 e = {};
            if (tau < ntile_c) {
                f32x16 acc = {};
#pragma unroll
                for (int d0 = 0; d0 < 4; ++d0) { const bf16x8 kf = *(const bf16x8*)(lds + L_CK + (32 * tau + r32) * 144 + (16 * d0 + 8 * hi) * 2);
                    acc = __builtin_amdgcn_mfma_f32_32x32x16_bf16(kf, qr[d0], acc, 0, 0, 0); }
#pragma unroll
                for (int r = 0; r < 16; ++r) { const int n = 32 * tau + crow(r, hi); e[r] = (n < nv) ? ex2(acc[r] - mx) : 0.f; sum += e[r]; }
#pragma unroll
                for (int s = 0; s < 2; ++s) {
                    const bf16x8 pf = pack8(e[8 * s + 0], e[8 * s + 1], e[8 * s + 2], e[8 * s + 3], e[8 * s + 4], e[8 * s + 5], e[8 * s + 6], e[8 * s + 7]);
#pragma unroll
                    for (int dh = 0; dh < 2; ++dh) { const unsigned char* vp = lds + L_CVT + (r32 + 32 * dh) * 272 + (32 * tau + 16 * s + 4 * hi) * 2;
                        const s16x4 lo = *(const s16x4*)vp, hi4 = *(const s16x4*)(vp + 16);
                        const bf16x8 vf = (bf16x8){lo[0], lo[1], lo[2], lo[3], hi4[0], hi4[1], hi4[2], hi4[3]};
                        oc[dh] = __builtin_amdgcn_mfma_f32_32x32x16_bf16(vf, pf, oc[dh], 0, 0, 0); }
                }
            }
#pragma unroll
            for (int a = 0; a < 4; ++a) { imph[16 * tau + 4 * a + 2 * hi + 0] = e[4 * a] + e[4 * a + 1]; imph[16 * tau + 4 * a + 2 * hi + 1] = e[4 * a + 2] + e[4 * a + 3]; }
        }
        sum += __shfl_xor(sum, 32);
        const float inv = 1.f / fmaxf(sum, 1e-30f);
        if (hi == 0) ((float*)(lds + L_INV))[hh * 64 + 32 * ts + r32] = inv;
        const float g0 = sigmoidf_(A.PROJ[m * NP + C_GATE + head * 3 + 0]) * inv;
#pragma unroll
        for (int dh = 0; dh < 2; ++dh)
#pragma unroll
            for (int r = 0; r < 16; ++r) tot[dh][r] = g0 * oc[dh][r];
    }
    __syncthreads();
    { float* ip = (float*)(lds + L_IMP); const float* iv = (const float*)(lds + L_INV);
#pragma unroll
      for (int i = 0; i < 8; ++i) { const int idx = tid + 512 * i, tk = idx >> 6;
          ip[idx] = (ip[idx] * iv[tk] + ip[4096 + idx] * iv[64 + tk]) + (ip[8192 + idx] * iv[128 + tk] + ip[12288 + idx] * iv[192 + tk]); } }
    __syncthreads();
    { const int tok = tid >> 3, jg = tid & 7; unsigned* mk = (unsigned*)(lds + L_MASK) + tok * 2;
      if (qblk <= 15) { if (jg == 0) { const unsigned long long am = (1ull << (qblk + 1)) - 1ull; mk[0] = (unsigned)am; mk[1] = (unsigned)(am >> 32); } }
      else {
          const float* iv = (const float*)(lds + L_IMP) + tok * 64; float vj[8]; int rk[8];
#pragma unroll
          for (int jj = 0; jj < 8; ++jj) { vj[jj] = iv[jg * 8 + jj]; rk[jj] = 0; }
          for (int i = 1; i <= qblk - 2; ++i) { const float vi = iv[i];
#pragma unroll
              for (int jj = 0; jj < 8; ++jj) { const int j = jg * 8 + jj; rk[jj] += (vi > vj[jj] || (vi == vj[jj] && i < j)) ? 1 : 0; } }
          unsigned bits = 0u;
#pragma unroll
          for (int jj = 0; jj < 8; ++jj) { const int j = jg * 8 + jj; const bool cand = (j >= 1 && j <= qblk - 2);
              if ((cand && rk[jj] < 13) || j == 0 || j == qblk || j == qblk - 1) bits |= 1u << ((jg & 3) * 8 + jj); }
          if (bits) atomicOr(mk + (jg >> 2), bits);
      } }
    __syncthreads();
    if (tid < 64) { const unsigned* mk = (const unsigned*)(lds + L_MASK) + tid * 2; atomicOr((unsigned*)(lds + L_UM), mk[0]); atomicOr((unsigned*)(lds + L_UM) + 1, mk[1]); }
    __syncthreads();
    unsigned long long tmask, umask;
    { const unsigned* mk = (const unsigned*)(lds + L_MASK) + trel * 2; tmask = (unsigned long long)mk[0] | ((unsigned long long)mk[1] << 32);
      const unsigned* um = (const unsigned*)(lds + L_UM); umask = (unsigned long long)um[0] | ((unsigned long long)um[1] << 32); }
    float* stash = (float*)(lds + L_IMP) + (size_t)wave * 2048 + lane;
#pragma unroll
    for (int dh = 0; dh < 2; ++dh)
#pragma unroll
        for (int r = 0; r < 16; ++r) stash[(dh * 16 + r) * 64] = tot[dh][r];
    {
        f32x16 o[2]; o[0] = (f32x16){}; o[1] = (f32x16){}; float mrun = 0.f, lrun = 0.f;
        attn_tiles<0>(lds, A.KS + (size_t)b * SEQ * 128 + kvh * 64, A.VS + (size_t)b * SEQ * 128 + kvh * 64, 0, qblk, umask, tmask, qblk, trel, qr, o, mrun, lrun, tid, r32, hi);
        lrun += __shfl_xor(lrun, 32);
        const float g1 = lrun > 0.f ? sigmoidf_(A.PROJ[m * NP + C_GATE + head * 3 + 1]) / lrun : 0.f;
#pragma unroll
        for (int dh = 0; dh < 2; ++dh)
#pragma unroll
            for (int r = 0; r < 16; ++r) stash[(dh * 16 + r) * 64] += g1 * o[dh][r];
    }
    {
        f32x16 o[2]; o[0] = (f32x16){}; o[1] = (f32x16){}; float mrun = 0.f, lrun = 0.f;
        const int jlo = qblk >= 8 ? qblk - 8 : 0;
        attn_tiles<1>(lds, A.KW + (size_t)b * SEQ * 128 + kvh * 64, A.VW + (size_t)b * SEQ * 128 + kvh * 64, jlo, qblk, ~0ull, ~0ull, qblk, trel, qr, o, mrun, lrun, tid, r32, hi);
        lrun += __shfl_xor(lrun, 32);
        const float g2 = lrun > 0.f ? sigmoidf_(A.PROJ[m * NP + C_GATE + head * 3 + 2]) / lrun : 0.f;
#pragma unroll
        for (int dh = 0; dh < 2; ++dh)
#pragma unroll
            for (int r = 0; r < 16; ++r) tot[dh][r] = stash[(dh * 16 + r) * 64] + g2 * o[dh][r];
    }
    bf16* mo = A.MIX + m * 1024 + 512 + head * 64;
#pragma unroll
    for (int dh = 0; dh < 2; ++dh)
#pragma unroll
        for (int a = 0; a < 4; ++a) { const int d0 = 32 * dh + 8 * a + 4 * hi;
            *(v2u*)(mo + d0) = (v2u){pk2(tot[dh][4 * a], tot[dh][4 * a + 1]), pk2(tot[dh][4 * a + 2], tot[dh][4 * a + 3])}; }
}

struct SAttArgs { const bf16* QB; const bf16* KS; const bf16* VS; const bf16* KW; const bf16* VW; const float* CKS; const float* CVS; const float* PROJ; const float* cache; const int* page_table; const float* state_win; bf16* MIX; int l; };
constexpr int S2_IMP = 0, S2_MK = 512, S2_ITEMS = 576, S2_OC = 1024, S2_MG = 8192;
constexpr int S2_MG_STRIDE = 4224;
template <bool F32> __device__ __forceinline__ void s2_block(const void* kbase, const void* vbase, int kstride, int nvalid, const bf16x8 (&qf)[2], const bool (&keep)[4][4], f32x4 (&O)[4], float& mrun, float& lrun, int fr, int fq) {
    f32x4 kraw[4][2][2]; bf16x8 kb[4][2]; f32x4 vraw[2][8]; v2u vb[2][8];
#pragma unroll
    for (int tk = 0; tk < 4; ++tk) { const int key = 16 * tk + fr, kc = key < nvalid ? key : nvalid - 1;
#pragma unroll
        for (int ks = 0; ks < 2; ++ks) {
            if (F32) { const float* p = (const float*)kbase + (size_t)kc * kstride + 32 * ks + 8 * fq; kraw[tk][ks][0] = *(const f32x4*)p; kraw[tk][ks][1] = *(const f32x4*)(p + 4); }
            else kb[tk][ks] = *(const bf16x8*)((const bf16*)kbase + (size_t)kc * 128 + 32 * ks + 8 * fq); } }
#pragma unroll
    for (int ks = 0; ks < 2; ++ks)
#pragma unroll
        for (int j = 0; j < 8; ++j) { const int key = 32 * ks + 16 * (j >> 2) + 4 * fq + (j & 3), kc = key < nvalid ? key : nvalid - 1;
            if (F32) vraw[ks][j] = *(const f32x4*)((const float*)vbase + (size_t)kc * kstride + 4 * fr);
            else vb[ks][j] = *(const v2u*)((const bf16*)vbase + (size_t)kc * 128 + 4 * fr); }
    __builtin_amdgcn_sched_barrier(0);
    f32x4 acc[4];
#pragma unroll
    for (int tk = 0; tk < 4; ++tk) { bf16x8 kx[2];
#pragma unroll
        for (int ks = 0; ks < 2; ++ks) { if (F32) { const f32x4 a = kraw[tk][ks][0], b = kraw[tk][ks][1]; kx[ks] = pack8(a.x, a.y, a.z, a.w, b.x, b.y, b.z, b.w); } else kx[ks] = kb[tk][ks]; }
        f32x4 a4 = {0.f, 0.f, 0.f, 0.f};
        a4 = __builtin_amdgcn_mfma_f32_16x16x32_bf16(kx[0], qf[0], a4, 0, 0, 0); a4 = __builtin_amdgcn_mfma_f32_16x16x32_bf16(kx[1], qf[1], a4, 0, 0, 0);
        acc[tk] = a4; }
    float mx = NEG_INF;
#pragma unroll
    for (int tk = 0; tk < 4; ++tk)
#pragma unroll
        for (int i = 0; i < 4; ++i) { if (!keep[tk][i]) acc[tk][i] = NEG_INF; mx = fmaxf(mx, acc[tk][i]); }
    mx = fmaxf(mx, __shfl_xor(mx, 16)); mx = fmaxf(mx, __shfl_xor(mx, 32));
    const float mn = fmaxf(mrun, mx), msafe = (mn == NEG_INF) ? 0.f : mn, alpha = ex2(mrun - msafe);
    float ls = 0.f;
#pragma unroll
    for (int tk = 0; tk < 4; ++tk)
#pragma unroll
        for (int i = 0; i < 4; ++i) { const float e = ex2(acc[tk][i] - msafe); acc[tk][i] = e; ls += e; }
    lrun = lrun * alpha + ls; mrun = mn;
#pragma unroll
    for (int td = 0; td < 4; ++td) O[td] *= alpha;
#pragma unroll
    for (int ks = 0; ks < 2; ++ks) {
        const bf16x8 pf = pack8(acc[2 * ks][0], acc[2 * ks][1], acc[2 * ks][2], acc[2 * ks][3], acc[2 * ks + 1][0], acc[2 * ks + 1][1], acc[2 * ks + 1][2], acc[2 * ks + 1][3]);
        float vv[8][4];
#pragma unroll
        for (int j = 0; j < 8; ++j) {
            if (F32) { const f32x4 v = vraw[ks][j]; vv[j][0] = v.x; vv[j][1] = v.y; vv[j][2] = v.z; vv[j][3] = v.w; }
            else { const v2u w = vb[ks][j]; vv[j][0] = bf2f((unsigned short)(w.x & 0xffffu)); vv[j][1] = bf2f((unsigned short)(w.x >> 16)); vv[j][2] = bf2f((unsigned short)(w.y & 0xffffu)); vv[j][3] = bf2f((unsigned short)(w.y >> 16)); } }
#pragma unroll
        for (int td = 0; td < 4; ++td) { const bf16x8 vx = pack8(vv[0][td], vv[1][td], vv[2][td], vv[3][td], vv[4][td], vv[5][td], vv[6][td], vv[7][td]);
            O[td] = __builtin_amdgcn_mfma_f32_16x16x32_bf16(vx, pf, O[td], 0, 0, 0); }
    }
}
__device__ __forceinline__ void nsa_sample_unit(const SAttArgs& A, unsigned char* lds, int unit, int tid) {
    const int sb = unit >> 1, kvh = unit & 1, l = A.l;
    const int lane = tid & 63, wave = __builtin_amdgcn_readfirstlane(tid >> 6), fr = lane & 15, fq = lane >> 4;
    const int qi = fr >> 2, qh = fr & 3;
    float* IMP = (float*)(lds + S2_IMP); unsigned* MK = (unsigned*)(lds + S2_MK); int* ITEMS = (int*)(lds + S2_ITEMS);
    const size_t mq = (size_t)MP + sb * 4 + qi;
    __syncthreads();
    if (tid < 8) MK[tid] = 0u;
    bf16x8 qf[2];
#pragma unroll
    for (int ks = 0; ks < 2; ++ks) qf[ks] = *(const bf16x8*)(A.QB + mq * 512 + (kvh * 4 + qh) * 64 + 32 * ks + 8 * fq);
    {
        f32x4 O[4]; float mrun = NEG_INF, lrun = 0.f;
#pragma unroll
        for (int td = 0; td < 4; ++td) O[td] = (f32x4){0.f, 0.f, 0.f, 0.f};
        bool keep[4][4];
#pragma unroll
        for (int tk = 0; tk < 4; ++tk)
#pragma unroll
            for (int i = 0; i < 4; ++i) keep[tk][i] = true;
        const float* ckf = A.CKS + ((size_t)sb * 64 * 2 + kvh) * 64; const float* cvf = A.CVS + ((size_t)sb * 64 * 2 + kvh) * 64;
        f32x4 acc[4];
#pragma unroll
        for (int tk = 0; tk < 4; ++tk) { bf16x8 kx[2];
#pragma unroll
            for (int ks = 0; ks < 2; ++ks) { const float* p = ckf + (size_t)(16 * tk + fr) * 128 + 32 * ks + 8 * fq; const f32x4 a = *(const f32x4*)p, b = *(const f32x4*)(p + 4); kx[ks] = pack8(a.x, a.y, a.z, a.w, b.x, b.y, b.z, b.w); }
            f32x4 a4 = {0.f, 0.f, 0.f, 0.f};
            a4 = __builtin_amdgcn_mfma_f32_16x16x32_bf16(kx[0], qf[0], a4, 0, 0, 0); a4 = __builtin_amdgcn_mfma_f32_16x16x32_bf16(kx[1], qf[1], a4, 0, 0, 0);
            acc[tk] = a4; }
        float mx = NEG_INF;
#pragma unroll
        for (int tk = 0; tk < 4; ++tk)
#pragma unroll
            for (int i = 0; i < 4; ++i) mx = fmaxf(mx, acc[tk][i]);
        mx = fmaxf(mx, __shfl_xor(mx, 16)); mx = fmaxf(mx, __shfl_xor(mx, 32));
        float ls = 0.f;
#pragma unroll
        for (int tk = 0; tk < 4; ++tk)
#pragma unroll
            for (int i = 0; i < 4; ++i) { const float e = ex2(acc[tk][i] - mx); acc[tk][i] = e; ls += e; }
        ls += __shfl_xor(ls, 16); ls += __shfl_xor(ls, 32);
        const float inv = 1.f / fmaxf(ls, 1e-30f);
        if (wave == 0) {
#pragma unroll
            for (int tk = 0; tk < 4; ++tk)
#pragma unroll
                for (int b2 = 0; b2 < 2; ++b2) { float v = (acc[tk][2 * b2] + acc[tk][2 * b2 + 1]) * inv;
                    v += __shfl_xor(v, 1); v += __shfl_xor(v, 2);
                    if (qh == 0) IMP[qi * 32 + 8 * tk + 2 * fq + b2] = v; }
#pragma unroll
            for (int ks = 0; ks < 2; ++ks) {
                const bf16x8 pf = pack8(acc[2 * ks][0], acc[2 * ks][1], acc[2 * ks][2], acc[2 * ks][3], acc[2 * ks + 1][0], acc[2 * ks + 1][1], acc[2 * ks + 1][2], acc[2 * ks + 1][3]);
#pragma unroll
                for (int td = 0; td < 4; ++td) { float vv[8];
#pragma unroll
                    for (int j = 0; j < 8; ++j) { const int key = 32 * ks + 16 * (j >> 2) + 4 * fq + (j & 3); vv[j] = cvf[(size_t)key * 128 + 4 * fr + td]; }
                    const bf16x8 vx = pack8(vv[0], vv[1], vv[2], vv[3], vv[4], vv[5], vv[6], vv[7]);
                    O[td] = __builtin_amdgcn_mfma_f32_16x16x32_bf16(vx, pf, O[td], 0, 0, 0); } }
            const float g0 = sigmoidf_(A.PROJ[mq * NP + C_GATE + (kvh * 4 + qh) * 3 + 0]) * inv;
            float* OC = (float*)(lds + S2_OC);
#pragma unroll
            for (int td = 0; td < 4; ++td)
#pragma unroll
                for (int i = 0; i < 4; ++i) OC[(16 * fq + 4 * i + td) * 16 + fr] = g0 * O[td][i];
        }
        (void)mrun; (void)lrun; (void)keep;
    }
    __syncthreads();
    if (tid < 128) { const int i = tid >> 5, j = tid & 31; bool sel = (j == 0 || j == 31);
        if (j >= 1 && j <= 30) { const float vj = IMP[i * 32 + j]; int rk = 0;
            for (int q = 1; q <= 30; ++q) { const float vi = IMP[i * 32 + q]; rk += (vi > vj || (vi == vj && q < j)) ? 1 : 0; }
            sel = rk < 13; }
        if (sel) { atomicOr(MK + i, 1u << j); atomicOr(MK + 4, 1u << j); } }
    __syncthreads();
    if (tid == 0) { const unsigned um = MK[4]; int n = 0;
        for (int j = 0; j < 32; ++j) if ((um >> j) & 1u) ITEMS[1 + n++] = j;
        ITEMS[1 + n++] = 32;
        for (int jb = 0; jb < 9; ++jb) ITEMS[1 + n++] = 64 + jb;
        ITEMS[0] = n; }
    __syncthreads();
    {
        const int nitems = ITEMS[0]; const unsigned tm = MK[qi];
        f32x4 Os[4], Ow[4]; float ms = NEG_INF, lsum = 0.f, mw = NEG_INF, lw = 0.f;
#pragma unroll
        for (int td = 0; td < 4; ++td) { Os[td] = (f32x4){0.f, 0.f, 0.f, 0.f}; Ow[td] = (f32x4){0.f, 0.f, 0.f, 0.f}; }
        const float* wb = A.state_win + ((size_t)l * NSB + sb) * 512 * 256 + kvh * 64;
        for (int it = wave; it < nitems; it += NWAVES) {
            const int code = ITEMS[1 + it]; bool keep[4][4];
            if (code < 64) {
                const int j = code;
                if (j < 32) { const int phys = A.page_table[sb * NPAGES + (j >> 1)];
                    const float* base = A.cache + ((((size_t)l * NPOOL + phys) * 2 + kvh) * 128 + (j & 1) * 64) * 256;
                    const bool tsel = ((tm >> j) & 1u) != 0u;
#pragma unroll
                    for (int tk = 0; tk < 4; ++tk)
#pragma unroll
                        for (int i = 0; i < 4; ++i) keep[tk][i] = tsel;
                    s2_block<true>(base + 128, base + 192, 256, 64, qf, keep, Os, ms, lsum, fr, fq);
                } else {
#pragma unroll
                    for (int tk = 0; tk < 4; ++tk)
#pragma unroll
                        for (int i = 0; i < 4; ++i) { const int key = 16 * tk + 4 * fq + i; keep[tk][i] = key <= qi; }
                    s2_block<false>(A.KS + ((size_t)MP + sb * 4) * 128 + kvh * 64, A.VS + ((size_t)MP + sb * 4) * 128 + kvh * 64, 128, 4, qf, keep, Os, ms, lsum, fr, fq);
                }
            } else {
                const int jb = code - 64;
                if (jb < 8) {
#pragma unroll
                    for (int tk = 0; tk < 4; ++tk)
#pragma unroll
                        for (int i = 0; i < 4; ++i) { const int r = 64 * jb + 16 * tk + 4 * fq + i; keep[tk][i] = r >= qi; }
                    s2_block<true>(wb + (size_t)(64 * jb) * 256, wb + (size_t)(64 * jb) * 256 + 128, 256, 64, qf, keep, Ow, mw, lw, fr, fq);
                } else {
#pragma unroll
                    for (int tk = 0; tk < 4; ++tk)
#pragma unroll
                        for (int i = 0; i < 4; ++i) { const int key = 16 * tk + 4 * fq + i; keep[tk][i] = key <= qi; }
                    s2_block<false>(A.KW + ((size_t)MP + sb * 4) * 128 + kvh * 64, A.VW + ((size_t)MP + sb * 4) * 128 + kvh * 64, 128, 4, qf, keep, Ow, mw, lw, fr, fq);
                }
            }
        }
        lsum += __shfl_xor(lsum, 16); lsum += __shfl_xor(lsum, 32); lw += __shfl_xor(lw, 16); lw += __shfl_xor(lw, 32);
        float* Ps = (float*)(lds + S2_MG + (wave * 2 + 0) * S2_MG_STRIDE); float* Pw = (float*)(lds + S2_MG + (wave * 2 + 1) * S2_MG_STRIDE);
#pragma unroll
        for (int td = 0; td < 4; ++td)
#pragma unroll
            for (int i = 0; i < 4; ++i) { Ps[(16 * fq + 4 * i + td) * 16 + fr] = Os[td][i]; Pw[(16 * fq + 4 * i + td) * 16 + fr] = Ow[td][i]; }
        if (fq == 0) { Ps[1024 + fr] = ms; Ps[1040 + fr] = lsum; Pw[1024 + fr] = mw; Pw[1040 + fr] = lw; }
    }
    __syncthreads();
    {
        const int q = tid & 15, i = q >> 2, hh = q & 3; const size_t m = (size_t)MP + sb * 4 + i;
        const float* OC = (const float*)(lds + S2_OC);
        float res[2];
#pragma unroll
        for (int k = 0; k < 2; ++k) res[k] = OC[((tid >> 4) + 32 * k) * 16 + q];
#pragma unroll
        for (int br = 0; br < 2; ++br) {
            float M = NEG_INF;
#pragma unroll
            for (int w = 0; w < NWAVES; ++w) M = fmaxf(M, ((const float*)(lds + S2_MG + (w * 2 + br) * S2_MG_STRIDE))[1024 + q]);
            float L = 0.f, o0 = 0.f, o1 = 0.f;
#pragma unroll
            for (int w = 0; w < NWAVES; ++w) { const float* P = (const float*)(lds + S2_MG + (w * 2 + br) * S2_MG_STRIDE);
                const float f = ex2(P[1024 + q] - M);
                L += P[1040 + q] * f; o0 += P[(tid >> 4) * 16 + q] * f; o1 += P[((tid >> 4) + 32) * 16 + q] * f; }
            const float g = sigmoidf_(A.PROJ[m * NP + C_GATE + (kvh * 4 + hh) * 3 + 1 + br]) / fmaxf(L, 1e-30f);
            res[0] += g * o0; res[1] += g * o1;
        }
#pragma unroll
        for (int k = 0; k < 2; ++k) A.MIX[m * 1024 + 512 + (kvh * 4 + hh) * 64 + (tid >> 4) + 32 * k] = (bf16)f2bf(res[k]);
    }
}

constexpr int CW_CMPQ = 256;
__device__ __forceinline__ void compress_pull(const CmpArgs& A, unsigned char* lds, unsigned* head, volatile LAS int* slot, int max_batches, int tid) {
    for (int nb = 0; nb < max_batches; ++nb) {
        __syncthreads();
        if (tid == 0) *slot = (int)__hip_atomic_fetch_add(head, 1u, __ATOMIC_RELAXED, __HIP_MEMORY_SCOPE_AGENT);
        __syncthreads();
        const int b = *slot;
        if (b >= 256) break;
        compress_batch(A, lds, b, true, tid);
    }
    __syncthreads();
}

struct Args { const GAS void* in[22]; GAS float* out; GAS unsigned char* ws; int ph_lo, ph_hi; };
constexpr int PH_PER_LAYER = 10, N_PHASES = 1 + NL * PH_PER_LAYER;
__global__ void __launch_bounds__(NWAVES * 64, 2) hymba_fwd(Args args) {
    extern __shared__ __attribute__((aligned(16))) unsigned char lds[];
    const int G = gridDim.x, bx = blockIdx.x, NGW = G * NWAVES;
    const int wave_s_ = __builtin_amdgcn_readfirstlane((int)threadIdx.x >> 6);
#define TID_NOW() (wave_s_ * 64 + (int)__builtin_amdgcn_mbcnt_hi(~0u, __builtin_amdgcn_mbcnt_lo(~0u, 0u)))
#define SUB_IDS int tid = TID_NOW(); asm volatile("" : "+v"(tid)); const int lane = tid & 63, wave = __builtin_amdgcn_readfirstlane(tid >> 6), gw = bx * NWAVES + wave; (void)lane; (void)gw; (void)wave;
#define PHASE_IDS int tid = TID_NOW(); asm volatile("" : "+v"(tid)); const int lane = tid & 63, wave = __builtin_amdgcn_readfirstlane(tid >> 6), gw = bx * NWAVES + wave; (void)lane; (void)gw; const __attribute__((address_space(4))) unsigned long long* ka_ = (const __attribute__((address_space(4))) unsigned long long*)__builtin_amdgcn_kernarg_segment_ptr(); asm volatile("" : "+s"(ka_)); GAS unsigned char* wsg_ = (GAS unsigned char*)ka_[23]; unsigned char* wsl = (unsigned char*)wsg_;
#define x_prompt ((const float*)(const GAS float*)ka_[0])
#define x_sample ((const float*)(const GAS float*)ka_[1])
#define cache_kv ((const float*)(const GAS float*)ka_[2])
#define page_table ((const int*)(const GAS int*)ka_[3])
#define state_win ((const float*)(const GAS float*)ka_[4])
#define state_gdn ((const float*)(const GAS float*)ka_[5])
#define state_conv ((const float*)(const GAS float*)ka_[6])
#define norm_mix ((const float*)(const GAS float*)ka_[7])
#define w_in ((const float*)(const GAS float*)ka_[8])
#define conv_w ((const float*)(const GAS float*)ka_[9])
#define a_log ((const float*)(const GAS float*)ka_[10])
#define dt_bias ((const float*)(const GAS float*)ka_[11])
#define gdn_norm ((const float*)(const GAS float*)ka_[12])
#define cmp_pe_k ((const float*)(const GAS float*)ka_[13])
#define cmp_w_k ((const float*)(const GAS float*)ka_[14])
#define cmp_pe_v ((const float*)(const GAS float*)ka_[15])
#define cmp_w_v ((const float*)(const GAS float*)ka_[16])
#define w_out ((const float*)(const GAS float*)ka_[17])
#define norm_mlp ((const float*)(const GAS float*)ka_[18])
#define w_up ((const float*)(const GAS float*)ka_[19])
#define w_down ((const float*)(const GAS float*)ka_[20])
#define norm_final ((const float*)(const GAS float*)ka_[21])
#define out ((float*)(GAS float*)ka_[22])
#define WIN_T ((bf16*)(wsl + WS_WIN))
#define WOUT_T ((bf16*)(wsl + WS_WOUT))
#define WUP_T ((bf16*)(wsl + WS_WUP))
#define WDN_T ((bf16*)(wsl + WS_WDN))
#define CMPW ((bf16*)(wsl + WS_CMPW))
#define HB ((bf16*)(wsl + WS_HB))
#define PROJ ((float*)(wsl + WS_PROJ))
#define X1 ((bf16*)(wsl + WS_X1))
#define X2 ((bf16*)(wsl + WS_X2))
#define MIX ((bf16*)(wsl + WS_MIX))
#define HID ((bf16*)(wsl + WS_HID))
#define QN ((float*)(wsl + WS_QN))
#define KN ((float*)(wsl + WS_KN))
#define VG ((float*)(wsl + WS_VG))
#define OG ((float*)(wsl + WS_OG))
#define GG ((float*)(wsl + WS_G))
#define BETA ((float*)(wsl + WS_BETA))
#define KQ ((float*)(wsl + WS_KQ))
#define QB ((bf16*)(wsl + WS_QB))
#define KS ((bf16*)(wsl + WS_KS))
#define VS ((bf16*)(wsl + WS_VS))
#define KW ((bf16*)(wsl + WS_KW))
#define VW ((bf16*)(wsl + WS_VW))
#define CKP ((float*)(wsl + WS_CKP))
#define CVP ((float*)(wsl + WS_CVP))
#define CKS ((float*)(wsl + WS_CKS))
#define CVS ((float*)(wsl + WS_CVS))
#define GK ((bf16*)(wsl + WS_GK))
#define GQ ((bf16*)(wsl + WS_GQ))
#define GKT ((bf16*)(wsl + WS_GKT))
#define GVT ((bf16*)(wsl + WS_GVT))
#define GG2 ((float*)(wsl + WS_GG2))
#define BETA2 ((float*)(wsl + WS_BETA2))
#define WX ((bf16*)(wsl + WS_WX))
#define QX ((bf16*)(wsl + WS_QX))
#define QKX ((bf16*)(wsl + WS_QKX))
#define KTX ((bf16*)(wsl + WS_KTX))
#define U0F ((float*)(wsl + WS_U0F))
#define GL ((float*)(wsl + WS_GL))
#define PARTD ((float*)(wsl + WS_PARTD))
#define PARTG ((float*)(wsl + WS_PARTG))
    LAS unsigned char* ldsl = (LAS unsigned char*)lds;

    const int lo = args.ph_lo, hi = args.ph_hi;
    { const int t0_ = TID_NOW(); if (t0_ < 16) ((LAS unsigned*)(ldsl + MISC_OFF))[t0_] = 0u; }
    __syncthreads();
    XcdBarrier bar = xcd_barrier_post((unsigned*)((unsigned char*)args.ws + WS_CTL) + CW_BAR, (volatile LAS unsigned*)(ldsl + MISC_OFF), TID_NOW() == 0);
#define BOTH(k) (lo <= (k) && (k) + 1 < hi)
#define GRID_BAR(k) do { if (BOTH(k)) { for (int rb_ = 0; rb_ < REP_BAR; ++rb_) xcd_barrier(bar, TID_NOW() == 0); } } while (0)
#ifndef REP_PG
#define REP_PG 1
#endif
#ifndef REP_PA
#define REP_PA 1
#endif
#ifndef REP_BAR
#define REP_BAR 1
#endif
#ifndef REP_GSMP
#define REP_GSMP 1
#endif
#ifndef REP_P0
#define REP_P0 1
#endif
#ifndef REP_LIGHT
#define REP_LIGHT 1
#endif
#ifndef REP_PB_ROW
#define REP_PB_ROW 1
#endif
#ifndef REP_PB_PREP
#define REP_PB_PREP 1
#endif
#ifndef REP_PB_CMP
#define REP_PB_CMP 1
#endif
#ifndef REP_PB_COPY
#define REP_PB_COPY 1
#endif
#ifndef REP_PB2
#define REP_PB2 1
#endif
#ifndef REP_SCAN
#define REP_SCAN 1
#endif
#ifndef REP_ATTP
#define REP_ATTP 1
#endif
#ifndef REP_ATTS
#define REP_ATTS 1
#endif
#ifndef REP_GEMM
#define REP_GEMM 1
#endif
#define EN(i) (((PH_MASK_T) >> (i)) & 1u)
#define SUB(i) (((SUB_MASK_T) >> (i)) & 1u)
#define IN(k) (lo <= (k) && (k) < hi)

    if (IN(0)) { PHASE_IDS
        for (int rep0 = 0; rep0 < REP_P0; ++rep0) {
        LAS float* scr = (LAS float*)(ldsl + wave * 16384);
        constexpr int I_IN = 16 * 112, I_OUT = 16 * 32, I_UP = 16 * 128, I_DN = 64 * 32, I_C = 32 * 2, I_L = I_IN + I_OUT + I_UP + I_DN + 2 * I_C;
        for (int it = gw; it < NL * I_L; it += NGW) {
            const int l = it / I_L; int r = it % I_L;
            if (r < I_IN) { transpose_item(w_in + (size_t)l * DM * NPROJ, DM, NPROJ, NP, WIN_T + (size_t)l * NP * DM, scr, r, lane); continue; } r -= I_IN;
            if (r < I_OUT) { transpose_item(w_out + (size_t)l * DM * DM, DM, DM, DM, WOUT_T + (size_t)l * DM * DM, scr, r, lane); continue; } r -= I_OUT;
            if (r < I_UP) { transpose_item(w_up + (size_t)l * DM * DFF, DM, DFF, DFF, WUP_T + (size_t)l * DFF * DM, scr, r, lane); continue; } r -= I_UP;
            if (r < I_DN) { transpose_item(w_down + (size_t)l * DFF * DM, DFF, DM, DM, WDN_T + (size_t)l * DM * DFF, scr, r, lane); continue; } r -= I_DN;
            if (r < I_C) { transpose_item(cmp_w_k + (size_t)l * 2048 * 64, 2048, 64, 64, CMPW + (size_t)((l * 2 + 0) * 64) * 2048, scr, r, lane); continue; } r -= I_C;
            transpose_item(cmp_w_v + (size_t)l * 2048 * 64, 2048, 64, 64, CMPW + (size_t)((l * 2 + 1) * 64) * 2048, scr, r, lane);
        }
        for (int m = gw; m < MT; m += NGW) { const float* xr = (m < MP) ? x_prompt + (size_t)m * DM : x_sample + (size_t)(m - MP) * DM; rms_row(xr, false, norm_mix, HB + (size_t)m * DM, nullptr, lane); }
        }
    }

    GRID_BAR(0);
    for (int l = 0; l < NL; ++l) {
        const int pb = 1 + l * PH_PER_LAYER;
        if (IN(pb + 0)) { PHASE_IDS
            pg8::Gemm g{HB, WIN_T + (size_t)l * NP * DM, MT, NP, DM, DM}; pg8::StaticOrder S; S.init(MT, NP, G, bx);
            pg8::EpiF32 E{PROJ, NP};
            _Pragma("unroll 1") for (int rep = 0; rep < REP_PA; ++rep) pg8::gemm_phase<pg8::EpiF32, pg8::StaticOrder, true, true>(ldsl, g, S, E, tid);
            if (l == 0 && bx >= (MT / 256) * (NP / 256) % G) { SUB_IDS CmpArgs CA{PROJ, cache_kv, page_table, cmp_pe_k, cmp_pe_v, CMPW, wsl, 0};
                compress_pull(CA, lds, (unsigned*)(wsl + WS_CTL) + CW_CMPQ, (volatile LAS int*)(ldsl + MISC_OFF + 36), 1, tid); }
        }
        GRID_BAR(pb + 0);
        if (IN(pb + 1)) { PHASE_IDS
            { SUB_IDS PBArgs A{PROJ, state_conv, conv_w, a_log, dt_bias, QN, KN, VG, GG, BETA, KQ, QB, KS, VS, KW, VW, out, l};
              for (int rep = 0; rep < REP_PB_ROW; ++rep) if (gw >= 128) for (int m = gw - 128; m < MT; m += 2 * (NGW - 128)) {
                  const int m2 = m + (NGW - 128); const bool has2 = m2 < MT; PBRegs r0, r1;
                  pb_row_load(A, m, lane, r0); pb_row_load(A, has2 ? m2 : m, lane, r1);
                  __builtin_amdgcn_sched_barrier(0);
                  pb_row(A, m, lane, r0); if (has2) pb_row(A, m2, lane, r1); }
              for (int u = gw; u < MS * 8; u += NGW) pb_sample_head(A, u, lane); }
            { SUB_IDS GPArgs A{PROJ, conv_w, a_log, dt_bias, GK, GQ, GKT, GVT, GG2, BETA2, l};
              for (int rep = 0; rep < REP_PB_PREP; ++rep) for (int u = gw; u < (MP / 8) * 8; u += 2 * NGW) {
                  GPRegs r0, r1; const int u2 = (u + NGW < (MP / 8) * 8) ? u + NGW : u; gdn_prep_load(A, u, lane, r0); gdn_prep_load(A, u2, lane, r1);
                  __builtin_amdgcn_sched_barrier(0);
                  gdn_prep_unit(A, u, lane, r0); gdn_prep_unit(A, u2, lane, r1); } }
            { SUB_IDS CmpArgs A{PROJ, cache_kv, page_table, cmp_pe_k, cmp_pe_v, CMPW, wsl, l};
              if (bx < 16) compress_batch(A, lds, bx, false, tid);
              compress_pull(A, lds, (unsigned*)(wsl + WS_CTL) + CW_CMPQ + 64 * l, (volatile LAS int*)(ldsl + MISC_OFF + 36), 1 << 20, tid); }
        }
        GRID_BAR(pb + 1);
        if (IN(pb + 2)) { PHASE_IDS
            GCArgs A{GK, GQ, GKT, GVT, GG2, BETA2, WX, QX, QKX, KTX, U0F, GL};
            for (int rep = 0; rep < REP_PB2; ++rep) for (int u = gw; u < 32 * 64; u += NGW) gdn_chunk_unit(A, lds + wave * GC_LDS_PER_WAVE, u, lane);
        }
        GRID_BAR(pb + 2);
        if (IN(pb + 3)) {
            { PHASE_IDS GdnArgs GA{QN, KN, VG, GG, BETA, KQ, OG, PROJ, state_gdn, gdn_norm, MIX, out, l};
                for (int rep = 0; rep < REP_GSMP; ++rep) for (int u = gw; u < NSB * 8; u += NGW) gdn_sample_unit(GA, u, lane); }
            { PHASE_IDS
                GS2Args SG{WX, QX, QKX, KTX, U0F, GL, OG, out, l};
                AttArgs AA{QB, KS, VS, KW, VW, CKP, CVP, PROJ, MIX};
                SAttArgs SA{QB, KS, VS, KW, VW, CKS, CVS, PROJ, cache_kv, page_table, state_win, MIX, l};
                unsigned* qhead = (unsigned*)(wsl + WS_CTL) + CW_QUEUE + 64 * l;
                volatile LAS int* slot = (volatile LAS int*)(ldsl + MISC_OFF + 32);
                for (;;) {
                    __syncthreads();
                    if (tid == 0) *slot = (int)__hip_atomic_fetch_add(qhead, 1u, __ATOMIC_RELAXED, __HIP_MEMORY_SCOPE_AGENT);
                    __syncthreads();
                    int u = *slot;
                    constexpr int XP = (REP_ATTP - 1) * 512, XS = (REP_ATTS - 1) * 256, XG = (REP_SCAN - 1) * 32;
                    if (u >= 800 + XP + XS + XG + 128) break;
                    if (u >= 32 && u < 928) { const int g_ = (u - 32) / 7, k_ = (u - 32) % 7;
                        u = (k_ < 4) ? 32 + 4 * g_ + k_ : (k_ < 6) ? 544 + 2 * g_ + (k_ - 4) : 800 + g_; }
                    if (u >= 800 + XP + XS + XG) {
                        const int sb = u - (800 + XP + XS + XG); const f32x4* src = (const f32x4*)(state_win + ((size_t)l * NSB + sb) * 512 * 256) + 256; f32x4* dst = (f32x4*)(out + O_WINS + ((size_t)l * NSB + sb) * 512 * 256);
                        for (int i = tid; i < 508 * 64; i += 8 * NWAVES * 64) { f32x4 v[8];
#pragma unroll
                            for (int k = 0; k < 8; ++k) { const int ii = i + k * NWAVES * 64; v[k] = src[ii < 508 * 64 ? ii : i]; }
#pragma unroll
                            for (int k = 0; k < 8; ++k) { const int ii = i + k * NWAVES * 64; if (ii < 508 * 64) dst[ii] = v[k]; } }
                        continue; }
                    if (u >= 800) { int v = u - 800; if (v < XP) u = 32 + (v & 511); else { v -= XP; if (v < XS) u = 544 + (v & 255); else u = (v - XS) & 31; } }
                    int tq = TID_NOW(); asm volatile("" : "+v"(tq));
                    if (u < 32) gdn_scan3_block(SG, lds, u, tq);
                    else if (u < 32 + 512) nsa_prompt_unit(AA, lds, u - 32, tq);
                    else nsa_sample_unit(SA, lds, u - 544, tq);
                }
            }
        }
        GRID_BAR(pb + 3);
        if (IN(pb + 4)) { PHASE_IDS
            const float gnl = gdn_norm[l * 64 + lane];
            for (int rep = 0; rep < REP_LIGHT; ++rep) for (int m = gw; m < MP; m += NGW) {
                float ov[8], zv[8];
#pragma unroll
                for (int h = 0; h < 8; ++h) { ov[h] = OG[(size_t)m * 512 + h * 64 + lane]; zv[h] = PROJ[(size_t)m * NP + C_Z + h * 64 + lane]; }
                __builtin_amdgcn_sched_barrier(0);
#pragma unroll
                for (int h = 0; h < 8; ++h) { const float ms = dpp_sum(ov[h] * ov[h]) * (1.f / 64.f);
                    MIX[(size_t)m * 1024 + h * 64 + lane] = (bf16)f2bf(ov[h] * (1.f / sqrtf(ms + 1e-6f)) * gnl * siluf_(zv[h])); } }
        }
        GRID_BAR(pb + 4);
        if (IN(pb + 5)) { PHASE_IDS
            { pg8::Gemm g{MIX, WOUT_T + (size_t)l * DM * DM, MP, DM, DM, DM}; pg8::StaticOrder S; S.init(MP, DM, G, bx);
              pg8::EpiResid E{(l == 0) ? (const void*)x_prompt : (const void*)X2, l != 0, X1, DM};
              pg8::gemm_phase<pg8::EpiResid, pg8::StaticOrder, true, true>(ldsl, g, S, E, tid); }
            { pg8::Gemm g{MIX, WOUT_T + (size_t)l * DM * DM, MT, DM, PD_KL, DM}; pg8::SplitKOrder S; S.init(MP / 256, MS / 256, DM / 256, PD_KS, PD_KL, G, bx);
              pg8::EpiPart E{PARTD, DM, MP, MS};
              pg8::gemm_phase<pg8::EpiPart, pg8::SplitKOrder, false, true>(ldsl, g, S, E, tid); }
        }
        GRID_BAR(pb + 5);
        if (IN(pb + 6)) { PHASE_IDS
            for (int m = gw; m < MP; m += 2 * NGW) { const int m2 = m + NGW;
                if (m2 < MP) rms_row2(X1 + (size_t)m * DM, X1 + (size_t)m2 * DM, true, norm_mlp + (size_t)l * DM, HB + (size_t)m * DM, HB + (size_t)m2 * DM, nullptr, nullptr, lane);
                else rms_row(X1 + (size_t)m * DM, true, norm_mlp + (size_t)l * DM, HB + (size_t)m * DM, nullptr, lane); }
            for (int m = MP + gw; m < MT; m += NGW) { const void* bs = (l == 0) ? (const void*)(x_sample + (size_t)(m - MP) * DM) : (const void*)(X2 + (size_t)m * DM);
                rms_row_parts(bs, l != 0, PARTD + (size_t)(m - MP) * DM, PD_KS, (size_t)MS * DM, X1 + (size_t)m * DM, norm_mlp + (size_t)l * DM, HB + (size_t)m * DM, nullptr, lane); } }
        GRID_BAR(pb + 6);
        if (IN(pb + 7)) { PHASE_IDS
            pg8::Gemm g{HB, WUP_T + (size_t)l * DFF * DM, MT, DFF, DM, DM}; pg8::StaticOrder S; S.init(MT, DFF, G, bx);
            pg8::EpiRelu2 E{HID, DFF};
            pg8::gemm_phase<pg8::EpiRelu2, pg8::StaticOrder, true, true>(ldsl, g, S, E, tid);
            if (l + 1 < NL && bx >= (MT / 256) * (DFF / 256) % G) { SUB_IDS CmpArgs CA{PROJ, cache_kv, page_table, cmp_pe_k, cmp_pe_v, CMPW, wsl, l + 1};
                compress_pull(CA, lds, (unsigned*)(wsl + WS_CTL) + CW_CMPQ + 64 * (l + 1), (volatile LAS int*)(ldsl + MISC_OFF + 36), 1, tid); }
        }
        GRID_BAR(pb + 7);
        if (IN(pb + 8)) { PHASE_IDS
            { pg8::Gemm g{HID, WDN_T + (size_t)l * DM * DFF, MP, DM, DFF, DFF}; pg8::StaticOrder S; S.init(MP, DM, G, bx);
              pg8::EpiResid E{(const void*)X1, true, X2, DM};
              pg8::gemm_phase<pg8::EpiResid, pg8::StaticOrder, true, true>(ldsl, g, S, E, tid); }
            { pg8::Gemm g{HID, WDN_T + (size_t)l * DM * DFF, MT, DM, PG_KL, DFF}; pg8::SplitKOrder S; S.init(MP / 256, MS / 256, DM / 256, PG_KS, PG_KL, G, bx);
              pg8::EpiPart E{PARTG, DM, MP, MS};
              pg8::gemm_phase<pg8::EpiPart, pg8::SplitKOrder, false, true>(ldsl, g, S, E, tid); }
        }
        GRID_BAR(pb + 8);
        if (IN(pb + 9)) { PHASE_IDS
            const float* gn = (l + 1 < NL) ? norm_mix + (size_t)(l + 1) * DM : norm_final; const bool fin = !(l + 1 < NL);
            for (int m = gw; m < MP; m += 2 * NGW) { const int m2 = m + NGW;
                if (m2 < MP) rms_row2(X2 + (size_t)m * DM, X2 + (size_t)m2 * DM, true, gn, fin ? nullptr : HB + (size_t)m * DM, fin ? nullptr : HB + (size_t)m2 * DM, fin ? out + O_YP + (size_t)m * DM : nullptr, fin ? out + O_YP + (size_t)m2 * DM : nullptr, lane);
                else rms_row(X2 + (size_t)m * DM, true, gn, fin ? nullptr : HB + (size_t)m * DM, fin ? out + O_YP + (size_t)m * DM : nullptr, lane); }
            for (int m = MP + gw; m < MT; m += NGW)
                rms_row_parts(X1 + (size_t)m * DM, true, PARTG + (size_t)(m - MP) * DM, PG_KS, (size_t)MS * DM, X2 + (size_t)m * DM, gn, fin ? nullptr : HB + (size_t)m * DM, fin ? out + O_YP + (size_t)m * DM : nullptr, lane);
        }
        GRID_BAR(pb + 9);
    }
#undef IN
}

#undef x_prompt
#undef x_sample
#undef cache_kv
#undef page_table
#undef state_win
#undef state_gdn
#undef state_conv
#undef norm_mix
#undef w_in
#undef conv_w
#undef a_log
#undef dt_bias
#undef gdn_norm
#undef cmp_pe_k
#undef cmp_w_k
#undef cmp_pe_v
#undef cmp_w_v
#undef w_out
#undef norm_mlp
#undef w_up
#undef w_down
#undef norm_final
#undef out
#ifndef MK_PER_PHASE
#define MK_PER_PHASE 0
#endif
typedef void (*kfn_t)(Args); static const kfn_t K_ALL = hymba_fwd;
extern "C" void kernel_launch(void* const* d_in, const int* in_sizes, int n_in, void* d_out, int out_size, void* d_ws, size_t ws_size, hipStream_t stream) {
    static int grid = 0;
    if (grid == 0) {
        if (n_in != 22 || out_size != (int)O_END || ws_size < WS_END) { fprintf(stderr, "kernel_launch: unexpected shapes (n_in %d, out %d, ws %zu)\n", n_in, out_size, ws_size); grid = -1; return; }
        int dev = 0, cus = 0, per_cu = 0;
        if (hipGetDevice(&dev) != hipSuccess || hipDeviceGetAttribute(&cus, hipDeviceAttributeMultiprocessorCount, dev) != hipSuccess) { grid = -1; return; }
        if (hipFuncSetAttribute((const void*)K_ALL, hipFuncAttributeMaxDynamicSharedMemorySize, LDS_BYTES) != hipSuccess) { fprintf(stderr, "kernel_launch: hipFuncSetAttribute failed\n"); grid = -1; return; }
        if (hipOccupancyMaxActiveBlocksPerMultiprocessor(&per_cu, (const void*)K_ALL, NWAVES * 64, LDS_BYTES) != hipSuccess || per_cu < 1) { fprintf(stderr, "kernel_launch: occupancy query says %d blocks per CU\n", per_cu); }
        (void)hipGetLastError();
        grid = cus;
    }
    if (grid < 0) return;
    (void)hipMemsetAsync((char*)d_ws + WS_CTL, 0, CTL_ZERO_BYTES, stream);
    Args a{};
    for (int i = 0; i < 22; ++i) a.in[i] = (const GAS void*)d_in[i];
    a.out = (GAS float*)d_out; a.ws = (GAS unsigned char*)d_ws;
    const dim3 g(grid), b(NWAVES * 64);
#if MK_PER_PHASE
    for (int ph = 0; ph < N_PHASES; ++ph) { a.ph_lo = ph; a.ph_hi = ph + 1; K_ALL<<<g, b, LDS_BYTES, stream>>>(a); }
#else
    a.ph_lo = 0; a.ph_hi = N_PHASES; K_ALL<<<g, b, LDS_BYTES, stream>>>(a);
#endif
}
```

```cpp
#include <hip/hip_runtime.h>
#include <cstdio>
#include <cstdint>
namespace pg8 {
#define PG8_LAS __attribute__((address_space(3)))
typedef unsigned short bf16_t;
typedef short bf16x8 __attribute__((ext_vector_type(8)));
typedef float f32x4 __attribute__((ext_vector_type(4)));
typedef unsigned u32x4 __attribute__((ext_vector_type(4)));
constexpr int BM = 256, BK = 64, HALF = 128, HTB = HALF * BK * 2  , STAGE_BYTES = 8 * HTB, NXCD = 8, WGM = 8;

__host__ __device__ __forceinline__ int lds_byte(int r, int c) { const int st = (r >> 4) * 2 + (c >> 5), rr = r & 15, cc = c & 31, ob = rr * 64 + cc * 2; return st * 1024 + (ob ^ (((ob >> 9) & 1) << 5)); }
__host__ __device__ __forceinline__ void stage_rc(int b, int& R, int& C) { const int st = b / 1024, sb = b % 1024, swz = sb ^ (((sb >> 9) & 1) << 5); R = (st >> 1) * 16 + swz / 64; C = (st & 1) * 32 + (swz % 64) / 2; }
__host__ __device__ __forceinline__ int perm32(int rho) { const int n = rho >> 4, i = rho & 15; return 8 * (i >> 2) + 4 * n + (i & 3); }

struct Unit { int pm, pn, kofs, kc; };
struct Gemm { const bf16_t* A; const bf16_t* Bt; int M, N, K, ld; };

struct StaticOrder {
    int nM, nN, nwg, G, c;
    __host__ __device__ void init(int M, int N, int G_, int c_) { nM = M / BM; nN = N / BM; nwg = nM * nN; G = G_; c = c_; }
    __host__ __device__ bool next(int i, Unit& u) const {
        const long L = (long)i * G + c; if (L >= nwg) return false;
        int wgid = (int)L; { const int q = nwg / NXCD, r = nwg % NXCD, xcd = wgid % NXCD, off = wgid / NXCD; wgid = (xcd < r ? xcd * (q + 1) : r * (q + 1) + (xcd - r) * q) + off; }
        const int nig = WGM * nN, gid = wgid / nig, fm = gid * WGM, gsz = (nM - fm) < WGM ? (nM - fm) : WGM;
        u.pm = fm + ((wgid % nig) % gsz); u.pn = (wgid % nig) / gsz; u.kofs = 0; u.kc = 0; return true;
    }
    __device__ __forceinline__ void a_ready(const Unit&) const {}
    __device__ __forceinline__ void done(const Unit&) const {}
};

__device__ __forceinline__ unsigned cvt_pk_bf16(float lo, float hi) { unsigned r; asm volatile("v_cvt_pk_bf16_f32 %0, %1, %2" : "=v"(r) : "v"(lo), "v"(hi)); return r; }

struct EpiF32 {
    static constexpr bool PERM = false, AFTER_DRAIN = false;
    float* O; int ldc; const float* RS;
    __device__ __forceinline__ void operator()(const f32x4 (&acc)[2][2][4][2], const Unit& u, int wr, int wc, int fr, int fq) const {
        const int row0 = u.pm * BM + wr * 64 + fr, col0 = u.pn * BM + wc * 32 + 4 * fq;
        float rs[2][4];
#pragma unroll
        for (int ai = 0; ai < 2; ++ai)
#pragma unroll
            for (int m = 0; m < 4; ++m) rs[ai][m] = RS[row0 + ai * HALF + m * 16];
#pragma unroll
        for (int ai = 0; ai < 2; ++ai)
#pragma unroll
            for (int m = 0; m < 4; ++m) { float* rowp = O + (size_t)(row0 + ai * HALF + m * 16) * ldc + col0;
#pragma unroll
                for (int bj = 0; bj < 2; ++bj)
#pragma unroll
                    for (int n = 0; n < 2; ++n) *(f32x4*)(rowp + bj * HALF + n * 16) = acc[ai][bj][m][n] * rs[ai][m]; }
    }
};
struct EpiResid {
    static constexpr bool PERM = false, AFTER_DRAIN = false;
    const void* base; bool base_bf; bf16_t* O; int ldc; float* SS;
    __device__ __forceinline__ void operator()(const f32x4 (&acc)[2][2][4][2], const Unit& u, int wr, int wc, int fr, int fq) const {
        const int row0 = u.pm * BM + wr * 64 + fr, col0 = u.pn * BM + wc * 32 + 4 * fq;
        typedef unsigned u32x2_ __attribute__((ext_vector_type(2)));
#pragma unroll
        for (int ai = 0; ai < 2; ++ai)
#pragma unroll
            for (int m = 0; m < 4; ++m) { const size_t off = (size_t)(row0 + ai * HALF + m * 16) * ldc + col0; float sq = 0.f;
#pragma unroll
                for (int bj = 0; bj < 2; ++bj)
#pragma unroll
                    for (int n = 0; n < 2; ++n) { const size_t o2 = off + bj * HALF + n * 16; f32x4 r;
                        if (base_bf) { const u32x2_ w = *(const u32x2_*)((const bf16_t*)base + o2);
                            r = (f32x4){__builtin_bit_cast(float, w.x << 16), __builtin_bit_cast(float, w.x & 0xffff0000u), __builtin_bit_cast(float, w.y << 16), __builtin_bit_cast(float, w.y & 0xffff0000u)}; }
                        else r = *(const f32x4*)((const float*)base + o2);
                        r += acc[ai][bj][m][n];
                        u32x2_ ow; ow.x = cvt_pk_bf16(r[0], r[1]); ow.y = cvt_pk_bf16(r[2], r[3]); *(u32x2_*)(O + o2) = ow;
                        const float q0 = __builtin_bit_cast(float, ow.x << 16), q1 = __builtin_bit_cast(float, ow.x & 0xffff0000u), q2 = __builtin_bit_cast(float, ow.y << 16), q3 = __builtin_bit_cast(float, ow.y & 0xffff0000u);
                        sq += (q0 * q0 + q1 * q1) + (q2 * q2 + q3 * q3); }
                sq += __shfl_xor(sq, 16); sq += __shfl_xor(sq, 32);
                if (fq == 0) SS[(size_t)(row0 + ai * HALF + m * 16) * 16 + u.pn * 4 + wc] = sq; }
    }
};
struct EpiRelu2 {
    static constexpr bool PERM = true, AFTER_DRAIN = false;
    bf16_t* O; int ldc; const float* RS;
    __device__ __forceinline__ void operator()(const f32x4 (&acc)[2][2][4][2], const Unit& u, int wr, int wc, int fr, int fq) const {
        const int row0 = u.pm * BM + wr * 64 + fr, col0 = u.pn * BM + wc * 32 + 8 * fq;
        float rs[2][4];
#pragma unroll
        for (int ai = 0; ai < 2; ++ai)
#pragma unroll
            for (int m = 0; m < 4; ++m) rs[ai][m] = RS[row0 + ai * HALF + m * 16];
#pragma unroll
        for (int ai = 0; ai < 2; ++ai)
#pragma unroll
            for (int m = 0; m < 4; ++m) { bf16_t* rowp = O + (size_t)(row0 + ai * HALF + m * 16) * ldc + col0;
#pragma unroll
                for (int bj = 0; bj < 2; ++bj) { f32x4 v0 = acc[ai][bj][m][0] * rs[ai][m], v1 = acc[ai][bj][m][1] * rs[ai][m];
#pragma unroll
                    for (int i = 0; i < 4; ++i) { const float a = v0[i] > 0.f ? v0[i] : 0.f, b = v1[i] > 0.f ? v1[i] : 0.f; v0[i] = a * a; v1[i] = b * b; }
                    u32x4 w; w.x = cvt_pk_bf16(v0[0], v0[1]); w.y = cvt_pk_bf16(v0[2], v0[3]); w.z = cvt_pk_bf16(v1[0], v1[1]); w.w = cvt_pk_bf16(v1[2], v1[3]);
                    *(u32x4*)(rowp + bj * HALF) = w; } }
    }
};

struct SplitKOrder {
    int pm0, nN, KS, KL, total, G, c;
    __host__ __device__ void init(int pm0_, int nPm, int nN_, int KS_, int KL_, int G_, int c_) { pm0 = pm0_; nN = nN_; KS = KS_; KL = KL_; total = nPm * nN_ * KS_; G = G_; c = c_; }
    __host__ __device__ bool next(int i, Unit& u) const {
        const long L = (long)i * G + c; if (L >= total) return false;
        const int l = (int)L, kc = l % KS, rest = l / KS; u.pn = rest % nN; u.pm = pm0 + rest / nN; u.kofs = kc * KL; u.kc = kc; return true; }
    __device__ __forceinline__ void a_ready(const Unit&) const {}
    __device__ __forceinline__ void done(const Unit&) const {}
};
struct EpiPart {
    static constexpr bool PERM = false, AFTER_DRAIN = false;
    float* P; int ldc; int row0; int rows;
    __device__ __forceinline__ void operator()(const f32x4 (&acc)[2][2][4][2], const Unit& u, int wr, int wc, int fr, int fq) const {
        const int rowl = u.pm * BM - row0 + wr * 64 + fr, col0 = u.pn * BM + wc * 32 + 4 * fq;
        float* base = P + (size_t)u.kc * rows * ldc;
#pragma unroll
        for (int ai = 0; ai < 2; ++ai)
#pragma unroll
            for (int m = 0; m < 4; ++m) { float* rowp = base + (size_t)(rowl + ai * HALF + m * 16) * ldc + col0;
#pragma unroll
                for (int bj = 0; bj < 2; ++bj)
#pragma unroll
                    for (int n = 0; n < 2; ++n) *(f32x4*)(rowp + bj * HALF + n * 16) = acc[ai][bj][m][n]; }
    }
};
template <class Epi, class Sched, bool ALIGN_EPI = false, bool SP2 = false>
__device__ __forceinline__ void gemm_phase(PG8_LAS unsigned char* lds, const Gemm g, const Sched& S, const Epi& E, int tid_in) {
    int tid = tid_in; asm volatile("" : "+v"(tid));
    const int wid = __builtin_amdgcn_readfirstlane(tid >> 6), lane = tid & 63, wr = wid >> 2, wc = wid & 3, fr = lane & 15, fq = lane >> 4;
    const int K = g.ld, nt = g.K / BK;
    unsigned voffA[2], voffB[2];
#pragma unroll
    for (int i = 0; i < 2; ++i) { int R, C; stage_rc(tid * 16 + i * 8192, R, C); const int Rb = Epi::PERM ? ((R & ~31) + perm32(R & 31)) : R;
        voffA[i] = (unsigned)(R * K + C) * 2u; voffB[i] = (unsigned)(Rb * K + C) * 2u; }
    const size_t kstep = (size_t)(BK * 2);
    const size_t hstep = (size_t)HALF * K * 2;
    const size_t tstep = 2 * hstep;
    const unsigned ldsw = (unsigned)wid * 1024u;
    const int aoff = lds_byte(wr * 64 + fr, fq * 8), boff = lds_byte(wc * 32 + fr, fq * 8);
#define PG8_SA(b, h) (((b) * 2 + (h)) * HTB)
#define PG8_SB(b, h) ((4 + (b) * 2 + (h)) * HTB)
#define PG8_STAGE(bufoff, gbase, voff) do { _Pragma("unroll") for (int _i = 0; _i < 2; ++_i) \
        __builtin_amdgcn_global_load_lds((const unsigned*)((const char*)(gbase) + (voff)[_i]), (PG8_LAS unsigned*)(lds + (bufoff) + ldsw + _i * 8192), 16, 0, 0); } while (0)
#define PG8_LDA(dst, b, h) do { _Pragma("unroll") for (int m = 0; m < 4; ++m) _Pragma("unroll") for (int k = 0; k < 2; ++k) dst[m][k] = *(const PG8_LAS bf16x8*)(lds + PG8_SA(b, h) + aoff + m * 2048 + k * 1024); } while (0)
#define PG8_LDB(dst, b, h) do { _Pragma("unroll") for (int n = 0; n < 2; ++n) _Pragma("unroll") for (int k = 0; k < 2; ++k) dst[n][k] = *(const PG8_LAS bf16x8*)(lds + PG8_SB(b, h) + boff + n * 2048 + k * 1024); } while (0)
#define PG8_MMA(ai, bj, At, Bt) do { __builtin_amdgcn_s_setprio(1); _Pragma("unroll") for (int m = 0; m < 4; ++m) _Pragma("unroll") for (int n = 0; n < 2; ++n) _Pragma("unroll") for (int k = 0; k < 2; ++k) \
        acc[ai][bj][m][n] = __builtin_amdgcn_mfma_f32_16x16x32_bf16(Bt[n][k], At[m][k], acc[ai][bj][m][n], 0, 0, 0); __builtin_amdgcn_s_setprio(0); } while (0)
#define PG8_WAIT_V(n) asm volatile("s_waitcnt vmcnt(" #n ")" ::: "memory")
#define PG8_WAIT_L(n) asm volatile("s_waitcnt lgkmcnt(" #n ")" ::: "memory")
#define PG8_BAR __builtin_amdgcn_s_barrier()
#define PG8_SCHED __builtin_amdgcn_sched_barrier(0)
    Unit cur, nxt; int ui = 0;
    if (!S.next(0, cur)) return;
    f32x4 acc[2][2][4][2];
#pragma unroll
    for (int a = 0; a < 2; ++a)
#pragma unroll
        for (int b = 0; b < 2; ++b)
#pragma unroll
            for (int m = 0; m < 4; ++m)
#pragma unroll
                for (int n = 0; n < 2; ++n) acc[a][b][m][n] = (f32x4){0.f, 0.f, 0.f, 0.f};
    bf16x8 At[4][2], B0[2][2], B1[2][2];
    const char* cA = (const char*)g.A + (size_t)cur.pm * tstep + (size_t)cur.kofs * 2; const char* cB = (const char*)g.Bt + (size_t)cur.pn * tstep + (size_t)cur.kofs * 2;
    S.a_ready(cur);
    if constexpr (SP2) {
        PG8_STAGE(PG8_SB(0, 0), cB, voffB); PG8_STAGE(PG8_SB(0, 1), cB + hstep, voffB); PG8_STAGE(PG8_SA(0, 0), cA, voffA); PG8_STAGE(PG8_SA(0, 1), cA + hstep, voffA);
        if (wr == 1) PG8_BAR;
        PG8_WAIT_V(2); PG8_BAR;
        PG8_STAGE(PG8_SB(1, 0), cB + kstep, voffB); PG8_STAGE(PG8_SA(1, 0), cA + kstep, voffA); PG8_STAGE(PG8_SB(1, 1), cB + hstep + kstep, voffB);
        PG8_WAIT_V(6); PG8_BAR;
    } else {
        PG8_STAGE(PG8_SB(0, 0), cB, voffB); PG8_STAGE(PG8_SA(0, 0), cA, voffA); PG8_STAGE(PG8_SB(0, 1), cB + hstep, voffB); PG8_STAGE(PG8_SA(0, 1), cA + hstep, voffA);
        if (wr == 1) PG8_BAR;
        PG8_WAIT_V(4); PG8_BAR;
        PG8_STAGE(PG8_SB(1, 0), cB + kstep, voffB); PG8_STAGE(PG8_SA(1, 0), cA + kstep, voffA); PG8_STAGE(PG8_SB(1, 1), cB + hstep + kstep, voffB);
        PG8_WAIT_V(6); PG8_BAR;
    }
    for (;;) {
        const bool has_next = S.next(ui + 1, nxt);
        const char* nA = has_next ? (const char*)g.A + (size_t)nxt.pm * tstep + (size_t)nxt.kofs * 2 : cA; const char* nB = has_next ? (const char*)g.Bt + (size_t)nxt.pn * tstep + (size_t)nxt.kofs * 2 : cB;
        for (int t = 0; t < nt; t += 2) {
            const bool last = (t == nt - 2);
            const char* a1 = cA + (size_t)(t + 1) * kstep;
            const char* a2 = last ? nA : cA + (size_t)(t + 2) * kstep; const char* b2 = last ? nB : cB + (size_t)(t + 2) * kstep;
            const char* a3 = a2 + kstep; const char* b3 = b2 + kstep;
            if (last && has_next) S.a_ready(nxt);
            if constexpr (SP2) {
            PG8_LDB(B0, 0, 0); PG8_LDB(B1, 0, 1); PG8_SCHED; PG8_LDA(At, 0, 0); PG8_STAGE(PG8_SA(1, 1), a1 + hstep, voffA);
            PG8_WAIT_V(8); PG8_WAIT_L(0); PG8_BAR; PG8_MMA(0, 0, At, B0); PG8_MMA(0, 1, At, B1); PG8_BAR; PG8_SCHED;
            PG8_LDA(At, 0, 1); PG8_STAGE(PG8_SB(0, 0), b2, voffB); PG8_STAGE(PG8_SB(0, 1), b2 + hstep, voffB); PG8_STAGE(PG8_SA(0, 0), a2, voffA);
            PG8_WAIT_V(8); PG8_WAIT_L(0); PG8_BAR; PG8_MMA(1, 0, At, B0); PG8_MMA(1, 1, At, B1); PG8_BAR; PG8_SCHED;
            PG8_LDB(B0, 1, 0); PG8_LDB(B1, 1, 1); PG8_SCHED; PG8_LDA(At, 1, 0); PG8_STAGE(PG8_SA(0, 1), a2 + hstep, voffA);
            PG8_WAIT_V(8); PG8_WAIT_L(0); PG8_BAR; PG8_MMA(0, 0, At, B0); PG8_MMA(0, 1, At, B1); PG8_BAR; PG8_SCHED;
            PG8_LDA(At, 1, 1); PG8_STAGE(PG8_SB(1, 0), b3, voffB); PG8_STAGE(PG8_SB(1, 1), b3 + hstep, voffB); PG8_STAGE(PG8_SA(1, 0), a3, voffA);
            PG8_WAIT_V(8); PG8_WAIT_L(0); PG8_BAR; PG8_MMA(1, 0, At, B0); PG8_MMA(1, 1, At, B1); PG8_BAR; PG8_SCHED;
            } else {
            PG8_LDB(B0, 0, 0); PG8_SCHED; PG8_LDA(At, 0, 0); PG8_STAGE(PG8_SA(1, 1), a1 + hstep, voffA);
            PG8_WAIT_L(8); PG8_BAR; PG8_WAIT_L(0); PG8_MMA(0, 0, At, B0); PG8_BAR; PG8_SCHED;
            PG8_LDB(B1, 0, 1); PG8_STAGE(PG8_SB(0, 0), b2, voffB);
            PG8_BAR; PG8_WAIT_L(0); PG8_MMA(0, 1, At, B1); PG8_BAR;
            PG8_LDA(At, 0, 1); PG8_STAGE(PG8_SA(0, 0), a2, voffA);
            PG8_BAR; PG8_WAIT_L(0); PG8_MMA(1, 0, At, B0); PG8_BAR; PG8_SCHED;
            PG8_STAGE(PG8_SB(0, 1), b2 + hstep, voffB);
            PG8_WAIT_V(6); PG8_BAR; PG8_MMA(1, 1, At, B1); PG8_BAR;
            PG8_LDB(B0, 1, 0); PG8_SCHED; PG8_LDA(At, 1, 0); PG8_STAGE(PG8_SA(0, 1), a2 + hstep, voffA);
            PG8_WAIT_L(8); PG8_BAR; PG8_WAIT_L(0); PG8_MMA(0, 0, At, B0); PG8_BAR; PG8_SCHED;
            PG8_LDB(B1, 1, 1); PG8_STAGE(PG8_SB(1, 0), b3, voffB);
            PG8_BAR; PG8_WAIT_L(0); PG8_MMA(0, 1, At, B1); PG8_BAR;
            PG8_LDA(At, 1, 1); PG8_STAGE(PG8_SA(1, 0), a3, voffA);
            PG8_BAR; PG8_WAIT_L(0); PG8_MMA(1, 0, At, B0); PG8_BAR; PG8_SCHED;
            PG8_STAGE(PG8_SB(1, 1), b3 + hstep, voffB);
            PG8_WAIT_V(6); PG8_BAR; PG8_MMA(1, 1, At, B1); PG8_BAR;
            }
        }
        if constexpr (ALIGN_EPI) { if (wr == 0) PG8_BAR; }
        if constexpr (!Epi::AFTER_DRAIN) { E(acc, cur, wr, wc, fr, fq); S.done(cur); }
        if (!has_next) break;
#pragma unroll
        for (int a = 0; a < 2; ++a)
#pragma unroll
            for (int b = 0; b < 2; ++b)
#pragma unroll
                for (int m = 0; m < 4; ++m)
#pragma unroll
                    for (int n = 0; n < 2; ++n) acc[a][b][m][n] = (f32x4){0.f, 0.f, 0.f, 0.f};
        cur = nxt; cA = nA; cB = nB; ++ui;
        if constexpr (ALIGN_EPI) { if (wr == 1) PG8_BAR; }
    }
    PG8_WAIT_V(0);
    if constexpr (!ALIGN_EPI) { if (wr == 0) PG8_BAR; }
    PG8_BAR;
    if constexpr (Epi::AFTER_DRAIN) { E.fused(acc, cur, wr, wc, fr, fq, lds, wid, lane); S.done(cur); }
#undef PG8_SA
#undef PG8_SB
#undef PG8_STAGE
#undef PG8_LDA
#undef PG8_LDB
#undef PG8_MMA
#undef PG8_WAIT_V
#undef PG8_WAIT_L
#undef PG8_BAR
#undef PG8_SCHED
}
}

constexpr int DM = 1024, NPB = 4, SEQ = 4096, MP = NPB * SEQ, NSB = 128, DSEQ = 4, MS = NSB * DSEQ, MT = MP + MS;
constexpr int NPROJ = 3368, NP = 3584, DFF = 4096, NL = 2;
constexpr int C_QKV = 0, C_Z = 1536, C_A = 2048, C_BETA = 2056, C_Q = 2064, C_KV = 2576, C_GATE = 3344;
constexpr int PAST = 2048, NPAGES = 16, NPOOL = 2560;
constexpr float C2 = 0.125f * 1.4426950408889634f;
constexpr float NEG_INF = -__builtin_inff();
constexpr size_t O_YP = 0, O_YS = 16777216, O_KVP = 17301504, O_KVS = 34078720, O_WINP = 34603008, O_WINS = 35651584, O_GDNP = 69206016, O_GDNS = 69468160, O_CONVP = 77856768, O_CONVS = 77893632, O_END = 79073280;
constexpr size_t MiB = 1u << 20;
constexpr size_t WS_CTL = 0, CTL_ZERO_BYTES = 1 * MiB;
constexpr size_t WS_WIN = 2 * MiB, WS_WOUT = 16 * MiB, WS_WUP = 20 * MiB, WS_WDN = 36 * MiB, WS_CMPW = 52 * MiB;
constexpr size_t WS_HB = 54 * MiB, WS_PROJ = 88 * MiB, WS_X1 = 320 * MiB, WS_X2 = 386 * MiB, WS_MIX = 452 * MiB, WS_HID = 486 * MiB;
constexpr size_t WS_QN = 618 * MiB, WS_KN = 651 * MiB, WS_VG = 684 * MiB, WS_OG = 717 * MiB, WS_G = 750 * MiB, WS_BETA = 751 * MiB, WS_KQ = 752 * MiB;
constexpr size_t WS_QB = 753 * MiB, WS_KS = 770 * MiB, WS_VS = 775 * MiB, WS_KW = 780 * MiB, WS_VW = 785 * MiB;
constexpr size_t WS_CKP = 790 * MiB, WS_CVP = 791 * MiB, WS_CKS = 792 * MiB, WS_CVS = 796 * MiB;
constexpr size_t WS_GK = 800 * MiB, WS_GQ = 816 * MiB, WS_GKT = 832 * MiB, WS_GVT = 848 * MiB, WS_GG2 = 864 * MiB, WS_BETA2 = 865 * MiB;
constexpr size_t WS_WX = 866 * MiB, WS_QX = 882 * MiB, WS_QKX = 898 * MiB, WS_KTX = 914 * MiB, WS_U0F = 930 * MiB, WS_GL = 962 * MiB, WS_END = 1043 * MiB;
constexpr size_t WS_PARTD = 963 * MiB, WS_PARTG = 979 * MiB;
constexpr size_t WS_SS = 996 * MiB, WS_RS = 998 * MiB;
constexpr int PD_KS = 4, PD_KL = DM / PD_KS, PG_KS = 8, PG_KL = DFF / PG_KS;
constexpr int CW_QUEUE = 64;
constexpr int CW_BAR = 4096;
constexpr int RING_BYTES = 131072, LDS_BYTES = 147456, MISC_OFF = LDS_BYTES - 64;
constexpr int NWAVES = 8;

#define GAS __attribute__((address_space(1)))
#define LAS __attribute__((address_space(3)))
typedef unsigned short bf16;
typedef unsigned v4u __attribute__((ext_vector_type(4)));
typedef unsigned v2u __attribute__((ext_vector_type(2)));
typedef float f32x4 __attribute__((ext_vector_type(4)));
typedef float f32x16 __attribute__((ext_vector_type(16)));
typedef short bf16x8 __attribute__((ext_vector_type(8)));
typedef short s16x4 __attribute__((ext_vector_type(4)));
#define LDS_WAIT() asm volatile("s_waitcnt lgkmcnt(0)" ::: "memory")
__device__ __forceinline__ unsigned f2bf(float f) { unsigned u = __builtin_bit_cast(unsigned, f); return (u + 0x7fffu + ((u >> 16) & 1u)) >> 16; }
typedef float f32x2_t_ __attribute__((ext_vector_type(2))); typedef __bf16 bf16x2_t_ __attribute__((ext_vector_type(2)));
__device__ __forceinline__ unsigned pk2(float lo, float hi) { const f32x2_t_ v = {lo, hi}; const bf16x2_t_ b = __builtin_convertvector(v, bf16x2_t_); return __builtin_bit_cast(unsigned, b); }
__device__ __forceinline__ float bf2f(unsigned short b) { return __builtin_bit_cast(float, (unsigned)b << 16); }
__device__ __forceinline__ bf16x8 pack8(float a0, float a1, float a2, float a3, float a4, float a5, float a6, float a7) {
    v4u w; w.x = pk2(a0, a1); w.y = pk2(a2, a3); w.z = pk2(a4, a5); w.w = pk2(a6, a7); return __builtin_bit_cast(bf16x8, w); }
__device__ __forceinline__ float wave_sum(float v) {
#pragma unroll
    for (int o = 1; o < 64; o <<= 1) v += __shfl_xor(v, o);
    return v;
}
template <int CTRL, int RMASK> __device__ __forceinline__ float dpp_add(float v) {
    const int t = __builtin_amdgcn_update_dpp(0, __builtin_bit_cast(int, v), CTRL, RMASK, 0xf, false);
    return v + __builtin_bit_cast(float, t);
}
__device__ __forceinline__ float dpp_sum(float v) {
    v = dpp_add<0x111, 0xf>(v); v = dpp_add<0x112, 0xf>(v); v = dpp_add<0x114, 0xf>(v); v = dpp_add<0x118, 0xf>(v);
    v = dpp_add<0x142, 0xa>(v); v = dpp_add<0x143, 0xc>(v);
    return __builtin_bit_cast(float, __builtin_amdgcn_readlane(__builtin_bit_cast(int, v), 63));
}
__device__ __forceinline__ float ex2(float x) { return __builtin_amdgcn_exp2f(x); }
__device__ __forceinline__ float sigmoidf_(float x) { return 1.f / (1.f + __expf(-x)); }
__device__ __forceinline__ float siluf_(float x) { return x / (1.f + __expf(-x)); }
__device__ __forceinline__ int crow(int r, int hi) { return (r & 3) + 8 * (r >> 2) + 4 * hi; }
__device__ __forceinline__ void rope_cs(int pos, int d, float& cs, float& sn) {
    const float invf = exp2f(-(float)d * 0.4152410118609203f);
    double rv = (double)pos * (double)invf * 0.15915494309189535; rv -= floor(rv);
    const float rf = (float)rv; sn = __builtin_amdgcn_sinf(rf); cs = __builtin_amdgcn_cosf(rf);
}

#define XB_TMO      128
#define XB_XCNT(j)  (256  + 64 * (j))
#define XB_XSUB(j)  (1280 + 64 * (j))
#define XB_XGEN(j)  (2304 + 64 * (j))
#define XB_TOP      3328
#define XB_TOPGEN   3392
#define XCD_BAR_WORDS 3456
#define XB_SPIN_CAP (1u << 18)

__device__ __forceinline__ unsigned xb_ld(unsigned* p)              { return __hip_atomic_load(p, __ATOMIC_RELAXED, __HIP_MEMORY_SCOPE_AGENT); }
__device__ __forceinline__ unsigned xb_add(unsigned* p, unsigned v) { return __hip_atomic_fetch_add(p, v, __ATOMIC_RELAXED, __HIP_MEMORY_SCOPE_AGENT); }
__device__ __forceinline__ unsigned xb_xcc_id() { return (unsigned)__builtin_amdgcn_s_getreg((3 << 11) | 20) & 0xFu; }
#define XB_SPIN(cond, bar) do { unsigned _sp = 0; while (cond) { __builtin_amdgcn_s_sleep(1); \
    if ((++_sp & 255u) == 0u) { if (xb_ld(&(bar)[XB_TMO])) break; if (_sp > XB_SPIN_CAP) { atomicAdd(&(bar)[XB_TMO], 1u); break; } } } } while (0)

struct XcdBarrier {
    unsigned* bar; unsigned x;
    volatile LAS unsigned* st;
};

__device__ __forceinline__ XcdBarrier xcd_barrier_post(unsigned* bar, volatile LAS unsigned* st, bool leader) {
    XcdBarrier b; b.bar = bar; b.x = xb_xcc_id(); b.st = st;
    if (leader) (void)xb_add(&bar[XB_XCNT(b.x)], 1u);
    return b;
}
__device__ __forceinline__ void xcd_barrier_complete(unsigned* bar, unsigned x, unsigned& nloc, unsigned& nx) {
    const unsigned G = gridDim.x * gridDim.y * gridDim.z;
    unsigned sum, cnt, mine, sp = 0u;
    for (;;) {
        sum = 0u; cnt = 0u; mine = 0u;
#pragma unroll
        for (unsigned j = 0; j < 16; ++j) { const unsigned c = xb_ld(&bar[XB_XCNT(j)]); sum += c; cnt += (c > 0u) ? 1u : 0u; mine = (j == x) ? c : mine; }
        if (sum == G) break;
        __builtin_amdgcn_s_sleep(1);
        if ((++sp & 255u) == 0u) { if (xb_ld(&bar[XB_TMO])) break; if (sp > XB_SPIN_CAP) { atomicAdd(&bar[XB_TMO], 1u); break; } }
    }
    nloc = mine > 0u ? mine : 1u; nx = cnt > 0u ? cnt : 1u;
}

__device__ __forceinline__ void xcd_barrier(const XcdBarrier& b, bool leader) {
    asm volatile("s_waitcnt vmcnt(0)" ::: "memory");
    __syncthreads();
    if (leader) {
        unsigned* bar = b.bar;
        __builtin_amdgcn_s_waitcnt(0);
        unsigned nloc = b.st[0], nx = b.st[1];
        if (nloc == 0u) { xcd_barrier_complete(bar, b.x, nloc, nx); b.st[0] = nloc; b.st[1] = nx; }
        const unsigned old = xb_add(&bar[XB_XSUB(b.x)], 1u);
        const unsigned gen = old / nloc;
        if (old + 1u == (gen + 1u) * nloc) {
            __builtin_amdgcn_fence(__ATOMIC_RELEASE, "agent");
            asm volatile("s_waitcnt vmcnt(0)" ::: "memory");
            const unsigned og = xb_add(&bar[XB_TOP], 1u);
            const unsigned tg = og / nx;
            if (og + 1u == (tg + 1u) * nx) xb_add(&bar[XB_TOPGEN], 1u);
            else XB_SPIN(xb_ld(&bar[XB_TOPGEN]) == tg, bar);
            __builtin_amdgcn_fence(__ATOMIC_ACQUIRE, "agent");
            xb_add(&bar[XB_XGEN(b.x)], 1u);
            asm volatile("s_waitcnt vmcnt(0)" ::: "memory");
        } else {
            XB_SPIN(xb_ld(&bar[XB_XGEN(b.x)]) == gen, bar);
            __builtin_amdgcn_fence(__ATOMIC_ACQUIRE, "agent");
            asm volatile("s_waitcnt vmcnt(0)" ::: "memory");
        }
    }
    __syncthreads();
}

__device__ __forceinline__ void transpose_item(const float* W, int K, int N, int Npad, bf16* WT, LAS float* scr, int item, int lane, const float* gk = nullptr) {
    const int nblk = Npad / 32, kb = item / nblk, nb = item % nblk, k0 = 64 * kb, n0 = 32 * nb;
    const int ncol = n0 + (lane & 31);
    float wv_[32];
#pragma unroll
    for (int i = 0; i < 32; ++i) { const int kk = 2 * i + (lane >> 5); wv_[i] = (ncol < N) ? W[(size_t)(k0 + kk) * N + ncol] : 0.f; }
    __builtin_amdgcn_sched_barrier(0);
#pragma unroll
    for (int i = 0; i < 32; ++i) { const int kk = 2 * i + (lane >> 5); scr[kk * 33 + (lane & 31)] = wv_[i]; }
    LDS_WAIT(); asm volatile("" ::: "memory");
    const int c = lane & 7;
    f32x4 g0 = {1.f, 1.f, 1.f, 1.f}, g1 = g0;
    if (gk) { g0 = *(const f32x4*)(gk + k0 + 8 * c); g1 = *(const f32x4*)(gk + k0 + 8 * c + 4); }
#pragma unroll
    for (int j = 0; j < 4; ++j) { const int n = (lane >> 3) + 8 * j; const LAS float* s = scr + (8 * c) * 33 + n;
        v4u o; o.x = pk2(s[0 * 33] * g0.x, s[1 * 33] * g0.y); o.y = pk2(s[2 * 33] * g0.z, s[3 * 33] * g0.w); o.z = pk2(s[4 * 33] * g1.x, s[5 * 33] * g1.y); o.w = pk2(s[6 * 33] * g1.z, s[7 * 33] * g1.w);
        *(v4u*)(WT + (size_t)(n0 + n) * K + k0 + 8 * c) = o; }
    LDS_WAIT(); asm volatile("" ::: "memory");
}
__device__ __forceinline__ f32x4 ld4x(const void* row, int i, bool bf) {
    if (bf) { const v2u w = ((const v2u*)row)[i]; return (f32x4){bf2f((unsigned short)(w.x & 0xffffu)), bf2f((unsigned short)(w.x >> 16)), bf2f((unsigned short)(w.y & 0xffffu)), bf2f((unsigned short)(w.y >> 16))}; }
    return ((const f32x4*)row)[i]; }
__device__ __forceinline__ void rms_row(const void* xrow, bool bf, const float* g, bf16* orow, float* of32, int lane) {
    f32x4 v[4]; float s = 0.f;
#pragma unroll
    for (int j = 0; j < 4; ++j) { v[j] = ld4x(xrow, 64 * j + lane, bf); s += (v[j].x * v[j].x + v[j].y * v[j].y) + (v[j].z * v[j].z + v[j].w * v[j].w); }
    const float rstd = 1.f / sqrtf(wave_sum(s) * (1.f / DM) + 1e-6f);
#pragma unroll
    for (int j = 0; j < 4; ++j) { const f32x4 gg = ((const f32x4*)g)[64 * j + lane]; const f32x4 o = v[j] * rstd * gg;
        if (of32) ((f32x4*)of32)[64 * j + lane] = o;
        else ((v2u*)orow)[64 * j + lane] = (v2u){pk2(o.x, o.y), pk2(o.z, o.w)}; }
}

__device__ __forceinline__ void rms_row2(const void* xa, const void* xb, bool bf, const float* g, bf16* oa, bf16* ob, float* fa, float* fb, int lane) {
    f32x4 va[4], vb[4];
#pragma unroll
    for (int j = 0; j < 4; ++j) { va[j] = ld4x(xa, 64 * j + lane, bf); vb[j] = ld4x(xb, 64 * j + lane, bf); }
    __builtin_amdgcn_sched_barrier(0);
    float sa = 0.f, sb = 0.f;
#pragma unroll
    for (int j = 0; j < 4; ++j) { sa += (va[j].x * va[j].x + va[j].y * va[j].y) + (va[j].z * va[j].z + va[j].w * va[j].w); sb += (vb[j].x * vb[j].x + vb[j].y * vb[j].y) + (vb[j].z * vb[j].z + vb[j].w * vb[j].w); }
    const float ra = 1.f / sqrtf(wave_sum(sa) * (1.f / DM) + 1e-6f), rb = 1.f / sqrtf(wave_sum(sb) * (1.f / DM) + 1e-6f);
#pragma unroll
    for (int j = 0; j < 4; ++j) { const f32x4 gg = ((const f32x4*)g)[64 * j + lane]; const f32x4 o1 = va[j] * ra * gg, o2 = vb[j] * rb * gg;
        if (fa) { ((f32x4*)fa)[64 * j + lane] = o1; ((f32x4*)fb)[64 * j + lane] = o2; }
        else { ((v2u*)oa)[64 * j + lane] = (v2u){pk2(o1.x, o1.y), pk2(o1.z, o1.w)}; ((v2u*)ob)[64 * j + lane] = (v2u){pk2(o2.x, o2.y), pk2(o2.z, o2.w)}; } }
}
__device__ __forceinline__ void rms_row_parts(const void* base, bool bf, const float* parts, int nparts, size_t part_stride, bf16* xout, const float* g, bf16* orow, float* of32, int lane) {
    f32x4 v[4]; float s = 0.f;
#pragma unroll
    for (int j = 0; j < 4; ++j) v[j] = ld4x(base, 64 * j + lane, bf);
    for (int p = 0; p < nparts; ++p) { const f32x4* pr = (const f32x4*)(parts + (size_t)p * part_stride) + lane;
#pragma unroll
        for (int j = 0; j < 4; ++j) v[j] += pr[64 * j]; }
#pragma unroll
    for (int j = 0; j < 4; ++j) { if (xout) ((v2u*)xout)[64 * j + lane] = (v2u){pk2(v[j].x, v[j].y), pk2(v[j].z, v[j].w)}; s += (v[j].x * v[j].x + v[j].y * v[j].y) + (v[j].z * v[j].z + v[j].w * v[j].w); }
    const float rstd = 1.f / sqrtf(wave_sum(s) * (1.f / DM) + 1e-6f);
#pragma unroll
    for (int j = 0; j < 4; ++j) { const f32x4 gg = ((const f32x4*)g)[64 * j + lane]; const f32x4 o = v[j] * rstd * gg;
        if (of32) ((f32x4*)of32)[64 * j + lane] = o;
        else ((v2u*)orow)[64 * j + lane] = (v2u){pk2(o.x, o.y), pk2(o.z, o.w)}; }
}

__device__ __forceinline__ void resid_parts_row(const void* base, bool bf, const float* parts, int nparts, size_t part_stride, bf16* xout, float* rs, int lane) {
    f32x4 v[4]; float s = 0.f;
#pragma unroll
    for (int j = 0; j < 4; ++j) v[j] = ld4x(base, 64 * j + lane, bf);
    for (int p = 0; p < nparts; ++p) { const f32x4* pr = (const f32x4*)(parts + (size_t)p * part_stride) + lane;
#pragma unroll
        for (int j = 0; j < 4; ++j) v[j] += pr[64 * j]; }
#pragma unroll
    for (int j = 0; j < 4; ++j) { const unsigned w0 = pk2(v[j].x, v[j].y), w1 = pk2(v[j].z, v[j].w); ((v2u*)xout)[64 * j + lane] = (v2u){w0, w1};
        const float q0 = bf2f((unsigned short)(w0 & 0xffffu)), q1 = bf2f((unsigned short)(w0 >> 16)), q2 = bf2f((unsigned short)(w1 & 0xffffu)), q3 = bf2f((unsigned short)(w1 >> 16));
        s += (q0 * q0 + q1 * q1) + (q2 * q2 + q3 * q3); }
    const float tot = wave_sum(s);
    if (lane == 0) *rs = 1.f / sqrtf(tot * (1.f / DM) + 1e-6f);
}
__device__ __forceinline__ void rs_from_parts(const float* SS, float* RS, int m) {
    const f32x4* p = (const f32x4*)(SS + (size_t)m * 16); const f32x4 a = p[0], b = p[1], c = p[2], d = p[3];
    const float s = ((a.x + a.y) + (a.z + a.w)) + ((b.x + b.y) + (b.z + b.w)) + ((c.x + c.y) + (c.z + c.w)) + ((d.x + d.y) + (d.z + d.w));
    RS[m] = 1.f / sqrtf(s * (1.f / DM) + 1e-6f);
}

struct PBArgs { const float* PROJ; const float* state_conv; const float* conv_w; const float* a_log; const float* dt_bias;
    float* QN; float* KN; float* VG; float* G; float* BETA; float* KQ; bf16* QB; bf16* KS; bf16* VS; bf16* KW; bf16* VW; float* out; int l; };
struct PBRegs { float qs_[8], qo_[8], kvs_[12], kvo_[12]; };
__device__ __forceinline__ void pb_row_load(const PBArgs& A, int m, int lane, PBRegs& R) {
    const float* pr = A.PROJ + (size_t)m * NP;
#pragma unroll
    for (int h = 0; h < 8; ++h) { R.qs_[h] = pr[C_Q + h * 64 + lane]; R.qo_[h] = pr[C_Q + h * 64 + (lane ^ 32)]; }
#pragma unroll
    for (int i = 0; i < 12; ++i) { R.kvs_[i] = pr[C_KV + i * 64 + lane]; R.kvo_[i] = pr[C_KV + i * 64 + (lane ^ 32)]; }
}
__device__ __forceinline__ void pb_row(const PBArgs& A, int m, int lane, const PBRegs& R) {
    const bool is_s = m >= MP; int b, t;
    if (!is_s) { b = m >> 12; t = m & 4095; } else { b = (m - MP) >> 2; t = (m - MP) & 3; }
    const int pos = is_s ? PAST + t : t, l = A.l;
    const float* pr = A.PROJ + (size_t)m * NP;
    const float* cw = A.conv_w + (size_t)l * 4 * 1536;
    const float* cb = A.state_conv + ((size_t)l * NSB + b) * 3 * 1536;
    if (!is_s && t >= SEQ - 3) { float* o = A.out + O_CONVP + ((size_t)(l * NPB + b) * 3 + (t - (SEQ - 3))) * 1536;
#pragma unroll 4
        for (int j = 0; j < 24; ++j) o[64 * j + lane] = pr[64 * j + lane]; }
    if (is_s && t >= 1) { float* o = A.out + O_CONVS + ((size_t)(l * NSB + b) * 3 + (t - 1)) * 1536;
#pragma unroll 4
        for (int j = 0; j < 24; ++j) o[64 * j + lane] = pr[64 * j + lane]; }
    const int half = lane >> 5; float cs, sn; rope_cs(pos, lane & 31, cs, sn);
    const float (&qs_)[8] = R.qs_; const float (&qo_)[8] = R.qo_; const float (&kvs_)[12] = R.kvs_; const float (&kvo_)[12] = R.kvo_;
#pragma unroll
    for (int h = 0; h < 8; ++h) { const float xs = qs_[h], xo = qo_[h];
        const float r = half ? (xs * cs + xo * sn) : (xs * cs - xo * sn);
        A.QB[(size_t)m * 512 + h * 64 + lane] = (bf16)f2bf(r * C2); }
#pragma unroll
    for (int s6 = 0; s6 < 6; ++s6)
#pragma unroll
        for (int kvh = 0; kvh < 2; ++kvh) {
            float v = kvs_[s6 * 2 + kvh];
            if (s6 == 2 || s6 == 4) { const float xo = kvo_[s6 * 2 + kvh]; v = half ? (v * cs + xo * sn) : (v * cs - xo * sn); }
            if (s6 < 4) {
                if (!is_s) A.out[O_KVP + ((((size_t)(l * NPB + b) * 2 + kvh) * SEQ + t) * 4 + s6) * 64 + lane] = v;
                else       A.out[O_KVS + ((((size_t)(l * NSB + b) * 2 + kvh) * DSEQ + t) * 4 + s6) * 64 + lane] = v;
            } else {
                const int idx = s6 - 4;
                if (!is_s) { if (t >= SEQ - 512) A.out[O_WINP + ((((size_t)(l * NPB + b) * 512 + (t - (SEQ - 512))) * 2 + idx) * 2 + kvh) * 64 + lane] = v; }
                else A.out[O_WINS + ((((size_t)(l * NSB + b) * 512 + (508 + t)) * 2 + idx) * 2 + kvh) * 64 + lane] = v;
            }
            const bf16 bv = (bf16)f2bf(v);
            if (s6 == 2) A.KS[(size_t)m * 128 + kvh * 64 + lane] = bv;
            if (s6 == 3) A.VS[(size_t)m * 128 + kvh * 64 + lane] = bv;
            if (s6 == 4) A.KW[(size_t)m * 128 + kvh * 64 + lane] = bv;
            if (s6 == 5) A.VW[(size_t)m * 128 + kvh * 64 + lane] = bv;
        }
}

__device__ __forceinline__ void pb_sample_head(const PBArgs& A, int u, int lane) {
    const int m = MP + (u >> 3), h = u & 7, b = (m - MP) >> 2, t = (m - MP) & 3, l = A.l;
    const float* pr = A.PROJ + (size_t)m * NP;
    const float* cw = A.conv_w + (size_t)l * 4 * 1536;
    const float* cb = A.state_conv + ((size_t)l * NSB + b) * 3 * 1536;
    float xv[3][4], wv[3][4];
#pragma unroll
    for (int part = 0; part < 3; ++part) { const int c = (part * 8 + h) * 64 + lane;
#pragma unroll
        for (int tap = 0; tap < 4; ++tap) { const int idx = t + tap;
            xv[part][tap] = (idx >= 3) ? A.PROJ[(size_t)(m - t + idx - 3) * NP + c] : cb[idx * 1536 + c];
            wv[part][tap] = cw[tap * 1536 + c]; } }
    __builtin_amdgcn_sched_barrier(0);
    float qkv[3];
#pragma unroll
    for (int part = 0; part < 3; ++part) qkv[part] = siluf_((xv[part][0] * wv[part][0] + xv[part][1] * wv[part][1]) + (xv[part][2] * wv[part][2] + xv[part][3] * wv[part][3]));
    const float q = qkv[0], k = qkv[1];
    const float qs = dpp_sum(q * q), ks = dpp_sum(k * k);
    const float qn = q * (1.f / sqrtf(qs + 1e-6f)) * 0.125f, kn = k * (1.f / sqrtf(ks + 1e-6f));
    const float kq = dpp_sum(qn * kn);
    A.QN[(size_t)m * 512 + h * 64 + lane] = qn; A.KN[(size_t)m * 512 + h * 64 + lane] = kn; A.VG[(size_t)m * 512 + h * 64 + lane] = qkv[2];
    if (lane == 0) A.KQ[(size_t)m * 8 + h] = kq;
    if (h == 0 && lane < 8) {
        const float a = pr[C_A + lane] + A.dt_bias[l * 8 + lane];
        const float sp = fmaxf(a, 0.f) + log1pf(__expf(-fabsf(a)));
        A.G[(size_t)m * 8 + lane] = -__expf(A.a_log[l * 8 + lane]) * sp;
        A.BETA[(size_t)m * 8 + lane] = sigmoidf_(pr[C_BETA + lane]); }
}

struct CmpArgs { const float* PROJ; const float* cache; const int* page_table; const float* pe_k; const float* pe_v; const bf16* CMPW; unsigned char* ws; int l; };
__device__ __forceinline__ void compress_batch(const CmpArgs& A, unsigned char* lds, int batch, bool is_s, int tid) {
    const int lane = tid & 63, wave = __builtin_amdgcn_readfirstlane(tid >> 6), fr = lane & 15, fq = lane >> 4, l = A.l;
    const int kv = batch & 1, ru = (batch >> 1) * 8 + wave;
    const int rho = 16 * ru + fr, NC = is_s ? 64 : 128;
    const int seq = rho / (2 * NC), n = (rho >> 1) % NC, kvh = rho & 1;
    const float* abase; size_t astride;
    if (!is_s) { abase = A.PROJ + (size_t)(seq * SEQ + 32 * n) * NP + C_KV + kv * 128 + kvh * 64; astride = NP; }
    else { const int page = A.page_table[seq * NPAGES + (n >> 2)];
        abase = A.cache + ((((size_t)l * NPOOL + page) * 2 + kvh) * 128 + (n & 3) * 32) * 256 + kv * 64; astride = 256; }
    const float* pe = (kv ? A.pe_v : A.pe_k) + (size_t)l * 2048;
    const bf16* Wt = A.CMPW + (size_t)((l * 2 + kv) * 64) * 2048;
    const int we = tid >> 3, wch = tid & 7;
    f32x4 acc[4];
#pragma unroll
    for (int et = 0; et < 4; ++et) acc[et] = (f32x4){0.f, 0.f, 0.f, 0.f};
    f32x4 sa[2][4], sp[2][4]; v4u wreg;
#define CB_LOADA(S, c) do { _Pragma("unroll") for (int ks = 0; ks < 2; ++ks) { const float* ap = abase + (size_t)(c) * astride + 32 * ks + 8 * fq; const float* pp = pe + (c) * 64 + 32 * ks + 8 * fq; \
        sa[S][2 * ks] = *(const f32x4*)ap; sa[S][2 * ks + 1] = *(const f32x4*)(ap + 4); sp[S][2 * ks] = *(const f32x4*)pp; sp[S][2 * ks + 1] = *(const f32x4*)(pp + 4); } } while (0)
#define CB_LOADW(c) do { wreg = *(const v4u*)(Wt + (size_t)we * 2048 + ((c) < 31 ? (c) : 31) * 64 + wch * 8); } while (0)
#define CB_STOREW(bufi) do { *(v4u*)(lds + (bufi) * 9216 + we * 144 + wch * 16) = wreg; } while (0)
#define CB_MMA(S, bufi) do { _Pragma("unroll") for (int ks = 0; ks < 2; ++ks) { const f32x4 a0 = sa[S][2 * ks] + sp[S][2 * ks], a1 = sa[S][2 * ks + 1] + sp[S][2 * ks + 1]; \
        const bf16x8 ya = pack8(a0.x, a0.y, a0.z, a0.w, a1.x, a1.y, a1.z, a1.w); \
        _Pragma("unroll") for (int et = 0; et < 4; ++et) { const bf16x8 wf_ = *(const bf16x8*)(lds + (bufi) * 9216 + (16 * et + fr) * 144 + (32 * ks + 8 * fq) * 2); \
            acc[et] = __builtin_amdgcn_mfma_f32_16x16x32_bf16(wf_, ya, acc[et], 0, 0, 0); } } } while (0)
    __syncthreads();
    CB_LOADW(0); CB_LOADA(0, 0);
    CB_STOREW(0); CB_LOADW(1);
    __syncthreads();
#pragma unroll 1
    for (int c = 0; c < 32; c += 2) {
        CB_STOREW(1); __builtin_amdgcn_sched_barrier(0); CB_LOADW(c + 2); CB_LOADA(1, c + 1); __builtin_amdgcn_sched_barrier(0);
        CB_MMA(0, 0); __builtin_amdgcn_sched_barrier(0);
        __syncthreads();
        CB_STOREW(0); __builtin_amdgcn_sched_barrier(0); CB_LOADW(c + 3); if (c + 2 < 32) { CB_LOADA(0, c + 2); } __builtin_amdgcn_sched_barrier(0);
        CB_MMA(1, 1); __builtin_amdgcn_sched_barrier(0);
        __syncthreads();
    }
#undef CB_LOADA
#undef CB_LOADW
#undef CB_STOREW
#undef CB_MMA
    if (kv == 0) { const int pos = 32 * n + 31;
#pragma unroll
        for (int et = 0; et < 2; ++et)
#pragma unroll
            for (int i = 0; i < 4; ++i) { float cs, sn; rope_cs(pos, 16 * et + 4 * fq + i, cs, sn);
                const float x1 = acc[et][i], x2 = acc[et + 2][i]; acc[et][i] = x1 * cs - x2 * sn; acc[et + 2][i] = x2 * cs + x1 * sn; } }
    float* ob = (float*)(A.ws + (is_s ? WS_CKS : WS_CKP) + (size_t)kv * (is_s ? (WS_CVS - WS_CKS) : (WS_CVP - WS_CKP))) + (size_t)rho * 64 + 4 * fq;
#pragma unroll
    for (int et = 0; et < 4; ++et) *(f32x4*)(ob + 16 * et) = acc[et];
}

struct GdnArgs { const float* QN; const float* KN; const float* VG; const float* G; const float* BETA; const float* KQ; float* OG; const float* PROJ; const float* state_gdn; const float* gdn_norm; bf16* MIX; float* out; int l; };
__device__ __forceinline__ void gdn_sample_unit(const GdnArgs& A, int unit, int lane) {
    const int sb = unit >> 3, h = unit & 7, l = A.l;
    const float* sp = A.state_gdn + (((size_t)l * NSB + sb) * 8 + h) * 4096;
    float S[64];
#pragma unroll
    for (int d = 0; d < 64; ++d) S[d] = sp[d * 64 + lane];
    const float gn = A.gdn_norm[l * 64 + lane];
    for (int i = 0; i < DSEQ; ++i) {
        const size_t m = (size_t)MP + sb * 4 + i;
        const float kd = A.KN[m * 512 + h * 64 + lane], qd = A.QN[m * 512 + h * 64 + lane], v = A.VG[m * 512 + h * 64 + lane];
        const float g = A.G[m * 8 + h], beta = A.BETA[m * 8 + h], kq = A.KQ[m * 8 + h];
        const int kdb = __builtin_bit_cast(int, kd), qdb = __builtin_bit_cast(int, qd);
        const float a = __expf(g); float r1 = 0.f, r2 = 0.f;
#pragma unroll
        for (int d = 0; d < 64; ++d) { const float kk = __builtin_bit_cast(float, __builtin_amdgcn_readlane(kdb, d)), qq = __builtin_bit_cast(float, __builtin_amdgcn_readlane(qdb, d)); r1 += S[d] * kk; r2 += S[d] * qq; }
        const float u = beta * (v - a * r1), o = a * r2 + u * kq;
#pragma unroll
        for (int d = 0; d < 64; ++d) { const float kk = __builtin_bit_cast(float, __builtin_amdgcn_readlane(kdb, d)); S[d] = a * S[d] + kk * u; }
        const float ms = wave_sum(o * o) * (1.f / 64.f);
        const float z = A.PROJ[m * NP + C_Z + h * 64 + lane];
        A.MIX[m * 1024 + h * 64 + lane] = (bf16)f2bf(o * (1.f / sqrtf(ms + 1e-6f)) * gn * siluf_(z));
    }
    float* so = A.out + O_GDNS + (((size_t)l * NSB + sb) * 8 + h) * 4096;
#pragma unroll
    for (int d = 0; d < 64; ++d) so[d * 64 + lane] = S[d];
}


__device__ __forceinline__ int perm_inv32(int p) { return (p & 32) + 16 * ((p >> 2) & 1) + 4 * ((p >> 3) & 3) + (p & 3); }
struct GPArgs { const float* PROJ; const float* conv_w; const float* a_log; const float* dt_bias; bf16* GK; bf16* GQ; bf16* GKT; bf16* GVT; float* GG2; float* BETA2; int l; };
struct GPRegs { float xx[3][11], ww[3][4]; };
__device__ __forceinline__ void gdn_prep_load(const GPArgs& A, int unit, int lane, GPRegs& R) {
    const int tg = unit >> 3, h = unit & 7, m0 = tg * 8, t0 = m0 & 4095;
    const float* cw = A.conv_w + (size_t)A.l * 4 * 1536;
#pragma unroll
    for (int part = 0; part < 3; ++part) { const int c = (part * 8 + h) * 64 + lane;
#pragma unroll
        for (int j = 0; j < 11; ++j) R.xx[part][j] = (t0 - 3 + j >= 0) ? A.PROJ[(size_t)(m0 - 3 + j) * NP + c] : 0.f;
#pragma unroll
        for (int k = 0; k < 4; ++k) R.ww[part][k] = cw[k * 1536 + c]; }
}
__device__ __forceinline__ void gdn_prep_unit(const GPArgs& A, int unit, int lane, const GPRegs& R) {
    const int tg = unit >> 3, h = unit & 7, m0 = tg * 8, b = m0 >> 12, t0 = m0 & 4095, l = A.l, bh = b * 8 + h;
    const float* cw = A.conv_w + (size_t)l * 4 * 1536;
    float val[3][8]; const float (&xx)[3][11] = R.xx; const float (&ww)[3][4] = R.ww;
#pragma unroll
    for (int part = 0; part < 3; ++part)
#pragma unroll
        for (int i = 0; i < 8; ++i) val[part][i] = siluf_(ww[part][0] * xx[part][i] + ww[part][1] * xx[part][i + 1] + ww[part][2] * xx[part][i + 2] + ww[part][3] * xx[part][i + 3]);
#pragma unroll
    for (int i = 0; i < 8; ++i) { const float q = val[0][i], k = val[1][i];
        const float qs = dpp_sum(q * q), ks = dpp_sum(k * k);
        val[0][i] = q * (1.f / sqrtf(qs + 1e-6f)) * 0.125f; val[1][i] = k * (1.f / sqrtf(ks + 1e-6f)); }
#pragma unroll
    for (int i = 0; i < 8; ++i) { A.GQ[((size_t)bh * 4096 + t0 + i) * 64 + lane] = (bf16)f2bf(val[0][i]); A.GK[((size_t)bh * 4096 + t0 + i) * 64 + lane] = (bf16)f2bf(val[1][i]); }
    *(v4u*)(A.GKT + ((size_t)bh * 64 + lane) * 4096 + t0) = (v4u){pk2(val[1][0], val[1][1]), pk2(val[1][2], val[1][3]), pk2(val[1][4], val[1][5]), pk2(val[1][6], val[1][7])};
    *(v4u*)(A.GVT + ((size_t)bh * 64 + lane) * 4096 + t0) = (v4u){pk2(val[2][0], val[2][1]), pk2(val[2][2], val[2][3]), pk2(val[2][4], val[2][5]), pk2(val[2][6], val[2][7])};
    if (lane < 8) { const float* pr = A.PROJ + (size_t)(m0 + lane) * NP;
        const float a = pr[C_A + h] + A.dt_bias[l * 8 + h];
        const float sp = fmaxf(a, 0.f) + log1pf(__expf(-fabsf(a)));
        A.GG2[(size_t)bh * 4096 + t0 + lane] = -__expf(A.a_log[l * 8 + h]) * sp;
        A.BETA2[(size_t)bh * 4096 + t0 + lane] = sigmoidf_(pr[C_BETA + h]); }
}
template <int I> __device__ __forceinline__ void fsub_row(float (&T)[64], const float* AL, int lane) {
    float tv = (lane == I) ? 1.f : 0.f;
#pragma unroll
    for (int j4 = 0; j4 < (I + 3) / 4; ++j4) { const f32x4 a = *(const f32x4*)(AL + I * 64 + 4 * j4);
#pragma unroll
        for (int e = 0; e < 4; ++e) if (4 * j4 + e < I) tv -= a[e] * T[4 * j4 + e]; }
    T[I] = tv;
}
template <int I> struct FSub { static __device__ __forceinline__ void run(float (&T)[64], const float* AL, int lane) { FSub<I - 1>::run(T, AL, lane); fsub_row<I>(T, AL, lane); } };
template <> struct FSub<-1> { static __device__ __forceinline__ void run(float (&)[64], const float*, int) {} };
struct GCArgs { const bf16* GK; const bf16* GQ; const bf16* GKT; const bf16* GVT; const float* GG2; const float* BETA2; bf16* WX; bf16* QX; bf16* QKX; bf16* KTX; float* U0F; float* GL; };
constexpr int GC_LDS_PER_WAVE = 17664;
__device__ __forceinline__ void gdn_chunk_unit(const GCArgs& A, unsigned char* wl, int unit, int lane_) {
    int lane = lane_; asm volatile("" : "+v"(lane));
    const int bh = unit >> 6, n = unit & 63, t0 = 64 * n, fr = lane & 15, fq = lane >> 4;
    float* AL = (float*)wl; float* SC = (float*)(wl + 16384);
    {   const float g = A.GG2[(size_t)bh * 4096 + t0 + lane], beta = A.BETA2[(size_t)bh * 4096 + t0 + lane];
        float gc = g;
        gc = dpp_add<0x111, 0xf>(gc); gc = dpp_add<0x112, 0xf>(gc); gc = dpp_add<0x114, 0xf>(gc); gc = dpp_add<0x118, 0xf>(gc); gc = dpp_add<0x142, 0xa>(gc); gc = dpp_add<0x143, 0xc>(gc);
        const float glast = __builtin_bit_cast(float, __builtin_amdgcn_readlane(__builtin_bit_cast(int, gc), 63));
        const float eg = __expf(gc);
        SC[lane] = gc; SC[64 + lane] = beta; SC[128 + lane] = beta * eg; SC[192 + lane] = eg; SC[256 + lane] = __expf(glast - gc);
        if (lane == 0) A.GL[unit] = __expf(glast); }
    LDS_WAIT(); asm volatile("" ::: "memory");
    {
        bf16x8 kf[4][2];
#pragma unroll
        for (int t4 = 0; t4 < 4; ++t4)
#pragma unroll
            for (int ks = 0; ks < 2; ++ks) kf[t4][ks] = *(const bf16x8*)(A.GK + ((size_t)bh * 4096 + t0 + 16 * t4 + fr) * 64 + 32 * ks + 8 * fq);
        __builtin_amdgcn_sched_barrier(0);
#pragma unroll
        for (int ti = 0; ti < 4; ++ti) { const f32x4 gi = *(const f32x4*)(SC + 16 * ti + 4 * fq), bi = *(const f32x4*)(SC + 64 + 16 * ti + 4 * fq);
#pragma unroll
            for (int tj = 0; tj < 4; ++tj) if (tj <= ti) { f32x4 acc = {0.f, 0.f, 0.f, 0.f};
                acc = __builtin_amdgcn_mfma_f32_16x16x32_bf16(kf[ti][0], kf[tj][0], acc, 0, 0, 0); acc = __builtin_amdgcn_mfma_f32_16x16x32_bf16(kf[ti][1], kf[tj][1], acc, 0, 0, 0);
                const float gj = SC[16 * tj + fr];
#pragma unroll
                for (int i = 0; i < 4; ++i) AL[(16 * ti + 4 * fq + i) * 64 + 16 * tj + fr] = bi[i] * acc[i] * __expf(fminf(gi[i] - gj, 0.f)); } }
    }
    LDS_WAIT(); asm volatile("" ::: "memory");
    {
        float T[64];
        FSub<63>::run(T, AL, lane);
        LDS_WAIT(); asm volatile("" ::: "memory");
        unsigned short* TB = (unsigned short*)wl;
#pragma unroll
        for (int i = 0; i < 64; ++i) TB[i * 72 + lane] = (unsigned short)f2bf(T[i]);
    }
    LDS_WAIT(); asm volatile("" ::: "memory");
    {
        bf16x8 tf[4][2];
#pragma unroll
        for (int ti = 0; ti < 4; ++ti)
#pragma unroll
            for (int ks = 0; ks < 2; ++ks) tf[ti][ks] = *(const bf16x8*)(wl + ((16 * ti + fr) * 72 + 32 * ks + 8 * fq) * 2);
#pragma unroll
        for (int which = 0; which < 2; ++which) { const bf16* src = which ? A.GVT : A.GKT; const float* sc = SC + (which ? 64 : 128);
            bf16x8 raws[4][2];
#pragma unroll
            for (int tn = 0; tn < 4; ++tn)
#pragma unroll
                for (int ks = 0; ks < 2; ++ks) raws[tn][ks] = *(const bf16x8*)(src + ((size_t)bh * 64 + 16 * tn + fr) * 4096 + t0 + 32 * ks + 8 * fq);
            __builtin_amdgcn_sched_barrier(0);
#pragma unroll
            for (int tn = 0; tn < 4; ++tn) { bf16x8 yb[2];
#pragma unroll
                for (int ks = 0; ks < 2; ++ks) { const bf16x8 raw = raws[tn][ks];
                    const f32x4 s0 = *(const f32x4*)(sc + 32 * ks + 8 * fq), s1 = *(const f32x4*)(sc + 32 * ks + 8 * fq + 4);
                    yb[ks] = pack8(bf2f((unsigned short)raw[0]) * s0.x, bf2f((unsigned short)raw[1]) * s0.y, bf2f((unsigned short)raw[2]) * s0.z, bf2f((unsigned short)raw[3]) * s0.w,
                                   bf2f((unsigned short)raw[4]) * s1.x, bf2f((unsigned short)raw[5]) * s1.y, bf2f((unsigned short)raw[6]) * s1.z, bf2f((unsigned short)raw[7]) * s1.w); }
#pragma unroll
                for (int ti = 0; ti < 4; ++ti) { f32x4 acc = {0.f, 0.f, 0.f, 0.f};
                    acc = __builtin_amdgcn_mfma_f32_16x16x32_bf16(tf[ti][0], yb[0], acc, 0, 0, 0);
                    if (ti >= 2) acc = __builtin_amdgcn_mfma_f32_16x16x32_bf16(tf[ti][1], yb[1], acc, 0, 0, 0);
                    if (which == 0) { const int p = 32 * (tn >> 1) + 8 * (fr >> 2) + 4 * (tn & 1) + (fr & 3);
#pragma unroll
                        for (int i = 0; i < 4; ++i) A.WX[((size_t)unit * 64 + 16 * ti + 4 * fq + i) * 64 + p] = (bf16)f2bf(acc[i]); }
                    else *(f32x4*)(A.U0F + (((size_t)unit * 16 + ti * 4 + tn) * 64 + lane) * 4) = acc; } } }
    }
    {
        bf16x8 kf[4][2], qf[4][2];
#pragma unroll
        for (int t4 = 0; t4 < 4; ++t4)
#pragma unroll
            for (int ks = 0; ks < 2; ++ks) { kf[t4][ks] = *(const bf16x8*)(A.GK + ((size_t)bh * 4096 + t0 + 16 * t4 + fr) * 64 + 32 * ks + 8 * fq);
                qf[t4][ks] = *(const bf16x8*)(A.GQ + ((size_t)bh * 4096 + t0 + 16 * t4 + fr) * 64 + 32 * ks + 8 * fq); }
        __builtin_amdgcn_sched_barrier(0);
#pragma unroll
        for (int ti = 0; ti < 4; ++ti) { const f32x4 gi = *(const f32x4*)(SC + 16 * ti + 4 * fq);
#pragma unroll
            for (int tj = 0; tj < 4; ++tj) { f32x4 acc = {0.f, 0.f, 0.f, 0.f};
                if (tj <= ti) { acc = __builtin_amdgcn_mfma_f32_16x16x32_bf16(qf[ti][0], kf[tj][0], acc, 0, 0, 0); acc = __builtin_amdgcn_mfma_f32_16x16x32_bf16(qf[ti][1], kf[tj][1], acc, 0, 0, 0); }
                const float gj = SC[16 * tj + fr]; const int p = 32 * (tj >> 1) + 8 * (fr >> 2) + 4 * (tj & 1) + (fr & 3);
#pragma unroll
                for (int i = 0; i < 4; ++i) { const int ri = 16 * ti + 4 * fq + i, cj = 16 * tj + fr;
                    const float v = (tj <= ti && ri >= cj) ? acc[i] * __expf(fminf(gi[i] - gj, 0.f)) : 0.f;
                    A.QKX[((size_t)unit * 64 + ri) * 64 + p] = (bf16)f2bf(v); } } }
    }
    {
        const int lg = perm_inv32(lane);
        const float ek = SC[256 + lg];
#pragma unroll 1
        for (int r0 = 0; r0 < 64; r0 += 16) { bf16 qv[16], kv[16];
#pragma unroll
            for (int i = 0; i < 16; ++i) { qv[i] = A.GQ[((size_t)bh * 4096 + t0 + r0 + i) * 64 + lg]; kv[i] = A.GKT[((size_t)bh * 64 + r0 + i) * 4096 + t0 + lg]; }
            __builtin_amdgcn_sched_barrier(0);
#pragma unroll
            for (int i = 0; i < 16; ++i) { A.QX[((size_t)unit * 64 + r0 + i) * 64 + lane] = (bf16)f2bf(bf2f(qv[i]) * SC[192 + r0 + i]);
                A.KTX[((size_t)unit * 64 + r0 + i) * 64 + lane] = (bf16)f2bf(bf2f(kv[i]) * ek); } }
    }
    LDS_WAIT(); asm volatile("" ::: "memory");
}
struct GS2Args { const bf16* WX; const bf16* QX; const bf16* QKX; const bf16* KTX; const float* U0F; const float* GL; float* OG; float* out; int l; };
__device__ __forceinline__ void gdn_scan2_wave(const GS2Args& A, int bh, int te, int lane) {
    const int fr = lane & 15, fq = lane >> 4, b = bh >> 3, h = bh & 7;
    f32x4 s[4]; bf16x8 sfr[2];
#pragma unroll
    for (int i = 0; i < 4; ++i) s[i] = (f32x4){0.f, 0.f, 0.f, 0.f};
    sfr[0] = (bf16x8){0, 0, 0, 0, 0, 0, 0, 0}; sfr[1] = sfr[0];
    f32x4 u[4]; bf16x8 wf[4][2], kt[4][2], qx[4][2], qkx[4][2]; float dec;
#define GS_LD_UW(nn) do { const size_t un_ = (size_t)bh * 64 + (nn); _Pragma("unroll") for (int tc = 0; tc < 4; ++tc) { u[tc] = *(const f32x4*)(A.U0F + ((un_ * 16 + tc * 4 + te) * 64 + lane) * 4); \
        _Pragma("unroll") for (int ks = 0; ks < 2; ++ks) wf[tc][ks] = *(const bf16x8*)(A.WX + (un_ * 64 + 16 * tc + fr) * 64 + 32 * ks + 8 * fq); } } while (0)
#define GS_LD_Q(nn) do { const size_t un_ = (size_t)bh * 64 + (nn); _Pragma("unroll") for (int tc = 0; tc < 4; ++tc) _Pragma("unroll") for (int ks = 0; ks < 2; ++ks) { \
        qx[tc][ks] = *(const bf16x8*)(A.QX + (un_ * 64 + 16 * tc + fr) * 64 + 32 * ks + 8 * fq); qkx[tc][ks] = *(const bf16x8*)(A.QKX + (un_ * 64 + 16 * tc + fr) * 64 + 32 * ks + 8 * fq); } } while (0)
#define GS_LD_K(nn) do { const size_t un_ = (size_t)bh * 64 + (nn); dec = A.GL[un_]; _Pragma("unroll") for (int tc = 0; tc < 4; ++tc) _Pragma("unroll") for (int ks = 0; ks < 2; ++ks) \
        kt[tc][ks] = *(const bf16x8*)(A.KTX + (un_ * 64 + 16 * tc + fr) * 64 + 32 * ks + 8 * fq); } while (0)
    GS_LD_UW(0); GS_LD_Q(0); GS_LD_K(0);
    __builtin_amdgcn_sched_barrier(0);
#pragma unroll 1
    for (int n = 0; n < 64; ++n) {
        const int nn = n < 63 ? n + 1 : 63;
#pragma unroll
        for (int tc = 0; tc < 4; ++tc) { f32x4 acc = {0.f, 0.f, 0.f, 0.f};
            acc = __builtin_amdgcn_mfma_f32_16x16x32_bf16(wf[tc][0], sfr[0], acc, 0, 0, 0); acc = __builtin_amdgcn_mfma_f32_16x16x32_bf16(wf[tc][1], sfr[1], acc, 0, 0, 0);
            u[tc] -= acc; }
        bf16x8 ufr[2];
#pragma unroll
        for (int ks = 0; ks < 2; ++ks) ufr[ks] = pack8(u[2 * ks][0], u[2 * ks][1], u[2 * ks][2], u[2 * ks][3], u[2 * ks + 1][0], u[2 * ks + 1][1], u[2 * ks + 1][2], u[2 * ks + 1][3]);
        __builtin_amdgcn_sched_barrier(0);
        GS_LD_UW(nn);
        __builtin_amdgcn_sched_barrier(0);
        f32x4 oacc[4];
#pragma unroll
        for (int tc = 0; tc < 4; ++tc) {
            f32x4 acc = {0.f, 0.f, 0.f, 0.f};
            acc = __builtin_amdgcn_mfma_f32_16x16x32_bf16(qx[tc][0], sfr[0], acc, 0, 0, 0); acc = __builtin_amdgcn_mfma_f32_16x16x32_bf16(qx[tc][1], sfr[1], acc, 0, 0, 0);
            acc = __builtin_amdgcn_mfma_f32_16x16x32_bf16(qkx[tc][0], ufr[0], acc, 0, 0, 0); acc = __builtin_amdgcn_mfma_f32_16x16x32_bf16(qkx[tc][1], ufr[1], acc, 0, 0, 0);
            oacc[tc] = acc; }
#pragma unroll
        for (int td = 0; td < 4; ++td) { f32x4 acc = s[td] * dec;
            acc = __builtin_amdgcn_mfma_f32_16x16x32_bf16(kt[td][0], ufr[0], acc, 0, 0, 0); acc = __builtin_amdgcn_mfma_f32_16x16x32_bf16(kt[td][1], ufr[1], acc, 0, 0, 0);
            s[td] = acc; }
#pragma unroll
        for (int ks = 0; ks < 2; ++ks) sfr[ks] = pack8(s[2 * ks][0], s[2 * ks][1], s[2 * ks][2], s[2 * ks][3], s[2 * ks + 1][0], s[2 * ks + 1][1], s[2 * ks + 1][2], s[2 * ks + 1][3]);
        __builtin_amdgcn_sched_barrier(0);
        GS_LD_Q(nn); GS_LD_K(nn);
#pragma unroll
        for (int tc = 0; tc < 4; ++tc)
#pragma unroll
            for (int i = 0; i < 4; ++i) A.OG[((size_t)b * SEQ + 64 * n + 16 * tc + 4 * fq + i) * 512 + h * 64 + 16 * te + fr] = oacc[tc][i];
        __builtin_amdgcn_sched_barrier(0);
    }
#undef GS_LD_UW
#undef GS_LD_Q
#undef GS_LD_K
#pragma unroll
    for (int td = 0; td < 4; ++td)
#pragma unroll
        for (int i = 0; i < 4; ++i) A.out[O_GDNP + ((((size_t)A.l * NPB + b) * 8 + h) * 64 + 16 * td + 4 * fq + i) * 64 + 16 * te + fr] = s[td][i];
}

constexpr int SC_ROW = 144, SC_MAT = 64 * SC_ROW, SC_U = 4 * SC_MAT, SC_STAGE = SC_U + 16384, SC_DEC = 2 * SC_STAGE;
__device__ __forceinline__ void gdn_scan3_block(const GS2Args& A, unsigned char* lds, int bh, int tid) {
    const int lane = tid & 63, wave = __builtin_amdgcn_readfirstlane(tid >> 6), fr = lane & 15, fq = lane >> 4, b = bh >> 3, h = bh & 7, te = wave;
    const int mrow = (tid >> 3), mch = tid & 7;
    v4u ra[6], rb[6];
#define SC_LOAD(R, nn) do { const size_t un_ = (size_t)bh * 64 + ((nn) < 63 ? (nn) : 63); \
        R[0] = *(const v4u*)(A.WX + un_ * 4096 + mrow * 64 + mch * 8); R[1] = *(const v4u*)(A.KTX + un_ * 4096 + mrow * 64 + mch * 8); \
        R[2] = *(const v4u*)(A.QX + un_ * 4096 + mrow * 64 + mch * 8); R[3] = *(const v4u*)(A.QKX + un_ * 4096 + mrow * 64 + mch * 8); \
        R[4] = *(const v4u*)(A.U0F + un_ * 4096 + (size_t)tid * 4); R[5] = *(const v4u*)(A.U0F + un_ * 4096 + (size_t)(tid + 512) * 4); } while (0)
#define SC_STORE(R, st) do { unsigned char* sb_ = lds + (st) * SC_STAGE; \
        *(v4u*)(sb_ + 0 * SC_MAT + mrow * SC_ROW + mch * 16) = R[0]; *(v4u*)(sb_ + 1 * SC_MAT + mrow * SC_ROW + mch * 16) = R[1]; \
        *(v4u*)(sb_ + 2 * SC_MAT + mrow * SC_ROW + mch * 16) = R[2]; *(v4u*)(sb_ + 3 * SC_MAT + mrow * SC_ROW + mch * 16) = R[3]; \
        *(v4u*)(sb_ + SC_U + tid * 16) = R[4]; *(v4u*)(sb_ + SC_U + (tid + 512) * 16) = R[5]; } while (0)
    f32x4 s[4]; bf16x8 sfr[2];
#pragma unroll
    for (int i = 0; i < 4; ++i) s[i] = (f32x4){0.f, 0.f, 0.f, 0.f};
    sfr[0] = (bf16x8){0, 0, 0, 0, 0, 0, 0, 0}; sfr[1] = sfr[0];
    __syncthreads();
    if (tid < 64) ((float*)(lds + SC_DEC))[tid] = A.GL[(size_t)bh * 64 + tid];
    SC_LOAD(ra, 0); SC_STORE(ra, 0);
    SC_LOAD(rb, 1); SC_LOAD(ra, 2);
    __syncthreads();
#define SC_CHUNK(n, st) do { if (wave < 4) { const unsigned char* sb_ = lds + (st) * SC_STAGE; \
        f32x4 u[4]; bf16x8 ufr[2]; \
        _Pragma("unroll") for (int tc = 0; tc < 4; ++tc) { u[tc] = *(const f32x4*)(sb_ + SC_U + ((tc * 4 + te) * 64 + lane) * 16); \
            const bf16x8 w0 = *(const bf16x8*)(sb_ + (16 * tc + fr) * SC_ROW + (8 * fq) * 2), w1 = *(const bf16x8*)(sb_ + (16 * tc + fr) * SC_ROW + (32 + 8 * fq) * 2); \
            f32x4 acc = {0.f, 0.f, 0.f, 0.f}; acc = __builtin_amdgcn_mfma_f32_16x16x32_bf16(w0, sfr[0], acc, 0, 0, 0); acc = __builtin_amdgcn_mfma_f32_16x16x32_bf16(w1, sfr[1], acc, 0, 0, 0); u[tc] -= acc; } \
        _Pragma("unroll") for (int ks = 0; ks < 2; ++ks) ufr[ks] = pack8(u[2 * ks][0], u[2 * ks][1], u[2 * ks][2], u[2 * ks][3], u[2 * ks + 1][0], u[2 * ks + 1][1], u[2 * ks + 1][2], u[2 * ks + 1][3]); \
        _Pragma("unroll") for (int tc = 0; tc < 4; ++tc) { \
            const bf16x8 q0 = *(const bf16x8*)(sb_ + 2 * SC_MAT + (16 * tc + fr) * SC_ROW + (8 * fq) * 2), q1 = *(const bf16x8*)(sb_ + 2 * SC_MAT + (16 * tc + fr) * SC_ROW + (32 + 8 * fq) * 2); \
            const bf16x8 k0 = *(const bf16x8*)(sb_ + 3 * SC_MAT + (16 * tc + fr) * SC_ROW + (8 * fq) * 2), k1 = *(const bf16x8*)(sb_ + 3 * SC_MAT + (16 * tc + fr) * SC_ROW + (32 + 8 * fq) * 2); \
            f32x4 acc = {0.f, 0.f, 0.f, 0.f}; \
            acc = __builtin_amdgcn_mfma_f32_16x16x32_bf16(q0, sfr[0], acc, 0, 0, 0); acc = __builtin_amdgcn_mfma_f32_16x16x32_bf16(q1, sfr[1], acc, 0, 0, 0); \
            acc = __builtin_amdgcn_mfma_f32_16x16x32_bf16(k0, ufr[0], acc, 0, 0, 0); acc = __builtin_amdgcn_mfma_f32_16x16x32_bf16(k1, ufr[1], acc, 0, 0, 0); \
            _Pragma("unroll") for (int i = 0; i < 4; ++i) A.OG[((size_t)b * SEQ + 64 * (n) + 16 * tc + 4 * fq + i) * 512 + h * 64 + 16 * te + fr] = acc[i]; } \
        const float dec = ((const float*)(lds + SC_DEC))[(n)]; \
        _Pragma("unroll") for (int td = 0; td < 4; ++td) { \
            const bf16x8 t0 = *(const bf16x8*)(sb_ + 1 * SC_MAT + (16 * td + fr) * SC_ROW + (8 * fq) * 2), t1 = *(const bf16x8*)(sb_ + 1 * SC_MAT + (16 * td + fr) * SC_ROW + (32 + 8 * fq) * 2); \
            f32x4 acc = s[td] * dec; acc = __builtin_amdgcn_mfma_f32_16x16x32_bf16(t0, ufr[0], acc, 0, 0, 0); acc = __builtin_amdgcn_mfma_f32_16x16x32_bf16(t1, ufr[1], acc, 0, 0, 0); s[td] = acc; } \
        _Pragma("unroll") for (int ks = 0; ks < 2; ++ks) sfr[ks] = pack8(s[2 * ks][0], s[2 * ks][1], s[2 * ks][2], s[2 * ks][3], s[2 * ks + 1][0], s[2 * ks + 1][1], s[2 * ks + 1][2], s[2 * ks + 1][3]); } } while (0)
#pragma unroll 1
    for (int n = 0; n < 64; n += 2) {
        SC_STORE(rb, 1); __builtin_amdgcn_sched_barrier(0); SC_LOAD(rb, n + 3); __builtin_amdgcn_sched_barrier(0);
        SC_CHUNK(n, 0);
        __syncthreads();
        SC_STORE(ra, 0); __builtin_amdgcn_sched_barrier(0); SC_LOAD(ra, n + 4); __builtin_amdgcn_sched_barrier(0);
        SC_CHUNK(n + 1, 1);
        __syncthreads();
    }
#undef SC_LOAD
#undef SC_STORE
#undef SC_CHUNK
    if (wave < 4) {
#pragma unroll
        for (int td = 0; td < 4; ++td)
#pragma unroll
            for (int i = 0; i < 4; ++i) A.out[O_GDNP + ((((size_t)A.l * NPB + b) * 8 + h) * 64 + 16 * td + 4 * fq + i) * 64 + 16 * te + fr] = s[td][i];
    }
}

constexpr int L_CK = 0, L_CVT = 18432, L_IMP = 36864, L_MASK = 102400, L_UM = 102912, L_INV = 102928, L_K = 104448, L_VT = 113664;
struct AttArgs { const bf16* QB; const bf16* KS; const bf16* VS; const bf16* KW; const bf16* VW; const float* CKP; const float* CVP; const float* PROJ; bf16* MIX; };

constexpr float ATT_THR = 16.f;
constexpr int L_K2 = 122880, L_VT2 = 132096, L_VT3 = 0;
template <int MODE>
__device__ __forceinline__ void attn_tiles(unsigned char* lds, const bf16* Kg, const bf16* Vg, int j_lo, int j_hi, unsigned long long umask, unsigned long long tmask,
                                           int qblk, int trel, const bf16x8 (&qr)[4], f32x16 (&o)[2], float& mref, float& lrun, int tid, int r32, int hi) {
    int j = j_lo; while (j <= j_hi && !((umask >> j) & 1ull)) ++j;
    const int key = tid >> 3, ch = tid & 7;
    v4u kvv = {0u, 0u, 0u, 0u}, vv = {0u, 0u, 0u, 0u};
#define AT_LOAD(jj) do { kvv = *(const v4u*)(Kg + (size_t)(64 * (jj) + key) * 128 + ch * 8); vv = *(const v4u*)(Vg + (size_t)(64 * (jj) + key) * 128 + ch * 8); } while (0)
#define AT_WRITE(kofs, vofs) do { *(v4u*)(lds + (kofs) + key * 144 + ch * 16) = kvv; *(v4u*)(lds + (vofs) + key * 144 + ch * 16) = vv; } while (0)
    if (j > j_hi) return;
    AT_LOAD(j);
    __syncthreads();
    AT_WRITE(L_K, L_VT);
    int jn = j + 1; while (jn <= j_hi && !((umask >> jn) & 1ull)) ++jn;
    if (jn <= j_hi) AT_LOAD(jn);
    __syncthreads();
    const bool grpB = (tid >= 256);
    v4u pwp[4];
#pragma unroll
    for (int i = 0; i < 4; ++i) pwp[i] = (v4u){0u, 0u, 0u, 0u};
    int it = 0, vprev = L_VT;
    typedef short v4i16_t_ __attribute__((ext_vector_type(4)));
    const int trl_ = tid & 63, trq_ = (trl_ & 15) >> 2, trp_ = trl_ & 3, trd_ = 16 * ((trl_ >> 4) & 1) + 4 * trp_;
#define AT_TR(p_) __builtin_bit_cast(s16x4, __builtin_amdgcn_ds_read_tr16_b64_v4i16((__attribute__((address_space(3))) v4i16_t_*)(p_)))
#define AT_PV(vofs, PW) do { _Pragma("unroll") for (int u = 0; u < 2; ++u) _Pragma("unroll") for (int s = 0; s < 2; ++s) { const bf16x8 pf = __builtin_bit_cast(bf16x8, PW[u * 2 + s]); \
        _Pragma("unroll") for (int dh = 0; dh < 2; ++dh) { const unsigned char* vp = lds + (vofs) + (32 * u + 16 * s + 4 * hi + trq_) * 144 + (32 * dh + trd_) * 2; \
            const s16x4 lo = AT_TR(vp), hi4 = AT_TR(vp + 8 * 144); \
            const bf16x8 vf = (bf16x8){lo[0], lo[1], lo[2], lo[3], hi4[0], hi4[1], hi4[2], hi4[3]}; \
            o[dh] = __builtin_amdgcn_mfma_f32_32x32x16_bf16(vf, pf, o[dh], 0, 0, 0); } } } while (0)
    while (j <= j_hi) {
        const int kb = (it & 1) ? L_K2 : L_K, kb2 = (it & 1) ? L_K : L_K2;
        const int m3 = it % 3, vb = (m3 == 0) ? L_VT : (m3 == 1) ? L_VT2 : L_VT3, vb2 = (m3 == 0) ? L_VT2 : (m3 == 1) ? L_VT3 : L_VT;
        if (grpB && it > 0) AT_PV(vprev, pwp);
        if (jn <= j_hi) AT_WRITE(kb2, vb2);
        int jnn = jn + 1; while (jnn <= j_hi && !((umask >> jnn) & 1ull)) ++jnn;
        if (jnn <= j_hi) AT_LOAD(jnn);
        __builtin_amdgcn_sched_barrier(0);
        const bool tsel = (MODE == 0) ? (((tmask >> j) & 1ull) != 0ull) : true;
        const float cval = tsel ? -mref : NEG_INF;
        f32x16 ct;
#pragma unroll
        for (int r = 0; r < 16; ++r) ct[r] = cval;
        f32x16 p[2];
#pragma unroll
        for (int u = 0; u < 2; ++u) { f32x16 acc;
#pragma unroll
            for (int d0 = 0; d0 < 4; ++d0) { const bf16x8 kf = *(const bf16x8*)(lds + kb + (32 * u + r32) * 144 + (16 * d0 + 8 * hi) * 2);
                acc = __builtin_amdgcn_mfma_f32_32x32x16_bf16(kf, qr[d0], d0 == 0 ? ct : acc, 0, 0, 0); }
            p[u] = acc; }
        if (j == qblk) {
#pragma unroll
            for (int u = 0; u < 2; ++u)
#pragma unroll
                for (int r = 0; r < 16; ++r) { const int kv = 32 * u + crow(r, hi); if (kv > trel) p[u][r] = NEG_INF; } }
        if (MODE == 1 && j == qblk - 8) {
#pragma unroll
            for (int u = 0; u < 2; ++u)
#pragma unroll
                for (int r = 0; r < 16; ++r) { const int kv = 32 * u + crow(r, hi); if (kv < trel) p[u][r] = NEG_INF; } }
        float rm;
        { float a = __builtin_fmaxf(__builtin_fmaxf(p[0][0], p[0][1]), p[1][0]), b2 = __builtin_fmaxf(__builtin_fmaxf(p[0][2], p[0][3]), p[1][1]); a = __builtin_fmaxf(__builtin_fmaxf(a, p[1][2]), p[1][3]);
#pragma unroll
          for (int r = 4; r < 16; r += 4) { a = __builtin_fmaxf(__builtin_fmaxf(a, p[0][r]), p[0][r + 1]); b2 = __builtin_fmaxf(__builtin_fmaxf(b2, p[0][r + 2]), p[0][r + 3]);
              a = __builtin_fmaxf(__builtin_fmaxf(a, p[1][r]), p[1][r + 1]); b2 = __builtin_fmaxf(__builtin_fmaxf(b2, p[1][r + 2]), p[1][r + 3]); }
          rm = __builtin_fmaxf(a, b2); }
        { auto rr = __builtin_amdgcn_permlane32_swap(__float_as_uint(rm), __float_as_uint(rm), false, false); rm = __builtin_fmaxf(__uint_as_float(rr[0]), __uint_as_float(rr[1])); }
        if (__builtin_expect(__any(rm > ATT_THR), 0)) {
            const float dl = (rm > ATT_THR) ? rm : 0.f, f = ex2(-dl);
            mref += dl; lrun *= f;
#pragma unroll
            for (int u = 0; u < 2; ++u)
#pragma unroll
                for (int r = 0; r < 16; ++r) p[u][r] -= dl;
#pragma unroll
            for (int dh = 0; dh < 2; ++dh)
#pragma unroll
                for (int r = 0; r < 16; ++r) o[dh][r] *= f; }
        typedef float f32x2v_ __attribute__((ext_vector_type(2)));
        f32x2v_ ls2 = {0.f, 0.f};
#pragma unroll
        for (int u = 0; u < 2; ++u)
#pragma unroll
            for (int r = 0; r < 16; r += 2) { const float e0 = ex2(p[u][r]), e1 = ex2(p[u][r + 1]); p[u][r] = e0; p[u][r + 1] = e1; ls2 += (f32x2v_){e0, e1}; }
        lrun += ls2.x + ls2.y;
        v4u pw[4];
#pragma unroll
        for (int u = 0; u < 2; ++u)
#pragma unroll
            for (int s = 0; s < 2; ++s) { pw[u * 2 + s].x = pk2(p[u][8 * s + 0], p[u][8 * s + 1]); pw[u * 2 + s].y = pk2(p[u][8 * s + 2], p[u][8 * s + 3]);
                pw[u * 2 + s].z = pk2(p[u][8 * s + 4], p[u][8 * s + 5]); pw[u * 2 + s].w = pk2(p[u][8 * s + 6], p[u][8 * s + 7]); }
        if (!grpB) AT_PV(vb, pw);
        else {
#pragma unroll
            for (int i = 0; i < 4; ++i) pwp[i] = pw[i];
            vprev = vb; }
        __syncthreads();
        j = jn; jn = jnn; ++it;
    }
    if (grpB && it > 0) AT_PV(vprev, pwp);
#undef AT_PV
#undef AT_TR
#undef AT_LOAD
#undef AT_WRITE
}

__device__ __forceinline__ void nsa_prompt_unit(const AttArgs& A, unsigned char* lds, int unit, int tid) {
    const int lane = tid & 63, wave = tid >> 6, r32 = lane & 31, hi = lane >> 5, hh = wave & 3, ts = wave >> 2;
    const int qblk = 63 - (unit >> 3), b = (unit >> 1) & 3, kvh = unit & 1;
    const int head = kvh * 4 + hh, trel = 32 * ts + r32, t = 64 * qblk + trel; const size_t m = (size_t)b * SEQ + t;
    __syncthreads();
    const int nvmax = 2 * qblk + 2, ntile_c = (nvmax + 31) >> 5;
    { const int ch = tid & 7;
      for (int n = tid >> 3; n < 32 * ntile_c; n += 64) {
          const float* ckp = A.CKP + ((size_t)(b * 128 + n) * 2 + kvh) * 64 + ch * 8; const float* cvp = A.CVP + ((size_t)(b * 128 + n) * 2 + kvh) * 64 + ch * 8;
          const f32x4 k0 = *(const f32x4*)ckp, k1 = *(const f32x4*)(ckp + 4), v0 = *(const f32x4*)cvp, v1 = *(const f32x4*)(cvp + 4);
          *(bf16x8*)(lds + L_CK + n * 144 + ch * 16) = pack8(k0.x, k0.y, k0.z, k0.w, k1.x, k1.y, k1.z, k1.w);
          unsigned short* vt = (unsigned short*)(lds + L_CVT);
          vt[(ch * 8 + 0) * 136 + n] = (unsigned short)f2bf(v0.x); vt[(ch * 8 + 1) * 136 + n] = (unsigned short)f2bf(v0.y); vt[(ch * 8 + 2) * 136 + n] = (unsigned short)f2bf(v0.z); vt[(ch * 8 + 3) * 136 + n] = (unsigned short)f2bf(v0.w);
          vt[(ch * 8 + 4) * 136 + n] = (unsigned short)f2bf(v1.x); vt[(ch * 8 + 5) * 136 + n] = (unsigned short)f2bf(v1.y); vt[(ch * 8 + 6) * 136 + n] = (unsigned short)f2bf(v1.z); vt[(ch * 8 + 7) * 136 + n] = (unsigned short)f2bf(v1.w);
      }
      if (tid < 128) ((unsigned*)(lds + L_MASK))[tid] = 0u;
      if (tid < 2) ((unsigned*)(lds + L_UM))[tid] = 0u; }
    bf16x8 qr[4];
#pragma unroll
    for (int d0 = 0; d0 < 4; ++d0) qr[d0] = *(const bf16x8*)(A.QB + m * 512 + head * 64 + 16 * d0 + 8 * hi);
    __syncthreads();
    f32x16 tot[2];
    {
        const int nv = (t + 1) >> 5;
        float mx = NEG_INF;
#pragma unroll 1
        for (int tau = 0; tau < ntile_c; ++tau) {
            f32x16 acc = {};
#pragma unroll
            for (int d0 = 0; d0 < 4; ++d0) { const bf16x8 kf = *(const bf16x8*)(lds + L_CK + (32 * tau + r32) * 144 + (16 * d0 + 8 * hi) * 2);
                acc = __builtin_amdgcn_mfma_f32_32x32x16_bf16(kf, qr[d0], acc, 0, 0, 0); }
#pragma unroll
            for (int r = 0; r < 16; ++r) { const int n = 32 * tau + crow(r, hi); if (n < nv) mx = fmaxf(mx, acc[r]); }
        }
        mx = fmaxf(mx, __shfl_xor(mx, 32)); if (mx == NEG_INF) mx = 0.f;
        float sum = 0.f;
        f32x16 oc[2]; oc[0] = (f32x16){}; oc[1] = (f32x16){};
        float* imph = (float*)(lds + L_IMP) + (size_t)hh * 4096 + (32 * ts + r32) * 64;
#pragma unroll 1
        for (int tau = 0; tau < 4; ++tau) {
            f32x16 e = {};
            if (tau < ntile_c) {
                f32x16 acc = {};
#pragma unroll
                for (int d0 = 0; d0 < 4; ++d0) { const bf16x8 kf = *(const bf16x8*)(lds + L_CK + (32 * tau + r32) * 144 + (16 * d0 + 8 * hi) * 2);
                    acc = __builtin_amdgcn_mfma_f32_32x32x16_bf16(kf, qr[d0], acc, 0, 0, 0); }
#pragma unroll
                for (int r = 0; r < 16; ++r) { const int n = 32 * tau + crow(r, hi); e[r] = (n < nv) ? ex2(acc[r] - mx) : 0.f; sum += e[r]; }
#pragma unroll
                for (int s = 0; s < 2; ++s) {
                    const bf16x8 pf = pack8(e[8 * s + 0], e[8 * s + 1], e[8 * s + 2], e[8 * s + 3], e[8 * s + 4], e[8 * s + 5], e[8 * s + 6], e[8 * s + 7]);
#pragma unroll
                    for (int dh = 0; dh < 2; ++dh) { const unsigned char* vp = lds + L_CVT + (r32 + 32 * dh) * 272 + (32 * tau + 16 * s + 4 * hi) * 2;
                        const s16x4 lo = *(const s16x4*)vp, hi4 = *(const s16x4*)(vp + 16);
                        const bf16x8 vf = (bf16x8){lo[0], lo[1], lo[2], lo[3], hi4[0], hi4[1], hi4[2], hi4[3]};
                        oc[dh] = __builtin_amdgcn_mfma_f32_32x32x16_bf16(vf, pf, oc[dh], 0, 0, 0); }
                }
            }
#pragma unroll
            for (int a = 0; a < 4; ++a) { imph[16 * tau + 4 * a + 2 * hi + 0] = e[4 * a] + e[4 * a + 1]; imph[16 * tau + 4 * a + 2 * hi + 1] = e[4 * a + 2] + e[4 * a + 3]; }
        }
        sum += __shfl_xor(sum, 32);
        const float inv = 1.f / fmaxf(sum, 1e-30f);
        if (hi == 0) ((float*)(lds + L_INV))[hh * 64 + 32 * ts + r32] = inv;
        const float g0 = sigmoidf_(A.PROJ[m * NP + C_GATE + head * 3 + 0]) * inv;
#pragma unroll
        for (int dh = 0; dh < 2; ++dh)
#pragma unroll
            for (int r = 0; r < 16; ++r) tot[dh][r] = g0 * oc[dh][r];
    }
    __syncthreads();
    { float* ip = (float*)(lds + L_IMP); const float* iv = (const float*)(lds + L_INV);
#pragma unroll
      for (int i = 0; i < 8; ++i) { const int idx = tid + 512 * i, tk = idx >> 6;
          ip[idx] = (ip[idx] * iv[tk] + ip[4096 + idx] * iv[64 + tk]) + (ip[8192 + idx] * iv[128 + tk] + ip[12288 + idx] * iv[192 + tk]); } }
    __syncthreads();
    { const int tok = tid >> 3, jg = tid & 7; unsigned* mk = (unsigned*)(lds + L_MASK) + tok * 2;
      if (qblk <= 15) { if (jg == 0) { const unsigned long long am = (1ull << (qblk + 1)) - 1ull; mk[0] = (unsigned)am; mk[1] = (unsigned)(am >> 32); } }
      else {
          const float* iv = (const float*)(lds + L_IMP) + tok * 64; float vj[8]; int rk[8];
#pragma unroll
          for (int jj = 0; jj < 8; ++jj) { vj[jj] = iv[jg * 8 + jj]; rk[jj] = 0; }
          for (int i = 1; i <= qblk - 2; ++i) { const float vi = iv[i];
#pragma unroll
              for (int jj = 0; jj < 8; ++jj) { const int j = jg * 8 + jj; rk[jj] += (vi > vj[jj] || (vi == vj[jj] && i < j)) ? 1 : 0; } }
          unsigned bits = 0u;
#pragma unroll
          for (int jj = 0; jj < 8; ++jj) { const int j = jg * 8 + jj; const bool cand = (j >= 1 && j <= qblk - 2);
              if ((cand && rk[jj] < 13) || j == 0 || j == qblk || j == qblk - 1) bits |= 1u << ((jg & 3) * 8 + jj); }
          if (bits) atomicOr(mk + (jg >> 2), bits);
      } }
    __syncthreads();
    if (tid < 64) { const unsigned* mk = (const unsigned*)(lds + L_MASK) + tid * 2; atomicOr((unsigned*)(lds + L_UM), mk[0]); atomicOr((unsigned*)(lds + L_UM) + 1, mk[1]); }
    __syncthreads();
    unsigned long long tmask, umask;
    { const unsigned* mk = (const unsigned*)(lds + L_MASK) + trel * 2; tmask = (unsigned long long)mk[0] | ((unsigned long long)mk[1] << 32);
      const unsigned* um = (const unsigned*)(lds + L_UM); umask = (unsigned long long)um[0] | ((unsigned long long)um[1] << 32); }
    float* stash = (float*)(lds + L_IMP) + (size_t)wave * 2048 + lane;
#pragma unroll
    for (int dh = 0; dh < 2; ++dh)
#pragma unroll
        for (int r = 0; r < 16; ++r) stash[(dh * 16 + r) * 64] = tot[dh][r];
    {
        f32x16 o[2]; o[0] = (f32x16){}; o[1] = (f32x16){}; float mrun = 0.f, lrun = 0.f;
        attn_tiles<0>(lds, A.KS + (size_t)b * SEQ * 128 + kvh * 64, A.VS + (size_t)b * SEQ * 128 + kvh * 64, 0, qblk, umask, tmask, qblk, trel, qr, o, mrun, lrun, tid, r32, hi);
        lrun += __shfl_xor(lrun, 32);
        const float g1 = lrun > 0.f ? sigmoidf_(A.PROJ[m * NP + C_GATE + head * 3 + 1]) / lrun : 0.f;
#pragma unroll
        for (int dh = 0; dh < 2; ++dh)
#pragma unroll
            for (int r = 0; r < 16; ++r) stash[(dh * 16 + r) * 64] += g1 * o[dh][r];
    }
    {
        f32x16 o[2]; o[0] = (f32x16){}; o[1] = (f32x16){}; float mrun = 0.f, lrun = 0.f;
        const int jlo = qblk >= 8 ? qblk - 8 : 0;
        attn_tiles<1>(lds, A.KW + (size_t)b * SEQ * 128 + kvh * 64, A.VW + (size_t)b * SEQ * 128 + kvh * 64, jlo, qblk, ~0ull, ~0ull, qblk, trel, qr, o, mrun, lrun, tid, r32, hi);
        lrun += __shfl_xor(lrun, 32);
        const float g2 = lrun > 0.f ? sigmoidf_(A.PROJ[m * NP + C_GATE + head * 3 + 2]) / lrun : 0.f;
#pragma unroll
        for (int dh = 0; dh < 2; ++dh)
#pragma unroll
            for (int r = 0; r < 16; ++r) tot[dh][r] = stash[(dh * 16 + r) * 64] + g2 * o[dh][r];
    }
    bf16* mo = A.MIX + m * 1024 + 512 + head * 64;
#pragma unroll
    for (int dh = 0; dh < 2; ++dh)
#pragma unroll
        for (int a = 0; a < 4; ++a) { const int d0 = 32 * dh + 8 * a + 4 * hi;
            *(v2u*)(mo + d0) = (v2u){pk2(tot[dh][4 * a], tot[dh][4 * a + 1]), pk2(tot[dh][4 * a + 2], tot[dh][4 * a + 3])}; }
}

struct SAttArgs { const bf16* QB; const bf16* KS; const bf16* VS; const bf16* KW; const bf16* VW; const float* CKS; const float* CVS; const float* PROJ; const float* cache; const int* page_table; const float* state_win; bf16* MIX; int l; };
constexpr int S2_IMP = 0, S2_MK = 512, S2_ITEMS = 576, S2_OC = 1024, S2_MG = 8192;
constexpr int S2_MG_STRIDE = 4224;
template <bool F32> __device__ __forceinline__ void s2_block(const void* kbase, const void* vbase, int kstride, int nvalid, const bf16x8 (&qf)[2], const bool (&keep)[4][4], f32x4 (&O)[4], float& mrun, float& lrun, int fr, int fq) {
    f32x4 kraw[4][2][2]; bf16x8 kb[4][2]; f32x4 vraw[2][8]; v2u vb[2][8];
#pragma unroll
    for (int tk = 0; tk < 4; ++tk) { const int key = 16 * tk + fr, kc = key < nvalid ? key : nvalid - 1;
#pragma unroll
        for (int ks = 0; ks < 2; ++ks) {
            if (F32) { const float* p = (const float*)kbase + (size_t)kc * kstride + 32 * ks + 8 * fq; kraw[tk][ks][0] = *(const f32x4*)p; kraw[tk][ks][1] = *(const f32x4*)(p + 4); }
            else kb[tk][ks] = *(const bf16x8*)((const bf16*)kbase + (size_t)kc * 128 + 32 * ks + 8 * fq); } }
#pragma unroll
    for (int ks = 0; ks < 2; ++ks)
#pragma unroll
        for (int j = 0; j < 8; ++j) { const int key = 32 * ks + 16 * (j >> 2) + 4 * fq + (j & 3), kc = key < nvalid ? key : nvalid - 1;
            if (F32) vraw[ks][j] = *(const f32x4*)((const float*)vbase + (size_t)kc * kstride + 4 * fr);
            else vb[ks][j] = *(const v2u*)((const bf16*)vbase + (size_t)kc * 128 + 4 * fr); }
    __builtin_amdgcn_sched_barrier(0);
    f32x4 acc[4];
#pragma unroll
    for (int tk = 0; tk < 4; ++tk) { bf16x8 kx[2];
#pragma unroll
        for (int ks = 0; ks < 2; ++ks) { if (F32) { const f32x4 a = kraw[tk][ks][0], b = kraw[tk][ks][1]; kx[ks] = pack8(a.x, a.y, a.z, a.w, b.x, b.y, b.z, b.w); } else kx[ks] = kb[tk][ks]; }
        f32x4 a4 = {0.f, 0.f, 0.f, 0.f};
        a4 = __builtin_amdgcn_mfma_f32_16x16x32_bf16(kx[0], qf[0], a4, 0, 0, 0); a4 = __builtin_amdgcn_mfma_f32_16x16x32_bf16(kx[1], qf[1], a4, 0, 0, 0);
        acc[tk] = a4; }
    float mx = NEG_INF;
#pragma unroll
    for (int tk = 0; tk < 4; ++tk)
#pragma unroll
        for (int i = 0; i < 4; ++i) { if (!keep[tk][i]) acc[tk][i] = NEG_INF; mx = fmaxf(mx, acc[tk][i]); }
    mx = fmaxf(mx, __shfl_xor(mx, 16)); mx = fmaxf(mx, __shfl_xor(mx, 32));
    const float mn = fmaxf(mrun, mx), msafe = (mn == NEG_INF) ? 0.f : mn, alpha = ex2(mrun - msafe);
    float ls = 0.f;
#pragma unroll
    for (int tk = 0; tk < 4; ++tk)
#pragma unroll
        for (int i = 0; i < 4; ++i) { const float e = ex2(acc[tk][i] - msafe); acc[tk][i] = e; ls += e; }
    lrun = lrun * alpha + ls; mrun = mn;
#pragma unroll
    for (int td = 0; td < 4; ++td) O[td] *= alpha;
#pragma unroll
    for (int ks = 0; ks < 2; ++ks) {
        const bf16x8 pf = pack8(acc[2 * ks][0], acc[2 * ks][1], acc[2 * ks][2], acc[2 * ks][3], acc[2 * ks + 1][0], acc[2 * ks + 1][1], acc[2 * ks + 1][2], acc[2 * ks + 1][3]);
        float vv[8][4];
#pragma unroll
        for (int j = 0; j < 8; ++j) {
            if (F32) { const f32x4 v = vraw[ks][j]; vv[j][0] = v.x; vv[j][1] = v.y; vv[j][2] = v.z; vv[j][3] = v.w; }
            else { const v2u w = vb[ks][j]; vv[j][0] = bf2f((unsigned short)(w.x & 0xffffu)); vv[j][1] = bf2f((unsigned short)(w.x >> 16)); vv[j][2] = bf2f((unsigned short)(w.y & 0xffffu)); vv[j][3] = bf2f((unsigned short)(w.y >> 16)); } }
#pragma unroll
        for (int td = 0; td < 4; ++td) { const bf16x8 vx = pack8(vv[0][td], vv[1][td], vv[2][td], vv[3][td], vv[4][td], vv[5][td], vv[6][td], vv[7][td]);
            O[td] = __builtin_amdgcn_mfma_f32_16x16x32_bf16(vx, pf, O[td], 0, 0, 0); }
    }
}
__device__ __forceinline__ void nsa_sample_unit(const SAttArgs& A, unsigned char* lds, int unit, int tid) {
    const int sb = unit >> 1, kvh = unit & 1, l = A.l;
    const int lane = tid & 63, wave = __builtin_amdgcn_readfirstlane(tid >> 6), fr = lane & 15, fq = lane >> 4;
    const int qi = fr >> 2, qh = fr & 3;
    float* IMP = (float*)(lds + S2_IMP); unsigned* MK = (unsigned*)(lds + S2_MK); int* ITEMS = (int*)(lds + S2_ITEMS);
    const size_t mq = (size_t)MP + sb * 4 + qi;
    __syncthreads();
    if (tid < 8) MK[tid] = 0u;
    bf16x8 qf[2];
#pragma unroll
    for (int ks = 0; ks < 2; ++ks) qf[ks] = *(const bf16x8*)(A.QB + mq * 512 + (kvh * 4 + qh) * 64 + 32 * ks + 8 * fq);
    {
        f32x4 O[4]; float mrun = NEG_INF, lrun = 0.f;
#pragma unroll
        for (int td = 0; td < 4; ++td) O[td] = (f32x4){0.f, 0.f, 0.f, 0.f};
        bool keep[4][4];
#pragma unroll
        for (int tk = 0; tk < 4; ++tk)
#pragma unroll
            for (int i = 0; i < 4; ++i) keep[tk][i] = true;
        const float* ckf = A.CKS + ((size_t)sb * 64 * 2 + kvh) * 64; const float* cvf = A.CVS + ((size_t)sb * 64 * 2 + kvh) * 64;
        f32x4 acc[4];
#pragma unroll
        for (int tk = 0; tk < 4; ++tk) { bf16x8 kx[2];
#pragma unroll
            for (int ks = 0; ks < 2; ++ks) { const float* p = ckf + (size_t)(16 * tk + fr) * 128 + 32 * ks + 8 * fq; const f32x4 a = *(const f32x4*)p, b = *(const f32x4*)(p + 4); kx[ks] = pack8(a.x, a.y, a.z, a.w, b.x, b.y, b.z, b.w); }
            f32x4 a4 = {0.f, 0.f, 0.f, 0.f};
            a4 = __builtin_amdgcn_mfma_f32_16x16x32_bf16(kx[0], qf[0], a4, 0, 0, 0); a4 = __builtin_amdgcn_mfma_f32_16x16x32_bf16(kx[1], qf[1], a4, 0, 0, 0);
            acc[tk] = a4; }
        float mx = NEG_INF;
#pragma unroll
        for (int tk = 0; tk < 4; ++tk)
#pragma unroll
            for (int i = 0; i < 4; ++i) mx = fmaxf(mx, acc[tk][i]);
        mx = fmaxf(mx, __shfl_xor(mx, 16)); mx = fmaxf(mx, __shfl_xor(mx, 32));
        float ls = 0.f;
#pragma unroll
        for (int tk = 0; tk < 4; ++tk)
#pragma unroll
            for (int i = 0; i < 4; ++i) { const float e = ex2(acc[tk][i] - mx); acc[tk][i] = e; ls += e; }
        ls += __shfl_xor(ls, 16); ls += __shfl_xor(ls, 32);
        const float inv = 1.f / fmaxf(ls, 1e-30f);
        if (wave == 0) {
#pragma unroll
            for (int tk = 0; tk < 4; ++tk)
#pragma unroll
                for (int b2 = 0; b2 < 2; ++b2) { float v = (acc[tk][2 * b2] + acc[tk][2 * b2 + 1]) * inv;
                    v += __shfl_xor(v, 1); v += __shfl_xor(v, 2);
                    if (qh == 0) IMP[qi * 32 + 8 * tk + 2 * fq + b2] = v; }
#pragma unroll
            for (int ks = 0; ks < 2; ++ks) {
                const bf16x8 pf = pack8(acc[2 * ks][0], acc[2 * ks][1], acc[2 * ks][2], acc[2 * ks][3], acc[2 * ks + 1][0], acc[2 * ks + 1][1], acc[2 * ks + 1][2], acc[2 * ks + 1][3]);
#pragma unroll
                for (int td = 0; td < 4; ++td) { float vv[8];
#pragma unroll
                    for (int j = 0; j < 8; ++j) { const int key = 32 * ks + 16 * (j >> 2) + 4 * fq + (j & 3); vv[j] = cvf[(size_t)key * 128 + 4 * fr + td]; }
                    const bf16x8 vx = pack8(vv[0], vv[1], vv[2], vv[3], vv[4], vv[5], vv[6], vv[7]);
                    O[td] = __builtin_amdgcn_mfma_f32_16x16x32_bf16(vx, pf, O[td], 0, 0, 0); } }
            const float g0 = sigmoidf_(A.PROJ[mq * NP + C_GATE + (kvh * 4 + qh) * 3 + 0]) * inv;
            float* OC = (float*)(lds + S2_OC);
#pragma unroll
            for (int td = 0; td < 4; ++td)
#pragma unroll
                for (int i = 0; i < 4; ++i) OC[(16 * fq + 4 * i + td) * 16 + fr] = g0 * O[td][i];
        }
        (void)mrun; (void)lrun; (void)keep;
    }
    __syncthreads();
    if (tid < 128) { const int i = tid >> 5, j = tid & 31; bool sel = (j == 0 || j == 31);
        if (j >= 1 && j <= 30) { const float vj = IMP[i * 32 + j]; int rk = 0;
            for (int q = 1; q <= 30; ++q) { const float vi = IMP[i * 32 + q]; rk += (vi > vj || (vi == vj && q < j)) ? 1 : 0; }
            sel = rk < 13; }
        if (sel) { atomicOr(MK + i, 1u << j); atomicOr(MK + 4, 1u << j); } }
    __syncthreads();
    if (tid == 0) { const unsigned um = MK[4]; int n = 0;
        for (int j = 0; j < 32; ++j) if ((um >> j) & 1u) ITEMS[1 + n++] = j;
        ITEMS[1 + n++] = 32;
        for (int jb = 0; jb < 9; ++jb) ITEMS[1 + n++] = 64 + jb;
        ITEMS[0] = n; }
    __syncthreads();
    {
        const int nitems = ITEMS[0]; const unsigned tm = MK[qi];
        f32x4 Os[4], Ow[4]; float ms = NEG_INF, lsum = 0.f, mw = NEG_INF, lw = 0.f;
#pragma unroll
        for (int td = 0; td < 4; ++td) { Os[td] = (f32x4){0.f, 0.f, 0.f, 0.f}; Ow[td] = (f32x4){0.f, 0.f, 0.f, 0.f}; }
        const float* wb = A.state_win + ((size_t)l * NSB + sb) * 512 * 256 + kvh * 64;
        for (int it = wave; it < nitems; it += NWAVES) {
            const int code = ITEMS[1 + it]; bool keep[4][4];
            if (code < 64) {
                const int j = code;
                if (j < 32) { const int phys = A.page_table[sb * NPAGES + (j >> 1)];
                    const float* base = A.cache + ((((size_t)l * NPOOL + phys) * 2 + kvh) * 128 + (j & 1) * 64) * 256;
                    const bool tsel = ((tm >> j) & 1u) != 0u;
#pragma unroll
                    for (int tk = 0; tk < 4; ++tk)
#pragma unroll
                        for (int i = 0; i < 4; ++i) keep[tk][i] = tsel;
                    s2_block<true>(base + 128, base + 192, 256, 64, qf, keep, Os, ms, lsum, fr, fq);
                } else {
#pragma unroll
                    for (int tk = 0; tk < 4; ++tk)
#pragma unroll
                        for (int i = 0; i < 4; ++i) { const int key = 16 * tk + 4 * fq + i; keep[tk][i] = key <= qi; }
                    s2_block<false>(A.KS + ((size_t)MP + sb * 4) * 128 + kvh * 64, A.VS + ((size_t)MP + sb * 4) * 128 + kvh * 64, 128, 4, qf, keep, Os, ms, lsum, fr, fq);
                }
            } else {
                const int jb = code - 64;
                if (jb < 8) {
#pragma unroll
                    for (int tk = 0; tk < 4; ++tk)
#pragma unroll
                        for (int i = 0; i < 4; ++i) { const int r = 64 * jb + 16 * tk + 4 * fq + i; keep[tk][i] = r >= qi; }
                    s2_block<true>(wb + (size_t)(64 * jb) * 256, wb + (size_t)(64 * jb) * 256 + 128, 256, 64, qf, keep, Ow, mw, lw, fr, fq);
                } else {
#pragma unroll
                    for (int tk = 0; tk < 4; ++tk)
#pragma unroll
                        for (int i = 0; i < 4; ++i) { const int key = 16 * tk + 4 * fq + i; keep[tk][i] = key <= qi; }
                    s2_block<false>(A.KW + ((size_t)MP + sb * 4) * 128 + kvh * 64, A.VW + ((size_t)MP + sb * 4) * 128 + kvh * 64, 128, 4, qf, keep, Ow, mw, lw, fr, fq);
                }
            }
        }
        lsum += __shfl_xor(lsum, 16); lsum += __shfl_xor(lsum, 32); lw += __shfl_xor(lw, 16); lw += __shfl_xor(lw, 32);
        float* Ps = (float*)(lds + S2_MG + (wave * 2 + 0) * S2_MG_STRIDE); float* Pw = (float*)(lds + S2_MG + (wave * 2 + 1) * S2_MG_STRIDE);
#pragma unroll
        for (int td = 0; td < 4; ++td)
#pragma unroll
            for (int i = 0; i < 4; ++i) { Ps[(16 * fq + 4 * i + td) * 16 + fr] = Os[td][i]; Pw[(16 * fq + 4 * i + td) * 16 + fr] = Ow[td][i]; }
        if (fq == 0) { Ps[1024 + fr] = ms; Ps[1040 + fr] = lsum; Pw[1024 + fr] = mw; Pw[1040 + fr] = lw; }
    }
    __syncthreads();
    {
        const int q = tid & 15, i = q >> 2, hh = q & 3; const size_t m = (size_t)MP + sb * 4 + i;
        const float* OC = (const float*)(lds + S2_OC);
        float res[2];
#pragma unroll
        for (int k = 0; k < 2; ++k) res[k] = OC[((tid >> 4) + 32 * k) * 16 + q];
#pragma unroll
        for (int br = 0; br < 2; ++br) {
            float M = NEG_INF;
#pragma unroll
            for (int w = 0; w < NWAVES; ++w) M = fmaxf(M, ((const float*)(lds + S2_MG + (w * 2 + br) * S2_MG_STRIDE))[1024 + q]);
            float L = 0.f, o0 = 0.f, o1 = 0.f;
#pragma unroll
            for (int w = 0; w < NWAVES; ++w) { const float* P = (const float*)(lds + S2_MG + (w * 2 + br) * S2_MG_STRIDE);
                const float f = ex2(P[1024 + q] - M);
                L += P[1040 + q] * f; o0 += P[(tid >> 4) * 16 + q] * f; o1 += P[((tid >> 4) + 32) * 16 + q] * f; }
            const float g = sigmoidf_(A.PROJ[m * NP + C_GATE + (kvh * 4 + hh) * 3 + 1 + br]) / fmaxf(L, 1e-30f);
            res[0] += g * o0; res[1] += g * o1;
        }
#pragma unroll
        for (int k = 0; k < 2; ++k) A.MIX[m * 1024 + 512 + (kvh * 4 + hh) * 64 + (tid >> 4) + 32 * k] = (bf16)f2bf(res[k]);
    }
}

constexpr int CW_CMPQ = 256;
__device__ __forceinline__ void compress_pull(const CmpArgs& A, unsigned char* lds, unsigned* head, volatile LAS int* slot, int max_batches, int tid) {
    for (int nb = 0; nb < max_batches; ++nb) {
        __syncthreads();
        if (tid == 0) *slot = (int)__hip_atomic_fetch_add(head, 1u, __ATOMIC_RELAXED, __HIP_MEMORY_SCOPE_AGENT);
        __syncthreads();
        const int b = *slot;
        if (b >= 256) break;
        compress_batch(A, lds, b, true, tid);
    }
    __syncthreads();
}

struct Args { const GAS void* in[22]; GAS float* out; GAS unsigned char* ws; int ph_lo, ph_hi; };
constexpr int PH_PER_LAYER = 10, N_PHASES = 1 + NL * PH_PER_LAYER;
__global__ void __launch_bounds__(NWAVES * 64, 2) hymba_fwd(Args args) {
    extern __shared__ __attribute__((aligned(16))) unsigned char lds[];
    const int G = gridDim.x, bx = blockIdx.x, NGW = G * NWAVES;
    const int wave_s_ = __builtin_amdgcn_readfirstlane((int)threadIdx.x >> 6);
#define TID_NOW() (wave_s_ * 64 + (int)__builtin_amdgcn_mbcnt_hi(~0u, __builtin_amdgcn_mbcnt_lo(~0u, 0u)))
#define SUB_IDS int tid = TID_NOW(); asm volatile("" : "+v"(tid)); const int lane = tid & 63, wave = __builtin_amdgcn_readfirstlane(tid >> 6), gw = bx * NWAVES + wave; (void)lane; (void)gw; (void)wave;
#define PHASE_IDS int tid = TID_NOW(); asm volatile("" : "+v"(tid)); const int lane = tid & 63, wave = __builtin_amdgcn_readfirstlane(tid >> 6), gw = bx * NWAVES + wave; (void)lane; (void)gw; const __attribute__((address_space(4))) unsigned long long* ka_ = (const __attribute__((address_space(4))) unsigned long long*)__builtin_amdgcn_kernarg_segment_ptr(); asm volatile("" : "+s"(ka_)); GAS unsigned char* wsg_ = (GAS unsigned char*)ka_[23]; unsigned char* wsl = (unsigned char*)wsg_;
#define x_prompt ((const float*)(const GAS float*)ka_[0])
#define x_sample ((const float*)(const GAS float*)ka_[1])
#define cache_kv ((const float*)(const GAS float*)ka_[2])
#define page_table ((const int*)(const GAS int*)ka_[3])
#define state_win ((const float*)(const GAS float*)ka_[4])
#define state_gdn ((const float*)(const GAS float*)ka_[5])
#define state_conv ((const float*)(const GAS float*)ka_[6])
#define norm_mix ((const float*)(const GAS float*)ka_[7])
#define w_in ((const float*)(const GAS float*)ka_[8])
#define conv_w ((const float*)(const GAS float*)ka_[9])
#define a_log ((const float*)(const GAS float*)ka_[10])
#define dt_bias ((const float*)(const GAS float*)ka_[11])
#define gdn_norm ((const float*)(const GAS float*)ka_[12])
#define cmp_pe_k ((const float*)(const GAS float*)ka_[13])
#define cmp_w_k ((const float*)(const GAS float*)ka_[14])
#define cmp_pe_v ((const float*)(const GAS float*)ka_[15])
#define cmp_w_v ((const float*)(const GAS float*)ka_[16])
#define w_out ((const float*)(const GAS float*)ka_[17])
#define norm_mlp ((const float*)(const GAS float*)ka_[18])
#define w_up ((const float*)(const GAS float*)ka_[19])
#define w_down ((const float*)(const GAS float*)ka_[20])
#define norm_final ((const float*)(const GAS float*)ka_[21])
#define out ((float*)(GAS float*)ka_[22])
#define WIN_T ((bf16*)(wsl + WS_WIN))
#define WOUT_T ((bf16*)(wsl + WS_WOUT))
#define WUP_T ((bf16*)(wsl + WS_WUP))
#define WDN_T ((bf16*)(wsl + WS_WDN))
#define CMPW ((bf16*)(wsl + WS_CMPW))
#define HB ((bf16*)(wsl + WS_HB))
#define PROJ ((float*)(wsl + WS_PROJ))
#define X1 ((bf16*)(wsl + WS_X1))
#define X2 ((bf16*)(wsl + WS_X2))
#define MIX ((bf16*)(wsl + WS_MIX))
#define HID ((bf16*)(wsl + WS_HID))
#define QN ((float*)(wsl + WS_QN))
#define KN ((float*)(wsl + WS_KN))
#define VG ((float*)(wsl + WS_VG))
#define OG ((float*)(wsl + WS_OG))
#define GG ((float*)(wsl + WS_G))
#define BETA ((float*)(wsl + WS_BETA))
#define KQ ((float*)(wsl + WS_KQ))
#define QB ((bf16*)(wsl + WS_QB))
#define KS ((bf16*)(wsl + WS_KS))
#define VS ((bf16*)(wsl + WS_VS))
#define KW ((bf16*)(wsl + WS_KW))
#define VW ((bf16*)(wsl + WS_VW))
#define CKP ((float*)(wsl + WS_CKP))
#define CVP ((float*)(wsl + WS_CVP))
#define CKS ((float*)(wsl + WS_CKS))
#define CVS ((float*)(wsl + WS_CVS))
#define GK ((bf16*)(wsl + WS_GK))
#define GQ ((bf16*)(wsl + WS_GQ))
#define GKT ((bf16*)(wsl + WS_GKT))
#define GVT ((bf16*)(wsl + WS_GVT))
#define GG2 ((float*)(wsl + WS_GG2))
#define BETA2 ((float*)(wsl + WS_BETA2))
#define WX ((bf16*)(wsl + WS_WX))
#define QX ((bf16*)(wsl + WS_QX))
#define QKX ((bf16*)(wsl + WS_QKX))
#define KTX ((bf16*)(wsl + WS_KTX))
#define U0F ((float*)(wsl + WS_U0F))
#define GL ((float*)(wsl + WS_GL))
#define PARTD ((float*)(wsl + WS_PARTD))
#define SSQ ((float*)(wsl + WS_SS))
#define RSC ((float*)(wsl + WS_RS))
#define PARTG ((float*)(wsl + WS_PARTG))
    LAS unsigned char* ldsl = (LAS unsigned char*)lds;

    const int lo = args.ph_lo, hi = args.ph_hi;
    { const int t0_ = TID_NOW(); if (t0_ < 16) ((LAS unsigned*)(ldsl + MISC_OFF))[t0_] = 0u; }
    __syncthreads();
    XcdBarrier bar = xcd_barrier_post((unsigned*)((unsigned char*)args.ws + WS_CTL) + CW_BAR, (volatile LAS unsigned*)(ldsl + MISC_OFF), TID_NOW() == 0);
#define BOTH(k) (lo <= (k) && (k) + 1 < hi)
#define GRID_BAR(k) do { if (BOTH(k)) { for (int rb_ = 0; rb_ < REP_BAR; ++rb_) xcd_barrier(bar, TID_NOW() == 0); } } while (0)
#ifndef REP_PG
#define REP_PG 1
#endif
#ifndef REP_PA
#define REP_PA 1
#endif
#ifndef REP_BAR
#define REP_BAR 1
#endif
#ifndef REP_GSMP
#define REP_GSMP 1
#endif
#ifndef REP_P0
#define REP_P0 1
#endif
#ifndef REP_LIGHT
#define REP_LIGHT 1
#endif
#ifndef REP_PB_ROW
#define REP_PB_ROW 1
#endif
#ifndef REP_PB_PREP
#define REP_PB_PREP 1
#endif
#ifndef REP_PB_CMP
#define REP_PB_CMP 1
#endif
#ifndef REP_PB_COPY
#define REP_PB_COPY 1
#endif
#ifndef REP_PB2
#define REP_PB2 1
#endif
#ifndef REP_SCAN
#define REP_SCAN 1
#endif
#ifndef REP_ATTP
#define REP_ATTP 1
#endif
#ifndef REP_ATTS
#define REP_ATTS 1
#endif
#ifndef REP_GEMM
#define REP_GEMM 1
#endif
#define EN(i) (((PH_MASK_T) >> (i)) & 1u)
#define SUB(i) (((SUB_MASK_T) >> (i)) & 1u)
#define IN(k) (lo <= (k) && (k) < hi)

    if (IN(0)) { PHASE_IDS
        for (int rep0 = 0; rep0 < REP_P0; ++rep0) {
        LAS float* scr = (LAS float*)(ldsl + wave * 16384);
        constexpr int I_IN = 16 * 112, I_OUT = 16 * 32, I_UP = 16 * 128, I_DN = 64 * 32, I_C = 32 * 2, I_L = I_IN + I_OUT + I_UP + I_DN + 2 * I_C;
        for (int it = gw; it < NL * I_L; it += NGW) {
            const int l = it / I_L; int r = it % I_L;
            if (r < I_IN) { transpose_item(w_in + (size_t)l * DM * NPROJ, DM, NPROJ, NP, WIN_T + (size_t)l * NP * DM, scr, r, lane, l > 0 ? norm_mix + (size_t)l * DM : nullptr); continue; } r -= I_IN;
            if (r < I_OUT) { transpose_item(w_out + (size_t)l * DM * DM, DM, DM, DM, WOUT_T + (size_t)l * DM * DM, scr, r, lane); continue; } r -= I_OUT;
            if (r < I_UP) { transpose_item(w_up + (size_t)l * DM * DFF, DM, DFF, DFF, WUP_T + (size_t)l * DFF * DM, scr, r, lane, norm_mlp + (size_t)l * DM); continue; } r -= I_UP;
            if (r < I_DN) { transpose_item(w_down + (size_t)l * DFF * DM, DFF, DM, DM, WDN_T + (size_t)l * DM * DFF, scr, r, lane); continue; } r -= I_DN;
            if (r < I_C) { transpose_item(cmp_w_k + (size_t)l * 2048 * 64, 2048, 64, 64, CMPW + (size_t)((l * 2 + 0) * 64) * 2048, scr, r, lane); continue; } r -= I_C;
            transpose_item(cmp_w_v + (size_t)l * 2048 * 64, 2048, 64, 64, CMPW + (size_t)((l * 2 + 1) * 64) * 2048, scr, r, lane);
        }
        for (int m = gw; m < MT; m += NGW) { const float* xr = (m < MP) ? x_prompt + (size_t)m * DM : x_sample + (size_t)(m - MP) * DM; rms_row(xr, false, norm_mix, HB + (size_t)m * DM, nullptr, lane); }
        for (int m = bx * NWAVES * 64 + tid; m < MT; m += G * NWAVES * 64) RSC[m] = 1.f;
        }
    }

    GRID_BAR(0);
    for (int l = 0; l < NL; ++l) {
        const int pb = 1 + l * PH_PER_LAYER;
        if (IN(pb + 0)) { PHASE_IDS
            pg8::Gemm g{(l == 0) ? HB : X2, WIN_T + (size_t)l * NP * DM, MT, NP, DM, DM}; pg8::StaticOrder S; S.init(MT, NP, G, bx);
            pg8::EpiF32 E{PROJ, NP, RSC};
            _Pragma("unroll 1") for (int rep = 0; rep < REP_PA; ++rep) pg8::gemm_phase<pg8::EpiF32, pg8::StaticOrder, true, true>(ldsl, g, S, E, tid);
            if (l == 0 && bx >= (MT / 256) * (NP / 256) % G) { SUB_IDS CmpArgs CA{PROJ, cache_kv, page_table, cmp_pe_k, cmp_pe_v, CMPW, wsl, 0};
                compress_pull(CA, lds, (unsigned*)(wsl + WS_CTL) + CW_CMPQ, (volatile LAS int*)(ldsl + MISC_OFF + 36), 1, tid); }
        }
        GRID_BAR(pb + 0);
        if (IN(pb + 1)) { PHASE_IDS
            { SUB_IDS PBArgs A{PROJ, state_conv, conv_w, a_log, dt_bias, QN, KN, VG, GG, BETA, KQ, QB, KS, VS, KW, VW, out, l};
              for (int rep = 0; rep < REP_PB_ROW; ++rep) if (gw >= 128) for (int m = gw - 128; m < MT; m += 2 * (NGW - 128)) {
                  const int m2 = m + (NGW - 128); const bool has2 = m2 < MT; PBRegs r0, r1;
                  pb_row_load(A, m, lane, r0); pb_row_load(A, has2 ? m2 : m, lane, r1);
                  __builtin_amdgcn_sched_barrier(0);
                  pb_row(A, m, lane, r0); if (has2) pb_row(A, m2, lane, r1); }
              for (int u = gw; u < MS * 8; u += NGW) pb_sample_head(A, u, lane); }
            { SUB_IDS GPArgs A{PROJ, conv_w, a_log, dt_bias, GK, GQ, GKT, GVT, GG2, BETA2, l};
              for (int rep = 0; rep < REP_PB_PREP; ++rep) for (int u = gw; u < (MP / 8) * 8; u += 2 * NGW) {
                  GPRegs r0, r1; const int u2 = (u + NGW < (MP / 8) * 8) ? u + NGW : u; gdn_prep_load(A, u, lane, r0); gdn_prep_load(A, u2, lane, r1);
                  __builtin_amdgcn_sched_barrier(0);
                  gdn_prep_unit(A, u, lane, r0); gdn_prep_unit(A, u2, lane, r1); } }
            { SUB_IDS CmpArgs A{PROJ, cache_kv, page_table, cmp_pe_k, cmp_pe_v, CMPW, wsl, l};
              if (bx < 16) compress_batch(A, lds, bx, false, tid);
              compress_pull(A, lds, (unsigned*)(wsl + WS_CTL) + CW_CMPQ + 64 * l, (volatile LAS int*)(ldsl + MISC_OFF + 36), 1 << 20, tid); }
        }
        GRID_BAR(pb + 1);
        if (IN(pb + 2)) { PHASE_IDS
            GCArgs A{GK, GQ, GKT, GVT, GG2, BETA2, WX, QX, QKX, KTX, U0F, GL};
            for (int rep = 0; rep < REP_PB2; ++rep) for (int u = gw; u < 32 * 64; u += NGW) gdn_chunk_unit(A, lds + wave * GC_LDS_PER_WAVE, u, lane);
        }
        GRID_BAR(pb + 2);
        if (IN(pb + 3)) {
            { PHASE_IDS GdnArgs GA{QN, KN, VG, GG, BETA, KQ, OG, PROJ, state_gdn, gdn_norm, MIX, out, l};
                for (int rep = 0; rep < REP_GSMP; ++rep) for (int u = gw; u < NSB * 8; u += NGW) gdn_sample_unit(GA, u, lane); }
            { PHASE_IDS
                GS2Args SG{WX, QX, QKX, KTX, U0F, GL, OG, out, l};
                AttArgs AA{QB, KS, VS, KW, VW, CKP, CVP, PROJ, MIX};
                SAttArgs SA{QB, KS, VS, KW, VW, CKS, CVS, PROJ, cache_kv, page_table, state_win, MIX, l};
                unsigned* qhead = (unsigned*)(wsl + WS_CTL) + CW_QUEUE + 64 * l;
                volatile LAS int* slot = (volatile LAS int*)(ldsl + MISC_OFF + 32);
                for (;;) {
                    __syncthreads();
                    if (tid == 0) *slot = (int)__hip_atomic_fetch_add(qhead, 1u, __ATOMIC_RELAXED, __HIP_MEMORY_SCOPE_AGENT);
                    __syncthreads();
                    int u = *slot;
                    constexpr int XP = (REP_ATTP - 1) * 512, XS = (REP_ATTS - 1) * 256, XG = (REP_SCAN - 1) * 32;
                    if (u >= 800 + XP + XS + XG + 128) break;
                    if (u >= 32 && u < 928) { const int g_ = (u - 32) / 7, k_ = (u - 32) % 7;
                        u = (k_ < 4) ? 32 + 4 * g_ + k_ : (k_ < 6) ? 544 + 2 * g_ + (k_ - 4) : 800 + g_; }
                    if (u >= 800 + XP + XS + XG) {
                        const int sb = u - (800 + XP + XS + XG); const f32x4* src = (const f32x4*)(state_win + ((size_t)l * NSB + sb) * 512 * 256) + 256; f32x4* dst = (f32x4*)(out + O_WINS + ((size_t)l * NSB + sb) * 512 * 256);
                        for (int i = tid; i < 508 * 64; i += 8 * NWAVES * 64) { f32x4 v[8];
#pragma unroll
                            for (int k = 0; k < 8; ++k) { const int ii = i + k * NWAVES * 64; v[k] = src[ii < 508 * 64 ? ii : i]; }
#pragma unroll
                            for (int k = 0; k < 8; ++k) { const int ii = i + k * NWAVES * 64; if (ii < 508 * 64) dst[ii] = v[k]; } }
                        continue; }
                    if (u >= 800) { int v = u - 800; if (v < XP) u = 32 + (v & 511); else { v -= XP; if (v < XS) u = 544 + (v & 255); else u = (v - XS) & 31; } }
                    int tq = TID_NOW(); asm volatile("" : "+v"(tq));
                    if (u < 32) gdn_scan3_block(SG, lds, u, tq);
                    else if (u < 32 + 512) nsa_prompt_unit(AA, lds, u - 32, tq);
                    else nsa_sample_unit(SA, lds, u - 544, tq);
                }
            }
        }
        GRID_BAR(pb + 3);
        if (IN(pb + 4)) { PHASE_IDS
            const float gnl = gdn_norm[l * 64 + lane];
            for (int rep = 0; rep < REP_LIGHT; ++rep) for (int m = gw; m < MP; m += NGW) {
                float ov[8], zv[8];
#pragma unroll
                for (int h = 0; h < 8; ++h) { ov[h] = OG[(size_t)m * 512 + h * 64 + lane]; zv[h] = PROJ[(size_t)m * NP + C_Z + h * 64 + lane]; }
                __builtin_amdgcn_sched_barrier(0);
#pragma unroll
                for (int h = 0; h < 8; ++h) { const float ms = dpp_sum(ov[h] * ov[h]) * (1.f / 64.f);
                    MIX[(size_t)m * 1024 + h * 64 + lane] = (bf16)f2bf(ov[h] * (1.f / sqrtf(ms + 1e-6f)) * gnl * siluf_(zv[h])); } }
        }
        GRID_BAR(pb + 4);
        if (IN(pb + 5)) { PHASE_IDS
            { pg8::Gemm g{MIX, WOUT_T + (size_t)l * DM * DM, MP, DM, DM, DM}; pg8::StaticOrder S; S.init(MP, DM, G, bx);
              pg8::EpiResid E{(l == 0) ? (const void*)x_prompt : (const void*)X2, l != 0, X1, DM, SSQ};
              pg8::gemm_phase<pg8::EpiResid, pg8::StaticOrder, true, true>(ldsl, g, S, E, tid); }
            { pg8::Gemm g{MIX, WOUT_T + (size_t)l * DM * DM, MT, DM, PD_KL, DM}; pg8::SplitKOrder S; S.init(MP / 256, MS / 256, DM / 256, PD_KS, PD_KL, G, bx);
              pg8::EpiPart E{PARTD, DM, MP, MS};
              pg8::gemm_phase<pg8::EpiPart, pg8::SplitKOrder, false, true>(ldsl, g, S, E, tid); }
        }
        GRID_BAR(pb + 5);
        if (IN(pb + 6)) { PHASE_IDS
            if (wave == 0) { for (int m = bx * 64 + lane; m < MP; m += G * 64) rs_from_parts(SSQ, RSC, m); }
            else for (int m = MP + bx * (NWAVES - 1) + wave - 1; m < MT; m += G * (NWAVES - 1)) { const void* bs = (l == 0) ? (const void*)(x_sample + (size_t)(m - MP) * DM) : (const void*)(X2 + (size_t)m * DM);
                resid_parts_row(bs, l != 0, PARTD + (size_t)(m - MP) * DM, PD_KS, (size_t)MS * DM, X1 + (size_t)m * DM, RSC + m, lane); } }
        GRID_BAR(pb + 6);
        if (IN(pb + 7)) { PHASE_IDS
            pg8::Gemm g{X1, WUP_T + (size_t)l * DFF * DM, MT, DFF, DM, DM}; pg8::StaticOrder S; S.init(MT, DFF, G, bx);
            pg8::EpiRelu2 E{HID, DFF, RSC};
            pg8::gemm_phase<pg8::EpiRelu2, pg8::StaticOrder, true, true>(ldsl, g, S, E, tid);
            if (l + 1 < NL && bx >= (MT / 256) * (DFF / 256) % G) { SUB_IDS CmpArgs CA{PROJ, cache_kv, page_table, cmp_pe_k, cmp_pe_v, CMPW, wsl, l + 1};
                compress_pull(CA, lds, (unsigned*)(wsl + WS_CTL) + CW_CMPQ + 64 * (l + 1), (volatile LAS int*)(ldsl + MISC_OFF + 36), 1, tid); }
        }
        GRID_BAR(pb + 7);
        if (IN(pb + 8)) { PHASE_IDS
            { pg8::Gemm g{HID, WDN_T + (size_t)l * DM * DFF, MP, DM, DFF, DFF}; pg8::StaticOrder S; S.init(MP, DM, G, bx);
              pg8::EpiResid E{(const void*)X1, true, X2, DM, SSQ};
              pg8::gemm_phase<pg8::EpiResid, pg8::StaticOrder, true, true>(ldsl, g, S, E, tid); }
            { pg8::Gemm g{HID, WDN_T + (size_t)l * DM * DFF, MT, DM, PG_KL, DFF}; pg8::SplitKOrder S; S.init(MP / 256, MS / 256, DM / 256, PG_KS, PG_KL, G, bx);
              pg8::EpiPart E{PARTG, DM, MP, MS};
              pg8::gemm_phase<pg8::EpiPart, pg8::SplitKOrder, false, true>(ldsl, g, S, E, tid); }
        }
        GRID_BAR(pb + 8);
        if (IN(pb + 9)) { PHASE_IDS
            const float* gn = (l + 1 < NL) ? norm_mix + (size_t)(l + 1) * DM : norm_final; const bool fin = !(l + 1 < NL);
            if (!fin) {
                if (wave == 0) { for (int m = bx * 64 + lane; m < MP; m += G * 64) rs_from_parts(SSQ, RSC, m); }
                else for (int m = MP + bx * (NWAVES - 1) + wave - 1; m < MT; m += G * (NWAVES - 1))
                    resid_parts_row(X1 + (size_t)m * DM, true, PARTG + (size_t)(m - MP) * DM, PG_KS, (size_t)MS * DM, X2 + (size_t)m * DM, RSC + m, lane);
            } else {
            for (int m = gw; m < MP; m += 2 * NGW) { const int m2 = m + NGW;
                if (m2 < MP) rms_row2(X2 + (size_t)m * DM, X2 + (size_t)m2 * DM, true, gn, fin ? nullptr : HB + (size_t)m * DM, fin ? nullptr : HB + (size_t)m2 * DM, fin ? out + O_YP + (size_t)m * DM : nullptr, fin ? out + O_YP + (size_t)m2 * DM : nullptr, lane);
                else rms_row(X2 + (size_t)m * DM, true, gn, fin ? nullptr : HB + (size_t)m * DM, fin ? out + O_YP + (size_t)m * DM : nullptr, lane); }
            for (int m = MP + gw; m < MT; m += NGW)
                rms_row_parts(X1 + (size_t)m * DM, true, PARTG + (size_t)(m - MP) * DM, PG_KS, (size_t)MS * DM, X2 + (size_t)m * DM, gn, fin ? nullptr : HB + (size_t)m * DM, fin ? out + O_YP + (size_t)m * DM : nullptr, lane);
            }
        }
        GRID_BAR(pb + 9);
    }
#undef IN
}

#undef x_prompt
#undef x_sample
#undef cache_kv
#undef page_table
#undef state_win
#undef state_gdn
#undef state_conv
#undef norm_mix
#undef w_in
#undef conv_w
#undef a_log
#undef dt_bias
#undef gdn_norm
#undef cmp_pe_k
#undef cmp_w_k
#undef cmp_pe_v
#undef cmp_w_v
#undef w_out
#undef norm_mlp
#undef w_up
#undef w_down
#undef norm_final
#undef out
#ifndef MK_PER_PHASE
#define MK_PER_PHASE 0
#endif
typedef void (*kfn_t)(Args); static const kfn_t K_ALL = hymba_fwd;
extern "C" void kernel_launch(void* const* d_in, const int* in_sizes, int n_in, void* d_out, int out_size, void* d_ws, size_t ws_size, hipStream_t stream) {
    static int grid = 0;
    if (grid == 0) {
        if (n_in != 22 || out_size != (int)O_END || ws_size < WS_END) { fprintf(stderr, "kernel_launch: unexpected shapes (n_in %d, out %d, ws %zu)\n", n_in, out_size, ws_size); grid = -1; return; }
        int dev = 0, cus = 0, per_cu = 0;
        if (hipGetDevice(&dev) != hipSuccess || hipDeviceGetAttribute(&cus, hipDeviceAttributeMultiprocessorCount, dev) != hipSuccess) { grid = -1; return; }
        if (hipFuncSetAttribute((const void*)K_ALL, hipFuncAttributeMaxDynamicSharedMemorySize, LDS_BYTES) != hipSuccess) { fprintf(stderr, "kernel_launch: hipFuncSetAttribute failed\n"); grid = -1; return; }
        if (hipOccupancyMaxActiveBlocksPerMultiprocessor(&per_cu, (const void*)K_ALL, NWAVES * 64, LDS_BYTES) != hipSuccess || per_cu < 1) { fprintf(stderr, "kernel_launch: occupancy query says %d blocks per CU\n", per_cu); }
        (void)hipGetLastError();
        grid = cus;
    }
    if (grid < 0) return;
    (void)hipMemsetAsync((char*)d_ws + WS_CTL, 0, CTL_ZERO_BYTES, stream);
    Args a{};
    for (int i = 0; i < 22; ++i) a.in[i] = (const GAS void*)d_in[i];
    a.out = (GAS float*)d_out; a.ws = (GAS unsigned char*)d_ws;
    const dim3 g(grid), b(NWAVES * 64);
#if MK_PER_PHASE
    for (int ph = 0; ph < N_PHASES; ++ph) { a.ph_lo = ph; a.ph_hi = ph + 1; K_ALL<<<g, b, LDS_BYTES, stream>>>(a); }
#else
    a.ph_lo = 0; a.ph_hi = N_PHASES; K_ALL<<<g, b, LDS_BYTES, stream>>>(a);
#endif
}
```

```cpp
#include <hip/hip_runtime.h>
#include <cstdio>
#include <cstdint>
namespace pg8 {
#define PG8_LAS __attribute__((address_space(3)))
typedef unsigned short bf16_t;
typedef short bf16x8 __attribute__((ext_vector_type(8)));
typedef float f32x4 __attribute__((ext_vector_type(4)));
typedef unsigned u32x4 __attribute__((ext_vector_type(4)));
constexpr int BM = 256, BK = 64, HALF = 128, HTB = HALF * BK * 2  , STAGE_BYTES = 8 * HTB, NXCD = 8, WGM = 8;

__host__ __device__ __forceinline__ int lds_byte(int r, int c) { const int st = (r >> 4) * 2 + (c >> 5), rr = r & 15, cc = c & 31, ob = rr * 64 + cc * 2; return st * 1024 + (ob ^ (((ob >> 9) & 1) << 5)); }
__host__ __device__ __forceinline__ void stage_rc(int b, int& R, int& C) { const int st = b / 1024, sb = b % 1024, swz = sb ^ (((sb >> 9) & 1) << 5); R = (st >> 1) * 16 + swz / 64; C = (st & 1) * 32 + (swz % 64) / 2; }
__host__ __device__ __forceinline__ int perm32(int rho) { const int n = rho >> 4, i = rho & 15; return 8 * (i >> 2) + 4 * n + (i & 3); }

struct Unit { int pm, pn, kofs, kc; };
struct Gemm { const bf16_t* A; const bf16_t* Bt; int M, N, K, ld; };

struct StaticOrder {
    int nM, nN, nwg, G, c;
    __host__ __device__ void init(int M, int N, int G_, int c_) { nM = M / BM; nN = N / BM; nwg = nM * nN; G = G_; c = c_; }
    __host__ __device__ bool next(int i, Unit& u) const {
        const long L = (long)i * G + c; if (L >= nwg) return false;
        int wgid = (int)L; { const int q = nwg / NXCD, r = nwg % NXCD, xcd = wgid % NXCD, off = wgid / NXCD; wgid = (xcd < r ? xcd * (q + 1) : r * (q + 1) + (xcd - r) * q) + off; }
        const int nig = WGM * nN, gid = wgid / nig, fm = gid * WGM, gsz = (nM - fm) < WGM ? (nM - fm) : WGM;
        u.pm = fm + ((wgid % nig) % gsz); u.pn = (wgid % nig) / gsz; u.kofs = 0; u.kc = 0; return true;
    }
    __device__ __forceinline__ void a_ready(const Unit&) const {}
    __device__ __forceinline__ void done(const Unit&) const {}
};

__device__ __forceinline__ void flag_spin(const unsigned* f, unsigned target) {
    unsigned sp = 0;
    while (__hip_atomic_load(f, __ATOMIC_RELAXED, __HIP_MEMORY_SCOPE_AGENT) < target) { __builtin_amdgcn_s_sleep(1); if (++sp > (1u << 21)) break; }
    asm volatile("" ::: "memory"); __builtin_amdgcn_sched_barrier(0);
}
__device__ __forceinline__ void flag_wait(const unsigned* f, unsigned target) {
    flag_spin(f, target);
    __builtin_amdgcn_fence(__ATOMIC_ACQUIRE, "agent");
    asm volatile("s_waitcnt vmcnt(0)" ::: "memory");
}
__device__ __forceinline__ float ld_agent(const float* p) { return __builtin_bit_cast(float, __hip_atomic_load((const unsigned*)p, __ATOMIC_RELAXED, __HIP_MEMORY_SCOPE_AGENT)); }
struct StaticOrderG : StaticOrder {
    const unsigned* f; unsigned target; int pmw; mutable bool ok;
    __device__ __forceinline__ void a_ready(const Unit& u) const { if (u.pm >= pmw && !ok) { flag_spin(f, target); ok = true; } }
};

__device__ __forceinline__ unsigned cvt_pk_bf16(float lo, float hi) { unsigned r; asm volatile("v_cvt_pk_bf16_f32 %0, %1, %2" : "=v"(r) : "v"(lo), "v"(hi)); return r; }

struct EpiF32 {
    static constexpr bool PERM = false, AFTER_DRAIN = false;
    float* O; int ldc; const float* RS; int rsplit; const unsigned* f; unsigned target; mutable bool ok;
    __device__ __forceinline__ void operator()(const f32x4 (&acc)[2][2][4][2], const Unit& u, int wr, int wc, int fr, int fq) const {
        const int row0 = u.pm * BM + wr * 64 + fr, col0 = u.pn * BM + wc * 32 + 4 * fq;
        if (!ok) { flag_spin(f, target); ok = true; }
        float rs[2][4];
#pragma unroll
        for (int ai = 0; ai < 2; ++ai)
#pragma unroll
            for (int m = 0; m < 4; ++m) { const int r_ = row0 + ai * HALF + m * 16; rs[ai][m] = ld_agent(RS + (r_ < rsplit ? r_ : rsplit + (r_ - rsplit) * 32)); }
#pragma unroll
        for (int ai = 0; ai < 2; ++ai)
#pragma unroll
            for (int m = 0; m < 4; ++m) { float* rowp = O + (size_t)(row0 + ai * HALF + m * 16) * ldc + col0;
#pragma unroll
                for (int bj = 0; bj < 2; ++bj)
#pragma unroll
                    for (int n = 0; n < 2; ++n) *(f32x4*)(rowp + bj * HALF + n * 16) = acc[ai][bj][m][n] * rs[ai][m]; }
    }
};
struct EpiResid {
    static constexpr bool PERM = false, AFTER_DRAIN = false;
    const void* base; bool base_bf; bf16_t* O; int ldc; float* SS;
    __device__ __forceinline__ void operator()(const f32x4 (&acc)[2][2][4][2], const Unit& u, int wr, int wc, int fr, int fq) const {
        const int row0 = u.pm * BM + wr * 64 + fr, col0 = u.pn * BM + wc * 32 + 4 * fq;
        typedef unsigned u32x2_ __attribute__((ext_vector_type(2)));
#pragma unroll
        for (int ai = 0; ai < 2; ++ai)
#pragma unroll
            for (int m = 0; m < 4; ++m) { const size_t off = (size_t)(row0 + ai * HALF + m * 16) * ldc + col0; float sq = 0.f;
#pragma unroll
                for (int bj = 0; bj < 2; ++bj)
#pragma unroll
                    for (int n = 0; n < 2; ++n) { const size_t o2 = off + bj * HALF + n * 16; f32x4 r;
                        if (base_bf) { const u32x2_ w = *(const u32x2_*)((const bf16_t*)base + o2);
                            r = (f32x4){__builtin_bit_cast(float, w.x << 16), __builtin_bit_cast(float, w.x & 0xffff0000u), __builtin_bit_cast(float, w.y << 16), __builtin_bit_cast(float, w.y & 0xffff0000u)}; }
                        else r = *(const f32x4*)((const float*)base + o2);
                        r += acc[ai][bj][m][n];
                        u32x2_ ow; ow.x = cvt_pk_bf16(r[0], r[1]); ow.y = cvt_pk_bf16(r[2], r[3]); *(u32x2_*)(O + o2) = ow;
                        const float q0 = __builtin_bit_cast(float, ow.x << 16), q1 = __builtin_bit_cast(float, ow.x & 0xffff0000u), q2 = __builtin_bit_cast(float, ow.y << 16), q3 = __builtin_bit_cast(float, ow.y & 0xffff0000u);
                        sq += (q0 * q0 + q1 * q1) + (q2 * q2 + q3 * q3); }
                sq += __shfl_xor(sq, 16); sq += __shfl_xor(sq, 32);
                if (fq == 0) SS[(size_t)(row0 + ai * HALF + m * 16) * 16 + u.pn * 4 + wc] = sq; }
    }
};
struct EpiRelu2 {
    static constexpr bool PERM = true, AFTER_DRAIN = false;
    bf16_t* O; int ldc; const float* RS; int rsplit; const unsigned* f; unsigned target; mutable bool ok;
    __device__ __forceinline__ void operator()(const f32x4 (&acc)[2][2][4][2], const Unit& u, int wr, int wc, int fr, int fq) const {
        const int row0 = u.pm * BM + wr * 64 + fr, col0 = u.pn * BM + wc * 32 + 8 * fq;
        if (!ok) { flag_spin(f, target); ok = true; }
        float rs[2][4];
#pragma unroll
        for (int ai = 0; ai < 2; ++ai)
#pragma unroll
            for (int m = 0; m < 4; ++m) { const int r_ = row0 + ai * HALF + m * 16; rs[ai][m] = ld_agent(RS + (r_ < rsplit ? r_ : rsplit + (r_ - rsplit) * 32)); }
#pragma unroll
        for (int ai = 0; ai < 2; ++ai)
#pragma unroll
            for (int m = 0; m < 4; ++m) { bf16_t* rowp = O + (size_t)(row0 + ai * HALF + m * 16) * ldc + col0;
#pragma unroll
                for (int bj = 0; bj < 2; ++bj) { f32x4 v0 = acc[ai][bj][m][0] * rs[ai][m], v1 = acc[ai][bj][m][1] * rs[ai][m];
#pragma unroll
                    for (int i = 0; i < 4; ++i) { const float a = v0[i] > 0.f ? v0[i] : 0.f, b = v1[i] > 0.f ? v1[i] : 0.f; v0[i] = a * a; v1[i] = b * b; }
                    u32x4 w; w.x = cvt_pk_bf16(v0[0], v0[1]); w.y = cvt_pk_bf16(v0[2], v0[3]); w.z = cvt_pk_bf16(v1[0], v1[1]); w.w = cvt_pk_bf16(v1[2], v1[3]);
                    *(u32x4*)(rowp + bj * HALF) = w; } }
    }
};

struct SplitKOrder {
    int pm0, nN, KS, KL, total, G, c;
    __host__ __device__ void init(int pm0_, int nPm, int nN_, int KS_, int KL_, int G_, int c_) { pm0 = pm0_; nN = nN_; KS = KS_; KL = KL_; total = nPm * nN_ * KS_; G = G_; c = c_; }
    __host__ __device__ bool next(int i, Unit& u) const {
        const long L = (long)i * G + c; if (L >= total) return false;
        const int l = (int)L, kc = l % KS, rest = l / KS; u.pn = rest % nN; u.pm = pm0 + rest / nN; u.kofs = kc * KL; u.kc = kc; return true; }
    __device__ __forceinline__ void a_ready(const Unit&) const {}
    __device__ __forceinline__ void done(const Unit&) const {}
};
struct EpiPart {
    static constexpr bool PERM = false, AFTER_DRAIN = false;
    float* P; int ldc; int row0; int rows;
    __device__ __forceinline__ void operator()(const f32x4 (&acc)[2][2][4][2], const Unit& u, int wr, int wc, int fr, int fq) const {
        const int rowl = u.pm * BM - row0 + wr * 64 + fr, col0 = u.pn * BM + wc * 32 + 4 * fq;
        float* base = P + (size_t)u.kc * rows * ldc;
#pragma unroll
        for (int ai = 0; ai < 2; ++ai)
#pragma unroll
            for (int m = 0; m < 4; ++m) { float* rowp = base + (size_t)(rowl + ai * HALF + m * 16) * ldc + col0;
#pragma unroll
                for (int bj = 0; bj < 2; ++bj)
#pragma unroll
                    for (int n = 0; n < 2; ++n) *(f32x4*)(rowp + bj * HALF + n * 16) = acc[ai][bj][m][n]; }
    }
};
template <class Epi, class Sched, bool ALIGN_EPI = false, bool SP2 = false>
__device__ __forceinline__ void gemm_phase(PG8_LAS unsigned char* lds, const Gemm g, const Sched& S, const Epi& E, int tid_in) {
    int tid = tid_in; asm volatile("" : "+v"(tid));
    const int wid = __builtin_amdgcn_readfirstlane(tid >> 6), lane = tid & 63, wr = wid >> 2, wc = wid & 3, fr = lane & 15, fq = lane >> 4;
    const int K = g.ld, nt = g.K / BK;
    unsigned voffA[2], voffB[2];
#pragma unroll
    for (int i = 0; i < 2; ++i) { int R, C; stage_rc(tid * 16 + i * 8192, R, C); const int Rb = Epi::PERM ? ((R & ~31) + perm32(R & 31)) : R;
        voffA[i] = (unsigned)(R * K + C) * 2u; voffB[i] = (unsigned)(Rb * K + C) * 2u; }
    const size_t kstep = (size_t)(BK * 2);
    const size_t hstep = (size_t)HALF * K * 2;
    const size_t tstep = 2 * hstep;
    const unsigned ldsw = (unsigned)wid * 1024u;
    const int aoff = lds_byte(wr * 64 + fr, fq * 8), boff = lds_byte(wc * 32 + fr, fq * 8);
#define PG8_SA(b, h) (((b) * 2 + (h)) * HTB)
#define PG8_SB(b, h) ((4 + (b) * 2 + (h)) * HTB)
#define PG8_STAGE(bufoff, gbase, voff) do { _Pragma("unroll") for (int _i = 0; _i < 2; ++_i) \
        __builtin_amdgcn_global_load_lds((const unsigned*)((const char*)(gbase) + (voff)[_i]), (PG8_LAS unsigned*)(lds + (bufoff) + ldsw + _i * 8192), 16, 0, 0); } while (0)
#define PG8_LDA(dst, b, h) do { _Pragma("unroll") for (int m = 0; m < 4; ++m) _Pragma("unroll") for (int k = 0; k < 2; ++k) dst[m][k] = *(const PG8_LAS bf16x8*)(lds + PG8_SA(b, h) + aoff + m * 2048 + k * 1024); } while (0)
#define PG8_LDB(dst, b, h) do { _Pragma("unroll") for (int n = 0; n < 2; ++n) _Pragma("unroll") for (int k = 0; k < 2; ++k) dst[n][k] = *(const PG8_LAS bf16x8*)(lds + PG8_SB(b, h) + boff + n * 2048 + k * 1024); } while (0)
#define PG8_MMA(ai, bj, At, Bt) do { __builtin_amdgcn_s_setprio(1); _Pragma("unroll") for (int m = 0; m < 4; ++m) _Pragma("unroll") for (int n = 0; n < 2; ++n) _Pragma("unroll") for (int k = 0; k < 2; ++k) \
        acc[ai][bj][m][n] = __builtin_amdgcn_mfma_f32_16x16x32_bf16(Bt[n][k], At[m][k], acc[ai][bj][m][n], 0, 0, 0); __builtin_amdgcn_s_setprio(0); } while (0)
#define PG8_WAIT_V(n) asm volatile("s_waitcnt vmcnt(" #n ")" ::: "memory")
#define PG8_WAIT_L(n) asm volatile("s_waitcnt lgkmcnt(" #n ")" ::: "memory")
#define PG8_BAR __builtin_amdgcn_s_barrier()
#define PG8_SCHED __builtin_amdgcn_sched_barrier(0)
    Unit cur, nxt; int ui = 0;
    if (!S.next(0, cur)) return;
    f32x4 acc[2][2][4][2];
#pragma unroll
    for (int a = 0; a < 2; ++a)
#pragma unroll
        for (int b = 0; b < 2; ++b)
#pragma unroll
            for (int m = 0; m < 4; ++m)
#pragma unroll
                for (int n = 0; n < 2; ++n) acc[a][b][m][n] = (f32x4){0.f, 0.f, 0.f, 0.f};
    bf16x8 At[4][2], B0[2][2], B1[2][2];
    const char* cA = (const char*)g.A + (size_t)cur.pm * tstep + (size_t)cur.kofs * 2; const char* cB = (const char*)g.Bt + (size_t)cur.pn * tstep + (size_t)cur.kofs * 2;
    S.a_ready(cur);
    if constexpr (SP2) {
        PG8_STAGE(PG8_SB(0, 0), cB, voffB); PG8_STAGE(PG8_SB(0, 1), cB + hstep, voffB); PG8_STAGE(PG8_SA(0, 0), cA, voffA); PG8_STAGE(PG8_SA(0, 1), cA + hstep, voffA);
        if (wr == 1) PG8_BAR;
        PG8_WAIT_V(2); PG8_BAR;
        PG8_STAGE(PG8_SB(1, 0), cB + kstep, voffB); PG8_STAGE(PG8_SA(1, 0), cA + kstep, voffA); PG8_STAGE(PG8_SB(1, 1), cB + hstep + kstep, voffB);
        PG8_WAIT_V(6); PG8_BAR;
    } else {
        PG8_STAGE(PG8_SB(0, 0), cB, voffB); PG8_STAGE(PG8_SA(0, 0), cA, voffA); PG8_STAGE(PG8_SB(0, 1), cB + hstep, voffB); PG8_STAGE(PG8_SA(0, 1), cA + hstep, voffA);
        if (wr == 1) PG8_BAR;
        PG8_WAIT_V(4); PG8_BAR;
        PG8_STAGE(PG8_SB(1, 0), cB + kstep, voffB); PG8_STAGE(PG8_SA(1, 0), cA + kstep, voffA); PG8_STAGE(PG8_SB(1, 1), cB + hstep + kstep, voffB);
        PG8_WAIT_V(6); PG8_BAR;
    }
    for (;;) {
        const bool has_next = S.next(ui + 1, nxt);
        const char* nA = has_next ? (const char*)g.A + (size_t)nxt.pm * tstep + (size_t)nxt.kofs * 2 : cA; const char* nB = has_next ? (const char*)g.Bt + (size_t)nxt.pn * tstep + (size_t)nxt.kofs * 2 : cB;
        for (int t = 0; t < nt; t += 2) {
            const bool last = (t == nt - 2);
            const char* a1 = cA + (size_t)(t + 1) * kstep;
            const char* a2 = last ? nA : cA + (size_t)(t + 2) * kstep; const char* b2 = last ? nB : cB + (size_t)(t + 2) * kstep;
            const char* a3 = a2 + kstep; const char* b3 = b2 + kstep;
            if (last && has_next) S.a_ready(nxt);
            if constexpr (SP2) {
            PG8_LDB(B0, 0, 0); PG8_LDB(B1, 0, 1); PG8_SCHED; PG8_LDA(At, 0, 0); PG8_STAGE(PG8_SA(1, 1), a1 + hstep, voffA);
            PG8_WAIT_V(8); PG8_WAIT_L(0); PG8_BAR; PG8_MMA(0, 0, At, B0); PG8_MMA(0, 1, At, B1); PG8_BAR; PG8_SCHED;
            PG8_LDA(At, 0, 1); PG8_STAGE(PG8_SB(0, 0), b2, voffB); PG8_STAGE(PG8_SB(0, 1), b2 + hstep, voffB); PG8_STAGE(PG8_SA(0, 0), a2, voffA);
            PG8_WAIT_V(8); PG8_WAIT_L(0); PG8_BAR; PG8_MMA(1, 0, At, B0); PG8_MMA(1, 1, At, B1); PG8_BAR; PG8_SCHED;
            PG8_LDB(B0, 1, 0); PG8_LDB(B1, 1, 1); PG8_SCHED; PG8_LDA(At, 1, 0); PG8_STAGE(PG8_SA(0, 1), a2 + hstep, voffA);
            PG8_WAIT_V(8); PG8_WAIT_L(0); PG8_BAR; PG8_MMA(0, 0, At, B0); PG8_MMA(0, 1, At, B1); PG8_BAR; PG8_SCHED;
            PG8_LDA(At, 1, 1); PG8_STAGE(PG8_SB(1, 0), b3, voffB); PG8_STAGE(PG8_SB(1, 1), b3 + hstep, voffB); PG8_STAGE(PG8_SA(1, 0), a3, voffA);
            PG8_WAIT_V(8); PG8_WAIT_L(0); PG8_BAR; PG8_MMA(1, 0, At, B0); PG8_MMA(1, 1, At, B1); PG8_BAR; PG8_SCHED;
            } else {
            PG8_LDB(B0, 0, 0); PG8_SCHED; PG8_LDA(At, 0, 0); PG8_STAGE(PG8_SA(1, 1), a1 + hstep, voffA);
            PG8_WAIT_L(8); PG8_BAR; PG8_WAIT_L(0); PG8_MMA(0, 0, At, B0); PG8_BAR; PG8_SCHED;
            PG8_LDB(B1, 0, 1); PG8_STAGE(PG8_SB(0, 0), b2, voffB);
            PG8_BAR; PG8_WAIT_L(0); PG8_MMA(0, 1, At, B1); PG8_BAR;
            PG8_LDA(At, 0, 1); PG8_STAGE(PG8_SA(0, 0), a2, voffA);
            PG8_BAR; PG8_WAIT_L(0); PG8_MMA(1, 0, At, B0); PG8_BAR; PG8_SCHED;
            PG8_STAGE(PG8_SB(0, 1), b2 + hstep, voffB);
            PG8_WAIT_V(6); PG8_BAR; PG8_MMA(1, 1, At, B1); PG8_BAR;
            PG8_LDB(B0, 1, 0); PG8_SCHED; PG8_LDA(At, 1, 0); PG8_STAGE(PG8_SA(0, 1), a2 + hstep, voffA);
            PG8_WAIT_L(8); PG8_BAR; PG8_WAIT_L(0); PG8_MMA(0, 0, At, B0); PG8_BAR; PG8_SCHED;
            PG8_LDB(B1, 1, 1); PG8_STAGE(PG8_SB(1, 0), b3, voffB);
            PG8_BAR; PG8_WAIT_L(0); PG8_MMA(0, 1, At, B1); PG8_BAR;
            PG8_LDA(At, 1, 1); PG8_STAGE(PG8_SA(1, 0), a3, voffA);
            PG8_BAR; PG8_WAIT_L(0); PG8_MMA(1, 0, At, B0); PG8_BAR; PG8_SCHED;
            PG8_STAGE(PG8_SB(1, 1), b3 + hstep, voffB);
            PG8_WAIT_V(6); PG8_BAR; PG8_MMA(1, 1, At, B1); PG8_BAR;
            }
        }
        if constexpr (ALIGN_EPI) { if (wr == 0) PG8_BAR; }
        if constexpr (!Epi::AFTER_DRAIN) { E(acc, cur, wr, wc, fr, fq); S.done(cur); }
        if (!has_next) break;
#pragma unroll
        for (int a = 0; a < 2; ++a)
#pragma unroll
            for (int b = 0; b < 2; ++b)
#pragma unroll
                for (int m = 0; m < 4; ++m)
#pragma unroll
                    for (int n = 0; n < 2; ++n) acc[a][b][m][n] = (f32x4){0.f, 0.f, 0.f, 0.f};
        cur = nxt; cA = nA; cB = nB; ++ui;
        if constexpr (ALIGN_EPI) { if (wr == 1) PG8_BAR; }
    }
    PG8_WAIT_V(0);
    if constexpr (!ALIGN_EPI) { if (wr == 0) PG8_BAR; }
    PG8_BAR;
    if constexpr (Epi::AFTER_DRAIN) { E.fused(acc, cur, wr, wc, fr, fq, lds, wid, lane); S.done(cur); }
#undef PG8_SA
#undef PG8_SB
#undef PG8_STAGE
#undef PG8_LDA
#undef PG8_LDB
#undef PG8_MMA
#undef PG8_WAIT_V
#undef PG8_WAIT_L
#undef PG8_BAR
#undef PG8_SCHED
}
}

constexpr int DM = 1024, NPB = 4, SEQ = 4096, MP = NPB * SEQ, NSB = 128, DSEQ = 4, MS = NSB * DSEQ, MT = MP + MS;
constexpr int NPROJ = 3368, NP = 3584, DFF = 4096, NL = 2;
constexpr int C_QKV = 0, C_Z = 1536, C_A = 2048, C_BETA = 2056, C_Q = 2064, C_KV = 2576, C_GATE = 3344;
constexpr int PAST = 2048, NPAGES = 16, NPOOL = 2560;
constexpr float C2 = 0.125f * 1.4426950408889634f;
constexpr float NEG_INF = -__builtin_inff();
constexpr size_t O_YP = 0, O_YS = 16777216, O_KVP = 17301504, O_KVS = 34078720, O_WINP = 34603008, O_WINS = 35651584, O_GDNP = 69206016, O_GDNS = 69468160, O_CONVP = 77856768, O_CONVS = 77893632, O_END = 79073280;
constexpr size_t MiB = 1u << 20;
constexpr size_t WS_CTL = 0, CTL_ZERO_BYTES = 1 * MiB;
constexpr size_t WS_WIN = 2 * MiB, WS_WOUT = 16 * MiB, WS_WUP = 20 * MiB, WS_WDN = 36 * MiB, WS_CMPW = 52 * MiB;
constexpr size_t WS_HB = 54 * MiB, WS_PROJ = 88 * MiB, WS_X1 = 320 * MiB, WS_X2 = 386 * MiB, WS_MIX = 452 * MiB, WS_HID = 486 * MiB;
constexpr size_t WS_QN = 618 * MiB, WS_KN = 651 * MiB, WS_VG = 684 * MiB, WS_OG = 717 * MiB, WS_G = 750 * MiB, WS_BETA = 751 * MiB, WS_KQ = 752 * MiB;
constexpr size_t WS_QB = 753 * MiB, WS_KS = 770 * MiB, WS_VS = 775 * MiB, WS_KW = 780 * MiB, WS_VW = 785 * MiB;
constexpr size_t WS_CKP = 790 * MiB, WS_CVP = 791 * MiB, WS_CKS = 792 * MiB, WS_CVS = 796 * MiB;
constexpr size_t WS_GK = 800 * MiB, WS_GQ = 816 * MiB, WS_GKT = 832 * MiB, WS_GVT = 848 * MiB, WS_GG2 = 864 * MiB, WS_BETA2 = 865 * MiB;
constexpr size_t WS_WX = 866 * MiB, WS_QX = 882 * MiB, WS_QKX = 898 * MiB, WS_KTX = 914 * MiB, WS_U0F = 930 * MiB, WS_GL = 962 * MiB, WS_END = 1043 * MiB;
constexpr size_t WS_PARTD = 963 * MiB, WS_PARTG = 979 * MiB;
constexpr size_t WS_SS = 996 * MiB, WS_RS = 998 * MiB;
constexpr int PD_KS = 4, PD_KL = DM / PD_KS, PG_KS = 8, PG_KL = DFF / PG_KS;
constexpr int CW_QUEUE = 64;
constexpr int CW_BAR = 4096;
constexpr size_t XL_BYTES = (size_t)MT * DM * 2;
constexpr int RS_STRIDE = MP + MS * 32;
constexpr int CW_GATE = 512;
constexpr int RING_BYTES = 131072, LDS_BYTES = 147456, MISC_OFF = LDS_BYTES - 64;
constexpr int NWAVES = 8;

#define GAS __attribute__((address_space(1)))
#define LAS __attribute__((address_space(3)))
typedef unsigned short bf16;
typedef unsigned v4u __attribute__((ext_vector_type(4)));
typedef unsigned v2u __attribute__((ext_vector_type(2)));
typedef float f32x4 __attribute__((ext_vector_type(4)));
typedef float f32x16 __attribute__((ext_vector_type(16)));
typedef short bf16x8 __attribute__((ext_vector_type(8)));
typedef short s16x4 __attribute__((ext_vector_type(4)));
#define LDS_WAIT() asm volatile("s_waitcnt lgkmcnt(0)" ::: "memory")
__device__ __forceinline__ unsigned f2bf(float f) { unsigned u = __builtin_bit_cast(unsigned, f); return (u + 0x7fffu + ((u >> 16) & 1u)) >> 16; }
typedef float f32x2_t_ __attribute__((ext_vector_type(2))); typedef __bf16 bf16x2_t_ __attribute__((ext_vector_type(2)));
__device__ __forceinline__ unsigned pk2(float lo, float hi) { const f32x2_t_ v = {lo, hi}; const bf16x2_t_ b = __builtin_convertvector(v, bf16x2_t_); return __builtin_bit_cast(unsigned, b); }
__device__ __forceinline__ float bf2f(unsigned short b) { return __builtin_bit_cast(float, (unsigned)b << 16); }
__device__ __forceinline__ bf16x8 pack8(float a0, float a1, float a2, float a3, float a4, float a5, float a6, float a7) {
    v4u w; w.x = pk2(a0, a1); w.y = pk2(a2, a3); w.z = pk2(a4, a5); w.w = pk2(a6, a7); return __builtin_bit_cast(bf16x8, w); }
__device__ __forceinline__ float wave_sum(float v) {
#pragma unroll
    for (int o = 1; o < 64; o <<= 1) v += __shfl_xor(v, o);
    return v;
}
template <int CTRL, int RMASK> __device__ __forceinline__ float dpp_add(float v) {
    const int t = __builtin_amdgcn_update_dpp(0, __builtin_bit_cast(int, v), CTRL, RMASK, 0xf, false);
    return v + __builtin_bit_cast(float, t);
}
__device__ __forceinline__ float dpp_sum(float v) {
    v = dpp_add<0x111, 0xf>(v); v = dpp_add<0x112, 0xf>(v); v = dpp_add<0x114, 0xf>(v); v = dpp_add<0x118, 0xf>(v);
    v = dpp_add<0x142, 0xa>(v); v = dpp_add<0x143, 0xc>(v);
    return __builtin_bit_cast(float, __builtin_amdgcn_readlane(__builtin_bit_cast(int, v), 63));
}
__device__ __forceinline__ float ex2(float x) { return __builtin_amdgcn_exp2f(x); }
__device__ __forceinline__ float sigmoidf_(float x) { return 1.f / (1.f + __expf(-x)); }
__device__ __forceinline__ float siluf_(float x) { return x / (1.f + __expf(-x)); }
__device__ __forceinline__ int crow(int r, int hi) { return (r & 3) + 8 * (r >> 2) + 4 * hi; }
__device__ __forceinline__ void rope_cs(int pos, int d, float& cs, float& sn) {
    const float invf = exp2f(-(float)d * 0.4152410118609203f);
    double rv = (double)pos * (double)invf * 0.15915494309189535; rv -= floor(rv);
    const float rf = (float)rv; sn = __builtin_amdgcn_sinf(rf); cs = __builtin_amdgcn_cosf(rf);
}

#define XB_TMO      128
#define XB_XCNT(j)  (256  + 64 * (j))
#define XB_XSUB(j)  (1280 + 64 * (j))
#define XB_XGEN(j)  (2304 + 64 * (j))
#define XB_TOP      3328
#define XB_TOPGEN   3392
#define XCD_BAR_WORDS 3456
#define XB_SPIN_CAP (1u << 18)

__device__ __forceinline__ unsigned xb_ld(unsigned* p)              { return __hip_atomic_load(p, __ATOMIC_RELAXED, __HIP_MEMORY_SCOPE_AGENT); }
__device__ __forceinline__ unsigned xb_add(unsigned* p, unsigned v) { return __hip_atomic_fetch_add(p, v, __ATOMIC_RELAXED, __HIP_MEMORY_SCOPE_AGENT); }
__device__ __forceinline__ unsigned xb_xcc_id() { return (unsigned)__builtin_amdgcn_s_getreg((3 << 11) | 20) & 0xFu; }
#define XB_SPIN(cond, bar) do { unsigned _sp = 0; while (cond) { __builtin_amdgcn_s_sleep(1); \
    if ((++_sp & 255u) == 0u) { if (xb_ld(&(bar)[XB_TMO])) break; if (_sp > XB_SPIN_CAP) { atomicAdd(&(bar)[XB_TMO], 1u); break; } } } } while (0)

struct XcdBarrier {
    unsigned* bar; unsigned x;
    volatile LAS unsigned* st;
};

__device__ __forceinline__ XcdBarrier xcd_barrier_post(unsigned* bar, volatile LAS unsigned* st, bool leader) {
    XcdBarrier b; b.bar = bar; b.x = xb_xcc_id(); b.st = st;
    if (leader) (void)xb_add(&bar[XB_XCNT(b.x)], 1u);
    return b;
}
__device__ __forceinline__ void xcd_barrier_complete(unsigned* bar, unsigned x, unsigned& nloc, unsigned& nx) {
    const unsigned G = gridDim.x * gridDim.y * gridDim.z;
    unsigned sum, cnt, mine, sp = 0u;
    for (;;) {
        sum = 0u; cnt = 0u; mine = 0u;
#pragma unroll
        for (unsigned j = 0; j < 16; ++j) { const unsigned c = xb_ld(&bar[XB_XCNT(j)]); sum += c; cnt += (c > 0u) ? 1u : 0u; mine = (j == x) ? c : mine; }
        if (sum == G) break;
        __builtin_amdgcn_s_sleep(1);
        if ((++sp & 255u) == 0u) { if (xb_ld(&bar[XB_TMO])) break; if (sp > XB_SPIN_CAP) { atomicAdd(&bar[XB_TMO], 1u); break; } }
    }
    nloc = mine > 0u ? mine : 1u; nx = cnt > 0u ? cnt : 1u;
}

__device__ __forceinline__ void xcd_barrier(const XcdBarrier& b, bool leader) {
    asm volatile("s_waitcnt vmcnt(0)" ::: "memory");
    __syncthreads();
    if (leader) {
        unsigned* bar = b.bar;
        __builtin_amdgcn_s_waitcnt(0);
        unsigned nloc = b.st[0], nx = b.st[1];
        if (nloc == 0u) { xcd_barrier_complete(bar, b.x, nloc, nx); b.st[0] = nloc; b.st[1] = nx; }
        const unsigned old = xb_add(&bar[XB_XSUB(b.x)], 1u);
        const unsigned gen = old / nloc;
        if (old + 1u == (gen + 1u) * nloc) {
            __builtin_amdgcn_fence(__ATOMIC_RELEASE, "agent");
            asm volatile("s_waitcnt vmcnt(0)" ::: "memory");
            const unsigned og = xb_add(&bar[XB_TOP], 1u);
            const unsigned tg = og / nx;
            if (og + 1u == (tg + 1u) * nx) xb_add(&bar[XB_TOPGEN], 1u);
            else XB_SPIN(xb_ld(&bar[XB_TOPGEN]) == tg, bar);
            __builtin_amdgcn_fence(__ATOMIC_ACQUIRE, "agent");
            xb_add(&bar[XB_XGEN(b.x)], 1u);
            asm volatile("s_waitcnt vmcnt(0)" ::: "memory");
        } else {
            XB_SPIN(xb_ld(&bar[XB_XGEN(b.x)]) == gen, bar);
            __builtin_amdgcn_fence(__ATOMIC_ACQUIRE, "agent");
            asm volatile("s_waitcnt vmcnt(0)" ::: "memory");
        }
    }
    __syncthreads();
}

__device__ __forceinline__ void transpose_item(const float* W, int K, int N, int Npad, bf16* WT, LAS float* scr, int item, int lane, const float* gk = nullptr) {
    const int nblk = Npad / 32, kb = item / nblk, nb = item % nblk, k0 = 64 * kb, n0 = 32 * nb;
    const int ncol = n0 + (lane & 31);
    float wv_[32];
#pragma unroll
    for (int i = 0; i < 32; ++i) { const int kk = 2 * i + (lane >> 5); wv_[i] = (ncol < N) ? W[(size_t)(k0 + kk) * N + ncol] : 0.f; }
    __builtin_amdgcn_sched_barrier(0);
#pragma unroll
    for (int i = 0; i < 32; ++i) { const int kk = 2 * i + (lane >> 5); scr[kk * 33 + (lane & 31)] = wv_[i]; }
    LDS_WAIT(); asm volatile("" ::: "memory");
    const int c = lane & 7;
    f32x4 g0 = {1.f, 1.f, 1.f, 1.f}, g1 = g0;
    if (gk) { g0 = *(const f32x4*)(gk + k0 + 8 * c); g1 = *(const f32x4*)(gk + k0 + 8 * c + 4); }
#pragma unroll
    for (int j = 0; j < 4; ++j) { const int n = (lane >> 3) + 8 * j; const LAS float* s = scr + (8 * c) * 33 + n;
        v4u o; o.x = pk2(s[0 * 33] * g0.x, s[1 * 33] * g0.y); o.y = pk2(s[2 * 33] * g0.z, s[3 * 33] * g0.w); o.z = pk2(s[4 * 33] * g1.x, s[5 * 33] * g1.y); o.w = pk2(s[6 * 33] * g1.z, s[7 * 33] * g1.w);
        *(v4u*)(WT + (size_t)(n0 + n) * K + k0 + 8 * c) = o; }
    LDS_WAIT(); asm volatile("" ::: "memory");
}
__device__ __forceinline__ f32x4 ld4x(const void* row, int i, bool bf) {
    if (bf) { const v2u w = ((const v2u*)row)[i]; return (f32x4){bf2f((unsigned short)(w.x & 0xffffu)), bf2f((unsigned short)(w.x >> 16)), bf2f((unsigned short)(w.y & 0xffffu)), bf2f((unsigned short)(w.y >> 16))}; }
    return ((const f32x4*)row)[i]; }
__device__ __forceinline__ void rms_row(const void* xrow, bool bf, const float* g, bf16* orow, float* of32, int lane) {
    f32x4 v[4]; float s = 0.f;
#pragma unroll
    for (int j = 0; j < 4; ++j) { v[j] = ld4x(xrow, 64 * j + lane, bf); s += (v[j].x * v[j].x + v[j].y * v[j].y) + (v[j].z * v[j].z + v[j].w * v[j].w); }
    const float rstd = 1.f / sqrtf(wave_sum(s) * (1.f / DM) + 1e-6f);
#pragma unroll
    for (int j = 0; j < 4; ++j) { const f32x4 gg = ((const f32x4*)g)[64 * j + lane]; const f32x4 o = v[j] * rstd * gg;
        if (of32) ((f32x4*)of32)[64 * j + lane] = o;
        else ((v2u*)orow)[64 * j + lane] = (v2u){pk2(o.x, o.y), pk2(o.z, o.w)}; }
}

__device__ __forceinline__ void rms_row2(const void* xa, const void* xb, bool bf, const float* g, bf16* oa, bf16* ob, float* fa, float* fb, int lane) {
    f32x4 va[4], vb[4];
#pragma unroll
    for (int j = 0; j < 4; ++j) { va[j] = ld4x(xa, 64 * j + lane, bf); vb[j] = ld4x(xb, 64 * j + lane, bf); }
    __builtin_amdgcn_sched_barrier(0);
    float sa = 0.f, sb = 0.f;
#pragma unroll
    for (int j = 0; j < 4; ++j) { sa += (va[j].x * va[j].x + va[j].y * va[j].y) + (va[j].z * va[j].z + va[j].w * va[j].w); sb += (vb[j].x * vb[j].x + vb[j].y * vb[j].y) + (vb[j].z * vb[j].z + vb[j].w * vb[j].w); }
    const float ra = 1.f / sqrtf(wave_sum(sa) * (1.f / DM) + 1e-6f), rb = 1.f / sqrtf(wave_sum(sb) * (1.f / DM) + 1e-6f);
#pragma unroll
    for (int j = 0; j < 4; ++j) { const f32x4 gg = ((const f32x4*)g)[64 * j + lane]; const f32x4 o1 = va[j] * ra * gg, o2 = vb[j] * rb * gg;
        if (fa) { ((f32x4*)fa)[64 * j + lane] = o1; ((f32x4*)fb)[64 * j + lane] = o2; }
        else { ((v2u*)oa)[64 * j + lane] = (v2u){pk2(o1.x, o1.y), pk2(o1.z, o1.w)}; ((v2u*)ob)[64 * j + lane] = (v2u){pk2(o2.x, o2.y), pk2(o2.z, o2.w)}; } }
}
__device__ __forceinline__ void rms_row_parts(const void* base, bool bf, const float* parts, int nparts, size_t part_stride, bf16* xout, const float* g, bf16* orow, float* of32, int lane) {
    f32x4 v[4]; float s = 0.f;
#pragma unroll
    for (int j = 0; j < 4; ++j) v[j] = ld4x(base, 64 * j + lane, bf);
    for (int p = 0; p < nparts; ++p) { const f32x4* pr = (const f32x4*)(parts + (size_t)p * part_stride) + lane;
#pragma unroll
        for (int j = 0; j < 4; ++j) v[j] += pr[64 * j]; }
#pragma unroll
    for (int j = 0; j < 4; ++j) { if (xout) ((v2u*)xout)[64 * j + lane] = (v2u){pk2(v[j].x, v[j].y), pk2(v[j].z, v[j].w)}; s += (v[j].x * v[j].x + v[j].y * v[j].y) + (v[j].z * v[j].z + v[j].w * v[j].w); }
    const float rstd = 1.f / sqrtf(wave_sum(s) * (1.f / DM) + 1e-6f);
#pragma unroll
    for (int j = 0; j < 4; ++j) { const f32x4 gg = ((const f32x4*)g)[64 * j + lane]; const f32x4 o = v[j] * rstd * gg;
        if (of32) ((f32x4*)of32)[64 * j + lane] = o;
        else ((v2u*)orow)[64 * j + lane] = (v2u){pk2(o.x, o.y), pk2(o.z, o.w)}; }
}

__device__ __forceinline__ void resid_parts_row(const void* base, bool bf, const float* parts, int nparts, size_t part_stride, bf16* xout, float* rs, int lane) {
    f32x4 v[4]; float s = 0.f;
#pragma unroll
    for (int j = 0; j < 4; ++j) v[j] = ld4x(base, 64 * j + lane, bf);
    for (int p = 0; p < nparts; ++p) { const f32x4* pr = (const f32x4*)(parts + (size_t)p * part_stride) + lane;
#pragma unroll
        for (int j = 0; j < 4; ++j) v[j] += pr[64 * j]; }
#pragma unroll
    for (int j = 0; j < 4; ++j) { const unsigned w0 = pk2(v[j].x, v[j].y), w1 = pk2(v[j].z, v[j].w); ((v2u*)xout)[64 * j + lane] = (v2u){w0, w1};
        const float q0 = bf2f((unsigned short)(w0 & 0xffffu)), q1 = bf2f((unsigned short)(w0 >> 16)), q2 = bf2f((unsigned short)(w1 & 0xffffu)), q3 = bf2f((unsigned short)(w1 >> 16));
        s += (q0 * q0 + q1 * q1) + (q2 * q2 + q3 * q3); }
    const float tot = wave_sum(s);
    if (lane == 0) *rs = 1.f / sqrtf(tot * (1.f / DM) + 1e-6f);
}
__device__ __forceinline__ void rs_from_parts(const float* SS, float* RS, int m) {
    const f32x4* p = (const f32x4*)(SS + (size_t)m * 16); const f32x4 a = p[0], b = p[1], c = p[2], d = p[3];
    const float s = ((a.x + a.y) + (a.z + a.w)) + ((b.x + b.y) + (b.z + b.w)) + ((c.x + c.y) + (c.z + c.w)) + ((d.x + d.y) + (d.z + d.w));
    RS[m] = 1.f / sqrtf(s * (1.f / DM) + 1e-6f);
}

struct PBArgs { const float* PROJ; const float* state_conv; const float* conv_w; const float* a_log; const float* dt_bias;
    float* QN; float* KN; float* VG; float* G; float* BETA; float* KQ; bf16* QB; bf16* KS; bf16* VS; bf16* KW; bf16* VW; float* out; int l; };
struct PBRegs { float qs_[8], qo_[8], kvs_[12], kvo_[12]; };
__device__ __forceinline__ void pb_row_load(const PBArgs& A, int m, int lane, PBRegs& R) {
    const float* pr = A.PROJ + (size_t)m * NP;
#pragma unroll
    for (int h = 0; h < 8; ++h) { R.qs_[h] = pr[C_Q + h * 64 + lane]; R.qo_[h] = pr[C_Q + h * 64 + (lane ^ 32)]; }
#pragma unroll
    for (int i = 0; i < 12; ++i) { R.kvs_[i] = pr[C_KV + i * 64 + lane]; R.kvo_[i] = pr[C_KV + i * 64 + (lane ^ 32)]; }
}
__device__ __forceinline__ void pb_row(const PBArgs& A, int m, int lane, const PBRegs& R) {
    const bool is_s = m >= MP; int b, t;
    if (!is_s) { b = m >> 12; t = m & 4095; } else { b = (m - MP) >> 2; t = (m - MP) & 3; }
    const int pos = is_s ? PAST + t : t, l = A.l;
    const float* pr = A.PROJ + (size_t)m * NP;
    const float* cw = A.conv_w + (size_t)l * 4 * 1536;
    const float* cb = A.state_conv + ((size_t)l * NSB + b) * 3 * 1536;
    if (!is_s && t >= SEQ - 3) { float* o = A.out + O_CONVP + ((size_t)(l * NPB + b) * 3 + (t - (SEQ - 3))) * 1536;
#pragma unroll 4
        for (int j = 0; j < 24; ++j) o[64 * j + lane] = pr[64 * j + lane]; }
    if (is_s && t >= 1) { float* o = A.out + O_CONVS + ((size_t)(l * NSB + b) * 3 + (t - 1)) * 1536;
#pragma unroll 4
        for (int j = 0; j < 24; ++j) o[64 * j + lane] = pr[64 * j + lane]; }
    const int half = lane >> 5; float cs, sn; rope_cs(pos, lane & 31, cs, sn);
    const float (&qs_)[8] = R.qs_; const float (&qo_)[8] = R.qo_; const float (&kvs_)[12] = R.kvs_; const float (&kvo_)[12] = R.kvo_;
#pragma unroll
    for (int h = 0; h < 8; ++h) { const float xs = qs_[h], xo = qo_[h];
        const float r = half ? (xs * cs + xo * sn) : (xs * cs - xo * sn);
        A.QB[(size_t)m * 512 + h * 64 + lane] = (bf16)f2bf(r * C2); }
#pragma unroll
    for (int s6 = 0; s6 < 6; ++s6)
#pragma unroll
        for (int kvh = 0; kvh < 2; ++kvh) {
            float v = kvs_[s6 * 2 + kvh];
            if (s6 == 2 || s6 == 4) { const float xo = kvo_[s6 * 2 + kvh]; v = half ? (v * cs + xo * sn) : (v * cs - xo * sn); }
            if (s6 < 4) {
                if (!is_s) A.out[O_KVP + ((((size_t)(l * NPB + b) * 2 + kvh) * SEQ + t) * 4 + s6) * 64 + lane] = v;
                else       A.out[O_KVS + ((((size_t)(l * NSB + b) * 2 + kvh) * DSEQ + t) * 4 + s6) * 64 + lane] = v;
            } else {
                const int idx = s6 - 4;
                if (!is_s) { if (t >= SEQ - 512) A.out[O_WINP + ((((size_t)(l * NPB + b) * 512 + (t - (SEQ - 512))) * 2 + idx) * 2 + kvh) * 64 + lane] = v; }
                else A.out[O_WINS + ((((size_t)(l * NSB + b) * 512 + (508 + t)) * 2 + idx) * 2 + kvh) * 64 + lane] = v;
            }
            const bf16 bv = (bf16)f2bf(v);
            if (s6 == 2) A.KS[(size_t)m * 128 + kvh * 64 + lane] = bv;
            if (s6 == 3) A.VS[(size_t)m * 128 + kvh * 64 + lane] = bv;
            if (s6 == 4) A.KW[(size_t)m * 128 + kvh * 64 + lane] = bv;
            if (s6 == 5) A.VW[(size_t)m * 128 + kvh * 64 + lane] = bv;
        }
}

__device__ __forceinline__ void pb_sample_head(const PBArgs& A, int u, int lane) {
    const int m = MP + (u >> 3), h = u & 7, b = (m - MP) >> 2, t = (m - MP) & 3, l = A.l;
    const float* pr = A.PROJ + (size_t)m * NP;
    const float* cw = A.conv_w + (size_t)l * 4 * 1536;
    const float* cb = A.state_conv + ((size_t)l * NSB + b) * 3 * 1536;
    float xv[3][4], wv[3][4];
#pragma unroll
    for (int part = 0; part < 3; ++part) { const int c = (part * 8 + h) * 64 + lane;
#pragma unroll
        for (int tap = 0; tap < 4; ++tap) { const int idx = t + tap;
            xv[part][tap] = (idx >= 3) ? A.PROJ[(size_t)(m - t + idx - 3) * NP + c] : cb[idx * 1536 + c];
            wv[part][tap] = cw[tap * 1536 + c]; } }
    __builtin_amdgcn_sched_barrier(0);
    float qkv[3];
#pragma unroll
    for (int part = 0; part < 3; ++part) qkv[part] = siluf_((xv[part][0] * wv[part][0] + xv[part][1] * wv[part][1]) + (xv[part][2] * wv[part][2] + xv[part][3] * wv[part][3]));
    const float q = qkv[0], k = qkv[1];
    const float qs = dpp_sum(q * q), ks = dpp_sum(k * k);
    const float qn = q * (1.f / sqrtf(qs + 1e-6f)) * 0.125f, kn = k * (1.f / sqrtf(ks + 1e-6f));
    const float kq = dpp_sum(qn * kn);
    A.QN[(size_t)m * 512 + h * 64 + lane] = qn; A.KN[(size_t)m * 512 + h * 64 + lane] = kn; A.VG[(size_t)m * 512 + h * 64 + lane] = qkv[2];
    if (lane == 0) A.KQ[(size_t)m * 8 + h] = kq;
    if (h == 0 && lane < 8) {
        const float a = pr[C_A + lane] + A.dt_bias[l * 8 + lane];
        const float sp = fmaxf(a, 0.f) + log1pf(__expf(-fabsf(a)));
        A.G[(size_t)m * 8 + lane] = -__expf(A.a_log[l * 8 + lane]) * sp;
        A.BETA[(size_t)m * 8 + lane] = sigmoidf_(pr[C_BETA + lane]); }
}

struct CmpArgs { const float* PROJ; const float* cache; const int* page_table; const float* pe_k; const float* pe_v; const bf16* CMPW; unsigned char* ws; int l; };
__device__ __forceinline__ void compress_batch(const CmpArgs& A, unsigned char* lds, int batch, bool is_s, int tid) {
    const int lane = tid & 63, wave = __builtin_amdgcn_readfirstlane(tid >> 6), fr = lane & 15, fq = lane >> 4, l = A.l;
    const int kv = batch & 1, ru = (batch >> 1) * 8 + wave;
    const int rho = 16 * ru + fr, NC = is_s ? 64 : 128;
    const int seq = rho / (2 * NC), n = (rho >> 1) % NC, kvh = rho & 1;
    const float* abase; size_t astride;
    if (!is_s) { abase = A.PROJ + (size_t)(seq * SEQ + 32 * n) * NP + C_KV + kv * 128 + kvh * 64; astride = NP; }
    else { const int page = A.page_table[seq * NPAGES + (n >> 2)];
        abase = A.cache + ((((size_t)l * NPOOL + page) * 2 + kvh) * 128 + (n & 3) * 32) * 256 + kv * 64; astride = 256; }
    const float* pe = (kv ? A.pe_v : A.pe_k) + (size_t)l * 2048;
    const bf16* Wt = A.CMPW + (size_t)((l * 2 + kv) * 64) * 2048;
    const int we = tid >> 3, wch = tid & 7;
    f32x4 acc[4];
#pragma unroll
    for (int et = 0; et < 4; ++et) acc[et] = (f32x4){0.f, 0.f, 0.f, 0.f};
    f32x4 sa[2][4], sp[2][4]; v4u wreg;
#define CB_LOADA(S, c) do { _Pragma("unroll") for (int ks = 0; ks < 2; ++ks) { const float* ap = abase + (size_t)(c) * astride + 32 * ks + 8 * fq; const float* pp = pe + (c) * 64 + 32 * ks + 8 * fq; \
        sa[S][2 * ks] = *(const f32x4*)ap; sa[S][2 * ks + 1] = *(const f32x4*)(ap + 4); sp[S][2 * ks] = *(const f32x4*)pp; sp[S][2 * ks + 1] = *(const f32x4*)(pp + 4); } } while (0)
#define CB_LOADW(c) do { wreg = *(const v4u*)(Wt + (size_t)we * 2048 + ((c) < 31 ? (c) : 31) * 64 + wch * 8); } while (0)
#define CB_STOREW(bufi) do { *(v4u*)(lds + (bufi) * 9216 + we * 144 + wch * 16) = wreg; } while (0)
#define CB_MMA(S, bufi) do { _Pragma("unroll") for (int ks = 0; ks < 2; ++ks) { const f32x4 a0 = sa[S][2 * ks] + sp[S][2 * ks], a1 = sa[S][2 * ks + 1] + sp[S][2 * ks + 1]; \
        const bf16x8 ya = pack8(a0.x, a0.y, a0.z, a0.w, a1.x, a1.y, a1.z, a1.w); \
        _Pragma("unroll") for (int et = 0; et < 4; ++et) { const bf16x8 wf_ = *(const bf16x8*)(lds + (bufi) * 9216 + (16 * et + fr) * 144 + (32 * ks + 8 * fq) * 2); \
            acc[et] = __builtin_amdgcn_mfma_f32_16x16x32_bf16(wf_, ya, acc[et], 0, 0, 0); } } } while (0)
    __syncthreads();
    CB_LOADW(0); CB_LOADA(0, 0);
    CB_STOREW(0); CB_LOADW(1);
    __syncthreads();
#pragma unroll 1
    for (int c = 0; c < 32; c += 2) {
        CB_STOREW(1); __builtin_amdgcn_sched_barrier(0); CB_LOADW(c + 2); CB_LOADA(1, c + 1); __builtin_amdgcn_sched_barrier(0);
        CB_MMA(0, 0); __builtin_amdgcn_sched_barrier(0);
        __syncthreads();
        CB_STOREW(0); __builtin_amdgcn_sched_barrier(0); CB_LOADW(c + 3); if (c + 2 < 32) { CB_LOADA(0, c + 2); } __builtin_amdgcn_sched_barrier(0);
        CB_MMA(1, 1); __builtin_amdgcn_sched_barrier(0);
        __syncthreads();
    }
#undef CB_LOADA
#undef CB_LOADW
#undef CB_STOREW
#undef CB_MMA
    if (kv == 0) { const int pos = 32 * n + 31;
#pragma unroll
        for (int et = 0; et < 2; ++et)
#pragma unroll
            for (int i = 0; i < 4; ++i) { float cs, sn; rope_cs(pos, 16 * et + 4 * fq + i, cs, sn);
                const float x1 = acc[et][i], x2 = acc[et + 2][i]; acc[et][i] = x1 * cs - x2 * sn; acc[et + 2][i] = x2 * cs + x1 * sn; } }
    float* ob = (float*)(A.ws + (is_s ? WS_CKS : WS_CKP) + (size_t)kv * (is_s ? (WS_CVS - WS_CKS) : (WS_CVP - WS_CKP))) + (size_t)rho * 64 + 4 * fq;
#pragma unroll
    for (int et = 0; et < 4; ++et) *(f32x4*)(ob + 16 * et) = acc[et];
}

struct GdnArgs { const float* QN; const float* KN; const float* VG; const float* G; const float* BETA; const float* KQ; float* OG; const float* PROJ; const float* state_gdn; const float* gdn_norm; bf16* MIX; float* out; int l; };
__device__ __forceinline__ void gdn_sample_unit(const GdnArgs& A, int unit, int lane) {
    const int sb = unit >> 3, h = unit & 7, l = A.l;
    const float* sp = A.state_gdn + (((size_t)l * NSB + sb) * 8 + h) * 4096;
    float S[64];
#pragma unroll
    for (int d = 0; d < 64; ++d) S[d] = sp[d * 64 + lane];
    const float gn = A.gdn_norm[l * 64 + lane];
    for (int i = 0; i < DSEQ; ++i) {
        const size_t m = (size_t)MP + sb * 4 + i;
        const float kd = A.KN[m * 512 + h * 64 + lane], qd = A.QN[m * 512 + h * 64 + lane], v = A.VG[m * 512 + h * 64 + lane];
        const float g = A.G[m * 8 + h], beta = A.BETA[m * 8 + h], kq = A.KQ[m * 8 + h];
        const int kdb = __builtin_bit_cast(int, kd), qdb = __builtin_bit_cast(int, qd);
        const float a = __expf(g); float r1 = 0.f, r2 = 0.f;
#pragma unroll
        for (int d = 0; d < 64; ++d) { const float kk = __builtin_bit_cast(float, __builtin_amdgcn_readlane(kdb, d)), qq = __builtin_bit_cast(float, __builtin_amdgcn_readlane(qdb, d)); r1 += S[d] * kk; r2 += S[d] * qq; }
        const float u = beta * (v - a * r1), o = a * r2 + u * kq;
#pragma unroll
        for (int d = 0; d < 64; ++d) { const float kk = __builtin_bit_cast(float, __builtin_amdgcn_readlane(kdb, d)); S[d] = a * S[d] + kk * u; }
        const float ms = wave_sum(o * o) * (1.f / 64.f);
        const float z = A.PROJ[m * NP + C_Z + h * 64 + lane];
        A.MIX[m * 1024 + h * 64 + lane] = (bf16)f2bf(o * (1.f / sqrtf(ms + 1e-6f)) * gn * siluf_(z));
    }
    float* so = A.out + O_GDNS + (((size_t)l * NSB + sb) * 8 + h) * 4096;
#pragma unroll
    for (int d = 0; d < 64; ++d) so[d * 64 + lane] = S[d];
}


__device__ __forceinline__ int perm_inv32(int p) { return (p & 32) + 16 * ((p >> 2) & 1) + 4 * ((p >> 3) & 3) + (p & 3); }
struct GPArgs { const float* PROJ; const float* conv_w; const float* a_log; const float* dt_bias; bf16* GK; bf16* GQ; bf16* GKT; bf16* GVT; float* GG2; float* BETA2; int l; };
struct GPRegs { float xx[3][11], ww[3][4]; };
__device__ __forceinline__ void gdn_prep_load(const GPArgs& A, int unit, int lane, GPRegs& R) {
    const int tg = unit >> 3, h = unit & 7, m0 = tg * 8, t0 = m0 & 4095;
    const float* cw = A.conv_w + (size_t)A.l * 4 * 1536;
#pragma unroll
    for (int part = 0; part < 3; ++part) { const int c = (part * 8 + h) * 64 + lane;
#pragma unroll
        for (int j = 0; j < 11; ++j) R.xx[part][j] = (t0 - 3 + j >= 0) ? A.PROJ[(size_t)(m0 - 3 + j) * NP + c] : 0.f;
#pragma unroll
        for (int k = 0; k < 4; ++k) R.ww[part][k] = cw[k * 1536 + c]; }
}
__device__ __forceinline__ void gdn_prep_unit(const GPArgs& A, int unit, int lane, const GPRegs& R) {
    const int tg = unit >> 3, h = unit & 7, m0 = tg * 8, b = m0 >> 12, t0 = m0 & 4095, l = A.l, bh = b * 8 + h;
    const float* cw = A.conv_w + (size_t)l * 4 * 1536;
    float val[3][8]; const float (&xx)[3][11] = R.xx; const float (&ww)[3][4] = R.ww;
#pragma unroll
    for (int part = 0; part < 3; ++part)
#pragma unroll
        for (int i = 0; i < 8; ++i) val[part][i] = siluf_(ww[part][0] * xx[part][i] + ww[part][1] * xx[part][i + 1] + ww[part][2] * xx[part][i + 2] + ww[part][3] * xx[part][i + 3]);
#pragma unroll
    for (int i = 0; i < 8; ++i) { const float q = val[0][i], k = val[1][i];
        const float qs = dpp_sum(q * q), ks = dpp_sum(k * k);
        val[0][i] = q * (1.f / sqrtf(qs + 1e-6f)) * 0.125f; val[1][i] = k * (1.f / sqrtf(ks + 1e-6f)); }
#pragma unroll
    for (int i = 0; i < 8; ++i) { A.GQ[((size_t)bh * 4096 + t0 + i) * 64 + lane] = (bf16)f2bf(val[0][i]); A.GK[((size_t)bh * 4096 + t0 + i) * 64 + lane] = (bf16)f2bf(val[1][i]); }
    *(v4u*)(A.GKT + ((size_t)bh * 64 + lane) * 4096 + t0) = (v4u){pk2(val[1][0], val[1][1]), pk2(val[1][2], val[1][3]), pk2(val[1][4], val[1][5]), pk2(val[1][6], val[1][7])};
    *(v4u*)(A.GVT + ((size_t)bh * 64 + lane) * 4096 + t0) = (v4u){pk2(val[2][0], val[2][1]), pk2(val[2][2], val[2][3]), pk2(val[2][4], val[2][5]), pk2(val[2][6], val[2][7])};
    if (lane < 8) { const float* pr = A.PROJ + (size_t)(m0 + lane) * NP;
        const float a = pr[C_A + h] + A.dt_bias[l * 8 + h];
        const float sp = fmaxf(a, 0.f) + log1pf(__expf(-fabsf(a)));
        A.GG2[(size_t)bh * 4096 + t0 + lane] = -__expf(A.a_log[l * 8 + h]) * sp;
        A.BETA2[(size_t)bh * 4096 + t0 + lane] = sigmoidf_(pr[C_BETA + h]); }
}
template <int I> __device__ __forceinline__ void fsub_row(float (&T)[64], const float* AL, int lane) {
    float tv = (lane == I) ? 1.f : 0.f;
#pragma unroll
    for (int j4 = 0; j4 < (I + 3) / 4; ++j4) { const f32x4 a = *(const f32x4*)(AL + I * 64 + 4 * j4);
#pragma unroll
        for (int e = 0; e < 4; ++e) if (4 * j4 + e < I) tv -= a[e] * T[4 * j4 + e]; }
    T[I] = tv;
}
template <int I> struct FSub { static __device__ __forceinline__ void run(float (&T)[64], const float* AL, int lane) { FSub<I - 1>::run(T, AL, lane); fsub_row<I>(T, AL, lane); } };
template <> struct FSub<-1> { static __device__ __forceinline__ void run(float (&)[64], const float*, int) {} };
struct GCArgs { const bf16* GK; const bf16* GQ; const bf16* GKT; const bf16* GVT; const float* GG2; const float* BETA2; bf16* WX; bf16* QX; bf16* QKX; bf16* KTX; float* U0F; float* GL; };
constexpr int GC_LDS_PER_WAVE = 17664;
__device__ __forceinline__ void gdn_chunk_unit(const GCArgs& A, unsigned char* wl, int unit, int lane_) {
    int lane = lane_; asm volatile("" : "+v"(lane));
    const int bh = unit >> 6, n = unit & 63, t0 = 64 * n, fr = lane & 15, fq = lane >> 4;
    float* AL = (float*)wl; float* SC = (float*)(wl + 16384);
    {   const float g = A.GG2[(size_t)bh * 4096 + t0 + lane], beta = A.BETA2[(size_t)bh * 4096 + t0 + lane];
        float gc = g;
        gc = dpp_add<0x111, 0xf>(gc); gc = dpp_add<0x112, 0xf>(gc); gc = dpp_add<0x114, 0xf>(gc); gc = dpp_add<0x118, 0xf>(gc); gc = dpp_add<0x142, 0xa>(gc); gc = dpp_add<0x143, 0xc>(gc);
        const float glast = __builtin_bit_cast(float, __builtin_amdgcn_readlane(__builtin_bit_cast(int, gc), 63));
        const float eg = __expf(gc);
        SC[lane] = gc; SC[64 + lane] = beta; SC[128 + lane] = beta * eg; SC[192 + lane] = eg; SC[256 + lane] = __expf(glast - gc);
        if (lane == 0) A.GL[unit] = __expf(glast); }
    LDS_WAIT(); asm volatile("" ::: "memory");
    {
        bf16x8 kf[4][2];
#pragma unroll
        for (int t4 = 0; t4 < 4; ++t4)
#pragma unroll
            for (int ks = 0; ks < 2; ++ks) kf[t4][ks] = *(const bf16x8*)(A.GK + ((size_t)bh * 4096 + t0 + 16 * t4 + fr) * 64 + 32 * ks + 8 * fq);
        __builtin_amdgcn_sched_barrier(0);
#pragma unroll
        for (int ti = 0; ti < 4; ++ti) { const f32x4 gi = *(const f32x4*)(SC + 16 * ti + 4 * fq), bi = *(const f32x4*)(SC + 64 + 16 * ti + 4 * fq);
#pragma unroll
            for (int tj = 0; tj < 4; ++tj) if (tj <= ti) { f32x4 acc = {0.f, 0.f, 0.f, 0.f};
                acc = __builtin_amdgcn_mfma_f32_16x16x32_bf16(kf[ti][0], kf[tj][0], acc, 0, 0, 0); acc = __builtin_amdgcn_mfma_f32_16x16x32_bf16(kf[ti][1], kf[tj][1], acc, 0, 0, 0);
                const float gj = SC[16 * tj + fr];
#pragma unroll
                for (int i = 0; i < 4; ++i) AL[(16 * ti + 4 * fq + i) * 64 + 16 * tj + fr] = bi[i] * acc[i] * __expf(fminf(gi[i] - gj, 0.f)); } }
    }
    LDS_WAIT(); asm volatile("" ::: "memory");
    {
        float T[64];
        FSub<63>::run(T, AL, lane);
        LDS_WAIT(); asm volatile("" ::: "memory");
        unsigned short* TB = (unsigned short*)wl;
#pragma unroll
        for (int i = 0; i < 64; ++i) TB[i * 72 + lane] = (unsigned short)f2bf(T[i]);
    }
    LDS_WAIT(); asm volatile("" ::: "memory");
    {
        bf16x8 tf[4][2];
#pragma unroll
        for (int ti = 0; ti < 4; ++ti)
#pragma unroll
            for (int ks = 0; ks < 2; ++ks) tf[ti][ks] = *(const bf16x8*)(wl + ((16 * ti + fr) * 72 + 32 * ks + 8 * fq) * 2);
#pragma unroll
        for (int which = 0; which < 2; ++which) { const bf16* src = which ? A.GVT : A.GKT; const float* sc = SC + (which ? 64 : 128);
            bf16x8 raws[4][2];
#pragma unroll
            for (int tn = 0; tn < 4; ++tn)
#pragma unroll
                for (int ks = 0; ks < 2; ++ks) raws[tn][ks] = *(const bf16x8*)(src + ((size_t)bh * 64 + 16 * tn + fr) * 4096 + t0 + 32 * ks + 8 * fq);
            __builtin_amdgcn_sched_barrier(0);
#pragma unroll
            for (int tn = 0; tn < 4; ++tn) { bf16x8 yb[2];
#pragma unroll
                for (int ks = 0; ks < 2; ++ks) { const bf16x8 raw = raws[tn][ks];
                    const f32x4 s0 = *(const f32x4*)(sc + 32 * ks + 8 * fq), s1 = *(const f32x4*)(sc + 32 * ks + 8 * fq + 4);
                    yb[ks] = pack8(bf2f((unsigned short)raw[0]) * s0.x, bf2f((unsigned short)raw[1]) * s0.y, bf2f((unsigned short)raw[2]) * s0.z, bf2f((unsigned short)raw[3]) * s0.w,
                                   bf2f((unsigned short)raw[4]) * s1.x, bf2f((unsigned short)raw[5]) * s1.y, bf2f((unsigned short)raw[6]) * s1.z, bf2f((unsigned short)raw[7]) * s1.w); }
#pragma unroll
                for (int ti = 0; ti < 4; ++ti) { f32x4 acc = {0.f, 0.f, 0.f, 0.f};
                    acc = __builtin_amdgcn_mfma_f32_16x16x32_bf16(tf[ti][0], yb[0], acc, 0, 0, 0);
                    if (ti >= 2) acc = __builtin_amdgcn_mfma_f32_16x16x32_bf16(tf[ti][1], yb[1], acc, 0, 0, 0);
                    if (which == 0) { const int p = 32 * (tn >> 1) + 8 * (fr >> 2) + 4 * (tn & 1) + (fr & 3);
#pragma unroll
                        for (int i = 0; i < 4; ++i) A.WX[((size_t)unit * 64 + 16 * ti + 4 * fq + i) * 64 + p] = (bf16)f2bf(acc[i]); }
                    else *(f32x4*)(A.U0F + (((size_t)unit * 16 + ti * 4 + tn) * 64 + lane) * 4) = acc; } } }
    }
    {
        bf16x8 kf[4][2], qf[4][2];
#pragma unroll
        for (int t4 = 0; t4 < 4; ++t4)
#pragma unroll
            for (int ks = 0; ks < 2; ++ks) { kf[t4][ks] = *(const bf16x8*)(A.GK + ((size_t)bh * 4096 + t0 + 16 * t4 + fr) * 64 + 32 * ks + 8 * fq);
                qf[t4][ks] = *(const bf16x8*)(A.GQ + ((size_t)bh * 4096 + t0 + 16 * t4 + fr) * 64 + 32 * ks + 8 * fq); }
        __builtin_amdgcn_sched_barrier(0);
#pragma unroll
        for (int ti = 0; ti < 4; ++ti) { const f32x4 gi = *(const f32x4*)(SC + 16 * ti + 4 * fq);
#pragma unroll
            for (int tj = 0; tj < 4; ++tj) { f32x4 acc = {0.f, 0.f, 0.f, 0.f};
                if (tj <= ti) { acc = __builtin_amdgcn_mfma_f32_16x16x32_bf16(qf[ti][0], kf[tj][0], acc, 0, 0, 0); acc = __builtin_amdgcn_mfma_f32_16x16x32_bf16(qf[ti][1], kf[tj][1], acc, 0, 0, 0); }
                const float gj = SC[16 * tj + fr]; const int p = 32 * (tj >> 1) + 8 * (fr >> 2) + 4 * (tj & 1) + (fr & 3);
#pragma unroll
                for (int i = 0; i < 4; ++i) { const int ri = 16 * ti + 4 * fq + i, cj = 16 * tj + fr;
                    const float v = (tj <= ti && ri >= cj) ? acc[i] * __expf(fminf(gi[i] - gj, 0.f)) : 0.f;
                    A.QKX[((size_t)unit * 64 + ri) * 64 + p] = (bf16)f2bf(v); } } }
    }
    {
        const int lg = perm_inv32(lane);
        const float ek = SC[256 + lg];
#pragma unroll 1
        for (int r0 = 0; r0 < 64; r0 += 16) { bf16 qv[16], kv[16];
#pragma unroll
            for (int i = 0; i < 16; ++i) { qv[i] = A.GQ[((size_t)bh * 4096 + t0 + r0 + i) * 64 + lg]; kv[i] = A.GKT[((size_t)bh * 64 + r0 + i) * 4096 + t0 + lg]; }
            __builtin_amdgcn_sched_barrier(0);
#pragma unroll
            for (int i = 0; i < 16; ++i) { A.QX[((size_t)unit * 64 + r0 + i) * 64 + lane] = (bf16)f2bf(bf2f(qv[i]) * SC[192 + r0 + i]);
                A.KTX[((size_t)unit * 64 + r0 + i) * 64 + lane] = (bf16)f2bf(bf2f(kv[i]) * ek); } }
    }
    LDS_WAIT(); asm volatile("" ::: "memory");
}
struct GS2Args { const bf16* WX; const bf16* QX; const bf16* QKX; const bf16* KTX; const float* U0F; const float* GL; float* OG; float* out; int l; };
__device__ __forceinline__ void gdn_scan2_wave(const GS2Args& A, int bh, int te, int lane) {
    const int fr = lane & 15, fq = lane >> 4, b = bh >> 3, h = bh & 7;
    f32x4 s[4]; bf16x8 sfr[2];
#pragma unroll
    for (int i = 0; i < 4; ++i) s[i] = (f32x4){0.f, 0.f, 0.f, 0.f};
    sfr[0] = (bf16x8){0, 0, 0, 0, 0, 0, 0, 0}; sfr[1] = sfr[0];
    f32x4 u[4]; bf16x8 wf[4][2], kt[4][2], qx[4][2], qkx[4][2]; float dec;
#define GS_LD_UW(nn) do { const size_t un_ = (size_t)bh * 64 + (nn); _Pragma("unroll") for (int tc = 0; tc < 4; ++tc) { u[tc] = *(const f32x4*)(A.U0F + ((un_ * 16 + tc * 4 + te) * 64 + lane) * 4); \
        _Pragma("unroll") for (int ks = 0; ks < 2; ++ks) wf[tc][ks] = *(const bf16x8*)(A.WX + (un_ * 64 + 16 * tc + fr) * 64 + 32 * ks + 8 * fq); } } while (0)
#define GS_LD_Q(nn) do { const size_t un_ = (size_t)bh * 64 + (nn); _Pragma("unroll") for (int tc = 0; tc < 4; ++tc) _Pragma("unroll") for (int ks = 0; ks < 2; ++ks) { \
        qx[tc][ks] = *(const bf16x8*)(A.QX + (un_ * 64 + 16 * tc + fr) * 64 + 32 * ks + 8 * fq); qkx[tc][ks] = *(const bf16x8*)(A.QKX + (un_ * 64 + 16 * tc + fr) * 64 + 32 * ks + 8 * fq); } } while (0)
#define GS_LD_K(nn) do { const size_t un_ = (size_t)bh * 64 + (nn); dec = A.GL[un_]; _Pragma("unroll") for (int tc = 0; tc < 4; ++tc) _Pragma("unroll") for (int ks = 0; ks < 2; ++ks) \
        kt[tc][ks] = *(const bf16x8*)(A.KTX + (un_ * 64 + 16 * tc + fr) * 64 + 32 * ks + 8 * fq); } while (0)
    GS_LD_UW(0); GS_LD_Q(0); GS_LD_K(0);
    __builtin_amdgcn_sched_barrier(0);
#pragma unroll 1
    for (int n = 0; n < 64; ++n) {
        const int nn = n < 63 ? n + 1 : 63;
#pragma unroll
        for (int tc = 0; tc < 4; ++tc) { f32x4 acc = {0.f, 0.f, 0.f, 0.f};
            acc = __builtin_amdgcn_mfma_f32_16x16x32_bf16(wf[tc][0], sfr[0], acc, 0, 0, 0); acc = __builtin_amdgcn_mfma_f32_16x16x32_bf16(wf[tc][1], sfr[1], acc, 0, 0, 0);
            u[tc] -= acc; }
        bf16x8 ufr[2];
#pragma unroll
        for (int ks = 0; ks < 2; ++ks) ufr[ks] = pack8(u[2 * ks][0], u[2 * ks][1], u[2 * ks][2], u[2 * ks][3], u[2 * ks + 1][0], u[2 * ks + 1][1], u[2 * ks + 1][2], u[2 * ks + 1][3]);
        __builtin_amdgcn_sched_barrier(0);
        GS_LD_UW(nn);
        __builtin_amdgcn_sched_barrier(0);
        f32x4 oacc[4];
#pragma unroll
        for (int tc = 0; tc < 4; ++tc) {
            f32x4 acc = {0.f, 0.f, 0.f, 0.f};
            acc = __builtin_amdgcn_mfma_f32_16x16x32_bf16(qx[tc][0], sfr[0], acc, 0, 0, 0); acc = __builtin_amdgcn_mfma_f32_16x16x32_bf16(qx[tc][1], sfr[1], acc, 0, 0, 0);
            acc = __builtin_amdgcn_mfma_f32_16x16x32_bf16(qkx[tc][0], ufr[0], acc, 0, 0, 0); acc = __builtin_amdgcn_mfma_f32_16x16x32_bf16(qkx[tc][1], ufr[1], acc, 0, 0, 0);
            oacc[tc] = acc; }
#pragma unroll
        for (int td = 0; td < 4; ++td) { f32x4 acc = s[td] * dec;
            acc = __builtin_amdgcn_mfma_f32_16x16x32_bf16(kt[td][0], ufr[0], acc, 0, 0, 0); acc = __builtin_amdgcn_mfma_f32_16x16x32_bf16(kt[td][1], ufr[1], acc, 0, 0, 0);
            s[td] = acc; }
#pragma unroll
        for (int ks = 0; ks < 2; ++ks) sfr[ks] = pack8(s[2 * ks][0], s[2 * ks][1], s[2 * ks][2], s[2 * ks][3], s[2 * ks + 1][0], s[2 * ks + 1][1], s[2 * ks + 1][2], s[2 * ks + 1][3]);
        __builtin_amdgcn_sched_barrier(0);
        GS_LD_Q(nn); GS_LD_K(nn);
#pragma unroll
        for (int tc = 0; tc < 4; ++tc)
#pragma unroll
            for (int i = 0; i < 4; ++i) A.OG[((size_t)b * SEQ + 64 * n + 16 * tc + 4 * fq + i) * 512 + h * 64 + 16 * te + fr] = oacc[tc][i];
        __builtin_amdgcn_sched_barrier(0);
    }
#undef GS_LD_UW
#undef GS_LD_Q
#undef GS_LD_K
#pragma unroll
    for (int td = 0; td < 4; ++td)
#pragma unroll
        for (int i = 0; i < 4; ++i) A.out[O_GDNP + ((((size_t)A.l * NPB + b) * 8 + h) * 64 + 16 * td + 4 * fq + i) * 64 + 16 * te + fr] = s[td][i];
}

constexpr int SC_ROW = 144, SC_MAT = 64 * SC_ROW, SC_U = 4 * SC_MAT, SC_STAGE = SC_U + 16384, SC_DEC = 2 * SC_STAGE;
__device__ __forceinline__ void gdn_scan3_block(const GS2Args& A, unsigned char* lds, int bh, int tid) {
    const int lane = tid & 63, wave = __builtin_amdgcn_readfirstlane(tid >> 6), fr = lane & 15, fq = lane >> 4, b = bh >> 3, h = bh & 7, te = wave;
    const int mrow = (tid >> 3), mch = tid & 7;
    v4u ra[6], rb[6];
#define SC_LOAD(R, nn) do { const size_t un_ = (size_t)bh * 64 + ((nn) < 63 ? (nn) : 63); \
        R[0] = *(const v4u*)(A.WX + un_ * 4096 + mrow * 64 + mch * 8); R[1] = *(const v4u*)(A.KTX + un_ * 4096 + mrow * 64 + mch * 8); \
        R[2] = *(const v4u*)(A.QX + un_ * 4096 + mrow * 64 + mch * 8); R[3] = *(const v4u*)(A.QKX + un_ * 4096 + mrow * 64 + mch * 8); \
        R[4] = *(const v4u*)(A.U0F + un_ * 4096 + (size_t)tid * 4); R[5] = *(const v4u*)(A.U0F + un_ * 4096 + (size_t)(tid + 512) * 4); } while (0)
#define SC_STORE(R, st) do { unsigned char* sb_ = lds + (st) * SC_STAGE; \
        *(v4u*)(sb_ + 0 * SC_MAT + mrow * SC_ROW + mch * 16) = R[0]; *(v4u*)(sb_ + 1 * SC_MAT + mrow * SC_ROW + mch * 16) = R[1]; \
        *(v4u*)(sb_ + 2 * SC_MAT + mrow * SC_ROW + mch * 16) = R[2]; *(v4u*)(sb_ + 3 * SC_MAT + mrow * SC_ROW + mch * 16) = R[3]; \
        *(v4u*)(sb_ + SC_U + tid * 16) = R[4]; *(v4u*)(sb_ + SC_U + (tid + 512) * 16) = R[5]; } while (0)
    f32x4 s[4]; bf16x8 sfr[2];
#pragma unroll
    for (int i = 0; i < 4; ++i) s[i] = (f32x4){0.f, 0.f, 0.f, 0.f};
    sfr[0] = (bf16x8){0, 0, 0, 0, 0, 0, 0, 0}; sfr[1] = sfr[0];
    __syncthreads();
    if (tid < 64) ((float*)(lds + SC_DEC))[tid] = A.GL[(size_t)bh * 64 + tid];
    SC_LOAD(ra, 0); SC_STORE(ra, 0);
    SC_LOAD(rb, 1); SC_LOAD(ra, 2);
    __syncthreads();
#define SC_CHUNK(n, st) do { if (wave < 4) { const unsigned char* sb_ = lds + (st) * SC_STAGE; \
        f32x4 u[4]; bf16x8 ufr[2]; \
        _Pragma("unroll") for (int tc = 0; tc < 4; ++tc) { u[tc] = *(const f32x4*)(sb_ + SC_U + ((tc * 4 + te) * 64 + lane) * 16); \
            const bf16x8 w0 = *(const bf16x8*)(sb_ + (16 * tc + fr) * SC_ROW + (8 * fq) * 2), w1 = *(const bf16x8*)(sb_ + (16 * tc + fr) * SC_ROW + (32 + 8 * fq) * 2); \
            f32x4 acc = {0.f, 0.f, 0.f, 0.f}; acc = __builtin_amdgcn_mfma_f32_16x16x32_bf16(w0, sfr[0], acc, 0, 0, 0); acc = __builtin_amdgcn_mfma_f32_16x16x32_bf16(w1, sfr[1], acc, 0, 0, 0); u[tc] -= acc; } \
        _Pragma("unroll") for (int ks = 0; ks < 2; ++ks) ufr[ks] = pack8(u[2 * ks][0], u[2 * ks][1], u[2 * ks][2], u[2 * ks][3], u[2 * ks + 1][0], u[2 * ks + 1][1], u[2 * ks + 1][2], u[2 * ks + 1][3]); \
        _Pragma("unroll") for (int tc = 0; tc < 4; ++tc) { \
            const bf16x8 q0 = *(const bf16x8*)(sb_ + 2 * SC_MAT + (16 * tc + fr) * SC_ROW + (8 * fq) * 2), q1 = *(const bf16x8*)(sb_ + 2 * SC_MAT + (16 * tc + fr) * SC_ROW + (32 + 8 * fq) * 2); \
            const bf16x8 k0 = *(const bf16x8*)(sb_ + 3 * SC_MAT + (16 * tc + fr) * SC_ROW + (8 * fq) * 2), k1 = *(const bf16x8*)(sb_ + 3 * SC_MAT + (16 * tc + fr) * SC_ROW + (32 + 8 * fq) * 2); \
            f32x4 acc = {0.f, 0.f, 0.f, 0.f}; \
            acc = __builtin_amdgcn_mfma_f32_16x16x32_bf16(q0, sfr[0], acc, 0, 0, 0); acc = __builtin_amdgcn_mfma_f32_16x16x32_bf16(q1, sfr[1], acc, 0, 0, 0); \
            acc = __builtin_amdgcn_mfma_f32_16x16x32_bf16(k0, ufr[0], acc, 0, 0, 0); acc = __builtin_amdgcn_mfma_f32_16x16x32_bf16(k1, ufr[1], acc, 0, 0, 0); \
            _Pragma("unroll") for (int i = 0; i < 4; ++i) A.OG[((size_t)b * SEQ + 64 * (n) + 16 * tc + 4 * fq + i) * 512 + h * 64 + 16 * te + fr] = acc[i]; } \
        const float dec = ((const float*)(lds + SC_DEC))[(n)]; \
        _Pragma("unroll") for (int td = 0; td < 4; ++td) { \
            const bf16x8 t0 = *(const bf16x8*)(sb_ + 1 * SC_MAT + (16 * td + fr) * SC_ROW + (8 * fq) * 2), t1 = *(const bf16x8*)(sb_ + 1 * SC_MAT + (16 * td + fr) * SC_ROW + (32 + 8 * fq) * 2); \
            f32x4 acc = s[td] * dec; acc = __builtin_amdgcn_mfma_f32_16x16x32_bf16(t0, ufr[0], acc, 0, 0, 0); acc = __builtin_amdgcn_mfma_f32_16x16x32_bf16(t1, ufr[1], acc, 0, 0, 0); s[td] = acc; } \
        _Pragma("unroll") for (int ks = 0; ks < 2; ++ks) sfr[ks] = pack8(s[2 * ks][0], s[2 * ks][1], s[2 * ks][2], s[2 * ks][3], s[2 * ks + 1][0], s[2 * ks + 1][1], s[2 * ks + 1][2], s[2 * ks + 1][3]); } } while (0)
#pragma unroll 1
    for (int n = 0; n < 64; n += 2) {
        SC_STORE(rb, 1); __builtin_amdgcn_sched_barrier(0); SC_LOAD(rb, n + 3); __builtin_amdgcn_sched_barrier(0);
        SC_CHUNK(n, 0);
        __syncthreads();
        SC_STORE(ra, 0); __builtin_amdgcn_sched_barrier(0); SC_LOAD(ra, n + 4); __builtin_amdgcn_sched_barrier(0);
        SC_CHUNK(n + 1, 1);
        __syncthreads();
    }
#undef SC_LOAD
#undef SC_STORE
#undef SC_CHUNK
    if (wave < 4) {
#pragma unroll
        for (int td = 0; td < 4; ++td)
#pragma unroll
            for (int i = 0; i < 4; ++i) A.out[O_GDNP + ((((size_t)A.l * NPB + b) * 8 + h) * 64 + 16 * td + 4 * fq + i) * 64 + 16 * te + fr] = s[td][i];
    }
}

constexpr int L_CK = 0, L_CVT = 18432, L_IMP = 36864, L_MASK = 102400, L_UM = 102912, L_INV = 102928, L_K = 104448, L_VT = 113664;
struct AttArgs { const bf16* QB; const bf16* KS; const bf16* VS; const bf16* KW; const bf16* VW; const float* CKP; const float* CVP; const float* PROJ; bf16* MIX; };

constexpr float ATT_THR = 16.f;
constexpr int L_K2 = 122880, L_VT2 = 132096, L_VT3 = 0;
template <int MODE>
__device__ __forceinline__ void attn_tiles(unsigned char* lds, const bf16* Kg, const bf16* Vg, int j_lo, int j_hi, unsigned long long umask, unsigned long long tmask,
                                           int qblk, int trel, const bf16x8 (&qr)[4], f32x16 (&o)[2], float& mref, float& lrun, int tid, int r32, int hi) {
    int j = j_lo; while (j <= j_hi && !((umask >> j) & 1ull)) ++j;
    const int key = tid >> 3, ch = tid & 7;
    v4u kvv = {0u, 0u, 0u, 0u}, vv = {0u, 0u, 0u, 0u};
#define AT_LOAD(jj) do { kvv = *(const v4u*)(Kg + (size_t)(64 * (jj) + key) * 128 + ch * 8); vv = *(const v4u*)(Vg + (size_t)(64 * (jj) + key) * 128 + ch * 8); } while (0)
#define AT_WRITE(kofs, vofs) do { *(v4u*)(lds + (kofs) + key * 144 + ch * 16) = kvv; *(v4u*)(lds + (vofs) + key * 144 + ch * 16) = vv; } while (0)
    if (j > j_hi) return;
    AT_LOAD(j);
    __syncthreads();
    AT_WRITE(L_K, L_VT);
    int jn = j + 1; while (jn <= j_hi && !((umask >> jn) & 1ull)) ++jn;
    if (jn <= j_hi) AT_LOAD(jn);
    __syncthreads();
    const bool grpB = (tid >= 256);
    v4u pwp[4];
#pragma unroll
    for (int i = 0; i < 4; ++i) pwp[i] = (v4u){0u, 0u, 0u, 0u};
    int it = 0, vprev = L_VT;
    typedef short v4i16_t_ __attribute__((ext_vector_type(4)));
    const int trl_ = tid & 63, trq_ = (trl_ & 15) >> 2, trp_ = trl_ & 3, trd_ = 16 * ((trl_ >> 4) & 1) + 4 * trp_;
#define AT_TR(p_) __builtin_bit_cast(s16x4, __builtin_amdgcn_ds_read_tr16_b64_v4i16((__attribute__((address_space(3))) v4i16_t_*)(p_)))
#define AT_PV(vofs, PW) do { _Pragma("unroll") for (int u = 0; u < 2; ++u) _Pragma("unroll") for (int s = 0; s < 2; ++s) { const bf16x8 pf = __builtin_bit_cast(bf16x8, PW[u * 2 + s]); \
        _Pragma("unroll") for (int dh = 0; dh < 2; ++dh) { const unsigned char* vp = lds + (vofs) + (32 * u + 16 * s + 4 * hi + trq_) * 144 + (32 * dh + trd_) * 2; \
            const s16x4 lo = AT_TR(vp), hi4 = AT_TR(vp + 8 * 144); \
            const bf16x8 vf = (bf16x8){lo[0], lo[1], lo[2], lo[3], hi4[0], hi4[1], hi4[2], hi4[3]}; \
            o[dh] = __builtin_amdgcn_mfma_f32_32x32x16_bf16(vf, pf, o[dh], 0, 0, 0); } } } while (0)
    while (j <= j_hi) {
        const int kb = (it & 1) ? L_K2 : L_K, kb2 = (it & 1) ? L_K : L_K2;
        const int m3 = it % 3, vb = (m3 == 0) ? L_VT : (m3 == 1) ? L_VT2 : L_VT3, vb2 = (m3 == 0) ? L_VT2 : (m3 == 1) ? L_VT3 : L_VT;
        if (grpB && it > 0) AT_PV(vprev, pwp);
        if (jn <= j_hi) AT_WRITE(kb2, vb2);
        int jnn = jn + 1; while (jnn <= j_hi && !((umask >> jnn) & 1ull)) ++jnn;
        if (jnn <= j_hi) AT_LOAD(jnn);
        __builtin_amdgcn_sched_barrier(0);
        const bool tsel = (MODE == 0) ? (((tmask >> j) & 1ull) != 0ull) : true;
        const float cval = tsel ? -mref : NEG_INF;
        f32x16 ct;
#pragma unroll
        for (int r = 0; r < 16; ++r) ct[r] = cval;
        f32x16 p[2];
#pragma unroll
        for (int u = 0; u < 2; ++u) { f32x16 acc;
#pragma unroll
            for (int d0 = 0; d0 < 4; ++d0) { const bf16x8 kf = *(const bf16x8*)(lds + kb + (32 * u + r32) * 144 + (16 * d0 + 8 * hi) * 2);
                acc = __builtin_amdgcn_mfma_f32_32x32x16_bf16(kf, qr[d0], d0 == 0 ? ct : acc, 0, 0, 0); }
            p[u] = acc; }
        if (j == qblk) {
#pragma unroll
            for (int u = 0; u < 2; ++u)
#pragma unroll
                for (int r = 0; r < 16; ++r) { const int kv = 32 * u + crow(r, hi); if (kv > trel) p[u][r] = NEG_INF; } }
        if (MODE == 1 && j == qblk - 8) {
#pragma unroll
            for (int u = 0; u < 2; ++u)
#pragma unroll
                for (int r = 0; r < 16; ++r) { const int kv = 32 * u + crow(r, hi); if (kv < trel) p[u][r] = NEG_INF; } }
        float rm;
        { float a = __builtin_fmaxf(__builtin_fmaxf(p[0][0], p[0][1]), p[1][0]), b2 = __builtin_fmaxf(__builtin_fmaxf(p[0][2], p[0][3]), p[1][1]); a = __builtin_fmaxf(__builtin_fmaxf(a, p[1][2]), p[1][3]);
#pragma unroll
          for (int r = 4; r < 16; r += 4) { a = __builtin_fmaxf(__builtin_fmaxf(a, p[0][r]), p[0][r + 1]); b2 = __builtin_fmaxf(__builtin_fmaxf(b2, p[0][r + 2]), p[0][r + 3]);
              a = __builtin_fmaxf(__builtin_fmaxf(a, p[1][r]), p[1][r + 1]); b2 = __builtin_fmaxf(__builtin_fmaxf(b2, p[1][r + 2]), p[1][r + 3]); }
          rm = __builtin_fmaxf(a, b2); }
        { auto rr = __builtin_amdgcn_permlane32_swap(__float_as_uint(rm), __float_as_uint(rm), false, false); rm = __builtin_fmaxf(__uint_as_float(rr[0]), __uint_as_float(rr[1])); }
        if (__builtin_expect(__any(rm > ATT_THR), 0)) {
            const float dl = (rm > ATT_THR) ? rm : 0.f, f = ex2(-dl);
            mref += dl; lrun *= f;
#pragma unroll
            for (int u = 0; u < 2; ++u)
#pragma unroll
                for (int r = 0; r < 16; ++r) p[u][r] -= dl;
#pragma unroll
            for (int dh = 0; dh < 2; ++dh)
#pragma unroll
                for (int r = 0; r < 16; ++r) o[dh][r] *= f; }
        typedef float f32x2v_ __attribute__((ext_vector_type(2)));
        f32x2v_ ls2 = {0.f, 0.f};
#pragma unroll
        for (int u = 0; u < 2; ++u)
#pragma unroll
            for (int r = 0; r < 16; r += 2) { const float e0 = ex2(p[u][r]), e1 = ex2(p[u][r + 1]); p[u][r] = e0; p[u][r + 1] = e1; ls2 += (f32x2v_){e0, e1}; }
        lrun += ls2.x + ls2.y;
        v4u pw[4];
#pragma unroll
        for (int u = 0; u < 2; ++u)
#pragma unroll
            for (int s = 0; s < 2; ++s) { pw[u * 2 + s].x = pk2(p[u][8 * s + 0], p[u][8 * s + 1]); pw[u * 2 + s].y = pk2(p[u][8 * s + 2], p[u][8 * s + 3]);
                pw[u * 2 + s].z = pk2(p[u][8 * s + 4], p[u][8 * s + 5]); pw[u * 2 + s].w = pk2(p[u][8 * s + 6], p[u][8 * s + 7]); }
        if (!grpB) AT_PV(vb, pw);
        else {
#pragma unroll
            for (int i = 0; i < 4; ++i) pwp[i] = pw[i];
            vprev = vb; }
        __syncthreads();
        j = jn; jn = jnn; ++it;
    }
    if (grpB && it > 0) AT_PV(vprev, pwp);
#undef AT_PV
#undef AT_TR
#undef AT_LOAD
#undef AT_WRITE
}

__device__ __forceinline__ void nsa_prompt_unit(const AttArgs& A, unsigned char* lds, int unit, int tid) {
    const int lane = tid & 63, wave = tid >> 6, r32 = lane & 31, hi = lane >> 5, hh = wave & 3, ts = wave >> 2;
    const int qblk = 63 - (unit >> 3), b = (unit >> 1) & 3, kvh = unit & 1;
    const int head = kvh * 4 + hh, trel = 32 * ts + r32, t = 64 * qblk + trel; const size_t m = (size_t)b * SEQ + t;
    __syncthreads();
    const int nvmax = 2 * qblk + 2, ntile_c = (nvmax + 31) >> 5;
    { const int ch = tid & 7;
      for (int n = tid >> 3; n < 32 * ntile_c; n += 64) {
          const float* ckp = A.CKP + ((size_t)(b * 128 + n) * 2 + kvh) * 64 + ch * 8; const float* cvp = A.CVP + ((size_t)(b * 128 + n) * 2 + kvh) * 64 + ch * 8;
          const f32x4 k0 = *(const f32x4*)ckp, k1 = *(const f32x4*)(ckp + 4), v0 = *(const f32x4*)cvp, v1 = *(const f32x4*)(cvp + 4);
          *(bf16x8*)(lds + L_CK + n * 144 + ch * 16) = pack8(k0.x, k0.y, k0.z, k0.w, k1.x, k1.y, k1.z, k1.w);
          unsigned short* vt = (unsigned short*)(lds + L_CVT);
          vt[(ch * 8 + 0) * 136 + n] = (unsigned short)f2bf(v0.x); vt[(ch * 8 + 1) * 136 + n] = (unsigned short)f2bf(v0.y); vt[(ch * 8 + 2) * 136 + n] = (unsigned short)f2bf(v0.z); vt[(ch * 8 + 3) * 136 + n] = (unsigned short)f2bf(v0.w);
          vt[(ch * 8 + 4) * 136 + n] = (unsigned short)f2bf(v1.x); vt[(ch * 8 + 5) * 136 + n] = (unsigned short)f2bf(v1.y); vt[(ch * 8 + 6) * 136 + n] = (unsigned short)f2bf(v1.z); vt[(ch * 8 + 7) * 136 + n] = (unsigned short)f2bf(v1.w);
      }
      if (tid < 128) ((unsigned*)(lds + L_MASK))[tid] = 0u;
      if (tid < 2) ((unsigned*)(lds + L_UM))[tid] = 0u; }
    bf16x8 qr[4];
#pragma unroll
    for (int d0 = 0; d0 < 4; ++d0) qr[d0] = *(const bf16x8*)(A.QB + m * 512 + head * 64 + 16 * d0 + 8 * hi);
    __syncthreads();
    f32x16 tot[2];
    {
        const int nv = (t + 1) >> 5;
        float mx = NEG_INF;
#pragma unroll 1
        for (int tau = 0; tau < ntile_c; ++tau) {
            f32x16 acc = {};
#pragma unroll
            for (int d0 = 0; d0 < 4; ++d0) { const bf16x8 kf = *(const bf16x8*)(lds + L_CK + (32 * tau + r32) * 144 + (16 * d0 + 8 * hi) * 2);
                acc = __builtin_amdgcn_mfma_f32_32x32x16_bf16(kf, qr[d0], acc, 0, 0, 0); }
#pragma unroll
            for (int r = 0; r < 16; ++r) { const int n = 32 * tau + crow(r, hi); if (n < nv) mx = fmaxf(mx, acc[r]); }
        }
        mx = fmaxf(mx, __shfl_xor(mx, 32)); if (mx == NEG_INF) mx = 0.f;
        float sum = 0.f;
        f32x16 oc[2]; oc[0] = (f32x16){}; oc[1] = (f32x16){};
        float* imph = (float*)(lds + L_IMP) + (size_t)hh * 4096 + (32 * ts + r32) * 64;
#pragma unroll 1
        for (int tau = 0; tau < 4; ++tau) {
            f32x16 e = {};
            if (tau < ntile_c) {
                f32x16 acc = {};
#pragma unroll
                for (int d0 = 0; d0 < 4; ++d0) { const bf16x8 kf = *(const bf16x8*)(lds + L_CK + (32 * tau + r32) * 144 + (16 * d0 + 8 * hi) * 2);
                    acc = __builtin_amdgcn_mfma_f32_32x32x16_bf16(kf, qr[d0], acc, 0, 0, 0); }
#pragma unroll
                for (int r = 0; r < 16; ++r) { const int n = 32 * tau + crow(r, hi); e[r] = (n < nv) ? ex2(acc[r] - mx) : 0.f; sum += e[r]; }
#pragma unroll
                for (int s = 0; s < 2; ++s) {
                    const bf16x8 pf = pack8(e[8 * s + 0], e[8 * s + 1], e[8 * s + 2], e[8 * s + 3], e[8 * s + 4], e[8 * s + 5], e[8 * s + 6], e[8 * s + 7]);
#pragma unroll
                    for (int dh = 0; dh < 2; ++dh) { const unsigned char* vp = lds + L_CVT + (r32 + 32 * dh) * 272 + (32 * tau + 16 * s + 4 * hi) * 2;
                        const s16x4 lo = *(const s16x4*)vp, hi4 = *(const s16x4*)(vp + 16);
                        const bf16x8 vf = (bf16x8){lo[0], lo[1], lo[2], lo[3], hi4[0], hi4[1], hi4[2], hi4[3]};
                        oc[dh] = __builtin_amdgcn_mfma_f32_32x32x16_bf16(vf, pf, oc[dh], 0, 0, 0); }
                }
            }
#pragma unroll
            for (int a = 0; a < 4; ++a) { imph[16 * tau + 4 * a + 2 * hi + 0] = e[4 * a] + e[4 * a + 1]; imph[16 * tau + 4 * a + 2 * hi + 1] = e[4 * a + 2] + e[4 * a + 3]; }
        }
        sum += __shfl_xor(sum, 32);
        const float inv = 1.f / fmaxf(sum, 1e-30f);
        if (hi == 0) ((float*)(lds + L_INV))[hh * 64 + 32 * ts + r32] = inv;
        const float g0 = sigmoidf_(A.PROJ[m * NP + C_GATE + head * 3 + 0]) * inv;
#pragma unroll
        for (int dh = 0; dh < 2; ++dh)
#pragma unroll
            for (int r = 0; r < 16; ++r) tot[dh][r] = g0 * oc[dh][r];
    }
    __syncthreads();
    { float* ip = (float*)(lds + L_IMP); const float* iv = (const float*)(lds + L_INV);
#pragma unroll
      for (int i = 0; i < 8; ++i) { const int idx = tid + 512 * i, tk = idx >> 6;
          ip[idx] = (ip[idx] * iv[tk] + ip[4096 + idx] * iv[64 + tk]) + (ip[8192 + idx] * iv[128 + tk] + ip[12288 + idx] * iv[192 + tk]); } }
    __syncthreads();
    { const int tok = tid >> 3, jg = tid & 7; unsigned* mk = (unsigned*)(lds + L_MASK) + tok * 2;
      if (qblk <= 15) { if (jg == 0) { const unsigned long long am = (1ull << (qblk + 1)) - 1ull; mk[0] = (unsigned)am; mk[1] = (unsigned)(am >> 32); } }
      else {
          const float* iv = (const float*)(lds + L_IMP) + tok * 64; float vj[8]; int rk[8];
#pragma unroll
          for (int jj = 0; jj < 8; ++jj) { vj[jj] = iv[jg * 8 + jj]; rk[jj] = 0; }
          for (int i = 1; i <= qblk - 2; ++i) { const float vi = iv[i];
#pragma unroll
              for (int jj = 0; jj < 8; ++jj) { const int j = jg * 8 + jj; rk[jj] += (vi > vj[jj] || (vi == vj[jj] && i < j)) ? 1 : 0; } }
          unsigned bits = 0u;
#pragma unroll
          for (int jj = 0; jj < 8; ++jj) { const int j = jg * 8 + jj; const bool cand = (j >= 1 && j <= qblk - 2);
              if ((cand && rk[jj] < 13) || j == 0 || j == qblk || j == qblk - 1) bits |= 1u << ((jg & 3) * 8 + jj); }
          if (bits) atomicOr(mk + (jg >> 2), bits);
      } }
    __syncthreads();
    if (tid < 64) { const unsigned* mk = (const unsigned*)(lds + L_MASK) + tid * 2; atomicOr((unsigned*)(lds + L_UM), mk[0]); atomicOr((unsigned*)(lds + L_UM) + 1, mk[1]); }
    __syncthreads();
    unsigned long long tmask, umask;
    { const unsigned* mk = (const unsigned*)(lds + L_MASK) + trel * 2; tmask = (unsigned long long)mk[0] | ((unsigned long long)mk[1] << 32);
      const unsigned* um = (const unsigned*)(lds + L_UM); umask = (unsigned long long)um[0] | ((unsigned long long)um[1] << 32); }
    float* stash = (float*)(lds + L_IMP) + (size_t)wave * 2048 + lane;
#pragma unroll
    for (int dh = 0; dh < 2; ++dh)
#pragma unroll
        for (int r = 0; r < 16; ++r) stash[(dh * 16 + r) * 64] = tot[dh][r];
    {
        f32x16 o[2]; o[0] = (f32x16){}; o[1] = (f32x16){}; float mrun = 0.f, lrun = 0.f;
        attn_tiles<0>(lds, A.KS + (size_t)b * SEQ * 128 + kvh * 64, A.VS + (size_t)b * SEQ * 128 + kvh * 64, 0, qblk, umask, tmask, qblk, trel, qr, o, mrun, lrun, tid, r32, hi);
        lrun += __shfl_xor(lrun, 32);
        const float g1 = lrun > 0.f ? sigmoidf_(A.PROJ[m * NP + C_GATE + head * 3 + 1]) / lrun : 0.f;
#pragma unroll
        for (int dh = 0; dh < 2; ++dh)
#pragma unroll
            for (int r = 0; r < 16; ++r) stash[(dh * 16 + r) * 64] += g1 * o[dh][r];
    }
    {
        f32x16 o[2]; o[0] = (f32x16){}; o[1] = (f32x16){}; float mrun = 0.f, lrun = 0.f;
        const int jlo = qblk >= 8 ? qblk - 8 : 0;
        attn_tiles<1>(lds, A.KW + (size_t)b * SEQ * 128 + kvh * 64, A.VW + (size_t)b * SEQ * 128 + kvh * 64, jlo, qblk, ~0ull, ~0ull, qblk, trel, qr, o, mrun, lrun, tid, r32, hi);
        lrun += __shfl_xor(lrun, 32);
        const float g2 = lrun > 0.f ? sigmoidf_(A.PROJ[m * NP + C_GATE + head * 3 + 2]) / lrun : 0.f;
#pragma unroll
        for (int dh = 0; dh < 2; ++dh)
#pragma unroll
            for (int r = 0; r < 16; ++r) tot[dh][r] = stash[(dh * 16 + r) * 64] + g2 * o[dh][r];
    }
    bf16* mo = A.MIX + m * 1024 + 512 + head * 64;
#pragma unroll
    for (int dh = 0; dh < 2; ++dh)
#pragma unroll
        for (int a = 0; a < 4; ++a) { const int d0 = 32 * dh + 8 * a + 4 * hi;
            *(v2u*)(mo + d0) = (v2u){pk2(tot[dh][4 * a], tot[dh][4 * a + 1]), pk2(tot[dh][4 * a + 2], tot[dh][4 * a + 3])}; }
}

struct SAttArgs { const bf16* QB; const bf16* KS; const bf16* VS; const bf16* KW; const bf16* VW; const float* CKS; const float* CVS; const float* PROJ; const float* cache; const int* page_table; const float* state_win; bf16* MIX; int l; };
constexpr int S2_IMP = 0, S2_MK = 512, S2_ITEMS = 576, S2_OC = 1024, S2_MG = 8192;
constexpr int S2_MG_STRIDE = 4224;
template <bool F32> __device__ __forceinline__ void s2_block(const void* kbase, const void* vbase, int kstride, int nvalid, const bf16x8 (&qf)[2], const bool (&keep)[4][4], f32x4 (&O)[4], float& mrun, float& lrun, int fr, int fq) {
    f32x4 kraw[4][2][2]; bf16x8 kb[4][2]; f32x4 vraw[2][8]; v2u vb[2][8];
#pragma unroll
    for (int tk = 0; tk < 4; ++tk) { const int key = 16 * tk + fr, kc = key < nvalid ? key : nvalid - 1;
#pragma unroll
        for (int ks = 0; ks < 2; ++ks) {
            if (F32) { const float* p = (const float*)kbase + (size_t)kc * kstride + 32 * ks + 8 * fq; kraw[tk][ks][0] = *(const f32x4*)p; kraw[tk][ks][1] = *(const f32x4*)(p + 4); }
            else kb[tk][ks] = *(const bf16x8*)((const bf16*)kbase + (size_t)kc * 128 + 32 * ks + 8 * fq); } }
#pragma unroll
    for (int ks = 0; ks < 2; ++ks)
#pragma unroll
        for (int j = 0; j < 8; ++j) { const int key = 32 * ks + 16 * (j >> 2) + 4 * fq + (j & 3), kc = key < nvalid ? key : nvalid - 1;
            if (F32) vraw[ks][j] = *(const f32x4*)((const float*)vbase + (size_t)kc * kstride + 4 * fr);
            else vb[ks][j] = *(const v2u*)((const bf16*)vbase + (size_t)kc * 128 + 4 * fr); }
    __builtin_amdgcn_sched_barrier(0);
    f32x4 acc[4];
#pragma unroll
    for (int tk = 0; tk < 4; ++tk) { bf16x8 kx[2];
#pragma unroll
        for (int ks = 0; ks < 2; ++ks) { if (F32) { const f32x4 a = kraw[tk][ks][0], b = kraw[tk][ks][1]; kx[ks] = pack8(a.x, a.y, a.z, a.w, b.x, b.y, b.z, b.w); } else kx[ks] = kb[tk][ks]; }
        f32x4 a4 = {0.f, 0.f, 0.f, 0.f};
        a4 = __builtin_amdgcn_mfma_f32_16x16x32_bf16(kx[0], qf[0], a4, 0, 0, 0); a4 = __builtin_amdgcn_mfma_f32_16x16x32_bf16(kx[1], qf[1], a4, 0, 0, 0);
        acc[tk] = a4; }
    float mx = NEG_INF;
#pragma unroll
    for (int tk = 0; tk < 4; ++tk)
#pragma unroll
        for (int i = 0; i < 4; ++i) { if (!keep[tk][i]) acc[tk][i] = NEG_INF; mx = fmaxf(mx, acc[tk][i]); }
    mx = fmaxf(mx, __shfl_xor(mx, 16)); mx = fmaxf(mx, __shfl_xor(mx, 32));
    const float mn = fmaxf(mrun, mx), msafe = (mn == NEG_INF) ? 0.f : mn, alpha = ex2(mrun - msafe);
    float ls = 0.f;
#pragma unroll
    for (int tk = 0; tk < 4; ++tk)
#pragma unroll
        for (int i = 0; i < 4; ++i) { const float e = ex2(acc[tk][i] - msafe); acc[tk][i] = e; ls += e; }
    lrun = lrun * alpha + ls; mrun = mn;
#pragma unroll
    for (int td = 0; td < 4; ++td) O[td] *= alpha;
#pragma unroll
    for (int ks = 0; ks < 2; ++ks) {
        const bf16x8 pf = pack8(acc[2 * ks][0], acc[2 * ks][1], acc[2 * ks][2], acc[2 * ks][3], acc[2 * ks + 1][0], acc[2 * ks + 1][1], acc[2 * ks + 1][2], acc[2 * ks + 1][3]);
        float vv[8][4];
#pragma unroll
        for (int j = 0; j < 8; ++j) {
            if (F32) { const f32x4 v = vraw[ks][j]; vv[j][0] = v.x; vv[j][1] = v.y; vv[j][2] = v.z; vv[j][3] = v.w; }
            else { const v2u w = vb[ks][j]; vv[j][0] = bf2f((unsigned short)(w.x & 0xffffu)); vv[j][1] = bf2f((unsigned short)(w.x >> 16)); vv[j][2] = bf2f((unsigned short)(w.y & 0xffffu)); vv[j][3] = bf2f((unsigned short)(w.y >> 16)); } }
#pragma unroll
        for (int td = 0; td < 4; ++td) { const bf16x8 vx = pack8(vv[0][td], vv[1][td], vv[2][td], vv[3][td], vv[4][td], vv[5][td], vv[6][td], vv[7][td]);
            O[td] = __builtin_amdgcn_mfma_f32_16x16x32_bf16(vx, pf, O[td], 0, 0, 0); }
    }
}
__device__ __forceinline__ void nsa_sample_unit(const SAttArgs& A, unsigned char* lds, int unit, int tid) {
    const int sb = unit >> 1, kvh = unit & 1, l = A.l;
    const int lane = tid & 63, wave = __builtin_amdgcn_readfirstlane(tid >> 6), fr = lane & 15, fq = lane >> 4;
    const int qi = fr >> 2, qh = fr & 3;
    float* IMP = (float*)(lds + S2_IMP); unsigned* MK = (unsigned*)(lds + S2_MK); int* ITEMS = (int*)(lds + S2_ITEMS);
    const size_t mq = (size_t)MP + sb * 4 + qi;
    __syncthreads();
    if (tid < 8) MK[tid] = 0u;
    bf16x8 qf[2];
#pragma unroll
    for (int ks = 0; ks < 2; ++ks) qf[ks] = *(const bf16x8*)(A.QB + mq * 512 + (kvh * 4 + qh) * 64 + 32 * ks + 8 * fq);
    {
        f32x4 O[4]; float mrun = NEG_INF, lrun = 0.f;
#pragma unroll
        for (int td = 0; td < 4; ++td) O[td] = (f32x4){0.f, 0.f, 0.f, 0.f};
        bool keep[4][4];
#pragma unroll
        for (int tk = 0; tk < 4; ++tk)
#pragma unroll
            for (int i = 0; i < 4; ++i) keep[tk][i] = true;
        const float* ckf = A.CKS + ((size_t)sb * 64 * 2 + kvh) * 64; const float* cvf = A.CVS + ((size_t)sb * 64 * 2 + kvh) * 64;
        f32x4 acc[4];
#pragma unroll
        for (int tk = 0; tk < 4; ++tk) { bf16x8 kx[2];
#pragma unroll
            for (int ks = 0; ks < 2; ++ks) { const float* p = ckf + (size_t)(16 * tk + fr) * 128 + 32 * ks + 8 * fq; const f32x4 a = *(const f32x4*)p, b = *(const f32x4*)(p + 4); kx[ks] = pack8(a.x, a.y, a.z, a.w, b.x, b.y, b.z, b.w); }
            f32x4 a4 = {0.f, 0.f, 0.f, 0.f};
            a4 = __builtin_amdgcn_mfma_f32_16x16x32_bf16(kx[0], qf[0], a4, 0, 0, 0); a4 = __builtin_amdgcn_mfma_f32_16x16x32_bf16(kx[1], qf[1], a4, 0, 0, 0);
            acc[tk] = a4; }
        float mx = NEG_INF;
#pragma unroll
        for (int tk = 0; tk < 4; ++tk)
#pragma unroll
            for (int i = 0; i < 4; ++i) mx = fmaxf(mx, acc[tk][i]);
        mx = fmaxf(mx, __shfl_xor(mx, 16)); mx = fmaxf(mx, __shfl_xor(mx, 32));
        float ls = 0.f;
#pragma unroll
        for (int tk = 0; tk < 4; ++tk)
#pragma unroll
            for (int i = 0; i < 4; ++i) { const float e = ex2(acc[tk][i] - mx); acc[tk][i] = e; ls += e; }
        ls += __shfl_xor(ls, 16); ls += __shfl_xor(ls, 32);
        const float inv = 1.f / fmaxf(ls, 1e-30f);
        if (wave == 0) {
#pragma unroll
            for (int tk = 0; tk < 4; ++tk)
#pragma unroll
                for (int b2 = 0; b2 < 2; ++b2) { float v = (acc[tk][2 * b2] + acc[tk][2 * b2 + 1]) * inv;
                    v += __shfl_xor(v, 1); v += __shfl_xor(v, 2);
                    if (qh == 0) IMP[qi * 32 + 8 * tk + 2 * fq + b2] = v; }
#pragma unroll
            for (int ks = 0; ks < 2; ++ks) {
                const bf16x8 pf = pack8(acc[2 * ks][0], acc[2 * ks][1], acc[2 * ks][2], acc[2 * ks][3], acc[2 * ks + 1][0], acc[2 * ks + 1][1], acc[2 * ks + 1][2], acc[2 * ks + 1][3]);
#pragma unroll
                for (int td = 0; td < 4; ++td) { float vv[8];
#pragma unroll
                    for (int j = 0; j < 8; ++j) { const int key = 32 * ks + 16 * (j >> 2) + 4 * fq + (j & 3); vv[j] = cvf[(size_t)key * 128 + 4 * fr + td]; }
                    const bf16x8 vx = pack8(vv[0], vv[1], vv[2], vv[3], vv[4], vv[5], vv[6], vv[7]);
                    O[td] = __builtin_amdgcn_mfma_f32_16x16x32_bf16(vx, pf, O[td], 0, 0, 0); } }
            const float g0 = sigmoidf_(A.PROJ[mq * NP + C_GATE + (kvh * 4 + qh) * 3 + 0]) * inv;
            float* OC = (float*)(lds + S2_OC);
#pragma unroll
            for (int td = 0; td < 4; ++td)
#pragma unroll
                for (int i = 0; i < 4; ++i) OC[(16 * fq + 4 * i + td) * 16 + fr] = g0 * O[td][i];
        }
        (void)mrun; (void)lrun; (void)keep;
    }
    __syncthreads();
    if (tid < 128) { const int i = tid >> 5, j = tid & 31; bool sel = (j == 0 || j == 31);
        if (j >= 1 && j <= 30) { const float vj = IMP[i * 32 + j]; int rk = 0;
            for (int q = 1; q <= 30; ++q) { const float vi = IMP[i * 32 + q]; rk += (vi > vj || (vi == vj && q < j)) ? 1 : 0; }
            sel = rk < 13; }
        if (sel) { atomicOr(MK + i, 1u << j); atomicOr(MK + 4, 1u << j); } }
    __syncthreads();
    if (tid == 0) { const unsigned um = MK[4]; int n = 0;
        for (int j = 0; j < 32; ++j) if ((um >> j) & 1u) ITEMS[1 + n++] = j;
        ITEMS[1 + n++] = 32;
        for (int jb = 0; jb < 9; ++jb) ITEMS[1 + n++] = 64 + jb;
        ITEMS[0] = n; }
    __syncthreads();
    {
        const int nitems = ITEMS[0]; const unsigned tm = MK[qi];
        f32x4 Os[4], Ow[4]; float ms = NEG_INF, lsum = 0.f, mw = NEG_INF, lw = 0.f;
#pragma unroll
        for (int td = 0; td < 4; ++td) { Os[td] = (f32x4){0.f, 0.f, 0.f, 0.f}; Ow[td] = (f32x4){0.f, 0.f, 0.f, 0.f}; }
        const float* wb = A.state_win + ((size_t)l * NSB + sb) * 512 * 256 + kvh * 64;
        for (int it = wave; it < nitems; it += NWAVES) {
            const int code = ITEMS[1 + it]; bool keep[4][4];
            if (code < 64) {
                const int j = code;
                if (j < 32) { const int phys = A.page_table[sb * NPAGES + (j >> 1)];
                    const float* base = A.cache + ((((size_t)l * NPOOL + phys) * 2 + kvh) * 128 + (j & 1) * 64) * 256;
                    const bool tsel = ((tm >> j) & 1u) != 0u;
#pragma unroll
                    for (int tk = 0; tk < 4; ++tk)
#pragma unroll
                        for (int i = 0; i < 4; ++i) keep[tk][i] = tsel;
                    s2_block<true>(base + 128, base + 192, 256, 64, qf, keep, Os, ms, lsum, fr, fq);
                } else {
#pragma unroll
                    for (int tk = 0; tk < 4; ++tk)
#pragma unroll
                        for (int i = 0; i < 4; ++i) { const int key = 16 * tk + 4 * fq + i; keep[tk][i] = key <= qi; }
                    s2_block<false>(A.KS + ((size_t)MP + sb * 4) * 128 + kvh * 64, A.VS + ((size_t)MP + sb * 4) * 128 + kvh * 64, 128, 4, qf, keep, Os, ms, lsum, fr, fq);
                }
            } else {
                const int jb = code - 64;
                if (jb < 8) {
#pragma unroll
                    for (int tk = 0; tk < 4; ++tk)
#pragma unroll
                        for (int i = 0; i < 4; ++i) { const int r = 64 * jb + 16 * tk + 4 * fq + i; keep[tk][i] = r >= qi; }
                    s2_block<true>(wb + (size_t)(64 * jb) * 256, wb + (size_t)(64 * jb) * 256 + 128, 256, 64, qf, keep, Ow, mw, lw, fr, fq);
                } else {
#pragma unroll
                    for (int tk = 0; tk < 4; ++tk)
#pragma unroll
                        for (int i = 0; i < 4; ++i) { const int key = 16 * tk + 4 * fq + i; keep[tk][i] = key <= qi; }
                    s2_block<false>(A.KW + ((size_t)MP + sb * 4) * 128 + kvh * 64, A.VW + ((size_t)MP + sb * 4) * 128 + kvh * 64, 128, 4, qf, keep, Ow, mw, lw, fr, fq);
                }
            }
        }
        lsum += __shfl_xor(lsum, 16); lsum += __shfl_xor(lsum, 32); lw += __shfl_xor(lw, 16); lw += __shfl_xor(lw, 32);
        float* Ps = (float*)(lds + S2_MG + (wave * 2 + 0) * S2_MG_STRIDE); float* Pw = (float*)(lds + S2_MG + (wave * 2 + 1) * S2_MG_STRIDE);
#pragma unroll
        for (int td = 0; td < 4; ++td)
#pragma unroll
            for (int i = 0; i < 4; ++i) { Ps[(16 * fq + 4 * i + td) * 16 + fr] = Os[td][i]; Pw[(16 * fq + 4 * i + td) * 16 + fr] = Ow[td][i]; }
        if (fq == 0) { Ps[1024 + fr] = ms; Ps[1040 + fr] = lsum; Pw[1024 + fr] = mw; Pw[1040 + fr] = lw; }
    }
    __syncthreads();
    {
        const int q = tid & 15, i = q >> 2, hh = q & 3; const size_t m = (size_t)MP + sb * 4 + i;
        const float* OC = (const float*)(lds + S2_OC);
        float res[2];
#pragma unroll
        for (int k = 0; k < 2; ++k) res[k] = OC[((tid >> 4) + 32 * k) * 16 + q];
#pragma unroll
        for (int br = 0; br < 2; ++br) {
            float M = NEG_INF;
#pragma unroll
            for (int w = 0; w < NWAVES; ++w) M = fmaxf(M, ((const float*)(lds + S2_MG + (w * 2 + br) * S2_MG_STRIDE))[1024 + q]);
            float L = 0.f, o0 = 0.f, o1 = 0.f;
#pragma unroll
            for (int w = 0; w < NWAVES; ++w) { const float* P = (const float*)(lds + S2_MG + (w * 2 + br) * S2_MG_STRIDE);
                const float f = ex2(P[1024 + q] - M);
                L += P[1040 + q] * f; o0 += P[(tid >> 4) * 16 + q] * f; o1 += P[((tid >> 4) + 32) * 16 + q] * f; }
            const float g = sigmoidf_(A.PROJ[m * NP + C_GATE + (kvh * 4 + hh) * 3 + 1 + br]) / fmaxf(L, 1e-30f);
            res[0] += g * o0; res[1] += g * o1;
        }
#pragma unroll
        for (int k = 0; k < 2; ++k) A.MIX[m * 1024 + 512 + (kvh * 4 + hh) * 64 + (tid >> 4) + 32 * k] = (bf16)f2bf(res[k]);
    }
}

constexpr int CW_CMPQ = 256;
__device__ __forceinline__ void compress_pull(const CmpArgs& A, unsigned char* lds, unsigned* head, volatile LAS int* slot, int max_batches, int tid) {
    for (int nb = 0; nb < max_batches; ++nb) {
        __syncthreads();
        if (tid == 0) *slot = (int)__hip_atomic_fetch_add(head, 1u, __ATOMIC_RELAXED, __HIP_MEMORY_SCOPE_AGENT);
        __syncthreads();
        const int b = *slot;
        if (b >= 256) break;
        compress_batch(A, lds, b, true, tid);
    }
    __syncthreads();
}

struct Args { const GAS void* in[22]; GAS float* out; GAS unsigned char* ws; int ph_lo, ph_hi; };
constexpr int PH_PER_LAYER = 10, N_PHASES = 1 + NL * PH_PER_LAYER;
__global__ void __launch_bounds__(NWAVES * 64, 2) hymba_fwd(Args args) {
    extern __shared__ __attribute__((aligned(16))) unsigned char lds[];
    const int G = gridDim.x, bx = blockIdx.x, NGW = G * NWAVES;
    const int wave_s_ = __builtin_amdgcn_readfirstlane((int)threadIdx.x >> 6);
#define TID_NOW() (wave_s_ * 64 + (int)__builtin_amdgcn_mbcnt_hi(~0u, __builtin_amdgcn_mbcnt_lo(~0u, 0u)))
#define SUB_IDS int tid = TID_NOW(); asm volatile("" : "+v"(tid)); const int lane = tid & 63, wave = __builtin_amdgcn_readfirstlane(tid >> 6), gw = bx * NWAVES + wave; (void)lane; (void)gw; (void)wave;
#define PHASE_IDS int tid = TID_NOW(); asm volatile("" : "+v"(tid)); const int lane = tid & 63, wave = __builtin_amdgcn_readfirstlane(tid >> 6), gw = bx * NWAVES + wave; (void)lane; (void)gw; const __attribute__((address_space(4))) unsigned long long* ka_ = (const __attribute__((address_space(4))) unsigned long long*)__builtin_amdgcn_kernarg_segment_ptr(); asm volatile("" : "+s"(ka_)); GAS unsigned char* wsg_ = (GAS unsigned char*)ka_[23]; unsigned char* wsl = (unsigned char*)wsg_;
#define x_prompt ((const float*)(const GAS float*)ka_[0])
#define x_sample ((const float*)(const GAS float*)ka_[1])
#define cache_kv ((const float*)(const GAS float*)ka_[2])
#define page_table ((const int*)(const GAS int*)ka_[3])
#define state_win ((const float*)(const GAS float*)ka_[4])
#define state_gdn ((const float*)(const GAS float*)ka_[5])
#define state_conv ((const float*)(const GAS float*)ka_[6])
#define norm_mix ((const float*)(const GAS float*)ka_[7])
#define w_in ((const float*)(const GAS float*)ka_[8])
#define conv_w ((const float*)(const GAS float*)ka_[9])
#define a_log ((const float*)(const GAS float*)ka_[10])
#define dt_bias ((const float*)(const GAS float*)ka_[11])
#define gdn_norm ((const float*)(const GAS float*)ka_[12])
#define cmp_pe_k ((const float*)(const GAS float*)ka_[13])
#define cmp_w_k ((const float*)(const GAS float*)ka_[14])
#define cmp_pe_v ((const float*)(const GAS float*)ka_[15])
#define cmp_w_v ((const float*)(const GAS float*)ka_[16])
#define w_out ((const float*)(const GAS float*)ka_[17])
#define norm_mlp ((const float*)(const GAS float*)ka_[18])
#define w_up ((const float*)(const GAS float*)ka_[19])
#define w_down ((const float*)(const GAS float*)ka_[20])
#define norm_final ((const float*)(const GAS float*)ka_[21])
#define out ((float*)(GAS float*)ka_[22])
#define WIN_T ((bf16*)(wsl + WS_WIN))
#define WOUT_T ((bf16*)(wsl + WS_WOUT))
#define WUP_T ((bf16*)(wsl + WS_WUP))
#define WDN_T ((bf16*)(wsl + WS_WDN))
#define CMPW ((bf16*)(wsl + WS_CMPW))
#define HB ((bf16*)(wsl + WS_HB))
#define PROJ ((float*)(wsl + WS_PROJ))
#define X1 ((bf16*)(wsl + WS_X1 + (size_t)l * XL_BYTES))
#define X2 ((bf16*)(wsl + WS_X2 + (size_t)l * XL_BYTES))
#define X1P ((bf16*)(wsl + WS_X1 + (size_t)(l - 1) * XL_BYTES))
#define X2P ((bf16*)(wsl + WS_X2 + (size_t)(l - 1) * XL_BYTES))
#define MIX ((bf16*)(wsl + WS_MIX))
#define HID ((bf16*)(wsl + WS_HID))
#define QN ((float*)(wsl + WS_QN))
#define KN ((float*)(wsl + WS_KN))
#define VG ((float*)(wsl + WS_VG))
#define OG ((float*)(wsl + WS_OG))
#define GG ((float*)(wsl + WS_G))
#define BETA ((float*)(wsl + WS_BETA))
#define KQ ((float*)(wsl + WS_KQ))
#define QB ((bf16*)(wsl + WS_QB))
#define KS ((bf16*)(wsl + WS_KS))
#define VS ((bf16*)(wsl + WS_VS))
#define KW ((bf16*)(wsl + WS_KW))
#define VW ((bf16*)(wsl + WS_VW))
#define CKP ((float*)(wsl + WS_CKP))
#define CVP ((float*)(wsl + WS_CVP))
#define CKS ((float*)(wsl + WS_CKS))
#define CVS ((float*)(wsl + WS_CVS))
#define GK ((bf16*)(wsl + WS_GK))
#define GQ ((bf16*)(wsl + WS_GQ))
#define GKT ((bf16*)(wsl + WS_GKT))
#define GVT ((bf16*)(wsl + WS_GVT))
#define GG2 ((float*)(wsl + WS_GG2))
#define BETA2 ((float*)(wsl + WS_BETA2))
#define WX ((bf16*)(wsl + WS_WX))
#define QX ((bf16*)(wsl + WS_QX))
#define QKX ((bf16*)(wsl + WS_QKX))
#define KTX ((bf16*)(wsl + WS_KTX))
#define U0F ((float*)(wsl + WS_U0F))
#define GL ((float*)(wsl + WS_GL))
#define PARTD ((float*)(wsl + WS_PARTD))
#define SSQ ((float*)(wsl + WS_SS))
#define RSS(s) ((float*)(wsl + WS_RS) + (size_t)(s) * RS_STRIDE)
#define PARTG ((float*)(wsl + WS_PARTG))
    LAS unsigned char* ldsl = (LAS unsigned char*)lds;

    const int lo = args.ph_lo, hi = args.ph_hi;
    { const int t0_ = TID_NOW(); if (t0_ < 16) ((LAS unsigned*)(ldsl + MISC_OFF))[t0_] = 0u; }
    __syncthreads();
    XcdBarrier bar = xcd_barrier_post((unsigned*)((unsigned char*)args.ws + WS_CTL) + CW_BAR, (volatile LAS unsigned*)(ldsl + MISC_OFF), TID_NOW() == 0);
#define BOTH(k) (lo <= (k) && (k) + 1 < hi)
#define GRID_BAR(k) do { if (BOTH(k)) { for (int rb_ = 0; rb_ < REP_BAR; ++rb_) xcd_barrier(bar, TID_NOW() == 0); } } while (0)
#ifndef REP_PG
#define REP_PG 1
#endif
#ifndef REP_PA
#define REP_PA 1
#endif
#ifndef REP_BAR
#define REP_BAR 1
#endif
#ifndef REP_GSMP
#define REP_GSMP 1
#endif
#ifndef REP_P0
#define REP_P0 1
#endif
#ifndef REP_LIGHT
#define REP_LIGHT 1
#endif
#ifndef REP_PB_ROW
#define REP_PB_ROW 1
#endif
#ifndef REP_PB_PREP
#define REP_PB_PREP 1
#endif
#ifndef REP_PB_CMP
#define REP_PB_CMP 1
#endif
#ifndef REP_PB_COPY
#define REP_PB_COPY 1
#endif
#ifndef REP_PB2
#define REP_PB2 1
#endif
#ifndef REP_SCAN
#define REP_SCAN 1
#endif
#ifndef REP_ATTP
#define REP_ATTP 1
#endif
#ifndef REP_ATTS
#define REP_ATTS 1
#endif
#ifndef REP_GEMM
#define REP_GEMM 1
#endif
#define EN(i) (((PH_MASK_T) >> (i)) & 1u)
#define SUB(i) (((SUB_MASK_T) >> (i)) & 1u)
#define IN(k) (lo <= (k) && (k) < hi)

    if (IN(0)) { PHASE_IDS
        for (int rep0 = 0; rep0 < REP_P0; ++rep0) {
        LAS float* scr = (LAS float*)(ldsl + wave * 16384);
        constexpr int I_IN = 16 * 112, I_OUT = 16 * 32, I_UP = 16 * 128, I_DN = 64 * 32, I_C = 32 * 2, I_L = I_IN + I_OUT + I_UP + I_DN + 2 * I_C;
        for (int it = gw; it < NL * I_L; it += NGW) {
            const int l = it / I_L; int r = it % I_L;
            if (r < I_IN) { transpose_item(w_in + (size_t)l * DM * NPROJ, DM, NPROJ, NP, WIN_T + (size_t)l * NP * DM, scr, r, lane, l > 0 ? norm_mix + (size_t)l * DM : nullptr); continue; } r -= I_IN;
            if (r < I_OUT) { transpose_item(w_out + (size_t)l * DM * DM, DM, DM, DM, WOUT_T + (size_t)l * DM * DM, scr, r, lane); continue; } r -= I_OUT;
            if (r < I_UP) { transpose_item(w_up + (size_t)l * DM * DFF, DM, DFF, DFF, WUP_T + (size_t)l * DFF * DM, scr, r, lane, norm_mlp + (size_t)l * DM); continue; } r -= I_UP;
            if (r < I_DN) { transpose_item(w_down + (size_t)l * DFF * DM, DFF, DM, DM, WDN_T + (size_t)l * DM * DFF, scr, r, lane); continue; } r -= I_DN;
            if (r < I_C) { transpose_item(cmp_w_k + (size_t)l * 2048 * 64, 2048, 64, 64, CMPW + (size_t)((l * 2 + 0) * 64) * 2048, scr, r, lane); continue; } r -= I_C;
            transpose_item(cmp_w_v + (size_t)l * 2048 * 64, 2048, 64, 64, CMPW + (size_t)((l * 2 + 1) * 64) * 2048, scr, r, lane);
        }
        for (int m = gw; m < MT; m += NGW) { const float* xr = (m < MP) ? x_prompt + (size_t)m * DM : x_sample + (size_t)(m - MP) * DM; rms_row(xr, false, norm_mix, HB + (size_t)m * DM, nullptr, lane); }
        for (int m = bx * NWAVES * 64 + tid; m < MT; m += G * NWAVES * 64) RSS(0)[m < MP ? m : MP + (m - MP) * 32] = 1.f;
        }
    }

    GRID_BAR(0);
    for (int l = 0; l < NL; ++l) {
        const int pb = 1 + l * PH_PER_LAYER;
        if (IN(pb + 0)) { PHASE_IDS
            unsigned* gate = (unsigned*)(wsl + WS_CTL) + CW_GATE + 64 * (2 * l);
            if (l > 0) {
                if (wave == 0) { for (int m = bx * 64 + lane; m < MP; m += G * 64) rs_from_parts(SSQ, RSS(2 * l), m); }
                else for (int m = MP + bx * (NWAVES - 1) + wave - 1; m < MT; m += G * (NWAVES - 1))
                    resid_parts_row(X1P + (size_t)m * DM, true, PARTG + (size_t)(m - MP) * DM, PG_KS, (size_t)MS * DM, X2P + (size_t)m * DM, RSS(2 * l) + MP + (m - MP) * 32, lane);
                asm volatile("s_waitcnt vmcnt(0)" ::: "memory"); __syncthreads();
                if (TID_NOW() == 0) {
                    const unsigned nloc = bar.st[0], old = xb_add(gate + 1 + bar.x, 1u);
                    if (old + 1u == nloc) { __builtin_amdgcn_fence(__ATOMIC_RELEASE, "agent"); asm volatile("s_waitcnt vmcnt(0)" ::: "memory"); (void)xb_add(gate, nloc); } } }
            const unsigned gtarget = (l > 0) ? (unsigned)G : 0u;
            pg8::Gemm g{(l == 0) ? HB : X2P, WIN_T + (size_t)l * NP * DM, MT, NP, DM, DM}; pg8::StaticOrderG S; S.init(MT, NP, G, bx); S.f = gate; S.target = gtarget; S.pmw = MP / 256; S.ok = false;
            pg8::EpiF32 E{PROJ, NP, RSS(2 * l), MP, gate, gtarget, false};
            _Pragma("unroll 1") for (int rep = 0; rep < REP_PA; ++rep) pg8::gemm_phase<pg8::EpiF32, pg8::StaticOrderG, true, true>(ldsl, g, S, E, tid);
            if (l == 0 && bx >= (MT / 256) * (NP / 256) % G) { SUB_IDS CmpArgs CA{PROJ, cache_kv, page_table, cmp_pe_k, cmp_pe_v, CMPW, wsl, 0};
                compress_pull(CA, lds, (unsigned*)(wsl + WS_CTL) + CW_CMPQ, (volatile LAS int*)(ldsl + MISC_OFF + 36), 1, tid); }
        }
        GRID_BAR(pb + 0);
        if (IN(pb + 1)) { PHASE_IDS
            { SUB_IDS PBArgs A{PROJ, state_conv, conv_w, a_log, dt_bias, QN, KN, VG, GG, BETA, KQ, QB, KS, VS, KW, VW, out, l};
              for (int rep = 0; rep < REP_PB_ROW; ++rep) if (gw >= 128) for (int m = gw - 128; m < MT; m += 2 * (NGW - 128)) {
                  const int m2 = m + (NGW - 128); const bool has2 = m2 < MT; PBRegs r0, r1;
                  pb_row_load(A, m, lane, r0); pb_row_load(A, has2 ? m2 : m, lane, r1);
                  __builtin_amdgcn_sched_barrier(0);
                  pb_row(A, m, lane, r0); if (has2) pb_row(A, m2, lane, r1); }
              for (int u = gw; u < MS * 8; u += NGW) pb_sample_head(A, u, lane); }
            { SUB_IDS GPArgs A{PROJ, conv_w, a_log, dt_bias, GK, GQ, GKT, GVT, GG2, BETA2, l};
              for (int rep = 0; rep < REP_PB_PREP; ++rep) for (int u = gw; u < (MP / 8) * 8; u += 2 * NGW) {
                  GPRegs r0, r1; const int u2 = (u + NGW < (MP / 8) * 8) ? u + NGW : u; gdn_prep_load(A, u, lane, r0); gdn_prep_load(A, u2, lane, r1);
                  __builtin_amdgcn_sched_barrier(0);
                  gdn_prep_unit(A, u, lane, r0); gdn_prep_unit(A, u2, lane, r1); } }
            { SUB_IDS CmpArgs A{PROJ, cache_kv, page_table, cmp_pe_k, cmp_pe_v, CMPW, wsl, l};
              if (bx < 16) compress_batch(A, lds, bx, false, tid);
              compress_pull(A, lds, (unsigned*)(wsl + WS_CTL) + CW_CMPQ + 64 * l, (volatile LAS int*)(ldsl + MISC_OFF + 36), 1 << 20, tid); }
        }
        GRID_BAR(pb + 1);
        if (IN(pb + 2)) { PHASE_IDS
            GCArgs A{GK, GQ, GKT, GVT, GG2, BETA2, WX, QX, QKX, KTX, U0F, GL};
            for (int rep = 0; rep < REP_PB2; ++rep) for (int u = gw; u < 32 * 64; u += NGW) gdn_chunk_unit(A, lds + wave * GC_LDS_PER_WAVE, u, lane);
        }
        GRID_BAR(pb + 2);
        if (IN(pb + 3)) {
            { PHASE_IDS GdnArgs GA{QN, KN, VG, GG, BETA, KQ, OG, PROJ, state_gdn, gdn_norm, MIX, out, l};
                for (int rep = 0; rep < REP_GSMP; ++rep) for (int u = gw; u < NSB * 8; u += NGW) gdn_sample_unit(GA, u, lane); }
            { PHASE_IDS
                GS2Args SG{WX, QX, QKX, KTX, U0F, GL, OG, out, l};
                AttArgs AA{QB, KS, VS, KW, VW, CKP, CVP, PROJ, MIX};
                SAttArgs SA{QB, KS, VS, KW, VW, CKS, CVS, PROJ, cache_kv, page_table, state_win, MIX, l};
                unsigned* qhead = (unsigned*)(wsl + WS_CTL) + CW_QUEUE + 64 * l;
                volatile LAS int* slot = (volatile LAS int*)(ldsl + MISC_OFF + 32);
                for (;;) {
                    __syncthreads();
                    if (tid == 0) *slot = (int)__hip_atomic_fetch_add(qhead, 1u, __ATOMIC_RELAXED, __HIP_MEMORY_SCOPE_AGENT);
                    __syncthreads();
                    int u = *slot;
                    constexpr int XP = (REP_ATTP - 1) * 512, XS = (REP_ATTS - 1) * 256, XG = (REP_SCAN - 1) * 32;
                    if (u >= 800 + XP + XS + XG + 128) break;
                    if (u >= 32 && u < 928) { const int g_ = (u - 32) / 7, k_ = (u - 32) % 7;
                        u = (k_ < 4) ? 32 + 4 * g_ + k_ : (k_ < 6) ? 544 + 2 * g_ + (k_ - 4) : 800 + g_; }
                    if (u >= 800 + XP + XS + XG) {
                        const int sb = u - (800 + XP + XS + XG); const f32x4* src = (const f32x4*)(state_win + ((size_t)l * NSB + sb) * 512 * 256) + 256; f32x4* dst = (f32x4*)(out + O_WINS + ((size_t)l * NSB + sb) * 512 * 256);
                        for (int i = tid; i < 508 * 64; i += 8 * NWAVES * 64) { f32x4 v[8];
#pragma unroll
                            for (int k = 0; k < 8; ++k) { const int ii = i + k * NWAVES * 64; v[k] = src[ii < 508 * 64 ? ii : i]; }
#pragma unroll
                            for (int k = 0; k < 8; ++k) { const int ii = i + k * NWAVES * 64; if (ii < 508 * 64) dst[ii] = v[k]; } }
                        continue; }
                    if (u >= 800) { int v = u - 800; if (v < XP) u = 32 + (v & 511); else { v -= XP; if (v < XS) u = 544 + (v & 255); else u = (v - XS) & 31; } }
                    int tq = TID_NOW(); asm volatile("" : "+v"(tq));
                    if (u < 32) gdn_scan3_block(SG, lds, u, tq);
                    else if (u < 32 + 512) nsa_prompt_unit(AA, lds, u - 32, tq);
                    else nsa_sample_unit(SA, lds, u - 544, tq);
                }
            }
        }
        GRID_BAR(pb + 3);
        if (IN(pb + 4)) { PHASE_IDS
            const float gnl = gdn_norm[l * 64 + lane];
            for (int rep = 0; rep < REP_LIGHT; ++rep) for (int m = gw; m < MP; m += NGW) {
                float ov[8], zv[8];
#pragma unroll
                for (int h = 0; h < 8; ++h) { ov[h] = OG[(size_t)m * 512 + h * 64 + lane]; zv[h] = PROJ[(size_t)m * NP + C_Z + h * 64 + lane]; }
                __builtin_amdgcn_sched_barrier(0);
#pragma unroll
                for (int h = 0; h < 8; ++h) { const float ms = dpp_sum(ov[h] * ov[h]) * (1.f / 64.f);
                    MIX[(size_t)m * 1024 + h * 64 + lane] = (bf16)f2bf(ov[h] * (1.f / sqrtf(ms + 1e-6f)) * gnl * siluf_(zv[h])); } }
        }
        GRID_BAR(pb + 4);
        if (IN(pb + 5)) { PHASE_IDS
            { pg8::Gemm g{MIX, WOUT_T + (size_t)l * DM * DM, MP, DM, DM, DM}; pg8::StaticOrder S; S.init(MP, DM, G, bx);
              pg8::EpiResid E{(l == 0) ? (const void*)x_prompt : (const void*)X2P, l != 0, X1, DM, SSQ};
              pg8::gemm_phase<pg8::EpiResid, pg8::StaticOrder, true, true>(ldsl, g, S, E, tid); }
            { pg8::Gemm g{MIX, WOUT_T + (size_t)l * DM * DM, MT, DM, PD_KL, DM}; pg8::SplitKOrder S; S.init(MP / 256, MS / 256, DM / 256, PD_KS, PD_KL, G, bx);
              pg8::EpiPart E{PARTD, DM, MP, MS};
              pg8::gemm_phase<pg8::EpiPart, pg8::SplitKOrder, false, true>(ldsl, g, S, E, tid); }
        }
        GRID_BAR(pb + 5);
        if (IN(pb + 7)) { PHASE_IDS
            unsigned* gate = (unsigned*)(wsl + WS_CTL) + CW_GATE + 64 * (2 * l + 1);
            {
                if (wave == 0) { for (int m = bx * 64 + lane; m < MP; m += G * 64) rs_from_parts(SSQ, RSS(2 * l + 1), m); }
                else for (int m = MP + bx * (NWAVES - 1) + wave - 1; m < MT; m += G * (NWAVES - 1)) { const void* bs = (l == 0) ? (const void*)(x_sample + (size_t)(m - MP) * DM) : (const void*)(X2P + (size_t)m * DM);
                    resid_parts_row(bs, l != 0, PARTD + (size_t)(m - MP) * DM, PD_KS, (size_t)MS * DM, X1 + (size_t)m * DM, RSS(2 * l + 1) + MP + (m - MP) * 32, lane); }
                asm volatile("s_waitcnt vmcnt(0)" ::: "memory"); __syncthreads();
                if (TID_NOW() == 0) {
                    const unsigned nloc = bar.st[0], old = xb_add(gate + 1 + bar.x, 1u);
                    if (old + 1u == nloc) { __builtin_amdgcn_fence(__ATOMIC_RELEASE, "agent"); asm volatile("s_waitcnt vmcnt(0)" ::: "memory"); (void)xb_add(gate, nloc); } } }
            pg8::Gemm g{X1, WUP_T + (size_t)l * DFF * DM, MT, DFF, DM, DM}; pg8::StaticOrderG S; S.init(MT, DFF, G, bx); S.f = gate; S.target = (unsigned)G; S.pmw = MP / 256; S.ok = false;
            pg8::EpiRelu2 E{HID, DFF, RSS(2 * l + 1), MP, gate, (unsigned)G, false};
            pg8::gemm_phase<pg8::EpiRelu2, pg8::StaticOrderG, true, true>(ldsl, g, S, E, tid);
            if (l + 1 < NL && bx >= (MT / 256) * (DFF / 256) % G) { SUB_IDS CmpArgs CA{PROJ, cache_kv, page_table, cmp_pe_k, cmp_pe_v, CMPW, wsl, l + 1};
                compress_pull(CA, lds, (unsigned*)(wsl + WS_CTL) + CW_CMPQ + 64 * (l + 1), (volatile LAS int*)(ldsl + MISC_OFF + 36), 1, tid); }
        }
        GRID_BAR(pb + 7);
        if (IN(pb + 8)) { PHASE_IDS
            { pg8::Gemm g{HID, WDN_T + (size_t)l * DM * DFF, MP, DM, DFF, DFF}; pg8::StaticOrder S; S.init(MP, DM, G, bx);
              pg8::EpiResid E{(const void*)X1, true, X2, DM, SSQ};
              pg8::gemm_phase<pg8::EpiResid, pg8::StaticOrder, true, true>(ldsl, g, S, E, tid); }
            { pg8::Gemm g{HID, WDN_T + (size_t)l * DM * DFF, MT, DM, PG_KL, DFF}; pg8::SplitKOrder S; S.init(MP / 256, MS / 256, DM / 256, PG_KS, PG_KL, G, bx);
              pg8::EpiPart E{PARTG, DM, MP, MS};
              pg8::gemm_phase<pg8::EpiPart, pg8::SplitKOrder, false, true>(ldsl, g, S, E, tid); }
        }
        GRID_BAR(pb + 8);
        if (IN(pb + 9)) { PHASE_IDS
            const float* gn = (l + 1 < NL) ? norm_mix + (size_t)(l + 1) * DM : norm_final; const bool fin = !(l + 1 < NL);
            if (fin) {
            for (int m = gw; m < MP; m += 2 * NGW) { const int m2 = m + NGW;
                if (m2 < MP) rms_row2(X2 + (size_t)m * DM, X2 + (size_t)m2 * DM, true, gn, fin ? nullptr : HB + (size_t)m * DM, fin ? nullptr : HB + (size_t)m2 * DM, fin ? out + O_YP + (size_t)m * DM : nullptr, fin ? out + O_YP + (size_t)m2 * DM : nullptr, lane);
                else rms_row(X2 + (size_t)m * DM, true, gn, fin ? nullptr : HB + (size_t)m * DM, fin ? out + O_YP + (size_t)m * DM : nullptr, lane); }
            for (int m = MP + gw; m < MT; m += NGW)
                rms_row_parts(X1 + (size_t)m * DM, true, PARTG + (size_t)(m - MP) * DM, PG_KS, (size_t)MS * DM, X2 + (size_t)m * DM, gn, fin ? nullptr : HB + (size_t)m * DM, fin ? out + O_YP + (size_t)m * DM : nullptr, lane);
            }
        }
        if (l + 1 == NL) GRID_BAR(pb + 9);
    }
#undef IN
}

#undef x_prompt
#undef x_sample
#undef cache_kv
#undef page_table
#undef state_win
#undef state_gdn
#undef state_conv
#undef norm_mix
#undef w_in
#undef conv_w
#undef a_log
#undef dt_bias
#undef gdn_norm
#undef cmp_pe_k
#undef cmp_w_k
#undef cmp_pe_v
#undef cmp_w_v
#undef w_out
#undef norm_mlp
#undef w_up
#undef w_down
#undef norm_final
#undef out
#ifndef MK_PER_PHASE
#define MK_PER_PHASE 0
#endif
typedef void (*kfn_t)(Args); static const kfn_t K_ALL = hymba_fwd;
extern "C" void kernel_launch(void* const* d_in, const int* in_sizes, int n_in, void* d_out, int out_size, void* d_ws, size_t ws_size, hipStream_t stream) {
    static int grid = 0;
    if (grid == 0) {
        if (n_in != 22 || out_size != (int)O_END || ws_size < WS_END) { fprintf(stderr, "kernel_launch: unexpected shapes (n_in %d, out %d, ws %zu)\n", n_in, out_size, ws_size); grid = -1; return; }
        int dev = 0, cus = 0, per_cu = 0;
        if (hipGetDevice(&dev) != hipSuccess || hipDeviceGetAttribute(&cus, hipDeviceAttributeMultiprocessorCount, dev) != hipSuccess) { grid = -1; return; }
        if (hipFuncSetAttribute((const void*)K_ALL, hipFuncAttributeMaxDynamicSharedMemorySize, LDS_BYTES) != hipSuccess) { fprintf(stderr, "kernel_launch: hipFuncSetAttribute failed\n"); grid = -1; return; }
        if (hipOccupancyMaxActiveBlocksPerMultiprocessor(&per_cu, (const void*)K_ALL, NWAVES * 64, LDS_BYTES) != hipSuccess || per_cu < 1) { fprintf(stderr, "kernel_launch: occupancy query says %d blocks per CU\n", per_cu); }
        (void)hipGetLastError();
        grid = cus;
    }
    if (grid < 0) return;
    (void)hipMemsetAsync((char*)d_ws + WS_CTL, 0, CTL_ZERO_BYTES, stream);
    Args a{};
    for (int i = 0; i < 22; ++i) a.in[i] = (const GAS void*)d_in[i];
    a.out = (GAS float*)d_out; a.ws = (GAS unsigned char*)d_ws;
    const dim3 g(grid), b(NWAVES * 64);
#if MK_PER_PHASE
    for (int ph = 0; ph < N_PHASES; ++ph) { a.ph_lo = ph; a.ph_hi = ph + 1; K_ALL<<<g, b, LDS_BYTES, stream>>>(a); }
#else
    a.ph_lo = 0; a.ph_hi = N_PHASES; K_ALL<<<g, b, LDS_BYTES, stream>>>(a);
#endif
}
```

```cpp
#include <hip/hip_runtime.h>
#include <cstdio>
#include <cstdint>
namespace pg8 {
#define PG8_LAS __attribute__((address_space(3)))
typedef unsigned short bf16_t;
typedef short bf16x8 __attribute__((ext_vector_type(8)));
typedef float f32x4 __attribute__((ext_vector_type(4)));
typedef unsigned u32x4 __attribute__((ext_vector_type(4)));
constexpr int BM = 256, BK = 64, HALF = 128, HTB = HALF * BK * 2  , STAGE_BYTES = 8 * HTB, NXCD = 8, WGM = 8;

__host__ __device__ __forceinline__ int lds_byte(int r, int c) { const int st = (r >> 4) * 2 + (c >> 5), rr = r & 15, cc = c & 31, ob = rr * 64 + cc * 2; return st * 1024 + (ob ^ (((ob >> 9) & 1) << 5)); }
__host__ __device__ __forceinline__ void stage_rc(int b, int& R, int& C) { const int st = b / 1024, sb = b % 1024, swz = sb ^ (((sb >> 9) & 1) << 5); R = (st >> 1) * 16 + swz / 64; C = (st & 1) * 32 + (swz % 64) / 2; }
__host__ __device__ __forceinline__ int perm32(int rho) { const int n = rho >> 4, i = rho & 15; return 8 * (i >> 2) + 4 * n + (i & 3); }

struct Unit { int pm, pn, kofs, kc; };
struct Gemm { const bf16_t* A; const bf16_t* Bt; int M, N, K, ld; };

struct StaticOrder {
    int nM, nN, nwg, G, c;
    __host__ __device__ void init(int M, int N, int G_, int c_) { nM = M / BM; nN = N / BM; nwg = nM * nN; G = G_; c = c_; }
    __host__ __device__ bool next(int i, Unit& u) const {
        const long L = (long)i * G + c; if (L >= nwg) return false;
        int wgid = (int)L; { const int q = nwg / NXCD, r = nwg % NXCD, xcd = wgid % NXCD, off = wgid / NXCD; wgid = (xcd < r ? xcd * (q + 1) : r * (q + 1) + (xcd - r) * q) + off; }
        const int nig = WGM * nN, gid = wgid / nig, fm = gid * WGM, gsz = (nM - fm) < WGM ? (nM - fm) : WGM;
        u.pm = fm + ((wgid % nig) % gsz); u.pn = (wgid % nig) / gsz; u.kofs = 0; u.kc = 0; return true;
    }
    __device__ __forceinline__ void a_ready(const Unit&) const {}
    __device__ __forceinline__ void done(const Unit&) const {}
};

__device__ __forceinline__ void flag_spin(const unsigned* f, unsigned target) {
    unsigned sp = 0;
    while (__hip_atomic_load(f, __ATOMIC_RELAXED, __HIP_MEMORY_SCOPE_AGENT) < target) { __builtin_amdgcn_s_sleep(1); if (++sp > (1u << 21)) break; }
    asm volatile("" ::: "memory"); __builtin_amdgcn_sched_barrier(0);
}
__device__ __forceinline__ void flag_wait(const unsigned* f, unsigned target) {
    flag_spin(f, target);
    __builtin_amdgcn_fence(__ATOMIC_ACQUIRE, "agent");
    asm volatile("s_waitcnt vmcnt(0)" ::: "memory");
}
__device__ __forceinline__ float ld_agent(const float* p) { return __builtin_bit_cast(float, __hip_atomic_load((const unsigned*)p, __ATOMIC_RELAXED, __HIP_MEMORY_SCOPE_AGENT)); }
struct StaticOrderG : StaticOrder {
    const unsigned* f; unsigned target; int pmw; mutable bool ok;
    __device__ __forceinline__ void a_ready(const Unit& u) const { if (u.pm >= pmw && !ok) { flag_spin(f, target); ok = true; } }
};

__device__ __forceinline__ unsigned cvt_pk_bf16(float lo, float hi) { unsigned r; asm volatile("v_cvt_pk_bf16_f32 %0, %1, %2" : "=v"(r) : "v"(lo), "v"(hi)); return r; }

struct EpiF32 {
    static constexpr bool PERM = false, AFTER_DRAIN = false;
    float* O; int ldc; const float* RS; int rsplit; const unsigned* f; unsigned target; mutable bool ok;
    __device__ __forceinline__ void operator()(const f32x4 (&acc)[2][2][4][2], const Unit& u, int wr, int wc, int fr, int fq) const {
        const int row0 = u.pm * BM + wr * 64 + fr, col0 = u.pn * BM + wc * 32 + 4 * fq;
        if (!ok) { flag_spin(f, target); ok = true; }
        float rs[2][4];
#pragma unroll
        for (int ai = 0; ai < 2; ++ai)
#pragma unroll
            for (int m = 0; m < 4; ++m) { const int r_ = row0 + ai * HALF + m * 16; rs[ai][m] = ld_agent(RS + (r_ < rsplit ? r_ : rsplit + (r_ - rsplit) * 32)); }
#pragma unroll
        for (int ai = 0; ai < 2; ++ai)
#pragma unroll
            for (int m = 0; m < 4; ++m) { float* rowp = O + (size_t)(row0 + ai * HALF + m * 16) * ldc + col0;
#pragma unroll
                for (int bj = 0; bj < 2; ++bj)
#pragma unroll
                    for (int n = 0; n < 2; ++n) *(f32x4*)(rowp + bj * HALF + n * 16) = acc[ai][bj][m][n] * rs[ai][m]; }
    }
};
struct EpiResid {
    static constexpr bool PERM = false, AFTER_DRAIN = false;
    const void* base; bool base_bf; bf16_t* O; int ldc; float* SS;
    __device__ __forceinline__ void operator()(const f32x4 (&acc)[2][2][4][2], const Unit& u, int wr, int wc, int fr, int fq) const {
        const int row0 = u.pm * BM + wr * 64 + fr, col0 = u.pn * BM + wc * 32 + 4 * fq;
        typedef unsigned u32x2_ __attribute__((ext_vector_type(2)));
#pragma unroll
        for (int ai = 0; ai < 2; ++ai)
#pragma unroll
            for (int m = 0; m < 4; ++m) { const size_t off = (size_t)(row0 + ai * HALF + m * 16) * ldc + col0; float sq = 0.f;
#pragma unroll
                for (int bj = 0; bj < 2; ++bj)
#pragma unroll
                    for (int n = 0; n < 2; ++n) { const size_t o2 = off + bj * HALF + n * 16; f32x4 r;
                        if (base_bf) { const u32x2_ w = *(const u32x2_*)((const bf16_t*)base + o2);
                            r = (f32x4){__builtin_bit_cast(float, w.x << 16), __builtin_bit_cast(float, w.x & 0xffff0000u), __builtin_bit_cast(float, w.y << 16), __builtin_bit_cast(float, w.y & 0xffff0000u)}; }
                        else r = *(const f32x4*)((const float*)base + o2);
                        r += acc[ai][bj][m][n];
                        u32x2_ ow; ow.x = cvt_pk_bf16(r[0], r[1]); ow.y = cvt_pk_bf16(r[2], r[3]); *(u32x2_*)(O + o2) = ow;
                        const float q0 = __builtin_bit_cast(float, ow.x << 16), q1 = __builtin_bit_cast(float, ow.x & 0xffff0000u), q2 = __builtin_bit_cast(float, ow.y << 16), q3 = __builtin_bit_cast(float, ow.y & 0xffff0000u);
                        sq += (q0 * q0 + q1 * q1) + (q2 * q2 + q3 * q3); }
                sq += __shfl_xor(sq, 16); sq += __shfl_xor(sq, 32);
                if (fq == 0) SS[(size_t)(row0 + ai * HALF + m * 16) * 16 + u.pn * 4 + wc] = sq; }
    }
};
struct EpiRelu2 {
    static constexpr bool PERM = true, AFTER_DRAIN = false;
    bf16_t* O; int ldc; const float* RS; int rsplit; const unsigned* f; unsigned target; mutable bool ok;
    __device__ __forceinline__ void operator()(const f32x4 (&acc)[2][2][4][2], const Unit& u, int wr, int wc, int fr, int fq) const {
        const int row0 = u.pm * BM + wr * 64 + fr, col0 = u.pn * BM + wc * 32 + 8 * fq;
        if (!ok) { flag_spin(f, target); ok = true; }
        float rs[2][4];
#pragma unroll
        for (int ai = 0; ai < 2; ++ai)
#pragma unroll
            for (int m = 0; m < 4; ++m) { const int r_ = row0 + ai * HALF + m * 16; rs[ai][m] = ld_agent(RS + (r_ < rsplit ? r_ : rsplit + (r_ - rsplit) * 32)); }
#pragma unroll
        for (int ai = 0; ai < 2; ++ai)
#pragma unroll
            for (int m = 0; m < 4; ++m) { bf16_t* rowp = O + (size_t)(row0 + ai * HALF + m * 16) * ldc + col0;
#pragma unroll
                for (int bj = 0; bj < 2; ++bj) { f32x4 v0 = acc[ai][bj][m][0] * rs[ai][m], v1 = acc[ai][bj][m][1] * rs[ai][m];
#pragma unroll
                    for (int i = 0; i < 4; ++i) { const float a = v0[i] > 0.f ? v0[i] : 0.f, b = v1[i] > 0.f ? v1[i] : 0.f; v0[i] = a * a; v1[i] = b * b; }
                    u32x4 w; w.x = cvt_pk_bf16(v0[0], v0[1]); w.y = cvt_pk_bf16(v0[2], v0[3]); w.z = cvt_pk_bf16(v1[0], v1[1]); w.w = cvt_pk_bf16(v1[2], v1[3]);
                    *(u32x4*)(rowp + bj * HALF) = w; } }
    }
};

struct SplitKOrder {
    int pm0, nN, KS, KL, total, G, c;
    __host__ __device__ void init(int pm0_, int nPm, int nN_, int KS_, int KL_, int G_, int c_) { pm0 = pm0_; nN = nN_; KS = KS_; KL = KL_; total = nPm * nN_ * KS_; G = G_; c = c_; }
    __host__ __device__ bool next(int i, Unit& u) const {
        const long L = (long)i * G + c; if (L >= total) return false;
        const int l = (int)L, kc = l % KS, rest = l / KS; u.pn = rest % nN; u.pm = pm0 + rest / nN; u.kofs = kc * KL; u.kc = kc; return true; }
    __device__ __forceinline__ void a_ready(const Unit&) const {}
    __device__ __forceinline__ void done(const Unit&) const {}
};
struct EpiPart {
    static constexpr bool PERM = false, AFTER_DRAIN = false;
    float* P; int ldc; int row0; int rows;
    __device__ __forceinline__ void operator()(const f32x4 (&acc)[2][2][4][2], const Unit& u, int wr, int wc, int fr, int fq) const {
        const int rowl = u.pm * BM - row0 + wr * 64 + fr, col0 = u.pn * BM + wc * 32 + 4 * fq;
        float* base = P + (size_t)u.kc * rows * ldc;
#pragma unroll
        for (int ai = 0; ai < 2; ++ai)
#pragma unroll
            for (int m = 0; m < 4; ++m) { float* rowp = base + (size_t)(rowl + ai * HALF + m * 16) * ldc + col0;
#pragma unroll
                for (int bj = 0; bj < 2; ++bj)
#pragma unroll
                    for (int n = 0; n < 2; ++n) *(f32x4*)(rowp + bj * HALF + n * 16) = acc[ai][bj][m][n]; }
    }
};
template <class Epi, class Sched, bool ALIGN_EPI = false, bool SP2 = false>
__device__ __forceinline__ void gemm_phase(PG8_LAS unsigned char* lds, const Gemm g, const Sched& S, const Epi& E, int tid_in) {
    int tid = tid_in; asm volatile("" : "+v"(tid));
    const int wid = __builtin_amdgcn_readfirstlane(tid >> 6), lane = tid & 63, wr = wid >> 2, wc = wid & 3, fr = lane & 15, fq = lane >> 4;
    const int K = g.ld, nt = g.K / BK;
    unsigned voffA[2], voffB[2];
#pragma unroll
    for (int i = 0; i < 2; ++i) { int R, C; stage_rc(tid * 16 + i * 8192, R, C); const int Rb = Epi::PERM ? ((R & ~31) + perm32(R & 31)) : R;
        voffA[i] = (unsigned)(R * K + C) * 2u; voffB[i] = (unsigned)(Rb * K + C) * 2u; }
    const size_t kstep = (size_t)(BK * 2);
    const size_t hstep = (size_t)HALF * K * 2;
    const size_t tstep = 2 * hstep;
    const unsigned ldsw = (unsigned)wid * 1024u;
    const int aoff = lds_byte(wr * 64 + fr, fq * 8), boff = lds_byte(wc * 32 + fr, fq * 8);
#define PG8_SA(b, h) (((b) * 2 + (h)) * HTB)
#define PG8_SB(b, h) ((4 + (b) * 2 + (h)) * HTB)
#define PG8_STAGE(bufoff, gbase, voff) do { _Pragma("unroll") for (int _i = 0; _i < 2; ++_i) \
        __builtin_amdgcn_global_load_lds((const unsigned*)((const char*)(gbase) + (voff)[_i]), (PG8_LAS unsigned*)(lds + (bufoff) + ldsw + _i * 8192), 16, 0, 0); } while (0)
#define PG8_LDA(dst, b, h) do { _Pragma("unroll") for (int m = 0; m < 4; ++m) _Pragma("unroll") for (int k = 0; k < 2; ++k) dst[m][k] = *(const PG8_LAS bf16x8*)(lds + PG8_SA(b, h) + aoff + m * 2048 + k * 1024); } while (0)
#define PG8_LDB(dst, b, h) do { _Pragma("unroll") for (int n = 0; n < 2; ++n) _Pragma("unroll") for (int k = 0; k < 2; ++k) dst[n][k] = *(const PG8_LAS bf16x8*)(lds + PG8_SB(b, h) + boff + n * 2048 + k * 1024); } while (0)
#define PG8_MMA(ai, bj, At, Bt) do { __builtin_amdgcn_s_setprio(1); _Pragma("unroll") for (int m = 0; m < 4; ++m) _Pragma("unroll") for (int n = 0; n < 2; ++n) _Pragma("unroll") for (int k = 0; k < 2; ++k) \
        acc[ai][bj][m][n] = __builtin_amdgcn_mfma_f32_16x16x32_bf16(Bt[n][k], At[m][k], acc[ai][bj][m][n], 0, 0, 0); __builtin_amdgcn_s_setprio(0); } while (0)
#define PG8_WAIT_V(n) asm volatile("s_waitcnt vmcnt(" #n ")" ::: "memory")
#define PG8_WAIT_L(n) asm volatile("s_waitcnt lgkmcnt(" #n ")" ::: "memory")
#define PG8_BAR __builtin_amdgcn_s_barrier()
#define PG8_SCHED __builtin_amdgcn_sched_barrier(0)
    Unit cur, nxt; int ui = 0;
    if (!S.next(0, cur)) return;
    f32x4 acc[2][2][4][2];
#pragma unroll
    for (int a = 0; a < 2; ++a)
#pragma unroll
        for (int b = 0; b < 2; ++b)
#pragma unroll
            for (int m = 0; m < 4; ++m)
#pragma unroll
                for (int n = 0; n < 2; ++n) acc[a][b][m][n] = (f32x4){0.f, 0.f, 0.f, 0.f};
    bf16x8 At[4][2], B0[2][2], B1[2][2];
    const char* cA = (const char*)g.A + (size_t)cur.pm * tstep + (size_t)cur.kofs * 2; const char* cB = (const char*)g.Bt + (size_t)cur.pn * tstep + (size_t)cur.kofs * 2;
    S.a_ready(cur);
    if constexpr (SP2) {
        PG8_STAGE(PG8_SB(0, 0), cB, voffB); PG8_STAGE(PG8_SB(0, 1), cB + hstep, voffB); PG8_STAGE(PG8_SA(0, 0), cA, voffA); PG8_STAGE(PG8_SA(0, 1), cA + hstep, voffA);
        if (wr == 1) PG8_BAR;
        PG8_WAIT_V(2); PG8_BAR;
        PG8_STAGE(PG8_SB(1, 0), cB + kstep, voffB); PG8_STAGE(PG8_SA(1, 0), cA + kstep, voffA); PG8_STAGE(PG8_SB(1, 1), cB + hstep + kstep, voffB);
        PG8_WAIT_V(6); PG8_BAR;
    } else {
        PG8_STAGE(PG8_SB(0, 0), cB, voffB); PG8_STAGE(PG8_SA(0, 0), cA, voffA); PG8_STAGE(PG8_SB(0, 1), cB + hstep, voffB); PG8_STAGE(PG8_SA(0, 1), cA + hstep, voffA);
        if (wr == 1) PG8_BAR;
        PG8_WAIT_V(4); PG8_BAR;
        PG8_STAGE(PG8_SB(1, 0), cB + kstep, voffB); PG8_STAGE(PG8_SA(1, 0), cA + kstep, voffA); PG8_STAGE(PG8_SB(1, 1), cB + hstep + kstep, voffB);
        PG8_WAIT_V(6); PG8_BAR;
    }
    for (;;) {
        const bool has_next = S.next(ui + 1, nxt);
        const char* nA = has_next ? (const char*)g.A + (size_t)nxt.pm * tstep + (size_t)nxt.kofs * 2 : cA; const char* nB = has_next ? (const char*)g.Bt + (size_t)nxt.pn * tstep + (size_t)nxt.kofs * 2 : cB;
        for (int t = 0; t < nt; t += 2) {
            const bool last = (t == nt - 2);
            const char* a1 = cA + (size_t)(t + 1) * kstep;
            const char* a2 = last ? nA : cA + (size_t)(t + 2) * kstep; const char* b2 = last ? nB : cB + (size_t)(t + 2) * kstep;
            const char* a3 = a2 + kstep; const char* b3 = b2 + kstep;
            if (last && has_next) S.a_ready(nxt);
            if constexpr (SP2) {
            PG8_LDB(B0, 0, 0); PG8_LDB(B1, 0, 1); PG8_SCHED; PG8_LDA(At, 0, 0); PG8_STAGE(PG8_SA(1, 1), a1 + hstep, voffA);
            PG8_WAIT_V(8); PG8_WAIT_L(0); PG8_BAR; PG8_MMA(0, 0, At, B0); PG8_MMA(0, 1, At, B1); PG8_BAR; PG8_SCHED;
            PG8_LDA(At, 0, 1); PG8_STAGE(PG8_SB(0, 0), b2, voffB); PG8_STAGE(PG8_SB(0, 1), b2 + hstep, voffB); PG8_STAGE(PG8_SA(0, 0), a2, voffA);
            PG8_WAIT_V(8); PG8_WAIT_L(0); PG8_BAR; PG8_MMA(1, 0, At, B0); PG8_MMA(1, 1, At, B1); PG8_BAR; PG8_SCHED;
            PG8_LDB(B0, 1, 0); PG8_LDB(B1, 1, 1); PG8_SCHED; PG8_LDA(At, 1, 0); PG8_STAGE(PG8_SA(0, 1), a2 + hstep, voffA);
            PG8_WAIT_V(8); PG8_WAIT_L(0); PG8_BAR; PG8_MMA(0, 0, At, B0); PG8_MMA(0, 1, At, B1); PG8_BAR; PG8_SCHED;
            PG8_LDA(At, 1, 1); PG8_STAGE(PG8_SB(1, 0), b3, voffB); PG8_STAGE(PG8_SB(1, 1), b3 + hstep, voffB); PG8_STAGE(PG8_SA(1, 0), a3, voffA);
            PG8_WAIT_V(8); PG8_WAIT_L(0); PG8_BAR; PG8_MMA(1, 0, At, B0); PG8_MMA(1, 1, At, B1); PG8_BAR; PG8_SCHED;
            } else {
            PG8_LDB(B0, 0, 0); PG8_SCHED; PG8_LDA(At, 0, 0); PG8_STAGE(PG8_SA(1, 1), a1 + hstep, voffA);
            PG8_WAIT_L(8); PG8_BAR; PG8_WAIT_L(0); PG8_MMA(0, 0, At, B0); PG8_BAR; PG8_SCHED;
            PG8_LDB(B1, 0, 1); PG8_STAGE(PG8_SB(0, 0), b2, voffB);
            PG8_BAR; PG8_WAIT_L(0); PG8_MMA(0, 1, At, B1); PG8_BAR;
            PG8_LDA(At, 0, 1); PG8_STAGE(PG8_SA(0, 0), a2, voffA);
            PG8_BAR; PG8_WAIT_L(0); PG8_MMA(1, 0, At, B0); PG8_BAR; PG8_SCHED;
            PG8_STAGE(PG8_SB(0, 1), b2 + hstep, voffB);
            PG8_WAIT_V(6); PG8_BAR; PG8_MMA(1, 1, At, B1); PG8_BAR;
            PG8_LDB(B0, 1, 0); PG8_SCHED; PG8_LDA(At, 1, 0); PG8_STAGE(PG8_SA(0, 1), a2 + hstep, voffA);
            PG8_WAIT_L(8); PG8_BAR; PG8_WAIT_L(0); PG8_MMA(0, 0, At, B0); PG8_BAR; PG8_SCHED;
            PG8_LDB(B1, 1, 1); PG8_STAGE(PG8_SB(1, 0), b3, voffB);
            PG8_BAR; PG8_WAIT_L(0); PG8_MMA(0, 1, At, B1); PG8_BAR;
            PG8_LDA(At, 1, 1); PG8_STAGE(PG8_SA(1, 0), a3, voffA);
            PG8_BAR; PG8_WAIT_L(0); PG8_MMA(1, 0, At, B0); PG8_BAR; PG8_SCHED;
            PG8_STAGE(PG8_SB(1, 1), b3 + hstep, voffB);
            PG8_WAIT_V(6); PG8_BAR; PG8_MMA(1, 1, At, B1); PG8_BAR;
            }
        }
        if constexpr (ALIGN_EPI) { if (wr == 0) PG8_BAR; }
        if constexpr (!Epi::AFTER_DRAIN) { E(acc, cur, wr, wc, fr, fq); S.done(cur); }
        if (!has_next) break;
#pragma unroll
        for (int a = 0; a < 2; ++a)
#pragma unroll
            for (int b = 0; b < 2; ++b)
#pragma unroll
                for (int m = 0; m < 4; ++m)
#pragma unroll
                    for (int n = 0; n < 2; ++n) acc[a][b][m][n] = (f32x4){0.f, 0.f, 0.f, 0.f};
        cur = nxt; cA = nA; cB = nB; ++ui;
        if constexpr (ALIGN_EPI) { if (wr == 1) PG8_BAR; }
    }
    PG8_WAIT_V(0);
    if constexpr (!ALIGN_EPI) { if (wr == 0) PG8_BAR; }
    PG8_BAR;
    if constexpr (Epi::AFTER_DRAIN) { E.fused(acc, cur, wr, wc, fr, fq, lds, wid, lane); S.done(cur); }
#undef PG8_SA
#undef PG8_SB
#undef PG8_STAGE
#undef PG8_LDA
#undef PG8_LDB
#undef PG8_MMA
#undef PG8_WAIT_V
#undef PG8_WAIT_L
#undef PG8_BAR
#undef PG8_SCHED
}
}

constexpr int DM = 1024, NPB = 4, SEQ = 4096, MP = NPB * SEQ, NSB = 128, DSEQ = 4, MS = NSB * DSEQ, MT = MP + MS;
constexpr int NPROJ = 3368, NP = 3584, DFF = 4096, NL = 2;
constexpr int C_QKV = 0, C_Z = 1536, C_A = 2048, C_BETA = 2056, C_Q = 2064, C_KV = 2576, C_GATE = 3344;
constexpr int PAST = 2048, NPAGES = 16, NPOOL = 2560;
constexpr float C2 = 0.125f * 1.4426950408889634f;
constexpr float NEG_INF = -__builtin_inff();
constexpr size_t O_YP = 0, O_YS = 16777216, O_KVP = 17301504, O_KVS = 34078720, O_WINP = 34603008, O_WINS = 35651584, O_GDNP = 69206016, O_GDNS = 69468160, O_CONVP = 77856768, O_CONVS = 77893632, O_END = 79073280;
constexpr size_t MiB = 1u << 20;
constexpr size_t WS_CTL = 0, CTL_ZERO_BYTES = 1 * MiB;
constexpr size_t WS_WIN = 2 * MiB, WS_WOUT = 16 * MiB, WS_WUP = 20 * MiB, WS_WDN = 36 * MiB, WS_CMPW = 52 * MiB;
constexpr size_t WS_HB = 54 * MiB, WS_PROJ = 88 * MiB, WS_X1 = 320 * MiB, WS_X2 = 386 * MiB, WS_MIX = 452 * MiB, WS_HID = 486 * MiB;
constexpr size_t WS_QN = 618 * MiB, WS_KN = 651 * MiB, WS_VG = 684 * MiB, WS_OG = 717 * MiB, WS_G = 750 * MiB, WS_BETA = 751 * MiB, WS_KQ = 752 * MiB;
constexpr size_t WS_QB = 753 * MiB, WS_KS = 770 * MiB, WS_VS = 775 * MiB, WS_KW = 780 * MiB, WS_VW = 785 * MiB;
constexpr size_t WS_CKP = 790 * MiB, WS_CVP = 791 * MiB, WS_CKS = 792 * MiB, WS_CVS = 796 * MiB;
constexpr size_t WS_GK = 800 * MiB, WS_GQ = 816 * MiB, WS_GKT = 832 * MiB, WS_GVT = 848 * MiB, WS_GG2 = 864 * MiB, WS_BETA2 = 865 * MiB;
constexpr size_t WS_WX = 866 * MiB, WS_QX = 882 * MiB, WS_QKX = 898 * MiB, WS_KTX = 914 * MiB, WS_U0F = 930 * MiB, WS_GL = 962 * MiB, WS_END = 1043 * MiB;
constexpr size_t WS_PARTD = 963 * MiB, WS_PARTG = 979 * MiB;
constexpr size_t WS_OG2 = 1000 * MiB;
constexpr size_t WS_SS = 996 * MiB, WS_RS = 998 * MiB;
constexpr int PD_KS = 4, PD_KL = DM / PD_KS, PG_KS = 8, PG_KL = DFF / PG_KS;
constexpr int CW_QUEUE = 64;
constexpr int CW_BAR = 4096;
constexpr size_t XL_BYTES = (size_t)MT * DM * 2;
constexpr int RS_STRIDE = MP + MS * 32;
constexpr int CW_SCAN = 768;
constexpr int CW_GATE = 512;
constexpr int RING_BYTES = 131072, LDS_BYTES = 147456, MISC_OFF = LDS_BYTES - 64;
constexpr int NWAVES = 8;

#define GAS __attribute__((address_space(1)))
#define LAS __attribute__((address_space(3)))
typedef unsigned short bf16;
typedef unsigned v4u __attribute__((ext_vector_type(4)));
typedef unsigned v2u __attribute__((ext_vector_type(2)));
typedef float f32x4 __attribute__((ext_vector_type(4)));
typedef float f32x16 __attribute__((ext_vector_type(16)));
typedef short bf16x8 __attribute__((ext_vector_type(8)));
typedef short s16x4 __attribute__((ext_vector_type(4)));
#define LDS_WAIT() asm volatile("s_waitcnt lgkmcnt(0)" ::: "memory")
__device__ __forceinline__ unsigned f2bf(float f) { unsigned u = __builtin_bit_cast(unsigned, f); return (u + 0x7fffu + ((u >> 16) & 1u)) >> 16; }
typedef float f32x2_t_ __attribute__((ext_vector_type(2))); typedef __bf16 bf16x2_t_ __attribute__((ext_vector_type(2)));
__device__ __forceinline__ unsigned pk2(float lo, float hi) { const f32x2_t_ v = {lo, hi}; const bf16x2_t_ b = __builtin_convertvector(v, bf16x2_t_); return __builtin_bit_cast(unsigned, b); }
__device__ __forceinline__ float bf2f(unsigned short b) { return __builtin_bit_cast(float, (unsigned)b << 16); }
__device__ __forceinline__ bf16x8 pack8(float a0, float a1, float a2, float a3, float a4, float a5, float a6, float a7) {
    v4u w; w.x = pk2(a0, a1); w.y = pk2(a2, a3); w.z = pk2(a4, a5); w.w = pk2(a6, a7); return __builtin_bit_cast(bf16x8, w); }
__device__ __forceinline__ float wave_sum(float v) {
#pragma unroll
    for (int o = 1; o < 64; o <<= 1) v += __shfl_xor(v, o);
    return v;
}
template <int CTRL, int RMASK> __device__ __forceinline__ float dpp_add(float v) {
    const int t = __builtin_amdgcn_update_dpp(0, __builtin_bit_cast(int, v), CTRL, RMASK, 0xf, false);
    return v + __builtin_bit_cast(float, t);
}
__device__ __forceinline__ float dpp_sum(float v) {
    v = dpp_add<0x111, 0xf>(v); v = dpp_add<0x112, 0xf>(v); v = dpp_add<0x114, 0xf>(v); v = dpp_add<0x118, 0xf>(v);
    v = dpp_add<0x142, 0xa>(v); v = dpp_add<0x143, 0xc>(v);
    return __builtin_bit_cast(float, __builtin_amdgcn_readlane(__builtin_bit_cast(int, v), 63));
}
__device__ __forceinline__ float ex2(float x) { return __builtin_amdgcn_exp2f(x); }
__device__ __forceinline__ float sigmoidf_(float x) { return 1.f / (1.f + __expf(-x)); }
__device__ __forceinline__ float siluf_(float x) { return x / (1.f + __expf(-x)); }
__device__ __forceinline__ int crow(int r, int hi) { return (r & 3) + 8 * (r >> 2) + 4 * hi; }
__device__ __forceinline__ void rope_cs(int pos, int d, float& cs, float& sn) {
    const float invf = exp2f(-(float)d * 0.4152410118609203f);
    double rv = (double)pos * (double)invf * 0.15915494309189535; rv -= floor(rv);
    const float rf = (float)rv; sn = __builtin_amdgcn_sinf(rf); cs = __builtin_amdgcn_cosf(rf);
}

#define XB_TMO      128
#define XB_XCNT(j)  (256  + 64 * (j))
#define XB_XSUB(j)  (1280 + 64 * (j))
#define XB_XGEN(j)  (2304 + 64 * (j))
#define XB_TOP      3328
#define XB_TOPGEN   3392
#define XCD_BAR_WORDS 3456
#define XB_SPIN_CAP (1u << 18)

__device__ __forceinline__ unsigned xb_ld(unsigned* p)              { return __hip_atomic_load(p, __ATOMIC_RELAXED, __HIP_MEMORY_SCOPE_AGENT); }
__device__ __forceinline__ unsigned xb_add(unsigned* p, unsigned v) { return __hip_atomic_fetch_add(p, v, __ATOMIC_RELAXED, __HIP_MEMORY_SCOPE_AGENT); }
__device__ __forceinline__ unsigned xb_xcc_id() { return (unsigned)__builtin_amdgcn_s_getreg((3 << 11) | 20) & 0xFu; }
#define XB_SPIN(cond, bar) do { unsigned _sp = 0; while (cond) { __builtin_amdgcn_s_sleep(1); \
    if ((++_sp & 255u) == 0u) { if (xb_ld(&(bar)[XB_TMO])) break; if (_sp > XB_SPIN_CAP) { atomicAdd(&(bar)[XB_TMO], 1u); break; } } } } while (0)

struct XcdBarrier {
    unsigned* bar; unsigned x;
    volatile LAS unsigned* st;
};

__device__ __forceinline__ XcdBarrier xcd_barrier_post(unsigned* bar, volatile LAS unsigned* st, bool leader) {
    XcdBarrier b; b.bar = bar; b.x = xb_xcc_id(); b.st = st;
    if (leader) (void)xb_add(&bar[XB_XCNT(b.x)], 1u);
    return b;
}
__device__ __forceinline__ void xcd_barrier_complete(unsigned* bar, unsigned x, unsigned& nloc, unsigned& nx) {
    const unsigned G = gridDim.x * gridDim.y * gridDim.z;
    unsigned sum, cnt, mine, sp = 0u;
    for (;;) {
        sum = 0u; cnt = 0u; mine = 0u;
#pragma unroll
        for (unsigned j = 0; j < 16; ++j) { const unsigned c = xb_ld(&bar[XB_XCNT(j)]); sum += c; cnt += (c > 0u) ? 1u : 0u; mine = (j == x) ? c : mine; }
        if (sum == G) break;
        __builtin_amdgcn_s_sleep(1);
        if ((++sp & 255u) == 0u) { if (xb_ld(&bar[XB_TMO])) break; if (sp > XB_SPIN_CAP) { atomicAdd(&bar[XB_TMO], 1u); break; } }
    }
    nloc = mine > 0u ? mine : 1u; nx = cnt > 0u ? cnt : 1u;
}

__device__ __forceinline__ void xcd_barrier(const XcdBarrier& b, bool leader) {
    asm volatile("s_waitcnt vmcnt(0)" ::: "memory");
    __syncthreads();
    if (leader) {
        unsigned* bar = b.bar;
        __builtin_amdgcn_s_waitcnt(0);
        unsigned nloc = b.st[0], nx = b.st[1];
        if (nloc == 0u) { xcd_barrier_complete(bar, b.x, nloc, nx); b.st[0] = nloc; b.st[1] = nx; }
        const unsigned old = xb_add(&bar[XB_XSUB(b.x)], 1u);
        const unsigned gen = old / nloc;
        if (old + 1u == (gen + 1u) * nloc) {
            __builtin_amdgcn_fence(__ATOMIC_RELEASE, "agent");
            asm volatile("s_waitcnt vmcnt(0)" ::: "memory");
            const unsigned og = xb_add(&bar[XB_TOP], 1u);
            const unsigned tg = og / nx;
            if (og + 1u == (tg + 1u) * nx) xb_add(&bar[XB_TOPGEN], 1u);
            else XB_SPIN(xb_ld(&bar[XB_TOPGEN]) == tg, bar);
            __builtin_amdgcn_fence(__ATOMIC_ACQUIRE, "agent");
            xb_add(&bar[XB_XGEN(b.x)], 1u);
            asm volatile("s_waitcnt vmcnt(0)" ::: "memory");
        } else {
            XB_SPIN(xb_ld(&bar[XB_XGEN(b.x)]) == gen, bar);
            __builtin_amdgcn_fence(__ATOMIC_ACQUIRE, "agent");
            asm volatile("s_waitcnt vmcnt(0)" ::: "memory");
        }
    }
    __syncthreads();
}

__device__ __forceinline__ void transpose_item(const float* W, int K, int N, int Npad, bf16* WT, LAS float* scr, int item, int lane, const float* gk = nullptr) {
    const int nblk = Npad / 32, kb = item / nblk, nb = item % nblk, k0 = 64 * kb, n0 = 32 * nb;
    const int ncol = n0 + (lane & 31);
    float wv_[32];
#pragma unroll
    for (int i = 0; i < 32; ++i) { const int kk = 2 * i + (lane >> 5); wv_[i] = (ncol < N) ? W[(size_t)(k0 + kk) * N + ncol] : 0.f; }
    __builtin_amdgcn_sched_barrier(0);
#pragma unroll
    for (int i = 0; i < 32; ++i) { const int kk = 2 * i + (lane >> 5); scr[kk * 33 + (lane & 31)] = wv_[i]; }
    LDS_WAIT(); asm volatile("" ::: "memory");
    const int c = lane & 7;
    f32x4 g0 = {1.f, 1.f, 1.f, 1.f}, g1 = g0;
    if (gk) { g0 = *(const f32x4*)(gk + k0 + 8 * c); g1 = *(const f32x4*)(gk + k0 + 8 * c + 4); }
#pragma unroll
    for (int j = 0; j < 4; ++j) { const int n = (lane >> 3) + 8 * j; const LAS float* s = scr + (8 * c) * 33 + n;
        v4u o; o.x = pk2(s[0 * 33] * g0.x, s[1 * 33] * g0.y); o.y = pk2(s[2 * 33] * g0.z, s[3 * 33] * g0.w); o.z = pk2(s[4 * 33] * g1.x, s[5 * 33] * g1.y); o.w = pk2(s[6 * 33] * g1.z, s[7 * 33] * g1.w);
        *(v4u*)(WT + (size_t)(n0 + n) * K + k0 + 8 * c) = o; }
    LDS_WAIT(); asm volatile("" ::: "memory");
}
__device__ __forceinline__ f32x4 ld4x(const void* row, int i, bool bf) {
    if (bf) { const v2u w = ((const v2u*)row)[i]; return (f32x4){bf2f((unsigned short)(w.x & 0xffffu)), bf2f((unsigned short)(w.x >> 16)), bf2f((unsigned short)(w.y & 0xffffu)), bf2f((unsigned short)(w.y >> 16))}; }
    return ((const f32x4*)row)[i]; }
__device__ __forceinline__ void rms_row(const void* xrow, bool bf, const float* g, bf16* orow, float* of32, int lane) {
    f32x4 v[4]; float s = 0.f;
#pragma unroll
    for (int j = 0; j < 4; ++j) { v[j] = ld4x(xrow, 64 * j + lane, bf); s += (v[j].x * v[j].x + v[j].y * v[j].y) + (v[j].z * v[j].z + v[j].w * v[j].w); }
    const float rstd = 1.f / sqrtf(wave_sum(s) * (1.f / DM) + 1e-6f);
#pragma unroll
    for (int j = 0; j < 4; ++j) { const f32x4 gg = ((const f32x4*)g)[64 * j + lane]; const f32x4 o = v[j] * rstd * gg;
        if (of32) ((f32x4*)of32)[64 * j + lane] = o;
        else ((v2u*)orow)[64 * j + lane] = (v2u){pk2(o.x, o.y), pk2(o.z, o.w)}; }
}

__device__ __forceinline__ void rms_row2(const void* xa, const void* xb, bool bf, const float* g, bf16* oa, bf16* ob, float* fa, float* fb, int lane) {
    f32x4 va[4], vb[4];
#pragma unroll
    for (int j = 0; j < 4; ++j) { va[j] = ld4x(xa, 64 * j + lane, bf); vb[j] = ld4x(xb, 64 * j + lane, bf); }
    __builtin_amdgcn_sched_barrier(0);
    float sa = 0.f, sb = 0.f;
#pragma unroll
    for (int j = 0; j < 4; ++j) { sa += (va[j].x * va[j].x + va[j].y * va[j].y) + (va[j].z * va[j].z + va[j].w * va[j].w); sb += (vb[j].x * vb[j].x + vb[j].y * vb[j].y) + (vb[j].z * vb[j].z + vb[j].w * vb[j].w); }
    const float ra = 1.f / sqrtf(wave_sum(sa) * (1.f / DM) + 1e-6f), rb = 1.f / sqrtf(wave_sum(sb) * (1.f / DM) + 1e-6f);
#pragma unroll
    for (int j = 0; j < 4; ++j) { const f32x4 gg = ((const f32x4*)g)[64 * j + lane]; const f32x4 o1 = va[j] * ra * gg, o2 = vb[j] * rb * gg;
        if (fa) { ((f32x4*)fa)[64 * j + lane] = o1; ((f32x4*)fb)[64 * j + lane] = o2; }
        else { ((v2u*)oa)[64 * j + lane] = (v2u){pk2(o1.x, o1.y), pk2(o1.z, o1.w)}; ((v2u*)ob)[64 * j + lane] = (v2u){pk2(o2.x, o2.y), pk2(o2.z, o2.w)}; } }
}
__device__ __forceinline__ void rms_row_parts(const void* base, bool bf, const float* parts, int nparts, size_t part_stride, bf16* xout, const float* g, bf16* orow, float* of32, int lane) {
    f32x4 v[4]; float s = 0.f;
#pragma unroll
    for (int j = 0; j < 4; ++j) v[j] = ld4x(base, 64 * j + lane, bf);
    for (int p = 0; p < nparts; ++p) { const f32x4* pr = (const f32x4*)(parts + (size_t)p * part_stride) + lane;
#pragma unroll
        for (int j = 0; j < 4; ++j) v[j] += pr[64 * j]; }
#pragma unroll
    for (int j = 0; j < 4; ++j) { if (xout) ((v2u*)xout)[64 * j + lane] = (v2u){pk2(v[j].x, v[j].y), pk2(v[j].z, v[j].w)}; s += (v[j].x * v[j].x + v[j].y * v[j].y) + (v[j].z * v[j].z + v[j].w * v[j].w); }
    const float rstd = 1.f / sqrtf(wave_sum(s) * (1.f / DM) + 1e-6f);
#pragma unroll
    for (int j = 0; j < 4; ++j) { const f32x4 gg = ((const f32x4*)g)[64 * j + lane]; const f32x4 o = v[j] * rstd * gg;
        if (of32) ((f32x4*)of32)[64 * j + lane] = o;
        else ((v2u*)orow)[64 * j + lane] = (v2u){pk2(o.x, o.y), pk2(o.z, o.w)}; }
}

__device__ __forceinline__ void resid_parts_row(const void* base, bool bf, const float* parts, int nparts, size_t part_stride, bf16* xout, float* rs, int lane) {
    f32x4 v[4]; float s = 0.f;
#pragma unroll
    for (int j = 0; j < 4; ++j) v[j] = ld4x(base, 64 * j + lane, bf);
    for (int p = 0; p < nparts; ++p) { const f32x4* pr = (const f32x4*)(parts + (size_t)p * part_stride) + lane;
#pragma unroll
        for (int j = 0; j < 4; ++j) v[j] += pr[64 * j]; }
#pragma unroll
    for (int j = 0; j < 4; ++j) { const unsigned w0 = pk2(v[j].x, v[j].y), w1 = pk2(v[j].z, v[j].w); ((v2u*)xout)[64 * j + lane] = (v2u){w0, w1};
        const float q0 = bf2f((unsigned short)(w0 & 0xffffu)), q1 = bf2f((unsigned short)(w0 >> 16)), q2 = bf2f((unsigned short)(w1 & 0xffffu)), q3 = bf2f((unsigned short)(w1 >> 16));
        s += (q0 * q0 + q1 * q1) + (q2 * q2 + q3 * q3); }
    const float tot = wave_sum(s);
    if (lane == 0) *rs = 1.f / sqrtf(tot * (1.f / DM) + 1e-6f);
}
__device__ __forceinline__ void rs_from_parts(const float* SS, float* RS, int m) {
    const f32x4* p = (const f32x4*)(SS + (size_t)m * 16); const f32x4 a = p[0], b = p[1], c = p[2], d = p[3];
    const float s = ((a.x + a.y) + (a.z + a.w)) + ((b.x + b.y) + (b.z + b.w)) + ((c.x + c.y) + (c.z + c.w)) + ((d.x + d.y) + (d.z + d.w));
    RS[m] = 1.f / sqrtf(s * (1.f / DM) + 1e-6f);
}

struct PBArgs { const float* PROJ; const float* state_conv; const float* conv_w; const float* a_log; const float* dt_bias;
    float* QN; float* KN; float* VG; float* G; float* BETA; float* KQ; bf16* QB; bf16* KS; bf16* VS; bf16* KW; bf16* VW; float* out; int l; };
struct PBRegs { float qs_[8], qo_[8], kvs_[12], kvo_[12]; };
__device__ __forceinline__ void pb_row_load(const PBArgs& A, int m, int lane, PBRegs& R) {
    const float* pr = A.PROJ + (size_t)m * NP;
#pragma unroll
    for (int h = 0; h < 8; ++h) { R.qs_[h] = pr[C_Q + h * 64 + lane]; R.qo_[h] = pr[C_Q + h * 64 + (lane ^ 32)]; }
#pragma unroll
    for (int i = 0; i < 12; ++i) { R.kvs_[i] = pr[C_KV + i * 64 + lane]; R.kvo_[i] = pr[C_KV + i * 64 + (lane ^ 32)]; }
}
__device__ __forceinline__ void pb_row(const PBArgs& A, int m, int lane, const PBRegs& R) {
    const bool is_s = m >= MP; int b, t;
    if (!is_s) { b = m >> 12; t = m & 4095; } else { b = (m - MP) >> 2; t = (m - MP) & 3; }
    const int pos = is_s ? PAST + t : t, l = A.l;
    const float* pr = A.PROJ + (size_t)m * NP;
    const float* cw = A.conv_w + (size_t)l * 4 * 1536;
    const float* cb = A.state_conv + ((size_t)l * NSB + b) * 3 * 1536;
    if (!is_s && t >= SEQ - 3) { float* o = A.out + O_CONVP + ((size_t)(l * NPB + b) * 3 + (t - (SEQ - 3))) * 1536;
#pragma unroll 4
        for (int j = 0; j < 24; ++j) o[64 * j + lane] = pr[64 * j + lane]; }
    if (is_s && t >= 1) { float* o = A.out + O_CONVS + ((size_t)(l * NSB + b) * 3 + (t - 1)) * 1536;
#pragma unroll 4
        for (int j = 0; j < 24; ++j) o[64 * j + lane] = pr[64 * j + lane]; }
    const int half = lane >> 5; float cs, sn; rope_cs(pos, lane & 31, cs, sn);
    const float (&qs_)[8] = R.qs_; const float (&qo_)[8] = R.qo_; const float (&kvs_)[12] = R.kvs_; const float (&kvo_)[12] = R.kvo_;
#pragma unroll
    for (int h = 0; h < 8; ++h) { const float xs = qs_[h], xo = qo_[h];
        const float r = half ? (xs * cs + xo * sn) : (xs * cs - xo * sn);
        A.QB[(size_t)m * 512 + h * 64 + lane] = (bf16)f2bf(r * C2); }
#pragma unroll
    for (int s6 = 0; s6 < 6; ++s6)
#pragma unroll
        for (int kvh = 0; kvh < 2; ++kvh) {
            float v = kvs_[s6 * 2 + kvh];
            if (s6 == 2 || s6 == 4) { const float xo = kvo_[s6 * 2 + kvh]; v = half ? (v * cs + xo * sn) : (v * cs - xo * sn); }
            if (s6 < 4) {
                if (!is_s) A.out[O_KVP + ((((size_t)(l * NPB + b) * 2 + kvh) * SEQ + t) * 4 + s6) * 64 + lane] = v;
                else       A.out[O_KVS + ((((size_t)(l * NSB + b) * 2 + kvh) * DSEQ + t) * 4 + s6) * 64 + lane] = v;
            } else {
                const int idx = s6 - 4;
                if (!is_s) { if (t >= SEQ - 512) A.out[O_WINP + ((((size_t)(l * NPB + b) * 512 + (t - (SEQ - 512))) * 2 + idx) * 2 + kvh) * 64 + lane] = v; }
                else A.out[O_WINS + ((((size_t)(l * NSB + b) * 512 + (508 + t)) * 2 + idx) * 2 + kvh) * 64 + lane] = v;
            }
            const bf16 bv = (bf16)f2bf(v);
            if (s6 == 2) A.KS[(size_t)m * 128 + kvh * 64 + lane] = bv;
            if (s6 == 3) A.VS[(size_t)m * 128 + kvh * 64 + lane] = bv;
            if (s6 == 4) A.KW[(size_t)m * 128 + kvh * 64 + lane] = bv;
            if (s6 == 5) A.VW[(size_t)m * 128 + kvh * 64 + lane] = bv;
        }
}

__device__ __forceinline__ void pb_sample_head(const PBArgs& A, int u, int lane) {
    const int m = MP + (u >> 3), h = u & 7, b = (m - MP) >> 2, t = (m - MP) & 3, l = A.l;
    const float* pr = A.PROJ + (size_t)m * NP;
    const float* cw = A.conv_w + (size_t)l * 4 * 1536;
    const float* cb = A.state_conv + ((size_t)l * NSB + b) * 3 * 1536;
    float xv[3][4], wv[3][4];
#pragma unroll
    for (int part = 0; part < 3; ++part) { const int c = (part * 8 + h) * 64 + lane;
#pragma unroll
        for (int tap = 0; tap < 4; ++tap) { const int idx = t + tap;
            xv[part][tap] = (idx >= 3) ? A.PROJ[(size_t)(m - t + idx - 3) * NP + c] : cb[idx * 1536 + c];
            wv[part][tap] = cw[tap * 1536 + c]; } }
    __builtin_amdgcn_sched_barrier(0);
    float qkv[3];
#pragma unroll
    for (int part = 0; part < 3; ++part) qkv[part] = siluf_((xv[part][0] * wv[part][0] + xv[part][1] * wv[part][1]) + (xv[part][2] * wv[part][2] + xv[part][3] * wv[part][3]));
    const float q = qkv[0], k = qkv[1];
    const float qs = dpp_sum(q * q), ks = dpp_sum(k * k);
    const float qn = q * (1.f / sqrtf(qs + 1e-6f)) * 0.125f, kn = k * (1.f / sqrtf(ks + 1e-6f));
    const float kq = dpp_sum(qn * kn);
    A.QN[(size_t)m * 512 + h * 64 + lane] = qn; A.KN[(size_t)m * 512 + h * 64 + lane] = kn; A.VG[(size_t)m * 512 + h * 64 + lane] = qkv[2];
    if (lane == 0) A.KQ[(size_t)m * 8 + h] = kq;
    if (h == 0 && lane < 8) {
        const float a = pr[C_A + lane] + A.dt_bias[l * 8 + lane];
        const float sp = fmaxf(a, 0.f) + log1pf(__expf(-fabsf(a)));
        A.G[(size_t)m * 8 + lane] = -__expf(A.a_log[l * 8 + lane]) * sp;
        A.BETA[(size_t)m * 8 + lane] = sigmoidf_(pr[C_BETA + lane]); }
}

struct CmpArgs { const float* PROJ; const float* cache; const int* page_table; const float* pe_k; const float* pe_v; const bf16* CMPW; unsigned char* ws; int l; };
__device__ __forceinline__ void compress_batch(const CmpArgs& A, unsigned char* lds, int batch, bool is_s, int tid) {
    const int lane = tid & 63, wave = __builtin_amdgcn_readfirstlane(tid >> 6), fr = lane & 15, fq = lane >> 4, l = A.l;
    const int kv = batch & 1, ru = (batch >> 1) * 8 + wave;
    const int rho = 16 * ru + fr, NC = is_s ? 64 : 128;
    const int seq = rho / (2 * NC), n = (rho >> 1) % NC, kvh = rho & 1;
    const float* abase; size_t astride;
    if (!is_s) { abase = A.PROJ + (size_t)(seq * SEQ + 32 * n) * NP + C_KV + kv * 128 + kvh * 64; astride = NP; }
    else { const int page = A.page_table[seq * NPAGES + (n >> 2)];
        abase = A.cache + ((((size_t)l * NPOOL + page) * 2 + kvh) * 128 + (n & 3) * 32) * 256 + kv * 64; astride = 256; }
    const float* pe = (kv ? A.pe_v : A.pe_k) + (size_t)l * 2048;
    const bf16* Wt = A.CMPW + (size_t)((l * 2 + kv) * 64) * 2048;
    const int we = tid >> 3, wch = tid & 7;
    f32x4 acc[4];
#pragma unroll
    for (int et = 0; et < 4; ++et) acc[et] = (f32x4){0.f, 0.f, 0.f, 0.f};
    f32x4 sa[2][4], sp[2][4]; v4u wreg;
#define CB_LOADA(S, c) do { _Pragma("unroll") for (int ks = 0; ks < 2; ++ks) { const float* ap = abase + (size_t)(c) * astride + 32 * ks + 8 * fq; const float* pp = pe + (c) * 64 + 32 * ks + 8 * fq; \
        sa[S][2 * ks] = *(const f32x4*)ap; sa[S][2 * ks + 1] = *(const f32x4*)(ap + 4); sp[S][2 * ks] = *(const f32x4*)pp; sp[S][2 * ks + 1] = *(const f32x4*)(pp + 4); } } while (0)
#define CB_LOADW(c) do { wreg = *(const v4u*)(Wt + (size_t)we * 2048 + ((c) < 31 ? (c) : 31) * 64 + wch * 8); } while (0)
#define CB_STOREW(bufi) do { *(v4u*)(lds + (bufi) * 9216 + we * 144 + wch * 16) = wreg; } while (0)
#define CB_MMA(S, bufi) do { _Pragma("unroll") for (int ks = 0; ks < 2; ++ks) { const f32x4 a0 = sa[S][2 * ks] + sp[S][2 * ks], a1 = sa[S][2 * ks + 1] + sp[S][2 * ks + 1]; \
        const bf16x8 ya = pack8(a0.x, a0.y, a0.z, a0.w, a1.x, a1.y, a1.z, a1.w); \
        _Pragma("unroll") for (int et = 0; et < 4; ++et) { const bf16x8 wf_ = *(const bf16x8*)(lds + (bufi) * 9216 + (16 * et + fr) * 144 + (32 * ks + 8 * fq) * 2); \
            acc[et] = __builtin_amdgcn_mfma_f32_16x16x32_bf16(wf_, ya, acc[et], 0, 0, 0); } } } while (0)
    __syncthreads();
    CB_LOADW(0); CB_LOADA(0, 0);
    CB_STOREW(0); CB_LOADW(1);
    __syncthreads();
#pragma unroll 1
    for (int c = 0; c < 32; c += 2) {
        CB_STOREW(1); __builtin_amdgcn_sched_barrier(0); CB_LOADW(c + 2); CB_LOADA(1, c + 1); __builtin_amdgcn_sched_barrier(0);
        CB_MMA(0, 0); __builtin_amdgcn_sched_barrier(0);
        __syncthreads();
        CB_STOREW(0); __builtin_amdgcn_sched_barrier(0); CB_LOADW(c + 3); if (c + 2 < 32) { CB_LOADA(0, c + 2); } __builtin_amdgcn_sched_barrier(0);
        CB_MMA(1, 1); __builtin_amdgcn_sched_barrier(0);
        __syncthreads();
    }
#undef CB_LOADA
#undef CB_LOADW
#undef CB_STOREW
#undef CB_MMA
    if (kv == 0) { const int pos = 32 * n + 31;
#pragma unroll
        for (int et = 0; et < 2; ++et)
#pragma unroll
            for (int i = 0; i < 4; ++i) { float cs, sn; rope_cs(pos, 16 * et + 4 * fq + i, cs, sn);
                const float x1 = acc[et][i], x2 = acc[et + 2][i]; acc[et][i] = x1 * cs - x2 * sn; acc[et + 2][i] = x2 * cs + x1 * sn; } }
    float* ob = (float*)(A.ws + (is_s ? WS_CKS : WS_CKP) + (size_t)kv * (is_s ? (WS_CVS - WS_CKS) : (WS_CVP - WS_CKP))) + (size_t)rho * 64 + 4 * fq;
#pragma unroll
    for (int et = 0; et < 4; ++et) *(f32x4*)(ob + 16 * et) = acc[et];
}

struct GdnArgs { const float* QN; const float* KN; const float* VG; const float* G; const float* BETA; const float* KQ; float* OG; const float* PROJ; const float* state_gdn; const float* gdn_norm; bf16* MIX; float* out; int l; };
__device__ __forceinline__ void gdn_sample_unit(const GdnArgs& A, int unit, int lane) {
    const int sb = unit >> 3, h = unit & 7, l = A.l;
    const float* sp = A.state_gdn + (((size_t)l * NSB + sb) * 8 + h) * 4096;
    float S[64];
#pragma unroll
    for (int d = 0; d < 64; ++d) S[d] = sp[d * 64 + lane];
    const float gn = A.gdn_norm[l * 64 + lane];
    for (int i = 0; i < DSEQ; ++i) {
        const size_t m = (size_t)MP + sb * 4 + i;
        const float kd = A.KN[m * 512 + h * 64 + lane], qd = A.QN[m * 512 + h * 64 + lane], v = A.VG[m * 512 + h * 64 + lane];
        const float g = A.G[m * 8 + h], beta = A.BETA[m * 8 + h], kq = A.KQ[m * 8 + h];
        const int kdb = __builtin_bit_cast(int, kd), qdb = __builtin_bit_cast(int, qd);
        const float a = __expf(g); float r1 = 0.f, r2 = 0.f;
#pragma unroll
        for (int d = 0; d < 64; ++d) { const float kk = __builtin_bit_cast(float, __builtin_amdgcn_readlane(kdb, d)), qq = __builtin_bit_cast(float, __builtin_amdgcn_readlane(qdb, d)); r1 += S[d] * kk; r2 += S[d] * qq; }
        const float u = beta * (v - a * r1), o = a * r2 + u * kq;
#pragma unroll
        for (int d = 0; d < 64; ++d) { const float kk = __builtin_bit_cast(float, __builtin_amdgcn_readlane(kdb, d)); S[d] = a * S[d] + kk * u; }
        const float ms = wave_sum(o * o) * (1.f / 64.f);
        const float z = A.PROJ[m * NP + C_Z + h * 64 + lane];
        A.MIX[m * 1024 + h * 64 + lane] = (bf16)f2bf(o * (1.f / sqrtf(ms + 1e-6f)) * gn * siluf_(z));
    }
    float* so = A.out + O_GDNS + (((size_t)l * NSB + sb) * 8 + h) * 4096;
#pragma unroll
    for (int d = 0; d < 64; ++d) so[d * 64 + lane] = S[d];
}


__device__ __forceinline__ int perm_inv32(int p) { return (p & 32) + 16 * ((p >> 2) & 1) + 4 * ((p >> 3) & 3) + (p & 3); }
struct GPArgs { const float* PROJ; const float* conv_w; const float* a_log; const float* dt_bias; bf16* GK; bf16* GQ; bf16* GKT; bf16* GVT; float* GG2; float* BETA2; int l; };
struct GPRegs { float xx[3][11], ww[3][4]; };
__device__ __forceinline__ void gdn_prep_load(const GPArgs& A, int unit, int lane, GPRegs& R) {
    const int tg = unit >> 3, h = unit & 7, m0 = tg * 8, t0 = m0 & 4095;
    const float* cw = A.conv_w + (size_t)A.l * 4 * 1536;
#pragma unroll
    for (int part = 0; part < 3; ++part) { const int c = (part * 8 + h) * 64 + lane;
#pragma unroll
        for (int j = 0; j < 11; ++j) R.xx[part][j] = (t0 - 3 + j >= 0) ? A.PROJ[(size_t)(m0 - 3 + j) * NP + c] : 0.f;
#pragma unroll
        for (int k = 0; k < 4; ++k) R.ww[part][k] = cw[k * 1536 + c]; }
}
__device__ __forceinline__ void gdn_prep_unit(const GPArgs& A, int unit, int lane, const GPRegs& R) {
    const int tg = unit >> 3, h = unit & 7, m0 = tg * 8, b = m0 >> 12, t0 = m0 & 4095, l = A.l, bh = b * 8 + h;
    const float* cw = A.conv_w + (size_t)l * 4 * 1536;
    float val[3][8]; const float (&xx)[3][11] = R.xx; const float (&ww)[3][4] = R.ww;
#pragma unroll
    for (int part = 0; part < 3; ++part)
#pragma unroll
        for (int i = 0; i < 8; ++i) val[part][i] = siluf_(ww[part][0] * xx[part][i] + ww[part][1] * xx[part][i + 1] + ww[part][2] * xx[part][i + 2] + ww[part][3] * xx[part][i + 3]);
#pragma unroll
    for (int i = 0; i < 8; ++i) { const float q = val[0][i], k = val[1][i];
        const float qs = dpp_sum(q * q), ks = dpp_sum(k * k);
        val[0][i] = q * (1.f / sqrtf(qs + 1e-6f)) * 0.125f; val[1][i] = k * (1.f / sqrtf(ks + 1e-6f)); }
#pragma unroll
    for (int i = 0; i < 8; ++i) { A.GQ[((size_t)bh * 4096 + t0 + i) * 64 + lane] = (bf16)f2bf(val[0][i]); A.GK[((size_t)bh * 4096 + t0 + i) * 64 + lane] = (bf16)f2bf(val[1][i]); }
    *(v4u*)(A.GKT + ((size_t)bh * 64 + lane) * 4096 + t0) = (v4u){pk2(val[1][0], val[1][1]), pk2(val[1][2], val[1][3]), pk2(val[1][4], val[1][5]), pk2(val[1][6], val[1][7])};
    *(v4u*)(A.GVT + ((size_t)bh * 64 + lane) * 4096 + t0) = (v4u){pk2(val[2][0], val[2][1]), pk2(val[2][2], val[2][3]), pk2(val[2][4], val[2][5]), pk2(val[2][6], val[2][7])};
    if (lane < 8) { const float* pr = A.PROJ + (size_t)(m0 + lane) * NP;
        const float a = pr[C_A + h] + A.dt_bias[l * 8 + h];
        const float sp = fmaxf(a, 0.f) + log1pf(__expf(-fabsf(a)));
        A.GG2[(size_t)bh * 4096 + t0 + lane] = -__expf(A.a_log[l * 8 + h]) * sp;
        A.BETA2[(size_t)bh * 4096 + t0 + lane] = sigmoidf_(pr[C_BETA + h]); }
}
template <int I> __device__ __forceinline__ void fsub_row(float (&T)[64], const float* AL, int lane) {
    float tv = (lane == I) ? 1.f : 0.f;
#pragma unroll
    for (int j4 = 0; j4 < (I + 3) / 4; ++j4) { const f32x4 a = *(const f32x4*)(AL + I * 64 + 4 * j4);
#pragma unroll
        for (int e = 0; e < 4; ++e) if (4 * j4 + e < I) tv -= a[e] * T[4 * j4 + e]; }
    T[I] = tv;
}
template <int I> struct FSub { static __device__ __forceinline__ void run(float (&T)[64], const float* AL, int lane) { FSub<I - 1>::run(T, AL, lane); fsub_row<I>(T, AL, lane); } };
template <> struct FSub<-1> { static __device__ __forceinline__ void run(float (&)[64], const float*, int) {} };
struct GCArgs { const bf16* GK; const bf16* GQ; const bf16* GKT; const bf16* GVT; const float* GG2; const float* BETA2; bf16* WX; bf16* QX; bf16* QKX; bf16* KTX; float* U0F; float* GL; };
constexpr int GC_LDS_PER_WAVE = 17664;
__device__ __forceinline__ void gdn_chunk_unit(const GCArgs& A, unsigned char* wl, int unit, int lane_) {
    int lane = lane_; asm volatile("" : "+v"(lane));
    const int bh = unit >> 6, n = unit & 63, t0 = 64 * n, fr = lane & 15, fq = lane >> 4;
    float* AL = (float*)wl; float* SC = (float*)(wl + 16384);
    {   const float g = A.GG2[(size_t)bh * 4096 + t0 + lane], beta = A.BETA2[(size_t)bh * 4096 + t0 + lane];
        float gc = g;
        gc = dpp_add<0x111, 0xf>(gc); gc = dpp_add<0x112, 0xf>(gc); gc = dpp_add<0x114, 0xf>(gc); gc = dpp_add<0x118, 0xf>(gc); gc = dpp_add<0x142, 0xa>(gc); gc = dpp_add<0x143, 0xc>(gc);
        const float glast = __builtin_bit_cast(float, __builtin_amdgcn_readlane(__builtin_bit_cast(int, gc), 63));
        const float eg = __expf(gc);
        SC[lane] = gc; SC[64 + lane] = beta; SC[128 + lane] = beta * eg; SC[192 + lane] = eg; SC[256 + lane] = __expf(glast - gc);
        if (lane == 0) A.GL[unit] = __expf(glast); }
    LDS_WAIT(); asm volatile("" ::: "memory");
    {
        bf16x8 kf[4][2];
#pragma unroll
        for (int t4 = 0; t4 < 4; ++t4)
#pragma unroll
            for (int ks = 0; ks < 2; ++ks) kf[t4][ks] = *(const bf16x8*)(A.GK + ((size_t)bh * 4096 + t0 + 16 * t4 + fr) * 64 + 32 * ks + 8 * fq);
        __builtin_amdgcn_sched_barrier(0);
#pragma unroll
        for (int ti = 0; ti < 4; ++ti) { const f32x4 gi = *(const f32x4*)(SC + 16 * ti + 4 * fq), bi = *(const f32x4*)(SC + 64 + 16 * ti + 4 * fq);
#pragma unroll
            for (int tj = 0; tj < 4; ++tj) if (tj <= ti) { f32x4 acc = {0.f, 0.f, 0.f, 0.f};
                acc = __builtin_amdgcn_mfma_f32_16x16x32_bf16(kf[ti][0], kf[tj][0], acc, 0, 0, 0); acc = __builtin_amdgcn_mfma_f32_16x16x32_bf16(kf[ti][1], kf[tj][1], acc, 0, 0, 0);
                const float gj = SC[16 * tj + fr];
#pragma unroll
                for (int i = 0; i < 4; ++i) AL[(16 * ti + 4 * fq + i) * 64 + 16 * tj + fr] = bi[i] * acc[i] * __expf(fminf(gi[i] - gj, 0.f)); } }
    }
    LDS_WAIT(); asm volatile("" ::: "memory");
    {
        float T[64];
        FSub<63>::run(T, AL, lane);
        LDS_WAIT(); asm volatile("" ::: "memory");
        unsigned short* TB = (unsigned short*)wl;
#pragma unroll
        for (int i = 0; i < 64; ++i) TB[i * 72 + lane] = (unsigned short)f2bf(T[i]);
    }
    LDS_WAIT(); asm volatile("" ::: "memory");
    {
        bf16x8 tf[4][2];
#pragma unroll
        for (int ti = 0; ti < 4; ++ti)
#pragma unroll
            for (int ks = 0; ks < 2; ++ks) tf[ti][ks] = *(const bf16x8*)(wl + ((16 * ti + fr) * 72 + 32 * ks + 8 * fq) * 2);
#pragma unroll
        for (int which = 0; which < 2; ++which) { const bf16* src = which ? A.GVT : A.GKT; const float* sc = SC + (which ? 64 : 128);
            bf16x8 raws[4][2];
#pragma unroll
            for (int tn = 0; tn < 4; ++tn)
#pragma unroll
                for (int ks = 0; ks < 2; ++ks) raws[tn][ks] = *(const bf16x8*)(src + ((size_t)bh * 64 + 16 * tn + fr) * 4096 + t0 + 32 * ks + 8 * fq);
            __builtin_amdgcn_sched_barrier(0);
#pragma unroll
            for (int tn = 0; tn < 4; ++tn) { bf16x8 yb[2];
#pragma unroll
                for (int ks = 0; ks < 2; ++ks) { const bf16x8 raw = raws[tn][ks];
                    const f32x4 s0 = *(const f32x4*)(sc + 32 * ks + 8 * fq), s1 = *(const f32x4*)(sc + 32 * ks + 8 * fq + 4);
                    yb[ks] = pack8(bf2f((unsigned short)raw[0]) * s0.x, bf2f((unsigned short)raw[1]) * s0.y, bf2f((unsigned short)raw[2]) * s0.z, bf2f((unsigned short)raw[3]) * s0.w,
                                   bf2f((unsigned short)raw[4]) * s1.x, bf2f((unsigned short)raw[5]) * s1.y, bf2f((unsigned short)raw[6]) * s1.z, bf2f((unsigned short)raw[7]) * s1.w); }
#pragma unroll
                for (int ti = 0; ti < 4; ++ti) { f32x4 acc = {0.f, 0.f, 0.f, 0.f};
                    acc = __builtin_amdgcn_mfma_f32_16x16x32_bf16(tf[ti][0], yb[0], acc, 0, 0, 0);
                    if (ti >= 2) acc = __builtin_amdgcn_mfma_f32_16x16x32_bf16(tf[ti][1], yb[1], acc, 0, 0, 0);
                    if (which == 0) { const int p = 32 * (tn >> 1) + 8 * (fr >> 2) + 4 * (tn & 1) + (fr & 3);
#pragma unroll
                        for (int i = 0; i < 4; ++i) A.WX[((size_t)unit * 64 + 16 * ti + 4 * fq + i) * 64 + p] = (bf16)f2bf(acc[i]); }
                    else *(f32x4*)(A.U0F + (((size_t)unit * 16 + ti * 4 + tn) * 64 + lane) * 4) = acc; } } }
    }
    {
        bf16x8 kf[4][2], qf[4][2];
#pragma unroll
        for (int t4 = 0; t4 < 4; ++t4)
#pragma unroll
            for (int ks = 0; ks < 2; ++ks) { kf[t4][ks] = *(const bf16x8*)(A.GK + ((size_t)bh * 4096 + t0 + 16 * t4 + fr) * 64 + 32 * ks + 8 * fq);
                qf[t4][ks] = *(const bf16x8*)(A.GQ + ((size_t)bh * 4096 + t0 + 16 * t4 + fr) * 64 + 32 * ks + 8 * fq); }
        __builtin_amdgcn_sched_barrier(0);
#pragma unroll
        for (int ti = 0; ti < 4; ++ti) { const f32x4 gi = *(const f32x4*)(SC + 16 * ti + 4 * fq);
#pragma unroll
            for (int tj = 0; tj < 4; ++tj) { f32x4 acc = {0.f, 0.f, 0.f, 0.f};
                if (tj <= ti) { acc = __builtin_amdgcn_mfma_f32_16x16x32_bf16(qf[ti][0], kf[tj][0], acc, 0, 0, 0); acc = __builtin_amdgcn_mfma_f32_16x16x32_bf16(qf[ti][1], kf[tj][1], acc, 0, 0, 0); }
                const float gj = SC[16 * tj + fr]; const int p = 32 * (tj >> 1) + 8 * (fr >> 2) + 4 * (tj & 1) + (fr & 3);
#pragma unroll
                for (int i = 0; i < 4; ++i) { const int ri = 16 * ti + 4 * fq + i, cj = 16 * tj + fr;
                    const float v = (tj <= ti && ri >= cj) ? acc[i] * __expf(fminf(gi[i] - gj, 0.f)) : 0.f;
                    A.QKX[((size_t)unit * 64 + ri) * 64 + p] = (bf16)f2bf(v); } } }
    }
    {
        const int lg = perm_inv32(lane);
        const float ek = SC[256 + lg];
#pragma unroll 1
        for (int r0 = 0; r0 < 64; r0 += 16) { bf16 qv[16], kv[16];
#pragma unroll
            for (int i = 0; i < 16; ++i) { qv[i] = A.GQ[((size_t)bh * 4096 + t0 + r0 + i) * 64 + lg]; kv[i] = A.GKT[((size_t)bh * 64 + r0 + i) * 4096 + t0 + lg]; }
            __builtin_amdgcn_sched_barrier(0);
#pragma unroll
            for (int i = 0; i < 16; ++i) { A.QX[((size_t)unit * 64 + r0 + i) * 64 + lane] = (bf16)f2bf(bf2f(qv[i]) * SC[192 + r0 + i]);
                A.KTX[((size_t)unit * 64 + r0 + i) * 64 + lane] = (bf16)f2bf(bf2f(kv[i]) * ek); } }
    }
    LDS_WAIT(); asm volatile("" ::: "memory");
}
struct GS2Args { const bf16* WX; const bf16* QX; const bf16* QKX; const bf16* KTX; const float* U0F; const float* GL; float* OG; float* out; int l; };
__device__ __forceinline__ void gdn_scan2_wave(const GS2Args& A, int bh, int te, int lane) {
    const int fr = lane & 15, fq = lane >> 4, b = bh >> 3, h = bh & 7;
    f32x4 s[4]; bf16x8 sfr[2];
#pragma unroll
    for (int i = 0; i < 4; ++i) s[i] = (f32x4){0.f, 0.f, 0.f, 0.f};
    sfr[0] = (bf16x8){0, 0, 0, 0, 0, 0, 0, 0}; sfr[1] = sfr[0];
    f32x4 u[4]; bf16x8 wf[4][2], kt[4][2], qx[4][2], qkx[4][2]; float dec;
#define GS_LD_UW(nn) do { const size_t un_ = (size_t)bh * 64 + (nn); _Pragma("unroll") for (int tc = 0; tc < 4; ++tc) { u[tc] = *(const f32x4*)(A.U0F + ((un_ * 16 + tc * 4 + te) * 64 + lane) * 4); \
        _Pragma("unroll") for (int ks = 0; ks < 2; ++ks) wf[tc][ks] = *(const bf16x8*)(A.WX + (un_ * 64 + 16 * tc + fr) * 64 + 32 * ks + 8 * fq); } } while (0)
#define GS_LD_Q(nn) do { const size_t un_ = (size_t)bh * 64 + (nn); _Pragma("unroll") for (int tc = 0; tc < 4; ++tc) _Pragma("unroll") for (int ks = 0; ks < 2; ++ks) { \
        qx[tc][ks] = *(const bf16x8*)(A.QX + (un_ * 64 + 16 * tc + fr) * 64 + 32 * ks + 8 * fq); qkx[tc][ks] = *(const bf16x8*)(A.QKX + (un_ * 64 + 16 * tc + fr) * 64 + 32 * ks + 8 * fq); } } while (0)
#define GS_LD_K(nn) do { const size_t un_ = (size_t)bh * 64 + (nn); dec = A.GL[un_]; _Pragma("unroll") for (int tc = 0; tc < 4; ++tc) _Pragma("unroll") for (int ks = 0; ks < 2; ++ks) \
        kt[tc][ks] = *(const bf16x8*)(A.KTX + (un_ * 64 + 16 * tc + fr) * 64 + 32 * ks + 8 * fq); } while (0)
    GS_LD_UW(0); GS_LD_Q(0); GS_LD_K(0);
    __builtin_amdgcn_sched_barrier(0);
#pragma unroll 1
    for (int n = 0; n < 64; ++n) {
        const int nn = n < 63 ? n + 1 : 63;
#pragma unroll
        for (int tc = 0; tc < 4; ++tc) { f32x4 acc = {0.f, 0.f, 0.f, 0.f};
            acc = __builtin_amdgcn_mfma_f32_16x16x32_bf16(wf[tc][0], sfr[0], acc, 0, 0, 0); acc = __builtin_amdgcn_mfma_f32_16x16x32_bf16(wf[tc][1], sfr[1], acc, 0, 0, 0);
            u[tc] -= acc; }
        bf16x8 ufr[2];
#pragma unroll
        for (int ks = 0; ks < 2; ++ks) ufr[ks] = pack8(u[2 * ks][0], u[2 * ks][1], u[2 * ks][2], u[2 * ks][3], u[2 * ks + 1][0], u[2 * ks + 1][1], u[2 * ks + 1][2], u[2 * ks + 1][3]);
        __builtin_amdgcn_sched_barrier(0);
        GS_LD_UW(nn);
        __builtin_amdgcn_sched_barrier(0);
        f32x4 oacc[4];
#pragma unroll
        for (int tc = 0; tc < 4; ++tc) {
            f32x4 acc = {0.f, 0.f, 0.f, 0.f};
            acc = __builtin_amdgcn_mfma_f32_16x16x32_bf16(qx[tc][0], sfr[0], acc, 0, 0, 0); acc = __builtin_amdgcn_mfma_f32_16x16x32_bf16(qx[tc][1], sfr[1], acc, 0, 0, 0);
            acc = __builtin_amdgcn_mfma_f32_16x16x32_bf16(qkx[tc][0], ufr[0], acc, 0, 0, 0); acc = __builtin_amdgcn_mfma_f32_16x16x32_bf16(qkx[tc][1], ufr[1], acc, 0, 0, 0);
            oacc[tc] = acc; }
#pragma unroll
        for (int td = 0; td < 4; ++td) { f32x4 acc = s[td] * dec;
            acc = __builtin_amdgcn_mfma_f32_16x16x32_bf16(kt[td][0], ufr[0], acc, 0, 0, 0); acc = __builtin_amdgcn_mfma_f32_16x16x32_bf16(kt[td][1], ufr[1], acc, 0, 0, 0);
            s[td] = acc; }
#pragma unroll
        for (int ks = 0; ks < 2; ++ks) sfr[ks] = pack8(s[2 * ks][0], s[2 * ks][1], s[2 * ks][2], s[2 * ks][3], s[2 * ks + 1][0], s[2 * ks + 1][1], s[2 * ks + 1][2], s[2 * ks + 1][3]);
        __builtin_amdgcn_sched_barrier(0);
        GS_LD_Q(nn); GS_LD_K(nn);
#pragma unroll
        for (int tc = 0; tc < 4; ++tc)
#pragma unroll
            for (int i = 0; i < 4; ++i) A.OG[((size_t)b * SEQ + 64 * n + 16 * tc + 4 * fq + i) * 512 + h * 64 + 16 * te + fr] = oacc[tc][i];
        __builtin_amdgcn_sched_barrier(0);
    }
#undef GS_LD_UW
#undef GS_LD_Q
#undef GS_LD_K
#pragma unroll
    for (int td = 0; td < 4; ++td)
#pragma unroll
        for (int i = 0; i < 4; ++i) A.out[O_GDNP + ((((size_t)A.l * NPB + b) * 8 + h) * 64 + 16 * td + 4 * fq + i) * 64 + 16 * te + fr] = s[td][i];
}

constexpr int SC_ROW = 144, SC_MAT = 64 * SC_ROW, SC_U = 4 * SC_MAT, SC_STAGE = SC_U + 16384, SC_DEC = 2 * SC_STAGE;
__device__ __forceinline__ void gdn_scan3_block(const GS2Args& A, unsigned char* lds, int bh, int tid) {
    const int lane = tid & 63, wave = __builtin_amdgcn_readfirstlane(tid >> 6), fr = lane & 15, fq = lane >> 4, b = bh >> 3, h = bh & 7, te = wave;
    const int mrow = (tid >> 3), mch = tid & 7;
    v4u ra[6], rb[6];
#define SC_LOAD(R, nn) do { const size_t un_ = (size_t)bh * 64 + ((nn) < 63 ? (nn) : 63); \
        R[0] = *(const v4u*)(A.WX + un_ * 4096 + mrow * 64 + mch * 8); R[1] = *(const v4u*)(A.KTX + un_ * 4096 + mrow * 64 + mch * 8); \
        R[2] = *(const v4u*)(A.QX + un_ * 4096 + mrow * 64 + mch * 8); R[3] = *(const v4u*)(A.QKX + un_ * 4096 + mrow * 64 + mch * 8); \
        R[4] = *(const v4u*)(A.U0F + un_ * 4096 + (size_t)tid * 4); R[5] = *(const v4u*)(A.U0F + un_ * 4096 + (size_t)(tid + 512) * 4); } while (0)
#define SC_STORE(R, st) do { unsigned char* sb_ = lds + (st) * SC_STAGE; \
        *(v4u*)(sb_ + 0 * SC_MAT + mrow * SC_ROW + mch * 16) = R[0]; *(v4u*)(sb_ + 1 * SC_MAT + mrow * SC_ROW + mch * 16) = R[1]; \
        *(v4u*)(sb_ + 2 * SC_MAT + mrow * SC_ROW + mch * 16) = R[2]; *(v4u*)(sb_ + 3 * SC_MAT + mrow * SC_ROW + mch * 16) = R[3]; \
        *(v4u*)(sb_ + SC_U + tid * 16) = R[4]; *(v4u*)(sb_ + SC_U + (tid + 512) * 16) = R[5]; } while (0)
    f32x4 s[4]; bf16x8 sfr[2];
#pragma unroll
    for (int i = 0; i < 4; ++i) s[i] = (f32x4){0.f, 0.f, 0.f, 0.f};
    sfr[0] = (bf16x8){0, 0, 0, 0, 0, 0, 0, 0}; sfr[1] = sfr[0];
    __syncthreads();
    if (tid < 64) ((float*)(lds + SC_DEC))[tid] = A.GL[(size_t)bh * 64 + tid];
    SC_LOAD(ra, 0); SC_STORE(ra, 0);
    SC_LOAD(rb, 1); SC_LOAD(ra, 2);
    __syncthreads();
#define SC_CHUNK(n, st) do { if (wave < 4) { const unsigned char* sb_ = lds + (st) * SC_STAGE; \
        f32x4 u[4]; bf16x8 ufr[2]; \
        _Pragma("unroll") for (int tc = 0; tc < 4; ++tc) { u[tc] = *(const f32x4*)(sb_ + SC_U + ((tc * 4 + te) * 64 + lane) * 16); \
            const bf16x8 w0 = *(const bf16x8*)(sb_ + (16 * tc + fr) * SC_ROW + (8 * fq) * 2), w1 = *(const bf16x8*)(sb_ + (16 * tc + fr) * SC_ROW + (32 + 8 * fq) * 2); \
            f32x4 acc = {0.f, 0.f, 0.f, 0.f}; acc = __builtin_amdgcn_mfma_f32_16x16x32_bf16(w0, sfr[0], acc, 0, 0, 0); acc = __builtin_amdgcn_mfma_f32_16x16x32_bf16(w1, sfr[1], acc, 0, 0, 0); u[tc] -= acc; } \
        _Pragma("unroll") for (int ks = 0; ks < 2; ++ks) ufr[ks] = pack8(u[2 * ks][0], u[2 * ks][1], u[2 * ks][2], u[2 * ks][3], u[2 * ks + 1][0], u[2 * ks + 1][1], u[2 * ks + 1][2], u[2 * ks + 1][3]); \
        _Pragma("unroll") for (int tc = 0; tc < 4; ++tc) { \
            const bf16x8 q0 = *(const bf16x8*)(sb_ + 2 * SC_MAT + (16 * tc + fr) * SC_ROW + (8 * fq) * 2), q1 = *(const bf16x8*)(sb_ + 2 * SC_MAT + (16 * tc + fr) * SC_ROW + (32 + 8 * fq) * 2); \
            const bf16x8 k0 = *(const bf16x8*)(sb_ + 3 * SC_MAT + (16 * tc + fr) * SC_ROW + (8 * fq) * 2), k1 = *(const bf16x8*)(sb_ + 3 * SC_MAT + (16 * tc + fr) * SC_ROW + (32 + 8 * fq) * 2); \
            f32x4 acc = {0.f, 0.f, 0.f, 0.f}; \
            acc = __builtin_amdgcn_mfma_f32_16x16x32_bf16(q0, sfr[0], acc, 0, 0, 0); acc = __builtin_amdgcn_mfma_f32_16x16x32_bf16(q1, sfr[1], acc, 0, 0, 0); \
            acc = __builtin_amdgcn_mfma_f32_16x16x32_bf16(k0, ufr[0], acc, 0, 0, 0); acc = __builtin_amdgcn_mfma_f32_16x16x32_bf16(k1, ufr[1], acc, 0, 0, 0); \
            _Pragma("unroll") for (int i = 0; i < 4; ++i) A.OG[((size_t)b * SEQ + 64 * (n) + 16 * tc + 4 * fq + i) * 512 + h * 64 + 16 * te + fr] = acc[i]; } \
        const float dec = ((const float*)(lds + SC_DEC))[(n)]; \
        _Pragma("unroll") for (int td = 0; td < 4; ++td) { \
            const bf16x8 t0 = *(const bf16x8*)(sb_ + 1 * SC_MAT + (16 * td + fr) * SC_ROW + (8 * fq) * 2), t1 = *(const bf16x8*)(sb_ + 1 * SC_MAT + (16 * td + fr) * SC_ROW + (32 + 8 * fq) * 2); \
            f32x4 acc = s[td] * dec; acc = __builtin_amdgcn_mfma_f32_16x16x32_bf16(t0, ufr[0], acc, 0, 0, 0); acc = __builtin_amdgcn_mfma_f32_16x16x32_bf16(t1, ufr[1], acc, 0, 0, 0); s[td] = acc; } \
        _Pragma("unroll") for (int ks = 0; ks < 2; ++ks) sfr[ks] = pack8(s[2 * ks][0], s[2 * ks][1], s[2 * ks][2], s[2 * ks][3], s[2 * ks + 1][0], s[2 * ks + 1][1], s[2 * ks + 1][2], s[2 * ks + 1][3]); } } while (0)
#pragma unroll 1
    for (int n = 0; n < 64; n += 2) {
        SC_STORE(rb, 1); __builtin_amdgcn_sched_barrier(0); SC_LOAD(rb, n + 3); __builtin_amdgcn_sched_barrier(0);
        SC_CHUNK(n, 0);
        __syncthreads();
        SC_STORE(ra, 0); __builtin_amdgcn_sched_barrier(0); SC_LOAD(ra, n + 4); __builtin_amdgcn_sched_barrier(0);
        SC_CHUNK(n + 1, 1);
        __syncthreads();
    }
#undef SC_LOAD
#undef SC_STORE
#undef SC_CHUNK
    if (wave < 4) {
#pragma unroll
        for (int td = 0; td < 4; ++td)
#pragma unroll
            for (int i = 0; i < 4; ++i) A.out[O_GDNP + ((((size_t)A.l * NPB + b) * 8 + h) * 64 + 16 * td + 4 * fq + i) * 64 + 16 * te + fr] = s[td][i];
    }
}

constexpr int L_CK = 0, L_CVT = 18432, L_IMP = 36864, L_MASK = 102400, L_UM = 102912, L_INV = 102928, L_K = 104448, L_VT = 113664;
struct AttArgs { const bf16* QB; const bf16* KS; const bf16* VS; const bf16* KW; const bf16* VW; const float* CKP; const float* CVP; const float* PROJ; bf16* MIX; };

constexpr float ATT_THR = 16.f;
constexpr int L_K2 = 122880, L_VT2 = 132096, L_VT3 = 0;
template <int MODE>
__device__ __forceinline__ void attn_tiles(unsigned char* lds, const bf16* Kg, const bf16* Vg, int j_lo, int j_hi, unsigned long long umask, unsigned long long tmask,
                                           int qblk, int trel, const bf16x8 (&qr)[4], f32x16 (&o)[2], float& mref, float& lrun, int tid, int r32, int hi) {
    int j = j_lo; while (j <= j_hi && !((umask >> j) & 1ull)) ++j;
    const int key = tid >> 3, ch = tid & 7;
    v4u kvv = {0u, 0u, 0u, 0u}, vv = {0u, 0u, 0u, 0u};
#define AT_LOAD(jj) do { kvv = *(const v4u*)(Kg + (size_t)(64 * (jj) + key) * 128 + ch * 8); vv = *(const v4u*)(Vg + (size_t)(64 * (jj) + key) * 128 + ch * 8); } while (0)
#define AT_WRITE(kofs, vofs) do { *(v4u*)(lds + (kofs) + key * 144 + ch * 16) = kvv; *(v4u*)(lds + (vofs) + key * 144 + ch * 16) = vv; } while (0)
    if (j > j_hi) return;
    AT_LOAD(j);
    __syncthreads();
    AT_WRITE(L_K, L_VT);
    int jn = j + 1; while (jn <= j_hi && !((umask >> jn) & 1ull)) ++jn;
    if (jn <= j_hi) AT_LOAD(jn);
    __syncthreads();
    const bool grpB = (tid >= 256);
    v4u pwp[4];
#pragma unroll
    for (int i = 0; i < 4; ++i) pwp[i] = (v4u){0u, 0u, 0u, 0u};
    int it = 0, vprev = L_VT;
    typedef short v4i16_t_ __attribute__((ext_vector_type(4)));
    const int trl_ = tid & 63, trq_ = (trl_ & 15) >> 2, trp_ = trl_ & 3, trd_ = 16 * ((trl_ >> 4) & 1) + 4 * trp_;
#define AT_TR(p_) __builtin_bit_cast(s16x4, __builtin_amdgcn_ds_read_tr16_b64_v4i16((__attribute__((address_space(3))) v4i16_t_*)(p_)))
#define AT_PV(vofs, PW) do { _Pragma("unroll") for (int u = 0; u < 2; ++u) _Pragma("unroll") for (int s = 0; s < 2; ++s) { const bf16x8 pf = __builtin_bit_cast(bf16x8, PW[u * 2 + s]); \
        _Pragma("unroll") for (int dh = 0; dh < 2; ++dh) { const unsigned char* vp = lds + (vofs) + (32 * u + 16 * s + 4 * hi + trq_) * 144 + (32 * dh + trd_) * 2; \
            const s16x4 lo = AT_TR(vp), hi4 = AT_TR(vp + 8 * 144); \
            const bf16x8 vf = (bf16x8){lo[0], lo[1], lo[2], lo[3], hi4[0], hi4[1], hi4[2], hi4[3]}; \
            o[dh] = __builtin_amdgcn_mfma_f32_32x32x16_bf16(vf, pf, o[dh], 0, 0, 0); } } } while (0)
    while (j <= j_hi) {
        const int kb = (it & 1) ? L_K2 : L_K, kb2 = (it & 1) ? L_K : L_K2;
        const int m3 = it % 3, vb = (m3 == 0) ? L_VT : (m3 == 1) ? L_VT2 : L_VT3, vb2 = (m3 == 0) ? L_VT2 : (m3 == 1) ? L_VT3 : L_VT;
        if (grpB && it > 0) AT_PV(vprev, pwp);
        if (jn <= j_hi) AT_WRITE(kb2, vb2);
        int jnn = jn + 1; while (jnn <= j_hi && !((umask >> jnn) & 1ull)) ++jnn;
        if (jnn <= j_hi) AT_LOAD(jnn);
        __builtin_amdgcn_sched_barrier(0);
        const bool tsel = (MODE == 0) ? (((tmask >> j) & 1ull) != 0ull) : true;
        const float cval = tsel ? -mref : NEG_INF;
        f32x16 ct;
#pragma unroll
        for (int r = 0; r < 16; ++r) ct[r] = cval;
        f32x16 p[2];
#pragma unroll
        for (int u = 0; u < 2; ++u) { f32x16 acc;
#pragma unroll
            for (int d0 = 0; d0 < 4; ++d0) { const bf16x8 kf = *(const bf16x8*)(lds + kb + (32 * u + r32) * 144 + (16 * d0 + 8 * hi) * 2);
                acc = __builtin_amdgcn_mfma_f32_32x32x16_bf16(kf, qr[d0], d0 == 0 ? ct : acc, 0, 0, 0); }
            p[u] = acc; }
        if (j == qblk) {
#pragma unroll
            for (int u = 0; u < 2; ++u)
#pragma unroll
                for (int r = 0; r < 16; ++r) { const int kv = 32 * u + crow(r, hi); if (kv > trel) p[u][r] = NEG_INF; } }
        if (MODE == 1 && j == qblk - 8) {
#pragma unroll
            for (int u = 0; u < 2; ++u)
#pragma unroll
                for (int r = 0; r < 16; ++r) { const int kv = 32 * u + crow(r, hi); if (kv < trel) p[u][r] = NEG_INF; } }
        float rm;
        { float a = __builtin_fmaxf(__builtin_fmaxf(p[0][0], p[0][1]), p[1][0]), b2 = __builtin_fmaxf(__builtin_fmaxf(p[0][2], p[0][3]), p[1][1]); a = __builtin_fmaxf(__builtin_fmaxf(a, p[1][2]), p[1][3]);
#pragma unroll
          for (int r = 4; r < 16; r += 4) { a = __builtin_fmaxf(__builtin_fmaxf(a, p[0][r]), p[0][r + 1]); b2 = __builtin_fmaxf(__builtin_fmaxf(b2, p[0][r + 2]), p[0][r + 3]);
              a = __builtin_fmaxf(__builtin_fmaxf(a, p[1][r]), p[1][r + 1]); b2 = __builtin_fmaxf(__builtin_fmaxf(b2, p[1][r + 2]), p[1][r + 3]); }
          rm = __builtin_fmaxf(a, b2); }
        { auto rr = __builtin_amdgcn_permlane32_swap(__float_as_uint(rm), __float_as_uint(rm), false, false); rm = __builtin_fmaxf(__uint_as_float(rr[0]), __uint_as_float(rr[1])); }
        if (__builtin_expect(__any(rm > ATT_THR), 0)) {
            const float dl = (rm > ATT_THR) ? rm : 0.f, f = ex2(-dl);
            mref += dl; lrun *= f;
#pragma unroll
            for (int u = 0; u < 2; ++u)
#pragma unroll
                for (int r = 0; r < 16; ++r) p[u][r] -= dl;
#pragma unroll
            for (int dh = 0; dh < 2; ++dh)
#pragma unroll
                for (int r = 0; r < 16; ++r) o[dh][r] *= f; }
        typedef float f32x2v_ __attribute__((ext_vector_type(2)));
        f32x2v_ ls2 = {0.f, 0.f};
#pragma unroll
        for (int u = 0; u < 2; ++u)
#pragma unroll
            for (int r = 0; r < 16; r += 2) { const float e0 = ex2(p[u][r]), e1 = ex2(p[u][r + 1]); p[u][r] = e0; p[u][r + 1] = e1; ls2 += (f32x2v_){e0, e1}; }
        lrun += ls2.x + ls2.y;
        v4u pw[4];
#pragma unroll
        for (int u = 0; u < 2; ++u)
#pragma unroll
            for (int s = 0; s < 2; ++s) { pw[u * 2 + s].x = pk2(p[u][8 * s + 0], p[u][8 * s + 1]); pw[u * 2 + s].y = pk2(p[u][8 * s + 2], p[u][8 * s + 3]);
                pw[u * 2 + s].z = pk2(p[u][8 * s + 4], p[u][8 * s + 5]); pw[u * 2 + s].w = pk2(p[u][8 * s + 6], p[u][8 * s + 7]); }
        if (!grpB) AT_PV(vb, pw);
        else {
#pragma unroll
            for (int i = 0; i < 4; ++i) pwp[i] = pw[i];
            vprev = vb; }
        __syncthreads();
        j = jn; jn = jnn; ++it;
    }
    if (grpB && it > 0) AT_PV(vprev, pwp);
#undef AT_PV
#undef AT_TR
#undef AT_LOAD
#undef AT_WRITE
}

__device__ __forceinline__ void nsa_prompt_unit(const AttArgs& A, unsigned char* lds, int unit, int tid) {
    const int lane = tid & 63, wave = tid >> 6, r32 = lane & 31, hi = lane >> 5, hh = wave & 3, ts = wave >> 2;
    const int qblk = 63 - (unit >> 3), b = (unit >> 1) & 3, kvh = unit & 1;
    const int head = kvh * 4 + hh, trel = 32 * ts + r32, t = 64 * qblk + trel; const size_t m = (size_t)b * SEQ + t;
    __syncthreads();
    const int nvmax = 2 * qblk + 2, ntile_c = (nvmax + 31) >> 5;
    { const int ch = tid & 7;
      for (int n = tid >> 3; n < 32 * ntile_c; n += 64) {
          const float* ckp = A.CKP + ((size_t)(b * 128 + n) * 2 + kvh) * 64 + ch * 8; const float* cvp = A.CVP + ((size_t)(b * 128 + n) * 2 + kvh) * 64 + ch * 8;
          const f32x4 k0 = *(const f32x4*)ckp, k1 = *(const f32x4*)(ckp + 4), v0 = *(const f32x4*)cvp, v1 = *(const f32x4*)(cvp + 4);
          *(bf16x8*)(lds + L_CK + n * 144 + ch * 16) = pack8(k0.x, k0.y, k0.z, k0.w, k1.x, k1.y, k1.z, k1.w);
          unsigned short* vt = (unsigned short*)(lds + L_CVT);
          vt[(ch * 8 + 0) * 136 + n] = (unsigned short)f2bf(v0.x); vt[(ch * 8 + 1) * 136 + n] = (unsigned short)f2bf(v0.y); vt[(ch * 8 + 2) * 136 + n] = (unsigned short)f2bf(v0.z); vt[(ch * 8 + 3) * 136 + n] = (unsigned short)f2bf(v0.w);
          vt[(ch * 8 + 4) * 136 + n] = (unsigned short)f2bf(v1.x); vt[(ch * 8 + 5) * 136 + n] = (unsigned short)f2bf(v1.y); vt[(ch * 8 + 6) * 136 + n] = (unsigned short)f2bf(v1.z); vt[(ch * 8 + 7) * 136 + n] = (unsigned short)f2bf(v1.w);
      }
      if (tid < 128) ((unsigned*)(lds + L_MASK))[tid] = 0u;
      if (tid < 2) ((unsigned*)(lds + L_UM))[tid] = 0u; }
    bf16x8 qr[4];
#pragma unroll
    for (int d0 = 0; d0 < 4; ++d0) qr[d0] = *(const bf16x8*)(A.QB + m * 512 + head * 64 + 16 * d0 + 8 * hi);
    __syncthreads();
    f32x16 tot[2];
    {
        const int nv = (t + 1) >> 5;
        float mx = NEG_INF;
#pragma unroll 1
        for (int tau = 0; tau < ntile_c; ++tau) {
            f32x16 acc = {};
#pragma unroll
            for (int d0 = 0; d0 < 4; ++d0) { const bf16x8 kf = *(const bf16x8*)(lds + L_CK + (32 * tau + r32) * 144 + (16 * d0 + 8 * hi) * 2);
                acc = __builtin_amdgcn_mfma_f32_32x32x16_bf16(kf, qr[d0], acc, 0, 0, 0); }
#pragma unroll
            for (int r = 0; r < 16; ++r) { const int n = 32 * tau + crow(r, hi); if (n < nv) mx = fmaxf(mx, acc[r]); }
        }
        mx = fmaxf(mx, __shfl_xor(mx, 32)); if (mx == NEG_INF) mx = 0.f;
        float sum = 0.f;
        f32x16 oc[2]; oc[0] = (f32x16){}; oc[1] = (f32x16){};
        float* imph = (float*)(lds + L_IMP) + (size_t)hh * 4096 + (32 * ts + r32) * 64;
#pragma unroll 1
        for (int tau = 0; tau < 4; ++tau) {
            f32x16 e = {};
            if (tau < ntile_c) {
                f32x16 acc = {};
#pragma unroll
                for (int d0 = 0; d0 < 4; ++d0) { const bf16x8 kf = *(const bf16x8*)(lds + L_CK + (32 * tau + r32) * 144 + (16 * d0 + 8 * hi) * 2);
                    acc = __builtin_amdgcn_mfma_f32_32x32x16_bf16(kf, qr[d0], acc, 0, 0, 0); }
#pragma unroll
                for (int r = 0; r < 16; ++r) { const int n = 32 * tau + crow(r, hi); e[r] = (n < nv) ? ex2(acc[r] - mx) : 0.f; sum += e[r]; }
#pragma unroll
                for (int s = 0; s < 2; ++s) {
                    const bf16x8 pf = pack8(e[8 * s + 0], e[8 * s + 1], e[8 * s + 2], e[8 * s + 3], e[8 * s + 4], e[8 * s + 5], e[8 * s + 6], e[8 * s + 7]);
#pragma unroll
                    for (int dh = 0; dh < 2; ++dh) { const unsigned char* vp = lds + L_CVT + (r32 + 32 * dh) * 272 + (32 * tau + 16 * s + 4 * hi) * 2;
                        const s16x4 lo = *(const s16x4*)vp, hi4 = *(const s16x4*)(vp + 16);
                        const bf16x8 vf = (bf16x8){lo[0], lo[1], lo[2], lo[3], hi4[0], hi4[1], hi4[2], hi4[3]};
                        oc[dh] = __builtin_amdgcn_mfma_f32_32x32x16_bf16(vf, pf, oc[dh], 0, 0, 0); }
                }
            }
#pragma unroll
            for (int a = 0; a < 4; ++a) { imph[16 * tau + 4 * a + 2 * hi + 0] = e[4 * a] + e[4 * a + 1]; imph[16 * tau + 4 * a + 2 * hi + 1] = e[4 * a + 2] + e[4 * a + 3]; }
        }
        sum += __shfl_xor(sum, 32);
        const float inv = 1.f / fmaxf(sum, 1e-30f);
        if (hi == 0) ((float*)(lds + L_INV))[hh * 64 + 32 * ts + r32] = inv;
        const float g0 = sigmoidf_(A.PROJ[m * NP + C_GATE + head * 3 + 0]) * inv;
#pragma unroll
        for (int dh = 0; dh < 2; ++dh)
#pragma unroll
            for (int r = 0; r < 16; ++r) tot[dh][r] = g0 * oc[dh][r];
    }
    __syncthreads();
    { float* ip = (float*)(lds + L_IMP); const float* iv = (const float*)(lds + L_INV);
#pragma unroll
      for (int i = 0; i < 8; ++i) { const int idx = tid + 512 * i, tk = idx >> 6;
          ip[idx] = (ip[idx] * iv[tk] + ip[4096 + idx] * iv[64 + tk]) + (ip[8192 + idx] * iv[128 + tk] + ip[12288 + idx] * iv[192 + tk]); } }
    __syncthreads();
    { const int tok = tid >> 3, jg = tid & 7; unsigned* mk = (unsigned*)(lds + L_MASK) + tok * 2;
      if (qblk <= 15) { if (jg == 0) { const unsigned long long am = (1ull << (qblk + 1)) - 1ull; mk[0] = (unsigned)am; mk[1] = (unsigned)(am >> 32); } }
      else {
          const float* iv = (const float*)(lds + L_IMP) + tok * 64; float vj[8]; int rk[8];
#pragma unroll
          for (int jj = 0; jj < 8; ++jj) { vj[jj] = iv[jg * 8 + jj]; rk[jj] = 0; }
          for (int i = 1; i <= qblk - 2; ++i) { const float vi = iv[i];
#pragma unroll
              for (int jj = 0; jj < 8; ++jj) { const int j = jg * 8 + jj; rk[jj] += (vi > vj[jj] || (vi == vj[jj] && i < j)) ? 1 : 0; } }
          unsigned bits = 0u;
#pragma unroll
          for (int jj = 0; jj < 8; ++jj) { const int j = jg * 8 + jj; const bool cand = (j >= 1 && j <= qblk - 2);
              if ((cand && rk[jj] < 13) || j == 0 || j == qblk || j == qblk - 1) bits |= 1u << ((jg & 3) * 8 + jj); }
          if (bits) atomicOr(mk + (jg >> 2), bits);
      } }
    __syncthreads();
    if (tid < 64) { const unsigned* mk = (const unsigned*)(lds + L_MASK) + tid * 2; atomicOr((unsigned*)(lds + L_UM), mk[0]); atomicOr((unsigned*)(lds + L_UM) + 1, mk[1]); }
    __syncthreads();
    unsigned long long tmask, umask;
    { const unsigned* mk = (const unsigned*)(lds + L_MASK) + trel * 2; tmask = (unsigned long long)mk[0] | ((unsigned long long)mk[1] << 32);
      const unsigned* um = (const unsigned*)(lds + L_UM); umask = (unsigned long long)um[0] | ((unsigned long long)um[1] << 32); }
    float* stash = (float*)(lds + L_IMP) + (size_t)wave * 2048 + lane;
#pragma unroll
    for (int dh = 0; dh < 2; ++dh)
#pragma unroll
        for (int r = 0; r < 16; ++r) stash[(dh * 16 + r) * 64] = tot[dh][r];
    {
        f32x16 o[2]; o[0] = (f32x16){}; o[1] = (f32x16){}; float mrun = 0.f, lrun = 0.f;
        attn_tiles<0>(lds, A.KS + (size_t)b * SEQ * 128 + kvh * 64, A.VS + (size_t)b * SEQ * 128 + kvh * 64, 0, qblk, umask, tmask, qblk, trel, qr, o, mrun, lrun, tid, r32, hi);
        lrun += __shfl_xor(lrun, 32);
        const float g1 = lrun > 0.f ? sigmoidf_(A.PROJ[m * NP + C_GATE + head * 3 + 1]) / lrun : 0.f;
#pragma unroll
        for (int dh = 0; dh < 2; ++dh)
#pragma unroll
            for (int r = 0; r < 16; ++r) stash[(dh * 16 + r) * 64] += g1 * o[dh][r];
    }
    {
        f32x16 o[2]; o[0] = (f32x16){}; o[1] = (f32x16){}; float mrun = 0.f, lrun = 0.f;
        const int jlo = qblk >= 8 ? qblk - 8 : 0;
        attn_tiles<1>(lds, A.KW + (size_t)b * SEQ * 128 + kvh * 64, A.VW + (size_t)b * SEQ * 128 + kvh * 64, jlo, qblk, ~0ull, ~0ull, qblk, trel, qr, o, mrun, lrun, tid, r32, hi);
        lrun += __shfl_xor(lrun, 32);
        const float g2 = lrun > 0.f ? sigmoidf_(A.PROJ[m * NP + C_GATE + head * 3 + 2]) / lrun : 0.f;
#pragma unroll
        for (int dh = 0; dh < 2; ++dh)
#pragma unroll
            for (int r = 0; r < 16; ++r) tot[dh][r] = stash[(dh * 16 + r) * 64] + g2 * o[dh][r];
    }
    bf16* mo = A.MIX + m * 1024 + 512 + head * 64;
#pragma unroll
    for (int dh = 0; dh < 2; ++dh)
#pragma unroll
        for (int a = 0; a < 4; ++a) { const int d0 = 32 * dh + 8 * a + 4 * hi;
            *(v2u*)(mo + d0) = (v2u){pk2(tot[dh][4 * a], tot[dh][4 * a + 1]), pk2(tot[dh][4 * a + 2], tot[dh][4 * a + 3])}; }
}

struct SAttArgs { const bf16* QB; const bf16* KS; const bf16* VS; const bf16* KW; const bf16* VW; const float* CKS; const float* CVS; const float* PROJ; const float* cache; const int* page_table; const float* state_win; bf16* MIX; int l; };
constexpr int S2_IMP = 0, S2_MK = 512, S2_ITEMS = 576, S2_OC = 1024, S2_MG = 8192;
constexpr int S2_MG_STRIDE = 4224;
template <bool F32> __device__ __forceinline__ void s2_block(const void* kbase, const void* vbase, int kstride, int nvalid, const bf16x8 (&qf)[2], const bool (&keep)[4][4], f32x4 (&O)[4], float& mrun, float& lrun, int fr, int fq) {
    f32x4 kraw[4][2][2]; bf16x8 kb[4][2]; f32x4 vraw[2][8]; v2u vb[2][8];
#pragma unroll
    for (int tk = 0; tk < 4; ++tk) { const int key = 16 * tk + fr, kc = key < nvalid ? key : nvalid - 1;
#pragma unroll
        for (int ks = 0; ks < 2; ++ks) {
            if (F32) { const float* p = (const float*)kbase + (size_t)kc * kstride + 32 * ks + 8 * fq; kraw[tk][ks][0] = *(const f32x4*)p; kraw[tk][ks][1] = *(const f32x4*)(p + 4); }
            else kb[tk][ks] = *(const bf16x8*)((const bf16*)kbase + (size_t)kc * 128 + 32 * ks + 8 * fq); } }
#pragma unroll
    for (int ks = 0; ks < 2; ++ks)
#pragma unroll
        for (int j = 0; j < 8; ++j) { const int key = 32 * ks + 16 * (j >> 2) + 4 * fq + (j & 3), kc = key < nvalid ? key : nvalid - 1;
            if (F32) vraw[ks][j] = *(const f32x4*)((const float*)vbase + (size_t)kc * kstride + 4 * fr);
            else vb[ks][j] = *(const v2u*)((const bf16*)vbase + (size_t)kc * 128 + 4 * fr); }
    __builtin_amdgcn_sched_barrier(0);
    f32x4 acc[4];
#pragma unroll
    for (int tk = 0; tk < 4; ++tk) { bf16x8 kx[2];
#pragma unroll
        for (int ks = 0; ks < 2; ++ks) { if (F32) { const f32x4 a = kraw[tk][ks][0], b = kraw[tk][ks][1]; kx[ks] = pack8(a.x, a.y, a.z, a.w, b.x, b.y, b.z, b.w); } else kx[ks] = kb[tk][ks]; }
        f32x4 a4 = {0.f, 0.f, 0.f, 0.f};
        a4 = __builtin_amdgcn_mfma_f32_16x16x32_bf16(kx[0], qf[0], a4, 0, 0, 0); a4 = __builtin_amdgcn_mfma_f32_16x16x32_bf16(kx[1], qf[1], a4, 0, 0, 0);
        acc[tk] = a4; }
    float mx = NEG_INF;
#pragma unroll
    for (int tk = 0; tk < 4; ++tk)
#pragma unroll
        for (int i = 0; i < 4; ++i) { if (!keep[tk][i]) acc[tk][i] = NEG_INF; mx = fmaxf(mx, acc[tk][i]); }
    mx = fmaxf(mx, __shfl_xor(mx, 16)); mx = fmaxf(mx, __shfl_xor(mx, 32));
    const float mn = fmaxf(mrun, mx), msafe = (mn == NEG_INF) ? 0.f : mn, alpha = ex2(mrun - msafe);
    float ls = 0.f;
#pragma unroll
    for (int tk = 0; tk < 4; ++tk)
#pragma unroll
        for (int i = 0; i < 4; ++i) { const float e = ex2(acc[tk][i] - msafe); acc[tk][i] = e; ls += e; }
    lrun = lrun * alpha + ls; mrun = mn;
#pragma unroll
    for (int td = 0; td < 4; ++td) O[td] *= alpha;
#pragma unroll
    for (int ks = 0; ks < 2; ++ks) {
        const bf16x8 pf = pack8(acc[2 * ks][0], acc[2 * ks][1], acc[2 * ks][2], acc[2 * ks][3], acc[2 * ks + 1][0], acc[2 * ks + 1][1], acc[2 * ks + 1][2], acc[2 * ks + 1][3]);
        float vv[8][4];
#pragma unroll
        for (int j = 0; j < 8; ++j) {
            if (F32) { const f32x4 v = vraw[ks][j]; vv[j][0] = v.x; vv[j][1] = v.y; vv[j][2] = v.z; vv[j][3] = v.w; }
            else { const v2u w = vb[ks][j]; vv[j][0] = bf2f((unsigned short)(w.x & 0xffffu)); vv[j][1] = bf2f((unsigned short)(w.x >> 16)); vv[j][2] = bf2f((unsigned short)(w.y & 0xffffu)); vv[j][3] = bf2f((unsigned short)(w.y >> 16)); } }
#pragma unroll
        for (int td = 0; td < 4; ++td) { const bf16x8 vx = pack8(vv[0][td], vv[1][td], vv[2][td], vv[3][td], vv[4][td], vv[5][td], vv[6][td], vv[7][td]);
            O[td] = __builtin_amdgcn_mfma_f32_16x16x32_bf16(vx, pf, O[td], 0, 0, 0); }
    }
}
__device__ __forceinline__ void nsa_sample_unit(const SAttArgs& A, unsigned char* lds, int unit, int tid) {
    const int sb = unit >> 1, kvh = unit & 1, l = A.l;
    const int lane = tid & 63, wave = __builtin_amdgcn_readfirstlane(tid >> 6), fr = lane & 15, fq = lane >> 4;
    const int qi = fr >> 2, qh = fr & 3;
    float* IMP = (float*)(lds + S2_IMP); unsigned* MK = (unsigned*)(lds + S2_MK); int* ITEMS = (int*)(lds + S2_ITEMS);
    const size_t mq = (size_t)MP + sb * 4 + qi;
    __syncthreads();
    if (tid < 8) MK[tid] = 0u;
    bf16x8 qf[2];
#pragma unroll
    for (int ks = 0; ks < 2; ++ks) qf[ks] = *(const bf16x8*)(A.QB + mq * 512 + (kvh * 4 + qh) * 64 + 32 * ks + 8 * fq);
    {
        f32x4 O[4]; float mrun = NEG_INF, lrun = 0.f;
#pragma unroll
        for (int td = 0; td < 4; ++td) O[td] = (f32x4){0.f, 0.f, 0.f, 0.f};
        bool keep[4][4];
#pragma unroll
        for (int tk = 0; tk < 4; ++tk)
#pragma unroll
            for (int i = 0; i < 4; ++i) keep[tk][i] = true;
        const float* ckf = A.CKS + ((size_t)sb * 64 * 2 + kvh) * 64; const float* cvf = A.CVS + ((size_t)sb * 64 * 2 + kvh) * 64;
        f32x4 acc[4];
#pragma unroll
        for (int tk = 0; tk < 4; ++tk) { bf16x8 kx[2];
#pragma unroll
            for (int ks = 0; ks < 2; ++ks) { const float* p = ckf + (size_t)(16 * tk + fr) * 128 + 32 * ks + 8 * fq; const f32x4 a = *(const f32x4*)p, b = *(const f32x4*)(p + 4); kx[ks] = pack8(a.x, a.y, a.z, a.w, b.x, b.y, b.z, b.w); }
            f32x4 a4 = {0.f, 0.f, 0.f, 0.f};
            a4 = __builtin_amdgcn_mfma_f32_16x16x32_bf16(kx[0], qf[0], a4, 0, 0, 0); a4 = __builtin_amdgcn_mfma_f32_16x16x32_bf16(kx[1], qf[1], a4, 0, 0, 0);
            acc[tk] = a4; }
        float mx = NEG_INF;
#pragma unroll
        for (int tk = 0; tk < 4; ++tk)
#pragma unroll
            for (int i = 0; i < 4; ++i) mx = fmaxf(mx, acc[tk][i]);
        mx = fmaxf(mx, __shfl_xor(mx, 16)); mx = fmaxf(mx, __shfl_xor(mx, 32));
        float ls = 0.f;
#pragma unroll
        for (int tk = 0; tk < 4; ++tk)
#pragma unroll
            for (int i = 0; i < 4; ++i) { const float e = ex2(acc[tk][i] - mx); acc[tk][i] = e; ls += e; }
        ls += __shfl_xor(ls, 16); ls += __shfl_xor(ls, 32);
        const float inv = 1.f / fmaxf(ls, 1e-30f);
        if (wave == 0) {
#pragma unroll
            for (int tk = 0; tk < 4; ++tk)
#pragma unroll
                for (int b2 = 0; b2 < 2; ++b2) { float v = (acc[tk][2 * b2] + acc[tk][2 * b2 + 1]) * inv;
                    v += __shfl_xor(v, 1); v += __shfl_xor(v, 2);
                    if (qh == 0) IMP[qi * 32 + 8 * tk + 2 * fq + b2] = v; }
#pragma unroll
            for (int ks = 0; ks < 2; ++ks) {
                const bf16x8 pf = pack8(acc[2 * ks][0], acc[2 * ks][1], acc[2 * ks][2], acc[2 * ks][3], acc[2 * ks + 1][0], acc[2 * ks + 1][1], acc[2 * ks + 1][2], acc[2 * ks + 1][3]);
#pragma unroll
                for (int td = 0; td < 4; ++td) { float vv[8];
#pragma unroll
                    for (int j = 0; j < 8; ++j) { const int key = 32 * ks + 16 * (j >> 2) + 4 * fq + (j & 3); vv[j] = cvf[(size_t)key * 128 + 4 * fr + td]; }
                    const bf16x8 vx = pack8(vv[0], vv[1], vv[2], vv[3], vv[4], vv[5], vv[6], vv[7]);
                    O[td] = __builtin_amdgcn_mfma_f32_16x16x32_bf16(vx, pf, O[td], 0, 0, 0); } }
            const float g0 = sigmoidf_(A.PROJ[mq * NP + C_GATE + (kvh * 4 + qh) * 3 + 0]) * inv;
            float* OC = (float*)(lds + S2_OC);
#pragma unroll
            for (int td = 0; td < 4; ++td)
#pragma unroll
                for (int i = 0; i < 4; ++i) OC[(16 * fq + 4 * i + td) * 16 + fr] = g0 * O[td][i];
        }
        (void)mrun; (void)lrun; (void)keep;
    }
    __syncthreads();
    if (tid < 128) { const int i = tid >> 5, j = tid & 31; bool sel = (j == 0 || j == 31);
        if (j >= 1 && j <= 30) { const float vj = IMP[i * 32 + j]; int rk = 0;
            for (int q = 1; q <= 30; ++q) { const float vi = IMP[i * 32 + q]; rk += (vi > vj || (vi == vj && q < j)) ? 1 : 0; }
            sel = rk < 13; }
        if (sel) { atomicOr(MK + i, 1u << j); atomicOr(MK + 4, 1u << j); } }
    __syncthreads();
    if (tid == 0) { const unsigned um = MK[4]; int n = 0;
        for (int j = 0; j < 32; ++j) if ((um >> j) & 1u) ITEMS[1 + n++] = j;
        ITEMS[1 + n++] = 32;
        for (int jb = 0; jb < 9; ++jb) ITEMS[1 + n++] = 64 + jb;
        ITEMS[0] = n; }
    __syncthreads();
    {
        const int nitems = ITEMS[0]; const unsigned tm = MK[qi];
        f32x4 Os[4], Ow[4]; float ms = NEG_INF, lsum = 0.f, mw = NEG_INF, lw = 0.f;
#pragma unroll
        for (int td = 0; td < 4; ++td) { Os[td] = (f32x4){0.f, 0.f, 0.f, 0.f}; Ow[td] = (f32x4){0.f, 0.f, 0.f, 0.f}; }
        const float* wb = A.state_win + ((size_t)l * NSB + sb) * 512 * 256 + kvh * 64;
        for (int it = wave; it < nitems; it += NWAVES) {
            const int code = ITEMS[1 + it]; bool keep[4][4];
            if (code < 64) {
                const int j = code;
                if (j < 32) { const int phys = A.page_table[sb * NPAGES + (j >> 1)];
                    const float* base = A.cache + ((((size_t)l * NPOOL + phys) * 2 + kvh) * 128 + (j & 1) * 64) * 256;
                    const bool tsel = ((tm >> j) & 1u) != 0u;
#pragma unroll
                    for (int tk = 0; tk < 4; ++tk)
#pragma unroll
                        for (int i = 0; i < 4; ++i) keep[tk][i] = tsel;
                    s2_block<true>(base + 128, base + 192, 256, 64, qf, keep, Os, ms, lsum, fr, fq);
                } else {
#pragma unroll
                    for (int tk = 0; tk < 4; ++tk)
#pragma unroll
                        for (int i = 0; i < 4; ++i) { const int key = 16 * tk + 4 * fq + i; keep[tk][i] = key <= qi; }
                    s2_block<false>(A.KS + ((size_t)MP + sb * 4) * 128 + kvh * 64, A.VS + ((size_t)MP + sb * 4) * 128 + kvh * 64, 128, 4, qf, keep, Os, ms, lsum, fr, fq);
                }
            } else {
                const int jb = code - 64;
                if (jb < 8) {
#pragma unroll
                    for (int tk = 0; tk < 4; ++tk)
#pragma unroll
                        for (int i = 0; i < 4; ++i) { const int r = 64 * jb + 16 * tk + 4 * fq + i; keep[tk][i] = r >= qi; }
                    s2_block<true>(wb + (size_t)(64 * jb) * 256, wb + (size_t)(64 * jb) * 256 + 128, 256, 64, qf, keep, Ow, mw, lw, fr, fq);
                } else {
#pragma unroll
                    for (int tk = 0; tk < 4; ++tk)
#pragma unroll
                        for (int i = 0; i < 4; ++i) { const int key = 16 * tk + 4 * fq + i; keep[tk][i] = key <= qi; }
                    s2_block<false>(A.KW + ((size_t)MP + sb * 4) * 128 + kvh * 64, A.VW + ((size_t)MP + sb * 4) * 128 + kvh * 64, 128, 4, qf, keep, Ow, mw, lw, fr, fq);
                }
            }
        }
        lsum += __shfl_xor(lsum, 16); lsum += __shfl_xor(lsum, 32); lw += __shfl_xor(lw, 16); lw += __shfl_xor(lw, 32);
        float* Ps = (float*)(lds + S2_MG + (wave * 2 + 0) * S2_MG_STRIDE); float* Pw = (float*)(lds + S2_MG + (wave * 2 + 1) * S2_MG_STRIDE);
#pragma unroll
        for (int td = 0; td < 4; ++td)
#pragma unroll
            for (int i = 0; i < 4; ++i) { Ps[(16 * fq + 4 * i + td) * 16 + fr] = Os[td][i]; Pw[(16 * fq + 4 * i + td) * 16 + fr] = Ow[td][i]; }
        if (fq == 0) { Ps[1024 + fr] = ms; Ps[1040 + fr] = lsum; Pw[1024 + fr] = mw; Pw[1040 + fr] = lw; }
    }
    __syncthreads();
    {
        const int q = tid & 15, i = q >> 2, hh = q & 3; const size_t m = (size_t)MP + sb * 4 + i;
        const float* OC = (const float*)(lds + S2_OC);
        float res[2];
#pragma unroll
        for (int k = 0; k < 2; ++k) res[k] = OC[((tid >> 4) + 32 * k) * 16 + q];
#pragma unroll
        for (int br = 0; br < 2; ++br) {
            float M = NEG_INF;
#pragma unroll
            for (int w = 0; w < NWAVES; ++w) M = fmaxf(M, ((const float*)(lds + S2_MG + (w * 2 + br) * S2_MG_STRIDE))[1024 + q]);
            float L = 0.f, o0 = 0.f, o1 = 0.f;
#pragma unroll
            for (int w = 0; w < NWAVES; ++w) { const float* P = (const float*)(lds + S2_MG + (w * 2 + br) * S2_MG_STRIDE);
                const float f = ex2(P[1024 + q] - M);
                L += P[1040 + q] * f; o0 += P[(tid >> 4) * 16 + q] * f; o1 += P[((tid >> 4) + 32) * 16 + q] * f; }
            const float g = sigmoidf_(A.PROJ[m * NP + C_GATE + (kvh * 4 + hh) * 3 + 1 + br]) / fmaxf(L, 1e-30f);
            res[0] += g * o0; res[1] += g * o1;
        }
#pragma unroll
        for (int k = 0; k < 2; ++k) A.MIX[m * 1024 + 512 + (kvh * 4 + hh) * 64 + (tid >> 4) + 32 * k] = (bf16)f2bf(res[k]);
    }
}

constexpr int CW_CMPQ = 256;
__device__ __forceinline__ void compress_pull(const CmpArgs& A, unsigned char* lds, unsigned* head, volatile LAS int* slot, int max_batches, int tid) {
    for (int nb = 0; nb < max_batches; ++nb) {
        __syncthreads();
        if (tid == 0) *slot = (int)__hip_atomic_fetch_add(head, 1u, __ATOMIC_RELAXED, __HIP_MEMORY_SCOPE_AGENT);
        __syncthreads();
        const int b = *slot;
        if (b >= 256) break;
        compress_batch(A, lds, b, true, tid);
    }
    __syncthreads();
}

struct Args { const GAS void* in[22]; GAS float* out; GAS unsigned char* ws; int ph_lo, ph_hi; };
constexpr int PH_PER_LAYER = 10, N_PHASES = 1 + NL * PH_PER_LAYER;
__global__ void __launch_bounds__(NWAVES * 64, 2) hymba_fwd(Args args) {
    extern __shared__ __attribute__((aligned(16))) unsigned char lds[];
    const int G = gridDim.x, bx = blockIdx.x, NGW = G * NWAVES;
    const int wave_s_ = __builtin_amdgcn_readfirstlane((int)threadIdx.x >> 6);
#define TID_NOW() (wave_s_ * 64 + (int)__builtin_amdgcn_mbcnt_hi(~0u, __builtin_amdgcn_mbcnt_lo(~0u, 0u)))
#define SUB_IDS int tid = TID_NOW(); asm volatile("" : "+v"(tid)); const int lane = tid & 63, wave = __builtin_amdgcn_readfirstlane(tid >> 6), gw = bx * NWAVES + wave; (void)lane; (void)gw; (void)wave;
#define PHASE_IDS int tid = TID_NOW(); asm volatile("" : "+v"(tid)); const int lane = tid & 63, wave = __builtin_amdgcn_readfirstlane(tid >> 6), gw = bx * NWAVES + wave; (void)lane; (void)gw; const __attribute__((address_space(4))) unsigned long long* ka_ = (const __attribute__((address_space(4))) unsigned long long*)__builtin_amdgcn_kernarg_segment_ptr(); asm volatile("" : "+s"(ka_)); GAS unsigned char* wsg_ = (GAS unsigned char*)ka_[23]; unsigned char* wsl = (unsigned char*)wsg_;
#define x_prompt ((const float*)(const GAS float*)ka_[0])
#define x_sample ((const float*)(const GAS float*)ka_[1])
#define cache_kv ((const float*)(const GAS float*)ka_[2])
#define page_table ((const int*)(const GAS int*)ka_[3])
#define state_win ((const float*)(const GAS float*)ka_[4])
#define state_gdn ((const float*)(const GAS float*)ka_[5])
#define state_conv ((const float*)(const GAS float*)ka_[6])
#define norm_mix ((const float*)(const GAS float*)ka_[7])
#define w_in ((const float*)(const GAS float*)ka_[8])
#define conv_w ((const float*)(const GAS float*)ka_[9])
#define a_log ((const float*)(const GAS float*)ka_[10])
#define dt_bias ((const float*)(const GAS float*)ka_[11])
#define gdn_norm ((const float*)(const GAS float*)ka_[12])
#define cmp_pe_k ((const float*)(const GAS float*)ka_[13])
#define cmp_w_k ((const float*)(const GAS float*)ka_[14])
#define cmp_pe_v ((const float*)(const GAS float*)ka_[15])
#define cmp_w_v ((const float*)(const GAS float*)ka_[16])
#define w_out ((const float*)(const GAS float*)ka_[17])
#define norm_mlp ((const float*)(const GAS float*)ka_[18])
#define w_up ((const float*)(const GAS float*)ka_[19])
#define w_down ((const float*)(const GAS float*)ka_[20])
#define norm_final ((const float*)(const GAS float*)ka_[21])
#define out ((float*)(GAS float*)ka_[22])
#define WIN_T ((bf16*)(wsl + WS_WIN))
#define WOUT_T ((bf16*)(wsl + WS_WOUT))
#define WUP_T ((bf16*)(wsl + WS_WUP))
#define WDN_T ((bf16*)(wsl + WS_WDN))
#define CMPW ((bf16*)(wsl + WS_CMPW))
#define HB ((bf16*)(wsl + WS_HB))
#define PROJ ((float*)(wsl + WS_PROJ))
#define X1 ((bf16*)(wsl + WS_X1 + (size_t)l * XL_BYTES))
#define X2 ((bf16*)(wsl + WS_X2 + (size_t)l * XL_BYTES))
#define X1P ((bf16*)(wsl + WS_X1 + (size_t)(l - 1) * XL_BYTES))
#define X2P ((bf16*)(wsl + WS_X2 + (size_t)(l - 1) * XL_BYTES))
#define MIX ((bf16*)(wsl + WS_MIX))
#define HID ((bf16*)(wsl + WS_HID))
#define QN ((float*)(wsl + WS_QN))
#define KN ((float*)(wsl + WS_KN))
#define VG ((float*)(wsl + WS_VG))
#define OG ((float*)(wsl + (l == 0 ? WS_OG : WS_OG2)))
#define GG ((float*)(wsl + WS_G))
#define BETA ((float*)(wsl + WS_BETA))
#define KQ ((float*)(wsl + WS_KQ))
#define QB ((bf16*)(wsl + WS_QB))
#define KS ((bf16*)(wsl + WS_KS))
#define VS ((bf16*)(wsl + WS_VS))
#define KW ((bf16*)(wsl + WS_KW))
#define VW ((bf16*)(wsl + WS_VW))
#define CKP ((float*)(wsl + WS_CKP))
#define CVP ((float*)(wsl + WS_CVP))
#define CKS ((float*)(wsl + WS_CKS))
#define CVS ((float*)(wsl + WS_CVS))
#define GK ((bf16*)(wsl + WS_GK))
#define GQ ((bf16*)(wsl + WS_GQ))
#define GKT ((bf16*)(wsl + WS_GKT))
#define GVT ((bf16*)(wsl + WS_GVT))
#define GG2 ((float*)(wsl + WS_GG2))
#define BETA2 ((float*)(wsl + WS_BETA2))
#define WX ((bf16*)(wsl + WS_WX))
#define QX ((bf16*)(wsl + WS_QX))
#define QKX ((bf16*)(wsl + WS_QKX))
#define KTX ((bf16*)(wsl + WS_KTX))
#define U0F ((float*)(wsl + WS_U0F))
#define GL ((float*)(wsl + WS_GL))
#define PARTD ((float*)(wsl + WS_PARTD))
#define SSQ ((float*)(wsl + WS_SS))
#define RSS(s) ((float*)(wsl + WS_RS) + (size_t)(s) * RS_STRIDE)
#define PARTG ((float*)(wsl + WS_PARTG))
    LAS unsigned char* ldsl = (LAS unsigned char*)lds;

    const int lo = args.ph_lo, hi = args.ph_hi;
    { const int t0_ = TID_NOW(); if (t0_ < 16) ((LAS unsigned*)(ldsl + MISC_OFF))[t0_] = 0u; }
    __syncthreads();
    XcdBarrier bar = xcd_barrier_post((unsigned*)((unsigned char*)args.ws + WS_CTL) + CW_BAR, (volatile LAS unsigned*)(ldsl + MISC_OFF), TID_NOW() == 0);
#define BOTH(k) (lo <= (k) && (k) + 1 < hi)
#define GRID_BAR(k) do { if (BOTH(k)) { for (int rb_ = 0; rb_ < REP_BAR; ++rb_) xcd_barrier(bar, TID_NOW() == 0); } } while (0)
#ifndef REP_PG
#define REP_PG 1
#endif
#ifndef REP_PA
#define REP_PA 1
#endif
#ifndef REP_BAR
#define REP_BAR 1
#endif
#ifndef REP_GSMP
#define REP_GSMP 1
#endif
#ifndef REP_P0
#define REP_P0 1
#endif
#ifndef REP_LIGHT
#define REP_LIGHT 1
#endif
#ifndef REP_PB_ROW
#define REP_PB_ROW 1
#endif
#ifndef REP_PB_PREP
#define REP_PB_PREP 1
#endif
#ifndef REP_PB_CMP
#define REP_PB_CMP 1
#endif
#ifndef REP_PB_COPY
#define REP_PB_COPY 1
#endif
#ifndef REP_PB2
#define REP_PB2 1
#endif
#ifndef REP_SCAN
#define REP_SCAN 1
#endif
#ifndef REP_ATTP
#define REP_ATTP 1
#endif
#ifndef REP_ATTS
#define REP_ATTS 1
#endif
#ifndef REP_GEMM
#define REP_GEMM 1
#endif
#define EN(i) (((PH_MASK_T) >> (i)) & 1u)
#define SUB(i) (((SUB_MASK_T) >> (i)) & 1u)
#define IN(k) (lo <= (k) && (k) < hi)

    if (IN(0)) { PHASE_IDS
        for (int rep0 = 0; rep0 < REP_P0; ++rep0) {
        LAS float* scr = (LAS float*)(ldsl + wave * 16384);
        constexpr int I_IN = 16 * 112, I_OUT = 16 * 32, I_UP = 16 * 128, I_DN = 64 * 32, I_C = 32 * 2, I_L = I_IN + I_OUT + I_UP + I_DN + 2 * I_C;
        for (int it = gw; it < NL * I_L; it += NGW) {
            const int l = it / I_L; int r = it % I_L;
            if (r < I_IN) { transpose_item(w_in + (size_t)l * DM * NPROJ, DM, NPROJ, NP, WIN_T + (size_t)l * NP * DM, scr, r, lane, l > 0 ? norm_mix + (size_t)l * DM : nullptr); continue; } r -= I_IN;
            if (r < I_OUT) { transpose_item(w_out + (size_t)l * DM * DM, DM, DM, DM, WOUT_T + (size_t)l * DM * DM, scr, r, lane); continue; } r -= I_OUT;
            if (r < I_UP) { transpose_item(w_up + (size_t)l * DM * DFF, DM, DFF, DFF, WUP_T + (size_t)l * DFF * DM, scr, r, lane, norm_mlp + (size_t)l * DM); continue; } r -= I_UP;
            if (r < I_DN) { transpose_item(w_down + (size_t)l * DFF * DM, DFF, DM, DM, WDN_T + (size_t)l * DM * DFF, scr, r, lane); continue; } r -= I_DN;
            if (r < I_C) { transpose_item(cmp_w_k + (size_t)l * 2048 * 64, 2048, 64, 64, CMPW + (size_t)((l * 2 + 0) * 64) * 2048, scr, r, lane); continue; } r -= I_C;
            transpose_item(cmp_w_v + (size_t)l * 2048 * 64, 2048, 64, 64, CMPW + (size_t)((l * 2 + 1) * 64) * 2048, scr, r, lane);
        }
        for (int m = gw; m < MT; m += NGW) { const float* xr = (m < MP) ? x_prompt + (size_t)m * DM : x_sample + (size_t)(m - MP) * DM; rms_row(xr, false, norm_mix, HB + (size_t)m * DM, nullptr, lane); }
        for (int m = bx * NWAVES * 64 + tid; m < MT; m += G * NWAVES * 64) RSS(0)[m < MP ? m : MP + (m - MP) * 32] = 1.f;
        }
    }

    GRID_BAR(0);
    for (int l = 0; l < NL; ++l) {
        const int pb = 1 + l * PH_PER_LAYER;
        if (IN(pb + 0)) { PHASE_IDS
            unsigned* gate = (unsigned*)(wsl + WS_CTL) + CW_GATE + 64 * (2 * l);
            if (l > 0) {
                if (wave == 0) { for (int m = bx * 64 + lane; m < MP; m += G * 64) rs_from_parts(SSQ, RSS(2 * l), m); }
                else for (int m = MP + bx * (NWAVES - 1) + wave - 1; m < MT; m += G * (NWAVES - 1))
                    resid_parts_row(X1P + (size_t)m * DM, true, PARTG + (size_t)(m - MP) * DM, PG_KS, (size_t)MS * DM, X2P + (size_t)m * DM, RSS(2 * l) + MP + (m - MP) * 32, lane);
                asm volatile("s_waitcnt vmcnt(0)" ::: "memory"); __syncthreads();
                if (TID_NOW() == 0) {
                    const unsigned nloc = bar.st[0], old = xb_add(gate + 1 + bar.x, 1u);
                    if (old + 1u == nloc) { __builtin_amdgcn_fence(__ATOMIC_RELEASE, "agent"); asm volatile("s_waitcnt vmcnt(0)" ::: "memory"); (void)xb_add(gate, nloc); } } }
            const unsigned gtarget = (l > 0) ? (unsigned)G : 0u;
            pg8::Gemm g{(l == 0) ? HB : X2P, WIN_T + (size_t)l * NP * DM, MT, NP, DM, DM}; pg8::StaticOrderG S; S.init(MT, NP, G, bx); S.f = gate; S.target = gtarget; S.pmw = MP / 256; S.ok = false;
            pg8::EpiF32 E{PROJ, NP, RSS(2 * l), MP, gate, gtarget, false};
            _Pragma("unroll 1") for (int rep = 0; rep < REP_PA; ++rep) pg8::gemm_phase<pg8::EpiF32, pg8::StaticOrderG, true, true>(ldsl, g, S, E, tid);
            if (l == 0 && bx >= (MT / 256) * (NP / 256) % G) { SUB_IDS CmpArgs CA{PROJ, cache_kv, page_table, cmp_pe_k, cmp_pe_v, CMPW, wsl, 0};
                compress_pull(CA, lds, (unsigned*)(wsl + WS_CTL) + CW_CMPQ, (volatile LAS int*)(ldsl + MISC_OFF + 36), 1, tid); }
        }
        GRID_BAR(pb + 0);
        if (IN(pb + 1)) { PHASE_IDS
            { SUB_IDS PBArgs A{PROJ, state_conv, conv_w, a_log, dt_bias, QN, KN, VG, GG, BETA, KQ, QB, KS, VS, KW, VW, out, l};
              for (int rep = 0; rep < REP_PB_ROW; ++rep) if (gw >= 128) for (int m = gw - 128; m < MT; m += 2 * (NGW - 128)) {
                  const int m2 = m + (NGW - 128); const bool has2 = m2 < MT; PBRegs r0, r1;
                  pb_row_load(A, m, lane, r0); pb_row_load(A, has2 ? m2 : m, lane, r1);
                  __builtin_amdgcn_sched_barrier(0);
                  pb_row(A, m, lane, r0); if (has2) pb_row(A, m2, lane, r1); }
              for (int u = gw; u < MS * 8; u += NGW) pb_sample_head(A, u, lane); }
            { SUB_IDS GPArgs A{PROJ, conv_w, a_log, dt_bias, GK, GQ, GKT, GVT, GG2, BETA2, l};
              for (int rep = 0; rep < REP_PB_PREP; ++rep) for (int u = gw; u < (MP / 8) * 8; u += 2 * NGW) {
                  GPRegs r0, r1; const int u2 = (u + NGW < (MP / 8) * 8) ? u + NGW : u; gdn_prep_load(A, u, lane, r0); gdn_prep_load(A, u2, lane, r1);
                  __builtin_amdgcn_sched_barrier(0);
                  gdn_prep_unit(A, u, lane, r0); gdn_prep_unit(A, u2, lane, r1); } }
            { SUB_IDS CmpArgs A{PROJ, cache_kv, page_table, cmp_pe_k, cmp_pe_v, CMPW, wsl, l};
              if (bx < 16) compress_batch(A, lds, bx, false, tid);
              compress_pull(A, lds, (unsigned*)(wsl + WS_CTL) + CW_CMPQ + 64 * l, (volatile LAS int*)(ldsl + MISC_OFF + 36), 1 << 20, tid); }
        }
        GRID_BAR(pb + 1);
        if (IN(pb + 2)) { PHASE_IDS
            GCArgs A{GK, GQ, GKT, GVT, GG2, BETA2, WX, QX, QKX, KTX, U0F, GL};
            for (int rep = 0; rep < REP_PB2; ++rep) for (int u = gw; u < 32 * 64; u += NGW) gdn_chunk_unit(A, lds + wave * GC_LDS_PER_WAVE, u, lane);
        }
        GRID_BAR(pb + 2);
        if (IN(pb + 3)) {
            { PHASE_IDS GdnArgs GA{QN, KN, VG, GG, BETA, KQ, OG, PROJ, state_gdn, gdn_norm, MIX, out, l};
                for (int rep = 0; rep < REP_GSMP; ++rep) for (int u = gw; u < NSB * 8; u += NGW) gdn_sample_unit(GA, u, lane); }
            { PHASE_IDS
                GS2Args SG{WX, QX, QKX, KTX, U0F, GL, OG, out, l};
                AttArgs AA{QB, KS, VS, KW, VW, CKP, CVP, PROJ, MIX};
                SAttArgs SA{QB, KS, VS, KW, VW, CKS, CVS, PROJ, cache_kv, page_table, state_win, MIX, l};
                unsigned* qhead = (unsigned*)(wsl + WS_CTL) + CW_QUEUE + 64 * l;
                volatile LAS int* slot = (volatile LAS int*)(ldsl + MISC_OFF + 32);
                for (;;) {
                    __syncthreads();
                    if (tid == 0) *slot = (int)__hip_atomic_fetch_add(qhead, 1u, __ATOMIC_RELAXED, __HIP_MEMORY_SCOPE_AGENT);
                    __syncthreads();
                    int u = *slot;
                    constexpr int XP = (REP_ATTP - 1) * 512, XS = (REP_ATTS - 1) * 256, XG = (REP_SCAN - 1) * 32;
                    if (u >= 800 + XP + XS + XG + 128 + 256) break;
                    if (u >= 800 + XP + XS + XG + 128) {
                        const int j = u - (800 + XP + XS + XG + 128), wv = __builtin_amdgcn_readfirstlane(tid >> 6), ln = tid & 63;
                        pg8::flag_spin((unsigned*)(wsl + WS_CTL) + CW_SCAN + 64 * l + (j >> 6), 8u);
                        const float gnl = gdn_norm[l * 64 + ln];
                        for (int r = 0; r < 8; r += 2) { const int m0 = 64 * j + wv * 8 + r;
                            float ov[2][8], zv[2][8];
#pragma unroll
                            for (int q = 0; q < 2; ++q)
#pragma unroll
                                for (int h = 0; h < 8; ++h) { ov[q][h] = OG[(size_t)(m0 + q) * 512 + h * 64 + ln]; zv[q][h] = PROJ[(size_t)(m0 + q) * NP + C_Z + h * 64 + ln]; }
                            __builtin_amdgcn_sched_barrier(0);
#pragma unroll
                            for (int q = 0; q < 2; ++q)
#pragma unroll
                                for (int h = 0; h < 8; ++h) { const float ms = dpp_sum(ov[q][h] * ov[q][h]) * (1.f / 64.f);
                                    MIX[(size_t)(m0 + q) * 1024 + h * 64 + ln] = (bf16)f2bf(ov[q][h] * (1.f / sqrtf(ms + 1e-6f)) * gnl * siluf_(zv[q][h])); } }
                        continue; }
                    if (u >= 32 && u < 928) { const int g_ = (u - 32) / 7, k_ = (u - 32) % 7;
                        u = (k_ < 4) ? 32 + 4 * g_ + k_ : (k_ < 6) ? 544 + 2 * g_ + (k_ - 4) : 800 + g_; }
                    if (u >= 800 + XP + XS + XG) {
                        const int sb = u - (800 + XP + XS + XG); const f32x4* src = (const f32x4*)(state_win + ((size_t)l * NSB + sb) * 512 * 256) + 256; f32x4* dst = (f32x4*)(out + O_WINS + ((size_t)l * NSB + sb) * 512 * 256);
                        for (int i = tid; i < 508 * 64; i += 8 * NWAVES * 64) { f32x4 v[8];
#pragma unroll
                            for (int k = 0; k < 8; ++k) { const int ii = i + k * NWAVES * 64; v[k] = src[ii < 508 * 64 ? ii : i]; }
#pragma unroll
                            for (int k = 0; k < 8; ++k) { const int ii = i + k * NWAVES * 64; if (ii < 508 * 64) dst[ii] = v[k]; } }
                        continue; }
                    if (u >= 800) { int v = u - 800; if (v < XP) u = 32 + (v & 511); else { v -= XP; if (v < XS) u = 544 + (v & 255); else u = (v - XS) & 31; } }
                    int tq = TID_NOW(); asm volatile("" : "+v"(tq));
                    if (u < 32) { gdn_scan3_block(SG, lds, u, tq);
                        asm volatile("s_waitcnt vmcnt(0)" ::: "memory"); __syncthreads();
                        if (tq == 0) { __builtin_amdgcn_fence(__ATOMIC_RELEASE, "agent"); asm volatile("s_waitcnt vmcnt(0)" ::: "memory"); (void)xb_add((unsigned*)(wsl + WS_CTL) + CW_SCAN + 64 * l + (u >> 3), 1u); } }
                    else if (u < 32 + 512) nsa_prompt_unit(AA, lds, u - 32, tq);
                    else nsa_sample_unit(SA, lds, u - 544, tq);
                }
            }
        }
        GRID_BAR(pb + 3);
        if (IN(pb + 5)) { PHASE_IDS
            { pg8::Gemm g{MIX, WOUT_T + (size_t)l * DM * DM, MP, DM, DM, DM}; pg8::StaticOrder S; S.init(MP, DM, G, bx);
              pg8::EpiResid E{(l == 0) ? (const void*)x_prompt : (const void*)X2P, l != 0, X1, DM, SSQ};
              pg8::gemm_phase<pg8::EpiResid, pg8::StaticOrder, true, true>(ldsl, g, S, E, tid); }
            { pg8::Gemm g{MIX, WOUT_T + (size_t)l * DM * DM, MT, DM, PD_KL, DM}; pg8::SplitKOrder S; S.init(MP / 256, MS / 256, DM / 256, PD_KS, PD_KL, G, bx);
              pg8::EpiPart E{PARTD, DM, MP, MS};
              pg8::gemm_phase<pg8::EpiPart, pg8::SplitKOrder, false, true>(ldsl, g, S, E, tid); }
        }
        GRID_BAR(pb + 5);
        if (IN(pb + 7)) { PHASE_IDS
            unsigned* gate = (unsigned*)(wsl + WS_CTL) + CW_GATE + 64 * (2 * l + 1);
            {
                if (wave == 0) { for (int m = bx * 64 + lane; m < MP; m += G * 64) rs_from_parts(SSQ, RSS(2 * l + 1), m); }
                else for (int m = MP + bx * (NWAVES - 1) + wave - 1; m < MT; m += G * (NWAVES - 1)) { const void* bs = (l == 0) ? (const void*)(x_sample + (size_t)(m - MP) * DM) : (const void*)(X2P + (size_t)m * DM);
                    resid_parts_row(bs, l != 0, PARTD + (size_t)(m - MP) * DM, PD_KS, (size_t)MS * DM, X1 + (size_t)m * DM, RSS(2 * l + 1) + MP + (m - MP) * 32, lane); }
                asm volatile("s_waitcnt vmcnt(0)" ::: "memory"); __syncthreads();
                if (TID_NOW() == 0) {
                    const unsigned nloc = bar.st[0], old = xb_add(gate + 1 + bar.x, 1u);
                    if (old + 1u == nloc) { __builtin_amdgcn_fence(__ATOMIC_RELEASE, "agent"); asm volatile("s_waitcnt vmcnt(0)" ::: "memory"); (void)xb_add(gate, nloc); } } }
            pg8::Gemm g{X1, WUP_T + (size_t)l * DFF * DM, MT, DFF, DM, DM}; pg8::StaticOrderG S; S.init(MT, DFF, G, bx); S.f = gate; S.target = (unsigned)G; S.pmw = MP / 256; S.ok = false;
            pg8::EpiRelu2 E{HID, DFF, RSS(2 * l + 1), MP, gate, (unsigned)G, false};
            pg8::gemm_phase<pg8::EpiRelu2, pg8::StaticOrderG, true, true>(ldsl, g, S, E, tid);
            if (l + 1 < NL && bx >= (MT / 256) * (DFF / 256) % G) { SUB_IDS CmpArgs CA{PROJ, cache_kv, page_table, cmp_pe_k, cmp_pe_v, CMPW, wsl, l + 1};
                compress_pull(CA, lds, (unsigned*)(wsl + WS_CTL) + CW_CMPQ + 64 * (l + 1), (volatile LAS int*)(ldsl + MISC_OFF + 36), 1, tid); }
        }
        GRID_BAR(pb + 7);
        if (IN(pb + 8)) { PHASE_IDS
            { pg8::Gemm g{HID, WDN_T + (size_t)l * DM * DFF, MP, DM, DFF, DFF}; pg8::StaticOrder S; S.init(MP, DM, G, bx);
              pg8::EpiResid E{(const void*)X1, true, X2, DM, SSQ};
              pg8::gemm_phase<pg8::EpiResid, pg8::StaticOrder, true, true>(ldsl, g, S, E, tid); }
            { pg8::Gemm g{HID, WDN_T + (size_t)l * DM * DFF, MT, DM, PG_KL, DFF}; pg8::SplitKOrder S; S.init(MP / 256, MS / 256, DM / 256, PG_KS, PG_KL, G, bx);
              pg8::EpiPart E{PARTG, DM, MP, MS};
              pg8::gemm_phase<pg8::EpiPart, pg8::SplitKOrder, false, true>(ldsl, g, S, E, tid); }
        }
        GRID_BAR(pb + 8);
        if (IN(pb + 9)) { PHASE_IDS
            const float* gn = (l + 1 < NL) ? norm_mix + (size_t)(l + 1) * DM : norm_final; const bool fin = !(l + 1 < NL);
            if (fin) {
            for (int m = gw; m < MP; m += 2 * NGW) { const int m2 = m + NGW;
                if (m2 < MP) rms_row2(X2 + (size_t)m * DM, X2 + (size_t)m2 * DM, true, gn, fin ? nullptr : HB + (size_t)m * DM, fin ? nullptr : HB + (size_t)m2 * DM, fin ? out + O_YP + (size_t)m * DM : nullptr, fin ? out + O_YP + (size_t)m2 * DM : nullptr, lane);
                else rms_row(X2 + (size_t)m * DM, true, gn, fin ? nullptr : HB + (size_t)m * DM, fin ? out + O_YP + (size_t)m * DM : nullptr, lane); }
            for (int m = MP + gw; m < MT; m += NGW)
                rms_row_parts(X1 + (size_t)m * DM, true, PARTG + (size_t)(m - MP) * DM, PG_KS, (size_t)MS * DM, X2 + (size_t)m * DM, gn, fin ? nullptr : HB + (size_t)m * DM, fin ? out + O_YP + (size_t)m * DM : nullptr, lane);
            }
        }
        if (l + 1 == NL) GRID_BAR(pb + 9);
    }
#undef IN
}

#undef x_prompt
#undef x_sample
#undef cache_kv
#undef page_table
#undef state_win
#undef state_gdn
#undef state_conv
#undef norm_mix
#undef w_in
#undef conv_w
#undef a_log
#undef dt_bias
#undef gdn_norm
#undef cmp_pe_k
#undef cmp_w_k
#undef cmp_pe_v
#undef cmp_w_v
#undef w_out
#undef norm_mlp
#undef w_up
#undef w_down
#undef norm_final
#undef out
#ifndef MK_PER_PHASE
#define MK_PER_PHASE 0
#endif
typedef void (*kfn_t)(Args); static const kfn_t K_ALL = hymba_fwd;
extern "C" void kernel_launch(void* const* d_in, const int* in_sizes, int n_in, void* d_out, int out_size, void* d_ws, size_t ws_size, hipStream_t stream) {
    static int grid = 0;
    if (grid == 0) {
        if (n_in != 22 || out_size != (int)O_END || ws_size < WS_END) { fprintf(stderr, "kernel_launch: unexpected shapes (n_in %d, out %d, ws %zu)\n", n_in, out_size, ws_size); grid = -1; return; }
        int dev = 0, cus = 0, per_cu = 0;
        if (hipGetDevice(&dev) != hipSuccess || hipDeviceGetAttribute(&cus, hipDeviceAttributeMultiprocessorCount, dev) != hipSuccess) { grid = -1; return; }
        if (hipFuncSetAttribute((const void*)K_ALL, hipFuncAttributeMaxDynamicSharedMemorySize, LDS_BYTES) != hipSuccess) { fprintf(stderr, "kernel_launch: hipFuncSetAttribute failed\n"); grid = -1; return; }
        if (hipOccupancyMaxActiveBlocksPerMultiprocessor(&per_cu, (const void*)K_ALL, NWAVES * 64, LDS_BYTES) != hipSuccess || per_cu < 1) { fprintf(stderr, "kernel_launch: occupancy query says %d blocks per CU\n", per_cu); }
        (void)hipGetLastError();
        grid = cus;
    }
    if (grid < 0) return;
    (void)hipMemsetAsync((char*)d_ws + WS_CTL, 0, CTL_ZERO_BYTES, stream);
    Args a{};
    for (int i = 0; i < 22; ++i) a.in[i] = (const GAS void*)d_in[i];
    a.out = (GAS float*)d_out; a.ws = (GAS unsigned char*)d_ws;
    const dim3 g(grid), b(NWAVES * 64);
#if MK_PER_PHASE
    for (int ph = 0; ph < N_PHASES; ++ph) { a.ph_lo = ph; a.ph_hi = ph + 1; K_ALL<<<g, b, LDS_BYTES, stream>>>(a); }
#else
    a.ph_lo = 0; a.ph_hi = N_PHASES; K_ALL<<<g, b, LDS_BYTES, stream>>>(a);
#endif
}
```

```cpp
#include <hip/hip_runtime.h>
#include <cstdio>
#include <cstdint>
namespace pg8 {
#define PG8_LAS __attribute__((address_space(3)))
typedef unsigned short bf16_t;
typedef short bf16x8 __attribute__((ext_vector_type(8)));
typedef float f32x4 __attribute__((ext_vector_type(4)));
typedef unsigned u32x4 __attribute__((ext_vector_type(4)));
constexpr int BM = 256, BK = 64, HALF = 128, HTB = HALF * BK * 2  , STAGE_BYTES = 8 * HTB, NXCD = 8, WGM = 8;

__host__ __device__ __forceinline__ int lds_byte(int r, int c) { const int st = (r >> 4) * 2 + (c >> 5), rr = r & 15, cc = c & 31, ob = rr * 64 + cc * 2; return st * 1024 + (ob ^ (((ob >> 9) & 1) << 5)); }
__host__ __device__ __forceinline__ void stage_rc(int b, int& R, int& C) { const int st = b / 1024, sb = b % 1024, swz = sb ^ (((sb >> 9) & 1) << 5); R = (st >> 1) * 16 + swz / 64; C = (st & 1) * 32 + (swz % 64) / 2; }
__host__ __device__ __forceinline__ int perm32(int rho) { const int n = rho >> 4, i = rho & 15; return 8 * (i >> 2) + 4 * n + (i & 3); }

struct Unit { int pm, pn, kofs, kc; };
struct Gemm { const bf16_t* A; const bf16_t* Bt; int M, N, K, ld; };

struct StaticOrder {
    int nM, nN, nwg, G, c;
    __host__ __device__ void init(int M, int N, int G_, int c_) { nM = M / BM; nN = N / BM; nwg = nM * nN; G = G_; c = c_; }
    __host__ __device__ bool next(int i, Unit& u) const {
        const long L = (long)i * G + c; if (L >= nwg) return false;
        int wgid = (int)L; { const int q = nwg / NXCD, r = nwg % NXCD, xcd = wgid % NXCD, off = wgid / NXCD; wgid = (xcd < r ? xcd * (q + 1) : r * (q + 1) + (xcd - r) * q) + off; }
        const int nig = WGM * nN, gid = wgid / nig, fm = gid * WGM, gsz = (nM - fm) < WGM ? (nM - fm) : WGM;
        u.pm = fm + ((wgid % nig) % gsz); u.pn = (wgid % nig) / gsz; u.kofs = 0; u.kc = 0; return true;
    }
    __device__ __forceinline__ void a_ready(const Unit&) const {}
    __device__ __forceinline__ void done(const Unit&) const {}
};

__device__ __forceinline__ void flag_spin(const unsigned* f, unsigned target) {
    unsigned sp = 0;
    while (__hip_atomic_load(f, __ATOMIC_RELAXED, __HIP_MEMORY_SCOPE_AGENT) < target) { __builtin_amdgcn_s_sleep(1); if (++sp > (1u << 21)) break; }
    asm volatile("" ::: "memory"); __builtin_amdgcn_sched_barrier(0);
}
__device__ __forceinline__ void flag_wait(const unsigned* f, unsigned target) {
    flag_spin(f, target);
    __builtin_amdgcn_fence(__ATOMIC_ACQUIRE, "agent");
    asm volatile("s_waitcnt vmcnt(0)" ::: "memory");
}
__device__ __forceinline__ float ld_agent(const float* p) { return __builtin_bit_cast(float, __hip_atomic_load((const unsigned*)p, __ATOMIC_RELAXED, __HIP_MEMORY_SCOPE_AGENT)); }
struct StaticOrderG : StaticOrder {
    const unsigned* f; unsigned target; int pmw; mutable bool ok;
    __device__ __forceinline__ void a_ready(const Unit& u) const { if (u.pm >= pmw && !ok) { flag_spin(f, target); ok = true; } }
};

__device__ __forceinline__ unsigned cvt_pk_bf16(float lo, float hi) { unsigned r; asm volatile("v_cvt_pk_bf16_f32 %0, %1, %2" : "=v"(r) : "v"(lo), "v"(hi)); return r; }

struct EpiF32 {
    static constexpr bool PERM = false, AFTER_DRAIN = false;
    float* O; int ldc; const float* RS; int rsplit; const unsigned* f; unsigned target; mutable bool ok;
    __device__ __forceinline__ void operator()(const f32x4 (&acc)[2][2][4][2], const Unit& u, int wr, int wc, int fr, int fq) const {
        const int row0 = u.pm * BM + wr * 64 + fr, col0 = u.pn * BM + wc * 32 + 4 * fq;
        if (!ok) { flag_spin(f, target); ok = true; }
        float rs[2][4];
#pragma unroll
        for (int ai = 0; ai < 2; ++ai)
#pragma unroll
            for (int m = 0; m < 4; ++m) { const int r_ = row0 + ai * HALF + m * 16; rs[ai][m] = ld_agent(RS + (r_ < rsplit ? r_ : rsplit + (r_ - rsplit) * 32)); }
#pragma unroll
        for (int ai = 0; ai < 2; ++ai)
#pragma unroll
            for (int m = 0; m < 4; ++m) { float* rowp = O + (size_t)(row0 + ai * HALF + m * 16) * ldc + col0;
#pragma unroll
                for (int bj = 0; bj < 2; ++bj)
#pragma unroll
                    for (int n = 0; n < 2; ++n) *(f32x4*)(rowp + bj * HALF + n * 16) = acc[ai][bj][m][n] * rs[ai][m]; }
    }
};
struct EpiResid {
    static constexpr bool PERM = false, AFTER_DRAIN = false;
    const void* base; bool base_bf; bf16_t* O; int ldc; float* SS;
    __device__ __forceinline__ void operator()(const f32x4 (&acc)[2][2][4][2], const Unit& u, int wr, int wc, int fr, int fq) const {
        const int row0 = u.pm * BM + wr * 64 + fr, col0 = u.pn * BM + wc * 32 + 4 * fq;
        typedef unsigned u32x2_ __attribute__((ext_vector_type(2)));
#pragma unroll
        for (int ai = 0; ai < 2; ++ai)
#pragma unroll
            for (int m = 0; m < 4; ++m) { const size_t off = (size_t)(row0 + ai * HALF + m * 16) * ldc + col0; float sq = 0.f;
#pragma unroll
                for (int bj = 0; bj < 2; ++bj)
#pragma unroll
                    for (int n = 0; n < 2; ++n) { const size_t o2 = off + bj * HALF + n * 16; f32x4 r;
                        if (base_bf) { const u32x2_ w = *(const u32x2_*)((const bf16_t*)base + o2);
                            r = (f32x4){__builtin_bit_cast(float, w.x << 16), __builtin_bit_cast(float, w.x & 0xffff0000u), __builtin_bit_cast(float, w.y << 16), __builtin_bit_cast(float, w.y & 0xffff0000u)}; }
                        else r = *(const f32x4*)((const float*)base + o2);
                        r += acc[ai][bj][m][n];
                        u32x2_ ow; ow.x = cvt_pk_bf16(r[0], r[1]); ow.y = cvt_pk_bf16(r[2], r[3]); *(u32x2_*)(O + o2) = ow;
                        const float q0 = __builtin_bit_cast(float, ow.x << 16), q1 = __builtin_bit_cast(float, ow.x & 0xffff0000u), q2 = __builtin_bit_cast(float, ow.y << 16), q3 = __builtin_bit_cast(float, ow.y & 0xffff0000u);
                        sq += (q0 * q0 + q1 * q1) + (q2 * q2 + q3 * q3); }
                sq += __shfl_xor(sq, 16); sq += __shfl_xor(sq, 32);
                if (fq == 0) SS[(size_t)(row0 + ai * HALF + m * 16) * 16 + u.pn * 4 + wc] = sq; }
    }
};
struct EpiRelu2 {
    static constexpr bool PERM = true, AFTER_DRAIN = false;
    bf16_t* O; int ldc; const float* RS; int rsplit; const unsigned* f; unsigned target; mutable bool ok;
    __device__ __forceinline__ void operator()(const f32x4 (&acc)[2][2][4][2], const Unit& u, int wr, int wc, int fr, int fq) const {
        const int row0 = u.pm * BM + wr * 64 + fr, col0 = u.pn * BM + wc * 32 + 8 * fq;
        if (!ok) { flag_spin(f, target); ok = true; }
        float rs[2][4];
#pragma unroll
        for (int ai = 0; ai < 2; ++ai)
#pragma unroll
            for (int m = 0; m < 4; ++m) { const int r_ = row0 + ai * HALF + m * 16; rs[ai][m] = ld_agent(RS + (r_ < rsplit ? r_ : rsplit + (r_ - rsplit) * 32)); }
#pragma unroll
        for (int ai = 0; ai < 2; ++ai)
#pragma unroll
            for (int m = 0; m < 4; ++m) { bf16_t* rowp = O + (size_t)(row0 + ai * HALF + m * 16) * ldc + col0;
#pragma unroll
                for (int bj = 0; bj < 2; ++bj) { f32x4 v0 = acc[ai][bj][m][0] * rs[ai][m], v1 = acc[ai][bj][m][1] * rs[ai][m];
#pragma unroll
                    for (int i = 0; i < 4; ++i) { const float a = v0[i] > 0.f ? v0[i] : 0.f, b = v1[i] > 0.f ? v1[i] : 0.f; v0[i] = a * a; v1[i] = b * b; }
                    u32x4 w; w.x = cvt_pk_bf16(v0[0], v0[1]); w.y = cvt_pk_bf16(v0[2], v0[3]); w.z = cvt_pk_bf16(v1[0], v1[1]); w.w = cvt_pk_bf16(v1[2], v1[3]);
                    *(u32x4*)(rowp + bj * HALF) = w; } }
    }
};

struct SplitKOrder {
    int pm0, nN, KS, KL, total, G, c;
    __host__ __device__ void init(int pm0_, int nPm, int nN_, int KS_, int KL_, int G_, int c_) { pm0 = pm0_; nN = nN_; KS = KS_; KL = KL_; total = nPm * nN_ * KS_; G = G_; c = c_; }
    __host__ __device__ bool next(int i, Unit& u) const {
        const long L = (long)i * G + c; if (L >= total) return false;
        const int l = (int)L, kc = l % KS, rest = l / KS; u.pn = rest % nN; u.pm = pm0 + rest / nN; u.kofs = kc * KL; u.kc = kc; return true; }
    __device__ __forceinline__ void a_ready(const Unit&) const {}
    __device__ __forceinline__ void done(const Unit&) const {}
};
struct EpiPart {
    static constexpr bool PERM = false, AFTER_DRAIN = false;
    float* P; int ldc; int row0; int rows;
    __device__ __forceinline__ void operator()(const f32x4 (&acc)[2][2][4][2], const Unit& u, int wr, int wc, int fr, int fq) const {
        const int rowl = u.pm * BM - row0 + wr * 64 + fr, col0 = u.pn * BM + wc * 32 + 4 * fq;
        float* base = P + (size_t)u.kc * rows * ldc;
#pragma unroll
        for (int ai = 0; ai < 2; ++ai)
#pragma unroll
            for (int m = 0; m < 4; ++m) { float* rowp = base + (size_t)(rowl + ai * HALF + m * 16) * ldc + col0;
#pragma unroll
                for (int bj = 0; bj < 2; ++bj)
#pragma unroll
                    for (int n = 0; n < 2; ++n) *(f32x4*)(rowp + bj * HALF + n * 16) = acc[ai][bj][m][n]; }
    }
};
template <class Epi, class Sched, bool ALIGN_EPI = false, bool SP2 = false>
__device__ __forceinline__ void gemm_phase(PG8_LAS unsigned char* lds, const Gemm g, const Sched& S, const Epi& E, int tid_in) {
    int tid = tid_in; asm volatile("" : "+v"(tid));
    const int wid = __builtin_amdgcn_readfirstlane(tid >> 6), lane = tid & 63, wr = wid >> 2, wc = wid & 3, fr = lane & 15, fq = lane >> 4;
    const int K = g.ld, nt = g.K / BK;
    unsigned voffA[2], voffB[2];
#pragma unroll
    for (int i = 0; i < 2; ++i) { int R, C; stage_rc(tid * 16 + i * 8192, R, C); const int Rb = Epi::PERM ? ((R & ~31) + perm32(R & 31)) : R;
        voffA[i] = (unsigned)(R * K + C) * 2u; voffB[i] = (unsigned)(Rb * K + C) * 2u; }
    const size_t kstep = (size_t)(BK * 2);
    const size_t hstep = (size_t)HALF * K * 2;
    const size_t tstep = 2 * hstep;
    const unsigned ldsw = (unsigned)wid * 1024u;
    const int aoff = lds_byte(wr * 64 + fr, fq * 8), boff = lds_byte(wc * 32 + fr, fq * 8);
#define PG8_SA(b, h) (((b) * 2 + (h)) * HTB)
#define PG8_SB(b, h) ((4 + (b) * 2 + (h)) * HTB)
#define PG8_STAGE(bufoff, gbase, voff) do { _Pragma("unroll") for (int _i = 0; _i < 2; ++_i) \
        __builtin_amdgcn_global_load_lds((const unsigned*)((const char*)(gbase) + (voff)[_i]), (PG8_LAS unsigned*)(lds + (bufoff) + ldsw + _i * 8192), 16, 0, 0); } while (0)
#define PG8_LDA(dst, b, h) do { _Pragma("unroll") for (int m = 0; m < 4; ++m) _Pragma("unroll") for (int k = 0; k < 2; ++k) dst[m][k] = *(const PG8_LAS bf16x8*)(lds + PG8_SA(b, h) + aoff + m * 2048 + k * 1024); } while (0)
#define PG8_LDB(dst, b, h) do { _Pragma("unroll") for (int n = 0; n < 2; ++n) _Pragma("unroll") for (int k = 0; k < 2; ++k) dst[n][k] = *(const PG8_LAS bf16x8*)(lds + PG8_SB(b, h) + boff + n * 2048 + k * 1024); } while (0)
#define PG8_MMA(ai, bj, At, Bt) do { __builtin_amdgcn_s_setprio(1); _Pragma("unroll") for (int m = 0; m < 4; ++m) _Pragma("unroll") for (int n = 0; n < 2; ++n) _Pragma("unroll") for (int k = 0; k < 2; ++k) \
        acc[ai][bj][m][n] = __builtin_amdgcn_mfma_f32_16x16x32_bf16(Bt[n][k], At[m][k], acc[ai][bj][m][n], 0, 0, 0); __builtin_amdgcn_s_setprio(0); } while (0)
#define PG8_WAIT_V(n) asm volatile("s_waitcnt vmcnt(" #n ")" ::: "memory")
#define PG8_WAIT_L(n) asm volatile("s_waitcnt lgkmcnt(" #n ")" ::: "memory")
#define PG8_BAR __builtin_amdgcn_s_barrier()
#define PG8_SCHED __builtin_amdgcn_sched_barrier(0)
    Unit cur, nxt; int ui = 0;
    if (!S.next(0, cur)) return;
    f32x4 acc[2][2][4][2];
#pragma unroll
    for (int a = 0; a < 2; ++a)
#pragma unroll
        for (int b = 0; b < 2; ++b)
#pragma unroll
            for (int m = 0; m < 4; ++m)
#pragma unroll
                for (int n = 0; n < 2; ++n) acc[a][b][m][n] = (f32x4){0.f, 0.f, 0.f, 0.f};
    bf16x8 At[4][2], B0[2][2], B1[2][2];
    const char* cA = (const char*)g.A + (size_t)cur.pm * tstep + (size_t)cur.kofs * 2; const char* cB = (const char*)g.Bt + (size_t)cur.pn * tstep + (size_t)cur.kofs * 2;
    S.a_ready(cur);
    if constexpr (SP2) {
        PG8_STAGE(PG8_SB(0, 0), cB, voffB); PG8_STAGE(PG8_SB(0, 1), cB + hstep, voffB); PG8_STAGE(PG8_SA(0, 0), cA, voffA); PG8_STAGE(PG8_SA(0, 1), cA + hstep, voffA);
        if (wr == 1) PG8_BAR;
        PG8_WAIT_V(2); PG8_BAR;
        PG8_STAGE(PG8_SB(1, 0), cB + kstep, voffB); PG8_STAGE(PG8_SA(1, 0), cA + kstep, voffA); PG8_STAGE(PG8_SB(1, 1), cB + hstep + kstep, voffB);
        PG8_WAIT_V(6); PG8_BAR;
    } else {
        PG8_STAGE(PG8_SB(0, 0), cB, voffB); PG8_STAGE(PG8_SA(0, 0), cA, voffA); PG8_STAGE(PG8_SB(0, 1), cB + hstep, voffB); PG8_STAGE(PG8_SA(0, 1), cA + hstep, voffA);
        if (wr == 1) PG8_BAR;
        PG8_WAIT_V(4); PG8_BAR;
        PG8_STAGE(PG8_SB(1, 0), cB + kstep, voffB); PG8_STAGE(PG8_SA(1, 0), cA + kstep, voffA); PG8_STAGE(PG8_SB(1, 1), cB + hstep + kstep, voffB);
        PG8_WAIT_V(6); PG8_BAR;
    }
    for (;;) {
        const bool has_next = S.next(ui + 1, nxt);
        const char* nA = has_next ? (const char*)g.A + (size_t)nxt.pm * tstep + (size_t)nxt.kofs * 2 : cA; const char* nB = has_next ? (const char*)g.Bt + (size_t)nxt.pn * tstep + (size_t)nxt.kofs * 2 : cB;
        for (int t = 0; t < nt; t += 2) {
            const bool last = (t == nt - 2);
            const char* a1 = cA + (size_t)(t + 1) * kstep;
            const char* a2 = last ? nA : cA + (size_t)(t + 2) * kstep; const char* b2 = last ? nB : cB + (size_t)(t + 2) * kstep;
            const char* a3 = a2 + kstep; const char* b3 = b2 + kstep;
            if (last && has_next) S.a_ready(nxt);
            if constexpr (SP2) {
            PG8_LDB(B0, 0, 0); PG8_LDB(B1, 0, 1); PG8_SCHED; PG8_LDA(At, 0, 0); PG8_STAGE(PG8_SA(1, 1), a1 + hstep, voffA);
            PG8_WAIT_V(8); PG8_WAIT_L(0); PG8_BAR; PG8_MMA(0, 0, At, B0); PG8_MMA(0, 1, At, B1); PG8_BAR; PG8_SCHED;
            PG8_LDA(At, 0, 1); PG8_STAGE(PG8_SB(0, 0), b2, voffB); PG8_STAGE(PG8_SB(0, 1), b2 + hstep, voffB); PG8_STAGE(PG8_SA(0, 0), a2, voffA);
            PG8_WAIT_V(8); PG8_WAIT_L(0); PG8_BAR; PG8_MMA(1, 0, At, B0); PG8_MMA(1, 1, At, B1); PG8_BAR; PG8_SCHED;
            PG8_LDB(B0, 1, 0); PG8_LDB(B1, 1, 1); PG8_SCHED; PG8_LDA(At, 1, 0); PG8_STAGE(PG8_SA(0, 1), a2 + hstep, voffA);
            PG8_WAIT_V(8); PG8_WAIT_L(0); PG8_BAR; PG8_MMA(0, 0, At, B0); PG8_MMA(0, 1, At, B1); PG8_BAR; PG8_SCHED;
            PG8_LDA(At, 1, 1); PG8_STAGE(PG8_SB(1, 0), b3, voffB); PG8_STAGE(PG8_SB(1, 1), b3 + hstep, voffB); PG8_STAGE(PG8_SA(1, 0), a3, voffA);
            PG8_WAIT_V(8); PG8_WAIT_L(0); PG8_BAR; PG8_MMA(1, 0, At, B0); PG8_MMA(1, 1, At, B1); PG8_BAR; PG8_SCHED;
            } else {
            PG8_LDB(B0, 0, 0); PG8_SCHED; PG8_LDA(At, 0, 0); PG8_STAGE(PG8_SA(1, 1), a1 + hstep, voffA);
            PG8_WAIT_L(8); PG8_BAR; PG8_WAIT_L(0); PG8_MMA(0, 0, At, B0); PG8_BAR; PG8_SCHED;
            PG8_LDB(B1, 0, 1); PG8_STAGE(PG8_SB(0, 0), b2, voffB);
            PG8_BAR; PG8_WAIT_L(0); PG8_MMA(0, 1, At, B1); PG8_BAR;
            PG8_LDA(At, 0, 1); PG8_STAGE(PG8_SA(0, 0), a2, voffA);
            PG8_BAR; PG8_WAIT_L(0); PG8_MMA(1, 0, At, B0); PG8_BAR; PG8_SCHED;
            PG8_STAGE(PG8_SB(0, 1), b2 + hstep, voffB);
            PG8_WAIT_V(6); PG8_BAR; PG8_MMA(1, 1, At, B1); PG8_BAR;
            PG8_LDB(B0, 1, 0); PG8_SCHED; PG8_LDA(At, 1, 0); PG8_STAGE(PG8_SA(0, 1), a2 + hstep, voffA);
            PG8_WAIT_L(8); PG8_BAR; PG8_WAIT_L(0); PG8_MMA(0, 0, At, B0); PG8_BAR; PG8_SCHED;
            PG8_LDB(B1, 1, 1); PG8_STAGE(PG8_SB(1, 0), b3, voffB);
            PG8_BAR; PG8_WAIT_L(0); PG8_MMA(0, 1, At, B1); PG8_BAR;
            PG8_LDA(At, 1, 1); PG8_STAGE(PG8_SA(1, 0), a3, voffA);
            PG8_BAR; PG8_WAIT_L(0); PG8_MMA(1, 0, At, B0); PG8_BAR; PG8_SCHED;
            PG8_STAGE(PG8_SB(1, 1), b3 + hstep, voffB);
            PG8_WAIT_V(6); PG8_BAR; PG8_MMA(1, 1, At, B1); PG8_BAR;
            }
        }
        if constexpr (ALIGN_EPI) { if (wr == 0) PG8_BAR; }
        if constexpr (!Epi::AFTER_DRAIN) { E(acc, cur, wr, wc, fr, fq); S.done(cur); }
        if (!has_next) break;
#pragma unroll
        for (int a = 0; a < 2; ++a)
#pragma unroll
            for (int b = 0; b < 2; ++b)
#pragma unroll
                for (int m = 0; m < 4; ++m)
#pragma unroll
                    for (int n = 0; n < 2; ++n) acc[a][b][m][n] = (f32x4){0.f, 0.f, 0.f, 0.f};
        cur = nxt; cA = nA; cB = nB; ++ui;
        if constexpr (ALIGN_EPI) { if (wr == 1) PG8_BAR; }
    }
    PG8_WAIT_V(0);
    if constexpr (!ALIGN_EPI) { if (wr == 0) PG8_BAR; }
    PG8_BAR;
    if constexpr (Epi::AFTER_DRAIN) { E.fused(acc, cur, wr, wc, fr, fq, lds, wid, lane); S.done(cur); }
#undef PG8_SA
#undef PG8_SB
#undef PG8_STAGE
#undef PG8_LDA
#undef PG8_LDB
#undef PG8_MMA
#undef PG8_WAIT_V
#undef PG8_WAIT_L
#undef PG8_BAR
#undef PG8_SCHED
}
}

constexpr int DM = 1024, NPB = 4, SEQ = 4096, MP = NPB * SEQ, NSB = 128, DSEQ = 4, MS = NSB * DSEQ, MT = MP + MS;
constexpr int NPROJ = 3368, NP = 3584, DFF = 4096, NL = 2;
constexpr int C_QKV = 0, C_Z = 1536, C_A = 2048, C_BETA = 2056, C_Q = 2064, C_KV = 2576, C_GATE = 3344;
constexpr int PAST = 2048, NPAGES = 16, NPOOL = 2560;
constexpr float C2 = 0.125f * 1.4426950408889634f;
constexpr float NEG_INF = -__builtin_inff();
constexpr size_t O_YP = 0, O_YS = 16777216, O_KVP = 17301504, O_KVS = 34078720, O_WINP = 34603008, O_WINS = 35651584, O_GDNP = 69206016, O_GDNS = 69468160, O_CONVP = 77856768, O_CONVS = 77893632, O_END = 79073280;
constexpr size_t MiB = 1u << 20;
constexpr size_t WS_CTL = 0, CTL_ZERO_BYTES = 1 * MiB;
constexpr size_t WS_WIN = 2 * MiB, WS_WOUT = 16 * MiB, WS_WUP = 20 * MiB, WS_WDN = 36 * MiB, WS_CMPW = 52 * MiB;
constexpr size_t WS_HB = 54 * MiB, WS_PROJ = 88 * MiB, WS_X1 = 320 * MiB, WS_X2 = 386 * MiB, WS_MIX = 452 * MiB, WS_HID = 486 * MiB;
constexpr size_t WS_QN = 618 * MiB, WS_KN = 651 * MiB, WS_VG = 684 * MiB, WS_OG = 717 * MiB, WS_G = 750 * MiB, WS_BETA = 751 * MiB, WS_KQ = 752 * MiB;
constexpr size_t WS_QB = 753 * MiB, WS_KS = 770 * MiB, WS_VS = 775 * MiB, WS_KW = 780 * MiB, WS_VW = 785 * MiB;
constexpr size_t WS_CKP = 790 * MiB, WS_CVP = 791 * MiB, WS_CKS = 792 * MiB, WS_CVS = 796 * MiB;
constexpr size_t WS_GK = 800 * MiB, WS_GQ = 816 * MiB, WS_GKT = 832 * MiB, WS_GVT = 848 * MiB, WS_GG2 = 864 * MiB, WS_BETA2 = 865 * MiB;
constexpr size_t WS_WX = 866 * MiB, WS_QX = 882 * MiB, WS_QKX = 898 * MiB, WS_KTX = 914 * MiB, WS_U0F = 930 * MiB, WS_GL = 962 * MiB, WS_END = 1043 * MiB;
constexpr size_t WS_PARTD = 963 * MiB, WS_PARTG = 979 * MiB;
constexpr size_t WS_OG2 = 1000 * MiB;
constexpr size_t WS_SS = 996 * MiB, WS_RS = 998 * MiB;
constexpr int PD_KS = 4, PD_KL = DM / PD_KS, PG_KS = 8, PG_KL = DFF / PG_KS;
constexpr int CW_QUEUE = 64;
constexpr int CW_BAR = 4096;
constexpr size_t XL_BYTES = (size_t)MT * DM * 2;
constexpr int RS_STRIDE = MP + MS * 32;
constexpr int CW_SCAN = 768;
constexpr int CW_GATE = 512;
constexpr int RING_BYTES = 131072, LDS_BYTES = 147456, MISC_OFF = LDS_BYTES - 64;
constexpr int NWAVES = 8;

#define GAS __attribute__((address_space(1)))
#define LAS __attribute__((address_space(3)))
typedef unsigned short bf16;
typedef unsigned v4u __attribute__((ext_vector_type(4)));
typedef unsigned v2u __attribute__((ext_vector_type(2)));
typedef float f32x4 __attribute__((ext_vector_type(4)));
typedef float f32x16 __attribute__((ext_vector_type(16)));
typedef short bf16x8 __attribute__((ext_vector_type(8)));
typedef short s16x4 __attribute__((ext_vector_type(4)));
#define LDS_WAIT() asm volatile("s_waitcnt lgkmcnt(0)" ::: "memory")
__device__ __forceinline__ unsigned f2bf(float f) { unsigned u = __builtin_bit_cast(unsigned, f); return (u + 0x7fffu + ((u >> 16) & 1u)) >> 16; }
typedef float f32x2_t_ __attribute__((ext_vector_type(2))); typedef __bf16 bf16x2_t_ __attribute__((ext_vector_type(2)));
__device__ __forceinline__ unsigned pk2(float lo, float hi) { const f32x2_t_ v = {lo, hi}; const bf16x2_t_ b = __builtin_convertvector(v, bf16x2_t_); return __builtin_bit_cast(unsigned, b); }
__device__ __forceinline__ float bf2f(unsigned short b) { return __builtin_bit_cast(float, (unsigned)b << 16); }
__device__ __forceinline__ bf16x8 pack8(float a0, float a1, float a2, float a3, float a4, float a5, float a6, float a7) {
    v4u w; w.x = pk2(a0, a1); w.y = pk2(a2, a3); w.z = pk2(a4, a5); w.w = pk2(a6, a7); return __builtin_bit_cast(bf16x8, w); }
__device__ __forceinline__ float wave_sum(float v) {
#pragma unroll
    for (int o = 1; o < 64; o <<= 1) v += __shfl_xor(v, o);
    return v;
}
template <int CTRL, int RMASK> __device__ __forceinline__ float dpp_add(float v) {
    const int t = __builtin_amdgcn_update_dpp(0, __builtin_bit_cast(int, v), CTRL, RMASK, 0xf, false);
    return v + __builtin_bit_cast(float, t);
}
__device__ __forceinline__ float dpp_sum(float v) {
    v = dpp_add<0x111, 0xf>(v); v = dpp_add<0x112, 0xf>(v); v = dpp_add<0x114, 0xf>(v); v = dpp_add<0x118, 0xf>(v);
    v = dpp_add<0x142, 0xa>(v); v = dpp_add<0x143, 0xc>(v);
    return __builtin_bit_cast(float, __builtin_amdgcn_readlane(__builtin_bit_cast(int, v), 63));
}
__device__ __forceinline__ float ex2(float x) { return __builtin_amdgcn_exp2f(x); }
__device__ __forceinline__ float sigmoidf_(float x) { return 1.f / (1.f + __expf(-x)); }
__device__ __forceinline__ float siluf_(float x) { return x / (1.f + __expf(-x)); }
__device__ __forceinline__ int crow(int r, int hi) { return (r & 3) + 8 * (r >> 2) + 4 * hi; }
__device__ __forceinline__ void rope_cs(int pos, int d, float& cs, float& sn) {
    const float invf = exp2f(-(float)d * 0.4152410118609203f);
    double rv = (double)pos * (double)invf * 0.15915494309189535; rv -= floor(rv);
    const float rf = (float)rv; sn = __builtin_amdgcn_sinf(rf); cs = __builtin_amdgcn_cosf(rf);
}

#define XB_TMO      128
#define XB_XCNT(j)  (256  + 64 * (j))
#define XB_XSUB(j)  (1280 + 64 * (j))
#define XB_XGEN(j)  (2304 + 64 * (j))
#define XB_TOP      3328
#define XB_TOPGEN   3392
#define XCD_BAR_WORDS 3456
#define XB_SPIN_CAP (1u << 18)

__device__ __forceinline__ unsigned xb_ld(unsigned* p)              { return __hip_atomic_load(p, __ATOMIC_RELAXED, __HIP_MEMORY_SCOPE_AGENT); }
__device__ __forceinline__ unsigned xb_add(unsigned* p, unsigned v) { return __hip_atomic_fetch_add(p, v, __ATOMIC_RELAXED, __HIP_MEMORY_SCOPE_AGENT); }
__device__ __forceinline__ unsigned xb_xcc_id() { return (unsigned)__builtin_amdgcn_s_getreg((3 << 11) | 20) & 0xFu; }
#define XB_SPIN(cond, bar) do { unsigned _sp = 0; while (cond) { __builtin_amdgcn_s_sleep(1); \
    if ((++_sp & 255u) == 0u) { if (xb_ld(&(bar)[XB_TMO])) break; if (_sp > XB_SPIN_CAP) { atomicAdd(&(bar)[XB_TMO], 1u); break; } } } } while (0)

struct XcdBarrier {
    unsigned* bar; unsigned x;
    volatile LAS unsigned* st;
};

__device__ __forceinline__ XcdBarrier xcd_barrier_post(unsigned* bar, volatile LAS unsigned* st, bool leader) {
    XcdBarrier b; b.bar = bar; b.x = xb_xcc_id(); b.st = st;
    if (leader) (void)xb_add(&bar[XB_XCNT(b.x)], 1u);
    return b;
}
__device__ __forceinline__ void xcd_barrier_complete(unsigned* bar, unsigned x, unsigned& nloc, unsigned& nx) {
    const unsigned G = gridDim.x * gridDim.y * gridDim.z;
    unsigned sum, cnt, mine, sp = 0u;
    for (;;) {
        sum = 0u; cnt = 0u; mine = 0u;
#pragma unroll
        for (unsigned j = 0; j < 16; ++j) { const unsigned c = xb_ld(&bar[XB_XCNT(j)]); sum += c; cnt += (c > 0u) ? 1u : 0u; mine = (j == x) ? c : mine; }
        if (sum == G) break;
        __builtin_amdgcn_s_sleep(1);
        if ((++sp & 255u) == 0u) { if (xb_ld(&bar[XB_TMO])) break; if (sp > XB_SPIN_CAP) { atomicAdd(&bar[XB_TMO], 1u); break; } }
    }
    nloc = mine > 0u ? mine : 1u; nx = cnt > 0u ? cnt : 1u;
}

__device__ __forceinline__ void xcd_barrier(const XcdBarrier& b, bool leader) {
    asm volatile("s_waitcnt vmcnt(0)" ::: "memory");
    __syncthreads();
    if (leader) {
        unsigned* bar = b.bar;
        __builtin_amdgcn_s_waitcnt(0);
        unsigned nloc = b.st[0], nx = b.st[1];
        if (nloc == 0u) { xcd_barrier_complete(bar, b.x, nloc, nx); b.st[0] = nloc; b.st[1] = nx; }
        const unsigned old = xb_add(&bar[XB_XSUB(b.x)], 1u);
        const unsigned gen = old / nloc;
        if (old + 1u == (gen + 1u) * nloc) {
            __builtin_amdgcn_fence(__ATOMIC_RELEASE, "agent");
            asm volatile("s_waitcnt vmcnt(0)" ::: "memory");
            const unsigned og = xb_add(&bar[XB_TOP], 1u);
            const unsigned tg = og / nx;
            if (og + 1u == (tg + 1u) * nx) xb_add(&bar[XB_TOPGEN], 1u);
            else XB_SPIN(xb_ld(&bar[XB_TOPGEN]) == tg, bar);
            __builtin_amdgcn_fence(__ATOMIC_ACQUIRE, "agent");
            xb_add(&bar[XB_XGEN(b.x)], 1u);
            asm volatile("s_waitcnt vmcnt(0)" ::: "memory");
        } else {
            XB_SPIN(xb_ld(&bar[XB_XGEN(b.x)]) == gen, bar);
            __builtin_amdgcn_fence(__ATOMIC_ACQUIRE, "agent");
            asm volatile("s_waitcnt vmcnt(0)" ::: "memory");
        }
    }
    __syncthreads();
}

__device__ __forceinline__ void transpose_item(const float* W, int K, int N, int Npad, bf16* WT, LAS float* scr, int item, int lane, const float* gk = nullptr) {
    const int nblk = Npad / 32, kb = item / nblk, nb = item % nblk, k0 = 64 * kb, n0 = 32 * nb;
    const int ncol = n0 + (lane & 31);
    float wv_[32];
#pragma unroll
    for (int i = 0; i < 32; ++i) { const int kk = 2 * i + (lane >> 5); wv_[i] = (ncol < N) ? W[(size_t)(k0 + kk) * N + ncol] : 0.f; }
    __builtin_amdgcn_sched_barrier(0);
#pragma unroll
    for (int i = 0; i < 32; ++i) { const int kk = 2 * i + (lane >> 5); scr[kk * 33 + (lane & 31)] = wv_[i]; }
    LDS_WAIT(); asm volatile("" ::: "memory");
    const int c = lane & 7;
    f32x4 g0 = {1.f, 1.f, 1.f, 1.f}, g1 = g0;
    if (gk) { g0 = *(const f32x4*)(gk + k0 + 8 * c); g1 = *(const f32x4*)(gk + k0 + 8 * c + 4); }
#pragma unroll
    for (int j = 0; j < 4; ++j) { const int n = (lane >> 3) + 8 * j; const LAS float* s = scr + (8 * c) * 33 + n;
        v4u o; o.x = pk2(s[0 * 33] * g0.x, s[1 * 33] * g0.y); o.y = pk2(s[2 * 33] * g0.z, s[3 * 33] * g0.w); o.z = pk2(s[4 * 33] * g1.x, s[5 * 33] * g1.y); o.w = pk2(s[6 * 33] * g1.z, s[7 * 33] * g1.w);
        *(v4u*)(WT + (size_t)(n0 + n) * K + k0 + 8 * c) = o; }
    LDS_WAIT(); asm volatile("" ::: "memory");
}
__device__ __forceinline__ f32x4 ld4x(const void* row, int i, bool bf) {
    if (bf) { const v2u w = ((const v2u*)row)[i]; return (f32x4){bf2f((unsigned short)(w.x & 0xffffu)), bf2f((unsigned short)(w.x >> 16)), bf2f((unsigned short)(w.y & 0xffffu)), bf2f((unsigned short)(w.y >> 16))}; }
    return ((const f32x4*)row)[i]; }
__device__ __forceinline__ void rms_row(const void* xrow, bool bf, const float* g, bf16* orow, float* of32, int lane) {
    f32x4 v[4]; float s = 0.f;
#pragma unroll
    for (int j = 0; j < 4; ++j) { v[j] = ld4x(xrow, 64 * j + lane, bf); s += (v[j].x * v[j].x + v[j].y * v[j].y) + (v[j].z * v[j].z + v[j].w * v[j].w); }
    const float rstd = 1.f / sqrtf(wave_sum(s) * (1.f / DM) + 1e-6f);
#pragma unroll
    for (int j = 0; j < 4; ++j) { const f32x4 gg = ((const f32x4*)g)[64 * j + lane]; const f32x4 o = v[j] * rstd * gg;
        if (of32) ((f32x4*)of32)[64 * j + lane] = o;
        else ((v2u*)orow)[64 * j + lane] = (v2u){pk2(o.x, o.y), pk2(o.z, o.w)}; }
}

__device__ __forceinline__ void rms_row2(const void* xa, const void* xb, bool bf, const float* g, bf16* oa, bf16* ob, float* fa, float* fb, int lane) {
    f32x4 va[4], vb[4];
#pragma unroll
    for (int j = 0; j < 4; ++j) { va[j] = ld4x(xa, 64 * j + lane, bf); vb[j] = ld4x(xb, 64 * j + lane, bf); }
    __builtin_amdgcn_sched_barrier(0);
    float sa = 0.f, sb = 0.f;
#pragma unroll
    for (int j = 0; j < 4; ++j) { sa += (va[j].x * va[j].x + va[j].y * va[j].y) + (va[j].z * va[j].z + va[j].w * va[j].w); sb += (vb[j].x * vb[j].x + vb[j].y * vb[j].y) + (vb[j].z * vb[j].z + vb[j].w * vb[j].w); }
    const float ra = 1.f / sqrtf(wave_sum(sa) * (1.f / DM) + 1e-6f), rb = 1.f / sqrtf(wave_sum(sb) * (1.f / DM) + 1e-6f);
#pragma unroll
    for (int j = 0; j < 4; ++j) { const f32x4 gg = ((const f32x4*)g)[64 * j + lane]; const f32x4 o1 = va[j] * ra * gg, o2 = vb[j] * rb * gg;
        if (fa) { ((f32x4*)fa)[64 * j + lane] = o1; ((f32x4*)fb)[64 * j + lane] = o2; }
        else { ((v2u*)oa)[64 * j + lane] = (v2u){pk2(o1.x, o1.y), pk2(o1.z, o1.w)}; ((v2u*)ob)[64 * j + lane] = (v2u){pk2(o2.x, o2.y), pk2(o2.z, o2.w)}; } }
}
__device__ __forceinline__ void rms_row_parts(const void* base, bool bf, const float* parts, int nparts, size_t part_stride, bf16* xout, const float* g, bf16* orow, float* of32, int lane) {
    f32x4 v[4]; float s = 0.f;
#pragma unroll
    for (int j = 0; j < 4; ++j) v[j] = ld4x(base, 64 * j + lane, bf);
    for (int p = 0; p < nparts; ++p) { const f32x4* pr = (const f32x4*)(parts + (size_t)p * part_stride) + lane;
#pragma unroll
        for (int j = 0; j < 4; ++j) v[j] += pr[64 * j]; }
#pragma unroll
    for (int j = 0; j < 4; ++j) { if (xout) ((v2u*)xout)[64 * j + lane] = (v2u){pk2(v[j].x, v[j].y), pk2(v[j].z, v[j].w)}; s += (v[j].x * v[j].x + v[j].y * v[j].y) + (v[j].z * v[j].z + v[j].w * v[j].w); }
    const float rstd = 1.f / sqrtf(wave_sum(s) * (1.f / DM) + 1e-6f);
#pragma unroll
    for (int j = 0; j < 4; ++j) { const f32x4 gg = ((const f32x4*)g)[64 * j + lane]; const f32x4 o = v[j] * rstd * gg;
        if (of32) ((f32x4*)of32)[64 * j + lane] = o;
        else ((v2u*)orow)[64 * j + lane] = (v2u){pk2(o.x, o.y), pk2(o.z, o.w)}; }
}

__device__ __forceinline__ void resid_parts_row(const void* base, bool bf, const float* parts, int nparts, size_t part_stride, bf16* xout, float* rs, int lane) {
    f32x4 v[4]; float s = 0.f;
#pragma unroll
    for (int j = 0; j < 4; ++j) v[j] = ld4x(base, 64 * j + lane, bf);
    for (int p = 0; p < nparts; ++p) { const f32x4* pr = (const f32x4*)(parts + (size_t)p * part_stride) + lane;
#pragma unroll
        for (int j = 0; j < 4; ++j) v[j] += pr[64 * j]; }
#pragma unroll
    for (int j = 0; j < 4; ++j) { const unsigned w0 = pk2(v[j].x, v[j].y), w1 = pk2(v[j].z, v[j].w); ((v2u*)xout)[64 * j + lane] = (v2u){w0, w1};
        const float q0 = bf2f((unsigned short)(w0 & 0xffffu)), q1 = bf2f((unsigned short)(w0 >> 16)), q2 = bf2f((unsigned short)(w1 & 0xffffu)), q3 = bf2f((unsigned short)(w1 >> 16));
        s += (q0 * q0 + q1 * q1) + (q2 * q2 + q3 * q3); }
    const float tot = wave_sum(s);
    if (lane == 0) *rs = 1.f / sqrtf(tot * (1.f / DM) + 1e-6f);
}
__device__ __forceinline__ void rs_from_parts(const float* SS, float* RS, int m) {
    const f32x4* p = (const f32x4*)(SS + (size_t)m * 16); const f32x4 a = p[0], b = p[1], c = p[2], d = p[3];
    const float s = ((a.x + a.y) + (a.z + a.w)) + ((b.x + b.y) + (b.z + b.w)) + ((c.x + c.y) + (c.z + c.w)) + ((d.x + d.y) + (d.z + d.w));
    RS[m] = 1.f / sqrtf(s * (1.f / DM) + 1e-6f);
}

struct PBArgs { const float* PROJ; const float* state_conv; const float* conv_w; const float* a_log; const float* dt_bias;
    float* QN; float* KN; float* VG; float* G; float* BETA; float* KQ; bf16* QB; bf16* KS; bf16* VS; bf16* KW; bf16* VW; float* out; int l; };
struct PBRegs { float qs_[8], qo_[8], kvs_[12], kvo_[12]; };
__device__ __forceinline__ void pb_row_load(const PBArgs& A, int m, int lane, PBRegs& R) {
    const float* pr = A.PROJ + (size_t)m * NP;
#pragma unroll
    for (int h = 0; h < 8; ++h) { R.qs_[h] = pr[C_Q + h * 64 + lane]; R.qo_[h] = pr[C_Q + h * 64 + (lane ^ 32)]; }
#pragma unroll
    for (int i = 0; i < 12; ++i) { R.kvs_[i] = pr[C_KV + i * 64 + lane]; R.kvo_[i] = pr[C_KV + i * 64 + (lane ^ 32)]; }
}
__device__ __forceinline__ void pb_row(const PBArgs& A, int m, int lane, const PBRegs& R) {
    const bool is_s = m >= MP; int b, t;
    if (!is_s) { b = m >> 12; t = m & 4095; } else { b = (m - MP) >> 2; t = (m - MP) & 3; }
    const int pos = is_s ? PAST + t : t, l = A.l;
    const float* pr = A.PROJ + (size_t)m * NP;
    const float* cw = A.conv_w + (size_t)l * 4 * 1536;
    const float* cb = A.state_conv + ((size_t)l * NSB + b) * 3 * 1536;
    if (!is_s && t >= SEQ - 3) { float* o = A.out + O_CONVP + ((size_t)(l * NPB + b) * 3 + (t - (SEQ - 3))) * 1536;
#pragma unroll 4
        for (int j = 0; j < 24; ++j) o[64 * j + lane] = pr[64 * j + lane]; }
    if (is_s && t >= 1) { float* o = A.out + O_CONVS + ((size_t)(l * NSB + b) * 3 + (t - 1)) * 1536;
#pragma unroll 4
        for (int j = 0; j < 24; ++j) o[64 * j + lane] = pr[64 * j + lane]; }
    const int half = lane >> 5; float cs, sn; rope_cs(pos, lane & 31, cs, sn);
    const float (&qs_)[8] = R.qs_; const float (&qo_)[8] = R.qo_; const float (&kvs_)[12] = R.kvs_; const float (&kvo_)[12] = R.kvo_;
#pragma unroll
    for (int h = 0; h < 8; ++h) { const float xs = qs_[h], xo = qo_[h];
        const float r = half ? (xs * cs + xo * sn) : (xs * cs - xo * sn);
        A.QB[(size_t)m * 512 + h * 64 + lane] = (bf16)f2bf(r * C2); }
#pragma unroll
    for (int s6 = 0; s6 < 6; ++s6)
#pragma unroll
        for (int kvh = 0; kvh < 2; ++kvh) {
            float v = kvs_[s6 * 2 + kvh];
            if (s6 == 2 || s6 == 4) { const float xo = kvo_[s6 * 2 + kvh]; v = half ? (v * cs + xo * sn) : (v * cs - xo * sn); }
            if (s6 < 4) {
                if (!is_s) A.out[O_KVP + ((((size_t)(l * NPB + b) * 2 + kvh) * SEQ + t) * 4 + s6) * 64 + lane] = v;
                else       A.out[O_KVS + ((((size_t)(l * NSB + b) * 2 + kvh) * DSEQ + t) * 4 + s6) * 64 + lane] = v;
            } else {
                const int idx = s6 - 4;
                if (!is_s) { if (t >= SEQ - 512) A.out[O_WINP + ((((size_t)(l * NPB + b) * 512 + (t - (SEQ - 512))) * 2 + idx) * 2 + kvh) * 64 + lane] = v; }
                else A.out[O_WINS + ((((size_t)(l * NSB + b) * 512 + (508 + t)) * 2 + idx) * 2 + kvh) * 64 + lane] = v;
            }
            const bf16 bv = (bf16)f2bf(v);
            if (s6 == 2) A.KS[(size_t)m * 128 + kvh * 64 + lane] = bv;
            if (s6 == 3) A.VS[(size_t)m * 128 + kvh * 64 + lane] = bv;
            if (s6 == 4) A.KW[(size_t)m * 128 + kvh * 64 + lane] = bv;
            if (s6 == 5) A.VW[(size_t)m * 128 + kvh * 64 + lane] = bv;
        }
}

__device__ __forceinline__ void pb_sample_head(const PBArgs& A, int u, int lane) {
    const int m = MP + (u >> 3), h = u & 7, b = (m - MP) >> 2, t = (m - MP) & 3, l = A.l;
    const float* pr = A.PROJ + (size_t)m * NP;
    const float* cw = A.conv_w + (size_t)l * 4 * 1536;
    const float* cb = A.state_conv + ((size_t)l * NSB + b) * 3 * 1536;
    float xv[3][4], wv[3][4];
#pragma unroll
    for (int part = 0; part < 3; ++part) { const int c = (part * 8 + h) * 64 + lane;
#pragma unroll
        for (int tap = 0; tap < 4; ++tap) { const int idx = t + tap;
            xv[part][tap] = (idx >= 3) ? A.PROJ[(size_t)(m - t + idx - 3) * NP + c] : cb[idx * 1536 + c];
            wv[part][tap] = cw[tap * 1536 + c]; } }
    __builtin_amdgcn_sched_barrier(0);
    float qkv[3];
#pragma unroll
    for (int part = 0; part < 3; ++part) qkv[part] = siluf_((xv[part][0] * wv[part][0] + xv[part][1] * wv[part][1]) + (xv[part][2] * wv[part][2] + xv[part][3] * wv[part][3]));
    const float q = qkv[0], k = qkv[1];
    const float qs = dpp_sum(q * q), ks = dpp_sum(k * k);
    const float qn = q * (1.f / sqrtf(qs + 1e-6f)) * 0.125f, kn = k * (1.f / sqrtf(ks + 1e-6f));
    const float kq = dpp_sum(qn * kn);
    A.QN[(size_t)m * 512 + h * 64 + lane] = qn; A.KN[(size_t)m * 512 + h * 64 + lane] = kn; A.VG[(size_t)m * 512 + h * 64 + lane] = qkv[2];
    if (lane == 0) A.KQ[(size_t)m * 8 + h] = kq;
    if (h == 0 && lane < 8) {
        const float a = pr[C_A + lane] + A.dt_bias[l * 8 + lane];
        const float sp = fmaxf(a, 0.f) + log1pf(__expf(-fabsf(a)));
        A.G[(size_t)m * 8 + lane] = -__expf(A.a_log[l * 8 + lane]) * sp;
        A.BETA[(size_t)m * 8 + lane] = sigmoidf_(pr[C_BETA + lane]); }
}

struct CmpArgs { const float* PROJ; const float* cache; const int* page_table; const float* pe_k; const float* pe_v; const bf16* CMPW; unsigned char* ws; int l; };
__device__ __forceinline__ void compress_batch(const CmpArgs& A, unsigned char* lds, int batch, bool is_s, int tid) {
    const int lane = tid & 63, wave = __builtin_amdgcn_readfirstlane(tid >> 6), fr = lane & 15, fq = lane >> 4, l = A.l;
    const int kv = batch & 1, ru = (batch >> 1) * 8 + wave;
    const int rho = 16 * ru + fr, NC = is_s ? 64 : 128;
    const int seq = rho / (2 * NC), n = (rho >> 1) % NC, kvh = rho & 1;
    const float* abase; size_t astride;
    if (!is_s) { abase = A.PROJ + (size_t)(seq * SEQ + 32 * n) * NP + C_KV + kv * 128 + kvh * 64; astride = NP; }
    else { const int page = A.page_table[seq * NPAGES + (n >> 2)];
        abase = A.cache + ((((size_t)l * NPOOL + page) * 2 + kvh) * 128 + (n & 3) * 32) * 256 + kv * 64; astride = 256; }
    const float* pe = (kv ? A.pe_v : A.pe_k) + (size_t)l * 2048;
    const bf16* Wt = A.CMPW + (size_t)((l * 2 + kv) * 64) * 2048;
    const int we = tid >> 3, wch = tid & 7;
    f32x4 acc[4];
#pragma unroll
    for (int et = 0; et < 4; ++et) acc[et] = (f32x4){0.f, 0.f, 0.f, 0.f};
    f32x4 sa[2][4], sp[2][4]; v4u wreg;
#define CB_LOADA(S, c) do { _Pragma("unroll") for (int ks = 0; ks < 2; ++ks) { const float* ap = abase + (size_t)(c) * astride + 32 * ks + 8 * fq; const float* pp = pe + (c) * 64 + 32 * ks + 8 * fq; \
        sa[S][2 * ks] = *(const f32x4*)ap; sa[S][2 * ks + 1] = *(const f32x4*)(ap + 4); sp[S][2 * ks] = *(const f32x4*)pp; sp[S][2 * ks + 1] = *(const f32x4*)(pp + 4); } } while (0)
#define CB_LOADW(c) do { wreg = *(const v4u*)(Wt + (size_t)we * 2048 + ((c) < 31 ? (c) : 31) * 64 + wch * 8); } while (0)
#define CB_STOREW(bufi) do { *(v4u*)(lds + (bufi) * 9216 + we * 144 + wch * 16) = wreg; } while (0)
#define CB_MMA(S, bufi) do { _Pragma("unroll") for (int ks = 0; ks < 2; ++ks) { const f32x4 a0 = sa[S][2 * ks] + sp[S][2 * ks], a1 = sa[S][2 * ks + 1] + sp[S][2 * ks + 1]; \
        const bf16x8 ya = pack8(a0.x, a0.y, a0.z, a0.w, a1.x, a1.y, a1.z, a1.w); \
        _Pragma("unroll") for (int et = 0; et < 4; ++et) { const bf16x8 wf_ = *(const bf16x8*)(lds + (bufi) * 9216 + (16 * et + fr) * 144 + (32 * ks + 8 * fq) * 2); \
            acc[et] = __builtin_amdgcn_mfma_f32_16x16x32_bf16(wf_, ya, acc[et], 0, 0, 0); } } } while (0)
    __syncthreads();
    CB_LOADW(0); CB_LOADA(0, 0);
    CB_STOREW(0); CB_LOADW(1);
    __syncthreads();
#pragma unroll 1
    for (int c = 0; c < 32; c += 2) {
        CB_STOREW(1); __builtin_amdgcn_sched_barrier(0); CB_LOADW(c + 2); CB_LOADA(1, c + 1); __builtin_amdgcn_sched_barrier(0);
        CB_MMA(0, 0); __builtin_amdgcn_sched_barrier(0);
        __syncthreads();
        CB_STOREW(0); __builtin_amdgcn_sched_barrier(0); CB_LOADW(c + 3); if (c + 2 < 32) { CB_LOADA(0, c + 2); } __builtin_amdgcn_sched_barrier(0);
        CB_MMA(1, 1); __builtin_amdgcn_sched_barrier(0);
        __syncthreads();
    }
#undef CB_LOADA
#undef CB_LOADW
#undef CB_STOREW
#undef CB_MMA
    if (kv == 0) { const int pos = 32 * n + 31;
#pragma unroll
        for (int et = 0; et < 2; ++et)
#pragma unroll
            for (int i = 0; i < 4; ++i) { float cs, sn; rope_cs(pos, 16 * et + 4 * fq + i, cs, sn);
                const float x1 = acc[et][i], x2 = acc[et + 2][i]; acc[et][i] = x1 * cs - x2 * sn; acc[et + 2][i] = x2 * cs + x1 * sn; } }
    float* ob = (float*)(A.ws + (is_s ? WS_CKS : WS_CKP) + (size_t)kv * (is_s ? (WS_CVS - WS_CKS) : (WS_CVP - WS_CKP))) + (size_t)rho * 64 + 4 * fq;
#pragma unroll
    for (int et = 0; et < 4; ++et) *(f32x4*)(ob + 16 * et) = acc[et];
}

struct GdnArgs { const float* QN; const float* KN; const float* VG; const float* G; const float* BETA; const float* KQ; float* OG; const float* PROJ; const float* state_gdn; const float* gdn_norm; bf16* MIX; float* out; int l; };
__device__ __forceinline__ void gdn_sample_unit(const GdnArgs& A, int unit, int lane) {
    const int sb = unit >> 3, h = unit & 7, l = A.l;
    const float* sp = A.state_gdn + (((size_t)l * NSB + sb) * 8 + h) * 4096;
    float S[64];
#pragma unroll
    for (int d = 0; d < 64; ++d) S[d] = sp[d * 64 + lane];
    const float gn = A.gdn_norm[l * 64 + lane];
    for (int i = 0; i < DSEQ; ++i) {
        const size_t m = (size_t)MP + sb * 4 + i;
        const float kd = A.KN[m * 512 + h * 64 + lane], qd = A.QN[m * 512 + h * 64 + lane], v = A.VG[m * 512 + h * 64 + lane];
        const float g = A.G[m * 8 + h], beta = A.BETA[m * 8 + h], kq = A.KQ[m * 8 + h];
        const int kdb = __builtin_bit_cast(int, kd), qdb = __builtin_bit_cast(int, qd);
        const float a = __expf(g); float r1 = 0.f, r2 = 0.f;
#pragma unroll
        for (int d = 0; d < 64; ++d) { const float kk = __builtin_bit_cast(float, __builtin_amdgcn_readlane(kdb, d)), qq = __builtin_bit_cast(float, __builtin_amdgcn_readlane(qdb, d)); r1 += S[d] * kk; r2 += S[d] * qq; }
        const float u = beta * (v - a * r1), o = a * r2 + u * kq;
#pragma unroll
        for (int d = 0; d < 64; ++d) { const float kk = __builtin_bit_cast(float, __builtin_amdgcn_readlane(kdb, d)); S[d] = a * S[d] + kk * u; }
        const float ms = wave_sum(o * o) * (1.f / 64.f);
        const float z = A.PROJ[m * NP + C_Z + h * 64 + lane];
        A.MIX[m * 1024 + h * 64 + lane] = (bf16)f2bf(o * (1.f / sqrtf(ms + 1e-6f)) * gn * siluf_(z));
    }
    float* so = A.out + O_GDNS + (((size_t)l * NSB + sb) * 8 + h) * 4096;
#pragma unroll
    for (int d = 0; d < 64; ++d) so[d * 64 + lane] = S[d];
}


__device__ __forceinline__ int perm_inv32(int p) { return (p & 32) + 16 * ((p >> 2) & 1) + 4 * ((p >> 3) & 3) + (p & 3); }
struct GPArgs { const float* PROJ; const float* conv_w; const float* a_log; const float* dt_bias; bf16* GK; bf16* GQ; bf16* GKT; bf16* GVT; float* GG2; float* BETA2; int l; };
struct GPRegs { float xx[3][11], ww[3][4]; };
__device__ __forceinline__ void gdn_prep_load(const GPArgs& A, int unit, int lane, GPRegs& R) {
    const int tg = unit >> 3, h = unit & 7, m0 = tg * 8, t0 = m0 & 4095;
    const float* cw = A.conv_w + (size_t)A.l * 4 * 1536;
#pragma unroll
    for (int part = 0; part < 3; ++part) { const int c = (part * 8 + h) * 64 + lane;
#pragma unroll
        for (int j = 0; j < 11; ++j) R.xx[part][j] = (t0 - 3 + j >= 0) ? A.PROJ[(size_t)(m0 - 3 + j) * NP + c] : 0.f;
#pragma unroll
        for (int k = 0; k < 4; ++k) R.ww[part][k] = cw[k * 1536 + c]; }
}
__device__ __forceinline__ void gdn_prep_unit(const GPArgs& A, int unit, int lane, const GPRegs& R) {
    const int tg = unit >> 3, h = unit & 7, m0 = tg * 8, b = m0 >> 12, t0 = m0 & 4095, l = A.l, bh = b * 8 + h;
    const float* cw = A.conv_w + (size_t)l * 4 * 1536;
    float val[3][8]; const float (&xx)[3][11] = R.xx; const float (&ww)[3][4] = R.ww;
#pragma unroll
    for (int part = 0; part < 3; ++part)
#pragma unroll
        for (int i = 0; i < 8; ++i) val[part][i] = siluf_(ww[part][0] * xx[part][i] + ww[part][1] * xx[part][i + 1] + ww[part][2] * xx[part][i + 2] + ww[part][3] * xx[part][i + 3]);
#pragma unroll
    for (int i = 0; i < 8; ++i) { const float q = val[0][i], k = val[1][i];
        const float qs = dpp_sum(q * q), ks = dpp_sum(k * k);
        val[0][i] = q * (1.f / sqrtf(qs + 1e-6f)) * 0.125f; val[1][i] = k * (1.f / sqrtf(ks + 1e-6f)); }
#pragma unroll
    for (int i = 0; i < 8; ++i) { A.GQ[((size_t)bh * 4096 + t0 + i) * 64 + lane] = (bf16)f2bf(val[0][i]); A.GK[((size_t)bh * 4096 + t0 + i) * 64 + lane] = (bf16)f2bf(val[1][i]); }
    *(v4u*)(A.GKT + ((size_t)bh * 64 + lane) * 4096 + t0) = (v4u){pk2(val[1][0], val[1][1]), pk2(val[1][2], val[1][3]), pk2(val[1][4], val[1][5]), pk2(val[1][6], val[1][7])};
    *(v4u*)(A.GVT + ((size_t)bh * 64 + lane) * 4096 + t0) = (v4u){pk2(val[2][0], val[2][1]), pk2(val[2][2], val[2][3]), pk2(val[2][4], val[2][5]), pk2(val[2][6], val[2][7])};
    if (lane < 8) { const float* pr = A.PROJ + (size_t)(m0 + lane) * NP;
        const float a = pr[C_A + h] + A.dt_bias[l * 8 + h];
        const float sp = fmaxf(a, 0.f) + log1pf(__expf(-fabsf(a)));
        A.GG2[(size_t)bh * 4096 + t0 + lane] = -__expf(A.a_log[l * 8 + h]) * sp;
        A.BETA2[(size_t)bh * 4096 + t0 + lane] = sigmoidf_(pr[C_BETA + h]); }
}
template <int I> __device__ __forceinline__ void fsub_row(float (&T)[64], const float* AL, int lane) {
    float tv = (lane == I) ? 1.f : 0.f;
#pragma unroll
    for (int j4 = 0; j4 < (I + 3) / 4; ++j4) { const f32x4 a = *(const f32x4*)(AL + I * 64 + 4 * j4);
#pragma unroll
        for (int e = 0; e < 4; ++e) if (4 * j4 + e < I) tv -= a[e] * T[4 * j4 + e]; }
    T[I] = tv;
}
template <int I> struct FSub { static __device__ __forceinline__ void run(float (&T)[64], const float* AL, int lane) { FSub<I - 1>::run(T, AL, lane); fsub_row<I>(T, AL, lane); } };
template <> struct FSub<-1> { static __device__ __forceinline__ void run(float (&)[64], const float*, int) {} };
struct GCArgs { const bf16* GK; const bf16* GQ; const bf16* GKT; const bf16* GVT; const float* GG2; const float* BETA2; bf16* WX; bf16* QX; bf16* QKX; bf16* KTX; float* U0F; float* GL; };
constexpr int GC_LDS_PER_WAVE = 17664;
__device__ __forceinline__ void gdn_chunk_unit(const GCArgs& A, unsigned char* wl, int unit, int lane_) {
    int lane = lane_; asm volatile("" : "+v"(lane));
    const int bh = unit >> 6, n = unit & 63, t0 = 64 * n, fr = lane & 15, fq = lane >> 4;
    float* AL = (float*)wl; float* SC = (float*)(wl + 16384);
    {   const float g = A.GG2[(size_t)bh * 4096 + t0 + lane], beta = A.BETA2[(size_t)bh * 4096 + t0 + lane];
        float gc = g;
        gc = dpp_add<0x111, 0xf>(gc); gc = dpp_add<0x112, 0xf>(gc); gc = dpp_add<0x114, 0xf>(gc); gc = dpp_add<0x118, 0xf>(gc); gc = dpp_add<0x142, 0xa>(gc); gc = dpp_add<0x143, 0xc>(gc);
        const float glast = __builtin_bit_cast(float, __builtin_amdgcn_readlane(__builtin_bit_cast(int, gc), 63));
        const float eg = __expf(gc);
        SC[lane] = gc; SC[64 + lane] = beta; SC[128 + lane] = beta * eg; SC[192 + lane] = eg; SC[256 + lane] = __expf(glast - gc);
        if (lane == 0) A.GL[unit] = __expf(glast); }
    LDS_WAIT(); asm volatile("" ::: "memory");
    {
        bf16x8 kf[4][2];
#pragma unroll
        for (int t4 = 0; t4 < 4; ++t4)
#pragma unroll
            for (int ks = 0; ks < 2; ++ks) kf[t4][ks] = *(const bf16x8*)(A.GK + ((size_t)bh * 4096 + t0 + 16 * t4 + fr) * 64 + 32 * ks + 8 * fq);
        __builtin_amdgcn_sched_barrier(0);
#pragma unroll
        for (int ti = 0; ti < 4; ++ti) { const f32x4 gi = *(const f32x4*)(SC + 16 * ti + 4 * fq), bi = *(const f32x4*)(SC + 64 + 16 * ti + 4 * fq);
#pragma unroll
            for (int tj = 0; tj < 4; ++tj) if (tj <= ti) { f32x4 acc = {0.f, 0.f, 0.f, 0.f};
                acc = __builtin_amdgcn_mfma_f32_16x16x32_bf16(kf[ti][0], kf[tj][0], acc, 0, 0, 0); acc = __builtin_amdgcn_mfma_f32_16x16x32_bf16(kf[ti][1], kf[tj][1], acc, 0, 0, 0);
                const float gj = SC[16 * tj + fr];
#pragma unroll
                for (int i = 0; i < 4; ++i) AL[(16 * ti + 4 * fq + i) * 64 + 16 * tj + fr] = bi[i] * acc[i] * __expf(fminf(gi[i] - gj, 0.f)); } }
    }
    LDS_WAIT(); asm volatile("" ::: "memory");
    {
        float T[64];
        FSub<63>::run(T, AL, lane);
        LDS_WAIT(); asm volatile("" ::: "memory");
        unsigned short* TB = (unsigned short*)wl;
#pragma unroll
        for (int i = 0; i < 64; ++i) TB[i * 72 + lane] = (unsigned short)f2bf(T[i]);
    }
    LDS_WAIT(); asm volatile("" ::: "memory");
    {
        bf16x8 tf[4][2];
#pragma unroll
        for (int ti = 0; ti < 4; ++ti)
#pragma unroll
            for (int ks = 0; ks < 2; ++ks) tf[ti][ks] = *(const bf16x8*)(wl + ((16 * ti + fr) * 72 + 32 * ks + 8 * fq) * 2);
#pragma unroll
        for (int which = 0; which < 2; ++which) { const bf16* src = which ? A.GVT : A.GKT; const float* sc = SC + (which ? 64 : 128);
            bf16x8 raws[4][2];
#pragma unroll
            for (int tn = 0; tn < 4; ++tn)
#pragma unroll
                for (int ks = 0; ks < 2; ++ks) raws[tn][ks] = *(const bf16x8*)(src + ((size_t)bh * 64 + 16 * tn + fr) * 4096 + t0 + 32 * ks + 8 * fq);
            __builtin_amdgcn_sched_barrier(0);
#pragma unroll
            for (int tn = 0; tn < 4; ++tn) { bf16x8 yb[2];
#pragma unroll
                for (int ks = 0; ks < 2; ++ks) { const bf16x8 raw = raws[tn][ks];
                    const f32x4 s0 = *(const f32x4*)(sc + 32 * ks + 8 * fq), s1 = *(const f32x4*)(sc + 32 * ks + 8 * fq + 4);
                    yb[ks] = pack8(bf2f((unsigned short)raw[0]) * s0.x, bf2f((unsigned short)raw[1]) * s0.y, bf2f((unsigned short)raw[2]) * s0.z, bf2f((unsigned short)raw[3]) * s0.w,
                                   bf2f((unsigned short)raw[4]) * s1.x, bf2f((unsigned short)raw[5]) * s1.y, bf2f((unsigned short)raw[6]) * s1.z, bf2f((unsigned short)raw[7]) * s1.w); }
#pragma unroll
                for (int ti = 0; ti < 4; ++ti) { f32x4 acc = {0.f, 0.f, 0.f, 0.f};
                    acc = __builtin_amdgcn_mfma_f32_16x16x32_bf16(tf[ti][0], yb[0], acc, 0, 0, 0);
                    if (ti >= 2) acc = __builtin_amdgcn_mfma_f32_16x16x32_bf16(tf[ti][1], yb[1], acc, 0, 0, 0);
                    if (which == 0) { const int p = 32 * (tn >> 1) + 8 * (fr >> 2) + 4 * (tn & 1) + (fr & 3);
#pragma unroll
                        for (int i = 0; i < 4; ++i) A.WX[((size_t)unit * 64 + 16 * ti + 4 * fq + i) * 64 + p] = (bf16)f2bf(acc[i]); }
                    else *(f32x4*)(A.U0F + (((size_t)unit * 16 + ti * 4 + tn) * 64 + lane) * 4) = acc; } } }
    }
    {
        bf16x8 kf[4][2], qf[4][2];
#pragma unroll
        for (int t4 = 0; t4 < 4; ++t4)
#pragma unroll
            for (int ks = 0; ks < 2; ++ks) { kf[t4][ks] = *(const bf16x8*)(A.GK + ((size_t)bh * 4096 + t0 + 16 * t4 + fr) * 64 + 32 * ks + 8 * fq);
                qf[t4][ks] = *(const bf16x8*)(A.GQ + ((size_t)bh * 4096 + t0 + 16 * t4 + fr) * 64 + 32 * ks + 8 * fq); }
        __builtin_amdgcn_sched_barrier(0);
#pragma unroll
        for (int ti = 0; ti < 4; ++ti) { const f32x4 gi = *(const f32x4*)(SC + 16 * ti + 4 * fq);
#pragma unroll
            for (int tj = 0; tj < 4; ++tj) { f32x4 acc = {0.f, 0.f, 0.f, 0.f};
                if (tj <= ti) { acc = __builtin_amdgcn_mfma_f32_16x16x32_bf16(qf[ti][0], kf[tj][0], acc, 0, 0, 0); acc = __builtin_amdgcn_mfma_f32_16x16x32_bf16(qf[ti][1], kf[tj][1], acc, 0, 0, 0); }
                const float gj = SC[16 * tj + fr]; const int p = 32 * (tj >> 1) + 8 * (fr >> 2) + 4 * (tj & 1) + (fr & 3);
#pragma unroll
                for (int i = 0; i < 4; ++i) { const int ri = 16 * ti + 4 * fq + i, cj = 16 * tj + fr;
                    const float v = (tj <= ti && ri >= cj) ? acc[i] * __expf(fminf(gi[i] - gj, 0.f)) : 0.f;
                    A.QKX[((size_t)unit * 64 + ri) * 64 + p] = (bf16)f2bf(v); } } }
    }
    {
        const int lg = perm_inv32(lane);
        const float ek = SC[256 + lg];
#pragma unroll 1
        for (int r0 = 0; r0 < 64; r0 += 16) { bf16 qv[16], kv[16];
#pragma unroll
            for (int i = 0; i < 16; ++i) { qv[i] = A.GQ[((size_t)bh * 4096 + t0 + r0 + i) * 64 + lg]; kv[i] = A.GKT[((size_t)bh * 64 + r0 + i) * 4096 + t0 + lg]; }
            __builtin_amdgcn_sched_barrier(0);
#pragma unroll
            for (int i = 0; i < 16; ++i) { A.QX[((size_t)unit * 64 + r0 + i) * 64 + lane] = (bf16)f2bf(bf2f(qv[i]) * SC[192 + r0 + i]);
                A.KTX[((size_t)unit * 64 + r0 + i) * 64 + lane] = (bf16)f2bf(bf2f(kv[i]) * ek); } }
    }
    LDS_WAIT(); asm volatile("" ::: "memory");
}
struct GS2Args { const bf16* WX; const bf16* QX; const bf16* QKX; const bf16* KTX; const float* U0F; const float* GL; float* OG; float* out; int l; };
__device__ __forceinline__ void gdn_scan2_wave(const GS2Args& A, int bh, int te, int lane) {
    const int fr = lane & 15, fq = lane >> 4, b = bh >> 3, h = bh & 7;
    f32x4 s[4]; bf16x8 sfr[2];
#pragma unroll
    for (int i = 0; i < 4; ++i) s[i] = (f32x4){0.f, 0.f, 0.f, 0.f};
    sfr[0] = (bf16x8){0, 0, 0, 0, 0, 0, 0, 0}; sfr[1] = sfr[0];
    f32x4 u[4]; bf16x8 wf[4][2], kt[4][2], qx[4][2], qkx[4][2]; float dec;
#define GS_LD_UW(nn) do { const size_t un_ = (size_t)bh * 64 + (nn); _Pragma("unroll") for (int tc = 0; tc < 4; ++tc) { u[tc] = *(const f32x4*)(A.U0F + ((un_ * 16 + tc * 4 + te) * 64 + lane) * 4); \
        _Pragma("unroll") for (int ks = 0; ks < 2; ++ks) wf[tc][ks] = *(const bf16x8*)(A.WX + (un_ * 64 + 16 * tc + fr) * 64 + 32 * ks + 8 * fq); } } while (0)
#define GS_LD_Q(nn) do { const size_t un_ = (size_t)bh * 64 + (nn); _Pragma("unroll") for (int tc = 0; tc < 4; ++tc) _Pragma("unroll") for (int ks = 0; ks < 2; ++ks) { \
        qx[tc][ks] = *(const bf16x8*)(A.QX + (un_ * 64 + 16 * tc + fr) * 64 + 32 * ks + 8 * fq); qkx[tc][ks] = *(const bf16x8*)(A.QKX + (un_ * 64 + 16 * tc + fr) * 64 + 32 * ks + 8 * fq); } } while (0)
#define GS_LD_K(nn) do { const size_t un_ = (size_t)bh * 64 + (nn); dec = A.GL[un_]; _Pragma("unroll") for (int tc = 0; tc < 4; ++tc) _Pragma("unroll") for (int ks = 0; ks < 2; ++ks) \
        kt[tc][ks] = *(const bf16x8*)(A.KTX + (un_ * 64 + 16 * tc + fr) * 64 + 32 * ks + 8 * fq); } while (0)
    GS_LD_UW(0); GS_LD_Q(0); GS_LD_K(0);
    __builtin_amdgcn_sched_barrier(0);
#pragma unroll 1
    for (int n = 0; n < 64; ++n) {
        const int nn = n < 63 ? n + 1 : 63;
#pragma unroll
        for (int tc = 0; tc < 4; ++tc) { f32x4 acc = {0.f, 0.f, 0.f, 0.f};
            acc = __builtin_amdgcn_mfma_f32_16x16x32_bf16(wf[tc][0], sfr[0], acc, 0, 0, 0); acc = __builtin_amdgcn_mfma_f32_16x16x32_bf16(wf[tc][1], sfr[1], acc, 0, 0, 0);
            u[tc] -= acc; }
        bf16x8 ufr[2];
#pragma unroll
        for (int ks = 0; ks < 2; ++ks) ufr[ks] = pack8(u[2 * ks][0], u[2 * ks][1], u[2 * ks][2], u[2 * ks][3], u[2 * ks + 1][0], u[2 * ks + 1][1], u[2 * ks + 1][2], u[2 * ks + 1][3]);
        __builtin_amdgcn_sched_barrier(0);
        GS_LD_UW(nn);
        __builtin_amdgcn_sched_barrier(0);
        f32x4 oacc[4];
#pragma unroll
        for (int tc = 0; tc < 4; ++tc) {
            f32x4 acc = {0.f, 0.f, 0.f, 0.f};
            acc = __builtin_amdgcn_mfma_f32_16x16x32_bf16(qx[tc][0], sfr[0], acc, 0, 0, 0); acc = __builtin_amdgcn_mfma_f32_16x16x32_bf16(qx[tc][1], sfr[1], acc, 0, 0, 0);
            acc = __builtin_amdgcn_mfma_f32_16x16x32_bf16(qkx[tc][0], ufr[0], acc, 0, 0, 0); acc = __builtin_amdgcn_mfma_f32_16x16x32_bf16(qkx[tc][1], ufr[1], acc, 0, 0, 0);
            oacc[tc] = acc; }
#pragma unroll
        for (int td = 0; td < 4; ++td) { f32x4 acc = s[td] * dec;
            acc = __builtin_amdgcn_mfma_f32_16x16x32_bf16(kt[td][0], ufr[0], acc, 0, 0, 0); acc = __builtin_amdgcn_mfma_f32_16x16x32_bf16(kt[td][1], ufr[1], acc, 0, 0, 0);
            s[td] = acc; }
#pragma unroll
        for (int ks = 0; ks < 2; ++ks) sfr[ks] = pack8(s[2 * ks][0], s[2 * ks][1], s[2 * ks][2], s[2 * ks][3], s[2 * ks + 1][0], s[2 * ks + 1][1], s[2 * ks + 1][2], s[2 * ks + 1][3]);
        __builtin_amdgcn_sched_barrier(0);
        GS_LD_Q(nn); GS_LD_K(nn);
#pragma unroll
        for (int tc = 0; tc < 4; ++tc)
#pragma unroll
            for (int i = 0; i < 4; ++i) A.OG[((size_t)b * SEQ + 64 * n + 16 * tc + 4 * fq + i) * 512 + h * 64 + 16 * te + fr] = oacc[tc][i];
        __builtin_amdgcn_sched_barrier(0);
    }
#undef GS_LD_UW
#undef GS_LD_Q
#undef GS_LD_K
#pragma unroll
    for (int td = 0; td < 4; ++td)
#pragma unroll
        for (int i = 0; i < 4; ++i) A.out[O_GDNP + ((((size_t)A.l * NPB + b) * 8 + h) * 64 + 16 * td + 4 * fq + i) * 64 + 16 * te + fr] = s[td][i];
}

constexpr int SC_ROW = 144, SC_MAT = 64 * SC_ROW, SC_U = 4 * SC_MAT, SC_STAGE = SC_U + 16384, SC_DEC = 2 * SC_STAGE;
__device__ __forceinline__ void gdn_scan3_block(const GS2Args& A, unsigned char* lds, int bh, int tid) {
    const int lane = tid & 63, wave = __builtin_amdgcn_readfirstlane(tid >> 6), fr = lane & 15, fq = lane >> 4, b = bh >> 3, h = bh & 7, te = wave;
    const int mrow = (tid >> 3), mch = tid & 7;
    v4u ra[6], rb[6];
#define SC_LOAD(R, nn) do { const size_t un_ = (size_t)bh * 64 + ((nn) < 63 ? (nn) : 63); \
        R[0] = *(const v4u*)(A.WX + un_ * 4096 + mrow * 64 + mch * 8); R[1] = *(const v4u*)(A.KTX + un_ * 4096 + mrow * 64 + mch * 8); \
        R[2] = *(const v4u*)(A.QX + un_ * 4096 + mrow * 64 + mch * 8); R[3] = *(const v4u*)(A.QKX + un_ * 4096 + mrow * 64 + mch * 8); \
        R[4] = *(const v4u*)(A.U0F + un_ * 4096 + (size_t)tid * 4); R[5] = *(const v4u*)(A.U0F + un_ * 4096 + (size_t)(tid + 512) * 4); } while (0)
#define SC_STORE(R, st) do { unsigned char* sb_ = lds + (st) * SC_STAGE; \
        *(v4u*)(sb_ + 0 * SC_MAT + mrow * SC_ROW + mch * 16) = R[0]; *(v4u*)(sb_ + 1 * SC_MAT + mrow * SC_ROW + mch * 16) = R[1]; \
        *(v4u*)(sb_ + 2 * SC_MAT + mrow * SC_ROW + mch * 16) = R[2]; *(v4u*)(sb_ + 3 * SC_MAT + mrow * SC_ROW + mch * 16) = R[3]; \
        *(v4u*)(sb_ + SC_U + tid * 16) = R[4]; *(v4u*)(sb_ + SC_U + (tid + 512) * 16) = R[5]; } while (0)
    f32x4 s[4]; bf16x8 sfr[2];
#pragma unroll
    for (int i = 0; i < 4; ++i) s[i] = (f32x4){0.f, 0.f, 0.f, 0.f};
    sfr[0] = (bf16x8){0, 0, 0, 0, 0, 0, 0, 0}; sfr[1] = sfr[0];
    __syncthreads();
    if (tid < 64) ((float*)(lds + SC_DEC))[tid] = A.GL[(size_t)bh * 64 + tid];
    SC_LOAD(ra, 0); SC_STORE(ra, 0);
    SC_LOAD(rb, 1); SC_LOAD(ra, 2);
    __syncthreads();
#define SC_CHUNK(n, st) do { if (wave < 4) { const unsigned char* sb_ = lds + (st) * SC_STAGE; \
        f32x4 u[4]; bf16x8 ufr[2]; \
        _Pragma("unroll") for (int tc = 0; tc < 4; ++tc) { u[tc] = *(const f32x4*)(sb_ + SC_U + ((tc * 4 + te) * 64 + lane) * 16); \
            const bf16x8 w0 = *(const bf16x8*)(sb_ + (16 * tc + fr) * SC_ROW + (8 * fq) * 2), w1 = *(const bf16x8*)(sb_ + (16 * tc + fr) * SC_ROW + (32 + 8 * fq) * 2); \
            f32x4 acc = {0.f, 0.f, 0.f, 0.f}; acc = __builtin_amdgcn_mfma_f32_16x16x32_bf16(w0, sfr[0], acc, 0, 0, 0); acc = __builtin_amdgcn_mfma_f32_16x16x32_bf16(w1, sfr[1], acc, 0, 0, 0); u[tc] -= acc; } \
        _Pragma("unroll") for (int ks = 0; ks < 2; ++ks) ufr[ks] = pack8(u[2 * ks][0], u[2 * ks][1], u[2 * ks][2], u[2 * ks][3], u[2 * ks + 1][0], u[2 * ks + 1][1], u[2 * ks + 1][2], u[2 * ks + 1][3]); \
        _Pragma("unroll") for (int tc = 0; tc < 4; ++tc) { \
            const bf16x8 q0 = *(const bf16x8*)(sb_ + 2 * SC_MAT + (16 * tc + fr) * SC_ROW + (8 * fq) * 2), q1 = *(const bf16x8*)(sb_ + 2 * SC_MAT + (16 * tc + fr) * SC_ROW + (32 + 8 * fq) * 2); \
            const bf16x8 k0 = *(const bf16x8*)(sb_ + 3 * SC_MAT + (16 * tc + fr) * SC_ROW + (8 * fq) * 2), k1 = *(const bf16x8*)(sb_ + 3 * SC_MAT + (16 * tc + fr) * SC_ROW + (32 + 8 * fq) * 2); \
            f32x4 acc = {0.f, 0.f, 0.f, 0.f}; \
            acc = __builtin_amdgcn_mfma_f32_16x16x32_bf16(q0, sfr[0], acc, 0, 0, 0); acc = __builtin_amdgcn_mfma_f32_16x16x32_bf16(q1, sfr[1], acc, 0, 0, 0); \
            acc = __builtin_amdgcn_mfma_f32_16x16x32_bf16(k0, ufr[0], acc, 0, 0, 0); acc = __builtin_amdgcn_mfma_f32_16x16x32_bf16(k1, ufr[1], acc, 0, 0, 0); \
            _Pragma("unroll") for (int i = 0; i < 4; ++i) A.OG[((size_t)b * SEQ + 64 * (n) + 16 * tc + 4 * fq + i) * 512 + h * 64 + 16 * te + fr] = acc[i]; } \
        const float dec = ((const float*)(lds + SC_DEC))[(n)]; \
        _Pragma("unroll") for (int td = 0; td < 4; ++td) { \
            const bf16x8 t0 = *(const bf16x8*)(sb_ + 1 * SC_MAT + (16 * td + fr) * SC_ROW + (8 * fq) * 2), t1 = *(const bf16x8*)(sb_ + 1 * SC_MAT + (16 * td + fr) * SC_ROW + (32 + 8 * fq) * 2); \
            f32x4 acc = s[td] * dec; acc = __builtin_amdgcn_mfma_f32_16x16x32_bf16(t0, ufr[0], acc, 0, 0, 0); acc = __builtin_amdgcn_mfma_f32_16x16x32_bf16(t1, ufr[1], acc, 0, 0, 0); s[td] = acc; } \
        _Pragma("unroll") for (int ks = 0; ks < 2; ++ks) sfr[ks] = pack8(s[2 * ks][0], s[2 * ks][1], s[2 * ks][2], s[2 * ks][3], s[2 * ks + 1][0], s[2 * ks + 1][1], s[2 * ks + 1][2], s[2 * ks + 1][3]); } } while (0)
#pragma unroll 1
    for (int n = 0; n < 64; n += 2) {
        SC_STORE(rb, 1); __builtin_amdgcn_sched_barrier(0); SC_LOAD(rb, n + 3); __builtin_amdgcn_sched_barrier(0);
        SC_CHUNK(n, 0);
        __syncthreads();
        SC_STORE(ra, 0); __builtin_amdgcn_sched_barrier(0); SC_LOAD(ra, n + 4); __builtin_amdgcn_sched_barrier(0);
        SC_CHUNK(n + 1, 1);
        __syncthreads();
    }
#undef SC_LOAD
#undef SC_STORE
#undef SC_CHUNK
    if (wave < 4) {
#pragma unroll
        for (int td = 0; td < 4; ++td)
#pragma unroll
            for (int i = 0; i < 4; ++i) A.out[O_GDNP + ((((size_t)A.l * NPB + b) * 8 + h) * 64 + 16 * td + 4 * fq + i) * 64 + 16 * te + fr] = s[td][i];
    }
}

constexpr int L_CK = 0, L_CVT = 18432, L_IMP = 36864, L_MASK = 102400, L_UM = 102912, L_INV = 102928, L_K = 104448, L_VT = 113664;
struct AttArgs { const bf16* QB; const bf16* KS; const bf16* VS; const bf16* KW; const bf16* VW; const float* CKP; const float* CVP; const float* PROJ; bf16* MIX; };

constexpr float ATT_THR = 16.f;
constexpr int L_K2 = 122880, L_VT2 = 132096, L_VT3 = 0;
template <int MODE>
__device__ __forceinline__ void attn_tiles(unsigned char* lds, const bf16* Kg, const bf16* Vg, int j_lo, int j_hi, unsigned long long umask, unsigned long long tmask,
                                           int qblk, int trel, const bf16x8 (&qr)[4], f32x16 (&o)[2], float& mref, float& lrun, int tid, int r32, int hi) {
    int j = j_lo; while (j <= j_hi && !((umask >> j) & 1ull)) ++j;
    const int key = tid >> 3, ch = tid & 7;
    v4u kvv = {0u, 0u, 0u, 0u}, vv = {0u, 0u, 0u, 0u};
#define AT_LOAD(jj) do { kvv = *(const v4u*)(Kg + (size_t)(64 * (jj) + key) * 128 + ch * 8); vv = *(const v4u*)(Vg + (size_t)(64 * (jj) + key) * 128 + ch * 8); } while (0)
#define AT_WRITE(kofs, vofs) do { *(v4u*)(lds + (kofs) + key * 144 + ch * 16) = kvv; *(v4u*)(lds + (vofs) + key * 144 + ch * 16) = vv; } while (0)
    if (j > j_hi) return;
    AT_LOAD(j);
    __syncthreads();
    AT_WRITE(L_K, L_VT);
    int jn = j + 1; while (jn <= j_hi && !((umask >> jn) & 1ull)) ++jn;
    if (jn <= j_hi) AT_LOAD(jn);
    __syncthreads();
    const bool grpB = (tid >= 256);
    v4u pwp[4];
#pragma unroll
    for (int i = 0; i < 4; ++i) pwp[i] = (v4u){0u, 0u, 0u, 0u};
    int it = 0, vprev = L_VT;
    typedef short v4i16_t_ __attribute__((ext_vector_type(4)));
    const int trl_ = tid & 63, trq_ = (trl_ & 15) >> 2, trp_ = trl_ & 3, trd_ = 16 * ((trl_ >> 4) & 1) + 4 * trp_;
#define AT_TR(p_) __builtin_bit_cast(s16x4, __builtin_amdgcn_ds_read_tr16_b64_v4i16((__attribute__((address_space(3))) v4i16_t_*)(p_)))
#define AT_PV(vofs, PW) do { _Pragma("unroll") for (int u = 0; u < 2; ++u) _Pragma("unroll") for (int s = 0; s < 2; ++s) { const bf16x8 pf = __builtin_bit_cast(bf16x8, PW[u * 2 + s]); \
        _Pragma("unroll") for (int dh = 0; dh < 2; ++dh) { const unsigned char* vp = lds + (vofs) + (32 * u + 16 * s + 4 * hi + trq_) * 144 + (32 * dh + trd_) * 2; \
            const s16x4 lo = AT_TR(vp), hi4 = AT_TR(vp + 8 * 144); \
            const bf16x8 vf = (bf16x8){lo[0], lo[1], lo[2], lo[3], hi4[0], hi4[1], hi4[2], hi4[3]}; \
            o[dh] = __builtin_amdgcn_mfma_f32_32x32x16_bf16(vf, pf, o[dh], 0, 0, 0); } } } while (0)
    while (j <= j_hi) {
        const int kb = (it & 1) ? L_K2 : L_K, kb2 = (it & 1) ? L_K : L_K2;
        const int m3 = it % 3, vb = (m3 == 0) ? L_VT : (m3 == 1) ? L_VT2 : L_VT3, vb2 = (m3 == 0) ? L_VT2 : (m3 == 1) ? L_VT3 : L_VT;
        if (grpB && it > 0) AT_PV(vprev, pwp);
        if (jn <= j_hi) AT_WRITE(kb2, vb2);
        int jnn = jn + 1; while (jnn <= j_hi && !((umask >> jnn) & 1ull)) ++jnn;
        if (jnn <= j_hi) AT_LOAD(jnn);
        __builtin_amdgcn_sched_barrier(0);
        const bool tsel = (MODE == 0) ? (((tmask >> j) & 1ull) != 0ull) : true;
        const float cval = tsel ? -mref : NEG_INF;
        f32x16 ct;
#pragma unroll
        for (int r = 0; r < 16; ++r) ct[r] = cval;
        f32x16 p[2];
#pragma unroll
        for (int u = 0; u < 2; ++u) { f32x16 acc;
#pragma unroll
            for (int d0 = 0; d0 < 4; ++d0) { const bf16x8 kf = *(const bf16x8*)(lds + kb + (32 * u + r32) * 144 + (16 * d0 + 8 * hi) * 2);
                acc = __builtin_amdgcn_mfma_f32_32x32x16_bf16(kf, qr[d0], d0 == 0 ? ct : acc, 0, 0, 0); }
            p[u] = acc; }
        if (j == qblk) {
#pragma unroll
            for (int u = 0; u < 2; ++u)
#pragma unroll
                for (int r = 0; r < 16; ++r) { const int kv = 32 * u + crow(r, hi); if (kv > trel) p[u][r] = NEG_INF; } }
        if (MODE == 1 && j == qblk - 8) {
#pragma unroll
            for (int u = 0; u < 2; ++u)
#pragma unroll
                for (int r = 0; r < 16; ++r) { const int kv = 32 * u + crow(r, hi); if (kv < trel) p[u][r] = NEG_INF; } }
        float rm;
        { float a = __builtin_fmaxf(__builtin_fmaxf(p[0][0], p[0][1]), p[1][0]), b2 = __builtin_fmaxf(__builtin_fmaxf(p[0][2], p[0][3]), p[1][1]); a = __builtin_fmaxf(__builtin_fmaxf(a, p[1][2]), p[1][3]);
#pragma unroll
          for (int r = 4; r < 16; r += 4) { a = __builtin_fmaxf(__builtin_fmaxf(a, p[0][r]), p[0][r + 1]); b2 = __builtin_fmaxf(__builtin_fmaxf(b2, p[0][r + 2]), p[0][r + 3]);
              a = __builtin_fmaxf(__builtin_fmaxf(a, p[1][r]), p[1][r + 1]); b2 = __builtin_fmaxf(__builtin_fmaxf(b2, p[1][r + 2]), p[1][r + 3]); }
          rm = __builtin_fmaxf(a, b2); }
        { auto rr = __builtin_amdgcn_permlane32_swap(__float_as_uint(rm), __float_as_uint(rm), false, false); rm = __builtin_fmaxf(__uint_as_float(rr[0]), __uint_as_float(rr[1])); }
        if (__builtin_expect(__any(rm > ATT_THR), 0)) {
            const float dl = (rm > ATT_THR) ? rm : 0.f, f = ex2(-dl);
            mref += dl; lrun *= f;
#pragma unroll
            for (int u = 0; u < 2; ++u)
#pragma unroll
                for (int r = 0; r < 16; ++r) p[u][r] -= dl;
#pragma unroll
            for (int dh = 0; dh < 2; ++dh)
#pragma unroll
                for (int r = 0; r < 16; ++r) o[dh][r] *= f; }
        typedef float f32x2v_ __attribute__((ext_vector_type(2)));
        f32x2v_ ls2 = {0.f, 0.f};
#pragma unroll
        for (int u = 0; u < 2; ++u)
#pragma unroll
            for (int r = 0; r < 16; r += 2) { const float e0 = ex2(p[u][r]), e1 = ex2(p[u][r + 1]); p[u][r] = e0; p[u][r + 1] = e1; ls2 += (f32x2v_){e0, e1}; }
        lrun += ls2.x + ls2.y;
        v4u pw[4];
#pragma unroll
        for (int u = 0; u < 2; ++u)
#pragma unroll
            for (int s = 0; s < 2; ++s) { pw[u * 2 + s].x = pk2(p[u][8 * s + 0], p[u][8 * s + 1]); pw[u * 2 + s].y = pk2(p[u][8 * s + 2], p[u][8 * s + 3]);
                pw[u * 2 + s].z = pk2(p[u][8 * s + 4], p[u][8 * s + 5]); pw[u * 2 + s].w = pk2(p[u][8 * s + 6], p[u][8 * s + 7]); }
        if (!grpB) AT_PV(vb, pw);
        else {
#pragma unroll
            for (int i = 0; i < 4; ++i) pwp[i] = pw[i];
            vprev = vb; }
        __syncthreads();
        j = jn; jn = jnn; ++it;
    }
    if (grpB && it > 0) AT_PV(vprev, pwp);
#undef AT_PV
#undef AT_TR
#undef AT_LOAD
#undef AT_WRITE
}

__device__ __forceinline__ void nsa_prompt_unit(const AttArgs& A, unsigned char* lds, int unit, int tid) {
    const int lane = tid & 63, wave = tid >> 6, r32 = lane & 31, hi = lane >> 5, hh = wave & 3, ts = wave >> 2;
    const int qblk = 63 - (unit >> 3), b = (unit >> 1) & 3, kvh = unit & 1;
    const int head = kvh * 4 + hh, trel = 32 * ts + r32, t = 64 * qblk + trel; const size_t m = (size_t)b * SEQ + t;
    __syncthreads();
    const int nvmax = 2 * qblk + 2, ntile_c = (nvmax + 31) >> 5;
    { const int ch = tid & 7;
      for (int n = tid >> 3; n < 32 * ntile_c; n += 64) {
          const float* ckp = A.CKP + ((size_t)(b * 128 + n) * 2 + kvh) * 64 + ch * 8; const float* cvp = A.CVP + ((size_t)(b * 128 + n) * 2 + kvh) * 64 + ch * 8;
          const f32x4 k0 = *(const f32x4*)ckp, k1 = *(const f32x4*)(ckp + 4), v0 = *(const f32x4*)cvp, v1 = *(const f32x4*)(cvp + 4);
          *(bf16x8*)(lds + L_CK + n * 144 + ch * 16) = pack8(k0.x, k0.y, k0.z, k0.w, k1.x, k1.y, k1.z, k1.w);
          unsigned short* vt = (unsigned short*)(lds + L_CVT);
          vt[(ch * 8 + 0) * 136 + n] = (unsigned short)f2bf(v0.x); vt[(ch * 8 + 1) * 136 + n] = (unsigned short)f2bf(v0.y); vt[(ch * 8 + 2) * 136 + n] = (unsigned short)f2bf(v0.z); vt[(ch * 8 + 3) * 136 + n] = (unsigned short)f2bf(v0.w);
          vt[(ch * 8 + 4) * 136 + n] = (unsigned short)f2bf(v1.x); vt[(ch * 8 + 5) * 136 + n] = (unsigned short)f2bf(v1.y); vt[(ch * 8 + 6) * 136 + n] = (unsigned short)f2bf(v1.z); vt[(ch * 8 + 7) * 136 + n] = (unsigned short)f2bf(v1.w);
      }
      if (tid < 128) ((unsigned*)(lds + L_MASK))[tid] = 0u;
      if (tid < 2) ((unsigned*)(lds + L_UM))[tid] = 0u; }
    bf16x8 qr[4];
#pragma unroll
    for (int d0 = 0; d0 < 4; ++d0) qr[d0] = *(const bf16x8*)(A.QB + m * 512 + head * 64 + 16 * d0 + 8 * hi);
    __syncthreads();
    f32x16 tot[2];
    {
        const int nv = (t + 1) >> 5;
        float mx = NEG_INF;
#pragma unroll 1
        for (int tau = 0; tau < ntile_c; ++tau) {
            f32x16 acc = {};
#pragma unroll
            for (int d0 = 0; d0 < 4; ++d0) { const bf16x8 kf = *(const bf16x8*)(lds + L_CK + (32 * tau + r32) * 144 + (16 * d0 + 8 * hi) * 2);
                acc = __builtin_amdgcn_mfma_f32_32x32x16_bf16(kf, qr[d0], acc, 0, 0, 0); }
#pragma unroll
            for (int r = 0; r < 16; ++r) { const int n = 32 * tau + crow(r, hi); if (n < nv) mx = fmaxf(mx, acc[r]); }
        }
        mx = fmaxf(mx, __shfl_xor(mx, 32)); if (mx == NEG_INF) mx = 0.f;
        float sum = 0.f;
        f32x16 oc[2]; oc[0] = (f32x16){}; oc[1] = (f32x16){};
        float* imph = (float*)(lds + L_IMP) + (size_t)hh * 4096 + (32 * ts + r32) * 64;
#pragma unroll 1
        for (int tau = 0; tau < 4; ++tau) {
            f32x16 e = {};
            if (tau < ntile_c) {
                f32x16 acc = {};
#pragma unroll
                for (int d0 = 0; d0 < 4; ++d0) { const bf16x8 kf = *(const bf16x8*)(lds + L_CK + (32 * tau + r32) * 144 + (16 * d0 + 8 * hi) * 2);
                    acc = __builtin_amdgcn_mfma_f32_32x32x16_bf16(kf, qr[d0], acc, 0, 0, 0); }
#pragma unroll
                for (int r = 0; r < 16; ++r) { const int n = 32 * tau + crow(r, hi); e[r] = (n < nv) ? ex2(acc[r] - mx) : 0.f; sum += e[r]; }
#pragma unroll
                for (int s = 0; s < 2; ++s) {
                    const bf16x8 pf = pack8(e[8 * s + 0], e[8 * s + 1], e[8 * s + 2], e[8 * s + 3], e[8 * s + 4], e[8 * s + 5], e[8 * s + 6], e[8 * s + 7]);
#pragma unroll
                    for (int dh = 0; dh < 2; ++dh) { const unsigned char* vp = lds + L_CVT + (r32 + 32 * dh) * 272 + (32 * tau + 16 * s + 4 * hi) * 2;
                        const s16x4 lo = *(const s16x4*)vp, hi4 = *(const s16x4*)(vp + 16);
                        const bf16x8 vf = (bf16x8){lo[0], lo[1], lo[2], lo[3], hi4[0], hi4[1], hi4[2], hi4[3]};
                        oc[dh] = __builtin_amdgcn_mfma_f32_32x32x16_bf16(vf, pf, oc[dh], 0, 0, 0); }
                }
            }
#pragma unroll
            for (int a = 0; a < 4; ++a) { imph[16 * tau + 4 * a + 2 * hi + 0] = e[4 * a] + e[4 * a + 1]; imph[16 * tau + 4 * a + 2 * hi + 1] = e[4 * a + 2] + e[4 * a + 3]; }
        }
        sum += __shfl_xor(sum, 32);
        const float inv = 1.f / fmaxf(sum, 1e-30f);
        if (hi == 0) ((float*)(lds + L_INV))[hh * 64 + 32 * ts + r32] = inv;
        const float g0 = sigmoidf_(A.PROJ[m * NP + C_GATE + head * 3 + 0]) * inv;
#pragma unroll
        for (int dh = 0; dh < 2; ++dh)
#pragma unroll
            for (int r = 0; r < 16; ++r) tot[dh][r] = g0 * oc[dh][r];
    }
    __syncthreads();
    { float* ip = (float*)(lds + L_IMP); const float* iv = (const float*)(lds + L_INV);
#pragma unroll
      for (int i = 0; i < 8; ++i) { const int idx = tid + 512 * i, tk = idx >> 6;
          ip[idx] = (ip[idx] * iv[tk] + ip[4096 + idx] * iv[64 + tk]) + (ip[8192 + idx] * iv[128 + tk] + ip[12288 + idx] * iv[192 + tk]); } }
    __syncthreads();
    { const int tok = tid >> 3, jg = tid & 7; unsigned* mk = (unsigned*)(lds + L_MASK) + tok * 2;
      if (qblk <= 15) { if (jg == 0) { const unsigned long long am = (1ull << (qblk + 1)) - 1ull; mk[0] = (unsigned)am; mk[1] = (unsigned)(am >> 32); } }
      else {
          const float* iv = (const float*)(lds + L_IMP) + tok * 64; float vj[8]; int rk[8];
#pragma unroll
          for (int jj = 0; jj < 8; ++jj) { vj[jj] = iv[jg * 8 + jj]; rk[jj] = 0; }
          for (int i = 1; i <= qblk - 2; ++i) { const float vi = iv[i];
#pragma unroll
              for (int jj = 0; jj < 8; ++jj) { const int j = jg * 8 + jj; rk[jj] += (vi > vj[jj] || (vi == vj[jj] && i < j)) ? 1 : 0; } }
          unsigned bits = 0u;
#pragma unroll
          for (int jj = 0; jj < 8; ++jj) { const int j = jg * 8 + jj; const bool cand = (j >= 1 && j <= qblk - 2);
              if ((cand && rk[jj] < 13) || j == 0 || j == qblk || j == qblk - 1) bits |= 1u << ((jg & 3) * 8 + jj); }
          if (bits) atomicOr(mk + (jg >> 2), bits);
      } }
    __syncthreads();
    if (tid < 64) { const unsigned* mk = (const unsigned*)(lds + L_MASK) + tid * 2; atomicOr((unsigned*)(lds + L_UM), mk[0]); atomicOr((unsigned*)(lds + L_UM) + 1, mk[1]); }
    __syncthreads();
    unsigned long long tmask, umask;
    { const unsigned* mk = (const unsigned*)(lds + L_MASK) + trel * 2; tmask = (unsigned long long)mk[0] | ((unsigned long long)mk[1] << 32);
      const unsigned* um = (const unsigned*)(lds + L_UM); umask = (unsigned long long)um[0] | ((unsigned long long)um[1] << 32); }
    float* stash = (float*)(lds + L_IMP) + (size_t)wave * 2048 + lane;
#pragma unroll
    for (int dh = 0; dh < 2; ++dh)
#pragma unroll
        for (int r = 0; r < 16; ++r) stash[(dh * 16 + r) * 64] = tot[dh][r];
    {
        f32x16 o[2]; o[0] = (f32x16){}; o[1] = (f32x16){}; float mrun = 0.f, lrun = 0.f;
        attn_tiles<0>(lds, A.KS + (size_t)b * SEQ * 128 + kvh * 64, A.VS + (size_t)b * SEQ * 128 + kvh * 64, 0, qblk, umask, tmask, qblk, trel, qr, o, mrun, lrun, tid, r32, hi);
        lrun += __shfl_xor(lrun, 32);
        const float g1 = lrun > 0.f ? sigmoidf_(A.PROJ[m * NP + C_GATE + head * 3 + 1]) / lrun : 0.f;
#pragma unroll
        for (int dh = 0; dh < 2; ++dh)
#pragma unroll
            for (int r = 0; r < 16; ++r) stash[(dh * 16 + r) * 64] += g1 * o[dh][r];
    }
    {
        f32x16 o[2]; o[0] = (f32x16){}; o[1] = (f32x16){}; float mrun = 0.f, lrun = 0.f;
        const int jlo = qblk >= 8 ? qblk - 8 : 0;
        attn_tiles<1>(lds, A.KW + (size_t)b * SEQ * 128 + kvh * 64, A.VW + (size_t)b * SEQ * 128 + kvh * 64, jlo, qblk, ~0ull, ~0ull, qblk, trel, qr, o, mrun, lrun, tid, r32, hi);
        lrun += __shfl_xor(lrun, 32);
        const float g2 = lrun > 0.f ? sigmoidf_(A.PROJ[m * NP + C_GATE + head * 3 + 2]) / lrun : 0.f;
#pragma unroll
        for (int dh = 0; dh < 2; ++dh)
#pragma unroll
            for (int r = 0; r < 16; ++r) tot[dh][r] = stash[(dh * 16 + r) * 64] + g2 * o[dh][r];
    }
    bf16* mo = A.MIX + m * 1024 + 512 + head * 64;
#pragma unroll
    for (int dh = 0; dh < 2; ++dh)
#pragma unroll
        for (int a = 0; a < 4; ++a) { const int d0 = 32 * dh + 8 * a + 4 * hi;
            *(v2u*)(mo + d0) = (v2u){pk2(tot[dh][4 * a], tot[dh][4 * a + 1]), pk2(tot[dh][4 * a + 2], tot[dh][4 * a + 3])}; }
}

struct SAttArgs { const bf16* QB; const bf16* KS; const bf16* VS; const bf16* KW; const bf16* VW; const float* CKS; const float* CVS; const float* PROJ; const float* cache; const int* page_table; const float* state_win; bf16* MIX; int l; };
constexpr int S2_IMP = 0, S2_MK = 512, S2_ITEMS = 576, S2_OC = 1024, S2_MG = 8192;
constexpr int S2_MG_STRIDE = 4224;
template <bool F32> __device__ __forceinline__ void s2_block(const void* kbase, const void* vbase, int kstride, int nvalid, const bf16x8 (&qf)[2], const bool (&keep)[4][4], f32x4 (&O)[4], float& mrun, float& lrun, int fr, int fq) {
    f32x4 kraw[4][2][2]; bf16x8 kb[4][2]; f32x4 vraw[2][8]; v2u vb[2][8];
#pragma unroll
    for (int tk = 0; tk < 4; ++tk) { const int key = 16 * tk + fr, kc = key < nvalid ? key : nvalid - 1;
#pragma unroll
        for (int ks = 0; ks < 2; ++ks) {
            if (F32) { const float* p = (const float*)kbase + (size_t)kc * kstride + 32 * ks + 8 * fq; kraw[tk][ks][0] = *(const f32x4*)p; kraw[tk][ks][1] = *(const f32x4*)(p + 4); }
            else kb[tk][ks] = *(const bf16x8*)((const bf16*)kbase + (size_t)kc * 128 + 32 * ks + 8 * fq); } }
#pragma unroll
    for (int ks = 0; ks < 2; ++ks)
#pragma unroll
        for (int j = 0; j < 8; ++j) { const int key = 32 * ks + 16 * (j >> 2) + 4 * fq + (j & 3), kc = key < nvalid ? key : nvalid - 1;
            if (F32) vraw[ks][j] = *(const f32x4*)((const float*)vbase + (size_t)kc * kstride + 4 * fr);
            else vb[ks][j] = *(const v2u*)((const bf16*)vbase + (size_t)kc * 128 + 4 * fr); }
    __builtin_amdgcn_sched_barrier(0);
    f32x4 acc[4];
#pragma unroll
    for (int tk = 0; tk < 4; ++tk) { bf16x8 kx[2];
#pragma unroll
        for (int ks = 0; ks < 2; ++ks) { if (F32) { const f32x4 a = kraw[tk][ks][0], b = kraw[tk][ks][1]; kx[ks] = pack8(a.x, a.y, a.z, a.w, b.x, b.y, b.z, b.w); } else kx[ks] = kb[tk][ks]; }
        f32x4 a4 = {0.f, 0.f, 0.f, 0.f};
        a4 = __builtin_amdgcn_mfma_f32_16x16x32_bf16(kx[0], qf[0], a4, 0, 0, 0); a4 = __builtin_amdgcn_mfma_f32_16x16x32_bf16(kx[1], qf[1], a4, 0, 0, 0);
        acc[tk] = a4; }
    float mx = NEG_INF;
#pragma unroll
    for (int tk = 0; tk < 4; ++tk)
#pragma unroll
        for (int i = 0; i < 4; ++i) { if (!keep[tk][i]) acc[tk][i] = NEG_INF; mx = fmaxf(mx, acc[tk][i]); }
    mx = fmaxf(mx, __shfl_xor(mx, 16)); mx = fmaxf(mx, __shfl_xor(mx, 32));
    const float mn = fmaxf(mrun, mx), msafe = (mn == NEG_INF) ? 0.f : mn, alpha = ex2(mrun - msafe);
    float ls = 0.f;
#pragma unroll
    for (int tk = 0; tk < 4; ++tk)
#pragma unroll
        for (int i = 0; i < 4; ++i) { const float e = ex2(acc[tk][i] - msafe); acc[tk][i] = e; ls += e; }
    lrun = lrun * alpha + ls; mrun = mn;
#pragma unroll
    for (int td = 0; td < 4; ++td) O[td] *= alpha;
#pragma unroll
    for (int ks = 0; ks < 2; ++ks) {
        const bf16x8 pf = pack8(acc[2 * ks][0], acc[2 * ks][1], acc[2 * ks][2], acc[2 * ks][3], acc[2 * ks + 1][0], acc[2 * ks + 1][1], acc[2 * ks + 1][2], acc[2 * ks + 1][3]);
        float vv[8][4];
#pragma unroll
        for (int j = 0; j < 8; ++j) {
            if (F32) { const f32x4 v = vraw[ks][j]; vv[j][0] = v.x; vv[j][1] = v.y; vv[j][2] = v.z; vv[j][3] = v.w; }
            else { const v2u w = vb[ks][j]; vv[j][0] = bf2f((unsigned short)(w.x & 0xffffu)); vv[j][1] = bf2f((unsigned short)(w.x >> 16)); vv[j][2] = bf2f((unsigned short)(w.y & 0xffffu)); vv[j][3] = bf2f((unsigned short)(w.y >> 16)); } }
#pragma unroll
        for (int td = 0; td < 4; ++td) { const bf16x8 vx = pack8(vv[0][td], vv[1][td], vv[2][td], vv[3][td], vv[4][td], vv[5][td], vv[6][td], vv[7][td]);
            O[td] = __builtin_amdgcn_mfma_f32_16x16x32_bf16(vx, pf, O[td], 0, 0, 0); }
    }
}
__device__ __forceinline__ void nsa_sample_unit(const SAttArgs& A, unsigned char* lds, int unit, int tid) {
    const int sb = unit >> 1, kvh = unit & 1, l = A.l;
    const int lane = tid & 63, wave = __builtin_amdgcn_readfirstlane(tid >> 6), fr = lane & 15, fq = lane >> 4;
    const int qi = fr >> 2, qh = fr & 3;
    float* IMP = (float*)(lds + S2_IMP); unsigned* MK = (unsigned*)(lds + S2_MK); int* ITEMS = (int*)(lds + S2_ITEMS);
    const size_t mq = (size_t)MP + sb * 4 + qi;
    __syncthreads();
    if (tid < 8) MK[tid] = 0u;
    bf16x8 qf[2];
#pragma unroll
    for (int ks = 0; ks < 2; ++ks) qf[ks] = *(const bf16x8*)(A.QB + mq * 512 + (kvh * 4 + qh) * 64 + 32 * ks + 8 * fq);
    {
        f32x4 O[4]; float mrun = NEG_INF, lrun = 0.f;
#pragma unroll
        for (int td = 0; td < 4; ++td) O[td] = (f32x4){0.f, 0.f, 0.f, 0.f};
        bool keep[4][4];
#pragma unroll
        for (int tk = 0; tk < 4; ++tk)
#pragma unroll
            for (int i = 0; i < 4; ++i) keep[tk][i] = true;
        const float* ckf = A.CKS + ((size_t)sb * 64 * 2 + kvh) * 64; const float* cvf = A.CVS + ((size_t)sb * 64 * 2 + kvh) * 64;
        f32x4 acc[4];
#pragma unroll
        for (int tk = 0; tk < 4; ++tk) { bf16x8 kx[2];
#pragma unroll
            for (int ks = 0; ks < 2; ++ks) { const float* p = ckf + (size_t)(16 * tk + fr) * 128 + 32 * ks + 8 * fq; const f32x4 a = *(const f32x4*)p, b = *(const f32x4*)(p + 4); kx[ks] = pack8(a.x, a.y, a.z, a.w, b.x, b.y, b.z, b.w); }
            f32x4 a4 = {0.f, 0.f, 0.f, 0.f};
            a4 = __builtin_amdgcn_mfma_f32_16x16x32_bf16(kx[0], qf[0], a4, 0, 0, 0); a4 = __builtin_amdgcn_mfma_f32_16x16x32_bf16(kx[1], qf[1], a4, 0, 0, 0);
            acc[tk] = a4; }
        float mx = NEG_INF;
#pragma unroll
        for (int tk = 0; tk < 4; ++tk)
#pragma unroll
            for (int i = 0; i < 4; ++i) mx = fmaxf(mx, acc[tk][i]);
        mx = fmaxf(mx, __shfl_xor(mx, 16)); mx = fmaxf(mx, __shfl_xor(mx, 32));
        float ls = 0.f;
#pragma unroll
        for (int tk = 0; tk < 4; ++tk)
#pragma unroll
            for (int i = 0; i < 4; ++i) { const float e = ex2(acc[tk][i] - mx); acc[tk][i] = e; ls += e; }
        ls += __shfl_xor(ls, 16); ls += __shfl_xor(ls, 32);
        const float inv = 1.f / fmaxf(ls, 1e-30f);
        if (wave == 0) {
#pragma unroll
            for (int tk = 0; tk < 4; ++tk)
#pragma unroll
                for (int b2 = 0; b2 < 2; ++b2) { float v = (acc[tk][2 * b2] + acc[tk][2 * b2 + 1]) * inv;
                    v += __shfl_xor(v, 1); v += __shfl_xor(v, 2);
                    if (qh == 0) IMP[qi * 32 + 8 * tk + 2 * fq + b2] = v; }
#pragma unroll
            for (int ks = 0; ks < 2; ++ks) {
                const bf16x8 pf = pack8(acc[2 * ks][0], acc[2 * ks][1], acc[2 * ks][2], acc[2 * ks][3], acc[2 * ks + 1][0], acc[2 * ks + 1][1], acc[2 * ks + 1][2], acc[2 * ks + 1][3]);
#pragma unroll
                for (int td = 0; td < 4; ++td) { float vv[8];
#pragma unroll
                    for (int j = 0; j < 8; ++j) { const int key = 32 * ks + 16 * (j >> 2) + 4 * fq + (j & 3); vv[j] = cvf[(size_t)key * 128 + 4 * fr + td]; }
                    const bf16x8 vx = pack8(vv[0], vv[1], vv[2], vv[3], vv[4], vv[5], vv[6], vv[7]);
                    O[td] = __builtin_amdgcn_mfma_f32_16x16x32_bf16(vx, pf, O[td], 0, 0, 0); } }
            const float g0 = sigmoidf_(A.PROJ[mq * NP + C_GATE + (kvh * 4 + qh) * 3 + 0]) * inv;
            float* OC = (float*)(lds + S2_OC);
#pragma unroll
            for (int td = 0; td < 4; ++td)
#pragma unroll
                for (int i = 0; i < 4; ++i) OC[(16 * fq + 4 * i + td) * 16 + fr] = g0 * O[td][i];
        }
        (void)mrun; (void)lrun; (void)keep;
    }
    __syncthreads();
    if (tid < 128) { const int i = tid >> 5, j = tid & 31; bool sel = (j == 0 || j == 31);
        if (j >= 1 && j <= 30) { const float vj = IMP[i * 32 + j]; int rk = 0;
            for (int q = 1; q <= 30; ++q) { const float vi = IMP[i * 32 + q]; rk += (vi > vj || (vi == vj && q < j)) ? 1 : 0; }
            sel = rk < 13; }
        if (sel) { atomicOr(MK + i, 1u << j); atomicOr(MK + 4, 1u << j); } }
    __syncthreads();
    if (tid == 0) { const unsigned um = MK[4]; int n = 0;
        for (int j = 0; j < 32; ++j) if ((um >> j) & 1u) ITEMS[1 + n++] = j;
        ITEMS[1 + n++] = 32;
        for (int jb = 0; jb < 9; ++jb) ITEMS[1 + n++] = 64 + jb;
        ITEMS[0] = n; }
    __syncthreads();
    {
        const int nitems = ITEMS[0]; const unsigned tm = MK[qi];
        f32x4 Os[4], Ow[4]; float ms = NEG_INF, lsum = 0.f, mw = NEG_INF, lw = 0.f;
#pragma unroll
        for (int td = 0; td < 4; ++td) { Os[td] = (f32x4){0.f, 0.f, 0.f, 0.f}; Ow[td] = (f32x4){0.f, 0.f, 0.f, 0.f}; }
        const float* wb = A.state_win + ((size_t)l * NSB + sb) * 512 * 256 + kvh * 64;
        for (int it = wave; it < nitems; it += NWAVES) {
            const int code = ITEMS[1 + it]; bool keep[4][4];
            if (code < 64) {
                const int j = code;
                if (j < 32) { const int phys = A.page_table[sb * NPAGES + (j >> 1)];
                    const float* base = A.cache + ((((size_t)l * NPOOL + phys) * 2 + kvh) * 128 + (j & 1) * 64) * 256;
                    const bool tsel = ((tm >> j) & 1u) != 0u;
#pragma unroll
                    for (int tk = 0; tk < 4; ++tk)
#pragma unroll
                        for (int i = 0; i < 4; ++i) keep[tk][i] = tsel;
                    s2_block<true>(base + 128, base + 192, 256, 64, qf, keep, Os, ms, lsum, fr, fq);
                } else {
#pragma unroll
                    for (int tk = 0; tk < 4; ++tk)
#pragma unroll
                        for (int i = 0; i < 4; ++i) { const int key = 16 * tk + 4 * fq + i; keep[tk][i] = key <= qi; }
                    s2_block<false>(A.KS + ((size_t)MP + sb * 4) * 128 + kvh * 64, A.VS + ((size_t)MP + sb * 4) * 128 + kvh * 64, 128, 4, qf, keep, Os, ms, lsum, fr, fq);
                }
            } else {
                const int jb = code - 64;
                if (jb < 8) {
#pragma unroll
                    for (int tk = 0; tk < 4; ++tk)
#pragma unroll
                        for (int i = 0; i < 4; ++i) { const int r = 64 * jb + 16 * tk + 4 * fq + i; keep[tk][i] = r >= qi; }
                    s2_block<true>(wb + (size_t)(64 * jb) * 256, wb + (size_t)(64 * jb) * 256 + 128, 256, 64, qf, keep, Ow, mw, lw, fr, fq);
                } else {
#pragma unroll
                    for (int tk = 0; tk < 4; ++tk)
#pragma unroll
                        for (int i = 0; i < 4; ++i) { const int key = 16 * tk + 4 * fq + i; keep[tk][i] = key <= qi; }
                    s2_block<false>(A.KW + ((size_t)MP + sb * 4) * 128 + kvh * 64, A.VW + ((size_t)MP + sb * 4) * 128 + kvh * 64, 128, 4, qf, keep, Ow, mw, lw, fr, fq);
                }
            }
        }
        lsum += __shfl_xor(lsum, 16); lsum += __shfl_xor(lsum, 32); lw += __shfl_xor(lw, 16); lw += __shfl_xor(lw, 32);
        float* Ps = (float*)(lds + S2_MG + (wave * 2 + 0) * S2_MG_STRIDE); float* Pw = (float*)(lds + S2_MG + (wave * 2 + 1) * S2_MG_STRIDE);
#pragma unroll
        for (int td = 0; td < 4; ++td)
#pragma unroll
            for (int i = 0; i < 4; ++i) { Ps[(16 * fq + 4 * i + td) * 16 + fr] = Os[td][i]; Pw[(16 * fq + 4 * i + td) * 16 + fr] = Ow[td][i]; }
        if (fq == 0) { Ps[1024 + fr] = ms; Ps[1040 + fr] = lsum; Pw[1024 + fr] = mw; Pw[1040 + fr] = lw; }
    }
    __syncthreads();
    {
        const int q = tid & 15, i = q >> 2, hh = q & 3; const size_t m = (size_t)MP + sb * 4 + i;
        const float* OC = (const float*)(lds + S2_OC);
        float res[2];
#pragma unroll
        for (int k = 0; k < 2; ++k) res[k] = OC[((tid >> 4) + 32 * k) * 16 + q];
#pragma unroll
        for (int br = 0; br < 2; ++br) {
            float M = NEG_INF;
#pragma unroll
            for (int w = 0; w < NWAVES; ++w) M = fmaxf(M, ((const float*)(lds + S2_MG + (w * 2 + br) * S2_MG_STRIDE))[1024 + q]);
            float L = 0.f, o0 = 0.f, o1 = 0.f;
#pragma unroll
            for (int w = 0; w < NWAVES; ++w) { const float* P = (const float*)(lds + S2_MG + (w * 2 + br) * S2_MG_STRIDE);
                const float f = ex2(P[1024 + q] - M);
                L += P[1040 + q] * f; o0 += P[(tid >> 4) * 16 + q] * f; o1 += P[((tid >> 4) + 32) * 16 + q] * f; }
            const float g = sigmoidf_(A.PROJ[m * NP + C_GATE + (kvh * 4 + hh) * 3 + 1 + br]) / fmaxf(L, 1e-30f);
            res[0] += g * o0; res[1] += g * o1;
        }
#pragma unroll
        for (int k = 0; k < 2; ++k) A.MIX[m * 1024 + 512 + (kvh * 4 + hh) * 64 + (tid >> 4) + 32 * k] = (bf16)f2bf(res[k]);
    }
}

constexpr int CW_CMPQ = 256;
__device__ __forceinline__ void compress_pull(const CmpArgs& A, unsigned char* lds, unsigned* head, volatile LAS int* slot, int max_batches, int tid) {
    for (int nb = 0; nb < max_batches; ++nb) {
        __syncthreads();
        if (tid == 0) *slot = (int)__hip_atomic_fetch_add(head, 1u, __ATOMIC_RELAXED, __HIP_MEMORY_SCOPE_AGENT);
        __syncthreads();
        const int b = *slot;
        if (b >= 256) break;
        compress_batch(A, lds, b, true, tid);
    }
    __syncthreads();
}

struct Args { const GAS void* in[22]; GAS float* out; GAS unsigned char* ws; int ph_lo, ph_hi; };
constexpr int PH_PER_LAYER = 10, N_PHASES = 1 + NL * PH_PER_LAYER;
__global__ void __launch_bounds__(NWAVES * 64, 2) hymba_fwd(Args args) {
    extern __shared__ __attribute__((aligned(16))) unsigned char lds[];
    const int G = gridDim.x, bx = blockIdx.x, NGW = G * NWAVES;
    const int wave_s_ = __builtin_amdgcn_readfirstlane((int)threadIdx.x >> 6);
#define TID_NOW() (wave_s_ * 64 + (int)__builtin_amdgcn_mbcnt_hi(~0u, __builtin_amdgcn_mbcnt_lo(~0u, 0u)))
#define SUB_IDS int tid = TID_NOW(); asm volatile("" : "+v"(tid)); const int lane = tid & 63, wave = __builtin_amdgcn_readfirstlane(tid >> 6), gw = bx * NWAVES + wave; (void)lane; (void)gw; (void)wave;
#define PHASE_IDS int tid = TID_NOW(); asm volatile("" : "+v"(tid)); const int lane = tid & 63, wave = __builtin_amdgcn_readfirstlane(tid >> 6), gw = bx * NWAVES + wave; (void)lane; (void)gw; const __attribute__((address_space(4))) unsigned long long* ka_ = (const __attribute__((address_space(4))) unsigned long long*)__builtin_amdgcn_kernarg_segment_ptr(); asm volatile("" : "+s"(ka_)); GAS unsigned char* wsg_ = (GAS unsigned char*)ka_[23]; unsigned char* wsl = (unsigned char*)wsg_;
#define x_prompt ((const float*)(const GAS float*)ka_[0])
#define x_sample ((const float*)(const GAS float*)ka_[1])
#define cache_kv ((const float*)(const GAS float*)ka_[2])
#define page_table ((const int*)(const GAS int*)ka_[3])
#define state_win ((const float*)(const GAS float*)ka_[4])
#define state_gdn ((const float*)(const GAS float*)ka_[5])
#define state_conv ((const float*)(const GAS float*)ka_[6])
#define norm_mix ((const float*)(const GAS float*)ka_[7])
#define w_in ((const float*)(const GAS float*)ka_[8])
#define conv_w ((const float*)(const GAS float*)ka_[9])
#define a_log ((const float*)(const GAS float*)ka_[10])
#define dt_bias ((const float*)(const GAS float*)ka_[11])
#define gdn_norm ((const float*)(const GAS float*)ka_[12])
#define cmp_pe_k ((const float*)(const GAS float*)ka_[13])
#define cmp_w_k ((const float*)(const GAS float*)ka_[14])
#define cmp_pe_v ((const float*)(const GAS float*)ka_[15])
#define cmp_w_v ((const float*)(const GAS float*)ka_[16])
#define w_out ((const float*)(const GAS float*)ka_[17])
#define norm_mlp ((const float*)(const GAS float*)ka_[18])
#define w_up ((const float*)(const GAS float*)ka_[19])
#define w_down ((const float*)(const GAS float*)ka_[20])
#define norm_final ((const float*)(const GAS float*)ka_[21])
#define out ((float*)(GAS float*)ka_[22])
#define WIN_T ((bf16*)(wsl + WS_WIN))
#define WOUT_T ((bf16*)(wsl + WS_WOUT))
#define WUP_T ((bf16*)(wsl + WS_WUP))
#define WDN_T ((bf16*)(wsl + WS_WDN))
#define CMPW ((bf16*)(wsl + WS_CMPW))
#define HB ((bf16*)(wsl + WS_HB))
#define PROJ ((float*)(wsl + WS_PROJ))
#define X1 ((bf16*)(wsl + WS_X1 + (size_t)l * XL_BYTES))
#define X2 ((bf16*)(wsl + WS_X2 + (size_t)l * XL_BYTES))
#define X1P ((bf16*)(wsl + WS_X1 + (size_t)(l - 1) * XL_BYTES))
#define X2P ((bf16*)(wsl + WS_X2 + (size_t)(l - 1) * XL_BYTES))
#define MIX ((bf16*)(wsl + WS_MIX))
#define HID ((bf16*)(wsl + WS_HID))
#define QN ((float*)(wsl + WS_QN))
#define KN ((float*)(wsl + WS_KN))
#define VG ((float*)(wsl + WS_VG))
#define OG ((float*)(wsl + (l == 0 ? WS_OG : WS_OG2)))
#define GG ((float*)(wsl + WS_G))
#define BETA ((float*)(wsl + WS_BETA))
#define KQ ((float*)(wsl + WS_KQ))
#define QB ((bf16*)(wsl + WS_QB))
#define KS ((bf16*)(wsl + WS_KS))
#define VS ((bf16*)(wsl + WS_VS))
#define KW ((bf16*)(wsl + WS_KW))
#define VW ((bf16*)(wsl + WS_VW))
#define CKP ((float*)(wsl + WS_CKP))
#define CVP ((float*)(wsl + WS_CVP))
#define CKS ((float*)(wsl + WS_CKS))
#define CVS ((float*)(wsl + WS_CVS))
#define GK ((bf16*)(wsl + WS_GK))
#define GQ ((bf16*)(wsl + WS_GQ))
#define GKT ((bf16*)(wsl + WS_GKT))
#define GVT ((bf16*)(wsl + WS_GVT))
#define GG2 ((float*)(wsl + WS_GG2))
#define BETA2 ((float*)(wsl + WS_BETA2))
#define WX ((bf16*)(wsl + WS_WX))
#define QX ((bf16*)(wsl + WS_QX))
#define QKX ((bf16*)(wsl + WS_QKX))
#define KTX ((bf16*)(wsl + WS_KTX))
#define U0F ((float*)(wsl + WS_U0F))
#define GL ((float*)(wsl + WS_GL))
#define PARTD ((float*)(wsl + WS_PARTD))
#define SSQ ((float*)(wsl + WS_SS))
#define RSS(s) ((float*)(wsl + WS_RS) + (size_t)(s) * RS_STRIDE)
#define PARTG ((float*)(wsl + WS_PARTG))
    LAS unsigned char* ldsl = (LAS unsigned char*)lds;

    const int lo = args.ph_lo, hi = args.ph_hi;
    { const int t0_ = TID_NOW(); if (t0_ < 16) ((LAS unsigned*)(ldsl + MISC_OFF))[t0_] = 0u; }
    __syncthreads();
    XcdBarrier bar = xcd_barrier_post((unsigned*)((unsigned char*)args.ws + WS_CTL) + CW_BAR, (volatile LAS unsigned*)(ldsl + MISC_OFF), TID_NOW() == 0);
#define BOTH(k) (lo <= (k) && (k) + 1 < hi)
#define GRID_BAR(k) do { if (BOTH(k)) { for (int rb_ = 0; rb_ < REP_BAR; ++rb_) xcd_barrier(bar, TID_NOW() == 0); } } while (0)
#ifndef REP_PG
#define REP_PG 1
#endif
#ifndef REP_PA
#define REP_PA 1
#endif
#ifndef REP_BAR
#define REP_BAR 1
#endif
#ifndef REP_GSMP
#define REP_GSMP 1
#endif
#ifndef REP_P0
#define REP_P0 1
#endif
#ifndef REP_LIGHT
#define REP_LIGHT 1
#endif
#ifndef REP_PB_ROW
#define REP_PB_ROW 1
#endif
#ifndef REP_PB_PREP
#define REP_PB_PREP 1
#endif
#ifndef REP_PB_CMP
#define REP_PB_CMP 1
#endif
#ifndef REP_PB_COPY
#define REP_PB_COPY 1
#endif
#ifndef REP_PB2
#define REP_PB2 1
#endif
#ifndef REP_SCAN
#define REP_SCAN 1
#endif
#ifndef REP_ATTP
#define REP_ATTP 1
#endif
#ifndef REP_ATTS
#define REP_ATTS 1
#endif
#ifndef REP_GEMM
#define REP_GEMM 1
#endif
#define EN(i) (((PH_MASK_T) >> (i)) & 1u)
#define SUB(i) (((SUB_MASK_T) >> (i)) & 1u)
#define IN(k) (lo <= (k) && (k) < hi)

    if (IN(0)) { PHASE_IDS
        for (int rep0 = 0; rep0 < REP_P0; ++rep0) {
        LAS float* scr = (LAS float*)(ldsl + wave * 16384);
        constexpr int I_IN = 16 * 112, I_OUT = 16 * 32, I_UP = 16 * 128, I_DN = 64 * 32, I_C = 32 * 2, I_L = I_IN + I_OUT + I_UP + I_DN + 2 * I_C;
        for (int it = gw; it < NL * I_L; it += NGW) {
            const int l = it / I_L; int r = it % I_L;
            if (l > 0 && r < I_IN + I_OUT + I_UP + I_DN) continue;
            if (r < I_IN) { transpose_item(w_in + (size_t)l * DM * NPROJ, DM, NPROJ, NP, WIN_T + (size_t)l * NP * DM, scr, r, lane, l > 0 ? norm_mix + (size_t)l * DM : nullptr); continue; } r -= I_IN;
            if (r < I_OUT) { transpose_item(w_out + (size_t)l * DM * DM, DM, DM, DM, WOUT_T + (size_t)l * DM * DM, scr, r, lane); continue; } r -= I_OUT;
            if (r < I_UP) { transpose_item(w_up + (size_t)l * DM * DFF, DM, DFF, DFF, WUP_T + (size_t)l * DFF * DM, scr, r, lane, norm_mlp + (size_t)l * DM); continue; } r -= I_UP;
            if (r < I_DN) { transpose_item(w_down + (size_t)l * DFF * DM, DFF, DM, DM, WDN_T + (size_t)l * DM * DFF, scr, r, lane); continue; } r -= I_DN;
            if (r < I_C) { transpose_item(cmp_w_k + (size_t)l * 2048 * 64, 2048, 64, 64, CMPW + (size_t)((l * 2 + 0) * 64) * 2048, scr, r, lane); continue; } r -= I_C;
            transpose_item(cmp_w_v + (size_t)l * 2048 * 64, 2048, 64, 64, CMPW + (size_t)((l * 2 + 1) * 64) * 2048, scr, r, lane);
        }
        for (int m = gw; m < MT; m += NGW) { const float* xr = (m < MP) ? x_prompt + (size_t)m * DM : x_sample + (size_t)(m - MP) * DM; rms_row(xr, false, norm_mix, HB + (size_t)m * DM, nullptr, lane); }
        for (int m = bx * NWAVES * 64 + tid; m < MT; m += G * NWAVES * 64) RSS(0)[m < MP ? m : MP + (m - MP) * 32] = 1.f;
        }
    }

    GRID_BAR(0);
    for (int l = 0; l < NL; ++l) {
        const int pb = 1 + l * PH_PER_LAYER;
        if (IN(pb + 0)) { PHASE_IDS
            unsigned* gate = (unsigned*)(wsl + WS_CTL) + CW_GATE + 64 * (2 * l);
            if (l > 0) {
                if (wave == 0) { for (int m = bx * 64 + lane; m < MP; m += G * 64) rs_from_parts(SSQ, RSS(2 * l), m); }
                else for (int m = MP + bx * (NWAVES - 1) + wave - 1; m < MT; m += G * (NWAVES - 1))
                    resid_parts_row(X1P + (size_t)m * DM, true, PARTG + (size_t)(m - MP) * DM, PG_KS, (size_t)MS * DM, X2P + (size_t)m * DM, RSS(2 * l) + MP + (m - MP) * 32, lane);
                asm volatile("s_waitcnt vmcnt(0)" ::: "memory"); __syncthreads();
                if (TID_NOW() == 0) {
                    const unsigned nloc = bar.st[0], old = xb_add(gate + 1 + bar.x, 1u);
                    if (old + 1u == nloc) { __builtin_amdgcn_fence(__ATOMIC_RELEASE, "agent"); asm volatile("s_waitcnt vmcnt(0)" ::: "memory"); (void)xb_add(gate, nloc); } } }
            const unsigned gtarget = (l > 0) ? (unsigned)G : 0u;
            pg8::Gemm g{(l == 0) ? HB : X2P, WIN_T + (size_t)l * NP * DM, MT, NP, DM, DM}; pg8::StaticOrderG S; S.init(MT, NP, G, bx); S.f = gate; S.target = gtarget; S.pmw = MP / 256; S.ok = false;
            pg8::EpiF32 E{PROJ, NP, RSS(2 * l), MP, gate, gtarget, false};
            _Pragma("unroll 1") for (int rep = 0; rep < REP_PA; ++rep) pg8::gemm_phase<pg8::EpiF32, pg8::StaticOrderG, true, true>(ldsl, g, S, E, tid);
            if (l == 0 && bx >= (MT / 256) * (NP / 256) % G) { SUB_IDS CmpArgs CA{PROJ, cache_kv, page_table, cmp_pe_k, cmp_pe_v, CMPW, wsl, 0};
                compress_pull(CA, lds, (unsigned*)(wsl + WS_CTL) + CW_CMPQ, (volatile LAS int*)(ldsl + MISC_OFF + 36), 1, tid); }
        }
        GRID_BAR(pb + 0);
        if (IN(pb + 1)) { PHASE_IDS
            { SUB_IDS PBArgs A{PROJ, state_conv, conv_w, a_log, dt_bias, QN, KN, VG, GG, BETA, KQ, QB, KS, VS, KW, VW, out, l};
              for (int rep = 0; rep < REP_PB_ROW; ++rep) if (gw >= 128) for (int m = gw - 128; m < MT; m += 2 * (NGW - 128)) {
                  const int m2 = m + (NGW - 128); const bool has2 = m2 < MT; PBRegs r0, r1;
                  pb_row_load(A, m, lane, r0); pb_row_load(A, has2 ? m2 : m, lane, r1);
                  __builtin_amdgcn_sched_barrier(0);
                  pb_row(A, m, lane, r0); if (has2) pb_row(A, m2, lane, r1); }
              for (int u = gw; u < MS * 8; u += NGW) pb_sample_head(A, u, lane); }
            { SUB_IDS GPArgs A{PROJ, conv_w, a_log, dt_bias, GK, GQ, GKT, GVT, GG2, BETA2, l};
              for (int rep = 0; rep < REP_PB_PREP; ++rep) for (int u = gw; u < (MP / 8) * 8; u += 2 * NGW) {
                  GPRegs r0, r1; const int u2 = (u + NGW < (MP / 8) * 8) ? u + NGW : u; gdn_prep_load(A, u, lane, r0); gdn_prep_load(A, u2, lane, r1);
                  __builtin_amdgcn_sched_barrier(0);
                  gdn_prep_unit(A, u, lane, r0); gdn_prep_unit(A, u2, lane, r1); } }
            { SUB_IDS CmpArgs A{PROJ, cache_kv, page_table, cmp_pe_k, cmp_pe_v, CMPW, wsl, l};
              if (bx < 16) compress_batch(A, lds, bx, false, tid);
              compress_pull(A, lds, (unsigned*)(wsl + WS_CTL) + CW_CMPQ + 64 * l, (volatile LAS int*)(ldsl + MISC_OFF + 36), 1 << 20, tid); }
        }
        GRID_BAR(pb + 1);
        if (IN(pb + 2)) { PHASE_IDS
            GCArgs A{GK, GQ, GKT, GVT, GG2, BETA2, WX, QX, QKX, KTX, U0F, GL};
            for (int rep = 0; rep < REP_PB2; ++rep) for (int u = gw; u < 32 * 64; u += NGW) gdn_chunk_unit(A, lds + wave * GC_LDS_PER_WAVE, u, lane);
        }
        GRID_BAR(pb + 2);
        if (IN(pb + 3)) {
            { PHASE_IDS GdnArgs GA{QN, KN, VG, GG, BETA, KQ, OG, PROJ, state_gdn, gdn_norm, MIX, out, l};
                for (int rep = 0; rep < REP_GSMP; ++rep) for (int u = gw; u < NSB * 8; u += NGW) gdn_sample_unit(GA, u, lane); }
            { PHASE_IDS
                GS2Args SG{WX, QX, QKX, KTX, U0F, GL, OG, out, l};
                AttArgs AA{QB, KS, VS, KW, VW, CKP, CVP, PROJ, MIX};
                SAttArgs SA{QB, KS, VS, KW, VW, CKS, CVS, PROJ, cache_kv, page_table, state_win, MIX, l};
                unsigned* qhead = (unsigned*)(wsl + WS_CTL) + CW_QUEUE + 64 * l;
                volatile LAS int* slot = (volatile LAS int*)(ldsl + MISC_OFF + 32);
                for (;;) {
                    __syncthreads();
                    if (tid == 0) *slot = (int)__hip_atomic_fetch_add(qhead, 1u, __ATOMIC_RELAXED, __HIP_MEMORY_SCOPE_AGENT);
                    __syncthreads();
                    int u = *slot;
                    constexpr int XP = (REP_ATTP - 1) * 512, XS = (REP_ATTS - 1) * 256, XG = (REP_SCAN - 1) * 32;
                    constexpr int NTRU = (16 * 112 + 16 * 32 + 16 * 128 + 64 * 32) / 8;
                    const int ntr = (l + 1 < NL) ? NTRU : 0;
                    if (u >= 800 + XP + XS + XG + 128 + ntr + 256) break;
                    if (u >= 800 + XP + XS + XG + 128 && u < 800 + XP + XS + XG + 128 + ntr) {
                        const __attribute__((address_space(4))) unsigned long long* ka_ = (const __attribute__((address_space(4))) unsigned long long*)__builtin_amdgcn_kernarg_segment_ptr(); asm volatile("" : "+s"(ka_));
                        int tq2 = TID_NOW(); asm volatile("" : "+v"(tq2));
                        const int wv = __builtin_amdgcn_readfirstlane(tq2 >> 6), ln = tq2 & 63, l1 = l + 1; int r = (u - (800 + XP + XS + XG + 128)) * 8 + wv;
                        LAS float* scr = (LAS float*)(ldsl + wv * 16384);
                        constexpr int I_IN = 16 * 112, I_OUT = 16 * 32, I_UP = 16 * 128;
                        if (r < I_IN) transpose_item(w_in + (size_t)l1 * DM * NPROJ, DM, NPROJ, NP, WIN_T + (size_t)l1 * NP * DM, scr, r, ln, norm_mix + (size_t)l1 * DM);
                        else if (r < I_IN + I_OUT) transpose_item(w_out + (size_t)l1 * DM * DM, DM, DM, DM, WOUT_T + (size_t)l1 * DM * DM, scr, r - I_IN, ln);
                        else if (r < I_IN + I_OUT + I_UP) transpose_item(w_up + (size_t)l1 * DM * DFF, DM, DFF, DFF, WUP_T + (size_t)l1 * DFF * DM, scr, r - I_IN - I_OUT, ln, norm_mlp + (size_t)l1 * DM);
                        else transpose_item(w_down + (size_t)l1 * DFF * DM, DFF, DM, DM, WDN_T + (size_t)l1 * DM * DFF, scr, r - I_IN - I_OUT - I_UP, ln);
                        continue; }
                    if (u >= 800 + XP + XS + XG + 128 + ntr) {
                        const int j = u - (800 + XP + XS + XG + 128 + ntr), wv = __builtin_amdgcn_readfirstlane(tid >> 6), ln = tid & 63;
                        pg8::flag_spin((unsigned*)(wsl + WS_CTL) + CW_SCAN + 64 * l + (j >> 6), 8u);
                        const float gnl = gdn_norm[l * 64 + ln];
                        for (int r = 0; r < 8; r += 2) { const int m0 = 64 * j + wv * 8 + r;
                            float ov[2][8], zv[2][8];
#pragma unroll
                            for (int q = 0; q < 2; ++q)
#pragma unroll
                                for (int h = 0; h < 8; ++h) { ov[q][h] = OG[(size_t)(m0 + q) * 512 + h * 64 + ln]; zv[q][h] = PROJ[(size_t)(m0 + q) * NP + C_Z + h * 64 + ln]; }
                            __builtin_amdgcn_sched_barrier(0);
#pragma unroll
                            for (int q = 0; q < 2; ++q)
#pragma unroll
                                for (int h = 0; h < 8; ++h) { const float ms = dpp_sum(ov[q][h] * ov[q][h]) * (1.f / 64.f);
                                    MIX[(size_t)(m0 + q) * 1024 + h * 64 + ln] = (bf16)f2bf(ov[q][h] * (1.f / sqrtf(ms + 1e-6f)) * gnl * siluf_(zv[q][h])); } }
                        continue; }
                    if (u >= 32 && u < 928) { const int g_ = (u - 32) / 7, k_ = (u - 32) % 7;
                        u = (k_ < 4) ? 32 + 4 * g_ + k_ : (k_ < 6) ? 544 + 2 * g_ + (k_ - 4) : 800 + g_; }
                    if (u >= 800 + XP + XS + XG) {
                        const int sb = u - (800 + XP + XS + XG); const f32x4* src = (const f32x4*)(state_win + ((size_t)l * NSB + sb) * 512 * 256) + 256; f32x4* dst = (f32x4*)(out + O_WINS + ((size_t)l * NSB + sb) * 512 * 256);
                        for (int i = tid; i < 508 * 64; i += 8 * NWAVES * 64) { f32x4 v[8];
#pragma unroll
                            for (int k = 0; k < 8; ++k) { const int ii = i + k * NWAVES * 64; v[k] = src[ii < 508 * 64 ? ii : i]; }
#pragma unroll
                            for (int k = 0; k < 8; ++k) { const int ii = i + k * NWAVES * 64; if (ii < 508 * 64) dst[ii] = v[k]; } }
                        continue; }
                    if (u >= 800) { int v = u - 800; if (v < XP) u = 32 + (v & 511); else { v -= XP; if (v < XS) u = 544 + (v & 255); else u = (v - XS) & 31; } }
                    int tq = TID_NOW(); asm volatile("" : "+v"(tq));
                    if (u < 32) { gdn_scan3_block(SG, lds, u, tq);
                        asm volatile("s_waitcnt vmcnt(0)" ::: "memory"); __syncthreads();
                        if (tq == 0) { __builtin_amdgcn_fence(__ATOMIC_RELEASE, "agent"); asm volatile("s_waitcnt vmcnt(0)" ::: "memory"); (void)xb_add((unsigned*)(wsl + WS_CTL) + CW_SCAN + 64 * l + (u >> 3), 1u); } }
                    else if (u < 32 + 512) nsa_prompt_unit(AA, lds, u - 32, tq);
                    else nsa_sample_unit(SA, lds, u - 544, tq);
                }
            }
        }
        GRID_BAR(pb + 3);
        if (IN(pb + 5)) { PHASE_IDS
            { pg8::Gemm g{MIX, WOUT_T + (size_t)l * DM * DM, MP, DM, DM, DM}; pg8::StaticOrder S; S.init(MP, DM, G, bx);
              pg8::EpiResid E{(l == 0) ? (const void*)x_prompt : (const void*)X2P, l != 0, X1, DM, SSQ};
              pg8::gemm_phase<pg8::EpiResid, pg8::StaticOrder, true, true>(ldsl, g, S, E, tid); }
            { pg8::Gemm g{MIX, WOUT_T + (size_t)l * DM * DM, MT, DM, PD_KL, DM}; pg8::SplitKOrder S; S.init(MP / 256, MS / 256, DM / 256, PD_KS, PD_KL, G, bx);
              pg8::EpiPart E{PARTD, DM, MP, MS};
              pg8::gemm_phase<pg8::EpiPart, pg8::SplitKOrder, false, true>(ldsl, g, S, E, tid); }
        }
        GRID_BAR(pb + 5);
        if (IN(pb + 7)) { PHASE_IDS
            unsigned* gate = (unsigned*)(wsl + WS_CTL) + CW_GATE + 64 * (2 * l + 1);
            {
                if (wave == 0) { for (int m = bx * 64 + lane; m < MP; m += G * 64) rs_from_parts(SSQ, RSS(2 * l + 1), m); }
                else for (int m = MP + bx * (NWAVES - 1) + wave - 1; m < MT; m += G * (NWAVES - 1)) { const void* bs = (l == 0) ? (const void*)(x_sample + (size_t)(m - MP) * DM) : (const void*)(X2P + (size_t)m * DM);
                    resid_parts_row(bs, l != 0, PARTD + (size_t)(m - MP) * DM, PD_KS, (size_t)MS * DM, X1 + (size_t)m * DM, RSS(2 * l + 1) + MP + (m - MP) * 32, lane); }
                asm volatile("s_waitcnt vmcnt(0)" ::: "memory"); __syncthreads();
                if (TID_NOW() == 0) {
                    const unsigned nloc = bar.st[0], old = xb_add(gate + 1 + bar.x, 1u);
                    if (old + 1u == nloc) { __builtin_amdgcn_fence(__ATOMIC_RELEASE, "agent"); asm volatile("s_waitcnt vmcnt(0)" ::: "memory"); (void)xb_add(gate, nloc); } } }
            pg8::Gemm g{X1, WUP_T + (size_t)l * DFF * DM, MT, DFF, DM, DM}; pg8::StaticOrderG S; S.init(MT, DFF, G, bx); S.f = gate; S.target = (unsigned)G; S.pmw = MP / 256; S.ok = false;
            pg8::EpiRelu2 E{HID, DFF, RSS(2 * l + 1), MP, gate, (unsigned)G, false};
            pg8::gemm_phase<pg8::EpiRelu2, pg8::StaticOrderG, true, true>(ldsl, g, S, E, tid);
            if (l + 1 < NL && bx >= (MT / 256) * (DFF / 256) % G) { SUB_IDS CmpArgs CA{PROJ, cache_kv, page_table, cmp_pe_k, cmp_pe_v, CMPW, wsl, l + 1};
                compress_pull(CA, lds, (unsigned*)(wsl + WS_CTL) + CW_CMPQ + 64 * (l + 1), (volatile LAS int*)(ldsl + MISC_OFF + 36), 1, tid); }
        }
        GRID_BAR(pb + 7);
        if (IN(pb + 8)) { PHASE_IDS
            { pg8::Gemm g{HID, WDN_T + (size_t)l * DM * DFF, MP, DM, DFF, DFF}; pg8::StaticOrder S; S.init(MP, DM, G, bx);
              pg8::EpiResid E{(const void*)X1, true, X2, DM, SSQ};
              pg8::gemm_phase<pg8::EpiResid, pg8::StaticOrder, true, true>(ldsl, g, S, E, tid); }
            { pg8::Gemm g{HID, WDN_T + (size_t)l * DM * DFF, MT, DM, PG_KL, DFF}; pg8::SplitKOrder S; S.init(MP / 256, MS / 256, DM / 256, PG_KS, PG_KL, G, bx);
              pg8::EpiPart E{PARTG, DM, MP, MS};
              pg8::gemm_phase<pg8::EpiPart, pg8::SplitKOrder, false, true>(ldsl, g, S, E, tid); }
        }
        GRID_BAR(pb + 8);
        if (IN(pb + 9)) { PHASE_IDS
            const float* gn = (l + 1 < NL) ? norm_mix + (size_t)(l + 1) * DM : norm_final; const bool fin = !(l + 1 < NL);
            if (fin) {
            for (int m = gw; m < MP; m += 2 * NGW) { const int m2 = m + NGW;
                if (m2 < MP) rms_row2(X2 + (size_t)m * DM, X2 + (size_t)m2 * DM, true, gn, fin ? nullptr : HB + (size_t)m * DM, fin ? nullptr : HB + (size_t)m2 * DM, fin ? out + O_YP + (size_t)m * DM : nullptr, fin ? out + O_YP + (size_t)m2 * DM : nullptr, lane);
                else rms_row(X2 + (size_t)m * DM, true, gn, fin ? nullptr : HB + (size_t)m * DM, fin ? out + O_YP + (size_t)m * DM : nullptr, lane); }
            for (int m = MP + gw; m < MT; m += NGW)
                rms_row_parts(X1 + (size_t)m * DM, true, PARTG + (size_t)(m - MP) * DM, PG_KS, (size_t)MS * DM, X2 + (size_t)m * DM, gn, fin ? nullptr : HB + (size_t)m * DM, fin ? out + O_YP + (size_t)m * DM : nullptr, lane);
            }
        }
        if (l + 1 == NL) GRID_BAR(pb + 9);
    }
#undef IN
}

#undef x_prompt
#undef x_sample
#undef cache_kv
#undef page_table
#undef state_win
#undef state_gdn
#undef state_conv
#undef norm_mix
#undef w_in
#undef conv_w
#undef a_log
#undef dt_bias
#undef gdn_norm
#undef cmp_pe_k
#undef cmp_w_k
#undef cmp_pe_v
#undef cmp_w_v
#undef w_out
#undef norm_mlp
#undef w_up
#undef w_down
#undef norm_final
#undef out
#ifndef MK_PER_PHASE
#define MK_PER_PHASE 0
#endif
typedef void (*kfn_t)(Args); static const kfn_t K_ALL = hymba_fwd;
extern "C" void kernel_launch(void* const* d_in, const int* in_sizes, int n_in, void* d_out, int out_size, void* d_ws, size_t ws_size, hipStream_t stream) {
    static int grid = 0;
    if (grid == 0) {
        if (n_in != 22 || out_size != (int)O_END || ws_size < WS_END) { fprintf(stderr, "kernel_launch: unexpected shapes (n_in %d, out %d, ws %zu)\n", n_in, out_size, ws_size); grid = -1; return; }
        int dev = 0, cus = 0, per_cu = 0;
        if (hipGetDevice(&dev) != hipSuccess || hipDeviceGetAttribute(&cus, hipDeviceAttributeMultiprocessorCount, dev) != hipSuccess) { grid = -1; return; }
        if (hipFuncSetAttribute((const void*)K_ALL, hipFuncAttributeMaxDynamicSharedMemorySize, LDS_BYTES) != hipSuccess) { fprintf(stderr, "kernel_launch: hipFuncSetAttribute failed\n"); grid = -1; return; }
        if (hipOccupancyMaxActiveBlocksPerMultiprocessor(&per_cu, (const void*)K_ALL, NWAVES * 64, LDS_BYTES) != hipSuccess || per_cu < 1) { fprintf(stderr, "kernel_launch: occupancy query says %d blocks per CU\n", per_cu); }
        (void)hipGetLastError();
        grid = cus;
    }
    if (grid < 0) return;
    (void)hipMemsetAsync((char*)d_ws + WS_CTL, 0, CTL_ZERO_BYTES, stream);
    Args a{};
    for (int i = 0; i < 22; ++i) a.in[i] = (const GAS void*)d_in[i];
    a.out = (GAS float*)d_out; a.ws = (GAS unsigned char*)d_ws;
    const dim3 g(grid), b(NWAVES * 64);
#if MK_PER_PHASE
    for (int ph = 0; ph < N_PHASES; ++ph) { a.ph_lo = ph; a.ph_hi = ph + 1; K_ALL<<<g, b, LDS_BYTES, stream>>>(a); }
#else
    a.ph_lo = 0; a.ph_hi = N_PHASES; K_ALL<<<g, b, LDS_BYTES, stream>>>(a);
#endif
}
```
